# Optimizing an MI355X kernel written in HIP

```python
import math
import jax, jax.numpy as jnp
from jax import lax
import numpy as np

D_MODEL = 1024
BATCH = 8
SEQ = 2048
DEPTH = 1
DEC_BATCH = 128
DEC_SEQ = 4
PAST_LEN = 16384
PAGE_SIZE = 128

D_MIX = D_MODEL
W_A = D_MIX // 2
W_B = D_MIX - W_A
H_A = 8
HD_A = W_A // H_A
CONV_W = 4
LRU_C = 8.0
S5_GROUP = 16
G_B = W_B // S5_GROUP
N_S5 = 64
D_FF = 4 * D_MODEL
ALPHA = (2.0 * DEPTH) ** 0.25
BETA = (8.0 * DEPTH) ** -0.25
LN_EPS = 1e-5

kernel_name = "hymba_rglru_s5_deepnorm_adaln_step"


def layer_norm(x, g, b):
    xf = x.astype(jnp.float32)
    mu = jnp.mean(xf, axis=-1, keepdims=True)
    var = jnp.mean(jnp.square(xf - mu), axis=-1, keepdims=True)
    return (xf - mu) * lax.rsqrt(var + LN_EPS) * g + b


def causal_dwconv(x, buf, w, b):
    xx = jnp.concatenate([buf.astype(x.dtype), x], axis=1)
    y = lax.conv_general_dilated(xx, w[:, None, :].astype(xx.dtype), window_strides=(1,),
                                 padding='VALID', dimension_numbers=('NWC', 'WIO', 'NWC'),
                                 feature_group_count=x.shape[-1])
    return y + b, xx[:, -(CONV_W - 1):]


def linear_scan(a, b, h0):
    b = b.at[:, 0].add(a[:, 0] * h0)
    def comb(l, r):
        return (l[0] * r[0], r[0] * l[1] + r[1])
    _, h = lax.associative_scan(comb, (a, b), axis=1)
    return h


def complex_scan(ar, ai, br, bi, h0r, h0i):
    br = br.at[:, 0].add(ar[:, 0] * h0r - ai[:, 0] * h0i)
    bi = bi.at[:, 0].add(ar[:, 0] * h0i + ai[:, 0] * h0r)
    def comb(l, r):
        a1r, a1i, b1r, b1i = l
        a2r, a2i, b2r, b2i = r
        return (a2r * a1r - a2i * a1i, a2r * a1i + a2i * a1r,
                a2r * b1r - a2i * b1i + b2r, a2r * b1i + a2i * b1r + b2i)
    _, _, hr, hi = lax.associative_scan(comb, (ar, ai, br, bi), axis=1)
    return hr, hi


def rglru(x, h0, w_r, b_r, w_i, b_i, lam, reset_first):
    B, T, _ = x.shape
    xf = x.astype(jnp.float32)
    xh = xf.reshape(B, T, H_A, HD_A)
    r = jax.nn.sigmoid(jnp.einsum('bthi,hij->bthj', xh, w_r) + b_r).reshape(B, T, W_A)
    gi = jax.nn.sigmoid(jnp.einsum('bthi,hij->bthj', xh, w_i) + b_i).reshape(B, T, W_A)
    log_a = -LRU_C * r * jax.nn.softplus(-lam.astype(jnp.float32))
    a = jnp.exp(log_a)
    mult = jnp.sqrt(-jnp.expm1(2.0 * log_a))
    if reset_first:
        mult = mult.at[:, 0].set(1.0)
    return linear_scan(a, mult * gi * xf, h0.astype(jnp.float32))


def s5_ssm(u, s0r, s0i, a_re, a_im, log_dt, b_re, b_im, c_re, c_im, d_skip):
    B, T, _ = u.shape
    uf = u.astype(jnp.float32).reshape(B, T, G_B, S5_GROUP)
    dt = jnp.exp(log_dt.astype(jnp.float32))[:, None]
    ar = a_re.astype(jnp.float32)
    ai = a_im.astype(jnp.float32)
    mag = jnp.exp(dt * ar)
    abr = mag * jnp.cos(dt * ai)
    abi = mag * jnp.sin(dt * ai)
    den = ar * ar + ai * ai
    nr = abr - 1.0
    qr = (nr * ar + abi * ai) / den
    qi = (abi * ar - nr * ai) / den
    bbr = qr[..., None] * b_re - qi[..., None] * b_im
    bbi = qr[..., None] * b_im + qi[..., None] * b_re
    bur = jnp.einsum('btgk,gnk->btgn', uf, bbr)
    bui = jnp.einsum('btgk,gnk->btgn', uf, bbi)
    full = bur.shape
    hr, hi = complex_scan(jnp.broadcast_to(abr, full), jnp.broadcast_to(abi, full),
                          bur, bui, s0r.astype(jnp.float32), s0i.astype(jnp.float32))
    y = (jnp.einsum('btgn,gkn->btgk', hr, c_re) - jnp.einsum('btgn,gkn->btgk', hi, c_im)
         + d_skip * uf)
    return y.reshape(B, T, W_B), hr[:, -1], hi[:, -1]


def trunk_layer(x, c, conv_buf, h0, s0r, s0i, reset_first, p):
    mod = jnp.dot(jax.nn.silu(c), p['ada_w']) + p['ada_b']
    sh1, sc1, g1, sh2, sc2, g2 = [m[:, None, :] for m in jnp.split(mod, 6, axis=-1)]
    h = x * (1.0 + sc1) + sh1
    z = jnp.dot(h, p['in_proj'])
    gate_a = z[..., :W_A]
    xa = z[..., W_A:2 * W_A]
    xb = z[..., 2 * W_A:]
    xa_c, conv_new = causal_dwconv(xa, conv_buf, p['conv_w'], p['conv_b'])
    hseq = rglru(xa_c, h0, p['rg_wr'], p['rg_br'], p['rg_wi'], p['rg_bi'], p['rg_lam'], reset_first)
    y_a = jax.nn.gelu(gate_a) * hseq
    y_s, sr, si = s5_ssm(xb, s0r, s0i, p['s5_a_re'], p['s5_a_im'], p['s5_log_dt'],
                         p['s5_b_re'], p['s5_b_im'], p['s5_c_re'], p['s5_c_im'], p['s5_d'])
    gy = jax.nn.gelu(y_s)
    y_b = gy * jax.nn.sigmoid(jnp.dot(gy, p['glu_w']) + p['glu_b'])
    mix = jnp.dot(jnp.concatenate([y_a, y_b], axis=-1), p['out_proj'])
    x = layer_norm(ALPHA * x + g1 * mix, p['ln1_g'], p['ln1_b'])
    h = x * (1.0 + sc2) + sh2
    f = jnp.dot(jnp.square(jax.nn.relu(jnp.dot(h, p['mlp_w1']) + p['mlp_b1'])), p['mlp_w2']) + p['mlp_b2']
    x = layer_norm(ALPHA * x + g2 * f, p['ln2_g'], p['ln2_b'])
    return x, conv_new, hseq[:, -1], sr, si


def setup_inputs(seed: int = 0) -> dict:
    key = jax.random.key(seed)
    ks = iter(jax.random.split(key, 48))
    nrm = lambda shape, s: s * jax.random.normal(next(ks), shape, jnp.float32)
    L = DEPTH
    u = jax.random.uniform(next(ks), (L, W_A), jnp.float32, minval=0.9, maxval=0.999)
    base = u ** (1.0 / LRU_C)
    rg_lam = jnp.log(base) - jnp.log1p(-base)
    log_dt = jax.random.uniform(next(ks), (L, G_B), jnp.float32,
                                minval=math.log(0.001), maxval=math.log(0.1))
    a_im = math.pi * jnp.arange(N_S5, dtype=jnp.float32)
    return {
        "x_prompt": nrm((BATCH, SEQ, D_MODEL), 1.0),
        "x_sample": nrm((DEC_BATCH, DEC_SEQ, D_MODEL), 1.0),
        "state_conv": nrm((L, DEC_BATCH, CONV_W - 1, W_A), 1.0),
        "state_rglru_h": nrm((L, DEC_BATCH, W_A), 0.5),
        "state_s5_re": nrm((L, DEC_BATCH, G_B, N_S5), 0.3),
        "state_s5_im": nrm((L, DEC_BATCH, G_B, N_S5), 0.3),
        "c_prompt": nrm((BATCH, D_MODEL), 1.0),
        "c_sample": nrm((DEC_BATCH, D_MODEL), 1.0),
        "ada_w": nrm((L, D_MODEL, 6 * D_MODEL), 0.5 * D_MODEL ** -0.5),
        "ada_b": nrm((L, 6 * D_MODEL), 0.02),
        "in_proj": nrm((L, D_MODEL, 2 * W_A + W_B), D_MODEL ** -0.5),
        "conv_w": nrm((L, CONV_W, W_A), CONV_W ** -0.5),
        "conv_b": nrm((L, W_A), 0.02),
        "rg_wr": nrm((L, H_A, HD_A, HD_A), HD_A ** -0.5),
        "rg_br": nrm((L, H_A, HD_A), 0.02),
        "rg_wi": nrm((L, H_A, HD_A, HD_A), HD_A ** -0.5),
        "rg_bi": nrm((L, H_A, HD_A), 0.02),
        "rg_lam": rg_lam,
        "s5_a_re": -0.5 + nrm((L, G_B, N_S5), 0.01),
        "s5_a_im": a_im + nrm((L, G_B, N_S5), 0.01),
        "s5_log_dt": log_dt,
        "s5_b_re": nrm((L, G_B, N_S5, S5_GROUP), (2.0 * S5_GROUP) ** -0.5),
        "s5_b_im": nrm((L, G_B, N_S5, S5_GROUP), (2.0 * S5_GROUP) ** -0.5),
        "s5_c_re": nrm((L, G_B, S5_GROUP, N_S5), (2.0 * N_S5) ** -0.5),
        "s5_c_im": nrm((L, G_B, S5_GROUP, N_S5), (2.0 * N_S5) ** -0.5),
        "s5_d": nrm((L, G_B, S5_GROUP), 1.0),
        "glu_w": nrm((L, W_B, W_B), W_B ** -0.5),
        "glu_b": nrm((L, W_B), 0.02),
        "out_proj": nrm((L, D_MIX, D_MODEL), BETA * D_MIX ** -0.5),
        "ln1_g": 1.0 + nrm((L, D_MODEL), 0.02),
        "ln1_b": nrm((L, D_MODEL), 0.02),
        "mlp_w1": nrm((L, D_MODEL, D_FF), D_MODEL ** -0.5),
        "mlp_b1": nrm((L, D_FF), 0.02),
        "mlp_w2": nrm((L, D_FF, D_MODEL), BETA * D_FF ** -0.5),
        "mlp_b2": nrm((L, D_MODEL), 0.02),
        "ln2_g": 1.0 + nrm((L, D_MODEL), 0.02),
        "ln2_b": nrm((L, D_MODEL), 0.02),
    }


def reference(x_prompt, x_sample, state_conv, state_rglru_h, state_s5_re, state_s5_im,
              c_prompt, c_sample, ada_w, ada_b, in_proj, conv_w, conv_b, rg_wr, rg_br, rg_wi,
              rg_bi, rg_lam, s5_a_re, s5_a_im, s5_log_dt, s5_b_re, s5_b_im, s5_c_re, s5_c_im,
              s5_d, glu_w, glu_b, out_proj, ln1_g, ln1_b, mlp_w1, mlp_b1, mlp_w2, mlp_b2,
              ln2_g, ln2_b):
    xp = x_prompt
    xs = x_sample
    conv_p, h_p, sre_p, sim_p = [], [], [], []
    conv_s, h_s, sre_s, sim_s = [], [], [], []
    for l in range(DEPTH):
        p = dict(ada_w=ada_w[l], ada_b=ada_b[l], in_proj=in_proj[l], conv_w=conv_w[l],
                 conv_b=conv_b[l], rg_wr=rg_wr[l], rg_br=rg_br[l], rg_wi=rg_wi[l], rg_bi=rg_bi[l],
                 rg_lam=rg_lam[l], s5_a_re=s5_a_re[l], s5_a_im=s5_a_im[l], s5_log_dt=s5_log_dt[l],
                 s5_b_re=s5_b_re[l], s5_b_im=s5_b_im[l], s5_c_re=s5_c_re[l], s5_c_im=s5_c_im[l],
                 s5_d=s5_d[l], glu_w=glu_w[l], glu_b=glu_b[l], out_proj=out_proj[l],
                 ln1_g=ln1_g[l], ln1_b=ln1_b[l], mlp_w1=mlp_w1[l], mlp_b1=mlp_b1[l],
                 mlp_w2=mlp_w2[l], mlp_b2=mlp_b2[l], ln2_g=ln2_g[l], ln2_b=ln2_b[l])
        zc = jnp.zeros((xp.shape[0], CONV_W - 1, W_A), xp.dtype)
        zh = jnp.zeros((xp.shape[0], W_A), jnp.float32)
        zs = jnp.zeros((xp.shape[0], G_B, N_S5), jnp.float32)
        xp, cb, hl, sr, si = trunk_layer(xp, c_prompt, zc, zh, zs, zs, True, p)
        conv_p.append(cb); h_p.append(hl); sre_p.append(sr); sim_p.append(si)
        xs, cb, hl, sr, si = trunk_layer(xs, c_sample, state_conv[l], state_rglru_h[l],
                                         state_s5_re[l], state_s5_im[l], False, p)
        conv_s.append(cb); h_s.append(hl); sre_s.append(sr); sim_s.append(si)
    return (xp, xs, jnp.stack(conv_p), jnp.stack(h_p), jnp.stack(sre_p), jnp.stack(sim_p),
            jnp.stack(conv_s), jnp.stack(h_s), jnp.stack(sre_s), jnp.stack(sim_s))
```

```cpp
#include <hip/hip_runtime.h>
#include <cstdio>
#include <cstdint>
#include <cmath>

#ifndef MK_N_LAUNCHES
#define MK_N_LAUNCHES 10
#endif

namespace pg8 {
#define PG8_LAS __attribute__((address_space(3)))
typedef unsigned short bf16_t;
typedef short bf16x8 __attribute__((ext_vector_type(8)));
typedef float f32x4 __attribute__((ext_vector_type(4)));
typedef unsigned u32x4 __attribute__((ext_vector_type(4)));
constexpr int BM = 256, BK = 64, HALF = 128, HTB = HALF * BK * 2, STAGE_BYTES = 8 * HTB, NXCD = 8, WGM = 8;

__host__ __device__ __forceinline__ int lds_byte(int r, int c) { const int st = (r >> 4) * 2 + (c >> 5), rr = r & 15, cc = c & 31, ob = rr * 64 + cc * 2; return st * 1024 + (ob ^ (((ob >> 9) & 1) << 5)); }
__host__ __device__ __forceinline__ void stage_rc(int b, int& R, int& C) { const int st = b / 1024, sb = b % 1024, swz = sb ^ (((sb >> 9) & 1) << 5); R = (st >> 1) * 16 + swz / 64; C = (st & 1) * 32 + (swz % 64) / 2; }
__host__ __device__ __forceinline__ int perm32(int rho) { const int n = rho >> 4, i = rho & 15; return 8 * (i >> 2) + 4 * n + (i & 3); }

struct Unit { int pm, pn; };
struct Gemm { const bf16_t* A; const bf16_t* Bt; int M, N, K; };

struct StaticOrder {
    int nM, nN, nwg, G, c;
    __host__ __device__ void init(int M, int N, int G_, int c_) { nM = M / BM; nN = N / BM; nwg = nM * nN; G = G_; c = c_; }
    __host__ __device__ bool next(int i, Unit& u) const {
        const long L = (long)i * G + c; if (L >= nwg) return false;
        int wgid = (int)L; { const int q = nwg / NXCD, r = nwg % NXCD, xcd = wgid % NXCD, off = wgid / NXCD; wgid = (xcd < r ? xcd * (q + 1) : r * (q + 1) + (xcd - r) * q) + off; }
        const int nig = WGM * nN, gid = wgid / nig, fm = gid * WGM, gsz = (nM - fm) < WGM ? (nM - fm) : WGM;
        u.pm = fm + ((wgid % nig) % gsz); u.pn = (wgid % nig) / gsz; return true;
    }
    __device__ __forceinline__ void a_ready(const Unit&) const {}
    __device__ __forceinline__ void done(const Unit&) const {}
};

__device__ __forceinline__ unsigned cvt_pk_bf16(float lo, float hi) { unsigned r; asm volatile("v_cvt_pk_bf16_f32 %0, %1, %2" : "=v"(r) : "v"(lo), "v"(hi)); return r; }
__device__ __forceinline__ float bf_lo(unsigned w) { return __builtin_bit_cast(float, w << 16); }
__device__ __forceinline__ float bf_hi(unsigned w) { return __builtin_bit_cast(float, w & 0xffff0000u); }

template <int ACT> struct EpiBf16 {
    static constexpr bool PERM = true, AFTER_DRAIN = false;
    bf16_t* O; int ldc; const float* bias;
    __device__ __forceinline__ void operator()(const f32x4 (&acc)[2][2][4][2], const Unit& u, int wr, int wc, int fr, int fq) const {
        const int row0 = u.pm * BM + wr * 64 + fr; const int col0 = u.pn * BM + wc * 32 + 8 * fq;
        f32x4 bv[2][2];
#pragma unroll
        for (int bj = 0; bj < 2; ++bj)
#pragma unroll
            for (int n = 0; n < 2; ++n) bv[bj][n] = bias ? *(const f32x4*)(bias + col0 + bj * HALF + 4 * n) : (f32x4){0.f, 0.f, 0.f, 0.f};
#pragma unroll
        for (int ai = 0; ai < 2; ++ai)
#pragma unroll
            for (int m = 0; m < 4; ++m) { bf16_t* rowp = O + (size_t)(row0 + ai * HALF + m * 16) * ldc + col0;
#pragma unroll
                for (int bj = 0; bj < 2; ++bj) { f32x4 v0 = acc[ai][bj][m][0] + bv[bj][0], v1 = acc[ai][bj][m][1] + bv[bj][1];
                    if (ACT == 3) {
#pragma unroll
                        for (int e = 0; e < 4; ++e) { const float a = fmaxf(v0[e], 0.f), b = fmaxf(v1[e], 0.f); v0[e] = a * a; v1[e] = b * b; } }
                    u32x4 w; w.x = cvt_pk_bf16(v0[0], v0[1]); w.y = cvt_pk_bf16(v0[2], v0[3]); w.z = cvt_pk_bf16(v1[0], v1[1]); w.w = cvt_pk_bf16(v1[2], v1[3]);
                    *(u32x4*)(rowp + bj * HALF) = w; } }
    }
};
struct EpiGlu {
    static constexpr bool PERM = true, AFTER_DRAIN = false;
    const bf16_t* Gy; int ldg; bf16_t* O; int ldc; int coff; const float* bias;
    __device__ __forceinline__ void operator()(const f32x4 (&acc)[2][2][4][2], const Unit& u, int wr, int wc, int fr, int fq) const {
        const int row0 = u.pm * BM + wr * 64 + fr; const int col0 = u.pn * BM + wc * 32 + 8 * fq;
        f32x4 bv[2][2];
#pragma unroll
        for (int bj = 0; bj < 2; ++bj)
#pragma unroll
            for (int n = 0; n < 2; ++n) bv[bj][n] = *(const f32x4*)(bias + col0 + bj * HALF + 4 * n);
#pragma unroll
        for (int ai = 0; ai < 2; ++ai)
#pragma unroll
            for (int m = 0; m < 4; ++m) { const size_t row = (size_t)(row0 + ai * HALF + m * 16);
#pragma unroll
                for (int bj = 0; bj < 2; ++bj) { const f32x4 v0 = acc[ai][bj][m][0] + bv[bj][0], v1 = acc[ai][bj][m][1] + bv[bj][1];
                    const u32x4 g = *(const u32x4*)(Gy + row * ldg + col0 + bj * HALF);
                    float o[8];
                    o[0] = bf_lo(g.x) / (1.f + __expf(-v0[0])); o[1] = bf_hi(g.x) / (1.f + __expf(-v0[1]));
                    o[2] = bf_lo(g.y) / (1.f + __expf(-v0[2])); o[3] = bf_hi(g.y) / (1.f + __expf(-v0[3]));
                    o[4] = bf_lo(g.z) / (1.f + __expf(-v1[0])); o[5] = bf_hi(g.z) / (1.f + __expf(-v1[1]));
                    o[6] = bf_lo(g.w) / (1.f + __expf(-v1[2])); o[7] = bf_hi(g.w) / (1.f + __expf(-v1[3]));
                    u32x4 w; w.x = cvt_pk_bf16(o[0], o[1]); w.y = cvt_pk_bf16(o[2], o[3]); w.z = cvt_pk_bf16(o[4], o[5]); w.w = cvt_pk_bf16(o[6], o[7]);
                    *(u32x4*)(O + row * ldc + coff + col0 + bj * HALF) = w; } }
    }
};
struct EpiRes {
    static constexpr bool PERM = false, AFTER_DRAIN = false;
    const float* basep; const float* bases; float* out; const float* gate  ; const float* bias; float alpha; int MP;
    __device__ __forceinline__ void operator()(const f32x4 (&acc)[2][2][4][2], const Unit& u, int wr, int wc, int fr, int fq) const {
        const int row0 = u.pm * BM + wr * 64 + fr, col0 = u.pn * BM + wc * 32 + 4 * fq;
        f32x4 bv[2][2];
#pragma unroll
        for (int bj = 0; bj < 2; ++bj)
#pragma unroll
            for (int n = 0; n < 2; ++n) bv[bj][n] = bias ? *(const f32x4*)(bias + col0 + bj * HALF + n * 16) : (f32x4){0.f, 0.f, 0.f, 0.f};
#pragma unroll
        for (int ai = 0; ai < 2; ++ai)
#pragma unroll
            for (int m = 0; m < 4; ++m) { const int row = row0 + ai * HALF + m * 16;
                const bool smp = row >= MP; const int mr = smp ? 8 + ((row - MP) >> 2) : (row >> 11);
                const float* bp = smp ? bases + (size_t)(row - MP) * 1024 : basep + (size_t)row * 1024;
                const float* gp = gate + (size_t)mr * 6144; float* op = out + (size_t)row * 1024;
#pragma unroll
                for (int bj = 0; bj < 2; ++bj)
#pragma unroll
                    for (int n = 0; n < 2; ++n) { const int c = col0 + bj * HALF + n * 16;
                        const f32x4 b = *(const f32x4*)(bp + c), g = *(const f32x4*)(gp + c);
                        *(f32x4*)(op + c) = b * alpha + g * (acc[ai][bj][m][n] + bv[bj][n]); } }
    }
};

template <class Epi, class Sched, bool ALIGN_EPI = false, bool SP2 = false>
__device__ __forceinline__ void gemm_phase(PG8_LAS unsigned char* lds, const Gemm g, const Sched& S, const Epi& E) {
    const int tid = threadIdx.x, wid = __builtin_amdgcn_readfirstlane(tid >> 6), lane = tid & 63, wr = wid >> 2, wc = wid & 3, fr = lane & 15, fq = lane >> 4;
    const int K = g.K, nt = K / BK;
    unsigned voffA[2], voffB[2];
#pragma unroll
    for (int i = 0; i < 2; ++i) { int R, C; stage_rc(tid * 16 + i * 8192, R, C); const int Rb = Epi::PERM ? ((R & ~31) + perm32(R & 31)) : R;
        voffA[i] = (unsigned)(R * K + C) * 2u; voffB[i] = (unsigned)(Rb * K + C) * 2u; }
    const size_t kstep = (size_t)(BK * 2);
    const size_t hstep = (size_t)HALF * K * 2;
    const size_t tstep = 2 * hstep;
    const unsigned ldsw = (unsigned)wid * 1024u;
    const int aoff = lds_byte(wr * 64 + fr, fq * 8), boff = lds_byte(wc * 32 + fr, fq * 8);
#define PG8_SA(b, h) (((b) * 2 + (h)) * HTB)
#define PG8_SB(b, h) ((4 + (b) * 2 + (h)) * HTB)
#define PG8_STAGE(bufoff, gbase, voff) do { _Pragma("unroll") for (int _i = 0; _i < 2; ++_i) \
        __builtin_amdgcn_global_load_lds((const unsigned*)((const char*)(gbase) + (voff)[_i]), (PG8_LAS unsigned*)(lds + (bufoff) + ldsw + _i * 8192), 16, 0, 0); } while (0)
#define PG8_LDA(dst, b, h) do { _Pragma("unroll") for (int m = 0; m < 4; ++m) _Pragma("unroll") for (int k = 0; k < 2; ++k) dst[m][k] = *(const PG8_LAS bf16x8*)(lds + PG8_SA(b, h) + aoff + m * 2048 + k * 1024); } while (0)
#define PG8_LDB(dst, b, h) do { _Pragma("unroll") for (int n = 0; n < 2; ++n) _Pragma("unroll") for (int k = 0; k < 2; ++k) dst[n][k] = *(const PG8_LAS bf16x8*)(lds + PG8_SB(b, h) + boff + n * 2048 + k * 1024); } while (0)
#define PG8_MMA(ai, bj, At, Bt) do { __builtin_amdgcn_s_setprio(1); _Pragma("unroll") for (int m = 0; m < 4; ++m) _Pragma("unroll") for (int n = 0; n < 2; ++n) _Pragma("unroll") for (int k = 0; k < 2; ++k) \
        acc[ai][bj][m][n] = __builtin_amdgcn_mfma_f32_16x16x32_bf16(Bt[n][k], At[m][k], acc[ai][bj][m][n], 0, 0, 0); __builtin_amdgcn_s_setprio(0); } while (0)
#define PG8_WAIT_V(n) asm volatile("s_waitcnt vmcnt(" #n ")" ::: "memory")
#define PG8_WAIT_L(n) asm volatile("s_waitcnt lgkmcnt(" #n ")" ::: "memory")
#define PG8_BAR __builtin_amdgcn_s_barrier()
#define PG8_SCHED __builtin_amdgcn_sched_barrier(0)
    Unit cur, nxt; int ui = 0;
    if (!S.next(0, cur)) return;
    f32x4 acc[2][2][4][2];
#pragma unroll
    for (int a = 0; a < 2; ++a)
#pragma unroll
        for (int b = 0; b < 2; ++b)
#pragma unroll
            for (int m = 0; m < 4; ++m)
#pragma unroll
                for (int n = 0; n < 2; ++n) acc[a][b][m][n] = (f32x4){0.f, 0.f, 0.f, 0.f};
    bf16x8 At[4][2], B0[2][2], B1[2][2];
    const char* cA = (const char*)g.A + (size_t)cur.pm * tstep; const char* cB = (const char*)g.Bt + (size_t)cur.pn * tstep;
    S.a_ready(cur);
    if constexpr (SP2) {
        PG8_STAGE(PG8_SB(0, 0), cB, voffB); PG8_STAGE(PG8_SB(0, 1), cB + hstep, voffB); PG8_STAGE(PG8_SA(0, 0), cA, voffA); PG8_STAGE(PG8_SA(0, 1), cA + hstep, voffA);
        if (wr == 1) PG8_BAR;
        PG8_WAIT_V(2); PG8_BAR;
        PG8_STAGE(PG8_SB(1, 0), cB + kstep, voffB); PG8_STAGE(PG8_SA(1, 0), cA + kstep, voffA); PG8_STAGE(PG8_SB(1, 1), cB + hstep + kstep, voffB);
        PG8_WAIT_V(6); PG8_BAR;
    } else {
        PG8_STAGE(PG8_SB(0, 0), cB, voffB); PG8_STAGE(PG8_SA(0, 0), cA, voffA); PG8_STAGE(PG8_SB(0, 1), cB + hstep, voffB); PG8_STAGE(PG8_SA(0, 1), cA + hstep, voffA);
        if (wr == 1) PG8_BAR;
        PG8_WAIT_V(4); PG8_BAR;
        PG8_STAGE(PG8_SB(1, 0), cB + kstep, voffB); PG8_STAGE(PG8_SA(1, 0), cA + kstep, voffA); PG8_STAGE(PG8_SB(1, 1), cB + hstep + kstep, voffB);
        PG8_WAIT_V(6); PG8_BAR;
    }
    for (;;) {
        const bool has_next = S.next(ui + 1, nxt);
        const char* nA = has_next ? (const char*)g.A + (size_t)nxt.pm * tstep : cA; const char* nB = has_next ? (const char*)g.Bt + (size_t)nxt.pn * tstep : cB;
        for (int t = 0; t < nt; t += 2) {
            const bool last = (t == nt - 2);
            const char* a1 = cA + (size_t)(t + 1) * kstep;
            const char* a2 = last ? nA : cA + (size_t)(t + 2) * kstep; const char* b2 = last ? nB : cB + (size_t)(t + 2) * kstep;
            const char* a3 = a2 + kstep; const char* b3 = b2 + kstep;
            if (last && has_next) S.a_ready(nxt);
            if constexpr (SP2) {
            PG8_LDB(B0, 0, 0); PG8_LDB(B1, 0, 1); PG8_SCHED; PG8_LDA(At, 0, 0); PG8_STAGE(PG8_SA(1, 1), a1 + hstep, voffA);
            PG8_WAIT_V(8); PG8_WAIT_L(0); PG8_BAR; PG8_MMA(0, 0, At, B0); PG8_MMA(0, 1, At, B1); PG8_BAR; PG8_SCHED;
            PG8_LDA(At, 0, 1); PG8_STAGE(PG8_SB(0, 0), b2, voffB); PG8_STAGE(PG8_SB(0, 1), b2 + hstep, voffB); PG8_STAGE(PG8_SA(0, 0), a2, voffA);
            PG8_WAIT_V(8); PG8_WAIT_L(0); PG8_BAR; PG8_MMA(1, 0, At, B0); PG8_MMA(1, 1, At, B1); PG8_BAR; PG8_SCHED;
            PG8_LDB(B0, 1, 0); PG8_LDB(B1, 1, 1); PG8_SCHED; PG8_LDA(At, 1, 0); PG8_STAGE(PG8_SA(0, 1), a2 + hstep, voffA);
            PG8_WAIT_V(8); PG8_WAIT_L(0); PG8_BAR; PG8_MMA(0, 0, At, B0); PG8_MMA(0, 1, At, B1); PG8_BAR; PG8_SCHED;
            PG8_LDA(At, 1, 1); PG8_STAGE(PG8_SB(1, 0), b3, voffB); PG8_STAGE(PG8_SB(1, 1), b3 + hstep, voffB); PG8_STAGE(PG8_SA(1, 0), a3, voffA);
            PG8_WAIT_V(8); PG8_WAIT_L(0); PG8_BAR; PG8_MMA(1, 0, At, B0); PG8_MMA(1, 1, At, B1); PG8_BAR; PG8_SCHED;
            } else {
            PG8_LDB(B0, 0, 0); PG8_SCHED; PG8_LDA(At, 0, 0); PG8_STAGE(PG8_SA(1, 1), a1 + hstep, voffA);
            PG8_WAIT_L(8); PG8_BAR; PG8_WAIT_L(0); PG8_MMA(0, 0, At, B0); PG8_BAR; PG8_SCHED;
            PG8_LDB(B1, 0, 1); PG8_STAGE(PG8_SB(0, 0), b2, voffB);
            PG8_BAR; PG8_WAIT_L(0); PG8_MMA(0, 1, At, B1); PG8_BAR;
            PG8_LDA(At, 0, 1); PG8_STAGE(PG8_SA(0, 0), a2, voffA);
            PG8_BAR; PG8_WAIT_L(0); PG8_MMA(1, 0, At, B0); PG8_BAR; PG8_SCHED;
            PG8_STAGE(PG8_SB(0, 1), b2 + hstep, voffB);
            PG8_WAIT_V(6); PG8_BAR; PG8_MMA(1, 1, At, B1); PG8_BAR;
            PG8_LDB(B0, 1, 0); PG8_SCHED; PG8_LDA(At, 1, 0); PG8_STAGE(PG8_SA(0, 1), a2 + hstep, voffA);
            PG8_WAIT_L(8); PG8_BAR; PG8_WAIT_L(0); PG8_MMA(0, 0, At, B0); PG8_BAR; PG8_SCHED;
            PG8_LDB(B1, 1, 1); PG8_STAGE(PG8_SB(1, 0), b3, voffB);
            PG8_BAR; PG8_WAIT_L(0); PG8_MMA(0, 1, At, B1); PG8_BAR;
            PG8_LDA(At, 1, 1); PG8_STAGE(PG8_SA(1, 0), a3, voffA);
            PG8_BAR; PG8_WAIT_L(0); PG8_MMA(1, 0, At, B0); PG8_BAR; PG8_SCHED;
            PG8_STAGE(PG8_SB(1, 1), b3 + hstep, voffB);
            PG8_WAIT_V(6); PG8_BAR; PG8_MMA(1, 1, At, B1); PG8_BAR;
            }
        }
        if constexpr (ALIGN_EPI) { if (wr == 0) PG8_BAR; }
        if constexpr (!Epi::AFTER_DRAIN) { E(acc, cur, wr, wc, fr, fq); S.done(cur); }
        if (!has_next) break;
#pragma unroll
        for (int a = 0; a < 2; ++a)
#pragma unroll
            for (int b = 0; b < 2; ++b)
#pragma unroll
                for (int m = 0; m < 4; ++m)
#pragma unroll
                    for (int n = 0; n < 2; ++n) acc[a][b][m][n] = (f32x4){0.f, 0.f, 0.f, 0.f};
        cur = nxt; cA = nA; cB = nB; ++ui;
        if constexpr (ALIGN_EPI) { if (wr == 1) PG8_BAR; }
    }
    PG8_WAIT_V(0);
    if constexpr (!ALIGN_EPI) { if (wr == 0) PG8_BAR; }
    PG8_BAR;
#undef PG8_SA
#undef PG8_SB
#undef PG8_STAGE
#undef PG8_LDA
#undef PG8_LDB
#undef PG8_MMA
#undef PG8_WAIT_V
#undef PG8_WAIT_L
#undef PG8_BAR
#undef PG8_SCHED
}
}

#ifndef PG8_SP2
#define PG8_SP2 true
#endif
#ifndef PG8_ALIGN
#define PG8_ALIGN true
#endif

constexpr int NWAVES = 8;
constexpr int N_LAUNCHES = MK_N_LAUNCHES;
constexpr int N_PHASES = 10;
constexpr int D = 1024, MP = 16384, MS = 512, M = MP + MS, TP = 2048, NBP = 8, NBS = 128, TS = 4;
constexpr int NZ = 1536, WA = 512, WB = 512, FF = 4096, NMOD = 6 * D, NROWMOD = NBP + NBS;
constexpr int GB = 32, NS5 = 64, KS5 = 16, HA = 8, HDA = 64;
constexpr float LN_EPS = 1e-5f;
constexpr float ALPHA = 1.189207115002721f;

constexpr size_t O_YP = 0, O_YS = (size_t)MP * D, O_CONVP = O_YS + (size_t)MS * D, O_HP = O_CONVP + (size_t)NBP * 3 * WA, O_SRP = O_HP + (size_t)NBP * WA,
                 O_SIP = O_SRP + (size_t)NBP * GB * NS5, O_CONVS = O_SIP + (size_t)NBP * GB * NS5, O_HS = O_CONVS + (size_t)NBS * 3 * WA, O_SRS = O_HS + (size_t)NBS * WA,
                 O_SIS = O_SRS + (size_t)NBS * GB * NS5, O_END = O_SIS + (size_t)NBS * GB * NS5;

constexpr size_t MiB = 1u << 20;
constexpr size_t WS_CTL = 0, CTL_ZERO_BYTES = 1 * MiB;
constexpr size_t WS_WIN = 1 * MiB, WS_WGLU = 4 * MiB, WS_WOUT = 5 * MiB, WS_W1 = 7 * MiB, WS_W2 = 15 * MiB;
constexpr size_t WS_MOD = 23 * MiB;
constexpr size_t WS_S5C = 27 * MiB;
constexpr size_t WS_XN = 28 * MiB;
constexpr size_t WS_Z = 61 * MiB;
constexpr size_t WS_YCAT = 111 * MiB;
constexpr size_t WS_G = 144 * MiB;
constexpr size_t WS_U = 61 * MiB;
constexpr size_t WS_END = 194 * MiB;
static_assert(WS_XN + (size_t)M * D * 2 <= WS_Z && WS_Z + (size_t)M * NZ * 2 <= WS_YCAT && WS_YCAT + (size_t)M * D * 2 <= WS_G && WS_G + (size_t)M * WB * 2 <= WS_END && WS_U + (size_t)M * FF * 2 <= WS_END, "d_ws map");
constexpr int SC_ABR = 0, SC_ABI = 2048, SC_BBR = 4096, SC_BBI = 4096 + 32768, SC_RGL = 4096 + 65536, SC_END = SC_RGL + 512;
constexpr int CW_TMO = 0, CW_CODE = 1, CW_BAR = 4096;

constexpr int RING_OFF = 0, RING_BYTES = 131072;
constexpr int LDSCTL_OFF = RING_BYTES, MISC_OFF = LDSCTL_OFF + 320;
constexpr int LDS_BYTES = 147456;

#define GAS __attribute__((address_space(1)))
#define LAS __attribute__((address_space(3)))
typedef unsigned short bf16;
typedef unsigned v4u __attribute__((ext_vector_type(4)));
typedef float f32x4 __attribute__((ext_vector_type(4)));
typedef GAS unsigned gu32;
#define RLX_AGENT __ATOMIC_RELAXED, __HIP_MEMORY_SCOPE_AGENT
#define LDS_WAIT() asm volatile("s_waitcnt lgkmcnt(0)" ::: "memory")
#define VM_WAIT() asm volatile("s_waitcnt vmcnt(0)" ::: "memory")
__device__ __forceinline__ unsigned f2bf(float f) { unsigned u = __builtin_bit_cast(unsigned, f); return (u + 0x7fffu + ((u >> 16) & 1u)) >> 16; }
__device__ __forceinline__ unsigned pk2(float lo, float hi) { return f2bf(lo) | (f2bf(hi) << 16); }
__device__ __forceinline__ float bf2f(bf16 v) { return __builtin_bit_cast(float, (unsigned)v << 16); }
__device__ __forceinline__ float gelu_tanh(float x) { const float t = 1.5957691216057308f * (x + 0.044715f * x * x * x); return x / (1.f + __expf(-t)); }
__device__ __forceinline__ float sigmoidf_(float x) { return 1.f / (1.f + __expf(-x)); }

#define XB_TMO      128
#define XB_XCNT(j)  (256  + 64 * (j))
#define XB_XSUB(j)  (1280 + 64 * (j))
#define XB_XGEN(j)  (2304 + 64 * (j))
#define XB_TOP      3328
#define XB_TOPGEN   3392
#define XCD_BAR_WORDS 3456
#define XB_SPIN_CAP (1u << 18)
__device__ __forceinline__ unsigned xb_ld(unsigned* p)              { return __hip_atomic_load(p, __ATOMIC_RELAXED, __HIP_MEMORY_SCOPE_AGENT); }
__device__ __forceinline__ unsigned xb_add(unsigned* p, unsigned v) { return __hip_atomic_fetch_add(p, v, __ATOMIC_RELAXED, __HIP_MEMORY_SCOPE_AGENT); }
__device__ __forceinline__ unsigned xb_xcc_id() { return (unsigned)__builtin_amdgcn_s_getreg((3 << 11) | 20) & 0xFu; }
#define XB_SPIN(cond, bar) do { unsigned _sp = 0; while (cond) { __builtin_amdgcn_s_sleep(1); \
    if ((++_sp & 255u) == 0u) { if (xb_ld(&(bar)[XB_TMO])) break; if (_sp > XB_SPIN_CAP) { atomicAdd(&(bar)[XB_TMO], 1u); break; } } } } while (0)
struct XcdBarrier { unsigned* bar; unsigned x; volatile LAS unsigned* st; };
__device__ __forceinline__ XcdBarrier xcd_barrier_post(unsigned* bar, volatile LAS unsigned* st) {
    XcdBarrier b; b.bar = bar; b.x = xb_xcc_id(); b.st = st;
    if (threadIdx.x == 0) (void)xb_add(&bar[XB_XCNT(b.x)], 1u);
    return b;
}
__device__ __forceinline__ void xcd_barrier_complete(unsigned* bar, unsigned x, unsigned& nloc, unsigned& nx) {
    const unsigned G = gridDim.x * gridDim.y * gridDim.z;
    unsigned sum, cnt, mine, sp = 0u;
    for (;;) {
        sum = 0u; cnt = 0u; mine = 0u;
#pragma unroll
        for (unsigned j = 0; j < 16; ++j) { const unsigned c = xb_ld(&bar[XB_XCNT(j)]); sum += c; cnt += (c > 0u) ? 1u : 0u; mine = (j == x) ? c : mine; }
        if (sum == G) break;
        __builtin_amdgcn_s_sleep(1);
        if ((++sp & 255u) == 0u) { if (xb_ld(&bar[XB_TMO])) break; if (sp > XB_SPIN_CAP) { atomicAdd(&bar[XB_TMO], 1u); break; } }
    }
    nloc = mine > 0u ? mine : 1u; nx = cnt > 0u ? cnt : 1u;
}
__device__ __forceinline__ void xcd_barrier(const XcdBarrier& b) {
    asm volatile("s_waitcnt vmcnt(0)" ::: "memory");
    __syncthreads();
    if (threadIdx.x == 0) {
        unsigned* bar = b.bar;
        __builtin_amdgcn_s_waitcnt(0);
        unsigned nloc = b.st[0], nx = b.st[1];
        if (nloc == 0u) { xcd_barrier_complete(bar, b.x, nloc, nx); b.st[0] = nloc; b.st[1] = nx; }
        const unsigned old = xb_add(&bar[XB_XSUB(b.x)], 1u);
        const unsigned gen = old / nloc;
        if (old + 1u == (gen + 1u) * nloc) {
            __builtin_amdgcn_fence(__ATOMIC_RELEASE, "agent");
            asm volatile("s_waitcnt vmcnt(0)" ::: "memory");
            const unsigned og = xb_add(&bar[XB_TOP], 1u);
            const unsigned tg = og / nx;
            if (og + 1u == (tg + 1u) * nx) xb_add(&bar[XB_TOPGEN], 1u);
            else XB_SPIN(xb_ld(&bar[XB_TOPGEN]) == tg, bar);
            __builtin_amdgcn_fence(__ATOMIC_ACQUIRE, "agent");
            xb_add(&bar[XB_XGEN(b.x)], 1u);
            asm volatile("s_waitcnt vmcnt(0)" ::: "memory");
        } else {
            XB_SPIN(xb_ld(&bar[XB_XGEN(b.x)]) == gen, bar);
            __builtin_amdgcn_fence(__ATOMIC_ACQUIRE, "agent");
            asm volatile("s_waitcnt vmcnt(0)" ::: "memory");
        }
    }
    __syncthreads();
}

struct Frame {
    LAS unsigned char* lds;
    volatile LAS unsigned* MISC;
    gu32* ctl;
    int tid, lane, wave;
    int vcu, G;
    float* out;
    unsigned char* ws;
};
struct Args { const float* in[37]; float* out; unsigned char* ws; int ph_lo, ph_hi, li, pad; };
__device__ __forceinline__ float wave_sum(float v) {
#pragma unroll
    for (int o = 1; o < 64; o <<= 1) v += __shfl_xor(v, o);
    return v;
}
enum { I_XP = 0, I_XS, I_SCONV, I_SH, I_SSR, I_SSI, I_CP, I_CS, I_ADAW, I_ADAB, I_INPROJ, I_CONVW, I_CONVB, I_RGWR, I_RGBR, I_RGWI, I_RGBI, I_RGLAM,
       I_S5ARE, I_S5AIM, I_S5LOGDT, I_S5BRE, I_S5BIM, I_S5CRE, I_S5CIM, I_S5D, I_GLUW, I_GLUB, I_OUTPROJ, I_LN1G, I_LN1B, I_W1, I_B1, I_W2, I_B2, I_LN2G, I_LN2B };

__device__ __forceinline__ void p0_transpose_item(const float* W, int K, int N, bf16* WT, LAS float* scr, int item, int lane) {
    const int nblk = N / 32, kb = item / nblk, nb = item % nblk, k0 = 64 * kb, n0 = 32 * nb;
#pragma unroll 8
    for (int i = 0; i < 32; ++i) { const int kk = 2 * i + (lane >> 5); scr[kk * 33 + (lane & 31)] = W[(size_t)(k0 + kk) * N + n0 + (lane & 31)]; }
    LDS_WAIT(); asm volatile("" ::: "memory");
    const int c = lane & 7;
#pragma unroll
    for (int j = 0; j < 4; ++j) { const int n = (lane >> 3) + 8 * j; const LAS float* s = scr + (8 * c) * 33 + n;
        v4u o; o.x = pk2(s[0 * 33], s[1 * 33]); o.y = pk2(s[2 * 33], s[3 * 33]); o.z = pk2(s[4 * 33], s[5 * 33]); o.w = pk2(s[6 * 33], s[7 * 33]);
        *(GAS v4u*)(WT + (size_t)(n0 + n) * K + k0 + 8 * c) = o; }
    LDS_WAIT(); asm volatile("" ::: "memory");
}

__device__ __forceinline__ void p0_prologue(Frame& F, const Args& A) {
    LAS float* scr = (LAS float*)(F.lds + RING_OFF + F.wave * 16384);
    const int gw = F.wave * F.G + F.vcu, NGW = F.G * NWAVES;
    constexpr int I_IN = (D / 64) * (NZ / 32), I_GL = (WB / 64) * (WB / 32), I_OU = (D / 64) * (D / 32), I_1 = (D / 64) * (FF / 32), I_2 = (FF / 64) * (D / 32);
    constexpr int I_S5 = GB, I_RG = WA / 64;
    constexpr int NITEMS = I_IN + I_GL + I_OU + I_1 + I_2 + I_S5 + I_RG;
    float* sc = (float*)(F.ws + WS_S5C);
    for (int it = gw; it < NITEMS; it += NGW) {
        int r = it;
        if (r < I_IN) { p0_transpose_item(A.in[I_INPROJ], D, NZ, (bf16*)(F.ws + WS_WIN), scr, r, F.lane); continue; } r -= I_IN;
        if (r < I_GL) { p0_transpose_item(A.in[I_GLUW], WB, WB, (bf16*)(F.ws + WS_WGLU), scr, r, F.lane); continue; } r -= I_GL;
        if (r < I_OU) { p0_transpose_item(A.in[I_OUTPROJ], D, D, (bf16*)(F.ws + WS_WOUT), scr, r, F.lane); continue; } r -= I_OU;
        if (r < I_1) { p0_transpose_item(A.in[I_W1], D, FF, (bf16*)(F.ws + WS_W1), scr, r, F.lane); continue; } r -= I_1;
        if (r < I_2) { p0_transpose_item(A.in[I_W2], FF, D, (bf16*)(F.ws + WS_W2), scr, r, F.lane); continue; } r -= I_2;
        if (r < I_S5) {
            const int g = r, n = F.lane, gn = g * NS5 + n;
            const double dt = exp((double)A.in[I_S5LOGDT][g]), ar = (double)A.in[I_S5ARE][gn], ai = (double)A.in[I_S5AIM][gn];
            const double mag = exp(dt * ar), abr = mag * cos(dt * ai), abi = mag * sin(dt * ai), den = ar * ar + ai * ai, nr = abr - 1.0;
            const double qr = (nr * ar + abi * ai) / den, qi = (abi * ar - nr * ai) / den;
            sc[SC_ABR + gn] = (float)abr; sc[SC_ABI + gn] = (float)abi;
            for (int k = 0; k < KS5; ++k) { const double br = (double)A.in[I_S5BRE][gn * KS5 + k], bi = (double)A.in[I_S5BIM][gn * KS5 + k];
                sc[SC_BBR + gn * KS5 + k] = (float)(qr * br - qi * bi); sc[SC_BBI + gn * KS5 + k] = (float)(qr * bi + qi * br); }
            continue; } r -= I_S5;
        { const int c = r * 64 + F.lane; const double lam = (double)A.in[I_RGLAM][c];
          sc[SC_RGL + c] = (float)(-8.0 * log1p(exp(-lam)) * 1.4426950408889634); }
    }
    __syncthreads();
    LAS float* sT = (LAS float*)(F.lds + RING_OFF);
    float* mod = (float*)(F.ws + WS_MOD);
    constexpr int NRG = NROWMOD / 8, NCB = NMOD / 512;
    for (int it = F.vcu; it < NRG * NCB; it += F.G) {
        const int rg = it / NCB, cb = it % NCB;
        for (int e = F.tid; e < 8 * 1024; e += NWAVES * 64) { const int rr = e >> 10, k = e & 1023, row = rg * 8 + rr;
            const float v = row < NBP ? A.in[I_CP][(size_t)row * D + k] : A.in[I_CS][(size_t)(row - NBP) * D + k];
            sT[k * 8 + rr] = v / (1.f + expf(-v)); }
        __syncthreads();
        const int col = cb * 512 + F.tid; const float* w = A.in[I_ADAW] + col;
        float a[8];
#pragma unroll
        for (int i = 0; i < 8; ++i) a[i] = 0.f;
#pragma unroll 4
        for (int k = 0; k < 1024; ++k) { const float wv = w[(size_t)k * NMOD]; const f32x4 s0 = *(const LAS f32x4*)(sT + k * 8), s1 = *(const LAS f32x4*)(sT + k * 8 + 4);
            a[0] += s0[0] * wv; a[1] += s0[1] * wv; a[2] += s0[2] * wv; a[3] += s0[3] * wv; a[4] += s1[0] * wv; a[5] += s1[1] * wv; a[6] += s1[2] * wv; a[7] += s1[3] * wv; }
        const float bb = A.in[I_ADAB][col];
#pragma unroll
        for (int i = 0; i < 8; ++i) mod[(size_t)(rg * 8 + i) * NMOD + col] = a[i] + bb;
        __syncthreads();
    }
}

__device__ __forceinline__ int mod_row(int m) { return m < MP ? (m >> 11) : NBP + ((m - MP) >> 2); }
__device__ __forceinline__ const float* x_row(const Args& A, int m) { return m < MP ? A.in[I_XP] + (size_t)m * D : A.in[I_XS] + (size_t)(m - MP) * D; }

__device__ __forceinline__ void p1_modulate(Frame& F, const Args& A) {
    const int gw = F.vcu * NWAVES + F.wave, NGW = F.G * NWAVES;
    const float* mod = (const float*)(F.ws + WS_MOD); bf16* XN = (bf16*)(F.ws + WS_XN);
    for (int m = gw; m < M; m += NGW) {
        const GAS f32x4* xr = (const GAS f32x4*)x_row(A, m) + F.lane; const float* mr = mod + (size_t)mod_row(m) * NMOD;
        const GAS f32x4* sh = (const GAS f32x4*)(mr) + F.lane; const GAS f32x4* scp = (const GAS f32x4*)(mr + D) + F.lane;
        GAS unsigned long long* o8 = (GAS unsigned long long*)(XN + (size_t)m * D) + F.lane;
#pragma unroll
        for (int j = 0; j < 4; ++j) { const f32x4 v = xr[64 * j], a = sh[64 * j], s = scp[64 * j]; const f32x4 h = v * (s + 1.f) + a;
            o8[64 * j] = (unsigned long long)pk2(h.x, h.y) | ((unsigned long long)pk2(h.z, h.w) << 32); }
    }
}

template <bool SECOND>
__device__ __forceinline__ void ln_rows(Frame& F, const Args& A) {
    const int gw = F.vcu * NWAVES + F.wave, NGW = F.G * NWAVES;
    const float* mod = (const float*)(F.ws + WS_MOD); bf16* XN = (bf16*)(F.ws + WS_XN);
    const GAS f32x4* gg = (const GAS f32x4*)A.in[SECOND ? I_LN2G : I_LN1G] + F.lane; const GAS f32x4* gb = (const GAS f32x4*)A.in[SECOND ? I_LN2B : I_LN1B] + F.lane;
    for (int m = gw; m < M; m += NGW) {
        GAS f32x4* xr = (GAS f32x4*)(F.out + (size_t)m * D) + F.lane;
        f32x4 v[4]; float s = 0.f;
#pragma unroll
        for (int j = 0; j < 4; ++j) { v[j] = xr[64 * j]; s += (v[j].x + v[j].y) + (v[j].z + v[j].w); }
        const float mean = wave_sum(s) * (1.f / D); float s2 = 0.f;
#pragma unroll
        for (int j = 0; j < 4; ++j) { v[j] = v[j] - mean; s2 += (v[j].x * v[j].x + v[j].y * v[j].y) + (v[j].z * v[j].z + v[j].w * v[j].w); }
        const float rstd = 1.f / sqrtf(wave_sum(s2) * (1.f / D) + LN_EPS);
#pragma unroll
        for (int j = 0; j < 4; ++j) { v[j] = v[j] * rstd * gg[64 * j] + gb[64 * j]; xr[64 * j] = v[j]; }
        if (!SECOND) {
            const float* mr = mod + (size_t)mod_row(m) * NMOD;
            const GAS f32x4* sh = (const GAS f32x4*)(mr + 3 * D) + F.lane; const GAS f32x4* scp = (const GAS f32x4*)(mr + 4 * D) + F.lane;
            GAS unsigned long long* o8 = (GAS unsigned long long*)(XN + (size_t)m * D) + F.lane;
#pragma unroll
            for (int j = 0; j < 4; ++j) { const f32x4 h = v[j] * (scp[64 * j] + 1.f) + sh[64 * j];
                o8[64 * j] = (unsigned long long)pk2(h.x, h.y) | ((unsigned long long)pk2(h.z, h.w) << 32); }
        }
    }
}

__device__ __forceinline__ void rg_item_ref(Frame& F, const Args& A, bool prompt, int b, int hd, LAS float* scr) {
    const int j = F.lane, c = hd * HDA + j;
    const bf16* Z = (const bf16*)(F.ws + WS_Z); bf16* Y = (bf16*)(F.ws + WS_YCAT); const float* sc = (const float*)(F.ws + WS_S5C);
    float wr[64], wi[64];
#pragma unroll
    for (int i = 0; i < 64; ++i) { wr[i] = A.in[I_RGWR][(size_t)(hd * 64 + i) * 64 + j]; wi[i] = A.in[I_RGWI][(size_t)(hd * 64 + i) * 64 + j]; }
    const float br = A.in[I_RGBR][c], bi = A.in[I_RGBI][c], L2 = sc[SC_RGL + c];
    const float w0 = A.in[I_CONVW][c], w1 = A.in[I_CONVW][WA + c], w2 = A.in[I_CONVW][2 * WA + c], w3 = A.in[I_CONVW][3 * WA + c], cb = A.in[I_CONVB][c];
    int T, m0; float x3, x2, x1, h;
    if (prompt) { T = TP; m0 = b * TP; x3 = 0.f; x2 = 0.f; x1 = 0.f; h = 0.f; }
    else { T = TS; m0 = MP + b * TS; x3 = A.in[I_SCONV][(size_t)(b * 3 + 0) * WA + c]; x2 = A.in[I_SCONV][(size_t)(b * 3 + 1) * WA + c]; x1 = A.in[I_SCONV][(size_t)(b * 3 + 2) * WA + c]; h = A.in[I_SH][(size_t)b * WA + c]; }
    for (int t = 0; t < T; ++t) {
        const size_t m = (size_t)(m0 + t);
        const float xa = bf2f(Z[m * NZ + WA + c]), gate = bf2f(Z[m * NZ + c]);
        const float xc = cb + w0 * x3 + w1 * x2 + w2 * x1 + w3 * xa; x3 = x2; x2 = x1; x1 = xa;
        scr[j] = xc; LDS_WAIT(); asm volatile("" ::: "memory");
        float rp = br, gp = bi;
#pragma unroll
        for (int i4 = 0; i4 < 16; ++i4) { const f32x4 v = *(const LAS f32x4*)(scr + 4 * i4);
            rp += v[0] * wr[4 * i4] + v[1] * wr[4 * i4 + 1] + v[2] * wr[4 * i4 + 2] + v[3] * wr[4 * i4 + 3];
            gp += v[0] * wi[4 * i4] + v[1] * wi[4 * i4 + 1] + v[2] * wi[4 * i4 + 2] + v[3] * wi[4 * i4 + 3]; }
        LDS_WAIT(); asm volatile("" ::: "memory");
        const float r = sigmoidf_(rp), gi = sigmoidf_(gp);
        const float a = exp2f(r * L2);
        float mult = sqrtf(fmaxf(1.f - a * a, 0.f));
        if (prompt && t == 0) mult = 1.f;
        h = a * h + mult * gi * xc;
        Y[m * D + c] = (bf16)f2bf(gelu_tanh(gate) * h);
    }
    float* oc = F.out + (prompt ? O_CONVP : O_CONVS); float* oh = F.out + (prompt ? O_HP : O_HS);
    oc[(size_t)(b * 3 + 0) * WA + c] = x3; oc[(size_t)(b * 3 + 1) * WA + c] = x2; oc[(size_t)(b * 3 + 2) * WA + c] = x1;
    oh[(size_t)b * WA + c] = h;
}
__device__ __forceinline__ void s5_item_ref(Frame& F, const Args& A, bool prompt, int b, int g, LAS float* scr) {
    const int n = F.lane, gn = g * NS5 + n, k = F.lane & 15, part = F.lane >> 4;
    const bf16* Z = (const bf16*)(F.ws + WS_Z); bf16* Gy = (bf16*)(F.ws + WS_G); const float* sc = (const float*)(F.ws + WS_S5C);
    float bbr[16], bbi[16], cre[16], cim[16];
#pragma unroll
    for (int i = 0; i < 16; ++i) { bbr[i] = sc[SC_BBR + gn * KS5 + i]; bbi[i] = sc[SC_BBI + gn * KS5 + i];
        cre[i] = A.in[I_S5CRE][(size_t)(g * KS5 + k) * NS5 + part * 16 + i]; cim[i] = A.in[I_S5CIM][(size_t)(g * KS5 + k) * NS5 + part * 16 + i]; }
    const float abr = sc[SC_ABR + gn], abi = sc[SC_ABI + gn], dk = A.in[I_S5D][g * KS5 + k];
    int T, m0; float hr, hi;
    if (prompt) { T = TP; m0 = b * TP; hr = 0.f; hi = 0.f; }
    else { T = TS; m0 = MP + b * TS; hr = A.in[I_SSR][(size_t)(b * GB + g) * NS5 + n]; hi = A.in[I_SSI][(size_t)(b * GB + g) * NS5 + n]; }
    for (int t = 0; t < T; ++t) {
        const size_t m = (size_t)(m0 + t);
        const bf16* zr = Z + m * NZ + 2 * WA + g * KS5;
        const v4u u0 = *(const v4u*)zr, u1 = *(const v4u*)(zr + 8);
        float u[16];
        u[0] = pg8::bf_lo(u0.x); u[1] = pg8::bf_hi(u0.x); u[2] = pg8::bf_lo(u0.y); u[3] = pg8::bf_hi(u0.y); u[4] = pg8::bf_lo(u0.z); u[5] = pg8::bf_hi(u0.z); u[6] = pg8::bf_lo(u0.w); u[7] = pg8::bf_hi(u0.w);
        u[8] = pg8::bf_lo(u1.x); u[9] = pg8::bf_hi(u1.x); u[10] = pg8::bf_lo(u1.y); u[11] = pg8::bf_hi(u1.y); u[12] = pg8::bf_lo(u1.z); u[13] = pg8::bf_hi(u1.z); u[14] = pg8::bf_lo(u1.w); u[15] = pg8::bf_hi(u1.w);
        float bur = 0.f, bui = 0.f;
#pragma unroll
        for (int i = 0; i < 16; ++i) { bur += bbr[i] * u[i]; bui += bbi[i] * u[i]; }
        const float nhr = abr * hr - abi * hi + bur, nhi = abr * hi + abi * hr + bui; hr = nhr; hi = nhi;
        scr[n] = hr; scr[64 + n] = hi; LDS_WAIT(); asm volatile("" ::: "memory");
        float p = 0.f;
#pragma unroll
        for (int i4 = 0; i4 < 4; ++i4) { const f32x4 vr = *(const LAS f32x4*)(scr + part * 16 + 4 * i4), vi = *(const LAS f32x4*)(scr + 64 + part * 16 + 4 * i4);
#pragma unroll
            for (int e = 0; e < 4; ++e) p += vr[e] * cre[4 * i4 + e] - vi[e] * cim[4 * i4 + e]; }
        LDS_WAIT(); asm volatile("" ::: "memory");
        p += __shfl_xor(p, 16); p += __shfl_xor(p, 32);
        const float uk = bf2f(zr[k]);
        if (F.lane < 16) Gy[m * WB + g * KS5 + k] = (bf16)f2bf(gelu_tanh(p + dk * uk));
    }
    float* osr = F.out + (prompt ? O_SRP : O_SRS); float* osi = F.out + (prompt ? O_SIP : O_SIS);
    osr[(size_t)(b * GB + g) * NS5 + n] = hr; osi[(size_t)(b * GB + g) * NS5 + n] = hi;
}
__device__ __forceinline__ void p3_mixers_ref(Frame& F, const Args& A) {
    LAS float* scr = (LAS float*)(F.lds + RING_OFF + F.wave * 1024);
    const int gw = F.wave * F.G + F.vcu, NGW = F.G * NWAVES;
    constexpr int N_RGP = NBP * HA, N_S5P = NBP * GB, N_RGS = NBS * HA, N_S5S = NBS * GB;
    for (int it = gw; it < N_RGP + N_S5P + N_RGS + N_S5S; it += NGW) {
        int r = it;
        if (r < N_RGP) { rg_item_ref(F, A, true, r / HA, r % HA, scr); continue; } r -= N_RGP;
        if (r < N_S5P) { s5_item_ref(F, A, true, r / GB, r % GB, scr); continue; } r -= N_S5P;
        if (r < N_RGS) { rg_item_ref(F, A, false, r / HA, r % HA, scr); continue; } r -= N_RGS;
        s5_item_ref(F, A, false, r / GB, r % GB, scr);
    }
}

__global__ void __launch_bounds__(NWAVES * 64, 2) fwd(Args A) {
    extern __shared__ __attribute__((aligned(16))) unsigned char lds[];
    Frame F;
    F.lds = (LAS unsigned char*)lds;
    F.MISC = (volatile LAS unsigned*)(F.lds + MISC_OFF);
    F.tid = threadIdx.x; F.lane = F.tid & 63; F.wave = __builtin_amdgcn_readfirstlane(F.tid >> 6);
    F.G = gridDim.x; { const int bx = blockIdx.x; F.vcu = (F.G % 8 == 0) ? (bx % 8) * (F.G / 8) + bx / 8 : bx; }
    F.out = A.out; F.ws = A.ws; F.ctl = (gu32*)(A.ws + WS_CTL);
    for (int u = F.tid; u < (LDS_BYTES - LDSCTL_OFF) / 4; u += NWAVES * 64) ((LAS unsigned*)(F.lds + LDSCTL_OFF))[u] = 0u;
    __syncthreads();
    XcdBarrier bar; bar.bar = (unsigned*)(F.ctl + CW_BAR); bar.x = 0; bar.st = nullptr;
    if (N_LAUNCHES == 1) bar = xcd_barrier_post((unsigned*)(F.ctl + CW_BAR), F.MISC + 8);
#define GRID_BAR() do { if (N_LAUNCHES == 1) xcd_barrier(bar); } while (0)
    const int lo = A.ph_lo, hi = A.ph_hi;
#define IN(k) (lo <= (k) && (k) < hi)
#define BOTH(k) (IN(k) && IN((k) + 1))
    bf16* XN = (bf16*)(F.ws + WS_XN); bf16* Z = (bf16*)(F.ws + WS_Z); bf16* YC = (bf16*)(F.ws + WS_YCAT); bf16* GY = (bf16*)(F.ws + WS_G); bf16* U = (bf16*)(F.ws + WS_U);
    const float* mod = (const float*)(F.ws + WS_MOD);

    if (IN(0)) { p0_prologue(F, A); if (BOTH(0)) GRID_BAR(); }
    if (IN(1)) { p1_modulate(F, A); if (BOTH(1)) GRID_BAR(); }
    if (IN(2)) {
        pg8::Gemm g{XN, (const bf16*)(F.ws + WS_WIN), M, NZ, D}; pg8::StaticOrder S; S.init(M, NZ, F.G, (int)blockIdx.x);
        pg8::EpiBf16<0> E{Z, NZ, nullptr};
        pg8::gemm_phase<pg8::EpiBf16<0>, pg8::StaticOrder, PG8_ALIGN, PG8_SP2>(F.lds + RING_OFF, g, S, E);
        if (BOTH(2)) GRID_BAR();
    }
    if (IN(3)) { p3_mixers_ref(F, A); if (BOTH(3)) GRID_BAR(); }
    if (IN(4)) {
        pg8::Gemm g{GY, (const bf16*)(F.ws + WS_WGLU), M, WB, WB}; pg8::StaticOrder S; S.init(M, WB, F.G, (int)blockIdx.x);
        pg8::EpiGlu E{GY, WB, YC, D, WA, A.in[I_GLUB]};
        pg8::gemm_phase<pg8::EpiGlu, pg8::StaticOrder, PG8_ALIGN, PG8_SP2>(F.lds + RING_OFF, g, S, E);
        if (BOTH(4)) GRID_BAR();
    }
    if (IN(5)) {
        pg8::Gemm g{YC, (const bf16*)(F.ws + WS_WOUT), M, D, D}; pg8::StaticOrder S; S.init(M, D, F.G, (int)blockIdx.x);
        pg8::EpiRes E{A.in[I_XP], A.in[I_XS], F.out, mod + 2 * D, nullptr, ALPHA, MP};
        pg8::gemm_phase<pg8::EpiRes, pg8::StaticOrder, PG8_ALIGN, PG8_SP2>(F.lds + RING_OFF, g, S, E);
        if (BOTH(5)) GRID_BAR();
    }
    if (IN(6)) { ln_rows<false>(F, A); if (BOTH(6)) GRID_BAR(); }
    if (IN(7)) {
        pg8::Gemm g{XN, (const bf16*)(F.ws + WS_W1), M, FF, D}; pg8::StaticOrder S; S.init(M, FF, F.G, (int)blockIdx.x);
        pg8::EpiBf16<3> E{U, FF, A.in[I_B1]};
        pg8::gemm_phase<pg8::EpiBf16<3>, pg8::StaticOrder, PG8_ALIGN, PG8_SP2>(F.lds + RING_OFF, g, S, E);
        if (BOTH(7)) GRID_BAR();
    }
    if (IN(8)) {
        pg8::Gemm g{U, (const bf16*)(F.ws + WS_W2), M, D, FF}; pg8::StaticOrder S; S.init(M, D, F.G, (int)blockIdx.x);
        pg8::EpiRes E{F.out, F.out + (size_t)MP * D, F.out, mod + 5 * D, A.in[I_B2], ALPHA, MP};
        pg8::gemm_phase<pg8::EpiRes, pg8::StaticOrder, PG8_ALIGN, PG8_SP2>(F.lds + RING_OFF, g, S, E);
        if (BOTH(8)) GRID_BAR();
    }
    if (IN(9)) { ln_rows<true>(F, A); }
#undef IN
#undef BOTH
}

extern "C" void kernel_launch(void* const* d_in, const int* in_sizes, int n_in, void* d_out, int out_size, void* d_ws, size_t ws_size, hipStream_t stream) {
    static int grid = 0;
    if (grid == 0) {
        if (n_in != 37 || in_sizes[0] != MP * D || out_size != (int)O_END || ws_size < WS_END) { fprintf(stderr, "kernel_launch: unexpected shapes (n_in %d, in0 %d, out %d, ws %zu)\n", n_in, n_in > 0 ? in_sizes[0] : -1, out_size, ws_size); grid = -1; return; }
        int dev = 0, cus = 0, per_cu = 0;
        if (hipGetDevice(&dev) != hipSuccess || hipDeviceGetAttribute(&cus, hipDeviceAttributeMultiprocessorCount, dev) != hipSuccess) { grid = -1; return; }
        if (hipFuncSetAttribute((const void*)fwd, hipFuncAttributeMaxDynamicSharedMemorySize, LDS_BYTES) != hipSuccess) { fprintf(stderr, "kernel_launch: hipFuncSetAttribute failed\n"); grid = -1; return; }
        if (hipOccupancyMaxActiveBlocksPerMultiprocessor(&per_cu, (const void*)fwd, NWAVES * 64, LDS_BYTES) != hipSuccess || per_cu < 1) { fprintf(stderr, "kernel_launch: occupancy query says %d\n", per_cu); }
        (void)hipGetLastError();
        grid = cus;
    }
    if (grid < 0) return;
    (void)hipMemsetAsync((char*)d_ws + WS_CTL, 0, CTL_ZERO_BYTES, stream);
    Args a{};
    for (int i = 0; i < 37; ++i) a.in[i] = (const float*)d_in[i];
    a.out = (float*)d_out; a.ws = (unsigned char*)d_ws;
    for (int li = 0; li < N_LAUNCHES; ++li) {
        if (N_LAUNCHES == 1) { a.ph_lo = 0; a.ph_hi = N_PHASES; } else { a.ph_lo = li; a.ph_hi = li + 1; }
        a.li = li;
        hipLaunchKernelGGL(fwd, dim3(grid), dim3(NWAVES * 64), LDS_BYTES, stream, a);
    }
}
```

```cpp
#include <hip/hip_runtime.h>
#include <cstdio>
#include <cstdint>
#include <cmath>

#ifndef MK_N_LAUNCHES
#define MK_N_LAUNCHES 1
#endif

namespace pg8 {
#define PG8_LAS __attribute__((address_space(3)))
typedef unsigned short bf16_t;
typedef short bf16x8 __attribute__((ext_vector_type(8)));
typedef float f32x4 __attribute__((ext_vector_type(4)));
typedef unsigned u32x4 __attribute__((ext_vector_type(4)));
constexpr int BM = 256, BK = 64, HALF = 128, HTB = HALF * BK * 2, STAGE_BYTES = 8 * HTB, NXCD = 8, WGM = 8;

__host__ __device__ __forceinline__ int lds_byte(int r, int c) { const int st = (r >> 4) * 2 + (c >> 5), rr = r & 15, cc = c & 31, ob = rr * 64 + cc * 2; return st * 1024 + (ob ^ (((ob >> 9) & 1) << 5)); }
__host__ __device__ __forceinline__ void stage_rc(int b, int& R, int& C) { const int st = b / 1024, sb = b % 1024, swz = sb ^ (((sb >> 9) & 1) << 5); R = (st >> 1) * 16 + swz / 64; C = (st & 1) * 32 + (swz % 64) / 2; }
__host__ __device__ __forceinline__ int perm32(int rho) { const int n = rho >> 4, i = rho & 15; return 8 * (i >> 2) + 4 * n + (i & 3); }

struct Unit { int pm, pn; };
struct Gemm { const bf16_t* A; const bf16_t* Bt; int M, N, K; };

struct StaticOrder {
    int nM, nN, nwg, G, c;
    __host__ __device__ void init(int M, int N, int G_, int c_) { nM = M / BM; nN = N / BM; nwg = nM * nN; G = G_; c = c_; }
    __host__ __device__ bool next(int i, Unit& u) const {
        const long L = (long)i * G + c; if (L >= nwg) return false;
        int wgid = (int)L; { const int q = nwg / NXCD, r = nwg % NXCD, xcd = wgid % NXCD, off = wgid / NXCD; wgid = (xcd < r ? xcd * (q + 1) : r * (q + 1) + (xcd - r) * q) + off; }
        const int nig = WGM * nN, gid = wgid / nig, fm = gid * WGM, gsz = (nM - fm) < WGM ? (nM - fm) : WGM;
        u.pm = fm + ((wgid % nig) % gsz); u.pn = (wgid % nig) / gsz; return true;
    }
    __device__ __forceinline__ void a_ready(const Unit&) const {}
    __device__ __forceinline__ void done(const Unit&) const {}
};

__device__ __forceinline__ unsigned cvt_pk_bf16(float lo, float hi) { unsigned r; asm volatile("v_cvt_pk_bf16_f32 %0, %1, %2" : "=v"(r) : "v"(lo), "v"(hi)); return r; }
__device__ __forceinline__ float bf_lo(unsigned w) { return __builtin_bit_cast(float, w << 16); }
__device__ __forceinline__ float bf_hi(unsigned w) { return __builtin_bit_cast(float, w & 0xffff0000u); }

template <int ACT> struct EpiBf16 {
    static constexpr bool PERM = true, AFTER_DRAIN = false;
    bf16_t* O; int ldc; const float* bias;
    __device__ __forceinline__ void operator()(const f32x4 (&acc)[2][2][4][2], const Unit& u, int wr, int wc, int fr, int fq) const {
        const int row0 = u.pm * BM + wr * 64 + fr; const int col0 = u.pn * BM + wc * 32 + 8 * fq;
        f32x4 bv[2][2];
#pragma unroll
        for (int bj = 0; bj < 2; ++bj)
#pragma unroll
            for (int n = 0; n < 2; ++n) bv[bj][n] = bias ? *(const f32x4*)(bias + col0 + bj * HALF + 4 * n) : (f32x4){0.f, 0.f, 0.f, 0.f};
#pragma unroll
        for (int ai = 0; ai < 2; ++ai)
#pragma unroll
            for (int m = 0; m < 4; ++m) { bf16_t* rowp = O + (size_t)(row0 + ai * HALF + m * 16) * ldc + col0;
#pragma unroll
                for (int bj = 0; bj < 2; ++bj) { f32x4 v0 = acc[ai][bj][m][0] + bv[bj][0], v1 = acc[ai][bj][m][1] + bv[bj][1];
                    if (ACT == 3) {
#pragma unroll
                        for (int e = 0; e < 4; ++e) { const float a = fmaxf(v0[e], 0.f), b = fmaxf(v1[e], 0.f); v0[e] = a * a; v1[e] = b * b; } }
                    u32x4 w; w.x = cvt_pk_bf16(v0[0], v0[1]); w.y = cvt_pk_bf16(v0[2], v0[3]); w.z = cvt_pk_bf16(v1[0], v1[1]); w.w = cvt_pk_bf16(v1[2], v1[3]);
                    *(u32x4*)(rowp + bj * HALF) = w; } }
    }
};
struct EpiGlu {
    static constexpr bool PERM = true, AFTER_DRAIN = false;
    const bf16_t* Gy; int ldg; bf16_t* O; int ldc; int coff; const float* bias;
    __device__ __forceinline__ void operator()(const f32x4 (&acc)[2][2][4][2], const Unit& u, int wr, int wc, int fr, int fq) const {
        const int row0 = u.pm * BM + wr * 64 + fr; const int col0 = u.pn * BM + wc * 32 + 8 * fq;
        f32x4 bv[2][2];
#pragma unroll
        for (int bj = 0; bj < 2; ++bj)
#pragma unroll
            for (int n = 0; n < 2; ++n) bv[bj][n] = *(const f32x4*)(bias + col0 + bj * HALF + 4 * n);
#pragma unroll
        for (int ai = 0; ai < 2; ++ai)
#pragma unroll
            for (int m = 0; m < 4; ++m) { const size_t row = (size_t)(row0 + ai * HALF + m * 16);
#pragma unroll
                for (int bj = 0; bj < 2; ++bj) { const f32x4 v0 = acc[ai][bj][m][0] + bv[bj][0], v1 = acc[ai][bj][m][1] + bv[bj][1];
                    const u32x4 g = *(const u32x4*)(Gy + row * ldg + col0 + bj * HALF);
                    float o[8];
                    o[0] = bf_lo(g.x) / (1.f + __expf(-v0[0])); o[1] = bf_hi(g.x) / (1.f + __expf(-v0[1]));
                    o[2] = bf_lo(g.y) / (1.f + __expf(-v0[2])); o[3] = bf_hi(g.y) / (1.f + __expf(-v0[3]));
                    o[4] = bf_lo(g.z) / (1.f + __expf(-v1[0])); o[5] = bf_hi(g.z) / (1.f + __expf(-v1[1]));
                    o[6] = bf_lo(g.w) / (1.f + __expf(-v1[2])); o[7] = bf_hi(g.w) / (1.f + __expf(-v1[3]));
                    u32x4 w; w.x = cvt_pk_bf16(o[0], o[1]); w.y = cvt_pk_bf16(o[2], o[3]); w.z = cvt_pk_bf16(o[4], o[5]); w.w = cvt_pk_bf16(o[6], o[7]);
                    *(u32x4*)(O + row * ldc + coff + col0 + bj * HALF) = w; } }
    }
};
struct EpiRes {
    static constexpr bool PERM = false, AFTER_DRAIN = false;
    const float* basep; const float* bases; float* out; const float* gate  ; const float* bias; float alpha; int MP;
    __device__ __forceinline__ void operator()(const f32x4 (&acc)[2][2][4][2], const Unit& u, int wr, int wc, int fr, int fq) const {
        const int row0 = u.pm * BM + wr * 64 + fr, col0 = u.pn * BM + wc * 32 + 4 * fq;
        f32x4 bv[2][2];
#pragma unroll
        for (int bj = 0; bj < 2; ++bj)
#pragma unroll
            for (int n = 0; n < 2; ++n) bv[bj][n] = bias ? *(const f32x4*)(bias + col0 + bj * HALF + n * 16) : (f32x4){0.f, 0.f, 0.f, 0.f};
#pragma unroll
        for (int ai = 0; ai < 2; ++ai)
#pragma unroll
            for (int m = 0; m < 4; ++m) { const int row = row0 + ai * HALF + m * 16;
                const bool smp = row >= MP; const int mr = smp ? 8 + ((row - MP) >> 2) : (row >> 11);
                const float* bp = smp ? bases + (size_t)(row - MP) * 1024 : basep + (size_t)row * 1024;
                const float* gp = gate + (size_t)mr * 6144; float* op = out + (size_t)row * 1024;
#pragma unroll
                for (int bj = 0; bj < 2; ++bj)
#pragma unroll
                    for (int n = 0; n < 2; ++n) { const int c = col0 + bj * HALF + n * 16;
                        const f32x4 b = *(const f32x4*)(bp + c), g = *(const f32x4*)(gp + c);
                        *(f32x4*)(op + c) = b * alpha + g * (acc[ai][bj][m][n] + bv[bj][n]); } }
    }
};

template <class Epi, class Sched, bool ALIGN_EPI = false, bool SP2 = false>
__device__ __forceinline__ void gemm_phase(PG8_LAS unsigned char* lds, const Gemm g, const Sched& S, const Epi& E) {
    const int tid = threadIdx.x, wid = __builtin_amdgcn_readfirstlane(tid >> 6), lane = tid & 63, wr = wid >> 2, wc = wid & 3, fr = lane & 15, fq = lane >> 4;
    const int K = g.K, nt = K / BK;
    unsigned voffA[2], voffB[2];
#pragma unroll
    for (int i = 0; i < 2; ++i) { int R, C; stage_rc(tid * 16 + i * 8192, R, C); const int Rb = Epi::PERM ? ((R & ~31) + perm32(R & 31)) : R;
        voffA[i] = (unsigned)(R * K + C) * 2u; voffB[i] = (unsigned)(Rb * K + C) * 2u; }
    const size_t kstep = (size_t)(BK * 2);
    const size_t hstep = (size_t)HALF * K * 2;
    const size_t tstep = 2 * hstep;
    const unsigned ldsw = (unsigned)wid * 1024u;
    const int aoff = lds_byte(wr * 64 + fr, fq * 8), boff = lds_byte(wc * 32 + fr, fq * 8);
#define PG8_SA(b, h) (((b) * 2 + (h)) * HTB)
#define PG8_SB(b, h) ((4 + (b) * 2 + (h)) * HTB)
#define PG8_STAGE(bufoff, gbase, voff) do { _Pragma("unroll") for (int _i = 0; _i < 2; ++_i) \
        __builtin_amdgcn_global_load_lds((const unsigned*)((const char*)(gbase) + (voff)[_i]), (PG8_LAS unsigned*)(lds + (bufoff) + ldsw + _i * 8192), 16, 0, 0); } while (0)
#define PG8_LDA(dst, b, h) do { _Pragma("unroll") for (int m = 0; m < 4; ++m) _Pragma("unroll") for (int k = 0; k < 2; ++k) dst[m][k] = *(const PG8_LAS bf16x8*)(lds + PG8_SA(b, h) + aoff + m * 2048 + k * 1024); } while (0)
#define PG8_LDB(dst, b, h) do { _Pragma("unroll") for (int n = 0; n < 2; ++n) _Pragma("unroll") for (int k = 0; k < 2; ++k) dst[n][k] = *(const PG8_LAS bf16x8*)(lds + PG8_SB(b, h) + boff + n * 2048 + k * 1024); } while (0)
#define PG8_MMA(ai, bj, At, Bt) do { __builtin_amdgcn_s_setprio(1); _Pragma("unroll") for (int m = 0; m < 4; ++m) _Pragma("unroll") for (int n = 0; n < 2; ++n) _Pragma("unroll") for (int k = 0; k < 2; ++k) \
        acc[ai][bj][m][n] = __builtin_amdgcn_mfma_f32_16x16x32_bf16(Bt[n][k], At[m][k], acc[ai][bj][m][n], 0, 0, 0); __builtin_amdgcn_s_setprio(0); } while (0)
#define PG8_WAIT_V(n) asm volatile("s_waitcnt vmcnt(" #n ")" ::: "memory")
#define PG8_WAIT_L(n) asm volatile("s_waitcnt lgkmcnt(" #n ")" ::: "memory")
#define PG8_BAR __builtin_amdgcn_s_barrier()
#define PG8_SCHED __builtin_amdgcn_sched_barrier(0)
    Unit cur, nxt; int ui = 0;
    if (!S.next(0, cur)) return;
    f32x4 acc[2][2][4][2];
#pragma unroll
    for (int a = 0; a < 2; ++a)
#pragma unroll
        for (int b = 0; b < 2; ++b)
#pragma unroll
            for (int m = 0; m < 4; ++m)
#pragma unroll
                for (int n = 0; n < 2; ++n) acc[a][b][m][n] = (f32x4){0.f, 0.f, 0.f, 0.f};
    bf16x8 At[4][2], B0[2][2], B1[2][2];
    const char* cA = (const char*)g.A + (size_t)cur.pm * tstep; const char* cB = (const char*)g.Bt + (size_t)cur.pn * tstep;
    S.a_ready(cur);
    if constexpr (SP2) {
        PG8_STAGE(PG8_SB(0, 0), cB, voffB); PG8_STAGE(PG8_SB(0, 1), cB + hstep, voffB); PG8_STAGE(PG8_SA(0, 0), cA, voffA); PG8_STAGE(PG8_SA(0, 1), cA + hstep, voffA);
        if (wr == 1) PG8_BAR;
        PG8_WAIT_V(2); PG8_BAR;
        PG8_STAGE(PG8_SB(1, 0), cB + kstep, voffB); PG8_STAGE(PG8_SA(1, 0), cA + kstep, voffA); PG8_STAGE(PG8_SB(1, 1), cB + hstep + kstep, voffB);
        PG8_WAIT_V(6); PG8_BAR;
    } else {
        PG8_STAGE(PG8_SB(0, 0), cB, voffB); PG8_STAGE(PG8_SA(0, 0), cA, voffA); PG8_STAGE(PG8_SB(0, 1), cB + hstep, voffB); PG8_STAGE(PG8_SA(0, 1), cA + hstep, voffA);
        if (wr == 1) PG8_BAR;
        PG8_WAIT_V(4); PG8_BAR;
        PG8_STAGE(PG8_SB(1, 0), cB + kstep, voffB); PG8_STAGE(PG8_SA(1, 0), cA + kstep, voffA); PG8_STAGE(PG8_SB(1, 1), cB + hstep + kstep, voffB);
        PG8_WAIT_V(6); PG8_BAR;
    }
    for (;;) {
        const bool has_next = S.next(ui + 1, nxt);
        const char* nA = has_next ? (const char*)g.A + (size_t)nxt.pm * tstep : cA; const char* nB = has_next ? (const char*)g.Bt + (size_t)nxt.pn * tstep : cB;
        for (int t = 0; t < nt; t += 2) {
            const bool last = (t == nt - 2);
            const char* a1 = cA + (size_t)(t + 1) * kstep;
            const char* a2 = last ? nA : cA + (size_t)(t + 2) * kstep; const char* b2 = last ? nB : cB + (size_t)(t + 2) * kstep;
            const char* a3 = a2 + kstep; const char* b3 = b2 + kstep;
            if (last && has_next) S.a_ready(nxt);
            if constexpr (SP2) {
            PG8_LDB(B0, 0, 0); PG8_LDB(B1, 0, 1); PG8_SCHED; PG8_LDA(At, 0, 0); PG8_STAGE(PG8_SA(1, 1), a1 + hstep, voffA);
            PG8_WAIT_V(8); PG8_WAIT_L(0); PG8_BAR; PG8_MMA(0, 0, At, B0); PG8_MMA(0, 1, At, B1); PG8_BAR; PG8_SCHED;
            PG8_LDA(At, 0, 1); PG8_STAGE(PG8_SB(0, 0), b2, voffB); PG8_STAGE(PG8_SB(0, 1), b2 + hstep, voffB); PG8_STAGE(PG8_SA(0, 0), a2, voffA);
            PG8_WAIT_V(8); PG8_WAIT_L(0); PG8_BAR; PG8_MMA(1, 0, At, B0); PG8_MMA(1, 1, At, B1); PG8_BAR; PG8_SCHED;
            PG8_LDB(B0, 1, 0); PG8_LDB(B1, 1, 1); PG8_SCHED; PG8_LDA(At, 1, 0); PG8_STAGE(PG8_SA(0, 1), a2 + hstep, voffA);
            PG8_WAIT_V(8); PG8_WAIT_L(0); PG8_BAR; PG8_MMA(0, 0, At, B0); PG8_MMA(0, 1, At, B1); PG8_BAR; PG8_SCHED;
            PG8_LDA(At, 1, 1); PG8_STAGE(PG8_SB(1, 0), b3, voffB); PG8_STAGE(PG8_SB(1, 1), b3 + hstep, voffB); PG8_STAGE(PG8_SA(1, 0), a3, voffA);
            PG8_WAIT_V(8); PG8_WAIT_L(0); PG8_BAR; PG8_MMA(1, 0, At, B0); PG8_MMA(1, 1, At, B1); PG8_BAR; PG8_SCHED;
            } else {
            PG8_LDB(B0, 0, 0); PG8_SCHED; PG8_LDA(At, 0, 0); PG8_STAGE(PG8_SA(1, 1), a1 + hstep, voffA);
            PG8_WAIT_L(8); PG8_BAR; PG8_WAIT_L(0); PG8_MMA(0, 0, At, B0); PG8_BAR; PG8_SCHED;
            PG8_LDB(B1, 0, 1); PG8_STAGE(PG8_SB(0, 0), b2, voffB);
            PG8_BAR; PG8_WAIT_L(0); PG8_MMA(0, 1, At, B1); PG8_BAR;
            PG8_LDA(At, 0, 1); PG8_STAGE(PG8_SA(0, 0), a2, voffA);
            PG8_BAR; PG8_WAIT_L(0); PG8_MMA(1, 0, At, B0); PG8_BAR; PG8_SCHED;
            PG8_STAGE(PG8_SB(0, 1), b2 + hstep, voffB);
            PG8_WAIT_V(6); PG8_BAR; PG8_MMA(1, 1, At, B1); PG8_BAR;
            PG8_LDB(B0, 1, 0); PG8_SCHED; PG8_LDA(At, 1, 0); PG8_STAGE(PG8_SA(0, 1), a2 + hstep, voffA);
            PG8_WAIT_L(8); PG8_BAR; PG8_WAIT_L(0); PG8_MMA(0, 0, At, B0); PG8_BAR; PG8_SCHED;
            PG8_LDB(B1, 1, 1); PG8_STAGE(PG8_SB(1, 0), b3, voffB);
            PG8_BAR; PG8_WAIT_L(0); PG8_MMA(0, 1, At, B1); PG8_BAR;
            PG8_LDA(At, 1, 1); PG8_STAGE(PG8_SA(1, 0), a3, voffA);
            PG8_BAR; PG8_WAIT_L(0); PG8_MMA(1, 0, At, B0); PG8_BAR; PG8_SCHED;
            PG8_STAGE(PG8_SB(1, 1), b3 + hstep, voffB);
            PG8_WAIT_V(6); PG8_BAR; PG8_MMA(1, 1, At, B1); PG8_BAR;
            }
        }
        if constexpr (ALIGN_EPI) { if (wr == 0) PG8_BAR; }
        if constexpr (!Epi::AFTER_DRAIN) { E(acc, cur, wr, wc, fr, fq); S.done(cur); }
        if (!has_next) break;
#pragma unroll
        for (int a = 0; a < 2; ++a)
#pragma unroll
            for (int b = 0; b < 2; ++b)
#pragma unroll
                for (int m = 0; m < 4; ++m)
#pragma unroll
                    for (int n = 0; n < 2; ++n) acc[a][b][m][n] = (f32x4){0.f, 0.f, 0.f, 0.f};
        cur = nxt; cA = nA; cB = nB; ++ui;
        if constexpr (ALIGN_EPI) { if (wr == 1) PG8_BAR; }
    }
    PG8_WAIT_V(0);
    if constexpr (!ALIGN_EPI) { if (wr == 0) PG8_BAR; }
    PG8_BAR;
#undef PG8_SA
#undef PG8_SB
#undef PG8_STAGE
#undef PG8_LDA
#undef PG8_LDB
#undef PG8_MMA
#undef PG8_WAIT_V
#undef PG8_WAIT_L
#undef PG8_BAR
#undef PG8_SCHED
}
}

#ifndef PG8_SP2
#define PG8_SP2 true
#endif
#ifndef PG8_ALIGN
#define PG8_ALIGN true
#endif

constexpr int NWAVES = 8;
constexpr int N_LAUNCHES = MK_N_LAUNCHES;
constexpr int N_PHASES = 10;
constexpr int D = 1024, MP = 16384, MS = 512, M = MP + MS, TP = 2048, NBP = 8, NBS = 128, TS = 4;
constexpr int NZ = 1536, WA = 512, WB = 512, FF = 4096, NMOD = 6 * D, NROWMOD = NBP + NBS;
constexpr int GB = 32, NS5 = 64, KS5 = 16, HA = 8, HDA = 64;
constexpr float LN_EPS = 1e-5f;
constexpr float ALPHA = 1.189207115002721f;

constexpr size_t O_YP = 0, O_YS = (size_t)MP * D, O_CONVP = O_YS + (size_t)MS * D, O_HP = O_CONVP + (size_t)NBP * 3 * WA, O_SRP = O_HP + (size_t)NBP * WA,
                 O_SIP = O_SRP + (size_t)NBP * GB * NS5, O_CONVS = O_SIP + (size_t)NBP * GB * NS5, O_HS = O_CONVS + (size_t)NBS * 3 * WA, O_SRS = O_HS + (size_t)NBS * WA,
                 O_SIS = O_SRS + (size_t)NBS * GB * NS5, O_END = O_SIS + (size_t)NBS * GB * NS5;

constexpr size_t MiB = 1u << 20;
constexpr size_t WS_CTL = 0, CTL_ZERO_BYTES = 1 * MiB;
constexpr size_t WS_WIN = 1 * MiB, WS_WGLU = 4 * MiB, WS_WOUT = 5 * MiB, WS_W1 = 7 * MiB, WS_W2 = 15 * MiB;
constexpr size_t WS_MOD = 23 * MiB;
constexpr size_t WS_S5C = 27 * MiB;
constexpr size_t WS_XN = 28 * MiB;
constexpr size_t WS_Z = 61 * MiB;
constexpr size_t WS_YCAT = 111 * MiB;
constexpr size_t WS_G = 144 * MiB;
constexpr size_t WS_U = 61 * MiB;
constexpr size_t WS_END = 194 * MiB;
static_assert(WS_XN + (size_t)M * D * 2 <= WS_Z && WS_Z + (size_t)M * NZ * 2 <= WS_YCAT && WS_YCAT + (size_t)M * D * 2 <= WS_G && WS_G + (size_t)M * WB * 2 <= WS_END && WS_U + (size_t)M * FF * 2 <= WS_END, "d_ws map");
constexpr int SC_ABR = 0, SC_ABI = 2048, SC_BBR = 4096, SC_BBI = 4096 + 32768, SC_RGL = 4096 + 65536, SC_END = SC_RGL + 512;
constexpr int CW_TMO = 0, CW_CODE = 1, CW_BAR = 4096;

constexpr int RING_OFF = 0, RING_BYTES = 131072;
constexpr int LDSCTL_OFF = RING_BYTES, MISC_OFF = LDSCTL_OFF + 320;
constexpr int LDS_BYTES = 147456;

#define GAS __attribute__((address_space(1)))
#define LAS __attribute__((address_space(3)))
typedef unsigned short bf16;
typedef unsigned v4u __attribute__((ext_vector_type(4)));
typedef float f32x4 __attribute__((ext_vector_type(4)));
typedef GAS unsigned gu32;
#define RLX_AGENT __ATOMIC_RELAXED, __HIP_MEMORY_SCOPE_AGENT
#define LDS_WAIT() asm volatile("s_waitcnt lgkmcnt(0)" ::: "memory")
#define VM_WAIT() asm volatile("s_waitcnt vmcnt(0)" ::: "memory")
__device__ __forceinline__ unsigned f2bf(float f) { unsigned u = __builtin_bit_cast(unsigned, f); return (u + 0x7fffu + ((u >> 16) & 1u)) >> 16; }
__device__ __forceinline__ unsigned pk2(float lo, float hi) { return f2bf(lo) | (f2bf(hi) << 16); }
__device__ __forceinline__ float bf2f(bf16 v) { return __builtin_bit_cast(float, (unsigned)v << 16); }
__device__ __forceinline__ float gelu_tanh(float x) { const float t = 1.5957691216057308f * (x + 0.044715f * x * x * x); return x / (1.f + __expf(-t)); }
__device__ __forceinline__ float sigmoidf_(float x) { return 1.f / (1.f + __expf(-x)); }

#define XB_TMO      128
#define XB_XCNT(j)  (256  + 64 * (j))
#define XB_XSUB(j)  (1280 + 64 * (j))
#define XB_XGEN(j)  (2304 + 64 * (j))
#define XB_TOP      3328
#define XB_TOPGEN   3392
#define XCD_BAR_WORDS 3456
#define XB_SPIN_CAP (1u << 18)
__device__ __forceinline__ unsigned xb_ld(unsigned* p)              { return __hip_atomic_load(p, __ATOMIC_RELAXED, __HIP_MEMORY_SCOPE_AGENT); }
__device__ __forceinline__ unsigned xb_add(unsigned* p, unsigned v) { return __hip_atomic_fetch_add(p, v, __ATOMIC_RELAXED, __HIP_MEMORY_SCOPE_AGENT); }
__device__ __forceinline__ unsigned xb_xcc_id() { return (unsigned)__builtin_amdgcn_s_getreg((3 << 11) | 20) & 0xFu; }
#define XB_SPIN(cond, bar) do { unsigned _sp = 0; while (cond) { __builtin_amdgcn_s_sleep(1); \
    if ((++_sp & 255u) == 0u) { if (xb_ld(&(bar)[XB_TMO])) break; if (_sp > XB_SPIN_CAP) { atomicAdd(&(bar)[XB_TMO], 1u); break; } } } } while (0)
struct XcdBarrier { unsigned* bar; unsigned x; volatile LAS unsigned* st; };
__device__ __forceinline__ XcdBarrier xcd_barrier_post(unsigned* bar, volatile LAS unsigned* st) {
    XcdBarrier b; b.bar = bar; b.x = xb_xcc_id(); b.st = st;
    if (threadIdx.x == 0) (void)xb_add(&bar[XB_XCNT(b.x)], 1u);
    return b;
}
__device__ __forceinline__ void xcd_barrier_complete(unsigned* bar, unsigned x, unsigned& nloc, unsigned& nx) {
    const unsigned G = gridDim.x * gridDim.y * gridDim.z;
    unsigned sum, cnt, mine, sp = 0u;
    for (;;) {
        sum = 0u; cnt = 0u; mine = 0u;
#pragma unroll
        for (unsigned j = 0; j < 16; ++j) { const unsigned c = xb_ld(&bar[XB_XCNT(j)]); sum += c; cnt += (c > 0u) ? 1u : 0u; mine = (j == x) ? c : mine; }
        if (sum == G) break;
        __builtin_amdgcn_s_sleep(1);
        if ((++sp & 255u) == 0u) { if (xb_ld(&bar[XB_TMO])) break; if (sp > XB_SPIN_CAP) { atomicAdd(&bar[XB_TMO], 1u); break; } }
    }
    nloc = mine > 0u ? mine : 1u; nx = cnt > 0u ? cnt : 1u;
}
__device__ __forceinline__ void xcd_barrier(const XcdBarrier& b) {
    asm volatile("s_waitcnt vmcnt(0)" ::: "memory");
    __syncthreads();
    if (threadIdx.x == 0) {
        unsigned* bar = b.bar;
        __builtin_amdgcn_s_waitcnt(0);
        unsigned nloc = b.st[0], nx = b.st[1];
        if (nloc == 0u) { xcd_barrier_complete(bar, b.x, nloc, nx); b.st[0] = nloc; b.st[1] = nx; }
        const unsigned old = xb_add(&bar[XB_XSUB(b.x)], 1u);
        const unsigned gen = old / nloc;
        if (old + 1u == (gen + 1u) * nloc) {
            __builtin_amdgcn_fence(__ATOMIC_RELEASE, "agent");
            asm volatile("s_waitcnt vmcnt(0)" ::: "memory");
            const unsigned og = xb_add(&bar[XB_TOP], 1u);
            const unsigned tg = og / nx;
            if (og + 1u == (tg + 1u) * nx) xb_add(&bar[XB_TOPGEN], 1u);
            else XB_SPIN(xb_ld(&bar[XB_TOPGEN]) == tg, bar);
            __builtin_amdgcn_fence(__ATOMIC_ACQUIRE, "agent");
            xb_add(&bar[XB_XGEN(b.x)], 1u);
            asm volatile("s_waitcnt vmcnt(0)" ::: "memory");
        } else {
            XB_SPIN(xb_ld(&bar[XB_XGEN(b.x)]) == gen, bar);
            __builtin_amdgcn_fence(__ATOMIC_ACQUIRE, "agent");
            asm volatile("s_waitcnt vmcnt(0)" ::: "memory");
        }
    }
    __syncthreads();
}

struct Frame {
    LAS unsigned char* lds;
    volatile LAS unsigned* MISC;
    gu32* ctl;
    int tid, lane, wave;
    int vcu, G;
    float* out;
    unsigned char* ws;
};
struct Args { const float* in[37]; float* out; unsigned char* ws; int ph_lo, ph_hi, li, pad; };
__device__ __forceinline__ float wave_sum(float v) {
#pragma unroll
    for (int o = 1; o < 64; o <<= 1) v += __shfl_xor(v, o);
    return v;
}
enum { I_XP = 0, I_XS, I_SCONV, I_SH, I_SSR, I_SSI, I_CP, I_CS, I_ADAW, I_ADAB, I_INPROJ, I_CONVW, I_CONVB, I_RGWR, I_RGBR, I_RGWI, I_RGBI, I_RGLAM,
       I_S5ARE, I_S5AIM, I_S5LOGDT, I_S5BRE, I_S5BIM, I_S5CRE, I_S5CIM, I_S5D, I_GLUW, I_GLUB, I_OUTPROJ, I_LN1G, I_LN1B, I_W1, I_B1, I_W2, I_B2, I_LN2G, I_LN2B };

__device__ __forceinline__ void p0_transpose_item(const float* W, int K, int N, bf16* WT, LAS float* scr, int item, int lane) {
    const int nblk = N / 32, kb = item / nblk, nb = item % nblk, k0 = 64 * kb, n0 = 32 * nb;
#pragma unroll 8
    for (int i = 0; i < 32; ++i) { const int kk = 2 * i + (lane >> 5); scr[kk * 33 + (lane & 31)] = W[(size_t)(k0 + kk) * N + n0 + (lane & 31)]; }
    LDS_WAIT(); asm volatile("" ::: "memory");
    const int c = lane & 7;
#pragma unroll
    for (int j = 0; j < 4; ++j) { const int n = (lane >> 3) + 8 * j; const LAS float* s = scr + (8 * c) * 33 + n;
        v4u o; o.x = pk2(s[0 * 33], s[1 * 33]); o.y = pk2(s[2 * 33], s[3 * 33]); o.z = pk2(s[4 * 33], s[5 * 33]); o.w = pk2(s[6 * 33], s[7 * 33]);
        *(GAS v4u*)(WT + (size_t)(n0 + n) * K + k0 + 8 * c) = o; }
    LDS_WAIT(); asm volatile("" ::: "memory");
}

__device__ __forceinline__ void p0_prologue(Frame& F, const Args& A) {
    LAS float* scr = (LAS float*)(F.lds + RING_OFF + F.wave * 16384);
    const int gw = F.wave * F.G + F.vcu, NGW = F.G * NWAVES;
    constexpr int I_IN = (D / 64) * (NZ / 32), I_GL = (WB / 64) * (WB / 32), I_OU = (D / 64) * (D / 32), I_1 = (D / 64) * (FF / 32), I_2 = (FF / 64) * (D / 32);
    constexpr int I_S5 = GB, I_RG = WA / 64;
    constexpr int NITEMS = I_IN + I_GL + I_OU + I_1 + I_2 + I_S5 + I_RG;
    float* sc = (float*)(F.ws + WS_S5C);
    for (int it = gw; it < NITEMS; it += NGW) {
        int r = it;
        if (r < I_IN) { p0_transpose_item(A.in[I_INPROJ], D, NZ, (bf16*)(F.ws + WS_WIN), scr, r, F.lane); continue; } r -= I_IN;
        if (r < I_GL) { p0_transpose_item(A.in[I_GLUW], WB, WB, (bf16*)(F.ws + WS_WGLU), scr, r, F.lane); continue; } r -= I_GL;
        if (r < I_OU) { p0_transpose_item(A.in[I_OUTPROJ], D, D, (bf16*)(F.ws + WS_WOUT), scr, r, F.lane); continue; } r -= I_OU;
        if (r < I_1) { p0_transpose_item(A.in[I_W1], D, FF, (bf16*)(F.ws + WS_W1), scr, r, F.lane); continue; } r -= I_1;
        if (r < I_2) { p0_transpose_item(A.in[I_W2], FF, D, (bf16*)(F.ws + WS_W2), scr, r, F.lane); continue; } r -= I_2;
        if (r < I_S5) {
            const int g = r, n = F.lane, gn = g * NS5 + n;
            const double dt = exp((double)A.in[I_S5LOGDT][g]), ar = (double)A.in[I_S5ARE][gn], ai = (double)A.in[I_S5AIM][gn];
            const double mag = exp(dt * ar), abr = mag * cos(dt * ai), abi = mag * sin(dt * ai), den = ar * ar + ai * ai, nr = abr - 1.0;
            const double qr = (nr * ar + abi * ai) / den, qi = (abi * ar - nr * ai) / den;
            sc[SC_ABR + gn] = (float)abr; sc[SC_ABI + gn] = (float)abi;
            for (int k = 0; k < KS5; ++k) { const double br = (double)A.in[I_S5BRE][gn * KS5 + k], bi = (double)A.in[I_S5BIM][gn * KS5 + k];
                sc[SC_BBR + gn * KS5 + k] = (float)(qr * br - qi * bi); sc[SC_BBI + gn * KS5 + k] = (float)(qr * bi + qi * br); }
            continue; } r -= I_S5;
        { const int c = r * 64 + F.lane; const double lam = (double)A.in[I_RGLAM][c];
          sc[SC_RGL + c] = (float)(-8.0 * log1p(exp(-lam)) * 1.4426950408889634); }
    }
    __syncthreads();
    LAS float* sT = (LAS float*)(F.lds + RING_OFF);
    float* mod = (float*)(F.ws + WS_MOD);
    constexpr int NRG = NROWMOD / 8, NCB = NMOD / 512;
    for (int it = F.vcu; it < NRG * NCB; it += F.G) {
        const int rg = it / NCB, cb = it % NCB;
        for (int e = F.tid; e < 8 * 1024; e += NWAVES * 64) { const int rr = e >> 10, k = e & 1023, row = rg * 8 + rr;
            const float v = row < NBP ? A.in[I_CP][(size_t)row * D + k] : A.in[I_CS][(size_t)(row - NBP) * D + k];
            sT[k * 8 + rr] = v / (1.f + expf(-v)); }
        __syncthreads();
        const int col = cb * 512 + F.tid; const float* w = A.in[I_ADAW] + col;
        float a[8];
#pragma unroll
        for (int i = 0; i < 8; ++i) a[i] = 0.f;
#pragma unroll 4
        for (int k = 0; k < 1024; ++k) { const float wv = w[(size_t)k * NMOD]; const f32x4 s0 = *(const LAS f32x4*)(sT + k * 8), s1 = *(const LAS f32x4*)(sT + k * 8 + 4);
            a[0] += s0[0] * wv; a[1] += s0[1] * wv; a[2] += s0[2] * wv; a[3] += s0[3] * wv; a[4] += s1[0] * wv; a[5] += s1[1] * wv; a[6] += s1[2] * wv; a[7] += s1[3] * wv; }
        const float bb = A.in[I_ADAB][col];
#pragma unroll
        for (int i = 0; i < 8; ++i) mod[(size_t)(rg * 8 + i) * NMOD + col] = a[i] + bb;
        __syncthreads();
    }
}

__device__ __forceinline__ int mod_row(int m) { return m < MP ? (m >> 11) : NBP + ((m - MP) >> 2); }
__device__ __forceinline__ const float* x_row(const Args& A, int m) { return m < MP ? A.in[I_XP] + (size_t)m * D : A.in[I_XS] + (size_t)(m - MP) * D; }

__device__ __forceinline__ void p1_modulate(Frame& F, const Args& A) {
    const int gw = F.vcu * NWAVES + F.wave, NGW = F.G * NWAVES;
    const float* mod = (const float*)(F.ws + WS_MOD); bf16* XN = (bf16*)(F.ws + WS_XN);
    for (int m = gw; m < M; m += NGW) {
        const GAS f32x4* xr = (const GAS f32x4*)x_row(A, m) + F.lane; const float* mr = mod + (size_t)mod_row(m) * NMOD;
        const GAS f32x4* sh = (const GAS f32x4*)(mr) + F.lane; const GAS f32x4* scp = (const GAS f32x4*)(mr + D) + F.lane;
        GAS unsigned long long* o8 = (GAS unsigned long long*)(XN + (size_t)m * D) + F.lane;
#pragma unroll
        for (int j = 0; j < 4; ++j) { const f32x4 v = xr[64 * j], a = sh[64 * j], s = scp[64 * j]; const f32x4 h = v * (s + 1.f) + a;
            o8[64 * j] = (unsigned long long)pk2(h.x, h.y) | ((unsigned long long)pk2(h.z, h.w) << 32); }
    }
}

template <bool SECOND>
__device__ __forceinline__ void ln_rows(Frame& F, const Args& A) {
    const int gw = F.vcu * NWAVES + F.wave, NGW = F.G * NWAVES;
    const float* mod = (const float*)(F.ws + WS_MOD); bf16* XN = (bf16*)(F.ws + WS_XN);
    const GAS f32x4* gg = (const GAS f32x4*)A.in[SECOND ? I_LN2G : I_LN1G] + F.lane; const GAS f32x4* gb = (const GAS f32x4*)A.in[SECOND ? I_LN2B : I_LN1B] + F.lane;
    for (int m = gw; m < M; m += NGW) {
        GAS f32x4* xr = (GAS f32x4*)(F.out + (size_t)m * D) + F.lane;
        f32x4 v[4]; float s = 0.f;
#pragma unroll
        for (int j = 0; j < 4; ++j) { v[j] = xr[64 * j]; s += (v[j].x + v[j].y) + (v[j].z + v[j].w); }
        const float mean = wave_sum(s) * (1.f / D); float s2 = 0.f;
#pragma unroll
        for (int j = 0; j < 4; ++j) { v[j] = v[j] - mean; s2 += (v[j].x * v[j].x + v[j].y * v[j].y) + (v[j].z * v[j].z + v[j].w * v[j].w); }
        const float rstd = 1.f / sqrtf(wave_sum(s2) * (1.f / D) + LN_EPS);
#pragma unroll
        for (int j = 0; j < 4; ++j) { v[j] = v[j] * rstd * gg[64 * j] + gb[64 * j]; xr[64 * j] = v[j]; }
        if (!SECOND) {
            const float* mr = mod + (size_t)mod_row(m) * NMOD;
            const GAS f32x4* sh = (const GAS f32x4*)(mr + 3 * D) + F.lane; const GAS f32x4* scp = (const GAS f32x4*)(mr + 4 * D) + F.lane;
            GAS unsigned long long* o8 = (GAS unsigned long long*)(XN + (size_t)m * D) + F.lane;
#pragma unroll
            for (int j = 0; j < 4; ++j) { const f32x4 h = v[j] * (scp[64 * j] + 1.f) + sh[64 * j];
                o8[64 * j] = (unsigned long long)pk2(h.x, h.y) | ((unsigned long long)pk2(h.z, h.w) << 32); }
        }
    }
}

__device__ __forceinline__ void rg_item_ref(Frame& F, const Args& A, bool prompt, int b, int hd, LAS float* scr) {
    const int j = F.lane, c = hd * HDA + j;
    const bf16* Z = (const bf16*)(F.ws + WS_Z); bf16* Y = (bf16*)(F.ws + WS_YCAT); const float* sc = (const float*)(F.ws + WS_S5C);
    float wr[64], wi[64];
#pragma unroll
    for (int i = 0; i < 64; ++i) { wr[i] = A.in[I_RGWR][(size_t)(hd * 64 + i) * 64 + j]; wi[i] = A.in[I_RGWI][(size_t)(hd * 64 + i) * 64 + j]; }
    const float br = A.in[I_RGBR][c], bi = A.in[I_RGBI][c], L2 = sc[SC_RGL + c];
    const float w0 = A.in[I_CONVW][c], w1 = A.in[I_CONVW][WA + c], w2 = A.in[I_CONVW][2 * WA + c], w3 = A.in[I_CONVW][3 * WA + c], cb = A.in[I_CONVB][c];
    int T, m0; float x3, x2, x1, h;
    if (prompt) { T = TP; m0 = b * TP; x3 = 0.f; x2 = 0.f; x1 = 0.f; h = 0.f; }
    else { T = TS; m0 = MP + b * TS; x3 = A.in[I_SCONV][(size_t)(b * 3 + 0) * WA + c]; x2 = A.in[I_SCONV][(size_t)(b * 3 + 1) * WA + c]; x1 = A.in[I_SCONV][(size_t)(b * 3 + 2) * WA + c]; h = A.in[I_SH][(size_t)b * WA + c]; }
    for (int t = 0; t < T; ++t) {
        const size_t m = (size_t)(m0 + t);
        const float xa = bf2f(Z[m * NZ + WA + c]), gate = bf2f(Z[m * NZ + c]);
        const float xc = cb + w0 * x3 + w1 * x2 + w2 * x1 + w3 * xa; x3 = x2; x2 = x1; x1 = xa;
        scr[j] = xc; LDS_WAIT(); asm volatile("" ::: "memory");
        float rp = br, gp = bi;
#pragma unroll
        for (int i4 = 0; i4 < 16; ++i4) { const f32x4 v = *(const LAS f32x4*)(scr + 4 * i4);
            rp += v[0] * wr[4 * i4] + v[1] * wr[4 * i4 + 1] + v[2] * wr[4 * i4 + 2] + v[3] * wr[4 * i4 + 3];
            gp += v[0] * wi[4 * i4] + v[1] * wi[4 * i4 + 1] + v[2] * wi[4 * i4 + 2] + v[3] * wi[4 * i4 + 3]; }
        LDS_WAIT(); asm volatile("" ::: "memory");
        const float r = sigmoidf_(rp), gi = sigmoidf_(gp);
        const float a = exp2f(r * L2);
        float mult = sqrtf(fmaxf(1.f - a * a, 0.f));
        if (prompt && t == 0) mult = 1.f;
        h = a * h + mult * gi * xc;
        Y[m * D + c] = (bf16)f2bf(gelu_tanh(gate) * h);
    }
    float* oc = F.out + (prompt ? O_CONVP : O_CONVS); float* oh = F.out + (prompt ? O_HP : O_HS);
    oc[(size_t)(b * 3 + 0) * WA + c] = x3; oc[(size_t)(b * 3 + 1) * WA + c] = x2; oc[(size_t)(b * 3 + 2) * WA + c] = x1;
    oh[(size_t)b * WA + c] = h;
}
__device__ __forceinline__ void s5_item_ref(Frame& F, const Args& A, bool prompt, int b, int g, LAS float* scr) {
    const int n = F.lane, gn = g * NS5 + n, k = F.lane & 15, part = F.lane >> 4;
    const bf16* Z = (const bf16*)(F.ws + WS_Z); bf16* Gy = (bf16*)(F.ws + WS_G); const float* sc = (const float*)(F.ws + WS_S5C);
    float bbr[16], bbi[16], cre[16], cim[16];
#pragma unroll
    for (int i = 0; i < 16; ++i) { bbr[i] = sc[SC_BBR + gn * KS5 + i]; bbi[i] = sc[SC_BBI + gn * KS5 + i];
        cre[i] = A.in[I_S5CRE][(size_t)(g * KS5 + k) * NS5 + part * 16 + i]; cim[i] = A.in[I_S5CIM][(size_t)(g * KS5 + k) * NS5 + part * 16 + i]; }
    const float abr = sc[SC_ABR + gn], abi = sc[SC_ABI + gn], dk = A.in[I_S5D][g * KS5 + k];
    int T, m0; float hr, hi;
    if (prompt) { T = TP; m0 = b * TP; hr = 0.f; hi = 0.f; }
    else { T = TS; m0 = MP + b * TS; hr = A.in[I_SSR][(size_t)(b * GB + g) * NS5 + n]; hi = A.in[I_SSI][(size_t)(b * GB + g) * NS5 + n]; }
    for (int t = 0; t < T; ++t) {
        const size_t m = (size_t)(m0 + t);
        const bf16* zr = Z + m * NZ + 2 * WA + g * KS5;
        const v4u u0 = *(const v4u*)zr, u1 = *(const v4u*)(zr + 8);
        float u[16];
        u[0] = pg8::bf_lo(u0.x); u[1] = pg8::bf_hi(u0.x); u[2] = pg8::bf_lo(u0.y); u[3] = pg8::bf_hi(u0.y); u[4] = pg8::bf_lo(u0.z); u[5] = pg8::bf_hi(u0.z); u[6] = pg8::bf_lo(u0.w); u[7] = pg8::bf_hi(u0.w);
        u[8] = pg8::bf_lo(u1.x); u[9] = pg8::bf_hi(u1.x); u[10] = pg8::bf_lo(u1.y); u[11] = pg8::bf_hi(u1.y); u[12] = pg8::bf_lo(u1.z); u[13] = pg8::bf_hi(u1.z); u[14] = pg8::bf_lo(u1.w); u[15] = pg8::bf_hi(u1.w);
        float bur = 0.f, bui = 0.f;
#pragma unroll
        for (int i = 0; i < 16; ++i) { bur += bbr[i] * u[i]; bui += bbi[i] * u[i]; }
        const float nhr = abr * hr - abi * hi + bur, nhi = abr * hi + abi * hr + bui; hr = nhr; hi = nhi;
        scr[n] = hr; scr[64 + n] = hi; LDS_WAIT(); asm volatile("" ::: "memory");
        float p = 0.f;
#pragma unroll
        for (int i4 = 0; i4 < 4; ++i4) { const f32x4 vr = *(const LAS f32x4*)(scr + part * 16 + 4 * i4), vi = *(const LAS f32x4*)(scr + 64 + part * 16 + 4 * i4);
#pragma unroll
            for (int e = 0; e < 4; ++e) p += vr[e] * cre[4 * i4 + e] - vi[e] * cim[4 * i4 + e]; }
        LDS_WAIT(); asm volatile("" ::: "memory");
        p += __shfl_xor(p, 16); p += __shfl_xor(p, 32);
        const float uk = bf2f(zr[k]);
        if (F.lane < 16) Gy[m * WB + g * KS5 + k] = (bf16)f2bf(gelu_tanh(p + dk * uk));
    }
    float* osr = F.out + (prompt ? O_SRP : O_SRS); float* osi = F.out + (prompt ? O_SIP : O_SIS);
    osr[(size_t)(b * GB + g) * NS5 + n] = hr; osi[(size_t)(b * GB + g) * NS5 + n] = hi;
}
__device__ __forceinline__ void p3_mixers_ref(Frame& F, const Args& A) {
    LAS float* scr = (LAS float*)(F.lds + RING_OFF + F.wave * 1024);
    const int gw = F.wave * F.G + F.vcu, NGW = F.G * NWAVES;
    constexpr int N_RGP = NBP * HA, N_S5P = NBP * GB, N_RGS = NBS * HA, N_S5S = NBS * GB;
    for (int it = gw; it < N_RGP + N_S5P + N_RGS + N_S5S; it += NGW) {
        int r = it;
        if (r < N_RGP) { rg_item_ref(F, A, true, r / HA, r % HA, scr); continue; } r -= N_RGP;
        if (r < N_S5P) { s5_item_ref(F, A, true, r / GB, r % GB, scr); continue; } r -= N_S5P;
        if (r < N_RGS) { rg_item_ref(F, A, false, r / HA, r % HA, scr); continue; } r -= N_RGS;
        s5_item_ref(F, A, false, r / GB, r % GB, scr);
    }
}

__global__ void __launch_bounds__(NWAVES * 64, 2) fwd(Args A) {
    extern __shared__ __attribute__((aligned(16))) unsigned char lds[];
    Frame F;
    F.lds = (LAS unsigned char*)lds;
    F.MISC = (volatile LAS unsigned*)(F.lds + MISC_OFF);
    F.tid = threadIdx.x; F.lane = F.tid & 63; F.wave = __builtin_amdgcn_readfirstlane(F.tid >> 6);
    F.G = gridDim.x; { const int bx = blockIdx.x; F.vcu = (F.G % 8 == 0) ? (bx % 8) * (F.G / 8) + bx / 8 : bx; }
    F.out = A.out; F.ws = A.ws; F.ctl = (gu32*)(A.ws + WS_CTL);
    for (int u = F.tid; u < (LDS_BYTES - LDSCTL_OFF) / 4; u += NWAVES * 64) ((LAS unsigned*)(F.lds + LDSCTL_OFF))[u] = 0u;
    __syncthreads();
    XcdBarrier bar; bar.bar = (unsigned*)(F.ctl + CW_BAR); bar.x = 0; bar.st = nullptr;
    if (N_LAUNCHES == 1) bar = xcd_barrier_post((unsigned*)(F.ctl + CW_BAR), F.MISC + 8);
#define GRID_BAR() do { if (N_LAUNCHES == 1) xcd_barrier(bar); } while (0)
    const int lo = A.ph_lo, hi = A.ph_hi;
#define IN(k) (lo <= (k) && (k) < hi)
#define BOTH(k) (IN(k) && IN((k) + 1))
    bf16* XN = (bf16*)(F.ws + WS_XN); bf16* Z = (bf16*)(F.ws + WS_Z); bf16* YC = (bf16*)(F.ws + WS_YCAT); bf16* GY = (bf16*)(F.ws + WS_G); bf16* U = (bf16*)(F.ws + WS_U);
    const float* mod = (const float*)(F.ws + WS_MOD);

    if (IN(0)) { p0_prologue(F, A); if (BOTH(0)) GRID_BAR(); }
    if (IN(1)) { p1_modulate(F, A); if (BOTH(1)) GRID_BAR(); }
    if (IN(2)) {
        pg8::Gemm g{XN, (const bf16*)(F.ws + WS_WIN), M, NZ, D}; pg8::StaticOrder S; S.init(M, NZ, F.G, (int)blockIdx.x);
        pg8::EpiBf16<0> E{Z, NZ, nullptr};
        pg8::gemm_phase<pg8::EpiBf16<0>, pg8::StaticOrder, PG8_ALIGN, PG8_SP2>(F.lds + RING_OFF, g, S, E);
        if (BOTH(2)) GRID_BAR();
    }
    if (IN(3)) { p3_mixers_ref(F, A); if (BOTH(3)) GRID_BAR(); }
    if (IN(4)) {
        pg8::Gemm g{GY, (const bf16*)(F.ws + WS_WGLU), M, WB, WB}; pg8::StaticOrder S; S.init(M, WB, F.G, (int)blockIdx.x);
        pg8::EpiGlu E{GY, WB, YC, D, WA, A.in[I_GLUB]};
        pg8::gemm_phase<pg8::EpiGlu, pg8::StaticOrder, PG8_ALIGN, PG8_SP2>(F.lds + RING_OFF, g, S, E);
        if (BOTH(4)) GRID_BAR();
    }
    if (IN(5)) {
        pg8::Gemm g{YC, (const bf16*)(F.ws + WS_WOUT), M, D, D}; pg8::StaticOrder S; S.init(M, D, F.G, (int)blockIdx.x);
        pg8::EpiRes E{A.in[I_XP], A.in[I_XS], F.out, mod + 2 * D, nullptr, ALPHA, MP};
        pg8::gemm_phase<pg8::EpiRes, pg8::StaticOrder, PG8_ALIGN, PG8_SP2>(F.lds + RING_OFF, g, S, E);
        if (BOTH(5)) GRID_BAR();
    }
    if (IN(6)) { ln_rows<false>(F, A); if (BOTH(6)) GRID_BAR(); }
    if (IN(7)) {
        pg8::Gemm g{XN, (const bf16*)(F.ws + WS_W1), M, FF, D}; pg8::StaticOrder S; S.init(M, FF, F.G, (int)blockIdx.x);
        pg8::EpiBf16<3> E{U, FF, A.in[I_B1]};
        pg8::gemm_phase<pg8::EpiBf16<3>, pg8::StaticOrder, PG8_ALIGN, PG8_SP2>(F.lds + RING_OFF, g, S, E);
        if (BOTH(7)) GRID_BAR();
    }
    if (IN(8)) {
        pg8::Gemm g{U, (const bf16*)(F.ws + WS_W2), M, D, FF}; pg8::StaticOrder S; S.init(M, D, F.G, (int)blockIdx.x);
        pg8::EpiRes E{F.out, F.out + (size_t)MP * D, F.out, mod + 5 * D, A.in[I_B2], ALPHA, MP};
        pg8::gemm_phase<pg8::EpiRes, pg8::StaticOrder, PG8_ALIGN, PG8_SP2>(F.lds + RING_OFF, g, S, E);
        if (BOTH(8)) GRID_BAR();
    }
    if (IN(9)) { ln_rows<true>(F, A); }
#undef IN
#undef BOTH
}

extern "C" void kernel_launch(void* const* d_in, const int* in_sizes, int n_in, void* d_out, int out_size, void* d_ws, size_t ws_size, hipStream_t stream) {
    static int grid = 0;
    if (grid == 0) {
        if (n_in != 37 || in_sizes[0] != MP * D || out_size != (int)O_END || ws_size < WS_END) { fprintf(stderr, "kernel_launch: unexpected shapes (n_in %d, in0 %d, out %d, ws %zu)\n", n_in, n_in > 0 ? in_sizes[0] : -1, out_size, ws_size); grid = -1; return; }
        int dev = 0, cus = 0, per_cu = 0;
        if (hipGetDevice(&dev) != hipSuccess || hipDeviceGetAttribute(&cus, hipDeviceAttributeMultiprocessorCount, dev) != hipSuccess) { grid = -1; return; }
        if (hipFuncSetAttribute((const void*)fwd, hipFuncAttributeMaxDynamicSharedMemorySize, LDS_BYTES) != hipSuccess) { fprintf(stderr, "kernel_launch: hipFuncSetAttribute failed\n"); grid = -1; return; }
        if (hipOccupancyMaxActiveBlocksPerMultiprocessor(&per_cu, (const void*)fwd, NWAVES * 64, LDS_BYTES) != hipSuccess || per_cu < 1) { fprintf(stderr, "kernel_launch: occupancy query says %d\n", per_cu); }
        (void)hipGetLastError();
        grid = cus;
    }
    if (grid < 0) return;
    (void)hipMemsetAsync((char*)d_ws + WS_CTL, 0, CTL_ZERO_BYTES, stream);
    Args a{};
    for (int i = 0; i < 37; ++i) a.in[i] = (const float*)d_in[i];
    a.out = (float*)d_out; a.ws = (unsigned char*)d_ws;
    for (int li = 0; li < N_LAUNCHES; ++li) {
        if (N_LAUNCHES == 1) { a.ph_lo = 0; a.ph_hi = N_PHASES; } else { a.ph_lo = li; a.ph_hi = li + 1; }
        a.li = li;
        hipLaunchKernelGGL(fwd, dim3(grid), dim3(NWAVES * 64), LDS_BYTES, stream, a);
    }
}
```

```cpp
#include <hip/hip_runtime.h>
#include <cstdio>
#include <cstdint>
#include <cmath>

#ifndef MK_N_LAUNCHES
#define MK_N_LAUNCHES 1
#endif

namespace pg8 {
#define PG8_LAS __attribute__((address_space(3)))
typedef unsigned short bf16_t;
typedef short bf16x8 __attribute__((ext_vector_type(8)));
typedef float f32x4 __attribute__((ext_vector_type(4)));
typedef unsigned u32x4 __attribute__((ext_vector_type(4)));
constexpr int BM = 256, BK = 64, HALF = 128, HTB = HALF * BK * 2, STAGE_BYTES = 8 * HTB, NXCD = 8, WGM = 8;

__host__ __device__ __forceinline__ int lds_byte(int r, int c) { const int st = (r >> 4) * 2 + (c >> 5), rr = r & 15, cc = c & 31, ob = rr * 64 + cc * 2; return st * 1024 + (ob ^ (((ob >> 9) & 1) << 5)); }
__host__ __device__ __forceinline__ void stage_rc(int b, int& R, int& C) { const int st = b / 1024, sb = b % 1024, swz = sb ^ (((sb >> 9) & 1) << 5); R = (st >> 1) * 16 + swz / 64; C = (st & 1) * 32 + (swz % 64) / 2; }
__host__ __device__ __forceinline__ int perm32(int rho) { const int n = rho >> 4, i = rho & 15; return 8 * (i >> 2) + 4 * n + (i & 3); }

struct Unit { int pm, pn; };
struct Gemm { const bf16_t* A; const bf16_t* Bt; int M, N, K; };

struct StaticOrder {
    int nM, nN, nwg, G, c;
    __host__ __device__ void init(int M, int N, int G_, int c_) { nM = M / BM; nN = N / BM; nwg = nM * nN; G = G_; c = c_; }
    __host__ __device__ bool next(int i, Unit& u) const {
        const long L = (long)i * G + c; if (L >= nwg) return false;
        int wgid = (int)L; { const int q = nwg / NXCD, r = nwg % NXCD, xcd = wgid % NXCD, off = wgid / NXCD; wgid = (xcd < r ? xcd * (q + 1) : r * (q + 1) + (xcd - r) * q) + off; }
        const int nig = WGM * nN, gid = wgid / nig, fm = gid * WGM, gsz = (nM - fm) < WGM ? (nM - fm) : WGM;
        u.pm = fm + ((wgid % nig) % gsz); u.pn = (wgid % nig) / gsz; return true;
    }
    __device__ __forceinline__ void a_ready(const Unit&) const {}
    __device__ __forceinline__ void done(const Unit&) const {}
};

__device__ __forceinline__ unsigned cvt_pk_bf16(float lo, float hi) { unsigned r; asm volatile("v_cvt_pk_bf16_f32 %0, %1, %2" : "=v"(r) : "v"(lo), "v"(hi)); return r; }
__device__ __forceinline__ float bf_lo(unsigned w) { return __builtin_bit_cast(float, w << 16); }
__device__ __forceinline__ float bf_hi(unsigned w) { return __builtin_bit_cast(float, w & 0xffff0000u); }

template <int ACT> struct EpiBf16 {
    static constexpr bool PERM = true, AFTER_DRAIN = false;
    bf16_t* O; int ldc; const float* bias;
    __device__ __forceinline__ void operator()(const f32x4 (&acc)[2][2][4][2], const Unit& u, int wr, int wc, int fr, int fq) const {
        const int row0 = u.pm * BM + wr * 64 + fr; const int col0 = u.pn * BM + wc * 32 + 8 * fq;
        f32x4 bv[2][2];
#pragma unroll
        for (int bj = 0; bj < 2; ++bj)
#pragma unroll
            for (int n = 0; n < 2; ++n) bv[bj][n] = bias ? *(const f32x4*)(bias + col0 + bj * HALF + 4 * n) : (f32x4){0.f, 0.f, 0.f, 0.f};
#pragma unroll
        for (int ai = 0; ai < 2; ++ai)
#pragma unroll
            for (int m = 0; m < 4; ++m) { bf16_t* rowp = O + (size_t)(row0 + ai * HALF + m * 16) * ldc + col0;
#pragma unroll
                for (int bj = 0; bj < 2; ++bj) { f32x4 v0 = acc[ai][bj][m][0] + bv[bj][0], v1 = acc[ai][bj][m][1] + bv[bj][1];
                    if (ACT == 3) {
#pragma unroll
                        for (int e = 0; e < 4; ++e) { const float a = fmaxf(v0[e], 0.f), b = fmaxf(v1[e], 0.f); v0[e] = a * a; v1[e] = b * b; } }
                    u32x4 w; w.x = cvt_pk_bf16(v0[0], v0[1]); w.y = cvt_pk_bf16(v0[2], v0[3]); w.z = cvt_pk_bf16(v1[0], v1[1]); w.w = cvt_pk_bf16(v1[2], v1[3]);
                    *(u32x4*)(rowp + bj * HALF) = w; } }
    }
};
struct EpiGlu {
    static constexpr bool PERM = true, AFTER_DRAIN = false;
    const bf16_t* Gy; int ldg; bf16_t* O; int ldc; int coff; const float* bias;
    __device__ __forceinline__ void operator()(const f32x4 (&acc)[2][2][4][2], const Unit& u, int wr, int wc, int fr, int fq) const {
        const int row0 = u.pm * BM + wr * 64 + fr; const int col0 = u.pn * BM + wc * 32 + 8 * fq;
        f32x4 bv[2][2];
#pragma unroll
        for (int bj = 0; bj < 2; ++bj)
#pragma unroll
            for (int n = 0; n < 2; ++n) bv[bj][n] = *(const f32x4*)(bias + col0 + bj * HALF + 4 * n);
#pragma unroll
        for (int ai = 0; ai < 2; ++ai)
#pragma unroll
            for (int m = 0; m < 4; ++m) { const size_t row = (size_t)(row0 + ai * HALF + m * 16);
#pragma unroll
                for (int bj = 0; bj < 2; ++bj) { const f32x4 v0 = acc[ai][bj][m][0] + bv[bj][0], v1 = acc[ai][bj][m][1] + bv[bj][1];
                    const u32x4 g = *(const u32x4*)(Gy + row * ldg + col0 + bj * HALF);
                    float o[8];
                    o[0] = bf_lo(g.x) / (1.f + __expf(-v0[0])); o[1] = bf_hi(g.x) / (1.f + __expf(-v0[1]));
                    o[2] = bf_lo(g.y) / (1.f + __expf(-v0[2])); o[3] = bf_hi(g.y) / (1.f + __expf(-v0[3]));
                    o[4] = bf_lo(g.z) / (1.f + __expf(-v1[0])); o[5] = bf_hi(g.z) / (1.f + __expf(-v1[1]));
                    o[6] = bf_lo(g.w) / (1.f + __expf(-v1[2])); o[7] = bf_hi(g.w) / (1.f + __expf(-v1[3]));
                    u32x4 w; w.x = cvt_pk_bf16(o[0], o[1]); w.y = cvt_pk_bf16(o[2], o[3]); w.z = cvt_pk_bf16(o[4], o[5]); w.w = cvt_pk_bf16(o[6], o[7]);
                    *(u32x4*)(O + row * ldc + coff + col0 + bj * HALF) = w; } }
    }
};
struct EpiRes {
    static constexpr bool PERM = false, AFTER_DRAIN = false;
    const float* basep; const float* bases; float* out; const float* gate  ; const float* bias; float alpha; int MP;
    __device__ __forceinline__ void operator()(const f32x4 (&acc)[2][2][4][2], const Unit& u, int wr, int wc, int fr, int fq) const {
        const int row0 = u.pm * BM + wr * 64 + fr, col0 = u.pn * BM + wc * 32 + 4 * fq;
        f32x4 bv[2][2];
#pragma unroll
        for (int bj = 0; bj < 2; ++bj)
#pragma unroll
            for (int n = 0; n < 2; ++n) bv[bj][n] = bias ? *(const f32x4*)(bias + col0 + bj * HALF + n * 16) : (f32x4){0.f, 0.f, 0.f, 0.f};
#pragma unroll
        for (int ai = 0; ai < 2; ++ai)
#pragma unroll
            for (int m = 0; m < 4; ++m) { const int row = row0 + ai * HALF + m * 16;
                const bool smp = row >= MP; const int mr = smp ? 8 + ((row - MP) >> 2) : (row >> 11);
                const float* bp = smp ? bases + (size_t)(row - MP) * 1024 : basep + (size_t)row * 1024;
                const float* gp = gate + (size_t)mr * 6144; float* op = out + (size_t)row * 1024;
#pragma unroll
                for (int bj = 0; bj < 2; ++bj)
#pragma unroll
                    for (int n = 0; n < 2; ++n) { const int c = col0 + bj * HALF + n * 16;
                        const f32x4 b = *(const f32x4*)(bp + c), g = *(const f32x4*)(gp + c);
                        *(f32x4*)(op + c) = b * alpha + g * (acc[ai][bj][m][n] + bv[bj][n]); } }
    }
};

template <class Epi, class Sched, bool ALIGN_EPI = false, bool SP2 = false>
__device__ __forceinline__ void gemm_phase(PG8_LAS unsigned char* lds, const Gemm g, const Sched& S, const Epi& E) {
    const int tid = threadIdx.x, wid = __builtin_amdgcn_readfirstlane(tid >> 6), lane = tid & 63, wr = wid >> 2, wc = wid & 3, fr = lane & 15, fq = lane >> 4;
    const int K = g.K, nt = K / BK;
    unsigned voffA[2], voffB[2];
#pragma unroll
    for (int i = 0; i < 2; ++i) { int R, C; stage_rc(tid * 16 + i * 8192, R, C); const int Rb = Epi::PERM ? ((R & ~31) + perm32(R & 31)) : R;
        voffA[i] = (unsigned)(R * K + C) * 2u; voffB[i] = (unsigned)(Rb * K + C) * 2u; }
    const size_t kstep = (size_t)(BK * 2);
    const size_t hstep = (size_t)HALF * K * 2;
    const size_t tstep = 2 * hstep;
    const unsigned ldsw = (unsigned)wid * 1024u;
    const int aoff = lds_byte(wr * 64 + fr, fq * 8), boff = lds_byte(wc * 32 + fr, fq * 8);
#define PG8_SA(b, h) (((b) * 2 + (h)) * HTB)
#define PG8_SB(b, h) ((4 + (b) * 2 + (h)) * HTB)
#define PG8_STAGE(bufoff, gbase, voff) do { _Pragma("unroll") for (int _i = 0; _i < 2; ++_i) \
        __builtin_amdgcn_global_load_lds((const unsigned*)((const char*)(gbase) + (voff)[_i]), (PG8_LAS unsigned*)(lds + (bufoff) + ldsw + _i * 8192), 16, 0, 0); } while (0)
#define PG8_LDA(dst, b, h) do { _Pragma("unroll") for (int m = 0; m < 4; ++m) _Pragma("unroll") for (int k = 0; k < 2; ++k) dst[m][k] = *(const PG8_LAS bf16x8*)(lds + PG8_SA(b, h) + aoff + m * 2048 + k * 1024); } while (0)
#define PG8_LDB(dst, b, h) do { _Pragma("unroll") for (int n = 0; n < 2; ++n) _Pragma("unroll") for (int k = 0; k < 2; ++k) dst[n][k] = *(const PG8_LAS bf16x8*)(lds + PG8_SB(b, h) + boff + n * 2048 + k * 1024); } while (0)
#define PG8_MMA(ai, bj, At, Bt) do { __builtin_amdgcn_s_setprio(1); _Pragma("unroll") for (int m = 0; m < 4; ++m) _Pragma("unroll") for (int n = 0; n < 2; ++n) _Pragma("unroll") for (int k = 0; k < 2; ++k) \
        acc[ai][bj][m][n] = __builtin_amdgcn_mfma_f32_16x16x32_bf16(Bt[n][k], At[m][k], acc[ai][bj][m][n], 0, 0, 0); __builtin_amdgcn_s_setprio(0); } while (0)
#define PG8_WAIT_V(n) asm volatile("s_waitcnt vmcnt(" #n ")" ::: "memory")
#define PG8_WAIT_L(n) asm volatile("s_waitcnt lgkmcnt(" #n ")" ::: "memory")
#define PG8_BAR __builtin_amdgcn_s_barrier()
#define PG8_SCHED __builtin_amdgcn_sched_barrier(0)
    Unit cur, nxt; int ui = 0;
    if (!S.next(0, cur)) return;
    f32x4 acc[2][2][4][2];
#pragma unroll
    for (int a = 0; a < 2; ++a)
#pragma unroll
        for (int b = 0; b < 2; ++b)
#pragma unroll
            for (int m = 0; m < 4; ++m)
#pragma unroll
                for (int n = 0; n < 2; ++n) acc[a][b][m][n] = (f32x4){0.f, 0.f, 0.f, 0.f};
    bf16x8 At[4][2], B0[2][2], B1[2][2];
    const char* cA = (const char*)g.A + (size_t)cur.pm * tstep; const char* cB = (const char*)g.Bt + (size_t)cur.pn * tstep;
    S.a_ready(cur);
    if constexpr (SP2) {
        PG8_STAGE(PG8_SB(0, 0), cB, voffB); PG8_STAGE(PG8_SB(0, 1), cB + hstep, voffB); PG8_STAGE(PG8_SA(0, 0), cA, voffA); PG8_STAGE(PG8_SA(0, 1), cA + hstep, voffA);
        if (wr == 1) PG8_BAR;
        PG8_WAIT_V(2); PG8_BAR;
        PG8_STAGE(PG8_SB(1, 0), cB + kstep, voffB); PG8_STAGE(PG8_SA(1, 0), cA + kstep, voffA); PG8_STAGE(PG8_SB(1, 1), cB + hstep + kstep, voffB);
        PG8_WAIT_V(6); PG8_BAR;
    } else {
        PG8_STAGE(PG8_SB(0, 0), cB, voffB); PG8_STAGE(PG8_SA(0, 0), cA, voffA); PG8_STAGE(PG8_SB(0, 1), cB + hstep, voffB); PG8_STAGE(PG8_SA(0, 1), cA + hstep, voffA);
        if (wr == 1) PG8_BAR;
        PG8_WAIT_V(4); PG8_BAR;
        PG8_STAGE(PG8_SB(1, 0), cB + kstep, voffB); PG8_STAGE(PG8_SA(1, 0), cA + kstep, voffA); PG8_STAGE(PG8_SB(1, 1), cB + hstep + kstep, voffB);
        PG8_WAIT_V(6); PG8_BAR;
    }
    for (;;) {
        const bool has_next = S.next(ui + 1, nxt);
        const char* nA = has_next ? (const char*)g.A + (size_t)nxt.pm * tstep : cA; const char* nB = has_next ? (const char*)g.Bt + (size_t)nxt.pn * tstep : cB;
        for (int t = 0; t < nt; t += 2) {
            const bool last = (t == nt - 2);
            const char* a1 = cA + (size_t)(t + 1) * kstep;
            const char* a2 = last ? nA : cA + (size_t)(t + 2) * kstep; const char* b2 = last ? nB : cB + (size_t)(t + 2) * kstep;
            const char* a3 = a2 + kstep; const char* b3 = b2 + kstep;
            if (last && has_next) S.a_ready(nxt);
            if constexpr (SP2) {
            PG8_LDB(B0, 0, 0); PG8_LDB(B1, 0, 1); PG8_SCHED; PG8_LDA(At, 0, 0); PG8_STAGE(PG8_SA(1, 1), a1 + hstep, voffA);
            PG8_WAIT_V(8); PG8_WAIT_L(0); PG8_BAR; PG8_MMA(0, 0, At, B0); PG8_MMA(0, 1, At, B1); PG8_BAR; PG8_SCHED;
            PG8_LDA(At, 0, 1); PG8_STAGE(PG8_SB(0, 0), b2, voffB); PG8_STAGE(PG8_SB(0, 1), b2 + hstep, voffB); PG8_STAGE(PG8_SA(0, 0), a2, voffA);
            PG8_WAIT_V(8); PG8_WAIT_L(0); PG8_BAR; PG8_MMA(1, 0, At, B0); PG8_MMA(1, 1, At, B1); PG8_BAR; PG8_SCHED;
            PG8_LDB(B0, 1, 0); PG8_LDB(B1, 1, 1); PG8_SCHED; PG8_LDA(At, 1, 0); PG8_STAGE(PG8_SA(0, 1), a2 + hstep, voffA);
            PG8_WAIT_V(8); PG8_WAIT_L(0); PG8_BAR; PG8_MMA(0, 0, At, B0); PG8_MMA(0, 1, At, B1); PG8_BAR; PG8_SCHED;
            PG8_LDA(At, 1, 1); PG8_STAGE(PG8_SB(1, 0), b3, voffB); PG8_STAGE(PG8_SB(1, 1), b3 + hstep, voffB); PG8_STAGE(PG8_SA(1, 0), a3, voffA);
            PG8_WAIT_V(8); PG8_WAIT_L(0); PG8_BAR; PG8_MMA(1, 0, At, B0); PG8_MMA(1, 1, At, B1); PG8_BAR; PG8_SCHED;
            } else {
            PG8_LDB(B0, 0, 0); PG8_SCHED; PG8_LDA(At, 0, 0); PG8_STAGE(PG8_SA(1, 1), a1 + hstep, voffA);
            PG8_WAIT_L(8); PG8_BAR; PG8_WAIT_L(0); PG8_MMA(0, 0, At, B0); PG8_BAR; PG8_SCHED;
            PG8_LDB(B1, 0, 1); PG8_STAGE(PG8_SB(0, 0), b2, voffB);
            PG8_BAR; PG8_WAIT_L(0); PG8_MMA(0, 1, At, B1); PG8_BAR;
            PG8_LDA(At, 0, 1); PG8_STAGE(PG8_SA(0, 0), a2, voffA);
            PG8_BAR; PG8_WAIT_L(0); PG8_MMA(1, 0, At, B0); PG8_BAR; PG8_SCHED;
            PG8_STAGE(PG8_SB(0, 1), b2 + hstep, voffB);
            PG8_WAIT_V(6); PG8_BAR; PG8_MMA(1, 1, At, B1); PG8_BAR;
            PG8_LDB(B0, 1, 0); PG8_SCHED; PG8_LDA(At, 1, 0); PG8_STAGE(PG8_SA(0, 1), a2 + hstep, voffA);
            PG8_WAIT_L(8); PG8_BAR; PG8_WAIT_L(0); PG8_MMA(0, 0, At, B0); PG8_BAR; PG8_SCHED;
            PG8_LDB(B1, 1, 1); PG8_STAGE(PG8_SB(1, 0), b3, voffB);
            PG8_BAR; PG8_WAIT_L(0); PG8_MMA(0, 1, At, B1); PG8_BAR;
            PG8_LDA(At, 1, 1); PG8_STAGE(PG8_SA(1, 0), a3, voffA);
            PG8_BAR; PG8_WAIT_L(0); PG8_MMA(1, 0, At, B0); PG8_BAR; PG8_SCHED;
            PG8_STAGE(PG8_SB(1, 1), b3 + hstep, voffB);
            PG8_WAIT_V(6); PG8_BAR; PG8_MMA(1, 1, At, B1); PG8_BAR;
            }
        }
        if constexpr (ALIGN_EPI) { if (wr == 0) PG8_BAR; }
        if constexpr (!Epi::AFTER_DRAIN) { E(acc, cur, wr, wc, fr, fq); S.done(cur); }
        if (!has_next) break;
#pragma unroll
        for (int a = 0; a < 2; ++a)
#pragma unroll
            for (int b = 0; b < 2; ++b)
#pragma unroll
                for (int m = 0; m < 4; ++m)
#pragma unroll
                    for (int n = 0; n < 2; ++n) acc[a][b][m][n] = (f32x4){0.f, 0.f, 0.f, 0.f};
        cur = nxt; cA = nA; cB = nB; ++ui;
        if constexpr (ALIGN_EPI) { if (wr == 1) PG8_BAR; }
    }
    PG8_WAIT_V(0);
    if constexpr (!ALIGN_EPI) { if (wr == 0) PG8_BAR; }
    PG8_BAR;
#undef PG8_SA
#undef PG8_SB
#undef PG8_STAGE
#undef PG8_LDA
#undef PG8_LDB
#undef PG8_MMA
#undef PG8_WAIT_V
#undef PG8_WAIT_L
#undef PG8_BAR
#undef PG8_SCHED
}
}

#ifndef PG8_SP2
#define PG8_SP2 true
#endif
#ifndef PG8_ALIGN
#define PG8_ALIGN true
#endif

constexpr int NWAVES = 8;
constexpr int N_LAUNCHES = MK_N_LAUNCHES;
constexpr int N_PHASES = 10;
constexpr int D = 1024, MP = 16384, MS = 512, M = MP + MS, TP = 2048, NBP = 8, NBS = 128, TS = 4;
constexpr int NZ = 1536, WA = 512, WB = 512, FF = 4096, NMOD = 6 * D, NROWMOD = NBP + NBS;
constexpr int GB = 32, NS5 = 64, KS5 = 16, HA = 8, HDA = 64;
constexpr float LN_EPS = 1e-5f;
constexpr float ALPHA = 1.189207115002721f;

constexpr size_t O_YP = 0, O_YS = (size_t)MP * D, O_CONVP = O_YS + (size_t)MS * D, O_HP = O_CONVP + (size_t)NBP * 3 * WA, O_SRP = O_HP + (size_t)NBP * WA,
                 O_SIP = O_SRP + (size_t)NBP * GB * NS5, O_CONVS = O_SIP + (size_t)NBP * GB * NS5, O_HS = O_CONVS + (size_t)NBS * 3 * WA, O_SRS = O_HS + (size_t)NBS * WA,
                 O_SIS = O_SRS + (size_t)NBS * GB * NS5, O_END = O_SIS + (size_t)NBS * GB * NS5;

constexpr size_t MiB = 1u << 20;
constexpr size_t WS_CTL = 0, CTL_ZERO_BYTES = 1 * MiB;
constexpr size_t WS_WIN = 1 * MiB, WS_WGLU = 4 * MiB, WS_WOUT = 5 * MiB, WS_W1 = 7 * MiB, WS_W2 = 15 * MiB;
constexpr size_t WS_MOD = 23 * MiB;
constexpr size_t WS_S5C = 27 * MiB;
constexpr size_t WS_XN = 28 * MiB;
constexpr size_t WS_Z = 61 * MiB;
constexpr size_t WS_YCAT = 111 * MiB;
constexpr size_t WS_G = 144 * MiB;
constexpr size_t WS_U = 61 * MiB;
constexpr size_t WS_TAB = 194 * MiB;
constexpr size_t WS_END = 196 * MiB;
constexpr size_t TB_BF1 = 0, TB_BF2 = TB_BF1 + 32 * 4 * 64 * 16, TB_TA = TB_BF2 + 32 * 8 * 64 * 16, TB_ZP = TB_TA + 32 * 2 * 2 * 32 * 4, TB_Z16N = TB_ZP + 32 * 17 * 2 * 2 * 32 * 4,
                 TB_RG = TB_Z16N + 32 * 2 * 64 * 4, TB_END = TB_RG + 8 * 2 * 2 * 4 * 64 * 16;
static_assert(WS_TAB + TB_END <= WS_END, "tables");
static_assert(WS_XN + (size_t)M * D * 2 <= WS_Z && WS_Z + (size_t)M * NZ * 2 <= WS_YCAT && WS_YCAT + (size_t)M * D * 2 <= WS_G && WS_G + (size_t)M * WB * 2 <= WS_END && WS_U + (size_t)M * FF * 2 <= WS_TAB, "d_ws map");
constexpr int SC_ABR = 0, SC_ABI = 2048, SC_BBR = 4096, SC_BBI = 4096 + 32768, SC_RGL = 4096 + 65536, SC_END = SC_RGL + 512;
constexpr int CW_TMO = 0, CW_CODE = 1, CW_BAR = 4096;

constexpr int RING_OFF = 0, RING_BYTES = 131072;
constexpr int LDSCTL_OFF = RING_BYTES, MISC_OFF = LDSCTL_OFF + 320;
constexpr int LDS_BYTES = 147456;

#define GAS __attribute__((address_space(1)))
#define LAS __attribute__((address_space(3)))
typedef unsigned short bf16;
typedef unsigned v4u __attribute__((ext_vector_type(4)));
typedef float f32x4 __attribute__((ext_vector_type(4)));
typedef GAS unsigned gu32;
#define RLX_AGENT __ATOMIC_RELAXED, __HIP_MEMORY_SCOPE_AGENT
#define LDS_WAIT() asm volatile("s_waitcnt lgkmcnt(0)" ::: "memory")
#define VM_WAIT() asm volatile("s_waitcnt vmcnt(0)" ::: "memory")
__device__ __forceinline__ unsigned f2bf(float f) { unsigned u = __builtin_bit_cast(unsigned, f); return (u + 0x7fffu + ((u >> 16) & 1u)) >> 16; }
__device__ __forceinline__ unsigned pk2(float lo, float hi) { return f2bf(lo) | (f2bf(hi) << 16); }
__device__ __forceinline__ float bf2f(bf16 v) { return __builtin_bit_cast(float, (unsigned)v << 16); }
__device__ __forceinline__ float gelu_tanh(float x) { const float t = 1.5957691216057308f * (x + 0.044715f * x * x * x); return x / (1.f + __expf(-t)); }
__device__ __forceinline__ float sigmoidf_(float x) { return 1.f / (1.f + __expf(-x)); }

#define XB_TMO      128
#define XB_XCNT(j)  (256  + 64 * (j))
#define XB_XSUB(j)  (1280 + 64 * (j))
#define XB_XGEN(j)  (2304 + 64 * (j))
#define XB_TOP      3328
#define XB_TOPGEN   3392
#define XCD_BAR_WORDS 3456
#define XB_SPIN_CAP (1u << 18)
__device__ __forceinline__ unsigned xb_ld(unsigned* p)              { return __hip_atomic_load(p, __ATOMIC_RELAXED, __HIP_MEMORY_SCOPE_AGENT); }
__device__ __forceinline__ unsigned xb_add(unsigned* p, unsigned v) { return __hip_atomic_fetch_add(p, v, __ATOMIC_RELAXED, __HIP_MEMORY_SCOPE_AGENT); }
__device__ __forceinline__ unsigned xb_xcc_id() { return (unsigned)__builtin_amdgcn_s_getreg((3 << 11) | 20) & 0xFu; }
#define XB_SPIN(cond, bar) do { unsigned _sp = 0; while (cond) { __builtin_amdgcn_s_sleep(1); \
    if ((++_sp & 255u) == 0u) { if (xb_ld(&(bar)[XB_TMO])) break; if (_sp > XB_SPIN_CAP) { atomicAdd(&(bar)[XB_TMO], 1u); break; } } } } while (0)
struct XcdBarrier { unsigned* bar; unsigned x; volatile LAS unsigned* st; };
__device__ __forceinline__ XcdBarrier xcd_barrier_post(unsigned* bar, volatile LAS unsigned* st) {
    XcdBarrier b; b.bar = bar; b.x = xb_xcc_id(); b.st = st;
    if (threadIdx.x == 0) (void)xb_add(&bar[XB_XCNT(b.x)], 1u);
    return b;
}
__device__ __forceinline__ void xcd_barrier_complete(unsigned* bar, unsigned x, unsigned& nloc, unsigned& nx) {
    const unsigned G = gridDim.x * gridDim.y * gridDim.z;
    unsigned sum, cnt, mine, sp = 0u;
    for (;;) {
        sum = 0u; cnt = 0u; mine = 0u;
#pragma unroll
        for (unsigned j = 0; j < 16; ++j) { const unsigned c = xb_ld(&bar[XB_XCNT(j)]); sum += c; cnt += (c > 0u) ? 1u : 0u; mine = (j == x) ? c : mine; }
        if (sum == G) break;
        __builtin_amdgcn_s_sleep(1);
        if ((++sp & 255u) == 0u) { if (xb_ld(&bar[XB_TMO])) break; if (sp > XB_SPIN_CAP) { atomicAdd(&bar[XB_TMO], 1u); break; } }
    }
    nloc = mine > 0u ? mine : 1u; nx = cnt > 0u ? cnt : 1u;
}
__device__ __forceinline__ void xcd_barrier(const XcdBarrier& b) {
    asm volatile("s_waitcnt vmcnt(0)" ::: "memory");
    __syncthreads();
    if (threadIdx.x == 0) {
        unsigned* bar = b.bar;
        __builtin_amdgcn_s_waitcnt(0);
        unsigned nloc = b.st[0], nx = b.st[1];
        if (nloc == 0u) { xcd_barrier_complete(bar, b.x, nloc, nx); b.st[0] = nloc; b.st[1] = nx; }
        const unsigned old = xb_add(&bar[XB_XSUB(b.x)], 1u);
        const unsigned gen = old / nloc;
        if (old + 1u == (gen + 1u) * nloc) {
            __builtin_amdgcn_fence(__ATOMIC_RELEASE, "agent");
            asm volatile("s_waitcnt vmcnt(0)" ::: "memory");
            const unsigned og = xb_add(&bar[XB_TOP], 1u);
            const unsigned tg = og / nx;
            if (og + 1u == (tg + 1u) * nx) xb_add(&bar[XB_TOPGEN], 1u);
            else XB_SPIN(xb_ld(&bar[XB_TOPGEN]) == tg, bar);
            __builtin_amdgcn_fence(__ATOMIC_ACQUIRE, "agent");
            xb_add(&bar[XB_XGEN(b.x)], 1u);
            asm volatile("s_waitcnt vmcnt(0)" ::: "memory");
        } else {
            XB_SPIN(xb_ld(&bar[XB_XGEN(b.x)]) == gen, bar);
            __builtin_amdgcn_fence(__ATOMIC_ACQUIRE, "agent");
            asm volatile("s_waitcnt vmcnt(0)" ::: "memory");
        }
    }
    __syncthreads();
}

struct Frame {
    LAS unsigned char* lds;
    volatile LAS unsigned* MISC;
    gu32* ctl;
    int tid, lane, wave;
    int vcu, G;
    float* out;
    unsigned char* ws;
};
struct Args { const float* in[37]; float* out; unsigned char* ws; int ph_lo, ph_hi, li, pad; };
__device__ __forceinline__ float wave_sum(float v) {
#pragma unroll
    for (int o = 1; o < 64; o <<= 1) v += __shfl_xor(v, o);
    return v;
}
enum { I_XP = 0, I_XS, I_SCONV, I_SH, I_SSR, I_SSI, I_CP, I_CS, I_ADAW, I_ADAB, I_INPROJ, I_CONVW, I_CONVB, I_RGWR, I_RGBR, I_RGWI, I_RGBI, I_RGLAM,
       I_S5ARE, I_S5AIM, I_S5LOGDT, I_S5BRE, I_S5BIM, I_S5CRE, I_S5CIM, I_S5D, I_GLUW, I_GLUB, I_OUTPROJ, I_LN1G, I_LN1B, I_W1, I_B1, I_W2, I_B2, I_LN2G, I_LN2B };

__device__ __forceinline__ void p0_transpose_item(const float* W, int K, int N, bf16* WT, LAS float* scr, int item, int lane) {
    const int nblk = N / 32, kb = item / nblk, nb = item % nblk, k0 = 64 * kb, n0 = 32 * nb;
#pragma unroll 8
    for (int i = 0; i < 32; ++i) { const int kk = 2 * i + (lane >> 5); scr[kk * 33 + (lane & 31)] = W[(size_t)(k0 + kk) * N + n0 + (lane & 31)]; }
    LDS_WAIT(); asm volatile("" ::: "memory");
    const int c = lane & 7;
#pragma unroll
    for (int j = 0; j < 4; ++j) { const int n = (lane >> 3) + 8 * j; const LAS float* s = scr + (8 * c) * 33 + n;
        v4u o; o.x = pk2(s[0 * 33], s[1 * 33]); o.y = pk2(s[2 * 33], s[3 * 33]); o.z = pk2(s[4 * 33], s[5 * 33]); o.w = pk2(s[6 * 33], s[7 * 33]);
        *(GAS v4u*)(WT + (size_t)(n0 + n) * K + k0 + 8 * c) = o; }
    LDS_WAIT(); asm volatile("" ::: "memory");
}

__device__ __forceinline__ void p0_prologue(Frame& F, const Args& A) {
    LAS float* scr = (LAS float*)(F.lds + RING_OFF + F.wave * 16384);
    const int gw = F.wave * F.G + F.vcu, NGW = F.G * NWAVES;
    constexpr int I_IN = (D / 64) * (NZ / 32), I_GL = (WB / 64) * (WB / 32), I_OU = (D / 64) * (D / 32), I_1 = (D / 64) * (FF / 32), I_2 = (FF / 64) * (D / 32);
    constexpr int I_S5 = GB, I_RG = WA / 64;
    constexpr int NITEMS = I_IN + I_GL + I_OU + I_1 + I_2 + I_S5 + I_RG;
    float* sc = (float*)(F.ws + WS_S5C);
    for (int it = gw; it < NITEMS; it += NGW) {
        int r = it;
        if (r < I_IN) { p0_transpose_item(A.in[I_INPROJ], D, NZ, (bf16*)(F.ws + WS_WIN), scr, r, F.lane); continue; } r -= I_IN;
        if (r < I_GL) { p0_transpose_item(A.in[I_GLUW], WB, WB, (bf16*)(F.ws + WS_WGLU), scr, r, F.lane); continue; } r -= I_GL;
        if (r < I_OU) { p0_transpose_item(A.in[I_OUTPROJ], D, D, (bf16*)(F.ws + WS_WOUT), scr, r, F.lane); continue; } r -= I_OU;
        if (r < I_1) { p0_transpose_item(A.in[I_W1], D, FF, (bf16*)(F.ws + WS_W1), scr, r, F.lane); continue; } r -= I_1;
        if (r < I_2) { p0_transpose_item(A.in[I_W2], FF, D, (bf16*)(F.ws + WS_W2), scr, r, F.lane); continue; } r -= I_2;
        if (r < I_S5) {
            const int g = r, n = F.lane, gn = g * NS5 + n;
            const double dt = exp((double)A.in[I_S5LOGDT][g]), ar = (double)A.in[I_S5ARE][gn], ai = (double)A.in[I_S5AIM][gn];
            const double mag = exp(dt * ar), abr = mag * cos(dt * ai), abi = mag * sin(dt * ai), den = ar * ar + ai * ai, nr = abr - 1.0;
            const double qr = (nr * ar + abi * ai) / den, qi = (abi * ar - nr * ai) / den;
            sc[SC_ABR + gn] = (float)abr; sc[SC_ABI + gn] = (float)abi;
            unsigned char* tab = F.ws + WS_TAB;
            bf16* BF1 = (bf16*)(tab + TB_BF1); bf16* BF2 = (bf16*)(tab + TB_BF2); float* TA = (float*)(tab + TB_TA); float* ZP = (float*)(tab + TB_ZP); float* Z16N = (float*)(tab + TB_Z16N);
            const int sh = n >> 5, v = n & 31, hh = (v >> 2) & 1, ii = (v & 3) + 4 * (v >> 3);
            for (int k = 0; k < KS5; ++k) { const double br = (double)A.in[I_S5BRE][gn * KS5 + k], bi = (double)A.in[I_S5BIM][gn * KS5 + k];
                const float vr = (float)(qr * br - qi * bi), vi = (float)(qr * bi + qi * br);
                sc[SC_BBR + gn * KS5 + k] = vr; sc[SC_BBI + gn * KS5 + k] = vi;
                const int lp = (n & 31) + 32 * (k >> 3), jj = k & 7;
                BF1[(size_t)((g * 4 + 0 + sh) * 64 + lp) * 8 + jj] = (bf16)f2bf(vr); BF1[(size_t)((g * 4 + 2 + sh) * 64 + lp) * 8 + jj] = (bf16)f2bf(vi); }
            { const int s2 = (n >> 4) & 1, jj = 4 * ((n >> 3) & 1) + (n & 3), hk = (n >> 2) & 1;
              for (int ch = 0; ch < KS5; ++ch) { const int hr_ = ch >> 3, i8 = ch & 7, R = (i8 & 3) + 8 * (i8 >> 2) + 4 * hr_, lp = R + 32 * hk;
                  const float cr = A.in[I_S5CRE][(size_t)(g * KS5 + ch) * NS5 + n], ci = A.in[I_S5CIM][(size_t)(g * KS5 + ch) * NS5 + n];
                  BF2[(size_t)((g * 8 + (0 + sh) * 2 + s2) * 64 + lp) * 8 + jj] = (bf16)f2bf(cr); BF2[(size_t)((g * 8 + (2 + sh) * 2 + s2) * 64 + lp) * 8 + jj] = (bf16)f2bf(-ci); }
              for (int z = 0; z < 4; ++z) { const int cidx = n + 64 * z, ks = cidx >> 5, r16 = cidx & 31, lp = 16 + (r16 & 15) + 32 * (r16 >> 4);
                  *(v4u*)(BF2 + (size_t)((g * 8 + ks) * 64 + lp) * 8) = (v4u){0u, 0u, 0u, 0u}; } }
            TA[((g * 2 + hh) * 2 + 0) * 32 + sh * 16 + ii] = (float)abr; TA[((g * 2 + hh) * 2 + 1) * 32 + sh * 16 + ii] = (float)abi;
            for (int e = 0; e <= 16; ++e) { const double mg = exp(8.0 * e * dt * ar), an = 8.0 * e * dt * ai; const float zr = (float)(mg * cos(an)), zi = (float)(mg * sin(an));
                ZP[(((g * 17 + e) * 2 + hh) * 2 + 0) * 32 + sh * 16 + ii] = zr; ZP[(((g * 17 + e) * 2 + hh) * 2 + 1) * 32 + sh * 16 + ii] = zi;
                if (e == 16) { Z16N[(g * 2 + 0) * 64 + n] = zr; Z16N[(g * 2 + 1) * 64 + n] = zi; } }
            continue; } r -= I_S5;
        { const int c = r * 64 + F.lane; const double lam = (double)A.in[I_RGLAM][c];
          sc[SC_RGL + c] = (float)(-8.0 * log1p(exp(-lam)) * 1.4426950408889634); }
    }
    __syncthreads();
    LAS float* sT = (LAS float*)(F.lds + RING_OFF);
    float* mod = (float*)(F.ws + WS_MOD);
    constexpr int NRG = NROWMOD / 8, NCB = NMOD / 512;
    for (int it = F.vcu; it < NRG * NCB; it += F.G) {
        const int rg = it / NCB, cb = it % NCB;
        for (int e = F.tid; e < 8 * 1024; e += NWAVES * 64) { const int rr = e >> 10, k = e & 1023, row = rg * 8 + rr;
            const float v = row < NBP ? A.in[I_CP][(size_t)row * D + k] : A.in[I_CS][(size_t)(row - NBP) * D + k];
            sT[k * 8 + rr] = v / (1.f + expf(-v)); }
        __syncthreads();
        const int col = cb * 512 + F.tid; const float* w = A.in[I_ADAW] + col;
        float a[8];
#pragma unroll
        for (int i = 0; i < 8; ++i) a[i] = 0.f;
#pragma unroll 4
        for (int k = 0; k < 1024; ++k) { const float wv = w[(size_t)k * NMOD]; const f32x4 s0 = *(const LAS f32x4*)(sT + k * 8), s1 = *(const LAS f32x4*)(sT + k * 8 + 4);
            a[0] += s0[0] * wv; a[1] += s0[1] * wv; a[2] += s0[2] * wv; a[3] += s0[3] * wv; a[4] += s1[0] * wv; a[5] += s1[1] * wv; a[6] += s1[2] * wv; a[7] += s1[3] * wv; }
        const float bb = A.in[I_ADAB][col];
#pragma unroll
        for (int i = 0; i < 8; ++i) mod[(size_t)(rg * 8 + i) * NMOD + col] = a[i] + bb;
        __syncthreads();
    }
}

__device__ __forceinline__ int mod_row(int m) { return m < MP ? (m >> 11) : NBP + ((m - MP) >> 2); }
__device__ __forceinline__ const float* x_row(const Args& A, int m) { return m < MP ? A.in[I_XP] + (size_t)m * D : A.in[I_XS] + (size_t)(m - MP) * D; }

__device__ __forceinline__ void p1_modulate(Frame& F, const Args& A) {
    const int gw = F.vcu * NWAVES + F.wave, NGW = F.G * NWAVES;
    const float* mod = (const float*)(F.ws + WS_MOD); bf16* XN = (bf16*)(F.ws + WS_XN);
    for (int m = gw; m < M; m += NGW) {
        const GAS f32x4* xr = (const GAS f32x4*)x_row(A, m) + F.lane; const float* mr = mod + (size_t)mod_row(m) * NMOD;
        const GAS f32x4* sh = (const GAS f32x4*)(mr) + F.lane; const GAS f32x4* scp = (const GAS f32x4*)(mr + D) + F.lane;
        GAS unsigned long long* o8 = (GAS unsigned long long*)(XN + (size_t)m * D) + F.lane;
#pragma unroll
        for (int j = 0; j < 4; ++j) { const f32x4 v = xr[64 * j], a = sh[64 * j], s = scp[64 * j]; const f32x4 h = v * (s + 1.f) + a;
            o8[64 * j] = (unsigned long long)pk2(h.x, h.y) | ((unsigned long long)pk2(h.z, h.w) << 32); }
    }
}

template <bool SECOND>
__device__ __forceinline__ void ln_rows(Frame& F, const Args& A) {
    const int gw = F.vcu * NWAVES + F.wave, NGW = F.G * NWAVES;
    const float* mod = (const float*)(F.ws + WS_MOD); bf16* XN = (bf16*)(F.ws + WS_XN);
    const GAS f32x4* gg = (const GAS f32x4*)A.in[SECOND ? I_LN2G : I_LN1G] + F.lane; const GAS f32x4* gb = (const GAS f32x4*)A.in[SECOND ? I_LN2B : I_LN1B] + F.lane;
    for (int m = gw; m < M; m += NGW) {
        GAS f32x4* xr = (GAS f32x4*)(F.out + (size_t)m * D) + F.lane;
        f32x4 v[4]; float s = 0.f;
#pragma unroll
        for (int j = 0; j < 4; ++j) { v[j] = xr[64 * j]; s += (v[j].x + v[j].y) + (v[j].z + v[j].w); }
        const float mean = wave_sum(s) * (1.f / D); float s2 = 0.f;
#pragma unroll
        for (int j = 0; j < 4; ++j) { v[j] = v[j] - mean; s2 += (v[j].x * v[j].x + v[j].y * v[j].y) + (v[j].z * v[j].z + v[j].w * v[j].w); }
        const float rstd = 1.f / sqrtf(wave_sum(s2) * (1.f / D) + LN_EPS);
#pragma unroll
        for (int j = 0; j < 4; ++j) { v[j] = v[j] * rstd * gg[64 * j] + gb[64 * j]; xr[64 * j] = v[j]; }
        if (!SECOND) {
            const float* mr = mod + (size_t)mod_row(m) * NMOD;
            const GAS f32x4* sh = (const GAS f32x4*)(mr + 3 * D) + F.lane; const GAS f32x4* scp = (const GAS f32x4*)(mr + 4 * D) + F.lane;
            GAS unsigned long long* o8 = (GAS unsigned long long*)(XN + (size_t)m * D) + F.lane;
#pragma unroll
            for (int j = 0; j < 4; ++j) { const f32x4 h = v[j] * (scp[64 * j] + 1.f) + sh[64 * j];
                o8[64 * j] = (unsigned long long)pk2(h.x, h.y) | ((unsigned long long)pk2(h.z, h.w) << 32); }
        }
    }
}

__device__ __forceinline__ void rg_item_ref(Frame& F, const Args& A, bool prompt, int b, int hd, LAS float* scr) {
    const int j = F.lane, c = hd * HDA + j;
    const bf16* Z = (const bf16*)(F.ws + WS_Z); bf16* Y = (bf16*)(F.ws + WS_YCAT); const float* sc = (const float*)(F.ws + WS_S5C);
    float wr[64], wi[64];
#pragma unroll
    for (int i = 0; i < 64; ++i) { wr[i] = A.in[I_RGWR][(size_t)(hd * 64 + i) * 64 + j]; wi[i] = A.in[I_RGWI][(size_t)(hd * 64 + i) * 64 + j]; }
    const float br = A.in[I_RGBR][c], bi = A.in[I_RGBI][c], L2 = sc[SC_RGL + c];
    const float w0 = A.in[I_CONVW][c], w1 = A.in[I_CONVW][WA + c], w2 = A.in[I_CONVW][2 * WA + c], w3 = A.in[I_CONVW][3 * WA + c], cb = A.in[I_CONVB][c];
    int T, m0; float x3, x2, x1, h;
    if (prompt) { T = TP; m0 = b * TP; x3 = 0.f; x2 = 0.f; x1 = 0.f; h = 0.f; }
    else { T = TS; m0 = MP + b * TS; x3 = A.in[I_SCONV][(size_t)(b * 3 + 0) * WA + c]; x2 = A.in[I_SCONV][(size_t)(b * 3 + 1) * WA + c]; x1 = A.in[I_SCONV][(size_t)(b * 3 + 2) * WA + c]; h = A.in[I_SH][(size_t)b * WA + c]; }
    for (int t = 0; t < T; ++t) {
        const size_t m = (size_t)(m0 + t);
        const float xa = bf2f(Z[m * NZ + WA + c]), gate = bf2f(Z[m * NZ + c]);
        const float xc = cb + w0 * x3 + w1 * x2 + w2 * x1 + w3 * xa; x3 = x2; x2 = x1; x1 = xa;
        scr[j] = xc; LDS_WAIT(); asm volatile("" ::: "memory");
        float rp = br, gp = bi;
#pragma unroll
        for (int i4 = 0; i4 < 16; ++i4) { const f32x4 v = *(const LAS f32x4*)(scr + 4 * i4);
            rp += v[0] * wr[4 * i4] + v[1] * wr[4 * i4 + 1] + v[2] * wr[4 * i4 + 2] + v[3] * wr[4 * i4 + 3];
            gp += v[0] * wi[4 * i4] + v[1] * wi[4 * i4 + 1] + v[2] * wi[4 * i4 + 2] + v[3] * wi[4 * i4 + 3]; }
        LDS_WAIT(); asm volatile("" ::: "memory");
        const float r = sigmoidf_(rp), gi = sigmoidf_(gp);
        const float a = exp2f(r * L2);
        float mult = sqrtf(fmaxf(1.f - a * a, 0.f));
        if (prompt && t == 0) mult = 1.f;
        h = a * h + mult * gi * xc;
        Y[m * D + c] = (bf16)f2bf(gelu_tanh(gate) * h);
    }
    float* oc = F.out + (prompt ? O_CONVP : O_CONVS); float* oh = F.out + (prompt ? O_HP : O_HS);
    oc[(size_t)(b * 3 + 0) * WA + c] = x3; oc[(size_t)(b * 3 + 1) * WA + c] = x2; oc[(size_t)(b * 3 + 2) * WA + c] = x1;
    oh[(size_t)b * WA + c] = h;
}
__device__ __forceinline__ void s5_item_ref(Frame& F, const Args& A, bool prompt, int b, int g, LAS float* scr) {
    const int n = F.lane, gn = g * NS5 + n, k = F.lane & 15, part = F.lane >> 4;
    const bf16* Z = (const bf16*)(F.ws + WS_Z); bf16* Gy = (bf16*)(F.ws + WS_G); const float* sc = (const float*)(F.ws + WS_S5C);
    float bbr[16], bbi[16], cre[16], cim[16];
#pragma unroll
    for (int i = 0; i < 16; ++i) { bbr[i] = sc[SC_BBR + gn * KS5 + i]; bbi[i] = sc[SC_BBI + gn * KS5 + i];
        cre[i] = A.in[I_S5CRE][(size_t)(g * KS5 + k) * NS5 + part * 16 + i]; cim[i] = A.in[I_S5CIM][(size_t)(g * KS5 + k) * NS5 + part * 16 + i]; }
    const float abr = sc[SC_ABR + gn], abi = sc[SC_ABI + gn], dk = A.in[I_S5D][g * KS5 + k];
    int T, m0; float hr, hi;
    if (prompt) { T = TP; m0 = b * TP; hr = 0.f; hi = 0.f; }
    else { T = TS; m0 = MP + b * TS; hr = A.in[I_SSR][(size_t)(b * GB + g) * NS5 + n]; hi = A.in[I_SSI][(size_t)(b * GB + g) * NS5 + n]; }
    for (int t = 0; t < T; ++t) {
        const size_t m = (size_t)(m0 + t);
        const bf16* zr = Z + m * NZ + 2 * WA + g * KS5;
        const v4u u0 = *(const v4u*)zr, u1 = *(const v4u*)(zr + 8);
        float u[16];
        u[0] = pg8::bf_lo(u0.x); u[1] = pg8::bf_hi(u0.x); u[2] = pg8::bf_lo(u0.y); u[3] = pg8::bf_hi(u0.y); u[4] = pg8::bf_lo(u0.z); u[5] = pg8::bf_hi(u0.z); u[6] = pg8::bf_lo(u0.w); u[7] = pg8::bf_hi(u0.w);
        u[8] = pg8::bf_lo(u1.x); u[9] = pg8::bf_hi(u1.x); u[10] = pg8::bf_lo(u1.y); u[11] = pg8::bf_hi(u1.y); u[12] = pg8::bf_lo(u1.z); u[13] = pg8::bf_hi(u1.z); u[14] = pg8::bf_lo(u1.w); u[15] = pg8::bf_hi(u1.w);
        float bur = 0.f, bui = 0.f;
#pragma unroll
        for (int i = 0; i < 16; ++i) { bur += bbr[i] * u[i]; bui += bbi[i] * u[i]; }
        const float nhr = abr * hr - abi * hi + bur, nhi = abr * hi + abi * hr + bui; hr = nhr; hi = nhi;
        scr[n] = hr; scr[64 + n] = hi; LDS_WAIT(); asm volatile("" ::: "memory");
        float p = 0.f;
#pragma unroll
        for (int i4 = 0; i4 < 4; ++i4) { const f32x4 vr = *(const LAS f32x4*)(scr + part * 16 + 4 * i4), vi = *(const LAS f32x4*)(scr + 64 + part * 16 + 4 * i4);
#pragma unroll
            for (int e = 0; e < 4; ++e) p += vr[e] * cre[4 * i4 + e] - vi[e] * cim[4 * i4 + e]; }
        LDS_WAIT(); asm volatile("" ::: "memory");
        p += __shfl_xor(p, 16); p += __shfl_xor(p, 32);
        const float uk = bf2f(zr[k]);
        if (F.lane < 16) Gy[m * WB + g * KS5 + k] = (bf16)f2bf(gelu_tanh(p + dk * uk));
    }
    float* osr = F.out + (prompt ? O_SRP : O_SRS); float* osi = F.out + (prompt ? O_SIP : O_SIS);
    osr[(size_t)(b * GB + g) * NS5 + n] = hr; osi[(size_t)(b * GB + g) * NS5 + n] = hi;
}

typedef short bf16x8v __attribute__((ext_vector_type(8)));
typedef float f32x16 __attribute__((ext_vector_type(16)));
typedef float f32x2v __attribute__((ext_vector_type(2)));
typedef __bf16 bf16x2v __attribute__((ext_vector_type(2)));
#define MFMA32(a, b, c) __builtin_amdgcn_mfma_f32_32x32x16_bf16((a), (b), (c), 0, 0, 0)
__device__ __forceinline__ unsigned pkbf(float a, float b) { const f32x2v v = {a, b}; const bf16x2v r = __builtin_convertvector(v, bf16x2v); return __builtin_bit_cast(unsigned, r); }
template <int CTRL> __device__ __forceinline__ float dppf(float old, float v) { return __builtin_bit_cast(float, __builtin_amdgcn_update_dpp(__builtin_bit_cast(int, old), __builtin_bit_cast(int, v), CTRL, 0xF, 0xF, false)); }
__device__ __forceinline__ f32x16 ld16(const float* p) { f32x16 r;
#pragma unroll
    for (int i = 0; i < 4; ++i) { const f32x4 v = *(const f32x4*)(p + 4 * i); r[4 * i] = v[0]; r[4 * i + 1] = v[1]; r[4 * i + 2] = v[2]; r[4 * i + 3] = v[3]; }
    return r; }
__device__ __forceinline__ bf16x8v pack8(const f32x16& x, int s) { v4u p; p.x = pkbf(x[8 * s], x[8 * s + 1]); p.y = pkbf(x[8 * s + 2], x[8 * s + 3]); p.z = pkbf(x[8 * s + 4], x[8 * s + 5]); p.w = pkbf(x[8 * s + 6], x[8 * s + 7]); return __builtin_bit_cast(bf16x8v, p); }
template <int CTRL> __device__ __forceinline__ void s5_scan_step(f32x16& xr, f32x16& xi, const f32x16& zr, const f32x16& zi) {
#pragma unroll
    for (int i = 0; i < 16; ++i) { const float sr = dppf<CTRL>(0.f, xr[i]), si = dppf<CTRL>(0.f, xi[i]);
        xr[i] += zr[i] * sr - zi[i] * si; xi[i] += zr[i] * si + zi[i] * sr; }
}
constexpr int S5L_BF1 = 0, S5L_BF2 = 4096, S5L_TOT = 12288, S5L_CAR = 20480;
template <bool SECOND>
__device__ __forceinline__ void s5_step(LAS unsigned char* L, int lane, const bf16x8v u, f32x16& hr0, f32x16& hr1, f32x16& hi0, f32x16& hi1,
                                        const f32x16& ar0, const f32x16& ar1, const f32x16& ai0, const f32x16& ai1, const float (&dk)[8], bf16* gout) {
    const LAS bf16x8v* a1 = (const LAS bf16x8v*)(L + S5L_BF1) + lane;
    { const f32x16 cr = ar0 * hr0 - ai0 * hi0, ci = ar0 * hi0 + ai0 * hr0; hr0 = MFMA32(a1[0], u, cr); hi0 = MFMA32(a1[128], u, ci); }
    asm volatile("" : "+v"(hr0), "+v"(hi0));
    { const f32x16 cr = ar1 * hr1 - ai1 * hi1, ci = ar1 * hi1 + ai1 * hr1; hr1 = MFMA32(a1[64], u, cr); hi1 = MFMA32(a1[192], u, ci); }
    if (SECOND) {
        const LAS bf16x8v* a2 = (const LAS bf16x8v*)(L + S5L_BF2) + lane;
        f32x16 y;
#pragma unroll
        for (int i = 0; i < 16; ++i) y[i] = 0.f;
        y = MFMA32(a2[0 * 64], pack8(hr0, 0), y); y = MFMA32(a2[1 * 64], pack8(hr0, 1), y);
        y = MFMA32(a2[2 * 64], pack8(hr1, 0), y); y = MFMA32(a2[3 * 64], pack8(hr1, 1), y);
        y = MFMA32(a2[4 * 64], pack8(hi0, 0), y); y = MFMA32(a2[5 * 64], pack8(hi0, 1), y);
        y = MFMA32(a2[6 * 64], pack8(hi1, 0), y); y = MFMA32(a2[7 * 64], pack8(hi1, 1), y);
        const v4u uw = __builtin_bit_cast(v4u, u);
        float o[8];
        o[0] = gelu_tanh(y[0] + dk[0] * pg8::bf_lo(uw.x)); o[1] = gelu_tanh(y[1] + dk[1] * pg8::bf_hi(uw.x));
        o[2] = gelu_tanh(y[2] + dk[2] * pg8::bf_lo(uw.y)); o[3] = gelu_tanh(y[3] + dk[3] * pg8::bf_hi(uw.y));
        o[4] = gelu_tanh(y[4] + dk[4] * pg8::bf_lo(uw.z)); o[5] = gelu_tanh(y[5] + dk[5] * pg8::bf_hi(uw.z));
        o[6] = gelu_tanh(y[6] + dk[6] * pg8::bf_lo(uw.w)); o[7] = gelu_tanh(y[7] + dk[7] * pg8::bf_hi(uw.w));
        v4u w; w.x = pkbf(o[0], o[1]); w.y = pkbf(o[2], o[3]); w.z = pkbf(o[4], o[5]); w.w = pkbf(o[6], o[7]);
        *(v4u*)gout = w;
    }
}
__device__ __forceinline__ void s5_item_fast(Frame& F, const Args& A, int b, int g) {
    const int lane = F.lane, q = lane & 31, hh = lane >> 5, w = F.wave, c = w * 32 + q;
    LAS unsigned char* L = F.lds + RING_OFF;
    const unsigned char* tab = F.ws + WS_TAB;
    {
        const v4u* s1 = (const v4u*)(tab + TB_BF1) + (size_t)g * 256; const v4u* s2 = (const v4u*)(tab + TB_BF2) + (size_t)g * 512;
        if (F.tid < 256) ((LAS v4u*)(L + S5L_BF1))[F.tid] = s1[F.tid];
        ((LAS v4u*)(L + S5L_BF2))[F.tid] = s2[F.tid];
    }
    __syncthreads();
    const float* TA = (const float*)(tab + TB_TA) + (size_t)((g * 2 + hh) * 2) * 32;
    f32x16 ar0 = ld16(TA), ar1 = ld16(TA + 16), ai0 = ld16(TA + 32), ai1 = ld16(TA + 48);
    f32x16 hr0, hr1, hi0, hi1;
#pragma unroll
    for (int i = 0; i < 16; ++i) { hr0[i] = 0.f; hr1[i] = 0.f; hi0[i] = 0.f; hi1[i] = 0.f; }
    float dk[8];
#pragma unroll
    for (int i = 0; i < 8; ++i) dk[i] = A.in[I_S5D][g * KS5 + 8 * hh + i];
    const size_t m0 = (size_t)b * TP + (size_t)8 * c;
    const bf16* zrow = (const bf16*)(F.ws + WS_Z) + m0 * NZ + 2 * WA + g * KS5 + 8 * hh;
    bf16* grow = (bf16*)(F.ws + WS_G) + m0 * WB + g * KS5 + 8 * hh;
#pragma unroll 1
    for (int j = 0; j < 8; ++j) { const bf16x8v u = *(const bf16x8v*)(zrow + (size_t)j * NZ);
        s5_step<false>(L, lane, u, hr0, hr1, hi0, hi1, ar0, ar1, ai0, ai1, dk, nullptr); }
    const float* ZP = (const float*)(tab + TB_ZP);
#define S5_SCAN(E, CTRL) do { const float* z = ZP + (size_t)(((g * 17 + (E)) * 2 + hh) * 2) * 32; \
        { const f32x16 zr = ld16(z), zi = ld16(z + 32); s5_scan_step<CTRL>(hr0, hi0, zr, zi); } \
        asm volatile("" : "+v"(hr0), "+v"(hi0) :: "memory"); \
        { const f32x16 zr = ld16(z + 16), zi = ld16(z + 48); s5_scan_step<CTRL>(hr1, hi1, zr, zi); } \
        asm volatile("" : "+v"(hr1), "+v"(hi1) :: "memory"); } while (0)
    S5_SCAN(1, 0x111); S5_SCAN(2, 0x112); S5_SCAN(4, 0x114); S5_SCAN(8, 0x118);
#undef S5_SCAN
    const int seg = w * 2 + (q >> 4);
    LAS float* TOT = (LAS float*)(L + S5L_TOT); LAS float* CAR = (LAS float*)(L + S5L_CAR);
    if ((lane & 15) == 15) {
#pragma unroll
        for (int rho = 0; rho < 4; ++rho) {
            *(LAS f32x4*)(TOT + (seg * 2 + 0) * 64 + 0 + 8 * rho + 4 * hh) = (f32x4){hr0[4 * rho], hr0[4 * rho + 1], hr0[4 * rho + 2], hr0[4 * rho + 3]};
            *(LAS f32x4*)(TOT + (seg * 2 + 0) * 64 + 32 + 8 * rho + 4 * hh) = (f32x4){hr1[4 * rho], hr1[4 * rho + 1], hr1[4 * rho + 2], hr1[4 * rho + 3]};
            *(LAS f32x4*)(TOT + (seg * 2 + 1) * 64 + 0 + 8 * rho + 4 * hh) = (f32x4){hi0[4 * rho], hi0[4 * rho + 1], hi0[4 * rho + 2], hi0[4 * rho + 3]};
            *(LAS f32x4*)(TOT + (seg * 2 + 1) * 64 + 32 + 8 * rho + 4 * hh) = (f32x4){hi1[4 * rho], hi1[4 * rho + 1], hi1[4 * rho + 2], hi1[4 * rho + 3]}; }
    }
    __syncthreads();
    if (F.tid < 64) {
        const float* z16 = (const float*)(tab + TB_Z16N) + (size_t)g * 128; const float zr = z16[F.tid], zi = z16[64 + F.tid];
        float cr = 0.f, ci = 0.f;
#pragma unroll
        for (int sg = 0; sg < 16; ++sg) { CAR[(sg * 2 + 0) * 64 + F.tid] = cr; CAR[(sg * 2 + 1) * 64 + F.tid] = ci;
            const float tr = TOT[(sg * 2 + 0) * 64 + F.tid], ti = TOT[(sg * 2 + 1) * 64 + F.tid];
            const float ncr = zr * cr - zi * ci + tr, nci = zr * ci + zi * cr + ti; cr = ncr; ci = nci; }
    }
    __syncthreads();
    {
        const float* z = ZP + (size_t)(((g * 17 + (q & 15)) * 2 + hh) * 2) * 32;
#define S5_EXCL(HR, HI, OFF) do { const f32x16 zr = ld16(z + (OFF)), zi = ld16(z + 32 + (OFF)); f32x16 kr, ki; \
        _Pragma("unroll") for (int rho = 0; rho < 4; ++rho) { \
            const f32x4 a0 = *(const LAS f32x4*)(CAR + (seg * 2 + 0) * 64 + 2 * (OFF) + 8 * rho + 4 * hh), b0 = *(const LAS f32x4*)(CAR + (seg * 2 + 1) * 64 + 2 * (OFF) + 8 * rho + 4 * hh); \
            _Pragma("unroll") for (int e = 0; e < 4; ++e) { kr[4 * rho + e] = a0[e]; ki[4 * rho + e] = b0[e]; } } \
        _Pragma("unroll") for (int i = 0; i < 16; ++i) { const float sr = dppf<0x111>(0.f, HR[i]), si = dppf<0x111>(0.f, HI[i]); \
            HR[i] = sr + zr[i] * kr[i] - zi[i] * ki[i]; HI[i] = si + zr[i] * ki[i] + zi[i] * kr[i]; } } while (0)
        S5_EXCL(hr0, hi0, 0); asm volatile("" : "+v"(hr0), "+v"(hi0) :: "memory"); S5_EXCL(hr1, hi1, 16); asm volatile("" : "+v"(hr1), "+v"(hi1) :: "memory");
#undef S5_EXCL
    }
    { int off = 0; asm volatile("" : "+v"(off)); const float* TA2 = TA + off; ar0 = ld16(TA2); ar1 = ld16(TA2 + 16); ai0 = ld16(TA2 + 32); ai1 = ld16(TA2 + 48); }
#pragma unroll 1
    for (int j = 0; j < 8; ++j) { const bf16x8v u = *(const bf16x8v*)(zrow + (size_t)j * NZ);
        s5_step<true>(L, lane, u, hr0, hr1, hi0, hi1, ar0, ar1, ai0, ai1, dk, grow + (size_t)j * WB); }
    if (w == NWAVES - 1 && q == 31) {
        float* osr = F.out + O_SRP + (size_t)(b * GB + g) * NS5; float* osi = F.out + O_SIP + (size_t)(b * GB + g) * NS5;
#pragma unroll
        for (int i = 0; i < 16; ++i) { const int n = (i & 3) + 8 * (i >> 2) + 4 * hh; osr[n] = hr0[i]; osr[32 + n] = hr1[i]; osi[n] = hi0[i]; osi[32 + n] = hi1[i]; }
    }
    __syncthreads();
}

__device__ __forceinline__ void p3_mixers_ref(Frame& F, const Args& A) {
    LAS float* scr = (LAS float*)(F.lds + RING_OFF + F.wave * 1024);
    const int gw = F.wave * F.G + F.vcu, NGW = F.G * NWAVES;
    constexpr int N_RGP = NBP * HA, N_S5P = NBP * GB, N_RGS = NBS * HA, N_S5S = NBS * GB;
    if (F.vcu < N_S5P) s5_item_fast(F, A, F.vcu / GB, F.vcu % GB);
    for (int it = F.vcu + F.G; it < N_S5P; it += F.G) { for (int wv = F.wave; wv < 1; wv += NWAVES) s5_item_ref(F, A, true, it / GB, it % GB, scr); }
    for (int it = gw; it < N_RGP + N_RGS + N_S5S; it += NGW) {
        int r = it;
        if (r < N_RGP) { rg_item_ref(F, A, true, r / HA, r % HA, scr); continue; } r -= N_RGP;
        if (r < N_RGS) { rg_item_ref(F, A, false, r / HA, r % HA, scr); continue; } r -= N_RGS;
        s5_item_ref(F, A, false, r / GB, r % GB, scr);
    }
}

__global__ void __launch_bounds__(NWAVES * 64, 2) fwd(Args A) {
    extern __shared__ __attribute__((aligned(16))) unsigned char lds[];
    Frame F;
    F.lds = (LAS unsigned char*)lds;
    F.MISC = (volatile LAS unsigned*)(F.lds + MISC_OFF);
    F.tid = threadIdx.x; F.lane = F.tid & 63; F.wave = __builtin_amdgcn_readfirstlane(F.tid >> 6);
    F.G = gridDim.x; { const int bx = blockIdx.x; F.vcu = (F.G % 8 == 0) ? (bx % 8) * (F.G / 8) + bx / 8 : bx; }
    F.out = A.out; F.ws = A.ws; F.ctl = (gu32*)(A.ws + WS_CTL);
    for (int u = F.tid; u < (LDS_BYTES - LDSCTL_OFF) / 4; u += NWAVES * 64) ((LAS unsigned*)(F.lds + LDSCTL_OFF))[u] = 0u;
    __syncthreads();
    XcdBarrier bar; bar.bar = (unsigned*)(F.ctl + CW_BAR); bar.x = 0; bar.st = nullptr;
    if (N_LAUNCHES == 1) bar = xcd_barrier_post((unsigned*)(F.ctl + CW_BAR), F.MISC + 8);
#define GRID_BAR() do { if (N_LAUNCHES == 1) xcd_barrier(bar); } while (0)
    const int lo = A.ph_lo, hi = A.ph_hi;
#define IN(k) (lo <= (k) && (k) < hi)
#define BOTH(k) (IN(k) && IN((k) + 1))
    bf16* XN = (bf16*)(F.ws + WS_XN); bf16* Z = (bf16*)(F.ws + WS_Z); bf16* YC = (bf16*)(F.ws + WS_YCAT); bf16* GY = (bf16*)(F.ws + WS_G); bf16* U = (bf16*)(F.ws + WS_U);
    const float* mod = (const float*)(F.ws + WS_MOD);

    if (IN(0)) { p0_prologue(F, A); if (BOTH(0)) GRID_BAR(); }
    if (IN(1)) { p1_modulate(F, A); if (BOTH(1)) GRID_BAR(); }
    if (IN(2)) {
        pg8::Gemm g{XN, (const bf16*)(F.ws + WS_WIN), M, NZ, D}; pg8::StaticOrder S; S.init(M, NZ, F.G, (int)blockIdx.x);
        pg8::EpiBf16<0> E{Z, NZ, nullptr};
        pg8::gemm_phase<pg8::EpiBf16<0>, pg8::StaticOrder, PG8_ALIGN, PG8_SP2>(F.lds + RING_OFF, g, S, E);
        if (BOTH(2)) GRID_BAR();
    }
    if (IN(3)) { p3_mixers_ref(F, A); if (BOTH(3)) GRID_BAR(); }
    if (IN(4)) {
        pg8::Gemm g{GY, (const bf16*)(F.ws + WS_WGLU), M, WB, WB}; pg8::StaticOrder S; S.init(M, WB, F.G, (int)blockIdx.x);
        pg8::EpiGlu E{GY, WB, YC, D, WA, A.in[I_GLUB]};
        pg8::gemm_phase<pg8::EpiGlu, pg8::StaticOrder, PG8_ALIGN, PG8_SP2>(F.lds + RING_OFF, g, S, E);
        if (BOTH(4)) GRID_BAR();
    }
    if (IN(5)) {
        pg8::Gemm g{YC, (const bf16*)(F.ws + WS_WOUT), M, D, D}; pg8::StaticOrder S; S.init(M, D, F.G, (int)blockIdx.x);
        pg8::EpiRes E{A.in[I_XP], A.in[I_XS], F.out, mod + 2 * D, nullptr, ALPHA, MP};
        pg8::gemm_phase<pg8::EpiRes, pg8::StaticOrder, PG8_ALIGN, PG8_SP2>(F.lds + RING_OFF, g, S, E);
        if (BOTH(5)) GRID_BAR();
    }
    if (IN(6)) { ln_rows<false>(F, A); if (BOTH(6)) GRID_BAR(); }
    if (IN(7)) {
        pg8::Gemm g{XN, (const bf16*)(F.ws + WS_W1), M, FF, D}; pg8::StaticOrder S; S.init(M, FF, F.G, (int)blockIdx.x);
        pg8::EpiBf16<3> E{U, FF, A.in[I_B1]};
        pg8::gemm_phase<pg8::EpiBf16<3>, pg8::StaticOrder, PG8_ALIGN, PG8_SP2>(F.lds + RING_OFF, g, S, E);
        if (BOTH(7)) GRID_BAR();
    }
    if (IN(8)) {
        pg8::Gemm g{U, (const bf16*)(F.ws + WS_W2), M, D, FF}; pg8::StaticOrder S; S.init(M, D, F.G, (int)blockIdx.x);
        pg8::EpiRes E{F.out, F.out + (size_t)MP * D, F.out, mod + 5 * D, A.in[I_B2], ALPHA, MP};
        pg8::gemm_phase<pg8::EpiRes, pg8::StaticOrder, PG8_ALIGN, PG8_SP2>(F.lds + RING_OFF, g, S, E);
        if (BOTH(8)) GRID_BAR();
    }
    if (IN(9)) { ln_rows<true>(F, A); }
#undef IN
#undef BOTH
}

extern "C" void kernel_launch(void* const* d_in, const int* in_sizes, int n_in, void* d_out, int out_size, void* d_ws, size_t ws_size, hipStream_t stream) {
    static int grid = 0;
    if (grid == 0) {
        if (n_in != 37 || in_sizes[0] != MP * D || out_size != (int)O_END || ws_size < WS_END) { fprintf(stderr, "kernel_launch: unexpected shapes (n_in %d, in0 %d, out %d, ws %zu)\n", n_in, n_in > 0 ? in_sizes[0] : -1, out_size, ws_size); grid = -1; return; }
        int dev = 0, cus = 0, per_cu = 0;
        if (hipGetDevice(&dev) != hipSuccess || hipDeviceGetAttribute(&cus, hipDeviceAttributeMultiprocessorCount, dev) != hipSuccess) { grid = -1; return; }
        if (hipFuncSetAttribute((const void*)fwd, hipFuncAttributeMaxDynamicSharedMemorySize, LDS_BYTES) != hipSuccess) { fprintf(stderr, "kernel_launch: hipFuncSetAttribute failed\n"); grid = -1; return; }
        if (hipOccupancyMaxActiveBlocksPerMultiprocessor(&per_cu, (const void*)fwd, NWAVES * 64, LDS_BYTES) != hipSuccess || per_cu < 1) { fprintf(stderr, "kernel_launch: occupancy query says %d\n", per_cu); }
        (void)hipGetLastError();
        grid = cus;
    }
    if (grid < 0) return;
    (void)hipMemsetAsync((char*)d_ws + WS_CTL, 0, CTL_ZERO_BYTES, stream);
    Args a{};
    for (int i = 0; i < 37; ++i) a.in[i] = (const float*)d_in[i];
    a.out = (float*)d_out; a.ws = (unsigned char*)d_ws;
    for (int li = 0; li < N_LAUNCHES; ++li) {
        if (N_LAUNCHES == 1) { a.ph_lo = 0; a.ph_hi = N_PHASES; } else { a.ph_lo = li; a.ph_hi = li + 1; }
        a.li = li;
        hipLaunchKernelGGL(fwd, dim3(grid), dim3(NWAVES * 64), LDS_BYTES, stream, a);
    }
}
```

```cpp
#include <hip/hip_runtime.h>
#include <cstdio>
#include <cstdint>
#include <cmath>

#ifndef MK_N_LAUNCHES
#define MK_N_LAUNCHES 1
#endif

namespace pg8 {
#define PG8_LAS __attribute__((address_space(3)))
typedef unsigned short bf16_t;
typedef short bf16x8 __attribute__((ext_vector_type(8)));
typedef float f32x4 __attribute__((ext_vector_type(4)));
typedef unsigned u32x4 __attribute__((ext_vector_type(4)));
constexpr int BM = 256, BK = 64, HALF = 128, HTB = HALF * BK * 2, STAGE_BYTES = 8 * HTB, NXCD = 8, WGM = 8;

__host__ __device__ __forceinline__ int lds_byte(int r, int c) { const int st = (r >> 4) * 2 + (c >> 5), rr = r & 15, cc = c & 31, ob = rr * 64 + cc * 2; return st * 1024 + (ob ^ (((ob >> 9) & 1) << 5)); }
__host__ __device__ __forceinline__ void stage_rc(int b, int& R, int& C) { const int st = b / 1024, sb = b % 1024, swz = sb ^ (((sb >> 9) & 1) << 5); R = (st >> 1) * 16 + swz / 64; C = (st & 1) * 32 + (swz % 64) / 2; }
__host__ __device__ __forceinline__ int perm32(int rho) { const int n = rho >> 4, i = rho & 15; return 8 * (i >> 2) + 4 * n + (i & 3); }

struct Unit { int pm, pn; };
struct Gemm { const bf16_t* A; const bf16_t* Bt; int M, N, K; };

struct StaticOrder {
    int nM, nN, nwg, G, c;
    __host__ __device__ void init(int M, int N, int G_, int c_) { nM = M / BM; nN = N / BM; nwg = nM * nN; G = G_; c = c_; }
    __host__ __device__ bool next(int i, Unit& u) const {
        const long L = (long)i * G + c; if (L >= nwg) return false;
        int wgid = (int)L; { const int q = nwg / NXCD, r = nwg % NXCD, xcd = wgid % NXCD, off = wgid / NXCD; wgid = (xcd < r ? xcd * (q + 1) : r * (q + 1) + (xcd - r) * q) + off; }
        const int nig = WGM * nN, gid = wgid / nig, fm = gid * WGM, gsz = (nM - fm) < WGM ? (nM - fm) : WGM;
        u.pm = fm + ((wgid % nig) % gsz); u.pn = (wgid % nig) / gsz; return true;
    }
    __device__ __forceinline__ void a_ready(const Unit&) const {}
    __device__ __forceinline__ void done(const Unit&) const {}
};

__device__ __forceinline__ unsigned cvt_pk_bf16(float lo, float hi) { unsigned r; asm volatile("v_cvt_pk_bf16_f32 %0, %1, %2" : "=v"(r) : "v"(lo), "v"(hi)); return r; }
__device__ __forceinline__ float bf_lo(unsigned w) { return __builtin_bit_cast(float, w << 16); }
__device__ __forceinline__ float bf_hi(unsigned w) { return __builtin_bit_cast(float, w & 0xffff0000u); }

template <int ACT> struct EpiBf16 {
    static constexpr bool PERM = true, AFTER_DRAIN = false;
    bf16_t* O; int ldc; const float* bias;
    __device__ __forceinline__ void operator()(const f32x4 (&acc)[2][2][4][2], const Unit& u, int wr, int wc, int fr, int fq) const {
        const int row0 = u.pm * BM + wr * 64 + fr; const int col0 = u.pn * BM + wc * 32 + 8 * fq;
        f32x4 bv[2][2];
#pragma unroll
        for (int bj = 0; bj < 2; ++bj)
#pragma unroll
            for (int n = 0; n < 2; ++n) bv[bj][n] = bias ? *(const f32x4*)(bias + col0 + bj * HALF + 4 * n) : (f32x4){0.f, 0.f, 0.f, 0.f};
#pragma unroll
        for (int ai = 0; ai < 2; ++ai)
#pragma unroll
            for (int m = 0; m < 4; ++m) { bf16_t* rowp = O + (size_t)(row0 + ai * HALF + m * 16) * ldc + col0;
#pragma unroll
                for (int bj = 0; bj < 2; ++bj) { f32x4 v0 = acc[ai][bj][m][0] + bv[bj][0], v1 = acc[ai][bj][m][1] + bv[bj][1];
                    if (ACT == 3) {
#pragma unroll
                        for (int e = 0; e < 4; ++e) { const float a = fmaxf(v0[e], 0.f), b = fmaxf(v1[e], 0.f); v0[e] = a * a; v1[e] = b * b; } }
                    u32x4 w; w.x = cvt_pk_bf16(v0[0], v0[1]); w.y = cvt_pk_bf16(v0[2], v0[3]); w.z = cvt_pk_bf16(v1[0], v1[1]); w.w = cvt_pk_bf16(v1[2], v1[3]);
                    *(u32x4*)(rowp + bj * HALF) = w; } }
    }
};
struct EpiGlu {
    static constexpr bool PERM = true, AFTER_DRAIN = false;
    const bf16_t* Gy; int ldg; bf16_t* O; int ldc; int coff; const float* bias;
    __device__ __forceinline__ void operator()(const f32x4 (&acc)[2][2][4][2], const Unit& u, int wr, int wc, int fr, int fq) const {
        const int row0 = u.pm * BM + wr * 64 + fr; const int col0 = u.pn * BM + wc * 32 + 8 * fq;
        f32x4 bv[2][2];
#pragma unroll
        for (int bj = 0; bj < 2; ++bj)
#pragma unroll
            for (int n = 0; n < 2; ++n) bv[bj][n] = *(const f32x4*)(bias + col0 + bj * HALF + 4 * n);
#pragma unroll
        for (int ai = 0; ai < 2; ++ai)
#pragma unroll
            for (int m = 0; m < 4; ++m) { const size_t row = (size_t)(row0 + ai * HALF + m * 16);
#pragma unroll
                for (int bj = 0; bj < 2; ++bj) { const f32x4 v0 = acc[ai][bj][m][0] + bv[bj][0], v1 = acc[ai][bj][m][1] + bv[bj][1];
                    const u32x4 g = *(const u32x4*)(Gy + row * ldg + col0 + bj * HALF);
                    float o[8];
                    o[0] = bf_lo(g.x) / (1.f + __expf(-v0[0])); o[1] = bf_hi(g.x) / (1.f + __expf(-v0[1]));
                    o[2] = bf_lo(g.y) / (1.f + __expf(-v0[2])); o[3] = bf_hi(g.y) / (1.f + __expf(-v0[3]));
                    o[4] = bf_lo(g.z) / (1.f + __expf(-v1[0])); o[5] = bf_hi(g.z) / (1.f + __expf(-v1[1]));
                    o[6] = bf_lo(g.w) / (1.f + __expf(-v1[2])); o[7] = bf_hi(g.w) / (1.f + __expf(-v1[3]));
                    u32x4 w; w.x = cvt_pk_bf16(o[0], o[1]); w.y = cvt_pk_bf16(o[2], o[3]); w.z = cvt_pk_bf16(o[4], o[5]); w.w = cvt_pk_bf16(o[6], o[7]);
                    *(u32x4*)(O + row * ldc + coff + col0 + bj * HALF) = w; } }
    }
};
struct EpiRes {
    static constexpr bool PERM = false, AFTER_DRAIN = false;
    const float* basep; const float* bases; float* out; const float* gate  ; const float* bias; float alpha; int MP;
    __device__ __forceinline__ void operator()(const f32x4 (&acc)[2][2][4][2], const Unit& u, int wr, int wc, int fr, int fq) const {
        const int row0 = u.pm * BM + wr * 64 + fr, col0 = u.pn * BM + wc * 32 + 4 * fq;
        f32x4 bv[2][2];
#pragma unroll
        for (int bj = 0; bj < 2; ++bj)
#pragma unroll
            for (int n = 0; n < 2; ++n) bv[bj][n] = bias ? *(const f32x4*)(bias + col0 + bj * HALF + n * 16) : (f32x4){0.f, 0.f, 0.f, 0.f};
#pragma unroll
        for (int ai = 0; ai < 2; ++ai)
#pragma unroll
            for (int m = 0; m < 4; ++m) { const int row = row0 + ai * HALF + m * 16;
                const bool smp = row >= MP; const int mr = smp ? 8 + ((row - MP) >> 2) : (row >> 11);
                const float* bp = smp ? bases + (size_t)(row - MP) * 1024 : basep + (size_t)row * 1024;
                const float* gp = gate + (size_t)mr * 6144; float* op = out + (size_t)row * 1024;
#pragma unroll
                for (int bj = 0; bj < 2; ++bj)
#pragma unroll
                    for (int n = 0; n < 2; ++n) { const int c = col0 + bj * HALF + n * 16;
                        const f32x4 b = *(const f32x4*)(bp + c), g = *(const f32x4*)(gp + c);
                        *(f32x4*)(op + c) = b * alpha + g * (acc[ai][bj][m][n] + bv[bj][n]); } }
    }
};

template <class Epi, class Sched, bool ALIGN_EPI = false, bool SP2 = false>
__device__ __forceinline__ void gemm_phase(PG8_LAS unsigned char* lds, const Gemm g, const Sched& S, const Epi& E) {
    const int tid = threadIdx.x, wid = __builtin_amdgcn_readfirstlane(tid >> 6), lane = tid & 63, wr = wid >> 2, wc = wid & 3, fr = lane & 15, fq = lane >> 4;
    const int K = g.K, nt = K / BK;
    unsigned voffA[2], voffB[2];
#pragma unroll
    for (int i = 0; i < 2; ++i) { int R, C; stage_rc(tid * 16 + i * 8192, R, C); const int Rb = Epi::PERM ? ((R & ~31) + perm32(R & 31)) : R;
        voffA[i] = (unsigned)(R * K + C) * 2u; voffB[i] = (unsigned)(Rb * K + C) * 2u; }
    const size_t kstep = (size_t)(BK * 2);
    const size_t hstep = (size_t)HALF * K * 2;
    const size_t tstep = 2 * hstep;
    const unsigned ldsw = (unsigned)wid * 1024u;
    const int aoff = lds_byte(wr * 64 + fr, fq * 8), boff = lds_byte(wc * 32 + fr, fq * 8);
#define PG8_SA(b, h) (((b) * 2 + (h)) * HTB)
#define PG8_SB(b, h) ((4 + (b) * 2 + (h)) * HTB)
#define PG8_STAGE(bufoff, gbase, voff) do { _Pragma("unroll") for (int _i = 0; _i < 2; ++_i) \
        __builtin_amdgcn_global_load_lds((const unsigned*)((const char*)(gbase) + (voff)[_i]), (PG8_LAS unsigned*)(lds + (bufoff) + ldsw + _i * 8192), 16, 0, 0); } while (0)
#define PG8_LDA(dst, b, h) do { _Pragma("unroll") for (int m = 0; m < 4; ++m) _Pragma("unroll") for (int k = 0; k < 2; ++k) dst[m][k] = *(const PG8_LAS bf16x8*)(lds + PG8_SA(b, h) + aoff + m * 2048 + k * 1024); } while (0)
#define PG8_LDB(dst, b, h) do { _Pragma("unroll") for (int n = 0; n < 2; ++n) _Pragma("unroll") for (int k = 0; k < 2; ++k) dst[n][k] = *(const PG8_LAS bf16x8*)(lds + PG8_SB(b, h) + boff + n * 2048 + k * 1024); } while (0)
#define PG8_MMA(ai, bj, At, Bt) do { __builtin_amdgcn_s_setprio(1); _Pragma("unroll") for (int m = 0; m < 4; ++m) _Pragma("unroll") for (int n = 0; n < 2; ++n) _Pragma("unroll") for (int k = 0; k < 2; ++k) \
        acc[ai][bj][m][n] = __builtin_amdgcn_mfma_f32_16x16x32_bf16(Bt[n][k], At[m][k], acc[ai][bj][m][n], 0, 0, 0); __builtin_amdgcn_s_setprio(0); } while (0)
#define PG8_WAIT_V(n) asm volatile("s_waitcnt vmcnt(" #n ")" ::: "memory")
#define PG8_WAIT_L(n) asm volatile("s_waitcnt lgkmcnt(" #n ")" ::: "memory")
#define PG8_BAR __builtin_amdgcn_s_barrier()
#define PG8_SCHED __builtin_amdgcn_sched_barrier(0)
    Unit cur, nxt; int ui = 0;
    if (!S.next(0, cur)) return;
    f32x4 acc[2][2][4][2];
#pragma unroll
    for (int a = 0; a < 2; ++a)
#pragma unroll
        for (int b = 0; b < 2; ++b)
#pragma unroll
            for (int m = 0; m < 4; ++m)
#pragma unroll
                for (int n = 0; n < 2; ++n) acc[a][b][m][n] = (f32x4){0.f, 0.f, 0.f, 0.f};
    bf16x8 At[4][2], B0[2][2], B1[2][2];
    const char* cA = (const char*)g.A + (size_t)cur.pm * tstep; const char* cB = (const char*)g.Bt + (size_t)cur.pn * tstep;
    S.a_ready(cur);
    if constexpr (SP2) {
        PG8_STAGE(PG8_SB(0, 0), cB, voffB); PG8_STAGE(PG8_SB(0, 1), cB + hstep, voffB); PG8_STAGE(PG8_SA(0, 0), cA, voffA); PG8_STAGE(PG8_SA(0, 1), cA + hstep, voffA);
        if (wr == 1) PG8_BAR;
        PG8_WAIT_V(2); PG8_BAR;
        PG8_STAGE(PG8_SB(1, 0), cB + kstep, voffB); PG8_STAGE(PG8_SA(1, 0), cA + kstep, voffA); PG8_STAGE(PG8_SB(1, 1), cB + hstep + kstep, voffB);
        PG8_WAIT_V(6); PG8_BAR;
    } else {
        PG8_STAGE(PG8_SB(0, 0), cB, voffB); PG8_STAGE(PG8_SA(0, 0), cA, voffA); PG8_STAGE(PG8_SB(0, 1), cB + hstep, voffB); PG8_STAGE(PG8_SA(0, 1), cA + hstep, voffA);
        if (wr == 1) PG8_BAR;
        PG8_WAIT_V(4); PG8_BAR;
        PG8_STAGE(PG8_SB(1, 0), cB + kstep, voffB); PG8_STAGE(PG8_SA(1, 0), cA + kstep, voffA); PG8_STAGE(PG8_SB(1, 1), cB + hstep + kstep, voffB);
        PG8_WAIT_V(6); PG8_BAR;
    }
    for (;;) {
        const bool has_next = S.next(ui + 1, nxt);
        const char* nA = has_next ? (const char*)g.A + (size_t)nxt.pm * tstep : cA; const char* nB = has_next ? (const char*)g.Bt + (size_t)nxt.pn * tstep : cB;
        for (int t = 0; t < nt; t += 2) {
            const bool last = (t == nt - 2);
            const char* a1 = cA + (size_t)(t + 1) * kstep;
            const char* a2 = last ? nA : cA + (size_t)(t + 2) * kstep; const char* b2 = last ? nB : cB + (size_t)(t + 2) * kstep;
            const char* a3 = a2 + kstep; const char* b3 = b2 + kstep;
            if (last && has_next) S.a_ready(nxt);
            if constexpr (SP2) {
            PG8_LDB(B0, 0, 0); PG8_LDB(B1, 0, 1); PG8_SCHED; PG8_LDA(At, 0, 0); PG8_STAGE(PG8_SA(1, 1), a1 + hstep, voffA);
            PG8_WAIT_V(8); PG8_WAIT_L(0); PG8_BAR; PG8_MMA(0, 0, At, B0); PG8_MMA(0, 1, At, B1); PG8_BAR; PG8_SCHED;
            PG8_LDA(At, 0, 1); PG8_STAGE(PG8_SB(0, 0), b2, voffB); PG8_STAGE(PG8_SB(0, 1), b2 + hstep, voffB); PG8_STAGE(PG8_SA(0, 0), a2, voffA);
            PG8_WAIT_V(8); PG8_WAIT_L(0); PG8_BAR; PG8_MMA(1, 0, At, B0); PG8_MMA(1, 1, At, B1); PG8_BAR; PG8_SCHED;
            PG8_LDB(B0, 1, 0); PG8_LDB(B1, 1, 1); PG8_SCHED; PG8_LDA(At, 1, 0); PG8_STAGE(PG8_SA(0, 1), a2 + hstep, voffA);
            PG8_WAIT_V(8); PG8_WAIT_L(0); PG8_BAR; PG8_MMA(0, 0, At, B0); PG8_MMA(0, 1, At, B1); PG8_BAR; PG8_SCHED;
            PG8_LDA(At, 1, 1); PG8_STAGE(PG8_SB(1, 0), b3, voffB); PG8_STAGE(PG8_SB(1, 1), b3 + hstep, voffB); PG8_STAGE(PG8_SA(1, 0), a3, voffA);
            PG8_WAIT_V(8); PG8_WAIT_L(0); PG8_BAR; PG8_MMA(1, 0, At, B0); PG8_MMA(1, 1, At, B1); PG8_BAR; PG8_SCHED;
            } else {
            PG8_LDB(B0, 0, 0); PG8_SCHED; PG8_LDA(At, 0, 0); PG8_STAGE(PG8_SA(1, 1), a1 + hstep, voffA);
            PG8_WAIT_L(8); PG8_BAR; PG8_WAIT_L(0); PG8_MMA(0, 0, At, B0); PG8_BAR; PG8_SCHED;
            PG8_LDB(B1, 0, 1); PG8_STAGE(PG8_SB(0, 0), b2, voffB);
            PG8_BAR; PG8_WAIT_L(0); PG8_MMA(0, 1, At, B1); PG8_BAR;
            PG8_LDA(At, 0, 1); PG8_STAGE(PG8_SA(0, 0), a2, voffA);
            PG8_BAR; PG8_WAIT_L(0); PG8_MMA(1, 0, At, B0); PG8_BAR; PG8_SCHED;
            PG8_STAGE(PG8_SB(0, 1), b2 + hstep, voffB);
            PG8_WAIT_V(6); PG8_BAR; PG8_MMA(1, 1, At, B1); PG8_BAR;
            PG8_LDB(B0, 1, 0); PG8_SCHED; PG8_LDA(At, 1, 0); PG8_STAGE(PG8_SA(0, 1), a2 + hstep, voffA);
            PG8_WAIT_L(8); PG8_BAR; PG8_WAIT_L(0); PG8_MMA(0, 0, At, B0); PG8_BAR; PG8_SCHED;
            PG8_LDB(B1, 1, 1); PG8_STAGE(PG8_SB(1, 0), b3, voffB);
            PG8_BAR; PG8_WAIT_L(0); PG8_MMA(0, 1, At, B1); PG8_BAR;
            PG8_LDA(At, 1, 1); PG8_STAGE(PG8_SA(1, 0), a3, voffA);
            PG8_BAR; PG8_WAIT_L(0); PG8_MMA(1, 0, At, B0); PG8_BAR; PG8_SCHED;
            PG8_STAGE(PG8_SB(1, 1), b3 + hstep, voffB);
            PG8_WAIT_V(6); PG8_BAR; PG8_MMA(1, 1, At, B1); PG8_BAR;
            }
        }
        if constexpr (ALIGN_EPI) { if (wr == 0) PG8_BAR; }
        if constexpr (!Epi::AFTER_DRAIN) { E(acc, cur, wr, wc, fr, fq); S.done(cur); }
        if (!has_next) break;
#pragma unroll
        for (int a = 0; a < 2; ++a)
#pragma unroll
            for (int b = 0; b < 2; ++b)
#pragma unroll
                for (int m = 0; m < 4; ++m)
#pragma unroll
                    for (int n = 0; n < 2; ++n) acc[a][b][m][n] = (f32x4){0.f, 0.f, 0.f, 0.f};
        cur = nxt; cA = nA; cB = nB; ++ui;
        if constexpr (ALIGN_EPI) { if (wr == 1) PG8_BAR; }
    }
    PG8_WAIT_V(0);
    if constexpr (!ALIGN_EPI) { if (wr == 0) PG8_BAR; }
    PG8_BAR;
#undef PG8_SA
#undef PG8_SB
#undef PG8_STAGE
#undef PG8_LDA
#undef PG8_LDB
#undef PG8_MMA
#undef PG8_WAIT_V
#undef PG8_WAIT_L
#undef PG8_BAR
#undef PG8_SCHED
}
}

#ifndef PG8_SP2
#define PG8_SP2 true
#endif
#ifndef PG8_ALIGN
#define PG8_ALIGN true
#endif

constexpr int NWAVES = 8;
constexpr int N_LAUNCHES = MK_N_LAUNCHES;
constexpr int N_PHASES = 10;
constexpr int D = 1024, MP = 16384, MS = 512, M = MP + MS, TP = 2048, NBP = 8, NBS = 128, TS = 4;
constexpr int NZ = 1536, WA = 512, WB = 512, FF = 4096, NMOD = 6 * D, NROWMOD = NBP + NBS;
constexpr int GB = 32, NS5 = 64, KS5 = 16, HA = 8, HDA = 64;
constexpr float LN_EPS = 1e-5f;
constexpr float ALPHA = 1.189207115002721f;

constexpr size_t O_YP = 0, O_YS = (size_t)MP * D, O_CONVP = O_YS + (size_t)MS * D, O_HP = O_CONVP + (size_t)NBP * 3 * WA, O_SRP = O_HP + (size_t)NBP * WA,
                 O_SIP = O_SRP + (size_t)NBP * GB * NS5, O_CONVS = O_SIP + (size_t)NBP * GB * NS5, O_HS = O_CONVS + (size_t)NBS * 3 * WA, O_SRS = O_HS + (size_t)NBS * WA,
                 O_SIS = O_SRS + (size_t)NBS * GB * NS5, O_END = O_SIS + (size_t)NBS * GB * NS5;

constexpr size_t MiB = 1u << 20;
constexpr size_t WS_CTL = 0, CTL_ZERO_BYTES = 1 * MiB;
constexpr size_t WS_WIN = 1 * MiB, WS_WGLU = 4 * MiB, WS_WOUT = 5 * MiB, WS_W1 = 7 * MiB, WS_W2 = 15 * MiB;
constexpr size_t WS_MOD = 23 * MiB;
constexpr size_t WS_S5C = 27 * MiB;
constexpr size_t WS_XN = 28 * MiB;
constexpr size_t WS_Z = 61 * MiB;
constexpr size_t WS_YCAT = 111 * MiB;
constexpr size_t WS_G = 144 * MiB;
constexpr size_t WS_U = 61 * MiB;
constexpr size_t WS_TAB = 194 * MiB;
constexpr size_t WS_END = 196 * MiB;
constexpr size_t TB_BF1 = 0, TB_BF2 = TB_BF1 + 32 * 4 * 64 * 16, TB_TA = TB_BF2 + 32 * 8 * 64 * 16, TB_ZP = TB_TA + 32 * 2 * 2 * 32 * 4, TB_Z16N = TB_ZP + 32 * 17 * 2 * 2 * 32 * 4,
                 TB_RG = TB_Z16N + 32 * 2 * 64 * 4, TB_END = TB_RG + 8 * 2 * 2 * 4 * 64 * 16;
static_assert(WS_TAB + TB_END <= WS_END, "tables");
static_assert(WS_XN + (size_t)M * D * 2 <= WS_Z && WS_Z + (size_t)M * NZ * 2 <= WS_YCAT && WS_YCAT + (size_t)M * D * 2 <= WS_G && WS_G + (size_t)M * WB * 2 <= WS_END && WS_U + (size_t)M * FF * 2 <= WS_TAB, "d_ws map");
constexpr int SC_ABR = 0, SC_ABI = 2048, SC_BBR = 4096, SC_BBI = 4096 + 32768, SC_RGL = 4096 + 65536, SC_END = SC_RGL + 512;
constexpr int CW_TMO = 0, CW_CODE = 1, CW_BAR = 4096;

constexpr int RING_OFF = 0, RING_BYTES = 131072;
constexpr int LDSCTL_OFF = RING_BYTES, MISC_OFF = LDSCTL_OFF + 320;
constexpr int LDS_BYTES = 147456;

#define GAS __attribute__((address_space(1)))
#define LAS __attribute__((address_space(3)))
typedef unsigned short bf16;
typedef unsigned v4u __attribute__((ext_vector_type(4)));
typedef float f32x4 __attribute__((ext_vector_type(4)));
typedef GAS unsigned gu32;
#define RLX_AGENT __ATOMIC_RELAXED, __HIP_MEMORY_SCOPE_AGENT
#define LDS_WAIT() asm volatile("s_waitcnt lgkmcnt(0)" ::: "memory")
#define VM_WAIT() asm volatile("s_waitcnt vmcnt(0)" ::: "memory")
__device__ __forceinline__ unsigned f2bf(float f) { unsigned u = __builtin_bit_cast(unsigned, f); return (u + 0x7fffu + ((u >> 16) & 1u)) >> 16; }
__device__ __forceinline__ unsigned pk2(float lo, float hi) { return f2bf(lo) | (f2bf(hi) << 16); }
__device__ __forceinline__ float bf2f(bf16 v) { return __builtin_bit_cast(float, (unsigned)v << 16); }
__device__ __forceinline__ float gelu_tanh(float x) { const float t = 1.5957691216057308f * (x + 0.044715f * x * x * x); return x / (1.f + __expf(-t)); }
__device__ __forceinline__ float sigmoidf_(float x) { return 1.f / (1.f + __expf(-x)); }

#define XB_TMO      128
#define XB_XCNT(j)  (256  + 64 * (j))
#define XB_XSUB(j)  (1280 + 64 * (j))
#define XB_XGEN(j)  (2304 + 64 * (j))
#define XB_TOP      3328
#define XB_TOPGEN   3392
#define XCD_BAR_WORDS 3456
#define XB_SPIN_CAP (1u << 18)
__device__ __forceinline__ unsigned xb_ld(unsigned* p)              { return __hip_atomic_load(p, __ATOMIC_RELAXED, __HIP_MEMORY_SCOPE_AGENT); }
__device__ __forceinline__ unsigned xb_add(unsigned* p, unsigned v) { return __hip_atomic_fetch_add(p, v, __ATOMIC_RELAXED, __HIP_MEMORY_SCOPE_AGENT); }
__device__ __forceinline__ unsigned xb_xcc_id() { return (unsigned)__builtin_amdgcn_s_getreg((3 << 11) | 20) & 0xFu; }
#define XB_SPIN(cond, bar) do { unsigned _sp = 0; while (cond) { __builtin_amdgcn_s_sleep(1); \
    if ((++_sp & 255u) == 0u) { if (xb_ld(&(bar)[XB_TMO])) break; if (_sp > XB_SPIN_CAP) { atomicAdd(&(bar)[XB_TMO], 1u); break; } } } } while (0)
struct XcdBarrier { unsigned* bar; unsigned x; volatile LAS unsigned* st; };
__device__ __forceinline__ XcdBarrier xcd_barrier_post(unsigned* bar, volatile LAS unsigned* st) {
    XcdBarrier b; b.bar = bar; b.x = xb_xcc_id(); b.st = st;
    if (threadIdx.x == 0) (void)xb_add(&bar[XB_XCNT(b.x)], 1u);
    return b;
}
__device__ __forceinline__ void xcd_barrier_complete(unsigned* bar, unsigned x, unsigned& nloc, unsigned& nx) {
    const unsigned G = gridDim.x * gridDim.y * gridDim.z;
    unsigned sum, cnt, mine, sp = 0u;
    for (;;) {
        sum = 0u; cnt = 0u; mine = 0u;
#pragma unroll
        for (unsigned j = 0; j < 16; ++j) { const unsigned c = xb_ld(&bar[XB_XCNT(j)]); sum += c; cnt += (c > 0u) ? 1u : 0u; mine = (j == x) ? c : mine; }
        if (sum == G) break;
        __builtin_amdgcn_s_sleep(1);
        if ((++sp & 255u) == 0u) { if (xb_ld(&bar[XB_TMO])) break; if (sp > XB_SPIN_CAP) { atomicAdd(&bar[XB_TMO], 1u); break; } }
    }
    nloc = mine > 0u ? mine : 1u; nx = cnt > 0u ? cnt : 1u;
}
__device__ __forceinline__ void xcd_barrier(const XcdBarrier& b) {
    asm volatile("s_waitcnt vmcnt(0)" ::: "memory");
    __syncthreads();
    if (threadIdx.x == 0) {
        unsigned* bar = b.bar;
        __builtin_amdgcn_s_waitcnt(0);
        unsigned nloc = b.st[0], nx = b.st[1];
        if (nloc == 0u) { xcd_barrier_complete(bar, b.x, nloc, nx); b.st[0] = nloc; b.st[1] = nx; }
        const unsigned old = xb_add(&bar[XB_XSUB(b.x)], 1u);
        const unsigned gen = old / nloc;
        if (old + 1u == (gen + 1u) * nloc) {
            __builtin_amdgcn_fence(__ATOMIC_RELEASE, "agent");
            asm volatile("s_waitcnt vmcnt(0)" ::: "memory");
            const unsigned og = xb_add(&bar[XB_TOP], 1u);
            const unsigned tg = og / nx;
            if (og + 1u == (tg + 1u) * nx) xb_add(&bar[XB_TOPGEN], 1u);
            else XB_SPIN(xb_ld(&bar[XB_TOPGEN]) == tg, bar);
            __builtin_amdgcn_fence(__ATOMIC_ACQUIRE, "agent");
            xb_add(&bar[XB_XGEN(b.x)], 1u);
            asm volatile("s_waitcnt vmcnt(0)" ::: "memory");
        } else {
            XB_SPIN(xb_ld(&bar[XB_XGEN(b.x)]) == gen, bar);
            __builtin_amdgcn_fence(__ATOMIC_ACQUIRE, "agent");
            asm volatile("s_waitcnt vmcnt(0)" ::: "memory");
        }
    }
    __syncthreads();
}

struct Frame {
    LAS unsigned char* lds;
    volatile LAS unsigned* MISC;
    gu32* ctl;
    int tid, lane, wave;
    int vcu, G;
    float* out;
    unsigned char* ws;
};
struct Args { const float* in[37]; float* out; unsigned char* ws; int ph_lo, ph_hi, li, pad; };
__device__ __forceinline__ float wave_sum(float v) {
#pragma unroll
    for (int o = 1; o < 64; o <<= 1) v += __shfl_xor(v, o);
    return v;
}
enum { I_XP = 0, I_XS, I_SCONV, I_SH, I_SSR, I_SSI, I_CP, I_CS, I_ADAW, I_ADAB, I_INPROJ, I_CONVW, I_CONVB, I_RGWR, I_RGBR, I_RGWI, I_RGBI, I_RGLAM,
       I_S5ARE, I_S5AIM, I_S5LOGDT, I_S5BRE, I_S5BIM, I_S5CRE, I_S5CIM, I_S5D, I_GLUW, I_GLUB, I_OUTPROJ, I_LN1G, I_LN1B, I_W1, I_B1, I_W2, I_B2, I_LN2G, I_LN2B };

__device__ __forceinline__ void p0_transpose_item(const float* W, int K, int N, bf16* WT, LAS float* scr, int item, int lane) {
    const int nblk = N / 32, kb = item / nblk, nb = item % nblk, k0 = 64 * kb, n0 = 32 * nb;
#pragma unroll 8
    for (int i = 0; i < 32; ++i) { const int kk = 2 * i + (lane >> 5); scr[kk * 33 + (lane & 31)] = W[(size_t)(k0 + kk) * N + n0 + (lane & 31)]; }
    LDS_WAIT(); asm volatile("" ::: "memory");
    const int c = lane & 7;
#pragma unroll
    for (int j = 0; j < 4; ++j) { const int n = (lane >> 3) + 8 * j; const LAS float* s = scr + (8 * c) * 33 + n;
        v4u o; o.x = pk2(s[0 * 33], s[1 * 33]); o.y = pk2(s[2 * 33], s[3 * 33]); o.z = pk2(s[4 * 33], s[5 * 33]); o.w = pk2(s[6 * 33], s[7 * 33]);
        *(GAS v4u*)(WT + (size_t)(n0 + n) * K + k0 + 8 * c) = o; }
    LDS_WAIT(); asm volatile("" ::: "memory");
}

__device__ __forceinline__ void p0_prologue(Frame& F, const Args& A) {
    LAS float* scr = (LAS float*)(F.lds + RING_OFF + F.wave * 16384);
    const int gw = F.wave * F.G + F.vcu, NGW = F.G * NWAVES;
    constexpr int I_IN = (D / 64) * (NZ / 32), I_GL = (WB / 64) * (WB / 32), I_OU = (D / 64) * (D / 32), I_1 = (D / 64) * (FF / 32), I_2 = (FF / 64) * (D / 32);
    constexpr int I_S5 = GB, I_RG = WA / 64, I_RGT = HA * 2 * 2 * 4;
    constexpr int NITEMS = I_IN + I_GL + I_OU + I_1 + I_2 + I_S5 + I_RG + I_RGT;
    float* sc = (float*)(F.ws + WS_S5C);
    for (int it = gw; it < NITEMS; it += NGW) {
        int r = it;
        if (r < I_IN) { p0_transpose_item(A.in[I_INPROJ], D, NZ, (bf16*)(F.ws + WS_WIN), scr, r, F.lane); continue; } r -= I_IN;
        if (r < I_GL) { p0_transpose_item(A.in[I_GLUW], WB, WB, (bf16*)(F.ws + WS_WGLU), scr, r, F.lane); continue; } r -= I_GL;
        if (r < I_OU) { p0_transpose_item(A.in[I_OUTPROJ], D, D, (bf16*)(F.ws + WS_WOUT), scr, r, F.lane); continue; } r -= I_OU;
        if (r < I_1) { p0_transpose_item(A.in[I_W1], D, FF, (bf16*)(F.ws + WS_W1), scr, r, F.lane); continue; } r -= I_1;
        if (r < I_2) { p0_transpose_item(A.in[I_W2], FF, D, (bf16*)(F.ws + WS_W2), scr, r, F.lane); continue; } r -= I_2;
        if (r < I_S5) {
            const int g = r, n = F.lane, gn = g * NS5 + n;
            const double dt = exp((double)A.in[I_S5LOGDT][g]), ar = (double)A.in[I_S5ARE][gn], ai = (double)A.in[I_S5AIM][gn];
            const double mag = exp(dt * ar), abr = mag * cos(dt * ai), abi = mag * sin(dt * ai), den = ar * ar + ai * ai, nr = abr - 1.0;
            const double qr = (nr * ar + abi * ai) / den, qi = (abi * ar - nr * ai) / den;
            sc[SC_ABR + gn] = (float)abr; sc[SC_ABI + gn] = (float)abi;
            unsigned char* tab = F.ws + WS_TAB;
            bf16* BF1 = (bf16*)(tab + TB_BF1); bf16* BF2 = (bf16*)(tab + TB_BF2); float* TA = (float*)(tab + TB_TA); float* ZP = (float*)(tab + TB_ZP); float* Z16N = (float*)(tab + TB_Z16N);
            const int sh = n >> 5, v = n & 31, hh = (v >> 2) & 1, ii = (v & 3) + 4 * (v >> 3);
            for (int k = 0; k < KS5; ++k) { const double br = (double)A.in[I_S5BRE][gn * KS5 + k], bi = (double)A.in[I_S5BIM][gn * KS5 + k];
                const float vr = (float)(qr * br - qi * bi), vi = (float)(qr * bi + qi * br);
                sc[SC_BBR + gn * KS5 + k] = vr; sc[SC_BBI + gn * KS5 + k] = vi;
                const int lp = (n & 31) + 32 * (k >> 3), jj = k & 7;
                BF1[(size_t)((g * 4 + 0 + sh) * 64 + lp) * 8 + jj] = (bf16)f2bf(vr); BF1[(size_t)((g * 4 + 2 + sh) * 64 + lp) * 8 + jj] = (bf16)f2bf(vi); }
            { const int s2 = (n >> 4) & 1, jj = 4 * ((n >> 3) & 1) + (n & 3), hk = (n >> 2) & 1;
              for (int ch = 0; ch < KS5; ++ch) { const int hr_ = ch >> 3, i8 = ch & 7, R = (i8 & 3) + 8 * (i8 >> 2) + 4 * hr_, lp = R + 32 * hk;
                  const float cr = A.in[I_S5CRE][(size_t)(g * KS5 + ch) * NS5 + n], ci = A.in[I_S5CIM][(size_t)(g * KS5 + ch) * NS5 + n];
                  BF2[(size_t)((g * 8 + (0 + sh) * 2 + s2) * 64 + lp) * 8 + jj] = (bf16)f2bf(cr); BF2[(size_t)((g * 8 + (2 + sh) * 2 + s2) * 64 + lp) * 8 + jj] = (bf16)f2bf(-ci); }
              for (int z = 0; z < 4; ++z) { const int cidx = n + 64 * z, ks = cidx >> 5, r16 = cidx & 31, lp = 16 + (r16 & 15) + 32 * (r16 >> 4);
                  *(v4u*)(BF2 + (size_t)((g * 8 + ks) * 64 + lp) * 8) = (v4u){0u, 0u, 0u, 0u}; } }
            TA[((g * 2 + hh) * 2 + 0) * 32 + sh * 16 + ii] = (float)abr; TA[((g * 2 + hh) * 2 + 1) * 32 + sh * 16 + ii] = (float)abi;
            for (int e = 0; e <= 16; ++e) { const double mg = exp(8.0 * e * dt * ar), an = 8.0 * e * dt * ai; const float zr = (float)(mg * cos(an)), zi = (float)(mg * sin(an));
                ZP[(((g * 17 + e) * 2 + hh) * 2 + 0) * 32 + sh * 16 + ii] = zr; ZP[(((g * 17 + e) * 2 + hh) * 2 + 1) * 32 + sh * 16 + ii] = zi;
                if (e == 16) { Z16N[(g * 2 + 0) * 64 + n] = zr; Z16N[(g * 2 + 1) * 64 + n] = zi; } }
            continue; } r -= I_S5;
        if (r < I_RG) { const int c = r * 64 + F.lane; const double lam = (double)A.in[I_RGLAM][c];
          sc[SC_RGL + c] = (float)(-8.0 * log1p(exp(-lam)) * 1.4426950408889634); continue; } r -= I_RG;
        {
            const int s4 = r & 3, gate = (r >> 2) & 1, jh = (r >> 3) & 1, hd = r >> 4;
            const int R = F.lane & 31, hk = F.lane >> 5, hR = (R >> 2) & 1, i = (R & 3) + 4 * (R >> 3), cho = 32 * jh + 16 * (i >> 3) + 8 * hR + (i & 7);
            const float* W = A.in[gate ? I_RGWI : I_RGWR] + (size_t)(hd * 64 + 16 * s4 + 8 * hk) * 64 + cho;
            v4u o; o.x = pk2(W[0], W[64]); o.y = pk2(W[128], W[192]); o.z = pk2(W[256], W[320]); o.w = pk2(W[384], W[448]);
            *(v4u*)(F.ws + WS_TAB + TB_RG + (size_t)(r * 64 + F.lane) * 16) = o;
        }
    }
    __syncthreads();
    LAS float* sT = (LAS float*)(F.lds + RING_OFF);
    float* mod = (float*)(F.ws + WS_MOD);
    constexpr int NRG = NROWMOD / 8, NCB = NMOD / 512;
    for (int it = F.vcu; it < NRG * NCB; it += F.G) {
        const int rg = it / NCB, cb = it % NCB;
        for (int e = F.tid; e < 8 * 1024; e += NWAVES * 64) { const int rr = e >> 10, k = e & 1023, row = rg * 8 + rr;
            const float v = row < NBP ? A.in[I_CP][(size_t)row * D + k] : A.in[I_CS][(size_t)(row - NBP) * D + k];
            sT[k * 8 + rr] = v / (1.f + expf(-v)); }
        __syncthreads();
        const int col = cb * 512 + F.tid; const float* w = A.in[I_ADAW] + col;
        float a[8];
#pragma unroll
        for (int i = 0; i < 8; ++i) a[i] = 0.f;
#pragma unroll 4
        for (int k = 0; k < 1024; ++k) { const float wv = w[(size_t)k * NMOD]; const f32x4 s0 = *(const LAS f32x4*)(sT + k * 8), s1 = *(const LAS f32x4*)(sT + k * 8 + 4);
            a[0] += s0[0] * wv; a[1] += s0[1] * wv; a[2] += s0[2] * wv; a[3] += s0[3] * wv; a[4] += s1[0] * wv; a[5] += s1[1] * wv; a[6] += s1[2] * wv; a[7] += s1[3] * wv; }
        const float bb = A.in[I_ADAB][col];
#pragma unroll
        for (int i = 0; i < 8; ++i) mod[(size_t)(rg * 8 + i) * NMOD + col] = a[i] + bb;
        __syncthreads();
    }
}

__device__ __forceinline__ int mod_row(int m) { return m < MP ? (m >> 11) : NBP + ((m - MP) >> 2); }
__device__ __forceinline__ const float* x_row(const Args& A, int m) { return m < MP ? A.in[I_XP] + (size_t)m * D : A.in[I_XS] + (size_t)(m - MP) * D; }

__device__ __forceinline__ void p1_modulate(Frame& F, const Args& A) {
    const int gw = F.vcu * NWAVES + F.wave, NGW = F.G * NWAVES;
    const float* mod = (const float*)(F.ws + WS_MOD); bf16* XN = (bf16*)(F.ws + WS_XN);
    for (int m = gw; m < M; m += NGW) {
        const GAS f32x4* xr = (const GAS f32x4*)x_row(A, m) + F.lane; const float* mr = mod + (size_t)mod_row(m) * NMOD;
        const GAS f32x4* sh = (const GAS f32x4*)(mr) + F.lane; const GAS f32x4* scp = (const GAS f32x4*)(mr + D) + F.lane;
        GAS unsigned long long* o8 = (GAS unsigned long long*)(XN + (size_t)m * D) + F.lane;
#pragma unroll
        for (int j = 0; j < 4; ++j) { const f32x4 v = xr[64 * j], a = sh[64 * j], s = scp[64 * j]; const f32x4 h = v * (s + 1.f) + a;
            o8[64 * j] = (unsigned long long)pk2(h.x, h.y) | ((unsigned long long)pk2(h.z, h.w) << 32); }
    }
}

template <bool SECOND>
__device__ __forceinline__ void ln_rows(Frame& F, const Args& A) {
    const int gw = F.vcu * NWAVES + F.wave, NGW = F.G * NWAVES;
    const float* mod = (const float*)(F.ws + WS_MOD); bf16* XN = (bf16*)(F.ws + WS_XN);
    const GAS f32x4* gg = (const GAS f32x4*)A.in[SECOND ? I_LN2G : I_LN1G] + F.lane; const GAS f32x4* gb = (const GAS f32x4*)A.in[SECOND ? I_LN2B : I_LN1B] + F.lane;
    for (int m = gw; m < M; m += NGW) {
        GAS f32x4* xr = (GAS f32x4*)(F.out + (size_t)m * D) + F.lane;
        f32x4 v[4]; float s = 0.f;
#pragma unroll
        for (int j = 0; j < 4; ++j) { v[j] = xr[64 * j]; s += (v[j].x + v[j].y) + (v[j].z + v[j].w); }
        const float mean = wave_sum(s) * (1.f / D); float s2 = 0.f;
#pragma unroll
        for (int j = 0; j < 4; ++j) { v[j] = v[j] - mean; s2 += (v[j].x * v[j].x + v[j].y * v[j].y) + (v[j].z * v[j].z + v[j].w * v[j].w); }
        const float rstd = 1.f / sqrtf(wave_sum(s2) * (1.f / D) + LN_EPS);
#pragma unroll
        for (int j = 0; j < 4; ++j) { v[j] = v[j] * rstd * gg[64 * j] + gb[64 * j]; xr[64 * j] = v[j]; }
        if (!SECOND) {
            const float* mr = mod + (size_t)mod_row(m) * NMOD;
            const GAS f32x4* sh = (const GAS f32x4*)(mr + 3 * D) + F.lane; const GAS f32x4* scp = (const GAS f32x4*)(mr + 4 * D) + F.lane;
            GAS unsigned long long* o8 = (GAS unsigned long long*)(XN + (size_t)m * D) + F.lane;
#pragma unroll
            for (int j = 0; j < 4; ++j) { const f32x4 h = v[j] * (scp[64 * j] + 1.f) + sh[64 * j];
                o8[64 * j] = (unsigned long long)pk2(h.x, h.y) | ((unsigned long long)pk2(h.z, h.w) << 32); }
        }
    }
}

__device__ __forceinline__ void rg_item_ref(Frame& F, const Args& A, bool prompt, int b, int hd, LAS float* scr) {
    const int j = F.lane, c = hd * HDA + j;
    const bf16* Z = (const bf16*)(F.ws + WS_Z); bf16* Y = (bf16*)(F.ws + WS_YCAT); const float* sc = (const float*)(F.ws + WS_S5C);
    float wr[64], wi[64];
#pragma unroll
    for (int i = 0; i < 64; ++i) { wr[i] = A.in[I_RGWR][(size_t)(hd * 64 + i) * 64 + j]; wi[i] = A.in[I_RGWI][(size_t)(hd * 64 + i) * 64 + j]; }
    const float br = A.in[I_RGBR][c], bi = A.in[I_RGBI][c], L2 = sc[SC_RGL + c];
    const float w0 = A.in[I_CONVW][c], w1 = A.in[I_CONVW][WA + c], w2 = A.in[I_CONVW][2 * WA + c], w3 = A.in[I_CONVW][3 * WA + c], cb = A.in[I_CONVB][c];
    int T, m0; float x3, x2, x1, h;
    if (prompt) { T = TP; m0 = b * TP; x3 = 0.f; x2 = 0.f; x1 = 0.f; h = 0.f; }
    else { T = TS; m0 = MP + b * TS; x3 = A.in[I_SCONV][(size_t)(b * 3 + 0) * WA + c]; x2 = A.in[I_SCONV][(size_t)(b * 3 + 1) * WA + c]; x1 = A.in[I_SCONV][(size_t)(b * 3 + 2) * WA + c]; h = A.in[I_SH][(size_t)b * WA + c]; }
    for (int t = 0; t < T; ++t) {
        const size_t m = (size_t)(m0 + t);
        const float xa = bf2f(Z[m * NZ + WA + c]), gate = bf2f(Z[m * NZ + c]);
        const float xc = cb + w0 * x3 + w1 * x2 + w2 * x1 + w3 * xa; x3 = x2; x2 = x1; x1 = xa;
        scr[j] = xc; LDS_WAIT(); asm volatile("" ::: "memory");
        float rp = br, gp = bi;
#pragma unroll
        for (int i4 = 0; i4 < 16; ++i4) { const f32x4 v = *(const LAS f32x4*)(scr + 4 * i4);
            rp += v[0] * wr[4 * i4] + v[1] * wr[4 * i4 + 1] + v[2] * wr[4 * i4 + 2] + v[3] * wr[4 * i4 + 3];
            gp += v[0] * wi[4 * i4] + v[1] * wi[4 * i4 + 1] + v[2] * wi[4 * i4 + 2] + v[3] * wi[4 * i4 + 3]; }
        LDS_WAIT(); asm volatile("" ::: "memory");
        const float r = sigmoidf_(rp), gi = sigmoidf_(gp);
        const float a = exp2f(r * L2);
        float mult = sqrtf(fmaxf(1.f - a * a, 0.f));
        if (prompt && t == 0) mult = 1.f;
        h = a * h + mult * gi * xc;
        Y[m * D + c] = (bf16)f2bf(gelu_tanh(gate) * h);
    }
    float* oc = F.out + (prompt ? O_CONVP : O_CONVS); float* oh = F.out + (prompt ? O_HP : O_HS);
    oc[(size_t)(b * 3 + 0) * WA + c] = x3; oc[(size_t)(b * 3 + 1) * WA + c] = x2; oc[(size_t)(b * 3 + 2) * WA + c] = x1;
    oh[(size_t)b * WA + c] = h;
}
__device__ __forceinline__ void s5_item_ref(Frame& F, const Args& A, bool prompt, int b, int g, LAS float* scr) {
    const int n = F.lane, gn = g * NS5 + n, k = F.lane & 15, part = F.lane >> 4;
    const bf16* Z = (const bf16*)(F.ws + WS_Z); bf16* Gy = (bf16*)(F.ws + WS_G); const float* sc = (const float*)(F.ws + WS_S5C);
    float bbr[16], bbi[16], cre[16], cim[16];
#pragma unroll
    for (int i = 0; i < 16; ++i) { bbr[i] = sc[SC_BBR + gn * KS5 + i]; bbi[i] = sc[SC_BBI + gn * KS5 + i];
        cre[i] = A.in[I_S5CRE][(size_t)(g * KS5 + k) * NS5 + part * 16 + i]; cim[i] = A.in[I_S5CIM][(size_t)(g * KS5 + k) * NS5 + part * 16 + i]; }
    const float abr = sc[SC_ABR + gn], abi = sc[SC_ABI + gn], dk = A.in[I_S5D][g * KS5 + k];
    int T, m0; float hr, hi;
    if (prompt) { T = TP; m0 = b * TP; hr = 0.f; hi = 0.f; }
    else { T = TS; m0 = MP + b * TS; hr = A.in[I_SSR][(size_t)(b * GB + g) * NS5 + n]; hi = A.in[I_SSI][(size_t)(b * GB + g) * NS5 + n]; }
    for (int t = 0; t < T; ++t) {
        const size_t m = (size_t)(m0 + t);
        const bf16* zr = Z + m * NZ + 2 * WA + g * KS5;
        const v4u u0 = *(const v4u*)zr, u1 = *(const v4u*)(zr + 8);
        float u[16];
        u[0] = pg8::bf_lo(u0.x); u[1] = pg8::bf_hi(u0.x); u[2] = pg8::bf_lo(u0.y); u[3] = pg8::bf_hi(u0.y); u[4] = pg8::bf_lo(u0.z); u[5] = pg8::bf_hi(u0.z); u[6] = pg8::bf_lo(u0.w); u[7] = pg8::bf_hi(u0.w);
        u[8] = pg8::bf_lo(u1.x); u[9] = pg8::bf_hi(u1.x); u[10] = pg8::bf_lo(u1.y); u[11] = pg8::bf_hi(u1.y); u[12] = pg8::bf_lo(u1.z); u[13] = pg8::bf_hi(u1.z); u[14] = pg8::bf_lo(u1.w); u[15] = pg8::bf_hi(u1.w);
        float bur = 0.f, bui = 0.f;
#pragma unroll
        for (int i = 0; i < 16; ++i) { bur += bbr[i] * u[i]; bui += bbi[i] * u[i]; }
        const float nhr = abr * hr - abi * hi + bur, nhi = abr * hi + abi * hr + bui; hr = nhr; hi = nhi;
        scr[n] = hr; scr[64 + n] = hi; LDS_WAIT(); asm volatile("" ::: "memory");
        float p = 0.f;
#pragma unroll
        for (int i4 = 0; i4 < 4; ++i4) { const f32x4 vr = *(const LAS f32x4*)(scr + part * 16 + 4 * i4), vi = *(const LAS f32x4*)(scr + 64 + part * 16 + 4 * i4);
#pragma unroll
            for (int e = 0; e < 4; ++e) p += vr[e] * cre[4 * i4 + e] - vi[e] * cim[4 * i4 + e]; }
        LDS_WAIT(); asm volatile("" ::: "memory");
        p += __shfl_xor(p, 16); p += __shfl_xor(p, 32);
        const float uk = bf2f(zr[k]);
        if (F.lane < 16) Gy[m * WB + g * KS5 + k] = (bf16)f2bf(gelu_tanh(p + dk * uk));
    }
    float* osr = F.out + (prompt ? O_SRP : O_SRS); float* osi = F.out + (prompt ? O_SIP : O_SIS);
    osr[(size_t)(b * GB + g) * NS5 + n] = hr; osi[(size_t)(b * GB + g) * NS5 + n] = hi;
}

typedef short bf16x8v __attribute__((ext_vector_type(8)));
typedef float f32x16 __attribute__((ext_vector_type(16)));
typedef float f32x2v __attribute__((ext_vector_type(2)));
typedef __bf16 bf16x2v __attribute__((ext_vector_type(2)));
#define MFMA32(a, b, c) __builtin_amdgcn_mfma_f32_32x32x16_bf16((a), (b), (c), 0, 0, 0)
__device__ __forceinline__ unsigned pkbf(float a, float b) { const f32x2v v = {a, b}; const bf16x2v r = __builtin_convertvector(v, bf16x2v); return __builtin_bit_cast(unsigned, r); }
template <int CTRL> __device__ __forceinline__ float dppf(float old, float v) { return __builtin_bit_cast(float, __builtin_amdgcn_update_dpp(__builtin_bit_cast(int, old), __builtin_bit_cast(int, v), CTRL, 0xF, 0xF, false)); }
__device__ __forceinline__ f32x16 ld16(const float* p) { f32x16 r;
#pragma unroll
    for (int i = 0; i < 4; ++i) { const f32x4 v = *(const f32x4*)(p + 4 * i); r[4 * i] = v[0]; r[4 * i + 1] = v[1]; r[4 * i + 2] = v[2]; r[4 * i + 3] = v[3]; }
    return r; }
__device__ __forceinline__ bf16x8v pack8(const f32x16& x, int s) { v4u p; p.x = pkbf(x[8 * s], x[8 * s + 1]); p.y = pkbf(x[8 * s + 2], x[8 * s + 3]); p.z = pkbf(x[8 * s + 4], x[8 * s + 5]); p.w = pkbf(x[8 * s + 6], x[8 * s + 7]); return __builtin_bit_cast(bf16x8v, p); }
template <int CTRL> __device__ __forceinline__ void s5_scan_step(f32x16& xr, f32x16& xi, const f32x16& zr, const f32x16& zi) {
#pragma unroll
    for (int i = 0; i < 16; ++i) { const float sr = dppf<CTRL>(0.f, xr[i]), si = dppf<CTRL>(0.f, xi[i]);
        xr[i] += zr[i] * sr - zi[i] * si; xi[i] += zr[i] * si + zi[i] * sr; }
}
constexpr int S5L_BF1 = 0, S5L_BF2 = 4096, S5L_TOT = 12288, S5L_CAR = 20480;
template <bool SECOND>
__device__ __forceinline__ void s5_step(LAS unsigned char* L, int lane, const bf16x8v u, f32x16& hr0, f32x16& hr1, f32x16& hi0, f32x16& hi1,
                                        const f32x16& ar0, const f32x16& ar1, const f32x16& ai0, const f32x16& ai1, const float (&dk)[8], bf16* gout) {
    const LAS bf16x8v* a1 = (const LAS bf16x8v*)(L + S5L_BF1) + lane;
    { const f32x16 cr = ar0 * hr0 - ai0 * hi0, ci = ar0 * hi0 + ai0 * hr0; hr0 = MFMA32(a1[0], u, cr); hi0 = MFMA32(a1[128], u, ci); }
    asm volatile("" : "+v"(hr0), "+v"(hi0));
    { const f32x16 cr = ar1 * hr1 - ai1 * hi1, ci = ar1 * hi1 + ai1 * hr1; hr1 = MFMA32(a1[64], u, cr); hi1 = MFMA32(a1[192], u, ci); }
    if (SECOND) {
        const LAS bf16x8v* a2 = (const LAS bf16x8v*)(L + S5L_BF2) + lane;
        f32x16 y;
#pragma unroll
        for (int i = 0; i < 16; ++i) y[i] = 0.f;
        y = MFMA32(a2[0 * 64], pack8(hr0, 0), y); y = MFMA32(a2[1 * 64], pack8(hr0, 1), y);
        y = MFMA32(a2[2 * 64], pack8(hr1, 0), y); y = MFMA32(a2[3 * 64], pack8(hr1, 1), y);
        y = MFMA32(a2[4 * 64], pack8(hi0, 0), y); y = MFMA32(a2[5 * 64], pack8(hi0, 1), y);
        y = MFMA32(a2[6 * 64], pack8(hi1, 0), y); y = MFMA32(a2[7 * 64], pack8(hi1, 1), y);
        const v4u uw = __builtin_bit_cast(v4u, u);
        float o[8];
        o[0] = gelu_tanh(y[0] + dk[0] * pg8::bf_lo(uw.x)); o[1] = gelu_tanh(y[1] + dk[1] * pg8::bf_hi(uw.x));
        o[2] = gelu_tanh(y[2] + dk[2] * pg8::bf_lo(uw.y)); o[3] = gelu_tanh(y[3] + dk[3] * pg8::bf_hi(uw.y));
        o[4] = gelu_tanh(y[4] + dk[4] * pg8::bf_lo(uw.z)); o[5] = gelu_tanh(y[5] + dk[5] * pg8::bf_hi(uw.z));
        o[6] = gelu_tanh(y[6] + dk[6] * pg8::bf_lo(uw.w)); o[7] = gelu_tanh(y[7] + dk[7] * pg8::bf_hi(uw.w));
        v4u w; w.x = pkbf(o[0], o[1]); w.y = pkbf(o[2], o[3]); w.z = pkbf(o[4], o[5]); w.w = pkbf(o[6], o[7]);
        *(v4u*)gout = w;
    }
}
__device__ __forceinline__ void s5_item_fast(Frame& F, const Args& A, int b, int g) {
    const int lane = F.lane, q = lane & 31, hh = lane >> 5, w = F.wave, c = w * 32 + q;
    LAS unsigned char* L = F.lds + RING_OFF;
    const unsigned char* tab = F.ws + WS_TAB;
    {
        const v4u* s1 = (const v4u*)(tab + TB_BF1) + (size_t)g * 256; const v4u* s2 = (const v4u*)(tab + TB_BF2) + (size_t)g * 512;
        if (F.tid < 256) ((LAS v4u*)(L + S5L_BF1))[F.tid] = s1[F.tid];
        ((LAS v4u*)(L + S5L_BF2))[F.tid] = s2[F.tid];
    }
    __syncthreads();
    const float* TA = (const float*)(tab + TB_TA) + (size_t)((g * 2 + hh) * 2) * 32;
    f32x16 ar0 = ld16(TA), ar1 = ld16(TA + 16), ai0 = ld16(TA + 32), ai1 = ld16(TA + 48);
    f32x16 hr0, hr1, hi0, hi1;
#pragma unroll
    for (int i = 0; i < 16; ++i) { hr0[i] = 0.f; hr1[i] = 0.f; hi0[i] = 0.f; hi1[i] = 0.f; }
    float dk[8];
#pragma unroll
    for (int i = 0; i < 8; ++i) dk[i] = A.in[I_S5D][g * KS5 + 8 * hh + i];
    const size_t m0 = (size_t)b * TP + (size_t)8 * c;
    const bf16* zrow = (const bf16*)(F.ws + WS_Z) + m0 * NZ + 2 * WA + g * KS5 + 8 * hh;
    bf16* grow = (bf16*)(F.ws + WS_G) + m0 * WB + g * KS5 + 8 * hh;
#pragma unroll 1
    for (int j = 0; j < 8; ++j) { const bf16x8v u = *(const bf16x8v*)(zrow + (size_t)j * NZ);
        s5_step<false>(L, lane, u, hr0, hr1, hi0, hi1, ar0, ar1, ai0, ai1, dk, nullptr); }
    const float* ZP = (const float*)(tab + TB_ZP);
#define S5_SCAN(E, CTRL) do { const float* z = ZP + (size_t)(((g * 17 + (E)) * 2 + hh) * 2) * 32; \
        { const f32x16 zr = ld16(z), zi = ld16(z + 32); s5_scan_step<CTRL>(hr0, hi0, zr, zi); } \
        asm volatile("" : "+v"(hr0), "+v"(hi0) :: "memory"); \
        { const f32x16 zr = ld16(z + 16), zi = ld16(z + 48); s5_scan_step<CTRL>(hr1, hi1, zr, zi); } \
        asm volatile("" : "+v"(hr1), "+v"(hi1) :: "memory"); } while (0)
    S5_SCAN(1, 0x111); S5_SCAN(2, 0x112); S5_SCAN(4, 0x114); S5_SCAN(8, 0x118);
#undef S5_SCAN
    const int seg = w * 2 + (q >> 4);
    LAS float* TOT = (LAS float*)(L + S5L_TOT); LAS float* CAR = (LAS float*)(L + S5L_CAR);
    if ((lane & 15) == 15) {
#pragma unroll
        for (int rho = 0; rho < 4; ++rho) {
            *(LAS f32x4*)(TOT + (seg * 2 + 0) * 64 + 0 + 8 * rho + 4 * hh) = (f32x4){hr0[4 * rho], hr0[4 * rho + 1], hr0[4 * rho + 2], hr0[4 * rho + 3]};
            *(LAS f32x4*)(TOT + (seg * 2 + 0) * 64 + 32 + 8 * rho + 4 * hh) = (f32x4){hr1[4 * rho], hr1[4 * rho + 1], hr1[4 * rho + 2], hr1[4 * rho + 3]};
            *(LAS f32x4*)(TOT + (seg * 2 + 1) * 64 + 0 + 8 * rho + 4 * hh) = (f32x4){hi0[4 * rho], hi0[4 * rho + 1], hi0[4 * rho + 2], hi0[4 * rho + 3]};
            *(LAS f32x4*)(TOT + (seg * 2 + 1) * 64 + 32 + 8 * rho + 4 * hh) = (f32x4){hi1[4 * rho], hi1[4 * rho + 1], hi1[4 * rho + 2], hi1[4 * rho + 3]}; }
    }
    __syncthreads();
    if (F.tid < 64) {
        const float* z16 = (const float*)(tab + TB_Z16N) + (size_t)g * 128; const float zr = z16[F.tid], zi = z16[64 + F.tid];
        float cr = 0.f, ci = 0.f;
#pragma unroll
        for (int sg = 0; sg < 16; ++sg) { CAR[(sg * 2 + 0) * 64 + F.tid] = cr; CAR[(sg * 2 + 1) * 64 + F.tid] = ci;
            const float tr = TOT[(sg * 2 + 0) * 64 + F.tid], ti = TOT[(sg * 2 + 1) * 64 + F.tid];
            const float ncr = zr * cr - zi * ci + tr, nci = zr * ci + zi * cr + ti; cr = ncr; ci = nci; }
    }
    __syncthreads();
    {
        const float* z = ZP + (size_t)(((g * 17 + (q & 15)) * 2 + hh) * 2) * 32;
#define S5_EXCL(HR, HI, OFF) do { const f32x16 zr = ld16(z + (OFF)), zi = ld16(z + 32 + (OFF)); f32x16 kr, ki; \
        _Pragma("unroll") for (int rho = 0; rho < 4; ++rho) { \
            const f32x4 a0 = *(const LAS f32x4*)(CAR + (seg * 2 + 0) * 64 + 2 * (OFF) + 8 * rho + 4 * hh), b0 = *(const LAS f32x4*)(CAR + (seg * 2 + 1) * 64 + 2 * (OFF) + 8 * rho + 4 * hh); \
            _Pragma("unroll") for (int e = 0; e < 4; ++e) { kr[4 * rho + e] = a0[e]; ki[4 * rho + e] = b0[e]; } } \
        _Pragma("unroll") for (int i = 0; i < 16; ++i) { const float sr = dppf<0x111>(0.f, HR[i]), si = dppf<0x111>(0.f, HI[i]); \
            HR[i] = sr + zr[i] * kr[i] - zi[i] * ki[i]; HI[i] = si + zr[i] * ki[i] + zi[i] * kr[i]; } } while (0)
        S5_EXCL(hr0, hi0, 0); asm volatile("" : "+v"(hr0), "+v"(hi0) :: "memory"); S5_EXCL(hr1, hi1, 16); asm volatile("" : "+v"(hr1), "+v"(hi1) :: "memory");
#undef S5_EXCL
    }
    { int off = 0; asm volatile("" : "+v"(off)); const float* TA2 = TA + off; ar0 = ld16(TA2); ar1 = ld16(TA2 + 16); ai0 = ld16(TA2 + 32); ai1 = ld16(TA2 + 48); }
#pragma unroll 1
    for (int j = 0; j < 8; ++j) { const bf16x8v u = *(const bf16x8v*)(zrow + (size_t)j * NZ);
        s5_step<true>(L, lane, u, hr0, hr1, hi0, hi1, ar0, ar1, ai0, ai1, dk, grow + (size_t)j * WB); }
    if (w == NWAVES - 1 && q == 31) {
        float* osr = F.out + O_SRP + (size_t)(b * GB + g) * NS5; float* osi = F.out + O_SIP + (size_t)(b * GB + g) * NS5;
#pragma unroll
        for (int i = 0; i < 16; ++i) { const int n = (i & 3) + 8 * (i >> 2) + 4 * hh; osr[n] = hr0[i]; osr[32 + n] = hr1[i]; osi[n] = hi0[i]; osi[32 + n] = hi1[i]; }
    }
    __syncthreads();
}


template <int CTRL, int RMASK> __device__ __forceinline__ float dppm(float old, float v) { return __builtin_bit_cast(float, __builtin_amdgcn_update_dpp(__builtin_bit_cast(int, old), __builtin_bit_cast(int, v), CTRL, RMASK, 0xF, false)); }
template <int CTRL, int RMASK> __device__ __forceinline__ void rg_scan_step(f32x16& a, f32x16& b) {
#pragma unroll
    for (int i = 0; i < 16; ++i) { const float as = dppm<CTRL, RMASK>(1.f, a[i]), bs = dppm<CTRL, RMASK>(0.f, b[i]); b[i] = a[i] * bs + b[i]; a[i] = a[i] * as; }
}
constexpr int RGL_AFR = 0, RGL_CWT = 8192, RGL_TOT = 10240, RGL_CST = 14336;
__device__ __forceinline__ void rg_item_fast(Frame& F, const Args& A, int b, int hd, int jh) {
    const int lane = F.lane, q = lane & 31, hh = lane >> 5, w = F.wave;
    LAS unsigned char* L = F.lds + RING_OFF;
    const float* sc = (const float*)(F.ws + WS_S5C);
    {
        const v4u* src = (const v4u*)(F.ws + WS_TAB + TB_RG) + (size_t)((hd * 2 + jh) * 8) * 64;
        ((LAS v4u*)(L + RGL_AFR))[F.tid] = src[F.tid];
        if (F.tid < 320) { const int h2 = F.tid / 160, tap = (F.tid % 160) / 32, e = F.tid % 32, c = hd * 64 + 16 * (e >> 3) + 8 * h2 + (e & 7);
            ((LAS float*)(L + RGL_CWT))[F.tid] = tap < 4 ? A.in[I_CONVW][tap * WA + c] : A.in[I_CONVB][c]; }
        if (F.tid >= 384 && F.tid < 480) { const int e = F.tid - 384, h2 = e / 48, kind = (e % 48) / 16, i = e % 16, c = hd * 64 + 32 * jh + 16 * (i >> 3) + 8 * h2 + (i & 7);
            ((LAS float*)(L + RGL_CST))[e] = kind == 0 ? A.in[I_RGBR][c] : (kind == 1 ? A.in[I_RGBI][c] : sc[SC_RGL + c]); }
        if (jh == 0 && F.tid < 192) { const int k = F.tid >> 6, ch = F.tid & 63;
            F.out[O_CONVP + (size_t)(b * 3 + k) * WA + hd * 64 + ch] = bf2f(((const bf16*)(F.ws + WS_Z))[(size_t)(b * TP + TP - 3 + k) * NZ + WA + hd * 64 + ch]); }
    }
    __syncthreads();
    float hround[16];
#pragma unroll
    for (int i = 0; i < 16; ++i) hround[i] = 0.f;
    const bf16* Zb = (const bf16*)(F.ws + WS_Z) + (size_t)b * TP * NZ; bf16* Yb = (bf16*)(F.ws + WS_YCAT) + (size_t)b * TP * D;
    const LAS float* CWT = (const LAS float*)(L + RGL_CWT) + hh * 160;
#pragma unroll 1
    for (int rd = 0; rd < 8; ++rd) {
        const int t = rd * 256 + w * 32 + q;
        v4u xr[4][4];
#pragma unroll
        for (int k = 0; k < 4; ++k) { const int tk = t - 3 + k; const bf16* zr = Zb + (size_t)(tk < 0 ? 0 : tk) * NZ + WA + hd * 64 + 8 * hh;
#pragma unroll
            for (int s4 = 0; s4 < 4; ++s4) { v4u v = *(const v4u*)(zr + 16 * s4); if (tk < 0) v = (v4u){0u, 0u, 0u, 0u}; xr[k][s4] = v; } }
        const bf16* gr = Zb + (size_t)t * NZ + hd * 64 + 32 * jh + 8 * hh;
        const v4u g0 = *(const v4u*)gr, g1 = *(const v4u*)(gr + 16);
        float xc[32];
#pragma unroll
        for (int s4 = 0; s4 < 4; ++s4) {
            float acc[8];
#pragma unroll
            for (int j4 = 0; j4 < 2; ++j4) { const f32x4 cb = *(const LAS f32x4*)(CWT + 4 * 32 + s4 * 8 + 4 * j4); acc[4 * j4] = cb[0]; acc[4 * j4 + 1] = cb[1]; acc[4 * j4 + 2] = cb[2]; acc[4 * j4 + 3] = cb[3]; }
#pragma unroll
            for (int k = 0; k < 4; ++k) { const v4u v = xr[k][s4];
                const f32x4 w0 = *(const LAS f32x4*)(CWT + k * 32 + s4 * 8), w1 = *(const LAS f32x4*)(CWT + k * 32 + s4 * 8 + 4);
                acc[0] += w0[0] * pg8::bf_lo(v.x); acc[1] += w0[1] * pg8::bf_hi(v.x); acc[2] += w0[2] * pg8::bf_lo(v.y); acc[3] += w0[3] * pg8::bf_hi(v.y);
                acc[4] += w1[0] * pg8::bf_lo(v.z); acc[5] += w1[1] * pg8::bf_hi(v.z); acc[6] += w1[2] * pg8::bf_lo(v.w); acc[7] += w1[3] * pg8::bf_hi(v.w); }
#pragma unroll
            for (int e = 0; e < 8; ++e) xc[s4 * 8 + e] = acc[e];
            asm volatile("" : "+v"(xc[s4 * 8]), "+v"(xc[s4 * 8 + 7]) :: "memory");
        }
        f32x16 dr, di;
#pragma unroll
        for (int i = 0; i < 16; ++i) { dr[i] = 0.f; di[i] = 0.f; }
        const LAS bf16x8v* af = (const LAS bf16x8v*)(L + RGL_AFR) + lane;
#pragma unroll
        for (int s4 = 0; s4 < 4; ++s4) { v4u p; p.x = pkbf(xc[s4 * 8], xc[s4 * 8 + 1]); p.y = pkbf(xc[s4 * 8 + 2], xc[s4 * 8 + 3]); p.z = pkbf(xc[s4 * 8 + 4], xc[s4 * 8 + 5]); p.w = pkbf(xc[s4 * 8 + 6], xc[s4 * 8 + 7]);
            const bf16x8v bfr = __builtin_bit_cast(bf16x8v, p);
            dr = MFMA32(af[s4 * 64], bfr, dr); di = MFMA32(af[(4 + s4) * 64], bfr, di); }
        f32x16 av, bv;
        const bool first = (t == 0);
        const LAS float* CST = (const LAS float*)(L + RGL_CST) + hh * 48;
#pragma unroll
        for (int i = 0; i < 16; ++i) { const float xcv = jh ? xc[16 + i] : xc[i];
            const float r = sigmoidf_(dr[i] + CST[i]), gi = sigmoidf_(di[i] + CST[16 + i]);
            const float a = __builtin_amdgcn_exp2f(r * CST[32 + i]);
            float mult = __builtin_sqrtf(fmaxf(1.f - a * a, 0.f)); if (first) mult = 1.f;
            av[i] = a; bv[i] = mult * gi * xcv; }
        rg_scan_step<0x111, 0xF>(av, bv); rg_scan_step<0x112, 0xF>(av, bv); rg_scan_step<0x114, 0xF>(av, bv); rg_scan_step<0x118, 0xF>(av, bv);
        rg_scan_step<0x142, 0xA>(av, bv);
        LAS float* TOT = (LAS float*)(L + RGL_TOT) + (rd & 1) * 512;
        if (q == 31) {
#pragma unroll
            for (int i4 = 0; i4 < 4; ++i4) { *(LAS f32x4*)(TOT + (w * 2 + 0) * 32 + hh * 16 + 4 * i4) = (f32x4){av[4 * i4], av[4 * i4 + 1], av[4 * i4 + 2], av[4 * i4 + 3]};
                                             *(LAS f32x4*)(TOT + (w * 2 + 1) * 32 + hh * 16 + 4 * i4) = (f32x4){bv[4 * i4], bv[4 * i4 + 1], bv[4 * i4 + 2], bv[4 * i4 + 3]}; }
        }
        __syncthreads();
        float hin[16];
#pragma unroll
        for (int i = 0; i < 16; ++i) hin[i] = 0.f;
#pragma unroll
        for (int w2 = 0; w2 < 8; ++w2) {
            if (w2 == w) {
#pragma unroll
                for (int i = 0; i < 16; ++i) hin[i] = hround[i]; }
#pragma unroll
            for (int i4 = 0; i4 < 4; ++i4) { const f32x4 p = *(const LAS f32x4*)(TOT + (w2 * 2 + 0) * 32 + hh * 16 + 4 * i4), hl = *(const LAS f32x4*)(TOT + (w2 * 2 + 1) * 32 + hh * 16 + 4 * i4);
#pragma unroll
                for (int e = 0; e < 4; ++e) hround[4 * i4 + e] = p[e] * hround[4 * i4 + e] + hl[e]; }
        }
        float o[16];
        const unsigned gw_[8] = {g0.x, g0.y, g0.z, g0.w, g1.x, g1.y, g1.z, g1.w};
#pragma unroll
        for (int i = 0; i < 16; ++i) { const float h = bv[i] + av[i] * hin[i]; const float gt = (i & 1) ? pg8::bf_hi(gw_[i >> 1]) : pg8::bf_lo(gw_[i >> 1]); o[i] = gelu_tanh(gt) * h; }
        bf16* yr = Yb + (size_t)t * D + hd * 64 + 32 * jh + 8 * hh;
        v4u w0; w0.x = pkbf(o[0], o[1]); w0.y = pkbf(o[2], o[3]); w0.z = pkbf(o[4], o[5]); w0.w = pkbf(o[6], o[7]);
        v4u w1; w1.x = pkbf(o[8], o[9]); w1.y = pkbf(o[10], o[11]); w1.z = pkbf(o[12], o[13]); w1.w = pkbf(o[14], o[15]);
        *(v4u*)yr = w0; *(v4u*)(yr + 16) = w1;
    }
    if (w == 0 && q == 0) {
#pragma unroll
        for (int i = 0; i < 16; ++i) F.out[O_HP + (size_t)b * WA + hd * 64 + 32 * jh + 16 * (i >> 3) + 8 * hh + (i & 7)] = hround[i];
    }
    __syncthreads();
}

__device__ __forceinline__ void p3_mixers_ref(Frame& F, const Args& A) {
    LAS float* scr = (LAS float*)(F.lds + RING_OFF + F.wave * 1024);
    const int gw = F.wave * F.G + F.vcu, NGW = F.G * NWAVES;
    constexpr int N_RGP = NBP * HA, N_S5P = NBP * GB, N_RGS = NBS * HA, N_S5S = NBS * GB;
    if (F.vcu < N_S5P) s5_item_fast(F, A, F.vcu / GB, F.vcu % GB);
    for (int it = F.vcu + F.G; it < N_S5P; it += F.G) { for (int wv = F.wave; wv < 1; wv += NWAVES) s5_item_ref(F, A, true, it / GB, it % GB, scr); }
    if (F.vcu < 2 * N_RGP) rg_item_fast(F, A, F.vcu / (2 * HA), (F.vcu / 2) % HA, F.vcu & 1);
    for (int it = F.vcu + F.G; it < 2 * N_RGP; it += F.G) { if ((it & 1) == 0) for (int wv = F.wave; wv < 1; wv += NWAVES) rg_item_ref(F, A, true, it / (2 * HA), (it / 2) % HA, scr); }
    for (int it = gw; it < N_RGS + N_S5S; it += NGW) {
        int r = it;
        if (r < N_RGS) { rg_item_ref(F, A, false, r / HA, r % HA, scr); continue; } r -= N_RGS;
        s5_item_ref(F, A, false, r / GB, r % GB, scr);
    }
}

__global__ void __launch_bounds__(NWAVES * 64, 2) fwd(Args A) {
    extern __shared__ __attribute__((aligned(16))) unsigned char lds[];
    Frame F;
    F.lds = (LAS unsigned char*)lds;
    F.MISC = (volatile LAS unsigned*)(F.lds + MISC_OFF);
    F.tid = threadIdx.x; F.lane = F.tid & 63; F.wave = __builtin_amdgcn_readfirstlane(F.tid >> 6);
    F.G = gridDim.x; { const int bx = blockIdx.x; F.vcu = (F.G % 8 == 0) ? (bx % 8) * (F.G / 8) + bx / 8 : bx; }
    F.out = A.out; F.ws = A.ws; F.ctl = (gu32*)(A.ws + WS_CTL);
    for (int u = F.tid; u < (LDS_BYTES - LDSCTL_OFF) / 4; u += NWAVES * 64) ((LAS unsigned*)(F.lds + LDSCTL_OFF))[u] = 0u;
    __syncthreads();
    XcdBarrier bar; bar.bar = (unsigned*)(F.ctl + CW_BAR); bar.x = 0; bar.st = nullptr;
    if (N_LAUNCHES == 1) bar = xcd_barrier_post((unsigned*)(F.ctl + CW_BAR), F.MISC + 8);
#define GRID_BAR() do { if (N_LAUNCHES == 1) xcd_barrier(bar); } while (0)
    const int lo = A.ph_lo, hi = A.ph_hi;
#define IN(k) (lo <= (k) && (k) < hi)
#define BOTH(k) (IN(k) && IN((k) + 1))
    bf16* XN = (bf16*)(F.ws + WS_XN); bf16* Z = (bf16*)(F.ws + WS_Z); bf16* YC = (bf16*)(F.ws + WS_YCAT); bf16* GY = (bf16*)(F.ws + WS_G); bf16* U = (bf16*)(F.ws + WS_U);
    const float* mod = (const float*)(F.ws + WS_MOD);

    if (IN(0)) { p0_prologue(F, A); if (BOTH(0)) GRID_BAR(); }
    if (IN(1)) { p1_modulate(F, A); if (BOTH(1)) GRID_BAR(); }
    if (IN(2)) {
        pg8::Gemm g{XN, (const bf16*)(F.ws + WS_WIN), M, NZ, D}; pg8::StaticOrder S; S.init(M, NZ, F.G, (int)blockIdx.x);
        pg8::EpiBf16<0> E{Z, NZ, nullptr};
        pg8::gemm_phase<pg8::EpiBf16<0>, pg8::StaticOrder, PG8_ALIGN, PG8_SP2>(F.lds + RING_OFF, g, S, E);
        if (BOTH(2)) GRID_BAR();
    }
    if (IN(3)) { p3_mixers_ref(F, A); if (BOTH(3)) GRID_BAR(); }
    if (IN(4)) {
        pg8::Gemm g{GY, (const bf16*)(F.ws + WS_WGLU), M, WB, WB}; pg8::StaticOrder S; S.init(M, WB, F.G, (int)blockIdx.x);
        pg8::EpiGlu E{GY, WB, YC, D, WA, A.in[I_GLUB]};
        pg8::gemm_phase<pg8::EpiGlu, pg8::StaticOrder, PG8_ALIGN, PG8_SP2>(F.lds + RING_OFF, g, S, E);
        if (BOTH(4)) GRID_BAR();
    }
    if (IN(5)) {
        pg8::Gemm g{YC, (const bf16*)(F.ws + WS_WOUT), M, D, D}; pg8::StaticOrder S; S.init(M, D, F.G, (int)blockIdx.x);
        pg8::EpiRes E{A.in[I_XP], A.in[I_XS], F.out, mod + 2 * D, nullptr, ALPHA, MP};
        pg8::gemm_phase<pg8::EpiRes, pg8::StaticOrder, PG8_ALIGN, PG8_SP2>(F.lds + RING_OFF, g, S, E);
        if (BOTH(5)) GRID_BAR();
    }
    if (IN(6)) { ln_rows<false>(F, A); if (BOTH(6)) GRID_BAR(); }
    if (IN(7)) {
        pg8::Gemm g{XN, (const bf16*)(F.ws + WS_W1), M, FF, D}; pg8::StaticOrder S; S.init(M, FF, F.G, (int)blockIdx.x);
        pg8::EpiBf16<3> E{U, FF, A.in[I_B1]};
        pg8::gemm_phase<pg8::EpiBf16<3>, pg8::StaticOrder, PG8_ALIGN, PG8_SP2>(F.lds + RING_OFF, g, S, E);
        if (BOTH(7)) GRID_BAR();
    }
    if (IN(8)) {
        pg8::Gemm g{U, (const bf16*)(F.ws + WS_W2), M, D, FF}; pg8::StaticOrder S; S.init(M, D, F.G, (int)blockIdx.x);
        pg8::EpiRes E{F.out, F.out + (size_t)MP * D, F.out, mod + 5 * D, A.in[I_B2], ALPHA, MP};
        pg8::gemm_phase<pg8::EpiRes, pg8::StaticOrder, PG8_ALIGN, PG8_SP2>(F.lds + RING_OFF, g, S, E);
        if (BOTH(8)) GRID_BAR();
    }
    if (IN(9)) { ln_rows<true>(F, A); }
#undef IN
#undef BOTH
}

extern "C" void kernel_launch(void* const* d_in, const int* in_sizes, int n_in, void* d_out, int out_size, void* d_ws, size_t ws_size, hipStream_t stream) {
    static int grid = 0;
    if (grid == 0) {
        if (n_in != 37 || in_sizes[0] != MP * D || out_size != (int)O_END || ws_size < WS_END) { fprintf(stderr, "kernel_launch: unexpected shapes (n_in %d, in0 %d, out %d, ws %zu)\n", n_in, n_in > 0 ? in_sizes[0] : -1, out_size, ws_size); grid = -1; return; }
        int dev = 0, cus = 0, per_cu = 0;
        if (hipGetDevice(&dev) != hipSuccess || hipDeviceGetAttribute(&cus, hipDeviceAttributeMultiprocessorCount, dev) != hipSuccess) { grid = -1; return; }
        if (hipFuncSetAttribute((const void*)fwd, hipFuncAttributeMaxDynamicSharedMemorySize, LDS_BYTES) != hipSuccess) { fprintf(stderr, "kernel_launch: hipFuncSetAttribute failed\n"); grid = -1; return; }
        if (hipOccupancyMaxActiveBlocksPerMultiprocessor(&per_cu, (const void*)fwd, NWAVES * 64, LDS_BYTES) != hipSuccess || per_cu < 1) { fprintf(stderr, "kernel_launch: occupancy query says %d\n", per_cu); }
        (void)hipGetLastError();
        grid = cus;
    }
    if (grid < 0) return;
    (void)hipMemsetAsync((char*)d_ws + WS_CTL, 0, CTL_ZERO_BYTES, stream);
    Args a{};
    for (int i = 0; i < 37; ++i) a.in[i] = (const float*)d_in[i];
    a.out = (float*)d_out; a.ws = (unsigned char*)d_ws;
    for (int li = 0; li < N_LAUNCHES; ++li) {
        if (N_LAUNCHES == 1) { a.ph_lo = 0; a.ph_hi = N_PHASES; } else { a.ph_lo = li; a.ph_hi = li + 1; }
        a.li = li;
        hipLaunchKernelGGL(fwd, dim3(grid), dim3(NWAVES * 64), LDS_BYTES, stream, a);
    }
}
```

```cpp
#include <hip/hip_runtime.h>
#include <cstdio>
#include <cstdint>
#include <cmath>

#ifndef MK_N_LAUNCHES
#define MK_N_LAUNCHES 1
#endif

namespace pg8 {
#define PG8_LAS __attribute__((address_space(3)))
typedef unsigned short bf16_t;
typedef short bf16x8 __attribute__((ext_vector_type(8)));
typedef float f32x4 __attribute__((ext_vector_type(4)));
typedef unsigned u32x4 __attribute__((ext_vector_type(4)));
constexpr int BM = 256, BK = 64, HALF = 128, HTB = HALF * BK * 2, STAGE_BYTES = 8 * HTB, NXCD = 8, WGM = 8;

__host__ __device__ __forceinline__ int lds_byte(int r, int c) { const int st = (r >> 4) * 2 + (c >> 5), rr = r & 15, cc = c & 31, ob = rr * 64 + cc * 2; return st * 1024 + (ob ^ (((ob >> 9) & 1) << 5)); }
__host__ __device__ __forceinline__ void stage_rc(int b, int& R, int& C) { const int st = b / 1024, sb = b % 1024, swz = sb ^ (((sb >> 9) & 1) << 5); R = (st >> 1) * 16 + swz / 64; C = (st & 1) * 32 + (swz % 64) / 2; }
__host__ __device__ __forceinline__ int perm32(int rho) { const int n = rho >> 4, i = rho & 15; return 8 * (i >> 2) + 4 * n + (i & 3); }

struct Unit { int pm, pn; };
struct Gemm { const bf16_t* A; const bf16_t* Bt; int M, N, K; };

struct StaticOrder {
    int nM, nN, nwg, G, c;
    __host__ __device__ void init(int M, int N, int G_, int c_) { nM = M / BM; nN = N / BM; nwg = nM * nN; G = G_; c = c_; }
    __host__ __device__ bool next(int i, Unit& u) const {
        const long L = (long)i * G + c; if (L >= nwg) return false;
        int wgid = (int)L; { const int q = nwg / NXCD, r = nwg % NXCD, xcd = wgid % NXCD, off = wgid / NXCD; wgid = (xcd < r ? xcd * (q + 1) : r * (q + 1) + (xcd - r) * q) + off; }
        const int nig = WGM * nN, gid = wgid / nig, fm = gid * WGM, gsz = (nM - fm) < WGM ? (nM - fm) : WGM;
        u.pm = fm + ((wgid % nig) % gsz); u.pn = (wgid % nig) / gsz; return true;
    }
    __device__ __forceinline__ void a_ready(const Unit&) const {}
    __device__ __forceinline__ void done(const Unit&) const {}
};

__device__ __forceinline__ unsigned cvt_pk_bf16(float lo, float hi) { unsigned r; asm volatile("v_cvt_pk_bf16_f32 %0, %1, %2" : "=v"(r) : "v"(lo), "v"(hi)); return r; }
__device__ __forceinline__ float bf_lo(unsigned w) { return __builtin_bit_cast(float, w << 16); }
__device__ __forceinline__ float bf_hi(unsigned w) { return __builtin_bit_cast(float, w & 0xffff0000u); }

template <int ACT> struct EpiBf16 {
    static constexpr bool PERM = true, AFTER_DRAIN = false;
    bf16_t* O; int ldc; const float* bias;
    __device__ __forceinline__ void operator()(const f32x4 (&acc)[2][2][4][2], const Unit& u, int wr, int wc, int fr, int fq) const {
        const int row0 = u.pm * BM + wr * 64 + fr; const int col0 = u.pn * BM + wc * 32 + 8 * fq;
        f32x4 bv[2][2];
#pragma unroll
        for (int bj = 0; bj < 2; ++bj)
#pragma unroll
            for (int n = 0; n < 2; ++n) bv[bj][n] = bias ? *(const f32x4*)(bias + col0 + bj * HALF + 4 * n) : (f32x4){0.f, 0.f, 0.f, 0.f};
#pragma unroll
        for (int ai = 0; ai < 2; ++ai)
#pragma unroll
            for (int m = 0; m < 4; ++m) { bf16_t* rowp = O + (size_t)(row0 + ai * HALF + m * 16) * ldc + col0;
#pragma unroll
                for (int bj = 0; bj < 2; ++bj) { f32x4 v0 = acc[ai][bj][m][0] + bv[bj][0], v1 = acc[ai][bj][m][1] + bv[bj][1];
                    if (ACT == 3) {
#pragma unroll
                        for (int e = 0; e < 4; ++e) { const float a = fmaxf(v0[e], 0.f), b = fmaxf(v1[e], 0.f); v0[e] = a * a; v1[e] = b * b; } }
                    u32x4 w; w.x = cvt_pk_bf16(v0[0], v0[1]); w.y = cvt_pk_bf16(v0[2], v0[3]); w.z = cvt_pk_bf16(v1[0], v1[1]); w.w = cvt_pk_bf16(v1[2], v1[3]);
                    *(u32x4*)(rowp + bj * HALF) = w; } }
    }
};
struct EpiGlu {
    static constexpr bool PERM = true, AFTER_DRAIN = false;
    const bf16_t* Gy; int ldg; bf16_t* O; int ldc; int coff; const float* bias;
    __device__ __forceinline__ void operator()(const f32x4 (&acc)[2][2][4][2], const Unit& u, int wr, int wc, int fr, int fq) const {
        const int row0 = u.pm * BM + wr * 64 + fr; const int col0 = u.pn * BM + wc * 32 + 8 * fq;
        f32x4 bv[2][2];
#pragma unroll
        for (int bj = 0; bj < 2; ++bj)
#pragma unroll
            for (int n = 0; n < 2; ++n) bv[bj][n] = *(const f32x4*)(bias + col0 + bj * HALF + 4 * n);
#pragma unroll
        for (int ai = 0; ai < 2; ++ai)
#pragma unroll
            for (int m = 0; m < 4; ++m) { const size_t row = (size_t)(row0 + ai * HALF + m * 16);
#pragma unroll
                for (int bj = 0; bj < 2; ++bj) { const f32x4 v0 = acc[ai][bj][m][0] + bv[bj][0], v1 = acc[ai][bj][m][1] + bv[bj][1];
                    const u32x4 g = *(const u32x4*)(Gy + row * ldg + col0 + bj * HALF);
                    float o[8];
                    o[0] = bf_lo(g.x) * __builtin_amdgcn_rcpf(1.f + __builtin_amdgcn_exp2f(-1.4426950408889634f * v0[0])); o[1] = bf_hi(g.x) * __builtin_amdgcn_rcpf(1.f + __builtin_amdgcn_exp2f(-1.4426950408889634f * v0[1]));
                    o[2] = bf_lo(g.y) * __builtin_amdgcn_rcpf(1.f + __builtin_amdgcn_exp2f(-1.4426950408889634f * v0[2])); o[3] = bf_hi(g.y) * __builtin_amdgcn_rcpf(1.f + __builtin_amdgcn_exp2f(-1.4426950408889634f * v0[3]));
                    o[4] = bf_lo(g.z) * __builtin_amdgcn_rcpf(1.f + __builtin_amdgcn_exp2f(-1.4426950408889634f * v1[0])); o[5] = bf_hi(g.z) * __builtin_amdgcn_rcpf(1.f + __builtin_amdgcn_exp2f(-1.4426950408889634f * v1[1]));
                    o[6] = bf_lo(g.w) * __builtin_amdgcn_rcpf(1.f + __builtin_amdgcn_exp2f(-1.4426950408889634f * v1[2])); o[7] = bf_hi(g.w) * __builtin_amdgcn_rcpf(1.f + __builtin_amdgcn_exp2f(-1.4426950408889634f * v1[3]));
                    u32x4 w; w.x = cvt_pk_bf16(o[0], o[1]); w.y = cvt_pk_bf16(o[2], o[3]); w.z = cvt_pk_bf16(o[4], o[5]); w.w = cvt_pk_bf16(o[6], o[7]);
                    *(u32x4*)(O + row * ldc + coff + col0 + bj * HALF) = w; } }
    }
};
struct EpiRes {
    static constexpr bool PERM = false, AFTER_DRAIN = false;
    const float* basep; const float* bases; float* out; const float* gate  ; const float* bias; float alpha; int MP;
    __device__ __forceinline__ void operator()(const f32x4 (&acc)[2][2][4][2], const Unit& u, int wr, int wc, int fr, int fq) const {
        const int row0 = u.pm * BM + wr * 64 + fr, col0 = u.pn * BM + wc * 32 + 4 * fq;
        f32x4 bv[2][2];
#pragma unroll
        for (int bj = 0; bj < 2; ++bj)
#pragma unroll
            for (int n = 0; n < 2; ++n) bv[bj][n] = bias ? *(const f32x4*)(bias + col0 + bj * HALF + n * 16) : (f32x4){0.f, 0.f, 0.f, 0.f};
#pragma unroll
        for (int ai = 0; ai < 2; ++ai)
#pragma unroll
            for (int m = 0; m < 4; ++m) { const int row = row0 + ai * HALF + m * 16;
                const bool smp = row >= MP; const int mr = smp ? 8 + ((row - MP) >> 2) : (row >> 11);
                const float* bp = smp ? bases + (size_t)(row - MP) * 1024 : basep + (size_t)row * 1024;
                const float* gp = gate + (size_t)mr * 6144; float* op = out + (size_t)row * 1024;
#pragma unroll
                for (int bj = 0; bj < 2; ++bj)
#pragma unroll
                    for (int n = 0; n < 2; ++n) { const int c = col0 + bj * HALF + n * 16;
                        const f32x4 b = *(const f32x4*)(bp + c), g = *(const f32x4*)(gp + c);
                        *(f32x4*)(op + c) = b * alpha + g * (acc[ai][bj][m][n] + bv[bj][n]); } }
    }
};

template <class Epi, class Sched, bool ALIGN_EPI = false, bool SP2 = false>
__device__ __forceinline__ void gemm_phase(PG8_LAS unsigned char* lds, const Gemm g, const Sched& S, const Epi& E) {
    const int tid = threadIdx.x, wid = __builtin_amdgcn_readfirstlane(tid >> 6), lane = tid & 63, wr = wid >> 2, wc = wid & 3, fr = lane & 15, fq = lane >> 4;
    const int K = g.K, nt = K / BK;
    unsigned voffA[2], voffB[2];
#pragma unroll
    for (int i = 0; i < 2; ++i) { int R, C; stage_rc(tid * 16 + i * 8192, R, C); const int Rb = Epi::PERM ? ((R & ~31) + perm32(R & 31)) : R;
        voffA[i] = (unsigned)(R * K + C) * 2u; voffB[i] = (unsigned)(Rb * K + C) * 2u; }
    const size_t kstep = (size_t)(BK * 2);
    const size_t hstep = (size_t)HALF * K * 2;
    const size_t tstep = 2 * hstep;
    const unsigned ldsw = (unsigned)wid * 1024u;
    const int aoff = lds_byte(wr * 64 + fr, fq * 8), boff = lds_byte(wc * 32 + fr, fq * 8);
#define PG8_SA(b, h) (((b) * 2 + (h)) * HTB)
#define PG8_SB(b, h) ((4 + (b) * 2 + (h)) * HTB)
#define PG8_STAGE(bufoff, gbase, voff) do { _Pragma("unroll") for (int _i = 0; _i < 2; ++_i) \
        __builtin_amdgcn_global_load_lds((const unsigned*)((const char*)(gbase) + (voff)[_i]), (PG8_LAS unsigned*)(lds + (bufoff) + ldsw + _i * 8192), 16, 0, 0); } while (0)
#define PG8_LDA(dst, b, h) do { _Pragma("unroll") for (int m = 0; m < 4; ++m) _Pragma("unroll") for (int k = 0; k < 2; ++k) dst[m][k] = *(const PG8_LAS bf16x8*)(lds + PG8_SA(b, h) + aoff + m * 2048 + k * 1024); } while (0)
#define PG8_LDB(dst, b, h) do { _Pragma("unroll") for (int n = 0; n < 2; ++n) _Pragma("unroll") for (int k = 0; k < 2; ++k) dst[n][k] = *(const PG8_LAS bf16x8*)(lds + PG8_SB(b, h) + boff + n * 2048 + k * 1024); } while (0)
#define PG8_MMA(ai, bj, At, Bt) do { __builtin_amdgcn_s_setprio(1); _Pragma("unroll") for (int m = 0; m < 4; ++m) _Pragma("unroll") for (int n = 0; n < 2; ++n) _Pragma("unroll") for (int k = 0; k < 2; ++k) \
        acc[ai][bj][m][n] = __builtin_amdgcn_mfma_f32_16x16x32_bf16(Bt[n][k], At[m][k], acc[ai][bj][m][n], 0, 0, 0); __builtin_amdgcn_s_setprio(0); } while (0)
#define PG8_WAIT_V(n) asm volatile("s_waitcnt vmcnt(" #n ")" ::: "memory")
#define PG8_WAIT_L(n) asm volatile("s_waitcnt lgkmcnt(" #n ")" ::: "memory")
#define PG8_BAR __builtin_amdgcn_s_barrier()
#define PG8_SCHED __builtin_amdgcn_sched_barrier(0)
    Unit cur, nxt; int ui = 0;
    if (!S.next(0, cur)) return;
    f32x4 acc[2][2][4][2];
#pragma unroll
    for (int a = 0; a < 2; ++a)
#pragma unroll
        for (int b = 0; b < 2; ++b)
#pragma unroll
            for (int m = 0; m < 4; ++m)
#pragma unroll
                for (int n = 0; n < 2; ++n) acc[a][b][m][n] = (f32x4){0.f, 0.f, 0.f, 0.f};
    bf16x8 At[4][2], B0[2][2], B1[2][2];
    const char* cA = (const char*)g.A + (size_t)cur.pm * tstep; const char* cB = (const char*)g.Bt + (size_t)cur.pn * tstep;
    S.a_ready(cur);
    if constexpr (SP2) {
        PG8_STAGE(PG8_SB(0, 0), cB, voffB); PG8_STAGE(PG8_SB(0, 1), cB + hstep, voffB); PG8_STAGE(PG8_SA(0, 0), cA, voffA); PG8_STAGE(PG8_SA(0, 1), cA + hstep, voffA);
        if (wr == 1) PG8_BAR;
        PG8_WAIT_V(2); PG8_BAR;
        PG8_STAGE(PG8_SB(1, 0), cB + kstep, voffB); PG8_STAGE(PG8_SA(1, 0), cA + kstep, voffA); PG8_STAGE(PG8_SB(1, 1), cB + hstep + kstep, voffB);
        PG8_WAIT_V(6); PG8_BAR;
    } else {
        PG8_STAGE(PG8_SB(0, 0), cB, voffB); PG8_STAGE(PG8_SA(0, 0), cA, voffA); PG8_STAGE(PG8_SB(0, 1), cB + hstep, voffB); PG8_STAGE(PG8_SA(0, 1), cA + hstep, voffA);
        if (wr == 1) PG8_BAR;
        PG8_WAIT_V(4); PG8_BAR;
        PG8_STAGE(PG8_SB(1, 0), cB + kstep, voffB); PG8_STAGE(PG8_SA(1, 0), cA + kstep, voffA); PG8_STAGE(PG8_SB(1, 1), cB + hstep + kstep, voffB);
        PG8_WAIT_V(6); PG8_BAR;
    }
    for (;;) {
        const bool has_next = S.next(ui + 1, nxt);
        const char* nA = has_next ? (const char*)g.A + (size_t)nxt.pm * tstep : cA; const char* nB = has_next ? (const char*)g.Bt + (size_t)nxt.pn * tstep : cB;
        for (int t = 0; t < nt; t += 2) {
            const bool last = (t == nt - 2);
            const char* a1 = cA + (size_t)(t + 1) * kstep;
            const char* a2 = last ? nA : cA + (size_t)(t + 2) * kstep; const char* b2 = last ? nB : cB + (size_t)(t + 2) * kstep;
            const char* a3 = a2 + kstep; const char* b3 = b2 + kstep;
            if (last && has_next) S.a_ready(nxt);
            if constexpr (SP2) {
            PG8_LDB(B0, 0, 0); PG8_LDB(B1, 0, 1); PG8_SCHED; PG8_LDA(At, 0, 0); PG8_STAGE(PG8_SA(1, 1), a1 + hstep, voffA);
            PG8_WAIT_V(8); PG8_WAIT_L(0); PG8_BAR; PG8_MMA(0, 0, At, B0); PG8_MMA(0, 1, At, B1); PG8_BAR; PG8_SCHED;
            PG8_LDA(At, 0, 1); PG8_STAGE(PG8_SB(0, 0), b2, voffB); PG8_STAGE(PG8_SB(0, 1), b2 + hstep, voffB); PG8_STAGE(PG8_SA(0, 0), a2, voffA);
            PG8_WAIT_V(8); PG8_WAIT_L(0); PG8_BAR; PG8_MMA(1, 0, At, B0); PG8_MMA(1, 1, At, B1); PG8_BAR; PG8_SCHED;
            PG8_LDB(B0, 1, 0); PG8_LDB(B1, 1, 1); PG8_SCHED; PG8_LDA(At, 1, 0); PG8_STAGE(PG8_SA(0, 1), a2 + hstep, voffA);
            PG8_WAIT_V(8); PG8_WAIT_L(0); PG8_BAR; PG8_MMA(0, 0, At, B0); PG8_MMA(0, 1, At, B1); PG8_BAR; PG8_SCHED;
            PG8_LDA(At, 1, 1); PG8_STAGE(PG8_SB(1, 0), b3, voffB); PG8_STAGE(PG8_SB(1, 1), b3 + hstep, voffB); PG8_STAGE(PG8_SA(1, 0), a3, voffA);
            PG8_WAIT_V(8); PG8_WAIT_L(0); PG8_BAR; PG8_MMA(1, 0, At, B0); PG8_MMA(1, 1, At, B1); PG8_BAR; PG8_SCHED;
            } else {
            PG8_LDB(B0, 0, 0); PG8_SCHED; PG8_LDA(At, 0, 0); PG8_STAGE(PG8_SA(1, 1), a1 + hstep, voffA);
            PG8_WAIT_L(8); PG8_BAR; PG8_WAIT_L(0); PG8_MMA(0, 0, At, B0); PG8_BAR; PG8_SCHED;
            PG8_LDB(B1, 0, 1); PG8_STAGE(PG8_SB(0, 0), b2, voffB);
            PG8_BAR; PG8_WAIT_L(0); PG8_MMA(0, 1, At, B1); PG8_BAR;
            PG8_LDA(At, 0, 1); PG8_STAGE(PG8_SA(0, 0), a2, voffA);
            PG8_BAR; PG8_WAIT_L(0); PG8_MMA(1, 0, At, B0); PG8_BAR; PG8_SCHED;
            PG8_STAGE(PG8_SB(0, 1), b2 + hstep, voffB);
            PG8_WAIT_V(6); PG8_BAR; PG8_MMA(1, 1, At, B1); PG8_BAR;
            PG8_LDB(B0, 1, 0); PG8_SCHED; PG8_LDA(At, 1, 0); PG8_STAGE(PG8_SA(0, 1), a2 + hstep, voffA);
            PG8_WAIT_L(8); PG8_BAR; PG8_WAIT_L(0); PG8_MMA(0, 0, At, B0); PG8_BAR; PG8_SCHED;
            PG8_LDB(B1, 1, 1); PG8_STAGE(PG8_SB(1, 0), b3, voffB);
            PG8_BAR; PG8_WAIT_L(0); PG8_MMA(0, 1, At, B1); PG8_BAR;
            PG8_LDA(At, 1, 1); PG8_STAGE(PG8_SA(1, 0), a3, voffA);
            PG8_BAR; PG8_WAIT_L(0); PG8_MMA(1, 0, At, B0); PG8_BAR; PG8_SCHED;
            PG8_STAGE(PG8_SB(1, 1), b3 + hstep, voffB);
            PG8_WAIT_V(6); PG8_BAR; PG8_MMA(1, 1, At, B1); PG8_BAR;
            }
        }
        if constexpr (ALIGN_EPI) { if (wr == 0) PG8_BAR; }
        if constexpr (!Epi::AFTER_DRAIN) { E(acc, cur, wr, wc, fr, fq); S.done(cur); }
        if (!has_next) break;
#pragma unroll
        for (int a = 0; a < 2; ++a)
#pragma unroll
            for (int b = 0; b < 2; ++b)
#pragma unroll
                for (int m = 0; m < 4; ++m)
#pragma unroll
                    for (int n = 0; n < 2; ++n) acc[a][b][m][n] = (f32x4){0.f, 0.f, 0.f, 0.f};
        cur = nxt; cA = nA; cB = nB; ++ui;
        if constexpr (ALIGN_EPI) { if (wr == 1) PG8_BAR; }
    }
    PG8_WAIT_V(0);
    if constexpr (!ALIGN_EPI) { if (wr == 0) PG8_BAR; }
    PG8_BAR;
#undef PG8_SA
#undef PG8_SB
#undef PG8_STAGE
#undef PG8_LDA
#undef PG8_LDB
#undef PG8_MMA
#undef PG8_WAIT_V
#undef PG8_WAIT_L
#undef PG8_BAR
#undef PG8_SCHED
}
}

#ifndef PROBE_DUP
#define PROBE_DUP 0
#endif
#ifndef PG8_SP2
#define PG8_SP2 true
#endif
#ifndef PG8_ALIGN
#define PG8_ALIGN true
#endif

constexpr int NWAVES = 8;
constexpr int N_LAUNCHES = MK_N_LAUNCHES;
constexpr int N_PHASES = 10;
constexpr int D = 1024, MP = 16384, MS = 512, M = MP + MS, TP = 2048, NBP = 8, NBS = 128, TS = 4;
constexpr int NZ = 1536, WA = 512, WB = 512, FF = 4096, NMOD = 6 * D, NROWMOD = NBP + NBS;
constexpr int GB = 32, NS5 = 64, KS5 = 16, HA = 8, HDA = 64;
constexpr float LN_EPS = 1e-5f;
constexpr float ALPHA = 1.189207115002721f;

constexpr size_t O_YP = 0, O_YS = (size_t)MP * D, O_CONVP = O_YS + (size_t)MS * D, O_HP = O_CONVP + (size_t)NBP * 3 * WA, O_SRP = O_HP + (size_t)NBP * WA,
                 O_SIP = O_SRP + (size_t)NBP * GB * NS5, O_CONVS = O_SIP + (size_t)NBP * GB * NS5, O_HS = O_CONVS + (size_t)NBS * 3 * WA, O_SRS = O_HS + (size_t)NBS * WA,
                 O_SIS = O_SRS + (size_t)NBS * GB * NS5, O_END = O_SIS + (size_t)NBS * GB * NS5;

constexpr size_t MiB = 1u << 20;
constexpr size_t WS_CTL = 0, CTL_ZERO_BYTES = 1 * MiB;
constexpr size_t WS_WIN = 1 * MiB, WS_WGLU = 4 * MiB, WS_WOUT = 5 * MiB, WS_W1 = 7 * MiB, WS_W2 = 15 * MiB;
constexpr size_t WS_MOD = 23 * MiB;
constexpr size_t WS_S5C = 27 * MiB;
constexpr size_t WS_XN = 28 * MiB;
constexpr size_t WS_Z = 61 * MiB;
constexpr size_t WS_YCAT = 111 * MiB;
constexpr size_t WS_G = 144 * MiB;
constexpr size_t WS_U = 61 * MiB;
constexpr size_t WS_TAB = 194 * MiB;
constexpr size_t WS_END = 196 * MiB;
constexpr size_t TB_BF1 = 0, TB_BF2 = TB_BF1 + 32 * 4 * 64 * 16, TB_TA = TB_BF2 + 32 * 8 * 64 * 16, TB_ZP = TB_TA + 32 * 2 * 2 * 32 * 4, TB_Z16N = TB_ZP + 32 * 17 * 2 * 2 * 32 * 4,
                 TB_RG = TB_Z16N + 32 * 2 * 64 * 4, TB_END = TB_RG + 8 * 2 * 2 * 4 * 64 * 16;
static_assert(WS_TAB + TB_END <= WS_END, "tables");
static_assert(WS_XN + (size_t)M * D * 2 <= WS_Z && WS_Z + (size_t)M * NZ * 2 <= WS_YCAT && WS_YCAT + (size_t)M * D * 2 <= WS_G && WS_G + (size_t)M * WB * 2 <= WS_END && WS_U + (size_t)M * FF * 2 <= WS_TAB, "d_ws map");
constexpr int SC_ABR = 0, SC_ABI = 2048, SC_BBR = 4096, SC_BBI = 4096 + 32768, SC_RGL = 4096 + 65536, SC_END = SC_RGL + 512;
constexpr int CW_TMO = 0, CW_CODE = 1, CW_BAR = 4096;

constexpr int RING_OFF = 0, RING_BYTES = 131072;
constexpr int LDSCTL_OFF = RING_BYTES, MISC_OFF = LDSCTL_OFF + 320;
constexpr int LDS_BYTES = 147456;

#define GAS __attribute__((address_space(1)))
#define LAS __attribute__((address_space(3)))
typedef unsigned short bf16;
typedef unsigned v4u __attribute__((ext_vector_type(4)));
typedef float f32x4 __attribute__((ext_vector_type(4)));
typedef GAS unsigned gu32;
#define RLX_AGENT __ATOMIC_RELAXED, __HIP_MEMORY_SCOPE_AGENT
#define LDS_WAIT() asm volatile("s_waitcnt lgkmcnt(0)" ::: "memory")
#define VM_WAIT() asm volatile("s_waitcnt vmcnt(0)" ::: "memory")
__device__ __forceinline__ unsigned f2bf(float f) { unsigned u = __builtin_bit_cast(unsigned, f); return (u + 0x7fffu + ((u >> 16) & 1u)) >> 16; }
__device__ __forceinline__ unsigned pk2(float lo, float hi) { return f2bf(lo) | (f2bf(hi) << 16); }
__device__ __forceinline__ float bf2f(bf16 v) { return __builtin_bit_cast(float, (unsigned)v << 16); }
__device__ __forceinline__ float gelu_tanh(float x) { const float t = -2.3022082f * (x + 0.044715f * x * x * x); return x * __builtin_amdgcn_rcpf(1.f + __builtin_amdgcn_exp2f(t)); }
__device__ __forceinline__ float sigmoidf_(float x) { return __builtin_amdgcn_rcpf(1.f + __builtin_amdgcn_exp2f(-1.4426950408889634f * x)); }

#define XB_TMO      128
#define XB_XCNT(j)  (256  + 64 * (j))
#define XB_XSUB(j)  (1280 + 64 * (j))
#define XB_XGEN(j)  (2304 + 64 * (j))
#define XB_TOP      3328
#define XB_TOPGEN   3392
#define XCD_BAR_WORDS 3456
#define XB_SPIN_CAP (1u << 18)
__device__ __forceinline__ unsigned xb_ld(unsigned* p)              { return __hip_atomic_load(p, __ATOMIC_RELAXED, __HIP_MEMORY_SCOPE_AGENT); }
__device__ __forceinline__ unsigned xb_add(unsigned* p, unsigned v) { return __hip_atomic_fetch_add(p, v, __ATOMIC_RELAXED, __HIP_MEMORY_SCOPE_AGENT); }
__device__ __forceinline__ unsigned xb_xcc_id() { return (unsigned)__builtin_amdgcn_s_getreg((3 << 11) | 20) & 0xFu; }
#define XB_SPIN(cond, bar) do { unsigned _sp = 0; while (cond) { __builtin_amdgcn_s_sleep(1); \
    if ((++_sp & 255u) == 0u) { if (xb_ld(&(bar)[XB_TMO])) break; if (_sp > XB_SPIN_CAP) { atomicAdd(&(bar)[XB_TMO], 1u); break; } } } } while (0)
struct XcdBarrier { unsigned* bar; unsigned x; volatile LAS unsigned* st; };
__device__ __forceinline__ XcdBarrier xcd_barrier_post(unsigned* bar, volatile LAS unsigned* st) {
    XcdBarrier b; b.bar = bar; b.x = xb_xcc_id(); b.st = st;
    if (threadIdx.x == 0) (void)xb_add(&bar[XB_XCNT(b.x)], 1u);
    return b;
}
__device__ __forceinline__ void xcd_barrier_complete(unsigned* bar, unsigned x, unsigned& nloc, unsigned& nx) {
    const unsigned G = gridDim.x * gridDim.y * gridDim.z;
    unsigned sum, cnt, mine, sp = 0u;
    for (;;) {
        sum = 0u; cnt = 0u; mine = 0u;
#pragma unroll
        for (unsigned j = 0; j < 16; ++j) { const unsigned c = xb_ld(&bar[XB_XCNT(j)]); sum += c; cnt += (c > 0u) ? 1u : 0u; mine = (j == x) ? c : mine; }
        if (sum == G) break;
        __builtin_amdgcn_s_sleep(1);
        if ((++sp & 255u) == 0u) { if (xb_ld(&bar[XB_TMO])) break; if (sp > XB_SPIN_CAP) { atomicAdd(&bar[XB_TMO], 1u); break; } }
    }
    nloc = mine > 0u ? mine : 1u; nx = cnt > 0u ? cnt : 1u;
}
__device__ __forceinline__ void xcd_barrier(const XcdBarrier& b) {
    asm volatile("s_waitcnt vmcnt(0)" ::: "memory");
    __syncthreads();
    if (threadIdx.x == 0) {
        unsigned* bar = b.bar;
        __builtin_amdgcn_s_waitcnt(0);
        unsigned nloc = b.st[0], nx = b.st[1];
        if (nloc == 0u) { xcd_barrier_complete(bar, b.x, nloc, nx); b.st[0] = nloc; b.st[1] = nx; }
        const unsigned old = xb_add(&bar[XB_XSUB(b.x)], 1u);
        const unsigned gen = old / nloc;
        if (old + 1u == (gen + 1u) * nloc) {
            __builtin_amdgcn_fence(__ATOMIC_RELEASE, "agent");
            asm volatile("s_waitcnt vmcnt(0)" ::: "memory");
            const unsigned og = xb_add(&bar[XB_TOP], 1u);
            const unsigned tg = og / nx;
            if (og + 1u == (tg + 1u) * nx) xb_add(&bar[XB_TOPGEN], 1u);
            else XB_SPIN(xb_ld(&bar[XB_TOPGEN]) == tg, bar);
            __builtin_amdgcn_fence(__ATOMIC_ACQUIRE, "agent");
            xb_add(&bar[XB_XGEN(b.x)], 1u);
            asm volatile("s_waitcnt vmcnt(0)" ::: "memory");
        } else {
            XB_SPIN(xb_ld(&bar[XB_XGEN(b.x)]) == gen, bar);
            __builtin_amdgcn_fence(__ATOMIC_ACQUIRE, "agent");
            asm volatile("s_waitcnt vmcnt(0)" ::: "memory");
        }
    }
    __syncthreads();
}

struct Frame {
    LAS unsigned char* lds;
    volatile LAS unsigned* MISC;
    gu32* ctl;
    int tid, lane, wave;
    int vcu, G;
    float* out;
    unsigned char* ws;
};
struct Args { const float* in[37]; float* out; unsigned char* ws; int ph_lo, ph_hi, li, pad; };
__device__ __forceinline__ float wave_sum(float v) {
#pragma unroll
    for (int o = 1; o < 64; o <<= 1) v += __shfl_xor(v, o);
    return v;
}
enum { I_XP = 0, I_XS, I_SCONV, I_SH, I_SSR, I_SSI, I_CP, I_CS, I_ADAW, I_ADAB, I_INPROJ, I_CONVW, I_CONVB, I_RGWR, I_RGBR, I_RGWI, I_RGBI, I_RGLAM,
       I_S5ARE, I_S5AIM, I_S5LOGDT, I_S5BRE, I_S5BIM, I_S5CRE, I_S5CIM, I_S5D, I_GLUW, I_GLUB, I_OUTPROJ, I_LN1G, I_LN1B, I_W1, I_B1, I_W2, I_B2, I_LN2G, I_LN2B };

typedef float f32x2m __attribute__((ext_vector_type(2)));
typedef __bf16 bf16x2m __attribute__((ext_vector_type(2)));
__device__ __forceinline__ unsigned pkbf0(float a, float b) { const f32x2m v = {a, b}; const bf16x2m r = __builtin_convertvector(v, bf16x2m); return __builtin_bit_cast(unsigned, r); }
typedef short bf16x8m __attribute__((ext_vector_type(8)));
typedef float f32x16m __attribute__((ext_vector_type(16)));
__device__ __forceinline__ void p0_transpose_item(const float* W, int K, int N, bf16* WT, LAS float* scr, int item, int lane) {
    const int nblk = N / 32, kb = item / nblk, nb = item % nblk, k0 = 64 * kb, n0 = 32 * nb;
#pragma unroll 8
    for (int i = 0; i < 32; ++i) { const int kk = 2 * i + (lane >> 5); scr[kk * 33 + (lane & 31)] = W[(size_t)(k0 + kk) * N + n0 + (lane & 31)]; }
    LDS_WAIT(); asm volatile("" ::: "memory");
    const int c = lane & 7;
#pragma unroll
    for (int j = 0; j < 4; ++j) { const int n = (lane >> 3) + 8 * j; const LAS float* s = scr + (8 * c) * 33 + n;
        v4u o; o.x = pk2(s[0 * 33], s[1 * 33]); o.y = pk2(s[2 * 33], s[3 * 33]); o.z = pk2(s[4 * 33], s[5 * 33]); o.w = pk2(s[6 * 33], s[7 * 33]);
        *(GAS v4u*)(WT + (size_t)(n0 + n) * K + k0 + 8 * c) = o; }
    LDS_WAIT(); asm volatile("" ::: "memory");
}

#ifndef PROBE_P0PART
#define PROBE_P0PART 7
#endif
__device__ __forceinline__ void p0_prologue(Frame& F, const Args& A, int rep = 0) {
    const int pmask = rep ? PROBE_P0PART : 7;
    LAS float* scr = (LAS float*)(F.lds + RING_OFF + F.wave * 16384);
    const int gw = F.wave * F.G + F.vcu, NGW = F.G * NWAVES;
    constexpr int I_IN = (D / 64) * (NZ / 32), I_GL = (WB / 64) * (WB / 32), I_OU = (D / 64) * (D / 32), I_1 = (D / 64) * (FF / 32), I_2 = (FF / 64) * (D / 32);
    constexpr int I_S5 = GB, I_RG = WA / 64, I_RGT = HA * 2 * 2 * 4;
    constexpr int NITEMS = I_IN + I_GL + I_OU + I_1 + I_2 + I_S5 + I_RG + I_RGT;
    float* sc = (float*)(F.ws + WS_S5C);
    for (int it = gw; it < NITEMS; it += NGW) {
        int r = it;
        if (!(pmask & 1) && it < I_IN + I_GL + I_OU + I_1 + I_2) continue;
        if (!(pmask & 2) && it >= I_IN + I_GL + I_OU + I_1 + I_2) continue;
        if (r < I_IN) { p0_transpose_item(A.in[I_INPROJ], D, NZ, (bf16*)(F.ws + WS_WIN), scr, r, F.lane); continue; } r -= I_IN;
        if (r < I_GL) { p0_transpose_item(A.in[I_GLUW], WB, WB, (bf16*)(F.ws + WS_WGLU), scr, r, F.lane); continue; } r -= I_GL;
        if (r < I_OU) { p0_transpose_item(A.in[I_OUTPROJ], D, D, (bf16*)(F.ws + WS_WOUT), scr, r, F.lane); continue; } r -= I_OU;
        if (r < I_1) { p0_transpose_item(A.in[I_W1], D, FF, (bf16*)(F.ws + WS_W1), scr, r, F.lane); continue; } r -= I_1;
        if (r < I_2) { p0_transpose_item(A.in[I_W2], FF, D, (bf16*)(F.ws + WS_W2), scr, r, F.lane); continue; } r -= I_2;
        if (r < I_S5) {
            const int g = r, n = F.lane, gn = g * NS5 + n;
            const double dt = exp((double)A.in[I_S5LOGDT][g]), ar = (double)A.in[I_S5ARE][gn], ai = (double)A.in[I_S5AIM][gn];
            const double mag = exp(dt * ar), abr = mag * cos(dt * ai), abi = mag * sin(dt * ai), den = ar * ar + ai * ai, nr = abr - 1.0;
            const double qr = (nr * ar + abi * ai) / den, qi = (abi * ar - nr * ai) / den;
            sc[SC_ABR + gn] = (float)abr; sc[SC_ABI + gn] = (float)abi;
            unsigned char* tab = F.ws + WS_TAB;
            bf16* BF1 = (bf16*)(tab + TB_BF1); bf16* BF2 = (bf16*)(tab + TB_BF2); float* TA = (float*)(tab + TB_TA); float* ZP = (float*)(tab + TB_ZP); float* Z16N = (float*)(tab + TB_Z16N);
            const int sh = n >> 5, v = n & 31, hh = (v >> 2) & 1, ii = (v & 3) + 4 * (v >> 3);
            for (int k = 0; k < KS5; ++k) { const double br = (double)A.in[I_S5BRE][gn * KS5 + k], bi = (double)A.in[I_S5BIM][gn * KS5 + k];
                const float vr = (float)(qr * br - qi * bi), vi = (float)(qr * bi + qi * br);
                sc[SC_BBR + gn * KS5 + k] = vr; sc[SC_BBI + gn * KS5 + k] = vi;
                const int lp = (n & 31) + 32 * (k >> 3), jj = k & 7;
                BF1[(size_t)((g * 4 + 0 + sh) * 64 + lp) * 8 + jj] = (bf16)f2bf(vr); BF1[(size_t)((g * 4 + 2 + sh) * 64 + lp) * 8 + jj] = (bf16)f2bf(vi); }
            { const int s2 = (n >> 4) & 1, jj = 4 * ((n >> 3) & 1) + (n & 3), hk = (n >> 2) & 1;
              for (int ch = 0; ch < KS5; ++ch) { const int hr_ = ch >> 3, i8 = ch & 7, R = (i8 & 3) + 8 * (i8 >> 2) + 4 * hr_, lp = R + 32 * hk;
                  const float cr = A.in[I_S5CRE][(size_t)(g * KS5 + ch) * NS5 + n], ci = A.in[I_S5CIM][(size_t)(g * KS5 + ch) * NS5 + n];
                  BF2[(size_t)((g * 8 + (0 + sh) * 2 + s2) * 64 + lp) * 8 + jj] = (bf16)f2bf(cr); BF2[(size_t)((g * 8 + (2 + sh) * 2 + s2) * 64 + lp) * 8 + jj] = (bf16)f2bf(-ci); }
              for (int z = 0; z < 4; ++z) { const int cidx = n + 64 * z, ks = cidx >> 5, r16 = cidx & 31, lp = 16 + (r16 & 15) + 32 * (r16 >> 4);
                  *(v4u*)(BF2 + (size_t)((g * 8 + ks) * 64 + lp) * 8) = (v4u){0u, 0u, 0u, 0u}; } }
            TA[((g * 2 + hh) * 2 + 0) * 32 + sh * 16 + ii] = (float)abr; TA[((g * 2 + hh) * 2 + 1) * 32 + sh * 16 + ii] = (float)abi;
            const double mg8 = exp(8.0 * dt * ar), z1r = mg8 * cos(8.0 * dt * ai), z1i = mg8 * sin(8.0 * dt * ai); double pzr = 1.0, pzi = 0.0;
            for (int e = 0; e <= 16; ++e) { const float zr = (float)pzr, zi = (float)pzi; { const double nr2 = pzr * z1r - pzi * z1i, ni2 = pzr * z1i + pzi * z1r; pzr = nr2; pzi = ni2; }
                ZP[(((g * 17 + e) * 2 + hh) * 2 + 0) * 32 + sh * 16 + ii] = zr; ZP[(((g * 17 + e) * 2 + hh) * 2 + 1) * 32 + sh * 16 + ii] = zi;
                if (e == 16) { Z16N[(g * 2 + 0) * 64 + n] = zr; Z16N[(g * 2 + 1) * 64 + n] = zi; } }
            continue; } r -= I_S5;
        if (r < I_RG) { const int c = r * 64 + F.lane; const double lam = (double)A.in[I_RGLAM][c];
          sc[SC_RGL + c] = (float)(-8.0 * log1p(exp(-lam)) * 1.4426950408889634); continue; } r -= I_RG;
        {
            const int s4 = r & 3, gate = (r >> 2) & 1, jh = (r >> 3) & 1, hd = r >> 4;
            const int R = F.lane & 31, hk = F.lane >> 5, hR = (R >> 2) & 1, i = (R & 3) + 4 * (R >> 3), cho = 32 * jh + 16 * (i >> 3) + 8 * hR + (i & 7);
            const float* W = A.in[gate ? I_RGWI : I_RGWR] + (size_t)(hd * 64 + 16 * s4 + 8 * hk) * 64 + cho;
            v4u o; o.x = pk2(W[0], W[64]); o.y = pk2(W[128], W[192]); o.z = pk2(W[256], W[320]); o.w = pk2(W[384], W[448]);
            *(v4u*)(F.ws + WS_TAB + TB_RG + (size_t)(r * 64 + F.lane) * 16) = o;
        }
    }
    __syncthreads();
    LAS float* RED = (LAS float*)(F.lds + RING_OFF);
    float* mod = (float*)(F.ws + WS_MOD);
    const int r32 = F.lane & 31, hh = F.lane >> 5;
#pragma unroll 1
    for (int it = F.vcu; it < ((pmask & 4) ? NMOD / 32 : 0); it += F.G) {
        const int n0 = it * 32;
        for (int e = F.tid; e < 5 * 16 * 64; e += NWAVES * 64) RED[e] = 0.f;
        __syncthreads();
        f32x16m acc[5];
#pragma unroll
        for (int rt = 0; rt < 5; ++rt)
#pragma unroll
            for (int i = 0; i < 16; ++i) acc[rt][i] = 0.f;
#pragma unroll 1
        for (int kb = 0; kb < 2; ++kb) {
        float bw[4][8];
#pragma unroll
        for (int ks = 0; ks < 4; ++ks) { const float* wp = A.in[I_ADAW] + (size_t)(F.wave * 128 + (kb * 4 + ks) * 16 + 8 * hh) * NMOD + n0 + r32;
#pragma unroll
            for (int j = 0; j < 8; ++j) bw[ks][j] = wp[(size_t)j * NMOD]; }
#pragma unroll
        for (int ks = 0; ks < 4; ++ks) {
            const int k0 = F.wave * 128 + (kb * 4 + ks) * 16 + 8 * hh;
            v4u bp; bp.x = pkbf0(bw[ks][0], bw[ks][1]); bp.y = pkbf0(bw[ks][2], bw[ks][3]); bp.z = pkbf0(bw[ks][4], bw[ks][5]); bp.w = pkbf0(bw[ks][6], bw[ks][7]);
            const bf16x8m bfr = __builtin_bit_cast(bf16x8m, bp);
#pragma unroll
            for (int rt = 0; rt < 5; ++rt) { int row = 32 * rt + r32; row = row > NROWMOD - 1 ? NROWMOD - 1 : row;
                const float* cp = (row < NBP ? A.in[I_CP] + (size_t)row * D : A.in[I_CS] + (size_t)(row - NBP) * D) + k0;
                const f32x4 c0 = *(const f32x4*)cp, c1 = *(const f32x4*)(cp + 4);
                v4u ap; ap.x = pkbf0(c0[0] * sigmoidf_(c0[0]), c0[1] * sigmoidf_(c0[1])); ap.y = pkbf0(c0[2] * sigmoidf_(c0[2]), c0[3] * sigmoidf_(c0[3]));
                ap.z = pkbf0(c1[0] * sigmoidf_(c1[0]), c1[1] * sigmoidf_(c1[1])); ap.w = pkbf0(c1[2] * sigmoidf_(c1[2]), c1[3] * sigmoidf_(c1[3]));
                acc[rt] = __builtin_amdgcn_mfma_f32_32x32x16_bf16(__builtin_bit_cast(bf16x8m, ap), bfr, acc[rt], 0, 0, 0); }
        }
        }
#pragma unroll
        for (int rt = 0; rt < 5; ++rt)
#pragma unroll
            for (int i = 0; i < 16; ++i) (void)__hip_atomic_fetch_add(RED + (rt * 16 + i) * 64 + F.lane, acc[rt][i], __ATOMIC_RELAXED, __HIP_MEMORY_SCOPE_WORKGROUP);
        __syncthreads();
        for (int e = F.tid; e < 5 * 16 * 64; e += NWAVES * 64) { const int rt = e >> 10, i = (e >> 6) & 15, l = e & 63, row = 32 * rt + (i & 3) + 8 * (i >> 2) + 4 * (l >> 5), col = n0 + (l & 31);
            if (row < NROWMOD) mod[(size_t)row * NMOD + col] = RED[e] + A.in[I_ADAB][col]; }
        __syncthreads();
    }
}

__device__ __forceinline__ int mod_row(int m) { return m < MP ? (m >> 11) : NBP + ((m - MP) >> 2); }
__device__ __forceinline__ const float* x_row(const Args& A, int m) { return m < MP ? A.in[I_XP] + (size_t)m * D : A.in[I_XS] + (size_t)(m - MP) * D; }

__device__ __forceinline__ void p1_modulate(Frame& F, const Args& A) {
    const int gw = F.vcu * NWAVES + F.wave, NGW = F.G * NWAVES;
    const float* mod = (const float*)(F.ws + WS_MOD); bf16* XN = (bf16*)(F.ws + WS_XN);
    for (int m = gw; m < M; m += NGW) {
        const GAS f32x4* xr = (const GAS f32x4*)x_row(A, m) + F.lane; const float* mr = mod + (size_t)mod_row(m) * NMOD;
        const GAS f32x4* sh = (const GAS f32x4*)(mr) + F.lane; const GAS f32x4* scp = (const GAS f32x4*)(mr + D) + F.lane;
        GAS unsigned long long* o8 = (GAS unsigned long long*)(XN + (size_t)m * D) + F.lane;
#pragma unroll
        for (int j = 0; j < 4; ++j) { const f32x4 v = xr[64 * j], a = sh[64 * j], s = scp[64 * j]; const f32x4 h = v * (s + 1.f) + a;
            o8[64 * j] = (unsigned long long)pk2(h.x, h.y) | ((unsigned long long)pk2(h.z, h.w) << 32); }
    }
}

template <bool SECOND>
__device__ __forceinline__ void ln_rows(Frame& F, const Args& A) {
    const int gw = F.vcu * NWAVES + F.wave, NGW = F.G * NWAVES;
    const float* mod = (const float*)(F.ws + WS_MOD); bf16* XN = (bf16*)(F.ws + WS_XN);
    const GAS f32x4* gg = (const GAS f32x4*)A.in[SECOND ? I_LN2G : I_LN1G] + F.lane; const GAS f32x4* gb = (const GAS f32x4*)A.in[SECOND ? I_LN2B : I_LN1B] + F.lane;
    for (int m = gw; m < M; m += NGW) {
        GAS f32x4* xr = (GAS f32x4*)(F.out + (size_t)m * D) + F.lane;
        f32x4 v[4]; float s = 0.f;
#pragma unroll
        for (int j = 0; j < 4; ++j) { v[j] = xr[64 * j]; s += (v[j].x + v[j].y) + (v[j].z + v[j].w); }
        const float mean = wave_sum(s) * (1.f / D); float s2 = 0.f;
#pragma unroll
        for (int j = 0; j < 4; ++j) { v[j] = v[j] - mean; s2 += (v[j].x * v[j].x + v[j].y * v[j].y) + (v[j].z * v[j].z + v[j].w * v[j].w); }
        const float rstd = 1.f / sqrtf(wave_sum(s2) * (1.f / D) + LN_EPS);
#pragma unroll
        for (int j = 0; j < 4; ++j) { v[j] = v[j] * rstd * gg[64 * j] + gb[64 * j]; xr[64 * j] = v[j]; }
        if (!SECOND) {
            const float* mr = mod + (size_t)mod_row(m) * NMOD;
            const GAS f32x4* sh = (const GAS f32x4*)(mr + 3 * D) + F.lane; const GAS f32x4* scp = (const GAS f32x4*)(mr + 4 * D) + F.lane;
            GAS unsigned long long* o8 = (GAS unsigned long long*)(XN + (size_t)m * D) + F.lane;
#pragma unroll
            for (int j = 0; j < 4; ++j) { const f32x4 h = v[j] * (scp[64 * j] + 1.f) + sh[64 * j];
                o8[64 * j] = (unsigned long long)pk2(h.x, h.y) | ((unsigned long long)pk2(h.z, h.w) << 32); }
        }
    }
}

__device__ __forceinline__ void rg_item_ref(Frame& F, const Args& A, bool prompt, int b, int hd, LAS float* scr) {
    const int j = F.lane, c = hd * HDA + j;
    const bf16* Z = (const bf16*)(F.ws + WS_Z); bf16* Y = (bf16*)(F.ws + WS_YCAT); const float* sc = (const float*)(F.ws + WS_S5C);
    float wr[64], wi[64];
#pragma unroll
    for (int i = 0; i < 64; ++i) { wr[i] = A.in[I_RGWR][(size_t)(hd * 64 + i) * 64 + j]; wi[i] = A.in[I_RGWI][(size_t)(hd * 64 + i) * 64 + j]; }
    const float br = A.in[I_RGBR][c], bi = A.in[I_RGBI][c], L2 = sc[SC_RGL + c];
    const float w0 = A.in[I_CONVW][c], w1 = A.in[I_CONVW][WA + c], w2 = A.in[I_CONVW][2 * WA + c], w3 = A.in[I_CONVW][3 * WA + c], cb = A.in[I_CONVB][c];
    int T, m0; float x3, x2, x1, h;
    if (prompt) { T = TP; m0 = b * TP; x3 = 0.f; x2 = 0.f; x1 = 0.f; h = 0.f; }
    else { T = TS; m0 = MP + b * TS; x3 = A.in[I_SCONV][(size_t)(b * 3 + 0) * WA + c]; x2 = A.in[I_SCONV][(size_t)(b * 3 + 1) * WA + c]; x1 = A.in[I_SCONV][(size_t)(b * 3 + 2) * WA + c]; h = A.in[I_SH][(size_t)b * WA + c]; }
    for (int t = 0; t < T; ++t) {
        const size_t m = (size_t)(m0 + t);
        const float xa = bf2f(Z[m * NZ + WA + c]), gate = bf2f(Z[m * NZ + c]);
        const float xc = cb + w0 * x3 + w1 * x2 + w2 * x1 + w3 * xa; x3 = x2; x2 = x1; x1 = xa;
        scr[j] = xc; LDS_WAIT(); asm volatile("" ::: "memory");
        float rp = br, gp = bi;
#pragma unroll
        for (int i4 = 0; i4 < 16; ++i4) { const f32x4 v = *(const LAS f32x4*)(scr + 4 * i4);
            rp += v[0] * wr[4 * i4] + v[1] * wr[4 * i4 + 1] + v[2] * wr[4 * i4 + 2] + v[3] * wr[4 * i4 + 3];
            gp += v[0] * wi[4 * i4] + v[1] * wi[4 * i4 + 1] + v[2] * wi[4 * i4 + 2] + v[3] * wi[4 * i4 + 3]; }
        LDS_WAIT(); asm volatile("" ::: "memory");
        const float r = sigmoidf_(rp), gi = sigmoidf_(gp);
        const float a = exp2f(r * L2);
        float mult = sqrtf(fmaxf(1.f - a * a, 0.f));
        if (prompt && t == 0) mult = 1.f;
        h = a * h + mult * gi * xc;
        Y[m * D + c] = (bf16)f2bf(gelu_tanh(gate) * h);
    }
    float* oc = F.out + (prompt ? O_CONVP : O_CONVS); float* oh = F.out + (prompt ? O_HP : O_HS);
    oc[(size_t)(b * 3 + 0) * WA + c] = x3; oc[(size_t)(b * 3 + 1) * WA + c] = x2; oc[(size_t)(b * 3 + 2) * WA + c] = x1;
    oh[(size_t)b * WA + c] = h;
}
__device__ __forceinline__ void s5_item_ref(Frame& F, const Args& A, bool prompt, int b, int g, LAS float* scr) {
    const int n = F.lane, gn = g * NS5 + n, k = F.lane & 15, part = F.lane >> 4;
    const bf16* Z = (const bf16*)(F.ws + WS_Z); bf16* Gy = (bf16*)(F.ws + WS_G); const float* sc = (const float*)(F.ws + WS_S5C);
    float bbr[16], bbi[16], cre[16], cim[16];
#pragma unroll
    for (int i = 0; i < 16; ++i) { bbr[i] = sc[SC_BBR + gn * KS5 + i]; bbi[i] = sc[SC_BBI + gn * KS5 + i];
        cre[i] = A.in[I_S5CRE][(size_t)(g * KS5 + k) * NS5 + part * 16 + i]; cim[i] = A.in[I_S5CIM][(size_t)(g * KS5 + k) * NS5 + part * 16 + i]; }
    const float abr = sc[SC_ABR + gn], abi = sc[SC_ABI + gn], dk = A.in[I_S5D][g * KS5 + k];
    int T, m0; float hr, hi;
    if (prompt) { T = TP; m0 = b * TP; hr = 0.f; hi = 0.f; }
    else { T = TS; m0 = MP + b * TS; hr = A.in[I_SSR][(size_t)(b * GB + g) * NS5 + n]; hi = A.in[I_SSI][(size_t)(b * GB + g) * NS5 + n]; }
    for (int t = 0; t < T; ++t) {
        const size_t m = (size_t)(m0 + t);
        const bf16* zr = Z + m * NZ + 2 * WA + g * KS5;
        const v4u u0 = *(const v4u*)zr, u1 = *(const v4u*)(zr + 8);
        float u[16];
        u[0] = pg8::bf_lo(u0.x); u[1] = pg8::bf_hi(u0.x); u[2] = pg8::bf_lo(u0.y); u[3] = pg8::bf_hi(u0.y); u[4] = pg8::bf_lo(u0.z); u[5] = pg8::bf_hi(u0.z); u[6] = pg8::bf_lo(u0.w); u[7] = pg8::bf_hi(u0.w);
        u[8] = pg8::bf_lo(u1.x); u[9] = pg8::bf_hi(u1.x); u[10] = pg8::bf_lo(u1.y); u[11] = pg8::bf_hi(u1.y); u[12] = pg8::bf_lo(u1.z); u[13] = pg8::bf_hi(u1.z); u[14] = pg8::bf_lo(u1.w); u[15] = pg8::bf_hi(u1.w);
        float bur = 0.f, bui = 0.f;
#pragma unroll
        for (int i = 0; i < 16; ++i) { bur += bbr[i] * u[i]; bui += bbi[i] * u[i]; }
        const float nhr = abr * hr - abi * hi + bur, nhi = abr * hi + abi * hr + bui; hr = nhr; hi = nhi;
        scr[n] = hr; scr[64 + n] = hi; LDS_WAIT(); asm volatile("" ::: "memory");
        float p = 0.f;
#pragma unroll
        for (int i4 = 0; i4 < 4; ++i4) { const f32x4 vr = *(const LAS f32x4*)(scr + part * 16 + 4 * i4), vi = *(const LAS f32x4*)(scr + 64 + part * 16 + 4 * i4);
#pragma unroll
            for (int e = 0; e < 4; ++e) p += vr[e] * cre[4 * i4 + e] - vi[e] * cim[4 * i4 + e]; }
        LDS_WAIT(); asm volatile("" ::: "memory");
        p += __shfl_xor(p, 16); p += __shfl_xor(p, 32);
        const float uk = bf2f(zr[k]);
        if (F.lane < 16) Gy[m * WB + g * KS5 + k] = (bf16)f2bf(gelu_tanh(p + dk * uk));
    }
    float* osr = F.out + (prompt ? O_SRP : O_SRS); float* osi = F.out + (prompt ? O_SIP : O_SIS);
    osr[(size_t)(b * GB + g) * NS5 + n] = hr; osi[(size_t)(b * GB + g) * NS5 + n] = hi;
}

typedef short bf16x8v __attribute__((ext_vector_type(8)));
typedef float f32x16 __attribute__((ext_vector_type(16)));
typedef float f32x2v __attribute__((ext_vector_type(2)));
typedef __bf16 bf16x2v __attribute__((ext_vector_type(2)));
#define MFMA32(a, b, c) __builtin_amdgcn_mfma_f32_32x32x16_bf16((a), (b), (c), 0, 0, 0)
__device__ __forceinline__ unsigned pkbf(float a, float b) { const f32x2v v = {a, b}; const bf16x2v r = __builtin_convertvector(v, bf16x2v); return __builtin_bit_cast(unsigned, r); }
template <int CTRL> __device__ __forceinline__ float dppf(float old, float v) { return __builtin_bit_cast(float, __builtin_amdgcn_update_dpp(__builtin_bit_cast(int, old), __builtin_bit_cast(int, v), CTRL, 0xF, 0xF, false)); }
__device__ __forceinline__ f32x16 ld16(const float* p) { f32x16 r;
#pragma unroll
    for (int i = 0; i < 4; ++i) { const f32x4 v = *(const f32x4*)(p + 4 * i); r[4 * i] = v[0]; r[4 * i + 1] = v[1]; r[4 * i + 2] = v[2]; r[4 * i + 3] = v[3]; }
    return r; }
__device__ __forceinline__ bf16x8v pack8(const f32x16& x, int s) { v4u p; p.x = pkbf(x[8 * s], x[8 * s + 1]); p.y = pkbf(x[8 * s + 2], x[8 * s + 3]); p.z = pkbf(x[8 * s + 4], x[8 * s + 5]); p.w = pkbf(x[8 * s + 6], x[8 * s + 7]); return __builtin_bit_cast(bf16x8v, p); }
template <int CTRL> __device__ __forceinline__ void s5_scan_step(f32x16& xr, f32x16& xi, const f32x16& zr, const f32x16& zi) {
#pragma unroll
    for (int i = 0; i < 16; ++i) { const float sr = dppf<CTRL>(0.f, xr[i]), si = dppf<CTRL>(0.f, xi[i]);
        xr[i] += zr[i] * sr - zi[i] * si; xi[i] += zr[i] * si + zi[i] * sr; }
}
constexpr int S5L_BF1 = 0, S5L_BF2 = 4096, S5L_TOT = 12288, S5L_CAR = 20480;
template <bool SECOND>
__device__ __forceinline__ void s5_step(LAS unsigned char* L, int lane, const bf16x8v u, f32x16& hr0, f32x16& hr1, f32x16& hi0, f32x16& hi1,
                                        const f32x16& ar0, const f32x16& ar1, const f32x16& ai0, const f32x16& ai1, const float (&dk)[8], bf16* gout) {
    const LAS bf16x8v* a1 = (const LAS bf16x8v*)(L + S5L_BF1) + lane;
    { const f32x16 cr = ar0 * hr0 - ai0 * hi0, ci = ar0 * hi0 + ai0 * hr0; hr0 = MFMA32(a1[0], u, cr); hi0 = MFMA32(a1[128], u, ci); }
    asm volatile("" : "+v"(hr0), "+v"(hi0));
    { const f32x16 cr = ar1 * hr1 - ai1 * hi1, ci = ar1 * hi1 + ai1 * hr1; hr1 = MFMA32(a1[64], u, cr); hi1 = MFMA32(a1[192], u, ci); }
    if (SECOND) {
        const LAS bf16x8v* a2 = (const LAS bf16x8v*)(L + S5L_BF2) + lane;
        f32x16 y;
#pragma unroll
        for (int i = 0; i < 16; ++i) y[i] = 0.f;
        y = MFMA32(a2[0 * 64], pack8(hr0, 0), y); y = MFMA32(a2[1 * 64], pack8(hr0, 1), y);
        y = MFMA32(a2[2 * 64], pack8(hr1, 0), y); y = MFMA32(a2[3 * 64], pack8(hr1, 1), y);
        y = MFMA32(a2[4 * 64], pack8(hi0, 0), y); y = MFMA32(a2[5 * 64], pack8(hi0, 1), y);
        y = MFMA32(a2[6 * 64], pack8(hi1, 0), y); y = MFMA32(a2[7 * 64], pack8(hi1, 1), y);
        const v4u uw = __builtin_bit_cast(v4u, u);
        float o[8];
        o[0] = gelu_tanh(y[0] + dk[0] * pg8::bf_lo(uw.x)); o[1] = gelu_tanh(y[1] + dk[1] * pg8::bf_hi(uw.x));
        o[2] = gelu_tanh(y[2] + dk[2] * pg8::bf_lo(uw.y)); o[3] = gelu_tanh(y[3] + dk[3] * pg8::bf_hi(uw.y));
        o[4] = gelu_tanh(y[4] + dk[4] * pg8::bf_lo(uw.z)); o[5] = gelu_tanh(y[5] + dk[5] * pg8::bf_hi(uw.z));
        o[6] = gelu_tanh(y[6] + dk[6] * pg8::bf_lo(uw.w)); o[7] = gelu_tanh(y[7] + dk[7] * pg8::bf_hi(uw.w));
        v4u w; w.x = pkbf(o[0], o[1]); w.y = pkbf(o[2], o[3]); w.z = pkbf(o[4], o[5]); w.w = pkbf(o[6], o[7]);
        *(v4u*)gout = w;
    }
}
__device__ __forceinline__ void s5_item_fast(Frame& F, const Args& A, int b, int g) {
    const int lane = F.lane, q = lane & 31, hh = lane >> 5, w = F.wave, c = w * 32 + q;
    LAS unsigned char* L = F.lds + RING_OFF;
    const unsigned char* tab = F.ws + WS_TAB;
    {
        const v4u* s1 = (const v4u*)(tab + TB_BF1) + (size_t)g * 256; const v4u* s2 = (const v4u*)(tab + TB_BF2) + (size_t)g * 512;
        if (F.tid < 256) ((LAS v4u*)(L + S5L_BF1))[F.tid] = s1[F.tid];
        ((LAS v4u*)(L + S5L_BF2))[F.tid] = s2[F.tid];
    }
    __syncthreads();
    const float* TA = (const float*)(tab + TB_TA) + (size_t)((g * 2 + hh) * 2) * 32;
    f32x16 ar0 = ld16(TA), ar1 = ld16(TA + 16), ai0 = ld16(TA + 32), ai1 = ld16(TA + 48);
    f32x16 hr0, hr1, hi0, hi1;
#pragma unroll
    for (int i = 0; i < 16; ++i) { hr0[i] = 0.f; hr1[i] = 0.f; hi0[i] = 0.f; hi1[i] = 0.f; }
    float dk[8];
#pragma unroll
    for (int i = 0; i < 8; ++i) dk[i] = A.in[I_S5D][g * KS5 + 8 * hh + i];
    const size_t m0 = (size_t)b * TP + (size_t)8 * c;
    const bf16* zrow = (const bf16*)(F.ws + WS_Z) + m0 * NZ + 2 * WA + g * KS5 + 8 * hh;
    bf16* grow = (bf16*)(F.ws + WS_G) + m0 * WB + g * KS5 + 8 * hh;
#pragma unroll 1
    for (int j = 0; j < 8; ++j) { const bf16x8v u = *(const bf16x8v*)(zrow + (size_t)j * NZ);
        s5_step<false>(L, lane, u, hr0, hr1, hi0, hi1, ar0, ar1, ai0, ai1, dk, nullptr); }
    const float* ZP = (const float*)(tab + TB_ZP);
#define S5_SCAN(E, CTRL) do { const float* z = ZP + (size_t)(((g * 17 + (E)) * 2 + hh) * 2) * 32; \
        { const f32x16 zr = ld16(z), zi = ld16(z + 32); s5_scan_step<CTRL>(hr0, hi0, zr, zi); } \
        asm volatile("" : "+v"(hr0), "+v"(hi0) :: "memory"); \
        { const f32x16 zr = ld16(z + 16), zi = ld16(z + 48); s5_scan_step<CTRL>(hr1, hi1, zr, zi); } \
        asm volatile("" : "+v"(hr1), "+v"(hi1) :: "memory"); } while (0)
    S5_SCAN(1, 0x111); S5_SCAN(2, 0x112); S5_SCAN(4, 0x114); S5_SCAN(8, 0x118);
#undef S5_SCAN
    const int seg = w * 2 + (q >> 4);
    LAS float* TOT = (LAS float*)(L + S5L_TOT); LAS float* CAR = (LAS float*)(L + S5L_CAR);
    if ((lane & 15) == 15) {
#pragma unroll
        for (int rho = 0; rho < 4; ++rho) {
            *(LAS f32x4*)(TOT + (seg * 2 + 0) * 64 + 0 + 8 * rho + 4 * hh) = (f32x4){hr0[4 * rho], hr0[4 * rho + 1], hr0[4 * rho + 2], hr0[4 * rho + 3]};
            *(LAS f32x4*)(TOT + (seg * 2 + 0) * 64 + 32 + 8 * rho + 4 * hh) = (f32x4){hr1[4 * rho], hr1[4 * rho + 1], hr1[4 * rho + 2], hr1[4 * rho + 3]};
            *(LAS f32x4*)(TOT + (seg * 2 + 1) * 64 + 0 + 8 * rho + 4 * hh) = (f32x4){hi0[4 * rho], hi0[4 * rho + 1], hi0[4 * rho + 2], hi0[4 * rho + 3]};
            *(LAS f32x4*)(TOT + (seg * 2 + 1) * 64 + 32 + 8 * rho + 4 * hh) = (f32x4){hi1[4 * rho], hi1[4 * rho + 1], hi1[4 * rho + 2], hi1[4 * rho + 3]}; }
    }
    __syncthreads();
    if (F.tid < 64) {
        const float* z16 = (const float*)(tab + TB_Z16N) + (size_t)g * 128; const float zr = z16[F.tid], zi = z16[64 + F.tid];
        float cr = 0.f, ci = 0.f;
#pragma unroll
        for (int sg = 0; sg < 16; ++sg) { CAR[(sg * 2 + 0) * 64 + F.tid] = cr; CAR[(sg * 2 + 1) * 64 + F.tid] = ci;
            const float tr = TOT[(sg * 2 + 0) * 64 + F.tid], ti = TOT[(sg * 2 + 1) * 64 + F.tid];
            const float ncr = zr * cr - zi * ci + tr, nci = zr * ci + zi * cr + ti; cr = ncr; ci = nci; }
    }
    __syncthreads();
    {
        const float* z = ZP + (size_t)(((g * 17 + (q & 15)) * 2 + hh) * 2) * 32;
#define S5_EXCL(HR, HI, OFF) do { const f32x16 zr = ld16(z + (OFF)), zi = ld16(z + 32 + (OFF)); f32x16 kr, ki; \
        _Pragma("unroll") for (int rho = 0; rho < 4; ++rho) { \
            const f32x4 a0 = *(const LAS f32x4*)(CAR + (seg * 2 + 0) * 64 + 2 * (OFF) + 8 * rho + 4 * hh), b0 = *(const LAS f32x4*)(CAR + (seg * 2 + 1) * 64 + 2 * (OFF) + 8 * rho + 4 * hh); \
            _Pragma("unroll") for (int e = 0; e < 4; ++e) { kr[4 * rho + e] = a0[e]; ki[4 * rho + e] = b0[e]; } } \
        _Pragma("unroll") for (int i = 0; i < 16; ++i) { const float sr = dppf<0x111>(0.f, HR[i]), si = dppf<0x111>(0.f, HI[i]); \
            HR[i] = sr + zr[i] * kr[i] - zi[i] * ki[i]; HI[i] = si + zr[i] * ki[i] + zi[i] * kr[i]; } } while (0)
        S5_EXCL(hr0, hi0, 0); asm volatile("" : "+v"(hr0), "+v"(hi0) :: "memory"); S5_EXCL(hr1, hi1, 16); asm volatile("" : "+v"(hr1), "+v"(hi1) :: "memory");
#undef S5_EXCL
    }
    { int off = 0; asm volatile("" : "+v"(off)); const float* TA2 = TA + off; ar0 = ld16(TA2); ar1 = ld16(TA2 + 16); ai0 = ld16(TA2 + 32); ai1 = ld16(TA2 + 48); }
#pragma unroll 1
    for (int j = 0; j < 8; ++j) { const bf16x8v u = *(const bf16x8v*)(zrow + (size_t)j * NZ);
        s5_step<true>(L, lane, u, hr0, hr1, hi0, hi1, ar0, ar1, ai0, ai1, dk, grow + (size_t)j * WB); }
    if (w == NWAVES - 1 && q == 31) {
        float* osr = F.out + O_SRP + (size_t)(b * GB + g) * NS5; float* osi = F.out + O_SIP + (size_t)(b * GB + g) * NS5;
#pragma unroll
        for (int i = 0; i < 16; ++i) { const int n = (i & 3) + 8 * (i >> 2) + 4 * hh; osr[n] = hr0[i]; osr[32 + n] = hr1[i]; osi[n] = hi0[i]; osi[32 + n] = hi1[i]; }
    }
    __syncthreads();
}


template <int CTRL, int RMASK> __device__ __forceinline__ float dppm(float old, float v) { return __builtin_bit_cast(float, __builtin_amdgcn_update_dpp(__builtin_bit_cast(int, old), __builtin_bit_cast(int, v), CTRL, RMASK, 0xF, false)); }
template <int CTRL, int RMASK> __device__ __forceinline__ void rg_scan_step(f32x16& a, f32x16& b) {
#pragma unroll
    for (int i = 0; i < 16; ++i) { const float as = dppm<CTRL, RMASK>(1.f, a[i]), bs = dppm<CTRL, RMASK>(0.f, b[i]); b[i] = a[i] * bs + b[i]; a[i] = a[i] * as; }
}
constexpr int RGL_AFR = 0, RGL_CWT = 8192, RGL_TOT = 10240, RGL_CST = 14336;
__device__ __forceinline__ void rg_item_fast(Frame& F, const Args& A, int b, int hd, int jh) {
    const int lane = F.lane, q = lane & 31, hh = lane >> 5, w = F.wave;
    LAS unsigned char* L = F.lds + RING_OFF;
    const float* sc = (const float*)(F.ws + WS_S5C);
    {
        const v4u* src = (const v4u*)(F.ws + WS_TAB + TB_RG) + (size_t)((hd * 2 + jh) * 8) * 64;
        ((LAS v4u*)(L + RGL_AFR))[F.tid] = src[F.tid];
        if (F.tid < 320) { const int h2 = F.tid / 160, tap = (F.tid % 160) / 32, e = F.tid % 32, c = hd * 64 + 16 * (e >> 3) + 8 * h2 + (e & 7);
            ((LAS float*)(L + RGL_CWT))[F.tid] = tap < 4 ? A.in[I_CONVW][tap * WA + c] : A.in[I_CONVB][c]; }
        if (F.tid >= 384 && F.tid < 480) { const int e = F.tid - 384, h2 = e / 48, kind = (e % 48) / 16, i = e % 16, c = hd * 64 + 32 * jh + 16 * (i >> 3) + 8 * h2 + (i & 7);
            ((LAS float*)(L + RGL_CST))[e] = kind == 0 ? A.in[I_RGBR][c] : (kind == 1 ? A.in[I_RGBI][c] : sc[SC_RGL + c]); }
        if (jh == 0 && F.tid < 192) { const int k = F.tid >> 6, ch = F.tid & 63;
            F.out[O_CONVP + (size_t)(b * 3 + k) * WA + hd * 64 + ch] = bf2f(((const bf16*)(F.ws + WS_Z))[(size_t)(b * TP + TP - 3 + k) * NZ + WA + hd * 64 + ch]); }
    }
    __syncthreads();
    float hround[16];
#pragma unroll
    for (int i = 0; i < 16; ++i) hround[i] = 0.f;
    const bf16* Zb = (const bf16*)(F.ws + WS_Z) + (size_t)b * TP * NZ; bf16* Yb = (bf16*)(F.ws + WS_YCAT) + (size_t)b * TP * D;
    const LAS float* CWT = (const LAS float*)(L + RGL_CWT) + hh * 160;
#pragma unroll 1
    for (int rd = 0; rd < 8; ++rd) {
        const int t = rd * 256 + w * 32 + q;
        v4u xr[4][4];
#pragma unroll
        for (int k = 0; k < 4; ++k) { const int tk = t - 3 + k; const bf16* zr = Zb + (size_t)(tk < 0 ? 0 : tk) * NZ + WA + hd * 64 + 8 * hh;
#pragma unroll
            for (int s4 = 0; s4 < 4; ++s4) { v4u v = *(const v4u*)(zr + 16 * s4); if (tk < 0) v = (v4u){0u, 0u, 0u, 0u}; xr[k][s4] = v; } }
        const bf16* gr = Zb + (size_t)t * NZ + hd * 64 + 32 * jh + 8 * hh;
        const v4u g0 = *(const v4u*)gr, g1 = *(const v4u*)(gr + 16);
        float xc[32];
#pragma unroll
        for (int s4 = 0; s4 < 4; ++s4) {
            float acc[8];
#pragma unroll
            for (int j4 = 0; j4 < 2; ++j4) { const f32x4 cb = *(const LAS f32x4*)(CWT + 4 * 32 + s4 * 8 + 4 * j4); acc[4 * j4] = cb[0]; acc[4 * j4 + 1] = cb[1]; acc[4 * j4 + 2] = cb[2]; acc[4 * j4 + 3] = cb[3]; }
#pragma unroll
            for (int k = 0; k < 4; ++k) { const v4u v = xr[k][s4];
                const f32x4 w0 = *(const LAS f32x4*)(CWT + k * 32 + s4 * 8), w1 = *(const LAS f32x4*)(CWT + k * 32 + s4 * 8 + 4);
                acc[0] += w0[0] * pg8::bf_lo(v.x); acc[1] += w0[1] * pg8::bf_hi(v.x); acc[2] += w0[2] * pg8::bf_lo(v.y); acc[3] += w0[3] * pg8::bf_hi(v.y);
                acc[4] += w1[0] * pg8::bf_lo(v.z); acc[5] += w1[1] * pg8::bf_hi(v.z); acc[6] += w1[2] * pg8::bf_lo(v.w); acc[7] += w1[3] * pg8::bf_hi(v.w); }
#pragma unroll
            for (int e = 0; e < 8; ++e) xc[s4 * 8 + e] = acc[e];
            asm volatile("" : "+v"(xc[s4 * 8]), "+v"(xc[s4 * 8 + 7]) :: "memory");
        }
        f32x16 dr, di;
#pragma unroll
        for (int i = 0; i < 16; ++i) { dr[i] = 0.f; di[i] = 0.f; }
        const LAS bf16x8v* af = (const LAS bf16x8v*)(L + RGL_AFR) + lane;
#pragma unroll
        for (int s4 = 0; s4 < 4; ++s4) { v4u p; p.x = pkbf(xc[s4 * 8], xc[s4 * 8 + 1]); p.y = pkbf(xc[s4 * 8 + 2], xc[s4 * 8 + 3]); p.z = pkbf(xc[s4 * 8 + 4], xc[s4 * 8 + 5]); p.w = pkbf(xc[s4 * 8 + 6], xc[s4 * 8 + 7]);
            const bf16x8v bfr = __builtin_bit_cast(bf16x8v, p);
            dr = MFMA32(af[s4 * 64], bfr, dr); di = MFMA32(af[(4 + s4) * 64], bfr, di); }
        f32x16 av, bv;
        const bool first = (t == 0);
        const LAS float* CST = (const LAS float*)(L + RGL_CST) + hh * 48;
#pragma unroll
        for (int i = 0; i < 16; ++i) { const float xcv = jh ? xc[16 + i] : xc[i];
            const float r = sigmoidf_(dr[i] + CST[i]), gi = sigmoidf_(di[i] + CST[16 + i]);
            const float a = __builtin_amdgcn_exp2f(r * CST[32 + i]);
            float mult = __builtin_sqrtf(fmaxf(1.f - a * a, 0.f)); if (first) mult = 1.f;
            av[i] = a; bv[i] = mult * gi * xcv; }
        rg_scan_step<0x111, 0xF>(av, bv); rg_scan_step<0x112, 0xF>(av, bv); rg_scan_step<0x114, 0xF>(av, bv); rg_scan_step<0x118, 0xF>(av, bv);
        rg_scan_step<0x142, 0xA>(av, bv);
        LAS float* TOT = (LAS float*)(L + RGL_TOT) + (rd & 1) * 512;
        if (q == 31) {
#pragma unroll
            for (int i4 = 0; i4 < 4; ++i4) { *(LAS f32x4*)(TOT + (w * 2 + 0) * 32 + hh * 16 + 4 * i4) = (f32x4){av[4 * i4], av[4 * i4 + 1], av[4 * i4 + 2], av[4 * i4 + 3]};
                                             *(LAS f32x4*)(TOT + (w * 2 + 1) * 32 + hh * 16 + 4 * i4) = (f32x4){bv[4 * i4], bv[4 * i4 + 1], bv[4 * i4 + 2], bv[4 * i4 + 3]}; }
        }
        __syncthreads();
        float hin[16];
#pragma unroll
        for (int i = 0; i < 16; ++i) hin[i] = 0.f;
#pragma unroll
        for (int w2 = 0; w2 < 8; ++w2) {
            if (w2 == w) {
#pragma unroll
                for (int i = 0; i < 16; ++i) hin[i] = hround[i]; }
#pragma unroll
            for (int i4 = 0; i4 < 4; ++i4) { const f32x4 p = *(const LAS f32x4*)(TOT + (w2 * 2 + 0) * 32 + hh * 16 + 4 * i4), hl = *(const LAS f32x4*)(TOT + (w2 * 2 + 1) * 32 + hh * 16 + 4 * i4);
#pragma unroll
                for (int e = 0; e < 4; ++e) hround[4 * i4 + e] = p[e] * hround[4 * i4 + e] + hl[e]; }
        }
        float o[16];
        const unsigned gw_[8] = {g0.x, g0.y, g0.z, g0.w, g1.x, g1.y, g1.z, g1.w};
#pragma unroll
        for (int i = 0; i < 16; ++i) { const float h = bv[i] + av[i] * hin[i]; const float gt = (i & 1) ? pg8::bf_hi(gw_[i >> 1]) : pg8::bf_lo(gw_[i >> 1]); o[i] = gelu_tanh(gt) * h; }
        bf16* yr = Yb + (size_t)t * D + hd * 64 + 32 * jh + 8 * hh;
        v4u w0; w0.x = pkbf(o[0], o[1]); w0.y = pkbf(o[2], o[3]); w0.z = pkbf(o[4], o[5]); w0.w = pkbf(o[6], o[7]);
        v4u w1; w1.x = pkbf(o[8], o[9]); w1.y = pkbf(o[10], o[11]); w1.z = pkbf(o[12], o[13]); w1.w = pkbf(o[14], o[15]);
        *(v4u*)yr = w0; *(v4u*)(yr + 16) = w1;
    }
    if (w == 0 && q == 0) {
#pragma unroll
        for (int i = 0; i < 16; ++i) F.out[O_HP + (size_t)b * WA + hd * 64 + 32 * jh + 16 * (i >> 3) + 8 * hh + (i & 7)] = hround[i];
    }
    __syncthreads();
}

__device__ __forceinline__ void p3_mixers_ref(Frame& F, const Args& A) {
    LAS float* scr = (LAS float*)(F.lds + RING_OFF + F.wave * 1024);
    const int gw = F.wave * F.G + F.vcu, NGW = F.G * NWAVES;
    constexpr int N_RGP = NBP * HA, N_S5P = NBP * GB, N_RGS = NBS * HA, N_S5S = NBS * GB;
    if (F.vcu < N_S5P) s5_item_fast(F, A, F.vcu / GB, F.vcu % GB);
    for (int it = F.vcu + F.G; it < N_S5P; it += F.G) { for (int wv = F.wave; wv < 1; wv += NWAVES) s5_item_ref(F, A, true, it / GB, it % GB, scr); }
    if (F.vcu < 2 * N_RGP) rg_item_fast(F, A, F.vcu / (2 * HA), (F.vcu / 2) % HA, F.vcu & 1);
    for (int it = F.vcu + F.G; it < 2 * N_RGP; it += F.G) { if ((it & 1) == 0) for (int wv = F.wave; wv < 1; wv += NWAVES) rg_item_ref(F, A, true, it / (2 * HA), (it / 2) % HA, scr); }
    for (int it = gw; it < N_RGS + N_S5S; it += NGW) {
        int r = it;
        if (r < N_RGS) { rg_item_ref(F, A, false, r / HA, r % HA, scr); continue; } r -= N_RGS;
        s5_item_ref(F, A, false, r / GB, r % GB, scr);
    }
}

__global__ void __launch_bounds__(NWAVES * 64, 2) fwd(Args A) {
    extern __shared__ __attribute__((aligned(16))) unsigned char lds[];
    Frame F;
    F.lds = (LAS unsigned char*)lds;
    F.MISC = (volatile LAS unsigned*)(F.lds + MISC_OFF);
    F.tid = threadIdx.x; F.lane = F.tid & 63; F.wave = __builtin_amdgcn_readfirstlane(F.tid >> 6);
    F.G = gridDim.x; { const int bx = blockIdx.x; F.vcu = (F.G % 8 == 0) ? (bx % 8) * (F.G / 8) + bx / 8 : bx; }
    F.out = A.out; F.ws = A.ws; F.ctl = (gu32*)(A.ws + WS_CTL);
    for (int u = F.tid; u < (LDS_BYTES - LDSCTL_OFF) / 4; u += NWAVES * 64) ((LAS unsigned*)(F.lds + LDSCTL_OFF))[u] = 0u;
    __syncthreads();
    XcdBarrier bar; bar.bar = (unsigned*)(F.ctl + CW_BAR); bar.x = 0; bar.st = nullptr;
    if (N_LAUNCHES == 1) bar = xcd_barrier_post((unsigned*)(F.ctl + CW_BAR), F.MISC + 8);
#define GRID_BAR() do { if (N_LAUNCHES == 1) xcd_barrier(bar); } while (0)
    const int lo = A.ph_lo, hi = A.ph_hi;
#define IN(k) (lo <= (k) && (k) < hi)
#define BOTH(k) (IN(k) && IN((k) + 1))
    bf16* XN = (bf16*)(F.ws + WS_XN); bf16* Z = (bf16*)(F.ws + WS_Z); bf16* YC = (bf16*)(F.ws + WS_YCAT); bf16* GY = (bf16*)(F.ws + WS_G); bf16* U = (bf16*)(F.ws + WS_U);
    const float* mod = (const float*)(F.ws + WS_MOD);

#define REPS(k) (((PROBE_DUP) >> (k)) & 1 ? 2 : 1)
    if (IN(0)) { for (int rep = 0; rep < REPS(0); ++rep) p0_prologue(F, A, rep); if (BOTH(0)) GRID_BAR(); }
    if (IN(1)) { for (int rep = 0; rep < REPS(1); ++rep) p1_modulate(F, A); if (BOTH(1)) GRID_BAR(); }
    if (IN(2)) for (int rep = 0; rep < REPS(2); ++rep) {
        pg8::Gemm g{XN, (const bf16*)(F.ws + WS_WIN), M, NZ, D}; pg8::StaticOrder S; S.init(M, NZ, F.G, (int)blockIdx.x);
        pg8::EpiBf16<0> E{Z, NZ, nullptr};
        pg8::gemm_phase<pg8::EpiBf16<0>, pg8::StaticOrder, PG8_ALIGN, PG8_SP2>(F.lds + RING_OFF, g, S, E);
        if (BOTH(2) && rep == REPS(2) - 1) GRID_BAR();
    }
    if (IN(3)) { p3_mixers_ref(F, A); if (REPS(3) == 2) { __syncthreads(); p3_mixers_ref(F, A); } if (BOTH(3)) GRID_BAR(); }
    if (IN(4)) for (int rep = 0; rep < REPS(4); ++rep) {
        pg8::Gemm g{GY, (const bf16*)(F.ws + WS_WGLU), M, WB, WB}; pg8::StaticOrder S; S.init(M, WB, F.G, (int)blockIdx.x);
        pg8::EpiGlu E{GY, WB, YC, D, WA, A.in[I_GLUB]};
        pg8::gemm_phase<pg8::EpiGlu, pg8::StaticOrder, PG8_ALIGN, PG8_SP2>(F.lds + RING_OFF, g, S, E);
        if (BOTH(4) && rep == REPS(4) - 1) GRID_BAR();
    }
    if (IN(5)) {
        pg8::Gemm g{YC, (const bf16*)(F.ws + WS_WOUT), M, D, D}; pg8::StaticOrder S; S.init(M, D, F.G, (int)blockIdx.x);
        pg8::EpiRes E{A.in[I_XP], A.in[I_XS], F.out, mod + 2 * D, nullptr, ALPHA, MP};
        pg8::gemm_phase<pg8::EpiRes, pg8::StaticOrder, PG8_ALIGN, PG8_SP2>(F.lds + RING_OFF, g, S, E);
        if (BOTH(5)) GRID_BAR();
    }
    if (IN(6)) { ln_rows<false>(F, A); if (BOTH(6)) GRID_BAR(); }
    if (IN(7)) for (int rep = 0; rep < REPS(7); ++rep) {
        pg8::Gemm g{XN, (const bf16*)(F.ws + WS_W1), M, FF, D}; pg8::StaticOrder S; S.init(M, FF, F.G, (int)blockIdx.x);
        pg8::EpiBf16<3> E{U, FF, A.in[I_B1]};
        pg8::gemm_phase<pg8::EpiBf16<3>, pg8::StaticOrder, PG8_ALIGN, PG8_SP2>(F.lds + RING_OFF, g, S, E);
        if (BOTH(7) && rep == REPS(7) - 1) GRID_BAR();
    }
    if (IN(8)) {
        pg8::Gemm g{U, (const bf16*)(F.ws + WS_W2), M, D, FF}; pg8::StaticOrder S; S.init(M, D, F.G, (int)blockIdx.x);
        pg8::EpiRes E{F.out, F.out + (size_t)MP * D, F.out, mod + 5 * D, A.in[I_B2], ALPHA, MP};
        pg8::gemm_phase<pg8::EpiRes, pg8::StaticOrder, PG8_ALIGN, PG8_SP2>(F.lds + RING_OFF, g, S, E);
        if (BOTH(8)) GRID_BAR();
    }
    if (IN(9)) { ln_rows<true>(F, A); }
#undef IN
#undef BOTH
}

extern "C" void kernel_launch(void* const* d_in, const int* in_sizes, int n_in, void* d_out, int out_size, void* d_ws, size_t ws_size, hipStream_t stream) {
    static int grid = 0;
    if (grid == 0) {
        if (n_in != 37 || in_sizes[0] != MP * D || out_size != (int)O_END || ws_size < WS_END) { fprintf(stderr, "kernel_launch: unexpected shapes (n_in %d, in0 %d, out %d, ws %zu)\n", n_in, n_in > 0 ? in_sizes[0] : -1, out_size, ws_size); grid = -1; return; }
        int dev = 0, cus = 0, per_cu = 0;
        if (hipGetDevice(&dev) != hipSuccess || hipDeviceGetAttribute(&cus, hipDeviceAttributeMultiprocessorCount, dev) != hipSuccess) { grid = -1; return; }
        if (hipFuncSetAttribute((const void*)fwd, hipFuncAttributeMaxDynamicSharedMemorySize, LDS_BYTES) != hipSuccess) { fprintf(stderr, "kernel_launch: hipFuncSetAttribute failed\n"); grid = -1; return; }
        if (hipOccupancyMaxActiveBlocksPerMultiprocessor(&per_cu, (const void*)fwd, NWAVES * 64, LDS_BYTES) != hipSuccess || per_cu < 1) { fprintf(stderr, "kernel_launch: occupancy query says %d\n", per_cu); }
        (void)hipGetLastError();
        grid = cus;
    }
    if (grid < 0) return;
    (void)hipMemsetAsync((char*)d_ws + WS_CTL, 0, CTL_ZERO_BYTES, stream);
    Args a{};
    for (int i = 0; i < 37; ++i) a.in[i] = (const float*)d_in[i];
    a.out = (float*)d_out; a.ws = (unsigned char*)d_ws;
    for (int li = 0; li < N_LAUNCHES; ++li) {
        if (N_LAUNCHES == 1) { a.ph_lo = 0; a.ph_hi = N_PHASES; } else { a.ph_lo = li; a.ph_hi = li + 1; }
        a.li = li;
        hipLaunchKernelGGL(fwd, dim3(grid), dim3(NWAVES * 64), LDS_BYTES, stream, a);
    }
}
```

```cpp
#include <hip/hip_runtime.h>
#include <cstdio>
#include <cstdint>
#include <cmath>

#ifndef MK_N_LAUNCHES
#define MK_N_LAUNCHES 1
#endif

namespace pg8 {
#define PG8_LAS __attribute__((address_space(3)))
typedef unsigned short bf16_t;
typedef short bf16x8 __attribute__((ext_vector_type(8)));
typedef float f32x4 __attribute__((ext_vector_type(4)));
typedef unsigned u32x4 __attribute__((ext_vector_type(4)));
constexpr int BM = 256, BK = 64, HALF = 128, HTB = HALF * BK * 2, STAGE_BYTES = 8 * HTB, NXCD = 8, WGM = 8;

__host__ __device__ __forceinline__ int lds_byte(int r, int c) { const int st = (r >> 4) * 2 + (c >> 5), rr = r & 15, cc = c & 31, ob = rr * 64 + cc * 2; return st * 1024 + (ob ^ (((ob >> 9) & 1) << 5)); }
__host__ __device__ __forceinline__ void stage_rc(int b, int& R, int& C) { const int st = b / 1024, sb = b % 1024, swz = sb ^ (((sb >> 9) & 1) << 5); R = (st >> 1) * 16 + swz / 64; C = (st & 1) * 32 + (swz % 64) / 2; }
__host__ __device__ __forceinline__ int perm32(int rho) { const int n = rho >> 4, i = rho & 15; return 8 * (i >> 2) + 4 * n + (i & 3); }

struct Unit { int pm, pn; };
struct Gemm { const bf16_t* A; const bf16_t* Bt; int M, N, K; };

struct StaticOrder {
    int nM, nN, nwg, G, c;
    __host__ __device__ void init(int M, int N, int G_, int c_) { nM = M / BM; nN = N / BM; nwg = nM * nN; G = G_; c = c_; }
    __host__ __device__ bool next(int i, Unit& u) const {
        const long L = (long)i * G + c; if (L >= nwg) return false;
        int wgid = (int)L; { const int q = nwg / NXCD, r = nwg % NXCD, xcd = wgid % NXCD, off = wgid / NXCD; wgid = (xcd < r ? xcd * (q + 1) : r * (q + 1) + (xcd - r) * q) + off; }
        const int nig = WGM * nN, gid = wgid / nig, fm = gid * WGM, gsz = (nM - fm) < WGM ? (nM - fm) : WGM;
        u.pm = fm + ((wgid % nig) % gsz); u.pn = (wgid % nig) / gsz; return true;
    }
    __device__ __forceinline__ void a_ready(const Unit&) const {}
    __device__ __forceinline__ void done(const Unit&) const {}
};

__device__ __forceinline__ unsigned cvt_pk_bf16(float lo, float hi) { unsigned r; asm volatile("v_cvt_pk_bf16_f32 %0, %1, %2" : "=v"(r) : "v"(lo), "v"(hi)); return r; }
__device__ __forceinline__ float bf_lo(unsigned w) { return __builtin_bit_cast(float, w << 16); }
__device__ __forceinline__ float bf_hi(unsigned w) { return __builtin_bit_cast(float, w & 0xffff0000u); }

template <int ACT> struct EpiBf16 {
    static constexpr bool PERM = true, AFTER_DRAIN = false;
    bf16_t* O; int ldc; const float* bias;
    __device__ __forceinline__ void operator()(const f32x4 (&acc)[2][2][4][2], const Unit& u, int wr, int wc, int fr, int fq) const {
        const int row0 = u.pm * BM + wr * 64 + fr; const int col0 = u.pn * BM + wc * 32 + 8 * fq;
        f32x4 bv[2][2];
#pragma unroll
        for (int bj = 0; bj < 2; ++bj)
#pragma unroll
            for (int n = 0; n < 2; ++n) bv[bj][n] = bias ? *(const f32x4*)(bias + col0 + bj * HALF + 4 * n) : (f32x4){0.f, 0.f, 0.f, 0.f};
#pragma unroll
        for (int ai = 0; ai < 2; ++ai)
#pragma unroll
            for (int m = 0; m < 4; ++m) { bf16_t* rowp = O + (size_t)(row0 + ai * HALF + m * 16) * ldc + col0;
#pragma unroll
                for (int bj = 0; bj < 2; ++bj) { f32x4 v0 = acc[ai][bj][m][0] + bv[bj][0], v1 = acc[ai][bj][m][1] + bv[bj][1];
                    if (ACT == 3) {
#pragma unroll
                        for (int e = 0; e < 4; ++e) { const float a = fmaxf(v0[e], 0.f), b = fmaxf(v1[e], 0.f); v0[e] = a * a; v1[e] = b * b; } }
                    u32x4 w; w.x = cvt_pk_bf16(v0[0], v0[1]); w.y = cvt_pk_bf16(v0[2], v0[3]); w.z = cvt_pk_bf16(v1[0], v1[1]); w.w = cvt_pk_bf16(v1[2], v1[3]);
                    *(u32x4*)(rowp + bj * HALF) = w; } }
    }
};
struct EpiGlu {
    static constexpr bool PERM = true, AFTER_DRAIN = false;
    const bf16_t* Gy; int ldg; bf16_t* O; int ldc; int coff; const float* bias;
    __device__ __forceinline__ void operator()(const f32x4 (&acc)[2][2][4][2], const Unit& u, int wr, int wc, int fr, int fq) const {
        const int row0 = u.pm * BM + wr * 64 + fr; const int col0 = u.pn * BM + wc * 32 + 8 * fq;
        f32x4 bv[2][2];
#pragma unroll
        for (int bj = 0; bj < 2; ++bj)
#pragma unroll
            for (int n = 0; n < 2; ++n) bv[bj][n] = *(const f32x4*)(bias + col0 + bj * HALF + 4 * n);
#pragma unroll
        for (int ai = 0; ai < 2; ++ai)
#pragma unroll
            for (int m = 0; m < 4; ++m) { const size_t row = (size_t)(row0 + ai * HALF + m * 16);
#pragma unroll
                for (int bj = 0; bj < 2; ++bj) { const f32x4 v0 = acc[ai][bj][m][0] + bv[bj][0], v1 = acc[ai][bj][m][1] + bv[bj][1];
                    const u32x4 g = *(const u32x4*)(Gy + row * ldg + col0 + bj * HALF);
                    float o[8];
                    o[0] = bf_lo(g.x) * __builtin_amdgcn_rcpf(1.f + __builtin_amdgcn_exp2f(-1.4426950408889634f * v0[0])); o[1] = bf_hi(g.x) * __builtin_amdgcn_rcpf(1.f + __builtin_amdgcn_exp2f(-1.4426950408889634f * v0[1]));
                    o[2] = bf_lo(g.y) * __builtin_amdgcn_rcpf(1.f + __builtin_amdgcn_exp2f(-1.4426950408889634f * v0[2])); o[3] = bf_hi(g.y) * __builtin_amdgcn_rcpf(1.f + __builtin_amdgcn_exp2f(-1.4426950408889634f * v0[3]));
                    o[4] = bf_lo(g.z) * __builtin_amdgcn_rcpf(1.f + __builtin_amdgcn_exp2f(-1.4426950408889634f * v1[0])); o[5] = bf_hi(g.z) * __builtin_amdgcn_rcpf(1.f + __builtin_amdgcn_exp2f(-1.4426950408889634f * v1[1]));
                    o[6] = bf_lo(g.w) * __builtin_amdgcn_rcpf(1.f + __builtin_amdgcn_exp2f(-1.4426950408889634f * v1[2])); o[7] = bf_hi(g.w) * __builtin_amdgcn_rcpf(1.f + __builtin_amdgcn_exp2f(-1.4426950408889634f * v1[3]));
                    u32x4 w; w.x = cvt_pk_bf16(o[0], o[1]); w.y = cvt_pk_bf16(o[2], o[3]); w.z = cvt_pk_bf16(o[4], o[5]); w.w = cvt_pk_bf16(o[6], o[7]);
                    *(u32x4*)(O + row * ldc + coff + col0 + bj * HALF) = w; } }
    }
};
struct EpiRes {
    static constexpr bool PERM = false, AFTER_DRAIN = false;
    const float* basep; const float* bases; float* out; const float* gate  ; const float* bias; float alpha; int MP;
    __device__ __forceinline__ void operator()(const f32x4 (&acc)[2][2][4][2], const Unit& u, int wr, int wc, int fr, int fq) const {
        const int row0 = u.pm * BM + wr * 64 + fr, col0 = u.pn * BM + wc * 32 + 4 * fq;
        f32x4 bv[2][2];
#pragma unroll
        for (int bj = 0; bj < 2; ++bj)
#pragma unroll
            for (int n = 0; n < 2; ++n) bv[bj][n] = bias ? *(const f32x4*)(bias + col0 + bj * HALF + n * 16) : (f32x4){0.f, 0.f, 0.f, 0.f};
#pragma unroll
        for (int ai = 0; ai < 2; ++ai)
#pragma unroll
            for (int m = 0; m < 4; ++m) { const int row = row0 + ai * HALF + m * 16;
                const bool smp = row >= MP; const int mr = smp ? 8 + ((row - MP) >> 2) : (row >> 11);
                const float* bp = smp ? bases + (size_t)(row - MP) * 1024 : basep + (size_t)row * 1024;
                const float* gp = gate + (size_t)mr * 6144; float* op = out + (size_t)row * 1024;
#pragma unroll
                for (int bj = 0; bj < 2; ++bj)
#pragma unroll
                    for (int n = 0; n < 2; ++n) { const int c = col0 + bj * HALF + n * 16;
                        const f32x4 b = *(const f32x4*)(bp + c), g = *(const f32x4*)(gp + c);
                        *(f32x4*)(op + c) = b * alpha + g * (acc[ai][bj][m][n] + bv[bj][n]); } }
    }
};

template <class Epi, class Sched, bool ALIGN_EPI = false, bool SP2 = false>
__device__ __forceinline__ void gemm_phase(PG8_LAS unsigned char* lds, const Gemm g, const Sched& S, const Epi& E) {
    const int tid = threadIdx.x, wid = __builtin_amdgcn_readfirstlane(tid >> 6), lane = tid & 63, wr = wid >> 2, wc = wid & 3, fr = lane & 15, fq = lane >> 4;
    const int K = g.K, nt = K / BK;
    unsigned voffA[2], voffB[2];
#pragma unroll
    for (int i = 0; i < 2; ++i) { int R, C; stage_rc(tid * 16 + i * 8192, R, C); const int Rb = Epi::PERM ? ((R & ~31) + perm32(R & 31)) : R;
        voffA[i] = (unsigned)(R * K + C) * 2u; voffB[i] = (unsigned)(Rb * K + C) * 2u; }
    const size_t kstep = (size_t)(BK * 2);
    const size_t hstep = (size_t)HALF * K * 2;
    const size_t tstep = 2 * hstep;
    const unsigned ldsw = (unsigned)wid * 1024u;
    const int aoff = lds_byte(wr * 64 + fr, fq * 8), boff = lds_byte(wc * 32 + fr, fq * 8);
#define PG8_SA(b, h) (((b) * 2 + (h)) * HTB)
#define PG8_SB(b, h) ((4 + (b) * 2 + (h)) * HTB)
#define PG8_STAGE(bufoff, gbase, voff) do { _Pragma("unroll") for (int _i = 0; _i < 2; ++_i) \
        __builtin_amdgcn_global_load_lds((const unsigned*)((const char*)(gbase) + (voff)[_i]), (PG8_LAS unsigned*)(lds + (bufoff) + ldsw + _i * 8192), 16, 0, 0); } while (0)
#define PG8_LDA(dst, b, h) do { _Pragma("unroll") for (int m = 0; m < 4; ++m) _Pragma("unroll") for (int k = 0; k < 2; ++k) dst[m][k] = *(const PG8_LAS bf16x8*)(lds + PG8_SA(b, h) + aoff + m * 2048 + k * 1024); } while (0)
#define PG8_LDB(dst, b, h) do { _Pragma("unroll") for (int n = 0; n < 2; ++n) _Pragma("unroll") for (int k = 0; k < 2; ++k) dst[n][k] = *(const PG8_LAS bf16x8*)(lds + PG8_SB(b, h) + boff + n * 2048 + k * 1024); } while (0)
#define PG8_MMA(ai, bj, At, Bt) do { __builtin_amdgcn_s_setprio(1); _Pragma("unroll") for (int m = 0; m < 4; ++m) _Pragma("unroll") for (int n = 0; n < 2; ++n) _Pragma("unroll") for (int k = 0; k < 2; ++k) \
        acc[ai][bj][m][n] = __builtin_amdgcn_mfma_f32_16x16x32_bf16(Bt[n][k], At[m][k], acc[ai][bj][m][n], 0, 0, 0); __builtin_amdgcn_s_setprio(0); } while (0)
#define PG8_WAIT_V(n) asm volatile("s_waitcnt vmcnt(" #n ")" ::: "memory")
#define PG8_WAIT_L(n) asm volatile("s_waitcnt lgkmcnt(" #n ")" ::: "memory")
#define PG8_BAR __builtin_amdgcn_s_barrier()
#define PG8_SCHED __builtin_amdgcn_sched_barrier(0)
    Unit cur, nxt; int ui = 0;
    if (!S.next(0, cur)) return;
    f32x4 acc[2][2][4][2];
#pragma unroll
    for (int a = 0; a < 2; ++a)
#pragma unroll
        for (int b = 0; b < 2; ++b)
#pragma unroll
            for (int m = 0; m < 4; ++m)
#pragma unroll
                for (int n = 0; n < 2; ++n) acc[a][b][m][n] = (f32x4){0.f, 0.f, 0.f, 0.f};
    bf16x8 At[4][2], B0[2][2], B1[2][2];
    const char* cA = (const char*)g.A + (size_t)cur.pm * tstep; const char* cB = (const char*)g.Bt + (size_t)cur.pn * tstep;
    S.a_ready(cur);
    if constexpr (SP2) {
        PG8_STAGE(PG8_SB(0, 0), cB, voffB); PG8_STAGE(PG8_SB(0, 1), cB + hstep, voffB); PG8_STAGE(PG8_SA(0, 0), cA, voffA); PG8_STAGE(PG8_SA(0, 1), cA + hstep, voffA);
        if (wr == 1) PG8_BAR;
        PG8_WAIT_V(2); PG8_BAR;
        PG8_STAGE(PG8_SB(1, 0), cB + kstep, voffB); PG8_STAGE(PG8_SA(1, 0), cA + kstep, voffA); PG8_STAGE(PG8_SB(1, 1), cB + hstep + kstep, voffB);
        PG8_WAIT_V(6); PG8_BAR;
    } else {
        PG8_STAGE(PG8_SB(0, 0), cB, voffB); PG8_STAGE(PG8_SA(0, 0), cA, voffA); PG8_STAGE(PG8_SB(0, 1), cB + hstep, voffB); PG8_STAGE(PG8_SA(0, 1), cA + hstep, voffA);
        if (wr == 1) PG8_BAR;
        PG8_WAIT_V(4); PG8_BAR;
        PG8_STAGE(PG8_SB(1, 0), cB + kstep, voffB); PG8_STAGE(PG8_SA(1, 0), cA + kstep, voffA); PG8_STAGE(PG8_SB(1, 1), cB + hstep + kstep, voffB);
        PG8_WAIT_V(6); PG8_BAR;
    }
    for (;;) {
        const bool has_next = S.next(ui + 1, nxt);
        const char* nA = has_next ? (const char*)g.A + (size_t)nxt.pm * tstep : cA; const char* nB = has_next ? (const char*)g.Bt + (size_t)nxt.pn * tstep : cB;
        for (int t = 0; t < nt; t += 2) {
            const bool last = (t == nt - 2);
            const char* a1 = cA + (size_t)(t + 1) * kstep;
            const char* a2 = last ? nA : cA + (size_t)(t + 2) * kstep; const char* b2 = last ? nB : cB + (size_t)(t + 2) * kstep;
            const char* a3 = a2 + kstep; const char* b3 = b2 + kstep;
            if (last && has_next) S.a_ready(nxt);
            if constexpr (SP2) {
            PG8_LDB(B0, 0, 0); PG8_LDB(B1, 0, 1); PG8_SCHED; PG8_LDA(At, 0, 0); PG8_STAGE(PG8_SA(1, 1), a1 + hstep, voffA);
            PG8_WAIT_V(8); PG8_WAIT_L(0); PG8_BAR; PG8_MMA(0, 0, At, B0); PG8_MMA(0, 1, At, B1); PG8_BAR; PG8_SCHED;
            PG8_LDA(At, 0, 1); PG8_STAGE(PG8_SB(0, 0), b2, voffB); PG8_STAGE(PG8_SB(0, 1), b2 + hstep, voffB); PG8_STAGE(PG8_SA(0, 0), a2, voffA);
            PG8_WAIT_V(8); PG8_WAIT_L(0); PG8_BAR; PG8_MMA(1, 0, At, B0); PG8_MMA(1, 1, At, B1); PG8_BAR; PG8_SCHED;
            PG8_LDB(B0, 1, 0); PG8_LDB(B1, 1, 1); PG8_SCHED; PG8_LDA(At, 1, 0); PG8_STAGE(PG8_SA(0, 1), a2 + hstep, voffA);
            PG8_WAIT_V(8); PG8_WAIT_L(0); PG8_BAR; PG8_MMA(0, 0, At, B0); PG8_MMA(0, 1, At, B1); PG8_BAR; PG8_SCHED;
            PG8_LDA(At, 1, 1); PG8_STAGE(PG8_SB(1, 0), b3, voffB); PG8_STAGE(PG8_SB(1, 1), b3 + hstep, voffB); PG8_STAGE(PG8_SA(1, 0), a3, voffA);
            PG8_WAIT_V(8); PG8_WAIT_L(0); PG8_BAR; PG8_MMA(1, 0, At, B0); PG8_MMA(1, 1, At, B1); PG8_BAR; PG8_SCHED;
            } else {
            PG8_LDB(B0, 0, 0); PG8_SCHED; PG8_LDA(At, 0, 0); PG8_STAGE(PG8_SA(1, 1), a1 + hstep, voffA);
            PG8_WAIT_L(8); PG8_BAR; PG8_WAIT_L(0); PG8_MMA(0, 0, At, B0); PG8_BAR; PG8_SCHED;
            PG8_LDB(B1, 0, 1); PG8_STAGE(PG8_SB(0, 0), b2, voffB);
            PG8_BAR; PG8_WAIT_L(0); PG8_MMA(0, 1, At, B1); PG8_BAR;
            PG8_LDA(At, 0, 1); PG8_STAGE(PG8_SA(0, 0), a2, voffA);
            PG8_BAR; PG8_WAIT_L(0); PG8_MMA(1, 0, At, B0); PG8_BAR; PG8_SCHED;
            PG8_STAGE(PG8_SB(0, 1), b2 + hstep, voffB);
            PG8_WAIT_V(6); PG8_BAR; PG8_MMA(1, 1, At, B1); PG8_BAR;
            PG8_LDB(B0, 1, 0); PG8_SCHED; PG8_LDA(At, 1, 0); PG8_STAGE(PG8_SA(0, 1), a2 + hstep, voffA);
            PG8_WAIT_L(8); PG8_BAR; PG8_WAIT_L(0); PG8_MMA(0, 0, At, B0); PG8_BAR; PG8_SCHED;
            PG8_LDB(B1, 1, 1); PG8_STAGE(PG8_SB(1, 0), b3, voffB);
            PG8_BAR; PG8_WAIT_L(0); PG8_MMA(0, 1, At, B1); PG8_BAR;
            PG8_LDA(At, 1, 1); PG8_STAGE(PG8_SA(1, 0), a3, voffA);
            PG8_BAR; PG8_WAIT_L(0); PG8_MMA(1, 0, At, B0); PG8_BAR; PG8_SCHED;
            PG8_STAGE(PG8_SB(1, 1), b3 + hstep, voffB);
            PG8_WAIT_V(6); PG8_BAR; PG8_MMA(1, 1, At, B1); PG8_BAR;
            }
        }
        if constexpr (ALIGN_EPI) { if (wr == 0) PG8_BAR; }
        if constexpr (!Epi::AFTER_DRAIN) { E(acc, cur, wr, wc, fr, fq); S.done(cur); }
        if (!has_next) break;
#pragma unroll
        for (int a = 0; a < 2; ++a)
#pragma unroll
            for (int b = 0; b < 2; ++b)
#pragma unroll
                for (int m = 0; m < 4; ++m)
#pragma unroll
                    for (int n = 0; n < 2; ++n) acc[a][b][m][n] = (f32x4){0.f, 0.f, 0.f, 0.f};
        cur = nxt; cA = nA; cB = nB; ++ui;
        if constexpr (ALIGN_EPI) { if (wr == 1) PG8_BAR; }
    }
    PG8_WAIT_V(0);
    if constexpr (!ALIGN_EPI) { if (wr == 0) PG8_BAR; }
    PG8_BAR;
#undef PG8_SA
#undef PG8_SB
#undef PG8_STAGE
#undef PG8_LDA
#undef PG8_LDB
#undef PG8_MMA
#undef PG8_WAIT_V
#undef PG8_WAIT_L
#undef PG8_BAR
#undef PG8_SCHED
}
}

#ifndef PROBE_DUP
#define PROBE_DUP 0
#endif
#ifndef PG8_SP2
#define PG8_SP2 true
#endif
#ifndef PG8_ALIGN
#define PG8_ALIGN true
#endif

constexpr int NWAVES = 8;
constexpr int N_LAUNCHES = MK_N_LAUNCHES;
constexpr int N_PHASES = 10;
constexpr int D = 1024, MP = 16384, MS = 512, M = MP + MS, TP = 2048, NBP = 8, NBS = 128, TS = 4;
constexpr int NZ = 1536, WA = 512, WB = 512, FF = 4096, NMOD = 6 * D, NROWMOD = NBP + NBS;
constexpr int GB = 32, NS5 = 64, KS5 = 16, HA = 8, HDA = 64;
constexpr float LN_EPS = 1e-5f;
constexpr float ALPHA = 1.189207115002721f;

constexpr size_t O_YP = 0, O_YS = (size_t)MP * D, O_CONVP = O_YS + (size_t)MS * D, O_HP = O_CONVP + (size_t)NBP * 3 * WA, O_SRP = O_HP + (size_t)NBP * WA,
                 O_SIP = O_SRP + (size_t)NBP * GB * NS5, O_CONVS = O_SIP + (size_t)NBP * GB * NS5, O_HS = O_CONVS + (size_t)NBS * 3 * WA, O_SRS = O_HS + (size_t)NBS * WA,
                 O_SIS = O_SRS + (size_t)NBS * GB * NS5, O_END = O_SIS + (size_t)NBS * GB * NS5;

constexpr size_t MiB = 1u << 20;
constexpr size_t WS_CTL = 0, CTL_ZERO_BYTES = 1 * MiB;
constexpr size_t WS_WIN = 1 * MiB, WS_WGLU = 4 * MiB, WS_WOUT = 5 * MiB, WS_W1 = 7 * MiB, WS_W2 = 15 * MiB;
constexpr size_t WS_MOD = 23 * MiB;
constexpr size_t WS_S5C = 27 * MiB;
constexpr size_t WS_XN = 28 * MiB;
constexpr size_t WS_Z = 61 * MiB;
constexpr size_t WS_YCAT = 111 * MiB;
constexpr size_t WS_G = 144 * MiB;
constexpr size_t WS_U = 61 * MiB;
constexpr size_t WS_TAB = 194 * MiB;
constexpr size_t WS_END = 196 * MiB;
constexpr size_t TB_BF1 = 0, TB_BF2 = TB_BF1 + 32 * 4 * 64 * 16, TB_TA = TB_BF2 + 32 * 8 * 64 * 16, TB_ZP = TB_TA + 32 * 2 * 2 * 32 * 4, TB_Z16N = TB_ZP + 32 * 17 * 2 * 2 * 32 * 4,
                 TB_RG = TB_Z16N + 32 * 2 * 64 * 4, TB_CB = TB_RG + 8 * 2 * 2 * 4 * 64 * 16, TB_END = TB_CB + 128 * 3 * 512 * 2;
static_assert(WS_TAB + TB_END <= WS_END, "tables");
static_assert(WS_XN + (size_t)M * D * 2 <= WS_Z && WS_Z + (size_t)M * NZ * 2 <= WS_YCAT && WS_YCAT + (size_t)M * D * 2 <= WS_G && WS_G + (size_t)M * WB * 2 <= WS_END && WS_U + (size_t)M * FF * 2 <= WS_TAB, "d_ws map");
constexpr int SC_ABR = 0, SC_ABI = 2048, SC_BBR = 4096, SC_BBI = 4096 + 32768, SC_RGL = 4096 + 65536, SC_END = SC_RGL + 512;
constexpr int CW_TMO = 0, CW_CODE = 1, CW_BAR = 4096;

constexpr int RING_OFF = 0, RING_BYTES = 131072;
constexpr int LDSCTL_OFF = RING_BYTES, MISC_OFF = LDSCTL_OFF + 320;
constexpr int LDS_BYTES = 147456;

#define GAS __attribute__((address_space(1)))
#define LAS __attribute__((address_space(3)))
typedef unsigned short bf16;
typedef unsigned v4u __attribute__((ext_vector_type(4)));
typedef float f32x4 __attribute__((ext_vector_type(4)));
typedef GAS unsigned gu32;
#define RLX_AGENT __ATOMIC_RELAXED, __HIP_MEMORY_SCOPE_AGENT
#define LDS_WAIT() asm volatile("s_waitcnt lgkmcnt(0)" ::: "memory")
#define VM_WAIT() asm volatile("s_waitcnt vmcnt(0)" ::: "memory")
__device__ __forceinline__ unsigned f2bf(float f) { unsigned u = __builtin_bit_cast(unsigned, f); return (u + 0x7fffu + ((u >> 16) & 1u)) >> 16; }
__device__ __forceinline__ unsigned pk2(float lo, float hi) { return f2bf(lo) | (f2bf(hi) << 16); }
__device__ __forceinline__ float bf2f(bf16 v) { return __builtin_bit_cast(float, (unsigned)v << 16); }
__device__ __forceinline__ float gelu_tanh(float x) { const float t = -2.3022082f * (x + 0.044715f * x * x * x); return x * __builtin_amdgcn_rcpf(1.f + __builtin_amdgcn_exp2f(t)); }
__device__ __forceinline__ float sigmoidf_(float x) { return __builtin_amdgcn_rcpf(1.f + __builtin_amdgcn_exp2f(-1.4426950408889634f * x)); }

#define XB_TMO      128
#define XB_XCNT(j)  (256  + 64 * (j))
#define XB_XSUB(j)  (1280 + 64 * (j))
#define XB_XGEN(j)  (2304 + 64 * (j))
#define XB_TOP      3328
#define XB_TOPGEN   3392
#define XCD_BAR_WORDS 3456
#define XB_SPIN_CAP (1u << 18)
__device__ __forceinline__ unsigned xb_ld(unsigned* p)              { return __hip_atomic_load(p, __ATOMIC_RELAXED, __HIP_MEMORY_SCOPE_AGENT); }
__device__ __forceinline__ unsigned xb_add(unsigned* p, unsigned v) { return __hip_atomic_fetch_add(p, v, __ATOMIC_RELAXED, __HIP_MEMORY_SCOPE_AGENT); }
__device__ __forceinline__ unsigned xb_xcc_id() { return (unsigned)__builtin_amdgcn_s_getreg((3 << 11) | 20) & 0xFu; }
#define XB_SPIN(cond, bar) do { unsigned _sp = 0; while (cond) { __builtin_amdgcn_s_sleep(1); \
    if ((++_sp & 255u) == 0u) { if (xb_ld(&(bar)[XB_TMO])) break; if (_sp > XB_SPIN_CAP) { atomicAdd(&(bar)[XB_TMO], 1u); break; } } } } while (0)
struct XcdBarrier { unsigned* bar; unsigned x; volatile LAS unsigned* st; };
__device__ __forceinline__ XcdBarrier xcd_barrier_post(unsigned* bar, volatile LAS unsigned* st) {
    XcdBarrier b; b.bar = bar; b.x = xb_xcc_id(); b.st = st;
    if (threadIdx.x == 0) (void)xb_add(&bar[XB_XCNT(b.x)], 1u);
    return b;
}
__device__ __forceinline__ void xcd_barrier_complete(unsigned* bar, unsigned x, unsigned& nloc, unsigned& nx) {
    const unsigned G = gridDim.x * gridDim.y * gridDim.z;
    unsigned sum, cnt, mine, sp = 0u;
    for (;;) {
        sum = 0u; cnt = 0u; mine = 0u;
#pragma unroll
        for (unsigned j = 0; j < 16; ++j) { const unsigned c = xb_ld(&bar[XB_XCNT(j)]); sum += c; cnt += (c > 0u) ? 1u : 0u; mine = (j == x) ? c : mine; }
        if (sum == G) break;
        __builtin_amdgcn_s_sleep(1);
        if ((++sp & 255u) == 0u) { if (xb_ld(&bar[XB_TMO])) break; if (sp > XB_SPIN_CAP) { atomicAdd(&bar[XB_TMO], 1u); break; } }
    }
    nloc = mine > 0u ? mine : 1u; nx = cnt > 0u ? cnt : 1u;
}
__device__ __forceinline__ void xcd_barrier(const XcdBarrier& b) {
    asm volatile("s_waitcnt vmcnt(0)" ::: "memory");
    __syncthreads();
    if (threadIdx.x == 0) {
        unsigned* bar = b.bar;
        __builtin_amdgcn_s_waitcnt(0);
        unsigned nloc = b.st[0], nx = b.st[1];
        if (nloc == 0u) { xcd_barrier_complete(bar, b.x, nloc, nx); b.st[0] = nloc; b.st[1] = nx; }
        const unsigned old = xb_add(&bar[XB_XSUB(b.x)], 1u);
        const unsigned gen = old / nloc;
        if (old + 1u == (gen + 1u) * nloc) {
            __builtin_amdgcn_fence(__ATOMIC_RELEASE, "agent");
            asm volatile("s_waitcnt vmcnt(0)" ::: "memory");
            const unsigned og = xb_add(&bar[XB_TOP], 1u);
            const unsigned tg = og / nx;
            if (og + 1u == (tg + 1u) * nx) xb_add(&bar[XB_TOPGEN], 1u);
            else XB_SPIN(xb_ld(&bar[XB_TOPGEN]) == tg, bar);
            __builtin_amdgcn_fence(__ATOMIC_ACQUIRE, "agent");
            xb_add(&bar[XB_XGEN(b.x)], 1u);
            asm volatile("s_waitcnt vmcnt(0)" ::: "memory");
        } else {
            XB_SPIN(xb_ld(&bar[XB_XGEN(b.x)]) == gen, bar);
            __builtin_amdgcn_fence(__ATOMIC_ACQUIRE, "agent");
            asm volatile("s_waitcnt vmcnt(0)" ::: "memory");
        }
    }
    __syncthreads();
}

struct Frame {
    LAS unsigned char* lds;
    volatile LAS unsigned* MISC;
    gu32* ctl;
    int tid, lane, wave;
    int vcu, G;
    float* out;
    unsigned char* ws;
};
struct Args { const float* in[37]; float* out; unsigned char* ws; int ph_lo, ph_hi, li, pad; };
__device__ __forceinline__ float wave_sum(float v) {
#pragma unroll
    for (int o = 1; o < 64; o <<= 1) v += __shfl_xor(v, o);
    return v;
}
enum { I_XP = 0, I_XS, I_SCONV, I_SH, I_SSR, I_SSI, I_CP, I_CS, I_ADAW, I_ADAB, I_INPROJ, I_CONVW, I_CONVB, I_RGWR, I_RGBR, I_RGWI, I_RGBI, I_RGLAM,
       I_S5ARE, I_S5AIM, I_S5LOGDT, I_S5BRE, I_S5BIM, I_S5CRE, I_S5CIM, I_S5D, I_GLUW, I_GLUB, I_OUTPROJ, I_LN1G, I_LN1B, I_W1, I_B1, I_W2, I_B2, I_LN2G, I_LN2B };

typedef float f32x2m __attribute__((ext_vector_type(2)));
typedef __bf16 bf16x2m __attribute__((ext_vector_type(2)));
__device__ __forceinline__ unsigned pkbf0(float a, float b) { const f32x2m v = {a, b}; const bf16x2m r = __builtin_convertvector(v, bf16x2m); return __builtin_bit_cast(unsigned, r); }
typedef short bf16x8m __attribute__((ext_vector_type(8)));
typedef float f32x16m __attribute__((ext_vector_type(16)));
__device__ __forceinline__ void p0_transpose_item(const float* W, int K, int N, bf16* WT, LAS float* scr, int item, int lane) {
    const int nblk = N / 32, kb = item / nblk, nb = item % nblk, k0 = 64 * kb, n0 = 32 * nb;
#pragma unroll 8
    for (int i = 0; i < 32; ++i) { const int kk = 2 * i + (lane >> 5); scr[kk * 33 + (lane & 31)] = W[(size_t)(k0 + kk) * N + n0 + (lane & 31)]; }
    LDS_WAIT(); asm volatile("" ::: "memory");
    const int c = lane & 7;
#pragma unroll
    for (int j = 0; j < 4; ++j) { const int n = (lane >> 3) + 8 * j; const LAS float* s = scr + (8 * c) * 33 + n;
        v4u o; o.x = pk2(s[0 * 33], s[1 * 33]); o.y = pk2(s[2 * 33], s[3 * 33]); o.z = pk2(s[4 * 33], s[5 * 33]); o.w = pk2(s[6 * 33], s[7 * 33]);
        *(GAS v4u*)(WT + (size_t)(n0 + n) * K + k0 + 8 * c) = o; }
    LDS_WAIT(); asm volatile("" ::: "memory");
}

#ifndef PROBE_P0PART
#define PROBE_P0PART 7
#endif
__device__ __forceinline__ void p0_prologue(Frame& F, const Args& A, int rep = 0) {
    const int pmask = rep ? PROBE_P0PART : 7;
    LAS float* scr = (LAS float*)(F.lds + RING_OFF + F.wave * 16384);
    const int gw = F.wave * F.G + F.vcu, NGW = F.G * NWAVES;
    constexpr int I_IN = (D / 64) * (NZ / 32), I_GL = (WB / 64) * (WB / 32), I_OU = (D / 64) * (D / 32), I_1 = (D / 64) * (FF / 32), I_2 = (FF / 64) * (D / 32);
    constexpr int I_S5 = GB, I_RG = WA / 64, I_RGT = HA * 2 * 2 * 4, I_CB = NBS * 3 * WA / 512;
    constexpr int NITEMS = I_IN + I_GL + I_OU + I_1 + I_2 + I_S5 + I_RG + I_RGT + I_CB;
    float* sc = (float*)(F.ws + WS_S5C);
    for (int it = gw; it < NITEMS; it += NGW) {
        int r = it;
        if (!(pmask & 1) && it < I_IN + I_GL + I_OU + I_1 + I_2) continue;
        if (!(pmask & 2) && it >= I_IN + I_GL + I_OU + I_1 + I_2) continue;
        if (r < I_IN) { p0_transpose_item(A.in[I_INPROJ], D, NZ, (bf16*)(F.ws + WS_WIN), scr, r, F.lane); continue; } r -= I_IN;
        if (r < I_GL) { p0_transpose_item(A.in[I_GLUW], WB, WB, (bf16*)(F.ws + WS_WGLU), scr, r, F.lane); continue; } r -= I_GL;
        if (r < I_OU) { p0_transpose_item(A.in[I_OUTPROJ], D, D, (bf16*)(F.ws + WS_WOUT), scr, r, F.lane); continue; } r -= I_OU;
        if (r < I_1) { p0_transpose_item(A.in[I_W1], D, FF, (bf16*)(F.ws + WS_W1), scr, r, F.lane); continue; } r -= I_1;
        if (r < I_2) { p0_transpose_item(A.in[I_W2], FF, D, (bf16*)(F.ws + WS_W2), scr, r, F.lane); continue; } r -= I_2;
        if (r < I_S5) {
            const int g = r, n = F.lane, gn = g * NS5 + n;
            const double dt = exp((double)A.in[I_S5LOGDT][g]), ar = (double)A.in[I_S5ARE][gn], ai = (double)A.in[I_S5AIM][gn];
            const double mag = exp(dt * ar), abr = mag * cos(dt * ai), abi = mag * sin(dt * ai), den = ar * ar + ai * ai, nr = abr - 1.0;
            const double qr = (nr * ar + abi * ai) / den, qi = (abi * ar - nr * ai) / den;
            sc[SC_ABR + gn] = (float)abr; sc[SC_ABI + gn] = (float)abi;
            unsigned char* tab = F.ws + WS_TAB;
            bf16* BF1 = (bf16*)(tab + TB_BF1); bf16* BF2 = (bf16*)(tab + TB_BF2); float* TA = (float*)(tab + TB_TA); float* ZP = (float*)(tab + TB_ZP); float* Z16N = (float*)(tab + TB_Z16N);
            const int sh = n >> 5, v = n & 31, hh = (v >> 2) & 1, ii = (v & 3) + 4 * (v >> 3);
            for (int k = 0; k < KS5; ++k) { const double br = (double)A.in[I_S5BRE][gn * KS5 + k], bi = (double)A.in[I_S5BIM][gn * KS5 + k];
                const float vr = (float)(qr * br - qi * bi), vi = (float)(qr * bi + qi * br);
                sc[SC_BBR + gn * KS5 + k] = vr; sc[SC_BBI + gn * KS5 + k] = vi;
                const int lp = (n & 31) + 32 * (k >> 3), jj = k & 7;
                BF1[(size_t)((g * 4 + 0 + sh) * 64 + lp) * 8 + jj] = (bf16)f2bf(vr); BF1[(size_t)((g * 4 + 2 + sh) * 64 + lp) * 8 + jj] = (bf16)f2bf(vi); }
            { const int s2 = (n >> 4) & 1, jj = 4 * ((n >> 3) & 1) + (n & 3), hk = (n >> 2) & 1;
              for (int ch = 0; ch < KS5; ++ch) { const int hr_ = ch >> 3, i8 = ch & 7, R = (i8 & 3) + 8 * (i8 >> 2) + 4 * hr_, lp = R + 32 * hk;
                  const float cr = A.in[I_S5CRE][(size_t)(g * KS5 + ch) * NS5 + n], ci = A.in[I_S5CIM][(size_t)(g * KS5 + ch) * NS5 + n];
                  BF2[(size_t)((g * 8 + (0 + sh) * 2 + s2) * 64 + lp) * 8 + jj] = (bf16)f2bf(cr); BF2[(size_t)((g * 8 + (2 + sh) * 2 + s2) * 64 + lp) * 8 + jj] = (bf16)f2bf(-ci); }
              for (int z = 0; z < 4; ++z) { const int cidx = n + 64 * z, ks = cidx >> 5, r16 = cidx & 31, lp = 16 + (r16 & 15) + 32 * (r16 >> 4);
                  *(v4u*)(BF2 + (size_t)((g * 8 + ks) * 64 + lp) * 8) = (v4u){0u, 0u, 0u, 0u}; } }
            TA[((g * 2 + hh) * 2 + 0) * 32 + sh * 16 + ii] = (float)abr; TA[((g * 2 + hh) * 2 + 1) * 32 + sh * 16 + ii] = (float)abi;
            const double mg8 = exp(8.0 * dt * ar), z1r = mg8 * cos(8.0 * dt * ai), z1i = mg8 * sin(8.0 * dt * ai); double pzr = 1.0, pzi = 0.0;
            for (int e = 0; e <= 16; ++e) { const float zr = (float)pzr, zi = (float)pzi; { const double nr2 = pzr * z1r - pzi * z1i, ni2 = pzr * z1i + pzi * z1r; pzr = nr2; pzi = ni2; }
                ZP[(((g * 17 + e) * 2 + hh) * 2 + 0) * 32 + sh * 16 + ii] = zr; ZP[(((g * 17 + e) * 2 + hh) * 2 + 1) * 32 + sh * 16 + ii] = zi;
                if (e == 16) { Z16N[(g * 2 + 0) * 64 + n] = zr; Z16N[(g * 2 + 1) * 64 + n] = zi; } }
            continue; } r -= I_S5;
        if (r < I_RG) { const int c = r * 64 + F.lane; const double lam = (double)A.in[I_RGLAM][c];
          sc[SC_RGL + c] = (float)(-8.0 * log1p(exp(-lam)) * 1.4426950408889634); continue; } r -= I_RG;
        if (r >= I_RGT) { r -= I_RGT;
            const float* src = A.in[I_SCONV] + (size_t)r * 512 + F.lane * 8; const f32x4 a0 = *(const f32x4*)src, a1 = *(const f32x4*)(src + 4);
            v4u o; o.x = pk2(a0[0], a0[1]); o.y = pk2(a0[2], a0[3]); o.z = pk2(a1[0], a1[1]); o.w = pk2(a1[2], a1[3]);
            *(v4u*)(F.ws + WS_TAB + TB_CB + ((size_t)r * 512 + F.lane * 8) * 2) = o; continue; }
        {
            const int s4 = r & 3, gate = (r >> 2) & 1, jh = (r >> 3) & 1, hd = r >> 4;
            const int R = F.lane & 31, hk = F.lane >> 5, hR = (R >> 2) & 1, i = (R & 3) + 4 * (R >> 3), cho = 32 * jh + 16 * (i >> 3) + 8 * hR + (i & 7);
            const float* W = A.in[gate ? I_RGWI : I_RGWR] + (size_t)(hd * 64 + 16 * s4 + 8 * hk) * 64 + cho;
            v4u o; o.x = pk2(W[0], W[64]); o.y = pk2(W[128], W[192]); o.z = pk2(W[256], W[320]); o.w = pk2(W[384], W[448]);
            *(v4u*)(F.ws + WS_TAB + TB_RG + (size_t)(r * 64 + F.lane) * 16) = o;
        }
    }
    __syncthreads();
    LAS float* RED = (LAS float*)(F.lds + RING_OFF);
    float* mod = (float*)(F.ws + WS_MOD);
    const int r32 = F.lane & 31, hh = F.lane >> 5;
#pragma unroll 1
    for (int it = F.vcu; it < ((pmask & 4) ? NMOD / 32 : 0); it += F.G) {
        const int n0 = it * 32;
        for (int e = F.tid; e < 5 * 16 * 64; e += NWAVES * 64) RED[e] = 0.f;
        __syncthreads();
        f32x16m acc[5];
#pragma unroll
        for (int rt = 0; rt < 5; ++rt)
#pragma unroll
            for (int i = 0; i < 16; ++i) acc[rt][i] = 0.f;
#pragma unroll 1
        for (int kb = 0; kb < 2; ++kb) {
        float bw[4][8];
#pragma unroll
        for (int ks = 0; ks < 4; ++ks) { const float* wp = A.in[I_ADAW] + (size_t)(F.wave * 128 + (kb * 4 + ks) * 16 + 8 * hh) * NMOD + n0 + r32;
#pragma unroll
            for (int j = 0; j < 8; ++j) bw[ks][j] = wp[(size_t)j * NMOD]; }
#pragma unroll
        for (int ks = 0; ks < 4; ++ks) {
            const int k0 = F.wave * 128 + (kb * 4 + ks) * 16 + 8 * hh;
            v4u bp; bp.x = pkbf0(bw[ks][0], bw[ks][1]); bp.y = pkbf0(bw[ks][2], bw[ks][3]); bp.z = pkbf0(bw[ks][4], bw[ks][5]); bp.w = pkbf0(bw[ks][6], bw[ks][7]);
            const bf16x8m bfr = __builtin_bit_cast(bf16x8m, bp);
#pragma unroll
            for (int rt = 0; rt < 5; ++rt) { int row = 32 * rt + r32; row = row > NROWMOD - 1 ? NROWMOD - 1 : row;
                const float* cp = (row < NBP ? A.in[I_CP] + (size_t)row * D : A.in[I_CS] + (size_t)(row - NBP) * D) + k0;
                const f32x4 c0 = *(const f32x4*)cp, c1 = *(const f32x4*)(cp + 4);
                v4u ap; ap.x = pkbf0(c0[0] * sigmoidf_(c0[0]), c0[1] * sigmoidf_(c0[1])); ap.y = pkbf0(c0[2] * sigmoidf_(c0[2]), c0[3] * sigmoidf_(c0[3]));
                ap.z = pkbf0(c1[0] * sigmoidf_(c1[0]), c1[1] * sigmoidf_(c1[1])); ap.w = pkbf0(c1[2] * sigmoidf_(c1[2]), c1[3] * sigmoidf_(c1[3]));
                acc[rt] = __builtin_amdgcn_mfma_f32_32x32x16_bf16(__builtin_bit_cast(bf16x8m, ap), bfr, acc[rt], 0, 0, 0); }
        }
        }
#pragma unroll
        for (int rt = 0; rt < 5; ++rt)
#pragma unroll
            for (int i = 0; i < 16; ++i) (void)__hip_atomic_fetch_add(RED + (rt * 16 + i) * 64 + F.lane, acc[rt][i], __ATOMIC_RELAXED, __HIP_MEMORY_SCOPE_WORKGROUP);
        __syncthreads();
        for (int e = F.tid; e < 5 * 16 * 64; e += NWAVES * 64) { const int rt = e >> 10, i = (e >> 6) & 15, l = e & 63, row = 32 * rt + (i & 3) + 8 * (i >> 2) + 4 * (l >> 5), col = n0 + (l & 31);
            if (row < NROWMOD) mod[(size_t)row * NMOD + col] = RED[e] + A.in[I_ADAB][col]; }
        __syncthreads();
    }
}

__device__ __forceinline__ int mod_row(int m) { return m < MP ? (m >> 11) : NBP + ((m - MP) >> 2); }
__device__ __forceinline__ const float* x_row(const Args& A, int m) { return m < MP ? A.in[I_XP] + (size_t)m * D : A.in[I_XS] + (size_t)(m - MP) * D; }

__device__ __forceinline__ void p1_modulate(Frame& F, const Args& A) {
    const int gw = F.vcu * NWAVES + F.wave, NGW = F.G * NWAVES;
    const float* mod = (const float*)(F.ws + WS_MOD); bf16* XN = (bf16*)(F.ws + WS_XN);
    for (int m = gw; m < M; m += NGW) {
        const GAS f32x4* xr = (const GAS f32x4*)x_row(A, m) + F.lane; const float* mr = mod + (size_t)mod_row(m) * NMOD;
        const GAS f32x4* sh = (const GAS f32x4*)(mr) + F.lane; const GAS f32x4* scp = (const GAS f32x4*)(mr + D) + F.lane;
        GAS unsigned long long* o8 = (GAS unsigned long long*)(XN + (size_t)m * D) + F.lane;
#pragma unroll
        for (int j = 0; j < 4; ++j) { const f32x4 v = xr[64 * j], a = sh[64 * j], s = scp[64 * j]; const f32x4 h = v * (s + 1.f) + a;
            o8[64 * j] = (unsigned long long)pk2(h.x, h.y) | ((unsigned long long)pk2(h.z, h.w) << 32); }
    }
}

template <bool SECOND>
__device__ __forceinline__ void ln_rows(Frame& F, const Args& A) {
    const int gw = F.vcu * NWAVES + F.wave, NGW = F.G * NWAVES;
    const float* mod = (const float*)(F.ws + WS_MOD); bf16* XN = (bf16*)(F.ws + WS_XN);
    const GAS f32x4* gg = (const GAS f32x4*)A.in[SECOND ? I_LN2G : I_LN1G] + F.lane; const GAS f32x4* gb = (const GAS f32x4*)A.in[SECOND ? I_LN2B : I_LN1B] + F.lane;
    for (int m = gw; m < M; m += NGW) {
        GAS f32x4* xr = (GAS f32x4*)(F.out + (size_t)m * D) + F.lane;
        f32x4 v[4]; float s = 0.f;
#pragma unroll
        for (int j = 0; j < 4; ++j) { v[j] = xr[64 * j]; s += (v[j].x + v[j].y) + (v[j].z + v[j].w); }
        const float mean = wave_sum(s) * (1.f / D); float s2 = 0.f;
#pragma unroll
        for (int j = 0; j < 4; ++j) { v[j] = v[j] - mean; s2 += (v[j].x * v[j].x + v[j].y * v[j].y) + (v[j].z * v[j].z + v[j].w * v[j].w); }
        const float rstd = 1.f / sqrtf(wave_sum(s2) * (1.f / D) + LN_EPS);
#pragma unroll
        for (int j = 0; j < 4; ++j) { v[j] = v[j] * rstd * gg[64 * j] + gb[64 * j]; xr[64 * j] = v[j]; }
        if (!SECOND) {
            const float* mr = mod + (size_t)mod_row(m) * NMOD;
            const GAS f32x4* sh = (const GAS f32x4*)(mr + 3 * D) + F.lane; const GAS f32x4* scp = (const GAS f32x4*)(mr + 4 * D) + F.lane;
            GAS unsigned long long* o8 = (GAS unsigned long long*)(XN + (size_t)m * D) + F.lane;
#pragma unroll
            for (int j = 0; j < 4; ++j) { const f32x4 h = v[j] * (scp[64 * j] + 1.f) + sh[64 * j];
                o8[64 * j] = (unsigned long long)pk2(h.x, h.y) | ((unsigned long long)pk2(h.z, h.w) << 32); }
        }
    }
}

__device__ __forceinline__ void rg_item_ref(Frame& F, const Args& A, bool prompt, int b, int hd, LAS float* scr) {
    const int j = F.lane, c = hd * HDA + j;
    const bf16* Z = (const bf16*)(F.ws + WS_Z); bf16* Y = (bf16*)(F.ws + WS_YCAT); const float* sc = (const float*)(F.ws + WS_S5C);
    float wr[64], wi[64];
#pragma unroll
    for (int i = 0; i < 64; ++i) { wr[i] = A.in[I_RGWR][(size_t)(hd * 64 + i) * 64 + j]; wi[i] = A.in[I_RGWI][(size_t)(hd * 64 + i) * 64 + j]; }
    const float br = A.in[I_RGBR][c], bi = A.in[I_RGBI][c], L2 = sc[SC_RGL + c];
    const float w0 = A.in[I_CONVW][c], w1 = A.in[I_CONVW][WA + c], w2 = A.in[I_CONVW][2 * WA + c], w3 = A.in[I_CONVW][3 * WA + c], cb = A.in[I_CONVB][c];
    int T, m0; float x3, x2, x1, h;
    if (prompt) { T = TP; m0 = b * TP; x3 = 0.f; x2 = 0.f; x1 = 0.f; h = 0.f; }
    else { T = TS; m0 = MP + b * TS; x3 = A.in[I_SCONV][(size_t)(b * 3 + 0) * WA + c]; x2 = A.in[I_SCONV][(size_t)(b * 3 + 1) * WA + c]; x1 = A.in[I_SCONV][(size_t)(b * 3 + 2) * WA + c]; h = A.in[I_SH][(size_t)b * WA + c]; }
    for (int t = 0; t < T; ++t) {
        const size_t m = (size_t)(m0 + t);
        const float xa = bf2f(Z[m * NZ + WA + c]), gate = bf2f(Z[m * NZ + c]);
        const float xc = cb + w0 * x3 + w1 * x2 + w2 * x1 + w3 * xa; x3 = x2; x2 = x1; x1 = xa;
        scr[j] = xc; LDS_WAIT(); asm volatile("" ::: "memory");
        float rp = br, gp = bi;
#pragma unroll
        for (int i4 = 0; i4 < 16; ++i4) { const f32x4 v = *(const LAS f32x4*)(scr + 4 * i4);
            rp += v[0] * wr[4 * i4] + v[1] * wr[4 * i4 + 1] + v[2] * wr[4 * i4 + 2] + v[3] * wr[4 * i4 + 3];
            gp += v[0] * wi[4 * i4] + v[1] * wi[4 * i4 + 1] + v[2] * wi[4 * i4 + 2] + v[3] * wi[4 * i4 + 3]; }
        LDS_WAIT(); asm volatile("" ::: "memory");
        const float r = sigmoidf_(rp), gi = sigmoidf_(gp);
        const float a = exp2f(r * L2);
        float mult = sqrtf(fmaxf(1.f - a * a, 0.f));
        if (prompt && t == 0) mult = 1.f;
        h = a * h + mult * gi * xc;
        Y[m * D + c] = (bf16)f2bf(gelu_tanh(gate) * h);
    }
    float* oc = F.out + (prompt ? O_CONVP : O_CONVS); float* oh = F.out + (prompt ? O_HP : O_HS);
    oc[(size_t)(b * 3 + 0) * WA + c] = x3; oc[(size_t)(b * 3 + 1) * WA + c] = x2; oc[(size_t)(b * 3 + 2) * WA + c] = x1;
    oh[(size_t)b * WA + c] = h;
}
__device__ __forceinline__ void s5_item_ref(Frame& F, const Args& A, bool prompt, int b, int g, LAS float* scr) {
    const int n = F.lane, gn = g * NS5 + n, k = F.lane & 15, part = F.lane >> 4;
    const bf16* Z = (const bf16*)(F.ws + WS_Z); bf16* Gy = (bf16*)(F.ws + WS_G); const float* sc = (const float*)(F.ws + WS_S5C);
    float bbr[16], bbi[16], cre[16], cim[16];
#pragma unroll
    for (int i = 0; i < 16; ++i) { bbr[i] = sc[SC_BBR + gn * KS5 + i]; bbi[i] = sc[SC_BBI + gn * KS5 + i];
        cre[i] = A.in[I_S5CRE][(size_t)(g * KS5 + k) * NS5 + part * 16 + i]; cim[i] = A.in[I_S5CIM][(size_t)(g * KS5 + k) * NS5 + part * 16 + i]; }
    const float abr = sc[SC_ABR + gn], abi = sc[SC_ABI + gn], dk = A.in[I_S5D][g * KS5 + k];
    int T, m0; float hr, hi;
    if (prompt) { T = TP; m0 = b * TP; hr = 0.f; hi = 0.f; }
    else { T = TS; m0 = MP + b * TS; hr = A.in[I_SSR][(size_t)(b * GB + g) * NS5 + n]; hi = A.in[I_SSI][(size_t)(b * GB + g) * NS5 + n]; }
    for (int t = 0; t < T; ++t) {
        const size_t m = (size_t)(m0 + t);
        const bf16* zr = Z + m * NZ + 2 * WA + g * KS5;
        const v4u u0 = *(const v4u*)zr, u1 = *(const v4u*)(zr + 8);
        float u[16];
        u[0] = pg8::bf_lo(u0.x); u[1] = pg8::bf_hi(u0.x); u[2] = pg8::bf_lo(u0.y); u[3] = pg8::bf_hi(u0.y); u[4] = pg8::bf_lo(u0.z); u[5] = pg8::bf_hi(u0.z); u[6] = pg8::bf_lo(u0.w); u[7] = pg8::bf_hi(u0.w);
        u[8] = pg8::bf_lo(u1.x); u[9] = pg8::bf_hi(u1.x); u[10] = pg8::bf_lo(u1.y); u[11] = pg8::bf_hi(u1.y); u[12] = pg8::bf_lo(u1.z); u[13] = pg8::bf_hi(u1.z); u[14] = pg8::bf_lo(u1.w); u[15] = pg8::bf_hi(u1.w);
        float bur = 0.f, bui = 0.f;
#pragma unroll
        for (int i = 0; i < 16; ++i) { bur += bbr[i] * u[i]; bui += bbi[i] * u[i]; }
        const float nhr = abr * hr - abi * hi + bur, nhi = abr * hi + abi * hr + bui; hr = nhr; hi = nhi;
        scr[n] = hr; scr[64 + n] = hi; LDS_WAIT(); asm volatile("" ::: "memory");
        float p = 0.f;
#pragma unroll
        for (int i4 = 0; i4 < 4; ++i4) { const f32x4 vr = *(const LAS f32x4*)(scr + part * 16 + 4 * i4), vi = *(const LAS f32x4*)(scr + 64 + part * 16 + 4 * i4);
#pragma unroll
            for (int e = 0; e < 4; ++e) p += vr[e] * cre[4 * i4 + e] - vi[e] * cim[4 * i4 + e]; }
        LDS_WAIT(); asm volatile("" ::: "memory");
        p += __shfl_xor(p, 16); p += __shfl_xor(p, 32);
        const float uk = bf2f(zr[k]);
        if (F.lane < 16) Gy[m * WB + g * KS5 + k] = (bf16)f2bf(gelu_tanh(p + dk * uk));
    }
    float* osr = F.out + (prompt ? O_SRP : O_SRS); float* osi = F.out + (prompt ? O_SIP : O_SIS);
    osr[(size_t)(b * GB + g) * NS5 + n] = hr; osi[(size_t)(b * GB + g) * NS5 + n] = hi;
}

typedef short bf16x8v __attribute__((ext_vector_type(8)));
typedef float f32x16 __attribute__((ext_vector_type(16)));
typedef float f32x2v __attribute__((ext_vector_type(2)));
typedef __bf16 bf16x2v __attribute__((ext_vector_type(2)));
#define MFMA32(a, b, c) __builtin_amdgcn_mfma_f32_32x32x16_bf16((a), (b), (c), 0, 0, 0)
__device__ __forceinline__ unsigned pkbf(float a, float b) { const f32x2v v = {a, b}; const bf16x2v r = __builtin_convertvector(v, bf16x2v); return __builtin_bit_cast(unsigned, r); }
template <int CTRL> __device__ __forceinline__ float dppf(float old, float v) { return __builtin_bit_cast(float, __builtin_amdgcn_update_dpp(__builtin_bit_cast(int, old), __builtin_bit_cast(int, v), CTRL, 0xF, 0xF, false)); }
__device__ __forceinline__ f32x16 ld16(const float* p) { f32x16 r;
#pragma unroll
    for (int i = 0; i < 4; ++i) { const f32x4 v = *(const f32x4*)(p + 4 * i); r[4 * i] = v[0]; r[4 * i + 1] = v[1]; r[4 * i + 2] = v[2]; r[4 * i + 3] = v[3]; }
    return r; }
__device__ __forceinline__ bf16x8v pack8(const f32x16& x, int s) { v4u p; p.x = pkbf(x[8 * s], x[8 * s + 1]); p.y = pkbf(x[8 * s + 2], x[8 * s + 3]); p.z = pkbf(x[8 * s + 4], x[8 * s + 5]); p.w = pkbf(x[8 * s + 6], x[8 * s + 7]); return __builtin_bit_cast(bf16x8v, p); }
template <int CTRL> __device__ __forceinline__ void s5_scan_step(f32x16& xr, f32x16& xi, const f32x16& zr, const f32x16& zi) {
#pragma unroll
    for (int i = 0; i < 16; ++i) { const float sr = dppf<CTRL>(0.f, xr[i]), si = dppf<CTRL>(0.f, xi[i]);
        xr[i] += zr[i] * sr - zi[i] * si; xi[i] += zr[i] * si + zi[i] * sr; }
}
constexpr int S5L_BF1 = 0, S5L_BF2 = 4096, S5L_TOT = 12288, S5L_CAR = 20480;
template <bool SECOND>
__device__ __forceinline__ void s5_step(LAS unsigned char* L, int lane, const bf16x8v u, f32x16& hr0, f32x16& hr1, f32x16& hi0, f32x16& hi1,
                                        const f32x16& ar0, const f32x16& ar1, const f32x16& ai0, const f32x16& ai1, const float (&dk)[8], bf16* gout) {
    const LAS bf16x8v* a1 = (const LAS bf16x8v*)(L + S5L_BF1) + lane;
    { const f32x16 cr = ar0 * hr0 - ai0 * hi0, ci = ar0 * hi0 + ai0 * hr0; hr0 = MFMA32(a1[0], u, cr); hi0 = MFMA32(a1[128], u, ci); }
    asm volatile("" : "+v"(hr0), "+v"(hi0));
    { const f32x16 cr = ar1 * hr1 - ai1 * hi1, ci = ar1 * hi1 + ai1 * hr1; hr1 = MFMA32(a1[64], u, cr); hi1 = MFMA32(a1[192], u, ci); }
    if (SECOND) {
        const LAS bf16x8v* a2 = (const LAS bf16x8v*)(L + S5L_BF2) + lane;
        f32x16 y;
#pragma unroll
        for (int i = 0; i < 16; ++i) y[i] = 0.f;
        y = MFMA32(a2[0 * 64], pack8(hr0, 0), y); y = MFMA32(a2[1 * 64], pack8(hr0, 1), y);
        y = MFMA32(a2[2 * 64], pack8(hr1, 0), y); y = MFMA32(a2[3 * 64], pack8(hr1, 1), y);
        y = MFMA32(a2[4 * 64], pack8(hi0, 0), y); y = MFMA32(a2[5 * 64], pack8(hi0, 1), y);
        y = MFMA32(a2[6 * 64], pack8(hi1, 0), y); y = MFMA32(a2[7 * 64], pack8(hi1, 1), y);
        const v4u uw = __builtin_bit_cast(v4u, u);
        float o[8];
        o[0] = gelu_tanh(y[0] + dk[0] * pg8::bf_lo(uw.x)); o[1] = gelu_tanh(y[1] + dk[1] * pg8::bf_hi(uw.x));
        o[2] = gelu_tanh(y[2] + dk[2] * pg8::bf_lo(uw.y)); o[3] = gelu_tanh(y[3] + dk[3] * pg8::bf_hi(uw.y));
        o[4] = gelu_tanh(y[4] + dk[4] * pg8::bf_lo(uw.z)); o[5] = gelu_tanh(y[5] + dk[5] * pg8::bf_hi(uw.z));
        o[6] = gelu_tanh(y[6] + dk[6] * pg8::bf_lo(uw.w)); o[7] = gelu_tanh(y[7] + dk[7] * pg8::bf_hi(uw.w));
        v4u w; w.x = pkbf(o[0], o[1]); w.y = pkbf(o[2], o[3]); w.z = pkbf(o[4], o[5]); w.w = pkbf(o[6], o[7]);
        *(v4u*)gout = w;
    }
}
__device__ __forceinline__ void s5_item_fast(Frame& F, const Args& A, int b, int g) {
    const int lane = F.lane, q = lane & 31, hh = lane >> 5, w = F.wave, c = w * 32 + q;
    LAS unsigned char* L = F.lds + RING_OFF;
    const unsigned char* tab = F.ws + WS_TAB;
    {
        const v4u* s1 = (const v4u*)(tab + TB_BF1) + (size_t)g * 256; const v4u* s2 = (const v4u*)(tab + TB_BF2) + (size_t)g * 512;
        if (F.tid < 256) ((LAS v4u*)(L + S5L_BF1))[F.tid] = s1[F.tid];
        ((LAS v4u*)(L + S5L_BF2))[F.tid] = s2[F.tid];
    }
    __syncthreads();
    const float* TA = (const float*)(tab + TB_TA) + (size_t)((g * 2 + hh) * 2) * 32;
    f32x16 ar0 = ld16(TA), ar1 = ld16(TA + 16), ai0 = ld16(TA + 32), ai1 = ld16(TA + 48);
    f32x16 hr0, hr1, hi0, hi1;
#pragma unroll
    for (int i = 0; i < 16; ++i) { hr0[i] = 0.f; hr1[i] = 0.f; hi0[i] = 0.f; hi1[i] = 0.f; }
    float dk[8];
#pragma unroll
    for (int i = 0; i < 8; ++i) dk[i] = A.in[I_S5D][g * KS5 + 8 * hh + i];
    const size_t m0 = (size_t)b * TP + (size_t)8 * c;
    const bf16* zrow = (const bf16*)(F.ws + WS_Z) + m0 * NZ + 2 * WA + g * KS5 + 8 * hh;
    bf16* grow = (bf16*)(F.ws + WS_G) + m0 * WB + g * KS5 + 8 * hh;
#pragma unroll 1
    for (int j = 0; j < 8; ++j) { const bf16x8v u = *(const bf16x8v*)(zrow + (size_t)j * NZ);
        s5_step<false>(L, lane, u, hr0, hr1, hi0, hi1, ar0, ar1, ai0, ai1, dk, nullptr); }
    const float* ZP = (const float*)(tab + TB_ZP);
#define S5_SCAN(E, CTRL) do { const float* z = ZP + (size_t)(((g * 17 + (E)) * 2 + hh) * 2) * 32; \
        { const f32x16 zr = ld16(z), zi = ld16(z + 32); s5_scan_step<CTRL>(hr0, hi0, zr, zi); } \
        asm volatile("" : "+v"(hr0), "+v"(hi0) :: "memory"); \
        { const f32x16 zr = ld16(z + 16), zi = ld16(z + 48); s5_scan_step<CTRL>(hr1, hi1, zr, zi); } \
        asm volatile("" : "+v"(hr1), "+v"(hi1) :: "memory"); } while (0)
    S5_SCAN(1, 0x111); S5_SCAN(2, 0x112); S5_SCAN(4, 0x114); S5_SCAN(8, 0x118);
#undef S5_SCAN
    const int seg = w * 2 + (q >> 4);
    LAS float* TOT = (LAS float*)(L + S5L_TOT); LAS float* CAR = (LAS float*)(L + S5L_CAR);
    if ((lane & 15) == 15) {
#pragma unroll
        for (int rho = 0; rho < 4; ++rho) {
            *(LAS f32x4*)(TOT + (seg * 2 + 0) * 64 + 0 + 8 * rho + 4 * hh) = (f32x4){hr0[4 * rho], hr0[4 * rho + 1], hr0[4 * rho + 2], hr0[4 * rho + 3]};
            *(LAS f32x4*)(TOT + (seg * 2 + 0) * 64 + 32 + 8 * rho + 4 * hh) = (f32x4){hr1[4 * rho], hr1[4 * rho + 1], hr1[4 * rho + 2], hr1[4 * rho + 3]};
            *(LAS f32x4*)(TOT + (seg * 2 + 1) * 64 + 0 + 8 * rho + 4 * hh) = (f32x4){hi0[4 * rho], hi0[4 * rho + 1], hi0[4 * rho + 2], hi0[4 * rho + 3]};
            *(LAS f32x4*)(TOT + (seg * 2 + 1) * 64 + 32 + 8 * rho + 4 * hh) = (f32x4){hi1[4 * rho], hi1[4 * rho + 1], hi1[4 * rho + 2], hi1[4 * rho + 3]}; }
    }
    __syncthreads();
    if (F.tid < 64) {
        const float* z16 = (const float*)(tab + TB_Z16N) + (size_t)g * 128; const float zr = z16[F.tid], zi = z16[64 + F.tid];
        float cr = 0.f, ci = 0.f;
#pragma unroll
        for (int sg = 0; sg < 16; ++sg) { CAR[(sg * 2 + 0) * 64 + F.tid] = cr; CAR[(sg * 2 + 1) * 64 + F.tid] = ci;
            const float tr = TOT[(sg * 2 + 0) * 64 + F.tid], ti = TOT[(sg * 2 + 1) * 64 + F.tid];
            const float ncr = zr * cr - zi * ci + tr, nci = zr * ci + zi * cr + ti; cr = ncr; ci = nci; }
    }
    __syncthreads();
    {
        const float* z = ZP + (size_t)(((g * 17 + (q & 15)) * 2 + hh) * 2) * 32;
#define S5_EXCL(HR, HI, OFF) do { const f32x16 zr = ld16(z + (OFF)), zi = ld16(z + 32 + (OFF)); f32x16 kr, ki; \
        _Pragma("unroll") for (int rho = 0; rho < 4; ++rho) { \
            const f32x4 a0 = *(const LAS f32x4*)(CAR + (seg * 2 + 0) * 64 + 2 * (OFF) + 8 * rho + 4 * hh), b0 = *(const LAS f32x4*)(CAR + (seg * 2 + 1) * 64 + 2 * (OFF) + 8 * rho + 4 * hh); \
            _Pragma("unroll") for (int e = 0; e < 4; ++e) { kr[4 * rho + e] = a0[e]; ki[4 * rho + e] = b0[e]; } } \
        _Pragma("unroll") for (int i = 0; i < 16; ++i) { const float sr = dppf<0x111>(0.f, HR[i]), si = dppf<0x111>(0.f, HI[i]); \
            HR[i] = sr + zr[i] * kr[i] - zi[i] * ki[i]; HI[i] = si + zr[i] * ki[i] + zi[i] * kr[i]; } } while (0)
        S5_EXCL(hr0, hi0, 0); asm volatile("" : "+v"(hr0), "+v"(hi0) :: "memory"); S5_EXCL(hr1, hi1, 16); asm volatile("" : "+v"(hr1), "+v"(hi1) :: "memory");
#undef S5_EXCL
    }
    { int off = 0; asm volatile("" : "+v"(off)); const float* TA2 = TA + off; ar0 = ld16(TA2); ar1 = ld16(TA2 + 16); ai0 = ld16(TA2 + 32); ai1 = ld16(TA2 + 48); }
#pragma unroll 1
    for (int j = 0; j < 8; ++j) { const bf16x8v u = *(const bf16x8v*)(zrow + (size_t)j * NZ);
        s5_step<true>(L, lane, u, hr0, hr1, hi0, hi1, ar0, ar1, ai0, ai1, dk, grow + (size_t)j * WB); }
    if (w == NWAVES - 1 && q == 31) {
        float* osr = F.out + O_SRP + (size_t)(b * GB + g) * NS5; float* osi = F.out + O_SIP + (size_t)(b * GB + g) * NS5;
#pragma unroll
        for (int i = 0; i < 16; ++i) { const int n = (i & 3) + 8 * (i >> 2) + 4 * hh; osr[n] = hr0[i]; osr[32 + n] = hr1[i]; osi[n] = hi0[i]; osi[32 + n] = hi1[i]; }
    }
    __syncthreads();
}


__device__ __forceinline__ void s5_item_sample(Frame& F, const Args& A, int g) {
    const int lane = F.lane, q = lane & 31, hh = lane >> 5, w = F.wave;
    LAS unsigned char* L = F.lds + RING_OFF;
    const unsigned char* tab = F.ws + WS_TAB;
    { const v4u* s1 = (const v4u*)(tab + TB_BF1) + (size_t)g * 256; const v4u* s2 = (const v4u*)(tab + TB_BF2) + (size_t)g * 512;
      if (F.tid < 256) ((LAS v4u*)(L + S5L_BF1))[F.tid] = s1[F.tid];
      ((LAS v4u*)(L + S5L_BF2))[F.tid] = s2[F.tid]; }
    __syncthreads();
    if (w < 4) {
        const int b = w * 32 + q;
        const float* TA = (const float*)(tab + TB_TA) + (size_t)((g * 2 + hh) * 2) * 32;
        const f32x16 ar0 = ld16(TA), ar1 = ld16(TA + 16), ai0 = ld16(TA + 32), ai1 = ld16(TA + 48);
        f32x16 hr0, hr1, hi0, hi1;
        const float* sr = A.in[I_SSR] + (size_t)(b * GB + g) * NS5; const float* si = A.in[I_SSI] + (size_t)(b * GB + g) * NS5;
#pragma unroll
        for (int rho = 0; rho < 4; ++rho) { const f32x4 a0 = *(const f32x4*)(sr + 8 * rho + 4 * hh), a1 = *(const f32x4*)(sr + 32 + 8 * rho + 4 * hh), b0 = *(const f32x4*)(si + 8 * rho + 4 * hh), b1 = *(const f32x4*)(si + 32 + 8 * rho + 4 * hh);
#pragma unroll
            for (int e = 0; e < 4; ++e) { hr0[4 * rho + e] = a0[e]; hr1[4 * rho + e] = a1[e]; hi0[4 * rho + e] = b0[e]; hi1[4 * rho + e] = b1[e]; } }
        float dk[8];
#pragma unroll
        for (int i = 0; i < 8; ++i) dk[i] = A.in[I_S5D][g * KS5 + 8 * hh + i];
        const size_t m0 = (size_t)MP + (size_t)b * TS;
        const bf16* zrow = (const bf16*)(F.ws + WS_Z) + m0 * NZ + 2 * WA + g * KS5 + 8 * hh;
        bf16* grow = (bf16*)(F.ws + WS_G) + m0 * WB + g * KS5 + 8 * hh;
#pragma unroll 1
        for (int j = 0; j < TS; ++j) { const bf16x8v u = *(const bf16x8v*)(zrow + (size_t)j * NZ);
            s5_step<true>(L, lane, u, hr0, hr1, hi0, hi1, ar0, ar1, ai0, ai1, dk, grow + (size_t)j * WB); }
        float* osr = F.out + O_SRS + (size_t)(b * GB + g) * NS5; float* osi = F.out + O_SIS + (size_t)(b * GB + g) * NS5;
#pragma unroll
        for (int rho = 0; rho < 4; ++rho) {
            *(f32x4*)(osr + 8 * rho + 4 * hh) = (f32x4){hr0[4 * rho], hr0[4 * rho + 1], hr0[4 * rho + 2], hr0[4 * rho + 3]};
            *(f32x4*)(osr + 32 + 8 * rho + 4 * hh) = (f32x4){hr1[4 * rho], hr1[4 * rho + 1], hr1[4 * rho + 2], hr1[4 * rho + 3]};
            *(f32x4*)(osi + 8 * rho + 4 * hh) = (f32x4){hi0[4 * rho], hi0[4 * rho + 1], hi0[4 * rho + 2], hi0[4 * rho + 3]};
            *(f32x4*)(osi + 32 + 8 * rho + 4 * hh) = (f32x4){hi1[4 * rho], hi1[4 * rho + 1], hi1[4 * rho + 2], hi1[4 * rho + 3]}; }
    }
    __syncthreads();
}

template <int CTRL, int RMASK> __device__ __forceinline__ float dppm(float old, float v) { return __builtin_bit_cast(float, __builtin_amdgcn_update_dpp(__builtin_bit_cast(int, old), __builtin_bit_cast(int, v), CTRL, RMASK, 0xF, false)); }
template <int CTRL, int RMASK> __device__ __forceinline__ void rg_scan_step(f32x16& a, f32x16& b) {
#pragma unroll
    for (int i = 0; i < 16; ++i) { const float as = dppm<CTRL, RMASK>(1.f, a[i]), bs = dppm<CTRL, RMASK>(0.f, b[i]); b[i] = a[i] * bs + b[i]; a[i] = a[i] * as; }
}
constexpr int RGL_AFR = 0, RGL_CWT = 8192, RGL_TOT = 10240, RGL_CST = 14336;
template <bool SAMPLE>
__device__ __forceinline__ void rg_item_fast(Frame& F, const Args& A, int b, int hd, int jh) {
    const int lane = F.lane, q = lane & 31, hh = lane >> 5, w = F.wave;
    LAS unsigned char* L = F.lds + RING_OFF;
    const float* sc = (const float*)(F.ws + WS_S5C);
    {
        const v4u* src = (const v4u*)(F.ws + WS_TAB + TB_RG) + (size_t)((hd * 2 + jh) * 8) * 64;
        ((LAS v4u*)(L + RGL_AFR))[F.tid] = src[F.tid];
        if (F.tid < 320) { const int h2 = F.tid / 160, tap = (F.tid % 160) / 32, e = F.tid % 32, c = hd * 64 + 16 * (e >> 3) + 8 * h2 + (e & 7);
            ((LAS float*)(L + RGL_CWT))[F.tid] = tap < 4 ? A.in[I_CONVW][tap * WA + c] : A.in[I_CONVB][c]; }
        if (F.tid >= 384 && F.tid < 480) { const int e = F.tid - 384, h2 = e / 48, kind = (e % 48) / 16, i = e % 16, c = hd * 64 + 32 * jh + 16 * (i >> 3) + 8 * h2 + (i & 7);
            ((LAS float*)(L + RGL_CST))[e] = kind == 0 ? A.in[I_RGBR][c] : (kind == 1 ? A.in[I_RGBI][c] : sc[SC_RGL + c]); }
        if (!SAMPLE && jh == 0 && F.tid < 192) { const int k = F.tid >> 6, ch = F.tid & 63;
            F.out[O_CONVP + (size_t)(b * 3 + k) * WA + hd * 64 + ch] = bf2f(((const bf16*)(F.ws + WS_Z))[(size_t)(b * TP + TP - 3 + k) * NZ + WA + hd * 64 + ch]); }
        if (SAMPLE && jh == 0) { for (int e = F.tid; e < NBS * 3 * 64; e += NWAVES * 64) { const int bb = e / 192, k = (e / 64) % 3, ch = e & 63;
            F.out[O_CONVS + (size_t)(bb * 3 + k) * WA + hd * 64 + ch] = bf2f(((const bf16*)(F.ws + WS_Z))[(size_t)(MP + bb * TS + 1 + k) * NZ + WA + hd * 64 + ch]); } }
    }
    __syncthreads();
    float hround[16];
#pragma unroll
    for (int i = 0; i < 16; ++i) hround[i] = 0.f;
    const bf16* Zb = (const bf16*)(F.ws + WS_Z) + (size_t)(SAMPLE ? MP : b * TP) * NZ; bf16* Yb = (bf16*)(F.ws + WS_YCAT) + (size_t)(SAMPLE ? MP : b * TP) * D;
    const bf16* CB = (const bf16*)(F.ws + WS_TAB + TB_CB);
    const LAS float* CWT = (const LAS float*)(L + RGL_CWT) + hh * 160;
#pragma unroll 1
    for (int rd = 0; rd < (SAMPLE ? 2 : 8); ++rd) {
        const int t = rd * 256 + w * 32 + q;
        v4u xr[4][4];
#pragma unroll
        for (int k = 0; k < 4; ++k) { const int tk = t - 3 + k; const bf16* zr = Zb + (size_t)(tk < 0 ? 0 : tk) * NZ + WA + hd * 64 + 8 * hh;
            if (SAMPLE) { const int jx = (t & 3) + k;
                if (jx < 3) zr = CB + (size_t)((t >> 2) * 3 + jx) * WA + hd * 64 + 8 * hh; }
#pragma unroll
            for (int s4 = 0; s4 < 4; ++s4) { v4u v = *(const v4u*)(zr + 16 * s4); if (!SAMPLE && tk < 0) v = (v4u){0u, 0u, 0u, 0u}; xr[k][s4] = v; } }
        const bf16* gr = Zb + (size_t)t * NZ + hd * 64 + 32 * jh + 8 * hh;
        const v4u g0 = *(const v4u*)gr, g1 = *(const v4u*)(gr + 16);
        float xc[32];
#pragma unroll
        for (int s4 = 0; s4 < 4; ++s4) {
            float acc[8];
#pragma unroll
            for (int j4 = 0; j4 < 2; ++j4) { const f32x4 cb = *(const LAS f32x4*)(CWT + 4 * 32 + s4 * 8 + 4 * j4); acc[4 * j4] = cb[0]; acc[4 * j4 + 1] = cb[1]; acc[4 * j4 + 2] = cb[2]; acc[4 * j4 + 3] = cb[3]; }
#pragma unroll
            for (int k = 0; k < 4; ++k) { const v4u v = xr[k][s4];
                const f32x4 w0 = *(const LAS f32x4*)(CWT + k * 32 + s4 * 8), w1 = *(const LAS f32x4*)(CWT + k * 32 + s4 * 8 + 4);
                acc[0] += w0[0] * pg8::bf_lo(v.x); acc[1] += w0[1] * pg8::bf_hi(v.x); acc[2] += w0[2] * pg8::bf_lo(v.y); acc[3] += w0[3] * pg8::bf_hi(v.y);
                acc[4] += w1[0] * pg8::bf_lo(v.z); acc[5] += w1[1] * pg8::bf_hi(v.z); acc[6] += w1[2] * pg8::bf_lo(v.w); acc[7] += w1[3] * pg8::bf_hi(v.w); }
#pragma unroll
            for (int e = 0; e < 8; ++e) xc[s4 * 8 + e] = acc[e];
            asm volatile("" : "+v"(xc[s4 * 8]), "+v"(xc[s4 * 8 + 7]) :: "memory");
        }
        f32x16 dr, di;
#pragma unroll
        for (int i = 0; i < 16; ++i) { dr[i] = 0.f; di[i] = 0.f; }
        const LAS bf16x8v* af = (const LAS bf16x8v*)(L + RGL_AFR) + lane;
#pragma unroll
        for (int s4 = 0; s4 < 4; ++s4) { v4u p; p.x = pkbf(xc[s4 * 8], xc[s4 * 8 + 1]); p.y = pkbf(xc[s4 * 8 + 2], xc[s4 * 8 + 3]); p.z = pkbf(xc[s4 * 8 + 4], xc[s4 * 8 + 5]); p.w = pkbf(xc[s4 * 8 + 6], xc[s4 * 8 + 7]);
            const bf16x8v bfr = __builtin_bit_cast(bf16x8v, p);
            dr = MFMA32(af[s4 * 64], bfr, dr); di = MFMA32(af[(4 + s4) * 64], bfr, di); }
        f32x16 av, bv;
        const bool first = !SAMPLE && (t == 0);
        const LAS float* CST = (const LAS float*)(L + RGL_CST) + hh * 48;
#pragma unroll
        for (int i = 0; i < 16; ++i) { const float xcv = jh ? xc[16 + i] : xc[i];
            const float r = sigmoidf_(dr[i] + CST[i]), gi = sigmoidf_(di[i] + CST[16 + i]);
            const float a = __builtin_amdgcn_exp2f(r * CST[32 + i]);
            float mult = __builtin_sqrtf(fmaxf(1.f - a * a, 0.f)); if (first) mult = 1.f;
            av[i] = a; bv[i] = mult * gi * xcv; }
        if (SAMPLE && (t & 3) == 0) {
            const float* h0 = A.in[I_SH] + (size_t)(t >> 2) * WA + hd * 64 + 32 * jh + 8 * hh;
#pragma unroll
            for (int i = 0; i < 16; ++i) { bv[i] += av[i] * h0[16 * (i >> 3) + (i & 7)]; av[i] = 0.f; } }
        rg_scan_step<0x111, 0xF>(av, bv); rg_scan_step<0x112, 0xF>(av, bv); rg_scan_step<0x114, 0xF>(av, bv); rg_scan_step<0x118, 0xF>(av, bv);
        rg_scan_step<0x142, 0xA>(av, bv);
        float hin[16];
#pragma unroll
        for (int i = 0; i < 16; ++i) hin[i] = 0.f;
        if (!SAMPLE) {
        LAS float* TOT = (LAS float*)(L + RGL_TOT) + (rd & 1) * 512;
        if (q == 31) {
#pragma unroll
            for (int i4 = 0; i4 < 4; ++i4) { *(LAS f32x4*)(TOT + (w * 2 + 0) * 32 + hh * 16 + 4 * i4) = (f32x4){av[4 * i4], av[4 * i4 + 1], av[4 * i4 + 2], av[4 * i4 + 3]};
                                             *(LAS f32x4*)(TOT + (w * 2 + 1) * 32 + hh * 16 + 4 * i4) = (f32x4){bv[4 * i4], bv[4 * i4 + 1], bv[4 * i4 + 2], bv[4 * i4 + 3]}; }
        }
        __syncthreads();
#pragma unroll
        for (int w2 = 0; w2 < 8; ++w2) {
            if (w2 == w) {
#pragma unroll
                for (int i = 0; i < 16; ++i) hin[i] = hround[i]; }
#pragma unroll
            for (int i4 = 0; i4 < 4; ++i4) { const f32x4 p = *(const LAS f32x4*)(TOT + (w2 * 2 + 0) * 32 + hh * 16 + 4 * i4), hl = *(const LAS f32x4*)(TOT + (w2 * 2 + 1) * 32 + hh * 16 + 4 * i4);
#pragma unroll
                for (int e = 0; e < 4; ++e) hround[4 * i4 + e] = p[e] * hround[4 * i4 + e] + hl[e]; }
        }
        }
        float o[16];
        const unsigned gw_[8] = {g0.x, g0.y, g0.z, g0.w, g1.x, g1.y, g1.z, g1.w};
#pragma unroll
        for (int i = 0; i < 16; ++i) { const float h = bv[i] + av[i] * hin[i]; const float gt = (i & 1) ? pg8::bf_hi(gw_[i >> 1]) : pg8::bf_lo(gw_[i >> 1]); o[i] = gelu_tanh(gt) * h; }
        bf16* yr = Yb + (size_t)t * D + hd * 64 + 32 * jh + 8 * hh;
        v4u w0; w0.x = pkbf(o[0], o[1]); w0.y = pkbf(o[2], o[3]); w0.z = pkbf(o[4], o[5]); w0.w = pkbf(o[6], o[7]);
        v4u w1; w1.x = pkbf(o[8], o[9]); w1.y = pkbf(o[10], o[11]); w1.z = pkbf(o[12], o[13]); w1.w = pkbf(o[14], o[15]);
        *(v4u*)yr = w0; *(v4u*)(yr + 16) = w1;
        if (SAMPLE && (t & 3) == 3) {
#pragma unroll
            for (int i = 0; i < 16; ++i) F.out[O_HS + (size_t)(t >> 2) * WA + hd * 64 + 32 * jh + 16 * (i >> 3) + 8 * hh + (i & 7)] = bv[i]; }
    }
    if (!SAMPLE && w == 0 && q == 0) {
#pragma unroll
        for (int i = 0; i < 16; ++i) F.out[O_HP + (size_t)b * WA + hd * 64 + 32 * jh + 16 * (i >> 3) + 8 * hh + (i & 7)] = hround[i];
    }
    __syncthreads();
}

__device__ __forceinline__ void p3_mixers_ref(Frame& F, const Args& A) {
    constexpr int N_RGP = NBP * HA, N_S5P = NBP * GB;
    if (F.vcu < N_S5P) s5_item_fast(F, A, F.vcu / GB, F.vcu % GB);
    if (F.vcu < 2 * N_RGP) rg_item_fast<false>(F, A, F.vcu / (2 * HA), (F.vcu / 2) % HA, F.vcu & 1);
    else if (F.vcu < 2 * N_RGP + GB) s5_item_sample(F, A, F.vcu - 2 * N_RGP);
    else if (F.vcu < 2 * N_RGP + GB + 2 * HA) rg_item_fast<true>(F, A, 0, (F.vcu - 2 * N_RGP - GB) >> 1, (F.vcu - 2 * N_RGP - GB) & 1);
}

__global__ void __launch_bounds__(NWAVES * 64, 2) fwd(Args A) {
    extern __shared__ __attribute__((aligned(16))) unsigned char lds[];
    Frame F;
    F.lds = (LAS unsigned char*)lds;
    F.MISC = (volatile LAS unsigned*)(F.lds + MISC_OFF);
    F.tid = threadIdx.x; F.lane = F.tid & 63; F.wave = __builtin_amdgcn_readfirstlane(F.tid >> 6);
    F.G = gridDim.x; { const int bx = blockIdx.x; F.vcu = (F.G % 8 == 0) ? (bx % 8) * (F.G / 8) + bx / 8 : bx; }
    F.out = A.out; F.ws = A.ws; F.ctl = (gu32*)(A.ws + WS_CTL);
    for (int u = F.tid; u < (LDS_BYTES - LDSCTL_OFF) / 4; u += NWAVES * 64) ((LAS unsigned*)(F.lds + LDSCTL_OFF))[u] = 0u;
    __syncthreads();
    XcdBarrier bar; bar.bar = (unsigned*)(F.ctl + CW_BAR); bar.x = 0; bar.st = nullptr;
    if (N_LAUNCHES == 1) bar = xcd_barrier_post((unsigned*)(F.ctl + CW_BAR), F.MISC + 8);
#define GRID_BAR() do { if (N_LAUNCHES == 1) xcd_barrier(bar); } while (0)
    const int lo = A.ph_lo, hi = A.ph_hi;
#define IN(k) (lo <= (k) && (k) < hi)
#define BOTH(k) (IN(k) && IN((k) + 1))
    bf16* XN = (bf16*)(F.ws + WS_XN); bf16* Z = (bf16*)(F.ws + WS_Z); bf16* YC = (bf16*)(F.ws + WS_YCAT); bf16* GY = (bf16*)(F.ws + WS_G); bf16* U = (bf16*)(F.ws + WS_U);
    const float* mod = (const float*)(F.ws + WS_MOD);

#define REPS(k) (((PROBE_DUP) >> (k)) & 1 ? 2 : 1)
    if (IN(0)) { for (int rep = 0; rep < REPS(0); ++rep) p0_prologue(F, A, rep); if (BOTH(0)) GRID_BAR(); }
    if (IN(1)) { for (int rep = 0; rep < REPS(1); ++rep) p1_modulate(F, A); if (BOTH(1)) GRID_BAR(); }
    if (IN(2)) for (int rep = 0; rep < REPS(2); ++rep) {
        pg8::Gemm g{XN, (const bf16*)(F.ws + WS_WIN), M, NZ, D}; pg8::StaticOrder S; S.init(M, NZ, F.G, (int)blockIdx.x);
        pg8::EpiBf16<0> E{Z, NZ, nullptr};
        pg8::gemm_phase<pg8::EpiBf16<0>, pg8::StaticOrder, PG8_ALIGN, PG8_SP2>(F.lds + RING_OFF, g, S, E);
        if (BOTH(2) && rep == REPS(2) - 1) GRID_BAR();
    }
    if (IN(3)) { p3_mixers_ref(F, A); if (REPS(3) == 2) { __syncthreads(); p3_mixers_ref(F, A); } if (BOTH(3)) GRID_BAR(); }
    if (IN(4)) for (int rep = 0; rep < REPS(4); ++rep) {
        pg8::Gemm g{GY, (const bf16*)(F.ws + WS_WGLU), M, WB, WB}; pg8::StaticOrder S; S.init(M, WB, F.G, (int)blockIdx.x);
        pg8::EpiGlu E{GY, WB, YC, D, WA, A.in[I_GLUB]};
        pg8::gemm_phase<pg8::EpiGlu, pg8::StaticOrder, PG8_ALIGN, PG8_SP2>(F.lds + RING_OFF, g, S, E);
        if (BOTH(4) && rep == REPS(4) - 1) GRID_BAR();
    }
    if (IN(5)) {
        pg8::Gemm g{YC, (const bf16*)(F.ws + WS_WOUT), M, D, D}; pg8::StaticOrder S; S.init(M, D, F.G, (int)blockIdx.x);
        pg8::EpiRes E{A.in[I_XP], A.in[I_XS], F.out, mod + 2 * D, nullptr, ALPHA, MP};
        pg8::gemm_phase<pg8::EpiRes, pg8::StaticOrder, PG8_ALIGN, PG8_SP2>(F.lds + RING_OFF, g, S, E);
        if (BOTH(5)) GRID_BAR();
    }
    if (IN(6)) { ln_rows<false>(F, A); if (BOTH(6)) GRID_BAR(); }
    if (IN(7)) for (int rep = 0; rep < REPS(7); ++rep) {
        pg8::Gemm g{XN, (const bf16*)(F.ws + WS_W1), M, FF, D}; pg8::StaticOrder S; S.init(M, FF, F.G, (int)blockIdx.x);
        pg8::EpiBf16<3> E{U, FF, A.in[I_B1]};
        pg8::gemm_phase<pg8::EpiBf16<3>, pg8::StaticOrder, PG8_ALIGN, PG8_SP2>(F.lds + RING_OFF, g, S, E);
        if (BOTH(7) && rep == REPS(7) - 1) GRID_BAR();
    }
    if (IN(8)) {
        pg8::Gemm g{U, (const bf16*)(F.ws + WS_W2), M, D, FF}; pg8::StaticOrder S; S.init(M, D, F.G, (int)blockIdx.x);
        pg8::EpiRes E{F.out, F.out + (size_t)MP * D, F.out, mod + 5 * D, A.in[I_B2], ALPHA, MP};
        pg8::gemm_phase<pg8::EpiRes, pg8::StaticOrder, PG8_ALIGN, PG8_SP2>(F.lds + RING_OFF, g, S, E);
        if (BOTH(8)) GRID_BAR();
    }
    if (IN(9)) { ln_rows<true>(F, A); }
#undef IN
#undef BOTH
}

extern "C" void kernel_launch(void* const* d_in, const int* in_sizes, int n_in, void* d_out, int out_size, void* d_ws, size_t ws_size, hipStream_t stream) {
    static int grid = 0;
    if (grid == 0) {
        if (n_in != 37 || in_sizes[0] != MP * D || out_size != (int)O_END || ws_size < WS_END) { fprintf(stderr, "kernel_launch: unexpected shapes (n_in %d, in0 %d, out %d, ws %zu)\n", n_in, n_in > 0 ? in_sizes[0] : -1, out_size, ws_size); grid = -1; return; }
        int dev = 0, cus = 0, per_cu = 0;
        if (hipGetDevice(&dev) != hipSuccess || hipDeviceGetAttribute(&cus, hipDeviceAttributeMultiprocessorCount, dev) != hipSuccess) { grid = -1; return; }
        if (hipFuncSetAttribute((const void*)fwd, hipFuncAttributeMaxDynamicSharedMemorySize, LDS_BYTES) != hipSuccess) { fprintf(stderr, "kernel_launch: hipFuncSetAttribute failed\n"); grid = -1; return; }
        if (hipOccupancyMaxActiveBlocksPerMultiprocessor(&per_cu, (const void*)fwd, NWAVES * 64, LDS_BYTES) != hipSuccess || per_cu < 1) { fprintf(stderr, "kernel_launch: occupancy query says %d\n", per_cu); }
        (void)hipGetLastError();
        grid = cus;
        if (grid < 256) { fprintf(stderr, "kernel_launch: this build needs 256 CUs (got %d)\n", grid); grid = -1; return; }
        grid = 256;
    }
    if (grid < 0) return;
    (void)hipMemsetAsync((char*)d_ws + WS_CTL, 0, CTL_ZERO_BYTES, stream);
    Args a{};
    for (int i = 0; i < 37; ++i) a.in[i] = (const float*)d_in[i];
    a.out = (float*)d_out; a.ws = (unsigned char*)d_ws;
    for (int li = 0; li < N_LAUNCHES; ++li) {
        if (N_LAUNCHES == 1) { a.ph_lo = 0; a.ph_hi = N_PHASES; } else { a.ph_lo = li; a.ph_hi = li + 1; }
        a.li = li;
        hipLaunchKernelGGL(fwd, dim3(grid), dim3(NWAVES * 64), LDS_BYTES, stream, a);
    }
}
```

```cpp
#include <hip/hip_runtime.h>
#include <cstdio>
#include <cstdint>
#include <cmath>

#ifndef MK_N_LAUNCHES
#define MK_N_LAUNCHES 1
#endif

namespace pg8 {
#define PG8_LAS __attribute__((address_space(3)))
typedef unsigned short bf16_t;
typedef short bf16x8 __attribute__((ext_vector_type(8)));
typedef float f32x4 __attribute__((ext_vector_type(4)));
typedef unsigned u32x4 __attribute__((ext_vector_type(4)));
constexpr int BM = 256, BK = 64, HALF = 128, HTB = HALF * BK * 2, STAGE_BYTES = 8 * HTB, NXCD = 8, WGM = 8;

__host__ __device__ __forceinline__ int lds_byte(int r, int c) { const int st = (r >> 4) * 2 + (c >> 5), rr = r & 15, cc = c & 31, ob = rr * 64 + cc * 2; return st * 1024 + (ob ^ (((ob >> 9) & 1) << 5)); }
__host__ __device__ __forceinline__ void stage_rc(int b, int& R, int& C) { const int st = b / 1024, sb = b % 1024, swz = sb ^ (((sb >> 9) & 1) << 5); R = (st >> 1) * 16 + swz / 64; C = (st & 1) * 32 + (swz % 64) / 2; }
__host__ __device__ __forceinline__ int perm32(int rho) { const int n = rho >> 4, i = rho & 15; return 8 * (i >> 2) + 4 * n + (i & 3); }

struct Unit { int pm, pn; };
struct Gemm { const bf16_t* A; const bf16_t* Bt; int M, N, K; };

struct StaticOrder {
    int nM, nN, nwg, G, c;
    __host__ __device__ void init(int M, int N, int G_, int c_) { nM = M / BM; nN = N / BM; nwg = nM * nN; G = G_; c = c_; }
    __host__ __device__ bool next(int i, Unit& u) const {
        const long L = (long)i * G + c; if (L >= nwg) return false;
        int wgid = (int)L; { const int q = nwg / NXCD, r = nwg % NXCD, xcd = wgid % NXCD, off = wgid / NXCD; wgid = (xcd < r ? xcd * (q + 1) : r * (q + 1) + (xcd - r) * q) + off; }
        const int nig = WGM * nN, gid = wgid / nig, fm = gid * WGM, gsz = (nM - fm) < WGM ? (nM - fm) : WGM;
        u.pm = fm + ((wgid % nig) % gsz); u.pn = (wgid % nig) / gsz; return true;
    }
    __device__ __forceinline__ void a_ready(const Unit&) const {}
    __device__ __forceinline__ void done(const Unit&) const {}
};

__device__ __forceinline__ unsigned cvt_pk_bf16(float lo, float hi) { unsigned r; asm volatile("v_cvt_pk_bf16_f32 %0, %1, %2" : "=v"(r) : "v"(lo), "v"(hi)); return r; }
__device__ __forceinline__ float bf_lo(unsigned w) { return __builtin_bit_cast(float, w << 16); }
__device__ __forceinline__ float bf_hi(unsigned w) { return __builtin_bit_cast(float, w & 0xffff0000u); }

template <int ACT> struct EpiBf16 {
    static constexpr bool PERM = true, AFTER_DRAIN = false;
    bf16_t* O; int ldc; const float* bias;
    __device__ __forceinline__ void operator()(const f32x4 (&acc)[2][2][4][2], const Unit& u, int wr, int wc, int fr, int fq) const {
        const int row0 = u.pm * BM + wr * 64 + fr; const int col0 = u.pn * BM + wc * 32 + 8 * fq;
        f32x4 bv[2][2];
#pragma unroll
        for (int bj = 0; bj < 2; ++bj)
#pragma unroll
            for (int n = 0; n < 2; ++n) bv[bj][n] = bias ? *(const f32x4*)(bias + col0 + bj * HALF + 4 * n) : (f32x4){0.f, 0.f, 0.f, 0.f};
#pragma unroll
        for (int ai = 0; ai < 2; ++ai)
#pragma unroll
            for (int m = 0; m < 4; ++m) { bf16_t* rowp = O + (size_t)(row0 + ai * HALF + m * 16) * ldc + col0;
#pragma unroll
                for (int bj = 0; bj < 2; ++bj) { f32x4 v0 = acc[ai][bj][m][0] + bv[bj][0], v1 = acc[ai][bj][m][1] + bv[bj][1];
                    if (ACT == 3) {
#pragma unroll
                        for (int e = 0; e < 4; ++e) { const float a = fmaxf(v0[e], 0.f), b = fmaxf(v1[e], 0.f); v0[e] = a * a; v1[e] = b * b; } }
                    u32x4 w; w.x = cvt_pk_bf16(v0[0], v0[1]); w.y = cvt_pk_bf16(v0[2], v0[3]); w.z = cvt_pk_bf16(v1[0], v1[1]); w.w = cvt_pk_bf16(v1[2], v1[3]);
                    *(u32x4*)(rowp + bj * HALF) = w; } }
    }
};
struct EpiGlu {
    static constexpr bool PERM = true, AFTER_DRAIN = false;
    const bf16_t* Gy; int ldg; bf16_t* O; int ldc; int coff; const float* bias;
    __device__ __forceinline__ void operator()(const f32x4 (&acc)[2][2][4][2], const Unit& u, int wr, int wc, int fr, int fq) const {
        const int row0 = u.pm * BM + wr * 64 + fr; const int col0 = u.pn * BM + wc * 32 + 8 * fq;
        f32x4 bv[2][2];
#pragma unroll
        for (int bj = 0; bj < 2; ++bj)
#pragma unroll
            for (int n = 0; n < 2; ++n) bv[bj][n] = *(const f32x4*)(bias + col0 + bj * HALF + 4 * n);
#pragma unroll
        for (int ai = 0; ai < 2; ++ai)
#pragma unroll
            for (int m = 0; m < 4; ++m) { const size_t row = (size_t)(row0 + ai * HALF + m * 16);
#pragma unroll
                for (int bj = 0; bj < 2; ++bj) { const f32x4 v0 = acc[ai][bj][m][0] + bv[bj][0], v1 = acc[ai][bj][m][1] + bv[bj][1];
                    const u32x4 g = *(const u32x4*)(Gy + row * ldg + col0 + bj * HALF);
                    float o[8];
                    o[0] = bf_lo(g.x) * __builtin_amdgcn_rcpf(1.f + __builtin_amdgcn_exp2f(-1.4426950408889634f * v0[0])); o[1] = bf_hi(g.x) * __builtin_amdgcn_rcpf(1.f + __builtin_amdgcn_exp2f(-1.4426950408889634f * v0[1]));
                    o[2] = bf_lo(g.y) * __builtin_amdgcn_rcpf(1.f + __builtin_amdgcn_exp2f(-1.4426950408889634f * v0[2])); o[3] = bf_hi(g.y) * __builtin_amdgcn_rcpf(1.f + __builtin_amdgcn_exp2f(-1.4426950408889634f * v0[3]));
                    o[4] = bf_lo(g.z) * __builtin_amdgcn_rcpf(1.f + __builtin_amdgcn_exp2f(-1.4426950408889634f * v1[0])); o[5] = bf_hi(g.z) * __builtin_amdgcn_rcpf(1.f + __builtin_amdgcn_exp2f(-1.4426950408889634f * v1[1]));
                    o[6] = bf_lo(g.w) * __builtin_amdgcn_rcpf(1.f + __builtin_amdgcn_exp2f(-1.4426950408889634f * v1[2])); o[7] = bf_hi(g.w) * __builtin_amdgcn_rcpf(1.f + __builtin_amdgcn_exp2f(-1.4426950408889634f * v1[3]));
                    u32x4 w; w.x = cvt_pk_bf16(o[0], o[1]); w.y = cvt_pk_bf16(o[2], o[3]); w.z = cvt_pk_bf16(o[4], o[5]); w.w = cvt_pk_bf16(o[6], o[7]);
                    *(u32x4*)(O + row * ldc + coff + col0 + bj * HALF) = w; } }
    }
};
struct EpiRes {
    static constexpr bool PERM = false, AFTER_DRAIN = false;
    const float* basep; const float* bases; float* out; const float* gate  ; const float* bias; float alpha; int MP;
    __device__ __forceinline__ void operator()(const f32x4 (&acc)[2][2][4][2], const Unit& u, int wr, int wc, int fr, int fq) const {
        const int row0 = u.pm * BM + wr * 64 + fr, col0 = u.pn * BM + wc * 32 + 4 * fq;
        f32x4 bv[2][2];
#pragma unroll
        for (int bj = 0; bj < 2; ++bj)
#pragma unroll
            for (int n = 0; n < 2; ++n) bv[bj][n] = bias ? *(const f32x4*)(bias + col0 + bj * HALF + n * 16) : (f32x4){0.f, 0.f, 0.f, 0.f};
#pragma unroll
        for (int ai = 0; ai < 2; ++ai)
#pragma unroll
            for (int m = 0; m < 4; ++m) { const int row = row0 + ai * HALF + m * 16;
                const bool smp = row >= MP; const int mr = smp ? 8 + ((row - MP) >> 2) : (row >> 11);
                const float* bp = smp ? bases + (size_t)(row - MP) * 1024 : basep + (size_t)row * 1024;
                const float* gp = gate + (size_t)mr * 6144; float* op = out + (size_t)row * 1024;
#pragma unroll
                for (int bj = 0; bj < 2; ++bj)
#pragma unroll
                    for (int n = 0; n < 2; ++n) { const int c = col0 + bj * HALF + n * 16;
                        const f32x4 b = *(const f32x4*)(bp + c), g = *(const f32x4*)(gp + c);
                        *(f32x4*)(op + c) = b * alpha + g * (acc[ai][bj][m][n] + bv[bj][n]); } }
    }
};

template <class Epi, class Sched, bool ALIGN_EPI = false, bool SP2 = false>
__device__ __forceinline__ void gemm_phase(PG8_LAS unsigned char* lds, const Gemm g, const Sched& S, const Epi& E) {
    const int tid = threadIdx.x, wid = __builtin_amdgcn_readfirstlane(tid >> 6), lane = tid & 63, wr = wid >> 2, wc = wid & 3, fr = lane & 15, fq = lane >> 4;
    const int K = g.K, nt = K / BK;
    unsigned voffA[2], voffB[2];
#pragma unroll
    for (int i = 0; i < 2; ++i) { int R, C; stage_rc(tid * 16 + i * 8192, R, C); const int Rb = Epi::PERM ? ((R & ~31) + perm32(R & 31)) : R;
        voffA[i] = (unsigned)(R * K + C) * 2u; voffB[i] = (unsigned)(Rb * K + C) * 2u; }
    const size_t kstep = (size_t)(BK * 2);
    const size_t hstep = (size_t)HALF * K * 2;
    const size_t tstep = 2 * hstep;
    const unsigned ldsw = (unsigned)wid * 1024u;
    const int aoff = lds_byte(wr * 64 + fr, fq * 8), boff = lds_byte(wc * 32 + fr, fq * 8);
#define PG8_SA(b, h) (((b) * 2 + (h)) * HTB)
#define PG8_SB(b, h) ((4 + (b) * 2 + (h)) * HTB)
#define PG8_STAGE(bufoff, gbase, voff) do { _Pragma("unroll") for (int _i = 0; _i < 2; ++_i) \
        __builtin_amdgcn_global_load_lds((const unsigned*)((const char*)(gbase) + (voff)[_i]), (PG8_LAS unsigned*)(lds + (bufoff) + ldsw + _i * 8192), 16, 0, 0); } while (0)
#define PG8_LDA(dst, b, h) do { _Pragma("unroll") for (int m = 0; m < 4; ++m) _Pragma("unroll") for (int k = 0; k < 2; ++k) dst[m][k] = *(const PG8_LAS bf16x8*)(lds + PG8_SA(b, h) + aoff + m * 2048 + k * 1024); } while (0)
#define PG8_LDB(dst, b, h) do { _Pragma("unroll") for (int n = 0; n < 2; ++n) _Pragma("unroll") for (int k = 0; k < 2; ++k) dst[n][k] = *(const PG8_LAS bf16x8*)(lds + PG8_SB(b, h) + boff + n * 2048 + k * 1024); } while (0)
#define PG8_MMA(ai, bj, At, Bt) do { __builtin_amdgcn_s_setprio(1); _Pragma("unroll") for (int m = 0; m < 4; ++m) _Pragma("unroll") for (int n = 0; n < 2; ++n) _Pragma("unroll") for (int k = 0; k < 2; ++k) \
        acc[ai][bj][m][n] = __builtin_amdgcn_mfma_f32_16x16x32_bf16(Bt[n][k], At[m][k], acc[ai][bj][m][n], 0, 0, 0); __builtin_amdgcn_s_setprio(0); } while (0)
#define PG8_WAIT_V(n) asm volatile("s_waitcnt vmcnt(" #n ")" ::: "memory")
#define PG8_WAIT_L(n) asm volatile("s_waitcnt lgkmcnt(" #n ")" ::: "memory")
#define PG8_BAR __builtin_amdgcn_s_barrier()
#define PG8_SCHED __builtin_amdgcn_sched_barrier(0)
    Unit cur, nxt; int ui = 0;
    if (!S.next(0, cur)) return;
    f32x4 acc[2][2][4][2];
#pragma unroll
    for (int a = 0; a < 2; ++a)
#pragma unroll
        for (int b = 0; b < 2; ++b)
#pragma unroll
            for (int m = 0; m < 4; ++m)
#pragma unroll
                for (int n = 0; n < 2; ++n) acc[a][b][m][n] = (f32x4){0.f, 0.f, 0.f, 0.f};
    bf16x8 At[4][2], B0[2][2], B1[2][2];
    const char* cA = (const char*)g.A + (size_t)cur.pm * tstep; const char* cB = (const char*)g.Bt + (size_t)cur.pn * tstep;
    S.a_ready(cur);
    if constexpr (SP2) {
        PG8_STAGE(PG8_SB(0, 0), cB, voffB); PG8_STAGE(PG8_SB(0, 1), cB + hstep, voffB); PG8_STAGE(PG8_SA(0, 0), cA, voffA); PG8_STAGE(PG8_SA(0, 1), cA + hstep, voffA);
        if (wr == 1) PG8_BAR;
        PG8_WAIT_V(2); PG8_BAR;
        PG8_STAGE(PG8_SB(1, 0), cB + kstep, voffB); PG8_STAGE(PG8_SA(1, 0), cA + kstep, voffA); PG8_STAGE(PG8_SB(1, 1), cB + hstep + kstep, voffB);
        PG8_WAIT_V(6); PG8_BAR;
    } else {
        PG8_STAGE(PG8_SB(0, 0), cB, voffB); PG8_STAGE(PG8_SA(0, 0), cA, voffA); PG8_STAGE(PG8_SB(0, 1), cB + hstep, voffB); PG8_STAGE(PG8_SA(0, 1), cA + hstep, voffA);
        if (wr == 1) PG8_BAR;
        PG8_WAIT_V(4); PG8_BAR;
        PG8_STAGE(PG8_SB(1, 0), cB + kstep, voffB); PG8_STAGE(PG8_SA(1, 0), cA + kstep, voffA); PG8_STAGE(PG8_SB(1, 1), cB + hstep + kstep, voffB);
        PG8_WAIT_V(6); PG8_BAR;
    }
    for (;;) {
        const bool has_next = S.next(ui + 1, nxt);
        const char* nA = has_next ? (const char*)g.A + (size_t)nxt.pm * tstep : cA; const char* nB = has_next ? (const char*)g.Bt + (size_t)nxt.pn * tstep : cB;
        for (int t = 0; t < nt; t += 2) {
            const bool last = (t == nt - 2);
            const char* a1 = cA + (size_t)(t + 1) * kstep;
            const char* a2 = last ? nA : cA + (size_t)(t + 2) * kstep; const char* b2 = last ? nB : cB + (size_t)(t + 2) * kstep;
            const char* a3 = a2 + kstep; const char* b3 = b2 + kstep;
            if (last && has_next) S.a_ready(nxt);
            if constexpr (SP2) {
            PG8_LDB(B0, 0, 0); PG8_LDB(B1, 0, 1); PG8_SCHED; PG8_LDA(At, 0, 0); PG8_STAGE(PG8_SA(1, 1), a1 + hstep, voffA);
            PG8_WAIT_V(8); PG8_WAIT_L(0); PG8_BAR; PG8_MMA(0, 0, At, B0); PG8_MMA(0, 1, At, B1); PG8_BAR; PG8_SCHED;
            PG8_LDA(At, 0, 1); PG8_STAGE(PG8_SB(0, 0), b2, voffB); PG8_STAGE(PG8_SB(0, 1), b2 + hstep, voffB); PG8_STAGE(PG8_SA(0, 0), a2, voffA);
            PG8_WAIT_V(8); PG8_WAIT_L(0); PG8_BAR; PG8_MMA(1, 0, At, B0); PG8_MMA(1, 1, At, B1); PG8_BAR; PG8_SCHED;
            PG8_LDB(B0, 1, 0); PG8_LDB(B1, 1, 1); PG8_SCHED; PG8_LDA(At, 1, 0); PG8_STAGE(PG8_SA(0, 1), a2 + hstep, voffA);
            PG8_WAIT_V(8); PG8_WAIT_L(0); PG8_BAR; PG8_MMA(0, 0, At, B0); PG8_MMA(0, 1, At, B1); PG8_BAR; PG8_SCHED;
            PG8_LDA(At, 1, 1); PG8_STAGE(PG8_SB(1, 0), b3, voffB); PG8_STAGE(PG8_SB(1, 1), b3 + hstep, voffB); PG8_STAGE(PG8_SA(1, 0), a3, voffA);
            PG8_WAIT_V(8); PG8_WAIT_L(0); PG8_BAR; PG8_MMA(1, 0, At, B0); PG8_MMA(1, 1, At, B1); PG8_BAR; PG8_SCHED;
            } else {
            PG8_LDB(B0, 0, 0); PG8_SCHED; PG8_LDA(At, 0, 0); PG8_STAGE(PG8_SA(1, 1), a1 + hstep, voffA);
            PG8_WAIT_L(8); PG8_BAR; PG8_WAIT_L(0); PG8_MMA(0, 0, At, B0); PG8_BAR; PG8_SCHED;
            PG8_LDB(B1, 0, 1); PG8_STAGE(PG8_SB(0, 0), b2, voffB);
            PG8_BAR; PG8_WAIT_L(0); PG8_MMA(0, 1, At, B1); PG8_BAR;
            PG8_LDA(At, 0, 1); PG8_STAGE(PG8_SA(0, 0), a2, voffA);
            PG8_BAR; PG8_WAIT_L(0); PG8_MMA(1, 0, At, B0); PG8_BAR; PG8_SCHED;
            PG8_STAGE(PG8_SB(0, 1), b2 + hstep, voffB);
            PG8_WAIT_V(6); PG8_BAR; PG8_MMA(1, 1, At, B1); PG8_BAR;
            PG8_LDB(B0, 1, 0); PG8_SCHED; PG8_LDA(At, 1, 0); PG8_STAGE(PG8_SA(0, 1), a2 + hstep, voffA);
            PG8_WAIT_L(8); PG8_BAR; PG8_WAIT_L(0); PG8_MMA(0, 0, At, B0); PG8_BAR; PG8_SCHED;
            PG8_LDB(B1, 1, 1); PG8_STAGE(PG8_SB(1, 0), b3, voffB);
            PG8_BAR; PG8_WAIT_L(0); PG8_MMA(0, 1, At, B1); PG8_BAR;
            PG8_LDA(At, 1, 1); PG8_STAGE(PG8_SA(1, 0), a3, voffA);
            PG8_BAR; PG8_WAIT_L(0); PG8_MMA(1, 0, At, B0); PG8_BAR; PG8_SCHED;
            PG8_STAGE(PG8_SB(1, 1), b3 + hstep, voffB);
            PG8_WAIT_V(6); PG8_BAR; PG8_MMA(1, 1, At, B1); PG8_BAR;
            }
        }
        if constexpr (ALIGN_EPI) { if (wr == 0) PG8_BAR; }
        if constexpr (!Epi::AFTER_DRAIN) { E(acc, cur, wr, wc, fr, fq); S.done(cur); }
        if (!has_next) break;
#pragma unroll
        for (int a = 0; a < 2; ++a)
#pragma unroll
            for (int b = 0; b < 2; ++b)
#pragma unroll
                for (int m = 0; m < 4; ++m)
#pragma unroll
                    for (int n = 0; n < 2; ++n) acc[a][b][m][n] = (f32x4){0.f, 0.f, 0.f, 0.f};
        cur = nxt; cA = nA; cB = nB; ++ui;
        if constexpr (ALIGN_EPI) { if (wr == 1) PG8_BAR; }
    }
    PG8_WAIT_V(0);
    if constexpr (!ALIGN_EPI) { if (wr == 0) PG8_BAR; }
    PG8_BAR;
#undef PG8_SA
#undef PG8_SB
#undef PG8_STAGE
#undef PG8_LDA
#undef PG8_LDB
#undef PG8_MMA
#undef PG8_WAIT_V
#undef PG8_WAIT_L
#undef PG8_BAR
#undef PG8_SCHED
}
}

#ifndef PROBE_DUP
#define PROBE_DUP 0
#endif
#ifndef PG8_SP2
#define PG8_SP2 true
#endif
#ifndef PG8_ALIGN
#define PG8_ALIGN true
#endif

constexpr int NWAVES = 8;
constexpr int N_LAUNCHES = MK_N_LAUNCHES;
constexpr int N_PHASES = 10;
constexpr int D = 1024, MP = 16384, MS = 512, M = MP + MS, TP = 2048, NBP = 8, NBS = 128, TS = 4;
constexpr int NZ = 1536, WA = 512, WB = 512, FF = 4096, NMOD = 6 * D, NROWMOD = NBP + NBS;
constexpr int GB = 32, NS5 = 64, KS5 = 16, HA = 8, HDA = 64;
constexpr float LN_EPS = 1e-5f;
constexpr float ALPHA = 1.189207115002721f;

constexpr size_t O_YP = 0, O_YS = (size_t)MP * D, O_CONVP = O_YS + (size_t)MS * D, O_HP = O_CONVP + (size_t)NBP * 3 * WA, O_SRP = O_HP + (size_t)NBP * WA,
                 O_SIP = O_SRP + (size_t)NBP * GB * NS5, O_CONVS = O_SIP + (size_t)NBP * GB * NS5, O_HS = O_CONVS + (size_t)NBS * 3 * WA, O_SRS = O_HS + (size_t)NBS * WA,
                 O_SIS = O_SRS + (size_t)NBS * GB * NS5, O_END = O_SIS + (size_t)NBS * GB * NS5;

constexpr size_t MiB = 1u << 20;
constexpr size_t WS_CTL = 0, CTL_ZERO_BYTES = 1 * MiB;
constexpr size_t WS_WIN = 1 * MiB, WS_WGLU = 4 * MiB, WS_WOUT = 5 * MiB, WS_W1 = 7 * MiB, WS_W2 = 15 * MiB;
constexpr size_t WS_MOD = 23 * MiB;
constexpr size_t WS_S5C = 27 * MiB;
constexpr size_t WS_XN = 28 * MiB;
constexpr size_t WS_Z = 61 * MiB;
constexpr size_t WS_YCAT = 111 * MiB;
constexpr size_t WS_G = 144 * MiB;
constexpr size_t WS_U = 61 * MiB;
constexpr size_t WS_TAB = 194 * MiB;
constexpr size_t WS_END = 196 * MiB;
constexpr size_t TB_BF1 = 0, TB_BF2 = TB_BF1 + 32 * 4 * 64 * 16, TB_TA = TB_BF2 + 32 * 8 * 64 * 16, TB_ZP = TB_TA + 32 * 2 * 2 * 32 * 4, TB_Z16N = TB_ZP + 32 * 17 * 2 * 2 * 32 * 4,
                 TB_RG = TB_Z16N + 32 * 2 * 64 * 4, TB_CB = TB_RG + 8 * 2 * 2 * 4 * 64 * 16, TB_END = TB_CB + 128 * 3 * 512 * 2;
static_assert(WS_TAB + TB_END <= WS_END, "tables");
static_assert(WS_XN + (size_t)M * D * 2 <= WS_Z && WS_Z + (size_t)M * NZ * 2 <= WS_YCAT && WS_YCAT + (size_t)M * D * 2 <= WS_G && WS_G + (size_t)M * WB * 2 <= WS_END && WS_U + (size_t)M * FF * 2 <= WS_TAB, "d_ws map");
constexpr int SC_ABR = 0, SC_ABI = 2048, SC_BBR = 4096, SC_BBI = 4096 + 32768, SC_RGL = 4096 + 65536, SC_END = SC_RGL + 512;
constexpr int CW_TMO = 0, CW_CODE = 1, CW_BAR = 4096;

constexpr int RING_OFF = 0, RING_BYTES = 131072;
constexpr int LDSCTL_OFF = RING_BYTES, MISC_OFF = LDSCTL_OFF + 320;
constexpr int LDS_BYTES = 147456;

#define GAS __attribute__((address_space(1)))
#define LAS __attribute__((address_space(3)))
typedef unsigned short bf16;
typedef unsigned v4u __attribute__((ext_vector_type(4)));
typedef float f32x4 __attribute__((ext_vector_type(4)));
typedef GAS unsigned gu32;
#define RLX_AGENT __ATOMIC_RELAXED, __HIP_MEMORY_SCOPE_AGENT
#define LDS_WAIT() asm volatile("s_waitcnt lgkmcnt(0)" ::: "memory")
#define VM_WAIT() asm volatile("s_waitcnt vmcnt(0)" ::: "memory")
__device__ __forceinline__ unsigned f2bf(float f) { unsigned u = __builtin_bit_cast(unsigned, f); return (u + 0x7fffu + ((u >> 16) & 1u)) >> 16; }
__device__ __forceinline__ unsigned pk2(float lo, float hi) { return f2bf(lo) | (f2bf(hi) << 16); }
__device__ __forceinline__ float bf2f(bf16 v) { return __builtin_bit_cast(float, (unsigned)v << 16); }
__device__ __forceinline__ float gelu_tanh(float x) { const float t = -2.3022082f * (x + 0.044715f * x * x * x); return x * __builtin_amdgcn_rcpf(1.f + __builtin_amdgcn_exp2f(t)); }
__device__ __forceinline__ float sigmoidf_(float x) { return __builtin_amdgcn_rcpf(1.f + __builtin_amdgcn_exp2f(-1.4426950408889634f * x)); }

#define XB_TMO      128
#define XB_XCNT(j)  (256  + 64 * (j))
#define XB_XSUB(j)  (1280 + 64 * (j))
#define XB_XGEN(j)  (2304 + 64 * (j))
#define XB_TOP      3328
#define XB_TOPGEN   3392
#define XCD_BAR_WORDS 3456
#define XB_SPIN_CAP (1u << 18)
__device__ __forceinline__ unsigned xb_ld(unsigned* p)              { return __hip_atomic_load(p, __ATOMIC_RELAXED, __HIP_MEMORY_SCOPE_AGENT); }
__device__ __forceinline__ unsigned xb_add(unsigned* p, unsigned v) { return __hip_atomic_fetch_add(p, v, __ATOMIC_RELAXED, __HIP_MEMORY_SCOPE_AGENT); }
__device__ __forceinline__ unsigned xb_xcc_id() { return (unsigned)__builtin_amdgcn_s_getreg((3 << 11) | 20) & 0xFu; }
#define XB_SPIN(cond, bar) do { unsigned _sp = 0; while (cond) { __builtin_amdgcn_s_sleep(1); \
    if ((++_sp & 255u) == 0u) { if (xb_ld(&(bar)[XB_TMO])) break; if (_sp > XB_SPIN_CAP) { atomicAdd(&(bar)[XB_TMO], 1u); break; } } } } while (0)
struct XcdBarrier { unsigned* bar; unsigned x; volatile LAS unsigned* st; };
__device__ __forceinline__ XcdBarrier xcd_barrier_post(unsigned* bar, volatile LAS unsigned* st) {
    XcdBarrier b; b.bar = bar; b.x = xb_xcc_id(); b.st = st;
    if (threadIdx.x == 0) (void)xb_add(&bar[XB_XCNT(b.x)], 1u);
    return b;
}
__device__ __forceinline__ void xcd_barrier_complete(unsigned* bar, unsigned x, unsigned& nloc, unsigned& nx) {
    const unsigned G = gridDim.x * gridDim.y * gridDim.z;
    unsigned sum, cnt, mine, sp = 0u;
    for (;;) {
        sum = 0u; cnt = 0u; mine = 0u;
#pragma unroll
        for (unsigned j = 0; j < 16; ++j) { const unsigned c = xb_ld(&bar[XB_XCNT(j)]); sum += c; cnt += (c > 0u) ? 1u : 0u; mine = (j == x) ? c : mine; }
        if (sum == G) break;
        __builtin_amdgcn_s_sleep(1);
        if ((++sp & 255u) == 0u) { if (xb_ld(&bar[XB_TMO])) break; if (sp > XB_SPIN_CAP) { atomicAdd(&bar[XB_TMO], 1u); break; } }
    }
    nloc = mine > 0u ? mine : 1u; nx = cnt > 0u ? cnt : 1u;
}
__device__ __forceinline__ void xcd_barrier(const XcdBarrier& b) {
    asm volatile("s_waitcnt vmcnt(0)" ::: "memory");
    __syncthreads();
    if (threadIdx.x == 0) {
        unsigned* bar = b.bar;
        __builtin_amdgcn_s_waitcnt(0);
        unsigned nloc = b.st[0], nx = b.st[1];
        if (nloc == 0u) { xcd_barrier_complete(bar, b.x, nloc, nx); b.st[0] = nloc; b.st[1] = nx; }
        const unsigned old = xb_add(&bar[XB_XSUB(b.x)], 1u);
        const unsigned gen = old / nloc;
        if (old + 1u == (gen + 1u) * nloc) {
            __builtin_amdgcn_fence(__ATOMIC_RELEASE, "agent");
            asm volatile("s_waitcnt vmcnt(0)" ::: "memory");
            const unsigned og = xb_add(&bar[XB_TOP], 1u);
            const unsigned tg = og / nx;
            if (og + 1u == (tg + 1u) * nx) xb_add(&bar[XB_TOPGEN], 1u);
            else XB_SPIN(xb_ld(&bar[XB_TOPGEN]) == tg, bar);
            __builtin_amdgcn_fence(__ATOMIC_ACQUIRE, "agent");
            xb_add(&bar[XB_XGEN(b.x)], 1u);
            asm volatile("s_waitcnt vmcnt(0)" ::: "memory");
        } else {
            XB_SPIN(xb_ld(&bar[XB_XGEN(b.x)]) == gen, bar);
            __builtin_amdgcn_fence(__ATOMIC_ACQUIRE, "agent");
            asm volatile("s_waitcnt vmcnt(0)" ::: "memory");
        }
    }
    __syncthreads();
}

struct Frame {
    LAS unsigned char* lds;
    volatile LAS unsigned* MISC;
    gu32* ctl;
    int tid, lane, wave;
    int vcu, G;
    float* out;
    unsigned char* ws;
};
struct Args { const float* in[37]; float* out; unsigned char* ws; int ph_lo, ph_hi, li, pad; };
__device__ __forceinline__ void refresh(Frame& F) { int t = threadIdx.x; asm volatile("" : "+v"(t)); F.tid = t; F.lane = t & 63; F.wave = __builtin_amdgcn_readfirstlane(t >> 6); }
__device__ __forceinline__ float wave_sum(float v) {
#pragma unroll
    for (int o = 1; o < 64; o <<= 1) v += __shfl_xor(v, o);
    return v;
}
enum { I_XP = 0, I_XS, I_SCONV, I_SH, I_SSR, I_SSI, I_CP, I_CS, I_ADAW, I_ADAB, I_INPROJ, I_CONVW, I_CONVB, I_RGWR, I_RGBR, I_RGWI, I_RGBI, I_RGLAM,
       I_S5ARE, I_S5AIM, I_S5LOGDT, I_S5BRE, I_S5BIM, I_S5CRE, I_S5CIM, I_S5D, I_GLUW, I_GLUB, I_OUTPROJ, I_LN1G, I_LN1B, I_W1, I_B1, I_W2, I_B2, I_LN2G, I_LN2B };

typedef float f32x2m __attribute__((ext_vector_type(2)));
typedef __bf16 bf16x2m __attribute__((ext_vector_type(2)));
__device__ __forceinline__ unsigned pkbf0(float a, float b) { const f32x2m v = {a, b}; const bf16x2m r = __builtin_convertvector(v, bf16x2m); return __builtin_bit_cast(unsigned, r); }
typedef short bf16x8m __attribute__((ext_vector_type(8)));
typedef float f32x16m __attribute__((ext_vector_type(16)));
__device__ __forceinline__ void p0_transpose_item(const float* W, int K, int N, bf16* WT, LAS float* scr, int item, int lane) {
    const int nblk = N / 32, kb = item / nblk, nb = item % nblk, k0 = 64 * kb, n0 = 32 * nb;
#pragma unroll 8
    for (int i = 0; i < 32; ++i) { const int kk = 2 * i + (lane >> 5); scr[kk * 33 + (lane & 31)] = W[(size_t)(k0 + kk) * N + n0 + (lane & 31)]; }
    LDS_WAIT(); asm volatile("" ::: "memory");
    const int c = lane & 7;
#pragma unroll
    for (int j = 0; j < 4; ++j) { const int n = (lane >> 3) + 8 * j; const LAS float* s = scr + (8 * c) * 33 + n;
        v4u o; o.x = pk2(s[0 * 33], s[1 * 33]); o.y = pk2(s[2 * 33], s[3 * 33]); o.z = pk2(s[4 * 33], s[5 * 33]); o.w = pk2(s[6 * 33], s[7 * 33]);
        *(GAS v4u*)(WT + (size_t)(n0 + n) * K + k0 + 8 * c) = o; }
    LDS_WAIT(); asm volatile("" ::: "memory");
}

#ifndef PROBE_P0PART
#define PROBE_P0PART 7
#endif
__device__ __forceinline__ void p0_prologue(Frame& F, const Args& A, int rep = 0) {
    refresh(F);
    const int pmask = rep ? PROBE_P0PART : 7;
    LAS float* scr = (LAS float*)(F.lds + RING_OFF + F.wave * 16384);
    const int gw = F.wave * F.G + F.vcu, NGW = F.G * NWAVES;
    constexpr int I_IN = (D / 64) * (NZ / 32), I_GL = (WB / 64) * (WB / 32), I_OU = (D / 64) * (D / 32), I_1 = (D / 64) * (FF / 32), I_2 = (FF / 64) * (D / 32);
    constexpr int I_S5 = GB, I_RG = WA / 64, I_RGT = HA * 2 * 2 * 4, I_CB = NBS * 3 * WA / 512;
    constexpr int NITEMS = I_IN + I_GL + I_OU + I_1 + I_2 + I_S5 + I_RG + I_RGT + I_CB;
    float* sc = (float*)(F.ws + WS_S5C);
    for (int it = gw; it < NITEMS; it += NGW) {
        int r = it;
        if (!(pmask & 1) && it < I_IN + I_GL + I_OU + I_1 + I_2) continue;
        if (!(pmask & 2) && it >= I_IN + I_GL + I_OU + I_1 + I_2) continue;
        if (r < I_IN) { p0_transpose_item(A.in[I_INPROJ], D, NZ, (bf16*)(F.ws + WS_WIN), scr, r, F.lane); continue; } r -= I_IN;
        if (r < I_GL) { p0_transpose_item(A.in[I_GLUW], WB, WB, (bf16*)(F.ws + WS_WGLU), scr, r, F.lane); continue; } r -= I_GL;
        if (r < I_OU) { p0_transpose_item(A.in[I_OUTPROJ], D, D, (bf16*)(F.ws + WS_WOUT), scr, r, F.lane); continue; } r -= I_OU;
        if (r < I_1) { p0_transpose_item(A.in[I_W1], D, FF, (bf16*)(F.ws + WS_W1), scr, r, F.lane); continue; } r -= I_1;
        if (r < I_2) { p0_transpose_item(A.in[I_W2], FF, D, (bf16*)(F.ws + WS_W2), scr, r, F.lane); continue; } r -= I_2;
        if (r < I_S5) {
            const int g = r, n = F.lane, gn = g * NS5 + n;
            const double dt = exp((double)A.in[I_S5LOGDT][g]), ar = (double)A.in[I_S5ARE][gn], ai = (double)A.in[I_S5AIM][gn];
            const double mag = exp(dt * ar), abr = mag * cos(dt * ai), abi = mag * sin(dt * ai), den = ar * ar + ai * ai, nr = abr - 1.0;
            const double qr = (nr * ar + abi * ai) / den, qi = (abi * ar - nr * ai) / den;
            sc[SC_ABR + gn] = (float)abr; sc[SC_ABI + gn] = (float)abi;
            unsigned char* tab = F.ws + WS_TAB;
            bf16* BF1 = (bf16*)(tab + TB_BF1); bf16* BF2 = (bf16*)(tab + TB_BF2); float* TA = (float*)(tab + TB_TA); float* ZP = (float*)(tab + TB_ZP); float* Z16N = (float*)(tab + TB_Z16N);
            const int sh = n >> 5, v = n & 31, hh = (v >> 2) & 1, ii = (v & 3) + 4 * (v >> 3);
            for (int k = 0; k < KS5; ++k) { const double br = (double)A.in[I_S5BRE][gn * KS5 + k], bi = (double)A.in[I_S5BIM][gn * KS5 + k];
                const float vr = (float)(qr * br - qi * bi), vi = (float)(qr * bi + qi * br);
                sc[SC_BBR + gn * KS5 + k] = vr; sc[SC_BBI + gn * KS5 + k] = vi;
                const int lp = (n & 31) + 32 * (k >> 3), jj = k & 7;
                BF1[(size_t)((g * 4 + 0 + sh) * 64 + lp) * 8 + jj] = (bf16)f2bf(vr); BF1[(size_t)((g * 4 + 2 + sh) * 64 + lp) * 8 + jj] = (bf16)f2bf(vi); }
            { const int s2 = (n >> 4) & 1, jj = 4 * ((n >> 3) & 1) + (n & 3), hk = (n >> 2) & 1;
              for (int ch = 0; ch < KS5; ++ch) { const int hr_ = ch >> 3, i8 = ch & 7, R = (i8 & 3) + 8 * (i8 >> 2) + 4 * hr_, lp = R + 32 * hk;
                  const float cr = A.in[I_S5CRE][(size_t)(g * KS5 + ch) * NS5 + n], ci = A.in[I_S5CIM][(size_t)(g * KS5 + ch) * NS5 + n];
                  BF2[(size_t)((g * 8 + (0 + sh) * 2 + s2) * 64 + lp) * 8 + jj] = (bf16)f2bf(cr); BF2[(size_t)((g * 8 + (2 + sh) * 2 + s2) * 64 + lp) * 8 + jj] = (bf16)f2bf(-ci); }
              for (int z = 0; z < 4; ++z) { const int cidx = n + 64 * z, ks = cidx >> 5, r16 = cidx & 31, lp = 16 + (r16 & 15) + 32 * (r16 >> 4);
                  *(v4u*)(BF2 + (size_t)((g * 8 + ks) * 64 + lp) * 8) = (v4u){0u, 0u, 0u, 0u}; } }
            TA[((g * 2 + hh) * 2 + 0) * 32 + sh * 16 + ii] = (float)abr; TA[((g * 2 + hh) * 2 + 1) * 32 + sh * 16 + ii] = (float)abi;
            const double mg8 = exp(8.0 * dt * ar), z1r = mg8 * cos(8.0 * dt * ai), z1i = mg8 * sin(8.0 * dt * ai); double pzr = 1.0, pzi = 0.0;
            for (int e = 0; e <= 16; ++e) { const float zr = (float)pzr, zi = (float)pzi; { const double nr2 = pzr * z1r - pzi * z1i, ni2 = pzr * z1i + pzi * z1r; pzr = nr2; pzi = ni2; }
                ZP[(((g * 17 + e) * 2 + hh) * 2 + 0) * 32 + sh * 16 + ii] = zr; ZP[(((g * 17 + e) * 2 + hh) * 2 + 1) * 32 + sh * 16 + ii] = zi;
                if (e == 16) { Z16N[(g * 2 + 0) * 64 + n] = zr; Z16N[(g * 2 + 1) * 64 + n] = zi; } }
            continue; } r -= I_S5;
        if (r < I_RG) { const int c = r * 64 + F.lane; const double lam = (double)A.in[I_RGLAM][c];
          sc[SC_RGL + c] = (float)(-8.0 * log1p(exp(-lam)) * 1.4426950408889634); continue; } r -= I_RG;
        if (r >= I_RGT) { r -= I_RGT;
            const float* src = A.in[I_SCONV] + (size_t)r * 512 + F.lane * 8; const f32x4 a0 = *(const f32x4*)src, a1 = *(const f32x4*)(src + 4);
            v4u o; o.x = pk2(a0[0], a0[1]); o.y = pk2(a0[2], a0[3]); o.z = pk2(a1[0], a1[1]); o.w = pk2(a1[2], a1[3]);
            *(v4u*)(F.ws + WS_TAB + TB_CB + ((size_t)r * 512 + F.lane * 8) * 2) = o; continue; }
        {
            const int s4 = r & 3, gate = (r >> 2) & 1, jh = (r >> 3) & 1, hd = r >> 4;
            const int R = F.lane & 31, hk = F.lane >> 5, hR = (R >> 2) & 1, i = (R & 3) + 4 * (R >> 3), cho = 32 * jh + 16 * (i >> 3) + 8 * hR + (i & 7);
            const float* W = A.in[gate ? I_RGWI : I_RGWR] + (size_t)(hd * 64 + 16 * s4 + 8 * hk) * 64 + cho;
            v4u o; o.x = pk2(W[0], W[64]); o.y = pk2(W[128], W[192]); o.z = pk2(W[256], W[320]); o.w = pk2(W[384], W[448]);
            *(v4u*)(F.ws + WS_TAB + TB_RG + (size_t)(r * 64 + F.lane) * 16) = o;
        }
    }
    __syncthreads();
    LAS float* RED = (LAS float*)(F.lds + RING_OFF);
    float* mod = (float*)(F.ws + WS_MOD);
    const int r32 = F.lane & 31, hh = F.lane >> 5;
#pragma unroll 1
    for (int it = F.vcu; it < ((pmask & 4) ? NMOD / 32 : 0); it += F.G) {
        const int n0 = it * 32;
        for (int e = F.tid; e < 5 * 16 * 64; e += NWAVES * 64) RED[e] = 0.f;
        __syncthreads();
        f32x16m acc[5];
#pragma unroll
        for (int rt = 0; rt < 5; ++rt)
#pragma unroll
            for (int i = 0; i < 16; ++i) acc[rt][i] = 0.f;
#pragma unroll 1
        for (int kb = 0; kb < 2; ++kb) {
        float bw[4][8];
#pragma unroll
        for (int ks = 0; ks < 4; ++ks) { const float* wp = A.in[I_ADAW] + (size_t)(F.wave * 128 + (kb * 4 + ks) * 16 + 8 * hh) * NMOD + n0 + r32;
#pragma unroll
            for (int j = 0; j < 8; ++j) bw[ks][j] = wp[(size_t)j * NMOD]; }
#pragma unroll
        for (int ks = 0; ks < 4; ++ks) {
            const int k0 = F.wave * 128 + (kb * 4 + ks) * 16 + 8 * hh;
            v4u bp; bp.x = pkbf0(bw[ks][0], bw[ks][1]); bp.y = pkbf0(bw[ks][2], bw[ks][3]); bp.z = pkbf0(bw[ks][4], bw[ks][5]); bp.w = pkbf0(bw[ks][6], bw[ks][7]);
            const bf16x8m bfr = __builtin_bit_cast(bf16x8m, bp);
#pragma unroll
            for (int rt = 0; rt < 5; ++rt) { int row = 32 * rt + r32; row = row > NROWMOD - 1 ? NROWMOD - 1 : row;
                const float* cp = (row < NBP ? A.in[I_CP] + (size_t)row * D : A.in[I_CS] + (size_t)(row - NBP) * D) + k0;
                const f32x4 c0 = *(const f32x4*)cp, c1 = *(const f32x4*)(cp + 4);
                v4u ap; ap.x = pkbf0(c0[0] * sigmoidf_(c0[0]), c0[1] * sigmoidf_(c0[1])); ap.y = pkbf0(c0[2] * sigmoidf_(c0[2]), c0[3] * sigmoidf_(c0[3]));
                ap.z = pkbf0(c1[0] * sigmoidf_(c1[0]), c1[1] * sigmoidf_(c1[1])); ap.w = pkbf0(c1[2] * sigmoidf_(c1[2]), c1[3] * sigmoidf_(c1[3]));
                acc[rt] = __builtin_amdgcn_mfma_f32_32x32x16_bf16(__builtin_bit_cast(bf16x8m, ap), bfr, acc[rt], 0, 0, 0); }
        }
        }
#pragma unroll
        for (int rt = 0; rt < 5; ++rt)
#pragma unroll
            for (int i = 0; i < 16; ++i) (void)__hip_atomic_fetch_add(RED + (rt * 16 + i) * 64 + F.lane, acc[rt][i], __ATOMIC_RELAXED, __HIP_MEMORY_SCOPE_WORKGROUP);
        __syncthreads();
        for (int e = F.tid; e < 5 * 16 * 64; e += NWAVES * 64) { const int rt = e >> 10, i = (e >> 6) & 15, l = e & 63, row = 32 * rt + (i & 3) + 8 * (i >> 2) + 4 * (l >> 5), col = n0 + (l & 31);
            if (row < NROWMOD) mod[(size_t)row * NMOD + col] = RED[e] + A.in[I_ADAB][col]; }
        __syncthreads();
    }
}

__device__ __forceinline__ int mod_row(int m) { return m < MP ? (m >> 11) : NBP + ((m - MP) >> 2); }
__device__ __forceinline__ const float* x_row(const Args& A, int m) { return m < MP ? A.in[I_XP] + (size_t)m * D : A.in[I_XS] + (size_t)(m - MP) * D; }

__device__ __forceinline__ void p1_modulate(Frame& F, const Args& A) {
    refresh(F);
    const int gw = F.vcu * NWAVES + F.wave, NGW = F.G * NWAVES;
    const float* mod = (const float*)(F.ws + WS_MOD); bf16* XN = (bf16*)(F.ws + WS_XN);
    for (int m = gw; m < M; m += NGW) {
        const GAS f32x4* xr = (const GAS f32x4*)x_row(A, m) + F.lane; const float* mr = mod + (size_t)mod_row(m) * NMOD;
        const GAS f32x4* sh = (const GAS f32x4*)(mr) + F.lane; const GAS f32x4* scp = (const GAS f32x4*)(mr + D) + F.lane;
        GAS unsigned long long* o8 = (GAS unsigned long long*)(XN + (size_t)m * D) + F.lane;
#pragma unroll
        for (int j = 0; j < 4; ++j) { const f32x4 v = xr[64 * j], a = sh[64 * j], s = scp[64 * j]; const f32x4 h = v * (s + 1.f) + a;
            o8[64 * j] = (unsigned long long)pk2(h.x, h.y) | ((unsigned long long)pk2(h.z, h.w) << 32); }
    }
}

template <bool SECOND>
__device__ __forceinline__ void ln_rows(Frame& F, const Args& A) {
    refresh(F);
    const int gw = F.vcu * NWAVES + F.wave, NGW = F.G * NWAVES;
    const float* mod = (const float*)(F.ws + WS_MOD); bf16* XN = (bf16*)(F.ws + WS_XN);
    const GAS f32x4* gg = (const GAS f32x4*)A.in[SECOND ? I_LN2G : I_LN1G] + F.lane; const GAS f32x4* gb = (const GAS f32x4*)A.in[SECOND ? I_LN2B : I_LN1B] + F.lane;
    for (int m = gw; m < M; m += NGW) {
        GAS f32x4* xr = (GAS f32x4*)(F.out + (size_t)m * D) + F.lane;
        f32x4 v[4]; float s = 0.f;
#pragma unroll
        for (int j = 0; j < 4; ++j) { v[j] = xr[64 * j]; s += (v[j].x + v[j].y) + (v[j].z + v[j].w); }
        const float mean = wave_sum(s) * (1.f / D); float s2 = 0.f;
#pragma unroll
        for (int j = 0; j < 4; ++j) { v[j] = v[j] - mean; s2 += (v[j].x * v[j].x + v[j].y * v[j].y) + (v[j].z * v[j].z + v[j].w * v[j].w); }
        const float rstd = 1.f / sqrtf(wave_sum(s2) * (1.f / D) + LN_EPS);
#pragma unroll
        for (int j = 0; j < 4; ++j) { v[j] = v[j] * rstd * gg[64 * j] + gb[64 * j]; xr[64 * j] = v[j]; }
        if (!SECOND) {
            const float* mr = mod + (size_t)mod_row(m) * NMOD;
            const GAS f32x4* sh = (const GAS f32x4*)(mr + 3 * D) + F.lane; const GAS f32x4* scp = (const GAS f32x4*)(mr + 4 * D) + F.lane;
            GAS unsigned long long* o8 = (GAS unsigned long long*)(XN + (size_t)m * D) + F.lane;
#pragma unroll
            for (int j = 0; j < 4; ++j) { const f32x4 h = v[j] * (scp[64 * j] + 1.f) + sh[64 * j];
                o8[64 * j] = (unsigned long long)pk2(h.x, h.y) | ((unsigned long long)pk2(h.z, h.w) << 32); }
        }
    }
}

__device__ __forceinline__ void rg_item_ref(Frame& F, const Args& A, bool prompt, int b, int hd, LAS float* scr) {
    const int j = F.lane, c = hd * HDA + j;
    const bf16* Z = (const bf16*)(F.ws + WS_Z); bf16* Y = (bf16*)(F.ws + WS_YCAT); const float* sc = (const float*)(F.ws + WS_S5C);
    float wr[64], wi[64];
#pragma unroll
    for (int i = 0; i < 64; ++i) { wr[i] = A.in[I_RGWR][(size_t)(hd * 64 + i) * 64 + j]; wi[i] = A.in[I_RGWI][(size_t)(hd * 64 + i) * 64 + j]; }
    const float br = A.in[I_RGBR][c], bi = A.in[I_RGBI][c], L2 = sc[SC_RGL + c];
    const float w0 = A.in[I_CONVW][c], w1 = A.in[I_CONVW][WA + c], w2 = A.in[I_CONVW][2 * WA + c], w3 = A.in[I_CONVW][3 * WA + c], cb = A.in[I_CONVB][c];
    int T, m0; float x3, x2, x1, h;
    if (prompt) { T = TP; m0 = b * TP; x3 = 0.f; x2 = 0.f; x1 = 0.f; h = 0.f; }
    else { T = TS; m0 = MP + b * TS; x3 = A.in[I_SCONV][(size_t)(b * 3 + 0) * WA + c]; x2 = A.in[I_SCONV][(size_t)(b * 3 + 1) * WA + c]; x1 = A.in[I_SCONV][(size_t)(b * 3 + 2) * WA + c]; h = A.in[I_SH][(size_t)b * WA + c]; }
    for (int t = 0; t < T; ++t) {
        const size_t m = (size_t)(m0 + t);
        const float xa = bf2f(Z[m * NZ + WA + c]), gate = bf2f(Z[m * NZ + c]);
        const float xc = cb + w0 * x3 + w1 * x2 + w2 * x1 + w3 * xa; x3 = x2; x2 = x1; x1 = xa;
        scr[j] = xc; LDS_WAIT(); asm volatile("" ::: "memory");
        float rp = br, gp = bi;
#pragma unroll
        for (int i4 = 0; i4 < 16; ++i4) { const f32x4 v = *(const LAS f32x4*)(scr + 4 * i4);
            rp += v[0] * wr[4 * i4] + v[1] * wr[4 * i4 + 1] + v[2] * wr[4 * i4 + 2] + v[3] * wr[4 * i4 + 3];
            gp += v[0] * wi[4 * i4] + v[1] * wi[4 * i4 + 1] + v[2] * wi[4 * i4 + 2] + v[3] * wi[4 * i4 + 3]; }
        LDS_WAIT(); asm volatile("" ::: "memory");
        const float r = sigmoidf_(rp), gi = sigmoidf_(gp);
        const float a = exp2f(r * L2);
        float mult = sqrtf(fmaxf(1.f - a * a, 0.f));
        if (prompt && t == 0) mult = 1.f;
        h = a * h + mult * gi * xc;
        Y[m * D + c] = (bf16)f2bf(gelu_tanh(gate) * h);
    }
    float* oc = F.out + (prompt ? O_CONVP : O_CONVS); float* oh = F.out + (prompt ? O_HP : O_HS);
    oc[(size_t)(b * 3 + 0) * WA + c] = x3; oc[(size_t)(b * 3 + 1) * WA + c] = x2; oc[(size_t)(b * 3 + 2) * WA + c] = x1;
    oh[(size_t)b * WA + c] = h;
}
__device__ __forceinline__ void s5_item_ref(Frame& F, const Args& A, bool prompt, int b, int g, LAS float* scr) {
    const int n = F.lane, gn = g * NS5 + n, k = F.lane & 15, part = F.lane >> 4;
    const bf16* Z = (const bf16*)(F.ws + WS_Z); bf16* Gy = (bf16*)(F.ws + WS_G); const float* sc = (const float*)(F.ws + WS_S5C);
    float bbr[16], bbi[16], cre[16], cim[16];
#pragma unroll
    for (int i = 0; i < 16; ++i) { bbr[i] = sc[SC_BBR + gn * KS5 + i]; bbi[i] = sc[SC_BBI + gn * KS5 + i];
        cre[i] = A.in[I_S5CRE][(size_t)(g * KS5 + k) * NS5 + part * 16 + i]; cim[i] = A.in[I_S5CIM][(size_t)(g * KS5 + k) * NS5 + part * 16 + i]; }
    const float abr = sc[SC_ABR + gn], abi = sc[SC_ABI + gn], dk = A.in[I_S5D][g * KS5 + k];
    int T, m0; float hr, hi;
    if (prompt) { T = TP; m0 = b * TP; hr = 0.f; hi = 0.f; }
    else { T = TS; m0 = MP + b * TS; hr = A.in[I_SSR][(size_t)(b * GB + g) * NS5 + n]; hi = A.in[I_SSI][(size_t)(b * GB + g) * NS5 + n]; }
    for (int t = 0; t < T; ++t) {
        const size_t m = (size_t)(m0 + t);
        const bf16* zr = Z + m * NZ + 2 * WA + g * KS5;
        const v4u u0 = *(const v4u*)zr, u1 = *(const v4u*)(zr + 8);
        float u[16];
        u[0] = pg8::bf_lo(u0.x); u[1] = pg8::bf_hi(u0.x); u[2] = pg8::bf_lo(u0.y); u[3] = pg8::bf_hi(u0.y); u[4] = pg8::bf_lo(u0.z); u[5] = pg8::bf_hi(u0.z); u[6] = pg8::bf_lo(u0.w); u[7] = pg8::bf_hi(u0.w);
        u[8] = pg8::bf_lo(u1.x); u[9] = pg8::bf_hi(u1.x); u[10] = pg8::bf_lo(u1.y); u[11] = pg8::bf_hi(u1.y); u[12] = pg8::bf_lo(u1.z); u[13] = pg8::bf_hi(u1.z); u[14] = pg8::bf_lo(u1.w); u[15] = pg8::bf_hi(u1.w);
        float bur = 0.f, bui = 0.f;
#pragma unroll
        for (int i = 0; i < 16; ++i) { bur += bbr[i] * u[i]; bui += bbi[i] * u[i]; }
        const float nhr = abr * hr - abi * hi + bur, nhi = abr * hi + abi * hr + bui; hr = nhr; hi = nhi;
        scr[n] = hr; scr[64 + n] = hi; LDS_WAIT(); asm volatile("" ::: "memory");
        float p = 0.f;
#pragma unroll
        for (int i4 = 0; i4 < 4; ++i4) { const f32x4 vr = *(const LAS f32x4*)(scr + part * 16 + 4 * i4), vi = *(const LAS f32x4*)(scr + 64 + part * 16 + 4 * i4);
#pragma unroll
            for (int e = 0; e < 4; ++e) p += vr[e] * cre[4 * i4 + e] - vi[e] * cim[4 * i4 + e]; }
        LDS_WAIT(); asm volatile("" ::: "memory");
        p += __shfl_xor(p, 16); p += __shfl_xor(p, 32);
        const float uk = bf2f(zr[k]);
        if (F.lane < 16) Gy[m * WB + g * KS5 + k] = (bf16)f2bf(gelu_tanh(p + dk * uk));
    }
    float* osr = F.out + (prompt ? O_SRP : O_SRS); float* osi = F.out + (prompt ? O_SIP : O_SIS);
    osr[(size_t)(b * GB + g) * NS5 + n] = hr; osi[(size_t)(b * GB + g) * NS5 + n] = hi;
}

typedef short bf16x8v __attribute__((ext_vector_type(8)));
typedef float f32x16 __attribute__((ext_vector_type(16)));
typedef float f32x2v __attribute__((ext_vector_type(2)));
typedef __bf16 bf16x2v __attribute__((ext_vector_type(2)));
#define MFMA32(a, b, c) __builtin_amdgcn_mfma_f32_32x32x16_bf16((a), (b), (c), 0, 0, 0)
__device__ __forceinline__ unsigned pkbf(float a, float b) { const f32x2v v = {a, b}; const bf16x2v r = __builtin_convertvector(v, bf16x2v); return __builtin_bit_cast(unsigned, r); }
template <int CTRL> __device__ __forceinline__ float dppf(float old, float v) { return __builtin_bit_cast(float, __builtin_amdgcn_update_dpp(__builtin_bit_cast(int, old), __builtin_bit_cast(int, v), CTRL, 0xF, 0xF, false)); }
__device__ __forceinline__ f32x16 ld16(const float* p) { f32x16 r;
#pragma unroll
    for (int i = 0; i < 4; ++i) { const f32x4 v = *(const f32x4*)(p + 4 * i); r[4 * i] = v[0]; r[4 * i + 1] = v[1]; r[4 * i + 2] = v[2]; r[4 * i + 3] = v[3]; }
    return r; }
__device__ __forceinline__ f32x16 ld16l(const LAS float* p) { f32x16 r;
#pragma unroll
    for (int i = 0; i < 4; ++i) { const f32x4 v = *(const LAS f32x4*)(p + 4 * i); r[4 * i] = v[0]; r[4 * i + 1] = v[1]; r[4 * i + 2] = v[2]; r[4 * i + 3] = v[3]; }
    return r; }
__device__ __forceinline__ bf16x8v pack8(const f32x16& x, int s) { v4u p; p.x = pkbf(x[8 * s], x[8 * s + 1]); p.y = pkbf(x[8 * s + 2], x[8 * s + 3]); p.z = pkbf(x[8 * s + 4], x[8 * s + 5]); p.w = pkbf(x[8 * s + 6], x[8 * s + 7]); return __builtin_bit_cast(bf16x8v, p); }
template <int CTRL> __device__ __forceinline__ void s5_scan_step(f32x16& xr, f32x16& xi, const f32x16& zr, const f32x16& zi) {
#pragma unroll
    for (int i = 0; i < 16; ++i) { const float sr = dppf<CTRL>(0.f, xr[i]), si = dppf<CTRL>(0.f, xi[i]);
        xr[i] += zr[i] * sr - zi[i] * si; xi[i] += zr[i] * si + zi[i] * sr; }
}
constexpr int S5L_BF1 = 0, S5L_BF2 = 4096, S5L_TOT = 12288, S5L_CAR = 20480, S5L_ZP = 28672  , S5L_TA = 37376  , S5L_U = 38912  ;
template <bool SECOND>
__device__ __forceinline__ void s5_step(LAS unsigned char* L, int lane, const bf16x8v u, f32x16& hr0, f32x16& hr1, f32x16& hi0, f32x16& hi1,
                                        const f32x16& ar0, const f32x16& ar1, const f32x16& ai0, const f32x16& ai1, const float (&dk)[8], bf16* gout) {
    const LAS bf16x8v* a1 = (const LAS bf16x8v*)(L + S5L_BF1) + lane;
    { const f32x16 cr = ar0 * hr0 - ai0 * hi0, ci = ar0 * hi0 + ai0 * hr0; hr0 = MFMA32(a1[0], u, cr); hi0 = MFMA32(a1[128], u, ci); }
    asm volatile("" : "+v"(hr0), "+v"(hi0));
    { const f32x16 cr = ar1 * hr1 - ai1 * hi1, ci = ar1 * hi1 + ai1 * hr1; hr1 = MFMA32(a1[64], u, cr); hi1 = MFMA32(a1[192], u, ci); }
    if (SECOND) {
        const LAS bf16x8v* a2 = (const LAS bf16x8v*)(L + S5L_BF2) + lane;
        f32x16 y;
#pragma unroll
        for (int i = 0; i < 16; ++i) y[i] = 0.f;
        y = MFMA32(a2[0 * 64], pack8(hr0, 0), y); y = MFMA32(a2[1 * 64], pack8(hr0, 1), y);
        y = MFMA32(a2[2 * 64], pack8(hr1, 0), y); y = MFMA32(a2[3 * 64], pack8(hr1, 1), y);
        y = MFMA32(a2[4 * 64], pack8(hi0, 0), y); y = MFMA32(a2[5 * 64], pack8(hi0, 1), y);
        y = MFMA32(a2[6 * 64], pack8(hi1, 0), y); y = MFMA32(a2[7 * 64], pack8(hi1, 1), y);
        const v4u uw = __builtin_bit_cast(v4u, u);
        float o[8];
        o[0] = gelu_tanh(y[0] + dk[0] * pg8::bf_lo(uw.x)); o[1] = gelu_tanh(y[1] + dk[1] * pg8::bf_hi(uw.x));
        o[2] = gelu_tanh(y[2] + dk[2] * pg8::bf_lo(uw.y)); o[3] = gelu_tanh(y[3] + dk[3] * pg8::bf_hi(uw.y));
        o[4] = gelu_tanh(y[4] + dk[4] * pg8::bf_lo(uw.z)); o[5] = gelu_tanh(y[5] + dk[5] * pg8::bf_hi(uw.z));
        o[6] = gelu_tanh(y[6] + dk[6] * pg8::bf_lo(uw.w)); o[7] = gelu_tanh(y[7] + dk[7] * pg8::bf_hi(uw.w));
        v4u w; w.x = pkbf(o[0], o[1]); w.y = pkbf(o[2], o[3]); w.z = pkbf(o[4], o[5]); w.w = pkbf(o[6], o[7]);
        *(v4u*)gout = w;
    }
}
__device__ __forceinline__ void s5_item_fast(Frame& F, const Args& A, int b, int g) {
    refresh(F);
    const int lane = F.lane, q = lane & 31, hh = lane >> 5, w = F.wave, c = w * 32 + q;
    LAS unsigned char* L = F.lds + RING_OFF;
    const unsigned char* tab = F.ws + WS_TAB;
    const size_t m0 = (size_t)b * TP + (size_t)8 * c;
    const bf16* zrow = (const bf16*)(F.ws + WS_Z) + m0 * NZ + 2 * WA + g * KS5 + 8 * hh;
    bf16* grow = (bf16*)(F.ws + WS_G) + m0 * WB + g * KS5 + 8 * hh;
    LAS v4u* UL = (LAS v4u*)(L + S5L_U) + F.tid;
    {
        v4u uu[8];
#pragma unroll
        for (int j = 0; j < 8; ++j) uu[j] = *(const v4u*)(zrow + (size_t)j * NZ);
        const v4u* s1 = (const v4u*)(tab + TB_BF1) + (size_t)g * 256; const v4u* s2 = (const v4u*)(tab + TB_BF2) + (size_t)g * 512;
        if (F.tid < 256) ((LAS v4u*)(L + S5L_BF1))[F.tid] = s1[F.tid];
        ((LAS v4u*)(L + S5L_BF2))[F.tid] = s2[F.tid];
        const v4u* s3 = (const v4u*)(tab + TB_ZP) + (size_t)g * (17 * 128 / 4); for (int e = F.tid; e < 17 * 128 / 4; e += NWAVES * 64) ((LAS v4u*)(L + S5L_ZP))[e] = s3[e];
        if (F.tid < 32) ((LAS v4u*)(L + S5L_TA))[F.tid] = ((const v4u*)(tab + TB_TA) + (size_t)g * 32)[F.tid];
#pragma unroll
        for (int j = 0; j < 8; ++j) UL[512 * j] = uu[j];
    }
    __syncthreads();
    const LAS float* TA = (const LAS float*)(L + S5L_TA) + hh * 64;
    f32x16 ar0 = ld16l(TA), ar1 = ld16l(TA + 16), ai0 = ld16l(TA + 32), ai1 = ld16l(TA + 48);
    f32x16 hr0, hr1, hi0, hi1;
#pragma unroll
    for (int i = 0; i < 16; ++i) { hr0[i] = 0.f; hr1[i] = 0.f; hi0[i] = 0.f; hi1[i] = 0.f; }
    float dk[8];
#pragma unroll
    for (int i = 0; i < 8; ++i) dk[i] = A.in[I_S5D][g * KS5 + 8 * hh + i];
#pragma unroll 1
    for (int j = 0; j < 8; ++j) { const bf16x8v u = __builtin_bit_cast(bf16x8v, UL[512 * j]);
        s5_step<false>(L, lane, u, hr0, hr1, hi0, hi1, ar0, ar1, ai0, ai1, dk, nullptr); }
    const LAS float* ZP = (const LAS float*)(L + S5L_ZP);
#define S5_SCAN(E, CTRL) do { const LAS float* z = ZP + (((E) * 2 + hh) * 2) * 32; \
        { const f32x16 zr = ld16l(z), zi = ld16l(z + 32); s5_scan_step<CTRL>(hr0, hi0, zr, zi); } \
        asm volatile("" : "+v"(hr0), "+v"(hi0) :: "memory"); \
        { const f32x16 zr = ld16l(z + 16), zi = ld16l(z + 48); s5_scan_step<CTRL>(hr1, hi1, zr, zi); } \
        asm volatile("" : "+v"(hr1), "+v"(hi1) :: "memory"); } while (0)
    S5_SCAN(1, 0x111); S5_SCAN(2, 0x112); S5_SCAN(4, 0x114); S5_SCAN(8, 0x118);
#undef S5_SCAN
    const int seg = w * 2 + (q >> 4);
    LAS float* TOT = (LAS float*)(L + S5L_TOT); LAS float* CAR = (LAS float*)(L + S5L_CAR);
    if ((lane & 15) == 15) {
#pragma unroll
        for (int rho = 0; rho < 4; ++rho) {
            *(LAS f32x4*)(TOT + (seg * 2 + 0) * 64 + 0 + 8 * rho + 4 * hh) = (f32x4){hr0[4 * rho], hr0[4 * rho + 1], hr0[4 * rho + 2], hr0[4 * rho + 3]};
            *(LAS f32x4*)(TOT + (seg * 2 + 0) * 64 + 32 + 8 * rho + 4 * hh) = (f32x4){hr1[4 * rho], hr1[4 * rho + 1], hr1[4 * rho + 2], hr1[4 * rho + 3]};
            *(LAS f32x4*)(TOT + (seg * 2 + 1) * 64 + 0 + 8 * rho + 4 * hh) = (f32x4){hi0[4 * rho], hi0[4 * rho + 1], hi0[4 * rho + 2], hi0[4 * rho + 3]};
            *(LAS f32x4*)(TOT + (seg * 2 + 1) * 64 + 32 + 8 * rho + 4 * hh) = (f32x4){hi1[4 * rho], hi1[4 * rho + 1], hi1[4 * rho + 2], hi1[4 * rho + 3]}; }
    }
    __syncthreads();
    if (F.tid < 64) {
        const float* z16 = (const float*)(tab + TB_Z16N) + (size_t)g * 128; const float zr = z16[F.tid], zi = z16[64 + F.tid];
        float cr = 0.f, ci = 0.f;
#pragma unroll
        for (int sg = 0; sg < 16; ++sg) { CAR[(sg * 2 + 0) * 64 + F.tid] = cr; CAR[(sg * 2 + 1) * 64 + F.tid] = ci;
            const float tr = TOT[(sg * 2 + 0) * 64 + F.tid], ti = TOT[(sg * 2 + 1) * 64 + F.tid];
            const float ncr = zr * cr - zi * ci + tr, nci = zr * ci + zi * cr + ti; cr = ncr; ci = nci; }
    }
    __syncthreads();
    {
        const LAS float* z = ZP + (((q & 15) * 2 + hh) * 2) * 32;
#define S5_EXCL(HR, HI, OFF) do { const f32x16 zr = ld16l(z + (OFF)), zi = ld16l(z + 32 + (OFF)); f32x16 kr, ki; \
        _Pragma("unroll") for (int rho = 0; rho < 4; ++rho) { \
            const f32x4 a0 = *(const LAS f32x4*)(CAR + (seg * 2 + 0) * 64 + 2 * (OFF) + 8 * rho + 4 * hh), b0 = *(const LAS f32x4*)(CAR + (seg * 2 + 1) * 64 + 2 * (OFF) + 8 * rho + 4 * hh); \
            _Pragma("unroll") for (int e = 0; e < 4; ++e) { kr[4 * rho + e] = a0[e]; ki[4 * rho + e] = b0[e]; } } \
        _Pragma("unroll") for (int i = 0; i < 16; ++i) { const float sr = dppf<0x111>(0.f, HR[i]), si = dppf<0x111>(0.f, HI[i]); \
            HR[i] = sr + zr[i] * kr[i] - zi[i] * ki[i]; HI[i] = si + zr[i] * ki[i] + zi[i] * kr[i]; } } while (0)
        S5_EXCL(hr0, hi0, 0); asm volatile("" : "+v"(hr0), "+v"(hi0) :: "memory"); S5_EXCL(hr1, hi1, 16); asm volatile("" : "+v"(hr1), "+v"(hi1) :: "memory");
#undef S5_EXCL
    }
    { int off = 0; asm volatile("" : "+v"(off)); const LAS float* TA2 = TA + off; ar0 = ld16l(TA2); ar1 = ld16l(TA2 + 16); ai0 = ld16l(TA2 + 32); ai1 = ld16l(TA2 + 48); }
#pragma unroll 1
    for (int j = 0; j < 8; ++j) { const bf16x8v u = __builtin_bit_cast(bf16x8v, UL[512 * j]);
        s5_step<true>(L, lane, u, hr0, hr1, hi0, hi1, ar0, ar1, ai0, ai1, dk, grow + (size_t)j * WB); }
    if (w == NWAVES - 1 && q == 31) {
        float* osr = F.out + O_SRP + (size_t)(b * GB + g) * NS5; float* osi = F.out + O_SIP + (size_t)(b * GB + g) * NS5;
#pragma unroll
        for (int i = 0; i < 16; ++i) { const int n = (i & 3) + 8 * (i >> 2) + 4 * hh; osr[n] = hr0[i]; osr[32 + n] = hr1[i]; osi[n] = hi0[i]; osi[32 + n] = hi1[i]; }
    }
    __syncthreads();
}

__device__ __forceinline__ void s5_item_sample(Frame& F, const Args& A, int g) {
    refresh(F);
    const int lane = F.lane, q = lane & 31, hh = lane >> 5, w = F.wave;
    LAS unsigned char* L = F.lds + RING_OFF;
    const unsigned char* tab = F.ws + WS_TAB;
    { const v4u* s1 = (const v4u*)(tab + TB_BF1) + (size_t)g * 256; const v4u* s2 = (const v4u*)(tab + TB_BF2) + (size_t)g * 512;
      if (F.tid < 256) ((LAS v4u*)(L + S5L_BF1))[F.tid] = s1[F.tid];
      ((LAS v4u*)(L + S5L_BF2))[F.tid] = s2[F.tid]; }
    __syncthreads();
    if (w < 4) {
        const int b = w * 32 + q;
        const float* TA = (const float*)(tab + TB_TA) + (size_t)((g * 2 + hh) * 2) * 32;
        const f32x16 ar0 = ld16(TA), ar1 = ld16(TA + 16), ai0 = ld16(TA + 32), ai1 = ld16(TA + 48);
        f32x16 hr0, hr1, hi0, hi1;
        const float* sr = A.in[I_SSR] + (size_t)(b * GB + g) * NS5; const float* si = A.in[I_SSI] + (size_t)(b * GB + g) * NS5;
#pragma unroll
        for (int rho = 0; rho < 4; ++rho) { const f32x4 a0 = *(const f32x4*)(sr + 8 * rho + 4 * hh), a1 = *(const f32x4*)(sr + 32 + 8 * rho + 4 * hh), b0 = *(const f32x4*)(si + 8 * rho + 4 * hh), b1 = *(const f32x4*)(si + 32 + 8 * rho + 4 * hh);
#pragma unroll
            for (int e = 0; e < 4; ++e) { hr0[4 * rho + e] = a0[e]; hr1[4 * rho + e] = a1[e]; hi0[4 * rho + e] = b0[e]; hi1[4 * rho + e] = b1[e]; } }
        float dk[8];
#pragma unroll
        for (int i = 0; i < 8; ++i) dk[i] = A.in[I_S5D][g * KS5 + 8 * hh + i];
        const size_t m0 = (size_t)MP + (size_t)b * TS;
        const bf16* zrow = (const bf16*)(F.ws + WS_Z) + m0 * NZ + 2 * WA + g * KS5 + 8 * hh;
        bf16* grow = (bf16*)(F.ws + WS_G) + m0 * WB + g * KS5 + 8 * hh;
        bf16x8v uu[TS];
#pragma unroll
        for (int j = 0; j < TS; ++j) uu[j] = *(const bf16x8v*)(zrow + (size_t)j * NZ);
#pragma unroll
        for (int j = 0; j < TS; ++j) s5_step<true>(L, lane, uu[j], hr0, hr1, hi0, hi1, ar0, ar1, ai0, ai1, dk, grow + (size_t)j * WB);
        float* osr = F.out + O_SRS + (size_t)(b * GB + g) * NS5; float* osi = F.out + O_SIS + (size_t)(b * GB + g) * NS5;
#pragma unroll
        for (int rho = 0; rho < 4; ++rho) {
            *(f32x4*)(osr + 8 * rho + 4 * hh) = (f32x4){hr0[4 * rho], hr0[4 * rho + 1], hr0[4 * rho + 2], hr0[4 * rho + 3]};
            *(f32x4*)(osr + 32 + 8 * rho + 4 * hh) = (f32x4){hr1[4 * rho], hr1[4 * rho + 1], hr1[4 * rho + 2], hr1[4 * rho + 3]};
            *(f32x4*)(osi + 8 * rho + 4 * hh) = (f32x4){hi0[4 * rho], hi0[4 * rho + 1], hi0[4 * rho + 2], hi0[4 * rho + 3]};
            *(f32x4*)(osi + 32 + 8 * rho + 4 * hh) = (f32x4){hi1[4 * rho], hi1[4 * rho + 1], hi1[4 * rho + 2], hi1[4 * rho + 3]}; }
    }
    __syncthreads();
}

template <int CTRL, int RMASK> __device__ __forceinline__ float dppm(float old, float v) { return __builtin_bit_cast(float, __builtin_amdgcn_update_dpp(__builtin_bit_cast(int, old), __builtin_bit_cast(int, v), CTRL, RMASK, 0xF, false)); }
template <int CTRL, int RMASK> __device__ __forceinline__ void rg_scan_step(f32x16& a, f32x16& b) {
#pragma unroll
    for (int i = 0; i < 16; ++i) { const float as = dppm<CTRL, RMASK>(1.f, a[i]), bs = dppm<CTRL, RMASK>(0.f, b[i]); b[i] = a[i] * bs + b[i]; a[i] = a[i] * as; }
}
constexpr int RGL_AFR = 0, RGL_CWT = 8192, RGL_TOT = 10240, RGL_CST = 14336;
constexpr int RGL_XAP = 144, RGL_GTP = 80;
constexpr int RGL_XA0 = 14848, RGL_GT0 = RGL_XA0 + 37376, RGL_BUF = 37376 + 20480;
static_assert(259 * RGL_XAP <= 37376 && 256 * RGL_GTP <= 20480 && RGL_XA0 + 2 * RGL_BUF <= RING_BYTES, "RG-LRU LDS map");
template <bool SAMPLE>
__device__ __forceinline__ void rg_item_fast(Frame& F, const Args& A, int b, int hd, int jh) {
    refresh(F);
    const int lane = F.lane, q = lane & 31, hh = lane >> 5, w = F.wave;
    LAS unsigned char* L = F.lds + RING_OFF;
    const float* sc = (const float*)(F.ws + WS_S5C);
    const bf16* Zb = (const bf16*)(F.ws + WS_Z) + (size_t)(SAMPLE ? MP : b * TP) * NZ; bf16* Yb = (bf16*)(F.ws + WS_YCAT) + (size_t)(SAMPLE ? MP : b * TP) * D;
    const bf16* CB = (const bf16*)(F.ws + WS_TAB + TB_CB);
    auto stage_load = [&](int T0, v4u (&st)[7]) {
#pragma unroll
        for (int k = 0; k < 7; ++k) { const int ci = F.tid + 512 * k; v4u v = (v4u){0u, 0u, 0u, 0u};
            if (ci < 2072) { const int tk = T0 - 3 + (ci >> 3); if (tk >= 0) v = *(const v4u*)(Zb + (size_t)tk * NZ + WA + hd * 64 + (ci & 7) * 8); }
            else if (ci < 2072 + 1024) { const int gi = ci - 2072; v = *(const v4u*)(Zb + (size_t)(T0 + (gi >> 2)) * NZ + hd * 64 + 32 * jh + (gi & 3) * 8); }
            st[k] = v; } };
    auto stage_write = [&](int par, const v4u (&st)[7]) {
#pragma unroll
        for (int k = 0; k < 7; ++k) { const int ci = F.tid + 512 * k;
            if (ci < 2072) *(LAS v4u*)(L + RGL_XA0 + par * RGL_BUF + (ci >> 3) * RGL_XAP + (ci & 7) * 16) = st[k];
            else if (ci < 2072 + 1024) { const int gi = ci - 2072; *(LAS v4u*)(L + RGL_GT0 + par * RGL_BUF + (gi >> 2) * RGL_GTP + (gi & 3) * 16) = st[k]; } } };
    {
        const v4u* src = (const v4u*)(F.ws + WS_TAB + TB_RG) + (size_t)((hd * 2 + jh) * 8) * 64;
        ((LAS v4u*)(L + RGL_AFR))[F.tid] = src[F.tid];
        if (F.tid < 320) { const int h2 = F.tid / 160, tap = (F.tid % 160) / 32, e = F.tid % 32, c = hd * 64 + 16 * (e >> 3) + 8 * h2 + (e & 7);
            ((LAS float*)(L + RGL_CWT))[F.tid] = tap < 4 ? A.in[I_CONVW][tap * WA + c] : A.in[I_CONVB][c]; }
        if (F.tid >= 384 && F.tid < 480) { const int e = F.tid - 384, h2 = e / 48, kind = (e % 48) / 16, i = e % 16, c = hd * 64 + 32 * jh + 16 * (i >> 3) + 8 * h2 + (i & 7);
            ((LAS float*)(L + RGL_CST))[e] = kind == 0 ? A.in[I_RGBR][c] : (kind == 1 ? A.in[I_RGBI][c] : sc[SC_RGL + c]); }
        if (!SAMPLE && jh == 0 && F.tid < 192) { const int k = F.tid >> 6, ch = F.tid & 63;
            F.out[O_CONVP + (size_t)(b * 3 + k) * WA + hd * 64 + ch] = bf2f(((const bf16*)(F.ws + WS_Z))[(size_t)(b * TP + TP - 3 + k) * NZ + WA + hd * 64 + ch]); }
        if (SAMPLE && jh == 0) { for (int e = F.tid; e < NBS * 3 * 64; e += NWAVES * 64) { const int bb = e / 192, k = (e / 64) % 3, ch = e & 63;
            F.out[O_CONVS + (size_t)(bb * 3 + k) * WA + hd * 64 + ch] = bf2f(((const bf16*)(F.ws + WS_Z))[(size_t)(MP + bb * TS + 1 + k) * NZ + WA + hd * 64 + ch]); } }
        if (!SAMPLE) { v4u st[7]; stage_load(0, st); stage_write(0, st); }
    }
    __syncthreads();
    float hround[16];
#pragma unroll
    for (int i = 0; i < 16; ++i) hround[i] = 0.f;
    const LAS float* CWT = (const LAS float*)(L + RGL_CWT) + hh * 160;
#pragma unroll 1
    for (int rd = 0; rd < (SAMPLE ? 2 : 8); ++rd) {
        const int t = rd * 256 + w * 32 + q;
        v4u stn[7];
        if (!SAMPLE) stage_load((rd + 1) * 256, stn);
        const LAS unsigned char* XAp = L + RGL_XA0 + (rd & 1) * RGL_BUF + (w * 32 + q) * RGL_XAP + 16 * hh;
        const LAS unsigned char* GTp = L + RGL_GT0 + (rd & 1) * RGL_BUF + (w * 32 + q) * RGL_GTP + 16 * hh;
        const bf16* zsr[4];
        if (SAMPLE) {
#pragma unroll
            for (int k = 0; k < 4; ++k) { const int jx = (t & 3) + k; zsr[k] = (jx < 3 ? CB + (size_t)((t >> 2) * 3 + jx) * WA : Zb + (size_t)(t - 3 + k) * NZ + WA) + hd * 64 + 8 * hh; } }
        v4u g0, g1;
        if (SAMPLE) { const bf16* gr = Zb + (size_t)t * NZ + hd * 64 + 32 * jh + 8 * hh; g0 = *(const v4u*)gr; g1 = *(const v4u*)(gr + 16); }
        else { g0 = *(const LAS v4u*)GTp; g1 = *(const LAS v4u*)(GTp + 32); }
        float xc[32];
#pragma unroll
        for (int s4 = 0; s4 < 4; ++s4) {
            float acc[8];
#pragma unroll
            for (int j4 = 0; j4 < 2; ++j4) { const f32x4 cb = *(const LAS f32x4*)(CWT + 4 * 32 + s4 * 8 + 4 * j4); acc[4 * j4] = cb[0]; acc[4 * j4 + 1] = cb[1]; acc[4 * j4 + 2] = cb[2]; acc[4 * j4 + 3] = cb[3]; }
#pragma unroll
            for (int k = 0; k < 4; ++k) { const v4u v = SAMPLE ? *(const v4u*)(zsr[k] + 16 * s4) : *(const LAS v4u*)(XAp + k * RGL_XAP + s4 * 32);
                const f32x4 w0 = *(const LAS f32x4*)(CWT + k * 32 + s4 * 8), w1 = *(const LAS f32x4*)(CWT + k * 32 + s4 * 8 + 4);
                acc[0] += w0[0] * pg8::bf_lo(v.x); acc[1] += w0[1] * pg8::bf_hi(v.x); acc[2] += w0[2] * pg8::bf_lo(v.y); acc[3] += w0[3] * pg8::bf_hi(v.y);
                acc[4] += w1[0] * pg8::bf_lo(v.z); acc[5] += w1[1] * pg8::bf_hi(v.z); acc[6] += w1[2] * pg8::bf_lo(v.w); acc[7] += w1[3] * pg8::bf_hi(v.w); }
#pragma unroll
            for (int e = 0; e < 8; ++e) xc[s4 * 8 + e] = acc[e];
            asm volatile("" : "+v"(xc[s4 * 8]), "+v"(xc[s4 * 8 + 7]) :: "memory");
        }
        f32x16 dr, di;
#pragma unroll
        for (int i = 0; i < 16; ++i) { dr[i] = 0.f; di[i] = 0.f; }
        const LAS bf16x8v* af = (const LAS bf16x8v*)(L + RGL_AFR) + lane;
#pragma unroll
        for (int s4 = 0; s4 < 4; ++s4) { v4u p; p.x = pkbf(xc[s4 * 8], xc[s4 * 8 + 1]); p.y = pkbf(xc[s4 * 8 + 2], xc[s4 * 8 + 3]); p.z = pkbf(xc[s4 * 8 + 4], xc[s4 * 8 + 5]); p.w = pkbf(xc[s4 * 8 + 6], xc[s4 * 8 + 7]);
            const bf16x8v bfr = __builtin_bit_cast(bf16x8v, p);
            dr = MFMA32(af[s4 * 64], bfr, dr); di = MFMA32(af[(4 + s4) * 64], bfr, di); }
        f32x16 av, bv;
        const bool first = !SAMPLE && (t == 0);
        const LAS float* CST = (const LAS float*)(L + RGL_CST) + hh * 48;
#pragma unroll
        for (int i = 0; i < 16; ++i) { const float xcv = jh ? xc[16 + i] : xc[i];
            const float r = sigmoidf_(dr[i] + CST[i]), gi = sigmoidf_(di[i] + CST[16 + i]);
            const float a = __builtin_amdgcn_exp2f(r * CST[32 + i]);
            float mult = __builtin_amdgcn_sqrtf(fmaxf(1.f - a * a, 0.f)); if (first) mult = 1.f;
            av[i] = a; bv[i] = mult * gi * xcv; }
        if (SAMPLE && (t & 3) == 0) {
            const float* h0 = A.in[I_SH] + (size_t)(t >> 2) * WA + hd * 64 + 32 * jh + 8 * hh;
#pragma unroll
            for (int i = 0; i < 16; ++i) { bv[i] += av[i] * h0[16 * (i >> 3) + (i & 7)]; av[i] = 0.f; } }
        rg_scan_step<0x111, 0xF>(av, bv); rg_scan_step<0x112, 0xF>(av, bv); rg_scan_step<0x114, 0xF>(av, bv); rg_scan_step<0x118, 0xF>(av, bv);
        rg_scan_step<0x142, 0xA>(av, bv);
        float hin[16];
#pragma unroll
        for (int i = 0; i < 16; ++i) hin[i] = 0.f;
        if (!SAMPLE) {
        LAS float* TOT = (LAS float*)(L + RGL_TOT) + (rd & 1) * 512;
        if (q == 31) {
#pragma unroll
            for (int i4 = 0; i4 < 4; ++i4) { *(LAS f32x4*)(TOT + (w * 2 + 0) * 32 + hh * 16 + 4 * i4) = (f32x4){av[4 * i4], av[4 * i4 + 1], av[4 * i4 + 2], av[4 * i4 + 3]};
                                             *(LAS f32x4*)(TOT + (w * 2 + 1) * 32 + hh * 16 + 4 * i4) = (f32x4){bv[4 * i4], bv[4 * i4 + 1], bv[4 * i4 + 2], bv[4 * i4 + 3]}; }
        }
        stage_write((rd + 1) & 1, stn);
        __syncthreads();
#pragma unroll
        for (int w2 = 0; w2 < 8; ++w2) {
            if (w2 == w) {
#pragma unroll
                for (int i = 0; i < 16; ++i) hin[i] = hround[i]; }
#pragma unroll
            for (int i4 = 0; i4 < 4; ++i4) { const f32x4 p = *(const LAS f32x4*)(TOT + (w2 * 2 + 0) * 32 + hh * 16 + 4 * i4), hl = *(const LAS f32x4*)(TOT + (w2 * 2 + 1) * 32 + hh * 16 + 4 * i4);
#pragma unroll
                for (int e = 0; e < 4; ++e) hround[4 * i4 + e] = p[e] * hround[4 * i4 + e] + hl[e]; }
        }
        }
        float o[16];
        const unsigned gw_[8] = {g0.x, g0.y, g0.z, g0.w, g1.x, g1.y, g1.z, g1.w};
#pragma unroll
        for (int i = 0; i < 16; ++i) { const float h = bv[i] + av[i] * hin[i]; const float gt = (i & 1) ? pg8::bf_hi(gw_[i >> 1]) : pg8::bf_lo(gw_[i >> 1]); o[i] = gelu_tanh(gt) * h; }
        bf16* yr = Yb + (size_t)t * D + hd * 64 + 32 * jh + 8 * hh;
        v4u w0; w0.x = pkbf(o[0], o[1]); w0.y = pkbf(o[2], o[3]); w0.z = pkbf(o[4], o[5]); w0.w = pkbf(o[6], o[7]);
        v4u w1; w1.x = pkbf(o[8], o[9]); w1.y = pkbf(o[10], o[11]); w1.z = pkbf(o[12], o[13]); w1.w = pkbf(o[14], o[15]);
        *(v4u*)yr = w0; *(v4u*)(yr + 16) = w1;
        if (SAMPLE && (t & 3) == 3) {
#pragma unroll
            for (int i = 0; i < 16; ++i) F.out[O_HS + (size_t)(t >> 2) * WA + hd * 64 + 32 * jh + 16 * (i >> 3) + 8 * hh + (i & 7)] = bv[i]; }
    }
    if (!SAMPLE && w == 0 && q == 0) {
#pragma unroll
        for (int i = 0; i < 16; ++i) F.out[O_HP + (size_t)b * WA + hd * 64 + 32 * jh + 16 * (i >> 3) + 8 * hh + (i & 7)] = hround[i];
    }
    __syncthreads();
}

#ifndef PROBE_P3PART
#define PROBE_P3PART 7
#endif
__device__ __forceinline__ void p3_mixers_ref(Frame& F, const Args& A, int rep = 0) {
    constexpr int N_RGP = NBP * HA, N_S5P = NBP * GB;
    const int pm = rep ? PROBE_P3PART : 7;
    if (F.vcu < 2 * N_RGP) {
        if (pm & 1) rg_item_fast<false>(F, A, F.vcu / (2 * HA), (F.vcu / 2) % HA, F.vcu & 1);
    } else {
        const int v = F.vcu - 2 * N_RGP, it = 2 * v;
        if (pm & 2) { s5_item_fast(F, A, it / GB, it % GB);
                      s5_item_fast(F, A, (it + 1) / GB, (it + 1) % GB); }
        if (pm & 4) { if (v < GB) s5_item_sample(F, A, v);
                      else if (v < GB + 2 * HA) rg_item_fast<true>(F, A, 0, (v - GB) >> 1, (v - GB) & 1); }
    }
}

__global__ void __launch_bounds__(NWAVES * 64, 2) fwd(Args A) {
    extern __shared__ __attribute__((aligned(16))) unsigned char lds[];
    Frame F;
    F.lds = (LAS unsigned char*)lds;
    F.MISC = (volatile LAS unsigned*)(F.lds + MISC_OFF);
    F.tid = threadIdx.x; F.lane = F.tid & 63; F.wave = __builtin_amdgcn_readfirstlane(F.tid >> 6);
    F.G = gridDim.x; { const int bx = blockIdx.x; F.vcu = (F.G % 8 == 0) ? (bx % 8) * (F.G / 8) + bx / 8 : bx; }
    F.out = A.out; F.ws = A.ws; F.ctl = (gu32*)(A.ws + WS_CTL);
    for (int u = F.tid; u < (LDS_BYTES - LDSCTL_OFF) / 4; u += NWAVES * 64) ((LAS unsigned*)(F.lds + LDSCTL_OFF))[u] = 0u;
    __syncthreads();
    XcdBarrier bar; bar.bar = (unsigned*)(F.ctl + CW_BAR); bar.x = 0; bar.st = nullptr;
    if (N_LAUNCHES == 1) bar = xcd_barrier_post((unsigned*)(F.ctl + CW_BAR), F.MISC + 8);
#define GRID_BAR() do { if (N_LAUNCHES == 1) xcd_barrier(bar); } while (0)
    const int lo = A.ph_lo, hi = A.ph_hi;
#define IN(k) (lo <= (k) && (k) < hi)
#define BOTH(k) (IN(k) && IN((k) + 1))
    bf16* XN = (bf16*)(F.ws + WS_XN); bf16* Z = (bf16*)(F.ws + WS_Z); bf16* YC = (bf16*)(F.ws + WS_YCAT); bf16* GY = (bf16*)(F.ws + WS_G); bf16* U = (bf16*)(F.ws + WS_U);
    const float* mod = (const float*)(F.ws + WS_MOD);

#define REPS(k) (((PROBE_DUP) >> (k)) & 1 ? 2 : 1)
    if (IN(0)) { for (int rep = 0; rep < REPS(0); ++rep) p0_prologue(F, A, rep); if (BOTH(0)) GRID_BAR(); }
    if (IN(1)) { for (int rep = 0; rep < REPS(1); ++rep) p1_modulate(F, A); if (BOTH(1)) GRID_BAR(); }
    if (IN(2)) for (int rep = 0; rep < REPS(2); ++rep) {
        pg8::Gemm g{XN, (const bf16*)(F.ws + WS_WIN), M, NZ, D}; pg8::StaticOrder S; S.init(M, NZ, F.G, (int)blockIdx.x);
        pg8::EpiBf16<0> E{Z, NZ, nullptr};
        pg8::gemm_phase<pg8::EpiBf16<0>, pg8::StaticOrder, PG8_ALIGN, PG8_SP2>(F.lds + RING_OFF, g, S, E);
        if (BOTH(2) && rep == REPS(2) - 1) GRID_BAR();
    }
    if (IN(3)) {
#pragma unroll 1
        for (int rep = 0; rep < REPS(3); ++rep) p3_mixers_ref(F, A, rep);
        if (BOTH(3)) GRID_BAR(); }
    if (IN(4)) for (int rep = 0; rep < REPS(4); ++rep) {
        pg8::Gemm g{GY, (const bf16*)(F.ws + WS_WGLU), M, WB, WB}; pg8::StaticOrder S; S.init(M, WB, F.G, (int)blockIdx.x);
        pg8::EpiGlu E{GY, WB, YC, D, WA, A.in[I_GLUB]};
        pg8::gemm_phase<pg8::EpiGlu, pg8::StaticOrder, PG8_ALIGN, PG8_SP2>(F.lds + RING_OFF, g, S, E);
        if (BOTH(4) && rep == REPS(4) - 1) GRID_BAR();
    }
    if (IN(5)) {
        pg8::Gemm g{YC, (const bf16*)(F.ws + WS_WOUT), M, D, D}; pg8::StaticOrder S; S.init(M, D, F.G, (int)blockIdx.x);
        pg8::EpiRes E{A.in[I_XP], A.in[I_XS], F.out, mod + 2 * D, nullptr, ALPHA, MP};
        pg8::gemm_phase<pg8::EpiRes, pg8::StaticOrder, PG8_ALIGN, PG8_SP2>(F.lds + RING_OFF, g, S, E);
        if (BOTH(5)) GRID_BAR();
    }
    if (IN(6)) { ln_rows<false>(F, A); if (BOTH(6)) GRID_BAR(); }
    if (IN(7)) for (int rep = 0; rep < REPS(7); ++rep) {
        pg8::Gemm g{XN, (const bf16*)(F.ws + WS_W1), M, FF, D}; pg8::StaticOrder S; S.init(M, FF, F.G, (int)blockIdx.x);
        pg8::EpiBf16<3> E{U, FF, A.in[I_B1]};
        pg8::gemm_phase<pg8::EpiBf16<3>, pg8::StaticOrder, PG8_ALIGN, PG8_SP2>(F.lds + RING_OFF, g, S, E);
        if (BOTH(7) && rep == REPS(7) - 1) GRID_BAR();
    }
    if (IN(8)) {
        pg8::Gemm g{U, (const bf16*)(F.ws + WS_W2), M, D, FF}; pg8::StaticOrder S; S.init(M, D, F.G, (int)blockIdx.x);
        pg8::EpiRes E{F.out, F.out + (size_t)MP * D, F.out, mod + 5 * D, A.in[I_B2], ALPHA, MP};
        pg8::gemm_phase<pg8::EpiRes, pg8::StaticOrder, PG8_ALIGN, PG8_SP2>(F.lds + RING_OFF, g, S, E);
        if (BOTH(8)) GRID_BAR();
    }
    if (IN(9)) { ln_rows<true>(F, A); }
#undef IN
#undef BOTH
}

extern "C" void kernel_launch(void* const* d_in, const int* in_sizes, int n_in, void* d_out, int out_size, void* d_ws, size_t ws_size, hipStream_t stream) {
    static int grid = 0;
    if (grid == 0) {
        if (n_in != 37 || in_sizes[0] != MP * D || out_size != (int)O_END || ws_size < WS_END) { fprintf(stderr, "kernel_launch: unexpected shapes (n_in %d, in0 %d, out %d, ws %zu)\n", n_in, n_in > 0 ? in_sizes[0] : -1, out_size, ws_size); grid = -1; return; }
        int dev = 0, cus = 0, per_cu = 0;
        if (hipGetDevice(&dev) != hipSuccess || hipDeviceGetAttribute(&cus, hipDeviceAttributeMultiprocessorCount, dev) != hipSuccess) { grid = -1; return; }
        if (hipFuncSetAttribute((const void*)fwd, hipFuncAttributeMaxDynamicSharedMemorySize, LDS_BYTES) != hipSuccess) { fprintf(stderr, "kernel_launch: hipFuncSetAttribute failed\n"); grid = -1; return; }
        if (hipOccupancyMaxActiveBlocksPerMultiprocessor(&per_cu, (const void*)fwd, NWAVES * 64, LDS_BYTES) != hipSuccess || per_cu < 1) { fprintf(stderr, "kernel_launch: occupancy query says %d\n", per_cu); }
        (void)hipGetLastError();
        grid = cus;
        if (grid < 256) { fprintf(stderr, "kernel_launch: this build needs 256 CUs (got %d)\n", grid); grid = -1; return; }
        grid = 256;
    }
    if (grid < 0) return;
    (void)hipMemsetAsync((char*)d_ws + WS_CTL, 0, CTL_ZERO_BYTES, stream);
    Args a{};
    for (int i = 0; i < 37; ++i) a.in[i] = (const float*)d_in[i];
    a.out = (float*)d_out; a.ws = (unsigned char*)d_ws;
    for (int li = 0; li < N_LAUNCHES; ++li) {
        if (N_LAUNCHES == 1) { a.ph_lo = 0; a.ph_hi = N_PHASES; } else { a.ph_lo = li; a.ph_hi = li + 1; }
        a.li = li;
        hipLaunchKernelGGL(fwd, dim3(grid), dim3(NWAVES * 64), LDS_BYTES, stream, a);
    }
}
```

```cpp
#include <hip/hip_runtime.h>
#include <cstdio>
#include <cstdint>
#include <cmath>

#ifndef MK_N_LAUNCHES
#define MK_N_LAUNCHES 1
#endif

namespace pg8 {
#define PG8_LAS __attribute__((address_space(3)))
typedef unsigned short bf16_t;
typedef short bf16x8 __attribute__((ext_vector_type(8)));
typedef float f32x4 __attribute__((ext_vector_type(4)));
typedef unsigned u32x4 __attribute__((ext_vector_type(4)));
constexpr int BM = 256, BK = 64, HALF = 128, HTB = HALF * BK * 2, STAGE_BYTES = 8 * HTB, NXCD = 8, WGM = 8;

__host__ __device__ __forceinline__ int lds_byte(int r, int c) { const int st = (r >> 4) * 2 + (c >> 5), rr = r & 15, cc = c & 31, ob = rr * 64 + cc * 2; return st * 1024 + (ob ^ (((ob >> 9) & 1) << 5)); }
__host__ __device__ __forceinline__ void stage_rc(int b, int& R, int& C) { const int st = b / 1024, sb = b % 1024, swz = sb ^ (((sb >> 9) & 1) << 5); R = (st >> 1) * 16 + swz / 64; C = (st & 1) * 32 + (swz % 64) / 2; }
__host__ __device__ __forceinline__ int perm32(int rho) { const int n = rho >> 4, i = rho & 15; return 8 * (i >> 2) + 4 * n + (i & 3); }

struct Unit { int pm, pn, k0, nkt, ks; };
struct Gemm { const bf16_t* A; const bf16_t* Bt; int M, N, K; };

struct StaticOrder {
    int nM, nN, nwg, G, c, K;
    __host__ __device__ void init(int M, int N, int G_, int c_, int K_) { nM = M / BM; nN = N / BM; nwg = nM * nN; G = G_; c = c_; K = K_; }
    __host__ __device__ __forceinline__ bool next(int i, Unit& u) const {
        const long L = (long)i * G + c; if (L >= nwg) return false;
        int wgid = (int)L; { const int q = nwg / NXCD, r = nwg % NXCD, xcd = wgid % NXCD, off = wgid / NXCD; wgid = (xcd < r ? xcd * (q + 1) : r * (q + 1) + (xcd - r) * q) + off; }
        const int nig = WGM * nN, gid = wgid / nig, fm = gid * WGM, gsz = (nM - fm) < WGM ? (nM - fm) : WGM;
        u.pm = fm + ((wgid % nig) % gsz); u.pn = (wgid % nig) / gsz; u.k0 = 0; u.nkt = K / BK; u.ks = 0; return true;
    }
    __device__ __forceinline__ void a_ready(const Unit&) const {}
    __device__ __forceinline__ void done(const Unit&) const {}
};

struct SplitOrder {
    StaticOrder P; int nN, NS, nP, G, c, K, r0;
    __host__ __device__ void init(int MPr, int N, int G_, int c_, int K_, int NS_) { P.init(MPr, N, G_, c_, K_); nN = N / BM; NS = NS_; nP = 2 * nN * NS; G = G_; c = c_; K = K_; r0 = (P.nwg + G - 1 - c) / G;   }
    __host__ __device__ __forceinline__ bool next(int i, Unit& u) const {
        Unit a; a.pm = 0; a.pn = 0; a.k0 = 0; a.nkt = K / BK; a.ks = 0;
        const bool okp = P.next(i < r0 ? i : 0, a);
        const int p = (i - r0) * G + (G - 1 - c), t = p / NS, ks = p % NS, nk = K / BK / NS;
        const bool split = i >= r0;
        u.pm = split ? P.nM + t / nN : a.pm; u.pn = split ? t % nN : a.pn; u.nkt = split ? nk : a.nkt; u.ks = split ? ks : 0; u.k0 = split ? ks * nk * BK : 0;
        return split ? (p < nP) : okp;
    }
    __device__ __forceinline__ void a_ready(const Unit&) const {}
    __device__ __forceinline__ void done(const Unit&) const {}
};

__device__ __forceinline__ unsigned cvt_pk_bf16(float lo, float hi) { unsigned r; asm volatile("v_cvt_pk_bf16_f32 %0, %1, %2" : "=v"(r) : "v"(lo), "v"(hi)); return r; }
__device__ __forceinline__ float bf_lo(unsigned w) { return __builtin_bit_cast(float, w << 16); }
__device__ __forceinline__ float bf_hi(unsigned w) { return __builtin_bit_cast(float, w & 0xffff0000u); }

template <int ACT> struct EpiBf16 {
    static constexpr bool PERM = true, AFTER_DRAIN = false;
    bf16_t* O; int ldc; const float* bias;
    __device__ __forceinline__ void operator()(const f32x4 (&acc)[2][2][4][2], const Unit& u, int wr, int wc, int fr, int fq) const {
        const int row0 = u.pm * BM + wr * 64 + fr; const int col0 = u.pn * BM + wc * 32 + 8 * fq;
        f32x4 bv[2][2];
#pragma unroll
        for (int bj = 0; bj < 2; ++bj)
#pragma unroll
            for (int n = 0; n < 2; ++n) bv[bj][n] = bias ? *(const f32x4*)(bias + col0 + bj * HALF + 4 * n) : (f32x4){0.f, 0.f, 0.f, 0.f};
#pragma unroll
        for (int ai = 0; ai < 2; ++ai)
#pragma unroll
            for (int m = 0; m < 4; ++m) { bf16_t* rowp = O + (size_t)(row0 + ai * HALF + m * 16) * ldc + col0;
#pragma unroll
                for (int bj = 0; bj < 2; ++bj) { f32x4 v0 = acc[ai][bj][m][0] + bv[bj][0], v1 = acc[ai][bj][m][1] + bv[bj][1];
                    if (ACT == 3) {
#pragma unroll
                        for (int e = 0; e < 4; ++e) { const float a = fmaxf(v0[e], 0.f), b = fmaxf(v1[e], 0.f); v0[e] = a * a; v1[e] = b * b; } }
                    u32x4 w; w.x = cvt_pk_bf16(v0[0], v0[1]); w.y = cvt_pk_bf16(v0[2], v0[3]); w.z = cvt_pk_bf16(v1[0], v1[1]); w.w = cvt_pk_bf16(v1[2], v1[3]);
                    *(u32x4*)(rowp + bj * HALF) = w; } }
    }
};
struct EpiGlu {
    static constexpr bool PERM = true, AFTER_DRAIN = false;
    const bf16_t* Gy; int ldg; bf16_t* O; int ldc; int coff; const float* bias;
    __device__ __forceinline__ void operator()(const f32x4 (&acc)[2][2][4][2], const Unit& u, int wr, int wc, int fr, int fq) const {
        const int row0 = u.pm * BM + wr * 64 + fr; const int col0 = u.pn * BM + wc * 32 + 8 * fq;
        f32x4 bv[2][2];
#pragma unroll
        for (int bj = 0; bj < 2; ++bj)
#pragma unroll
            for (int n = 0; n < 2; ++n) bv[bj][n] = *(const f32x4*)(bias + col0 + bj * HALF + 4 * n);
#pragma unroll
        for (int ai = 0; ai < 2; ++ai)
#pragma unroll
            for (int m = 0; m < 4; ++m) { const size_t row = (size_t)(row0 + ai * HALF + m * 16);
#pragma unroll
                for (int bj = 0; bj < 2; ++bj) { const f32x4 v0 = acc[ai][bj][m][0] + bv[bj][0], v1 = acc[ai][bj][m][1] + bv[bj][1];
                    const u32x4 g = *(const u32x4*)(Gy + row * ldg + col0 + bj * HALF);
                    float o[8];
                    o[0] = bf_lo(g.x) * __builtin_amdgcn_rcpf(1.f + __builtin_amdgcn_exp2f(-1.4426950408889634f * v0[0])); o[1] = bf_hi(g.x) * __builtin_amdgcn_rcpf(1.f + __builtin_amdgcn_exp2f(-1.4426950408889634f * v0[1]));
                    o[2] = bf_lo(g.y) * __builtin_amdgcn_rcpf(1.f + __builtin_amdgcn_exp2f(-1.4426950408889634f * v0[2])); o[3] = bf_hi(g.y) * __builtin_amdgcn_rcpf(1.f + __builtin_amdgcn_exp2f(-1.4426950408889634f * v0[3]));
                    o[4] = bf_lo(g.z) * __builtin_amdgcn_rcpf(1.f + __builtin_amdgcn_exp2f(-1.4426950408889634f * v1[0])); o[5] = bf_hi(g.z) * __builtin_amdgcn_rcpf(1.f + __builtin_amdgcn_exp2f(-1.4426950408889634f * v1[1]));
                    o[6] = bf_lo(g.w) * __builtin_amdgcn_rcpf(1.f + __builtin_amdgcn_exp2f(-1.4426950408889634f * v1[2])); o[7] = bf_hi(g.w) * __builtin_amdgcn_rcpf(1.f + __builtin_amdgcn_exp2f(-1.4426950408889634f * v1[3]));
                    u32x4 w; w.x = cvt_pk_bf16(o[0], o[1]); w.y = cvt_pk_bf16(o[2], o[3]); w.z = cvt_pk_bf16(o[4], o[5]); w.w = cvt_pk_bf16(o[6], o[7]);
                    *(u32x4*)(O + row * ldc + coff + col0 + bj * HALF) = w; } }
    }
};
struct EpiRes {
    static constexpr bool PERM = false, AFTER_DRAIN = false;
    const float* basep; const float* bases; float* out; const float* gate  ; const float* bias; float alpha; int MP; float* slab  ;
    __device__ __forceinline__ void operator()(const f32x4 (&acc)[2][2][4][2], const Unit& u, int wr, int wc, int fr, int fq) const {
        const int row0 = u.pm * BM + wr * 64 + fr, col0 = u.pn * BM + wc * 32 + 4 * fq;
        if (slab && row0 >= MP) {
            float* sp = slab + (size_t)u.ks * 512 * 1024;
#pragma unroll
            for (int ai = 0; ai < 2; ++ai)
#pragma unroll
                for (int m = 0; m < 4; ++m) { float* op = sp + (size_t)(row0 + ai * HALF + m * 16 - MP) * 1024;
#pragma unroll
                    for (int bj = 0; bj < 2; ++bj)
#pragma unroll
                        for (int n = 0; n < 2; ++n) *(f32x4*)(op + col0 + bj * HALF + n * 16) = acc[ai][bj][m][n]; }
            return; }
        f32x4 bv[2][2];
#pragma unroll
        for (int bj = 0; bj < 2; ++bj)
#pragma unroll
            for (int n = 0; n < 2; ++n) bv[bj][n] = bias ? *(const f32x4*)(bias + col0 + bj * HALF + n * 16) : (f32x4){0.f, 0.f, 0.f, 0.f};
#pragma unroll
        for (int ai = 0; ai < 2; ++ai)
#pragma unroll
            for (int m = 0; m < 4; ++m) { const int row = row0 + ai * HALF + m * 16;
                const bool smp = row >= MP; const int mr = smp ? 8 + ((row - MP) >> 2) : (row >> 11);
                const float* bp = smp ? bases + (size_t)(row - MP) * 1024 : basep + (size_t)row * 1024;
                const float* gp = gate + (size_t)mr * 6144; float* op = out + (size_t)row * 1024;
#pragma unroll
                for (int bj = 0; bj < 2; ++bj)
#pragma unroll
                    for (int n = 0; n < 2; ++n) { const int c = col0 + bj * HALF + n * 16;
                        const f32x4 b = *(const f32x4*)(bp + c), g = *(const f32x4*)(gp + c);
                        *(f32x4*)(op + c) = b * alpha + g * (acc[ai][bj][m][n] + bv[bj][n]); } }
    }
};

template <class Epi, class Sched, bool ALIGN_EPI = false, bool SP2 = false>
__device__ __forceinline__ void gemm_phase(PG8_LAS unsigned char* lds, const Gemm g, const Sched& S, const Epi& E) {
    const int tid = threadIdx.x, wid = __builtin_amdgcn_readfirstlane(tid >> 6), lane = tid & 63, wr = wid >> 2, wc = wid & 3, fr = lane & 15, fq = lane >> 4;
    const int K = g.K;
    unsigned voffA[2], voffB[2];
#pragma unroll
    for (int i = 0; i < 2; ++i) { int R, C; stage_rc(tid * 16 + i * 8192, R, C); const int Rb = Epi::PERM ? ((R & ~31) + perm32(R & 31)) : R;
        voffA[i] = (unsigned)(R * K + C) * 2u; voffB[i] = (unsigned)(Rb * K + C) * 2u; }
    const size_t kstep = (size_t)(BK * 2);
    const size_t hstep = (size_t)HALF * K * 2;
    const size_t tstep = 2 * hstep;
    const unsigned ldsw = (unsigned)wid * 1024u;
    const int aoff = lds_byte(wr * 64 + fr, fq * 8), boff = lds_byte(wc * 32 + fr, fq * 8);
#define PG8_SA(b, h) (((b) * 2 + (h)) * HTB)
#define PG8_SB(b, h) ((4 + (b) * 2 + (h)) * HTB)
#define PG8_STAGE(bufoff, gbase, voff) do { _Pragma("unroll") for (int _i = 0; _i < 2; ++_i) \
        __builtin_amdgcn_global_load_lds((const unsigned*)((const char*)(gbase) + (voff)[_i]), (PG8_LAS unsigned*)(lds + (bufoff) + ldsw + _i * 8192), 16, 0, 0); } while (0)
#define PG8_LDA(dst, b, h) do { _Pragma("unroll") for (int m = 0; m < 4; ++m) _Pragma("unroll") for (int k = 0; k < 2; ++k) dst[m][k] = *(const PG8_LAS bf16x8*)(lds + PG8_SA(b, h) + aoff + m * 2048 + k * 1024); } while (0)
#define PG8_LDB(dst, b, h) do { _Pragma("unroll") for (int n = 0; n < 2; ++n) _Pragma("unroll") for (int k = 0; k < 2; ++k) dst[n][k] = *(const PG8_LAS bf16x8*)(lds + PG8_SB(b, h) + boff + n * 2048 + k * 1024); } while (0)
#define PG8_MMA(ai, bj, At, Bt) do { __builtin_amdgcn_s_setprio(1); _Pragma("unroll") for (int m = 0; m < 4; ++m) _Pragma("unroll") for (int n = 0; n < 2; ++n) _Pragma("unroll") for (int k = 0; k < 2; ++k) \
        acc[ai][bj][m][n] = __builtin_amdgcn_mfma_f32_16x16x32_bf16(Bt[n][k], At[m][k], acc[ai][bj][m][n], 0, 0, 0); __builtin_amdgcn_s_setprio(0); } while (0)
#define PG8_WAIT_V(n) asm volatile("s_waitcnt vmcnt(" #n ")" ::: "memory")
#define PG8_WAIT_L(n) asm volatile("s_waitcnt lgkmcnt(" #n ")" ::: "memory")
#define PG8_BAR __builtin_amdgcn_s_barrier()
#define PG8_SCHED __builtin_amdgcn_sched_barrier(0)
    Unit cur, nxt; int ui = 0;
    if (!S.next(0, cur)) return;
    f32x4 acc[2][2][4][2];
#pragma unroll
    for (int a = 0; a < 2; ++a)
#pragma unroll
        for (int b = 0; b < 2; ++b)
#pragma unroll
            for (int m = 0; m < 4; ++m)
#pragma unroll
                for (int n = 0; n < 2; ++n) acc[a][b][m][n] = (f32x4){0.f, 0.f, 0.f, 0.f};
    bf16x8 At[4][2], B0[2][2], B1[2][2];
    const char* cA = (const char*)g.A + (size_t)cur.pm * tstep + (size_t)cur.k0 * 2; const char* cB = (const char*)g.Bt + (size_t)cur.pn * tstep + (size_t)cur.k0 * 2;
    S.a_ready(cur);
    if constexpr (SP2) {
        PG8_STAGE(PG8_SB(0, 0), cB, voffB); PG8_STAGE(PG8_SB(0, 1), cB + hstep, voffB); PG8_STAGE(PG8_SA(0, 0), cA, voffA); PG8_STAGE(PG8_SA(0, 1), cA + hstep, voffA);
        if (wr == 1) PG8_BAR;
        PG8_WAIT_V(2); PG8_BAR;
        PG8_STAGE(PG8_SB(1, 0), cB + kstep, voffB); PG8_STAGE(PG8_SA(1, 0), cA + kstep, voffA); PG8_STAGE(PG8_SB(1, 1), cB + hstep + kstep, voffB);
        PG8_WAIT_V(6); PG8_BAR;
    } else {
        PG8_STAGE(PG8_SB(0, 0), cB, voffB); PG8_STAGE(PG8_SA(0, 0), cA, voffA); PG8_STAGE(PG8_SB(0, 1), cB + hstep, voffB); PG8_STAGE(PG8_SA(0, 1), cA + hstep, voffA);
        if (wr == 1) PG8_BAR;
        PG8_WAIT_V(4); PG8_BAR;
        PG8_STAGE(PG8_SB(1, 0), cB + kstep, voffB); PG8_STAGE(PG8_SA(1, 0), cA + kstep, voffA); PG8_STAGE(PG8_SB(1, 1), cB + hstep + kstep, voffB);
        PG8_WAIT_V(6); PG8_BAR;
    }
    for (;;) {
        const bool has_next = S.next(ui + 1, nxt);
        const char* nA = has_next ? (const char*)g.A + (size_t)nxt.pm * tstep + (size_t)nxt.k0 * 2 : cA; const char* nB = has_next ? (const char*)g.Bt + (size_t)nxt.pn * tstep + (size_t)nxt.k0 * 2 : cB;
        const int nt = cur.nkt;
        for (int t = 0; t < nt; t += 2) {
            const bool last = (t == nt - 2);
            const char* a1 = cA + (size_t)(t + 1) * kstep;
            const char* a2 = last ? nA : cA + (size_t)(t + 2) * kstep; const char* b2 = last ? nB : cB + (size_t)(t + 2) * kstep;
            const char* a3 = a2 + kstep; const char* b3 = b2 + kstep;
            if (last && has_next) S.a_ready(nxt);
            if constexpr (SP2) {
            PG8_LDB(B0, 0, 0); PG8_LDB(B1, 0, 1); PG8_SCHED; PG8_LDA(At, 0, 0); PG8_STAGE(PG8_SA(1, 1), a1 + hstep, voffA);
            PG8_WAIT_V(8); PG8_WAIT_L(0); PG8_BAR; PG8_MMA(0, 0, At, B0); PG8_MMA(0, 1, At, B1); PG8_BAR; PG8_SCHED;
            PG8_LDA(At, 0, 1); PG8_STAGE(PG8_SB(0, 0), b2, voffB); PG8_STAGE(PG8_SB(0, 1), b2 + hstep, voffB); PG8_STAGE(PG8_SA(0, 0), a2, voffA);
            PG8_WAIT_V(8); PG8_WAIT_L(0); PG8_BAR; PG8_MMA(1, 0, At, B0); PG8_MMA(1, 1, At, B1); PG8_BAR; PG8_SCHED;
            PG8_LDB(B0, 1, 0); PG8_LDB(B1, 1, 1); PG8_SCHED; PG8_LDA(At, 1, 0); PG8_STAGE(PG8_SA(0, 1), a2 + hstep, voffA);
            PG8_WAIT_V(8); PG8_WAIT_L(0); PG8_BAR; PG8_MMA(0, 0, At, B0); PG8_MMA(0, 1, At, B1); PG8_BAR; PG8_SCHED;
            PG8_LDA(At, 1, 1); PG8_STAGE(PG8_SB(1, 0), b3, voffB); PG8_STAGE(PG8_SB(1, 1), b3 + hstep, voffB); PG8_STAGE(PG8_SA(1, 0), a3, voffA);
            PG8_WAIT_V(8); PG8_WAIT_L(0); PG8_BAR; PG8_MMA(1, 0, At, B0); PG8_MMA(1, 1, At, B1); PG8_BAR; PG8_SCHED;
            } else {
            PG8_LDB(B0, 0, 0); PG8_SCHED; PG8_LDA(At, 0, 0); PG8_STAGE(PG8_SA(1, 1), a1 + hstep, voffA);
            PG8_WAIT_L(8); PG8_BAR; PG8_WAIT_L(0); PG8_MMA(0, 0, At, B0); PG8_BAR; PG8_SCHED;
            PG8_LDB(B1, 0, 1); PG8_STAGE(PG8_SB(0, 0), b2, voffB);
            PG8_BAR; PG8_WAIT_L(0); PG8_MMA(0, 1, At, B1); PG8_BAR;
            PG8_LDA(At, 0, 1); PG8_STAGE(PG8_SA(0, 0), a2, voffA);
            PG8_BAR; PG8_WAIT_L(0); PG8_MMA(1, 0, At, B0); PG8_BAR; PG8_SCHED;
            PG8_STAGE(PG8_SB(0, 1), b2 + hstep, voffB);
            PG8_WAIT_V(6); PG8_BAR; PG8_MMA(1, 1, At, B1); PG8_BAR;
            PG8_LDB(B0, 1, 0); PG8_SCHED; PG8_LDA(At, 1, 0); PG8_STAGE(PG8_SA(0, 1), a2 + hstep, voffA);
            PG8_WAIT_L(8); PG8_BAR; PG8_WAIT_L(0); PG8_MMA(0, 0, At, B0); PG8_BAR; PG8_SCHED;
            PG8_LDB(B1, 1, 1); PG8_STAGE(PG8_SB(1, 0), b3, voffB);
            PG8_BAR; PG8_WAIT_L(0); PG8_MMA(0, 1, At, B1); PG8_BAR;
            PG8_LDA(At, 1, 1); PG8_STAGE(PG8_SA(1, 0), a3, voffA);
            PG8_BAR; PG8_WAIT_L(0); PG8_MMA(1, 0, At, B0); PG8_BAR; PG8_SCHED;
            PG8_STAGE(PG8_SB(1, 1), b3 + hstep, voffB);
            PG8_WAIT_V(6); PG8_BAR; PG8_MMA(1, 1, At, B1); PG8_BAR;
            }
        }
        if constexpr (ALIGN_EPI) { if (wr == 0) PG8_BAR; }
        if constexpr (!Epi::AFTER_DRAIN) { E(acc, cur, wr, wc, fr, fq); S.done(cur); }
        if (!has_next) break;
#pragma unroll
        for (int a = 0; a < 2; ++a)
#pragma unroll
            for (int b = 0; b < 2; ++b)
#pragma unroll
                for (int m = 0; m < 4; ++m)
#pragma unroll
                    for (int n = 0; n < 2; ++n) acc[a][b][m][n] = (f32x4){0.f, 0.f, 0.f, 0.f};
        cur = nxt; cA = nA; cB = nB; ++ui;
        if constexpr (ALIGN_EPI) { if (wr == 1) PG8_BAR; }
    }
    PG8_WAIT_V(0);
    if constexpr (!ALIGN_EPI) { if (wr == 0) PG8_BAR; }
    PG8_BAR;
#undef PG8_SA
#undef PG8_SB
#undef PG8_STAGE
#undef PG8_LDA
#undef PG8_LDB
#undef PG8_MMA
#undef PG8_WAIT_V
#undef PG8_WAIT_L
#undef PG8_BAR
#undef PG8_SCHED
}
}

#ifndef PROBE_DUP
#define PROBE_DUP 0
#endif
#ifndef PG8_SP2
#define PG8_SP2 true
#endif
#ifndef PG8_ALIGN
#define PG8_ALIGN true
#endif

constexpr int NWAVES = 8;
constexpr int N_LAUNCHES = MK_N_LAUNCHES;
constexpr int N_PHASES = 10;
constexpr int D = 1024, MP = 16384, MS = 512, M = MP + MS, TP = 2048, NBP = 8, NBS = 128, TS = 4;
constexpr int NZ = 1536, WA = 512, WB = 512, FF = 4096, NMOD = 6 * D, NROWMOD = NBP + NBS;
constexpr int GB = 32, NS5 = 64, KS5 = 16, HA = 8, HDA = 64;
constexpr float LN_EPS = 1e-5f;
constexpr int NS_OUT = 4, NS_DOWN = 8;
constexpr float ALPHA = 1.189207115002721f;

constexpr size_t O_YP = 0, O_YS = (size_t)MP * D, O_CONVP = O_YS + (size_t)MS * D, O_HP = O_CONVP + (size_t)NBP * 3 * WA, O_SRP = O_HP + (size_t)NBP * WA,
                 O_SIP = O_SRP + (size_t)NBP * GB * NS5, O_CONVS = O_SIP + (size_t)NBP * GB * NS5, O_HS = O_CONVS + (size_t)NBS * 3 * WA, O_SRS = O_HS + (size_t)NBS * WA,
                 O_SIS = O_SRS + (size_t)NBS * GB * NS5, O_END = O_SIS + (size_t)NBS * GB * NS5;

constexpr size_t MiB = 1u << 20;
constexpr size_t WS_CTL = 0, CTL_ZERO_BYTES = 1 * MiB;
constexpr size_t WS_WIN = 1 * MiB, WS_WGLU = 4 * MiB, WS_WOUT = 5 * MiB, WS_W1 = 7 * MiB, WS_W2 = 15 * MiB;
constexpr size_t WS_MOD = 23 * MiB;
constexpr size_t WS_S5C = 27 * MiB;
constexpr size_t WS_XN = 28 * MiB;
constexpr size_t WS_Z = 61 * MiB;
constexpr size_t WS_YCAT = 111 * MiB;
constexpr size_t WS_G = 144 * MiB;
constexpr size_t WS_U = 61 * MiB;
constexpr size_t WS_TAB = 194 * MiB;
constexpr size_t WS_SLAB = 196 * MiB;
constexpr size_t WS_END = 212 * MiB;
constexpr size_t TB_BF1 = 0, TB_BF2 = TB_BF1 + 32 * 4 * 64 * 16, TB_TA = TB_BF2 + 32 * 8 * 64 * 16, TB_ZP = TB_TA + 32 * 2 * 2 * 32 * 4, TB_Z16N = TB_ZP + 32 * 17 * 2 * 2 * 32 * 4,
                 TB_RG = TB_Z16N + 32 * 2 * 64 * 4, TB_CB = TB_RG + 8 * 2 * 2 * 4 * 64 * 16, TB_END = TB_CB + 128 * 3 * 512 * 2;
static_assert(WS_TAB + TB_END <= WS_SLAB, "tables");
static_assert(WS_XN + (size_t)M * D * 2 <= WS_Z && WS_Z + (size_t)M * NZ * 2 <= WS_YCAT && WS_YCAT + (size_t)M * D * 2 <= WS_G && WS_G + (size_t)M * WB * 2 <= WS_END && WS_U + (size_t)M * FF * 2 <= WS_TAB, "d_ws map");
constexpr int SC_ABR = 0, SC_ABI = 2048, SC_BBR = 4096, SC_BBI = 4096 + 32768, SC_RGL = 4096 + 65536, SC_END = SC_RGL + 512;
constexpr int CW_TMO = 0, CW_CODE = 1, CW_BAR = 4096;

constexpr int RING_OFF = 0, RING_BYTES = 131072;
constexpr int LDSCTL_OFF = RING_BYTES, MISC_OFF = LDSCTL_OFF + 320;
constexpr int LDS_BYTES = 147456;

#define GAS __attribute__((address_space(1)))
#define LAS __attribute__((address_space(3)))
typedef unsigned short bf16;
typedef unsigned v4u __attribute__((ext_vector_type(4)));
typedef float f32x4 __attribute__((ext_vector_type(4)));
typedef GAS unsigned gu32;
#define RLX_AGENT __ATOMIC_RELAXED, __HIP_MEMORY_SCOPE_AGENT
#define LDS_WAIT() asm volatile("s_waitcnt lgkmcnt(0)" ::: "memory")
#define VM_WAIT() asm volatile("s_waitcnt vmcnt(0)" ::: "memory")
__device__ __forceinline__ unsigned f2bf(float f) { unsigned u = __builtin_bit_cast(unsigned, f); return (u + 0x7fffu + ((u >> 16) & 1u)) >> 16; }
__device__ __forceinline__ unsigned pk2(float lo, float hi) { return f2bf(lo) | (f2bf(hi) << 16); }
__device__ __forceinline__ float bf2f(bf16 v) { return __builtin_bit_cast(float, (unsigned)v << 16); }
__device__ __forceinline__ float gelu_tanh(float x) { const float t = -2.3022082f * (x + 0.044715f * x * x * x); return x * __builtin_amdgcn_rcpf(1.f + __builtin_amdgcn_exp2f(t)); }
__device__ __forceinline__ float sigmoidf_(float x) { return __builtin_amdgcn_rcpf(1.f + __builtin_amdgcn_exp2f(-1.4426950408889634f * x)); }

#define XB_TMO      128
#define XB_XCNT(j)  (256  + 64 * (j))
#define XB_XSUB(j)  (1280 + 64 * (j))
#define XB_XGEN(j)  (2304 + 64 * (j))
#define XB_TOP      3328
#define XB_TOPGEN   3392
#define XCD_BAR_WORDS 3456
#define XB_SPIN_CAP (1u << 18)
__device__ __forceinline__ unsigned xb_ld(unsigned* p)              { return __hip_atomic_load(p, __ATOMIC_RELAXED, __HIP_MEMORY_SCOPE_AGENT); }
__device__ __forceinline__ unsigned xb_add(unsigned* p, unsigned v) { return __hip_atomic_fetch_add(p, v, __ATOMIC_RELAXED, __HIP_MEMORY_SCOPE_AGENT); }
__device__ __forceinline__ unsigned xb_xcc_id() { return (unsigned)__builtin_amdgcn_s_getreg((3 << 11) | 20) & 0xFu; }
#define XB_SPIN(cond, bar) do { unsigned _sp = 0; while (cond) { __builtin_amdgcn_s_sleep(1); \
    if ((++_sp & 255u) == 0u) { if (xb_ld(&(bar)[XB_TMO])) break; if (_sp > XB_SPIN_CAP) { atomicAdd(&(bar)[XB_TMO], 1u); break; } } } } while (0)
struct XcdBarrier { unsigned* bar; unsigned x; volatile LAS unsigned* st; };
__device__ __forceinline__ XcdBarrier xcd_barrier_post(unsigned* bar, volatile LAS unsigned* st) {
    XcdBarrier b; b.bar = bar; b.x = xb_xcc_id(); b.st = st;
    if (threadIdx.x == 0) (void)xb_add(&bar[XB_XCNT(b.x)], 1u);
    return b;
}
__device__ __forceinline__ void xcd_barrier_complete(unsigned* bar, unsigned x, unsigned& nloc, unsigned& nx) {
    const unsigned G = gridDim.x * gridDim.y * gridDim.z;
    unsigned sum, cnt, mine, sp = 0u;
    for (;;) {
        sum = 0u; cnt = 0u; mine = 0u;
#pragma unroll
        for (unsigned j = 0; j < 16; ++j) { const unsigned c = xb_ld(&bar[XB_XCNT(j)]); sum += c; cnt += (c > 0u) ? 1u : 0u; mine = (j == x) ? c : mine; }
        if (sum == G) break;
        __builtin_amdgcn_s_sleep(1);
        if ((++sp & 255u) == 0u) { if (xb_ld(&bar[XB_TMO])) break; if (sp > XB_SPIN_CAP) { atomicAdd(&bar[XB_TMO], 1u); break; } }
    }
    nloc = mine > 0u ? mine : 1u; nx = cnt > 0u ? cnt : 1u;
}
__device__ __forceinline__ void xcd_barrier(const XcdBarrier& b) {
    asm volatile("s_waitcnt vmcnt(0)" ::: "memory");
    __syncthreads();
    if (threadIdx.x == 0) {
        unsigned* bar = b.bar;
        __builtin_amdgcn_s_waitcnt(0);
        unsigned nloc = b.st[0], nx = b.st[1];
        if (nloc == 0u) { xcd_barrier_complete(bar, b.x, nloc, nx); b.st[0] = nloc; b.st[1] = nx; }
        const unsigned old = xb_add(&bar[XB_XSUB(b.x)], 1u);
        const unsigned gen = old / nloc;
        if (old + 1u == (gen + 1u) * nloc) {
            __builtin_amdgcn_fence(__ATOMIC_RELEASE, "agent");
            asm volatile("s_waitcnt vmcnt(0)" ::: "memory");
            const unsigned og = xb_add(&bar[XB_TOP], 1u);
            const unsigned tg = og / nx;
            if (og + 1u == (tg + 1u) * nx) xb_add(&bar[XB_TOPGEN], 1u);
            else XB_SPIN(xb_ld(&bar[XB_TOPGEN]) == tg, bar);
            __builtin_amdgcn_fence(__ATOMIC_ACQUIRE, "agent");
            xb_add(&bar[XB_XGEN(b.x)], 1u);
            asm volatile("s_waitcnt vmcnt(0)" ::: "memory");
        } else {
            XB_SPIN(xb_ld(&bar[XB_XGEN(b.x)]) == gen, bar);
            __builtin_amdgcn_fence(__ATOMIC_ACQUIRE, "agent");
            asm volatile("s_waitcnt vmcnt(0)" ::: "memory");
        }
    }
    __syncthreads();
}

struct Frame {
    LAS unsigned char* lds;
    volatile LAS unsigned* MISC;
    gu32* ctl;
    int tid, lane, wave;
    int vcu, G;
    float* out;
    unsigned char* ws;
};
struct Args { const float* in[37]; float* out; unsigned char* ws; int ph_lo, ph_hi, li, pad; };
__device__ __forceinline__ void refresh(Frame& F) { int t = threadIdx.x; asm volatile("" : "+v"(t)); F.tid = t; F.lane = t & 63; F.wave = __builtin_amdgcn_readfirstlane(t >> 6); }
__device__ __forceinline__ float wave_sum(float v) {
#pragma unroll
    for (int o = 1; o < 64; o <<= 1) v += __shfl_xor(v, o);
    return v;
}
enum { I_XP = 0, I_XS, I_SCONV, I_SH, I_SSR, I_SSI, I_CP, I_CS, I_ADAW, I_ADAB, I_INPROJ, I_CONVW, I_CONVB, I_RGWR, I_RGBR, I_RGWI, I_RGBI, I_RGLAM,
       I_S5ARE, I_S5AIM, I_S5LOGDT, I_S5BRE, I_S5BIM, I_S5CRE, I_S5CIM, I_S5D, I_GLUW, I_GLUB, I_OUTPROJ, I_LN1G, I_LN1B, I_W1, I_B1, I_W2, I_B2, I_LN2G, I_LN2B };

typedef float f32x2m __attribute__((ext_vector_type(2)));
typedef __bf16 bf16x2m __attribute__((ext_vector_type(2)));
__device__ __forceinline__ unsigned pkbf0(float a, float b) { const f32x2m v = {a, b}; const bf16x2m r = __builtin_convertvector(v, bf16x2m); return __builtin_bit_cast(unsigned, r); }
typedef short bf16x8m __attribute__((ext_vector_type(8)));
typedef float f32x16m __attribute__((ext_vector_type(16)));
__device__ __forceinline__ void p0_transpose_item(const float* W, int K, int N, bf16* WT, LAS float* scr, int item, int lane) {
    const int nblk = N / 32, kb = item / nblk, nb = item % nblk, k0 = 64 * kb, n0 = 32 * nb;
#pragma unroll 8
    for (int i = 0; i < 32; ++i) { const int kk = 2 * i + (lane >> 5); scr[kk * 33 + (lane & 31)] = W[(size_t)(k0 + kk) * N + n0 + (lane & 31)]; }
    LDS_WAIT(); asm volatile("" ::: "memory");
    const int c = lane & 7;
#pragma unroll
    for (int j = 0; j < 4; ++j) { const int n = (lane >> 3) + 8 * j; const LAS float* s = scr + (8 * c) * 33 + n;
        v4u o; o.x = pk2(s[0 * 33], s[1 * 33]); o.y = pk2(s[2 * 33], s[3 * 33]); o.z = pk2(s[4 * 33], s[5 * 33]); o.w = pk2(s[6 * 33], s[7 * 33]);
        *(GAS v4u*)(WT + (size_t)(n0 + n) * K + k0 + 8 * c) = o; }
    LDS_WAIT(); asm volatile("" ::: "memory");
}

#ifndef PROBE_P0PART
#define PROBE_P0PART 7
#endif
__device__ __forceinline__ void p0_prologue(Frame& F, const Args& A, int rep = 0) {
    refresh(F);
    const int pmask = rep ? PROBE_P0PART : 7;
    LAS float* scr = (LAS float*)(F.lds + RING_OFF + F.wave * 16384);
    const int gw = F.wave * F.G + F.vcu, NGW = F.G * NWAVES;
    constexpr int I_IN = (D / 64) * (NZ / 32), I_GL = (WB / 64) * (WB / 32), I_OU = (D / 64) * (D / 32), I_1 = (D / 64) * (FF / 32), I_2 = (FF / 64) * (D / 32);
    constexpr int I_S5 = GB, I_RG = WA / 64, I_RGT = HA * 2 * 2 * 4, I_CB = NBS * 3 * WA / 512;
    constexpr int NITEMS = I_IN + I_GL + I_OU + I_1 + I_2 + I_S5 + I_RG + I_RGT + I_CB;
    float* sc = (float*)(F.ws + WS_S5C);
    for (int it = gw; it < NITEMS; it += NGW) {
        int r = it;
        if (!(pmask & 1) && it < I_IN + I_GL + I_OU + I_1 + I_2) continue;
        if (!(pmask & 2) && it >= I_IN + I_GL + I_OU + I_1 + I_2) continue;
        if (r < I_IN) { p0_transpose_item(A.in[I_INPROJ], D, NZ, (bf16*)(F.ws + WS_WIN), scr, r, F.lane); continue; } r -= I_IN;
        if (r < I_GL) { p0_transpose_item(A.in[I_GLUW], WB, WB, (bf16*)(F.ws + WS_WGLU), scr, r, F.lane); continue; } r -= I_GL;
        if (r < I_OU) { p0_transpose_item(A.in[I_OUTPROJ], D, D, (bf16*)(F.ws + WS_WOUT), scr, r, F.lane); continue; } r -= I_OU;
        if (r < I_1) { p0_transpose_item(A.in[I_W1], D, FF, (bf16*)(F.ws + WS_W1), scr, r, F.lane); continue; } r -= I_1;
        if (r < I_2) { p0_transpose_item(A.in[I_W2], FF, D, (bf16*)(F.ws + WS_W2), scr, r, F.lane); continue; } r -= I_2;
        if (r < I_S5) {
            const int g = r, n = F.lane, gn = g * NS5 + n;
            const double dt = exp((double)A.in[I_S5LOGDT][g]), ar = (double)A.in[I_S5ARE][gn], ai = (double)A.in[I_S5AIM][gn];
            const double mag = exp(dt * ar), abr = mag * cos(dt * ai), abi = mag * sin(dt * ai), den = ar * ar + ai * ai, nr = abr - 1.0;
            const double qr = (nr * ar + abi * ai) / den, qi = (abi * ar - nr * ai) / den;
            sc[SC_ABR + gn] = (float)abr; sc[SC_ABI + gn] = (float)abi;
            unsigned char* tab = F.ws + WS_TAB;
            bf16* BF1 = (bf16*)(tab + TB_BF1); bf16* BF2 = (bf16*)(tab + TB_BF2); float* TA = (float*)(tab + TB_TA); float* ZP = (float*)(tab + TB_ZP); float* Z16N = (float*)(tab + TB_Z16N);
            const int sh = n >> 5, v = n & 31, hh = (v >> 2) & 1, ii = (v & 3) + 4 * (v >> 3);
            for (int k = 0; k < KS5; ++k) { const double br = (double)A.in[I_S5BRE][gn * KS5 + k], bi = (double)A.in[I_S5BIM][gn * KS5 + k];
                const float vr = (float)(qr * br - qi * bi), vi = (float)(qr * bi + qi * br);
                sc[SC_BBR + gn * KS5 + k] = vr; sc[SC_BBI + gn * KS5 + k] = vi;
                const int lp = (n & 31) + 32 * (k >> 3), jj = k & 7;
                BF1[(size_t)((g * 4 + 0 + sh) * 64 + lp) * 8 + jj] = (bf16)f2bf(vr); BF1[(size_t)((g * 4 + 2 + sh) * 64 + lp) * 8 + jj] = (bf16)f2bf(vi); }
            { const int s2 = (n >> 4) & 1, jj = 4 * ((n >> 3) & 1) + (n & 3), hk = (n >> 2) & 1;
              for (int ch = 0; ch < KS5; ++ch) { const int hr_ = ch >> 3, i8 = ch & 7, R = (i8 & 3) + 8 * (i8 >> 2) + 4 * hr_, lp = R + 32 * hk;
                  const float cr = A.in[I_S5CRE][(size_t)(g * KS5 + ch) * NS5 + n], ci = A.in[I_S5CIM][(size_t)(g * KS5 + ch) * NS5 + n];
                  BF2[(size_t)((g * 8 + (0 + sh) * 2 + s2) * 64 + lp) * 8 + jj] = (bf16)f2bf(cr); BF2[(size_t)((g * 8 + (2 + sh) * 2 + s2) * 64 + lp) * 8 + jj] = (bf16)f2bf(-ci); }
              for (int z = 0; z < 4; ++z) { const int cidx = n + 64 * z, ks = cidx >> 5, r16 = cidx & 31, lp = 16 + (r16 & 15) + 32 * (r16 >> 4);
                  *(v4u*)(BF2 + (size_t)((g * 8 + ks) * 64 + lp) * 8) = (v4u){0u, 0u, 0u, 0u}; } }
            TA[((g * 2 + hh) * 2 + 0) * 32 + sh * 16 + ii] = (float)abr; TA[((g * 2 + hh) * 2 + 1) * 32 + sh * 16 + ii] = (float)abi;
            const double mg8 = exp(8.0 * dt * ar), z1r = mg8 * cos(8.0 * dt * ai), z1i = mg8 * sin(8.0 * dt * ai); double pzr = 1.0, pzi = 0.0;
            for (int e = 0; e <= 16; ++e) { const float zr = (float)pzr, zi = (float)pzi; { const double nr2 = pzr * z1r - pzi * z1i, ni2 = pzr * z1i + pzi * z1r; pzr = nr2; pzi = ni2; }
                ZP[(((g * 17 + e) * 2 + hh) * 2 + 0) * 32 + sh * 16 + ii] = zr; ZP[(((g * 17 + e) * 2 + hh) * 2 + 1) * 32 + sh * 16 + ii] = zi;
                if (e == 16) { Z16N[(g * 2 + 0) * 64 + n] = zr; Z16N[(g * 2 + 1) * 64 + n] = zi; } }
            continue; } r -= I_S5;
        if (r < I_RG) { const int c = r * 64 + F.lane; const double lam = (double)A.in[I_RGLAM][c];
          sc[SC_RGL + c] = (float)(-8.0 * log1p(exp(-lam)) * 1.4426950408889634); continue; } r -= I_RG;
        if (r >= I_RGT) { r -= I_RGT;
            const float* src = A.in[I_SCONV] + (size_t)r * 512 + F.lane * 8; const f32x4 a0 = *(const f32x4*)src, a1 = *(const f32x4*)(src + 4);
            v4u o; o.x = pk2(a0[0], a0[1]); o.y = pk2(a0[2], a0[3]); o.z = pk2(a1[0], a1[1]); o.w = pk2(a1[2], a1[3]);
            *(v4u*)(F.ws + WS_TAB + TB_CB + ((size_t)r * 512 + F.lane * 8) * 2) = o; continue; }
        {
            const int s4 = r & 3, gate = (r >> 2) & 1, jh = (r >> 3) & 1, hd = r >> 4;
            const int R = F.lane & 31, hk = F.lane >> 5, hR = (R >> 2) & 1, i = (R & 3) + 4 * (R >> 3), cho = 32 * jh + 16 * (i >> 3) + 8 * hR + (i & 7);
            const float* W = A.in[gate ? I_RGWI : I_RGWR] + (size_t)(hd * 64 + 16 * s4 + 8 * hk) * 64 + cho;
            v4u o; o.x = pk2(W[0], W[64]); o.y = pk2(W[128], W[192]); o.z = pk2(W[256], W[320]); o.w = pk2(W[384], W[448]);
            *(v4u*)(F.ws + WS_TAB + TB_RG + (size_t)(r * 64 + F.lane) * 16) = o;
        }
    }
    __syncthreads();
    LAS float* RED = (LAS float*)(F.lds + RING_OFF);
    float* mod = (float*)(F.ws + WS_MOD);
    const int r32 = F.lane & 31, hh = F.lane >> 5;
#pragma unroll 1
    for (int it = F.vcu; it < ((pmask & 4) ? NMOD / 32 : 0); it += F.G) {
        const int n0 = it * 32;
        for (int e = F.tid; e < 5 * 16 * 64; e += NWAVES * 64) RED[e] = 0.f;
        __syncthreads();
        f32x16m acc[5];
#pragma unroll
        for (int rt = 0; rt < 5; ++rt)
#pragma unroll
            for (int i = 0; i < 16; ++i) acc[rt][i] = 0.f;
#pragma unroll 1
        for (int kb = 0; kb < 2; ++kb) {
        float bw[4][8];
#pragma unroll
        for (int ks = 0; ks < 4; ++ks) { const float* wp = A.in[I_ADAW] + (size_t)(F.wave * 128 + (kb * 4 + ks) * 16 + 8 * hh) * NMOD + n0 + r32;
#pragma unroll
            for (int j = 0; j < 8; ++j) bw[ks][j] = wp[(size_t)j * NMOD]; }
#pragma unroll
        for (int ks = 0; ks < 4; ++ks) {
            const int k0 = F.wave * 128 + (kb * 4 + ks) * 16 + 8 * hh;
            v4u bp; bp.x = pkbf0(bw[ks][0], bw[ks][1]); bp.y = pkbf0(bw[ks][2], bw[ks][3]); bp.z = pkbf0(bw[ks][4], bw[ks][5]); bp.w = pkbf0(bw[ks][6], bw[ks][7]);
            const bf16x8m bfr = __builtin_bit_cast(bf16x8m, bp);
#pragma unroll
            for (int rt = 0; rt < 5; ++rt) { int row = 32 * rt + r32; row = row > NROWMOD - 1 ? NROWMOD - 1 : row;
                const float* cp = (row < NBP ? A.in[I_CP] + (size_t)row * D : A.in[I_CS] + (size_t)(row - NBP) * D) + k0;
                const f32x4 c0 = *(const f32x4*)cp, c1 = *(const f32x4*)(cp + 4);
                v4u ap; ap.x = pkbf0(c0[0] * sigmoidf_(c0[0]), c0[1] * sigmoidf_(c0[1])); ap.y = pkbf0(c0[2] * sigmoidf_(c0[2]), c0[3] * sigmoidf_(c0[3]));
                ap.z = pkbf0(c1[0] * sigmoidf_(c1[0]), c1[1] * sigmoidf_(c1[1])); ap.w = pkbf0(c1[2] * sigmoidf_(c1[2]), c1[3] * sigmoidf_(c1[3]));
                acc[rt] = __builtin_amdgcn_mfma_f32_32x32x16_bf16(__builtin_bit_cast(bf16x8m, ap), bfr, acc[rt], 0, 0, 0); }
        }
        }
#pragma unroll
        for (int rt = 0; rt < 5; ++rt)
#pragma unroll
            for (int i = 0; i < 16; ++i) (void)__hip_atomic_fetch_add(RED + (rt * 16 + i) * 64 + F.lane, acc[rt][i], __ATOMIC_RELAXED, __HIP_MEMORY_SCOPE_WORKGROUP);
        __syncthreads();
        for (int e = F.tid; e < 5 * 16 * 64; e += NWAVES * 64) { const int rt = e >> 10, i = (e >> 6) & 15, l = e & 63, row = 32 * rt + (i & 3) + 8 * (i >> 2) + 4 * (l >> 5), col = n0 + (l & 31);
            if (row < NROWMOD) mod[(size_t)row * NMOD + col] = RED[e] + A.in[I_ADAB][col]; }
        __syncthreads();
    }
}

__device__ __forceinline__ int mod_row(int m) { return m < MP ? (m >> 11) : NBP + ((m - MP) >> 2); }
__device__ __forceinline__ const float* x_row(const Args& A, int m) { return m < MP ? A.in[I_XP] + (size_t)m * D : A.in[I_XS] + (size_t)(m - MP) * D; }

__device__ __forceinline__ void p1_modulate(Frame& F, const Args& A) {
    refresh(F);
    const int gw = F.vcu * NWAVES + F.wave, NGW = F.G * NWAVES;
    const float* mod = (const float*)(F.ws + WS_MOD); bf16* XN = (bf16*)(F.ws + WS_XN);
    for (int m = gw; m < M; m += NGW) {
        const GAS f32x4* xr = (const GAS f32x4*)x_row(A, m) + F.lane; const float* mr = mod + (size_t)mod_row(m) * NMOD;
        const GAS f32x4* sh = (const GAS f32x4*)(mr) + F.lane; const GAS f32x4* scp = (const GAS f32x4*)(mr + D) + F.lane;
        GAS unsigned long long* o8 = (GAS unsigned long long*)(XN + (size_t)m * D) + F.lane;
#pragma unroll
        for (int j = 0; j < 4; ++j) { const f32x4 v = xr[64 * j], a = sh[64 * j], s = scp[64 * j]; const f32x4 h = v * (s + 1.f) + a;
            o8[64 * j] = (unsigned long long)pk2(h.x, h.y) | ((unsigned long long)pk2(h.z, h.w) << 32); }
    }
}

template <bool SECOND>
__device__ __forceinline__ void ln_rows(Frame& F, const Args& A) {
    refresh(F);
    const int gw = F.vcu * NWAVES + F.wave, NGW = F.G * NWAVES;
    const float* mod = (const float*)(F.ws + WS_MOD); bf16* XN = (bf16*)(F.ws + WS_XN);
    const GAS f32x4* gg = (const GAS f32x4*)A.in[SECOND ? I_LN2G : I_LN1G] + F.lane; const GAS f32x4* gb = (const GAS f32x4*)A.in[SECOND ? I_LN2B : I_LN1B] + F.lane;
    for (int m = gw; m < M; m += NGW) {
        GAS f32x4* xr = (GAS f32x4*)(F.out + (size_t)m * D) + F.lane;
        f32x4 v[4]; float s = 0.f;
        if (m >= MP) {
            const float* mr = mod + (size_t)mod_row(m) * NMOD + (SECOND ? 5 : 2) * D;
            const GAS f32x4* bs = SECOND ? (const GAS f32x4*)xr : (const GAS f32x4*)(A.in[I_XS] + (size_t)(m - MP) * D) + F.lane;
            const GAS f32x4* sl = (const GAS f32x4*)((const float*)(F.ws + WS_SLAB) + (size_t)(m - MP) * D) + F.lane;
#pragma unroll
            for (int j = 0; j < 4; ++j) { f32x4 a = SECOND ? *((const GAS f32x4*)A.in[I_B2] + F.lane + 64 * j) : (f32x4){0.f, 0.f, 0.f, 0.f};
#pragma unroll
                for (int ks = 0; ks < (SECOND ? NS_DOWN : NS_OUT); ++ks) a += sl[(size_t)ks * (512 * 1024 / 4) + 64 * j];
                v[j] = bs[64 * j] * ALPHA + *((const GAS f32x4*)mr + F.lane + 64 * j) * a; }
        } else {
#pragma unroll
            for (int j = 0; j < 4; ++j) v[j] = xr[64 * j];
        }
#pragma unroll
        for (int j = 0; j < 4; ++j) s += (v[j].x + v[j].y) + (v[j].z + v[j].w);
        const float mean = wave_sum(s) * (1.f / D); float s2 = 0.f;
#pragma unroll
        for (int j = 0; j < 4; ++j) { v[j] = v[j] - mean; s2 += (v[j].x * v[j].x + v[j].y * v[j].y) + (v[j].z * v[j].z + v[j].w * v[j].w); }
        const float rstd = 1.f / sqrtf(wave_sum(s2) * (1.f / D) + LN_EPS);
#pragma unroll
        for (int j = 0; j < 4; ++j) { v[j] = v[j] * rstd * gg[64 * j] + gb[64 * j]; xr[64 * j] = v[j]; }
        if (!SECOND) {
            const float* mr = mod + (size_t)mod_row(m) * NMOD;
            const GAS f32x4* sh = (const GAS f32x4*)(mr + 3 * D) + F.lane; const GAS f32x4* scp = (const GAS f32x4*)(mr + 4 * D) + F.lane;
            GAS unsigned long long* o8 = (GAS unsigned long long*)(XN + (size_t)m * D) + F.lane;
#pragma unroll
            for (int j = 0; j < 4; ++j) { const f32x4 h = v[j] * (scp[64 * j] + 1.f) + sh[64 * j];
                o8[64 * j] = (unsigned long long)pk2(h.x, h.y) | ((unsigned long long)pk2(h.z, h.w) << 32); }
        }
    }
}

__device__ __forceinline__ void rg_item_ref(Frame& F, const Args& A, bool prompt, int b, int hd, LAS float* scr) {
    const int j = F.lane, c = hd * HDA + j;
    const bf16* Z = (const bf16*)(F.ws + WS_Z); bf16* Y = (bf16*)(F.ws + WS_YCAT); const float* sc = (const float*)(F.ws + WS_S5C);
    float wr[64], wi[64];
#pragma unroll
    for (int i = 0; i < 64; ++i) { wr[i] = A.in[I_RGWR][(size_t)(hd * 64 + i) * 64 + j]; wi[i] = A.in[I_RGWI][(size_t)(hd * 64 + i) * 64 + j]; }
    const float br = A.in[I_RGBR][c], bi = A.in[I_RGBI][c], L2 = sc[SC_RGL + c];
    const float w0 = A.in[I_CONVW][c], w1 = A.in[I_CONVW][WA + c], w2 = A.in[I_CONVW][2 * WA + c], w3 = A.in[I_CONVW][3 * WA + c], cb = A.in[I_CONVB][c];
    int T, m0; float x3, x2, x1, h;
    if (prompt) { T = TP; m0 = b * TP; x3 = 0.f; x2 = 0.f; x1 = 0.f; h = 0.f; }
    else { T = TS; m0 = MP + b * TS; x3 = A.in[I_SCONV][(size_t)(b * 3 + 0) * WA + c]; x2 = A.in[I_SCONV][(size_t)(b * 3 + 1) * WA + c]; x1 = A.in[I_SCONV][(size_t)(b * 3 + 2) * WA + c]; h = A.in[I_SH][(size_t)b * WA + c]; }
    for (int t = 0; t < T; ++t) {
        const size_t m = (size_t)(m0 + t);
        const float xa = bf2f(Z[m * NZ + WA + c]), gate = bf2f(Z[m * NZ + c]);
        const float xc = cb + w0 * x3 + w1 * x2 + w2 * x1 + w3 * xa; x3 = x2; x2 = x1; x1 = xa;
        scr[j] = xc; LDS_WAIT(); asm volatile("" ::: "memory");
        float rp = br, gp = bi;
#pragma unroll
        for (int i4 = 0; i4 < 16; ++i4) { const f32x4 v = *(const LAS f32x4*)(scr + 4 * i4);
            rp += v[0] * wr[4 * i4] + v[1] * wr[4 * i4 + 1] + v[2] * wr[4 * i4 + 2] + v[3] * wr[4 * i4 + 3];
            gp += v[0] * wi[4 * i4] + v[1] * wi[4 * i4 + 1] + v[2] * wi[4 * i4 + 2] + v[3] * wi[4 * i4 + 3]; }
        LDS_WAIT(); asm volatile("" ::: "memory");
        const float r = sigmoidf_(rp), gi = sigmoidf_(gp);
        const float a = exp2f(r * L2);
        float mult = sqrtf(fmaxf(1.f - a * a, 0.f));
        if (prompt && t == 0) mult = 1.f;
        h = a * h + mult * gi * xc;
        Y[m * D + c] = (bf16)f2bf(gelu_tanh(gate) * h);
    }
    float* oc = F.out + (prompt ? O_CONVP : O_CONVS); float* oh = F.out + (prompt ? O_HP : O_HS);
    oc[(size_t)(b * 3 + 0) * WA + c] = x3; oc[(size_t)(b * 3 + 1) * WA + c] = x2; oc[(size_t)(b * 3 + 2) * WA + c] = x1;
    oh[(size_t)b * WA + c] = h;
}
__device__ __forceinline__ void s5_item_ref(Frame& F, const Args& A, bool prompt, int b, int g, LAS float* scr) {
    const int n = F.lane, gn = g * NS5 + n, k = F.lane & 15, part = F.lane >> 4;
    const bf16* Z = (const bf16*)(F.ws + WS_Z); bf16* Gy = (bf16*)(F.ws + WS_G); const float* sc = (const float*)(F.ws + WS_S5C);
    float bbr[16], bbi[16], cre[16], cim[16];
#pragma unroll
    for (int i = 0; i < 16; ++i) { bbr[i] = sc[SC_BBR + gn * KS5 + i]; bbi[i] = sc[SC_BBI + gn * KS5 + i];
        cre[i] = A.in[I_S5CRE][(size_t)(g * KS5 + k) * NS5 + part * 16 + i]; cim[i] = A.in[I_S5CIM][(size_t)(g * KS5 + k) * NS5 + part * 16 + i]; }
    const float abr = sc[SC_ABR + gn], abi = sc[SC_ABI + gn], dk = A.in[I_S5D][g * KS5 + k];
    int T, m0; float hr, hi;
    if (prompt) { T = TP; m0 = b * TP; hr = 0.f; hi = 0.f; }
    else { T = TS; m0 = MP + b * TS; hr = A.in[I_SSR][(size_t)(b * GB + g) * NS5 + n]; hi = A.in[I_SSI][(size_t)(b * GB + g) * NS5 + n]; }
    for (int t = 0; t < T; ++t) {
        const size_t m = (size_t)(m0 + t);
        const bf16* zr = Z + m * NZ + 2 * WA + g * KS5;
        const v4u u0 = *(const v4u*)zr, u1 = *(const v4u*)(zr + 8);
        float u[16];
        u[0] = pg8::bf_lo(u0.x); u[1] = pg8::bf_hi(u0.x); u[2] = pg8::bf_lo(u0.y); u[3] = pg8::bf_hi(u0.y); u[4] = pg8::bf_lo(u0.z); u[5] = pg8::bf_hi(u0.z); u[6] = pg8::bf_lo(u0.w); u[7] = pg8::bf_hi(u0.w);
        u[8] = pg8::bf_lo(u1.x); u[9] = pg8::bf_hi(u1.x); u[10] = pg8::bf_lo(u1.y); u[11] = pg8::bf_hi(u1.y); u[12] = pg8::bf_lo(u1.z); u[13] = pg8::bf_hi(u1.z); u[14] = pg8::bf_lo(u1.w); u[15] = pg8::bf_hi(u1.w);
        float bur = 0.f, bui = 0.f;
#pragma unroll
        for (int i = 0; i < 16; ++i) { bur += bbr[i] * u[i]; bui += bbi[i] * u[i]; }
        const float nhr = abr * hr - abi * hi + bur, nhi = abr * hi + abi * hr + bui; hr = nhr; hi = nhi;
        scr[n] = hr; scr[64 + n] = hi; LDS_WAIT(); asm volatile("" ::: "memory");
        float p = 0.f;
#pragma unroll
        for (int i4 = 0; i4 < 4; ++i4) { const f32x4 vr = *(const LAS f32x4*)(scr + part * 16 + 4 * i4), vi = *(const LAS f32x4*)(scr + 64 + part * 16 + 4 * i4);
#pragma unroll
            for (int e = 0; e < 4; ++e) p += vr[e] * cre[4 * i4 + e] - vi[e] * cim[4 * i4 + e]; }
        LDS_WAIT(); asm volatile("" ::: "memory");
        p += __shfl_xor(p, 16); p += __shfl_xor(p, 32);
        const float uk = bf2f(zr[k]);
        if (F.lane < 16) Gy[m * WB + g * KS5 + k] = (bf16)f2bf(gelu_tanh(p + dk * uk));
    }
    float* osr = F.out + (prompt ? O_SRP : O_SRS); float* osi = F.out + (prompt ? O_SIP : O_SIS);
    osr[(size_t)(b * GB + g) * NS5 + n] = hr; osi[(size_t)(b * GB + g) * NS5 + n] = hi;
}

typedef short bf16x8v __attribute__((ext_vector_type(8)));
typedef float f32x16 __attribute__((ext_vector_type(16)));
typedef float f32x2v __attribute__((ext_vector_type(2)));
typedef __bf16 bf16x2v __attribute__((ext_vector_type(2)));
#define MFMA32(a, b, c) __builtin_amdgcn_mfma_f32_32x32x16_bf16((a), (b), (c), 0, 0, 0)
__device__ __forceinline__ unsigned pkbf(float a, float b) { const f32x2v v = {a, b}; const bf16x2v r = __builtin_convertvector(v, bf16x2v); return __builtin_bit_cast(unsigned, r); }
template <int CTRL> __device__ __forceinline__ float dppf(float old, float v) { return __builtin_bit_cast(float, __builtin_amdgcn_update_dpp(__builtin_bit_cast(int, old), __builtin_bit_cast(int, v), CTRL, 0xF, 0xF, false)); }
__device__ __forceinline__ f32x16 ld16(const float* p) { f32x16 r;
#pragma unroll
    for (int i = 0; i < 4; ++i) { const f32x4 v = *(const f32x4*)(p + 4 * i); r[4 * i] = v[0]; r[4 * i + 1] = v[1]; r[4 * i + 2] = v[2]; r[4 * i + 3] = v[3]; }
    return r; }
__device__ __forceinline__ f32x16 ld16l(const LAS float* p) { f32x16 r;
#pragma unroll
    for (int i = 0; i < 4; ++i) { const f32x4 v = *(const LAS f32x4*)(p + 4 * i); r[4 * i] = v[0]; r[4 * i + 1] = v[1]; r[4 * i + 2] = v[2]; r[4 * i + 3] = v[3]; }
    return r; }
__device__ __forceinline__ bf16x8v pack8(const f32x16& x, int s) { v4u p; p.x = pkbf(x[8 * s], x[8 * s + 1]); p.y = pkbf(x[8 * s + 2], x[8 * s + 3]); p.z = pkbf(x[8 * s + 4], x[8 * s + 5]); p.w = pkbf(x[8 * s + 6], x[8 * s + 7]); return __builtin_bit_cast(bf16x8v, p); }
template <int CTRL> __device__ __forceinline__ void s5_scan_step(f32x16& xr, f32x16& xi, const f32x16& zr, const f32x16& zi) {
#pragma unroll
    for (int i = 0; i < 16; ++i) { const float sr = dppf<CTRL>(0.f, xr[i]), si = dppf<CTRL>(0.f, xi[i]);
        xr[i] += zr[i] * sr - zi[i] * si; xi[i] += zr[i] * si + zi[i] * sr; }
}
constexpr int S5L_BF1 = 0, S5L_BF2 = 4096, S5L_TOT = 12288, S5L_CAR = 20480, S5L_ZP = 28672  , S5L_TA = 37376  , S5L_U = 38912  ;
template <bool SECOND>
__device__ __forceinline__ void s5_step(LAS unsigned char* L, int lane, const bf16x8v u, f32x16& hr0, f32x16& hr1, f32x16& hi0, f32x16& hi1,
                                        const f32x16& ar0, const f32x16& ar1, const f32x16& ai0, const f32x16& ai1, const float (&dk)[8], bf16* gout) {
    const LAS bf16x8v* a1 = (const LAS bf16x8v*)(L + S5L_BF1) + lane;
    { const f32x16 cr = ar0 * hr0 - ai0 * hi0, ci = ar0 * hi0 + ai0 * hr0; hr0 = MFMA32(a1[0], u, cr); hi0 = MFMA32(a1[128], u, ci); }
    asm volatile("" : "+v"(hr0), "+v"(hi0));
    { const f32x16 cr = ar1 * hr1 - ai1 * hi1, ci = ar1 * hi1 + ai1 * hr1; hr1 = MFMA32(a1[64], u, cr); hi1 = MFMA32(a1[192], u, ci); }
    if (SECOND) {
        const LAS bf16x8v* a2 = (const LAS bf16x8v*)(L + S5L_BF2) + lane;
        f32x16 y;
#pragma unroll
        for (int i = 0; i < 16; ++i) y[i] = 0.f;
        y = MFMA32(a2[0 * 64], pack8(hr0, 0), y); y = MFMA32(a2[1 * 64], pack8(hr0, 1), y);
        y = MFMA32(a2[2 * 64], pack8(hr1, 0), y); y = MFMA32(a2[3 * 64], pack8(hr1, 1), y);
        y = MFMA32(a2[4 * 64], pack8(hi0, 0), y); y = MFMA32(a2[5 * 64], pack8(hi0, 1), y);
        y = MFMA32(a2[6 * 64], pack8(hi1, 0), y); y = MFMA32(a2[7 * 64], pack8(hi1, 1), y);
        const v4u uw = __builtin_bit_cast(v4u, u);
        float o[8];
        o[0] = gelu_tanh(y[0] + dk[0] * pg8::bf_lo(uw.x)); o[1] = gelu_tanh(y[1] + dk[1] * pg8::bf_hi(uw.x));
        o[2] = gelu_tanh(y[2] + dk[2] * pg8::bf_lo(uw.y)); o[3] = gelu_tanh(y[3] + dk[3] * pg8::bf_hi(uw.y));
        o[4] = gelu_tanh(y[4] + dk[4] * pg8::bf_lo(uw.z)); o[5] = gelu_tanh(y[5] + dk[5] * pg8::bf_hi(uw.z));
        o[6] = gelu_tanh(y[6] + dk[6] * pg8::bf_lo(uw.w)); o[7] = gelu_tanh(y[7] + dk[7] * pg8::bf_hi(uw.w));
        v4u w; w.x = pkbf(o[0], o[1]); w.y = pkbf(o[2], o[3]); w.z = pkbf(o[4], o[5]); w.w = pkbf(o[6], o[7]);
        *(v4u*)gout = w;
    }
}
__device__ __forceinline__ void s5_item_fast(Frame& F, const Args& A, int b, int g) {
    refresh(F);
    const int lane = F.lane, q = lane & 31, hh = lane >> 5, w = F.wave, c = w * 32 + q;
    LAS unsigned char* L = F.lds + RING_OFF;
    const unsigned char* tab = F.ws + WS_TAB;
    const size_t m0 = (size_t)b * TP + (size_t)8 * c;
    const bf16* zrow = (const bf16*)(F.ws + WS_Z) + m0 * NZ + 2 * WA + g * KS5 + 8 * hh;
    bf16* grow = (bf16*)(F.ws + WS_G) + m0 * WB + g * KS5 + 8 * hh;
    LAS v4u* UL = (LAS v4u*)(L + S5L_U) + F.tid;
    {
        v4u uu[8];
#pragma unroll
        for (int j = 0; j < 8; ++j) uu[j] = *(const v4u*)(zrow + (size_t)j * NZ);
        const v4u* s1 = (const v4u*)(tab + TB_BF1) + (size_t)g * 256; const v4u* s2 = (const v4u*)(tab + TB_BF2) + (size_t)g * 512;
        if (F.tid < 256) ((LAS v4u*)(L + S5L_BF1))[F.tid] = s1[F.tid];
        ((LAS v4u*)(L + S5L_BF2))[F.tid] = s2[F.tid];
        const v4u* s3 = (const v4u*)(tab + TB_ZP) + (size_t)g * (17 * 128 / 4); for (int e = F.tid; e < 17 * 128 / 4; e += NWAVES * 64) ((LAS v4u*)(L + S5L_ZP))[e] = s3[e];
        if (F.tid < 32) ((LAS v4u*)(L + S5L_TA))[F.tid] = ((const v4u*)(tab + TB_TA) + (size_t)g * 32)[F.tid];
#pragma unroll
        for (int j = 0; j < 8; ++j) UL[512 * j] = uu[j];
    }
    __syncthreads();
    const LAS float* TA = (const LAS float*)(L + S5L_TA) + hh * 64;
    f32x16 ar0 = ld16l(TA), ar1 = ld16l(TA + 16), ai0 = ld16l(TA + 32), ai1 = ld16l(TA + 48);
    f32x16 hr0, hr1, hi0, hi1;
#pragma unroll
    for (int i = 0; i < 16; ++i) { hr0[i] = 0.f; hr1[i] = 0.f; hi0[i] = 0.f; hi1[i] = 0.f; }
    float dk[8];
#pragma unroll
    for (int i = 0; i < 8; ++i) dk[i] = A.in[I_S5D][g * KS5 + 8 * hh + i];
#pragma unroll 1
    for (int j = 0; j < 8; ++j) { const bf16x8v u = __builtin_bit_cast(bf16x8v, UL[512 * j]);
        s5_step<false>(L, lane, u, hr0, hr1, hi0, hi1, ar0, ar1, ai0, ai1, dk, nullptr); }
    const LAS float* ZP = (const LAS float*)(L + S5L_ZP);
#define S5_SCAN(E, CTRL) do { const LAS float* z = ZP + (((E) * 2 + hh) * 2) * 32; \
        { const f32x16 zr = ld16l(z), zi = ld16l(z + 32); s5_scan_step<CTRL>(hr0, hi0, zr, zi); } \
        asm volatile("" : "+v"(hr0), "+v"(hi0) :: "memory"); \
        { const f32x16 zr = ld16l(z + 16), zi = ld16l(z + 48); s5_scan_step<CTRL>(hr1, hi1, zr, zi); } \
        asm volatile("" : "+v"(hr1), "+v"(hi1) :: "memory"); } while (0)
    S5_SCAN(1, 0x111); S5_SCAN(2, 0x112); S5_SCAN(4, 0x114); S5_SCAN(8, 0x118);
#undef S5_SCAN
    const int seg = w * 2 + (q >> 4);
    LAS float* TOT = (LAS float*)(L + S5L_TOT); LAS float* CAR = (LAS float*)(L + S5L_CAR);
    if ((lane & 15) == 15) {
#pragma unroll
        for (int rho = 0; rho < 4; ++rho) {
            *(LAS f32x4*)(TOT + (seg * 2 + 0) * 64 + 0 + 8 * rho + 4 * hh) = (f32x4){hr0[4 * rho], hr0[4 * rho + 1], hr0[4 * rho + 2], hr0[4 * rho + 3]};
            *(LAS f32x4*)(TOT + (seg * 2 + 0) * 64 + 32 + 8 * rho + 4 * hh) = (f32x4){hr1[4 * rho], hr1[4 * rho + 1], hr1[4 * rho + 2], hr1[4 * rho + 3]};
            *(LAS f32x4*)(TOT + (seg * 2 + 1) * 64 + 0 + 8 * rho + 4 * hh) = (f32x4){hi0[4 * rho], hi0[4 * rho + 1], hi0[4 * rho + 2], hi0[4 * rho + 3]};
            *(LAS f32x4*)(TOT + (seg * 2 + 1) * 64 + 32 + 8 * rho + 4 * hh) = (f32x4){hi1[4 * rho], hi1[4 * rho + 1], hi1[4 * rho + 2], hi1[4 * rho + 3]}; }
    }
    __syncthreads();
    if (F.tid < 64) {
        const float* z16 = (const float*)(tab + TB_Z16N) + (size_t)g * 128; const float zr = z16[F.tid], zi = z16[64 + F.tid];
        float cr = 0.f, ci = 0.f;
#pragma unroll
        for (int sg = 0; sg < 16; ++sg) { CAR[(sg * 2 + 0) * 64 + F.tid] = cr; CAR[(sg * 2 + 1) * 64 + F.tid] = ci;
            const float tr = TOT[(sg * 2 + 0) * 64 + F.tid], ti = TOT[(sg * 2 + 1) * 64 + F.tid];
            const float ncr = zr * cr - zi * ci + tr, nci = zr * ci + zi * cr + ti; cr = ncr; ci = nci; }
    }
    __syncthreads();
    {
        const LAS float* z = ZP + (((q & 15) * 2 + hh) * 2) * 32;
#define S5_EXCL(HR, HI, OFF) do { const f32x16 zr = ld16l(z + (OFF)), zi = ld16l(z + 32 + (OFF)); f32x16 kr, ki; \
        _Pragma("unroll") for (int rho = 0; rho < 4; ++rho) { \
            const f32x4 a0 = *(const LAS f32x4*)(CAR + (seg * 2 + 0) * 64 + 2 * (OFF) + 8 * rho + 4 * hh), b0 = *(const LAS f32x4*)(CAR + (seg * 2 + 1) * 64 + 2 * (OFF) + 8 * rho + 4 * hh); \
            _Pragma("unroll") for (int e = 0; e < 4; ++e) { kr[4 * rho + e] = a0[e]; ki[4 * rho + e] = b0[e]; } } \
        _Pragma("unroll") for (int i = 0; i < 16; ++i) { const float sr = dppf<0x111>(0.f, HR[i]), si = dppf<0x111>(0.f, HI[i]); \
            HR[i] = sr + zr[i] * kr[i] - zi[i] * ki[i]; HI[i] = si + zr[i] * ki[i] + zi[i] * kr[i]; } } while (0)
        S5_EXCL(hr0, hi0, 0); asm volatile("" : "+v"(hr0), "+v"(hi0) :: "memory"); S5_EXCL(hr1, hi1, 16); asm volatile("" : "+v"(hr1), "+v"(hi1) :: "memory");
#undef S5_EXCL
    }
    { int off = 0; asm volatile("" : "+v"(off)); const LAS float* TA2 = TA + off; ar0 = ld16l(TA2); ar1 = ld16l(TA2 + 16); ai0 = ld16l(TA2 + 32); ai1 = ld16l(TA2 + 48); }
#pragma unroll 1
    for (int j = 0; j < 8; ++j) { const bf16x8v u = __builtin_bit_cast(bf16x8v, UL[512 * j]);
        s5_step<true>(L, lane, u, hr0, hr1, hi0, hi1, ar0, ar1, ai0, ai1, dk, grow + (size_t)j * WB); }
    if (w == NWAVES - 1 && q == 31) {
        float* osr = F.out + O_SRP + (size_t)(b * GB + g) * NS5; float* osi = F.out + O_SIP + (size_t)(b * GB + g) * NS5;
#pragma unroll
        for (int i = 0; i < 16; ++i) { const int n = (i & 3) + 8 * (i >> 2) + 4 * hh; osr[n] = hr0[i]; osr[32 + n] = hr1[i]; osi[n] = hi0[i]; osi[32 + n] = hi1[i]; }
    }
    __syncthreads();
}

__device__ __forceinline__ void s5_item_sample(Frame& F, const Args& A, int g) {
    refresh(F);
    const int lane = F.lane, q = lane & 31, hh = lane >> 5, w = F.wave;
    LAS unsigned char* L = F.lds + RING_OFF;
    const unsigned char* tab = F.ws + WS_TAB;
    { const v4u* s1 = (const v4u*)(tab + TB_BF1) + (size_t)g * 256; const v4u* s2 = (const v4u*)(tab + TB_BF2) + (size_t)g * 512;
      if (F.tid < 256) ((LAS v4u*)(L + S5L_BF1))[F.tid] = s1[F.tid];
      ((LAS v4u*)(L + S5L_BF2))[F.tid] = s2[F.tid]; }
    __syncthreads();
    if (w < 4) {
        const int b = w * 32 + q;
        const float* TA = (const float*)(tab + TB_TA) + (size_t)((g * 2 + hh) * 2) * 32;
        const f32x16 ar0 = ld16(TA), ar1 = ld16(TA + 16), ai0 = ld16(TA + 32), ai1 = ld16(TA + 48);
        f32x16 hr0, hr1, hi0, hi1;
        const float* sr = A.in[I_SSR] + (size_t)(b * GB + g) * NS5; const float* si = A.in[I_SSI] + (size_t)(b * GB + g) * NS5;
#pragma unroll
        for (int rho = 0; rho < 4; ++rho) { const f32x4 a0 = *(const f32x4*)(sr + 8 * rho + 4 * hh), a1 = *(const f32x4*)(sr + 32 + 8 * rho + 4 * hh), b0 = *(const f32x4*)(si + 8 * rho + 4 * hh), b1 = *(const f32x4*)(si + 32 + 8 * rho + 4 * hh);
#pragma unroll
            for (int e = 0; e < 4; ++e) { hr0[4 * rho + e] = a0[e]; hr1[4 * rho + e] = a1[e]; hi0[4 * rho + e] = b0[e]; hi1[4 * rho + e] = b1[e]; } }
        float dk[8];
#pragma unroll
        for (int i = 0; i < 8; ++i) dk[i] = A.in[I_S5D][g * KS5 + 8 * hh + i];
        const size_t m0 = (size_t)MP + (size_t)b * TS;
        const bf16* zrow = (const bf16*)(F.ws + WS_Z) + m0 * NZ + 2 * WA + g * KS5 + 8 * hh;
        bf16* grow = (bf16*)(F.ws + WS_G) + m0 * WB + g * KS5 + 8 * hh;
        bf16x8v uu[TS];
#pragma unroll
        for (int j = 0; j < TS; ++j) uu[j] = *(const bf16x8v*)(zrow + (size_t)j * NZ);
#pragma unroll
        for (int j = 0; j < TS; ++j) s5_step<true>(L, lane, uu[j], hr0, hr1, hi0, hi1, ar0, ar1, ai0, ai1, dk, grow + (size_t)j * WB);
        float* osr = F.out + O_SRS + (size_t)(b * GB + g) * NS5; float* osi = F.out + O_SIS + (size_t)(b * GB + g) * NS5;
#pragma unroll
        for (int rho = 0; rho < 4; ++rho) {
            *(f32x4*)(osr + 8 * rho + 4 * hh) = (f32x4){hr0[4 * rho], hr0[4 * rho + 1], hr0[4 * rho + 2], hr0[4 * rho + 3]};
            *(f32x4*)(osr + 32 + 8 * rho + 4 * hh) = (f32x4){hr1[4 * rho], hr1[4 * rho + 1], hr1[4 * rho + 2], hr1[4 * rho + 3]};
            *(f32x4*)(osi + 8 * rho + 4 * hh) = (f32x4){hi0[4 * rho], hi0[4 * rho + 1], hi0[4 * rho + 2], hi0[4 * rho + 3]};
            *(f32x4*)(osi + 32 + 8 * rho + 4 * hh) = (f32x4){hi1[4 * rho], hi1[4 * rho + 1], hi1[4 * rho + 2], hi1[4 * rho + 3]}; }
    }
    __syncthreads();
}

template <int CTRL, int RMASK> __device__ __forceinline__ float dppm(float old, float v) { return __builtin_bit_cast(float, __builtin_amdgcn_update_dpp(__builtin_bit_cast(int, old), __builtin_bit_cast(int, v), CTRL, RMASK, 0xF, false)); }
template <int CTRL, int RMASK> __device__ __forceinline__ void rg_scan_step(f32x16& a, f32x16& b) {
#pragma unroll
    for (int i = 0; i < 16; ++i) { const float as = dppm<CTRL, RMASK>(1.f, a[i]), bs = dppm<CTRL, RMASK>(0.f, b[i]); b[i] = a[i] * bs + b[i]; a[i] = a[i] * as; }
}
constexpr int RGL_AFR = 0, RGL_CWT = 8192, RGL_TOT = 10240, RGL_CST = 14336;
constexpr int RGL_XAP = 144, RGL_GTP = 80;
constexpr int RGL_XA0 = 14848, RGL_GT0 = RGL_XA0 + 37376, RGL_BUF = 37376 + 20480;
static_assert(259 * RGL_XAP <= 37376 && 256 * RGL_GTP <= 20480 && RGL_XA0 + 2 * RGL_BUF <= RING_BYTES, "RG-LRU LDS map");
template <bool SAMPLE>
__device__ __forceinline__ void rg_item_fast(Frame& F, const Args& A, int b, int hd, int jh) {
    refresh(F);
    const int lane = F.lane, q = lane & 31, hh = lane >> 5, w = F.wave;
    LAS unsigned char* L = F.lds + RING_OFF;
    const float* sc = (const float*)(F.ws + WS_S5C);
    const bf16* Zb = (const bf16*)(F.ws + WS_Z) + (size_t)(SAMPLE ? MP : b * TP) * NZ; bf16* Yb = (bf16*)(F.ws + WS_YCAT) + (size_t)(SAMPLE ? MP : b * TP) * D;
    const bf16* CB = (const bf16*)(F.ws + WS_TAB + TB_CB);
    auto stage_load = [&](int T0, v4u (&st)[7]) {
#pragma unroll
        for (int k = 0; k < 7; ++k) { const int ci = F.tid + 512 * k; v4u v = (v4u){0u, 0u, 0u, 0u};
            if (ci < 2072) { const int tk = T0 - 3 + (ci >> 3); if (tk >= 0) v = *(const v4u*)(Zb + (size_t)tk * NZ + WA + hd * 64 + (ci & 7) * 8); }
            else if (ci < 2072 + 1024) { const int gi = ci - 2072; v = *(const v4u*)(Zb + (size_t)(T0 + (gi >> 2)) * NZ + hd * 64 + 32 * jh + (gi & 3) * 8); }
            st[k] = v; } };
    auto stage_write = [&](int par, const v4u (&st)[7]) {
#pragma unroll
        for (int k = 0; k < 7; ++k) { const int ci = F.tid + 512 * k;
            if (ci < 2072) *(LAS v4u*)(L + RGL_XA0 + par * RGL_BUF + (ci >> 3) * RGL_XAP + (ci & 7) * 16) = st[k];
            else if (ci < 2072 + 1024) { const int gi = ci - 2072; *(LAS v4u*)(L + RGL_GT0 + par * RGL_BUF + (gi >> 2) * RGL_GTP + (gi & 3) * 16) = st[k]; } } };
    {
        const v4u* src = (const v4u*)(F.ws + WS_TAB + TB_RG) + (size_t)((hd * 2 + jh) * 8) * 64;
        ((LAS v4u*)(L + RGL_AFR))[F.tid] = src[F.tid];
        if (F.tid < 320) { const int h2 = F.tid / 160, tap = (F.tid % 160) / 32, e = F.tid % 32, c = hd * 64 + 16 * (e >> 3) + 8 * h2 + (e & 7);
            ((LAS float*)(L + RGL_CWT))[F.tid] = tap < 4 ? A.in[I_CONVW][tap * WA + c] : A.in[I_CONVB][c]; }
        if (F.tid >= 384 && F.tid < 480) { const int e = F.tid - 384, h2 = e / 48, kind = (e % 48) / 16, i = e % 16, c = hd * 64 + 32 * jh + 16 * (i >> 3) + 8 * h2 + (i & 7);
            ((LAS float*)(L + RGL_CST))[e] = kind == 0 ? A.in[I_RGBR][c] : (kind == 1 ? A.in[I_RGBI][c] : sc[SC_RGL + c]); }
        if (!SAMPLE && jh == 0 && F.tid < 192) { const int k = F.tid >> 6, ch = F.tid & 63;
            F.out[O_CONVP + (size_t)(b * 3 + k) * WA + hd * 64 + ch] = bf2f(((const bf16*)(F.ws + WS_Z))[(size_t)(b * TP + TP - 3 + k) * NZ + WA + hd * 64 + ch]); }
        if (SAMPLE && jh == 0) { for (int e = F.tid; e < NBS * 3 * 64; e += NWAVES * 64) { const int bb = e / 192, k = (e / 64) % 3, ch = e & 63;
            F.out[O_CONVS + (size_t)(bb * 3 + k) * WA + hd * 64 + ch] = bf2f(((const bf16*)(F.ws + WS_Z))[(size_t)(MP + bb * TS + 1 + k) * NZ + WA + hd * 64 + ch]); } }
        if (!SAMPLE) { v4u st[7]; stage_load(0, st); stage_write(0, st); }
    }
    __syncthreads();
    float hround[16];
#pragma unroll
    for (int i = 0; i < 16; ++i) hround[i] = 0.f;
    const LAS float* CWT = (const LAS float*)(L + RGL_CWT) + hh * 160;
#pragma unroll 1
    for (int rd = 0; rd < (SAMPLE ? 2 : 8); ++rd) {
        const int t = rd * 256 + w * 32 + q;
        v4u stn[7];
        if (!SAMPLE) stage_load((rd + 1) * 256, stn);
        const LAS unsigned char* XAp = L + RGL_XA0 + (rd & 1) * RGL_BUF + (w * 32 + q) * RGL_XAP + 16 * hh;
        const LAS unsigned char* GTp = L + RGL_GT0 + (rd & 1) * RGL_BUF + (w * 32 + q) * RGL_GTP + 16 * hh;
        const bf16* zsr[4];
        if (SAMPLE) {
#pragma unroll
            for (int k = 0; k < 4; ++k) { const int jx = (t & 3) + k; zsr[k] = (jx < 3 ? CB + (size_t)((t >> 2) * 3 + jx) * WA : Zb + (size_t)(t - 3 + k) * NZ + WA) + hd * 64 + 8 * hh; } }
        v4u g0, g1;
        if (SAMPLE) { const bf16* gr = Zb + (size_t)t * NZ + hd * 64 + 32 * jh + 8 * hh; g0 = *(const v4u*)gr; g1 = *(const v4u*)(gr + 16); }
        else { g0 = *(const LAS v4u*)GTp; g1 = *(const LAS v4u*)(GTp + 32); }
        float xc[32];
#pragma unroll
        for (int s4 = 0; s4 < 4; ++s4) {
            float acc[8];
#pragma unroll
            for (int j4 = 0; j4 < 2; ++j4) { const f32x4 cb = *(const LAS f32x4*)(CWT + 4 * 32 + s4 * 8 + 4 * j4); acc[4 * j4] = cb[0]; acc[4 * j4 + 1] = cb[1]; acc[4 * j4 + 2] = cb[2]; acc[4 * j4 + 3] = cb[3]; }
#pragma unroll
            for (int k = 0; k < 4; ++k) { const v4u v = SAMPLE ? *(const v4u*)(zsr[k] + 16 * s4) : *(const LAS v4u*)(XAp + k * RGL_XAP + s4 * 32);
                const f32x4 w0 = *(const LAS f32x4*)(CWT + k * 32 + s4 * 8), w1 = *(const LAS f32x4*)(CWT + k * 32 + s4 * 8 + 4);
                acc[0] += w0[0] * pg8::bf_lo(v.x); acc[1] += w0[1] * pg8::bf_hi(v.x); acc[2] += w0[2] * pg8::bf_lo(v.y); acc[3] += w0[3] * pg8::bf_hi(v.y);
                acc[4] += w1[0] * pg8::bf_lo(v.z); acc[5] += w1[1] * pg8::bf_hi(v.z); acc[6] += w1[2] * pg8::bf_lo(v.w); acc[7] += w1[3] * pg8::bf_hi(v.w); }
#pragma unroll
            for (int e = 0; e < 8; ++e) xc[s4 * 8 + e] = acc[e];
            asm volatile("" : "+v"(xc[s4 * 8]), "+v"(xc[s4 * 8 + 7]) :: "memory");
        }
        f32x16 dr, di;
#pragma unroll
        for (int i = 0; i < 16; ++i) { dr[i] = 0.f; di[i] = 0.f; }
        const LAS bf16x8v* af = (const LAS bf16x8v*)(L + RGL_AFR) + lane;
#pragma unroll
        for (int s4 = 0; s4 < 4; ++s4) { v4u p; p.x = pkbf(xc[s4 * 8], xc[s4 * 8 + 1]); p.y = pkbf(xc[s4 * 8 + 2], xc[s4 * 8 + 3]); p.z = pkbf(xc[s4 * 8 + 4], xc[s4 * 8 + 5]); p.w = pkbf(xc[s4 * 8 + 6], xc[s4 * 8 + 7]);
            const bf16x8v bfr = __builtin_bit_cast(bf16x8v, p);
            dr = MFMA32(af[s4 * 64], bfr, dr); di = MFMA32(af[(4 + s4) * 64], bfr, di); }
        f32x16 av, bv;
        const bool first = !SAMPLE && (t == 0);
        const LAS float* CST = (const LAS float*)(L + RGL_CST) + hh * 48;
#pragma unroll
        for (int i = 0; i < 16; ++i) { const float xcv = jh ? xc[16 + i] : xc[i];
            const float r = sigmoidf_(dr[i] + CST[i]), gi = sigmoidf_(di[i] + CST[16 + i]);
            const float a = __builtin_amdgcn_exp2f(r * CST[32 + i]);
            float mult = __builtin_amdgcn_sqrtf(fmaxf(1.f - a * a, 0.f)); if (first) mult = 1.f;
            av[i] = a; bv[i] = mult * gi * xcv; }
        if (SAMPLE && (t & 3) == 0) {
            const float* h0 = A.in[I_SH] + (size_t)(t >> 2) * WA + hd * 64 + 32 * jh + 8 * hh;
#pragma unroll
            for (int i = 0; i < 16; ++i) { bv[i] += av[i] * h0[16 * (i >> 3) + (i & 7)]; av[i] = 0.f; } }
        rg_scan_step<0x111, 0xF>(av, bv); rg_scan_step<0x112, 0xF>(av, bv); rg_scan_step<0x114, 0xF>(av, bv); rg_scan_step<0x118, 0xF>(av, bv);
        rg_scan_step<0x142, 0xA>(av, bv);
        float hin[16];
#pragma unroll
        for (int i = 0; i < 16; ++i) hin[i] = 0.f;
        if (!SAMPLE) {
        LAS float* TOT = (LAS float*)(L + RGL_TOT) + (rd & 1) * 512;
        if (q == 31) {
#pragma unroll
            for (int i4 = 0; i4 < 4; ++i4) { *(LAS f32x4*)(TOT + (w * 2 + 0) * 32 + hh * 16 + 4 * i4) = (f32x4){av[4 * i4], av[4 * i4 + 1], av[4 * i4 + 2], av[4 * i4 + 3]};
                                             *(LAS f32x4*)(TOT + (w * 2 + 1) * 32 + hh * 16 + 4 * i4) = (f32x4){bv[4 * i4], bv[4 * i4 + 1], bv[4 * i4 + 2], bv[4 * i4 + 3]}; }
        }
        stage_write((rd + 1) & 1, stn);
        __syncthreads();
#pragma unroll
        for (int w2 = 0; w2 < 8; ++w2) {
            if (w2 == w) {
#pragma unroll
                for (int i = 0; i < 16; ++i) hin[i] = hround[i]; }
#pragma unroll
            for (int i4 = 0; i4 < 4; ++i4) { const f32x4 p = *(const LAS f32x4*)(TOT + (w2 * 2 + 0) * 32 + hh * 16 + 4 * i4), hl = *(const LAS f32x4*)(TOT + (w2 * 2 + 1) * 32 + hh * 16 + 4 * i4);
#pragma unroll
                for (int e = 0; e < 4; ++e) hround[4 * i4 + e] = p[e] * hround[4 * i4 + e] + hl[e]; }
        }
        }
        float o[16];
        const unsigned gw_[8] = {g0.x, g0.y, g0.z, g0.w, g1.x, g1.y, g1.z, g1.w};
#pragma unroll
        for (int i = 0; i < 16; ++i) { const float h = bv[i] + av[i] * hin[i]; const float gt = (i & 1) ? pg8::bf_hi(gw_[i >> 1]) : pg8::bf_lo(gw_[i >> 1]); o[i] = gelu_tanh(gt) * h; }
        bf16* yr = Yb + (size_t)t * D + hd * 64 + 32 * jh + 8 * hh;
        v4u w0; w0.x = pkbf(o[0], o[1]); w0.y = pkbf(o[2], o[3]); w0.z = pkbf(o[4], o[5]); w0.w = pkbf(o[6], o[7]);
        v4u w1; w1.x = pkbf(o[8], o[9]); w1.y = pkbf(o[10], o[11]); w1.z = pkbf(o[12], o[13]); w1.w = pkbf(o[14], o[15]);
        *(v4u*)yr = w0; *(v4u*)(yr + 16) = w1;
        if (SAMPLE && (t & 3) == 3) {
#pragma unroll
            for (int i = 0; i < 16; ++i) F.out[O_HS + (size_t)(t >> 2) * WA + hd * 64 + 32 * jh + 16 * (i >> 3) + 8 * hh + (i & 7)] = bv[i]; }
    }
    if (!SAMPLE && w == 0 && q == 0) {
#pragma unroll
        for (int i = 0; i < 16; ++i) F.out[O_HP + (size_t)b * WA + hd * 64 + 32 * jh + 16 * (i >> 3) + 8 * hh + (i & 7)] = hround[i];
    }
    __syncthreads();
}

#ifndef PROBE_P3PART
#define PROBE_P3PART 7
#endif
__device__ __forceinline__ void p3_mixers_ref(Frame& F, const Args& A, int rep = 0) {
    constexpr int N_RGP = NBP * HA, N_S5P = NBP * GB;
    const int pm = rep ? PROBE_P3PART : 7;
    if (F.vcu < 2 * N_RGP) {
        if (pm & 1) rg_item_fast<false>(F, A, F.vcu / (2 * HA), (F.vcu / 2) % HA, F.vcu & 1);
    } else {
        const int v = F.vcu - 2 * N_RGP, it = 2 * v;
        if (pm & 2) { s5_item_fast(F, A, it / GB, it % GB);
                      s5_item_fast(F, A, (it + 1) / GB, (it + 1) % GB); }
        if (pm & 4) { if (v < GB) s5_item_sample(F, A, v);
                      else if (v < GB + 2 * HA) rg_item_fast<true>(F, A, 0, (v - GB) >> 1, (v - GB) & 1); }
    }
}

__global__ void __launch_bounds__(NWAVES * 64, 2) fwd(Args A) {
    extern __shared__ __attribute__((aligned(16))) unsigned char lds[];
    Frame F;
    F.lds = (LAS unsigned char*)lds;
    F.MISC = (volatile LAS unsigned*)(F.lds + MISC_OFF);
    F.tid = threadIdx.x; F.lane = F.tid & 63; F.wave = __builtin_amdgcn_readfirstlane(F.tid >> 6);
    F.G = gridDim.x; { const int bx = blockIdx.x; F.vcu = (F.G % 8 == 0) ? (bx % 8) * (F.G / 8) + bx / 8 : bx; }
    F.out = A.out; F.ws = A.ws; F.ctl = (gu32*)(A.ws + WS_CTL);
    for (int u = F.tid; u < (LDS_BYTES - LDSCTL_OFF) / 4; u += NWAVES * 64) ((LAS unsigned*)(F.lds + LDSCTL_OFF))[u] = 0u;
    __syncthreads();
    XcdBarrier bar; bar.bar = (unsigned*)(F.ctl + CW_BAR); bar.x = 0; bar.st = nullptr;
    if (N_LAUNCHES == 1) bar = xcd_barrier_post((unsigned*)(F.ctl + CW_BAR), F.MISC + 8);
#define GRID_BAR() do { if (N_LAUNCHES == 1) xcd_barrier(bar); } while (0)
    const int lo = A.ph_lo, hi = A.ph_hi;
#define IN(k) (lo <= (k) && (k) < hi)
#define BOTH(k) (IN(k) && IN((k) + 1))
    bf16* XN = (bf16*)(F.ws + WS_XN); bf16* Z = (bf16*)(F.ws + WS_Z); bf16* YC = (bf16*)(F.ws + WS_YCAT); bf16* GY = (bf16*)(F.ws + WS_G); bf16* U = (bf16*)(F.ws + WS_U);
    const float* mod = (const float*)(F.ws + WS_MOD);

#define REPS(k) (((PROBE_DUP) >> (k)) & 1 ? 2 : 1)
    if (IN(0)) { for (int rep = 0; rep < REPS(0); ++rep) p0_prologue(F, A, rep); if (BOTH(0)) GRID_BAR(); }
    if (IN(1)) { for (int rep = 0; rep < REPS(1); ++rep) p1_modulate(F, A); if (BOTH(1)) GRID_BAR(); }
    if (IN(2)) for (int rep = 0; rep < REPS(2); ++rep) {
        pg8::Gemm g{XN, (const bf16*)(F.ws + WS_WIN), M, NZ, D}; pg8::StaticOrder S; S.init(M, NZ, F.G, (int)blockIdx.x, D);
        pg8::EpiBf16<0> E{Z, NZ, nullptr};
        pg8::gemm_phase<pg8::EpiBf16<0>, pg8::StaticOrder, PG8_ALIGN, PG8_SP2>(F.lds + RING_OFF, g, S, E);
        if (BOTH(2) && rep == REPS(2) - 1) GRID_BAR();
    }
    if (IN(3)) {
#pragma unroll 1
        for (int rep = 0; rep < REPS(3); ++rep) p3_mixers_ref(F, A, rep);
        if (BOTH(3)) GRID_BAR(); }
    if (IN(4)) for (int rep = 0; rep < REPS(4); ++rep) {
        pg8::Gemm g{GY, (const bf16*)(F.ws + WS_WGLU), M, WB, WB}; pg8::StaticOrder S; S.init(M, WB, F.G, (int)blockIdx.x, WB);
        pg8::EpiGlu E{GY, WB, YC, D, WA, A.in[I_GLUB]};
        pg8::gemm_phase<pg8::EpiGlu, pg8::StaticOrder, PG8_ALIGN, PG8_SP2>(F.lds + RING_OFF, g, S, E);
        if (BOTH(4) && rep == REPS(4) - 1) GRID_BAR();
    }
    if (IN(5)) {
        pg8::Gemm g{YC, (const bf16*)(F.ws + WS_WOUT), M, D, D}; pg8::SplitOrder S; S.init(MP, D, F.G, (int)blockIdx.x, D, NS_OUT);
        pg8::EpiRes E{A.in[I_XP], A.in[I_XS], F.out, mod + 2 * D, nullptr, ALPHA, MP, (float*)(F.ws + WS_SLAB)};
        pg8::gemm_phase<pg8::EpiRes, pg8::SplitOrder, PG8_ALIGN, PG8_SP2>(F.lds + RING_OFF, g, S, E);
        if (BOTH(5)) GRID_BAR();
    }
    if (IN(6)) { ln_rows<false>(F, A); if (BOTH(6)) GRID_BAR(); }
    if (IN(7)) for (int rep = 0; rep < REPS(7); ++rep) {
        pg8::Gemm g{XN, (const bf16*)(F.ws + WS_W1), M, FF, D}; pg8::StaticOrder S; S.init(M, FF, F.G, (int)blockIdx.x, D);
        pg8::EpiBf16<3> E{U, FF, A.in[I_B1]};
        pg8::gemm_phase<pg8::EpiBf16<3>, pg8::StaticOrder, PG8_ALIGN, PG8_SP2>(F.lds + RING_OFF, g, S, E);
        if (BOTH(7) && rep == REPS(7) - 1) GRID_BAR();
    }
    if (IN(8)) {
        pg8::Gemm g{U, (const bf16*)(F.ws + WS_W2), M, D, FF}; pg8::SplitOrder S; S.init(MP, D, F.G, (int)blockIdx.x, FF, NS_DOWN);
        pg8::EpiRes E{F.out, F.out + (size_t)MP * D, F.out, mod + 5 * D, A.in[I_B2], ALPHA, MP, (float*)(F.ws + WS_SLAB)};
        pg8::gemm_phase<pg8::EpiRes, pg8::SplitOrder, PG8_ALIGN, PG8_SP2>(F.lds + RING_OFF, g, S, E);
        if (BOTH(8)) GRID_BAR();
    }
    if (IN(9)) { ln_rows<true>(F, A); }
#undef IN
#undef BOTH
}

extern "C" void kernel_launch(void* const* d_in, const int* in_sizes, int n_in, void* d_out, int out_size, void* d_ws, size_t ws_size, hipStream_t stream) {
    static int grid = 0;
    if (grid == 0) {
        if (n_in != 37 || in_sizes[0] != MP * D || out_size != (int)O_END || ws_size < WS_END) { fprintf(stderr, "kernel_launch: unexpected shapes (n_in %d, in0 %d, out %d, ws %zu)\n", n_in, n_in > 0 ? in_sizes[0] : -1, out_size, ws_size); grid = -1; return; }
        int dev = 0, cus = 0, per_cu = 0;
        if (hipGetDevice(&dev) != hipSuccess || hipDeviceGetAttribute(&cus, hipDeviceAttributeMultiprocessorCount, dev) != hipSuccess) { grid = -1; return; }
        if (hipFuncSetAttribute((const void*)fwd, hipFuncAttributeMaxDynamicSharedMemorySize, LDS_BYTES) != hipSuccess) { fprintf(stderr, "kernel_launch: hipFuncSetAttribute failed\n"); grid = -1; return; }
        if (hipOccupancyMaxActiveBlocksPerMultiprocessor(&per_cu, (const void*)fwd, NWAVES * 64, LDS_BYTES) != hipSuccess || per_cu < 1) { fprintf(stderr, "kernel_launch: occupancy query says %d\n", per_cu); }
        (void)hipGetLastError();
        grid = cus;
        if (grid < 256) { fprintf(stderr, "kernel_launch: this build needs 256 CUs (got %d)\n", grid); grid = -1; return; }
        grid = 256;
    }
    if (grid < 0) return;
    (void)hipMemsetAsync((char*)d_ws + WS_CTL, 0, CTL_ZERO_BYTES, stream);
    Args a{};
    for (int i = 0; i < 37; ++i) a.in[i] = (const float*)d_in[i];
    a.out = (float*)d_out; a.ws = (unsigned char*)d_ws;
    for (int li = 0; li < N_LAUNCHES; ++li) {
        if (N_LAUNCHES == 1) { a.ph_lo = 0; a.ph_hi = N_PHASES; } else { a.ph_lo = li; a.ph_hi = li + 1; }
        a.li = li;
        hipLaunchKernelGGL(fwd, dim3(grid), dim3(NWAVES * 64), LDS_BYTES, stream, a);
    }
}
```

```cpp
#include <hip/hip_runtime.h>
#include <cstdio>
#include <cstdint>
#include <cmath>

#ifndef MK_N_LAUNCHES
#define MK_N_LAUNCHES 1
#endif

namespace pg8 {
#define PG8_LAS __attribute__((address_space(3)))
typedef unsigned short bf16_t;
typedef short bf16x8 __attribute__((ext_vector_type(8)));
typedef float f32x4 __attribute__((ext_vector_type(4)));
typedef unsigned u32x4 __attribute__((ext_vector_type(4)));
constexpr int BM = 256, BK = 64, HALF = 128, HTB = HALF * BK * 2, STAGE_BYTES = 8 * HTB, NXCD = 8, WGM = 8;

__host__ __device__ __forceinline__ int lds_byte(int r, int c) { const int st = (r >> 4) * 2 + (c >> 5), rr = r & 15, cc = c & 31, ob = rr * 64 + cc * 2; return st * 1024 + (ob ^ (((ob >> 9) & 1) << 5)); }
__host__ __device__ __forceinline__ void stage_rc(int b, int& R, int& C) { const int st = b / 1024, sb = b % 1024, swz = sb ^ (((sb >> 9) & 1) << 5); R = (st >> 1) * 16 + swz / 64; C = (st & 1) * 32 + (swz % 64) / 2; }
__host__ __device__ __forceinline__ int perm32(int rho) { const int n = rho >> 4, i = rho & 15; return 8 * (i >> 2) + 4 * n + (i & 3); }

struct Unit { int pm, pn, k0, nkt, ks; };
struct Gemm { const bf16_t* A; const bf16_t* Bt; int M, N, K; };

struct StaticOrder {
    int nM, nN, nwg, G, c, K;
    __host__ __device__ void init(int M, int N, int G_, int c_, int K_) { nM = M / BM; nN = N / BM; nwg = nM * nN; G = G_; c = c_; K = K_; }
    __host__ __device__ __forceinline__ bool next(int i, Unit& u) const {
        const long L = (long)i * G + c; if (L >= nwg) return false;
        int wgid = (int)L; { const int q = nwg / NXCD, r = nwg % NXCD, xcd = wgid % NXCD, off = wgid / NXCD; wgid = (xcd < r ? xcd * (q + 1) : r * (q + 1) + (xcd - r) * q) + off; }
        const int nig = WGM * nN, gid = wgid / nig, fm = gid * WGM, gsz = (nM - fm) < WGM ? (nM - fm) : WGM;
        u.pm = fm + ((wgid % nig) % gsz); u.pn = (wgid % nig) / gsz; u.k0 = 0; u.nkt = K / BK; u.ks = 0; return true;
    }
    __device__ __forceinline__ void a_ready(const Unit&) const {}
    __device__ __forceinline__ void done(const Unit&) const {}
};

struct SplitOrder {
    StaticOrder P; int nN, NS, nP, G, c, K, r0;
    __host__ __device__ void init(int MPr, int N, int G_, int c_, int K_, int NS_) { P.init(MPr, N, G_, c_, K_); nN = N / BM; NS = NS_; nP = 2 * nN * NS; G = G_; c = c_; K = K_; r0 = (P.nwg + G - 1 - c) / G;   }
    __host__ __device__ __forceinline__ bool next(int i, Unit& u) const {
        Unit a; a.pm = 0; a.pn = 0; a.k0 = 0; a.nkt = K / BK; a.ks = 0;
        const bool okp = P.next(i < r0 ? i : 0, a);
        const int p = (i - r0) * G + (G - 1 - c), t = p / NS, ks = p % NS, nk = K / BK / NS;
        const bool split = i >= r0;
        u.pm = split ? P.nM + t / nN : a.pm; u.pn = split ? t % nN : a.pn; u.nkt = split ? nk : a.nkt; u.ks = split ? ks : 0; u.k0 = split ? ks * nk * BK : 0;
        return split ? (p < nP) : okp;
    }
    __device__ __forceinline__ void a_ready(const Unit&) const {}
    __device__ __forceinline__ void done(const Unit&) const {}
};

__device__ __forceinline__ unsigned cvt_pk_bf16(float lo, float hi) { unsigned r; asm volatile("v_cvt_pk_bf16_f32 %0, %1, %2" : "=v"(r) : "v"(lo), "v"(hi)); return r; }
__device__ __forceinline__ float bf_lo(unsigned w) { return __builtin_bit_cast(float, w << 16); }
__device__ __forceinline__ float bf_hi(unsigned w) { return __builtin_bit_cast(float, w & 0xffff0000u); }

template <int ACT> struct EpiBf16 {
    static constexpr bool PERM = true, AFTER_DRAIN = false;
    bf16_t* O; int ldc; const float* bias;
    __device__ __forceinline__ void operator()(const f32x4 (&acc)[2][2][4][2], const Unit& u, int wr, int wc, int fr, int fq) const {
        const int row0 = u.pm * BM + wr * 64 + fr; const int col0 = u.pn * BM + wc * 32 + 8 * fq;
        f32x4 bv[2][2];
#pragma unroll
        for (int bj = 0; bj < 2; ++bj)
#pragma unroll
            for (int n = 0; n < 2; ++n) bv[bj][n] = bias ? *(const f32x4*)(bias + col0 + bj * HALF + 4 * n) : (f32x4){0.f, 0.f, 0.f, 0.f};
#pragma unroll
        for (int ai = 0; ai < 2; ++ai)
#pragma unroll
            for (int m = 0; m < 4; ++m) { bf16_t* rowp = O + (size_t)(row0 + ai * HALF + m * 16) * ldc + col0;
#pragma unroll
                for (int bj = 0; bj < 2; ++bj) { f32x4 v0 = acc[ai][bj][m][0] + bv[bj][0], v1 = acc[ai][bj][m][1] + bv[bj][1];
                    if (ACT == 3) {
#pragma unroll
                        for (int e = 0; e < 4; ++e) { const float a = fmaxf(v0[e], 0.f), b = fmaxf(v1[e], 0.f); v0[e] = a * a; v1[e] = b * b; } }
                    u32x4 w; w.x = cvt_pk_bf16(v0[0], v0[1]); w.y = cvt_pk_bf16(v0[2], v0[3]); w.z = cvt_pk_bf16(v1[0], v1[1]); w.w = cvt_pk_bf16(v1[2], v1[3]);
                    *(u32x4*)(rowp + bj * HALF) = w; } }
    }
};
struct EpiGlu {
    static constexpr bool PERM = true, AFTER_DRAIN = false;
    const bf16_t* Gy; int ldg; bf16_t* O; int ldc; int coff; const float* bias;
    __device__ __forceinline__ void operator()(const f32x4 (&acc)[2][2][4][2], const Unit& u, int wr, int wc, int fr, int fq) const {
        const int row0 = u.pm * BM + wr * 64 + fr; const int col0 = u.pn * BM + wc * 32 + 8 * fq;
        f32x4 bv[2][2];
#pragma unroll
        for (int bj = 0; bj < 2; ++bj)
#pragma unroll
            for (int n = 0; n < 2; ++n) bv[bj][n] = *(const f32x4*)(bias + col0 + bj * HALF + 4 * n);
#pragma unroll
        for (int ai = 0; ai < 2; ++ai)
#pragma unroll
            for (int m = 0; m < 4; ++m) { const size_t row = (size_t)(row0 + ai * HALF + m * 16);
#pragma unroll
                for (int bj = 0; bj < 2; ++bj) { const f32x4 v0 = acc[ai][bj][m][0] + bv[bj][0], v1 = acc[ai][bj][m][1] + bv[bj][1];
                    const u32x4 g = *(const u32x4*)(Gy + row * ldg + col0 + bj * HALF);
                    float o[8];
                    o[0] = bf_lo(g.x) * __builtin_amdgcn_rcpf(1.f + __builtin_amdgcn_exp2f(-1.4426950408889634f * v0[0])); o[1] = bf_hi(g.x) * __builtin_amdgcn_rcpf(1.f + __builtin_amdgcn_exp2f(-1.4426950408889634f * v0[1]));
                    o[2] = bf_lo(g.y) * __builtin_amdgcn_rcpf(1.f + __builtin_amdgcn_exp2f(-1.4426950408889634f * v0[2])); o[3] = bf_hi(g.y) * __builtin_amdgcn_rcpf(1.f + __builtin_amdgcn_exp2f(-1.4426950408889634f * v0[3]));
                    o[4] = bf_lo(g.z) * __builtin_amdgcn_rcpf(1.f + __builtin_amdgcn_exp2f(-1.4426950408889634f * v1[0])); o[5] = bf_hi(g.z) * __builtin_amdgcn_rcpf(1.f + __builtin_amdgcn_exp2f(-1.4426950408889634f * v1[1]));
                    o[6] = bf_lo(g.w) * __builtin_amdgcn_rcpf(1.f + __builtin_amdgcn_exp2f(-1.4426950408889634f * v1[2])); o[7] = bf_hi(g.w) * __builtin_amdgcn_rcpf(1.f + __builtin_amdgcn_exp2f(-1.4426950408889634f * v1[3]));
                    u32x4 w; w.x = cvt_pk_bf16(o[0], o[1]); w.y = cvt_pk_bf16(o[2], o[3]); w.z = cvt_pk_bf16(o[4], o[5]); w.w = cvt_pk_bf16(o[6], o[7]);
                    *(u32x4*)(O + row * ldc + coff + col0 + bj * HALF) = w; } }
    }
};
struct EpiRes {
    static constexpr bool PERM = false, AFTER_DRAIN = false;
    const float* basep; const float* bases; float* out; const float* gate  ; const float* bias; float alpha; int MP; float* slab  ;
    __device__ __forceinline__ void operator()(const f32x4 (&acc)[2][2][4][2], const Unit& u, int wr, int wc, int fr, int fq) const {
        const int row0 = u.pm * BM + wr * 64 + fr, col0 = u.pn * BM + wc * 32 + 4 * fq;
        if (slab && row0 >= MP) {
            float* sp = slab + (size_t)u.ks * 512 * 1024;
#pragma unroll
            for (int ai = 0; ai < 2; ++ai)
#pragma unroll
                for (int m = 0; m < 4; ++m) { float* op = sp + (size_t)(row0 + ai * HALF + m * 16 - MP) * 1024;
#pragma unroll
                    for (int bj = 0; bj < 2; ++bj)
#pragma unroll
                        for (int n = 0; n < 2; ++n) *(f32x4*)(op + col0 + bj * HALF + n * 16) = acc[ai][bj][m][n]; }
            return; }
        f32x4 bv[2][2];
#pragma unroll
        for (int bj = 0; bj < 2; ++bj)
#pragma unroll
            for (int n = 0; n < 2; ++n) bv[bj][n] = bias ? *(const f32x4*)(bias + col0 + bj * HALF + n * 16) : (f32x4){0.f, 0.f, 0.f, 0.f};
#pragma unroll
        for (int ai = 0; ai < 2; ++ai)
#pragma unroll
            for (int m = 0; m < 4; ++m) { const int row = row0 + ai * HALF + m * 16;
                const bool smp = row >= MP; const int mr = smp ? 8 + ((row - MP) >> 2) : (row >> 11);
                const float* bp = smp ? bases + (size_t)(row - MP) * 1024 : basep + (size_t)row * 1024;
                const float* gp = gate + (size_t)mr * 6144; float* op = out + (size_t)row * 1024;
#pragma unroll
                for (int bj = 0; bj < 2; ++bj)
#pragma unroll
                    for (int n = 0; n < 2; ++n) { const int c = col0 + bj * HALF + n * 16;
                        const f32x4 b = *(const f32x4*)(bp + c), g = *(const f32x4*)(gp + c);
                        *(f32x4*)(op + c) = b * alpha + g * (acc[ai][bj][m][n] + bv[bj][n]); } }
    }
};

template <class Epi, class Sched, bool ALIGN_EPI = false, bool SP2 = false>
__device__ __forceinline__ void gemm_phase(PG8_LAS unsigned char* lds, const Gemm g, const Sched& S, const Epi& E) {
    const int tid = threadIdx.x, wid = __builtin_amdgcn_readfirstlane(tid >> 6), lane = tid & 63, wr = wid >> 2, wc = wid & 3, fr = lane & 15, fq = lane >> 4;
    const int K = g.K;
    unsigned voffA[2], voffB[2];
#pragma unroll
    for (int i = 0; i < 2; ++i) { int R, C; stage_rc(tid * 16 + i * 8192, R, C); const int Rb = Epi::PERM ? ((R & ~31) + perm32(R & 31)) : R;
        voffA[i] = (unsigned)(R * K + C) * 2u; voffB[i] = (unsigned)(Rb * K + C) * 2u; }
    const size_t kstep = (size_t)(BK * 2);
    const size_t hstep = (size_t)HALF * K * 2;
    const size_t tstep = 2 * hstep;
    const unsigned ldsw = (unsigned)wid * 1024u;
    const int aoff = lds_byte(wr * 64 + fr, fq * 8), boff = lds_byte(wc * 32 + fr, fq * 8);
#define PG8_SA(b, h) (((b) * 2 + (h)) * HTB)
#define PG8_SB(b, h) ((4 + (b) * 2 + (h)) * HTB)
#define PG8_STAGE(bufoff, gbase, voff) do { _Pragma("unroll") for (int _i = 0; _i < 2; ++_i) \
        __builtin_amdgcn_global_load_lds((const unsigned*)((const char*)(gbase) + (voff)[_i]), (PG8_LAS unsigned*)(lds + (bufoff) + ldsw + _i * 8192), 16, 0, 0); } while (0)
#define PG8_LDA(dst, b, h) do { _Pragma("unroll") for (int m = 0; m < 4; ++m) _Pragma("unroll") for (int k = 0; k < 2; ++k) dst[m][k] = *(const PG8_LAS bf16x8*)(lds + PG8_SA(b, h) + aoff + m * 2048 + k * 1024); } while (0)
#define PG8_LDB(dst, b, h) do { _Pragma("unroll") for (int n = 0; n < 2; ++n) _Pragma("unroll") for (int k = 0; k < 2; ++k) dst[n][k] = *(const PG8_LAS bf16x8*)(lds + PG8_SB(b, h) + boff + n * 2048 + k * 1024); } while (0)
#define PG8_MMA(ai, bj, At, Bt) do { __builtin_amdgcn_s_setprio(1); _Pragma("unroll") for (int m = 0; m < 4; ++m) _Pragma("unroll") for (int n = 0; n < 2; ++n) _Pragma("unroll") for (int k = 0; k < 2; ++k) \
        acc[ai][bj][m][n] = __builtin_amdgcn_mfma_f32_16x16x32_bf16(Bt[n][k], At[m][k], acc[ai][bj][m][n], 0, 0, 0); __builtin_amdgcn_s_setprio(0); } while (0)
#define PG8_WAIT_V(n) asm volatile("s_waitcnt vmcnt(" #n ")" ::: "memory")
#define PG8_WAIT_L(n) asm volatile("s_waitcnt lgkmcnt(" #n ")" ::: "memory")
#define PG8_BAR __builtin_amdgcn_s_barrier()
#define PG8_SCHED __builtin_amdgcn_sched_barrier(0)
    Unit cur, nxt; int ui = 0;
    if (!S.next(0, cur)) return;
    f32x4 acc[2][2][4][2];
#pragma unroll
    for (int a = 0; a < 2; ++a)
#pragma unroll
        for (int b = 0; b < 2; ++b)
#pragma unroll
            for (int m = 0; m < 4; ++m)
#pragma unroll
                for (int n = 0; n < 2; ++n) acc[a][b][m][n] = (f32x4){0.f, 0.f, 0.f, 0.f};
    bf16x8 At[4][2], B0[2][2], B1[2][2];
    const char* cA = (const char*)g.A + (size_t)cur.pm * tstep + (size_t)cur.k0 * 2; const char* cB = (const char*)g.Bt + (size_t)cur.pn * tstep + (size_t)cur.k0 * 2;
    S.a_ready(cur);
    if constexpr (SP2) {
        PG8_STAGE(PG8_SB(0, 0), cB, voffB); PG8_STAGE(PG8_SB(0, 1), cB + hstep, voffB); PG8_STAGE(PG8_SA(0, 0), cA, voffA); PG8_STAGE(PG8_SA(0, 1), cA + hstep, voffA);
        if (wr == 1) PG8_BAR;
        PG8_WAIT_V(2); PG8_BAR;
        PG8_STAGE(PG8_SB(1, 0), cB + kstep, voffB); PG8_STAGE(PG8_SA(1, 0), cA + kstep, voffA); PG8_STAGE(PG8_SB(1, 1), cB + hstep + kstep, voffB);
        PG8_WAIT_V(6); PG8_BAR;
    } else {
        PG8_STAGE(PG8_SB(0, 0), cB, voffB); PG8_STAGE(PG8_SA(0, 0), cA, voffA); PG8_STAGE(PG8_SB(0, 1), cB + hstep, voffB); PG8_STAGE(PG8_SA(0, 1), cA + hstep, voffA);
        if (wr == 1) PG8_BAR;
        PG8_WAIT_V(4); PG8_BAR;
        PG8_STAGE(PG8_SB(1, 0), cB + kstep, voffB); PG8_STAGE(PG8_SA(1, 0), cA + kstep, voffA); PG8_STAGE(PG8_SB(1, 1), cB + hstep + kstep, voffB);
        PG8_WAIT_V(6); PG8_BAR;
    }
    for (;;) {
        const bool has_next = S.next(ui + 1, nxt);
        const char* nA = has_next ? (const char*)g.A + (size_t)nxt.pm * tstep + (size_t)nxt.k0 * 2 : cA; const char* nB = has_next ? (const char*)g.Bt + (size_t)nxt.pn * tstep + (size_t)nxt.k0 * 2 : cB;
        const int nt = cur.nkt;
        for (int t = 0; t < nt; t += 2) {
            const bool last = (t == nt - 2);
            const char* a1 = cA + (size_t)(t + 1) * kstep;
            const char* a2 = last ? nA : cA + (size_t)(t + 2) * kstep; const char* b2 = last ? nB : cB + (size_t)(t + 2) * kstep;
            const char* a3 = a2 + kstep; const char* b3 = b2 + kstep;
            if (last && has_next) S.a_ready(nxt);
            if constexpr (SP2) {
            PG8_LDB(B0, 0, 0); PG8_LDB(B1, 0, 1); PG8_SCHED; PG8_LDA(At, 0, 0); PG8_STAGE(PG8_SA(1, 1), a1 + hstep, voffA);
            PG8_WAIT_V(8); PG8_WAIT_L(0); PG8_BAR; PG8_MMA(0, 0, At, B0); PG8_MMA(0, 1, At, B1); PG8_BAR; PG8_SCHED;
            PG8_LDA(At, 0, 1); PG8_STAGE(PG8_SB(0, 0), b2, voffB); PG8_STAGE(PG8_SB(0, 1), b2 + hstep, voffB); PG8_STAGE(PG8_SA(0, 0), a2, voffA);
            PG8_WAIT_V(8); PG8_WAIT_L(0); PG8_BAR; PG8_MMA(1, 0, At, B0); PG8_MMA(1, 1, At, B1); PG8_BAR; PG8_SCHED;
            PG8_LDB(B0, 1, 0); PG8_LDB(B1, 1, 1); PG8_SCHED; PG8_LDA(At, 1, 0); PG8_STAGE(PG8_SA(0, 1), a2 + hstep, voffA);
            PG8_WAIT_V(8); PG8_WAIT_L(0); PG8_BAR; PG8_MMA(0, 0, At, B0); PG8_MMA(0, 1, At, B1); PG8_BAR; PG8_SCHED;
            PG8_LDA(At, 1, 1); PG8_STAGE(PG8_SB(1, 0), b3, voffB); PG8_STAGE(PG8_SB(1, 1), b3 + hstep, voffB); PG8_STAGE(PG8_SA(1, 0), a3, voffA);
            PG8_WAIT_V(8); PG8_WAIT_L(0); PG8_BAR; PG8_MMA(1, 0, At, B0); PG8_MMA(1, 1, At, B1); PG8_BAR; PG8_SCHED;
            } else {
            PG8_LDB(B0, 0, 0); PG8_SCHED; PG8_LDA(At, 0, 0); PG8_STAGE(PG8_SA(1, 1), a1 + hstep, voffA);
            PG8_WAIT_L(8); PG8_BAR; PG8_WAIT_L(0); PG8_MMA(0, 0, At, B0); PG8_BAR; PG8_SCHED;
            PG8_LDB(B1, 0, 1); PG8_STAGE(PG8_SB(0, 0), b2, voffB);
            PG8_BAR; PG8_WAIT_L(0); PG8_MMA(0, 1, At, B1); PG8_BAR;
            PG8_LDA(At, 0, 1); PG8_STAGE(PG8_SA(0, 0), a2, voffA);
            PG8_BAR; PG8_WAIT_L(0); PG8_MMA(1, 0, At, B0); PG8_BAR; PG8_SCHED;
            PG8_STAGE(PG8_SB(0, 1), b2 + hstep, voffB);
            PG8_WAIT_V(6); PG8_BAR; PG8_MMA(1, 1, At, B1); PG8_BAR;
            PG8_LDB(B0, 1, 0); PG8_SCHED; PG8_LDA(At, 1, 0); PG8_STAGE(PG8_SA(0, 1), a2 + hstep, voffA);
            PG8_WAIT_L(8); PG8_BAR; PG8_WAIT_L(0); PG8_MMA(0, 0, At, B0); PG8_BAR; PG8_SCHED;
            PG8_LDB(B1, 1, 1); PG8_STAGE(PG8_SB(1, 0), b3, voffB);
            PG8_BAR; PG8_WAIT_L(0); PG8_MMA(0, 1, At, B1); PG8_BAR;
            PG8_LDA(At, 1, 1); PG8_STAGE(PG8_SA(1, 0), a3, voffA);
            PG8_BAR; PG8_WAIT_L(0); PG8_MMA(1, 0, At, B0); PG8_BAR; PG8_SCHED;
            PG8_STAGE(PG8_SB(1, 1), b3 + hstep, voffB);
            PG8_WAIT_V(6); PG8_BAR; PG8_MMA(1, 1, At, B1); PG8_BAR;
            }
        }
        if constexpr (ALIGN_EPI) { if (wr == 0) PG8_BAR; }
        if constexpr (!Epi::AFTER_DRAIN) { E(acc, cur, wr, wc, fr, fq); S.done(cur); }
        if (!has_next) break;
#pragma unroll
        for (int a = 0; a < 2; ++a)
#pragma unroll
            for (int b = 0; b < 2; ++b)
#pragma unroll
                for (int m = 0; m < 4; ++m)
#pragma unroll
                    for (int n = 0; n < 2; ++n) acc[a][b][m][n] = (f32x4){0.f, 0.f, 0.f, 0.f};
        cur = nxt; cA = nA; cB = nB; ++ui;
        if constexpr (ALIGN_EPI) { if (wr == 1) PG8_BAR; }
    }
    PG8_WAIT_V(0);
    if constexpr (!ALIGN_EPI) { if (wr == 0) PG8_BAR; }
    PG8_BAR;
#undef PG8_SA
#undef PG8_SB
#undef PG8_STAGE
#undef PG8_LDA
#undef PG8_LDB
#undef PG8_MMA
#undef PG8_WAIT_V
#undef PG8_WAIT_L
#undef PG8_BAR
#undef PG8_SCHED
}
}

#ifndef PROBE_DUP
#define PROBE_DUP 0
#endif
#ifndef PG8_SP2
#define PG8_SP2 true
#endif
#ifndef PG8_ALIGN
#define PG8_ALIGN true
#endif

constexpr int NWAVES = 8;
constexpr int N_LAUNCHES = MK_N_LAUNCHES;
constexpr int N_PHASES = 10;
constexpr int D = 1024, MP = 16384, MS = 512, M = MP + MS, TP = 2048, NBP = 8, NBS = 128, TS = 4;
constexpr int NZ = 1536, WA = 512, WB = 512, FF = 4096, NMOD = 6 * D, NROWMOD = NBP + NBS;
constexpr int GB = 32, NS5 = 64, KS5 = 16, HA = 8, HDA = 64;
constexpr float LN_EPS = 1e-5f;
constexpr int NS_OUT = 4, NS_DOWN = 8;
constexpr float ALPHA = 1.189207115002721f;

constexpr size_t O_YP = 0, O_YS = (size_t)MP * D, O_CONVP = O_YS + (size_t)MS * D, O_HP = O_CONVP + (size_t)NBP * 3 * WA, O_SRP = O_HP + (size_t)NBP * WA,
                 O_SIP = O_SRP + (size_t)NBP * GB * NS5, O_CONVS = O_SIP + (size_t)NBP * GB * NS5, O_HS = O_CONVS + (size_t)NBS * 3 * WA, O_SRS = O_HS + (size_t)NBS * WA,
                 O_SIS = O_SRS + (size_t)NBS * GB * NS5, O_END = O_SIS + (size_t)NBS * GB * NS5;

constexpr size_t MiB = 1u << 20;
constexpr size_t WS_CTL = 0, CTL_ZERO_BYTES = 1 * MiB;
constexpr size_t WS_WIN = 1 * MiB, WS_WGLU = 4 * MiB, WS_WOUT = 5 * MiB, WS_W1 = 7 * MiB, WS_W2 = 15 * MiB;
constexpr size_t WS_MOD = 23 * MiB;
constexpr size_t WS_S5C = 27 * MiB;
constexpr size_t WS_XN = 28 * MiB;
constexpr size_t WS_Z = 61 * MiB;
constexpr size_t WS_YCAT = 111 * MiB;
constexpr size_t WS_G = 144 * MiB;
constexpr size_t WS_U = 61 * MiB;
constexpr size_t WS_TAB = 194 * MiB;
constexpr size_t WS_SLAB = 196 * MiB;
constexpr size_t WS_END = 212 * MiB;
constexpr size_t TB_BF1 = 0, TB_BF2 = TB_BF1 + 32 * 4 * 64 * 16, TB_TA = TB_BF2 + 32 * 8 * 64 * 16, TB_ZP = TB_TA + 32 * 2 * 2 * 32 * 4, TB_Z16N = TB_ZP + 32 * 17 * 2 * 2 * 32 * 4,
                 TB_RG = TB_Z16N + 32 * 2 * 64 * 4, TB_CB = TB_RG + 8 * 2 * 2 * 4 * 64 * 16, TB_SILU = TB_CB + 128 * 3 * 512 * 2, TB_END = TB_SILU + 160 * 1024 * 2;
static_assert(WS_TAB + TB_END <= WS_SLAB, "tables");
static_assert(WS_XN + (size_t)M * D * 2 <= WS_Z && WS_Z + (size_t)M * NZ * 2 <= WS_YCAT && WS_YCAT + (size_t)M * D * 2 <= WS_G && WS_G + (size_t)M * WB * 2 <= WS_END && WS_U + (size_t)M * FF * 2 <= WS_TAB, "d_ws map");
constexpr int SC_ABR = 0, SC_ABI = 2048, SC_BBR = 4096, SC_BBI = 4096 + 32768, SC_RGL = 4096 + 65536, SC_END = SC_RGL + 512;
constexpr int CW_TMO = 0, CW_CODE = 1, CW_SILU = 64, CW_BAR = 4096;

constexpr int RING_OFF = 0, RING_BYTES = 131072;
constexpr int LDSCTL_OFF = RING_BYTES, MISC_OFF = LDSCTL_OFF + 320;
constexpr int LDS_BYTES = 147456;

#define GAS __attribute__((address_space(1)))
#define LAS __attribute__((address_space(3)))
typedef unsigned short bf16;
typedef unsigned v4u __attribute__((ext_vector_type(4)));
typedef float f32x4 __attribute__((ext_vector_type(4)));
typedef GAS unsigned gu32;
#define RLX_AGENT __ATOMIC_RELAXED, __HIP_MEMORY_SCOPE_AGENT
#define LDS_WAIT() asm volatile("s_waitcnt lgkmcnt(0)" ::: "memory")
#define VM_WAIT() asm volatile("s_waitcnt vmcnt(0)" ::: "memory")
__device__ __forceinline__ unsigned f2bf(float f) { unsigned u = __builtin_bit_cast(unsigned, f); return (u + 0x7fffu + ((u >> 16) & 1u)) >> 16; }
__device__ __forceinline__ unsigned pk2(float lo, float hi) { return f2bf(lo) | (f2bf(hi) << 16); }
__device__ __forceinline__ float bf2f(bf16 v) { return __builtin_bit_cast(float, (unsigned)v << 16); }
__device__ __forceinline__ float gelu_tanh(float x) { const float t = -2.3022082f * (x + 0.044715f * x * x * x); return x * __builtin_amdgcn_rcpf(1.f + __builtin_amdgcn_exp2f(t)); }
__device__ __forceinline__ float sigmoidf_(float x) { return __builtin_amdgcn_rcpf(1.f + __builtin_amdgcn_exp2f(-1.4426950408889634f * x)); }

#define XB_TMO      128
#define XB_XCNT(j)  (256  + 64 * (j))
#define XB_XSUB(j)  (1280 + 64 * (j))
#define XB_XGEN(j)  (2304 + 64 * (j))
#define XB_TOP      3328
#define XB_TOPGEN   3392
#define XCD_BAR_WORDS 3456
#define XB_SPIN_CAP (1u << 18)
__device__ __forceinline__ unsigned xb_ld(unsigned* p)              { return __hip_atomic_load(p, __ATOMIC_RELAXED, __HIP_MEMORY_SCOPE_AGENT); }
__device__ __forceinline__ unsigned xb_add(unsigned* p, unsigned v) { return __hip_atomic_fetch_add(p, v, __ATOMIC_RELAXED, __HIP_MEMORY_SCOPE_AGENT); }
__device__ __forceinline__ unsigned xb_xcc_id() { return (unsigned)__builtin_amdgcn_s_getreg((3 << 11) | 20) & 0xFu; }
#define XB_SPIN(cond, bar) do { unsigned _sp = 0; while (cond) { __builtin_amdgcn_s_sleep(1); \
    if ((++_sp & 255u) == 0u) { if (xb_ld(&(bar)[XB_TMO])) break; if (_sp > XB_SPIN_CAP) { atomicAdd(&(bar)[XB_TMO], 1u); break; } } } } while (0)
struct XcdBarrier { unsigned* bar; unsigned x; volatile LAS unsigned* st; };
__device__ __forceinline__ XcdBarrier xcd_barrier_post(unsigned* bar, volatile LAS unsigned* st) {
    XcdBarrier b; b.bar = bar; b.x = xb_xcc_id(); b.st = st;
    if (threadIdx.x == 0) (void)xb_add(&bar[XB_XCNT(b.x)], 1u);
    return b;
}
__device__ __forceinline__ void xcd_barrier_complete(unsigned* bar, unsigned x, unsigned& nloc, unsigned& nx) {
    const unsigned G = gridDim.x * gridDim.y * gridDim.z;
    unsigned sum, cnt, mine, sp = 0u;
    for (;;) {
        sum = 0u; cnt = 0u; mine = 0u;
#pragma unroll
        for (unsigned j = 0; j < 16; ++j) { const unsigned c = xb_ld(&bar[XB_XCNT(j)]); sum += c; cnt += (c > 0u) ? 1u : 0u; mine = (j == x) ? c : mine; }
        if (sum == G) break;
        __builtin_amdgcn_s_sleep(1);
        if ((++sp & 255u) == 0u) { if (xb_ld(&bar[XB_TMO])) break; if (sp > XB_SPIN_CAP) { atomicAdd(&bar[XB_TMO], 1u); break; } }
    }
    nloc = mine > 0u ? mine : 1u; nx = cnt > 0u ? cnt : 1u;
}
__device__ __forceinline__ void xcd_barrier(const XcdBarrier& b) {
    asm volatile("s_waitcnt vmcnt(0)" ::: "memory");
    __syncthreads();
    if (threadIdx.x == 0) {
        unsigned* bar = b.bar;
        __builtin_amdgcn_s_waitcnt(0);
        unsigned nloc = b.st[0], nx = b.st[1];
        if (nloc == 0u) { xcd_barrier_complete(bar, b.x, nloc, nx); b.st[0] = nloc; b.st[1] = nx; }
        const unsigned old = xb_add(&bar[XB_XSUB(b.x)], 1u);
        const unsigned gen = old / nloc;
        if (old + 1u == (gen + 1u) * nloc) {
            __builtin_amdgcn_fence(__ATOMIC_RELEASE, "agent");
            asm volatile("s_waitcnt vmcnt(0)" ::: "memory");
            const unsigned og = xb_add(&bar[XB_TOP], 1u);
            const unsigned tg = og / nx;
            if (og + 1u == (tg + 1u) * nx) xb_add(&bar[XB_TOPGEN], 1u);
            else XB_SPIN(xb_ld(&bar[XB_TOPGEN]) == tg, bar);
            __builtin_amdgcn_fence(__ATOMIC_ACQUIRE, "agent");
            xb_add(&bar[XB_XGEN(b.x)], 1u);
            asm volatile("s_waitcnt vmcnt(0)" ::: "memory");
        } else {
            XB_SPIN(xb_ld(&bar[XB_XGEN(b.x)]) == gen, bar);
            __builtin_amdgcn_fence(__ATOMIC_ACQUIRE, "agent");
            asm volatile("s_waitcnt vmcnt(0)" ::: "memory");
        }
    }
    __syncthreads();
}

struct Frame {
    LAS unsigned char* lds;
    volatile LAS unsigned* MISC;
    gu32* ctl;
    int tid, lane, wave;
    int vcu, G;
    float* out;
    unsigned char* ws;
};
struct Args { const float* in[37]; float* out; unsigned char* ws; int ph_lo, ph_hi, li, pad; };
__device__ __forceinline__ void refresh(Frame& F) { int t = threadIdx.x; asm volatile("" : "+v"(t)); F.tid = t; F.lane = t & 63; F.wave = __builtin_amdgcn_readfirstlane(t >> 6); }
__device__ __forceinline__ float wave_sum(float v) {
#pragma unroll
    for (int o = 1; o < 64; o <<= 1) v += __shfl_xor(v, o);
    return v;
}
enum { I_XP = 0, I_XS, I_SCONV, I_SH, I_SSR, I_SSI, I_CP, I_CS, I_ADAW, I_ADAB, I_INPROJ, I_CONVW, I_CONVB, I_RGWR, I_RGBR, I_RGWI, I_RGBI, I_RGLAM,
       I_S5ARE, I_S5AIM, I_S5LOGDT, I_S5BRE, I_S5BIM, I_S5CRE, I_S5CIM, I_S5D, I_GLUW, I_GLUB, I_OUTPROJ, I_LN1G, I_LN1B, I_W1, I_B1, I_W2, I_B2, I_LN2G, I_LN2B };

typedef float f32x2m __attribute__((ext_vector_type(2)));
typedef __bf16 bf16x2m __attribute__((ext_vector_type(2)));
__device__ __forceinline__ unsigned pkbf0(float a, float b) { const f32x2m v = {a, b}; const bf16x2m r = __builtin_convertvector(v, bf16x2m); return __builtin_bit_cast(unsigned, r); }
typedef short bf16x8m __attribute__((ext_vector_type(8)));
typedef float f32x16m __attribute__((ext_vector_type(16)));
__device__ __forceinline__ void p0_transpose_item(const float* W, int K, int N, bf16* WT, LAS float* scr, int item, int lane) {
    const int nblk = N / 32, kb = item / nblk, nb = item % nblk, k0 = 64 * kb, n0 = 32 * nb;
#pragma unroll 8
    for (int i = 0; i < 32; ++i) { const int kk = 2 * i + (lane >> 5); scr[kk * 33 + (lane & 31)] = W[(size_t)(k0 + kk) * N + n0 + (lane & 31)]; }
    LDS_WAIT(); asm volatile("" ::: "memory");
    const int c = lane & 7;
#pragma unroll
    for (int j = 0; j < 4; ++j) { const int n = (lane >> 3) + 8 * j; const LAS float* s = scr + (8 * c) * 33 + n;
        v4u o; o.x = pk2(s[0 * 33], s[1 * 33]); o.y = pk2(s[2 * 33], s[3 * 33]); o.z = pk2(s[4 * 33], s[5 * 33]); o.w = pk2(s[6 * 33], s[7 * 33]);
        *(GAS v4u*)(WT + (size_t)(n0 + n) * K + k0 + 8 * c) = o; }
    LDS_WAIT(); asm volatile("" ::: "memory");
}

#ifndef PROBE_P0PART
#define PROBE_P0PART 7
#endif
__device__ __forceinline__ void p0_prologue(Frame& F, const Args& A, int rep = 0) {
    refresh(F);
    const int pmask = rep ? PROBE_P0PART : 7;
    LAS float* scr = (LAS float*)(F.lds + RING_OFF + F.wave * 16384);
    const int gw = F.wave * F.G + F.vcu, NGW = F.G * NWAVES;
    {
        bf16* ST = (bf16*)(F.ws + WS_TAB + TB_SILU);
        for (int ch = F.vcu * NWAVES * 64 + F.tid; ch < 160 * 1024 / 8; ch += F.G * NWAVES * 64) { const int row = ch >> 7, k = (ch & 127) * 8; v4u o = (v4u){0u, 0u, 0u, 0u};
            if (row < NROWMOD) { const float* cp = (row < NBP ? A.in[I_CP] + (size_t)row * D : A.in[I_CS] + (size_t)(row - NBP) * D) + k; const f32x4 c0 = *(const f32x4*)cp, c1 = *(const f32x4*)(cp + 4);
                o.x = pk2(c0[0] * sigmoidf_(c0[0]), c0[1] * sigmoidf_(c0[1])); o.y = pk2(c0[2] * sigmoidf_(c0[2]), c0[3] * sigmoidf_(c0[3]));
                o.z = pk2(c1[0] * sigmoidf_(c1[0]), c1[1] * sigmoidf_(c1[1])); o.w = pk2(c1[2] * sigmoidf_(c1[2]), c1[3] * sigmoidf_(c1[3])); }
            *(v4u*)(ST + (size_t)ch * 8) = o; }
        VM_WAIT(); __syncthreads();
        if (F.tid == 0) { __builtin_amdgcn_fence(__ATOMIC_RELEASE, "agent"); VM_WAIT(); (void)__hip_atomic_fetch_add((unsigned*)(F.ctl + CW_SILU), 1u, RLX_AGENT); }
    }
    constexpr int I_IN = (D / 64) * (NZ / 32), I_GL = (WB / 64) * (WB / 32), I_OU = (D / 64) * (D / 32), I_1 = (D / 64) * (FF / 32), I_2 = (FF / 64) * (D / 32);
    constexpr int I_S5 = GB, I_RG = WA / 64, I_RGT = HA * 2 * 2 * 4, I_CB = NBS * 3 * WA / 512;
    constexpr int NITEMS = I_IN + I_GL + I_OU + I_1 + I_2 + I_S5 + I_RG + I_RGT + I_CB;
    float* sc = (float*)(F.ws + WS_S5C);
    for (int it = gw; it < NITEMS; it += NGW) {
        int r = it;
        if (!(pmask & 1) && it < I_IN + I_GL + I_OU + I_1 + I_2) continue;
        if (!(pmask & 2) && it >= I_IN + I_GL + I_OU + I_1 + I_2) continue;
        if (r < I_IN) { p0_transpose_item(A.in[I_INPROJ], D, NZ, (bf16*)(F.ws + WS_WIN), scr, r, F.lane); continue; } r -= I_IN;
        if (r < I_GL) { p0_transpose_item(A.in[I_GLUW], WB, WB, (bf16*)(F.ws + WS_WGLU), scr, r, F.lane); continue; } r -= I_GL;
        if (r < I_OU) { p0_transpose_item(A.in[I_OUTPROJ], D, D, (bf16*)(F.ws + WS_WOUT), scr, r, F.lane); continue; } r -= I_OU;
        if (r < I_1) { p0_transpose_item(A.in[I_W1], D, FF, (bf16*)(F.ws + WS_W1), scr, r, F.lane); continue; } r -= I_1;
        if (r < I_2) { p0_transpose_item(A.in[I_W2], FF, D, (bf16*)(F.ws + WS_W2), scr, r, F.lane); continue; } r -= I_2;
        if (r < I_S5) {
            const int g = r, n = F.lane, gn = g * NS5 + n;
            const double dt = exp((double)A.in[I_S5LOGDT][g]), ar = (double)A.in[I_S5ARE][gn], ai = (double)A.in[I_S5AIM][gn];
            const double mag = exp(dt * ar), abr = mag * cos(dt * ai), abi = mag * sin(dt * ai), den = ar * ar + ai * ai, nr = abr - 1.0;
            const double qr = (nr * ar + abi * ai) / den, qi = (abi * ar - nr * ai) / den;
            sc[SC_ABR + gn] = (float)abr; sc[SC_ABI + gn] = (float)abi;
            unsigned char* tab = F.ws + WS_TAB;
            bf16* BF1 = (bf16*)(tab + TB_BF1); bf16* BF2 = (bf16*)(tab + TB_BF2); float* TA = (float*)(tab + TB_TA); float* ZP = (float*)(tab + TB_ZP); float* Z16N = (float*)(tab + TB_Z16N);
            const int sh = n >> 5, v = n & 31, hh = (v >> 2) & 1, ii = (v & 3) + 4 * (v >> 3);
            for (int k = 0; k < KS5; ++k) { const double br = (double)A.in[I_S5BRE][gn * KS5 + k], bi = (double)A.in[I_S5BIM][gn * KS5 + k];
                const float vr = (float)(qr * br - qi * bi), vi = (float)(qr * bi + qi * br);
                sc[SC_BBR + gn * KS5 + k] = vr; sc[SC_BBI + gn * KS5 + k] = vi;
                const int lp = (n & 31) + 32 * (k >> 3), jj = k & 7;
                BF1[(size_t)((g * 4 + 0 + sh) * 64 + lp) * 8 + jj] = (bf16)f2bf(vr); BF1[(size_t)((g * 4 + 2 + sh) * 64 + lp) * 8 + jj] = (bf16)f2bf(vi); }
            { const int s2 = (n >> 4) & 1, jj = 4 * ((n >> 3) & 1) + (n & 3), hk = (n >> 2) & 1;
              for (int ch = 0; ch < KS5; ++ch) { const int hr_ = ch >> 3, i8 = ch & 7, R = (i8 & 3) + 8 * (i8 >> 2) + 4 * hr_, lp = R + 32 * hk;
                  const float cr = A.in[I_S5CRE][(size_t)(g * KS5 + ch) * NS5 + n], ci = A.in[I_S5CIM][(size_t)(g * KS5 + ch) * NS5 + n];
                  BF2[(size_t)((g * 8 + (0 + sh) * 2 + s2) * 64 + lp) * 8 + jj] = (bf16)f2bf(cr); BF2[(size_t)((g * 8 + (2 + sh) * 2 + s2) * 64 + lp) * 8 + jj] = (bf16)f2bf(-ci); }
              for (int z = 0; z < 4; ++z) { const int cidx = n + 64 * z, ks = cidx >> 5, r16 = cidx & 31, lp = 16 + (r16 & 15) + 32 * (r16 >> 4);
                  *(v4u*)(BF2 + (size_t)((g * 8 + ks) * 64 + lp) * 8) = (v4u){0u, 0u, 0u, 0u}; } }
            TA[((g * 2 + hh) * 2 + 0) * 32 + sh * 16 + ii] = (float)abr; TA[((g * 2 + hh) * 2 + 1) * 32 + sh * 16 + ii] = (float)abi;
            const double mg8 = exp(8.0 * dt * ar), z1r = mg8 * cos(8.0 * dt * ai), z1i = mg8 * sin(8.0 * dt * ai); double pzr = 1.0, pzi = 0.0;
            for (int e = 0; e <= 16; ++e) { const float zr = (float)pzr, zi = (float)pzi; { const double nr2 = pzr * z1r - pzi * z1i, ni2 = pzr * z1i + pzi * z1r; pzr = nr2; pzi = ni2; }
                ZP[(((g * 17 + e) * 2 + hh) * 2 + 0) * 32 + sh * 16 + ii] = zr; ZP[(((g * 17 + e) * 2 + hh) * 2 + 1) * 32 + sh * 16 + ii] = zi;
                if (e == 16) { Z16N[(g * 2 + 0) * 64 + n] = zr; Z16N[(g * 2 + 1) * 64 + n] = zi; } }
            continue; } r -= I_S5;
        if (r < I_RG) { const int c = r * 64 + F.lane; const double lam = (double)A.in[I_RGLAM][c];
          sc[SC_RGL + c] = (float)(-8.0 * log1p(exp(-lam)) * 1.4426950408889634); continue; } r -= I_RG;
        if (r >= I_RGT) { r -= I_RGT;
            const float* src = A.in[I_SCONV] + (size_t)r * 512 + F.lane * 8; const f32x4 a0 = *(const f32x4*)src, a1 = *(const f32x4*)(src + 4);
            v4u o; o.x = pk2(a0[0], a0[1]); o.y = pk2(a0[2], a0[3]); o.z = pk2(a1[0], a1[1]); o.w = pk2(a1[2], a1[3]);
            *(v4u*)(F.ws + WS_TAB + TB_CB + ((size_t)r * 512 + F.lane * 8) * 2) = o; continue; }
        {
            const int s4 = r & 3, gate = (r >> 2) & 1, jh = (r >> 3) & 1, hd = r >> 4;
            const int R = F.lane & 31, hk = F.lane >> 5, hR = (R >> 2) & 1, i = (R & 3) + 4 * (R >> 3), cho = 32 * jh + 16 * (i >> 3) + 8 * hR + (i & 7);
            const float* W = A.in[gate ? I_RGWI : I_RGWR] + (size_t)(hd * 64 + 16 * s4 + 8 * hk) * 64 + cho;
            v4u o; o.x = pk2(W[0], W[64]); o.y = pk2(W[128], W[192]); o.z = pk2(W[256], W[320]); o.w = pk2(W[384], W[448]);
            *(v4u*)(F.ws + WS_TAB + TB_RG + (size_t)(r * 64 + F.lane) * 16) = o;
        }
    }
    __syncthreads();
    if (F.tid == 0) {
        unsigned sp = 0; while (__hip_atomic_load((unsigned*)(F.ctl + CW_SILU), RLX_AGENT) < (unsigned)F.G * (unsigned)(rep + 1) && ++sp < (1u << 22)) __builtin_amdgcn_s_sleep(2);
        __builtin_amdgcn_fence(__ATOMIC_ACQUIRE, "agent"); VM_WAIT(); }
    __syncthreads();
    LAS float* RED = (LAS float*)(F.lds + RING_OFF);
    float* mod = (float*)(F.ws + WS_MOD);
    const int r32 = F.lane & 31, hh = F.lane >> 5;
    const bf16* ST = (const bf16*)(F.ws + WS_TAB + TB_SILU);
#pragma unroll 1
    for (int it = F.vcu; it < ((pmask & 4) ? NMOD / 32 : 0); it += F.G) {
        const int n0 = it * 32;
        f32x16m acc[5];
#pragma unroll
        for (int rt = 0; rt < 5; ++rt)
#pragma unroll
            for (int i = 0; i < 16; ++i) acc[rt][i] = 0.f;
#pragma unroll 1
        for (int kb = 0; kb < 4; ++kb) {
            float bw[2][8]; v4u af[2][5];
#pragma unroll
            for (int ks = 0; ks < 2; ++ks) { const int k0 = F.wave * 128 + (kb * 2 + ks) * 16 + 8 * hh;
                const float* wp = A.in[I_ADAW] + (size_t)k0 * NMOD + n0 + r32;
#pragma unroll
                for (int j = 0; j < 8; ++j) bw[ks][j] = wp[(size_t)j * NMOD];
#pragma unroll
                for (int rt = 0; rt < 5; ++rt) af[ks][rt] = *(const v4u*)(ST + (size_t)(32 * rt + r32) * D + k0); }
#pragma unroll
            for (int ks = 0; ks < 2; ++ks) {
                v4u bp; bp.x = pkbf0(bw[ks][0], bw[ks][1]); bp.y = pkbf0(bw[ks][2], bw[ks][3]); bp.z = pkbf0(bw[ks][4], bw[ks][5]); bp.w = pkbf0(bw[ks][6], bw[ks][7]);
                const bf16x8m bfr = __builtin_bit_cast(bf16x8m, bp);
#pragma unroll
                for (int rt = 0; rt < 5; ++rt) acc[rt] = __builtin_amdgcn_mfma_f32_32x32x16_bf16(__builtin_bit_cast(bf16x8m, af[ks][rt]), bfr, acc[rt], 0, 0, 0); }
        }
#pragma unroll
        for (int half = 4; half >= 1; half >>= 1) {
            if (F.wave >= half && F.wave < 2 * half) {
#pragma unroll
                for (int rt = 0; rt < 5; ++rt)
#pragma unroll
                    for (int i = 0; i < 16; ++i) RED[(F.wave - half) * 5120 + (rt * 16 + i) * 64 + F.lane] = acc[rt][i]; }
            __syncthreads();
            if (F.wave < half) {
#pragma unroll
                for (int rt = 0; rt < 5; ++rt)
#pragma unroll
                    for (int i = 0; i < 16; ++i) acc[rt][i] += RED[F.wave * 5120 + (rt * 16 + i) * 64 + F.lane]; }
            __syncthreads();
        }
        if (F.wave == 0) { const float bb = A.in[I_ADAB][n0 + r32];
#pragma unroll
            for (int rt = 0; rt < 5; ++rt)
#pragma unroll
                for (int i = 0; i < 16; ++i) { const int row = 32 * rt + (i & 3) + 8 * (i >> 2) + 4 * hh; if (row < NROWMOD) mod[(size_t)row * NMOD + n0 + r32] = acc[rt][i] + bb; } }
    }
}

__device__ __forceinline__ int mod_row(int m) { return m < MP ? (m >> 11) : NBP + ((m - MP) >> 2); }
__device__ __forceinline__ const float* x_row(const Args& A, int m) { return m < MP ? A.in[I_XP] + (size_t)m * D : A.in[I_XS] + (size_t)(m - MP) * D; }

__device__ __forceinline__ void p1_modulate(Frame& F, const Args& A) {
    refresh(F);
    const int gw = F.vcu * NWAVES + F.wave, NGW = F.G * NWAVES;
    const float* mod = (const float*)(F.ws + WS_MOD); bf16* XN = (bf16*)(F.ws + WS_XN);
    for (int m = gw; m < M; m += NGW) {
        const GAS f32x4* xr = (const GAS f32x4*)x_row(A, m) + F.lane; const float* mr = mod + (size_t)mod_row(m) * NMOD;
        const GAS f32x4* sh = (const GAS f32x4*)(mr) + F.lane; const GAS f32x4* scp = (const GAS f32x4*)(mr + D) + F.lane;
        GAS unsigned long long* o8 = (GAS unsigned long long*)(XN + (size_t)m * D) + F.lane;
#pragma unroll
        for (int j = 0; j < 4; ++j) { const f32x4 v = xr[64 * j], a = sh[64 * j], s = scp[64 * j]; const f32x4 h = v * (s + 1.f) + a;
            o8[64 * j] = (unsigned long long)pk2(h.x, h.y) | ((unsigned long long)pk2(h.z, h.w) << 32); }
    }
}

template <bool SECOND>
__device__ __forceinline__ void ln_rows(Frame& F, const Args& A) {
    refresh(F);
    const int gw = F.vcu * NWAVES + F.wave, NGW = F.G * NWAVES;
    const float* mod = (const float*)(F.ws + WS_MOD); bf16* XN = (bf16*)(F.ws + WS_XN);
    const GAS f32x4* gg = (const GAS f32x4*)A.in[SECOND ? I_LN2G : I_LN1G] + F.lane; const GAS f32x4* gb = (const GAS f32x4*)A.in[SECOND ? I_LN2B : I_LN1B] + F.lane;
    for (int m = gw; m < M; m += NGW) {
        GAS f32x4* xr = (GAS f32x4*)(F.out + (size_t)m * D) + F.lane;
        f32x4 v[4]; float s = 0.f;
        if (m >= MP) {
            const float* mr = mod + (size_t)mod_row(m) * NMOD + (SECOND ? 5 : 2) * D;
            const GAS f32x4* bs = SECOND ? (const GAS f32x4*)xr : (const GAS f32x4*)(A.in[I_XS] + (size_t)(m - MP) * D) + F.lane;
            const GAS f32x4* sl = (const GAS f32x4*)((const float*)(F.ws + WS_SLAB) + (size_t)(m - MP) * D) + F.lane;
#pragma unroll
            for (int j = 0; j < 4; ++j) { f32x4 a = SECOND ? *((const GAS f32x4*)A.in[I_B2] + F.lane + 64 * j) : (f32x4){0.f, 0.f, 0.f, 0.f};
#pragma unroll
                for (int ks = 0; ks < (SECOND ? NS_DOWN : NS_OUT); ++ks) a += sl[(size_t)ks * (512 * 1024 / 4) + 64 * j];
                v[j] = bs[64 * j] * ALPHA + *((const GAS f32x4*)mr + F.lane + 64 * j) * a; }
        } else {
#pragma unroll
            for (int j = 0; j < 4; ++j) v[j] = xr[64 * j];
        }
#pragma unroll
        for (int j = 0; j < 4; ++j) s += (v[j].x + v[j].y) + (v[j].z + v[j].w);
        const float mean = wave_sum(s) * (1.f / D); float s2 = 0.f;
#pragma unroll
        for (int j = 0; j < 4; ++j) { v[j] = v[j] - mean; s2 += (v[j].x * v[j].x + v[j].y * v[j].y) + (v[j].z * v[j].z + v[j].w * v[j].w); }
        const float rstd = 1.f / sqrtf(wave_sum(s2) * (1.f / D) + LN_EPS);
#pragma unroll
        for (int j = 0; j < 4; ++j) { v[j] = v[j] * rstd * gg[64 * j] + gb[64 * j]; xr[64 * j] = v[j]; }
        if (!SECOND) {
            const float* mr = mod + (size_t)mod_row(m) * NMOD;
            const GAS f32x4* sh = (const GAS f32x4*)(mr + 3 * D) + F.lane; const GAS f32x4* scp = (const GAS f32x4*)(mr + 4 * D) + F.lane;
            GAS unsigned long long* o8 = (GAS unsigned long long*)(XN + (size_t)m * D) + F.lane;
#pragma unroll
            for (int j = 0; j < 4; ++j) { const f32x4 h = v[j] * (scp[64 * j] + 1.f) + sh[64 * j];
                o8[64 * j] = (unsigned long long)pk2(h.x, h.y) | ((unsigned long long)pk2(h.z, h.w) << 32); }
        }
    }
}

__device__ __forceinline__ void rg_item_ref(Frame& F, const Args& A, bool prompt, int b, int hd, LAS float* scr) {
    const int j = F.lane, c = hd * HDA + j;
    const bf16* Z = (const bf16*)(F.ws + WS_Z); bf16* Y = (bf16*)(F.ws + WS_YCAT); const float* sc = (const float*)(F.ws + WS_S5C);
    float wr[64], wi[64];
#pragma unroll
    for (int i = 0; i < 64; ++i) { wr[i] = A.in[I_RGWR][(size_t)(hd * 64 + i) * 64 + j]; wi[i] = A.in[I_RGWI][(size_t)(hd * 64 + i) * 64 + j]; }
    const float br = A.in[I_RGBR][c], bi = A.in[I_RGBI][c], L2 = sc[SC_RGL + c];
    const float w0 = A.in[I_CONVW][c], w1 = A.in[I_CONVW][WA + c], w2 = A.in[I_CONVW][2 * WA + c], w3 = A.in[I_CONVW][3 * WA + c], cb = A.in[I_CONVB][c];
    int T, m0; float x3, x2, x1, h;
    if (prompt) { T = TP; m0 = b * TP; x3 = 0.f; x2 = 0.f; x1 = 0.f; h = 0.f; }
    else { T = TS; m0 = MP + b * TS; x3 = A.in[I_SCONV][(size_t)(b * 3 + 0) * WA + c]; x2 = A.in[I_SCONV][(size_t)(b * 3 + 1) * WA + c]; x1 = A.in[I_SCONV][(size_t)(b * 3 + 2) * WA + c]; h = A.in[I_SH][(size_t)b * WA + c]; }
    for (int t = 0; t < T; ++t) {
        const size_t m = (size_t)(m0 + t);
        const float xa = bf2f(Z[m * NZ + WA + c]), gate = bf2f(Z[m * NZ + c]);
        const float xc = cb + w0 * x3 + w1 * x2 + w2 * x1 + w3 * xa; x3 = x2; x2 = x1; x1 = xa;
        scr[j] = xc; LDS_WAIT(); asm volatile("" ::: "memory");
        float rp = br, gp = bi;
#pragma unroll
        for (int i4 = 0; i4 < 16; ++i4) { const f32x4 v = *(const LAS f32x4*)(scr + 4 * i4);
            rp += v[0] * wr[4 * i4] + v[1] * wr[4 * i4 + 1] + v[2] * wr[4 * i4 + 2] + v[3] * wr[4 * i4 + 3];
            gp += v[0] * wi[4 * i4] + v[1] * wi[4 * i4 + 1] + v[2] * wi[4 * i4 + 2] + v[3] * wi[4 * i4 + 3]; }
        LDS_WAIT(); asm volatile("" ::: "memory");
        const float r = sigmoidf_(rp), gi = sigmoidf_(gp);
        const float a = exp2f(r * L2);
        float mult = sqrtf(fmaxf(1.f - a * a, 0.f));
        if (prompt && t == 0) mult = 1.f;
        h = a * h + mult * gi * xc;
        Y[m * D + c] = (bf16)f2bf(gelu_tanh(gate) * h);
    }
    float* oc = F.out + (prompt ? O_CONVP : O_CONVS); float* oh = F.out + (prompt ? O_HP : O_HS);
    oc[(size_t)(b * 3 + 0) * WA + c] = x3; oc[(size_t)(b * 3 + 1) * WA + c] = x2; oc[(size_t)(b * 3 + 2) * WA + c] = x1;
    oh[(size_t)b * WA + c] = h;
}
__device__ __forceinline__ void s5_item_ref(Frame& F, const Args& A, bool prompt, int b, int g, LAS float* scr) {
    const int n = F.lane, gn = g * NS5 + n, k = F.lane & 15, part = F.lane >> 4;
    const bf16* Z = (const bf16*)(F.ws + WS_Z); bf16* Gy = (bf16*)(F.ws + WS_G); const float* sc = (const float*)(F.ws + WS_S5C);
    float bbr[16], bbi[16], cre[16], cim[16];
#pragma unroll
    for (int i = 0; i < 16; ++i) { bbr[i] = sc[SC_BBR + gn * KS5 + i]; bbi[i] = sc[SC_BBI + gn * KS5 + i];
        cre[i] = A.in[I_S5CRE][(size_t)(g * KS5 + k) * NS5 + part * 16 + i]; cim[i] = A.in[I_S5CIM][(size_t)(g * KS5 + k) * NS5 + part * 16 + i]; }
    const float abr = sc[SC_ABR + gn], abi = sc[SC_ABI + gn], dk = A.in[I_S5D][g * KS5 + k];
    int T, m0; float hr, hi;
    if (prompt) { T = TP; m0 = b * TP; hr = 0.f; hi = 0.f; }
    else { T = TS; m0 = MP + b * TS; hr = A.in[I_SSR][(size_t)(b * GB + g) * NS5 + n]; hi = A.in[I_SSI][(size_t)(b * GB + g) * NS5 + n]; }
    for (int t = 0; t < T; ++t) {
        const size_t m = (size_t)(m0 + t);
        const bf16* zr = Z + m * NZ + 2 * WA + g * KS5;
        const v4u u0 = *(const v4u*)zr, u1 = *(const v4u*)(zr + 8);
        float u[16];
        u[0] = pg8::bf_lo(u0.x); u[1] = pg8::bf_hi(u0.x); u[2] = pg8::bf_lo(u0.y); u[3] = pg8::bf_hi(u0.y); u[4] = pg8::bf_lo(u0.z); u[5] = pg8::bf_hi(u0.z); u[6] = pg8::bf_lo(u0.w); u[7] = pg8::bf_hi(u0.w);
        u[8] = pg8::bf_lo(u1.x); u[9] = pg8::bf_hi(u1.x); u[10] = pg8::bf_lo(u1.y); u[11] = pg8::bf_hi(u1.y); u[12] = pg8::bf_lo(u1.z); u[13] = pg8::bf_hi(u1.z); u[14] = pg8::bf_lo(u1.w); u[15] = pg8::bf_hi(u1.w);
        float bur = 0.f, bui = 0.f;
#pragma unroll
        for (int i = 0; i < 16; ++i) { bur += bbr[i] * u[i]; bui += bbi[i] * u[i]; }
        const float nhr = abr * hr - abi * hi + bur, nhi = abr * hi + abi * hr + bui; hr = nhr; hi = nhi;
        scr[n] = hr; scr[64 + n] = hi; LDS_WAIT(); asm volatile("" ::: "memory");
        float p = 0.f;
#pragma unroll
        for (int i4 = 0; i4 < 4; ++i4) { const f32x4 vr = *(const LAS f32x4*)(scr + part * 16 + 4 * i4), vi = *(const LAS f32x4*)(scr + 64 + part * 16 + 4 * i4);
#pragma unroll
            for (int e = 0; e < 4; ++e) p += vr[e] * cre[4 * i4 + e] - vi[e] * cim[4 * i4 + e]; }
        LDS_WAIT(); asm volatile("" ::: "memory");
        p += __shfl_xor(p, 16); p += __shfl_xor(p, 32);
        const float uk = bf2f(zr[k]);
        if (F.lane < 16) Gy[m * WB + g * KS5 + k] = (bf16)f2bf(gelu_tanh(p + dk * uk));
    }
    float* osr = F.out + (prompt ? O_SRP : O_SRS); float* osi = F.out + (prompt ? O_SIP : O_SIS);
    osr[(size_t)(b * GB + g) * NS5 + n] = hr; osi[(size_t)(b * GB + g) * NS5 + n] = hi;
}

typedef short bf16x8v __attribute__((ext_vector_type(8)));
typedef float f32x16 __attribute__((ext_vector_type(16)));
typedef float f32x2v __attribute__((ext_vector_type(2)));
typedef __bf16 bf16x2v __attribute__((ext_vector_type(2)));
#define MFMA32(a, b, c) __builtin_amdgcn_mfma_f32_32x32x16_bf16((a), (b), (c), 0, 0, 0)
__device__ __forceinline__ unsigned pkbf(float a, float b) { const f32x2v v = {a, b}; const bf16x2v r = __builtin_convertvector(v, bf16x2v); return __builtin_bit_cast(unsigned, r); }
template <int CTRL> __device__ __forceinline__ float dppf(float old, float v) { return __builtin_bit_cast(float, __builtin_amdgcn_update_dpp(__builtin_bit_cast(int, old), __builtin_bit_cast(int, v), CTRL, 0xF, 0xF, false)); }
__device__ __forceinline__ f32x16 ld16(const float* p) { f32x16 r;
#pragma unroll
    for (int i = 0; i < 4; ++i) { const f32x4 v = *(const f32x4*)(p + 4 * i); r[4 * i] = v[0]; r[4 * i + 1] = v[1]; r[4 * i + 2] = v[2]; r[4 * i + 3] = v[3]; }
    return r; }
__device__ __forceinline__ f32x16 ld16l(const LAS float* p) { f32x16 r;
#pragma unroll
    for (int i = 0; i < 4; ++i) { const f32x4 v = *(const LAS f32x4*)(p + 4 * i); r[4 * i] = v[0]; r[4 * i + 1] = v[1]; r[4 * i + 2] = v[2]; r[4 * i + 3] = v[3]; }
    return r; }
__device__ __forceinline__ bf16x8v pack8(const f32x16& x, int s) { v4u p; p.x = pkbf(x[8 * s], x[8 * s + 1]); p.y = pkbf(x[8 * s + 2], x[8 * s + 3]); p.z = pkbf(x[8 * s + 4], x[8 * s + 5]); p.w = pkbf(x[8 * s + 6], x[8 * s + 7]); return __builtin_bit_cast(bf16x8v, p); }
template <int CTRL> __device__ __forceinline__ void s5_scan_step(f32x16& xr, f32x16& xi, const f32x16& zr, const f32x16& zi) {
#pragma unroll
    for (int i = 0; i < 16; ++i) { const float sr = dppf<CTRL>(0.f, xr[i]), si = dppf<CTRL>(0.f, xi[i]);
        xr[i] += zr[i] * sr - zi[i] * si; xi[i] += zr[i] * si + zi[i] * sr; }
}
constexpr int S5L_BF1 = 0, S5L_BF2 = 4096, S5L_TOT = 12288, S5L_CAR = 20480, S5L_ZP = 28672  , S5L_TA = 37376  , S5L_U = 38912  ;
template <bool SECOND>
__device__ __forceinline__ void s5_step(LAS unsigned char* L, int lane, const bf16x8v u, f32x16& hr0, f32x16& hr1, f32x16& hi0, f32x16& hi1,
                                        const f32x16& ar0, const f32x16& ar1, const f32x16& ai0, const f32x16& ai1, const float (&dk)[8], bf16* gout) {
    const LAS bf16x8v* a1 = (const LAS bf16x8v*)(L + S5L_BF1) + lane;
    { const f32x16 cr = ar0 * hr0 - ai0 * hi0, ci = ar0 * hi0 + ai0 * hr0; hr0 = MFMA32(a1[0], u, cr); hi0 = MFMA32(a1[128], u, ci); }
    asm volatile("" : "+v"(hr0), "+v"(hi0));
    { const f32x16 cr = ar1 * hr1 - ai1 * hi1, ci = ar1 * hi1 + ai1 * hr1; hr1 = MFMA32(a1[64], u, cr); hi1 = MFMA32(a1[192], u, ci); }
    if (SECOND) {
        const LAS bf16x8v* a2 = (const LAS bf16x8v*)(L + S5L_BF2) + lane;
        f32x16 y;
#pragma unroll
        for (int i = 0; i < 16; ++i) y[i] = 0.f;
        y = MFMA32(a2[0 * 64], pack8(hr0, 0), y); y = MFMA32(a2[1 * 64], pack8(hr0, 1), y);
        y = MFMA32(a2[2 * 64], pack8(hr1, 0), y); y = MFMA32(a2[3 * 64], pack8(hr1, 1), y);
        y = MFMA32(a2[4 * 64], pack8(hi0, 0), y); y = MFMA32(a2[5 * 64], pack8(hi0, 1), y);
        y = MFMA32(a2[6 * 64], pack8(hi1, 0), y); y = MFMA32(a2[7 * 64], pack8(hi1, 1), y);
        const v4u uw = __builtin_bit_cast(v4u, u);
        float o[8];
        o[0] = gelu_tanh(y[0] + dk[0] * pg8::bf_lo(uw.x)); o[1] = gelu_tanh(y[1] + dk[1] * pg8::bf_hi(uw.x));
        o[2] = gelu_tanh(y[2] + dk[2] * pg8::bf_lo(uw.y)); o[3] = gelu_tanh(y[3] + dk[3] * pg8::bf_hi(uw.y));
        o[4] = gelu_tanh(y[4] + dk[4] * pg8::bf_lo(uw.z)); o[5] = gelu_tanh(y[5] + dk[5] * pg8::bf_hi(uw.z));
        o[6] = gelu_tanh(y[6] + dk[6] * pg8::bf_lo(uw.w)); o[7] = gelu_tanh(y[7] + dk[7] * pg8::bf_hi(uw.w));
        v4u w; w.x = pkbf(o[0], o[1]); w.y = pkbf(o[2], o[3]); w.z = pkbf(o[4], o[5]); w.w = pkbf(o[6], o[7]);
        *(v4u*)gout = w;
    }
}
__device__ __forceinline__ void s5_item_fast(Frame& F, const Args& A, int b, int g) {
    refresh(F);
    const int lane = F.lane, q = lane & 31, hh = lane >> 5, w = F.wave, c = w * 32 + q;
    LAS unsigned char* L = F.lds + RING_OFF;
    const unsigned char* tab = F.ws + WS_TAB;
    const size_t m0 = (size_t)b * TP + (size_t)8 * c;
    const bf16* zrow = (const bf16*)(F.ws + WS_Z) + m0 * NZ + 2 * WA + g * KS5 + 8 * hh;
    bf16* grow = (bf16*)(F.ws + WS_G) + m0 * WB + g * KS5 + 8 * hh;
    LAS v4u* UL = (LAS v4u*)(L + S5L_U) + F.tid;
    {
        v4u uu[8];
#pragma unroll
        for (int j = 0; j < 8; ++j) uu[j] = *(const v4u*)(zrow + (size_t)j * NZ);
        const v4u* s1 = (const v4u*)(tab + TB_BF1) + (size_t)g * 256; const v4u* s2 = (const v4u*)(tab + TB_BF2) + (size_t)g * 512;
        if (F.tid < 256) ((LAS v4u*)(L + S5L_BF1))[F.tid] = s1[F.tid];
        ((LAS v4u*)(L + S5L_BF2))[F.tid] = s2[F.tid];
        const v4u* s3 = (const v4u*)(tab + TB_ZP) + (size_t)g * (17 * 128 / 4); for (int e = F.tid; e < 17 * 128 / 4; e += NWAVES * 64) ((LAS v4u*)(L + S5L_ZP))[e] = s3[e];
        if (F.tid < 32) ((LAS v4u*)(L + S5L_TA))[F.tid] = ((const v4u*)(tab + TB_TA) + (size_t)g * 32)[F.tid];
#pragma unroll
        for (int j = 0; j < 8; ++j) UL[512 * j] = uu[j];
    }
    __syncthreads();
    const LAS float* TA = (const LAS float*)(L + S5L_TA) + hh * 64;
    f32x16 ar0 = ld16l(TA), ar1 = ld16l(TA + 16), ai0 = ld16l(TA + 32), ai1 = ld16l(TA + 48);
    f32x16 hr0, hr1, hi0, hi1;
#pragma unroll
    for (int i = 0; i < 16; ++i) { hr0[i] = 0.f; hr1[i] = 0.f; hi0[i] = 0.f; hi1[i] = 0.f; }
    float dk[8];
#pragma unroll
    for (int i = 0; i < 8; ++i) dk[i] = A.in[I_S5D][g * KS5 + 8 * hh + i];
#pragma unroll 1
    for (int j = 0; j < 8; ++j) { const bf16x8v u = __builtin_bit_cast(bf16x8v, UL[512 * j]);
        s5_step<false>(L, lane, u, hr0, hr1, hi0, hi1, ar0, ar1, ai0, ai1, dk, nullptr); }
    const LAS float* ZP = (const LAS float*)(L + S5L_ZP);
#define S5_SCAN(E, CTRL) do { const LAS float* z = ZP + (((E) * 2 + hh) * 2) * 32; \
        { const f32x16 zr = ld16l(z), zi = ld16l(z + 32); s5_scan_step<CTRL>(hr0, hi0, zr, zi); } \
        asm volatile("" : "+v"(hr0), "+v"(hi0) :: "memory"); \
        { const f32x16 zr = ld16l(z + 16), zi = ld16l(z + 48); s5_scan_step<CTRL>(hr1, hi1, zr, zi); } \
        asm volatile("" : "+v"(hr1), "+v"(hi1) :: "memory"); } while (0)
    S5_SCAN(1, 0x111); S5_SCAN(2, 0x112); S5_SCAN(4, 0x114); S5_SCAN(8, 0x118);
#undef S5_SCAN
    const int seg = w * 2 + (q >> 4);
    LAS float* TOT = (LAS float*)(L + S5L_TOT); LAS float* CAR = (LAS float*)(L + S5L_CAR);
    if ((lane & 15) == 15) {
#pragma unroll
        for (int rho = 0; rho < 4; ++rho) {
            *(LAS f32x4*)(TOT + (seg * 2 + 0) * 64 + 0 + 8 * rho + 4 * hh) = (f32x4){hr0[4 * rho], hr0[4 * rho + 1], hr0[4 * rho + 2], hr0[4 * rho + 3]};
            *(LAS f32x4*)(TOT + (seg * 2 + 0) * 64 + 32 + 8 * rho + 4 * hh) = (f32x4){hr1[4 * rho], hr1[4 * rho + 1], hr1[4 * rho + 2], hr1[4 * rho + 3]};
            *(LAS f32x4*)(TOT + (seg * 2 + 1) * 64 + 0 + 8 * rho + 4 * hh) = (f32x4){hi0[4 * rho], hi0[4 * rho + 1], hi0[4 * rho + 2], hi0[4 * rho + 3]};
            *(LAS f32x4*)(TOT + (seg * 2 + 1) * 64 + 32 + 8 * rho + 4 * hh) = (f32x4){hi1[4 * rho], hi1[4 * rho + 1], hi1[4 * rho + 2], hi1[4 * rho + 3]}; }
    }
    __syncthreads();
    if (F.tid < 64) {
        const float* z16 = (const float*)(tab + TB_Z16N) + (size_t)g * 128; const float zr = z16[F.tid], zi = z16[64 + F.tid];
        float cr = 0.f, ci = 0.f;
#pragma unroll
        for (int sg = 0; sg < 16; ++sg) { CAR[(sg * 2 + 0) * 64 + F.tid] = cr; CAR[(sg * 2 + 1) * 64 + F.tid] = ci;
            const float tr = TOT[(sg * 2 + 0) * 64 + F.tid], ti = TOT[(sg * 2 + 1) * 64 + F.tid];
            const float ncr = zr * cr - zi * ci + tr, nci = zr * ci + zi * cr + ti; cr = ncr; ci = nci; }
    }
    __syncthreads();
    {
        const LAS float* z = ZP + (((q & 15) * 2 + hh) * 2) * 32;
#define S5_EXCL(HR, HI, OFF) do { const f32x16 zr = ld16l(z + (OFF)), zi = ld16l(z + 32 + (OFF)); f32x16 kr, ki; \
        _Pragma("unroll") for (int rho = 0; rho < 4; ++rho) { \
            const f32x4 a0 = *(const LAS f32x4*)(CAR + (seg * 2 + 0) * 64 + 2 * (OFF) + 8 * rho + 4 * hh), b0 = *(const LAS f32x4*)(CAR + (seg * 2 + 1) * 64 + 2 * (OFF) + 8 * rho + 4 * hh); \
            _Pragma("unroll") for (int e = 0; e < 4; ++e) { kr[4 * rho + e] = a0[e]; ki[4 * rho + e] = b0[e]; } } \
        _Pragma("unroll") for (int i = 0; i < 16; ++i) { const float sr = dppf<0x111>(0.f, HR[i]), si = dppf<0x111>(0.f, HI[i]); \
            HR[i] = sr + zr[i] * kr[i] - zi[i] * ki[i]; HI[i] = si + zr[i] * ki[i] + zi[i] * kr[i]; } } while (0)
        S5_EXCL(hr0, hi0, 0); asm volatile("" : "+v"(hr0), "+v"(hi0) :: "memory"); S5_EXCL(hr1, hi1, 16); asm volatile("" : "+v"(hr1), "+v"(hi1) :: "memory");
#undef S5_EXCL
    }
    { int off = 0; asm volatile("" : "+v"(off)); const LAS float* TA2 = TA + off; ar0 = ld16l(TA2); ar1 = ld16l(TA2 + 16); ai0 = ld16l(TA2 + 32); ai1 = ld16l(TA2 + 48); }
#pragma unroll 1
    for (int j = 0; j < 8; ++j) { const bf16x8v u = __builtin_bit_cast(bf16x8v, UL[512 * j]);
        s5_step<true>(L, lane, u, hr0, hr1, hi0, hi1, ar0, ar1, ai0, ai1, dk, grow + (size_t)j * WB); }
    if (w == NWAVES - 1 && q == 31) {
        float* osr = F.out + O_SRP + (size_t)(b * GB + g) * NS5; float* osi = F.out + O_SIP + (size_t)(b * GB + g) * NS5;
#pragma unroll
        for (int i = 0; i < 16; ++i) { const int n = (i & 3) + 8 * (i >> 2) + 4 * hh; osr[n] = hr0[i]; osr[32 + n] = hr1[i]; osi[n] = hi0[i]; osi[32 + n] = hi1[i]; }
    }
    __syncthreads();
}

__device__ __forceinline__ void s5_item_sample(Frame& F, const Args& A, int g) {
    refresh(F);
    const int lane = F.lane, q = lane & 31, hh = lane >> 5, w = F.wave;
    LAS unsigned char* L = F.lds + RING_OFF;
    const unsigned char* tab = F.ws + WS_TAB;
    { const v4u* s1 = (const v4u*)(tab + TB_BF1) + (size_t)g * 256; const v4u* s2 = (const v4u*)(tab + TB_BF2) + (size_t)g * 512;
      if (F.tid < 256) ((LAS v4u*)(L + S5L_BF1))[F.tid] = s1[F.tid];
      ((LAS v4u*)(L + S5L_BF2))[F.tid] = s2[F.tid]; }
    __syncthreads();
    if (w < 4) {
        const int b = w * 32 + q;
        const float* TA = (const float*)(tab + TB_TA) + (size_t)((g * 2 + hh) * 2) * 32;
        const f32x16 ar0 = ld16(TA), ar1 = ld16(TA + 16), ai0 = ld16(TA + 32), ai1 = ld16(TA + 48);
        f32x16 hr0, hr1, hi0, hi1;
        const float* sr = A.in[I_SSR] + (size_t)(b * GB + g) * NS5; const float* si = A.in[I_SSI] + (size_t)(b * GB + g) * NS5;
#pragma unroll
        for (int rho = 0; rho < 4; ++rho) { const f32x4 a0 = *(const f32x4*)(sr + 8 * rho + 4 * hh), a1 = *(const f32x4*)(sr + 32 + 8 * rho + 4 * hh), b0 = *(const f32x4*)(si + 8 * rho + 4 * hh), b1 = *(const f32x4*)(si + 32 + 8 * rho + 4 * hh);
#pragma unroll
            for (int e = 0; e < 4; ++e) { hr0[4 * rho + e] = a0[e]; hr1[4 * rho + e] = a1[e]; hi0[4 * rho + e] = b0[e]; hi1[4 * rho + e] = b1[e]; } }
        float dk[8];
#pragma unroll
        for (int i = 0; i < 8; ++i) dk[i] = A.in[I_S5D][g * KS5 + 8 * hh + i];
        const size_t m0 = (size_t)MP + (size_t)b * TS;
        const bf16* zrow = (const bf16*)(F.ws + WS_Z) + m0 * NZ + 2 * WA + g * KS5 + 8 * hh;
        bf16* grow = (bf16*)(F.ws + WS_G) + m0 * WB + g * KS5 + 8 * hh;
        bf16x8v uu[TS];
#pragma unroll
        for (int j = 0; j < TS; ++j) uu[j] = *(const bf16x8v*)(zrow + (size_t)j * NZ);
#pragma unroll
        for (int j = 0; j < TS; ++j) s5_step<true>(L, lane, uu[j], hr0, hr1, hi0, hi1, ar0, ar1, ai0, ai1, dk, grow + (size_t)j * WB);
        float* osr = F.out + O_SRS + (size_t)(b * GB + g) * NS5; float* osi = F.out + O_SIS + (size_t)(b * GB + g) * NS5;
#pragma unroll
        for (int rho = 0; rho < 4; ++rho) {
            *(f32x4*)(osr + 8 * rho + 4 * hh) = (f32x4){hr0[4 * rho], hr0[4 * rho + 1], hr0[4 * rho + 2], hr0[4 * rho + 3]};
            *(f32x4*)(osr + 32 + 8 * rho + 4 * hh) = (f32x4){hr1[4 * rho], hr1[4 * rho + 1], hr1[4 * rho + 2], hr1[4 * rho + 3]};
            *(f32x4*)(osi + 8 * rho + 4 * hh) = (f32x4){hi0[4 * rho], hi0[4 * rho + 1], hi0[4 * rho + 2], hi0[4 * rho + 3]};
            *(f32x4*)(osi + 32 + 8 * rho + 4 * hh) = (f32x4){hi1[4 * rho], hi1[4 * rho + 1], hi1[4 * rho + 2], hi1[4 * rho + 3]}; }
    }
    __syncthreads();
}

template <int CTRL, int RMASK> __device__ __forceinline__ float dppm(float old, float v) { return __builtin_bit_cast(float, __builtin_amdgcn_update_dpp(__builtin_bit_cast(int, old), __builtin_bit_cast(int, v), CTRL, RMASK, 0xF, false)); }
template <int CTRL, int RMASK> __device__ __forceinline__ void rg_scan_step(f32x16& a, f32x16& b) {
#pragma unroll
    for (int i = 0; i < 16; ++i) { const float as = dppm<CTRL, RMASK>(1.f, a[i]), bs = dppm<CTRL, RMASK>(0.f, b[i]); b[i] = a[i] * bs + b[i]; a[i] = a[i] * as; }
}
constexpr int RGL_AFR = 0, RGL_CWT = 8192, RGL_TOT = 10240, RGL_CST = 14336;
constexpr int RGL_XAP = 144, RGL_GTP = 80;
constexpr int RGL_XA0 = 14848, RGL_GT0 = RGL_XA0 + 37376, RGL_BUF = 37376 + 20480;
static_assert(259 * RGL_XAP <= 37376 && 256 * RGL_GTP <= 20480 && RGL_XA0 + 2 * RGL_BUF <= RING_BYTES, "RG-LRU LDS map");
template <bool SAMPLE>
__device__ __forceinline__ void rg_item_fast(Frame& F, const Args& A, int b, int hd, int jh) {
    refresh(F);
    const int lane = F.lane, q = lane & 31, hh = lane >> 5, w = F.wave;
    LAS unsigned char* L = F.lds + RING_OFF;
    const float* sc = (const float*)(F.ws + WS_S5C);
    const bf16* Zb = (const bf16*)(F.ws + WS_Z) + (size_t)(SAMPLE ? MP : b * TP) * NZ; bf16* Yb = (bf16*)(F.ws + WS_YCAT) + (size_t)(SAMPLE ? MP : b * TP) * D;
    const bf16* CB = (const bf16*)(F.ws + WS_TAB + TB_CB);
    auto stage_load = [&](int T0, v4u (&st)[7]) {
#pragma unroll
        for (int k = 0; k < 7; ++k) { const int ci = F.tid + 512 * k; v4u v = (v4u){0u, 0u, 0u, 0u};
            if (ci < 2072) { const int tk = T0 - 3 + (ci >> 3); if (tk >= 0) v = *(const v4u*)(Zb + (size_t)tk * NZ + WA + hd * 64 + (ci & 7) * 8); }
            else if (ci < 2072 + 1024) { const int gi = ci - 2072; v = *(const v4u*)(Zb + (size_t)(T0 + (gi >> 2)) * NZ + hd * 64 + 32 * jh + (gi & 3) * 8); }
            st[k] = v; } };
    auto stage_write = [&](int par, const v4u (&st)[7]) {
#pragma unroll
        for (int k = 0; k < 7; ++k) { const int ci = F.tid + 512 * k;
            if (ci < 2072) *(LAS v4u*)(L + RGL_XA0 + par * RGL_BUF + (ci >> 3) * RGL_XAP + (ci & 7) * 16) = st[k];
            else if (ci < 2072 + 1024) { const int gi = ci - 2072; *(LAS v4u*)(L + RGL_GT0 + par * RGL_BUF + (gi >> 2) * RGL_GTP + (gi & 3) * 16) = st[k]; } } };
    {
        const v4u* src = (const v4u*)(F.ws + WS_TAB + TB_RG) + (size_t)((hd * 2 + jh) * 8) * 64;
        ((LAS v4u*)(L + RGL_AFR))[F.tid] = src[F.tid];
        if (F.tid < 320) { const int h2 = F.tid / 160, tap = (F.tid % 160) / 32, e = F.tid % 32, c = hd * 64 + 16 * (e >> 3) + 8 * h2 + (e & 7);
            ((LAS float*)(L + RGL_CWT))[F.tid] = tap < 4 ? A.in[I_CONVW][tap * WA + c] : A.in[I_CONVB][c]; }
        if (F.tid >= 384 && F.tid < 480) { const int e = F.tid - 384, h2 = e / 48, kind = (e % 48) / 16, i = e % 16, c = hd * 64 + 32 * jh + 16 * (i >> 3) + 8 * h2 + (i & 7);
            ((LAS float*)(L + RGL_CST))[e] = kind == 0 ? A.in[I_RGBR][c] : (kind == 1 ? A.in[I_RGBI][c] : sc[SC_RGL + c]); }
        if (!SAMPLE && jh == 0 && F.tid < 192) { const int k = F.tid >> 6, ch = F.tid & 63;
            F.out[O_CONVP + (size_t)(b * 3 + k) * WA + hd * 64 + ch] = bf2f(((const bf16*)(F.ws + WS_Z))[(size_t)(b * TP + TP - 3 + k) * NZ + WA + hd * 64 + ch]); }
        if (SAMPLE && jh == 0) { for (int e = F.tid; e < NBS * 3 * 64; e += NWAVES * 64) { const int bb = e / 192, k = (e / 64) % 3, ch = e & 63;
            F.out[O_CONVS + (size_t)(bb * 3 + k) * WA + hd * 64 + ch] = bf2f(((const bf16*)(F.ws + WS_Z))[(size_t)(MP + bb * TS + 1 + k) * NZ + WA + hd * 64 + ch]); } }
        if (!SAMPLE) { v4u st[7]; stage_load(0, st); stage_write(0, st); }
    }
    __syncthreads();
    float hround[16];
#pragma unroll
    for (int i = 0; i < 16; ++i) hround[i] = 0.f;
    const LAS float* CWT = (const LAS float*)(L + RGL_CWT) + hh * 160;
#pragma unroll 1
    for (int rd = 0; rd < (SAMPLE ? 2 : 8); ++rd) {
        const int t = rd * 256 + w * 32 + q;
        v4u stn[7];
        if (!SAMPLE) stage_load((rd + 1) * 256, stn);
        const LAS unsigned char* XAp = L + RGL_XA0 + (rd & 1) * RGL_BUF + (w * 32 + q) * RGL_XAP + 16 * hh;
        const LAS unsigned char* GTp = L + RGL_GT0 + (rd & 1) * RGL_BUF + (w * 32 + q) * RGL_GTP + 16 * hh;
        const bf16* zsr[4];
        if (SAMPLE) {
#pragma unroll
            for (int k = 0; k < 4; ++k) { const int jx = (t & 3) + k; zsr[k] = (jx < 3 ? CB + (size_t)((t >> 2) * 3 + jx) * WA : Zb + (size_t)(t - 3 + k) * NZ + WA) + hd * 64 + 8 * hh; } }
        v4u g0, g1;
        if (SAMPLE) { const bf16* gr = Zb + (size_t)t * NZ + hd * 64 + 32 * jh + 8 * hh; g0 = *(const v4u*)gr; g1 = *(const v4u*)(gr + 16); }
        else { g0 = *(const LAS v4u*)GTp; g1 = *(const LAS v4u*)(GTp + 32); }
        float xc[32];
#pragma unroll
        for (int s4 = 0; s4 < 4; ++s4) {
            float acc[8];
#pragma unroll
            for (int j4 = 0; j4 < 2; ++j4) { const f32x4 cb = *(const LAS f32x4*)(CWT + 4 * 32 + s4 * 8 + 4 * j4); acc[4 * j4] = cb[0]; acc[4 * j4 + 1] = cb[1]; acc[4 * j4 + 2] = cb[2]; acc[4 * j4 + 3] = cb[3]; }
#pragma unroll
            for (int k = 0; k < 4; ++k) { const v4u v = SAMPLE ? *(const v4u*)(zsr[k] + 16 * s4) : *(const LAS v4u*)(XAp + k * RGL_XAP + s4 * 32);
                const f32x4 w0 = *(const LAS f32x4*)(CWT + k * 32 + s4 * 8), w1 = *(const LAS f32x4*)(CWT + k * 32 + s4 * 8 + 4);
                acc[0] += w0[0] * pg8::bf_lo(v.x); acc[1] += w0[1] * pg8::bf_hi(v.x); acc[2] += w0[2] * pg8::bf_lo(v.y); acc[3] += w0[3] * pg8::bf_hi(v.y);
                acc[4] += w1[0] * pg8::bf_lo(v.z); acc[5] += w1[1] * pg8::bf_hi(v.z); acc[6] += w1[2] * pg8::bf_lo(v.w); acc[7] += w1[3] * pg8::bf_hi(v.w); }
#pragma unroll
            for (int e = 0; e < 8; ++e) xc[s4 * 8 + e] = acc[e];
            asm volatile("" : "+v"(xc[s4 * 8]), "+v"(xc[s4 * 8 + 7]) :: "memory");
        }
        f32x16 dr, di;
#pragma unroll
        for (int i = 0; i < 16; ++i) { dr[i] = 0.f; di[i] = 0.f; }
        const LAS bf16x8v* af = (const LAS bf16x8v*)(L + RGL_AFR) + lane;
#pragma unroll
        for (int s4 = 0; s4 < 4; ++s4) { v4u p; p.x = pkbf(xc[s4 * 8], xc[s4 * 8 + 1]); p.y = pkbf(xc[s4 * 8 + 2], xc[s4 * 8 + 3]); p.z = pkbf(xc[s4 * 8 + 4], xc[s4 * 8 + 5]); p.w = pkbf(xc[s4 * 8 + 6], xc[s4 * 8 + 7]);
            const bf16x8v bfr = __builtin_bit_cast(bf16x8v, p);
            dr = MFMA32(af[s4 * 64], bfr, dr); di = MFMA32(af[(4 + s4) * 64], bfr, di); }
        f32x16 av, bv;
        const bool first = !SAMPLE && (t == 0);
        const LAS float* CST = (const LAS float*)(L + RGL_CST) + hh * 48;
#pragma unroll
        for (int i = 0; i < 16; ++i) { const float xcv = jh ? xc[16 + i] : xc[i];
            const float r = sigmoidf_(dr[i] + CST[i]), gi = sigmoidf_(di[i] + CST[16 + i]);
            const float a = __builtin_amdgcn_exp2f(r * CST[32 + i]);
            float mult = __builtin_amdgcn_sqrtf(fmaxf(1.f - a * a, 0.f)); if (first) mult = 1.f;
            av[i] = a; bv[i] = mult * gi * xcv; }
        if (SAMPLE && (t & 3) == 0) {
            const float* h0 = A.in[I_SH] + (size_t)(t >> 2) * WA + hd * 64 + 32 * jh + 8 * hh;
#pragma unroll
            for (int i = 0; i < 16; ++i) { bv[i] += av[i] * h0[16 * (i >> 3) + (i & 7)]; av[i] = 0.f; } }
        rg_scan_step<0x111, 0xF>(av, bv); rg_scan_step<0x112, 0xF>(av, bv); rg_scan_step<0x114, 0xF>(av, bv); rg_scan_step<0x118, 0xF>(av, bv);
        rg_scan_step<0x142, 0xA>(av, bv);
        float hin[16];
#pragma unroll
        for (int i = 0; i < 16; ++i) hin[i] = 0.f;
        if (!SAMPLE) {
        LAS float* TOT = (LAS float*)(L + RGL_TOT) + (rd & 1) * 512;
        if (q == 31) {
#pragma unroll
            for (int i4 = 0; i4 < 4; ++i4) { *(LAS f32x4*)(TOT + (w * 2 + 0) * 32 + hh * 16 + 4 * i4) = (f32x4){av[4 * i4], av[4 * i4 + 1], av[4 * i4 + 2], av[4 * i4 + 3]};
                                             *(LAS f32x4*)(TOT + (w * 2 + 1) * 32 + hh * 16 + 4 * i4) = (f32x4){bv[4 * i4], bv[4 * i4 + 1], bv[4 * i4 + 2], bv[4 * i4 + 3]}; }
        }
        stage_write((rd + 1) & 1, stn);
        __syncthreads();
#pragma unroll
        for (int w2 = 0; w2 < 8; ++w2) {
            if (w2 == w) {
#pragma unroll
                for (int i = 0; i < 16; ++i) hin[i] = hround[i]; }
#pragma unroll
            for (int i4 = 0; i4 < 4; ++i4) { const f32x4 p = *(const LAS f32x4*)(TOT + (w2 * 2 + 0) * 32 + hh * 16 + 4 * i4), hl = *(const LAS f32x4*)(TOT + (w2 * 2 + 1) * 32 + hh * 16 + 4 * i4);
#pragma unroll
                for (int e = 0; e < 4; ++e) hround[4 * i4 + e] = p[e] * hround[4 * i4 + e] + hl[e]; }
        }
        }
        float o[16];
        const unsigned gw_[8] = {g0.x, g0.y, g0.z, g0.w, g1.x, g1.y, g1.z, g1.w};
#pragma unroll
        for (int i = 0; i < 16; ++i) { const float h = bv[i] + av[i] * hin[i]; const float gt = (i & 1) ? pg8::bf_hi(gw_[i >> 1]) : pg8::bf_lo(gw_[i >> 1]); o[i] = gelu_tanh(gt) * h; }
        bf16* yr = Yb + (size_t)t * D + hd * 64 + 32 * jh + 8 * hh;
        v4u w0; w0.x = pkbf(o[0], o[1]); w0.y = pkbf(o[2], o[3]); w0.z = pkbf(o[4], o[5]); w0.w = pkbf(o[6], o[7]);
        v4u w1; w1.x = pkbf(o[8], o[9]); w1.y = pkbf(o[10], o[11]); w1.z = pkbf(o[12], o[13]); w1.w = pkbf(o[14], o[15]);
        *(v4u*)yr = w0; *(v4u*)(yr + 16) = w1;
        if (SAMPLE && (t & 3) == 3) {
#pragma unroll
            for (int i = 0; i < 16; ++i) F.out[O_HS + (size_t)(t >> 2) * WA + hd * 64 + 32 * jh + 16 * (i >> 3) + 8 * hh + (i & 7)] = bv[i]; }
    }
    if (!SAMPLE && w == 0 && q == 0) {
#pragma unroll
        for (int i = 0; i < 16; ++i) F.out[O_HP + (size_t)b * WA + hd * 64 + 32 * jh + 16 * (i >> 3) + 8 * hh + (i & 7)] = hround[i];
    }
    __syncthreads();
}

#ifndef PROBE_P3PART
#define PROBE_P3PART 7
#endif
__device__ __forceinline__ void p3_mixers_ref(Frame& F, const Args& A, int rep = 0) {
    constexpr int N_RGP = NBP * HA, N_S5P = NBP * GB;
    const int pm = rep ? PROBE_P3PART : 7;
    if (F.vcu < 2 * N_RGP) {
        if (pm & 1) rg_item_fast<false>(F, A, F.vcu / (2 * HA), (F.vcu / 2) % HA, F.vcu & 1);
    } else {
        const int v = F.vcu - 2 * N_RGP, it = 2 * v;
        if (pm & 2) { s5_item_fast(F, A, it / GB, it % GB);
                      s5_item_fast(F, A, (it + 1) / GB, (it + 1) % GB); }
        if (pm & 4) { if (v < GB) s5_item_sample(F, A, v);
                      else if (v < GB + 2 * HA) rg_item_fast<true>(F, A, 0, (v - GB) >> 1, (v - GB) & 1); }
    }
}

__global__ void __launch_bounds__(NWAVES * 64, 2) fwd(Args A) {
    extern __shared__ __attribute__((aligned(16))) unsigned char lds[];
    Frame F;
    F.lds = (LAS unsigned char*)lds;
    F.MISC = (volatile LAS unsigned*)(F.lds + MISC_OFF);
    F.tid = threadIdx.x; F.lane = F.tid & 63; F.wave = __builtin_amdgcn_readfirstlane(F.tid >> 6);
    F.G = gridDim.x; { const int bx = blockIdx.x; F.vcu = (F.G % 8 == 0) ? (bx % 8) * (F.G / 8) + bx / 8 : bx; }
    F.out = A.out; F.ws = A.ws; F.ctl = (gu32*)(A.ws + WS_CTL);
    for (int u = F.tid; u < (LDS_BYTES - LDSCTL_OFF) / 4; u += NWAVES * 64) ((LAS unsigned*)(F.lds + LDSCTL_OFF))[u] = 0u;
    __syncthreads();
    XcdBarrier bar; bar.bar = (unsigned*)(F.ctl + CW_BAR); bar.x = 0; bar.st = nullptr;
    if (N_LAUNCHES == 1) bar = xcd_barrier_post((unsigned*)(F.ctl + CW_BAR), F.MISC + 8);
#define GRID_BAR() do { if (N_LAUNCHES == 1) xcd_barrier(bar); } while (0)
    const int lo = A.ph_lo, hi = A.ph_hi;
#define IN(k) (lo <= (k) && (k) < hi)
#define BOTH(k) (IN(k) && IN((k) + 1))
    bf16* XN = (bf16*)(F.ws + WS_XN); bf16* Z = (bf16*)(F.ws + WS_Z); bf16* YC = (bf16*)(F.ws + WS_YCAT); bf16* GY = (bf16*)(F.ws + WS_G); bf16* U = (bf16*)(F.ws + WS_U);
    const float* mod = (const float*)(F.ws + WS_MOD);

#define REPS(k) (((PROBE_DUP) >> (k)) & 1 ? 2 : 1)
    if (IN(0)) { for (int rep = 0; rep < REPS(0); ++rep) p0_prologue(F, A, rep); if (BOTH(0)) GRID_BAR(); }
    if (IN(1)) { for (int rep = 0; rep < REPS(1); ++rep) p1_modulate(F, A); if (BOTH(1)) GRID_BAR(); }
    if (IN(2)) for (int rep = 0; rep < REPS(2); ++rep) {
        pg8::Gemm g{XN, (const bf16*)(F.ws + WS_WIN), M, NZ, D}; pg8::StaticOrder S; S.init(M, NZ, F.G, (int)blockIdx.x, D);
        pg8::EpiBf16<0> E{Z, NZ, nullptr};
        pg8::gemm_phase<pg8::EpiBf16<0>, pg8::StaticOrder, PG8_ALIGN, PG8_SP2>(F.lds + RING_OFF, g, S, E);
        if (BOTH(2) && rep == REPS(2) - 1) GRID_BAR();
    }
    if (IN(3)) {
#pragma unroll 1
        for (int rep = 0; rep < REPS(3); ++rep) p3_mixers_ref(F, A, rep);
        if (BOTH(3)) GRID_BAR(); }
    if (IN(4)) for (int rep = 0; rep < REPS(4); ++rep) {
        pg8::Gemm g{GY, (const bf16*)(F.ws + WS_WGLU), M, WB, WB}; pg8::StaticOrder S; S.init(M, WB, F.G, (int)blockIdx.x, WB);
        pg8::EpiGlu E{GY, WB, YC, D, WA, A.in[I_GLUB]};
        pg8::gemm_phase<pg8::EpiGlu, pg8::StaticOrder, PG8_ALIGN, PG8_SP2>(F.lds + RING_OFF, g, S, E);
        if (BOTH(4) && rep == REPS(4) - 1) GRID_BAR();
    }
    if (IN(5)) {
        pg8::Gemm g{YC, (const bf16*)(F.ws + WS_WOUT), M, D, D}; pg8::SplitOrder S; S.init(MP, D, F.G, (int)blockIdx.x, D, NS_OUT);
        pg8::EpiRes E{A.in[I_XP], A.in[I_XS], F.out, mod + 2 * D, nullptr, ALPHA, MP, (float*)(F.ws + WS_SLAB)};
        pg8::gemm_phase<pg8::EpiRes, pg8::SplitOrder, PG8_ALIGN, PG8_SP2>(F.lds + RING_OFF, g, S, E);
        if (BOTH(5)) GRID_BAR();
    }
    if (IN(6)) { ln_rows<false>(F, A); if (BOTH(6)) GRID_BAR(); }
    if (IN(7)) for (int rep = 0; rep < REPS(7); ++rep) {
        pg8::Gemm g{XN, (const bf16*)(F.ws + WS_W1), M, FF, D}; pg8::StaticOrder S; S.init(M, FF, F.G, (int)blockIdx.x, D);
        pg8::EpiBf16<3> E{U, FF, A.in[I_B1]};
        pg8::gemm_phase<pg8::EpiBf16<3>, pg8::StaticOrder, PG8_ALIGN, PG8_SP2>(F.lds + RING_OFF, g, S, E);
        if (BOTH(7) && rep == REPS(7) - 1) GRID_BAR();
    }
    if (IN(8)) {
        pg8::Gemm g{U, (const bf16*)(F.ws + WS_W2), M, D, FF}; pg8::SplitOrder S; S.init(MP, D, F.G, (int)blockIdx.x, FF, NS_DOWN);
        pg8::EpiRes E{F.out, F.out + (size_t)MP * D, F.out, mod + 5 * D, A.in[I_B2], ALPHA, MP, (float*)(F.ws + WS_SLAB)};
        pg8::gemm_phase<pg8::EpiRes, pg8::SplitOrder, PG8_ALIGN, PG8_SP2>(F.lds + RING_OFF, g, S, E);
        if (BOTH(8)) GRID_BAR();
    }
    if (IN(9)) { ln_rows<true>(F, A); }
#undef IN
#undef BOTH
}

extern "C" void kernel_launch(void* const* d_in, const int* in_sizes, int n_in, void* d_out, int out_size, void* d_ws, size_t ws_size, hipStream_t stream) {
    static int grid = 0;
    if (grid == 0) {
        if (n_in != 37 || in_sizes[0] != MP * D || out_size != (int)O_END || ws_size < WS_END) { fprintf(stderr, "kernel_launch: unexpected shapes (n_in %d, in0 %d, out %d, ws %zu)\n", n_in, n_in > 0 ? in_sizes[0] : -1, out_size, ws_size); grid = -1; return; }
        int dev = 0, cus = 0, per_cu = 0;
        if (hipGetDevice(&dev) != hipSuccess || hipDeviceGetAttribute(&cus, hipDeviceAttributeMultiprocessorCount, dev) != hipSuccess) { grid = -1; return; }
        if (hipFuncSetAttribute((const void*)fwd, hipFuncAttributeMaxDynamicSharedMemorySize, LDS_BYTES) != hipSuccess) { fprintf(stderr, "kernel_launch: hipFuncSetAttribute failed\n"); grid = -1; return; }
        if (hipOccupancyMaxActiveBlocksPerMultiprocessor(&per_cu, (const void*)fwd, NWAVES * 64, LDS_BYTES) != hipSuccess || per_cu < 1) { fprintf(stderr, "kernel_launch: occupancy query says %d\n", per_cu); }
        (void)hipGetLastError();
        grid = cus;
        if (grid < 256) { fprintf(stderr, "kernel_launch: this build needs 256 CUs (got %d)\n", grid); grid = -1; return; }
        grid = 256;
    }
    if (grid < 0) return;
    (void)hipMemsetAsync((char*)d_ws + WS_CTL, 0, CTL_ZERO_BYTES, stream);
    Args a{};
    for (int i = 0; i < 37; ++i) a.in[i] = (const float*)d_in[i];
    a.out = (float*)d_out; a.ws = (unsigned char*)d_ws;
    for (int li = 0; li < N_LAUNCHES; ++li) {
        if (N_LAUNCHES == 1) { a.ph_lo = 0; a.ph_hi = N_PHASES; } else { a.ph_lo = li; a.ph_hi = li + 1; }
        a.li = li;
        hipLaunchKernelGGL(fwd, dim3(grid), dim3(NWAVES * 64), LDS_BYTES, stream, a);
    }
}
```

```cpp
#include <hip/hip_runtime.h>
#include <cstdio>
#include <cstdint>
#include <cmath>

#ifndef MK_N_LAUNCHES
#define MK_N_LAUNCHES 1
#endif

namespace pg8 {
#define PG8_LAS __attribute__((address_space(3)))
typedef unsigned short bf16_t;
typedef short bf16x8 __attribute__((ext_vector_type(8)));
typedef float f32x4 __attribute__((ext_vector_type(4)));
typedef unsigned u32x4 __attribute__((ext_vector_type(4)));
constexpr int BM = 256, BK = 64, HALF = 128, HTB = HALF * BK * 2, STAGE_BYTES = 8 * HTB, NXCD = 8, WGM = 8;

__host__ __device__ __forceinline__ int lds_byte(int r, int c) { const int st = (r >> 4) * 2 + (c >> 5), rr = r & 15, cc = c & 31, ob = rr * 64 + cc * 2; return st * 1024 + (ob ^ (((ob >> 9) & 1) << 5)); }
__host__ __device__ __forceinline__ void stage_rc(int b, int& R, int& C) { const int st = b / 1024, sb = b % 1024, swz = sb ^ (((sb >> 9) & 1) << 5); R = (st >> 1) * 16 + swz / 64; C = (st & 1) * 32 + (swz % 64) / 2; }
__host__ __device__ __forceinline__ int perm32(int rho) { const int n = rho >> 4, i = rho & 15; return 8 * (i >> 2) + 4 * n + (i & 3); }

struct Unit { int pm, pn, k0, nkt, ks; };
struct Gemm { const bf16_t* A; const bf16_t* Bt; int M, N, K; };

struct StaticOrder {
    int nM, nN, nwg, G, c, K;
    __host__ __device__ void init(int M, int N, int G_, int c_, int K_) { nM = M / BM; nN = N / BM; nwg = nM * nN; G = G_; c = c_; K = K_; }
    __host__ __device__ __forceinline__ bool next(int i, Unit& u) const {
        const long L = (long)i * G + c; if (L >= nwg) return false;
        int wgid = (int)L; { const int q = nwg / NXCD, r = nwg % NXCD, xcd = wgid % NXCD, off = wgid / NXCD; wgid = (xcd < r ? xcd * (q + 1) : r * (q + 1) + (xcd - r) * q) + off; }
        const int nig = WGM * nN, gid = wgid / nig, fm = gid * WGM, gsz = (nM - fm) < WGM ? (nM - fm) : WGM;
        u.pm = fm + ((wgid % nig) % gsz); u.pn = (wgid % nig) / gsz; u.k0 = 0; u.nkt = K / BK; u.ks = 0; return true;
    }
    __device__ __forceinline__ void a_ready(const Unit&) const {}
    __device__ __forceinline__ void done(const Unit&) const {}
};

struct SplitOrder {
    StaticOrder P; int nN, NS, nP, G, c, K, r0;
    __host__ __device__ void init(int MPr, int N, int G_, int c_, int K_, int NS_) { P.init(MPr, N, G_, c_, K_); nN = N / BM; NS = NS_; nP = 2 * nN * NS; G = G_; c = c_; K = K_; r0 = (P.nwg + G - 1 - c) / G;   }
    __host__ __device__ __forceinline__ bool next(int i, Unit& u) const {
        Unit a; a.pm = 0; a.pn = 0; a.k0 = 0; a.nkt = K / BK; a.ks = 0;
        const bool okp = P.next(i < r0 ? i : 0, a);
        const int p = (i - r0) * G + (G - 1 - c), t = p / NS, ks = p % NS, nk = K / BK / NS;
        const bool split = i >= r0;
        u.pm = split ? P.nM + t / nN : a.pm; u.pn = split ? t % nN : a.pn; u.nkt = split ? nk : a.nkt; u.ks = split ? ks : 0; u.k0 = split ? ks * nk * BK : 0;
        return split ? (p < nP) : okp;
    }
    __device__ __forceinline__ void a_ready(const Unit&) const {}
    __device__ __forceinline__ void done(const Unit&) const {}
};

__device__ __forceinline__ unsigned cvt_pk_bf16(float lo, float hi) { unsigned r; asm volatile("v_cvt_pk_bf16_f32 %0, %1, %2" : "=v"(r) : "v"(lo), "v"(hi)); return r; }
__device__ __forceinline__ float bf_lo(unsigned w) { return __builtin_bit_cast(float, w << 16); }
__device__ __forceinline__ float bf_hi(unsigned w) { return __builtin_bit_cast(float, w & 0xffff0000u); }

template <int ACT> struct EpiBf16 {
    static constexpr bool PERM = true, AFTER_DRAIN = false;
    bf16_t* O; int ldc; const float* bias;
    __device__ __forceinline__ void operator()(const f32x4 (&acc)[2][2][4][2], const Unit& u, int wr, int wc, int fr, int fq) const {
        const int row0 = u.pm * BM + wr * 64 + fr; const int col0 = u.pn * BM + wc * 32 + 8 * fq;
        f32x4 bv[2][2];
#pragma unroll
        for (int bj = 0; bj < 2; ++bj)
#pragma unroll
            for (int n = 0; n < 2; ++n) bv[bj][n] = bias ? *(const f32x4*)(bias + col0 + bj * HALF + 4 * n) : (f32x4){0.f, 0.f, 0.f, 0.f};
#pragma unroll
        for (int ai = 0; ai < 2; ++ai)
#pragma unroll
            for (int m = 0; m < 4; ++m) { bf16_t* rowp = O + (size_t)(row0 + ai * HALF + m * 16) * ldc + col0;
#pragma unroll
                for (int bj = 0; bj < 2; ++bj) { f32x4 v0 = acc[ai][bj][m][0] + bv[bj][0], v1 = acc[ai][bj][m][1] + bv[bj][1];
                    if (ACT == 3) {
#pragma unroll
                        for (int e = 0; e < 4; ++e) { const float a = fmaxf(v0[e], 0.f), b = fmaxf(v1[e], 0.f); v0[e] = a * a; v1[e] = b * b; } }
                    u32x4 w; w.x = cvt_pk_bf16(v0[0], v0[1]); w.y = cvt_pk_bf16(v0[2], v0[3]); w.z = cvt_pk_bf16(v1[0], v1[1]); w.w = cvt_pk_bf16(v1[2], v1[3]);
                    *(u32x4*)(rowp + bj * HALF) = w; } }
    }
};
struct EpiGlu {
    static constexpr bool PERM = true, AFTER_DRAIN = false;
    const bf16_t* Gy; int ldg; bf16_t* O; int ldc; int coff; const float* bias;
    __device__ __forceinline__ void operator()(const f32x4 (&acc)[2][2][4][2], const Unit& u, int wr, int wc, int fr, int fq) const {
        const int row0 = u.pm * BM + wr * 64 + fr; const int col0 = u.pn * BM + wc * 32 + 8 * fq;
        f32x4 bv[2][2];
#pragma unroll
        for (int bj = 0; bj < 2; ++bj)
#pragma unroll
            for (int n = 0; n < 2; ++n) bv[bj][n] = *(const f32x4*)(bias + col0 + bj * HALF + 4 * n);
#pragma unroll
        for (int ai = 0; ai < 2; ++ai)
#pragma unroll
            for (int m = 0; m < 4; ++m) { const size_t row = (size_t)(row0 + ai * HALF + m * 16);
#pragma unroll
                for (int bj = 0; bj < 2; ++bj) { const f32x4 v0 = acc[ai][bj][m][0] + bv[bj][0], v1 = acc[ai][bj][m][1] + bv[bj][1];
                    const u32x4 g = *(const u32x4*)(Gy + row * ldg + col0 + bj * HALF);
                    float o[8];
                    o[0] = bf_lo(g.x) * __builtin_amdgcn_rcpf(1.f + __builtin_amdgcn_exp2f(-1.4426950408889634f * v0[0])); o[1] = bf_hi(g.x) * __builtin_amdgcn_rcpf(1.f + __builtin_amdgcn_exp2f(-1.4426950408889634f * v0[1]));
                    o[2] = bf_lo(g.y) * __builtin_amdgcn_rcpf(1.f + __builtin_amdgcn_exp2f(-1.4426950408889634f * v0[2])); o[3] = bf_hi(g.y) * __builtin_amdgcn_rcpf(1.f + __builtin_amdgcn_exp2f(-1.4426950408889634f * v0[3]));
                    o[4] = bf_lo(g.z) * __builtin_amdgcn_rcpf(1.f + __builtin_amdgcn_exp2f(-1.4426950408889634f * v1[0])); o[5] = bf_hi(g.z) * __builtin_amdgcn_rcpf(1.f + __builtin_amdgcn_exp2f(-1.4426950408889634f * v1[1]));
                    o[6] = bf_lo(g.w) * __builtin_amdgcn_rcpf(1.f + __builtin_amdgcn_exp2f(-1.4426950408889634f * v1[2])); o[7] = bf_hi(g.w) * __builtin_amdgcn_rcpf(1.f + __builtin_amdgcn_exp2f(-1.4426950408889634f * v1[3]));
                    u32x4 w; w.x = cvt_pk_bf16(o[0], o[1]); w.y = cvt_pk_bf16(o[2], o[3]); w.z = cvt_pk_bf16(o[4], o[5]); w.w = cvt_pk_bf16(o[6], o[7]);
                    *(u32x4*)(O + row * ldc + coff + col0 + bj * HALF) = w; } }
    }
};
struct EpiRes {
    static constexpr bool PERM = true, AFTER_DRAIN = false;
    const float* basep; bf16_t* T; const float* gate  ; const float* bias; float alpha; int MP; float* slab;
    __device__ __forceinline__ void operator()(const f32x4 (&acc)[2][2][4][2], const Unit& u, int wr, int wc, int fr, int fq) const {
        const int row0 = u.pm * BM + wr * 64 + fr, col0 = u.pn * BM + wc * 32 + 8 * fq;
        if (row0 >= MP) {
            float* sp = slab + (size_t)u.ks * 512 * 1024;
#pragma unroll
            for (int ai = 0; ai < 2; ++ai)
#pragma unroll
                for (int m = 0; m < 4; ++m) { float* op = sp + (size_t)(row0 + ai * HALF + m * 16 - MP) * 1024;
#pragma unroll
                    for (int bj = 0; bj < 2; ++bj)
#pragma unroll
                        for (int n = 0; n < 2; ++n) *(f32x4*)(op + col0 + bj * HALF + n * 4) = acc[ai][bj][m][n]; }
            return; }
        f32x4 bv[2][2];
#pragma unroll
        for (int bj = 0; bj < 2; ++bj)
#pragma unroll
            for (int n = 0; n < 2; ++n) bv[bj][n] = bias ? *(const f32x4*)(bias + col0 + bj * HALF + n * 4) : (f32x4){0.f, 0.f, 0.f, 0.f};
        const float* gp = gate + (size_t)(row0 >> 11) * 6144;
#pragma unroll
        for (int ai = 0; ai < 2; ++ai)
#pragma unroll
            for (int m = 0; m < 4; ++m) { const int row = row0 + ai * HALF + m * 16;
                const float* bp = basep + (size_t)row * 1024; bf16_t* tp = T + (size_t)row * 1024;
#pragma unroll
                for (int bj = 0; bj < 2; ++bj) { const int c = col0 + bj * HALF;
                    const f32x4 b0 = *(const f32x4*)(bp + c), b1 = *(const f32x4*)(bp + c + 4), g0 = *(const f32x4*)(gp + c), g1 = *(const f32x4*)(gp + c + 4);
                    const f32x4 v0 = b0 * alpha + g0 * (acc[ai][bj][m][0] + bv[bj][0]), v1 = b1 * alpha + g1 * (acc[ai][bj][m][1] + bv[bj][1]);
                    u32x4 w; w.x = cvt_pk_bf16(v0[0], v0[1]); w.y = cvt_pk_bf16(v0[2], v0[3]); w.z = cvt_pk_bf16(v1[0], v1[1]); w.w = cvt_pk_bf16(v1[2], v1[3]);
                    *(u32x4*)(tp + c) = w; } }
    }
};

template <class Epi, class Sched, bool ALIGN_EPI = false, bool SP2 = false>
__device__ __forceinline__ void gemm_phase(PG8_LAS unsigned char* lds, const Gemm g, const Sched& S, const Epi& E) {
    const int tid = threadIdx.x, wid = __builtin_amdgcn_readfirstlane(tid >> 6), lane = tid & 63, wr = wid >> 2, wc = wid & 3, fr = lane & 15, fq = lane >> 4;
    const int K = g.K;
    unsigned voffA[2], voffB[2];
#pragma unroll
    for (int i = 0; i < 2; ++i) { int R, C; stage_rc(tid * 16 + i * 8192, R, C); const int Rb = Epi::PERM ? ((R & ~31) + perm32(R & 31)) : R;
        voffA[i] = (unsigned)(R * K + C) * 2u; voffB[i] = (unsigned)(Rb * K + C) * 2u; }
    const size_t kstep = (size_t)(BK * 2);
    const size_t hstep = (size_t)HALF * K * 2;
    const size_t tstep = 2 * hstep;
    const unsigned ldsw = (unsigned)wid * 1024u;
    const int aoff = lds_byte(wr * 64 + fr, fq * 8), boff = lds_byte(wc * 32 + fr, fq * 8);
#define PG8_SA(b, h) (((b) * 2 + (h)) * HTB)
#define PG8_SB(b, h) ((4 + (b) * 2 + (h)) * HTB)
#define PG8_STAGE(bufoff, gbase, voff) do { _Pragma("unroll") for (int _i = 0; _i < 2; ++_i) \
        __builtin_amdgcn_global_load_lds((const unsigned*)((const char*)(gbase) + (voff)[_i]), (PG8_LAS unsigned*)(lds + (bufoff) + ldsw + _i * 8192), 16, 0, 0); } while (0)
#define PG8_LDA(dst, b, h) do { _Pragma("unroll") for (int m = 0; m < 4; ++m) _Pragma("unroll") for (int k = 0; k < 2; ++k) dst[m][k] = *(const PG8_LAS bf16x8*)(lds + PG8_SA(b, h) + aoff + m * 2048 + k * 1024); } while (0)
#define PG8_LDB(dst, b, h) do { _Pragma("unroll") for (int n = 0; n < 2; ++n) _Pragma("unroll") for (int k = 0; k < 2; ++k) dst[n][k] = *(const PG8_LAS bf16x8*)(lds + PG8_SB(b, h) + boff + n * 2048 + k * 1024); } while (0)
#define PG8_MMA(ai, bj, At, Bt) do { __builtin_amdgcn_s_setprio(1); _Pragma("unroll") for (int m = 0; m < 4; ++m) _Pragma("unroll") for (int n = 0; n < 2; ++n) _Pragma("unroll") for (int k = 0; k < 2; ++k) \
        acc[ai][bj][m][n] = __builtin_amdgcn_mfma_f32_16x16x32_bf16(Bt[n][k], At[m][k], acc[ai][bj][m][n], 0, 0, 0); __builtin_amdgcn_s_setprio(0); } while (0)
#define PG8_WAIT_V(n) asm volatile("s_waitcnt vmcnt(" #n ")" ::: "memory")
#define PG8_WAIT_L(n) asm volatile("s_waitcnt lgkmcnt(" #n ")" ::: "memory")
#define PG8_BAR __builtin_amdgcn_s_barrier()
#define PG8_SCHED __builtin_amdgcn_sched_barrier(0)
    Unit cur, nxt; int ui = 0;
    if (!S.next(0, cur)) return;
    f32x4 acc[2][2][4][2];
#pragma unroll
    for (int a = 0; a < 2; ++a)
#pragma unroll
        for (int b = 0; b < 2; ++b)
#pragma unroll
            for (int m = 0; m < 4; ++m)
#pragma unroll
                for (int n = 0; n < 2; ++n) acc[a][b][m][n] = (f32x4){0.f, 0.f, 0.f, 0.f};
    bf16x8 At[4][2], B0[2][2], B1[2][2];
    const char* cA = (const char*)g.A + (size_t)cur.pm * tstep + (size_t)cur.k0 * 2; const char* cB = (const char*)g.Bt + (size_t)cur.pn * tstep + (size_t)cur.k0 * 2;
    S.a_ready(cur);
    if constexpr (SP2) {
        PG8_STAGE(PG8_SB(0, 0), cB, voffB); PG8_STAGE(PG8_SB(0, 1), cB + hstep, voffB); PG8_STAGE(PG8_SA(0, 0), cA, voffA); PG8_STAGE(PG8_SA(0, 1), cA + hstep, voffA);
        if (wr == 1) PG8_BAR;
        PG8_WAIT_V(2); PG8_BAR;
        PG8_STAGE(PG8_SB(1, 0), cB + kstep, voffB); PG8_STAGE(PG8_SA(1, 0), cA + kstep, voffA); PG8_STAGE(PG8_SB(1, 1), cB + hstep + kstep, voffB);
        PG8_WAIT_V(6); PG8_BAR;
    } else {
        PG8_STAGE(PG8_SB(0, 0), cB, voffB); PG8_STAGE(PG8_SA(0, 0), cA, voffA); PG8_STAGE(PG8_SB(0, 1), cB + hstep, voffB); PG8_STAGE(PG8_SA(0, 1), cA + hstep, voffA);
        if (wr == 1) PG8_BAR;
        PG8_WAIT_V(4); PG8_BAR;
        PG8_STAGE(PG8_SB(1, 0), cB + kstep, voffB); PG8_STAGE(PG8_SA(1, 0), cA + kstep, voffA); PG8_STAGE(PG8_SB(1, 1), cB + hstep + kstep, voffB);
        PG8_WAIT_V(6); PG8_BAR;
    }
    for (;;) {
        const bool has_next = S.next(ui + 1, nxt);
        const char* nA = has_next ? (const char*)g.A + (size_t)nxt.pm * tstep + (size_t)nxt.k0 * 2 : cA; const char* nB = has_next ? (const char*)g.Bt + (size_t)nxt.pn * tstep + (size_t)nxt.k0 * 2 : cB;
        const int nt = cur.nkt;
        for (int t = 0; t < nt; t += 2) {
            const bool last = (t == nt - 2);
            const char* a1 = cA + (size_t)(t + 1) * kstep;
            const char* a2 = last ? nA : cA + (size_t)(t + 2) * kstep; const char* b2 = last ? nB : cB + (size_t)(t + 2) * kstep;
            const char* a3 = a2 + kstep; const char* b3 = b2 + kstep;
            if (last && has_next) S.a_ready(nxt);
            if constexpr (SP2) {
            PG8_LDB(B0, 0, 0); PG8_LDB(B1, 0, 1); PG8_SCHED; PG8_LDA(At, 0, 0); PG8_STAGE(PG8_SA(1, 1), a1 + hstep, voffA);
            PG8_WAIT_V(8); PG8_WAIT_L(0); PG8_BAR; PG8_MMA(0, 0, At, B0); PG8_MMA(0, 1, At, B1); PG8_BAR; PG8_SCHED;
            PG8_LDA(At, 0, 1); PG8_STAGE(PG8_SB(0, 0), b2, voffB); PG8_STAGE(PG8_SB(0, 1), b2 + hstep, voffB); PG8_STAGE(PG8_SA(0, 0), a2, voffA);
            PG8_WAIT_V(8); PG8_WAIT_L(0); PG8_BAR; PG8_MMA(1, 0, At, B0); PG8_MMA(1, 1, At, B1); PG8_BAR; PG8_SCHED;
            PG8_LDB(B0, 1, 0); PG8_LDB(B1, 1, 1); PG8_SCHED; PG8_LDA(At, 1, 0); PG8_STAGE(PG8_SA(0, 1), a2 + hstep, voffA);
            PG8_WAIT_V(8); PG8_WAIT_L(0); PG8_BAR; PG8_MMA(0, 0, At, B0); PG8_MMA(0, 1, At, B1); PG8_BAR; PG8_SCHED;
            PG8_LDA(At, 1, 1); PG8_STAGE(PG8_SB(1, 0), b3, voffB); PG8_STAGE(PG8_SB(1, 1), b3 + hstep, voffB); PG8_STAGE(PG8_SA(1, 0), a3, voffA);
            PG8_WAIT_V(8); PG8_WAIT_L(0); PG8_BAR; PG8_MMA(1, 0, At, B0); PG8_MMA(1, 1, At, B1); PG8_BAR; PG8_SCHED;
            } else {
            PG8_LDB(B0, 0, 0); PG8_SCHED; PG8_LDA(At, 0, 0); PG8_STAGE(PG8_SA(1, 1), a1 + hstep, voffA);
            PG8_WAIT_L(8); PG8_BAR; PG8_WAIT_L(0); PG8_MMA(0, 0, At, B0); PG8_BAR; PG8_SCHED;
            PG8_LDB(B1, 0, 1); PG8_STAGE(PG8_SB(0, 0), b2, voffB);
            PG8_BAR; PG8_WAIT_L(0); PG8_MMA(0, 1, At, B1); PG8_BAR;
            PG8_LDA(At, 0, 1); PG8_STAGE(PG8_SA(0, 0), a2, voffA);
            PG8_BAR; PG8_WAIT_L(0); PG8_MMA(1, 0, At, B0); PG8_BAR; PG8_SCHED;
            PG8_STAGE(PG8_SB(0, 1), b2 + hstep, voffB);
            PG8_WAIT_V(6); PG8_BAR; PG8_MMA(1, 1, At, B1); PG8_BAR;
            PG8_LDB(B0, 1, 0); PG8_SCHED; PG8_LDA(At, 1, 0); PG8_STAGE(PG8_SA(0, 1), a2 + hstep, voffA);
            PG8_WAIT_L(8); PG8_BAR; PG8_WAIT_L(0); PG8_MMA(0, 0, At, B0); PG8_BAR; PG8_SCHED;
            PG8_LDB(B1, 1, 1); PG8_STAGE(PG8_SB(1, 0), b3, voffB);
            PG8_BAR; PG8_WAIT_L(0); PG8_MMA(0, 1, At, B1); PG8_BAR;
            PG8_LDA(At, 1, 1); PG8_STAGE(PG8_SA(1, 0), a3, voffA);
            PG8_BAR; PG8_WAIT_L(0); PG8_MMA(1, 0, At, B0); PG8_BAR; PG8_SCHED;
            PG8_STAGE(PG8_SB(1, 1), b3 + hstep, voffB);
            PG8_WAIT_V(6); PG8_BAR; PG8_MMA(1, 1, At, B1); PG8_BAR;
            }
        }
        if constexpr (ALIGN_EPI) { if (wr == 0) PG8_BAR; }
        if constexpr (!Epi::AFTER_DRAIN) { E(acc, cur, wr, wc, fr, fq); S.done(cur); }
        if (!has_next) break;
#pragma unroll
        for (int a = 0; a < 2; ++a)
#pragma unroll
            for (int b = 0; b < 2; ++b)
#pragma unroll
                for (int m = 0; m < 4; ++m)
#pragma unroll
                    for (int n = 0; n < 2; ++n) acc[a][b][m][n] = (f32x4){0.f, 0.f, 0.f, 0.f};
        cur = nxt; cA = nA; cB = nB; ++ui;
        if constexpr (ALIGN_EPI) { if (wr == 1) PG8_BAR; }
    }
    PG8_WAIT_V(0);
    if constexpr (!ALIGN_EPI) { if (wr == 0) PG8_BAR; }
    PG8_BAR;
#undef PG8_SA
#undef PG8_SB
#undef PG8_STAGE
#undef PG8_LDA
#undef PG8_LDB
#undef PG8_MMA
#undef PG8_WAIT_V
#undef PG8_WAIT_L
#undef PG8_BAR
#undef PG8_SCHED
}
}

#ifndef PROBE_DUP
#define PROBE_DUP 0
#endif
#ifndef PG8_SP2
#define PG8_SP2 true
#endif
#ifndef PG8_ALIGN
#define PG8_ALIGN true
#endif

constexpr int NWAVES = 8;
constexpr int N_LAUNCHES = MK_N_LAUNCHES;
constexpr int N_PHASES = 10;
constexpr int D = 1024, MP = 16384, MS = 512, M = MP + MS, TP = 2048, NBP = 8, NBS = 128, TS = 4;
constexpr int NZ = 1536, WA = 512, WB = 512, FF = 4096, NMOD = 6 * D, NROWMOD = NBP + NBS;
constexpr int GB = 32, NS5 = 64, KS5 = 16, HA = 8, HDA = 64;
constexpr float LN_EPS = 1e-5f;
constexpr int NS_OUT = 4, NS_DOWN = 8;
constexpr float ALPHA = 1.189207115002721f;

constexpr size_t O_YP = 0, O_YS = (size_t)MP * D, O_CONVP = O_YS + (size_t)MS * D, O_HP = O_CONVP + (size_t)NBP * 3 * WA, O_SRP = O_HP + (size_t)NBP * WA,
                 O_SIP = O_SRP + (size_t)NBP * GB * NS5, O_CONVS = O_SIP + (size_t)NBP * GB * NS5, O_HS = O_CONVS + (size_t)NBS * 3 * WA, O_SRS = O_HS + (size_t)NBS * WA,
                 O_SIS = O_SRS + (size_t)NBS * GB * NS5, O_END = O_SIS + (size_t)NBS * GB * NS5;

constexpr size_t MiB = 1u << 20;
constexpr size_t WS_CTL = 0, CTL_ZERO_BYTES = 1 * MiB;
constexpr size_t WS_WIN = 1 * MiB, WS_WGLU = 4 * MiB, WS_WOUT = 5 * MiB, WS_W1 = 7 * MiB, WS_W2 = 15 * MiB;
constexpr size_t WS_MOD = 23 * MiB;
constexpr size_t WS_S5C = 27 * MiB;
constexpr size_t WS_XN = 28 * MiB;
constexpr size_t WS_Z = 61 * MiB;
constexpr size_t WS_YCAT = 111 * MiB;
constexpr size_t WS_G = 144 * MiB;
constexpr size_t WS_U = 61 * MiB;
constexpr size_t WS_T1 = WS_Z;
constexpr size_t WS_T2 = WS_XN;
constexpr size_t WS_TAB = 194 * MiB;
constexpr size_t WS_SLAB = 196 * MiB;
constexpr size_t WS_END = 212 * MiB;
constexpr size_t TB_BF1 = 0, TB_BF2 = TB_BF1 + 32 * 4 * 64 * 16, TB_TA = TB_BF2 + 32 * 8 * 64 * 16, TB_ZP = TB_TA + 32 * 2 * 2 * 32 * 4, TB_Z16N = TB_ZP + 32 * 17 * 2 * 2 * 32 * 4,
                 TB_RG = TB_Z16N + 32 * 2 * 64 * 4, TB_CB = TB_RG + 8 * 2 * 2 * 4 * 64 * 16, TB_SILU = TB_CB + 128 * 3 * 512 * 2, TB_END = TB_SILU + 160 * 1024 * 2;
static_assert(WS_TAB + TB_END <= WS_SLAB, "tables");
static_assert(WS_XN + (size_t)M * D * 2 <= WS_Z && WS_Z + (size_t)M * NZ * 2 <= WS_YCAT && WS_YCAT + (size_t)M * D * 2 <= WS_G && WS_G + (size_t)M * WB * 2 <= WS_END && WS_U + (size_t)M * FF * 2 <= WS_TAB, "d_ws map");
constexpr int SC_ABR = 0, SC_ABI = 2048, SC_BBR = 4096, SC_BBI = 4096 + 32768, SC_RGL = 4096 + 65536, SC_END = SC_RGL + 512;
constexpr int CW_TMO = 0, CW_CODE = 1, CW_SILU = 64, CW_BAR = 4096;

constexpr int RING_OFF = 0, RING_BYTES = 131072;
constexpr int LDSCTL_OFF = RING_BYTES, MISC_OFF = LDSCTL_OFF + 320;
constexpr int LDS_BYTES = 147456;

#define GAS __attribute__((address_space(1)))
#define LAS __attribute__((address_space(3)))
typedef unsigned short bf16;
typedef unsigned v4u __attribute__((ext_vector_type(4)));
typedef float f32x4 __attribute__((ext_vector_type(4)));
typedef GAS unsigned gu32;
#define RLX_AGENT __ATOMIC_RELAXED, __HIP_MEMORY_SCOPE_AGENT
#define LDS_WAIT() asm volatile("s_waitcnt lgkmcnt(0)" ::: "memory")
#define VM_WAIT() asm volatile("s_waitcnt vmcnt(0)" ::: "memory")
__device__ __forceinline__ unsigned f2bf(float f) { unsigned u = __builtin_bit_cast(unsigned, f); return (u + 0x7fffu + ((u >> 16) & 1u)) >> 16; }
__device__ __forceinline__ unsigned pk2(float lo, float hi) { return f2bf(lo) | (f2bf(hi) << 16); }
__device__ __forceinline__ float bf2f(bf16 v) { return __builtin_bit_cast(float, (unsigned)v << 16); }
__device__ __forceinline__ float gelu_tanh(float x) { const float t = -2.3022082f * (x + 0.044715f * x * x * x); return x * __builtin_amdgcn_rcpf(1.f + __builtin_amdgcn_exp2f(t)); }
__device__ __forceinline__ float sigmoidf_(float x) { return __builtin_amdgcn_rcpf(1.f + __builtin_amdgcn_exp2f(-1.4426950408889634f * x)); }

#define XB_TMO      128
#define XB_XCNT(j)  (256  + 64 * (j))
#define XB_XSUB(j)  (1280 + 64 * (j))
#define XB_XGEN(j)  (2304 + 64 * (j))
#define XB_TOP      3328
#define XB_TOPGEN   3392
#define XCD_BAR_WORDS 3456
#define XB_SPIN_CAP (1u << 18)
__device__ __forceinline__ unsigned xb_ld(unsigned* p)              { return __hip_atomic_load(p, __ATOMIC_RELAXED, __HIP_MEMORY_SCOPE_AGENT); }
__device__ __forceinline__ unsigned xb_add(unsigned* p, unsigned v) { return __hip_atomic_fetch_add(p, v, __ATOMIC_RELAXED, __HIP_MEMORY_SCOPE_AGENT); }
__device__ __forceinline__ unsigned xb_xcc_id() { return (unsigned)__builtin_amdgcn_s_getreg((3 << 11) | 20) & 0xFu; }
#define XB_SPIN(cond, bar) do { unsigned _sp = 0; while (cond) { __builtin_amdgcn_s_sleep(1); \
    if ((++_sp & 255u) == 0u) { if (xb_ld(&(bar)[XB_TMO])) break; if (_sp > XB_SPIN_CAP) { atomicAdd(&(bar)[XB_TMO], 1u); break; } } } } while (0)
struct XcdBarrier { unsigned* bar; unsigned x; volatile LAS unsigned* st; };
__device__ __forceinline__ XcdBarrier xcd_barrier_post(unsigned* bar, volatile LAS unsigned* st) {
    XcdBarrier b; b.bar = bar; b.x = xb_xcc_id(); b.st = st;
    if (threadIdx.x == 0) (void)xb_add(&bar[XB_XCNT(b.x)], 1u);
    return b;
}
__device__ __forceinline__ void xcd_barrier_complete(unsigned* bar, unsigned x, unsigned& nloc, unsigned& nx) {
    const unsigned G = gridDim.x * gridDim.y * gridDim.z;
    unsigned sum, cnt, mine, sp = 0u;
    for (;;) {
        sum = 0u; cnt = 0u; mine = 0u;
#pragma unroll
        for (unsigned j = 0; j < 16; ++j) { const unsigned c = xb_ld(&bar[XB_XCNT(j)]); sum += c; cnt += (c > 0u) ? 1u : 0u; mine = (j == x) ? c : mine; }
        if (sum == G) break;
        __builtin_amdgcn_s_sleep(1);
        if ((++sp & 255u) == 0u) { if (xb_ld(&bar[XB_TMO])) break; if (sp > XB_SPIN_CAP) { atomicAdd(&bar[XB_TMO], 1u); break; } }
    }
    nloc = mine > 0u ? mine : 1u; nx = cnt > 0u ? cnt : 1u;
}
__device__ __forceinline__ void xcd_barrier(const XcdBarrier& b) {
    asm volatile("s_waitcnt vmcnt(0)" ::: "memory");
    __syncthreads();
    if (threadIdx.x == 0) {
        unsigned* bar = b.bar;
        __builtin_amdgcn_s_waitcnt(0);
        unsigned nloc = b.st[0], nx = b.st[1];
        if (nloc == 0u) { xcd_barrier_complete(bar, b.x, nloc, nx); b.st[0] = nloc; b.st[1] = nx; }
        const unsigned old = xb_add(&bar[XB_XSUB(b.x)], 1u);
        const unsigned gen = old / nloc;
        if (old + 1u == (gen + 1u) * nloc) {
            __builtin_amdgcn_fence(__ATOMIC_RELEASE, "agent");
            asm volatile("s_waitcnt vmcnt(0)" ::: "memory");
            const unsigned og = xb_add(&bar[XB_TOP], 1u);
            const unsigned tg = og / nx;
            if (og + 1u == (tg + 1u) * nx) xb_add(&bar[XB_TOPGEN], 1u);
            else XB_SPIN(xb_ld(&bar[XB_TOPGEN]) == tg, bar);
            __builtin_amdgcn_fence(__ATOMIC_ACQUIRE, "agent");
            xb_add(&bar[XB_XGEN(b.x)], 1u);
            asm volatile("s_waitcnt vmcnt(0)" ::: "memory");
        } else {
            XB_SPIN(xb_ld(&bar[XB_XGEN(b.x)]) == gen, bar);
            __builtin_amdgcn_fence(__ATOMIC_ACQUIRE, "agent");
            asm volatile("s_waitcnt vmcnt(0)" ::: "memory");
        }
    }
    __syncthreads();
}

struct Frame {
    LAS unsigned char* lds;
    volatile LAS unsigned* MISC;
    gu32* ctl;
    int tid, lane, wave;
    int vcu, G;
    float* out;
    unsigned char* ws;
};
struct Args { const float* in[37]; float* out; unsigned char* ws; int ph_lo, ph_hi, li, pad; };
__device__ __forceinline__ void refresh(Frame& F) { int t = threadIdx.x; asm volatile("" : "+v"(t)); F.tid = t; F.lane = t & 63; F.wave = __builtin_amdgcn_readfirstlane(t >> 6); }
__device__ __forceinline__ float wave_sum(float v) {
#pragma unroll
    for (int o = 1; o < 64; o <<= 1) v += __shfl_xor(v, o);
    return v;
}
enum { I_XP = 0, I_XS, I_SCONV, I_SH, I_SSR, I_SSI, I_CP, I_CS, I_ADAW, I_ADAB, I_INPROJ, I_CONVW, I_CONVB, I_RGWR, I_RGBR, I_RGWI, I_RGBI, I_RGLAM,
       I_S5ARE, I_S5AIM, I_S5LOGDT, I_S5BRE, I_S5BIM, I_S5CRE, I_S5CIM, I_S5D, I_GLUW, I_GLUB, I_OUTPROJ, I_LN1G, I_LN1B, I_W1, I_B1, I_W2, I_B2, I_LN2G, I_LN2B };

typedef float f32x2m __attribute__((ext_vector_type(2)));
typedef __bf16 bf16x2m __attribute__((ext_vector_type(2)));
__device__ __forceinline__ unsigned pkbf0(float a, float b) { const f32x2m v = {a, b}; const bf16x2m r = __builtin_convertvector(v, bf16x2m); return __builtin_bit_cast(unsigned, r); }
typedef short bf16x8m __attribute__((ext_vector_type(8)));
typedef float f32x16m __attribute__((ext_vector_type(16)));
__device__ __forceinline__ void p0_transpose_item(const float* W, int K, int N, bf16* WT, LAS float* scr, int item, int lane) {
    const int nblk = N / 32, kb = item / nblk, nb = item % nblk, k0 = 64 * kb, n0 = 32 * nb;
#pragma unroll 8
    for (int i = 0; i < 32; ++i) { const int kk = 2 * i + (lane >> 5); scr[kk * 33 + (lane & 31)] = W[(size_t)(k0 + kk) * N + n0 + (lane & 31)]; }
    LDS_WAIT(); asm volatile("" ::: "memory");
    const int c = lane & 7;
#pragma unroll
    for (int j = 0; j < 4; ++j) { const int n = (lane >> 3) + 8 * j; const LAS float* s = scr + (8 * c) * 33 + n;
        v4u o; o.x = pk2(s[0 * 33], s[1 * 33]); o.y = pk2(s[2 * 33], s[3 * 33]); o.z = pk2(s[4 * 33], s[5 * 33]); o.w = pk2(s[6 * 33], s[7 * 33]);
        *(GAS v4u*)(WT + (size_t)(n0 + n) * K + k0 + 8 * c) = o; }
    LDS_WAIT(); asm volatile("" ::: "memory");
}

constexpr int XI_IN = (D / 64) * (NZ / 32), XI_GL = (WB / 64) * (WB / 32), XI_OU = (D / 64) * (D / 32), XI_1 = (D / 64) * (FF / 32), XI_2 = (FF / 64) * (D / 32);
constexpr int XO_OU = XI_IN + XI_GL, XO_1 = XO_OU + XI_OU, XO_2 = XO_1 + XI_1, XO_END = XO_2 + XI_2;
__device__ __forceinline__ void xpose_item(Frame& F, const Args& A, LAS float* scr, int r) {
    if (r < XI_IN) { p0_transpose_item(A.in[I_INPROJ], D, NZ, (bf16*)(F.ws + WS_WIN), scr, r, F.lane); return; } r -= XI_IN;
    if (r < XI_GL) { p0_transpose_item(A.in[I_GLUW], WB, WB, (bf16*)(F.ws + WS_WGLU), scr, r, F.lane); return; } r -= XI_GL;
    if (r < XI_OU) { p0_transpose_item(A.in[I_OUTPROJ], D, D, (bf16*)(F.ws + WS_WOUT), scr, r, F.lane); return; } r -= XI_OU;
    if (r < XI_1) { p0_transpose_item(A.in[I_W1], D, FF, (bf16*)(F.ws + WS_W1), scr, r, F.lane); return; } r -= XI_1;
    p0_transpose_item(A.in[I_W2], FF, D, (bf16*)(F.ws + WS_W2), scr, r, F.lane);
}
__device__ __forceinline__ void xpose_range(Frame& F, const Args& A, int lo, int hi, int vlo) {
    refresh(F);
    if (F.vcu < vlo) return;
    LAS float* scr = (LAS float*)(F.lds + RING_OFF + F.wave * 16384);
    const int gw = F.wave * (F.G - vlo) + (F.vcu - vlo), ngw = (F.G - vlo) * NWAVES;
    for (int it = lo + gw; it < hi; it += ngw) xpose_item(F, A, scr, it);
}
__device__ __forceinline__ void xpose_range_b(Frame& F, const Args& A, int lo, int hi, int blo) {
    refresh(F);
    LAS float* scr = (LAS float*)(F.lds + RING_OFF + F.wave * 16384);
    const int gw = F.wave * (F.G - blo) + ((int)blockIdx.x - blo), ngw = (F.G - blo) * NWAVES;
    for (int it = lo + gw; it < hi; it += ngw) xpose_item(F, A, scr, it);
}
#ifndef PROBE_P0PART
#define PROBE_P0PART 7
#endif
__device__ __forceinline__ void p0_prologue(Frame& F, const Args& A, int rep = 0) {
    refresh(F);
    const int pmask = rep ? PROBE_P0PART : 7;
    LAS float* scr = (LAS float*)(F.lds + RING_OFF + F.wave * 16384);
    const int gw = F.wave * F.G + F.vcu, NGW = F.G * NWAVES;
    {
        bf16* ST = (bf16*)(F.ws + WS_TAB + TB_SILU);
        for (int ch = F.vcu * NWAVES * 64 + F.tid; ch < 160 * 1024 / 8; ch += F.G * NWAVES * 64) { const int row = ch >> 7, k = (ch & 127) * 8; v4u o = (v4u){0u, 0u, 0u, 0u};
            if (row < NROWMOD) { const float* cp = (row < NBP ? A.in[I_CP] + (size_t)row * D : A.in[I_CS] + (size_t)(row - NBP) * D) + k; const f32x4 c0 = *(const f32x4*)cp, c1 = *(const f32x4*)(cp + 4);
                o.x = pk2(c0[0] * sigmoidf_(c0[0]), c0[1] * sigmoidf_(c0[1])); o.y = pk2(c0[2] * sigmoidf_(c0[2]), c0[3] * sigmoidf_(c0[3]));
                o.z = pk2(c1[0] * sigmoidf_(c1[0]), c1[1] * sigmoidf_(c1[1])); o.w = pk2(c1[2] * sigmoidf_(c1[2]), c1[3] * sigmoidf_(c1[3])); }
            *(v4u*)(ST + (size_t)ch * 8) = o; }
        VM_WAIT(); __syncthreads();
        if (F.tid == 0) { __builtin_amdgcn_fence(__ATOMIC_RELEASE, "agent"); VM_WAIT(); (void)__hip_atomic_fetch_add((unsigned*)(F.ctl + CW_SILU), 1u, RLX_AGENT); }
    }
    constexpr int I_IN = XI_IN, I_GL = XI_GL;
    constexpr int I_S5 = GB, I_RG = WA / 64, I_RGT = HA * 2 * 2 * 4, I_CB = NBS * 3 * WA / 512;
    constexpr int NITEMS = I_IN + I_GL + I_S5 + I_RG + I_RGT + I_CB;
    float* sc = (float*)(F.ws + WS_S5C);
    for (int it = gw; it < NITEMS; it += NGW) {
        int r = it;
        if (!(pmask & 1) && it < I_IN + I_GL) continue;
        if (!(pmask & 2) && it >= I_IN + I_GL) continue;
        if (r < I_IN + I_GL) { xpose_item(F, A, scr, r); continue; } r -= I_IN + I_GL;
        if (r < I_S5) {
            const int g = r, n = F.lane, gn = g * NS5 + n;
            const double dt = exp((double)A.in[I_S5LOGDT][g]), ar = (double)A.in[I_S5ARE][gn], ai = (double)A.in[I_S5AIM][gn];
            const double mag = exp(dt * ar), abr = mag * cos(dt * ai), abi = mag * sin(dt * ai), den = ar * ar + ai * ai, nr = abr - 1.0;
            const double qr = (nr * ar + abi * ai) / den, qi = (abi * ar - nr * ai) / den;
            sc[SC_ABR + gn] = (float)abr; sc[SC_ABI + gn] = (float)abi;
            unsigned char* tab = F.ws + WS_TAB;
            bf16* BF1 = (bf16*)(tab + TB_BF1); bf16* BF2 = (bf16*)(tab + TB_BF2); float* TA = (float*)(tab + TB_TA); float* ZP = (float*)(tab + TB_ZP); float* Z16N = (float*)(tab + TB_Z16N);
            const int sh = n >> 5, v = n & 31, hh = (v >> 2) & 1, ii = (v & 3) + 4 * (v >> 3);
            for (int k = 0; k < KS5; ++k) { const double br = (double)A.in[I_S5BRE][gn * KS5 + k], bi = (double)A.in[I_S5BIM][gn * KS5 + k];
                const float vr = (float)(qr * br - qi * bi), vi = (float)(qr * bi + qi * br);
                sc[SC_BBR + gn * KS5 + k] = vr; sc[SC_BBI + gn * KS5 + k] = vi;
                const int lp = (n & 31) + 32 * (k >> 3), jj = k & 7;
                BF1[(size_t)((g * 4 + 0 + sh) * 64 + lp) * 8 + jj] = (bf16)f2bf(vr); BF1[(size_t)((g * 4 + 2 + sh) * 64 + lp) * 8 + jj] = (bf16)f2bf(vi); }
            { const int s2 = (n >> 4) & 1, jj = 4 * ((n >> 3) & 1) + (n & 3), hk = (n >> 2) & 1;
              for (int ch = 0; ch < KS5; ++ch) { const int hr_ = ch >> 3, i8 = ch & 7, R = (i8 & 3) + 8 * (i8 >> 2) + 4 * hr_, lp = R + 32 * hk;
                  const float cr = A.in[I_S5CRE][(size_t)(g * KS5 + ch) * NS5 + n], ci = A.in[I_S5CIM][(size_t)(g * KS5 + ch) * NS5 + n];
                  BF2[(size_t)((g * 8 + (0 + sh) * 2 + s2) * 64 + lp) * 8 + jj] = (bf16)f2bf(cr); BF2[(size_t)((g * 8 + (2 + sh) * 2 + s2) * 64 + lp) * 8 + jj] = (bf16)f2bf(-ci); }
              for (int z = 0; z < 4; ++z) { const int cidx = n + 64 * z, ks = cidx >> 5, r16 = cidx & 31, lp = 16 + (r16 & 15) + 32 * (r16 >> 4);
                  *(v4u*)(BF2 + (size_t)((g * 8 + ks) * 64 + lp) * 8) = (v4u){0u, 0u, 0u, 0u}; } }
            TA[((g * 2 + hh) * 2 + 0) * 32 + sh * 16 + ii] = (float)abr; TA[((g * 2 + hh) * 2 + 1) * 32 + sh * 16 + ii] = (float)abi;
            const double mg8 = exp(8.0 * dt * ar), z1r = mg8 * cos(8.0 * dt * ai), z1i = mg8 * sin(8.0 * dt * ai); double pzr = 1.0, pzi = 0.0;
            for (int e = 0; e <= 16; ++e) { const float zr = (float)pzr, zi = (float)pzi; { const double nr2 = pzr * z1r - pzi * z1i, ni2 = pzr * z1i + pzi * z1r; pzr = nr2; pzi = ni2; }
                ZP[(((g * 17 + e) * 2 + hh) * 2 + 0) * 32 + sh * 16 + ii] = zr; ZP[(((g * 17 + e) * 2 + hh) * 2 + 1) * 32 + sh * 16 + ii] = zi;
                if (e == 16) { Z16N[(g * 2 + 0) * 64 + n] = zr; Z16N[(g * 2 + 1) * 64 + n] = zi; } }
            continue; } r -= I_S5;
        if (r < I_RG) { const int c = r * 64 + F.lane; const double lam = (double)A.in[I_RGLAM][c];
          sc[SC_RGL + c] = (float)(-8.0 * log1p(exp(-lam)) * 1.4426950408889634); continue; } r -= I_RG;
        if (r >= I_RGT) { r -= I_RGT;
            const float* src = A.in[I_SCONV] + (size_t)r * 512 + F.lane * 8; const f32x4 a0 = *(const f32x4*)src, a1 = *(const f32x4*)(src + 4);
            v4u o; o.x = pk2(a0[0], a0[1]); o.y = pk2(a0[2], a0[3]); o.z = pk2(a1[0], a1[1]); o.w = pk2(a1[2], a1[3]);
            *(v4u*)(F.ws + WS_TAB + TB_CB + ((size_t)r * 512 + F.lane * 8) * 2) = o; continue; }
        {
            const int s4 = r & 3, gate = (r >> 2) & 1, jh = (r >> 3) & 1, hd = r >> 4;
            const int R = F.lane & 31, hk = F.lane >> 5, hR = (R >> 2) & 1, i = (R & 3) + 4 * (R >> 3), cho = 32 * jh + 16 * (i >> 3) + 8 * hR + (i & 7);
            const float* W = A.in[gate ? I_RGWI : I_RGWR] + (size_t)(hd * 64 + 16 * s4 + 8 * hk) * 64 + cho;
            v4u o; o.x = pk2(W[0], W[64]); o.y = pk2(W[128], W[192]); o.z = pk2(W[256], W[320]); o.w = pk2(W[384], W[448]);
            *(v4u*)(F.ws + WS_TAB + TB_RG + (size_t)(r * 64 + F.lane) * 16) = o;
        }
    }
    __syncthreads();
    if (F.tid == 0) {
        unsigned sp = 0; while (__hip_atomic_load((unsigned*)(F.ctl + CW_SILU), RLX_AGENT) < (unsigned)F.G * (unsigned)(rep + 1) && ++sp < (1u << 22)) __builtin_amdgcn_s_sleep(2);
        __builtin_amdgcn_fence(__ATOMIC_ACQUIRE, "agent"); VM_WAIT(); }
    __syncthreads();
    LAS float* RED = (LAS float*)(F.lds + RING_OFF);
    float* mod = (float*)(F.ws + WS_MOD);
    const int r32 = F.lane & 31, hh = F.lane >> 5;
    const bf16* ST = (const bf16*)(F.ws + WS_TAB + TB_SILU);
#pragma unroll 1
    for (int it = F.vcu; it < ((pmask & 4) ? NMOD / 32 : 0); it += F.G) {
        const int n0 = it * 32;
        f32x16m acc[5];
#pragma unroll
        for (int rt = 0; rt < 5; ++rt)
#pragma unroll
            for (int i = 0; i < 16; ++i) acc[rt][i] = 0.f;
#pragma unroll 1
        for (int kb = 0; kb < 4; ++kb) {
            float bw[2][8]; v4u af[2][5];
#pragma unroll
            for (int ks = 0; ks < 2; ++ks) { const int k0 = F.wave * 128 + (kb * 2 + ks) * 16 + 8 * hh;
                const float* wp = A.in[I_ADAW] + (size_t)k0 * NMOD + n0 + r32;
#pragma unroll
                for (int j = 0; j < 8; ++j) bw[ks][j] = wp[(size_t)j * NMOD];
#pragma unroll
                for (int rt = 0; rt < 5; ++rt) af[ks][rt] = *(const v4u*)(ST + (size_t)(32 * rt + r32) * D + k0); }
#pragma unroll
            for (int ks = 0; ks < 2; ++ks) {
                v4u bp; bp.x = pkbf0(bw[ks][0], bw[ks][1]); bp.y = pkbf0(bw[ks][2], bw[ks][3]); bp.z = pkbf0(bw[ks][4], bw[ks][5]); bp.w = pkbf0(bw[ks][6], bw[ks][7]);
                const bf16x8m bfr = __builtin_bit_cast(bf16x8m, bp);
#pragma unroll
                for (int rt = 0; rt < 5; ++rt) acc[rt] = __builtin_amdgcn_mfma_f32_32x32x16_bf16(__builtin_bit_cast(bf16x8m, af[ks][rt]), bfr, acc[rt], 0, 0, 0); }
        }
#pragma unroll
        for (int half = 4; half >= 1; half >>= 1) {
            if (F.wave >= half && F.wave < 2 * half) {
#pragma unroll
                for (int rt = 0; rt < 5; ++rt)
#pragma unroll
                    for (int i = 0; i < 16; ++i) RED[(F.wave - half) * 5120 + (rt * 16 + i) * 64 + F.lane] = acc[rt][i]; }
            __syncthreads();
            if (F.wave < half) {
#pragma unroll
                for (int rt = 0; rt < 5; ++rt)
#pragma unroll
                    for (int i = 0; i < 16; ++i) acc[rt][i] += RED[F.wave * 5120 + (rt * 16 + i) * 64 + F.lane]; }
            __syncthreads();
        }
        if (F.wave == 0) { const float bb = A.in[I_ADAB][n0 + r32];
#pragma unroll
            for (int rt = 0; rt < 5; ++rt)
#pragma unroll
                for (int i = 0; i < 16; ++i) { const int row = 32 * rt + (i & 3) + 8 * (i >> 2) + 4 * hh; if (row < NROWMOD) mod[(size_t)row * NMOD + n0 + r32] = acc[rt][i] + bb; } }
    }
}

__device__ __forceinline__ int mod_row(int m) { return m < MP ? (m >> 11) : NBP + ((m - MP) >> 2); }
__device__ __forceinline__ const float* x_row(const Args& A, int m) { return m < MP ? A.in[I_XP] + (size_t)m * D : A.in[I_XS] + (size_t)(m - MP) * D; }

__device__ __forceinline__ void p1_modulate(Frame& F, const Args& A) {
    refresh(F);
    const int gw = F.vcu * NWAVES + F.wave, NGW = F.G * NWAVES;
    const float* mod = (const float*)(F.ws + WS_MOD); bf16* XN = (bf16*)(F.ws + WS_XN);
    for (int m = gw; m < M; m += NGW) {
        const GAS f32x4* xr = (const GAS f32x4*)x_row(A, m) + F.lane; const float* mr = mod + (size_t)mod_row(m) * NMOD;
        const GAS f32x4* sh = (const GAS f32x4*)(mr) + F.lane; const GAS f32x4* scp = (const GAS f32x4*)(mr + D) + F.lane;
        GAS unsigned long long* o8 = (GAS unsigned long long*)(XN + (size_t)m * D) + F.lane;
#pragma unroll
        for (int j = 0; j < 4; ++j) { const f32x4 v = xr[64 * j], a = sh[64 * j], s = scp[64 * j]; const f32x4 h = v * (s + 1.f) + a;
            o8[64 * j] = (unsigned long long)pk2(h.x, h.y) | ((unsigned long long)pk2(h.z, h.w) << 32); }
    }
}

template <bool SECOND>
__device__ __forceinline__ void ln_rows(Frame& F, const Args& A) {
    refresh(F);
    const int gw = F.vcu * NWAVES + F.wave, NGW = F.G * NWAVES;
    const float* mod = (const float*)(F.ws + WS_MOD); bf16* XN = (bf16*)(F.ws + WS_XN);
    const GAS f32x4* gg = (const GAS f32x4*)A.in[SECOND ? I_LN2G : I_LN1G] + F.lane; const GAS f32x4* gb = (const GAS f32x4*)A.in[SECOND ? I_LN2B : I_LN1B] + F.lane;
    for (int m = gw; m < M; m += NGW) {
        GAS f32x4* xr = (GAS f32x4*)(F.out + (size_t)m * D) + F.lane;
        f32x4 v[4]; float s = 0.f;
        if (m >= MP) {
            const float* mr = mod + (size_t)mod_row(m) * NMOD + (SECOND ? 5 : 2) * D;
            const GAS f32x4* bs = SECOND ? (const GAS f32x4*)xr : (const GAS f32x4*)(A.in[I_XS] + (size_t)(m - MP) * D) + F.lane;
            const GAS f32x4* sl = (const GAS f32x4*)((const float*)(F.ws + WS_SLAB) + (size_t)(m - MP) * D) + F.lane;
#pragma unroll
            for (int j = 0; j < 4; ++j) { f32x4 a = SECOND ? *((const GAS f32x4*)A.in[I_B2] + F.lane + 64 * j) : (f32x4){0.f, 0.f, 0.f, 0.f};
#pragma unroll
                for (int ks = 0; ks < (SECOND ? NS_DOWN : NS_OUT); ++ks) a += sl[(size_t)ks * (512 * 1024 / 4) + 64 * j];
                v[j] = bs[64 * j] * ALPHA + *((const GAS f32x4*)mr + F.lane + 64 * j) * a; }
        } else {
            const GAS unsigned long long* tr = (const GAS unsigned long long*)((const bf16*)(F.ws + (SECOND ? WS_T2 : WS_T1)) + (size_t)m * D) + F.lane;
#pragma unroll
            for (int j = 0; j < 4; ++j) { const unsigned long long w = tr[64 * j]; const unsigned lo = (unsigned)w, hi = (unsigned)(w >> 32);
                v[j] = (f32x4){pg8::bf_lo(lo), pg8::bf_hi(lo), pg8::bf_lo(hi), pg8::bf_hi(hi)}; }
        }
#pragma unroll
        for (int j = 0; j < 4; ++j) s += (v[j].x + v[j].y) + (v[j].z + v[j].w);
        const float mean = wave_sum(s) * (1.f / D); float s2 = 0.f;
#pragma unroll
        for (int j = 0; j < 4; ++j) { v[j] = v[j] - mean; s2 += (v[j].x * v[j].x + v[j].y * v[j].y) + (v[j].z * v[j].z + v[j].w * v[j].w); }
        const float rstd = 1.f / sqrtf(wave_sum(s2) * (1.f / D) + LN_EPS);
#pragma unroll
        for (int j = 0; j < 4; ++j) { v[j] = v[j] * rstd * gg[64 * j] + gb[64 * j]; xr[64 * j] = v[j]; }
        if (!SECOND) {
            const float* mr = mod + (size_t)mod_row(m) * NMOD;
            const GAS f32x4* sh = (const GAS f32x4*)(mr + 3 * D) + F.lane; const GAS f32x4* scp = (const GAS f32x4*)(mr + 4 * D) + F.lane;
            GAS unsigned long long* o8 = (GAS unsigned long long*)(XN + (size_t)m * D) + F.lane;
#pragma unroll
            for (int j = 0; j < 4; ++j) { const f32x4 h = v[j] * (scp[64 * j] + 1.f) + sh[64 * j];
                o8[64 * j] = (unsigned long long)pk2(h.x, h.y) | ((unsigned long long)pk2(h.z, h.w) << 32); }
        }
    }
}

__device__ __forceinline__ void rg_item_ref(Frame& F, const Args& A, bool prompt, int b, int hd, LAS float* scr) {
    const int j = F.lane, c = hd * HDA + j;
    const bf16* Z = (const bf16*)(F.ws + WS_Z); bf16* Y = (bf16*)(F.ws + WS_YCAT); const float* sc = (const float*)(F.ws + WS_S5C);
    float wr[64], wi[64];
#pragma unroll
    for (int i = 0; i < 64; ++i) { wr[i] = A.in[I_RGWR][(size_t)(hd * 64 + i) * 64 + j]; wi[i] = A.in[I_RGWI][(size_t)(hd * 64 + i) * 64 + j]; }
    const float br = A.in[I_RGBR][c], bi = A.in[I_RGBI][c], L2 = sc[SC_RGL + c];
    const float w0 = A.in[I_CONVW][c], w1 = A.in[I_CONVW][WA + c], w2 = A.in[I_CONVW][2 * WA + c], w3 = A.in[I_CONVW][3 * WA + c], cb = A.in[I_CONVB][c];
    int T, m0; float x3, x2, x1, h;
    if (prompt) { T = TP; m0 = b * TP; x3 = 0.f; x2 = 0.f; x1 = 0.f; h = 0.f; }
    else { T = TS; m0 = MP + b * TS; x3 = A.in[I_SCONV][(size_t)(b * 3 + 0) * WA + c]; x2 = A.in[I_SCONV][(size_t)(b * 3 + 1) * WA + c]; x1 = A.in[I_SCONV][(size_t)(b * 3 + 2) * WA + c]; h = A.in[I_SH][(size_t)b * WA + c]; }
    for (int t = 0; t < T; ++t) {
        const size_t m = (size_t)(m0 + t);
        const float xa = bf2f(Z[m * NZ + WA + c]), gate = bf2f(Z[m * NZ + c]);
        const float xc = cb + w0 * x3 + w1 * x2 + w2 * x1 + w3 * xa; x3 = x2; x2 = x1; x1 = xa;
        scr[j] = xc; LDS_WAIT(); asm volatile("" ::: "memory");
        float rp = br, gp = bi;
#pragma unroll
        for (int i4 = 0; i4 < 16; ++i4) { const f32x4 v = *(const LAS f32x4*)(scr + 4 * i4);
            rp += v[0] * wr[4 * i4] + v[1] * wr[4 * i4 + 1] + v[2] * wr[4 * i4 + 2] + v[3] * wr[4 * i4 + 3];
            gp += v[0] * wi[4 * i4] + v[1] * wi[4 * i4 + 1] + v[2] * wi[4 * i4 + 2] + v[3] * wi[4 * i4 + 3]; }
        LDS_WAIT(); asm volatile("" ::: "memory");
        const float r = sigmoidf_(rp), gi = sigmoidf_(gp);
        const float a = exp2f(r * L2);
        float mult = sqrtf(fmaxf(1.f - a * a, 0.f));
        if (prompt && t == 0) mult = 1.f;
        h = a * h + mult * gi * xc;
        Y[m * D + c] = (bf16)f2bf(gelu_tanh(gate) * h);
    }
    float* oc = F.out + (prompt ? O_CONVP : O_CONVS); float* oh = F.out + (prompt ? O_HP : O_HS);
    oc[(size_t)(b * 3 + 0) * WA + c] = x3; oc[(size_t)(b * 3 + 1) * WA + c] = x2; oc[(size_t)(b * 3 + 2) * WA + c] = x1;
    oh[(size_t)b * WA + c] = h;
}
__device__ __forceinline__ void s5_item_ref(Frame& F, const Args& A, bool prompt, int b, int g, LAS float* scr) {
    const int n = F.lane, gn = g * NS5 + n, k = F.lane & 15, part = F.lane >> 4;
    const bf16* Z = (const bf16*)(F.ws + WS_Z); bf16* Gy = (bf16*)(F.ws + WS_G); const float* sc = (const float*)(F.ws + WS_S5C);
    float bbr[16], bbi[16], cre[16], cim[16];
#pragma unroll
    for (int i = 0; i < 16; ++i) { bbr[i] = sc[SC_BBR + gn * KS5 + i]; bbi[i] = sc[SC_BBI + gn * KS5 + i];
        cre[i] = A.in[I_S5CRE][(size_t)(g * KS5 + k) * NS5 + part * 16 + i]; cim[i] = A.in[I_S5CIM][(size_t)(g * KS5 + k) * NS5 + part * 16 + i]; }
    const float abr = sc[SC_ABR + gn], abi = sc[SC_ABI + gn], dk = A.in[I_S5D][g * KS5 + k];
    int T, m0; float hr, hi;
    if (prompt) { T = TP; m0 = b * TP; hr = 0.f; hi = 0.f; }
    else { T = TS; m0 = MP + b * TS; hr = A.in[I_SSR][(size_t)(b * GB + g) * NS5 + n]; hi = A.in[I_SSI][(size_t)(b * GB + g) * NS5 + n]; }
    for (int t = 0; t < T; ++t) {
        const size_t m = (size_t)(m0 + t);
        const bf16* zr = Z + m * NZ + 2 * WA + g * KS5;
        const v4u u0 = *(const v4u*)zr, u1 = *(const v4u*)(zr + 8);
        float u[16];
        u[0] = pg8::bf_lo(u0.x); u[1] = pg8::bf_hi(u0.x); u[2] = pg8::bf_lo(u0.y); u[3] = pg8::bf_hi(u0.y); u[4] = pg8::bf_lo(u0.z); u[5] = pg8::bf_hi(u0.z); u[6] = pg8::bf_lo(u0.w); u[7] = pg8::bf_hi(u0.w);
        u[8] = pg8::bf_lo(u1.x); u[9] = pg8::bf_hi(u1.x); u[10] = pg8::bf_lo(u1.y); u[11] = pg8::bf_hi(u1.y); u[12] = pg8::bf_lo(u1.z); u[13] = pg8::bf_hi(u1.z); u[14] = pg8::bf_lo(u1.w); u[15] = pg8::bf_hi(u1.w);
        float bur = 0.f, bui = 0.f;
#pragma unroll
        for (int i = 0; i < 16; ++i) { bur += bbr[i] * u[i]; bui += bbi[i] * u[i]; }
        const float nhr = abr * hr - abi * hi + bur, nhi = abr * hi + abi * hr + bui; hr = nhr; hi = nhi;
        scr[n] = hr; scr[64 + n] = hi; LDS_WAIT(); asm volatile("" ::: "memory");
        float p = 0.f;
#pragma unroll
        for (int i4 = 0; i4 < 4; ++i4) { const f32x4 vr = *(const LAS f32x4*)(scr + part * 16 + 4 * i4), vi = *(const LAS f32x4*)(scr + 64 + part * 16 + 4 * i4);
#pragma unroll
            for (int e = 0; e < 4; ++e) p += vr[e] * cre[4 * i4 + e] - vi[e] * cim[4 * i4 + e]; }
        LDS_WAIT(); asm volatile("" ::: "memory");
        p += __shfl_xor(p, 16); p += __shfl_xor(p, 32);
        const float uk = bf2f(zr[k]);
        if (F.lane < 16) Gy[m * WB + g * KS5 + k] = (bf16)f2bf(gelu_tanh(p + dk * uk));
    }
    float* osr = F.out + (prompt ? O_SRP : O_SRS); float* osi = F.out + (prompt ? O_SIP : O_SIS);
    osr[(size_t)(b * GB + g) * NS5 + n] = hr; osi[(size_t)(b * GB + g) * NS5 + n] = hi;
}

typedef short bf16x8v __attribute__((ext_vector_type(8)));
typedef float f32x16 __attribute__((ext_vector_type(16)));
typedef float f32x2v __attribute__((ext_vector_type(2)));
typedef __bf16 bf16x2v __attribute__((ext_vector_type(2)));
#define MFMA32(a, b, c) __builtin_amdgcn_mfma_f32_32x32x16_bf16((a), (b), (c), 0, 0, 0)
__device__ __forceinline__ unsigned pkbf(float a, float b) { const f32x2v v = {a, b}; const bf16x2v r = __builtin_convertvector(v, bf16x2v); return __builtin_bit_cast(unsigned, r); }
template <int CTRL> __device__ __forceinline__ float dppf(float old, float v) { return __builtin_bit_cast(float, __builtin_amdgcn_update_dpp(__builtin_bit_cast(int, old), __builtin_bit_cast(int, v), CTRL, 0xF, 0xF, false)); }
__device__ __forceinline__ f32x16 ld16(const float* p) { f32x16 r;
#pragma unroll
    for (int i = 0; i < 4; ++i) { const f32x4 v = *(const f32x4*)(p + 4 * i); r[4 * i] = v[0]; r[4 * i + 1] = v[1]; r[4 * i + 2] = v[2]; r[4 * i + 3] = v[3]; }
    return r; }
__device__ __forceinline__ f32x16 ld16l(const LAS float* p) { f32x16 r;
#pragma unroll
    for (int i = 0; i < 4; ++i) { const f32x4 v = *(const LAS f32x4*)(p + 4 * i); r[4 * i] = v[0]; r[4 * i + 1] = v[1]; r[4 * i + 2] = v[2]; r[4 * i + 3] = v[3]; }
    return r; }
__device__ __forceinline__ bf16x8v pack8(const f32x16& x, int s) { v4u p; p.x = pkbf(x[8 * s], x[8 * s + 1]); p.y = pkbf(x[8 * s + 2], x[8 * s + 3]); p.z = pkbf(x[8 * s + 4], x[8 * s + 5]); p.w = pkbf(x[8 * s + 6], x[8 * s + 7]); return __builtin_bit_cast(bf16x8v, p); }
template <int CTRL> __device__ __forceinline__ void s5_scan_step(f32x16& xr, f32x16& xi, const f32x16& zr, const f32x16& zi) {
#pragma unroll
    for (int i = 0; i < 16; ++i) { const float sr = dppf<CTRL>(0.f, xr[i]), si = dppf<CTRL>(0.f, xi[i]);
        xr[i] += zr[i] * sr - zi[i] * si; xi[i] += zr[i] * si + zi[i] * sr; }
}
constexpr int S5L_BF1 = 0, S5L_BF2 = 4096, S5L_TOT = 12288, S5L_CAR = 20480, S5L_ZP = 28672  , S5L_TA = 37376  , S5L_U = 38912  ;
template <bool SECOND>
__device__ __forceinline__ void s5_step(LAS unsigned char* L, int lane, const bf16x8v u, f32x16& hr0, f32x16& hr1, f32x16& hi0, f32x16& hi1,
                                        const f32x16& ar0, const f32x16& ar1, const f32x16& ai0, const f32x16& ai1, const float (&dk)[8], bf16* gout) {
    const LAS bf16x8v* a1 = (const LAS bf16x8v*)(L + S5L_BF1) + lane;
    { const f32x16 cr = ar0 * hr0 - ai0 * hi0, ci = ar0 * hi0 + ai0 * hr0; hr0 = MFMA32(a1[0], u, cr); hi0 = MFMA32(a1[128], u, ci); }
    asm volatile("" : "+v"(hr0), "+v"(hi0));
    { const f32x16 cr = ar1 * hr1 - ai1 * hi1, ci = ar1 * hi1 + ai1 * hr1; hr1 = MFMA32(a1[64], u, cr); hi1 = MFMA32(a1[192], u, ci); }
    if (SECOND) {
        const LAS bf16x8v* a2 = (const LAS bf16x8v*)(L + S5L_BF2) + lane;
        f32x16 y;
#pragma unroll
        for (int i = 0; i < 16; ++i) y[i] = 0.f;
        y = MFMA32(a2[0 * 64], pack8(hr0, 0), y); y = MFMA32(a2[1 * 64], pack8(hr0, 1), y);
        y = MFMA32(a2[2 * 64], pack8(hr1, 0), y); y = MFMA32(a2[3 * 64], pack8(hr1, 1), y);
        y = MFMA32(a2[4 * 64], pack8(hi0, 0), y); y = MFMA32(a2[5 * 64], pack8(hi0, 1), y);
        y = MFMA32(a2[6 * 64], pack8(hi1, 0), y); y = MFMA32(a2[7 * 64], pack8(hi1, 1), y);
        const v4u uw = __builtin_bit_cast(v4u, u);
        float o[8];
        o[0] = gelu_tanh(y[0] + dk[0] * pg8::bf_lo(uw.x)); o[1] = gelu_tanh(y[1] + dk[1] * pg8::bf_hi(uw.x));
        o[2] = gelu_tanh(y[2] + dk[2] * pg8::bf_lo(uw.y)); o[3] = gelu_tanh(y[3] + dk[3] * pg8::bf_hi(uw.y));
        o[4] = gelu_tanh(y[4] + dk[4] * pg8::bf_lo(uw.z)); o[5] = gelu_tanh(y[5] + dk[5] * pg8::bf_hi(uw.z));
        o[6] = gelu_tanh(y[6] + dk[6] * pg8::bf_lo(uw.w)); o[7] = gelu_tanh(y[7] + dk[7] * pg8::bf_hi(uw.w));
        v4u w; w.x = pkbf(o[0], o[1]); w.y = pkbf(o[2], o[3]); w.z = pkbf(o[4], o[5]); w.w = pkbf(o[6], o[7]);
        *(v4u*)gout = w;
    }
}
__device__ __forceinline__ void s5_item_fast(Frame& F, const Args& A, int b, int g) {
    refresh(F);
    const int lane = F.lane, q = lane & 31, hh = lane >> 5, w = F.wave, c = w * 32 + q;
    LAS unsigned char* L = F.lds + RING_OFF;
    const unsigned char* tab = F.ws + WS_TAB;
    const size_t m0 = (size_t)b * TP + (size_t)8 * c;
    const bf16* zrow = (const bf16*)(F.ws + WS_Z) + m0 * NZ + 2 * WA + g * KS5 + 8 * hh;
    bf16* grow = (bf16*)(F.ws + WS_G) + m0 * WB + g * KS5 + 8 * hh;
    LAS v4u* UL = (LAS v4u*)(L + S5L_U) + F.tid;
    {
        v4u uu[8];
#pragma unroll
        for (int j = 0; j < 8; ++j) uu[j] = *(const v4u*)(zrow + (size_t)j * NZ);
        const v4u* s1 = (const v4u*)(tab + TB_BF1) + (size_t)g * 256; const v4u* s2 = (const v4u*)(tab + TB_BF2) + (size_t)g * 512;
        if (F.tid < 256) ((LAS v4u*)(L + S5L_BF1))[F.tid] = s1[F.tid];
        ((LAS v4u*)(L + S5L_BF2))[F.tid] = s2[F.tid];
        const v4u* s3 = (const v4u*)(tab + TB_ZP) + (size_t)g * (17 * 128 / 4); for (int e = F.tid; e < 17 * 128 / 4; e += NWAVES * 64) ((LAS v4u*)(L + S5L_ZP))[e] = s3[e];
        if (F.tid < 32) ((LAS v4u*)(L + S5L_TA))[F.tid] = ((const v4u*)(tab + TB_TA) + (size_t)g * 32)[F.tid];
#pragma unroll
        for (int j = 0; j < 8; ++j) UL[512 * j] = uu[j];
    }
    __syncthreads();
    const LAS float* TA = (const LAS float*)(L + S5L_TA) + hh * 64;
    f32x16 ar0 = ld16l(TA), ar1 = ld16l(TA + 16), ai0 = ld16l(TA + 32), ai1 = ld16l(TA + 48);
    f32x16 hr0, hr1, hi0, hi1;
#pragma unroll
    for (int i = 0; i < 16; ++i) { hr0[i] = 0.f; hr1[i] = 0.f; hi0[i] = 0.f; hi1[i] = 0.f; }
    float dk[8];
#pragma unroll
    for (int i = 0; i < 8; ++i) dk[i] = A.in[I_S5D][g * KS5 + 8 * hh + i];
#pragma unroll 1
    for (int j = 0; j < 8; ++j) { const bf16x8v u = __builtin_bit_cast(bf16x8v, UL[512 * j]);
        s5_step<false>(L, lane, u, hr0, hr1, hi0, hi1, ar0, ar1, ai0, ai1, dk, nullptr); }
    const LAS float* ZP = (const LAS float*)(L + S5L_ZP);
#define S5_SCAN(E, CTRL) do { const LAS float* z = ZP + (((E) * 2 + hh) * 2) * 32; \
        { const f32x16 zr = ld16l(z), zi = ld16l(z + 32); s5_scan_step<CTRL>(hr0, hi0, zr, zi); } \
        asm volatile("" : "+v"(hr0), "+v"(hi0) :: "memory"); \
        { const f32x16 zr = ld16l(z + 16), zi = ld16l(z + 48); s5_scan_step<CTRL>(hr1, hi1, zr, zi); } \
        asm volatile("" : "+v"(hr1), "+v"(hi1) :: "memory"); } while (0)
    S5_SCAN(1, 0x111); S5_SCAN(2, 0x112); S5_SCAN(4, 0x114); S5_SCAN(8, 0x118);
#undef S5_SCAN
    const int seg = w * 2 + (q >> 4);
    LAS float* TOT = (LAS float*)(L + S5L_TOT); LAS float* CAR = (LAS float*)(L + S5L_CAR);
    if ((lane & 15) == 15) {
#pragma unroll
        for (int rho = 0; rho < 4; ++rho) {
            *(LAS f32x4*)(TOT + (seg * 2 + 0) * 64 + 0 + 8 * rho + 4 * hh) = (f32x4){hr0[4 * rho], hr0[4 * rho + 1], hr0[4 * rho + 2], hr0[4 * rho + 3]};
            *(LAS f32x4*)(TOT + (seg * 2 + 0) * 64 + 32 + 8 * rho + 4 * hh) = (f32x4){hr1[4 * rho], hr1[4 * rho + 1], hr1[4 * rho + 2], hr1[4 * rho + 3]};
            *(LAS f32x4*)(TOT + (seg * 2 + 1) * 64 + 0 + 8 * rho + 4 * hh) = (f32x4){hi0[4 * rho], hi0[4 * rho + 1], hi0[4 * rho + 2], hi0[4 * rho + 3]};
            *(LAS f32x4*)(TOT + (seg * 2 + 1) * 64 + 32 + 8 * rho + 4 * hh) = (f32x4){hi1[4 * rho], hi1[4 * rho + 1], hi1[4 * rho + 2], hi1[4 * rho + 3]}; }
    }
    __syncthreads();
    if (F.tid < 64) {
        const float* z16 = (const float*)(tab + TB_Z16N) + (size_t)g * 128; const float zr = z16[F.tid], zi = z16[64 + F.tid];
        float cr = 0.f, ci = 0.f;
#pragma unroll
        for (int sg = 0; sg < 16; ++sg) { CAR[(sg * 2 + 0) * 64 + F.tid] = cr; CAR[(sg * 2 + 1) * 64 + F.tid] = ci;
            const float tr = TOT[(sg * 2 + 0) * 64 + F.tid], ti = TOT[(sg * 2 + 1) * 64 + F.tid];
            const float ncr = zr * cr - zi * ci + tr, nci = zr * ci + zi * cr + ti; cr = ncr; ci = nci; }
    }
    __syncthreads();
    {
        const LAS float* z = ZP + (((q & 15) * 2 + hh) * 2) * 32;
#define S5_EXCL(HR, HI, OFF) do { const f32x16 zr = ld16l(z + (OFF)), zi = ld16l(z + 32 + (OFF)); f32x16 kr, ki; \
        _Pragma("unroll") for (int rho = 0; rho < 4; ++rho) { \
            const f32x4 a0 = *(const LAS f32x4*)(CAR + (seg * 2 + 0) * 64 + 2 * (OFF) + 8 * rho + 4 * hh), b0 = *(const LAS f32x4*)(CAR + (seg * 2 + 1) * 64 + 2 * (OFF) + 8 * rho + 4 * hh); \
            _Pragma("unroll") for (int e = 0; e < 4; ++e) { kr[4 * rho + e] = a0[e]; ki[4 * rho + e] = b0[e]; } } \
        _Pragma("unroll") for (int i = 0; i < 16; ++i) { const float sr = dppf<0x111>(0.f, HR[i]), si = dppf<0x111>(0.f, HI[i]); \
            HR[i] = sr + zr[i] * kr[i] - zi[i] * ki[i]; HI[i] = si + zr[i] * ki[i] + zi[i] * kr[i]; } } while (0)
        S5_EXCL(hr0, hi0, 0); asm volatile("" : "+v"(hr0), "+v"(hi0) :: "memory"); S5_EXCL(hr1, hi1, 16); asm volatile("" : "+v"(hr1), "+v"(hi1) :: "memory");
#undef S5_EXCL
    }
    { int off = 0; asm volatile("" : "+v"(off)); const LAS float* TA2 = TA + off; ar0 = ld16l(TA2); ar1 = ld16l(TA2 + 16); ai0 = ld16l(TA2 + 32); ai1 = ld16l(TA2 + 48); }
#pragma unroll 1
    for (int j = 0; j < 8; ++j) { const bf16x8v u = __builtin_bit_cast(bf16x8v, UL[512 * j]);
        s5_step<true>(L, lane, u, hr0, hr1, hi0, hi1, ar0, ar1, ai0, ai1, dk, grow + (size_t)j * WB); }
    if (w == NWAVES - 1 && q == 31) {
        float* osr = F.out + O_SRP + (size_t)(b * GB + g) * NS5; float* osi = F.out + O_SIP + (size_t)(b * GB + g) * NS5;
#pragma unroll
        for (int i = 0; i < 16; ++i) { const int n = (i & 3) + 8 * (i >> 2) + 4 * hh; osr[n] = hr0[i]; osr[32 + n] = hr1[i]; osi[n] = hi0[i]; osi[32 + n] = hi1[i]; }
    }
    __syncthreads();
}

__device__ __forceinline__ void s5_item_sample(Frame& F, const Args& A, int g) {
    refresh(F);
    const int lane = F.lane, q = lane & 31, hh = lane >> 5, w = F.wave;
    LAS unsigned char* L = F.lds + RING_OFF;
    const unsigned char* tab = F.ws + WS_TAB;
    { const v4u* s1 = (const v4u*)(tab + TB_BF1) + (size_t)g * 256; const v4u* s2 = (const v4u*)(tab + TB_BF2) + (size_t)g * 512;
      if (F.tid < 256) ((LAS v4u*)(L + S5L_BF1))[F.tid] = s1[F.tid];
      ((LAS v4u*)(L + S5L_BF2))[F.tid] = s2[F.tid]; }
    __syncthreads();
    if (w < 4) {
        const int b = w * 32 + q;
        const float* TA = (const float*)(tab + TB_TA) + (size_t)((g * 2 + hh) * 2) * 32;
        const f32x16 ar0 = ld16(TA), ar1 = ld16(TA + 16), ai0 = ld16(TA + 32), ai1 = ld16(TA + 48);
        f32x16 hr0, hr1, hi0, hi1;
        const float* sr = A.in[I_SSR] + (size_t)(b * GB + g) * NS5; const float* si = A.in[I_SSI] + (size_t)(b * GB + g) * NS5;
#pragma unroll
        for (int rho = 0; rho < 4; ++rho) { const f32x4 a0 = *(const f32x4*)(sr + 8 * rho + 4 * hh), a1 = *(const f32x4*)(sr + 32 + 8 * rho + 4 * hh), b0 = *(const f32x4*)(si + 8 * rho + 4 * hh), b1 = *(const f32x4*)(si + 32 + 8 * rho + 4 * hh);
#pragma unroll
            for (int e = 0; e < 4; ++e) { hr0[4 * rho + e] = a0[e]; hr1[4 * rho + e] = a1[e]; hi0[4 * rho + e] = b0[e]; hi1[4 * rho + e] = b1[e]; } }
        float dk[8];
#pragma unroll
        for (int i = 0; i < 8; ++i) dk[i] = A.in[I_S5D][g * KS5 + 8 * hh + i];
        const size_t m0 = (size_t)MP + (size_t)b * TS;
        const bf16* zrow = (const bf16*)(F.ws + WS_Z) + m0 * NZ + 2 * WA + g * KS5 + 8 * hh;
        bf16* grow = (bf16*)(F.ws + WS_G) + m0 * WB + g * KS5 + 8 * hh;
        bf16x8v uu[TS];
#pragma unroll
        for (int j = 0; j < TS; ++j) uu[j] = *(const bf16x8v*)(zrow + (size_t)j * NZ);
#pragma unroll
        for (int j = 0; j < TS; ++j) s5_step<true>(L, lane, uu[j], hr0, hr1, hi0, hi1, ar0, ar1, ai0, ai1, dk, grow + (size_t)j * WB);
        float* osr = F.out + O_SRS + (size_t)(b * GB + g) * NS5; float* osi = F.out + O_SIS + (size_t)(b * GB + g) * NS5;
#pragma unroll
        for (int rho = 0; rho < 4; ++rho) {
            *(f32x4*)(osr + 8 * rho + 4 * hh) = (f32x4){hr0[4 * rho], hr0[4 * rho + 1], hr0[4 * rho + 2], hr0[4 * rho + 3]};
            *(f32x4*)(osr + 32 + 8 * rho + 4 * hh) = (f32x4){hr1[4 * rho], hr1[4 * rho + 1], hr1[4 * rho + 2], hr1[4 * rho + 3]};
            *(f32x4*)(osi + 8 * rho + 4 * hh) = (f32x4){hi0[4 * rho], hi0[4 * rho + 1], hi0[4 * rho + 2], hi0[4 * rho + 3]};
            *(f32x4*)(osi + 32 + 8 * rho + 4 * hh) = (f32x4){hi1[4 * rho], hi1[4 * rho + 1], hi1[4 * rho + 2], hi1[4 * rho + 3]}; }
    }
    __syncthreads();
}

template <int CTRL, int RMASK> __device__ __forceinline__ float dppm(float old, float v) { return __builtin_bit_cast(float, __builtin_amdgcn_update_dpp(__builtin_bit_cast(int, old), __builtin_bit_cast(int, v), CTRL, RMASK, 0xF, false)); }
template <int CTRL, int RMASK> __device__ __forceinline__ void rg_scan_step(f32x16& a, f32x16& b) {
#pragma unroll
    for (int i = 0; i < 16; ++i) { const float as = dppm<CTRL, RMASK>(1.f, a[i]), bs = dppm<CTRL, RMASK>(0.f, b[i]); b[i] = a[i] * bs + b[i]; a[i] = a[i] * as; }
}
constexpr int RGL_AFR = 0, RGL_CWT = 8192, RGL_TOT = 10240, RGL_CST = 14336;
constexpr int RGL_XAP = 144, RGL_GTP = 80;
constexpr int RGL_XA0 = 14848, RGL_GT0 = RGL_XA0 + 37376, RGL_BUF = 37376 + 20480;
static_assert(259 * RGL_XAP <= 37376 && 256 * RGL_GTP <= 20480 && RGL_XA0 + 2 * RGL_BUF <= RING_BYTES, "RG-LRU LDS map");
template <bool SAMPLE>
__device__ __forceinline__ void rg_item_fast(Frame& F, const Args& A, int b, int hd, int jh) {
    refresh(F);
    const int lane = F.lane, q = lane & 31, hh = lane >> 5, w = F.wave;
    LAS unsigned char* L = F.lds + RING_OFF;
    const float* sc = (const float*)(F.ws + WS_S5C);
    const bf16* Zb = (const bf16*)(F.ws + WS_Z) + (size_t)(SAMPLE ? MP : b * TP) * NZ; bf16* Yb = (bf16*)(F.ws + WS_YCAT) + (size_t)(SAMPLE ? MP : b * TP) * D;
    const bf16* CB = (const bf16*)(F.ws + WS_TAB + TB_CB);
    auto stage_load = [&](int T0, v4u (&st)[7]) {
#pragma unroll
        for (int k = 0; k < 7; ++k) { const int ci = F.tid + 512 * k; v4u v = (v4u){0u, 0u, 0u, 0u};
            if (ci < 2072) { const int tk = T0 - 3 + (ci >> 3); if (tk >= 0) v = *(const v4u*)(Zb + (size_t)tk * NZ + WA + hd * 64 + (ci & 7) * 8); }
            else if (ci < 2072 + 1024) { const int gi = ci - 2072; v = *(const v4u*)(Zb + (size_t)(T0 + (gi >> 2)) * NZ + hd * 64 + 32 * jh + (gi & 3) * 8); }
            st[k] = v; } };
    auto stage_write = [&](int par, const v4u (&st)[7]) {
#pragma unroll
        for (int k = 0; k < 7; ++k) { const int ci = F.tid + 512 * k;
            if (ci < 2072) *(LAS v4u*)(L + RGL_XA0 + par * RGL_BUF + (ci >> 3) * RGL_XAP + (ci & 7) * 16) = st[k];
            else if (ci < 2072 + 1024) { const int gi = ci - 2072; *(LAS v4u*)(L + RGL_GT0 + par * RGL_BUF + (gi >> 2) * RGL_GTP + (gi & 3) * 16) = st[k]; } } };
    {
        const v4u* src = (const v4u*)(F.ws + WS_TAB + TB_RG) + (size_t)((hd * 2 + jh) * 8) * 64;
        ((LAS v4u*)(L + RGL_AFR))[F.tid] = src[F.tid];
        if (F.tid < 320) { const int h2 = F.tid / 160, tap = (F.tid % 160) / 32, e = F.tid % 32, c = hd * 64 + 16 * (e >> 3) + 8 * h2 + (e & 7);
            ((LAS float*)(L + RGL_CWT))[F.tid] = tap < 4 ? A.in[I_CONVW][tap * WA + c] : A.in[I_CONVB][c]; }
        if (F.tid >= 384 && F.tid < 480) { const int e = F.tid - 384, h2 = e / 48, kind = (e % 48) / 16, i = e % 16, c = hd * 64 + 32 * jh + 16 * (i >> 3) + 8 * h2 + (i & 7);
            ((LAS float*)(L + RGL_CST))[e] = kind == 0 ? A.in[I_RGBR][c] : (kind == 1 ? A.in[I_RGBI][c] : sc[SC_RGL + c]); }
        if (!SAMPLE && jh == 0 && F.tid < 192) { const int k = F.tid >> 6, ch = F.tid & 63;
            F.out[O_CONVP + (size_t)(b * 3 + k) * WA + hd * 64 + ch] = bf2f(((const bf16*)(F.ws + WS_Z))[(size_t)(b * TP + TP - 3 + k) * NZ + WA + hd * 64 + ch]); }
        if (SAMPLE && jh == 0) { for (int e = F.tid; e < NBS * 3 * 64; e += NWAVES * 64) { const int bb = e / 192, k = (e / 64) % 3, ch = e & 63;
            F.out[O_CONVS + (size_t)(bb * 3 + k) * WA + hd * 64 + ch] = bf2f(((const bf16*)(F.ws + WS_Z))[(size_t)(MP + bb * TS + 1 + k) * NZ + WA + hd * 64 + ch]); } }
        if (!SAMPLE) { v4u st[7]; stage_load(0, st); stage_write(0, st); }
    }
    __syncthreads();
    float hround[16];
#pragma unroll
    for (int i = 0; i < 16; ++i) hround[i] = 0.f;
    const LAS float* CWT = (const LAS float*)(L + RGL_CWT) + hh * 160;
#pragma unroll 1
    for (int rd = 0; rd < (SAMPLE ? 2 : 8); ++rd) {
        const int t = rd * 256 + w * 32 + q;
        v4u stn[7];
        if (!SAMPLE) stage_load((rd + 1) * 256, stn);
        const LAS unsigned char* XAp = L + RGL_XA0 + (rd & 1) * RGL_BUF + (w * 32 + q) * RGL_XAP + 16 * hh;
        const LAS unsigned char* GTp = L + RGL_GT0 + (rd & 1) * RGL_BUF + (w * 32 + q) * RGL_GTP + 16 * hh;
        const bf16* zsr[4];
        if (SAMPLE) {
#pragma unroll
            for (int k = 0; k < 4; ++k) { const int jx = (t & 3) + k; zsr[k] = (jx < 3 ? CB + (size_t)((t >> 2) * 3 + jx) * WA : Zb + (size_t)(t - 3 + k) * NZ + WA) + hd * 64 + 8 * hh; } }
        v4u g0, g1;
        if (SAMPLE) { const bf16* gr = Zb + (size_t)t * NZ + hd * 64 + 32 * jh + 8 * hh; g0 = *(const v4u*)gr; g1 = *(const v4u*)(gr + 16); }
        else { g0 = *(const LAS v4u*)GTp; g1 = *(const LAS v4u*)(GTp + 32); }
        float xc[32];
#pragma unroll
        for (int s4 = 0; s4 < 4; ++s4) {
            float acc[8];
#pragma unroll
            for (int j4 = 0; j4 < 2; ++j4) { const f32x4 cb = *(const LAS f32x4*)(CWT + 4 * 32 + s4 * 8 + 4 * j4); acc[4 * j4] = cb[0]; acc[4 * j4 + 1] = cb[1]; acc[4 * j4 + 2] = cb[2]; acc[4 * j4 + 3] = cb[3]; }
#pragma unroll
            for (int k = 0; k < 4; ++k) { const v4u v = SAMPLE ? *(const v4u*)(zsr[k] + 16 * s4) : *(const LAS v4u*)(XAp + k * RGL_XAP + s4 * 32);
                const f32x4 w0 = *(const LAS f32x4*)(CWT + k * 32 + s4 * 8), w1 = *(const LAS f32x4*)(CWT + k * 32 + s4 * 8 + 4);
                acc[0] += w0[0] * pg8::bf_lo(v.x); acc[1] += w0[1] * pg8::bf_hi(v.x); acc[2] += w0[2] * pg8::bf_lo(v.y); acc[3] += w0[3] * pg8::bf_hi(v.y);
                acc[4] += w1[0] * pg8::bf_lo(v.z); acc[5] += w1[1] * pg8::bf_hi(v.z); acc[6] += w1[2] * pg8::bf_lo(v.w); acc[7] += w1[3] * pg8::bf_hi(v.w); }
#pragma unroll
            for (int e = 0; e < 8; ++e) xc[s4 * 8 + e] = acc[e];
            asm volatile("" : "+v"(xc[s4 * 8]), "+v"(xc[s4 * 8 + 7]) :: "memory");
        }
        f32x16 dr, di;
#pragma unroll
        for (int i = 0; i < 16; ++i) { dr[i] = 0.f; di[i] = 0.f; }
        const LAS bf16x8v* af = (const LAS bf16x8v*)(L + RGL_AFR) + lane;
#pragma unroll
        for (int s4 = 0; s4 < 4; ++s4) { v4u p; p.x = pkbf(xc[s4 * 8], xc[s4 * 8 + 1]); p.y = pkbf(xc[s4 * 8 + 2], xc[s4 * 8 + 3]); p.z = pkbf(xc[s4 * 8 + 4], xc[s4 * 8 + 5]); p.w = pkbf(xc[s4 * 8 + 6], xc[s4 * 8 + 7]);
            const bf16x8v bfr = __builtin_bit_cast(bf16x8v, p);
            dr = MFMA32(af[s4 * 64], bfr, dr); di = MFMA32(af[(4 + s4) * 64], bfr, di); }
        f32x16 av, bv;
        const bool first = !SAMPLE && (t == 0);
        const LAS float* CST = (const LAS float*)(L + RGL_CST) + hh * 48;
#pragma unroll
        for (int i = 0; i < 16; ++i) { const float xcv = jh ? xc[16 + i] : xc[i];
            const float r = sigmoidf_(dr[i] + CST[i]), gi = sigmoidf_(di[i] + CST[16 + i]);
            const float a = __builtin_amdgcn_exp2f(r * CST[32 + i]);
            float mult = __builtin_amdgcn_sqrtf(fmaxf(1.f - a * a, 0.f)); if (first) mult = 1.f;
            av[i] = a; bv[i] = mult * gi * xcv; }
        if (SAMPLE && (t & 3) == 0) {
            const float* h0 = A.in[I_SH] + (size_t)(t >> 2) * WA + hd * 64 + 32 * jh + 8 * hh;
#pragma unroll
            for (int i = 0; i < 16; ++i) { bv[i] += av[i] * h0[16 * (i >> 3) + (i & 7)]; av[i] = 0.f; } }
        rg_scan_step<0x111, 0xF>(av, bv); rg_scan_step<0x112, 0xF>(av, bv); rg_scan_step<0x114, 0xF>(av, bv); rg_scan_step<0x118, 0xF>(av, bv);
        rg_scan_step<0x142, 0xA>(av, bv);
        float hin[16];
#pragma unroll
        for (int i = 0; i < 16; ++i) hin[i] = 0.f;
        if (!SAMPLE) {
        LAS float* TOT = (LAS float*)(L + RGL_TOT) + (rd & 1) * 512;
        if (q == 31) {
#pragma unroll
            for (int i4 = 0; i4 < 4; ++i4) { *(LAS f32x4*)(TOT + (w * 2 + 0) * 32 + hh * 16 + 4 * i4) = (f32x4){av[4 * i4], av[4 * i4 + 1], av[4 * i4 + 2], av[4 * i4 + 3]};
                                             *(LAS f32x4*)(TOT + (w * 2 + 1) * 32 + hh * 16 + 4 * i4) = (f32x4){bv[4 * i4], bv[4 * i4 + 1], bv[4 * i4 + 2], bv[4 * i4 + 3]}; }
        }
        stage_write((rd + 1) & 1, stn);
        __syncthreads();
#pragma unroll
        for (int w2 = 0; w2 < 8; ++w2) {
            if (w2 == w) {
#pragma unroll
                for (int i = 0; i < 16; ++i) hin[i] = hround[i]; }
#pragma unroll
            for (int i4 = 0; i4 < 4; ++i4) { const f32x4 p = *(const LAS f32x4*)(TOT + (w2 * 2 + 0) * 32 + hh * 16 + 4 * i4), hl = *(const LAS f32x4*)(TOT + (w2 * 2 + 1) * 32 + hh * 16 + 4 * i4);
#pragma unroll
                for (int e = 0; e < 4; ++e) hround[4 * i4 + e] = p[e] * hround[4 * i4 + e] + hl[e]; }
        }
        }
        float o[16];
        const unsigned gw_[8] = {g0.x, g0.y, g0.z, g0.w, g1.x, g1.y, g1.z, g1.w};
#pragma unroll
        for (int i = 0; i < 16; ++i) { const float h = bv[i] + av[i] * hin[i]; const float gt = (i & 1) ? pg8::bf_hi(gw_[i >> 1]) : pg8::bf_lo(gw_[i >> 1]); o[i] = gelu_tanh(gt) * h; }
        bf16* yr = Yb + (size_t)t * D + hd * 64 + 32 * jh + 8 * hh;
        v4u w0; w0.x = pkbf(o[0], o[1]); w0.y = pkbf(o[2], o[3]); w0.z = pkbf(o[4], o[5]); w0.w = pkbf(o[6], o[7]);
        v4u w1; w1.x = pkbf(o[8], o[9]); w1.y = pkbf(o[10], o[11]); w1.z = pkbf(o[12], o[13]); w1.w = pkbf(o[14], o[15]);
        *(v4u*)yr = w0; *(v4u*)(yr + 16) = w1;
        if (SAMPLE && (t & 3) == 3) {
#pragma unroll
            for (int i = 0; i < 16; ++i) F.out[O_HS + (size_t)(t >> 2) * WA + hd * 64 + 32 * jh + 16 * (i >> 3) + 8 * hh + (i & 7)] = bv[i]; }
    }
    if (!SAMPLE && w == 0 && q == 0) {
#pragma unroll
        for (int i = 0; i < 16; ++i) F.out[O_HP + (size_t)b * WA + hd * 64 + 32 * jh + 16 * (i >> 3) + 8 * hh + (i & 7)] = hround[i];
    }
    __syncthreads();
}

#ifndef PROBE_P3PART
#define PROBE_P3PART 7
#endif
__device__ __forceinline__ void p3_mixers_ref(Frame& F, const Args& A, int rep = 0) {
    constexpr int N_RGP = NBP * HA, N_S5P = NBP * GB;
    const int pm = rep ? PROBE_P3PART : 7;
    if (F.vcu < 2 * N_RGP) {
        if (pm & 1) rg_item_fast<false>(F, A, F.vcu / (2 * HA), (F.vcu / 2) % HA, F.vcu & 1);
    } else {
        const int v = F.vcu - 2 * N_RGP, it = 2 * v;
        if (pm & 2) { s5_item_fast(F, A, it / GB, it % GB);
                      s5_item_fast(F, A, (it + 1) / GB, (it + 1) % GB); }
        if (pm & 4) { if (v < GB) s5_item_sample(F, A, v);
                      else if (v < GB + 2 * HA) rg_item_fast<true>(F, A, 0, (v - GB) >> 1, (v - GB) & 1); }
    }
    if (rep == 0) xpose_range(F, A, XO_2, XO_END, 2 * N_RGP);
}

__global__ void __launch_bounds__(NWAVES * 64, 2) fwd(Args A) {
    extern __shared__ __attribute__((aligned(16))) unsigned char lds[];
    Frame F;
    F.lds = (LAS unsigned char*)lds;
    F.MISC = (volatile LAS unsigned*)(F.lds + MISC_OFF);
    F.tid = threadIdx.x; F.lane = F.tid & 63; F.wave = __builtin_amdgcn_readfirstlane(F.tid >> 6);
    F.G = gridDim.x; { const int bx = blockIdx.x; F.vcu = (F.G % 8 == 0) ? (bx % 8) * (F.G / 8) + bx / 8 : bx; }
    F.out = A.out; F.ws = A.ws; F.ctl = (gu32*)(A.ws + WS_CTL);
    for (int u = F.tid; u < (LDS_BYTES - LDSCTL_OFF) / 4; u += NWAVES * 64) ((LAS unsigned*)(F.lds + LDSCTL_OFF))[u] = 0u;
    __syncthreads();
    XcdBarrier bar; bar.bar = (unsigned*)(F.ctl + CW_BAR); bar.x = 0; bar.st = nullptr;
    if (N_LAUNCHES == 1) bar = xcd_barrier_post((unsigned*)(F.ctl + CW_BAR), F.MISC + 8);
#define GRID_BAR() do { if (N_LAUNCHES == 1) xcd_barrier(bar); } while (0)
    const int lo = A.ph_lo, hi = A.ph_hi;
#define IN(k) (lo <= (k) && (k) < hi)
#define BOTH(k) (IN(k) && IN((k) + 1))
    bf16* XN = (bf16*)(F.ws + WS_XN); bf16* Z = (bf16*)(F.ws + WS_Z); bf16* YC = (bf16*)(F.ws + WS_YCAT); bf16* GY = (bf16*)(F.ws + WS_G); bf16* U = (bf16*)(F.ws + WS_U);
    const float* mod = (const float*)(F.ws + WS_MOD);

#define REPS(k) (((PROBE_DUP) >> (k)) & 1 ? 2 : 1)
    if (IN(0)) { for (int rep = 0; rep < REPS(0); ++rep) p0_prologue(F, A, rep); if (BOTH(0)) GRID_BAR(); }
    if (IN(1)) { for (int rep = 0; rep < REPS(1); ++rep) p1_modulate(F, A); if (BOTH(1)) GRID_BAR(); }
    if (IN(2)) for (int rep = 0; rep < REPS(2); ++rep) {
        pg8::Gemm g{XN, (const bf16*)(F.ws + WS_WIN), M, NZ, D}; pg8::StaticOrder S; S.init(M, NZ, F.G, (int)blockIdx.x, D);
        pg8::EpiBf16<0> E{Z, NZ, nullptr};
        pg8::gemm_phase<pg8::EpiBf16<0>, pg8::StaticOrder, PG8_ALIGN, PG8_SP2>(F.lds + RING_OFF, g, S, E);
        if (BOTH(2) && rep == REPS(2) - 1) GRID_BAR();
    }
    if (IN(3)) {
#pragma unroll 1
        for (int rep = 0; rep < REPS(3); ++rep) p3_mixers_ref(F, A, rep);
        if (BOTH(3)) GRID_BAR(); }
    if (IN(4)) for (int rep = 0; rep < REPS(4); ++rep) {
        pg8::Gemm g{GY, (const bf16*)(F.ws + WS_WGLU), M, WB, WB}; pg8::StaticOrder S; S.init(M, WB, F.G, (int)blockIdx.x, WB);
        pg8::EpiGlu E{GY, WB, YC, D, WA, A.in[I_GLUB]};
        pg8::gemm_phase<pg8::EpiGlu, pg8::StaticOrder, PG8_ALIGN, PG8_SP2>(F.lds + RING_OFF, g, S, E);
        if (rep == 0 && (int)blockIdx.x >= (M / 256) * (WB / 256)) { __syncthreads(); xpose_range_b(F, A, XO_OU, XO_2, (M / 256) * (WB / 256)); }
        if (BOTH(4) && rep == REPS(4) - 1) GRID_BAR();
    }
    if (IN(5)) {
        pg8::Gemm g{YC, (const bf16*)(F.ws + WS_WOUT), M, D, D}; pg8::SplitOrder S; S.init(MP, D, F.G, (int)blockIdx.x, D, NS_OUT);
        pg8::EpiRes E{A.in[I_XP], (bf16*)(F.ws + WS_T1), mod + 2 * D, nullptr, ALPHA, MP, (float*)(F.ws + WS_SLAB)};
        pg8::gemm_phase<pg8::EpiRes, pg8::SplitOrder, PG8_ALIGN, PG8_SP2>(F.lds + RING_OFF, g, S, E);
        if (BOTH(5)) GRID_BAR();
    }
    if (IN(6)) { ln_rows<false>(F, A); if (BOTH(6)) GRID_BAR(); }
    if (IN(7)) for (int rep = 0; rep < REPS(7); ++rep) {
        pg8::Gemm g{XN, (const bf16*)(F.ws + WS_W1), M, FF, D}; pg8::StaticOrder S; S.init(M, FF, F.G, (int)blockIdx.x, D);
        pg8::EpiBf16<3> E{U, FF, A.in[I_B1]};
        pg8::gemm_phase<pg8::EpiBf16<3>, pg8::StaticOrder, PG8_ALIGN, PG8_SP2>(F.lds + RING_OFF, g, S, E);
        if (BOTH(7) && rep == REPS(7) - 1) GRID_BAR();
    }
    if (IN(8)) {
        pg8::Gemm g{U, (const bf16*)(F.ws + WS_W2), M, D, FF}; pg8::SplitOrder S; S.init(MP, D, F.G, (int)blockIdx.x, FF, NS_DOWN);
        pg8::EpiRes E{F.out, (bf16*)(F.ws + WS_T2), mod + 5 * D, A.in[I_B2], ALPHA, MP, (float*)(F.ws + WS_SLAB)};
        pg8::gemm_phase<pg8::EpiRes, pg8::SplitOrder, PG8_ALIGN, PG8_SP2>(F.lds + RING_OFF, g, S, E);
        if (BOTH(8)) GRID_BAR();
    }
    if (IN(9)) { ln_rows<true>(F, A); }
#undef IN
#undef BOTH
}

extern "C" void kernel_launch(void* const* d_in, const int* in_sizes, int n_in, void* d_out, int out_size, void* d_ws, size_t ws_size, hipStream_t stream) {
    static int grid = 0;
    if (grid == 0) {
        if (n_in != 37 || in_sizes[0] != MP * D || out_size != (int)O_END || ws_size < WS_END) { fprintf(stderr, "kernel_launch: unexpected shapes (n_in %d, in0 %d, out %d, ws %zu)\n", n_in, n_in > 0 ? in_sizes[0] : -1, out_size, ws_size); grid = -1; return; }
        int dev = 0, cus = 0, per_cu = 0;
        if (hipGetDevice(&dev) != hipSuccess || hipDeviceGetAttribute(&cus, hipDeviceAttributeMultiprocessorCount, dev) != hipSuccess) { grid = -1; return; }
        if (hipFuncSetAttribute((const void*)fwd, hipFuncAttributeMaxDynamicSharedMemorySize, LDS_BYTES) != hipSuccess) { fprintf(stderr, "kernel_launch: hipFuncSetAttribute failed\n"); grid = -1; return; }
        if (hipOccupancyMaxActiveBlocksPerMultiprocessor(&per_cu, (const void*)fwd, NWAVES * 64, LDS_BYTES) != hipSuccess || per_cu < 1) { fprintf(stderr, "kernel_launch: occupancy query says %d\n", per_cu); }
        (void)hipGetLastError();
        grid = cus;
        if (grid < 256) { fprintf(stderr, "kernel_launch: this build needs 256 CUs (got %d)\n", grid); grid = -1; return; }
        grid = 256;
    }
    if (grid < 0) return;
    (void)hipMemsetAsync((char*)d_ws + WS_CTL, 0, CTL_ZERO_BYTES, stream);
    Args a{};
    for (int i = 0; i < 37; ++i) a.in[i] = (const float*)d_in[i];
    a.out = (float*)d_out; a.ws = (unsigned char*)d_ws;
    for (int li = 0; li < N_LAUNCHES; ++li) {
        if (N_LAUNCHES == 1) { a.ph_lo = 0; a.ph_hi = N_PHASES; } else { a.ph_lo = li; a.ph_hi = li + 1; }
        a.li = li;
        hipLaunchKernelGGL(fwd, dim3(grid), dim3(NWAVES * 64), LDS_BYTES, stream, a);
    }
}
```

```cpp
#include <hip/hip_runtime.h>
#include <cstdio>
#include <cstdint>
#include <cmath>

#ifndef MK_N_LAUNCHES
#define MK_N_LAUNCHES 1
#endif

namespace pg8 {
#define PG8_LAS __attribute__((address_space(3)))
typedef unsigned short bf16_t;
typedef short bf16x8 __attribute__((ext_vector_type(8)));
typedef float f32x4 __attribute__((ext_vector_type(4)));
typedef unsigned u32x4 __attribute__((ext_vector_type(4)));
constexpr int BM = 256, BK = 64, HALF = 128, HTB = HALF * BK * 2, STAGE_BYTES = 8 * HTB, NXCD = 8, WGM = 8;

__host__ __device__ __forceinline__ int lds_byte(int r, int c) { const int st = (r >> 4) * 2 + (c >> 5), rr = r & 15, cc = c & 31, ob = rr * 64 + cc * 2; return st * 1024 + (ob ^ (((ob >> 9) & 1) << 5)); }
__host__ __device__ __forceinline__ void stage_rc(int b, int& R, int& C) { const int st = b / 1024, sb = b % 1024, swz = sb ^ (((sb >> 9) & 1) << 5); R = (st >> 1) * 16 + swz / 64; C = (st & 1) * 32 + (swz % 64) / 2; }
__host__ __device__ __forceinline__ int perm32(int rho) { const int n = rho >> 4, i = rho & 15; return 8 * (i >> 2) + 4 * n + (i & 3); }

struct Unit { int pm, pn, k0, nkt, ks; };
struct Gemm { const bf16_t* A; const bf16_t* Bt; int M, N, K; };

struct StaticOrder {
    int nM, nN, nwg, G, c, K;
    __host__ __device__ void init(int M, int N, int G_, int c_, int K_) { nM = M / BM; nN = N / BM; nwg = nM * nN; G = G_; c = c_; K = K_; }
    __host__ __device__ __forceinline__ bool next(int i, Unit& u) const {
        const long L = (long)i * G + c; if (L >= nwg) return false;
        int wgid = (int)L; { const int q = nwg / NXCD, r = nwg % NXCD, xcd = wgid % NXCD, off = wgid / NXCD; wgid = (xcd < r ? xcd * (q + 1) : r * (q + 1) + (xcd - r) * q) + off; }
        const int nig = WGM * nN, gid = wgid / nig, fm = gid * WGM, gsz = (nM - fm) < WGM ? (nM - fm) : WGM;
        u.pm = fm + ((wgid % nig) % gsz); u.pn = (wgid % nig) / gsz; u.k0 = 0; u.nkt = K / BK; u.ks = 0; return true;
    }
    __device__ __forceinline__ void a_ready(const Unit&) const {}
    __device__ __forceinline__ void done(const Unit&) const {}
};

struct SplitOrder {
    StaticOrder P; int nN, NS, nP, G, c, K, r0;
    __host__ __device__ void init(int MPr, int N, int G_, int c_, int K_, int NS_) { P.init(MPr, N, G_, c_, K_); nN = N / BM; NS = NS_; nP = 2 * nN * NS; G = G_; c = c_; K = K_; r0 = (P.nwg + G - 1 - c) / G;   }
    __host__ __device__ __forceinline__ bool next(int i, Unit& u) const {
        Unit a; a.pm = 0; a.pn = 0; a.k0 = 0; a.nkt = K / BK; a.ks = 0;
        const bool okp = P.next(i < r0 ? i : 0, a);
        const int p = (i - r0) * G + (G - 1 - c), t = p / NS, ks = p % NS, nk = K / BK / NS;
        const bool split = i >= r0;
        u.pm = split ? P.nM + t / nN : a.pm; u.pn = split ? t % nN : a.pn; u.nkt = split ? nk : a.nkt; u.ks = split ? ks : 0; u.k0 = split ? ks * nk * BK : 0;
        return split ? (p < nP) : okp;
    }
    __device__ __forceinline__ void a_ready(const Unit&) const {}
    __device__ __forceinline__ void done(const Unit&) const {}
};

__device__ __forceinline__ unsigned cvt_pk_bf16(float lo, float hi) { unsigned r; asm volatile("v_cvt_pk_bf16_f32 %0, %1, %2" : "=v"(r) : "v"(lo), "v"(hi)); return r; }
__device__ __forceinline__ float bf_lo(unsigned w) { return __builtin_bit_cast(float, w << 16); }
__device__ __forceinline__ float bf_hi(unsigned w) { return __builtin_bit_cast(float, w & 0xffff0000u); }

template <int ACT> struct EpiBf16 {
    static constexpr bool PERM = true, AFTER_DRAIN = false;
    bf16_t* O; int ldc; const float* bias;
    __device__ __forceinline__ void operator()(const f32x4 (&acc)[2][2][4][2], const Unit& u, int wr, int wc, int fr, int fq) const {
        const int row0 = u.pm * BM + wr * 64 + fr; const int col0 = u.pn * BM + wc * 32 + 8 * fq;
        f32x4 bv[2][2];
#pragma unroll
        for (int bj = 0; bj < 2; ++bj)
#pragma unroll
            for (int n = 0; n < 2; ++n) bv[bj][n] = bias ? *(const f32x4*)(bias + col0 + bj * HALF + 4 * n) : (f32x4){0.f, 0.f, 0.f, 0.f};
#pragma unroll
        for (int ai = 0; ai < 2; ++ai)
#pragma unroll
            for (int m = 0; m < 4; ++m) { bf16_t* rowp = O + (size_t)(row0 + ai * HALF + m * 16) * ldc + col0;
#pragma unroll
                for (int bj = 0; bj < 2; ++bj) { f32x4 v0 = acc[ai][bj][m][0] + bv[bj][0], v1 = acc[ai][bj][m][1] + bv[bj][1];
                    if (ACT == 3) {
#pragma unroll
                        for (int e = 0; e < 4; ++e) { const float a = fmaxf(v0[e], 0.f), b = fmaxf(v1[e], 0.f); v0[e] = a * a; v1[e] = b * b; } }
                    u32x4 w; w.x = cvt_pk_bf16(v0[0], v0[1]); w.y = cvt_pk_bf16(v0[2], v0[3]); w.z = cvt_pk_bf16(v1[0], v1[1]); w.w = cvt_pk_bf16(v1[2], v1[3]);
                    *(u32x4*)(rowp + bj * HALF) = w; } }
    }
};
struct EpiGlu {
    static constexpr bool PERM = true, AFTER_DRAIN = false;
    const bf16_t* Gy; int ldg; bf16_t* O; int ldc; int coff; const float* bias;
    __device__ __forceinline__ void operator()(const f32x4 (&acc)[2][2][4][2], const Unit& u, int wr, int wc, int fr, int fq) const {
        const int row0 = u.pm * BM + wr * 64 + fr; const int col0 = u.pn * BM + wc * 32 + 8 * fq;
        f32x4 bv[2][2];
#pragma unroll
        for (int bj = 0; bj < 2; ++bj)
#pragma unroll
            for (int n = 0; n < 2; ++n) bv[bj][n] = *(const f32x4*)(bias + col0 + bj * HALF + 4 * n);
#pragma unroll
        for (int ai = 0; ai < 2; ++ai)
#pragma unroll
            for (int m = 0; m < 4; ++m) { const size_t row = (size_t)(row0 + ai * HALF + m * 16);
#pragma unroll
                for (int bj = 0; bj < 2; ++bj) { const f32x4 v0 = acc[ai][bj][m][0] + bv[bj][0], v1 = acc[ai][bj][m][1] + bv[bj][1];
                    const u32x4 g = *(const u32x4*)(Gy + row * ldg + col0 + bj * HALF);
                    float o[8];
                    o[0] = bf_lo(g.x) * __builtin_amdgcn_rcpf(1.f + __builtin_amdgcn_exp2f(-1.4426950408889634f * v0[0])); o[1] = bf_hi(g.x) * __builtin_amdgcn_rcpf(1.f + __builtin_amdgcn_exp2f(-1.4426950408889634f * v0[1]));
                    o[2] = bf_lo(g.y) * __builtin_amdgcn_rcpf(1.f + __builtin_amdgcn_exp2f(-1.4426950408889634f * v0[2])); o[3] = bf_hi(g.y) * __builtin_amdgcn_rcpf(1.f + __builtin_amdgcn_exp2f(-1.4426950408889634f * v0[3]));
                    o[4] = bf_lo(g.z) * __builtin_amdgcn_rcpf(1.f + __builtin_amdgcn_exp2f(-1.4426950408889634f * v1[0])); o[5] = bf_hi(g.z) * __builtin_amdgcn_rcpf(1.f + __builtin_amdgcn_exp2f(-1.4426950408889634f * v1[1]));
                    o[6] = bf_lo(g.w) * __builtin_amdgcn_rcpf(1.f + __builtin_amdgcn_exp2f(-1.4426950408889634f * v1[2])); o[7] = bf_hi(g.w) * __builtin_amdgcn_rcpf(1.f + __builtin_amdgcn_exp2f(-1.4426950408889634f * v1[3]));
                    u32x4 w; w.x = cvt_pk_bf16(o[0], o[1]); w.y = cvt_pk_bf16(o[2], o[3]); w.z = cvt_pk_bf16(o[4], o[5]); w.w = cvt_pk_bf16(o[6], o[7]);
                    *(u32x4*)(O + row * ldc + coff + col0 + bj * HALF) = w; } }
    }
};
template <bool BASE16> struct EpiRes {
    static constexpr bool PERM = true, AFTER_DRAIN = false;
    const void* basep; bf16_t* T; const float* gate  ; const float* bias; float alpha; int MP; float* slab;
    __device__ __forceinline__ void operator()(const f32x4 (&acc)[2][2][4][2], const Unit& u, int wr, int wc, int fr, int fq) const {
        const int row0 = u.pm * BM + wr * 64 + fr, col0 = u.pn * BM + wc * 32 + 8 * fq;
        if (row0 >= MP) {
            float* sp = slab + (size_t)u.ks * 512 * 1024;
#pragma unroll
            for (int ai = 0; ai < 2; ++ai)
#pragma unroll
                for (int m = 0; m < 4; ++m) { float* op = sp + (size_t)(row0 + ai * HALF + m * 16 - MP) * 1024;
#pragma unroll
                    for (int bj = 0; bj < 2; ++bj)
#pragma unroll
                        for (int n = 0; n < 2; ++n) *(f32x4*)(op + col0 + bj * HALF + n * 4) = acc[ai][bj][m][n]; }
            return; }
        f32x4 bv[2][2];
#pragma unroll
        for (int bj = 0; bj < 2; ++bj)
#pragma unroll
            for (int n = 0; n < 2; ++n) bv[bj][n] = bias ? *(const f32x4*)(bias + col0 + bj * HALF + n * 4) : (f32x4){0.f, 0.f, 0.f, 0.f};
        const float* gp = gate + (size_t)(row0 >> 11) * 6144;
#pragma unroll
        for (int ai = 0; ai < 2; ++ai)
#pragma unroll
            for (int m = 0; m < 4; ++m) { const int row = row0 + ai * HALF + m * 16;
                bf16_t* tp = T + (size_t)row * 1024;
#pragma unroll
                for (int bj = 0; bj < 2; ++bj) { const int c = col0 + bj * HALF;
                    f32x4 b0, b1;
                    if (BASE16) { const u32x4 bw = *(const u32x4*)((const bf16_t*)basep + (size_t)row * 1024 + c); b0 = (f32x4){bf_lo(bw.x), bf_hi(bw.x), bf_lo(bw.y), bf_hi(bw.y)}; b1 = (f32x4){bf_lo(bw.z), bf_hi(bw.z), bf_lo(bw.w), bf_hi(bw.w)}; }
                    else { const float* bp = (const float*)basep + (size_t)row * 1024; b0 = *(const f32x4*)(bp + c); b1 = *(const f32x4*)(bp + c + 4); }
                    const f32x4 g0 = *(const f32x4*)(gp + c), g1 = *(const f32x4*)(gp + c + 4);
                    const f32x4 v0 = b0 * alpha + g0 * (acc[ai][bj][m][0] + bv[bj][0]), v1 = b1 * alpha + g1 * (acc[ai][bj][m][1] + bv[bj][1]);
                    u32x4 w; w.x = cvt_pk_bf16(v0[0], v0[1]); w.y = cvt_pk_bf16(v0[2], v0[3]); w.z = cvt_pk_bf16(v1[0], v1[1]); w.w = cvt_pk_bf16(v1[2], v1[3]);
                    *(u32x4*)(tp + c) = w; } }
    }
};

template <class Epi, class Sched, bool ALIGN_EPI = false, bool SP2 = false>
__device__ __forceinline__ void gemm_phase(PG8_LAS unsigned char* lds, const Gemm g, const Sched& S, const Epi& E) {
    const int tid = threadIdx.x, wid = __builtin_amdgcn_readfirstlane(tid >> 6), lane = tid & 63, wr = wid >> 2, wc = wid & 3, fr = lane & 15, fq = lane >> 4;
    const int K = g.K;
    unsigned voffA[2], voffB[2];
#pragma unroll
    for (int i = 0; i < 2; ++i) { int R, C; stage_rc(tid * 16 + i * 8192, R, C); const int Rb = Epi::PERM ? ((R & ~31) + perm32(R & 31)) : R;
        voffA[i] = (unsigned)(R * K + C) * 2u; voffB[i] = (unsigned)(Rb * K + C) * 2u; }
    const size_t kstep = (size_t)(BK * 2);
    const size_t hstep = (size_t)HALF * K * 2;
    const size_t tstep = 2 * hstep;
    const unsigned ldsw = (unsigned)wid * 1024u;
    const int aoff = lds_byte(wr * 64 + fr, fq * 8), boff = lds_byte(wc * 32 + fr, fq * 8);
#define PG8_SA(b, h) (((b) * 2 + (h)) * HTB)
#define PG8_SB(b, h) ((4 + (b) * 2 + (h)) * HTB)
#define PG8_STAGE(bufoff, gbase, voff) do { _Pragma("unroll") for (int _i = 0; _i < 2; ++_i) \
        __builtin_amdgcn_global_load_lds((const unsigned*)((const char*)(gbase) + (voff)[_i]), (PG8_LAS unsigned*)(lds + (bufoff) + ldsw + _i * 8192), 16, 0, 0); } while (0)
#define PG8_LDA(dst, b, h) do { _Pragma("unroll") for (int m = 0; m < 4; ++m) _Pragma("unroll") for (int k = 0; k < 2; ++k) dst[m][k] = *(const PG8_LAS bf16x8*)(lds + PG8_SA(b, h) + aoff + m * 2048 + k * 1024); } while (0)
#define PG8_LDB(dst, b, h) do { _Pragma("unroll") for (int n = 0; n < 2; ++n) _Pragma("unroll") for (int k = 0; k < 2; ++k) dst[n][k] = *(const PG8_LAS bf16x8*)(lds + PG8_SB(b, h) + boff + n * 2048 + k * 1024); } while (0)
#define PG8_MMA(ai, bj, At, Bt) do { __builtin_amdgcn_s_setprio(1); _Pragma("unroll") for (int m = 0; m < 4; ++m) _Pragma("unroll") for (int n = 0; n < 2; ++n) _Pragma("unroll") for (int k = 0; k < 2; ++k) \
        acc[ai][bj][m][n] = __builtin_amdgcn_mfma_f32_16x16x32_bf16(Bt[n][k], At[m][k], acc[ai][bj][m][n], 0, 0, 0); __builtin_amdgcn_s_setprio(0); } while (0)
#define PG8_WAIT_V(n) asm volatile("s_waitcnt vmcnt(" #n ")" ::: "memory")
#define PG8_WAIT_L(n) asm volatile("s_waitcnt lgkmcnt(" #n ")" ::: "memory")
#define PG8_BAR __builtin_amdgcn_s_barrier()
#define PG8_SCHED __builtin_amdgcn_sched_barrier(0)
    Unit cur, nxt; int ui = 0;
    if (!S.next(0, cur)) return;
    f32x4 acc[2][2][4][2];
#pragma unroll
    for (int a = 0; a < 2; ++a)
#pragma unroll
        for (int b = 0; b < 2; ++b)
#pragma unroll
            for (int m = 0; m < 4; ++m)
#pragma unroll
                for (int n = 0; n < 2; ++n) acc[a][b][m][n] = (f32x4){0.f, 0.f, 0.f, 0.f};
    bf16x8 At[4][2], B0[2][2], B1[2][2];
    const char* cA = (const char*)g.A + (size_t)cur.pm * tstep + (size_t)cur.k0 * 2; const char* cB = (const char*)g.Bt + (size_t)cur.pn * tstep + (size_t)cur.k0 * 2;
    S.a_ready(cur);
    if constexpr (SP2) {
        PG8_STAGE(PG8_SB(0, 0), cB, voffB); PG8_STAGE(PG8_SB(0, 1), cB + hstep, voffB); PG8_STAGE(PG8_SA(0, 0), cA, voffA); PG8_STAGE(PG8_SA(0, 1), cA + hstep, voffA);
        if (wr == 1) PG8_BAR;
        PG8_WAIT_V(2); PG8_BAR;
        PG8_STAGE(PG8_SB(1, 0), cB + kstep, voffB); PG8_STAGE(PG8_SA(1, 0), cA + kstep, voffA); PG8_STAGE(PG8_SB(1, 1), cB + hstep + kstep, voffB);
        PG8_WAIT_V(6); PG8_BAR;
    } else {
        PG8_STAGE(PG8_SB(0, 0), cB, voffB); PG8_STAGE(PG8_SA(0, 0), cA, voffA); PG8_STAGE(PG8_SB(0, 1), cB + hstep, voffB); PG8_STAGE(PG8_SA(0, 1), cA + hstep, voffA);
        if (wr == 1) PG8_BAR;
        PG8_WAIT_V(4); PG8_BAR;
        PG8_STAGE(PG8_SB(1, 0), cB + kstep, voffB); PG8_STAGE(PG8_SA(1, 0), cA + kstep, voffA); PG8_STAGE(PG8_SB(1, 1), cB + hstep + kstep, voffB);
        PG8_WAIT_V(6); PG8_BAR;
    }
    for (;;) {
        const bool has_next = S.next(ui + 1, nxt);
        const char* nA = has_next ? (const char*)g.A + (size_t)nxt.pm * tstep + (size_t)nxt.k0 * 2 : cA; const char* nB = has_next ? (const char*)g.Bt + (size_t)nxt.pn * tstep + (size_t)nxt.k0 * 2 : cB;
        const int nt = cur.nkt;
        for (int t = 0; t < nt; t += 2) {
            const bool last = (t == nt - 2);
            const char* a1 = cA + (size_t)(t + 1) * kstep;
            const char* a2 = last ? nA : cA + (size_t)(t + 2) * kstep; const char* b2 = last ? nB : cB + (size_t)(t + 2) * kstep;
            const char* a3 = a2 + kstep; const char* b3 = b2 + kstep;
            if (last && has_next) S.a_ready(nxt);
            if constexpr (SP2) {
            PG8_LDB(B0, 0, 0); PG8_LDB(B1, 0, 1); PG8_SCHED; PG8_LDA(At, 0, 0); PG8_STAGE(PG8_SA(1, 1), a1 + hstep, voffA);
            PG8_WAIT_V(8); PG8_WAIT_L(0); PG8_BAR; PG8_MMA(0, 0, At, B0); PG8_MMA(0, 1, At, B1); PG8_BAR; PG8_SCHED;
            PG8_LDA(At, 0, 1); PG8_STAGE(PG8_SB(0, 0), b2, voffB); PG8_STAGE(PG8_SB(0, 1), b2 + hstep, voffB); PG8_STAGE(PG8_SA(0, 0), a2, voffA);
            PG8_WAIT_V(8); PG8_WAIT_L(0); PG8_BAR; PG8_MMA(1, 0, At, B0); PG8_MMA(1, 1, At, B1); PG8_BAR; PG8_SCHED;
            PG8_LDB(B0, 1, 0); PG8_LDB(B1, 1, 1); PG8_SCHED; PG8_LDA(At, 1, 0); PG8_STAGE(PG8_SA(0, 1), a2 + hstep, voffA);
            PG8_WAIT_V(8); PG8_WAIT_L(0); PG8_BAR; PG8_MMA(0, 0, At, B0); PG8_MMA(0, 1, At, B1); PG8_BAR; PG8_SCHED;
            PG8_LDA(At, 1, 1); PG8_STAGE(PG8_SB(1, 0), b3, voffB); PG8_STAGE(PG8_SB(1, 1), b3 + hstep, voffB); PG8_STAGE(PG8_SA(1, 0), a3, voffA);
            PG8_WAIT_V(8); PG8_WAIT_L(0); PG8_BAR; PG8_MMA(1, 0, At, B0); PG8_MMA(1, 1, At, B1); PG8_BAR; PG8_SCHED;
            } else {
            PG8_LDB(B0, 0, 0); PG8_SCHED; PG8_LDA(At, 0, 0); PG8_STAGE(PG8_SA(1, 1), a1 + hstep, voffA);
            PG8_WAIT_L(8); PG8_BAR; PG8_WAIT_L(0); PG8_MMA(0, 0, At, B0); PG8_BAR; PG8_SCHED;
            PG8_LDB(B1, 0, 1); PG8_STAGE(PG8_SB(0, 0), b2, voffB);
            PG8_BAR; PG8_WAIT_L(0); PG8_MMA(0, 1, At, B1); PG8_BAR;
            PG8_LDA(At, 0, 1); PG8_STAGE(PG8_SA(0, 0), a2, voffA);
            PG8_BAR; PG8_WAIT_L(0); PG8_MMA(1, 0, At, B0); PG8_BAR; PG8_SCHED;
            PG8_STAGE(PG8_SB(0, 1), b2 + hstep, voffB);
            PG8_WAIT_V(6); PG8_BAR; PG8_MMA(1, 1, At, B1); PG8_BAR;
            PG8_LDB(B0, 1, 0); PG8_SCHED; PG8_LDA(At, 1, 0); PG8_STAGE(PG8_SA(0, 1), a2 + hstep, voffA);
            PG8_WAIT_L(8); PG8_BAR; PG8_WAIT_L(0); PG8_MMA(0, 0, At, B0); PG8_BAR; PG8_SCHED;
            PG8_LDB(B1, 1, 1); PG8_STAGE(PG8_SB(1, 0), b3, voffB);
            PG8_BAR; PG8_WAIT_L(0); PG8_MMA(0, 1, At, B1); PG8_BAR;
            PG8_LDA(At, 1, 1); PG8_STAGE(PG8_SA(1, 0), a3, voffA);
            PG8_BAR; PG8_WAIT_L(0); PG8_MMA(1, 0, At, B0); PG8_BAR; PG8_SCHED;
            PG8_STAGE(PG8_SB(1, 1), b3 + hstep, voffB);
            PG8_WAIT_V(6); PG8_BAR; PG8_MMA(1, 1, At, B1); PG8_BAR;
            }
        }
        if constexpr (ALIGN_EPI) { if (wr == 0) PG8_BAR; }
        if constexpr (!Epi::AFTER_DRAIN) { E(acc, cur, wr, wc, fr, fq); S.done(cur); }
        if (!has_next) break;
#pragma unroll
        for (int a = 0; a < 2; ++a)
#pragma unroll
            for (int b = 0; b < 2; ++b)
#pragma unroll
                for (int m = 0; m < 4; ++m)
#pragma unroll
                    for (int n = 0; n < 2; ++n) acc[a][b][m][n] = (f32x4){0.f, 0.f, 0.f, 0.f};
        cur = nxt; cA = nA; cB = nB; ++ui;
        if constexpr (ALIGN_EPI) { if (wr == 1) PG8_BAR; }
    }
    PG8_WAIT_V(0);
    if constexpr (!ALIGN_EPI) { if (wr == 0) PG8_BAR; }
    PG8_BAR;
#undef PG8_SA
#undef PG8_SB
#undef PG8_STAGE
#undef PG8_LDA
#undef PG8_LDB
#undef PG8_MMA
#undef PG8_WAIT_V
#undef PG8_WAIT_L
#undef PG8_BAR
#undef PG8_SCHED
}
}

#ifndef PROBE_DUP
#define PROBE_DUP 0
#endif
#ifndef PG8_SP2
#define PG8_SP2 true
#endif
#ifndef PG8_ALIGN
#define PG8_ALIGN true
#endif

constexpr int NWAVES = 8;
constexpr int N_LAUNCHES = MK_N_LAUNCHES;
constexpr int N_PHASES = 10;
constexpr int D = 1024, MP = 16384, MS = 512, M = MP + MS, TP = 2048, NBP = 8, NBS = 128, TS = 4;
constexpr int NZ = 1536, WA = 512, WB = 512, FF = 4096, NMOD = 6 * D, NROWMOD = NBP + NBS;
constexpr int GB = 32, NS5 = 64, KS5 = 16, HA = 8, HDA = 64;
constexpr float LN_EPS = 1e-5f;
constexpr int NS_OUT = 4, NS_DOWN = 8;
constexpr float ALPHA = 1.189207115002721f;

constexpr size_t O_YP = 0, O_YS = (size_t)MP * D, O_CONVP = O_YS + (size_t)MS * D, O_HP = O_CONVP + (size_t)NBP * 3 * WA, O_SRP = O_HP + (size_t)NBP * WA,
                 O_SIP = O_SRP + (size_t)NBP * GB * NS5, O_CONVS = O_SIP + (size_t)NBP * GB * NS5, O_HS = O_CONVS + (size_t)NBS * 3 * WA, O_SRS = O_HS + (size_t)NBS * WA,
                 O_SIS = O_SRS + (size_t)NBS * GB * NS5, O_END = O_SIS + (size_t)NBS * GB * NS5;

constexpr size_t MiB = 1u << 20;
constexpr size_t WS_CTL = 0, CTL_ZERO_BYTES = 1 * MiB;
constexpr size_t WS_WIN = 1 * MiB, WS_WGLU = 4 * MiB, WS_WOUT = 5 * MiB, WS_W1 = 7 * MiB, WS_W2 = 15 * MiB;
constexpr size_t WS_MOD = 23 * MiB;
constexpr size_t WS_S5C = 27 * MiB;
constexpr size_t WS_XN = 28 * MiB;
constexpr size_t WS_Z = 61 * MiB;
constexpr size_t WS_YCAT = 111 * MiB;
constexpr size_t WS_G = 144 * MiB;
constexpr size_t WS_U = 61 * MiB;
constexpr size_t WS_T1 = WS_Z;
constexpr size_t WS_T2 = WS_XN;
constexpr size_t WS_TAB = 194 * MiB;
constexpr size_t WS_SLAB = 196 * MiB;
constexpr size_t WS_X1B = 212 * MiB;
constexpr size_t WS_END = 246 * MiB;
constexpr size_t TB_BF1 = 0, TB_BF2 = TB_BF1 + 32 * 4 * 64 * 16, TB_TA = TB_BF2 + 32 * 8 * 64 * 16, TB_ZP = TB_TA + 32 * 2 * 2 * 32 * 4, TB_Z16N = TB_ZP + 32 * 17 * 2 * 2 * 32 * 4,
                 TB_RG = TB_Z16N + 32 * 2 * 64 * 4, TB_CB = TB_RG + 8 * 2 * 2 * 4 * 64 * 16, TB_SILU = TB_CB + 128 * 3 * 512 * 2, TB_END = TB_SILU + 160 * 1024 * 2;
static_assert(WS_TAB + TB_END <= WS_SLAB, "tables");
static_assert(WS_XN + (size_t)M * D * 2 <= WS_Z && WS_Z + (size_t)M * NZ * 2 <= WS_YCAT && WS_YCAT + (size_t)M * D * 2 <= WS_G && WS_G + (size_t)M * WB * 2 <= WS_END && WS_U + (size_t)M * FF * 2 <= WS_TAB, "d_ws map");
constexpr int SC_ABR = 0, SC_ABI = 2048, SC_BBR = 4096, SC_BBI = 4096 + 32768, SC_RGL = 4096 + 65536, SC_END = SC_RGL + 512;
constexpr int CW_TMO = 0, CW_CODE = 1, CW_SILU = 64, CW_BAR = 4096;

constexpr int RING_OFF = 0, RING_BYTES = 131072;
constexpr int LDSCTL_OFF = RING_BYTES, MISC_OFF = LDSCTL_OFF + 320;
constexpr int LDS_BYTES = 147456;

#define GAS __attribute__((address_space(1)))
#define LAS __attribute__((address_space(3)))
typedef unsigned short bf16;
typedef unsigned v4u __attribute__((ext_vector_type(4)));
typedef float f32x4 __attribute__((ext_vector_type(4)));
typedef GAS unsigned gu32;
#define RLX_AGENT __ATOMIC_RELAXED, __HIP_MEMORY_SCOPE_AGENT
#define LDS_WAIT() asm volatile("s_waitcnt lgkmcnt(0)" ::: "memory")
#define VM_WAIT() asm volatile("s_waitcnt vmcnt(0)" ::: "memory")
__device__ __forceinline__ unsigned f2bf(float f) { unsigned u = __builtin_bit_cast(unsigned, f); return (u + 0x7fffu + ((u >> 16) & 1u)) >> 16; }
__device__ __forceinline__ unsigned pk2(float lo, float hi) { return f2bf(lo) | (f2bf(hi) << 16); }
__device__ __forceinline__ float bf2f(bf16 v) { return __builtin_bit_cast(float, (unsigned)v << 16); }
__device__ __forceinline__ float gelu_tanh(float x) { const float t = -2.3022082f * (x + 0.044715f * x * x * x); return x * __builtin_amdgcn_rcpf(1.f + __builtin_amdgcn_exp2f(t)); }
__device__ __forceinline__ float sigmoidf_(float x) { return __builtin_amdgcn_rcpf(1.f + __builtin_amdgcn_exp2f(-1.4426950408889634f * x)); }

#define XB_TMO      128
#define XB_XCNT(j)  (256  + 64 * (j))
#define XB_XSUB(j)  (1280 + 64 * (j))
#define XB_XGEN(j)  (2304 + 64 * (j))
#define XB_TOP      3328
#define XB_TOPGEN   3392
#define XCD_BAR_WORDS 3456
#define XB_SPIN_CAP (1u << 18)
__device__ __forceinline__ unsigned xb_ld(unsigned* p)              { return __hip_atomic_load(p, __ATOMIC_RELAXED, __HIP_MEMORY_SCOPE_AGENT); }
__device__ __forceinline__ unsigned xb_add(unsigned* p, unsigned v) { return __hip_atomic_fetch_add(p, v, __ATOMIC_RELAXED, __HIP_MEMORY_SCOPE_AGENT); }
__device__ __forceinline__ unsigned xb_xcc_id() { return (unsigned)__builtin_amdgcn_s_getreg((3 << 11) | 20) & 0xFu; }
#define XB_SPIN(cond, bar) do { unsigned _sp = 0; while (cond) { __builtin_amdgcn_s_sleep(1); \
    if ((++_sp & 255u) == 0u) { if (xb_ld(&(bar)[XB_TMO])) break; if (_sp > XB_SPIN_CAP) { atomicAdd(&(bar)[XB_TMO], 1u); break; } } } } while (0)
struct XcdBarrier { unsigned* bar; unsigned x; volatile LAS unsigned* st; };
__device__ __forceinline__ XcdBarrier xcd_barrier_post(unsigned* bar, volatile LAS unsigned* st) {
    XcdBarrier b; b.bar = bar; b.x = xb_xcc_id(); b.st = st;
    if (threadIdx.x == 0) (void)xb_add(&bar[XB_XCNT(b.x)], 1u);
    return b;
}
__device__ __forceinline__ void xcd_barrier_complete(unsigned* bar, unsigned x, unsigned& nloc, unsigned& nx) {
    const unsigned G = gridDim.x * gridDim.y * gridDim.z;
    unsigned sum, cnt, mine, sp = 0u;
    for (;;) {
        sum = 0u; cnt = 0u; mine = 0u;
#pragma unroll
        for (unsigned j = 0; j < 16; ++j) { const unsigned c = xb_ld(&bar[XB_XCNT(j)]); sum += c; cnt += (c > 0u) ? 1u : 0u; mine = (j == x) ? c : mine; }
        if (sum == G) break;
        __builtin_amdgcn_s_sleep(1);
        if ((++sp & 255u) == 0u) { if (xb_ld(&bar[XB_TMO])) break; if (sp > XB_SPIN_CAP) { atomicAdd(&bar[XB_TMO], 1u); break; } }
    }
    nloc = mine > 0u ? mine : 1u; nx = cnt > 0u ? cnt : 1u;
}
__device__ __forceinline__ void xcd_barrier(const XcdBarrier& b) {
    asm volatile("s_waitcnt vmcnt(0)" ::: "memory");
    __syncthreads();
    if (threadIdx.x == 0) {
        unsigned* bar = b.bar;
        __builtin_amdgcn_s_waitcnt(0);
        unsigned nloc = b.st[0], nx = b.st[1];
        if (nloc == 0u) { xcd_barrier_complete(bar, b.x, nloc, nx); b.st[0] = nloc; b.st[1] = nx; }
        const unsigned old = xb_add(&bar[XB_XSUB(b.x)], 1u);
        const unsigned gen = old / nloc;
        if (old + 1u == (gen + 1u) * nloc) {
            __builtin_amdgcn_fence(__ATOMIC_RELEASE, "agent");
            asm volatile("s_waitcnt vmcnt(0)" ::: "memory");
            const unsigned og = xb_add(&bar[XB_TOP], 1u);
            const unsigned tg = og / nx;
            if (og + 1u == (tg + 1u) * nx) xb_add(&bar[XB_TOPGEN], 1u);
            else XB_SPIN(xb_ld(&bar[XB_TOPGEN]) == tg, bar);
            __builtin_amdgcn_fence(__ATOMIC_ACQUIRE, "agent");
            xb_add(&bar[XB_XGEN(b.x)], 1u);
            asm volatile("s_waitcnt vmcnt(0)" ::: "memory");
        } else {
            XB_SPIN(xb_ld(&bar[XB_XGEN(b.x)]) == gen, bar);
            __builtin_amdgcn_fence(__ATOMIC_ACQUIRE, "agent");
            asm volatile("s_waitcnt vmcnt(0)" ::: "memory");
        }
    }
    __syncthreads();
}

struct Frame {
    LAS unsigned char* lds;
    volatile LAS unsigned* MISC;
    gu32* ctl;
    int tid, lane, wave;
    int vcu, G;
    float* out;
    unsigned char* ws;
};
struct Args { const float* in[37]; float* out; unsigned char* ws; int ph_lo, ph_hi, li, pad; };
__device__ __forceinline__ void refresh(Frame& F) { int t = threadIdx.x; asm volatile("" : "+v"(t)); F.tid = t; F.lane = t & 63; F.wave = __builtin_amdgcn_readfirstlane(t >> 6); }
__device__ __forceinline__ float wave_sum(float v) {
#pragma unroll
    for (int o = 1; o < 64; o <<= 1) v += __shfl_xor(v, o);
    return v;
}
enum { I_XP = 0, I_XS, I_SCONV, I_SH, I_SSR, I_SSI, I_CP, I_CS, I_ADAW, I_ADAB, I_INPROJ, I_CONVW, I_CONVB, I_RGWR, I_RGBR, I_RGWI, I_RGBI, I_RGLAM,
       I_S5ARE, I_S5AIM, I_S5LOGDT, I_S5BRE, I_S5BIM, I_S5CRE, I_S5CIM, I_S5D, I_GLUW, I_GLUB, I_OUTPROJ, I_LN1G, I_LN1B, I_W1, I_B1, I_W2, I_B2, I_LN2G, I_LN2B };

typedef float f32x2m __attribute__((ext_vector_type(2)));
typedef __bf16 bf16x2m __attribute__((ext_vector_type(2)));
__device__ __forceinline__ unsigned pkbf0(float a, float b) { const f32x2m v = {a, b}; const bf16x2m r = __builtin_convertvector(v, bf16x2m); return __builtin_bit_cast(unsigned, r); }
typedef short bf16x8m __attribute__((ext_vector_type(8)));
typedef float f32x16m __attribute__((ext_vector_type(16)));
__device__ __forceinline__ void p0_transpose_item(const float* W, int K, int N, bf16* WT, LAS float* scr, int item, int lane) {
    const int nblk = N / 32, kb = item / nblk, nb = item % nblk, k0 = 64 * kb, n0 = 32 * nb;
#pragma unroll 8
    for (int i = 0; i < 32; ++i) { const int kk = 2 * i + (lane >> 5); scr[kk * 33 + (lane & 31)] = W[(size_t)(k0 + kk) * N + n0 + (lane & 31)]; }
    LDS_WAIT(); asm volatile("" ::: "memory");
    const int c = lane & 7;
#pragma unroll
    for (int j = 0; j < 4; ++j) { const int n = (lane >> 3) + 8 * j; const LAS float* s = scr + (8 * c) * 33 + n;
        v4u o; o.x = pk2(s[0 * 33], s[1 * 33]); o.y = pk2(s[2 * 33], s[3 * 33]); o.z = pk2(s[4 * 33], s[5 * 33]); o.w = pk2(s[6 * 33], s[7 * 33]);
        *(GAS v4u*)(WT + (size_t)(n0 + n) * K + k0 + 8 * c) = o; }
    LDS_WAIT(); asm volatile("" ::: "memory");
}

constexpr int XI_IN = (D / 64) * (NZ / 32), XI_GL = (WB / 64) * (WB / 32), XI_OU = (D / 64) * (D / 32), XI_1 = (D / 64) * (FF / 32), XI_2 = (FF / 64) * (D / 32);
constexpr int XO_OU = XI_IN + XI_GL, XO_1 = XO_OU + XI_OU, XO_2 = XO_1 + XI_1, XO_END = XO_2 + XI_2;
__device__ __forceinline__ void xpose_item(Frame& F, const Args& A, LAS float* scr, int r) {
    if (r < XI_IN) { p0_transpose_item(A.in[I_INPROJ], D, NZ, (bf16*)(F.ws + WS_WIN), scr, r, F.lane); return; } r -= XI_IN;
    if (r < XI_GL) { p0_transpose_item(A.in[I_GLUW], WB, WB, (bf16*)(F.ws + WS_WGLU), scr, r, F.lane); return; } r -= XI_GL;
    if (r < XI_OU) { p0_transpose_item(A.in[I_OUTPROJ], D, D, (bf16*)(F.ws + WS_WOUT), scr, r, F.lane); return; } r -= XI_OU;
    if (r < XI_1) { p0_transpose_item(A.in[I_W1], D, FF, (bf16*)(F.ws + WS_W1), scr, r, F.lane); return; } r -= XI_1;
    p0_transpose_item(A.in[I_W2], FF, D, (bf16*)(F.ws + WS_W2), scr, r, F.lane);
}
__device__ __forceinline__ void xpose_range(Frame& F, const Args& A, int lo, int hi, int vlo) {
    refresh(F);
    if (F.vcu < vlo) return;
    LAS float* scr = (LAS float*)(F.lds + RING_OFF + F.wave * 16384);
    const int gw = F.wave * (F.G - vlo) + (F.vcu - vlo), ngw = (F.G - vlo) * NWAVES;
    for (int it = lo + gw; it < hi; it += ngw) xpose_item(F, A, scr, it);
}
__device__ __forceinline__ void xpose_range_b(Frame& F, const Args& A, int lo, int hi, int blo) {
    refresh(F);
    LAS float* scr = (LAS float*)(F.lds + RING_OFF + F.wave * 16384);
    const int gw = F.wave * (F.G - blo) + ((int)blockIdx.x - blo), ngw = (F.G - blo) * NWAVES;
    for (int it = lo + gw; it < hi; it += ngw) xpose_item(F, A, scr, it);
}
#ifndef PROBE_P0PART
#define PROBE_P0PART 7
#endif
__device__ __forceinline__ void p0_prologue(Frame& F, const Args& A, int rep = 0) {
    refresh(F);
    const int pmask = rep ? PROBE_P0PART : 7;
    LAS float* scr = (LAS float*)(F.lds + RING_OFF + F.wave * 16384);
    const int gw = F.wave * F.G + F.vcu, NGW = F.G * NWAVES;
    {
        bf16* ST = (bf16*)(F.ws + WS_TAB + TB_SILU);
        for (int ch = F.vcu * NWAVES * 64 + F.tid; ch < 160 * 1024 / 8; ch += F.G * NWAVES * 64) { const int row = ch >> 7, k = (ch & 127) * 8; v4u o = (v4u){0u, 0u, 0u, 0u};
            if (row < NROWMOD) { const float* cp = (row < NBP ? A.in[I_CP] + (size_t)row * D : A.in[I_CS] + (size_t)(row - NBP) * D) + k; const f32x4 c0 = *(const f32x4*)cp, c1 = *(const f32x4*)(cp + 4);
                o.x = pk2(c0[0] * sigmoidf_(c0[0]), c0[1] * sigmoidf_(c0[1])); o.y = pk2(c0[2] * sigmoidf_(c0[2]), c0[3] * sigmoidf_(c0[3]));
                o.z = pk2(c1[0] * sigmoidf_(c1[0]), c1[1] * sigmoidf_(c1[1])); o.w = pk2(c1[2] * sigmoidf_(c1[2]), c1[3] * sigmoidf_(c1[3])); }
            *(v4u*)(ST + (size_t)ch * 8) = o; }
        VM_WAIT(); __syncthreads();
        if (F.tid == 0) { __builtin_amdgcn_fence(__ATOMIC_RELEASE, "agent"); VM_WAIT(); (void)__hip_atomic_fetch_add((unsigned*)(F.ctl + CW_SILU), 1u, RLX_AGENT); }
    }
    constexpr int I_IN = XI_IN, I_GL = XI_GL;
    constexpr int I_S5 = GB, I_RG = WA / 64, I_RGT = HA * 2 * 2 * 4, I_CB = NBS * 3 * WA / 512;
    constexpr int NITEMS = I_IN + I_GL + I_S5 + I_RG + I_RGT + I_CB;
    float* sc = (float*)(F.ws + WS_S5C);
    for (int it = gw; it < NITEMS; it += NGW) {
        int r = it;
        if (!(pmask & 1) && it < I_IN + I_GL) continue;
        if (!(pmask & 2) && it >= I_IN + I_GL) continue;
        if (r < I_IN + I_GL) { xpose_item(F, A, scr, r); continue; } r -= I_IN + I_GL;
        if (r < I_S5) {
            const int g = r, n = F.lane, gn = g * NS5 + n;
            const double dt = exp((double)A.in[I_S5LOGDT][g]), ar = (double)A.in[I_S5ARE][gn], ai = (double)A.in[I_S5AIM][gn];
            const double mag = exp(dt * ar), abr = mag * cos(dt * ai), abi = mag * sin(dt * ai), den = ar * ar + ai * ai, nr = abr - 1.0;
            const double qr = (nr * ar + abi * ai) / den, qi = (abi * ar - nr * ai) / den;
            sc[SC_ABR + gn] = (float)abr; sc[SC_ABI + gn] = (float)abi;
            unsigned char* tab = F.ws + WS_TAB;
            bf16* BF1 = (bf16*)(tab + TB_BF1); bf16* BF2 = (bf16*)(tab + TB_BF2); float* TA = (float*)(tab + TB_TA); float* ZP = (float*)(tab + TB_ZP); float* Z16N = (float*)(tab + TB_Z16N);
            const int sh = n >> 5, v = n & 31, hh = (v >> 2) & 1, ii = (v & 3) + 4 * (v >> 3);
            for (int k = 0; k < KS5; ++k) { const double br = (double)A.in[I_S5BRE][gn * KS5 + k], bi = (double)A.in[I_S5BIM][gn * KS5 + k];
                const float vr = (float)(qr * br - qi * bi), vi = (float)(qr * bi + qi * br);
                sc[SC_BBR + gn * KS5 + k] = vr; sc[SC_BBI + gn * KS5 + k] = vi;
                const int lp = (n & 31) + 32 * (k >> 3), jj = k & 7;
                BF1[(size_t)((g * 4 + 0 + sh) * 64 + lp) * 8 + jj] = (bf16)f2bf(vr); BF1[(size_t)((g * 4 + 2 + sh) * 64 + lp) * 8 + jj] = (bf16)f2bf(vi); }
            { const int s2 = (n >> 4) & 1, jj = 4 * ((n >> 3) & 1) + (n & 3), hk = (n >> 2) & 1;
              for (int ch = 0; ch < KS5; ++ch) { const int hr_ = ch >> 3, i8 = ch & 7, R = (i8 & 3) + 8 * (i8 >> 2) + 4 * hr_, lp = R + 32 * hk;
                  const float cr = A.in[I_S5CRE][(size_t)(g * KS5 + ch) * NS5 + n], ci = A.in[I_S5CIM][(size_t)(g * KS5 + ch) * NS5 + n];
                  BF2[(size_t)((g * 8 + (0 + sh) * 2 + s2) * 64 + lp) * 8 + jj] = (bf16)f2bf(cr); BF2[(size_t)((g * 8 + (2 + sh) * 2 + s2) * 64 + lp) * 8 + jj] = (bf16)f2bf(-ci); }
              for (int z = 0; z < 4; ++z) { const int cidx = n + 64 * z, ks = cidx >> 5, r16 = cidx & 31, lp = 16 + (r16 & 15) + 32 * (r16 >> 4);
                  *(v4u*)(BF2 + (size_t)((g * 8 + ks) * 64 + lp) * 8) = (v4u){0u, 0u, 0u, 0u}; } }
            TA[((g * 2 + hh) * 2 + 0) * 32 + sh * 16 + ii] = (float)abr; TA[((g * 2 + hh) * 2 + 1) * 32 + sh * 16 + ii] = (float)abi;
            const double mg8 = exp(8.0 * dt * ar), z1r = mg8 * cos(8.0 * dt * ai), z1i = mg8 * sin(8.0 * dt * ai); double pzr = 1.0, pzi = 0.0;
            for (int e = 0; e <= 16; ++e) { const float zr = (float)pzr, zi = (float)pzi; { const double nr2 = pzr * z1r - pzi * z1i, ni2 = pzr * z1i + pzi * z1r; pzr = nr2; pzi = ni2; }
                ZP[(((g * 17 + e) * 2 + hh) * 2 + 0) * 32 + sh * 16 + ii] = zr; ZP[(((g * 17 + e) * 2 + hh) * 2 + 1) * 32 + sh * 16 + ii] = zi;
                if (e == 16) { Z16N[(g * 2 + 0) * 64 + n] = zr; Z16N[(g * 2 + 1) * 64 + n] = zi; } }
            continue; } r -= I_S5;
        if (r < I_RG) { const int c = r * 64 + F.lane; const double lam = (double)A.in[I_RGLAM][c];
          sc[SC_RGL + c] = (float)(-8.0 * log1p(exp(-lam)) * 1.4426950408889634); continue; } r -= I_RG;
        if (r >= I_RGT) { r -= I_RGT;
            const float* src = A.in[I_SCONV] + (size_t)r * 512 + F.lane * 8; const f32x4 a0 = *(const f32x4*)src, a1 = *(const f32x4*)(src + 4);
            v4u o; o.x = pk2(a0[0], a0[1]); o.y = pk2(a0[2], a0[3]); o.z = pk2(a1[0], a1[1]); o.w = pk2(a1[2], a1[3]);
            *(v4u*)(F.ws + WS_TAB + TB_CB + ((size_t)r * 512 + F.lane * 8) * 2) = o; continue; }
        {
            const int s4 = r & 3, gate = (r >> 2) & 1, jh = (r >> 3) & 1, hd = r >> 4;
            const int R = F.lane & 31, hk = F.lane >> 5, hR = (R >> 2) & 1, i = (R & 3) + 4 * (R >> 3), cho = 32 * jh + 16 * (i >> 3) + 8 * hR + (i & 7);
            const float* W = A.in[gate ? I_RGWI : I_RGWR] + (size_t)(hd * 64 + 16 * s4 + 8 * hk) * 64 + cho;
            v4u o; o.x = pk2(W[0], W[64]); o.y = pk2(W[128], W[192]); o.z = pk2(W[256], W[320]); o.w = pk2(W[384], W[448]);
            *(v4u*)(F.ws + WS_TAB + TB_RG + (size_t)(r * 64 + F.lane) * 16) = o;
        }
    }
    __syncthreads();
    if (F.tid == 0) {
        unsigned sp = 0; while (__hip_atomic_load((unsigned*)(F.ctl + CW_SILU), RLX_AGENT) < (unsigned)F.G * (unsigned)(rep + 1) && ++sp < (1u << 22)) __builtin_amdgcn_s_sleep(2);
        __builtin_amdgcn_fence(__ATOMIC_ACQUIRE, "agent"); VM_WAIT(); }
    __syncthreads();
    LAS float* RED = (LAS float*)(F.lds + RING_OFF);
    float* mod = (float*)(F.ws + WS_MOD);
    const int r32 = F.lane & 31, hh = F.lane >> 5;
    const bf16* ST = (const bf16*)(F.ws + WS_TAB + TB_SILU);
#pragma unroll 1
    for (int it = F.vcu; it < ((pmask & 4) ? NMOD / 32 : 0); it += F.G) {
        const int n0 = it * 32;
        f32x16m acc[5];
#pragma unroll
        for (int rt = 0; rt < 5; ++rt)
#pragma unroll
            for (int i = 0; i < 16; ++i) acc[rt][i] = 0.f;
#pragma unroll 1
        for (int kb = 0; kb < 4; ++kb) {
            float bw[2][8]; v4u af[2][5];
#pragma unroll
            for (int ks = 0; ks < 2; ++ks) { const int k0 = F.wave * 128 + (kb * 2 + ks) * 16 + 8 * hh;
                const float* wp = A.in[I_ADAW] + (size_t)k0 * NMOD + n0 + r32;
#pragma unroll
                for (int j = 0; j < 8; ++j) bw[ks][j] = wp[(size_t)j * NMOD];
#pragma unroll
                for (int rt = 0; rt < 5; ++rt) af[ks][rt] = *(const v4u*)(ST + (size_t)(32 * rt + r32) * D + k0); }
#pragma unroll
            for (int ks = 0; ks < 2; ++ks) {
                v4u bp; bp.x = pkbf0(bw[ks][0], bw[ks][1]); bp.y = pkbf0(bw[ks][2], bw[ks][3]); bp.z = pkbf0(bw[ks][4], bw[ks][5]); bp.w = pkbf0(bw[ks][6], bw[ks][7]);
                const bf16x8m bfr = __builtin_bit_cast(bf16x8m, bp);
#pragma unroll
                for (int rt = 0; rt < 5; ++rt) acc[rt] = __builtin_amdgcn_mfma_f32_32x32x16_bf16(__builtin_bit_cast(bf16x8m, af[ks][rt]), bfr, acc[rt], 0, 0, 0); }
        }
#pragma unroll
        for (int half = 4; half >= 1; half >>= 1) {
            if (F.wave >= half && F.wave < 2 * half) {
#pragma unroll
                for (int rt = 0; rt < 5; ++rt)
#pragma unroll
                    for (int i = 0; i < 16; ++i) RED[(F.wave - half) * 5120 + (rt * 16 + i) * 64 + F.lane] = acc[rt][i]; }
            __syncthreads();
            if (F.wave < half) {
#pragma unroll
                for (int rt = 0; rt < 5; ++rt)
#pragma unroll
                    for (int i = 0; i < 16; ++i) acc[rt][i] += RED[F.wave * 5120 + (rt * 16 + i) * 64 + F.lane]; }
            __syncthreads();
        }
        if (F.wave == 0) { const float bb = A.in[I_ADAB][n0 + r32];
#pragma unroll
            for (int rt = 0; rt < 5; ++rt)
#pragma unroll
                for (int i = 0; i < 16; ++i) { const int row = 32 * rt + (i & 3) + 8 * (i >> 2) + 4 * hh; if (row < NROWMOD) mod[(size_t)row * NMOD + n0 + r32] = acc[rt][i] + bb; } }
    }
}

__device__ __forceinline__ int mod_row(int m) { return m < MP ? (m >> 11) : NBP + ((m - MP) >> 2); }
__device__ __forceinline__ const float* x_row(const Args& A, int m) { return m < MP ? A.in[I_XP] + (size_t)m * D : A.in[I_XS] + (size_t)(m - MP) * D; }

__device__ __forceinline__ void p1_modulate(Frame& F, const Args& A) {
    refresh(F);
    const int gw = F.vcu * NWAVES + F.wave, NGW = F.G * NWAVES;
    const float* mod = (const float*)(F.ws + WS_MOD); bf16* XN = (bf16*)(F.ws + WS_XN);
    for (int m = gw; m < M; m += NGW) {
        const GAS f32x4* xr = (const GAS f32x4*)x_row(A, m) + F.lane; const float* mr = mod + (size_t)mod_row(m) * NMOD;
        const GAS f32x4* sh = (const GAS f32x4*)(mr) + F.lane; const GAS f32x4* scp = (const GAS f32x4*)(mr + D) + F.lane;
        GAS unsigned long long* o8 = (GAS unsigned long long*)(XN + (size_t)m * D) + F.lane;
#pragma unroll
        for (int j = 0; j < 4; ++j) { const f32x4 v = xr[64 * j], a = sh[64 * j], s = scp[64 * j]; const f32x4 h = v * (s + 1.f) + a;
            o8[64 * j] = (unsigned long long)pk2(h.x, h.y) | ((unsigned long long)pk2(h.z, h.w) << 32); }
    }
}

template <bool SECOND>
__device__ __forceinline__ void ln_rows(Frame& F, const Args& A) {
    refresh(F);
    const int gw = F.vcu * NWAVES + F.wave, NGW = F.G * NWAVES;
    const float* mod = (const float*)(F.ws + WS_MOD); bf16* XN = (bf16*)(F.ws + WS_XN);
    const GAS f32x4* gg = (const GAS f32x4*)A.in[SECOND ? I_LN2G : I_LN1G] + F.lane; const GAS f32x4* gb = (const GAS f32x4*)A.in[SECOND ? I_LN2B : I_LN1B] + F.lane;
    for (int m = gw; m < M; m += NGW) {
        GAS f32x4* xr = (GAS f32x4*)(F.out + (size_t)m * D) + F.lane;
        f32x4 v[4]; float s = 0.f;
        if (m >= MP) {
            const float* mr = mod + (size_t)mod_row(m) * NMOD + (SECOND ? 5 : 2) * D;
            const GAS f32x4* bs = SECOND ? (const GAS f32x4*)xr : (const GAS f32x4*)(A.in[I_XS] + (size_t)(m - MP) * D) + F.lane;
            const GAS f32x4* sl = (const GAS f32x4*)((const float*)(F.ws + WS_SLAB) + (size_t)(m - MP) * D) + F.lane;
#pragma unroll
            for (int j = 0; j < 4; ++j) { f32x4 a = SECOND ? *((const GAS f32x4*)A.in[I_B2] + F.lane + 64 * j) : (f32x4){0.f, 0.f, 0.f, 0.f};
#pragma unroll
                for (int ks = 0; ks < (SECOND ? NS_DOWN : NS_OUT); ++ks) a += sl[(size_t)ks * (512 * 1024 / 4) + 64 * j];
                v[j] = bs[64 * j] * ALPHA + *((const GAS f32x4*)mr + F.lane + 64 * j) * a; }
        } else {
            const GAS unsigned long long* tr = (const GAS unsigned long long*)((const bf16*)(F.ws + (SECOND ? WS_T2 : WS_T1)) + (size_t)m * D) + F.lane;
#pragma unroll
            for (int j = 0; j < 4; ++j) { const unsigned long long w = tr[64 * j]; const unsigned lo = (unsigned)w, hi = (unsigned)(w >> 32);
                v[j] = (f32x4){pg8::bf_lo(lo), pg8::bf_hi(lo), pg8::bf_lo(hi), pg8::bf_hi(hi)}; }
        }
#pragma unroll
        for (int j = 0; j < 4; ++j) s += (v[j].x + v[j].y) + (v[j].z + v[j].w);
        const float mean = wave_sum(s) * (1.f / D); float s2 = 0.f;
#pragma unroll
        for (int j = 0; j < 4; ++j) { v[j] = v[j] - mean; s2 += (v[j].x * v[j].x + v[j].y * v[j].y) + (v[j].z * v[j].z + v[j].w * v[j].w); }
        const float rstd = 1.f / sqrtf(wave_sum(s2) * (1.f / D) + LN_EPS);
#pragma unroll
        for (int j = 0; j < 4; ++j) v[j] = v[j] * rstd * gg[64 * j] + gb[64 * j];
        if (SECOND || m >= MP) {
#pragma unroll
            for (int j = 0; j < 4; ++j) xr[64 * j] = v[j];
        } else {
            GAS unsigned long long* x8 = (GAS unsigned long long*)((bf16*)(F.ws + WS_X1B) + (size_t)m * D) + F.lane;
#pragma unroll
            for (int j = 0; j < 4; ++j) x8[64 * j] = (unsigned long long)pk2(v[j].x, v[j].y) | ((unsigned long long)pk2(v[j].z, v[j].w) << 32);
        }
        if (!SECOND) {
            const float* mr = mod + (size_t)mod_row(m) * NMOD;
            const GAS f32x4* sh = (const GAS f32x4*)(mr + 3 * D) + F.lane; const GAS f32x4* scp = (const GAS f32x4*)(mr + 4 * D) + F.lane;
            GAS unsigned long long* o8 = (GAS unsigned long long*)(XN + (size_t)m * D) + F.lane;
#pragma unroll
            for (int j = 0; j < 4; ++j) { const f32x4 h = v[j] * (scp[64 * j] + 1.f) + sh[64 * j];
                o8[64 * j] = (unsigned long long)pk2(h.x, h.y) | ((unsigned long long)pk2(h.z, h.w) << 32); }
        }
    }
}

__device__ __forceinline__ void rg_item_ref(Frame& F, const Args& A, bool prompt, int b, int hd, LAS float* scr) {
    const int j = F.lane, c = hd * HDA + j;
    const bf16* Z = (const bf16*)(F.ws + WS_Z); bf16* Y = (bf16*)(F.ws + WS_YCAT); const float* sc = (const float*)(F.ws + WS_S5C);
    float wr[64], wi[64];
#pragma unroll
    for (int i = 0; i < 64; ++i) { wr[i] = A.in[I_RGWR][(size_t)(hd * 64 + i) * 64 + j]; wi[i] = A.in[I_RGWI][(size_t)(hd * 64 + i) * 64 + j]; }
    const float br = A.in[I_RGBR][c], bi = A.in[I_RGBI][c], L2 = sc[SC_RGL + c];
    const float w0 = A.in[I_CONVW][c], w1 = A.in[I_CONVW][WA + c], w2 = A.in[I_CONVW][2 * WA + c], w3 = A.in[I_CONVW][3 * WA + c], cb = A.in[I_CONVB][c];
    int T, m0; float x3, x2, x1, h;
    if (prompt) { T = TP; m0 = b * TP; x3 = 0.f; x2 = 0.f; x1 = 0.f; h = 0.f; }
    else { T = TS; m0 = MP + b * TS; x3 = A.in[I_SCONV][(size_t)(b * 3 + 0) * WA + c]; x2 = A.in[I_SCONV][(size_t)(b * 3 + 1) * WA + c]; x1 = A.in[I_SCONV][(size_t)(b * 3 + 2) * WA + c]; h = A.in[I_SH][(size_t)b * WA + c]; }
    for (int t = 0; t < T; ++t) {
        const size_t m = (size_t)(m0 + t);
        const float xa = bf2f(Z[m * NZ + WA + c]), gate = bf2f(Z[m * NZ + c]);
        const float xc = cb + w0 * x3 + w1 * x2 + w2 * x1 + w3 * xa; x3 = x2; x2 = x1; x1 = xa;
        scr[j] = xc; LDS_WAIT(); asm volatile("" ::: "memory");
        float rp = br, gp = bi;
#pragma unroll
        for (int i4 = 0; i4 < 16; ++i4) { const f32x4 v = *(const LAS f32x4*)(scr + 4 * i4);
            rp += v[0] * wr[4 * i4] + v[1] * wr[4 * i4 + 1] + v[2] * wr[4 * i4 + 2] + v[3] * wr[4 * i4 + 3];
            gp += v[0] * wi[4 * i4] + v[1] * wi[4 * i4 + 1] + v[2] * wi[4 * i4 + 2] + v[3] * wi[4 * i4 + 3]; }
        LDS_WAIT(); asm volatile("" ::: "memory");
        const float r = sigmoidf_(rp), gi = sigmoidf_(gp);
        const float a = exp2f(r * L2);
        float mult = sqrtf(fmaxf(1.f - a * a, 0.f));
        if (prompt && t == 0) mult = 1.f;
        h = a * h + mult * gi * xc;
        Y[m * D + c] = (bf16)f2bf(gelu_tanh(gate) * h);
    }
    float* oc = F.out + (prompt ? O_CONVP : O_CONVS); float* oh = F.out + (prompt ? O_HP : O_HS);
    oc[(size_t)(b * 3 + 0) * WA + c] = x3; oc[(size_t)(b * 3 + 1) * WA + c] = x2; oc[(size_t)(b * 3 + 2) * WA + c] = x1;
    oh[(size_t)b * WA + c] = h;
}
__device__ __forceinline__ void s5_item_ref(Frame& F, const Args& A, bool prompt, int b, int g, LAS float* scr) {
    const int n = F.lane, gn = g * NS5 + n, k = F.lane & 15, part = F.lane >> 4;
    const bf16* Z = (const bf16*)(F.ws + WS_Z); bf16* Gy = (bf16*)(F.ws + WS_G); const float* sc = (const float*)(F.ws + WS_S5C);
    float bbr[16], bbi[16], cre[16], cim[16];
#pragma unroll
    for (int i = 0; i < 16; ++i) { bbr[i] = sc[SC_BBR + gn * KS5 + i]; bbi[i] = sc[SC_BBI + gn * KS5 + i];
        cre[i] = A.in[I_S5CRE][(size_t)(g * KS5 + k) * NS5 + part * 16 + i]; cim[i] = A.in[I_S5CIM][(size_t)(g * KS5 + k) * NS5 + part * 16 + i]; }
    const float abr = sc[SC_ABR + gn], abi = sc[SC_ABI + gn], dk = A.in[I_S5D][g * KS5 + k];
    int T, m0; float hr, hi;
    if (prompt) { T = TP; m0 = b * TP; hr = 0.f; hi = 0.f; }
    else { T = TS; m0 = MP + b * TS; hr = A.in[I_SSR][(size_t)(b * GB + g) * NS5 + n]; hi = A.in[I_SSI][(size_t)(b * GB + g) * NS5 + n]; }
    for (int t = 0; t < T; ++t) {
        const size_t m = (size_t)(m0 + t);
        const bf16* zr = Z + m * NZ + 2 * WA + g * KS5;
        const v4u u0 = *(const v4u*)zr, u1 = *(const v4u*)(zr + 8);
        float u[16];
        u[0] = pg8::bf_lo(u0.x); u[1] = pg8::bf_hi(u0.x); u[2] = pg8::bf_lo(u0.y); u[3] = pg8::bf_hi(u0.y); u[4] = pg8::bf_lo(u0.z); u[5] = pg8::bf_hi(u0.z); u[6] = pg8::bf_lo(u0.w); u[7] = pg8::bf_hi(u0.w);
        u[8] = pg8::bf_lo(u1.x); u[9] = pg8::bf_hi(u1.x); u[10] = pg8::bf_lo(u1.y); u[11] = pg8::bf_hi(u1.y); u[12] = pg8::bf_lo(u1.z); u[13] = pg8::bf_hi(u1.z); u[14] = pg8::bf_lo(u1.w); u[15] = pg8::bf_hi(u1.w);
        float bur = 0.f, bui = 0.f;
#pragma unroll
        for (int i = 0; i < 16; ++i) { bur += bbr[i] * u[i]; bui += bbi[i] * u[i]; }
        const float nhr = abr * hr - abi * hi + bur, nhi = abr * hi + abi * hr + bui; hr = nhr; hi = nhi;
        scr[n] = hr; scr[64 + n] = hi; LDS_WAIT(); asm volatile("" ::: "memory");
        float p = 0.f;
#pragma unroll
        for (int i4 = 0; i4 < 4; ++i4) { const f32x4 vr = *(const LAS f32x4*)(scr + part * 16 + 4 * i4), vi = *(const LAS f32x4*)(scr + 64 + part * 16 + 4 * i4);
#pragma unroll
            for (int e = 0; e < 4; ++e) p += vr[e] * cre[4 * i4 + e] - vi[e] * cim[4 * i4 + e]; }
        LDS_WAIT(); asm volatile("" ::: "memory");
        p += __shfl_xor(p, 16); p += __shfl_xor(p, 32);
        const float uk = bf2f(zr[k]);
        if (F.lane < 16) Gy[m * WB + g * KS5 + k] = (bf16)f2bf(gelu_tanh(p + dk * uk));
    }
    float* osr = F.out + (prompt ? O_SRP : O_SRS); float* osi = F.out + (prompt ? O_SIP : O_SIS);
    osr[(size_t)(b * GB + g) * NS5 + n] = hr; osi[(size_t)(b * GB + g) * NS5 + n] = hi;
}

typedef short bf16x8v __attribute__((ext_vector_type(8)));
typedef float f32x16 __attribute__((ext_vector_type(16)));
typedef float f32x2v __attribute__((ext_vector_type(2)));
typedef __bf16 bf16x2v __attribute__((ext_vector_type(2)));
#define MFMA32(a, b, c) __builtin_amdgcn_mfma_f32_32x32x16_bf16((a), (b), (c), 0, 0, 0)
__device__ __forceinline__ unsigned pkbf(float a, float b) { const f32x2v v = {a, b}; const bf16x2v r = __builtin_convertvector(v, bf16x2v); return __builtin_bit_cast(unsigned, r); }
template <int CTRL> __device__ __forceinline__ float dppf(float old, float v) { return __builtin_bit_cast(float, __builtin_amdgcn_update_dpp(__builtin_bit_cast(int, old), __builtin_bit_cast(int, v), CTRL, 0xF, 0xF, false)); }
__device__ __forceinline__ f32x16 ld16(const float* p) { f32x16 r;
#pragma unroll
    for (int i = 0; i < 4; ++i) { const f32x4 v = *(const f32x4*)(p + 4 * i); r[4 * i] = v[0]; r[4 * i + 1] = v[1]; r[4 * i + 2] = v[2]; r[4 * i + 3] = v[3]; }
    return r; }
__device__ __forceinline__ f32x16 ld16l(const LAS float* p) { f32x16 r;
#pragma unroll
    for (int i = 0; i < 4; ++i) { const f32x4 v = *(const LAS f32x4*)(p + 4 * i); r[4 * i] = v[0]; r[4 * i + 1] = v[1]; r[4 * i + 2] = v[2]; r[4 * i + 3] = v[3]; }
    return r; }
__device__ __forceinline__ bf16x8v pack8(const f32x16& x, int s) { v4u p; p.x = pkbf(x[8 * s], x[8 * s + 1]); p.y = pkbf(x[8 * s + 2], x[8 * s + 3]); p.z = pkbf(x[8 * s + 4], x[8 * s + 5]); p.w = pkbf(x[8 * s + 6], x[8 * s + 7]); return __builtin_bit_cast(bf16x8v, p); }
template <int CTRL> __device__ __forceinline__ void s5_scan_step(f32x16& xr, f32x16& xi, const f32x16& zr, const f32x16& zi) {
#pragma unroll
    for (int i = 0; i < 16; ++i) { const float sr = dppf<CTRL>(0.f, xr[i]), si = dppf<CTRL>(0.f, xi[i]);
        xr[i] += zr[i] * sr - zi[i] * si; xi[i] += zr[i] * si + zi[i] * sr; }
}
constexpr int S5L_BF1 = 0, S5L_BF2 = 4096, S5L_TOT = 12288, S5L_CAR = 20480, S5L_ZP = 28672  , S5L_TA = 37376  , S5L_U = 38912  ;
template <bool SECOND>
__device__ __forceinline__ void s5_step(LAS unsigned char* L, int lane, const bf16x8v u, f32x16& hr0, f32x16& hr1, f32x16& hi0, f32x16& hi1,
                                        const f32x16& ar0, const f32x16& ar1, const f32x16& ai0, const f32x16& ai1, const float (&dk)[8], bf16* gout) {
    const LAS bf16x8v* a1 = (const LAS bf16x8v*)(L + S5L_BF1) + lane;
    { const f32x16 cr = ar0 * hr0 - ai0 * hi0, ci = ar0 * hi0 + ai0 * hr0; hr0 = MFMA32(a1[0], u, cr); hi0 = MFMA32(a1[128], u, ci); }
    asm volatile("" : "+v"(hr0), "+v"(hi0));
    { const f32x16 cr = ar1 * hr1 - ai1 * hi1, ci = ar1 * hi1 + ai1 * hr1; hr1 = MFMA32(a1[64], u, cr); hi1 = MFMA32(a1[192], u, ci); }
    if (SECOND) {
        const LAS bf16x8v* a2 = (const LAS bf16x8v*)(L + S5L_BF2) + lane;
        f32x16 y;
#pragma unroll
        for (int i = 0; i < 16; ++i) y[i] = 0.f;
        y = MFMA32(a2[0 * 64], pack8(hr0, 0), y); y = MFMA32(a2[1 * 64], pack8(hr0, 1), y);
        y = MFMA32(a2[2 * 64], pack8(hr1, 0), y); y = MFMA32(a2[3 * 64], pack8(hr1, 1), y);
        y = MFMA32(a2[4 * 64], pack8(hi0, 0), y); y = MFMA32(a2[5 * 64], pack8(hi0, 1), y);
        y = MFMA32(a2[6 * 64], pack8(hi1, 0), y); y = MFMA32(a2[7 * 64], pack8(hi1, 1), y);
        const v4u uw = __builtin_bit_cast(v4u, u);
        float o[8];
        o[0] = gelu_tanh(y[0] + dk[0] * pg8::bf_lo(uw.x)); o[1] = gelu_tanh(y[1] + dk[1] * pg8::bf_hi(uw.x));
        o[2] = gelu_tanh(y[2] + dk[2] * pg8::bf_lo(uw.y)); o[3] = gelu_tanh(y[3] + dk[3] * pg8::bf_hi(uw.y));
        o[4] = gelu_tanh(y[4] + dk[4] * pg8::bf_lo(uw.z)); o[5] = gelu_tanh(y[5] + dk[5] * pg8::bf_hi(uw.z));
        o[6] = gelu_tanh(y[6] + dk[6] * pg8::bf_lo(uw.w)); o[7] = gelu_tanh(y[7] + dk[7] * pg8::bf_hi(uw.w));
        v4u w; w.x = pkbf(o[0], o[1]); w.y = pkbf(o[2], o[3]); w.z = pkbf(o[4], o[5]); w.w = pkbf(o[6], o[7]);
        *(v4u*)gout = w;
    }
}
__device__ __forceinline__ void s5_item_fast(Frame& F, const Args& A, int b, int g) {
    refresh(F);
    const int lane = F.lane, q = lane & 31, hh = lane >> 5, w = F.wave, c = w * 32 + q;
    LAS unsigned char* L = F.lds + RING_OFF;
    const unsigned char* tab = F.ws + WS_TAB;
    const size_t m0 = (size_t)b * TP + (size_t)8 * c;
    const bf16* zrow = (const bf16*)(F.ws + WS_Z) + m0 * NZ + 2 * WA + g * KS5 + 8 * hh;
    bf16* grow = (bf16*)(F.ws + WS_G) + m0 * WB + g * KS5 + 8 * hh;
    LAS v4u* UL = (LAS v4u*)(L + S5L_U) + F.tid;
    {
        v4u uu[8];
#pragma unroll
        for (int j = 0; j < 8; ++j) uu[j] = *(const v4u*)(zrow + (size_t)j * NZ);
        const v4u* s1 = (const v4u*)(tab + TB_BF1) + (size_t)g * 256; const v4u* s2 = (const v4u*)(tab + TB_BF2) + (size_t)g * 512;
        if (F.tid < 256) ((LAS v4u*)(L + S5L_BF1))[F.tid] = s1[F.tid];
        ((LAS v4u*)(L + S5L_BF2))[F.tid] = s2[F.tid];
        const v4u* s3 = (const v4u*)(tab + TB_ZP) + (size_t)g * (17 * 128 / 4); for (int e = F.tid; e < 17 * 128 / 4; e += NWAVES * 64) ((LAS v4u*)(L + S5L_ZP))[e] = s3[e];
        if (F.tid < 32) ((LAS v4u*)(L + S5L_TA))[F.tid] = ((const v4u*)(tab + TB_TA) + (size_t)g * 32)[F.tid];
#pragma unroll
        for (int j = 0; j < 8; ++j) UL[512 * j] = uu[j];
    }
    __syncthreads();
    const LAS float* TA = (const LAS float*)(L + S5L_TA) + hh * 64;
    f32x16 ar0 = ld16l(TA), ar1 = ld16l(TA + 16), ai0 = ld16l(TA + 32), ai1 = ld16l(TA + 48);
    f32x16 hr0, hr1, hi0, hi1;
#pragma unroll
    for (int i = 0; i < 16; ++i) { hr0[i] = 0.f; hr1[i] = 0.f; hi0[i] = 0.f; hi1[i] = 0.f; }
    float dk[8];
#pragma unroll
    for (int i = 0; i < 8; ++i) dk[i] = A.in[I_S5D][g * KS5 + 8 * hh + i];
#pragma unroll 1
    for (int j = 0; j < 8; ++j) { const bf16x8v u = __builtin_bit_cast(bf16x8v, UL[512 * j]);
        s5_step<false>(L, lane, u, hr0, hr1, hi0, hi1, ar0, ar1, ai0, ai1, dk, nullptr); }
    const LAS float* ZP = (const LAS float*)(L + S5L_ZP);
#define S5_SCAN(E, CTRL) do { const LAS float* z = ZP + (((E) * 2 + hh) * 2) * 32; \
        { const f32x16 zr = ld16l(z), zi = ld16l(z + 32); s5_scan_step<CTRL>(hr0, hi0, zr, zi); } \
        asm volatile("" : "+v"(hr0), "+v"(hi0) :: "memory"); \
        { const f32x16 zr = ld16l(z + 16), zi = ld16l(z + 48); s5_scan_step<CTRL>(hr1, hi1, zr, zi); } \
        asm volatile("" : "+v"(hr1), "+v"(hi1) :: "memory"); } while (0)
    S5_SCAN(1, 0x111); S5_SCAN(2, 0x112); S5_SCAN(4, 0x114); S5_SCAN(8, 0x118);
#undef S5_SCAN
    const int seg = w * 2 + (q >> 4);
    LAS float* TOT = (LAS float*)(L + S5L_TOT); LAS float* CAR = (LAS float*)(L + S5L_CAR);
    if ((lane & 15) == 15) {
#pragma unroll
        for (int rho = 0; rho < 4; ++rho) {
            *(LAS f32x4*)(TOT + (seg * 2 + 0) * 64 + 0 + 8 * rho + 4 * hh) = (f32x4){hr0[4 * rho], hr0[4 * rho + 1], hr0[4 * rho + 2], hr0[4 * rho + 3]};
            *(LAS f32x4*)(TOT + (seg * 2 + 0) * 64 + 32 + 8 * rho + 4 * hh) = (f32x4){hr1[4 * rho], hr1[4 * rho + 1], hr1[4 * rho + 2], hr1[4 * rho + 3]};
            *(LAS f32x4*)(TOT + (seg * 2 + 1) * 64 + 0 + 8 * rho + 4 * hh) = (f32x4){hi0[4 * rho], hi0[4 * rho + 1], hi0[4 * rho + 2], hi0[4 * rho + 3]};
            *(LAS f32x4*)(TOT + (seg * 2 + 1) * 64 + 32 + 8 * rho + 4 * hh) = (f32x4){hi1[4 * rho], hi1[4 * rho + 1], hi1[4 * rho + 2], hi1[4 * rho + 3]}; }
    }
    __syncthreads();
    if (F.tid < 64) {
        const float* z16 = (const float*)(tab + TB_Z16N) + (size_t)g * 128; const float zr = z16[F.tid], zi = z16[64 + F.tid];
        float cr = 0.f, ci = 0.f;
#pragma unroll
        for (int sg = 0; sg < 16; ++sg) { CAR[(sg * 2 + 0) * 64 + F.tid] = cr; CAR[(sg * 2 + 1) * 64 + F.tid] = ci;
            const float tr = TOT[(sg * 2 + 0) * 64 + F.tid], ti = TOT[(sg * 2 + 1) * 64 + F.tid];
            const float ncr = zr * cr - zi * ci + tr, nci = zr * ci + zi * cr + ti; cr = ncr; ci = nci; }
    }
    __syncthreads();
    {
        const LAS float* z = ZP + (((q & 15) * 2 + hh) * 2) * 32;
#define S5_EXCL(HR, HI, OFF) do { const f32x16 zr = ld16l(z + (OFF)), zi = ld16l(z + 32 + (OFF)); f32x16 kr, ki; \
        _Pragma("unroll") for (int rho = 0; rho < 4; ++rho) { \
            const f32x4 a0 = *(const LAS f32x4*)(CAR + (seg * 2 + 0) * 64 + 2 * (OFF) + 8 * rho + 4 * hh), b0 = *(const LAS f32x4*)(CAR + (seg * 2 + 1) * 64 + 2 * (OFF) + 8 * rho + 4 * hh); \
            _Pragma("unroll") for (int e = 0; e < 4; ++e) { kr[4 * rho + e] = a0[e]; ki[4 * rho + e] = b0[e]; } } \
        _Pragma("unroll") for (int i = 0; i < 16; ++i) { const float sr = dppf<0x111>(0.f, HR[i]), si = dppf<0x111>(0.f, HI[i]); \
            HR[i] = sr + zr[i] * kr[i] - zi[i] * ki[i]; HI[i] = si + zr[i] * ki[i] + zi[i] * kr[i]; } } while (0)
        S5_EXCL(hr0, hi0, 0); asm volatile("" : "+v"(hr0), "+v"(hi0) :: "memory"); S5_EXCL(hr1, hi1, 16); asm volatile("" : "+v"(hr1), "+v"(hi1) :: "memory");
#undef S5_EXCL
    }
    { int off = 0; asm volatile("" : "+v"(off)); const LAS float* TA2 = TA + off; ar0 = ld16l(TA2); ar1 = ld16l(TA2 + 16); ai0 = ld16l(TA2 + 32); ai1 = ld16l(TA2 + 48); }
#pragma unroll 1
    for (int j = 0; j < 8; ++j) { const bf16x8v u = __builtin_bit_cast(bf16x8v, UL[512 * j]);
        s5_step<true>(L, lane, u, hr0, hr1, hi0, hi1, ar0, ar1, ai0, ai1, dk, grow + (size_t)j * WB); }
    if (w == NWAVES - 1 && q == 31) {
        float* osr = F.out + O_SRP + (size_t)(b * GB + g) * NS5; float* osi = F.out + O_SIP + (size_t)(b * GB + g) * NS5;
#pragma unroll
        for (int i = 0; i < 16; ++i) { const int n = (i & 3) + 8 * (i >> 2) + 4 * hh; osr[n] = hr0[i]; osr[32 + n] = hr1[i]; osi[n] = hi0[i]; osi[32 + n] = hi1[i]; }
    }
    __syncthreads();
}

__device__ __forceinline__ void s5_item_sample(Frame& F, const Args& A, int g) {
    refresh(F);
    const int lane = F.lane, q = lane & 31, hh = lane >> 5, w = F.wave;
    LAS unsigned char* L = F.lds + RING_OFF;
    const unsigned char* tab = F.ws + WS_TAB;
    { const v4u* s1 = (const v4u*)(tab + TB_BF1) + (size_t)g * 256; const v4u* s2 = (const v4u*)(tab + TB_BF2) + (size_t)g * 512;
      if (F.tid < 256) ((LAS v4u*)(L + S5L_BF1))[F.tid] = s1[F.tid];
      ((LAS v4u*)(L + S5L_BF2))[F.tid] = s2[F.tid]; }
    __syncthreads();
    if (w < 4) {
        const int b = w * 32 + q;
        const float* TA = (const float*)(tab + TB_TA) + (size_t)((g * 2 + hh) * 2) * 32;
        const f32x16 ar0 = ld16(TA), ar1 = ld16(TA + 16), ai0 = ld16(TA + 32), ai1 = ld16(TA + 48);
        f32x16 hr0, hr1, hi0, hi1;
        const float* sr = A.in[I_SSR] + (size_t)(b * GB + g) * NS5; const float* si = A.in[I_SSI] + (size_t)(b * GB + g) * NS5;
#pragma unroll
        for (int rho = 0; rho < 4; ++rho) { const f32x4 a0 = *(const f32x4*)(sr + 8 * rho + 4 * hh), a1 = *(const f32x4*)(sr + 32 + 8 * rho + 4 * hh), b0 = *(const f32x4*)(si + 8 * rho + 4 * hh), b1 = *(const f32x4*)(si + 32 + 8 * rho + 4 * hh);
#pragma unroll
            for (int e = 0; e < 4; ++e) { hr0[4 * rho + e] = a0[e]; hr1[4 * rho + e] = a1[e]; hi0[4 * rho + e] = b0[e]; hi1[4 * rho + e] = b1[e]; } }
        float dk[8];
#pragma unroll
        for (int i = 0; i < 8; ++i) dk[i] = A.in[I_S5D][g * KS5 + 8 * hh + i];
        const size_t m0 = (size_t)MP + (size_t)b * TS;
        const bf16* zrow = (const bf16*)(F.ws + WS_Z) + m0 * NZ + 2 * WA + g * KS5 + 8 * hh;
        bf16* grow = (bf16*)(F.ws + WS_G) + m0 * WB + g * KS5 + 8 * hh;
        bf16x8v uu[TS];
#pragma unroll
        for (int j = 0; j < TS; ++j) uu[j] = *(const bf16x8v*)(zrow + (size_t)j * NZ);
#pragma unroll
        for (int j = 0; j < TS; ++j) s5_step<true>(L, lane, uu[j], hr0, hr1, hi0, hi1, ar0, ar1, ai0, ai1, dk, grow + (size_t)j * WB);
        float* osr = F.out + O_SRS + (size_t)(b * GB + g) * NS5; float* osi = F.out + O_SIS + (size_t)(b * GB + g) * NS5;
#pragma unroll
        for (int rho = 0; rho < 4; ++rho) {
            *(f32x4*)(osr + 8 * rho + 4 * hh) = (f32x4){hr0[4 * rho], hr0[4 * rho + 1], hr0[4 * rho + 2], hr0[4 * rho + 3]};
            *(f32x4*)(osr + 32 + 8 * rho + 4 * hh) = (f32x4){hr1[4 * rho], hr1[4 * rho + 1], hr1[4 * rho + 2], hr1[4 * rho + 3]};
            *(f32x4*)(osi + 8 * rho + 4 * hh) = (f32x4){hi0[4 * rho], hi0[4 * rho + 1], hi0[4 * rho + 2], hi0[4 * rho + 3]};
            *(f32x4*)(osi + 32 + 8 * rho + 4 * hh) = (f32x4){hi1[4 * rho], hi1[4 * rho + 1], hi1[4 * rho + 2], hi1[4 * rho + 3]}; }
    }
    __syncthreads();
}

template <int CTRL, int RMASK> __device__ __forceinline__ float dppm(float old, float v) { return __builtin_bit_cast(float, __builtin_amdgcn_update_dpp(__builtin_bit_cast(int, old), __builtin_bit_cast(int, v), CTRL, RMASK, 0xF, false)); }
template <int CTRL, int RMASK> __device__ __forceinline__ void rg_scan_step(f32x16& a, f32x16& b) {
#pragma unroll
    for (int i = 0; i < 16; ++i) { const float as = dppm<CTRL, RMASK>(1.f, a[i]), bs = dppm<CTRL, RMASK>(0.f, b[i]); b[i] = a[i] * bs + b[i]; a[i] = a[i] * as; }
}
constexpr int RGL_AFR = 0, RGL_CWT = 8192, RGL_TOT = 10240, RGL_CST = 14336;
constexpr int RGL_XAP = 144, RGL_GTP = 80;
constexpr int RGL_XA0 = 14848, RGL_GT0 = RGL_XA0 + 37376, RGL_BUF = 37376 + 20480;
static_assert(259 * RGL_XAP <= 37376 && 256 * RGL_GTP <= 20480 && RGL_XA0 + 2 * RGL_BUF <= RING_BYTES, "RG-LRU LDS map");
template <bool SAMPLE>
__device__ __forceinline__ void rg_item_fast(Frame& F, const Args& A, int b, int hd, int jh) {
    refresh(F);
    const int lane = F.lane, q = lane & 31, hh = lane >> 5, w = F.wave;
    LAS unsigned char* L = F.lds + RING_OFF;
    const float* sc = (const float*)(F.ws + WS_S5C);
    const bf16* Zb = (const bf16*)(F.ws + WS_Z) + (size_t)(SAMPLE ? MP : b * TP) * NZ; bf16* Yb = (bf16*)(F.ws + WS_YCAT) + (size_t)(SAMPLE ? MP : b * TP) * D;
    const bf16* CB = (const bf16*)(F.ws + WS_TAB + TB_CB);
    auto stage_load = [&](int T0, v4u (&st)[7]) {
#pragma unroll
        for (int k = 0; k < 7; ++k) { const int ci = F.tid + 512 * k; v4u v = (v4u){0u, 0u, 0u, 0u};
            if (ci < 2072) { const int tk = T0 - 3 + (ci >> 3); if (tk >= 0) v = *(const v4u*)(Zb + (size_t)tk * NZ + WA + hd * 64 + (ci & 7) * 8); }
            else if (ci < 2072 + 1024) { const int gi = ci - 2072; v = *(const v4u*)(Zb + (size_t)(T0 + (gi >> 2)) * NZ + hd * 64 + 32 * jh + (gi & 3) * 8); }
            st[k] = v; } };
    auto stage_write = [&](int par, const v4u (&st)[7]) {
#pragma unroll
        for (int k = 0; k < 7; ++k) { const int ci = F.tid + 512 * k;
            if (ci < 2072) *(LAS v4u*)(L + RGL_XA0 + par * RGL_BUF + (ci >> 3) * RGL_XAP + (ci & 7) * 16) = st[k];
            else if (ci < 2072 + 1024) { const int gi = ci - 2072; *(LAS v4u*)(L + RGL_GT0 + par * RGL_BUF + (gi >> 2) * RGL_GTP + (gi & 3) * 16) = st[k]; } } };
    {
        const v4u* src = (const v4u*)(F.ws + WS_TAB + TB_RG) + (size_t)((hd * 2 + jh) * 8) * 64;
        ((LAS v4u*)(L + RGL_AFR))[F.tid] = src[F.tid];
        if (F.tid < 320) { const int h2 = F.tid / 160, tap = (F.tid % 160) / 32, e = F.tid % 32, c = hd * 64 + 16 * (e >> 3) + 8 * h2 + (e & 7);
            ((LAS float*)(L + RGL_CWT))[F.tid] = tap < 4 ? A.in[I_CONVW][tap * WA + c] : A.in[I_CONVB][c]; }
        if (F.tid >= 384 && F.tid < 480) { const int e = F.tid - 384, h2 = e / 48, kind = (e % 48) / 16, i = e % 16, c = hd * 64 + 32 * jh + 16 * (i >> 3) + 8 * h2 + (i & 7);
            ((LAS float*)(L + RGL_CST))[e] = kind == 0 ? A.in[I_RGBR][c] : (kind == 1 ? A.in[I_RGBI][c] : sc[SC_RGL + c]); }
        if (!SAMPLE && jh == 0 && F.tid < 192) { const int k = F.tid >> 6, ch = F.tid & 63;
            F.out[O_CONVP + (size_t)(b * 3 + k) * WA + hd * 64 + ch] = bf2f(((const bf16*)(F.ws + WS_Z))[(size_t)(b * TP + TP - 3 + k) * NZ + WA + hd * 64 + ch]); }
        if (SAMPLE && jh == 0) { for (int e = F.tid; e < NBS * 3 * 64; e += NWAVES * 64) { const int bb = e / 192, k = (e / 64) % 3, ch = e & 63;
            F.out[O_CONVS + (size_t)(bb * 3 + k) * WA + hd * 64 + ch] = bf2f(((const bf16*)(F.ws + WS_Z))[(size_t)(MP + bb * TS + 1 + k) * NZ + WA + hd * 64 + ch]); } }
        if (!SAMPLE) { v4u st[7]; stage_load(0, st); stage_write(0, st); }
    }
    __syncthreads();
    float hround[16];
#pragma unroll
    for (int i = 0; i < 16; ++i) hround[i] = 0.f;
    const LAS float* CWT = (const LAS float*)(L + RGL_CWT) + hh * 160;
#pragma unroll 1
    for (int rd = 0; rd < (SAMPLE ? 2 : 8); ++rd) {
        const int t = rd * 256 + w * 32 + q;
        v4u stn[7];
        if (!SAMPLE) stage_load((rd + 1) * 256, stn);
        const LAS unsigned char* XAp = L + RGL_XA0 + (rd & 1) * RGL_BUF + (w * 32 + q) * RGL_XAP + 16 * hh;
        const LAS unsigned char* GTp = L + RGL_GT0 + (rd & 1) * RGL_BUF + (w * 32 + q) * RGL_GTP + 16 * hh;
        const bf16* zsr[4];
        if (SAMPLE) {
#pragma unroll
            for (int k = 0; k < 4; ++k) { const int jx = (t & 3) + k; zsr[k] = (jx < 3 ? CB + (size_t)((t >> 2) * 3 + jx) * WA : Zb + (size_t)(t - 3 + k) * NZ + WA) + hd * 64 + 8 * hh; } }
        v4u g0, g1;
        if (SAMPLE) { const bf16* gr = Zb + (size_t)t * NZ + hd * 64 + 32 * jh + 8 * hh; g0 = *(const v4u*)gr; g1 = *(const v4u*)(gr + 16); }
        else { g0 = *(const LAS v4u*)GTp; g1 = *(const LAS v4u*)(GTp + 32); }
        float xc[32];
#pragma unroll
        for (int s4 = 0; s4 < 4; ++s4) {
            float acc[8];
#pragma unroll
            for (int j4 = 0; j4 < 2; ++j4) { const f32x4 cb = *(const LAS f32x4*)(CWT + 4 * 32 + s4 * 8 + 4 * j4); acc[4 * j4] = cb[0]; acc[4 * j4 + 1] = cb[1]; acc[4 * j4 + 2] = cb[2]; acc[4 * j4 + 3] = cb[3]; }
#pragma unroll
            for (int k = 0; k < 4; ++k) { const v4u v = SAMPLE ? *(const v4u*)(zsr[k] + 16 * s4) : *(const LAS v4u*)(XAp + k * RGL_XAP + s4 * 32);
                const f32x4 w0 = *(const LAS f32x4*)(CWT + k * 32 + s4 * 8), w1 = *(const LAS f32x4*)(CWT + k * 32 + s4 * 8 + 4);
                acc[0] += w0[0] * pg8::bf_lo(v.x); acc[1] += w0[1] * pg8::bf_hi(v.x); acc[2] += w0[2] * pg8::bf_lo(v.y); acc[3] += w0[3] * pg8::bf_hi(v.y);
                acc[4] += w1[0] * pg8::bf_lo(v.z); acc[5] += w1[1] * pg8::bf_hi(v.z); acc[6] += w1[2] * pg8::bf_lo(v.w); acc[7] += w1[3] * pg8::bf_hi(v.w); }
#pragma unroll
            for (int e = 0; e < 8; ++e) xc[s4 * 8 + e] = acc[e];
            asm volatile("" : "+v"(xc[s4 * 8]), "+v"(xc[s4 * 8 + 7]) :: "memory");
        }
        f32x16 dr, di;
#pragma unroll
        for (int i = 0; i < 16; ++i) { dr[i] = 0.f; di[i] = 0.f; }
        const LAS bf16x8v* af = (const LAS bf16x8v*)(L + RGL_AFR) + lane;
#pragma unroll
        for (int s4 = 0; s4 < 4; ++s4) { v4u p; p.x = pkbf(xc[s4 * 8], xc[s4 * 8 + 1]); p.y = pkbf(xc[s4 * 8 + 2], xc[s4 * 8 + 3]); p.z = pkbf(xc[s4 * 8 + 4], xc[s4 * 8 + 5]); p.w = pkbf(xc[s4 * 8 + 6], xc[s4 * 8 + 7]);
            const bf16x8v bfr = __builtin_bit_cast(bf16x8v, p);
            dr = MFMA32(af[s4 * 64], bfr, dr); di = MFMA32(af[(4 + s4) * 64], bfr, di); }
        f32x16 av, bv;
        const bool first = !SAMPLE && (t == 0);
        const LAS float* CST = (const LAS float*)(L + RGL_CST) + hh * 48;
#pragma unroll
        for (int i = 0; i < 16; ++i) { const float xcv = jh ? xc[16 + i] : xc[i];
            const float r = sigmoidf_(dr[i] + CST[i]), gi = sigmoidf_(di[i] + CST[16 + i]);
            const float a = __builtin_amdgcn_exp2f(r * CST[32 + i]);
            float mult = __builtin_amdgcn_sqrtf(fmaxf(1.f - a * a, 0.f)); if (first) mult = 1.f;
            av[i] = a; bv[i] = mult * gi * xcv; }
        if (SAMPLE && (t & 3) == 0) {
            const float* h0 = A.in[I_SH] + (size_t)(t >> 2) * WA + hd * 64 + 32 * jh + 8 * hh;
#pragma unroll
            for (int i = 0; i < 16; ++i) { bv[i] += av[i] * h0[16 * (i >> 3) + (i & 7)]; av[i] = 0.f; } }
        rg_scan_step<0x111, 0xF>(av, bv); rg_scan_step<0x112, 0xF>(av, bv); rg_scan_step<0x114, 0xF>(av, bv); rg_scan_step<0x118, 0xF>(av, bv);
        rg_scan_step<0x142, 0xA>(av, bv);
        float hin[16];
#pragma unroll
        for (int i = 0; i < 16; ++i) hin[i] = 0.f;
        if (!SAMPLE) {
        LAS float* TOT = (LAS float*)(L + RGL_TOT) + (rd & 1) * 512;
        if (q == 31) {
#pragma unroll
            for (int i4 = 0; i4 < 4; ++i4) { *(LAS f32x4*)(TOT + (w * 2 + 0) * 32 + hh * 16 + 4 * i4) = (f32x4){av[4 * i4], av[4 * i4 + 1], av[4 * i4 + 2], av[4 * i4 + 3]};
                                             *(LAS f32x4*)(TOT + (w * 2 + 1) * 32 + hh * 16 + 4 * i4) = (f32x4){bv[4 * i4], bv[4 * i4 + 1], bv[4 * i4 + 2], bv[4 * i4 + 3]}; }
        }
        stage_write((rd + 1) & 1, stn);
        __syncthreads();
#pragma unroll
        for (int w2 = 0; w2 < 8; ++w2) {
            if (w2 == w) {
#pragma unroll
                for (int i = 0; i < 16; ++i) hin[i] = hround[i]; }
#pragma unroll
            for (int i4 = 0; i4 < 4; ++i4) { const f32x4 p = *(const LAS f32x4*)(TOT + (w2 * 2 + 0) * 32 + hh * 16 + 4 * i4), hl = *(const LAS f32x4*)(TOT + (w2 * 2 + 1) * 32 + hh * 16 + 4 * i4);
#pragma unroll
                for (int e = 0; e < 4; ++e) hround[4 * i4 + e] = p[e] * hround[4 * i4 + e] + hl[e]; }
        }
        }
        float o[16];
        const unsigned gw_[8] = {g0.x, g0.y, g0.z, g0.w, g1.x, g1.y, g1.z, g1.w};
#pragma unroll
        for (int i = 0; i < 16; ++i) { const float h = bv[i] + av[i] * hin[i]; const float gt = (i & 1) ? pg8::bf_hi(gw_[i >> 1]) : pg8::bf_lo(gw_[i >> 1]); o[i] = gelu_tanh(gt) * h; }
        bf16* yr = Yb + (size_t)t * D + hd * 64 + 32 * jh + 8 * hh;
        v4u w0; w0.x = pkbf(o[0], o[1]); w0.y = pkbf(o[2], o[3]); w0.z = pkbf(o[4], o[5]); w0.w = pkbf(o[6], o[7]);
        v4u w1; w1.x = pkbf(o[8], o[9]); w1.y = pkbf(o[10], o[11]); w1.z = pkbf(o[12], o[13]); w1.w = pkbf(o[14], o[15]);
        *(v4u*)yr = w0; *(v4u*)(yr + 16) = w1;
        if (SAMPLE && (t & 3) == 3) {
#pragma unroll
            for (int i = 0; i < 16; ++i) F.out[O_HS + (size_t)(t >> 2) * WA + hd * 64 + 32 * jh + 16 * (i >> 3) + 8 * hh + (i & 7)] = bv[i]; }
    }
    if (!SAMPLE && w == 0 && q == 0) {
#pragma unroll
        for (int i = 0; i < 16; ++i) F.out[O_HP + (size_t)b * WA + hd * 64 + 32 * jh + 16 * (i >> 3) + 8 * hh + (i & 7)] = hround[i];
    }
    __syncthreads();
}

#ifndef PROBE_P3PART
#define PROBE_P3PART 7
#endif
__device__ __forceinline__ void p3_mixers_ref(Frame& F, const Args& A, int rep = 0) {
    constexpr int N_RGP = NBP * HA, N_S5P = NBP * GB;
    const int pm = rep ? PROBE_P3PART : 7;
    if (F.vcu < 2 * N_RGP) {
        if (pm & 1) rg_item_fast<false>(F, A, F.vcu / (2 * HA), (F.vcu / 2) % HA, F.vcu & 1);
    } else {
        const int v = F.vcu - 2 * N_RGP, it = 2 * v;
        if (pm & 2) { s5_item_fast(F, A, it / GB, it % GB);
                      s5_item_fast(F, A, (it + 1) / GB, (it + 1) % GB); }
        if (pm & 4) { if (v < GB) s5_item_sample(F, A, v);
                      else if (v < GB + 2 * HA) rg_item_fast<true>(F, A, 0, (v - GB) >> 1, (v - GB) & 1); }
    }
    if (rep == 0) xpose_range(F, A, XO_2, XO_END, 2 * N_RGP);
}

__global__ void __launch_bounds__(NWAVES * 64, 2) fwd(Args A) {
    extern __shared__ __attribute__((aligned(16))) unsigned char lds[];
    Frame F;
    F.lds = (LAS unsigned char*)lds;
    F.MISC = (volatile LAS unsigned*)(F.lds + MISC_OFF);
    F.tid = threadIdx.x; F.lane = F.tid & 63; F.wave = __builtin_amdgcn_readfirstlane(F.tid >> 6);
    F.G = gridDim.x; { const int bx = blockIdx.x; F.vcu = (F.G % 8 == 0) ? (bx % 8) * (F.G / 8) + bx / 8 : bx; }
    F.out = A.out; F.ws = A.ws; F.ctl = (gu32*)(A.ws + WS_CTL);
    for (int u = F.tid; u < (LDS_BYTES - LDSCTL_OFF) / 4; u += NWAVES * 64) ((LAS unsigned*)(F.lds + LDSCTL_OFF))[u] = 0u;
    __syncthreads();
    XcdBarrier bar; bar.bar = (unsigned*)(F.ctl + CW_BAR); bar.x = 0; bar.st = nullptr;
    if (N_LAUNCHES == 1) bar = xcd_barrier_post((unsigned*)(F.ctl + CW_BAR), F.MISC + 8);
#define GRID_BAR() do { if (N_LAUNCHES == 1) xcd_barrier(bar); } while (0)
    const int lo = A.ph_lo, hi = A.ph_hi;
#define IN(k) (lo <= (k) && (k) < hi)
#define BOTH(k) (IN(k) && IN((k) + 1))
    bf16* XN = (bf16*)(F.ws + WS_XN); bf16* Z = (bf16*)(F.ws + WS_Z); bf16* YC = (bf16*)(F.ws + WS_YCAT); bf16* GY = (bf16*)(F.ws + WS_G); bf16* U = (bf16*)(F.ws + WS_U);
    const float* mod = (const float*)(F.ws + WS_MOD);

#define REPS(k) (((PROBE_DUP) >> (k)) & 1 ? 2 : 1)
#define PH0(rep) p0_prologue(F, A, rep)
#define PH1(rep) p1_modulate(F, A)
#define PH2(rep) do {     \
        pg8::Gemm g{XN, (const bf16*)(F.ws + WS_WIN), M, NZ, D}; pg8::StaticOrder S; S.init(M, NZ, F.G, (int)blockIdx.x, D); \
        pg8::EpiBf16<0> E{Z, NZ, nullptr}; \
        pg8::gemm_phase<pg8::EpiBf16<0>, pg8::StaticOrder, PG8_ALIGN, PG8_SP2>(F.lds + RING_OFF, g, S, E); } while (0)
#define PH3(rep) p3_mixers_ref(F, A, rep)
#define PH4(rep) do {     \
        pg8::Gemm g{GY, (const bf16*)(F.ws + WS_WGLU), M, WB, WB}; pg8::StaticOrder S; S.init(M, WB, F.G, (int)blockIdx.x, WB); \
        pg8::EpiGlu E{GY, WB, YC, D, WA, A.in[I_GLUB]}; \
        pg8::gemm_phase<pg8::EpiGlu, pg8::StaticOrder, PG8_ALIGN, PG8_SP2>(F.lds + RING_OFF, g, S, E); \
        if ((rep) == 0 && (int)blockIdx.x >= (M / 256) * (WB / 256)) { __syncthreads(); xpose_range_b(F, A, XO_OU, XO_2, (M / 256) * (WB / 256)); } } while (0)
#define PH5(rep) do {     \
        pg8::Gemm g{YC, (const bf16*)(F.ws + WS_WOUT), M, D, D}; pg8::SplitOrder S; S.init(MP, D, F.G, (int)blockIdx.x, D, NS_OUT); \
        pg8::EpiRes<false> E{A.in[I_XP], (bf16*)(F.ws + WS_T1), mod + 2 * D, nullptr, ALPHA, MP, (float*)(F.ws + WS_SLAB)}; \
        pg8::gemm_phase<pg8::EpiRes<false>, pg8::SplitOrder, PG8_ALIGN, PG8_SP2>(F.lds + RING_OFF, g, S, E); } while (0)
#define PH6(rep) ln_rows<false>(F, A)
#define PH7(rep) do {     \
        pg8::Gemm g{XN, (const bf16*)(F.ws + WS_W1), M, FF, D}; pg8::StaticOrder S; S.init(M, FF, F.G, (int)blockIdx.x, D); \
        pg8::EpiBf16<3> E{U, FF, A.in[I_B1]}; \
        pg8::gemm_phase<pg8::EpiBf16<3>, pg8::StaticOrder, PG8_ALIGN, PG8_SP2>(F.lds + RING_OFF, g, S, E); } while (0)
#define PH8(rep) do {     \
        pg8::Gemm g{U, (const bf16*)(F.ws + WS_W2), M, D, FF}; pg8::SplitOrder S; S.init(MP, D, F.G, (int)blockIdx.x, FF, NS_DOWN); \
        pg8::EpiRes<true> E{(const bf16*)(F.ws + WS_X1B), (bf16*)(F.ws + WS_T2), mod + 5 * D, A.in[I_B2], ALPHA, MP, (float*)(F.ws + WS_SLAB)}; \
        pg8::gemm_phase<pg8::EpiRes<true>, pg8::SplitOrder, PG8_ALIGN, PG8_SP2>(F.lds + RING_OFF, g, S, E); } while (0)
#define RUN(k, PH) do { if (IN(k)) { PH(0); if (REPS(k) == 2) { __syncthreads(); PH(1); } if (BOTH(k)) GRID_BAR(); } } while (0)
    RUN(0, PH0); RUN(1, PH1); RUN(2, PH2); RUN(3, PH3); RUN(4, PH4); RUN(5, PH5); RUN(6, PH6); RUN(7, PH7); RUN(8, PH8);
    if (IN(9)) { ln_rows<true>(F, A); }
#undef IN
#undef BOTH
}

extern "C" void kernel_launch(void* const* d_in, const int* in_sizes, int n_in, void* d_out, int out_size, void* d_ws, size_t ws_size, hipStream_t stream) {
    static int grid = 0;
    if (grid == 0) {
        if (n_in != 37 || in_sizes[0] != MP * D || out_size != (int)O_END || ws_size < WS_END) { fprintf(stderr, "kernel_launch: unexpected shapes (n_in %d, in0 %d, out %d, ws %zu)\n", n_in, n_in > 0 ? in_sizes[0] : -1, out_size, ws_size); grid = -1; return; }
        int dev = 0, cus = 0, per_cu = 0;
        if (hipGetDevice(&dev) != hipSuccess || hipDeviceGetAttribute(&cus, hipDeviceAttributeMultiprocessorCount, dev) != hipSuccess) { grid = -1; return; }
        if (hipFuncSetAttribute((const void*)fwd, hipFuncAttributeMaxDynamicSharedMemorySize, LDS_BYTES) != hipSuccess) { fprintf(stderr, "kernel_launch: hipFuncSetAttribute failed\n"); grid = -1; return; }
        if (hipOccupancyMaxActiveBlocksPerMultiprocessor(&per_cu, (const void*)fwd, NWAVES * 64, LDS_BYTES) != hipSuccess || per_cu < 1) { fprintf(stderr, "kernel_launch: occupancy query says %d\n", per_cu); }
        (void)hipGetLastError();
        grid = cus;
        if (grid < 256) { fprintf(stderr, "kernel_launch: this build needs 256 CUs (got %d)\n", grid); grid = -1; return; }
        grid = 256;
    }
    if (grid < 0) return;
    (void)hipMemsetAsync((char*)d_ws + WS_CTL, 0, CTL_ZERO_BYTES, stream);
    Args a{};
    for (int i = 0; i < 37; ++i) a.in[i] = (const float*)d_in[i];
    a.out = (float*)d_out; a.ws = (unsigned char*)d_ws;
    for (int li = 0; li < N_LAUNCHES; ++li) {
        if (N_LAUNCHES == 1) { a.ph_lo = 0; a.ph_hi = N_PHASES; } else { a.ph_lo = li; a.ph_hi = li + 1; }
        a.li = li;
        hipLaunchKernelGGL(fwd, dim3(grid), dim3(NWAVES * 64), LDS_BYTES, stream, a);
    }
}
```

```cpp
#include <hip/hip_runtime.h>
#include <cstdio>
#include <cstdint>
#include <cmath>

#ifndef MK_N_LAUNCHES
#define MK_N_LAUNCHES 1
#endif

namespace pg8 {
#define PG8_LAS __attribute__((address_space(3)))
typedef unsigned short bf16_t;
typedef short bf16x8 __attribute__((ext_vector_type(8)));
typedef float f32x4 __attribute__((ext_vector_type(4)));
typedef unsigned u32x4 __attribute__((ext_vector_type(4)));
constexpr int BM = 256, BK = 64, HALF = 128, HTB = HALF * BK * 2, STAGE_BYTES = 8 * HTB, NXCD = 8, WGM = 8;

__host__ __device__ __forceinline__ int lds_byte(int r, int c) { const int st = (r >> 4) * 2 + (c >> 5), rr = r & 15, cc = c & 31, ob = rr * 64 + cc * 2; return st * 1024 + (ob ^ (((ob >> 9) & 1) << 5)); }
__host__ __device__ __forceinline__ void stage_rc(int b, int& R, int& C) { const int st = b / 1024, sb = b % 1024, swz = sb ^ (((sb >> 9) & 1) << 5); R = (st >> 1) * 16 + swz / 64; C = (st & 1) * 32 + (swz % 64) / 2; }
__host__ __device__ __forceinline__ int perm32(int rho) { const int n = rho >> 4, i = rho & 15; return 8 * (i >> 2) + 4 * n + (i & 3); }

struct Unit { int pm, pn, k0, nkt, ks; };
struct Gemm { const bf16_t* A; const bf16_t* Bt; int M, N, K; };

struct StaticOrder {
    int nM, nN, nwg, G, c, K;
    __host__ __device__ void init(int M, int N, int G_, int c_, int K_) { nM = M / BM; nN = N / BM; nwg = nM * nN; G = G_; c = c_; K = K_; }
    __host__ __device__ __forceinline__ bool next(int i, Unit& u) const {
        const long L = (long)i * G + c; if (L >= nwg) return false;
        int wgid = (int)L; { const int q = nwg / NXCD, r = nwg % NXCD, xcd = wgid % NXCD, off = wgid / NXCD; wgid = (xcd < r ? xcd * (q + 1) : r * (q + 1) + (xcd - r) * q) + off; }
        const int nig = WGM * nN, gid = wgid / nig, fm = gid * WGM, gsz = (nM - fm) < WGM ? (nM - fm) : WGM;
        u.pm = fm + ((wgid % nig) % gsz); u.pn = (wgid % nig) / gsz; u.k0 = 0; u.nkt = K / BK; u.ks = 0; return true;
    }
    __device__ __forceinline__ void a_ready(const Unit&) const {}
    __device__ __forceinline__ void done(const Unit&) const {}
};

struct SplitOrder {
    StaticOrder P; int nN, NS, nP, G, c, K, r0;
    __host__ __device__ void init(int MPr, int N, int G_, int c_, int K_, int NS_) { P.init(MPr, N, G_, c_, K_); nN = N / BM; NS = NS_; nP = 2 * nN * NS; G = G_; c = c_; K = K_; r0 = (P.nwg + G - 1 - c) / G;   }
    __host__ __device__ __forceinline__ bool next(int i, Unit& u) const {
        Unit a; a.pm = 0; a.pn = 0; a.k0 = 0; a.nkt = K / BK; a.ks = 0;
        const bool okp = P.next(i < r0 ? i : 0, a);
        const int p = (i - r0) * G + (G - 1 - c), t = p / NS, ks = p % NS, nk = K / BK / NS;
        const bool split = i >= r0;
        u.pm = split ? P.nM + t / nN : a.pm; u.pn = split ? t % nN : a.pn; u.nkt = split ? nk : a.nkt; u.ks = split ? ks : 0; u.k0 = split ? ks * nk * BK : 0;
        return split ? (p < nP) : okp;
    }
    __device__ __forceinline__ void a_ready(const Unit&) const {}
    __device__ __forceinline__ void done(const Unit&) const {}
};

__device__ __forceinline__ unsigned cvt_pk_bf16(float lo, float hi) { unsigned r; asm volatile("v_cvt_pk_bf16_f32 %0, %1, %2" : "=v"(r) : "v"(lo), "v"(hi)); return r; }
__device__ __forceinline__ float bf_lo(unsigned w) { return __builtin_bit_cast(float, w << 16); }
__device__ __forceinline__ float bf_hi(unsigned w) { return __builtin_bit_cast(float, w & 0xffff0000u); }

template <int ACT> struct EpiBf16 {
    static constexpr bool PERM = true, AFTER_DRAIN = false;
    bf16_t* O; int ldc; const float* bias;
    __device__ __forceinline__ void operator()(const f32x4 (&acc)[2][2][4][2], const Unit& u, int wr, int wc, int fr, int fq) const {
        const int row0 = u.pm * BM + wr * 64 + fr; const int col0 = u.pn * BM + wc * 32 + 8 * fq;
        f32x4 bv[2][2];
#pragma unroll
        for (int bj = 0; bj < 2; ++bj)
#pragma unroll
            for (int n = 0; n < 2; ++n) bv[bj][n] = bias ? *(const f32x4*)(bias + col0 + bj * HALF + 4 * n) : (f32x4){0.f, 0.f, 0.f, 0.f};
#pragma unroll
        for (int ai = 0; ai < 2; ++ai)
#pragma unroll
            for (int m = 0; m < 4; ++m) { bf16_t* rowp = O + (size_t)(row0 + ai * HALF + m * 16) * ldc + col0;
#pragma unroll
                for (int bj = 0; bj < 2; ++bj) { f32x4 v0 = acc[ai][bj][m][0] + bv[bj][0], v1 = acc[ai][bj][m][1] + bv[bj][1];
                    if (ACT == 3) {
#pragma unroll
                        for (int e = 0; e < 4; ++e) { const float a = fmaxf(v0[e], 0.f), b = fmaxf(v1[e], 0.f); v0[e] = a * a; v1[e] = b * b; } }
                    u32x4 w; w.x = cvt_pk_bf16(v0[0], v0[1]); w.y = cvt_pk_bf16(v0[2], v0[3]); w.z = cvt_pk_bf16(v1[0], v1[1]); w.w = cvt_pk_bf16(v1[2], v1[3]);
                    *(u32x4*)(rowp + bj * HALF) = w; } }
    }
};
struct EpiGlu {
    static constexpr bool PERM = true, AFTER_DRAIN = false;
    const bf16_t* Gy; int ldg; bf16_t* O; int ldc; int coff; const float* bias;
    __device__ __forceinline__ void operator()(const f32x4 (&acc)[2][2][4][2], const Unit& u, int wr, int wc, int fr, int fq) const {
        const int row0 = u.pm * BM + wr * 64 + fr; const int col0 = u.pn * BM + wc * 32 + 8 * fq;
        f32x4 bv[2][2];
#pragma unroll
        for (int bj = 0; bj < 2; ++bj)
#pragma unroll
            for (int n = 0; n < 2; ++n) bv[bj][n] = *(const f32x4*)(bias + col0 + bj * HALF + 4 * n);
#pragma unroll
        for (int ai = 0; ai < 2; ++ai)
#pragma unroll
            for (int m = 0; m < 4; ++m) { const size_t row = (size_t)(row0 + ai * HALF + m * 16);
#pragma unroll
                for (int bj = 0; bj < 2; ++bj) { const f32x4 v0 = acc[ai][bj][m][0] + bv[bj][0], v1 = acc[ai][bj][m][1] + bv[bj][1];
                    const u32x4 g = *(const u32x4*)(Gy + row * ldg + col0 + bj * HALF);
                    float o[8];
                    o[0] = bf_lo(g.x) * __builtin_amdgcn_rcpf(1.f + __builtin_amdgcn_exp2f(-1.4426950408889634f * v0[0])); o[1] = bf_hi(g.x) * __builtin_amdgcn_rcpf(1.f + __builtin_amdgcn_exp2f(-1.4426950408889634f * v0[1]));
                    o[2] = bf_lo(g.y) * __builtin_amdgcn_rcpf(1.f + __builtin_amdgcn_exp2f(-1.4426950408889634f * v0[2])); o[3] = bf_hi(g.y) * __builtin_amdgcn_rcpf(1.f + __builtin_amdgcn_exp2f(-1.4426950408889634f * v0[3]));
                    o[4] = bf_lo(g.z) * __builtin_amdgcn_rcpf(1.f + __builtin_amdgcn_exp2f(-1.4426950408889634f * v1[0])); o[5] = bf_hi(g.z) * __builtin_amdgcn_rcpf(1.f + __builtin_amdgcn_exp2f(-1.4426950408889634f * v1[1]));
                    o[6] = bf_lo(g.w) * __builtin_amdgcn_rcpf(1.f + __builtin_amdgcn_exp2f(-1.4426950408889634f * v1[2])); o[7] = bf_hi(g.w) * __builtin_amdgcn_rcpf(1.f + __builtin_amdgcn_exp2f(-1.4426950408889634f * v1[3]));
                    u32x4 w; w.x = cvt_pk_bf16(o[0], o[1]); w.y = cvt_pk_bf16(o[2], o[3]); w.z = cvt_pk_bf16(o[4], o[5]); w.w = cvt_pk_bf16(o[6], o[7]);
                    *(u32x4*)(O + row * ldc + coff + col0 + bj * HALF) = w; } }
    }
};
template <bool BASE16> struct EpiRes {
    static constexpr bool PERM = true, AFTER_DRAIN = false;
    const void* basep; bf16_t* T; const float* gate  ; const float* bias; float alpha; int MP; float* slab;
    __device__ __forceinline__ void operator()(const f32x4 (&acc)[2][2][4][2], const Unit& u, int wr, int wc, int fr, int fq) const {
        const int row0 = u.pm * BM + wr * 64 + fr, col0 = u.pn * BM + wc * 32 + 8 * fq;
        if (row0 >= MP) {
            float* sp = slab + (size_t)u.ks * 512 * 1024;
#pragma unroll
            for (int ai = 0; ai < 2; ++ai)
#pragma unroll
                for (int m = 0; m < 4; ++m) { float* op = sp + (size_t)(row0 + ai * HALF + m * 16 - MP) * 1024;
#pragma unroll
                    for (int bj = 0; bj < 2; ++bj)
#pragma unroll
                        for (int n = 0; n < 2; ++n) *(f32x4*)(op + col0 + bj * HALF + n * 4) = acc[ai][bj][m][n]; }
            return; }
        f32x4 bv[2][2];
#pragma unroll
        for (int bj = 0; bj < 2; ++bj)
#pragma unroll
            for (int n = 0; n < 2; ++n) bv[bj][n] = bias ? *(const f32x4*)(bias + col0 + bj * HALF + n * 4) : (f32x4){0.f, 0.f, 0.f, 0.f};
        const float* gp = gate + (size_t)(row0 >> 11) * 6144;
#pragma unroll
        for (int ai = 0; ai < 2; ++ai)
#pragma unroll
            for (int m = 0; m < 4; ++m) { const int row = row0 + ai * HALF + m * 16;
                bf16_t* tp = T + (size_t)row * 1024;
#pragma unroll
                for (int bj = 0; bj < 2; ++bj) { const int c = col0 + bj * HALF;
                    f32x4 b0, b1;
                    if (BASE16) { const u32x4 bw = *(const u32x4*)((const bf16_t*)basep + (size_t)row * 1024 + c); b0 = (f32x4){bf_lo(bw.x), bf_hi(bw.x), bf_lo(bw.y), bf_hi(bw.y)}; b1 = (f32x4){bf_lo(bw.z), bf_hi(bw.z), bf_lo(bw.w), bf_hi(bw.w)}; }
                    else { const float* bp = (const float*)basep + (size_t)row * 1024; b0 = *(const f32x4*)(bp + c); b1 = *(const f32x4*)(bp + c + 4); }
                    const f32x4 g0 = *(const f32x4*)(gp + c), g1 = *(const f32x4*)(gp + c + 4);
                    const f32x4 v0 = b0 * alpha + g0 * (acc[ai][bj][m][0] + bv[bj][0]), v1 = b1 * alpha + g1 * (acc[ai][bj][m][1] + bv[bj][1]);
                    u32x4 w; w.x = cvt_pk_bf16(v0[0], v0[1]); w.y = cvt_pk_bf16(v0[2], v0[3]); w.z = cvt_pk_bf16(v1[0], v1[1]); w.w = cvt_pk_bf16(v1[2], v1[3]);
                    *(u32x4*)(tp + c) = w; } }
    }
};

template <class Epi, class Sched, bool ALIGN_EPI = false, bool SP2 = false>
__device__ __forceinline__ void gemm_phase(PG8_LAS unsigned char* lds, const Gemm g, const Sched& S, const Epi& E) {
    const int tid = threadIdx.x, wid = __builtin_amdgcn_readfirstlane(tid >> 6), lane = tid & 63, wr = wid >> 2, wc = wid & 3, fr = lane & 15, fq = lane >> 4;
    const int K = g.K;
    unsigned voffA[2], voffB[2];
#pragma unroll
    for (int i = 0; i < 2; ++i) { int R, C; stage_rc(tid * 16 + i * 8192, R, C); const int Rb = Epi::PERM ? ((R & ~31) + perm32(R & 31)) : R;
        voffA[i] = (unsigned)(R * K + C) * 2u; voffB[i] = (unsigned)(Rb * K + C) * 2u; }
    const size_t kstep = (size_t)(BK * 2);
    const size_t hstep = (size_t)HALF * K * 2;
    const size_t tstep = 2 * hstep;
    const unsigned ldsw = (unsigned)wid * 1024u;
    const int aoff = lds_byte(wr * 64 + fr, fq * 8), boff = lds_byte(wc * 32 + fr, fq * 8);
#define PG8_SA(b, h) (((b) * 2 + (h)) * HTB)
#define PG8_SB(b, h) ((4 + (b) * 2 + (h)) * HTB)
#define PG8_STAGE(bufoff, gbase, voff) do { _Pragma("unroll") for (int _i = 0; _i < 2; ++_i) \
        __builtin_amdgcn_global_load_lds((const unsigned*)((const char*)(gbase) + (voff)[_i]), (PG8_LAS unsigned*)(lds + (bufoff) + ldsw + _i * 8192), 16, 0, 0); } while (0)
#define PG8_LDA(dst, b, h) do { _Pragma("unroll") for (int m = 0; m < 4; ++m) _Pragma("unroll") for (int k = 0; k < 2; ++k) dst[m][k] = *(const PG8_LAS bf16x8*)(lds + PG8_SA(b, h) + aoff + m * 2048 + k * 1024); } while (0)
#define PG8_LDB(dst, b, h) do { _Pragma("unroll") for (int n = 0; n < 2; ++n) _Pragma("unroll") for (int k = 0; k < 2; ++k) dst[n][k] = *(const PG8_LAS bf16x8*)(lds + PG8_SB(b, h) + boff + n * 2048 + k * 1024); } while (0)
#define PG8_MMA(ai, bj, At, Bt) do { __builtin_amdgcn_s_setprio(1); _Pragma("unroll") for (int m = 0; m < 4; ++m) _Pragma("unroll") for (int n = 0; n < 2; ++n) _Pragma("unroll") for (int k = 0; k < 2; ++k) \
        acc[ai][bj][m][n] = __builtin_amdgcn_mfma_f32_16x16x32_bf16(Bt[n][k], At[m][k], acc[ai][bj][m][n], 0, 0, 0); __builtin_amdgcn_s_setprio(0); } while (0)
#define PG8_WAIT_V(n) asm volatile("s_waitcnt vmcnt(" #n ")" ::: "memory")
#define PG8_WAIT_L(n) asm volatile("s_waitcnt lgkmcnt(" #n ")" ::: "memory")
#define PG8_BAR __builtin_amdgcn_s_barrier()
#define PG8_SCHED __builtin_amdgcn_sched_barrier(0)
    Unit cur, nxt; int ui = 0;
    if (!S.next(0, cur)) return;
    f32x4 acc[2][2][4][2];
#pragma unroll
    for (int a = 0; a < 2; ++a)
#pragma unroll
        for (int b = 0; b < 2; ++b)
#pragma unroll
            for (int m = 0; m < 4; ++m)
#pragma unroll
                for (int n = 0; n < 2; ++n) acc[a][b][m][n] = (f32x4){0.f, 0.f, 0.f, 0.f};
    bf16x8 At[4][2], B0[2][2], B1[2][2];
    const char* cA = (const char*)g.A + (size_t)cur.pm * tstep + (size_t)cur.k0 * 2; const char* cB = (const char*)g.Bt + (size_t)cur.pn * tstep + (size_t)cur.k0 * 2;
    S.a_ready(cur);
    if constexpr (SP2) {
        PG8_STAGE(PG8_SB(0, 0), cB, voffB); PG8_STAGE(PG8_SB(0, 1), cB + hstep, voffB); PG8_STAGE(PG8_SA(0, 0), cA, voffA); PG8_STAGE(PG8_SA(0, 1), cA + hstep, voffA);
        if (wr == 1) PG8_BAR;
        PG8_WAIT_V(2); PG8_BAR;
        PG8_STAGE(PG8_SB(1, 0), cB + kstep, voffB); PG8_STAGE(PG8_SA(1, 0), cA + kstep, voffA); PG8_STAGE(PG8_SB(1, 1), cB + hstep + kstep, voffB);
        PG8_WAIT_V(6); PG8_BAR;
    } else {
        PG8_STAGE(PG8_SB(0, 0), cB, voffB); PG8_STAGE(PG8_SA(0, 0), cA, voffA); PG8_STAGE(PG8_SB(0, 1), cB + hstep, voffB); PG8_STAGE(PG8_SA(0, 1), cA + hstep, voffA);
        if (wr == 1) PG8_BAR;
        PG8_WAIT_V(4); PG8_BAR;
        PG8_STAGE(PG8_SB(1, 0), cB + kstep, voffB); PG8_STAGE(PG8_SA(1, 0), cA + kstep, voffA); PG8_STAGE(PG8_SB(1, 1), cB + hstep + kstep, voffB);
        PG8_WAIT_V(6); PG8_BAR;
    }
    for (;;) {
        const bool has_next = S.next(ui + 1, nxt);
        const char* nA = has_next ? (const char*)g.A + (size_t)nxt.pm * tstep + (size_t)nxt.k0 * 2 : cA; const char* nB = has_next ? (const char*)g.Bt + (size_t)nxt.pn * tstep + (size_t)nxt.k0 * 2 : cB;
        const int nt = cur.nkt;
        for (int t = 0; t < nt; t += 2) {
            const bool last = (t == nt - 2);
            const char* a1 = cA + (size_t)(t + 1) * kstep;
            const char* a2 = last ? nA : cA + (size_t)(t + 2) * kstep; const char* b2 = last ? nB : cB + (size_t)(t + 2) * kstep;
            const char* a3 = a2 + kstep; const char* b3 = b2 + kstep;
            if (last && has_next) S.a_ready(nxt);
            if constexpr (SP2) {
            PG8_LDB(B0, 0, 0); PG8_LDB(B1, 0, 1); PG8_SCHED; PG8_LDA(At, 0, 0); PG8_STAGE(PG8_SA(1, 1), a1 + hstep, voffA);
            PG8_WAIT_V(8); PG8_WAIT_L(0); PG8_BAR; PG8_MMA(0, 0, At, B0); PG8_MMA(0, 1, At, B1); PG8_BAR; PG8_SCHED;
            PG8_LDA(At, 0, 1); PG8_STAGE(PG8_SB(0, 0), b2, voffB); PG8_STAGE(PG8_SB(0, 1), b2 + hstep, voffB); PG8_STAGE(PG8_SA(0, 0), a2, voffA);
            PG8_WAIT_V(8); PG8_WAIT_L(0); PG8_BAR; PG8_MMA(1, 0, At, B0); PG8_MMA(1, 1, At, B1); PG8_BAR; PG8_SCHED;
            PG8_LDB(B0, 1, 0); PG8_LDB(B1, 1, 1); PG8_SCHED; PG8_LDA(At, 1, 0); PG8_STAGE(PG8_SA(0, 1), a2 + hstep, voffA);
            PG8_WAIT_V(8); PG8_WAIT_L(0); PG8_BAR; PG8_MMA(0, 0, At, B0); PG8_MMA(0, 1, At, B1); PG8_BAR; PG8_SCHED;
            PG8_LDA(At, 1, 1); PG8_STAGE(PG8_SB(1, 0), b3, voffB); PG8_STAGE(PG8_SB(1, 1), b3 + hstep, voffB); PG8_STAGE(PG8_SA(1, 0), a3, voffA);
            PG8_WAIT_V(8); PG8_WAIT_L(0); PG8_BAR; PG8_MMA(1, 0, At, B0); PG8_MMA(1, 1, At, B1); PG8_BAR; PG8_SCHED;
            } else {
            PG8_LDB(B0, 0, 0); PG8_SCHED; PG8_LDA(At, 0, 0); PG8_STAGE(PG8_SA(1, 1), a1 + hstep, voffA);
            PG8_WAIT_L(8); PG8_BAR; PG8_WAIT_L(0); PG8_MMA(0, 0, At, B0); PG8_BAR; PG8_SCHED;
            PG8_LDB(B1, 0, 1); PG8_STAGE(PG8_SB(0, 0), b2, voffB);
            PG8_BAR; PG8_WAIT_L(0); PG8_MMA(0, 1, At, B1); PG8_BAR;
            PG8_LDA(At, 0, 1); PG8_STAGE(PG8_SA(0, 0), a2, voffA);
            PG8_BAR; PG8_WAIT_L(0); PG8_MMA(1, 0, At, B0); PG8_BAR; PG8_SCHED;
            PG8_STAGE(PG8_SB(0, 1), b2 + hstep, voffB);
            PG8_WAIT_V(6); PG8_BAR; PG8_MMA(1, 1, At, B1); PG8_BAR;
            PG8_LDB(B0, 1, 0); PG8_SCHED; PG8_LDA(At, 1, 0); PG8_STAGE(PG8_SA(0, 1), a2 + hstep, voffA);
            PG8_WAIT_L(8); PG8_BAR; PG8_WAIT_L(0); PG8_MMA(0, 0, At, B0); PG8_BAR; PG8_SCHED;
            PG8_LDB(B1, 1, 1); PG8_STAGE(PG8_SB(1, 0), b3, voffB);
            PG8_BAR; PG8_WAIT_L(0); PG8_MMA(0, 1, At, B1); PG8_BAR;
            PG8_LDA(At, 1, 1); PG8_STAGE(PG8_SA(1, 0), a3, voffA);
            PG8_BAR; PG8_WAIT_L(0); PG8_MMA(1, 0, At, B0); PG8_BAR; PG8_SCHED;
            PG8_STAGE(PG8_SB(1, 1), b3 + hstep, voffB);
            PG8_WAIT_V(6); PG8_BAR; PG8_MMA(1, 1, At, B1); PG8_BAR;
            }
        }
        if constexpr (ALIGN_EPI) { if (wr == 0) PG8_BAR; }
        if constexpr (!Epi::AFTER_DRAIN) { E(acc, cur, wr, wc, fr, fq); S.done(cur); }
        if (!has_next) break;
#pragma unroll
        for (int a = 0; a < 2; ++a)
#pragma unroll
            for (int b = 0; b < 2; ++b)
#pragma unroll
                for (int m = 0; m < 4; ++m)
#pragma unroll
                    for (int n = 0; n < 2; ++n) acc[a][b][m][n] = (f32x4){0.f, 0.f, 0.f, 0.f};
        cur = nxt; cA = nA; cB = nB; ++ui;
        if constexpr (ALIGN_EPI) { if (wr == 1) PG8_BAR; }
    }
    PG8_WAIT_V(0);
    if constexpr (!ALIGN_EPI) { if (wr == 0) PG8_BAR; }
    PG8_BAR;
#undef PG8_SA
#undef PG8_SB
#undef PG8_STAGE
#undef PG8_LDA
#undef PG8_LDB
#undef PG8_MMA
#undef PG8_WAIT_V
#undef PG8_WAIT_L
#undef PG8_BAR
#undef PG8_SCHED
}
}

#ifndef PROBE_DUP
#define PROBE_DUP 0
#endif
#ifndef PG8_SP2
#define PG8_SP2 true
#endif
#ifndef PG8_ALIGN
#define PG8_ALIGN true
#endif

constexpr int NWAVES = 8;
constexpr int N_LAUNCHES = MK_N_LAUNCHES;
constexpr int N_PHASES = 10;
constexpr int D = 1024, MP = 16384, MS = 512, M = MP + MS, TP = 2048, NBP = 8, NBS = 128, TS = 4;
constexpr int NZ = 1536, WA = 512, WB = 512, FF = 4096, NMOD = 6 * D, NROWMOD = NBP + NBS;
constexpr int GB = 32, NS5 = 64, KS5 = 16, HA = 8, HDA = 64;
constexpr float LN_EPS = 1e-5f;
constexpr int NS_OUT = 4, NS_DOWN = 8;
constexpr float ALPHA = 1.189207115002721f;

constexpr size_t O_YP = 0, O_YS = (size_t)MP * D, O_CONVP = O_YS + (size_t)MS * D, O_HP = O_CONVP + (size_t)NBP * 3 * WA, O_SRP = O_HP + (size_t)NBP * WA,
                 O_SIP = O_SRP + (size_t)NBP * GB * NS5, O_CONVS = O_SIP + (size_t)NBP * GB * NS5, O_HS = O_CONVS + (size_t)NBS * 3 * WA, O_SRS = O_HS + (size_t)NBS * WA,
                 O_SIS = O_SRS + (size_t)NBS * GB * NS5, O_END = O_SIS + (size_t)NBS * GB * NS5;

constexpr size_t MiB = 1u << 20;
constexpr size_t WS_CTL = 0, CTL_ZERO_BYTES = 1 * MiB;
constexpr size_t WS_WIN = 1 * MiB, WS_WGLU = 4 * MiB, WS_WOUT = 5 * MiB, WS_W1 = 7 * MiB, WS_W2 = 15 * MiB;
constexpr size_t WS_MOD = 23 * MiB;
constexpr size_t WS_S5C = 27 * MiB;
constexpr size_t WS_XN = 28 * MiB;
constexpr size_t WS_Z = 61 * MiB;
constexpr size_t WS_YCAT = 111 * MiB;
constexpr size_t WS_G = 144 * MiB;
constexpr size_t WS_U = 61 * MiB;
constexpr size_t WS_T1 = WS_Z;
constexpr size_t WS_T2 = WS_XN;
constexpr size_t WS_TAB = 194 * MiB;
constexpr size_t WS_SLAB = 196 * MiB;
constexpr size_t WS_X1B = 212 * MiB;
constexpr size_t WS_END = 246 * MiB;
constexpr size_t TB_BF1 = 0, TB_BF2 = TB_BF1 + 32 * 4 * 64 * 16, TB_TA = TB_BF2 + 32 * 8 * 64 * 16, TB_ZP = TB_TA + 32 * 2 * 2 * 32 * 4, TB_Z16N = TB_ZP + 32 * 17 * 2 * 2 * 32 * 4,
                 TB_RG = TB_Z16N + 32 * 2 * 64 * 4, TB_CB = TB_RG + 8 * 2 * 2 * 4 * 64 * 16, TB_SILU = TB_CB + 128 * 3 * 512 * 2, TB_DG = TB_SILU + 160 * 1024 * 2, TB_END = TB_DG + 8 * 16 * 64 * 16;
static_assert(WS_TAB + TB_END <= WS_SLAB, "tables");
static_assert(WS_XN + (size_t)M * D * 2 <= WS_Z && WS_Z + (size_t)M * NZ * 2 <= WS_YCAT && WS_YCAT + (size_t)M * D * 2 <= WS_G && WS_G + (size_t)M * WB * 2 <= WS_END && WS_U + (size_t)M * FF * 2 <= WS_TAB, "d_ws map");
constexpr int SC_ABR = 0, SC_ABI = 2048, SC_BBR = 4096, SC_BBI = 4096 + 32768, SC_RGL = 4096 + 65536, SC_END = SC_RGL + 512;
constexpr int CW_TMO = 0, CW_CODE = 1, CW_SILU = 64, CW_BAR = 4096;

constexpr int RING_OFF = 0, RING_BYTES = 131072;
constexpr int LDSCTL_OFF = RING_BYTES, MISC_OFF = LDSCTL_OFF + 320;
constexpr int LDS_BYTES = 147456;

#define GAS __attribute__((address_space(1)))
#define LAS __attribute__((address_space(3)))
typedef unsigned short bf16;
typedef unsigned v4u __attribute__((ext_vector_type(4)));
typedef float f32x4 __attribute__((ext_vector_type(4)));
typedef GAS unsigned gu32;
#define RLX_AGENT __ATOMIC_RELAXED, __HIP_MEMORY_SCOPE_AGENT
#define LDS_WAIT() asm volatile("s_waitcnt lgkmcnt(0)" ::: "memory")
#define VM_WAIT() asm volatile("s_waitcnt vmcnt(0)" ::: "memory")
__device__ __forceinline__ unsigned f2bf(float f) { unsigned u = __builtin_bit_cast(unsigned, f); return (u + 0x7fffu + ((u >> 16) & 1u)) >> 16; }
__device__ __forceinline__ unsigned pk2(float lo, float hi) { return f2bf(lo) | (f2bf(hi) << 16); }
__device__ __forceinline__ float bf2f(bf16 v) { return __builtin_bit_cast(float, (unsigned)v << 16); }
__device__ __forceinline__ float gelu_tanh(float x) { const float t = -2.3022082f * (x + 0.044715f * x * x * x); return x * __builtin_amdgcn_rcpf(1.f + __builtin_amdgcn_exp2f(t)); }
__device__ __forceinline__ float sigmoidf_(float x) { return __builtin_amdgcn_rcpf(1.f + __builtin_amdgcn_exp2f(-1.4426950408889634f * x)); }

#define XB_TMO      128
#define XB_XCNT(j)  (256  + 64 * (j))
#define XB_XSUB(j)  (1280 + 64 * (j))
#define XB_XGEN(j)  (2304 + 64 * (j))
#define XB_TOP      3328
#define XB_TOPGEN   3392
#define XCD_BAR_WORDS 3456
#define XB_SPIN_CAP (1u << 18)
__device__ __forceinline__ unsigned xb_ld(unsigned* p)              { return __hip_atomic_load(p, __ATOMIC_RELAXED, __HIP_MEMORY_SCOPE_AGENT); }
__device__ __forceinline__ unsigned xb_add(unsigned* p, unsigned v) { return __hip_atomic_fetch_add(p, v, __ATOMIC_RELAXED, __HIP_MEMORY_SCOPE_AGENT); }
__device__ __forceinline__ unsigned xb_xcc_id() { return (unsigned)__builtin_amdgcn_s_getreg((3 << 11) | 20) & 0xFu; }
#define XB_SPIN(cond, bar) do { unsigned _sp = 0; while (cond) { __builtin_amdgcn_s_sleep(1); \
    if ((++_sp & 255u) == 0u) { if (xb_ld(&(bar)[XB_TMO])) break; if (_sp > XB_SPIN_CAP) { atomicAdd(&(bar)[XB_TMO], 1u); break; } } } } while (0)
struct XcdBarrier { unsigned* bar; unsigned x; volatile LAS unsigned* st; };
__device__ __forceinline__ XcdBarrier xcd_barrier_post(unsigned* bar, volatile LAS unsigned* st) {
    XcdBarrier b; b.bar = bar; b.x = xb_xcc_id(); b.st = st;
    if (threadIdx.x == 0) (void)xb_add(&bar[XB_XCNT(b.x)], 1u);
    return b;
}
__device__ __forceinline__ void xcd_barrier_complete(unsigned* bar, unsigned x, unsigned& nloc, unsigned& nx) {
    const unsigned G = gridDim.x * gridDim.y * gridDim.z;
    unsigned sum, cnt, mine, sp = 0u;
    for (;;) {
        sum = 0u; cnt = 0u; mine = 0u;
#pragma unroll
        for (unsigned j = 0; j < 16; ++j) { const unsigned c = xb_ld(&bar[XB_XCNT(j)]); sum += c; cnt += (c > 0u) ? 1u : 0u; mine = (j == x) ? c : mine; }
        if (sum == G) break;
        __builtin_amdgcn_s_sleep(1);
        if ((++sp & 255u) == 0u) { if (xb_ld(&bar[XB_TMO])) break; if (sp > XB_SPIN_CAP) { atomicAdd(&bar[XB_TMO], 1u); break; } }
    }
    nloc = mine > 0u ? mine : 1u; nx = cnt > 0u ? cnt : 1u;
}
__device__ __forceinline__ void xcd_barrier(const XcdBarrier& b) {
    asm volatile("s_waitcnt vmcnt(0)" ::: "memory");
    __syncthreads();
    if (threadIdx.x == 0) {
        unsigned* bar = b.bar;
        __builtin_amdgcn_s_waitcnt(0);
        unsigned nloc = b.st[0], nx = b.st[1];
        if (nloc == 0u) { xcd_barrier_complete(bar, b.x, nloc, nx); b.st[0] = nloc; b.st[1] = nx; }
        const unsigned old = xb_add(&bar[XB_XSUB(b.x)], 1u);
        const unsigned gen = old / nloc;
        if (old + 1u == (gen + 1u) * nloc) {
            __builtin_amdgcn_fence(__ATOMIC_RELEASE, "agent");
            asm volatile("s_waitcnt vmcnt(0)" ::: "memory");
            const unsigned og = xb_add(&bar[XB_TOP], 1u);
            const unsigned tg = og / nx;
            if (og + 1u == (tg + 1u) * nx) xb_add(&bar[XB_TOPGEN], 1u);
            else XB_SPIN(xb_ld(&bar[XB_TOPGEN]) == tg, bar);
            __builtin_amdgcn_fence(__ATOMIC_ACQUIRE, "agent");
            xb_add(&bar[XB_XGEN(b.x)], 1u);
            asm volatile("s_waitcnt vmcnt(0)" ::: "memory");
        } else {
            XB_SPIN(xb_ld(&bar[XB_XGEN(b.x)]) == gen, bar);
            __builtin_amdgcn_fence(__ATOMIC_ACQUIRE, "agent");
            asm volatile("s_waitcnt vmcnt(0)" ::: "memory");
        }
    }
    __syncthreads();
}

struct Frame {
    LAS unsigned char* lds;
    volatile LAS unsigned* MISC;
    gu32* ctl;
    int tid, lane, wave;
    int vcu, G;
    float* out;
    unsigned char* ws;
};
struct Args { const float* in[37]; float* out; unsigned char* ws; int ph_lo, ph_hi, li, pad; };
__device__ __forceinline__ void refresh(Frame& F) { int t = threadIdx.x; asm volatile("" : "+v"(t)); F.tid = t; F.lane = t & 63; F.wave = __builtin_amdgcn_readfirstlane(t >> 6); }
__device__ __forceinline__ float wave_sum(float v) {
#pragma unroll
    for (int o = 1; o < 64; o <<= 1) v += __shfl_xor(v, o);
    return v;
}
enum { I_XP = 0, I_XS, I_SCONV, I_SH, I_SSR, I_SSI, I_CP, I_CS, I_ADAW, I_ADAB, I_INPROJ, I_CONVW, I_CONVB, I_RGWR, I_RGBR, I_RGWI, I_RGBI, I_RGLAM,
       I_S5ARE, I_S5AIM, I_S5LOGDT, I_S5BRE, I_S5BIM, I_S5CRE, I_S5CIM, I_S5D, I_GLUW, I_GLUB, I_OUTPROJ, I_LN1G, I_LN1B, I_W1, I_B1, I_W2, I_B2, I_LN2G, I_LN2B };

typedef float f32x2m __attribute__((ext_vector_type(2)));
typedef __bf16 bf16x2m __attribute__((ext_vector_type(2)));
__device__ __forceinline__ unsigned pkbf0(float a, float b) { const f32x2m v = {a, b}; const bf16x2m r = __builtin_convertvector(v, bf16x2m); return __builtin_bit_cast(unsigned, r); }
typedef short bf16x8m __attribute__((ext_vector_type(8)));
typedef float f32x16m __attribute__((ext_vector_type(16)));
__device__ __forceinline__ void p0_transpose_item(const float* W, int K, int N, bf16* WT, LAS float* scr, int item, int lane) {
    const int nblk = N / 32, kb = item / nblk, nb = item % nblk, k0 = 64 * kb, n0 = 32 * nb;
#pragma unroll 8
    for (int i = 0; i < 32; ++i) { const int kk = 2 * i + (lane >> 5); scr[kk * 33 + (lane & 31)] = W[(size_t)(k0 + kk) * N + n0 + (lane & 31)]; }
    LDS_WAIT(); asm volatile("" ::: "memory");
    const int c = lane & 7;
#pragma unroll
    for (int j = 0; j < 4; ++j) { const int n = (lane >> 3) + 8 * j; const LAS float* s = scr + (8 * c) * 33 + n;
        v4u o; o.x = pk2(s[0 * 33], s[1 * 33]); o.y = pk2(s[2 * 33], s[3 * 33]); o.z = pk2(s[4 * 33], s[5 * 33]); o.w = pk2(s[6 * 33], s[7 * 33]);
        *(GAS v4u*)(WT + (size_t)(n0 + n) * K + k0 + 8 * c) = o; }
    LDS_WAIT(); asm volatile("" ::: "memory");
}

constexpr int XI_IN = (D / 64) * (NZ / 32), XI_GL = (WB / 64) * (WB / 32), XI_OU = (D / 64) * (D / 32), XI_1 = (D / 64) * (FF / 32), XI_2 = (FF / 64) * (D / 32);
constexpr int XO_OU = XI_IN + XI_GL, XO_1 = XO_OU + XI_OU, XO_2 = XO_1 + XI_1, XO_END = XO_2 + XI_2;
__device__ __forceinline__ void xpose_item(Frame& F, const Args& A, LAS float* scr, int r) {
    if (r < XI_IN) { p0_transpose_item(A.in[I_INPROJ], D, NZ, (bf16*)(F.ws + WS_WIN), scr, r, F.lane); return; } r -= XI_IN;
    if (r < XI_GL) { p0_transpose_item(A.in[I_GLUW], WB, WB, (bf16*)(F.ws + WS_WGLU), scr, r, F.lane); return; } r -= XI_GL;
    if (r < XI_OU) { p0_transpose_item(A.in[I_OUTPROJ], D, D, (bf16*)(F.ws + WS_WOUT), scr, r, F.lane); return; } r -= XI_OU;
    if (r < XI_1) { p0_transpose_item(A.in[I_W1], D, FF, (bf16*)(F.ws + WS_W1), scr, r, F.lane); return; } r -= XI_1;
    p0_transpose_item(A.in[I_W2], FF, D, (bf16*)(F.ws + WS_W2), scr, r, F.lane);
}
__device__ __forceinline__ void xpose_range(Frame& F, const Args& A, int lo, int hi, int vlo) {
    refresh(F);
    if (F.vcu < vlo) return;
    LAS float* scr = (LAS float*)(F.lds + RING_OFF + F.wave * 16384);
    const int gw = F.wave * (F.G - vlo) + (F.vcu - vlo), ngw = (F.G - vlo) * NWAVES;
    for (int it = lo + gw; it < hi; it += ngw) xpose_item(F, A, scr, it);
}
__device__ __forceinline__ void xpose_range_b(Frame& F, const Args& A, int lo, int hi, int blo) {
    refresh(F);
    LAS float* scr = (LAS float*)(F.lds + RING_OFF + F.wave * 16384);
    const int gw = F.wave * (F.G - blo) + ((int)blockIdx.x - blo), ngw = (F.G - blo) * NWAVES;
    for (int it = lo + gw; it < hi; it += ngw) xpose_item(F, A, scr, it);
}
#ifndef PROBE_P0PART
#define PROBE_P0PART 7
#endif
__device__ __forceinline__ void p0_prologue(Frame& F, const Args& A, int rep = 0) {
    refresh(F);
    const int pmask = rep ? PROBE_P0PART : 7;
    LAS float* scr = (LAS float*)(F.lds + RING_OFF + F.wave * 16384);
    const int gw = F.wave * F.G + F.vcu, NGW = F.G * NWAVES;
    {
        bf16* ST = (bf16*)(F.ws + WS_TAB + TB_SILU);
        for (int ch = F.vcu * NWAVES * 64 + F.tid; ch < 160 * 1024 / 8; ch += F.G * NWAVES * 64) { const int row = ch >> 7, k = (ch & 127) * 8; v4u o = (v4u){0u, 0u, 0u, 0u};
            if (row < NROWMOD) { const float* cp = (row < NBP ? A.in[I_CP] + (size_t)row * D : A.in[I_CS] + (size_t)(row - NBP) * D) + k; const f32x4 c0 = *(const f32x4*)cp, c1 = *(const f32x4*)(cp + 4);
                o.x = pk2(c0[0] * sigmoidf_(c0[0]), c0[1] * sigmoidf_(c0[1])); o.y = pk2(c0[2] * sigmoidf_(c0[2]), c0[3] * sigmoidf_(c0[3]));
                o.z = pk2(c1[0] * sigmoidf_(c1[0]), c1[1] * sigmoidf_(c1[1])); o.w = pk2(c1[2] * sigmoidf_(c1[2]), c1[3] * sigmoidf_(c1[3])); }
            *(v4u*)(ST + (size_t)ch * 8) = o; }
        VM_WAIT(); __syncthreads();
        if (F.tid == 0) { __builtin_amdgcn_fence(__ATOMIC_RELEASE, "agent"); VM_WAIT(); (void)__hip_atomic_fetch_add((unsigned*)(F.ctl + CW_SILU), 1u, RLX_AGENT); }
    }
    constexpr int I_IN = XI_IN, I_GL = XI_GL;
    constexpr int I_S5 = GB, I_RG = WA / 64, I_RGT = HA * 2 * 2 * 4, I_CB = NBS * 3 * WA / 512, I_DG = HA * 16;
    constexpr int NITEMS = I_IN + I_GL + I_S5 + I_RG + I_RGT + I_CB + I_DG;
    float* sc = (float*)(F.ws + WS_S5C);
    for (int it = gw; it < NITEMS; it += NGW) {
        int r = it;
        if (!(pmask & 1) && it < I_IN + I_GL) continue;
        if (!(pmask & 2) && it >= I_IN + I_GL) continue;
        if (r < I_IN + I_GL) { xpose_item(F, A, scr, r); continue; } r -= I_IN + I_GL;
        if (r < I_S5) {
            const int g = r, n = F.lane, gn = g * NS5 + n;
            const double dt = exp((double)A.in[I_S5LOGDT][g]), ar = (double)A.in[I_S5ARE][gn], ai = (double)A.in[I_S5AIM][gn];
            const double mag = exp(dt * ar), abr = mag * cos(dt * ai), abi = mag * sin(dt * ai), den = ar * ar + ai * ai, nr = abr - 1.0;
            const double qr = (nr * ar + abi * ai) / den, qi = (abi * ar - nr * ai) / den;
            sc[SC_ABR + gn] = (float)abr; sc[SC_ABI + gn] = (float)abi;
            unsigned char* tab = F.ws + WS_TAB;
            bf16* BF1 = (bf16*)(tab + TB_BF1); bf16* BF2 = (bf16*)(tab + TB_BF2); float* TA = (float*)(tab + TB_TA); float* ZP = (float*)(tab + TB_ZP); float* Z16N = (float*)(tab + TB_Z16N);
            const int sh = n >> 5, v = n & 31, hh = (v >> 2) & 1, ii = (v & 3) + 4 * (v >> 3);
            for (int k = 0; k < KS5; ++k) { const double br = (double)A.in[I_S5BRE][gn * KS5 + k], bi = (double)A.in[I_S5BIM][gn * KS5 + k];
                const float vr = (float)(qr * br - qi * bi), vi = (float)(qr * bi + qi * br);
                sc[SC_BBR + gn * KS5 + k] = vr; sc[SC_BBI + gn * KS5 + k] = vi;
                const int lp = (n & 31) + 32 * (k >> 3), jj = k & 7;
                BF1[(size_t)((g * 4 + 0 + sh) * 64 + lp) * 8 + jj] = (bf16)f2bf(vr); BF1[(size_t)((g * 4 + 2 + sh) * 64 + lp) * 8 + jj] = (bf16)f2bf(vi); }
            { const int s2 = (n >> 4) & 1, jj = 4 * ((n >> 3) & 1) + (n & 3), hk = (n >> 2) & 1;
              for (int ch = 0; ch < KS5; ++ch) { const int hr_ = ch >> 3, i8 = ch & 7, R = (i8 & 3) + 8 * (i8 >> 2) + 4 * hr_, lp = R + 32 * hk;
                  const float cr = A.in[I_S5CRE][(size_t)(g * KS5 + ch) * NS5 + n], ci = A.in[I_S5CIM][(size_t)(g * KS5 + ch) * NS5 + n];
                  BF2[(size_t)((g * 8 + (0 + sh) * 2 + s2) * 64 + lp) * 8 + jj] = (bf16)f2bf(cr); BF2[(size_t)((g * 8 + (2 + sh) * 2 + s2) * 64 + lp) * 8 + jj] = (bf16)f2bf(-ci); }
              for (int z = 0; z < 4; ++z) { const int cidx = n + 64 * z, ks = cidx >> 5, r16 = cidx & 31, lp = 16 + (r16 & 15) + 32 * (r16 >> 4);
                  *(v4u*)(BF2 + (size_t)((g * 8 + ks) * 64 + lp) * 8) = (v4u){0u, 0u, 0u, 0u}; } }
            TA[((g * 2 + hh) * 2 + 0) * 32 + sh * 16 + ii] = (float)abr; TA[((g * 2 + hh) * 2 + 1) * 32 + sh * 16 + ii] = (float)abi;
            const double mg8 = exp(8.0 * dt * ar), z1r = mg8 * cos(8.0 * dt * ai), z1i = mg8 * sin(8.0 * dt * ai); double pzr = 1.0, pzi = 0.0;
            for (int e = 0; e <= 16; ++e) { const float zr = (float)pzr, zi = (float)pzi; { const double nr2 = pzr * z1r - pzi * z1i, ni2 = pzr * z1i + pzi * z1r; pzr = nr2; pzi = ni2; }
                ZP[(((g * 17 + e) * 2 + hh) * 2 + 0) * 32 + sh * 16 + ii] = zr; ZP[(((g * 17 + e) * 2 + hh) * 2 + 1) * 32 + sh * 16 + ii] = zi;
                if (e == 16) { Z16N[(g * 2 + 0) * 64 + n] = zr; Z16N[(g * 2 + 1) * 64 + n] = zi; } }
            continue; } r -= I_S5;
        if (r < I_RG) { const int c = r * 64 + F.lane; const double lam = (double)A.in[I_RGLAM][c];
          sc[SC_RGL + c] = (float)(-8.0 * log1p(exp(-lam)) * 1.4426950408889634); continue; } r -= I_RG;
        if (r >= I_RGT + I_CB) { r -= I_RGT + I_CB;
            const int k = r & 3, sp = (r >> 2) & 1, tau = (r >> 3) & 1, hd = r >> 4, R = F.lane & 31, hk = F.lane >> 5;
            unsigned wv = 0u; if ((R >> 3) == 2 * sp + hk) wv = f2bf(A.in[I_CONVW][k * WA + hd * 64 + 32 * tau + R]);
            const int jj = R & 7; v4u o = (v4u){0u, 0u, 0u, 0u}; const unsigned word = (jj & 1) ? (wv << 16) : wv;
            if ((jj >> 1) == 0) o.x = word; else if ((jj >> 1) == 1) o.y = word; else if ((jj >> 1) == 2) o.z = word; else o.w = word;
            *(v4u*)(F.ws + WS_TAB + TB_DG + (size_t)(r * 64 + F.lane) * 16) = o; continue; }
        if (r >= I_RGT) { r -= I_RGT;
            const float* src = A.in[I_SCONV] + (size_t)r * 512 + F.lane * 8; const f32x4 a0 = *(const f32x4*)src, a1 = *(const f32x4*)(src + 4);
            v4u o; o.x = pk2(a0[0], a0[1]); o.y = pk2(a0[2], a0[3]); o.z = pk2(a1[0], a1[1]); o.w = pk2(a1[2], a1[3]);
            *(v4u*)(F.ws + WS_TAB + TB_CB + ((size_t)r * 512 + F.lane * 8) * 2) = o; continue; }
        {
            const int ks = r & 3, gate = (r >> 2) & 1, jh = (r >> 3) & 1, hd = r >> 4;
            const int R = F.lane & 31, hk = F.lane >> 5;
            const float* W = A.in[gate ? I_RGWI : I_RGWR] + (size_t)(hd * 64 + 32 * (ks >> 1) + 16 * (ks & 1) + 4 * hk) * 64 + 32 * jh + R;
            v4u o; o.x = pk2(W[0], W[64]); o.y = pk2(W[128], W[192]); o.z = pk2(W[8 * 64], W[9 * 64]); o.w = pk2(W[10 * 64], W[11 * 64]);
            *(v4u*)(F.ws + WS_TAB + TB_RG + (size_t)(r * 64 + F.lane) * 16) = o;
        }
    }
    __syncthreads();
    if (F.tid == 0) {
        unsigned sp = 0; while (__hip_atomic_load((unsigned*)(F.ctl + CW_SILU), RLX_AGENT) < (unsigned)F.G * (unsigned)(rep + 1) && ++sp < (1u << 22)) __builtin_amdgcn_s_sleep(2);
        __builtin_amdgcn_fence(__ATOMIC_ACQUIRE, "agent"); VM_WAIT(); }
    __syncthreads();
    LAS float* RED = (LAS float*)(F.lds + RING_OFF);
    float* mod = (float*)(F.ws + WS_MOD);
    const int r32 = F.lane & 31, hh = F.lane >> 5;
    const bf16* ST = (const bf16*)(F.ws + WS_TAB + TB_SILU);
#pragma unroll 1
    for (int it = F.vcu; it < ((pmask & 4) ? NMOD / 32 : 0); it += F.G) {
        const int n0 = it * 32;
        f32x16m acc[5];
#pragma unroll
        for (int rt = 0; rt < 5; ++rt)
#pragma unroll
            for (int i = 0; i < 16; ++i) acc[rt][i] = 0.f;
#pragma unroll 1
        for (int kb = 0; kb < 4; ++kb) {
            float bw[2][8]; v4u af[2][5];
#pragma unroll
            for (int ks = 0; ks < 2; ++ks) { const int k0 = F.wave * 128 + (kb * 2 + ks) * 16 + 8 * hh;
                const float* wp = A.in[I_ADAW] + (size_t)k0 * NMOD + n0 + r32;
#pragma unroll
                for (int j = 0; j < 8; ++j) bw[ks][j] = wp[(size_t)j * NMOD];
#pragma unroll
                for (int rt = 0; rt < 5; ++rt) af[ks][rt] = *(const v4u*)(ST + (size_t)(32 * rt + r32) * D + k0); }
#pragma unroll
            for (int ks = 0; ks < 2; ++ks) {
                v4u bp; bp.x = pkbf0(bw[ks][0], bw[ks][1]); bp.y = pkbf0(bw[ks][2], bw[ks][3]); bp.z = pkbf0(bw[ks][4], bw[ks][5]); bp.w = pkbf0(bw[ks][6], bw[ks][7]);
                const bf16x8m bfr = __builtin_bit_cast(bf16x8m, bp);
#pragma unroll
                for (int rt = 0; rt < 5; ++rt) acc[rt] = __builtin_amdgcn_mfma_f32_32x32x16_bf16(__builtin_bit_cast(bf16x8m, af[ks][rt]), bfr, acc[rt], 0, 0, 0); }
        }
#pragma unroll
        for (int half = 4; half >= 1; half >>= 1) {
            if (F.wave >= half && F.wave < 2 * half) {
#pragma unroll
                for (int rt = 0; rt < 5; ++rt)
#pragma unroll
                    for (int i = 0; i < 16; ++i) RED[(F.wave - half) * 5120 + (rt * 16 + i) * 64 + F.lane] = acc[rt][i]; }
            __syncthreads();
            if (F.wave < half) {
#pragma unroll
                for (int rt = 0; rt < 5; ++rt)
#pragma unroll
                    for (int i = 0; i < 16; ++i) acc[rt][i] += RED[F.wave * 5120 + (rt * 16 + i) * 64 + F.lane]; }
            __syncthreads();
        }
        if (F.wave == 0) { const float bb = A.in[I_ADAB][n0 + r32];
#pragma unroll
            for (int rt = 0; rt < 5; ++rt)
#pragma unroll
                for (int i = 0; i < 16; ++i) { const int row = 32 * rt + (i & 3) + 8 * (i >> 2) + 4 * hh; if (row < NROWMOD) mod[(size_t)row * NMOD + n0 + r32] = acc[rt][i] + bb; } }
    }
}

__device__ __forceinline__ int mod_row(int m) { return m < MP ? (m >> 11) : NBP + ((m - MP) >> 2); }
__device__ __forceinline__ const float* x_row(const Args& A, int m) { return m < MP ? A.in[I_XP] + (size_t)m * D : A.in[I_XS] + (size_t)(m - MP) * D; }

__device__ __forceinline__ void p1_modulate(Frame& F, const Args& A) {
    refresh(F);
    const int gw = F.vcu * NWAVES + F.wave, NGW = F.G * NWAVES;
    const float* mod = (const float*)(F.ws + WS_MOD); bf16* XN = (bf16*)(F.ws + WS_XN);
    for (int m = gw; m < M; m += NGW) {
        const GAS f32x4* xr = (const GAS f32x4*)x_row(A, m) + F.lane; const float* mr = mod + (size_t)mod_row(m) * NMOD;
        const GAS f32x4* sh = (const GAS f32x4*)(mr) + F.lane; const GAS f32x4* scp = (const GAS f32x4*)(mr + D) + F.lane;
        GAS unsigned long long* o8 = (GAS unsigned long long*)(XN + (size_t)m * D) + F.lane;
#pragma unroll
        for (int j = 0; j < 4; ++j) { const f32x4 v = xr[64 * j], a = sh[64 * j], s = scp[64 * j]; const f32x4 h = v * (s + 1.f) + a;
            o8[64 * j] = (unsigned long long)pk2(h.x, h.y) | ((unsigned long long)pk2(h.z, h.w) << 32); }
    }
}

template <bool SECOND>
__device__ __forceinline__ void ln_rows(Frame& F, const Args& A) {
    refresh(F);
    const int gw = F.vcu * NWAVES + F.wave, NGW = F.G * NWAVES;
    const float* mod = (const float*)(F.ws + WS_MOD); bf16* XN = (bf16*)(F.ws + WS_XN);
    const GAS f32x4* gg = (const GAS f32x4*)A.in[SECOND ? I_LN2G : I_LN1G] + F.lane; const GAS f32x4* gb = (const GAS f32x4*)A.in[SECOND ? I_LN2B : I_LN1B] + F.lane;
    for (int m = gw; m < M; m += NGW) {
        GAS f32x4* xr = (GAS f32x4*)(F.out + (size_t)m * D) + F.lane;
        f32x4 v[4]; float s = 0.f;
        if (m >= MP) {
            const float* mr = mod + (size_t)mod_row(m) * NMOD + (SECOND ? 5 : 2) * D;
            const GAS f32x4* bs = SECOND ? (const GAS f32x4*)xr : (const GAS f32x4*)(A.in[I_XS] + (size_t)(m - MP) * D) + F.lane;
            const GAS f32x4* sl = (const GAS f32x4*)((const float*)(F.ws + WS_SLAB) + (size_t)(m - MP) * D) + F.lane;
#pragma unroll
            for (int j = 0; j < 4; ++j) { f32x4 a = SECOND ? *((const GAS f32x4*)A.in[I_B2] + F.lane + 64 * j) : (f32x4){0.f, 0.f, 0.f, 0.f};
#pragma unroll
                for (int ks = 0; ks < (SECOND ? NS_DOWN : NS_OUT); ++ks) a += sl[(size_t)ks * (512 * 1024 / 4) + 64 * j];
                v[j] = bs[64 * j] * ALPHA + *((const GAS f32x4*)mr + F.lane + 64 * j) * a; }
        } else {
            const GAS unsigned long long* tr = (const GAS unsigned long long*)((const bf16*)(F.ws + (SECOND ? WS_T2 : WS_T1)) + (size_t)m * D) + F.lane;
#pragma unroll
            for (int j = 0; j < 4; ++j) { const unsigned long long w = tr[64 * j]; const unsigned lo = (unsigned)w, hi = (unsigned)(w >> 32);
                v[j] = (f32x4){pg8::bf_lo(lo), pg8::bf_hi(lo), pg8::bf_lo(hi), pg8::bf_hi(hi)}; }
        }
#pragma unroll
        for (int j = 0; j < 4; ++j) s += (v[j].x + v[j].y) + (v[j].z + v[j].w);
        const float mean = wave_sum(s) * (1.f / D); float s2 = 0.f;
#pragma unroll
        for (int j = 0; j < 4; ++j) { v[j] = v[j] - mean; s2 += (v[j].x * v[j].x + v[j].y * v[j].y) + (v[j].z * v[j].z + v[j].w * v[j].w); }
        const float rstd = 1.f / sqrtf(wave_sum(s2) * (1.f / D) + LN_EPS);
#pragma unroll
        for (int j = 0; j < 4; ++j) v[j] = v[j] * rstd * gg[64 * j] + gb[64 * j];
        if (SECOND || m >= MP) {
#pragma unroll
            for (int j = 0; j < 4; ++j) xr[64 * j] = v[j];
        } else {
            GAS unsigned long long* x8 = (GAS unsigned long long*)((bf16*)(F.ws + WS_X1B) + (size_t)m * D) + F.lane;
#pragma unroll
            for (int j = 0; j < 4; ++j) x8[64 * j] = (unsigned long long)pk2(v[j].x, v[j].y) | ((unsigned long long)pk2(v[j].z, v[j].w) << 32);
        }
        if (!SECOND) {
            const float* mr = mod + (size_t)mod_row(m) * NMOD;
            const GAS f32x4* sh = (const GAS f32x4*)(mr + 3 * D) + F.lane; const GAS f32x4* scp = (const GAS f32x4*)(mr + 4 * D) + F.lane;
            GAS unsigned long long* o8 = (GAS unsigned long long*)(XN + (size_t)m * D) + F.lane;
#pragma unroll
            for (int j = 0; j < 4; ++j) { const f32x4 h = v[j] * (scp[64 * j] + 1.f) + sh[64 * j];
                o8[64 * j] = (unsigned long long)pk2(h.x, h.y) | ((unsigned long long)pk2(h.z, h.w) << 32); }
        }
    }
}

__device__ __forceinline__ void rg_item_ref(Frame& F, const Args& A, bool prompt, int b, int hd, LAS float* scr) {
    const int j = F.lane, c = hd * HDA + j;
    const bf16* Z = (const bf16*)(F.ws + WS_Z); bf16* Y = (bf16*)(F.ws + WS_YCAT); const float* sc = (const float*)(F.ws + WS_S5C);
    float wr[64], wi[64];
#pragma unroll
    for (int i = 0; i < 64; ++i) { wr[i] = A.in[I_RGWR][(size_t)(hd * 64 + i) * 64 + j]; wi[i] = A.in[I_RGWI][(size_t)(hd * 64 + i) * 64 + j]; }
    const float br = A.in[I_RGBR][c], bi = A.in[I_RGBI][c], L2 = sc[SC_RGL + c];
    const float w0 = A.in[I_CONVW][c], w1 = A.in[I_CONVW][WA + c], w2 = A.in[I_CONVW][2 * WA + c], w3 = A.in[I_CONVW][3 * WA + c], cb = A.in[I_CONVB][c];
    int T, m0; float x3, x2, x1, h;
    if (prompt) { T = TP; m0 = b * TP; x3 = 0.f; x2 = 0.f; x1 = 0.f; h = 0.f; }
    else { T = TS; m0 = MP + b * TS; x3 = A.in[I_SCONV][(size_t)(b * 3 + 0) * WA + c]; x2 = A.in[I_SCONV][(size_t)(b * 3 + 1) * WA + c]; x1 = A.in[I_SCONV][(size_t)(b * 3 + 2) * WA + c]; h = A.in[I_SH][(size_t)b * WA + c]; }
    for (int t = 0; t < T; ++t) {
        const size_t m = (size_t)(m0 + t);
        const float xa = bf2f(Z[m * NZ + WA + c]), gate = bf2f(Z[m * NZ + c]);
        const float xc = cb + w0 * x3 + w1 * x2 + w2 * x1 + w3 * xa; x3 = x2; x2 = x1; x1 = xa;
        scr[j] = xc; LDS_WAIT(); asm volatile("" ::: "memory");
        float rp = br, gp = bi;
#pragma unroll
        for (int i4 = 0; i4 < 16; ++i4) { const f32x4 v = *(const LAS f32x4*)(scr + 4 * i4);
            rp += v[0] * wr[4 * i4] + v[1] * wr[4 * i4 + 1] + v[2] * wr[4 * i4 + 2] + v[3] * wr[4 * i4 + 3];
            gp += v[0] * wi[4 * i4] + v[1] * wi[4 * i4 + 1] + v[2] * wi[4 * i4 + 2] + v[3] * wi[4 * i4 + 3]; }
        LDS_WAIT(); asm volatile("" ::: "memory");
        const float r = sigmoidf_(rp), gi = sigmoidf_(gp);
        const float a = exp2f(r * L2);
        float mult = sqrtf(fmaxf(1.f - a * a, 0.f));
        if (prompt && t == 0) mult = 1.f;
        h = a * h + mult * gi * xc;
        Y[m * D + c] = (bf16)f2bf(gelu_tanh(gate) * h);
    }
    float* oc = F.out + (prompt ? O_CONVP : O_CONVS); float* oh = F.out + (prompt ? O_HP : O_HS);
    oc[(size_t)(b * 3 + 0) * WA + c] = x3; oc[(size_t)(b * 3 + 1) * WA + c] = x2; oc[(size_t)(b * 3 + 2) * WA + c] = x1;
    oh[(size_t)b * WA + c] = h;
}
__device__ __forceinline__ void s5_item_ref(Frame& F, const Args& A, bool prompt, int b, int g, LAS float* scr) {
    const int n = F.lane, gn = g * NS5 + n, k = F.lane & 15, part = F.lane >> 4;
    const bf16* Z = (const bf16*)(F.ws + WS_Z); bf16* Gy = (bf16*)(F.ws + WS_G); const float* sc = (const float*)(F.ws + WS_S5C);
    float bbr[16], bbi[16], cre[16], cim[16];
#pragma unroll
    for (int i = 0; i < 16; ++i) { bbr[i] = sc[SC_BBR + gn * KS5 + i]; bbi[i] = sc[SC_BBI + gn * KS5 + i];
        cre[i] = A.in[I_S5CRE][(size_t)(g * KS5 + k) * NS5 + part * 16 + i]; cim[i] = A.in[I_S5CIM][(size_t)(g * KS5 + k) * NS5 + part * 16 + i]; }
    const float abr = sc[SC_ABR + gn], abi = sc[SC_ABI + gn], dk = A.in[I_S5D][g * KS5 + k];
    int T, m0; float hr, hi;
    if (prompt) { T = TP; m0 = b * TP; hr = 0.f; hi = 0.f; }
    else { T = TS; m0 = MP + b * TS; hr = A.in[I_SSR][(size_t)(b * GB + g) * NS5 + n]; hi = A.in[I_SSI][(size_t)(b * GB + g) * NS5 + n]; }
    for (int t = 0; t < T; ++t) {
        const size_t m = (size_t)(m0 + t);
        const bf16* zr = Z + m * NZ + 2 * WA + g * KS5;
        const v4u u0 = *(const v4u*)zr, u1 = *(const v4u*)(zr + 8);
        float u[16];
        u[0] = pg8::bf_lo(u0.x); u[1] = pg8::bf_hi(u0.x); u[2] = pg8::bf_lo(u0.y); u[3] = pg8::bf_hi(u0.y); u[4] = pg8::bf_lo(u0.z); u[5] = pg8::bf_hi(u0.z); u[6] = pg8::bf_lo(u0.w); u[7] = pg8::bf_hi(u0.w);
        u[8] = pg8::bf_lo(u1.x); u[9] = pg8::bf_hi(u1.x); u[10] = pg8::bf_lo(u1.y); u[11] = pg8::bf_hi(u1.y); u[12] = pg8::bf_lo(u1.z); u[13] = pg8::bf_hi(u1.z); u[14] = pg8::bf_lo(u1.w); u[15] = pg8::bf_hi(u1.w);
        float bur = 0.f, bui = 0.f;
#pragma unroll
        for (int i = 0; i < 16; ++i) { bur += bbr[i] * u[i]; bui += bbi[i] * u[i]; }
        const float nhr = abr * hr - abi * hi + bur, nhi = abr * hi + abi * hr + bui; hr = nhr; hi = nhi;
        scr[n] = hr; scr[64 + n] = hi; LDS_WAIT(); asm volatile("" ::: "memory");
        float p = 0.f;
#pragma unroll
        for (int i4 = 0; i4 < 4; ++i4) { const f32x4 vr = *(const LAS f32x4*)(scr + part * 16 + 4 * i4), vi = *(const LAS f32x4*)(scr + 64 + part * 16 + 4 * i4);
#pragma unroll
            for (int e = 0; e < 4; ++e) p += vr[e] * cre[4 * i4 + e] - vi[e] * cim[4 * i4 + e]; }
        LDS_WAIT(); asm volatile("" ::: "memory");
        p += __shfl_xor(p, 16); p += __shfl_xor(p, 32);
        const float uk = bf2f(zr[k]);
        if (F.lane < 16) Gy[m * WB + g * KS5 + k] = (bf16)f2bf(gelu_tanh(p + dk * uk));
    }
    float* osr = F.out + (prompt ? O_SRP : O_SRS); float* osi = F.out + (prompt ? O_SIP : O_SIS);
    osr[(size_t)(b * GB + g) * NS5 + n] = hr; osi[(size_t)(b * GB + g) * NS5 + n] = hi;
}

typedef short bf16x8v __attribute__((ext_vector_type(8)));
typedef float f32x16 __attribute__((ext_vector_type(16)));
typedef float f32x2v __attribute__((ext_vector_type(2)));
typedef __bf16 bf16x2v __attribute__((ext_vector_type(2)));
#define MFMA32(a, b, c) __builtin_amdgcn_mfma_f32_32x32x16_bf16((a), (b), (c), 0, 0, 0)
__device__ __forceinline__ unsigned pkbf(float a, float b) { const f32x2v v = {a, b}; const bf16x2v r = __builtin_convertvector(v, bf16x2v); return __builtin_bit_cast(unsigned, r); }
template <int CTRL> __device__ __forceinline__ float dppf(float old, float v) { return __builtin_bit_cast(float, __builtin_amdgcn_update_dpp(__builtin_bit_cast(int, old), __builtin_bit_cast(int, v), CTRL, 0xF, 0xF, false)); }
__device__ __forceinline__ f32x16 ld16(const float* p) { f32x16 r;
#pragma unroll
    for (int i = 0; i < 4; ++i) { const f32x4 v = *(const f32x4*)(p + 4 * i); r[4 * i] = v[0]; r[4 * i + 1] = v[1]; r[4 * i + 2] = v[2]; r[4 * i + 3] = v[3]; }
    return r; }
__device__ __forceinline__ f32x16 ld16l(const LAS float* p) { f32x16 r;
#pragma unroll
    for (int i = 0; i < 4; ++i) { const f32x4 v = *(const LAS f32x4*)(p + 4 * i); r[4 * i] = v[0]; r[4 * i + 1] = v[1]; r[4 * i + 2] = v[2]; r[4 * i + 3] = v[3]; }
    return r; }
__device__ __forceinline__ bf16x8v pack8(const f32x16& x, int s) { v4u p; p.x = pkbf(x[8 * s], x[8 * s + 1]); p.y = pkbf(x[8 * s + 2], x[8 * s + 3]); p.z = pkbf(x[8 * s + 4], x[8 * s + 5]); p.w = pkbf(x[8 * s + 6], x[8 * s + 7]); return __builtin_bit_cast(bf16x8v, p); }
template <int CTRL> __device__ __forceinline__ void s5_scan_step(f32x16& xr, f32x16& xi, const f32x16& zr, const f32x16& zi) {
#pragma unroll
    for (int i = 0; i < 16; ++i) { const float sr = dppf<CTRL>(0.f, xr[i]), si = dppf<CTRL>(0.f, xi[i]);
        xr[i] += zr[i] * sr - zi[i] * si; xi[i] += zr[i] * si + zi[i] * sr; }
}
constexpr int S5L_BF1 = 0, S5L_BF2 = 4096, S5L_TOT = 12288, S5L_CAR = 20480, S5L_ZP = 28672  , S5L_TA = 37376  , S5L_U = 38912  ;
template <bool SECOND>
__device__ __forceinline__ void s5_step(LAS unsigned char* L, int lane, const bf16x8v u, f32x16& hr0, f32x16& hr1, f32x16& hi0, f32x16& hi1,
                                        const f32x16& ar0, const f32x16& ar1, const f32x16& ai0, const f32x16& ai1, const float (&dk)[8], bf16* gout) {
    const LAS bf16x8v* a1 = (const LAS bf16x8v*)(L + S5L_BF1) + lane;
    { const f32x16 cr = ar0 * hr0 - ai0 * hi0, ci = ar0 * hi0 + ai0 * hr0; hr0 = MFMA32(a1[0], u, cr); hi0 = MFMA32(a1[128], u, ci); }
    asm volatile("" : "+v"(hr0), "+v"(hi0));
    { const f32x16 cr = ar1 * hr1 - ai1 * hi1, ci = ar1 * hi1 + ai1 * hr1; hr1 = MFMA32(a1[64], u, cr); hi1 = MFMA32(a1[192], u, ci); }
    if (SECOND) {
        const LAS bf16x8v* a2 = (const LAS bf16x8v*)(L + S5L_BF2) + lane;
        f32x16 y;
#pragma unroll
        for (int i = 0; i < 16; ++i) y[i] = 0.f;
        y = MFMA32(a2[0 * 64], pack8(hr0, 0), y); y = MFMA32(a2[1 * 64], pack8(hr0, 1), y);
        y = MFMA32(a2[2 * 64], pack8(hr1, 0), y); y = MFMA32(a2[3 * 64], pack8(hr1, 1), y);
        y = MFMA32(a2[4 * 64], pack8(hi0, 0), y); y = MFMA32(a2[5 * 64], pack8(hi0, 1), y);
        y = MFMA32(a2[6 * 64], pack8(hi1, 0), y); y = MFMA32(a2[7 * 64], pack8(hi1, 1), y);
        const v4u uw = __builtin_bit_cast(v4u, u);
        float o[8];
        o[0] = gelu_tanh(y[0] + dk[0] * pg8::bf_lo(uw.x)); o[1] = gelu_tanh(y[1] + dk[1] * pg8::bf_hi(uw.x));
        o[2] = gelu_tanh(y[2] + dk[2] * pg8::bf_lo(uw.y)); o[3] = gelu_tanh(y[3] + dk[3] * pg8::bf_hi(uw.y));
        o[4] = gelu_tanh(y[4] + dk[4] * pg8::bf_lo(uw.z)); o[5] = gelu_tanh(y[5] + dk[5] * pg8::bf_hi(uw.z));
        o[6] = gelu_tanh(y[6] + dk[6] * pg8::bf_lo(uw.w)); o[7] = gelu_tanh(y[7] + dk[7] * pg8::bf_hi(uw.w));
        v4u w; w.x = pkbf(o[0], o[1]); w.y = pkbf(o[2], o[3]); w.z = pkbf(o[4], o[5]); w.w = pkbf(o[6], o[7]);
        *(v4u*)gout = w;
    }
}
__device__ __forceinline__ void s5_item_fast(Frame& F, const Args& A, int b, int g) {
    refresh(F);
    const int lane = F.lane, q = lane & 31, hh = lane >> 5, w = F.wave, c = w * 32 + q;
    LAS unsigned char* L = F.lds + RING_OFF;
    const unsigned char* tab = F.ws + WS_TAB;
    const size_t m0 = (size_t)b * TP + (size_t)8 * c;
    const bf16* zrow = (const bf16*)(F.ws + WS_Z) + m0 * NZ + 2 * WA + g * KS5 + 8 * hh;
    bf16* grow = (bf16*)(F.ws + WS_G) + m0 * WB + g * KS5 + 8 * hh;
    LAS v4u* UL = (LAS v4u*)(L + S5L_U) + F.tid;
    {
        v4u uu[8];
#pragma unroll
        for (int j = 0; j < 8; ++j) uu[j] = *(const v4u*)(zrow + (size_t)j * NZ);
        const v4u* s1 = (const v4u*)(tab + TB_BF1) + (size_t)g * 256; const v4u* s2 = (const v4u*)(tab + TB_BF2) + (size_t)g * 512;
        if (F.tid < 256) ((LAS v4u*)(L + S5L_BF1))[F.tid] = s1[F.tid];
        ((LAS v4u*)(L + S5L_BF2))[F.tid] = s2[F.tid];
        const v4u* s3 = (const v4u*)(tab + TB_ZP) + (size_t)g * (17 * 128 / 4); for (int e = F.tid; e < 17 * 128 / 4; e += NWAVES * 64) ((LAS v4u*)(L + S5L_ZP))[e] = s3[e];
        if (F.tid < 32) ((LAS v4u*)(L + S5L_TA))[F.tid] = ((const v4u*)(tab + TB_TA) + (size_t)g * 32)[F.tid];
#pragma unroll
        for (int j = 0; j < 8; ++j) UL[512 * j] = uu[j];
    }
    __syncthreads();
    const LAS float* TA = (const LAS float*)(L + S5L_TA) + hh * 64;
    f32x16 ar0 = ld16l(TA), ar1 = ld16l(TA + 16), ai0 = ld16l(TA + 32), ai1 = ld16l(TA + 48);
    f32x16 hr0, hr1, hi0, hi1;
#pragma unroll
    for (int i = 0; i < 16; ++i) { hr0[i] = 0.f; hr1[i] = 0.f; hi0[i] = 0.f; hi1[i] = 0.f; }
    float dk[8];
#pragma unroll
    for (int i = 0; i < 8; ++i) dk[i] = A.in[I_S5D][g * KS5 + 8 * hh + i];
#pragma unroll 1
    for (int j = 0; j < 8; ++j) { const bf16x8v u = __builtin_bit_cast(bf16x8v, UL[512 * j]);
        s5_step<false>(L, lane, u, hr0, hr1, hi0, hi1, ar0, ar1, ai0, ai1, dk, nullptr); }
    const LAS float* ZP = (const LAS float*)(L + S5L_ZP);
#define S5_SCAN(E, CTRL) do { const LAS float* z = ZP + (((E) * 2 + hh) * 2) * 32; \
        { const f32x16 zr = ld16l(z), zi = ld16l(z + 32); s5_scan_step<CTRL>(hr0, hi0, zr, zi); } \
        asm volatile("" : "+v"(hr0), "+v"(hi0) :: "memory"); \
        { const f32x16 zr = ld16l(z + 16), zi = ld16l(z + 48); s5_scan_step<CTRL>(hr1, hi1, zr, zi); } \
        asm volatile("" : "+v"(hr1), "+v"(hi1) :: "memory"); } while (0)
    S5_SCAN(1, 0x111); S5_SCAN(2, 0x112); S5_SCAN(4, 0x114); S5_SCAN(8, 0x118);
#undef S5_SCAN
    const int seg = w * 2 + (q >> 4);
    LAS float* TOT = (LAS float*)(L + S5L_TOT); LAS float* CAR = (LAS float*)(L + S5L_CAR);
    if ((lane & 15) == 15) {
#pragma unroll
        for (int rho = 0; rho < 4; ++rho) {
            *(LAS f32x4*)(TOT + (seg * 2 + 0) * 64 + 0 + 8 * rho + 4 * hh) = (f32x4){hr0[4 * rho], hr0[4 * rho + 1], hr0[4 * rho + 2], hr0[4 * rho + 3]};
            *(LAS f32x4*)(TOT + (seg * 2 + 0) * 64 + 32 + 8 * rho + 4 * hh) = (f32x4){hr1[4 * rho], hr1[4 * rho + 1], hr1[4 * rho + 2], hr1[4 * rho + 3]};
            *(LAS f32x4*)(TOT + (seg * 2 + 1) * 64 + 0 + 8 * rho + 4 * hh) = (f32x4){hi0[4 * rho], hi0[4 * rho + 1], hi0[4 * rho + 2], hi0[4 * rho + 3]};
            *(LAS f32x4*)(TOT + (seg * 2 + 1) * 64 + 32 + 8 * rho + 4 * hh) = (f32x4){hi1[4 * rho], hi1[4 * rho + 1], hi1[4 * rho + 2], hi1[4 * rho + 3]}; }
    }
    __syncthreads();
    if (F.tid < 64) {
        const float* z16 = (const float*)(tab + TB_Z16N) + (size_t)g * 128; const float zr = z16[F.tid], zi = z16[64 + F.tid];
        float cr = 0.f, ci = 0.f;
#pragma unroll
        for (int sg = 0; sg < 16; ++sg) { CAR[(sg * 2 + 0) * 64 + F.tid] = cr; CAR[(sg * 2 + 1) * 64 + F.tid] = ci;
            const float tr = TOT[(sg * 2 + 0) * 64 + F.tid], ti = TOT[(sg * 2 + 1) * 64 + F.tid];
            const float ncr = zr * cr - zi * ci + tr, nci = zr * ci + zi * cr + ti; cr = ncr; ci = nci; }
    }
    __syncthreads();
    {
        const LAS float* z = ZP + (((q & 15) * 2 + hh) * 2) * 32;
#define S5_EXCL(HR, HI, OFF) do { const f32x16 zr = ld16l(z + (OFF)), zi = ld16l(z + 32 + (OFF)); f32x16 kr, ki; \
        _Pragma("unroll") for (int rho = 0; rho < 4; ++rho) { \
            const f32x4 a0 = *(const LAS f32x4*)(CAR + (seg * 2 + 0) * 64 + 2 * (OFF) + 8 * rho + 4 * hh), b0 = *(const LAS f32x4*)(CAR + (seg * 2 + 1) * 64 + 2 * (OFF) + 8 * rho + 4 * hh); \
            _Pragma("unroll") for (int e = 0; e < 4; ++e) { kr[4 * rho + e] = a0[e]; ki[4 * rho + e] = b0[e]; } } \
        _Pragma("unroll") for (int i = 0; i < 16; ++i) { const float sr = dppf<0x111>(0.f, HR[i]), si = dppf<0x111>(0.f, HI[i]); \
            HR[i] = sr + zr[i] * kr[i] - zi[i] * ki[i]; HI[i] = si + zr[i] * ki[i] + zi[i] * kr[i]; } } while (0)
        S5_EXCL(hr0, hi0, 0); asm volatile("" : "+v"(hr0), "+v"(hi0) :: "memory"); S5_EXCL(hr1, hi1, 16); asm volatile("" : "+v"(hr1), "+v"(hi1) :: "memory");
#undef S5_EXCL
    }
    { int off = 0; asm volatile("" : "+v"(off)); const LAS float* TA2 = TA + off; ar0 = ld16l(TA2); ar1 = ld16l(TA2 + 16); ai0 = ld16l(TA2 + 32); ai1 = ld16l(TA2 + 48); }
#pragma unroll 1
    for (int j = 0; j < 8; ++j) { const bf16x8v u = __builtin_bit_cast(bf16x8v, UL[512 * j]);
        s5_step<true>(L, lane, u, hr0, hr1, hi0, hi1, ar0, ar1, ai0, ai1, dk, grow + (size_t)j * WB); }
    if (w == NWAVES - 1 && q == 31) {
        float* osr = F.out + O_SRP + (size_t)(b * GB + g) * NS5; float* osi = F.out + O_SIP + (size_t)(b * GB + g) * NS5;
#pragma unroll
        for (int i = 0; i < 16; ++i) { const int n = (i & 3) + 8 * (i >> 2) + 4 * hh; osr[n] = hr0[i]; osr[32 + n] = hr1[i]; osi[n] = hi0[i]; osi[32 + n] = hi1[i]; }
    }
    __syncthreads();
}

__device__ __forceinline__ void s5_item_sample(Frame& F, const Args& A, int g) {
    refresh(F);
    const int lane = F.lane, q = lane & 31, hh = lane >> 5, w = F.wave;
    LAS unsigned char* L = F.lds + RING_OFF;
    const unsigned char* tab = F.ws + WS_TAB;
    { const v4u* s1 = (const v4u*)(tab + TB_BF1) + (size_t)g * 256; const v4u* s2 = (const v4u*)(tab + TB_BF2) + (size_t)g * 512;
      if (F.tid < 256) ((LAS v4u*)(L + S5L_BF1))[F.tid] = s1[F.tid];
      ((LAS v4u*)(L + S5L_BF2))[F.tid] = s2[F.tid]; }
    __syncthreads();
    if (w < 4) {
        const int b = w * 32 + q;
        const float* TA = (const float*)(tab + TB_TA) + (size_t)((g * 2 + hh) * 2) * 32;
        const f32x16 ar0 = ld16(TA), ar1 = ld16(TA + 16), ai0 = ld16(TA + 32), ai1 = ld16(TA + 48);
        f32x16 hr0, hr1, hi0, hi1;
        const float* sr = A.in[I_SSR] + (size_t)(b * GB + g) * NS5; const float* si = A.in[I_SSI] + (size_t)(b * GB + g) * NS5;
#pragma unroll
        for (int rho = 0; rho < 4; ++rho) { const f32x4 a0 = *(const f32x4*)(sr + 8 * rho + 4 * hh), a1 = *(const f32x4*)(sr + 32 + 8 * rho + 4 * hh), b0 = *(const f32x4*)(si + 8 * rho + 4 * hh), b1 = *(const f32x4*)(si + 32 + 8 * rho + 4 * hh);
#pragma unroll
            for (int e = 0; e < 4; ++e) { hr0[4 * rho + e] = a0[e]; hr1[4 * rho + e] = a1[e]; hi0[4 * rho + e] = b0[e]; hi1[4 * rho + e] = b1[e]; } }
        float dk[8];
#pragma unroll
        for (int i = 0; i < 8; ++i) dk[i] = A.in[I_S5D][g * KS5 + 8 * hh + i];
        const size_t m0 = (size_t)MP + (size_t)b * TS;
        const bf16* zrow = (const bf16*)(F.ws + WS_Z) + m0 * NZ + 2 * WA + g * KS5 + 8 * hh;
        bf16* grow = (bf16*)(F.ws + WS_G) + m0 * WB + g * KS5 + 8 * hh;
        bf16x8v uu[TS];
#pragma unroll
        for (int j = 0; j < TS; ++j) uu[j] = *(const bf16x8v*)(zrow + (size_t)j * NZ);
#pragma unroll
        for (int j = 0; j < TS; ++j) s5_step<true>(L, lane, uu[j], hr0, hr1, hi0, hi1, ar0, ar1, ai0, ai1, dk, grow + (size_t)j * WB);
        float* osr = F.out + O_SRS + (size_t)(b * GB + g) * NS5; float* osi = F.out + O_SIS + (size_t)(b * GB + g) * NS5;
#pragma unroll
        for (int rho = 0; rho < 4; ++rho) {
            *(f32x4*)(osr + 8 * rho + 4 * hh) = (f32x4){hr0[4 * rho], hr0[4 * rho + 1], hr0[4 * rho + 2], hr0[4 * rho + 3]};
            *(f32x4*)(osr + 32 + 8 * rho + 4 * hh) = (f32x4){hr1[4 * rho], hr1[4 * rho + 1], hr1[4 * rho + 2], hr1[4 * rho + 3]};
            *(f32x4*)(osi + 8 * rho + 4 * hh) = (f32x4){hi0[4 * rho], hi0[4 * rho + 1], hi0[4 * rho + 2], hi0[4 * rho + 3]};
            *(f32x4*)(osi + 32 + 8 * rho + 4 * hh) = (f32x4){hi1[4 * rho], hi1[4 * rho + 1], hi1[4 * rho + 2], hi1[4 * rho + 3]}; }
    }
    __syncthreads();
}

template <int CTRL, int RMASK> __device__ __forceinline__ float dppm(float old, float v) { return __builtin_bit_cast(float, __builtin_amdgcn_update_dpp(__builtin_bit_cast(int, old), __builtin_bit_cast(int, v), CTRL, RMASK, 0xF, false)); }
template <int CTRL, int RMASK> __device__ __forceinline__ void rg_scan_step(f32x16& a, f32x16& b) {
#pragma unroll
    for (int i = 0; i < 16; ++i) { const float as = dppm<CTRL, RMASK>(1.f, a[i]), bs = dppm<CTRL, RMASK>(0.f, b[i]); b[i] = a[i] * bs + b[i]; a[i] = a[i] * as; }
}
constexpr int RGL_AFR = 0, RGL_DG = 8192, RGL_TOT = 24576, RGL_CST = 28672;
constexpr int RGL_XAP = 144;
constexpr int RGL_XA0 = 29696, RGL_BUF = 37376;
static_assert(259 * RGL_XAP <= RGL_BUF && RGL_XA0 + 2 * RGL_BUF <= RING_BYTES && RGL_CST + 640 <= RGL_XA0, "RG-LRU LDS map");
template <bool SAMPLE>
__device__ __forceinline__ void rg_item_fast(Frame& F, const Args& A, int b, int hd, int jh) {
    refresh(F);
    const int lane = F.lane, q = lane & 31, hh = lane >> 5, w = F.wave;
    LAS unsigned char* L = F.lds + RING_OFF;
    const float* sc = (const float*)(F.ws + WS_S5C);
    const bf16* Zb = (const bf16*)(F.ws + WS_Z) + (size_t)(SAMPLE ? MP : b * TP) * NZ; bf16* Yb = (bf16*)(F.ws + WS_YCAT) + (size_t)(SAMPLE ? MP : b * TP) * D;
    const bf16* CB = (const bf16*)(F.ws + WS_TAB + TB_CB);
    auto stage_load = [&](int T0, v4u (&st)[5]) {
#pragma unroll
        for (int k = 0; k < 5; ++k) { const int ci = F.tid + 512 * k; v4u v = (v4u){0u, 0u, 0u, 0u};
            if (ci < 2072) { const int tk = T0 - 3 + (ci >> 3); if (tk >= 0) v = *(const v4u*)(Zb + (size_t)tk * NZ + WA + hd * 64 + (ci & 7) * 8); }
            st[k] = v; } };
    auto stage_write = [&](int par, const v4u (&st)[5]) {
#pragma unroll
        for (int k = 0; k < 5; ++k) { const int ci = F.tid + 512 * k;
            if (ci < 2072) *(LAS v4u*)(L + RGL_XA0 + par * RGL_BUF + (ci >> 3) * RGL_XAP + (ci & 7) * 16) = st[k]; } };
    {
        const v4u* src = (const v4u*)(F.ws + WS_TAB + TB_RG) + (size_t)((hd * 2 + jh) * 8) * 64;
        ((LAS v4u*)(L + RGL_AFR))[F.tid] = src[F.tid];
        const v4u* sd = (const v4u*)(F.ws + WS_TAB + TB_DG) + (size_t)(hd * 16) * 64;
        ((LAS v4u*)(L + RGL_DG))[F.tid] = sd[F.tid]; ((LAS v4u*)(L + RGL_DG))[512 + F.tid] = sd[512 + F.tid];
        if (F.tid < 160) { const int h2 = F.tid / 80, kind = (F.tid % 80) / 16, i = F.tid % 16, cr = (i & 3) + 8 * (i >> 2) + 4 * h2;
            const int c = hd * 64 + 32 * jh + cr;
            ((LAS float*)(L + RGL_CST))[F.tid] = kind == 0 ? A.in[I_RGBR][c] : kind == 1 ? A.in[I_RGBI][c] : kind == 2 ? sc[SC_RGL + c] : A.in[I_CONVB][hd * 64 + 32 * (kind - 3) + cr]; }
        if (!SAMPLE && jh == 0 && F.tid < 192) { const int k = F.tid >> 6, ch = F.tid & 63;
            F.out[O_CONVP + (size_t)(b * 3 + k) * WA + hd * 64 + ch] = bf2f(((const bf16*)(F.ws + WS_Z))[(size_t)(b * TP + TP - 3 + k) * NZ + WA + hd * 64 + ch]); }
        if (SAMPLE && jh == 0) { for (int e = F.tid; e < NBS * 3 * 64; e += NWAVES * 64) { const int bb = e / 192, k = (e / 64) % 3, ch = e & 63;
            F.out[O_CONVS + (size_t)(bb * 3 + k) * WA + hd * 64 + ch] = bf2f(((const bf16*)(F.ws + WS_Z))[(size_t)(MP + bb * TS + 1 + k) * NZ + WA + hd * 64 + ch]); } }
        if (!SAMPLE) { v4u st[5]; stage_load(0, st); stage_write(0, st); }
    }
    __syncthreads();
    float hround[16];
#pragma unroll
    for (int i = 0; i < 16; ++i) hround[i] = 0.f;
    const LAS float* CST = (const LAS float*)(L + RGL_CST) + hh * 80;
    const LAS bf16x8v* af = (const LAS bf16x8v*)(L + RGL_AFR) + lane;
    const LAS bf16x8v* dg = (const LAS bf16x8v*)(L + RGL_DG) + lane;
#pragma unroll 1
    for (int rd = 0; rd < (SAMPLE ? 2 : 8); ++rd) {
        const int t = rd * 256 + w * 32 + q;
        v4u stn[5];
        if (!SAMPLE) stage_load((rd + 1) * 256, stn);
        const LAS unsigned char* XAp = L + RGL_XA0 + (rd & 1) * RGL_BUF + (w * 32 + q) * RGL_XAP + 16 * hh;
        const bf16* zsr[4];
        if (SAMPLE) {
#pragma unroll
            for (int k = 0; k < 4; ++k) { const int jx = (t & 3) + k; zsr[k] = (jx < 3 ? CB + (size_t)((t >> 2) * 3 + jx) * WA : Zb + (size_t)(t - 3 + k) * NZ + WA) + hd * 64 + 8 * hh; } }
        const bf16* gr = Zb + (size_t)t * NZ + hd * 64 + 32 * jh + 4 * hh;
        unsigned long long gq[4];
#pragma unroll
        for (int rho = 0; rho < 4; ++rho) gq[rho] = *(const unsigned long long*)(gr + 8 * rho);
        f32x16 dx0, dx1;
        { const f32x4 c0 = *(const LAS f32x4*)(CST + 48), c1 = *(const LAS f32x4*)(CST + 52), c2 = *(const LAS f32x4*)(CST + 56), c3 = *(const LAS f32x4*)(CST + 60);
          const f32x4 e0 = *(const LAS f32x4*)(CST + 64), e1 = *(const LAS f32x4*)(CST + 68), e2 = *(const LAS f32x4*)(CST + 72), e3 = *(const LAS f32x4*)(CST + 76);
#pragma unroll
          for (int e = 0; e < 4; ++e) { dx0[e] = c0[e]; dx0[4 + e] = c1[e]; dx0[8 + e] = c2[e]; dx0[12 + e] = c3[e]; dx1[e] = e0[e]; dx1[4 + e] = e1[e]; dx1[8 + e] = e2[e]; dx1[12 + e] = e3[e]; } }
#pragma unroll
        for (int k = 0; k < 4; ++k)
#pragma unroll
            for (int s4 = 0; s4 < 4; ++s4) {
                const bf16x8v xb = SAMPLE ? *(const bf16x8v*)(zsr[k] + 16 * s4) : *(const LAS bf16x8v*)(XAp + k * RGL_XAP + s4 * 32);
                if (s4 < 2) dx0 = MFMA32(dg[((0 * 2 + (s4 & 1)) * 4 + k) * 64], xb, dx0); else dx1 = MFMA32(dg[((1 * 2 + (s4 & 1)) * 4 + k) * 64], xb, dx1);
                if (s4 == 3) asm volatile("" : "+v"(dx0), "+v"(dx1) :: "memory"); }
        f32x16 dr, di;
#pragma unroll
        for (int i = 0; i < 16; ++i) { dr[i] = 0.f; di[i] = 0.f; }
        { const bf16x8v b00 = pack8(dx0, 0), b01 = pack8(dx0, 1), b10 = pack8(dx1, 0), b11 = pack8(dx1, 1);
          dr = MFMA32(af[0 * 64], b00, dr); di = MFMA32(af[4 * 64], b00, di); dr = MFMA32(af[1 * 64], b01, dr); di = MFMA32(af[5 * 64], b01, di);
          dr = MFMA32(af[2 * 64], b10, dr); di = MFMA32(af[6 * 64], b10, di); dr = MFMA32(af[3 * 64], b11, dr); di = MFMA32(af[7 * 64], b11, di); }
        f32x16 av, bv;
        const bool first = !SAMPLE && (t == 0);
#pragma unroll
        for (int i = 0; i < 16; ++i) { const float xcv = jh ? dx1[i] : dx0[i];
            const float r = sigmoidf_(dr[i] + CST[i]), gi = sigmoidf_(di[i] + CST[16 + i]);
            const float a = __builtin_amdgcn_exp2f(r * CST[32 + i]);
            float mult = __builtin_amdgcn_sqrtf(fmaxf(1.f - a * a, 0.f)); if (first) mult = 1.f;
            av[i] = a; bv[i] = mult * gi * xcv; }
        if (SAMPLE && (t & 3) == 0) {
            const float* h0 = A.in[I_SH] + (size_t)(t >> 2) * WA + hd * 64 + 32 * jh + 4 * hh;
#pragma unroll
            for (int i = 0; i < 16; ++i) { bv[i] += av[i] * h0[(i & 3) + 8 * (i >> 2)]; av[i] = 0.f; } }
        rg_scan_step<0x111, 0xF>(av, bv); rg_scan_step<0x112, 0xF>(av, bv); rg_scan_step<0x114, 0xF>(av, bv); rg_scan_step<0x118, 0xF>(av, bv);
        rg_scan_step<0x142, 0xA>(av, bv);
        float hin[16];
#pragma unroll
        for (int i = 0; i < 16; ++i) hin[i] = 0.f;
        if (!SAMPLE) {
        LAS float* TOT = (LAS float*)(L + RGL_TOT) + (rd & 1) * 512;
        if (q == 31) {
#pragma unroll
            for (int i4 = 0; i4 < 4; ++i4) { *(LAS f32x4*)(TOT + (w * 2 + 0) * 32 + hh * 16 + 4 * i4) = (f32x4){av[4 * i4], av[4 * i4 + 1], av[4 * i4 + 2], av[4 * i4 + 3]};
                                             *(LAS f32x4*)(TOT + (w * 2 + 1) * 32 + hh * 16 + 4 * i4) = (f32x4){bv[4 * i4], bv[4 * i4 + 1], bv[4 * i4 + 2], bv[4 * i4 + 3]}; }
        }
        stage_write((rd + 1) & 1, stn);
        __syncthreads();
#pragma unroll
        for (int w2 = 0; w2 < 8; ++w2) {
            if (w2 == w) {
#pragma unroll
                for (int i = 0; i < 16; ++i) hin[i] = hround[i]; }
#pragma unroll
            for (int i4 = 0; i4 < 4; ++i4) { const f32x4 p = *(const LAS f32x4*)(TOT + (w2 * 2 + 0) * 32 + hh * 16 + 4 * i4), hl = *(const LAS f32x4*)(TOT + (w2 * 2 + 1) * 32 + hh * 16 + 4 * i4);
#pragma unroll
                for (int e = 0; e < 4; ++e) hround[4 * i4 + e] = p[e] * hround[4 * i4 + e] + hl[e]; }
        }
        }
        bf16* yr = Yb + (size_t)t * D + hd * 64 + 32 * jh + 4 * hh;
#pragma unroll
        for (int rho = 0; rho < 4; ++rho) { const unsigned glo = (unsigned)gq[rho], ghi = (unsigned)(gq[rho] >> 32);
            const float o0 = gelu_tanh(pg8::bf_lo(glo)) * (bv[4 * rho] + av[4 * rho] * hin[4 * rho]), o1 = gelu_tanh(pg8::bf_hi(glo)) * (bv[4 * rho + 1] + av[4 * rho + 1] * hin[4 * rho + 1]);
            const float o2 = gelu_tanh(pg8::bf_lo(ghi)) * (bv[4 * rho + 2] + av[4 * rho + 2] * hin[4 * rho + 2]), o3 = gelu_tanh(pg8::bf_hi(ghi)) * (bv[4 * rho + 3] + av[4 * rho + 3] * hin[4 * rho + 3]);
            *(unsigned long long*)(yr + 8 * rho) = (unsigned long long)pkbf(o0, o1) | ((unsigned long long)pkbf(o2, o3) << 32); }
        if (SAMPLE && (t & 3) == 3) {
#pragma unroll
            for (int i = 0; i < 16; ++i) F.out[O_HS + (size_t)(t >> 2) * WA + hd * 64 + 32 * jh + (i & 3) + 8 * (i >> 2) + 4 * hh] = bv[i]; }
    }
    if (!SAMPLE && w == 0 && q == 0) {
#pragma unroll
        for (int i = 0; i < 16; ++i) F.out[O_HP + (size_t)b * WA + hd * 64 + 32 * jh + (i & 3) + 8 * (i >> 2) + 4 * hh] = hround[i];
    }
    __syncthreads();
}

#ifndef PROBE_P3PART
#define PROBE_P3PART 7
#endif
__device__ __forceinline__ void p3_mixers_ref(Frame& F, const Args& A, int rep = 0) {
    constexpr int N_RGP = NBP * HA, N_S5P = NBP * GB;
    const int pm = rep ? PROBE_P3PART : 7;
    if (F.vcu < 2 * N_RGP) {
        if (pm & 1) rg_item_fast<false>(F, A, F.vcu / (2 * HA), (F.vcu / 2) % HA, F.vcu & 1);
        if (pm & 4) { if (F.vcu < GB) s5_item_sample(F, A, F.vcu);
                      else if (F.vcu < GB + 2 * HA) rg_item_fast<true>(F, A, 0, (F.vcu - GB) >> 1, (F.vcu - GB) & 1); }
    } else {
        const int v = F.vcu - 2 * N_RGP, it = 2 * v;
        if (pm & 2) { s5_item_fast(F, A, it / GB, it % GB);
                      s5_item_fast(F, A, (it + 1) / GB, (it + 1) % GB); }
    }
    if (rep == 0) xpose_range(F, A, XO_2, XO_END, 0);
}

__global__ void __launch_bounds__(NWAVES * 64, 2) fwd(Args A) {
    extern __shared__ __attribute__((aligned(16))) unsigned char lds[];
    Frame F;
    F.lds = (LAS unsigned char*)lds;
    F.MISC = (volatile LAS unsigned*)(F.lds + MISC_OFF);
    F.tid = threadIdx.x; F.lane = F.tid & 63; F.wave = __builtin_amdgcn_readfirstlane(F.tid >> 6);
    F.G = gridDim.x; { const int bx = blockIdx.x; F.vcu = (F.G % 8 == 0) ? (bx % 8) * (F.G / 8) + bx / 8 : bx; }
    F.out = A.out; F.ws = A.ws; F.ctl = (gu32*)(A.ws + WS_CTL);
    for (int u = F.tid; u < (LDS_BYTES - LDSCTL_OFF) / 4; u += NWAVES * 64) ((LAS unsigned*)(F.lds + LDSCTL_OFF))[u] = 0u;
    __syncthreads();
    XcdBarrier bar; bar.bar = (unsigned*)(F.ctl + CW_BAR); bar.x = 0; bar.st = nullptr;
    if (N_LAUNCHES == 1) bar = xcd_barrier_post((unsigned*)(F.ctl + CW_BAR), F.MISC + 8);
#define GRID_BAR() do { if (N_LAUNCHES == 1) xcd_barrier(bar); } while (0)
    const int lo = A.ph_lo, hi = A.ph_hi;
#define IN(k) (lo <= (k) && (k) < hi)
#define BOTH(k) (IN(k) && IN((k) + 1))
    bf16* XN = (bf16*)(F.ws + WS_XN); bf16* Z = (bf16*)(F.ws + WS_Z); bf16* YC = (bf16*)(F.ws + WS_YCAT); bf16* GY = (bf16*)(F.ws + WS_G); bf16* U = (bf16*)(F.ws + WS_U);
    const float* mod = (const float*)(F.ws + WS_MOD);

#define REPS(k) (((PROBE_DUP) >> (k)) & 1 ? 2 : 1)
#define PH0(rep) p0_prologue(F, A, rep)
#define PH1(rep) p1_modulate(F, A)
#define PH2(rep) do {     \
        pg8::Gemm g{XN, (const bf16*)(F.ws + WS_WIN), M, NZ, D}; pg8::StaticOrder S; S.init(M, NZ, F.G, (int)blockIdx.x, D); \
        pg8::EpiBf16<0> E{Z, NZ, nullptr}; \
        pg8::gemm_phase<pg8::EpiBf16<0>, pg8::StaticOrder, PG8_ALIGN, PG8_SP2>(F.lds + RING_OFF, g, S, E); } while (0)
#define PH3(rep) p3_mixers_ref(F, A, rep)
#define PH4(rep) do {     \
        pg8::Gemm g{GY, (const bf16*)(F.ws + WS_WGLU), M, WB, WB}; pg8::StaticOrder S; S.init(M, WB, F.G, (int)blockIdx.x, WB); \
        pg8::EpiGlu E{GY, WB, YC, D, WA, A.in[I_GLUB]}; \
        pg8::gemm_phase<pg8::EpiGlu, pg8::StaticOrder, PG8_ALIGN, PG8_SP2>(F.lds + RING_OFF, g, S, E); \
        if ((rep) == 0 && (int)blockIdx.x >= (M / 256) * (WB / 256)) { __syncthreads(); xpose_range_b(F, A, XO_OU, XO_2, (M / 256) * (WB / 256)); } } while (0)
#define PH5(rep) do {     \
        pg8::Gemm g{YC, (const bf16*)(F.ws + WS_WOUT), M, D, D}; pg8::SplitOrder S; S.init(MP, D, F.G, (int)blockIdx.x, D, NS_OUT); \
        pg8::EpiRes<false> E{A.in[I_XP], (bf16*)(F.ws + WS_T1), mod + 2 * D, nullptr, ALPHA, MP, (float*)(F.ws + WS_SLAB)}; \
        pg8::gemm_phase<pg8::EpiRes<false>, pg8::SplitOrder, PG8_ALIGN, PG8_SP2>(F.lds + RING_OFF, g, S, E); } while (0)
#define PH6(rep) ln_rows<false>(F, A)
#define PH7(rep) do {     \
        pg8::Gemm g{XN, (const bf16*)(F.ws + WS_W1), M, FF, D}; pg8::StaticOrder S; S.init(M, FF, F.G, (int)blockIdx.x, D); \
        pg8::EpiBf16<3> E{U, FF, A.in[I_B1]}; \
        pg8::gemm_phase<pg8::EpiBf16<3>, pg8::StaticOrder, PG8_ALIGN, PG8_SP2>(F.lds + RING_OFF, g, S, E); } while (0)
#define PH8(rep) do {     \
        pg8::Gemm g{U, (const bf16*)(F.ws + WS_W2), M, D, FF}; pg8::SplitOrder S; S.init(MP, D, F.G, (int)blockIdx.x, FF, NS_DOWN); \
        pg8::EpiRes<true> E{(const bf16*)(F.ws + WS_X1B), (bf16*)(F.ws + WS_T2), mod + 5 * D, A.in[I_B2], ALPHA, MP, (float*)(F.ws + WS_SLAB)}; \
        pg8::gemm_phase<pg8::EpiRes<true>, pg8::SplitOrder, PG8_ALIGN, PG8_SP2>(F.lds + RING_OFF, g, S, E); } while (0)
#define RUN(k, PH) do { if (IN(k)) { PH(0); if (REPS(k) == 2) { __syncthreads(); PH(1); } if (BOTH(k)) GRID_BAR(); } } while (0)
    RUN(0, PH0); RUN(1, PH1); RUN(2, PH2); RUN(3, PH3); RUN(4, PH4); RUN(5, PH5); RUN(6, PH6); RUN(7, PH7); RUN(8, PH8);
    if (IN(9)) { ln_rows<true>(F, A); }
#undef IN
#undef BOTH
}

extern "C" void kernel_launch(void* const* d_in, const int* in_sizes, int n_in, void* d_out, int out_size, void* d_ws, size_t ws_size, hipStream_t stream) {
    static int grid = 0;
    if (grid == 0) {
        if (n_in != 37 || in_sizes[0] != MP * D || out_size != (int)O_END || ws_size < WS_END) { fprintf(stderr, "kernel_launch: unexpected shapes (n_in %d, in0 %d, out %d, ws %zu)\n", n_in, n_in > 0 ? in_sizes[0] : -1, out_size, ws_size); grid = -1; return; }
        int dev = 0, cus = 0, per_cu = 0;
        if (hipGetDevice(&dev) != hipSuccess || hipDeviceGetAttribute(&cus, hipDeviceAttributeMultiprocessorCount, dev) != hipSuccess) { grid = -1; return; }
        if (hipFuncSetAttribute((const void*)fwd, hipFuncAttributeMaxDynamicSharedMemorySize, LDS_BYTES) != hipSuccess) { fprintf(stderr, "kernel_launch: hipFuncSetAttribute failed\n"); grid = -1; return; }
        if (hipOccupancyMaxActiveBlocksPerMultiprocessor(&per_cu, (const void*)fwd, NWAVES * 64, LDS_BYTES) != hipSuccess || per_cu < 1) { fprintf(stderr, "kernel_launch: occupancy query says %d\n", per_cu); }
        (void)hipGetLastError();
        grid = cus;
        if (grid < 256) { fprintf(stderr, "kernel_launch: this build needs 256 CUs (got %d)\n", grid); grid = -1; return; }
        grid = 256;
    }
    if (grid < 0) return;
    (void)hipMemsetAsync((char*)d_ws + WS_CTL, 0, CTL_ZERO_BYTES, stream);
    Args a{};
    for (int i = 0; i < 37; ++i) a.in[i] = (const float*)d_in[i];
    a.out = (float*)d_out; a.ws = (unsigned char*)d_ws;
    for (int li = 0; li < N_LAUNCHES; ++li) {
        if (N_LAUNCHES == 1) { a.ph_lo = 0; a.ph_hi = N_PHASES; } else { a.ph_lo = li; a.ph_hi = li + 1; }
        a.li = li;
        hipLaunchKernelGGL(fwd, dim3(grid), dim3(NWAVES * 64), LDS_BYTES, stream, a);
    }
}
```

```cpp
#include <hip/hip_runtime.h>
#include <cstdio>
#include <cstdint>
#include <cmath>

#ifndef MK_N_LAUNCHES
#define MK_N_LAUNCHES 1
#endif

namespace pg8 {
#define PG8_LAS __attribute__((address_space(3)))
typedef unsigned short bf16_t;
typedef short bf16x8 __attribute__((ext_vector_type(8)));
typedef float f32x4 __attribute__((ext_vector_type(4)));
typedef unsigned u32x4 __attribute__((ext_vector_type(4)));
constexpr int BM = 256, BK = 64, HALF = 128, HTB = HALF * BK * 2, STAGE_BYTES = 8 * HTB, NXCD = 8, WGM = 8;

__host__ __device__ __forceinline__ int lds_byte(int r, int c) { const int st = (r >> 4) * 2 + (c >> 5), rr = r & 15, cc = c & 31, ob = rr * 64 + cc * 2; return st * 1024 + (ob ^ (((ob >> 9) & 1) << 5)); }
__host__ __device__ __forceinline__ void stage_rc(int b, int& R, int& C) { const int st = b / 1024, sb = b % 1024, swz = sb ^ (((sb >> 9) & 1) << 5); R = (st >> 1) * 16 + swz / 64; C = (st & 1) * 32 + (swz % 64) / 2; }
__host__ __device__ __forceinline__ int perm32(int rho) { const int n = rho >> 4, i = rho & 15; return 8 * (i >> 2) + 4 * n + (i & 3); }

struct Unit { int pm, pn, k0, nkt, ks; };
struct Gemm { const bf16_t* A; const bf16_t* Bt; int M, N, K; };

struct StaticOrder {
    int nM, nN, nwg, G, c, K;
    __host__ __device__ void init(int M, int N, int G_, int c_, int K_) { nM = M / BM; nN = N / BM; nwg = nM * nN; G = G_; c = c_; K = K_; }
    __host__ __device__ __forceinline__ bool next(int i, Unit& u) const {
        const long L = (long)i * G + c; if (L >= nwg) return false;
        int wgid = (int)L; { const int q = nwg / NXCD, r = nwg % NXCD, xcd = wgid % NXCD, off = wgid / NXCD; wgid = (xcd < r ? xcd * (q + 1) : r * (q + 1) + (xcd - r) * q) + off; }
        const int nig = WGM * nN, gid = wgid / nig, fm = gid * WGM, gsz = (nM - fm) < WGM ? (nM - fm) : WGM;
        u.pm = fm + ((wgid % nig) % gsz); u.pn = (wgid % nig) / gsz; u.k0 = 0; u.nkt = K / BK; u.ks = 0; return true;
    }
    __device__ __forceinline__ void a_ready(const Unit&) const {}
    __device__ __forceinline__ void done(const Unit&) const {}
};

struct SplitOrder {
    StaticOrder P; int nN, NS, nP, G, c, K, r0;
    __host__ __device__ void init(int MPr, int N, int G_, int c_, int K_, int NS_) { P.init(MPr, N, G_, c_, K_); nN = N / BM; NS = NS_; nP = 2 * nN * NS; G = G_; c = c_; K = K_; r0 = (P.nwg + G - 1 - c) / G;   }
    __host__ __device__ __forceinline__ bool next(int i, Unit& u) const {
        Unit a; a.pm = 0; a.pn = 0; a.k0 = 0; a.nkt = K / BK; a.ks = 0;
        const bool okp = P.next(i < r0 ? i : 0, a);
        const int p = (i - r0) * G + (G - 1 - c), t = p / NS, ks = p % NS, nk = K / BK / NS;
        const bool split = i >= r0;
        u.pm = split ? P.nM + t / nN : a.pm; u.pn = split ? t % nN : a.pn; u.nkt = split ? nk : a.nkt; u.ks = split ? ks : 0; u.k0 = split ? ks * nk * BK : 0;
        return split ? (p < nP) : okp;
    }
    __device__ __forceinline__ void a_ready(const Unit&) const {}
    __device__ __forceinline__ void done(const Unit&) const {}
};

struct OneUnit {
    Unit u0;
    __host__ __device__ __forceinline__ bool next(int i, Unit& u) const { u = u0; return i == 0; }
    __device__ __forceinline__ void a_ready(const Unit&) const {}
    __device__ __forceinline__ void done(const Unit&) const {}
};
__device__ __forceinline__ void st16_wt(void* p, u32x4 v) { asm volatile("global_store_dwordx4 %0, %1, off sc1\n\ts_nop 1" :: "v"(p), "v"(v)); }
__device__ __forceinline__ void st16f_wt(void* p, f32x4 v) { asm volatile("global_store_dwordx4 %0, %1, off sc1\n\ts_nop 1" :: "v"(p), "v"(v)); }
__device__ __forceinline__ unsigned cvt_pk_bf16(float lo, float hi) { unsigned r; asm volatile("v_cvt_pk_bf16_f32 %0, %1, %2" : "=v"(r) : "v"(lo), "v"(hi)); return r; }
__device__ __forceinline__ float bf_lo(unsigned w) { return __builtin_bit_cast(float, w << 16); }
__device__ __forceinline__ float bf_hi(unsigned w) { return __builtin_bit_cast(float, w & 0xffff0000u); }

template <int ACT> struct EpiBf16 {
    static constexpr bool PERM = true, AFTER_DRAIN = false;
    bf16_t* O; int ldc; const float* bias;
    __device__ __forceinline__ void operator()(const f32x4 (&acc)[2][2][4][2], const Unit& u, int wr, int wc, int fr, int fq) const {
        const int row0 = u.pm * BM + wr * 64 + fr; const int col0 = u.pn * BM + wc * 32 + 8 * fq;
        f32x4 bv[2][2];
#pragma unroll
        for (int bj = 0; bj < 2; ++bj)
#pragma unroll
            for (int n = 0; n < 2; ++n) bv[bj][n] = bias ? *(const f32x4*)(bias + col0 + bj * HALF + 4 * n) : (f32x4){0.f, 0.f, 0.f, 0.f};
#pragma unroll
        for (int ai = 0; ai < 2; ++ai)
#pragma unroll
            for (int m = 0; m < 4; ++m) { bf16_t* rowp = O + (size_t)(row0 + ai * HALF + m * 16) * ldc + col0;
#pragma unroll
                for (int bj = 0; bj < 2; ++bj) { f32x4 v0 = acc[ai][bj][m][0] + bv[bj][0], v1 = acc[ai][bj][m][1] + bv[bj][1];
                    if (ACT == 3) {
#pragma unroll
                        for (int e = 0; e < 4; ++e) { const float a = fmaxf(v0[e], 0.f), b = fmaxf(v1[e], 0.f); v0[e] = a * a; v1[e] = b * b; } }
                    u32x4 w; w.x = cvt_pk_bf16(v0[0], v0[1]); w.y = cvt_pk_bf16(v0[2], v0[3]); w.z = cvt_pk_bf16(v1[0], v1[1]); w.w = cvt_pk_bf16(v1[2], v1[3]);
                    *(u32x4*)(rowp + bj * HALF) = w; } }
    }
};
struct EpiGlu {
    static constexpr bool PERM = true, AFTER_DRAIN = false;
    const bf16_t* Gy; int ldg; bf16_t* O; int ldc; int coff; const float* bias;
    __device__ __forceinline__ void operator()(const f32x4 (&acc)[2][2][4][2], const Unit& u, int wr, int wc, int fr, int fq) const {
        const int row0 = u.pm * BM + wr * 64 + fr; const int col0 = u.pn * BM + wc * 32 + 8 * fq;
        f32x4 bv[2][2];
#pragma unroll
        for (int bj = 0; bj < 2; ++bj)
#pragma unroll
            for (int n = 0; n < 2; ++n) bv[bj][n] = *(const f32x4*)(bias + col0 + bj * HALF + 4 * n);
#pragma unroll
        for (int ai = 0; ai < 2; ++ai)
#pragma unroll
            for (int m = 0; m < 4; ++m) { const size_t row = (size_t)(row0 + ai * HALF + m * 16);
#pragma unroll
                for (int bj = 0; bj < 2; ++bj) { const f32x4 v0 = acc[ai][bj][m][0] + bv[bj][0], v1 = acc[ai][bj][m][1] + bv[bj][1];
                    const u32x4 g = *(const u32x4*)(Gy + row * ldg + col0 + bj * HALF);
                    float o[8];
                    o[0] = bf_lo(g.x) * __builtin_amdgcn_rcpf(1.f + __builtin_amdgcn_exp2f(-1.4426950408889634f * v0[0])); o[1] = bf_hi(g.x) * __builtin_amdgcn_rcpf(1.f + __builtin_amdgcn_exp2f(-1.4426950408889634f * v0[1]));
                    o[2] = bf_lo(g.y) * __builtin_amdgcn_rcpf(1.f + __builtin_amdgcn_exp2f(-1.4426950408889634f * v0[2])); o[3] = bf_hi(g.y) * __builtin_amdgcn_rcpf(1.f + __builtin_amdgcn_exp2f(-1.4426950408889634f * v0[3]));
                    o[4] = bf_lo(g.z) * __builtin_amdgcn_rcpf(1.f + __builtin_amdgcn_exp2f(-1.4426950408889634f * v1[0])); o[5] = bf_hi(g.z) * __builtin_amdgcn_rcpf(1.f + __builtin_amdgcn_exp2f(-1.4426950408889634f * v1[1]));
                    o[6] = bf_lo(g.w) * __builtin_amdgcn_rcpf(1.f + __builtin_amdgcn_exp2f(-1.4426950408889634f * v1[2])); o[7] = bf_hi(g.w) * __builtin_amdgcn_rcpf(1.f + __builtin_amdgcn_exp2f(-1.4426950408889634f * v1[3]));
                    u32x4 w; w.x = cvt_pk_bf16(o[0], o[1]); w.y = cvt_pk_bf16(o[2], o[3]); w.z = cvt_pk_bf16(o[4], o[5]); w.w = cvt_pk_bf16(o[6], o[7]);
                    *(u32x4*)(O + row * ldc + coff + col0 + bj * HALF) = w; } }
    }
};
template <bool BASE16> struct EpiRes {
    static constexpr bool PERM = true, AFTER_DRAIN = false;
    const void* basep; bf16_t* T; const float* gate  ; const float* bias; float alpha; int MP; float* slab;
    __device__ __forceinline__ void operator()(const f32x4 (&acc)[2][2][4][2], const Unit& u, int wr, int wc, int fr, int fq) const {
        const int row0 = u.pm * BM + wr * 64 + fr, col0 = u.pn * BM + wc * 32 + 8 * fq;
        if (row0 >= MP) {
            float* sp = slab + (size_t)u.ks * 512 * 1024;
#pragma unroll
            for (int ai = 0; ai < 2; ++ai)
#pragma unroll
                for (int m = 0; m < 4; ++m) { float* op = sp + (size_t)(row0 + ai * HALF + m * 16 - MP) * 1024;
#pragma unroll
                    for (int bj = 0; bj < 2; ++bj)
#pragma unroll
                        for (int n = 0; n < 2; ++n) *(f32x4*)(op + col0 + bj * HALF + n * 4) = acc[ai][bj][m][n]; }
            return; }
        f32x4 bv[2][2];
#pragma unroll
        for (int bj = 0; bj < 2; ++bj)
#pragma unroll
            for (int n = 0; n < 2; ++n) bv[bj][n] = bias ? *(const f32x4*)(bias + col0 + bj * HALF + n * 4) : (f32x4){0.f, 0.f, 0.f, 0.f};
        const float* gp = gate + (size_t)(row0 >> 11) * 6144;
#pragma unroll
        for (int ai = 0; ai < 2; ++ai)
#pragma unroll
            for (int m = 0; m < 4; ++m) { const int row = row0 + ai * HALF + m * 16;
                bf16_t* tp = T + (size_t)row * 1024;
#pragma unroll
                for (int bj = 0; bj < 2; ++bj) { const int c = col0 + bj * HALF;
                    f32x4 b0, b1;
                    if (BASE16) { const u32x4 bw = *(const u32x4*)((const bf16_t*)basep + (size_t)row * 1024 + c); b0 = (f32x4){bf_lo(bw.x), bf_hi(bw.x), bf_lo(bw.y), bf_hi(bw.y)}; b1 = (f32x4){bf_lo(bw.z), bf_hi(bw.z), bf_lo(bw.w), bf_hi(bw.w)}; }
                    else { const float* bp = (const float*)basep + (size_t)row * 1024; b0 = *(const f32x4*)(bp + c); b1 = *(const f32x4*)(bp + c + 4); }
                    const f32x4 g0 = *(const f32x4*)(gp + c), g1 = *(const f32x4*)(gp + c + 4);
                    const f32x4 v0 = b0 * alpha + g0 * (acc[ai][bj][m][0] + bv[bj][0]), v1 = b1 * alpha + g1 * (acc[ai][bj][m][1] + bv[bj][1]);
                    u32x4 w; w.x = cvt_pk_bf16(v0[0], v0[1]); w.y = cvt_pk_bf16(v0[2], v0[3]); w.z = cvt_pk_bf16(v1[0], v1[1]); w.w = cvt_pk_bf16(v1[2], v1[3]);
                    *(u32x4*)(tp + c) = w; } }
    }
};

template <class Epi, class Sched, bool ALIGN_EPI = false, bool SP2 = false>
__device__ __forceinline__ void gemm_phase(PG8_LAS unsigned char* lds, const Gemm g, const Sched& S, const Epi& E) {
    const int tid = threadIdx.x, wid = __builtin_amdgcn_readfirstlane(tid >> 6), lane = tid & 63, wr = wid >> 2, wc = wid & 3, fr = lane & 15, fq = lane >> 4;
    const int K = g.K;
    unsigned voffA[2], voffB[2];
#pragma unroll
    for (int i = 0; i < 2; ++i) { int R, C; stage_rc(tid * 16 + i * 8192, R, C); const int Rb = Epi::PERM ? ((R & ~31) + perm32(R & 31)) : R;
        voffA[i] = (unsigned)(R * K + C) * 2u; voffB[i] = (unsigned)(Rb * K + C) * 2u; }
    const size_t kstep = (size_t)(BK * 2);
    const size_t hstep = (size_t)HALF * K * 2;
    const size_t tstep = 2 * hstep;
    const unsigned ldsw = (unsigned)wid * 1024u;
    const int aoff = lds_byte(wr * 64 + fr, fq * 8), boff = lds_byte(wc * 32 + fr, fq * 8);
#define PG8_SA(b, h) (((b) * 2 + (h)) * HTB)
#define PG8_SB(b, h) ((4 + (b) * 2 + (h)) * HTB)
#define PG8_STAGE(bufoff, gbase, voff) do { _Pragma("unroll") for (int _i = 0; _i < 2; ++_i) \
        __builtin_amdgcn_global_load_lds((const unsigned*)((const char*)(gbase) + (voff)[_i]), (PG8_LAS unsigned*)(lds + (bufoff) + ldsw + _i * 8192), 16, 0, 0); } while (0)
#define PG8_LDA(dst, b, h) do { _Pragma("unroll") for (int m = 0; m < 4; ++m) _Pragma("unroll") for (int k = 0; k < 2; ++k) dst[m][k] = *(const PG8_LAS bf16x8*)(lds + PG8_SA(b, h) + aoff + m * 2048 + k * 1024); } while (0)
#define PG8_LDB(dst, b, h) do { _Pragma("unroll") for (int n = 0; n < 2; ++n) _Pragma("unroll") for (int k = 0; k < 2; ++k) dst[n][k] = *(const PG8_LAS bf16x8*)(lds + PG8_SB(b, h) + boff + n * 2048 + k * 1024); } while (0)
#define PG8_MMA(ai, bj, At, Bt) do { __builtin_amdgcn_s_setprio(1); _Pragma("unroll") for (int m = 0; m < 4; ++m) _Pragma("unroll") for (int n = 0; n < 2; ++n) _Pragma("unroll") for (int k = 0; k < 2; ++k) \
        acc[ai][bj][m][n] = __builtin_amdgcn_mfma_f32_16x16x32_bf16(Bt[n][k], At[m][k], acc[ai][bj][m][n], 0, 0, 0); __builtin_amdgcn_s_setprio(0); } while (0)
#define PG8_WAIT_V(n) asm volatile("s_waitcnt vmcnt(" #n ")" ::: "memory")
#define PG8_WAIT_L(n) asm volatile("s_waitcnt lgkmcnt(" #n ")" ::: "memory")
#define PG8_BAR __builtin_amdgcn_s_barrier()
#define PG8_SCHED __builtin_amdgcn_sched_barrier(0)
    Unit cur, nxt; int ui = 0;
    if (!S.next(0, cur)) return;
    f32x4 acc[2][2][4][2];
#pragma unroll
    for (int a = 0; a < 2; ++a)
#pragma unroll
        for (int b = 0; b < 2; ++b)
#pragma unroll
            for (int m = 0; m < 4; ++m)
#pragma unroll
                for (int n = 0; n < 2; ++n) acc[a][b][m][n] = (f32x4){0.f, 0.f, 0.f, 0.f};
    bf16x8 At[4][2], B0[2][2], B1[2][2];
    const char* cA = (const char*)g.A + (size_t)cur.pm * tstep + (size_t)cur.k0 * 2; const char* cB = (const char*)g.Bt + (size_t)cur.pn * tstep + (size_t)cur.k0 * 2;
    S.a_ready(cur);
    if constexpr (SP2) {
        PG8_STAGE(PG8_SB(0, 0), cB, voffB); PG8_STAGE(PG8_SB(0, 1), cB + hstep, voffB); PG8_STAGE(PG8_SA(0, 0), cA, voffA); PG8_STAGE(PG8_SA(0, 1), cA + hstep, voffA);
        if (wr == 1) PG8_BAR;
        PG8_WAIT_V(2); PG8_BAR;
        PG8_STAGE(PG8_SB(1, 0), cB + kstep, voffB); PG8_STAGE(PG8_SA(1, 0), cA + kstep, voffA); PG8_STAGE(PG8_SB(1, 1), cB + hstep + kstep, voffB);
        PG8_WAIT_V(6); PG8_BAR;
    } else {
        PG8_STAGE(PG8_SB(0, 0), cB, voffB); PG8_STAGE(PG8_SA(0, 0), cA, voffA); PG8_STAGE(PG8_SB(0, 1), cB + hstep, voffB); PG8_STAGE(PG8_SA(0, 1), cA + hstep, voffA);
        if (wr == 1) PG8_BAR;
        PG8_WAIT_V(4); PG8_BAR;
        PG8_STAGE(PG8_SB(1, 0), cB + kstep, voffB); PG8_STAGE(PG8_SA(1, 0), cA + kstep, voffA); PG8_STAGE(PG8_SB(1, 1), cB + hstep + kstep, voffB);
        PG8_WAIT_V(6); PG8_BAR;
    }
    for (;;) {
        const bool has_next = S.next(ui + 1, nxt);
        const char* nA = has_next ? (const char*)g.A + (size_t)nxt.pm * tstep + (size_t)nxt.k0 * 2 : cA; const char* nB = has_next ? (const char*)g.Bt + (size_t)nxt.pn * tstep + (size_t)nxt.k0 * 2 : cB;
        const int nt = cur.nkt;
        for (int t = 0; t < nt; t += 2) {
            const bool last = (t == nt - 2);
            const char* a1 = cA + (size_t)(t + 1) * kstep;
            const char* a2 = last ? nA : cA + (size_t)(t + 2) * kstep; const char* b2 = last ? nB : cB + (size_t)(t + 2) * kstep;
            const char* a3 = a2 + kstep; const char* b3 = b2 + kstep;
            if (last && has_next) S.a_ready(nxt);
            if constexpr (SP2) {
            PG8_LDB(B0, 0, 0); PG8_LDB(B1, 0, 1); PG8_SCHED; PG8_LDA(At, 0, 0); PG8_STAGE(PG8_SA(1, 1), a1 + hstep, voffA);
            PG8_WAIT_V(8); PG8_WAIT_L(0); PG8_BAR; PG8_MMA(0, 0, At, B0); PG8_MMA(0, 1, At, B1); PG8_BAR; PG8_SCHED;
            PG8_LDA(At, 0, 1); PG8_STAGE(PG8_SB(0, 0), b2, voffB); PG8_STAGE(PG8_SB(0, 1), b2 + hstep, voffB); PG8_STAGE(PG8_SA(0, 0), a2, voffA);
            PG8_WAIT_V(8); PG8_WAIT_L(0); PG8_BAR; PG8_MMA(1, 0, At, B0); PG8_MMA(1, 1, At, B1); PG8_BAR; PG8_SCHED;
            PG8_LDB(B0, 1, 0); PG8_LDB(B1, 1, 1); PG8_SCHED; PG8_LDA(At, 1, 0); PG8_STAGE(PG8_SA(0, 1), a2 + hstep, voffA);
            PG8_WAIT_V(8); PG8_WAIT_L(0); PG8_BAR; PG8_MMA(0, 0, At, B0); PG8_MMA(0, 1, At, B1); PG8_BAR; PG8_SCHED;
            PG8_LDA(At, 1, 1); PG8_STAGE(PG8_SB(1, 0), b3, voffB); PG8_STAGE(PG8_SB(1, 1), b3 + hstep, voffB); PG8_STAGE(PG8_SA(1, 0), a3, voffA);
            PG8_WAIT_V(8); PG8_WAIT_L(0); PG8_BAR; PG8_MMA(1, 0, At, B0); PG8_MMA(1, 1, At, B1); PG8_BAR; PG8_SCHED;
            } else {
            PG8_LDB(B0, 0, 0); PG8_SCHED; PG8_LDA(At, 0, 0); PG8_STAGE(PG8_SA(1, 1), a1 + hstep, voffA);
            PG8_WAIT_L(8); PG8_BAR; PG8_WAIT_L(0); PG8_MMA(0, 0, At, B0); PG8_BAR; PG8_SCHED;
            PG8_LDB(B1, 0, 1); PG8_STAGE(PG8_SB(0, 0), b2, voffB);
            PG8_BAR; PG8_WAIT_L(0); PG8_MMA(0, 1, At, B1); PG8_BAR;
            PG8_LDA(At, 0, 1); PG8_STAGE(PG8_SA(0, 0), a2, voffA);
            PG8_BAR; PG8_WAIT_L(0); PG8_MMA(1, 0, At, B0); PG8_BAR; PG8_SCHED;
            PG8_STAGE(PG8_SB(0, 1), b2 + hstep, voffB);
            PG8_WAIT_V(6); PG8_BAR; PG8_MMA(1, 1, At, B1); PG8_BAR;
            PG8_LDB(B0, 1, 0); PG8_SCHED; PG8_LDA(At, 1, 0); PG8_STAGE(PG8_SA(0, 1), a2 + hstep, voffA);
            PG8_WAIT_L(8); PG8_BAR; PG8_WAIT_L(0); PG8_MMA(0, 0, At, B0); PG8_BAR; PG8_SCHED;
            PG8_LDB(B1, 1, 1); PG8_STAGE(PG8_SB(1, 0), b3, voffB);
            PG8_BAR; PG8_WAIT_L(0); PG8_MMA(0, 1, At, B1); PG8_BAR;
            PG8_LDA(At, 1, 1); PG8_STAGE(PG8_SA(1, 0), a3, voffA);
            PG8_BAR; PG8_WAIT_L(0); PG8_MMA(1, 0, At, B0); PG8_BAR; PG8_SCHED;
            PG8_STAGE(PG8_SB(1, 1), b3 + hstep, voffB);
            PG8_WAIT_V(6); PG8_BAR; PG8_MMA(1, 1, At, B1); PG8_BAR;
            }
        }
        if constexpr (ALIGN_EPI) { if (wr == 0) PG8_BAR; }
        if constexpr (!Epi::AFTER_DRAIN) { E(acc, cur, wr, wc, fr, fq); S.done(cur); }
        if (!has_next) break;
#pragma unroll
        for (int a = 0; a < 2; ++a)
#pragma unroll
            for (int b = 0; b < 2; ++b)
#pragma unroll
                for (int m = 0; m < 4; ++m)
#pragma unroll
                    for (int n = 0; n < 2; ++n) acc[a][b][m][n] = (f32x4){0.f, 0.f, 0.f, 0.f};
        cur = nxt; cA = nA; cB = nB; ++ui;
        if constexpr (ALIGN_EPI) { if (wr == 1) PG8_BAR; }
    }
    PG8_WAIT_V(0);
    if constexpr (!ALIGN_EPI) { if (wr == 0) PG8_BAR; }
    PG8_BAR;
#undef PG8_SA
#undef PG8_SB
#undef PG8_STAGE
#undef PG8_LDA
#undef PG8_LDB
#undef PG8_MMA
#undef PG8_WAIT_V
#undef PG8_WAIT_L
#undef PG8_BAR
#undef PG8_SCHED
}
}

#ifndef PROBE_DUP
#define PROBE_DUP 0
#endif
#ifndef PG8_SP2
#define PG8_SP2 true
#endif
#ifndef PG8_ALIGN
#define PG8_ALIGN true
#endif

constexpr int NWAVES = 8;
constexpr int N_LAUNCHES = MK_N_LAUNCHES;
constexpr int N_PHASES = 10;
constexpr int D = 1024, MP = 16384, MS = 512, M = MP + MS, TP = 2048, NBP = 8, NBS = 128, TS = 4;
constexpr int NZ = 1536, WA = 512, WB = 512, FF = 4096, NMOD = 6 * D, NROWMOD = NBP + NBS;
constexpr int GB = 32, NS5 = 64, KS5 = 16, HA = 8, HDA = 64;
constexpr float LN_EPS = 1e-5f;
constexpr int NS_OUT = 4, NS_DOWN = 8;
constexpr float ALPHA = 1.189207115002721f;

constexpr size_t O_YP = 0, O_YS = (size_t)MP * D, O_CONVP = O_YS + (size_t)MS * D, O_HP = O_CONVP + (size_t)NBP * 3 * WA, O_SRP = O_HP + (size_t)NBP * WA,
                 O_SIP = O_SRP + (size_t)NBP * GB * NS5, O_CONVS = O_SIP + (size_t)NBP * GB * NS5, O_HS = O_CONVS + (size_t)NBS * 3 * WA, O_SRS = O_HS + (size_t)NBS * WA,
                 O_SIS = O_SRS + (size_t)NBS * GB * NS5, O_END = O_SIS + (size_t)NBS * GB * NS5;

constexpr size_t MiB = 1u << 20;
constexpr size_t WS_CTL = 0, CTL_ZERO_BYTES = 1 * MiB;
constexpr size_t WS_WIN = 1 * MiB, WS_WGLU = 4 * MiB, WS_WOUT = 5 * MiB, WS_W1 = 7 * MiB, WS_W2 = 15 * MiB;
constexpr size_t WS_MOD = 23 * MiB;
constexpr size_t WS_S5C = 27 * MiB;
constexpr size_t WS_XN = 28 * MiB;
constexpr size_t WS_Z = 61 * MiB;
constexpr size_t WS_YCAT = 111 * MiB;
constexpr size_t WS_G = 144 * MiB;
constexpr size_t WS_U = 61 * MiB;
constexpr size_t WS_T1 = WS_Z;
constexpr size_t WS_T2 = WS_XN;
constexpr size_t WS_TAB = 194 * MiB;
constexpr size_t WS_SLAB = 196 * MiB;
constexpr size_t WS_X1B = 212 * MiB;
constexpr size_t WS_END = 246 * MiB;
constexpr size_t TB_BF1 = 0, TB_BF2 = TB_BF1 + 32 * 4 * 64 * 16, TB_TA = TB_BF2 + 32 * 8 * 64 * 16, TB_ZP = TB_TA + 32 * 2 * 2 * 32 * 4, TB_Z16N = TB_ZP + 32 * 17 * 2 * 2 * 32 * 4,
                 TB_RG = TB_Z16N + 32 * 2 * 64 * 4, TB_CB = TB_RG + 8 * 2 * 2 * 4 * 64 * 16, TB_SILU = TB_CB + 128 * 3 * 512 * 2, TB_DG = TB_SILU + 160 * 1024 * 2, TB_END = TB_DG + 8 * 16 * 64 * 16;
static_assert(WS_TAB + TB_END <= WS_SLAB, "tables");
static_assert(WS_XN + (size_t)M * D * 2 <= WS_Z && WS_Z + (size_t)M * NZ * 2 <= WS_YCAT && WS_YCAT + (size_t)M * D * 2 <= WS_G && WS_G + (size_t)M * WB * 2 <= WS_END && WS_U + (size_t)M * FF * 2 <= WS_TAB, "d_ws map");
constexpr int SC_ABR = 0, SC_ABI = 2048, SC_BBR = 4096, SC_BBI = 4096 + 32768, SC_RGL = 4096 + 65536, SC_END = SC_RGL + 512;
constexpr int CW_TMO = 0, CW_CODE = 1, CW_SILU = 64, CW_MOD = 1024  , CW_S5B = 128  , CW_BAR = 4096;

constexpr int RING_OFF = 0, RING_BYTES = 131072;
constexpr int LDSCTL_OFF = RING_BYTES, MISC_OFF = LDSCTL_OFF + 320;
constexpr int LDS_BYTES = 147456;

#define GAS __attribute__((address_space(1)))
#define LAS __attribute__((address_space(3)))
typedef unsigned short bf16;
typedef unsigned v4u __attribute__((ext_vector_type(4)));
typedef float f32x4 __attribute__((ext_vector_type(4)));
typedef GAS unsigned gu32;
#define RLX_AGENT __ATOMIC_RELAXED, __HIP_MEMORY_SCOPE_AGENT
#define LDS_WAIT() asm volatile("s_waitcnt lgkmcnt(0)" ::: "memory")
#define VM_WAIT() asm volatile("s_waitcnt vmcnt(0)" ::: "memory")
__device__ __forceinline__ unsigned f2bf(float f) { unsigned u = __builtin_bit_cast(unsigned, f); return (u + 0x7fffu + ((u >> 16) & 1u)) >> 16; }
__device__ __forceinline__ unsigned pk2(float lo, float hi) { return f2bf(lo) | (f2bf(hi) << 16); }
__device__ __forceinline__ float bf2f(bf16 v) { return __builtin_bit_cast(float, (unsigned)v << 16); }
__device__ __forceinline__ float gelu_tanh(float x) { const float t = -2.3022082f * (x + 0.044715f * x * x * x); return x * __builtin_amdgcn_rcpf(1.f + __builtin_amdgcn_exp2f(t)); }
__device__ __forceinline__ float sigmoidf_(float x) { return __builtin_amdgcn_rcpf(1.f + __builtin_amdgcn_exp2f(-1.4426950408889634f * x)); }

#define XB_TMO      128
#define XB_XCNT(j)  (256  + 64 * (j))
#define XB_XSUB(j)  (1280 + 64 * (j))
#define XB_XGEN(j)  (2304 + 64 * (j))
#define XB_TOP      3328
#define XB_TOPGEN   3392
#define XCD_BAR_WORDS 3456
#define XB_SPIN_CAP (1u << 18)
__device__ __forceinline__ unsigned xb_ld(unsigned* p)              { return __hip_atomic_load(p, __ATOMIC_RELAXED, __HIP_MEMORY_SCOPE_AGENT); }
__device__ __forceinline__ unsigned xb_add(unsigned* p, unsigned v) { return __hip_atomic_fetch_add(p, v, __ATOMIC_RELAXED, __HIP_MEMORY_SCOPE_AGENT); }
__device__ __forceinline__ unsigned xb_xcc_id() { return (unsigned)__builtin_amdgcn_s_getreg((3 << 11) | 20) & 0xFu; }
#define XB_SPIN(cond, bar) do { unsigned _sp = 0; while (cond) { __builtin_amdgcn_s_sleep(1); \
    if ((++_sp & 255u) == 0u) { if (xb_ld(&(bar)[XB_TMO])) break; if (_sp > XB_SPIN_CAP) { atomicAdd(&(bar)[XB_TMO], 1u); break; } } } } while (0)
struct XcdBarrier { unsigned* bar; unsigned x; volatile LAS unsigned* st; };
__device__ __forceinline__ XcdBarrier xcd_barrier_post(unsigned* bar, volatile LAS unsigned* st) {
    XcdBarrier b; b.bar = bar; b.x = xb_xcc_id(); b.st = st;
    if (threadIdx.x == 0) (void)xb_add(&bar[XB_XCNT(b.x)], 1u);
    return b;
}
__device__ __forceinline__ void xcd_barrier_complete(unsigned* bar, unsigned x, unsigned& nloc, unsigned& nx) {
    const unsigned G = gridDim.x * gridDim.y * gridDim.z;
    unsigned sum, cnt, mine, sp = 0u;
    for (;;) {
        sum = 0u; cnt = 0u; mine = 0u;
#pragma unroll
        for (unsigned j = 0; j < 16; ++j) { const unsigned c = xb_ld(&bar[XB_XCNT(j)]); sum += c; cnt += (c > 0u) ? 1u : 0u; mine = (j == x) ? c : mine; }
        if (sum == G) break;
        __builtin_amdgcn_s_sleep(1);
        if ((++sp & 255u) == 0u) { if (xb_ld(&bar[XB_TMO])) break; if (sp > XB_SPIN_CAP) { atomicAdd(&bar[XB_TMO], 1u); break; } }
    }
    nloc = mine > 0u ? mine : 1u; nx = cnt > 0u ? cnt : 1u;
}
__device__ __forceinline__ void xcd_barrier(const XcdBarrier& b) {
    asm volatile("s_waitcnt vmcnt(0)" ::: "memory");
    __syncthreads();
    if (threadIdx.x == 0) {
        unsigned* bar = b.bar;
        __builtin_amdgcn_s_waitcnt(0);
        unsigned nloc = b.st[0], nx = b.st[1];
        if (nloc == 0u) { xcd_barrier_complete(bar, b.x, nloc, nx); b.st[0] = nloc; b.st[1] = nx; }
        const unsigned old = xb_add(&bar[XB_XSUB(b.x)], 1u);
        const unsigned gen = old / nloc;
        if (old + 1u == (gen + 1u) * nloc) {
            __builtin_amdgcn_fence(__ATOMIC_RELEASE, "agent");
            asm volatile("s_waitcnt vmcnt(0)" ::: "memory");
            const unsigned og = xb_add(&bar[XB_TOP], 1u);
            const unsigned tg = og / nx;
            if (og + 1u == (tg + 1u) * nx) xb_add(&bar[XB_TOPGEN], 1u);
            else XB_SPIN(xb_ld(&bar[XB_TOPGEN]) == tg, bar);
            __builtin_amdgcn_fence(__ATOMIC_ACQUIRE, "agent");
            xb_add(&bar[XB_XGEN(b.x)], 1u);
            asm volatile("s_waitcnt vmcnt(0)" ::: "memory");
        } else {
            XB_SPIN(xb_ld(&bar[XB_XGEN(b.x)]) == gen, bar);
            __builtin_amdgcn_fence(__ATOMIC_ACQUIRE, "agent");
            asm volatile("s_waitcnt vmcnt(0)" ::: "memory");
        }
    }
    __syncthreads();
}

struct Frame {
    LAS unsigned char* lds;
    volatile LAS unsigned* MISC;
    gu32* ctl;
    int tid, lane, wave;
    int vcu, G;
    float* out;
    unsigned char* ws;
};
struct Args { const float* in[37]; float* out; unsigned char* ws; int ph_lo, ph_hi, li, pad; };
__device__ __forceinline__ void refresh(Frame& F) { int t = threadIdx.x; asm volatile("" : "+v"(t)); F.tid = t; F.lane = t & 63; F.wave = __builtin_amdgcn_readfirstlane(t >> 6); }
__device__ __forceinline__ void cnt_arrive(Frame& F, int word) {
    VM_WAIT(); __syncthreads();
    if (F.tid == 0) { __builtin_amdgcn_fence(__ATOMIC_RELEASE, "agent"); VM_WAIT(); (void)__hip_atomic_fetch_add((unsigned*)(F.ctl + word), 1u, RLX_AGENT); }
}
__device__ __forceinline__ void cnt_wait_ge(Frame& F, int word, unsigned target) {
    if (F.tid == 0) { unsigned sp = 0; while (__hip_atomic_load((unsigned*)(F.ctl + word), RLX_AGENT) < target && ++sp < (1u << 22)) __builtin_amdgcn_s_sleep(2);
        __builtin_amdgcn_fence(__ATOMIC_ACQUIRE, "agent"); VM_WAIT(); }
    __syncthreads();
}
__device__ __forceinline__ float wave_sum(float v) {
#pragma unroll
    for (int o = 1; o < 64; o <<= 1) v += __shfl_xor(v, o);
    return v;
}
enum { I_XP = 0, I_XS, I_SCONV, I_SH, I_SSR, I_SSI, I_CP, I_CS, I_ADAW, I_ADAB, I_INPROJ, I_CONVW, I_CONVB, I_RGWR, I_RGBR, I_RGWI, I_RGBI, I_RGLAM,
       I_S5ARE, I_S5AIM, I_S5LOGDT, I_S5BRE, I_S5BIM, I_S5CRE, I_S5CIM, I_S5D, I_GLUW, I_GLUB, I_OUTPROJ, I_LN1G, I_LN1B, I_W1, I_B1, I_W2, I_B2, I_LN2G, I_LN2B };

typedef float f32x2m __attribute__((ext_vector_type(2)));
typedef __bf16 bf16x2m __attribute__((ext_vector_type(2)));
__device__ __forceinline__ unsigned pkbf0(float a, float b) { const f32x2m v = {a, b}; const bf16x2m r = __builtin_convertvector(v, bf16x2m); return __builtin_bit_cast(unsigned, r); }
typedef short bf16x8m __attribute__((ext_vector_type(8)));
typedef float f32x16m __attribute__((ext_vector_type(16)));
__device__ __forceinline__ void p0_transpose_item(const float* W, int K, int N, bf16* WT, LAS float* scr, int item, int lane) {
    const int nblk = N / 32, kb = item / nblk, nb = item % nblk, k0 = 64 * kb, n0 = 32 * nb;
#pragma unroll 8
    for (int i = 0; i < 32; ++i) { const int kk = 2 * i + (lane >> 5); scr[kk * 33 + (lane & 31)] = W[(size_t)(k0 + kk) * N + n0 + (lane & 31)]; }
    LDS_WAIT(); asm volatile("" ::: "memory");
    const int c = lane & 7;
#pragma unroll
    for (int j = 0; j < 4; ++j) { const int n = (lane >> 3) + 8 * j; const LAS float* s = scr + (8 * c) * 33 + n;
        v4u o; o.x = pk2(s[0 * 33], s[1 * 33]); o.y = pk2(s[2 * 33], s[3 * 33]); o.z = pk2(s[4 * 33], s[5 * 33]); o.w = pk2(s[6 * 33], s[7 * 33]);
        *(GAS v4u*)(WT + (size_t)(n0 + n) * K + k0 + 8 * c) = o; }
    LDS_WAIT(); asm volatile("" ::: "memory");
}

constexpr int XI_IN = (D / 64) * (NZ / 32), XI_GL = (WB / 64) * (WB / 32), XI_OU = (D / 64) * (D / 32), XI_1 = (D / 64) * (FF / 32), XI_2 = (FF / 64) * (D / 32);
constexpr int XO_OU = XI_IN + XI_GL, XO_1 = XO_OU + XI_OU, XO_2 = XO_1 + XI_1, XO_END = XO_2 + XI_2;
__device__ __forceinline__ void xpose_item(Frame& F, const Args& A, LAS float* scr, int r) {
    if (r < XI_IN) { p0_transpose_item(A.in[I_INPROJ], D, NZ, (bf16*)(F.ws + WS_WIN), scr, r, F.lane); return; } r -= XI_IN;
    if (r < XI_GL) { p0_transpose_item(A.in[I_GLUW], WB, WB, (bf16*)(F.ws + WS_WGLU), scr, r, F.lane); return; } r -= XI_GL;
    if (r < XI_OU) { p0_transpose_item(A.in[I_OUTPROJ], D, D, (bf16*)(F.ws + WS_WOUT), scr, r, F.lane); return; } r -= XI_OU;
    if (r < XI_1) { p0_transpose_item(A.in[I_W1], D, FF, (bf16*)(F.ws + WS_W1), scr, r, F.lane); return; } r -= XI_1;
    p0_transpose_item(A.in[I_W2], FF, D, (bf16*)(F.ws + WS_W2), scr, r, F.lane);
}
__device__ __forceinline__ void xpose_range(Frame& F, const Args& A, int lo, int hi, int vlo) {
    refresh(F);
    if (F.vcu < vlo) return;
    LAS float* scr = (LAS float*)(F.lds + RING_OFF + F.wave * 16384);
    const int gw = F.wave * (F.G - vlo) + (F.vcu - vlo), ngw = (F.G - vlo) * NWAVES;
    for (int it = lo + gw; it < hi; it += ngw) xpose_item(F, A, scr, it);
}
__device__ __forceinline__ void xpose_range_b(Frame& F, const Args& A, int lo, int hi, int blo) {
    refresh(F);
    LAS float* scr = (LAS float*)(F.lds + RING_OFF + F.wave * 16384);
    const int gw = F.wave * (F.G - blo) + ((int)blockIdx.x - blo), ngw = (F.G - blo) * NWAVES;
    for (int it = lo + gw; it < hi; it += ngw) xpose_item(F, A, scr, it);
}
#ifndef PROBE_P0PART
#define PROBE_P0PART 7
#endif
__device__ __forceinline__ void p0_prologue(Frame& F, const Args& A, int rep = 0) {
    refresh(F);
    const int pmask = rep ? PROBE_P0PART : 7;
    LAS float* scr = (LAS float*)(F.lds + RING_OFF + F.wave * 16384);
    const int gw = F.wave * F.G + F.vcu, NGW = F.G * NWAVES;
    {
        bf16* ST = (bf16*)(F.ws + WS_TAB + TB_SILU);
        for (int ch = F.vcu * NWAVES * 64 + F.tid; ch < 160 * 1024 / 8; ch += F.G * NWAVES * 64) { const int row = ch >> 7, k = (ch & 127) * 8; v4u o = (v4u){0u, 0u, 0u, 0u};
            if (row < NROWMOD) { const float* cp = (row < NBP ? A.in[I_CP] + (size_t)row * D : A.in[I_CS] + (size_t)(row - NBP) * D) + k; const f32x4 c0 = *(const f32x4*)cp, c1 = *(const f32x4*)(cp + 4);
                o.x = pk2(c0[0] * sigmoidf_(c0[0]), c0[1] * sigmoidf_(c0[1])); o.y = pk2(c0[2] * sigmoidf_(c0[2]), c0[3] * sigmoidf_(c0[3]));
                o.z = pk2(c1[0] * sigmoidf_(c1[0]), c1[1] * sigmoidf_(c1[1])); o.w = pk2(c1[2] * sigmoidf_(c1[2]), c1[3] * sigmoidf_(c1[3])); }
            *(v4u*)(ST + (size_t)ch * 8) = o; }
        VM_WAIT(); __syncthreads();
        if (F.tid == 0) { __builtin_amdgcn_fence(__ATOMIC_RELEASE, "agent"); VM_WAIT(); (void)__hip_atomic_fetch_add((unsigned*)(F.ctl + CW_SILU), 1u, RLX_AGENT); }
    }
    constexpr int I_IN = XI_IN, I_GL = XI_GL;
    constexpr int I_S5 = GB, I_RG = WA / 64, I_RGT = HA * 2 * 2 * 4, I_CB = NBS * 3 * WA / 512, I_DG = HA * 16;
    constexpr int NITEMS = I_IN + I_GL + I_S5 + I_RG + I_RGT + I_CB + I_DG;
    float* sc = (float*)(F.ws + WS_S5C);
    for (int it = gw; it < NITEMS; it += NGW) {
        int r = it;
        if (!(pmask & 1) && it < I_IN + I_GL) continue;
        if (!(pmask & 2) && it >= I_IN + I_GL) continue;
        if (r < I_IN + I_GL) { xpose_item(F, A, scr, r); continue; } r -= I_IN + I_GL;
        if (r < I_S5) {
            const int g = r, n = F.lane, gn = g * NS5 + n;
            const double dt = exp((double)A.in[I_S5LOGDT][g]), ar = (double)A.in[I_S5ARE][gn], ai = (double)A.in[I_S5AIM][gn];
            const double mag = exp(dt * ar), abr = mag * cos(dt * ai), abi = mag * sin(dt * ai), den = ar * ar + ai * ai, nr = abr - 1.0;
            const double qr = (nr * ar + abi * ai) / den, qi = (abi * ar - nr * ai) / den;
            sc[SC_ABR + gn] = (float)abr; sc[SC_ABI + gn] = (float)abi;
            unsigned char* tab = F.ws + WS_TAB;
            bf16* BF1 = (bf16*)(tab + TB_BF1); bf16* BF2 = (bf16*)(tab + TB_BF2); float* TA = (float*)(tab + TB_TA); float* ZP = (float*)(tab + TB_ZP); float* Z16N = (float*)(tab + TB_Z16N);
            const int sh = n >> 5, v = n & 31, hh = (v >> 2) & 1, ii = (v & 3) + 4 * (v >> 3);
            for (int k = 0; k < KS5; ++k) { const double br = (double)A.in[I_S5BRE][gn * KS5 + k], bi = (double)A.in[I_S5BIM][gn * KS5 + k];
                const float vr = (float)(qr * br - qi * bi), vi = (float)(qr * bi + qi * br);
                sc[SC_BBR + gn * KS5 + k] = vr; sc[SC_BBI + gn * KS5 + k] = vi;
                const int lp = (n & 31) + 32 * (k >> 3), jj = k & 7;
                BF1[(size_t)((g * 4 + 0 + sh) * 64 + lp) * 8 + jj] = (bf16)f2bf(vr); BF1[(size_t)((g * 4 + 2 + sh) * 64 + lp) * 8 + jj] = (bf16)f2bf(vi); }
            { const int s2 = (n >> 4) & 1, jj = 4 * ((n >> 3) & 1) + (n & 3), hk = (n >> 2) & 1;
              for (int ch = 0; ch < KS5; ++ch) { const int hr_ = ch >> 3, i8 = ch & 7, R = (i8 & 3) + 8 * (i8 >> 2) + 4 * hr_, lp = R + 32 * hk;
                  const float cr = A.in[I_S5CRE][(size_t)(g * KS5 + ch) * NS5 + n], ci = A.in[I_S5CIM][(size_t)(g * KS5 + ch) * NS5 + n];
                  BF2[(size_t)((g * 8 + (0 + sh) * 2 + s2) * 64 + lp) * 8 + jj] = (bf16)f2bf(cr); BF2[(size_t)((g * 8 + (2 + sh) * 2 + s2) * 64 + lp) * 8 + jj] = (bf16)f2bf(-ci); }
              for (int z = 0; z < 4; ++z) { const int cidx = n + 64 * z, ks = cidx >> 5, r16 = cidx & 31, lp = 16 + (r16 & 15) + 32 * (r16 >> 4);
                  *(v4u*)(BF2 + (size_t)((g * 8 + ks) * 64 + lp) * 8) = (v4u){0u, 0u, 0u, 0u}; } }
            TA[((g * 2 + hh) * 2 + 0) * 32 + sh * 16 + ii] = (float)abr; TA[((g * 2 + hh) * 2 + 1) * 32 + sh * 16 + ii] = (float)abi;
            const double mg8 = exp(8.0 * dt * ar), z1r = mg8 * cos(8.0 * dt * ai), z1i = mg8 * sin(8.0 * dt * ai); double pzr = 1.0, pzi = 0.0;
            for (int e = 0; e <= 16; ++e) { const float zr = (float)pzr, zi = (float)pzi; { const double nr2 = pzr * z1r - pzi * z1i, ni2 = pzr * z1i + pzi * z1r; pzr = nr2; pzi = ni2; }
                ZP[(((g * 17 + e) * 2 + hh) * 2 + 0) * 32 + sh * 16 + ii] = zr; ZP[(((g * 17 + e) * 2 + hh) * 2 + 1) * 32 + sh * 16 + ii] = zi;
                if (e == 16) { Z16N[(g * 2 + 0) * 64 + n] = zr; Z16N[(g * 2 + 1) * 64 + n] = zi; } }
            continue; } r -= I_S5;
        if (r < I_RG) { const int c = r * 64 + F.lane; const double lam = (double)A.in[I_RGLAM][c];
          sc[SC_RGL + c] = (float)(-8.0 * log1p(exp(-lam)) * 1.4426950408889634); continue; } r -= I_RG;
        if (r >= I_RGT + I_CB) { r -= I_RGT + I_CB;
            const int k = r & 3, sp = (r >> 2) & 1, tau = (r >> 3) & 1, hd = r >> 4, R = F.lane & 31, hk = F.lane >> 5;
            unsigned wv = 0u; if ((R >> 3) == 2 * sp + hk) wv = f2bf(A.in[I_CONVW][k * WA + hd * 64 + 32 * tau + R]);
            const int jj = R & 7; v4u o = (v4u){0u, 0u, 0u, 0u}; const unsigned word = (jj & 1) ? (wv << 16) : wv;
            if ((jj >> 1) == 0) o.x = word; else if ((jj >> 1) == 1) o.y = word; else if ((jj >> 1) == 2) o.z = word; else o.w = word;
            *(v4u*)(F.ws + WS_TAB + TB_DG + (size_t)(r * 64 + F.lane) * 16) = o; continue; }
        if (r >= I_RGT) { r -= I_RGT;
            const float* src = A.in[I_SCONV] + (size_t)r * 512 + F.lane * 8; const f32x4 a0 = *(const f32x4*)src, a1 = *(const f32x4*)(src + 4);
            v4u o; o.x = pk2(a0[0], a0[1]); o.y = pk2(a0[2], a0[3]); o.z = pk2(a1[0], a1[1]); o.w = pk2(a1[2], a1[3]);
            *(v4u*)(F.ws + WS_TAB + TB_CB + ((size_t)r * 512 + F.lane * 8) * 2) = o; continue; }
        {
            const int ks = r & 3, gate = (r >> 2) & 1, jh = (r >> 3) & 1, hd = r >> 4;
            const int R = F.lane & 31, hk = F.lane >> 5;
            const float* W = A.in[gate ? I_RGWI : I_RGWR] + (size_t)(hd * 64 + 32 * (ks >> 1) + 16 * (ks & 1) + 4 * hk) * 64 + 32 * jh + R;
            v4u o; o.x = pk2(W[0], W[64]); o.y = pk2(W[128], W[192]); o.z = pk2(W[8 * 64], W[9 * 64]); o.w = pk2(W[10 * 64], W[11 * 64]);
            *(v4u*)(F.ws + WS_TAB + TB_RG + (size_t)(r * 64 + F.lane) * 16) = o;
        }
    }
    __syncthreads();
    if (F.tid == 0) {
        unsigned sp = 0; while (__hip_atomic_load((unsigned*)(F.ctl + CW_SILU), RLX_AGENT) < (unsigned)F.G * (unsigned)(rep + 1) && ++sp < (1u << 22)) __builtin_amdgcn_s_sleep(2);
        __builtin_amdgcn_fence(__ATOMIC_ACQUIRE, "agent"); VM_WAIT(); }
    __syncthreads();
    LAS float* RED = (LAS float*)(F.lds + RING_OFF);
    float* mod = (float*)(F.ws + WS_MOD);
    const int r32 = F.lane & 31, hh = F.lane >> 5;
    const bf16* ST = (const bf16*)(F.ws + WS_TAB + TB_SILU);
#pragma unroll 1
    for (int it = F.vcu; it < ((pmask & 4) ? NMOD / 32 : 0); it += F.G) {
        const int n0 = it * 32;
        f32x16m acc[5];
#pragma unroll
        for (int rt = 0; rt < 5; ++rt)
#pragma unroll
            for (int i = 0; i < 16; ++i) acc[rt][i] = 0.f;
#pragma unroll 1
        for (int kb = 0; kb < 4; ++kb) {
            float bw[2][8]; v4u af[2][5];
#pragma unroll
            for (int ks = 0; ks < 2; ++ks) { const int k0 = F.wave * 128 + (kb * 2 + ks) * 16 + 8 * hh;
                const float* wp = A.in[I_ADAW] + (size_t)k0 * NMOD + n0 + r32;
#pragma unroll
                for (int j = 0; j < 8; ++j) bw[ks][j] = wp[(size_t)j * NMOD];
#pragma unroll
                for (int rt = 0; rt < 5; ++rt) af[ks][rt] = *(const v4u*)(ST + (size_t)(32 * rt + r32) * D + k0); }
#pragma unroll
            for (int ks = 0; ks < 2; ++ks) {
                v4u bp; bp.x = pkbf0(bw[ks][0], bw[ks][1]); bp.y = pkbf0(bw[ks][2], bw[ks][3]); bp.z = pkbf0(bw[ks][4], bw[ks][5]); bp.w = pkbf0(bw[ks][6], bw[ks][7]);
                const bf16x8m bfr = __builtin_bit_cast(bf16x8m, bp);
#pragma unroll
                for (int rt = 0; rt < 5; ++rt) acc[rt] = __builtin_amdgcn_mfma_f32_32x32x16_bf16(__builtin_bit_cast(bf16x8m, af[ks][rt]), bfr, acc[rt], 0, 0, 0); }
        }
#pragma unroll
        for (int half = 4; half >= 1; half >>= 1) {
            if (F.wave >= half && F.wave < 2 * half) {
#pragma unroll
                for (int rt = 0; rt < 5; ++rt)
#pragma unroll
                    for (int i = 0; i < 16; ++i) RED[(F.wave - half) * 5120 + (rt * 16 + i) * 64 + F.lane] = acc[rt][i]; }
            __syncthreads();
            if (F.wave < half) {
#pragma unroll
                for (int rt = 0; rt < 5; ++rt)
#pragma unroll
                    for (int i = 0; i < 16; ++i) acc[rt][i] += RED[F.wave * 5120 + (rt * 16 + i) * 64 + F.lane]; }
            __syncthreads();
        }
        if (F.wave == 0) { const float bb = A.in[I_ADAB][n0 + r32];
#pragma unroll
            for (int rt = 0; rt < 5; ++rt)
#pragma unroll
                for (int i = 0; i < 16; ++i) { const int row = 32 * rt + (i & 3) + 8 * (i >> 2) + 4 * hh; if (row < NROWMOD) mod[(size_t)row * NMOD + n0 + r32] = acc[rt][i] + bb; } }
        if (n0 < 2 * D) cnt_arrive(F, CW_MOD);
    }
}

__device__ __forceinline__ int mod_row(int m) { return m < MP ? (m >> 11) : NBP + ((m - MP) >> 2); }
__device__ __forceinline__ const float* x_row(const Args& A, int m) { return m < MP ? A.in[I_XP] + (size_t)m * D : A.in[I_XS] + (size_t)(m - MP) * D; }

__device__ __forceinline__ void p1_modulate(Frame& F, const Args& A, int rep = 0) {
    refresh(F);
    cnt_wait_ge(F, CW_MOD, (unsigned)(2 * D / 32));
    const int gw = F.vcu * NWAVES + F.wave, NGW = F.G * NWAVES;
    const float* mod = (const float*)(F.ws + WS_MOD); bf16* XN = (bf16*)(F.ws + WS_XN);
    for (int m = gw; m < M; m += NGW) {
        const float* xr = x_row(A, m) + 8 * F.lane; const float* mr = mod + (size_t)mod_row(m) * NMOD + 8 * F.lane;
#pragma unroll
        for (int j = 0; j < 2; ++j) { const f32x4 v0 = *(const f32x4*)(xr + 512 * j), v1 = *(const f32x4*)(xr + 512 * j + 4);
            const f32x4 a0 = *(const f32x4*)(mr + 512 * j), a1 = *(const f32x4*)(mr + 512 * j + 4), s0 = *(const f32x4*)(mr + D + 512 * j), s1 = *(const f32x4*)(mr + D + 512 * j + 4);
            const f32x4 h0 = v0 * (s0 + 1.f) + a0, h1 = v1 * (s1 + 1.f) + a1;
            v4u o; o.x = pk2(h0.x, h0.y); o.y = pk2(h0.z, h0.w); o.z = pk2(h1.x, h1.y); o.w = pk2(h1.z, h1.w);
            *(v4u*)(XN + (size_t)m * D + 512 * j + 8 * F.lane) = o; }
    }
}

__device__ __forceinline__ void unpack8(const v4u w, f32x4& a, f32x4& b) { a = (f32x4){pg8::bf_lo(w.x), pg8::bf_hi(w.x), pg8::bf_lo(w.y), pg8::bf_hi(w.y)}; b = (f32x4){pg8::bf_lo(w.z), pg8::bf_hi(w.z), pg8::bf_lo(w.w), pg8::bf_hi(w.w)}; }
__device__ __forceinline__ v4u pack8f(const f32x4 a, const f32x4 b) { v4u o; o.x = pk2(a.x, a.y); o.y = pk2(a.z, a.w); o.z = pk2(b.x, b.y); o.w = pk2(b.z, b.w); return o; }
template <bool SECOND>
__device__ __forceinline__ void ln_rows(Frame& F, const Args& A) {
    refresh(F);
    const int gw = F.vcu * NWAVES + F.wave, NGW = F.G * NWAVES;
    const float* mod = (const float*)(F.ws + WS_MOD); bf16* XN = (bf16*)(F.ws + WS_XN);
    const float* gg = A.in[SECOND ? I_LN2G : I_LN1G] + 8 * F.lane; const float* gb = A.in[SECOND ? I_LN2B : I_LN1B] + 8 * F.lane;
    for (int m = gw; m < M; m += NGW) {
        float* xr = F.out + (size_t)m * D + 8 * F.lane;
        f32x4 v[2][2]; float s = 0.f;
        if (m >= MP) {
            const float* mr = mod + (size_t)mod_row(m) * NMOD + (SECOND ? 5 : 2) * D + 8 * F.lane;
            const float* bs = SECOND ? xr : A.in[I_XS] + (size_t)(m - MP) * D + 8 * F.lane;
            const float* sl = (const float*)(F.ws + WS_SLAB) + (size_t)(m - MP) * D + 8 * F.lane;
#pragma unroll
            for (int j = 0; j < 2; ++j)
#pragma unroll
                for (int h = 0; h < 2; ++h) { const int o = 512 * j + 4 * h; f32x4 a = SECOND ? *(const f32x4*)(A.in[I_B2] + 8 * F.lane + o) : (f32x4){0.f, 0.f, 0.f, 0.f};
#pragma unroll
                    for (int ks = 0; ks < (SECOND ? NS_DOWN : NS_OUT); ++ks) a += *(const f32x4*)(sl + (size_t)ks * (512 * 1024) + o);
                    v[j][h] = *(const f32x4*)(bs + o) * ALPHA + *(const f32x4*)(mr + o) * a; }
        } else {
            const bf16* tr = (const bf16*)(F.ws + (SECOND ? WS_T2 : WS_T1)) + (size_t)m * D + 8 * F.lane;
#pragma unroll
            for (int j = 0; j < 2; ++j) unpack8(*(const v4u*)(tr + 512 * j), v[j][0], v[j][1]);
        }
#pragma unroll
        for (int j = 0; j < 2; ++j)
#pragma unroll
            for (int h = 0; h < 2; ++h) s += (v[j][h].x + v[j][h].y) + (v[j][h].z + v[j][h].w);
        const float mean = wave_sum(s) * (1.f / D); float s2 = 0.f;
#pragma unroll
        for (int j = 0; j < 2; ++j)
#pragma unroll
            for (int h = 0; h < 2; ++h) { v[j][h] = v[j][h] - mean; s2 += (v[j][h].x * v[j][h].x + v[j][h].y * v[j][h].y) + (v[j][h].z * v[j][h].z + v[j][h].w * v[j][h].w); }
        const float rstd = 1.f / sqrtf(wave_sum(s2) * (1.f / D) + LN_EPS);
#pragma unroll
        for (int j = 0; j < 2; ++j)
#pragma unroll
            for (int h = 0; h < 2; ++h) v[j][h] = v[j][h] * rstd * *(const f32x4*)(gg + 512 * j + 4 * h) + *(const f32x4*)(gb + 512 * j + 4 * h);
        if (SECOND || m >= MP) {
#pragma unroll
            for (int j = 0; j < 2; ++j) { *(f32x4*)(xr + 512 * j) = v[j][0]; *(f32x4*)(xr + 512 * j + 4) = v[j][1]; }
        } else {
            bf16* x1 = (bf16*)(F.ws + WS_X1B) + (size_t)m * D + 8 * F.lane;
#pragma unroll
            for (int j = 0; j < 2; ++j) *(v4u*)(x1 + 512 * j) = pack8f(v[j][0], v[j][1]);
        }
        if (!SECOND) {
            const float* mr = mod + (size_t)mod_row(m) * NMOD + 8 * F.lane;
#pragma unroll
            for (int j = 0; j < 2; ++j) { const int o = 512 * j;
                const f32x4 h0 = v[j][0] * (*(const f32x4*)(mr + 4 * D + o) + 1.f) + *(const f32x4*)(mr + 3 * D + o), h1 = v[j][1] * (*(const f32x4*)(mr + 4 * D + o + 4) + 1.f) + *(const f32x4*)(mr + 3 * D + o + 4);
                *(v4u*)(XN + (size_t)m * D + o + 8 * F.lane) = pack8f(h0, h1); }
        }
    }
}

__device__ __forceinline__ void rg_item_ref(Frame& F, const Args& A, bool prompt, int b, int hd, LAS float* scr) {
    const int j = F.lane, c = hd * HDA + j;
    const bf16* Z = (const bf16*)(F.ws + WS_Z); bf16* Y = (bf16*)(F.ws + WS_YCAT); const float* sc = (const float*)(F.ws + WS_S5C);
    float wr[64], wi[64];
#pragma unroll
    for (int i = 0; i < 64; ++i) { wr[i] = A.in[I_RGWR][(size_t)(hd * 64 + i) * 64 + j]; wi[i] = A.in[I_RGWI][(size_t)(hd * 64 + i) * 64 + j]; }
    const float br = A.in[I_RGBR][c], bi = A.in[I_RGBI][c], L2 = sc[SC_RGL + c];
    const float w0 = A.in[I_CONVW][c], w1 = A.in[I_CONVW][WA + c], w2 = A.in[I_CONVW][2 * WA + c], w3 = A.in[I_CONVW][3 * WA + c], cb = A.in[I_CONVB][c];
    int T, m0; float x3, x2, x1, h;
    if (prompt) { T = TP; m0 = b * TP; x3 = 0.f; x2 = 0.f; x1 = 0.f; h = 0.f; }
    else { T = TS; m0 = MP + b * TS; x3 = A.in[I_SCONV][(size_t)(b * 3 + 0) * WA + c]; x2 = A.in[I_SCONV][(size_t)(b * 3 + 1) * WA + c]; x1 = A.in[I_SCONV][(size_t)(b * 3 + 2) * WA + c]; h = A.in[I_SH][(size_t)b * WA + c]; }
    for (int t = 0; t < T; ++t) {
        const size_t m = (size_t)(m0 + t);
        const float xa = bf2f(Z[m * NZ + WA + c]), gate = bf2f(Z[m * NZ + c]);
        const float xc = cb + w0 * x3 + w1 * x2 + w2 * x1 + w3 * xa; x3 = x2; x2 = x1; x1 = xa;
        scr[j] = xc; LDS_WAIT(); asm volatile("" ::: "memory");
        float rp = br, gp = bi;
#pragma unroll
        for (int i4 = 0; i4 < 16; ++i4) { const f32x4 v = *(const LAS f32x4*)(scr + 4 * i4);
            rp += v[0] * wr[4 * i4] + v[1] * wr[4 * i4 + 1] + v[2] * wr[4 * i4 + 2] + v[3] * wr[4 * i4 + 3];
            gp += v[0] * wi[4 * i4] + v[1] * wi[4 * i4 + 1] + v[2] * wi[4 * i4 + 2] + v[3] * wi[4 * i4 + 3]; }
        LDS_WAIT(); asm volatile("" ::: "memory");
        const float r = sigmoidf_(rp), gi = sigmoidf_(gp);
        const float a = exp2f(r * L2);
        float mult = sqrtf(fmaxf(1.f - a * a, 0.f));
        if (prompt && t == 0) mult = 1.f;
        h = a * h + mult * gi * xc;
        Y[m * D + c] = (bf16)f2bf(gelu_tanh(gate) * h);
    }
    float* oc = F.out + (prompt ? O_CONVP : O_CONVS); float* oh = F.out + (prompt ? O_HP : O_HS);
    oc[(size_t)(b * 3 + 0) * WA + c] = x3; oc[(size_t)(b * 3 + 1) * WA + c] = x2; oc[(size_t)(b * 3 + 2) * WA + c] = x1;
    oh[(size_t)b * WA + c] = h;
}
__device__ __forceinline__ void s5_item_ref(Frame& F, const Args& A, bool prompt, int b, int g, LAS float* scr) {
    const int n = F.lane, gn = g * NS5 + n, k = F.lane & 15, part = F.lane >> 4;
    const bf16* Z = (const bf16*)(F.ws + WS_Z); bf16* Gy = (bf16*)(F.ws + WS_G); const float* sc = (const float*)(F.ws + WS_S5C);
    float bbr[16], bbi[16], cre[16], cim[16];
#pragma unroll
    for (int i = 0; i < 16; ++i) { bbr[i] = sc[SC_BBR + gn * KS5 + i]; bbi[i] = sc[SC_BBI + gn * KS5 + i];
        cre[i] = A.in[I_S5CRE][(size_t)(g * KS5 + k) * NS5 + part * 16 + i]; cim[i] = A.in[I_S5CIM][(size_t)(g * KS5 + k) * NS5 + part * 16 + i]; }
    const float abr = sc[SC_ABR + gn], abi = sc[SC_ABI + gn], dk = A.in[I_S5D][g * KS5 + k];
    int T, m0; float hr, hi;
    if (prompt) { T = TP; m0 = b * TP; hr = 0.f; hi = 0.f; }
    else { T = TS; m0 = MP + b * TS; hr = A.in[I_SSR][(size_t)(b * GB + g) * NS5 + n]; hi = A.in[I_SSI][(size_t)(b * GB + g) * NS5 + n]; }
    for (int t = 0; t < T; ++t) {
        const size_t m = (size_t)(m0 + t);
        const bf16* zr = Z + m * NZ + 2 * WA + g * KS5;
        const v4u u0 = *(const v4u*)zr, u1 = *(const v4u*)(zr + 8);
        float u[16];
        u[0] = pg8::bf_lo(u0.x); u[1] = pg8::bf_hi(u0.x); u[2] = pg8::bf_lo(u0.y); u[3] = pg8::bf_hi(u0.y); u[4] = pg8::bf_lo(u0.z); u[5] = pg8::bf_hi(u0.z); u[6] = pg8::bf_lo(u0.w); u[7] = pg8::bf_hi(u0.w);
        u[8] = pg8::bf_lo(u1.x); u[9] = pg8::bf_hi(u1.x); u[10] = pg8::bf_lo(u1.y); u[11] = pg8::bf_hi(u1.y); u[12] = pg8::bf_lo(u1.z); u[13] = pg8::bf_hi(u1.z); u[14] = pg8::bf_lo(u1.w); u[15] = pg8::bf_hi(u1.w);
        float bur = 0.f, bui = 0.f;
#pragma unroll
        for (int i = 0; i < 16; ++i) { bur += bbr[i] * u[i]; bui += bbi[i] * u[i]; }
        const float nhr = abr * hr - abi * hi + bur, nhi = abr * hi + abi * hr + bui; hr = nhr; hi = nhi;
        scr[n] = hr; scr[64 + n] = hi; LDS_WAIT(); asm volatile("" ::: "memory");
        float p = 0.f;
#pragma unroll
        for (int i4 = 0; i4 < 4; ++i4) { const f32x4 vr = *(const LAS f32x4*)(scr + part * 16 + 4 * i4), vi = *(const LAS f32x4*)(scr + 64 + part * 16 + 4 * i4);
#pragma unroll
            for (int e = 0; e < 4; ++e) p += vr[e] * cre[4 * i4 + e] - vi[e] * cim[4 * i4 + e]; }
        LDS_WAIT(); asm volatile("" ::: "memory");
        p += __shfl_xor(p, 16); p += __shfl_xor(p, 32);
        const float uk = bf2f(zr[k]);
        if (F.lane < 16) Gy[m * WB + g * KS5 + k] = (bf16)f2bf(gelu_tanh(p + dk * uk));
    }
    float* osr = F.out + (prompt ? O_SRP : O_SRS); float* osi = F.out + (prompt ? O_SIP : O_SIS);
    osr[(size_t)(b * GB + g) * NS5 + n] = hr; osi[(size_t)(b * GB + g) * NS5 + n] = hi;
}

typedef short bf16x8v __attribute__((ext_vector_type(8)));
typedef float f32x16 __attribute__((ext_vector_type(16)));
typedef float f32x2v __attribute__((ext_vector_type(2)));
typedef __bf16 bf16x2v __attribute__((ext_vector_type(2)));
#define MFMA32(a, b, c) __builtin_amdgcn_mfma_f32_32x32x16_bf16((a), (b), (c), 0, 0, 0)
__device__ __forceinline__ unsigned pkbf(float a, float b) { const f32x2v v = {a, b}; const bf16x2v r = __builtin_convertvector(v, bf16x2v); return __builtin_bit_cast(unsigned, r); }
template <int CTRL> __device__ __forceinline__ float dppf(float old, float v) { return __builtin_bit_cast(float, __builtin_amdgcn_update_dpp(__builtin_bit_cast(int, old), __builtin_bit_cast(int, v), CTRL, 0xF, 0xF, false)); }
__device__ __forceinline__ f32x16 ld16(const float* p) { f32x16 r;
#pragma unroll
    for (int i = 0; i < 4; ++i) { const f32x4 v = *(const f32x4*)(p + 4 * i); r[4 * i] = v[0]; r[4 * i + 1] = v[1]; r[4 * i + 2] = v[2]; r[4 * i + 3] = v[3]; }
    return r; }
__device__ __forceinline__ f32x16 ld16l(const LAS float* p) { f32x16 r;
#pragma unroll
    for (int i = 0; i < 4; ++i) { const f32x4 v = *(const LAS f32x4*)(p + 4 * i); r[4 * i] = v[0]; r[4 * i + 1] = v[1]; r[4 * i + 2] = v[2]; r[4 * i + 3] = v[3]; }
    return r; }
__device__ __forceinline__ bf16x8v pack8(const f32x16& x, int s) { v4u p; p.x = pkbf(x[8 * s], x[8 * s + 1]); p.y = pkbf(x[8 * s + 2], x[8 * s + 3]); p.z = pkbf(x[8 * s + 4], x[8 * s + 5]); p.w = pkbf(x[8 * s + 6], x[8 * s + 7]); return __builtin_bit_cast(bf16x8v, p); }
template <int CTRL> __device__ __forceinline__ void s5_scan_step(f32x16& xr, f32x16& xi, const f32x16& zr, const f32x16& zi) {
#pragma unroll
    for (int i = 0; i < 16; ++i) { const float sr = dppf<CTRL>(0.f, xr[i]), si = dppf<CTRL>(0.f, xi[i]);
        xr[i] += zr[i] * sr - zi[i] * si; xi[i] += zr[i] * si + zi[i] * sr; }
}
constexpr int S5L_BF1 = 0, S5L_BF2 = 4096, S5L_TOT = 12288, S5L_CAR = 20480, S5L_ZP = 28672  , S5L_TA = 37376  , S5L_U = 38912  ;
template <bool SECOND>
__device__ __forceinline__ void s5_step(LAS unsigned char* L, int lane, const bf16x8v u, f32x16& hr0, f32x16& hr1, f32x16& hi0, f32x16& hi1,
                                        const f32x16& ar0, const f32x16& ar1, const f32x16& ai0, const f32x16& ai1, const float (&dk)[8], bf16* gout) {
    const LAS bf16x8v* a1 = (const LAS bf16x8v*)(L + S5L_BF1) + lane;
    { const f32x16 cr = ar0 * hr0 - ai0 * hi0, ci = ar0 * hi0 + ai0 * hr0; hr0 = MFMA32(a1[0], u, cr); hi0 = MFMA32(a1[128], u, ci); }
    asm volatile("" : "+v"(hr0), "+v"(hi0));
    { const f32x16 cr = ar1 * hr1 - ai1 * hi1, ci = ar1 * hi1 + ai1 * hr1; hr1 = MFMA32(a1[64], u, cr); hi1 = MFMA32(a1[192], u, ci); }
    if (SECOND) {
        const LAS bf16x8v* a2 = (const LAS bf16x8v*)(L + S5L_BF2) + lane;
        f32x16 y;
#pragma unroll
        for (int i = 0; i < 16; ++i) y[i] = 0.f;
        y = MFMA32(a2[0 * 64], pack8(hr0, 0), y); y = MFMA32(a2[1 * 64], pack8(hr0, 1), y);
        y = MFMA32(a2[2 * 64], pack8(hr1, 0), y); y = MFMA32(a2[3 * 64], pack8(hr1, 1), y);
        y = MFMA32(a2[4 * 64], pack8(hi0, 0), y); y = MFMA32(a2[5 * 64], pack8(hi0, 1), y);
        y = MFMA32(a2[6 * 64], pack8(hi1, 0), y); y = MFMA32(a2[7 * 64], pack8(hi1, 1), y);
        const v4u uw = __builtin_bit_cast(v4u, u);
        float o[8];
        o[0] = gelu_tanh(y[0] + dk[0] * pg8::bf_lo(uw.x)); o[1] = gelu_tanh(y[1] + dk[1] * pg8::bf_hi(uw.x));
        o[2] = gelu_tanh(y[2] + dk[2] * pg8::bf_lo(uw.y)); o[3] = gelu_tanh(y[3] + dk[3] * pg8::bf_hi(uw.y));
        o[4] = gelu_tanh(y[4] + dk[4] * pg8::bf_lo(uw.z)); o[5] = gelu_tanh(y[5] + dk[5] * pg8::bf_hi(uw.z));
        o[6] = gelu_tanh(y[6] + dk[6] * pg8::bf_lo(uw.w)); o[7] = gelu_tanh(y[7] + dk[7] * pg8::bf_hi(uw.w));
        v4u w; w.x = pkbf(o[0], o[1]); w.y = pkbf(o[2], o[3]); w.z = pkbf(o[4], o[5]); w.w = pkbf(o[6], o[7]);
        *(v4u*)gout = w;
    }
}
__device__ __forceinline__ void s5_item_fast(Frame& F, const Args& A, int b, int g) {
    refresh(F);
    const int lane = F.lane, q = lane & 31, hh = lane >> 5, w = F.wave, c = w * 32 + q;
    LAS unsigned char* L = F.lds + RING_OFF;
    const unsigned char* tab = F.ws + WS_TAB;
    const size_t m0 = (size_t)b * TP + (size_t)8 * c;
    const bf16* zrow = (const bf16*)(F.ws + WS_Z) + m0 * NZ + 2 * WA + g * KS5 + 8 * hh;
    bf16* grow = (bf16*)(F.ws + WS_G) + m0 * WB + g * KS5 + 8 * hh;
    LAS v4u* UL = (LAS v4u*)(L + S5L_U) + F.tid;
    {
        v4u uu[8];
#pragma unroll
        for (int j = 0; j < 8; ++j) uu[j] = *(const v4u*)(zrow + (size_t)j * NZ);
        const v4u* s1 = (const v4u*)(tab + TB_BF1) + (size_t)g * 256; const v4u* s2 = (const v4u*)(tab + TB_BF2) + (size_t)g * 512;
        if (F.tid < 256) ((LAS v4u*)(L + S5L_BF1))[F.tid] = s1[F.tid];
        ((LAS v4u*)(L + S5L_BF2))[F.tid] = s2[F.tid];
        const v4u* s3 = (const v4u*)(tab + TB_ZP) + (size_t)g * (17 * 128 / 4); for (int e = F.tid; e < 17 * 128 / 4; e += NWAVES * 64) ((LAS v4u*)(L + S5L_ZP))[e] = s3[e];
        if (F.tid < 32) ((LAS v4u*)(L + S5L_TA))[F.tid] = ((const v4u*)(tab + TB_TA) + (size_t)g * 32)[F.tid];
#pragma unroll
        for (int j = 0; j < 8; ++j) UL[512 * j] = uu[j];
    }
    __syncthreads();
    const LAS float* TA = (const LAS float*)(L + S5L_TA) + hh * 64;
    f32x16 ar0 = ld16l(TA), ar1 = ld16l(TA + 16), ai0 = ld16l(TA + 32), ai1 = ld16l(TA + 48);
    f32x16 hr0, hr1, hi0, hi1;
#pragma unroll
    for (int i = 0; i < 16; ++i) { hr0[i] = 0.f; hr1[i] = 0.f; hi0[i] = 0.f; hi1[i] = 0.f; }
    float dk[8];
#pragma unroll
    for (int i = 0; i < 8; ++i) dk[i] = A.in[I_S5D][g * KS5 + 8 * hh + i];
#pragma unroll 1
    for (int j = 0; j < 8; ++j) { const bf16x8v u = __builtin_bit_cast(bf16x8v, UL[512 * j]);
        s5_step<false>(L, lane, u, hr0, hr1, hi0, hi1, ar0, ar1, ai0, ai1, dk, nullptr); }
    const LAS float* ZP = (const LAS float*)(L + S5L_ZP);
#define S5_SCAN(E, CTRL) do { const LAS float* z = ZP + (((E) * 2 + hh) * 2) * 32; \
        { const f32x16 zr = ld16l(z), zi = ld16l(z + 32); s5_scan_step<CTRL>(hr0, hi0, zr, zi); } \
        asm volatile("" : "+v"(hr0), "+v"(hi0) :: "memory"); \
        { const f32x16 zr = ld16l(z + 16), zi = ld16l(z + 48); s5_scan_step<CTRL>(hr1, hi1, zr, zi); } \
        asm volatile("" : "+v"(hr1), "+v"(hi1) :: "memory"); } while (0)
    S5_SCAN(1, 0x111); S5_SCAN(2, 0x112); S5_SCAN(4, 0x114); S5_SCAN(8, 0x118);
#undef S5_SCAN
    const int seg = w * 2 + (q >> 4);
    LAS float* TOT = (LAS float*)(L + S5L_TOT); LAS float* CAR = (LAS float*)(L + S5L_CAR);
    if ((lane & 15) == 15) {
#pragma unroll
        for (int rho = 0; rho < 4; ++rho) {
            *(LAS f32x4*)(TOT + (seg * 2 + 0) * 64 + 0 + 8 * rho + 4 * hh) = (f32x4){hr0[4 * rho], hr0[4 * rho + 1], hr0[4 * rho + 2], hr0[4 * rho + 3]};
            *(LAS f32x4*)(TOT + (seg * 2 + 0) * 64 + 32 + 8 * rho + 4 * hh) = (f32x4){hr1[4 * rho], hr1[4 * rho + 1], hr1[4 * rho + 2], hr1[4 * rho + 3]};
            *(LAS f32x4*)(TOT + (seg * 2 + 1) * 64 + 0 + 8 * rho + 4 * hh) = (f32x4){hi0[4 * rho], hi0[4 * rho + 1], hi0[4 * rho + 2], hi0[4 * rho + 3]};
            *(LAS f32x4*)(TOT + (seg * 2 + 1) * 64 + 32 + 8 * rho + 4 * hh) = (f32x4){hi1[4 * rho], hi1[4 * rho + 1], hi1[4 * rho + 2], hi1[4 * rho + 3]}; }
    }
    __syncthreads();
    if (F.tid < 64) {
        const float* z16 = (const float*)(tab + TB_Z16N) + (size_t)g * 128; const float zr = z16[F.tid], zi = z16[64 + F.tid];
        float cr = 0.f, ci = 0.f;
#pragma unroll
        for (int sg = 0; sg < 16; ++sg) { CAR[(sg * 2 + 0) * 64 + F.tid] = cr; CAR[(sg * 2 + 1) * 64 + F.tid] = ci;
            const float tr = TOT[(sg * 2 + 0) * 64 + F.tid], ti = TOT[(sg * 2 + 1) * 64 + F.tid];
            const float ncr = zr * cr - zi * ci + tr, nci = zr * ci + zi * cr + ti; cr = ncr; ci = nci; }
    }
    __syncthreads();
    {
        const LAS float* z = ZP + (((q & 15) * 2 + hh) * 2) * 32;
#define S5_EXCL(HR, HI, OFF) do { const f32x16 zr = ld16l(z + (OFF)), zi = ld16l(z + 32 + (OFF)); f32x16 kr, ki; \
        _Pragma("unroll") for (int rho = 0; rho < 4; ++rho) { \
            const f32x4 a0 = *(const LAS f32x4*)(CAR + (seg * 2 + 0) * 64 + 2 * (OFF) + 8 * rho + 4 * hh), b0 = *(const LAS f32x4*)(CAR + (seg * 2 + 1) * 64 + 2 * (OFF) + 8 * rho + 4 * hh); \
            _Pragma("unroll") for (int e = 0; e < 4; ++e) { kr[4 * rho + e] = a0[e]; ki[4 * rho + e] = b0[e]; } } \
        _Pragma("unroll") for (int i = 0; i < 16; ++i) { const float sr = dppf<0x111>(0.f, HR[i]), si = dppf<0x111>(0.f, HI[i]); \
            HR[i] = sr + zr[i] * kr[i] - zi[i] * ki[i]; HI[i] = si + zr[i] * ki[i] + zi[i] * kr[i]; } } while (0)
        S5_EXCL(hr0, hi0, 0); asm volatile("" : "+v"(hr0), "+v"(hi0) :: "memory"); S5_EXCL(hr1, hi1, 16); asm volatile("" : "+v"(hr1), "+v"(hi1) :: "memory");
#undef S5_EXCL
    }
    { int off = 0; asm volatile("" : "+v"(off)); const LAS float* TA2 = TA + off; ar0 = ld16l(TA2); ar1 = ld16l(TA2 + 16); ai0 = ld16l(TA2 + 32); ai1 = ld16l(TA2 + 48); }
#pragma unroll 1
    for (int j = 0; j < 8; ++j) { const bf16x8v u = __builtin_bit_cast(bf16x8v, UL[512 * j]);
        s5_step<true>(L, lane, u, hr0, hr1, hi0, hi1, ar0, ar1, ai0, ai1, dk, grow + (size_t)j * WB); }
    if (w == NWAVES - 1 && q == 31) {
        float* osr = F.out + O_SRP + (size_t)(b * GB + g) * NS5; float* osi = F.out + O_SIP + (size_t)(b * GB + g) * NS5;
#pragma unroll
        for (int i = 0; i < 16; ++i) { const int n = (i & 3) + 8 * (i >> 2) + 4 * hh; osr[n] = hr0[i]; osr[32 + n] = hr1[i]; osi[n] = hi0[i]; osi[32 + n] = hi1[i]; }
    }
    __syncthreads();
}

__device__ __forceinline__ void s5_item_sample(Frame& F, const Args& A, int g) {
    refresh(F);
    const int lane = F.lane, q = lane & 31, hh = lane >> 5, w = F.wave;
    LAS unsigned char* L = F.lds + RING_OFF;
    const unsigned char* tab = F.ws + WS_TAB;
    { const v4u* s1 = (const v4u*)(tab + TB_BF1) + (size_t)g * 256; const v4u* s2 = (const v4u*)(tab + TB_BF2) + (size_t)g * 512;
      if (F.tid < 256) ((LAS v4u*)(L + S5L_BF1))[F.tid] = s1[F.tid];
      ((LAS v4u*)(L + S5L_BF2))[F.tid] = s2[F.tid]; }
    __syncthreads();
    if (w < 4) {
        const int b = w * 32 + q;
        const float* TA = (const float*)(tab + TB_TA) + (size_t)((g * 2 + hh) * 2) * 32;
        const f32x16 ar0 = ld16(TA), ar1 = ld16(TA + 16), ai0 = ld16(TA + 32), ai1 = ld16(TA + 48);
        f32x16 hr0, hr1, hi0, hi1;
        const float* sr = A.in[I_SSR] + (size_t)(b * GB + g) * NS5; const float* si = A.in[I_SSI] + (size_t)(b * GB + g) * NS5;
#pragma unroll
        for (int rho = 0; rho < 4; ++rho) { const f32x4 a0 = *(const f32x4*)(sr + 8 * rho + 4 * hh), a1 = *(const f32x4*)(sr + 32 + 8 * rho + 4 * hh), b0 = *(const f32x4*)(si + 8 * rho + 4 * hh), b1 = *(const f32x4*)(si + 32 + 8 * rho + 4 * hh);
#pragma unroll
            for (int e = 0; e < 4; ++e) { hr0[4 * rho + e] = a0[e]; hr1[4 * rho + e] = a1[e]; hi0[4 * rho + e] = b0[e]; hi1[4 * rho + e] = b1[e]; } }
        float dk[8];
#pragma unroll
        for (int i = 0; i < 8; ++i) dk[i] = A.in[I_S5D][g * KS5 + 8 * hh + i];
        const size_t m0 = (size_t)MP + (size_t)b * TS;
        const bf16* zrow = (const bf16*)(F.ws + WS_Z) + m0 * NZ + 2 * WA + g * KS5 + 8 * hh;
        bf16* grow = (bf16*)(F.ws + WS_G) + m0 * WB + g * KS5 + 8 * hh;
        bf16x8v uu[TS];
#pragma unroll
        for (int j = 0; j < TS; ++j) uu[j] = *(const bf16x8v*)(zrow + (size_t)j * NZ);
#pragma unroll
        for (int j = 0; j < TS; ++j) s5_step<true>(L, lane, uu[j], hr0, hr1, hi0, hi1, ar0, ar1, ai0, ai1, dk, grow + (size_t)j * WB);
        float* osr = F.out + O_SRS + (size_t)(b * GB + g) * NS5; float* osi = F.out + O_SIS + (size_t)(b * GB + g) * NS5;
#pragma unroll
        for (int rho = 0; rho < 4; ++rho) {
            *(f32x4*)(osr + 8 * rho + 4 * hh) = (f32x4){hr0[4 * rho], hr0[4 * rho + 1], hr0[4 * rho + 2], hr0[4 * rho + 3]};
            *(f32x4*)(osr + 32 + 8 * rho + 4 * hh) = (f32x4){hr1[4 * rho], hr1[4 * rho + 1], hr1[4 * rho + 2], hr1[4 * rho + 3]};
            *(f32x4*)(osi + 8 * rho + 4 * hh) = (f32x4){hi0[4 * rho], hi0[4 * rho + 1], hi0[4 * rho + 2], hi0[4 * rho + 3]};
            *(f32x4*)(osi + 32 + 8 * rho + 4 * hh) = (f32x4){hi1[4 * rho], hi1[4 * rho + 1], hi1[4 * rho + 2], hi1[4 * rho + 3]}; }
    }
    __syncthreads();
}

template <int CTRL, int RMASK> __device__ __forceinline__ float dppm(float old, float v) { return __builtin_bit_cast(float, __builtin_amdgcn_update_dpp(__builtin_bit_cast(int, old), __builtin_bit_cast(int, v), CTRL, RMASK, 0xF, false)); }
template <int CTRL, int RMASK> __device__ __forceinline__ void rg_scan_step(f32x16& a, f32x16& b) {
#pragma unroll
    for (int i = 0; i < 16; ++i) { const float as = dppm<CTRL, RMASK>(1.f, a[i]), bs = dppm<CTRL, RMASK>(0.f, b[i]); b[i] = a[i] * bs + b[i]; a[i] = a[i] * as; }
}
constexpr int RGL_AFR = 0, RGL_DG = 8192, RGL_TOT = 24576, RGL_CST = 28672;
constexpr int RGL_XAP = 144;
constexpr int RGL_XA0 = 29696, RGL_BUF = 37376;
static_assert(259 * RGL_XAP <= RGL_BUF && RGL_XA0 + 2 * RGL_BUF <= RING_BYTES && RGL_CST + 640 <= RGL_XA0, "RG-LRU LDS map");
template <bool SAMPLE>
__device__ __forceinline__ void rg_item_fast(Frame& F, const Args& A, int b, int hd, int jh) {
    refresh(F);
    const int lane = F.lane, q = lane & 31, hh = lane >> 5, w = F.wave;
    LAS unsigned char* L = F.lds + RING_OFF;
    const float* sc = (const float*)(F.ws + WS_S5C);
    const bf16* Zb = (const bf16*)(F.ws + WS_Z) + (size_t)(SAMPLE ? MP : b * TP) * NZ; bf16* Yb = (bf16*)(F.ws + WS_YCAT) + (size_t)(SAMPLE ? MP : b * TP) * D;
    const bf16* CB = (const bf16*)(F.ws + WS_TAB + TB_CB);
    auto stage_load = [&](int T0, v4u (&st)[5]) {
#pragma unroll
        for (int k = 0; k < 5; ++k) { const int ci = F.tid + 512 * k; v4u v = (v4u){0u, 0u, 0u, 0u};
            if (ci < 2072) { const int tk = T0 - 3 + (ci >> 3); if (tk >= 0) v = *(const v4u*)(Zb + (size_t)tk * NZ + WA + hd * 64 + (ci & 7) * 8); }
            st[k] = v; } };
    auto stage_write = [&](int par, const v4u (&st)[5]) {
#pragma unroll
        for (int k = 0; k < 5; ++k) { const int ci = F.tid + 512 * k;
            if (ci < 2072) *(LAS v4u*)(L + RGL_XA0 + par * RGL_BUF + (ci >> 3) * RGL_XAP + (ci & 7) * 16) = st[k]; } };
    {
        const v4u* src = (const v4u*)(F.ws + WS_TAB + TB_RG) + (size_t)((hd * 2 + jh) * 8) * 64;
        ((LAS v4u*)(L + RGL_AFR))[F.tid] = src[F.tid];
        const v4u* sd = (const v4u*)(F.ws + WS_TAB + TB_DG) + (size_t)(hd * 16) * 64;
        ((LAS v4u*)(L + RGL_DG))[F.tid] = sd[F.tid]; ((LAS v4u*)(L + RGL_DG))[512 + F.tid] = sd[512 + F.tid];
        if (F.tid < 160) { const int h2 = F.tid / 80, kind = (F.tid % 80) / 16, i = F.tid % 16, cr = (i & 3) + 8 * (i >> 2) + 4 * h2;
            const int c = hd * 64 + 32 * jh + cr;
            ((LAS float*)(L + RGL_CST))[F.tid] = kind == 0 ? A.in[I_RGBR][c] : kind == 1 ? A.in[I_RGBI][c] : kind == 2 ? sc[SC_RGL + c] : A.in[I_CONVB][hd * 64 + 32 * (kind - 3) + cr]; }
        if (!SAMPLE && jh == 0 && F.tid < 192) { const int k = F.tid >> 6, ch = F.tid & 63;
            F.out[O_CONVP + (size_t)(b * 3 + k) * WA + hd * 64 + ch] = bf2f(((const bf16*)(F.ws + WS_Z))[(size_t)(b * TP + TP - 3 + k) * NZ + WA + hd * 64 + ch]); }
        if (SAMPLE && jh == 0) { for (int e = F.tid; e < NBS * 3 * 64; e += NWAVES * 64) { const int bb = e / 192, k = (e / 64) % 3, ch = e & 63;
            F.out[O_CONVS + (size_t)(bb * 3 + k) * WA + hd * 64 + ch] = bf2f(((const bf16*)(F.ws + WS_Z))[(size_t)(MP + bb * TS + 1 + k) * NZ + WA + hd * 64 + ch]); } }
        if (!SAMPLE) { v4u st[5]; stage_load(0, st); stage_write(0, st); }
    }
    __syncthreads();
    float hround[16];
#pragma unroll
    for (int i = 0; i < 16; ++i) hround[i] = 0.f;
    const LAS float* CST = (const LAS float*)(L + RGL_CST) + hh * 80;
    const LAS bf16x8v* af = (const LAS bf16x8v*)(L + RGL_AFR) + lane;
    const LAS bf16x8v* dg = (const LAS bf16x8v*)(L + RGL_DG) + lane;
#pragma unroll 1
    for (int rd = 0; rd < (SAMPLE ? 2 : 8); ++rd) {
        const int t = rd * 256 + w * 32 + q;
        v4u stn[5];
        if (!SAMPLE) stage_load((rd + 1) * 256, stn);
        const LAS unsigned char* XAp = L + RGL_XA0 + (rd & 1) * RGL_BUF + (w * 32 + q) * RGL_XAP + 16 * hh;
        const bf16* zsr[4];
        if (SAMPLE) {
#pragma unroll
            for (int k = 0; k < 4; ++k) { const int jx = (t & 3) + k; zsr[k] = (jx < 3 ? CB + (size_t)((t >> 2) * 3 + jx) * WA : Zb + (size_t)(t - 3 + k) * NZ + WA) + hd * 64 + 8 * hh; } }
        const bf16* gr = Zb + (size_t)t * NZ + hd * 64 + 32 * jh + 4 * hh;
        unsigned long long gq[4];
#pragma unroll
        for (int rho = 0; rho < 4; ++rho) gq[rho] = *(const unsigned long long*)(gr + 8 * rho);
        f32x16 dx0, dx1;
        { const f32x4 c0 = *(const LAS f32x4*)(CST + 48), c1 = *(const LAS f32x4*)(CST + 52), c2 = *(const LAS f32x4*)(CST + 56), c3 = *(const LAS f32x4*)(CST + 60);
          const f32x4 e0 = *(const LAS f32x4*)(CST + 64), e1 = *(const LAS f32x4*)(CST + 68), e2 = *(const LAS f32x4*)(CST + 72), e3 = *(const LAS f32x4*)(CST + 76);
#pragma unroll
          for (int e = 0; e < 4; ++e) { dx0[e] = c0[e]; dx0[4 + e] = c1[e]; dx0[8 + e] = c2[e]; dx0[12 + e] = c3[e]; dx1[e] = e0[e]; dx1[4 + e] = e1[e]; dx1[8 + e] = e2[e]; dx1[12 + e] = e3[e]; } }
#pragma unroll
        for (int k = 0; k < 4; ++k)
#pragma unroll
            for (int s4 = 0; s4 < 4; ++s4) {
                const bf16x8v xb = SAMPLE ? *(const bf16x8v*)(zsr[k] + 16 * s4) : *(const LAS bf16x8v*)(XAp + k * RGL_XAP + s4 * 32);
                if (s4 < 2) dx0 = MFMA32(dg[((0 * 2 + (s4 & 1)) * 4 + k) * 64], xb, dx0); else dx1 = MFMA32(dg[((1 * 2 + (s4 & 1)) * 4 + k) * 64], xb, dx1);
                if (s4 == 3) asm volatile("" : "+v"(dx0), "+v"(dx1) :: "memory"); }
        f32x16 dr, di;
#pragma unroll
        for (int i = 0; i < 16; ++i) { dr[i] = 0.f; di[i] = 0.f; }
        { const bf16x8v b00 = pack8(dx0, 0), b01 = pack8(dx0, 1), b10 = pack8(dx1, 0), b11 = pack8(dx1, 1);
          dr = MFMA32(af[0 * 64], b00, dr); di = MFMA32(af[4 * 64], b00, di); dr = MFMA32(af[1 * 64], b01, dr); di = MFMA32(af[5 * 64], b01, di);
          dr = MFMA32(af[2 * 64], b10, dr); di = MFMA32(af[6 * 64], b10, di); dr = MFMA32(af[3 * 64], b11, dr); di = MFMA32(af[7 * 64], b11, di); }
        f32x16 av, bv;
        const bool first = !SAMPLE && (t == 0);
#pragma unroll
        for (int i = 0; i < 16; ++i) { const float xcv = jh ? dx1[i] : dx0[i];
            const float r = sigmoidf_(dr[i] + CST[i]), gi = sigmoidf_(di[i] + CST[16 + i]);
            const float a = __builtin_amdgcn_exp2f(r * CST[32 + i]);
            float mult = __builtin_amdgcn_sqrtf(fmaxf(1.f - a * a, 0.f)); if (first) mult = 1.f;
            av[i] = a; bv[i] = mult * gi * xcv; }
        if (SAMPLE && (t & 3) == 0) {
            const float* h0 = A.in[I_SH] + (size_t)(t >> 2) * WA + hd * 64 + 32 * jh + 4 * hh;
#pragma unroll
            for (int i = 0; i < 16; ++i) { bv[i] += av[i] * h0[(i & 3) + 8 * (i >> 2)]; av[i] = 0.f; } }
        rg_scan_step<0x111, 0xF>(av, bv); rg_scan_step<0x112, 0xF>(av, bv); rg_scan_step<0x114, 0xF>(av, bv); rg_scan_step<0x118, 0xF>(av, bv);
        rg_scan_step<0x142, 0xA>(av, bv);
        float hin[16];
#pragma unroll
        for (int i = 0; i < 16; ++i) hin[i] = 0.f;
        if (!SAMPLE) {
        LAS float* TOT = (LAS float*)(L + RGL_TOT) + (rd & 1) * 512;
        if (q == 31) {
#pragma unroll
            for (int i4 = 0; i4 < 4; ++i4) { *(LAS f32x4*)(TOT + (w * 2 + 0) * 32 + hh * 16 + 4 * i4) = (f32x4){av[4 * i4], av[4 * i4 + 1], av[4 * i4 + 2], av[4 * i4 + 3]};
                                             *(LAS f32x4*)(TOT + (w * 2 + 1) * 32 + hh * 16 + 4 * i4) = (f32x4){bv[4 * i4], bv[4 * i4 + 1], bv[4 * i4 + 2], bv[4 * i4 + 3]}; }
        }
        stage_write((rd + 1) & 1, stn);
        __syncthreads();
#pragma unroll
        for (int w2 = 0; w2 < 8; ++w2) {
            if (w2 == w) {
#pragma unroll
                for (int i = 0; i < 16; ++i) hin[i] = hround[i]; }
#pragma unroll
            for (int i4 = 0; i4 < 4; ++i4) { const f32x4 p = *(const LAS f32x4*)(TOT + (w2 * 2 + 0) * 32 + hh * 16 + 4 * i4), hl = *(const LAS f32x4*)(TOT + (w2 * 2 + 1) * 32 + hh * 16 + 4 * i4);
#pragma unroll
                for (int e = 0; e < 4; ++e) hround[4 * i4 + e] = p[e] * hround[4 * i4 + e] + hl[e]; }
        }
        }
        bf16* yr = Yb + (size_t)t * D + hd * 64 + 32 * jh + 4 * hh;
#pragma unroll
        for (int rho = 0; rho < 4; ++rho) { const unsigned glo = (unsigned)gq[rho], ghi = (unsigned)(gq[rho] >> 32);
            const float o0 = gelu_tanh(pg8::bf_lo(glo)) * (bv[4 * rho] + av[4 * rho] * hin[4 * rho]), o1 = gelu_tanh(pg8::bf_hi(glo)) * (bv[4 * rho + 1] + av[4 * rho + 1] * hin[4 * rho + 1]);
            const float o2 = gelu_tanh(pg8::bf_lo(ghi)) * (bv[4 * rho + 2] + av[4 * rho + 2] * hin[4 * rho + 2]), o3 = gelu_tanh(pg8::bf_hi(ghi)) * (bv[4 * rho + 3] + av[4 * rho + 3] * hin[4 * rho + 3]);
            *(unsigned long long*)(yr + 8 * rho) = (unsigned long long)pkbf(o0, o1) | ((unsigned long long)pkbf(o2, o3) << 32); }
        if (SAMPLE && (t & 3) == 3) {
#pragma unroll
            for (int i = 0; i < 16; ++i) F.out[O_HS + (size_t)(t >> 2) * WA + hd * 64 + 32 * jh + (i & 3) + 8 * (i >> 2) + 4 * hh] = bv[i]; }
    }
    if (!SAMPLE && w == 0 && q == 0) {
#pragma unroll
        for (int i = 0; i < 16; ++i) F.out[O_HP + (size_t)b * WA + hd * 64 + 32 * jh + (i & 3) + 8 * (i >> 2) + 4 * hh] = hround[i];
    }
    __syncthreads();
}

#ifndef PROBE_P3PART
#define PROBE_P3PART 7
#endif
__device__ __forceinline__ void p3_mixers_ref(Frame& F, const Args& A, int rep = 0) {
    constexpr int N_RGP = NBP * HA, N_S5P = NBP * GB;
    const int pm = rep ? PROBE_P3PART : 7;
    bf16* GY = (bf16*)(F.ws + WS_G); bf16* YC = (bf16*)(F.ws + WS_YCAT);
    pg8::Gemm gg{GY, (const bf16*)(F.ws + WS_WGLU), M, WB, WB}; pg8::EpiGlu EG{GY, WB, YC, D, WA, A.in[I_GLUB]};
    pg8::OneUnit SG; SG.u0.pm = 0; SG.u0.pn = 0; SG.u0.k0 = 0; SG.u0.nkt = WB / 64; SG.u0.ks = 0; bool has_glu = false;
    if (F.vcu < 2 * N_RGP) {
        if (pm & 1) rg_item_fast<false>(F, A, F.vcu / (2 * HA), (F.vcu / 2) % HA, F.vcu & 1);
        if (pm & 4) { if (F.vcu < GB) { s5_item_sample(F, A, F.vcu); cnt_arrive(F, CW_S5B + 64 * NBP); }
                      else if (F.vcu < GB + 2 * HA) rg_item_fast<true>(F, A, 0, (F.vcu - GB) >> 1, (F.vcu - GB) & 1);
                      else if (F.vcu < GB + 2 * HA + 4) {
                          cnt_wait_ge(F, CW_S5B + 64 * NBP, (unsigned)GB * (unsigned)(rep + 1)); const int u = F.vcu - GB - 2 * HA; SG.u0.pm = MP / 256 + (u >> 1); SG.u0.pn = u & 1; has_glu = true; } }
    } else {
        const int v = F.vcu - 2 * N_RGP, it = 2 * v, bb = it / GB;
        if (pm & 2) { s5_item_fast(F, A, bb, it % GB);
                      s5_item_fast(F, A, bb, (it + 1) % GB);
                      cnt_arrive(F, CW_S5B + 64 * bb);
                      cnt_wait_ge(F, CW_S5B + 64 * bb, 16u * (unsigned)(rep + 1));
                      const int u = v & 15; SG.u0.pm = 8 * bb + (u >> 1); SG.u0.pn = u & 1; has_glu = true; }
    }
    if (has_glu) pg8::gemm_phase<pg8::EpiGlu, pg8::OneUnit, false, PG8_SP2>(F.lds + RING_OFF, gg, SG, EG);
    if (rep == 0) xpose_range(F, A, XO_2, XO_END, 0);
}

__global__ void __launch_bounds__(NWAVES * 64, 2) fwd(Args A) {
    extern __shared__ __attribute__((aligned(16))) unsigned char lds[];
    Frame F;
    F.lds = (LAS unsigned char*)lds;
    F.MISC = (volatile LAS unsigned*)(F.lds + MISC_OFF);
    F.tid = threadIdx.x; F.lane = F.tid & 63; F.wave = __builtin_amdgcn_readfirstlane(F.tid >> 6);
    F.G = gridDim.x; { const int bx = blockIdx.x; F.vcu = (F.G % 8 == 0) ? (bx % 8) * (F.G / 8) + bx / 8 : bx; }
    F.out = A.out; F.ws = A.ws; F.ctl = (gu32*)(A.ws + WS_CTL);
    for (int u = F.tid; u < (LDS_BYTES - LDSCTL_OFF) / 4; u += NWAVES * 64) ((LAS unsigned*)(F.lds + LDSCTL_OFF))[u] = 0u;
    __syncthreads();
    XcdBarrier bar; bar.bar = (unsigned*)(F.ctl + CW_BAR); bar.x = 0; bar.st = nullptr;
    if (N_LAUNCHES == 1) bar = xcd_barrier_post((unsigned*)(F.ctl + CW_BAR), F.MISC + 8);
#define GRID_BAR() do { if (N_LAUNCHES == 1) xcd_barrier(bar); } while (0)
    const int lo = A.ph_lo, hi = A.ph_hi;
#define IN(k) (lo <= (k) && (k) < hi)
#define BOTH(k) (IN(k) && IN((k) + 1))
    bf16* XN = (bf16*)(F.ws + WS_XN); bf16* Z = (bf16*)(F.ws + WS_Z); bf16* YC = (bf16*)(F.ws + WS_YCAT); bf16* GY = (bf16*)(F.ws + WS_G); bf16* U = (bf16*)(F.ws + WS_U);
    const float* mod = (const float*)(F.ws + WS_MOD);

#define REPS(k) (((PROBE_DUP) >> (k)) & 1 ? 2 : 1)
#define PH0(rep) p0_prologue(F, A, rep)
#define PH1(rep) p1_modulate(F, A, rep)
#define PH2(rep) do {     \
        pg8::Gemm g{XN, (const bf16*)(F.ws + WS_WIN), M, NZ, D}; pg8::StaticOrder S; S.init(M, NZ, F.G, (int)blockIdx.x, D); \
        pg8::EpiBf16<0> E{Z, NZ, nullptr}; \
        pg8::gemm_phase<pg8::EpiBf16<0>, pg8::StaticOrder, PG8_ALIGN, PG8_SP2>(F.lds + RING_OFF, g, S, E); \
        if ((rep) == 0 && (int)blockIdx.x >= (M / 256) * (NZ / 256) - F.G) { __syncthreads(); xpose_range_b(F, A, XO_OU, XO_2, (M / 256) * (NZ / 256) - F.G); } } while (0)
#define PH3(rep) p3_mixers_ref(F, A, rep)
#define PH4(rep) do { } while (0)
#define PH5(rep) do {     \
        pg8::Gemm g{YC, (const bf16*)(F.ws + WS_WOUT), M, D, D}; pg8::SplitOrder S; S.init(MP, D, F.G, (int)blockIdx.x, D, NS_OUT); \
        pg8::EpiRes<false> E{A.in[I_XP], (bf16*)(F.ws + WS_T1), mod + 2 * D, nullptr, ALPHA, MP, (float*)(F.ws + WS_SLAB)}; \
        pg8::gemm_phase<pg8::EpiRes<false>, pg8::SplitOrder, PG8_ALIGN, PG8_SP2>(F.lds + RING_OFF, g, S, E); } while (0)
#define PH6(rep) ln_rows<false>(F, A)
#define PH7(rep) do {     \
        pg8::Gemm g{XN, (const bf16*)(F.ws + WS_W1), M, FF, D}; pg8::StaticOrder S; S.init(M, FF, F.G, (int)blockIdx.x, D); \
        pg8::EpiBf16<3> E{U, FF, A.in[I_B1]}; \
        pg8::gemm_phase<pg8::EpiBf16<3>, pg8::StaticOrder, PG8_ALIGN, PG8_SP2>(F.lds + RING_OFF, g, S, E); } while (0)
#define PH8(rep) do {     \
        pg8::Gemm g{U, (const bf16*)(F.ws + WS_W2), M, D, FF}; pg8::SplitOrder S; S.init(MP, D, F.G, (int)blockIdx.x, FF, NS_DOWN); \
        pg8::EpiRes<true> E{(const bf16*)(F.ws + WS_X1B), (bf16*)(F.ws + WS_T2), mod + 5 * D, A.in[I_B2], ALPHA, MP, (float*)(F.ws + WS_SLAB)}; \
        pg8::gemm_phase<pg8::EpiRes<true>, pg8::SplitOrder, PG8_ALIGN, PG8_SP2>(F.lds + RING_OFF, g, S, E); } while (0)
#define RUN(k, PH) do { if (IN(k)) { PH(0); if (REPS(k) == 2) { __syncthreads(); PH(1); } if (BOTH(k)) GRID_BAR(); } } while (0)
    if (IN(0)) { PH0(0); if (REPS(0) == 2) { __syncthreads(); PH0(1); } if (IN(0) && !IN(1)) { } }
    RUN(1, PH1); RUN(2, PH2); RUN(3, PH3); RUN(5, PH5); RUN(6, PH6); RUN(7, PH7); RUN(8, PH8);
    if (IN(9)) { ln_rows<true>(F, A); }
#undef IN
#undef BOTH
}

extern "C" void kernel_launch(void* const* d_in, const int* in_sizes, int n_in, void* d_out, int out_size, void* d_ws, size_t ws_size, hipStream_t stream) {
    static int grid = 0;
    if (grid == 0) {
        if (n_in != 37 || in_sizes[0] != MP * D || out_size != (int)O_END || ws_size < WS_END) { fprintf(stderr, "kernel_launch: unexpected shapes (n_in %d, in0 %d, out %d, ws %zu)\n", n_in, n_in > 0 ? in_sizes[0] : -1, out_size, ws_size); grid = -1; return; }
        int dev = 0, cus = 0, per_cu = 0;
        if (hipGetDevice(&dev) != hipSuccess || hipDeviceGetAttribute(&cus, hipDeviceAttributeMultiprocessorCount, dev) != hipSuccess) { grid = -1; return; }
        if (hipFuncSetAttribute((const void*)fwd, hipFuncAttributeMaxDynamicSharedMemorySize, LDS_BYTES) != hipSuccess) { fprintf(stderr, "kernel_launch: hipFuncSetAttribute failed\n"); grid = -1; return; }
        if (hipOccupancyMaxActiveBlocksPerMultiprocessor(&per_cu, (const void*)fwd, NWAVES * 64, LDS_BYTES) != hipSuccess || per_cu < 1) { fprintf(stderr, "kernel_launch: occupancy query says %d\n", per_cu); }
        (void)hipGetLastError();
        grid = cus;
        if (grid < 256) { fprintf(stderr, "kernel_launch: this build needs 256 CUs (got %d)\n", grid); grid = -1; return; }
        grid = 256;
    }
    if (grid < 0) return;
    (void)hipMemsetAsync((char*)d_ws + WS_CTL, 0, CTL_ZERO_BYTES, stream);
    Args a{};
    for (int i = 0; i < 37; ++i) a.in[i] = (const float*)d_in[i];
    a.out = (float*)d_out; a.ws = (unsigned char*)d_ws;
    for (int li = 0; li < N_LAUNCHES; ++li) {
        if (N_LAUNCHES == 1) { a.ph_lo = 0; a.ph_hi = N_PHASES; } else { a.ph_lo = li; a.ph_hi = li + 1; }
        a.li = li;
        hipLaunchKernelGGL(fwd, dim3(grid), dim3(NWAVES * 64), LDS_BYTES, stream, a);
    }
}
```

```cpp
#include <hip/hip_runtime.h>
#include <cstdio>
#include <cstdint>
#include <cmath>

#ifndef MK_N_LAUNCHES
#define MK_N_LAUNCHES 1
#endif

namespace pg8 {
#define PG8_LAS __attribute__((address_space(3)))
typedef unsigned short bf16_t;
typedef short bf16x8 __attribute__((ext_vector_type(8)));
typedef float f32x4 __attribute__((ext_vector_type(4)));
typedef unsigned u32x4 __attribute__((ext_vector_type(4)));
constexpr int BM = 256, BK = 64, HALF = 128, HTB = HALF * BK * 2, STAGE_BYTES = 8 * HTB, NXCD = 8, WGM = 8;

__host__ __device__ __forceinline__ int lds_byte(int r, int c) { const int st = (r >> 4) * 2 + (c >> 5), rr = r & 15, cc = c & 31, ob = rr * 64 + cc * 2; return st * 1024 + (ob ^ (((ob >> 9) & 1) << 5)); }
__host__ __device__ __forceinline__ void stage_rc(int b, int& R, int& C) { const int st = b / 1024, sb = b % 1024, swz = sb ^ (((sb >> 9) & 1) << 5); R = (st >> 1) * 16 + swz / 64; C = (st & 1) * 32 + (swz % 64) / 2; }
__host__ __device__ __forceinline__ int perm32(int rho) { const int n = rho >> 4, i = rho & 15; return 8 * (i >> 2) + 4 * n + (i & 3); }

struct Unit { int pm, pn, k0, nkt, ks; };
struct Gemm { const bf16_t* A; const bf16_t* Bt; int M, N, K; };

struct StaticOrder {
    int nM, nN, nwg, G, c, K;
    __host__ __device__ void init(int M, int N, int G_, int c_, int K_) { nM = M / BM; nN = N / BM; nwg = nM * nN; G = G_; c = c_; K = K_; }
    __host__ __device__ __forceinline__ bool next(int i, Unit& u) const {
        const long L = (long)i * G + c; if (L >= nwg) return false;
        int wgid = (int)L; { const int q = nwg / NXCD, r = nwg % NXCD, xcd = wgid % NXCD, off = wgid / NXCD; wgid = (xcd < r ? xcd * (q + 1) : r * (q + 1) + (xcd - r) * q) + off; }
        const int nig = WGM * nN, gid = wgid / nig, fm = gid * WGM, gsz = (nM - fm) < WGM ? (nM - fm) : WGM;
        u.pm = fm + ((wgid % nig) % gsz); u.pn = (wgid % nig) / gsz; u.k0 = 0; u.nkt = K / BK; u.ks = 0; return true;
    }
    __device__ __forceinline__ void a_ready(const Unit&) const {}
    __device__ __forceinline__ void done(const Unit&) const {}
};

struct SplitOrder {
    StaticOrder P; int nN, NS, nP, G, c, K, r0;
    __host__ __device__ void init(int MPr, int N, int G_, int c_, int K_, int NS_) { P.init(MPr, N, G_, c_, K_); nN = N / BM; NS = NS_; nP = 2 * nN * NS; G = G_; c = c_; K = K_; r0 = (P.nwg + G - 1 - c) / G;   }
    __host__ __device__ __forceinline__ bool next(int i, Unit& u) const {
        Unit a; a.pm = 0; a.pn = 0; a.k0 = 0; a.nkt = K / BK; a.ks = 0;
        const bool okp = P.next(i < r0 ? i : 0, a);
        const int p = (i - r0) * G + (G - 1 - c), t = p / NS, ks = p % NS, nk = K / BK / NS;
        const bool split = i >= r0;
        u.pm = split ? P.nM + t / nN : a.pm; u.pn = split ? t % nN : a.pn; u.nkt = split ? nk : a.nkt; u.ks = split ? ks : 0; u.k0 = split ? ks * nk * BK : 0;
        return split ? (p < nP) : okp;
    }
    __device__ __forceinline__ void a_ready(const Unit&) const {}
    __device__ __forceinline__ void done(const Unit&) const {}
};

struct OneUnit {
    Unit u0;
    __host__ __device__ __forceinline__ bool next(int i, Unit& u) const { u = u0; return i == 0; }
    __device__ __forceinline__ void a_ready(const Unit&) const {}
    __device__ __forceinline__ void done(const Unit&) const {}
};
__device__ __forceinline__ void st16_wt(void* p, u32x4 v) { asm volatile("global_store_dwordx4 %0, %1, off sc1\n\ts_nop 1" :: "v"(p), "v"(v)); }
__device__ __forceinline__ void st16f_wt(void* p, f32x4 v) { asm volatile("global_store_dwordx4 %0, %1, off sc1\n\ts_nop 1" :: "v"(p), "v"(v)); }
__device__ __forceinline__ unsigned cvt_pk_bf16(float lo, float hi) { unsigned r; asm volatile("v_cvt_pk_bf16_f32 %0, %1, %2" : "=v"(r) : "v"(lo), "v"(hi)); return r; }
__device__ __forceinline__ float bf_lo(unsigned w) { return __builtin_bit_cast(float, w << 16); }
__device__ __forceinline__ float bf_hi(unsigned w) { return __builtin_bit_cast(float, w & 0xffff0000u); }

template <int ACT> struct EpiBf16 {
    static constexpr bool PERM = true, AFTER_DRAIN = false;
    bf16_t* O; int ldc; const float* bias;
    __device__ __forceinline__ void operator()(const f32x4 (&acc)[2][2][4][2], const Unit& u, int wr, int wc, int fr, int fq) const {
        const int row0 = u.pm * BM + wr * 64 + fr; const int col0 = u.pn * BM + wc * 32 + 8 * fq;
        f32x4 bv[2][2];
#pragma unroll
        for (int bj = 0; bj < 2; ++bj)
#pragma unroll
            for (int n = 0; n < 2; ++n) bv[bj][n] = bias ? *(const f32x4*)(bias + col0 + bj * HALF + 4 * n) : (f32x4){0.f, 0.f, 0.f, 0.f};
#pragma unroll
        for (int ai = 0; ai < 2; ++ai)
#pragma unroll
            for (int m = 0; m < 4; ++m) { bf16_t* rowp = O + (size_t)(row0 + ai * HALF + m * 16) * ldc + col0;
#pragma unroll
                for (int bj = 0; bj < 2; ++bj) { f32x4 v0 = acc[ai][bj][m][0] + bv[bj][0], v1 = acc[ai][bj][m][1] + bv[bj][1];
                    if (ACT == 3) {
#pragma unroll
                        for (int e = 0; e < 4; ++e) { const float a = fmaxf(v0[e], 0.f), b = fmaxf(v1[e], 0.f); v0[e] = a * a; v1[e] = b * b; } }
                    u32x4 w; w.x = cvt_pk_bf16(v0[0], v0[1]); w.y = cvt_pk_bf16(v0[2], v0[3]); w.z = cvt_pk_bf16(v1[0], v1[1]); w.w = cvt_pk_bf16(v1[2], v1[3]);
                    *(u32x4*)(rowp + bj * HALF) = w; } }
    }
};
struct EpiGlu {
    static constexpr bool PERM = true, AFTER_DRAIN = false;
    const bf16_t* Gy; int ldg; bf16_t* O; int ldc; int coff; const float* bias;
    __device__ __forceinline__ void operator()(const f32x4 (&acc)[2][2][4][2], const Unit& u, int wr, int wc, int fr, int fq) const {
        const int row0 = u.pm * BM + wr * 64 + fr; const int col0 = u.pn * BM + wc * 32 + 8 * fq;
        f32x4 bv[2][2];
#pragma unroll
        for (int bj = 0; bj < 2; ++bj)
#pragma unroll
            for (int n = 0; n < 2; ++n) bv[bj][n] = *(const f32x4*)(bias + col0 + bj * HALF + 4 * n);
#pragma unroll
        for (int ai = 0; ai < 2; ++ai)
#pragma unroll
            for (int m = 0; m < 4; ++m) { const size_t row = (size_t)(row0 + ai * HALF + m * 16);
#pragma unroll
                for (int bj = 0; bj < 2; ++bj) { const f32x4 v0 = acc[ai][bj][m][0] + bv[bj][0], v1 = acc[ai][bj][m][1] + bv[bj][1];
                    const u32x4 g = *(const u32x4*)(Gy + row * ldg + col0 + bj * HALF);
                    float o[8];
                    o[0] = bf_lo(g.x) * __builtin_amdgcn_rcpf(1.f + __builtin_amdgcn_exp2f(-1.4426950408889634f * v0[0])); o[1] = bf_hi(g.x) * __builtin_amdgcn_rcpf(1.f + __builtin_amdgcn_exp2f(-1.4426950408889634f * v0[1]));
                    o[2] = bf_lo(g.y) * __builtin_amdgcn_rcpf(1.f + __builtin_amdgcn_exp2f(-1.4426950408889634f * v0[2])); o[3] = bf_hi(g.y) * __builtin_amdgcn_rcpf(1.f + __builtin_amdgcn_exp2f(-1.4426950408889634f * v0[3]));
                    o[4] = bf_lo(g.z) * __builtin_amdgcn_rcpf(1.f + __builtin_amdgcn_exp2f(-1.4426950408889634f * v1[0])); o[5] = bf_hi(g.z) * __builtin_amdgcn_rcpf(1.f + __builtin_amdgcn_exp2f(-1.4426950408889634f * v1[1]));
                    o[6] = bf_lo(g.w) * __builtin_amdgcn_rcpf(1.f + __builtin_amdgcn_exp2f(-1.4426950408889634f * v1[2])); o[7] = bf_hi(g.w) * __builtin_amdgcn_rcpf(1.f + __builtin_amdgcn_exp2f(-1.4426950408889634f * v1[3]));
                    u32x4 w; w.x = cvt_pk_bf16(o[0], o[1]); w.y = cvt_pk_bf16(o[2], o[3]); w.z = cvt_pk_bf16(o[4], o[5]); w.w = cvt_pk_bf16(o[6], o[7]);
                    *(u32x4*)(O + row * ldc + coff + col0 + bj * HALF) = w; } }
    }
};
template <bool BASE16> struct EpiRes {
    static constexpr bool PERM = true, AFTER_DRAIN = false;
    const void* basep; bf16_t* T; const float* gate  ; const float* bias; float alpha; int MP; float* slab;
    __device__ __forceinline__ void operator()(const f32x4 (&acc)[2][2][4][2], const Unit& u, int wr, int wc, int fr, int fq) const {
        const int row0 = u.pm * BM + wr * 64 + fr, col0 = u.pn * BM + wc * 32 + 8 * fq;
        if (row0 >= MP) {
            float* sp = slab + (size_t)u.ks * 512 * 1024;
#pragma unroll
            for (int ai = 0; ai < 2; ++ai)
#pragma unroll
                for (int m = 0; m < 4; ++m) { float* op = sp + (size_t)(row0 + ai * HALF + m * 16 - MP) * 1024;
#pragma unroll
                    for (int bj = 0; bj < 2; ++bj)
#pragma unroll
                        for (int n = 0; n < 2; ++n) st16f_wt(op + col0 + bj * HALF + n * 4, acc[ai][bj][m][n]); }
            return; }
        f32x4 bv[2][2];
#pragma unroll
        for (int bj = 0; bj < 2; ++bj)
#pragma unroll
            for (int n = 0; n < 2; ++n) bv[bj][n] = bias ? *(const f32x4*)(bias + col0 + bj * HALF + n * 4) : (f32x4){0.f, 0.f, 0.f, 0.f};
        const float* gp = gate + (size_t)(row0 >> 11) * 6144;
#pragma unroll
        for (int ai = 0; ai < 2; ++ai)
#pragma unroll
            for (int m = 0; m < 4; ++m) { const int row = row0 + ai * HALF + m * 16;
                bf16_t* tp = T + (size_t)row * 1024;
#pragma unroll
                for (int bj = 0; bj < 2; ++bj) { const int c = col0 + bj * HALF;
                    f32x4 b0, b1;
                    if (BASE16) { const u32x4 bw = *(const u32x4*)((const bf16_t*)basep + (size_t)row * 1024 + c); b0 = (f32x4){bf_lo(bw.x), bf_hi(bw.x), bf_lo(bw.y), bf_hi(bw.y)}; b1 = (f32x4){bf_lo(bw.z), bf_hi(bw.z), bf_lo(bw.w), bf_hi(bw.w)}; }
                    else { const float* bp = (const float*)basep + (size_t)row * 1024; b0 = *(const f32x4*)(bp + c); b1 = *(const f32x4*)(bp + c + 4); }
                    const f32x4 g0 = *(const f32x4*)(gp + c), g1 = *(const f32x4*)(gp + c + 4);
                    const f32x4 v0 = b0 * alpha + g0 * (acc[ai][bj][m][0] + bv[bj][0]), v1 = b1 * alpha + g1 * (acc[ai][bj][m][1] + bv[bj][1]);
                    u32x4 w; w.x = cvt_pk_bf16(v0[0], v0[1]); w.y = cvt_pk_bf16(v0[2], v0[3]); w.z = cvt_pk_bf16(v1[0], v1[1]); w.w = cvt_pk_bf16(v1[2], v1[3]);
                    st16_wt(tp + c, w); } }
    }
};

template <class Epi, class Sched, bool ALIGN_EPI = false, bool SP2 = false>
__device__ __forceinline__ void gemm_phase(PG8_LAS unsigned char* lds, const Gemm g, const Sched& S, const Epi& E) {
    const int tid = threadIdx.x, wid = __builtin_amdgcn_readfirstlane(tid >> 6), lane = tid & 63, wr = wid >> 2, wc = wid & 3, fr = lane & 15, fq = lane >> 4;
    const int K = g.K;
    unsigned voffA[2], voffB[2];
#pragma unroll
    for (int i = 0; i < 2; ++i) { int R, C; stage_rc(tid * 16 + i * 8192, R, C); const int Rb = Epi::PERM ? ((R & ~31) + perm32(R & 31)) : R;
        voffA[i] = (unsigned)(R * K + C) * 2u; voffB[i] = (unsigned)(Rb * K + C) * 2u; }
    const size_t kstep = (size_t)(BK * 2);
    const size_t hstep = (size_t)HALF * K * 2;
    const size_t tstep = 2 * hstep;
    const unsigned ldsw = (unsigned)wid * 1024u;
    const int aoff = lds_byte(wr * 64 + fr, fq * 8), boff = lds_byte(wc * 32 + fr, fq * 8);
#define PG8_SA(b, h) (((b) * 2 + (h)) * HTB)
#define PG8_SB(b, h) ((4 + (b) * 2 + (h)) * HTB)
#define PG8_STAGE(bufoff, gbase, voff) do { _Pragma("unroll") for (int _i = 0; _i < 2; ++_i) \
        __builtin_amdgcn_global_load_lds((const unsigned*)((const char*)(gbase) + (voff)[_i]), (PG8_LAS unsigned*)(lds + (bufoff) + ldsw + _i * 8192), 16, 0, 0); } while (0)
#define PG8_LDA(dst, b, h) do { _Pragma("unroll") for (int m = 0; m < 4; ++m) _Pragma("unroll") for (int k = 0; k < 2; ++k) dst[m][k] = *(const PG8_LAS bf16x8*)(lds + PG8_SA(b, h) + aoff + m * 2048 + k * 1024); } while (0)
#define PG8_LDB(dst, b, h) do { _Pragma("unroll") for (int n = 0; n < 2; ++n) _Pragma("unroll") for (int k = 0; k < 2; ++k) dst[n][k] = *(const PG8_LAS bf16x8*)(lds + PG8_SB(b, h) + boff + n * 2048 + k * 1024); } while (0)
#define PG8_MMA(ai, bj, At, Bt) do { __builtin_amdgcn_s_setprio(1); _Pragma("unroll") for (int m = 0; m < 4; ++m) _Pragma("unroll") for (int n = 0; n < 2; ++n) _Pragma("unroll") for (int k = 0; k < 2; ++k) \
        acc[ai][bj][m][n] = __builtin_amdgcn_mfma_f32_16x16x32_bf16(Bt[n][k], At[m][k], acc[ai][bj][m][n], 0, 0, 0); __builtin_amdgcn_s_setprio(0); } while (0)
#define PG8_WAIT_V(n) asm volatile("s_waitcnt vmcnt(" #n ")" ::: "memory")
#define PG8_WAIT_L(n) asm volatile("s_waitcnt lgkmcnt(" #n ")" ::: "memory")
#define PG8_BAR __builtin_amdgcn_s_barrier()
#define PG8_SCHED __builtin_amdgcn_sched_barrier(0)
    Unit cur, nxt; int ui = 0;
    if (!S.next(0, cur)) return;
    f32x4 acc[2][2][4][2];
#pragma unroll
    for (int a = 0; a < 2; ++a)
#pragma unroll
        for (int b = 0; b < 2; ++b)
#pragma unroll
            for (int m = 0; m < 4; ++m)
#pragma unroll
                for (int n = 0; n < 2; ++n) acc[a][b][m][n] = (f32x4){0.f, 0.f, 0.f, 0.f};
    bf16x8 At[4][2], B0[2][2], B1[2][2];
    const char* cA = (const char*)g.A + (size_t)cur.pm * tstep + (size_t)cur.k0 * 2; const char* cB = (const char*)g.Bt + (size_t)cur.pn * tstep + (size_t)cur.k0 * 2;
    S.a_ready(cur);
    if constexpr (SP2) {
        PG8_STAGE(PG8_SB(0, 0), cB, voffB); PG8_STAGE(PG8_SB(0, 1), cB + hstep, voffB); PG8_STAGE(PG8_SA(0, 0), cA, voffA); PG8_STAGE(PG8_SA(0, 1), cA + hstep, voffA);
        if (wr == 1) PG8_BAR;
        PG8_WAIT_V(2); PG8_BAR;
        PG8_STAGE(PG8_SB(1, 0), cB + kstep, voffB); PG8_STAGE(PG8_SA(1, 0), cA + kstep, voffA); PG8_STAGE(PG8_SB(1, 1), cB + hstep + kstep, voffB);
        PG8_WAIT_V(6); PG8_BAR;
    } else {
        PG8_STAGE(PG8_SB(0, 0), cB, voffB); PG8_STAGE(PG8_SA(0, 0), cA, voffA); PG8_STAGE(PG8_SB(0, 1), cB + hstep, voffB); PG8_STAGE(PG8_SA(0, 1), cA + hstep, voffA);
        if (wr == 1) PG8_BAR;
        PG8_WAIT_V(4); PG8_BAR;
        PG8_STAGE(PG8_SB(1, 0), cB + kstep, voffB); PG8_STAGE(PG8_SA(1, 0), cA + kstep, voffA); PG8_STAGE(PG8_SB(1, 1), cB + hstep + kstep, voffB);
        PG8_WAIT_V(6); PG8_BAR;
    }
    for (;;) {
        const bool has_next = S.next(ui + 1, nxt);
        const char* nA = has_next ? (const char*)g.A + (size_t)nxt.pm * tstep + (size_t)nxt.k0 * 2 : cA; const char* nB = has_next ? (const char*)g.Bt + (size_t)nxt.pn * tstep + (size_t)nxt.k0 * 2 : cB;
        const int nt = cur.nkt;
        for (int t = 0; t < nt; t += 2) {
            const bool last = (t == nt - 2);
            const char* a1 = cA + (size_t)(t + 1) * kstep;
            const char* a2 = last ? nA : cA + (size_t)(t + 2) * kstep; const char* b2 = last ? nB : cB + (size_t)(t + 2) * kstep;
            const char* a3 = a2 + kstep; const char* b3 = b2 + kstep;
            if (last && has_next) S.a_ready(nxt);
            if constexpr (SP2) {
            PG8_LDB(B0, 0, 0); PG8_LDB(B1, 0, 1); PG8_SCHED; PG8_LDA(At, 0, 0); PG8_STAGE(PG8_SA(1, 1), a1 + hstep, voffA);
            PG8_WAIT_V(8); PG8_WAIT_L(0); PG8_BAR; PG8_MMA(0, 0, At, B0); PG8_MMA(0, 1, At, B1); PG8_BAR; PG8_SCHED;
            PG8_LDA(At, 0, 1); PG8_STAGE(PG8_SB(0, 0), b2, voffB); PG8_STAGE(PG8_SB(0, 1), b2 + hstep, voffB); PG8_STAGE(PG8_SA(0, 0), a2, voffA);
            PG8_WAIT_V(8); PG8_WAIT_L(0); PG8_BAR; PG8_MMA(1, 0, At, B0); PG8_MMA(1, 1, At, B1); PG8_BAR; PG8_SCHED;
            PG8_LDB(B0, 1, 0); PG8_LDB(B1, 1, 1); PG8_SCHED; PG8_LDA(At, 1, 0); PG8_STAGE(PG8_SA(0, 1), a2 + hstep, voffA);
            PG8_WAIT_V(8); PG8_WAIT_L(0); PG8_BAR; PG8_MMA(0, 0, At, B0); PG8_MMA(0, 1, At, B1); PG8_BAR; PG8_SCHED;
            PG8_LDA(At, 1, 1); PG8_STAGE(PG8_SB(1, 0), b3, voffB); PG8_STAGE(PG8_SB(1, 1), b3 + hstep, voffB); PG8_STAGE(PG8_SA(1, 0), a3, voffA);
            PG8_WAIT_V(8); PG8_WAIT_L(0); PG8_BAR; PG8_MMA(1, 0, At, B0); PG8_MMA(1, 1, At, B1); PG8_BAR; PG8_SCHED;
            } else {
            PG8_LDB(B0, 0, 0); PG8_SCHED; PG8_LDA(At, 0, 0); PG8_STAGE(PG8_SA(1, 1), a1 + hstep, voffA);
            PG8_WAIT_L(8); PG8_BAR; PG8_WAIT_L(0); PG8_MMA(0, 0, At, B0); PG8_BAR; PG8_SCHED;
            PG8_LDB(B1, 0, 1); PG8_STAGE(PG8_SB(0, 0), b2, voffB);
            PG8_BAR; PG8_WAIT_L(0); PG8_MMA(0, 1, At, B1); PG8_BAR;
            PG8_LDA(At, 0, 1); PG8_STAGE(PG8_SA(0, 0), a2, voffA);
            PG8_BAR; PG8_WAIT_L(0); PG8_MMA(1, 0, At, B0); PG8_BAR; PG8_SCHED;
            PG8_STAGE(PG8_SB(0, 1), b2 + hstep, voffB);
            PG8_WAIT_V(6); PG8_BAR; PG8_MMA(1, 1, At, B1); PG8_BAR;
            PG8_LDB(B0, 1, 0); PG8_SCHED; PG8_LDA(At, 1, 0); PG8_STAGE(PG8_SA(0, 1), a2 + hstep, voffA);
            PG8_WAIT_L(8); PG8_BAR; PG8_WAIT_L(0); PG8_MMA(0, 0, At, B0); PG8_BAR; PG8_SCHED;
            PG8_LDB(B1, 1, 1); PG8_STAGE(PG8_SB(1, 0), b3, voffB);
            PG8_BAR; PG8_WAIT_L(0); PG8_MMA(0, 1, At, B1); PG8_BAR;
            PG8_LDA(At, 1, 1); PG8_STAGE(PG8_SA(1, 0), a3, voffA);
            PG8_BAR; PG8_WAIT_L(0); PG8_MMA(1, 0, At, B0); PG8_BAR; PG8_SCHED;
            PG8_STAGE(PG8_SB(1, 1), b3 + hstep, voffB);
            PG8_WAIT_V(6); PG8_BAR; PG8_MMA(1, 1, At, B1); PG8_BAR;
            }
        }
        if constexpr (ALIGN_EPI) { if (wr == 0) PG8_BAR; }
        if constexpr (!Epi::AFTER_DRAIN) { E(acc, cur, wr, wc, fr, fq); S.done(cur); }
        if (!has_next) break;
#pragma unroll
        for (int a = 0; a < 2; ++a)
#pragma unroll
            for (int b = 0; b < 2; ++b)
#pragma unroll
                for (int m = 0; m < 4; ++m)
#pragma unroll
                    for (int n = 0; n < 2; ++n) acc[a][b][m][n] = (f32x4){0.f, 0.f, 0.f, 0.f};
        cur = nxt; cA = nA; cB = nB; ++ui;
        if constexpr (ALIGN_EPI) { if (wr == 1) PG8_BAR; }
    }
    PG8_WAIT_V(0);
    if constexpr (!ALIGN_EPI) { if (wr == 0) PG8_BAR; }
    PG8_BAR;
#undef PG8_SA
#undef PG8_SB
#undef PG8_STAGE
#undef PG8_LDA
#undef PG8_LDB
#undef PG8_MMA
#undef PG8_WAIT_V
#undef PG8_WAIT_L
#undef PG8_BAR
#undef PG8_SCHED
}
}

#ifndef PROBE_DUP
#define PROBE_DUP 0
#endif
#ifndef PG8_SP2
#define PG8_SP2 true
#endif
#ifndef PG8_ALIGN
#define PG8_ALIGN true
#endif

constexpr int NWAVES = 8;
constexpr int N_LAUNCHES = MK_N_LAUNCHES;
constexpr int N_PHASES = 10;
constexpr int D = 1024, MP = 16384, MS = 512, M = MP + MS, TP = 2048, NBP = 8, NBS = 128, TS = 4;
constexpr int NZ = 1536, WA = 512, WB = 512, FF = 4096, NMOD = 6 * D, NROWMOD = NBP + NBS;
constexpr int GB = 32, NS5 = 64, KS5 = 16, HA = 8, HDA = 64;
constexpr float LN_EPS = 1e-5f;
constexpr int NS_OUT = 4, NS_DOWN = 8;
constexpr float ALPHA = 1.189207115002721f;

constexpr size_t O_YP = 0, O_YS = (size_t)MP * D, O_CONVP = O_YS + (size_t)MS * D, O_HP = O_CONVP + (size_t)NBP * 3 * WA, O_SRP = O_HP + (size_t)NBP * WA,
                 O_SIP = O_SRP + (size_t)NBP * GB * NS5, O_CONVS = O_SIP + (size_t)NBP * GB * NS5, O_HS = O_CONVS + (size_t)NBS * 3 * WA, O_SRS = O_HS + (size_t)NBS * WA,
                 O_SIS = O_SRS + (size_t)NBS * GB * NS5, O_END = O_SIS + (size_t)NBS * GB * NS5;

constexpr size_t MiB = 1u << 20;
constexpr size_t WS_CTL = 0, CTL_ZERO_BYTES = 1 * MiB;
constexpr size_t WS_WIN = 1 * MiB, WS_WGLU = 4 * MiB, WS_WOUT = 5 * MiB, WS_W1 = 7 * MiB, WS_W2 = 15 * MiB;
constexpr size_t WS_MOD = 23 * MiB;
constexpr size_t WS_S5C = 27 * MiB;
constexpr size_t WS_XN = 28 * MiB;
constexpr size_t WS_Z = 61 * MiB;
constexpr size_t WS_YCAT = 111 * MiB;
constexpr size_t WS_G = 144 * MiB;
constexpr size_t WS_U = 61 * MiB;
constexpr size_t WS_T1 = WS_Z;
constexpr size_t WS_T2 = WS_XN;
constexpr size_t WS_TAB = 194 * MiB;
constexpr size_t WS_SLAB = 196 * MiB;
constexpr size_t WS_X1B = 212 * MiB;
constexpr size_t WS_END = 246 * MiB;
constexpr size_t TB_BF1 = 0, TB_BF2 = TB_BF1 + 32 * 4 * 64 * 16, TB_TA = TB_BF2 + 32 * 8 * 64 * 16, TB_ZP = TB_TA + 32 * 2 * 2 * 32 * 4, TB_Z16N = TB_ZP + 32 * 17 * 2 * 2 * 32 * 4,
                 TB_RG = TB_Z16N + 32 * 2 * 64 * 4, TB_CB = TB_RG + 8 * 2 * 2 * 4 * 64 * 16, TB_SILU = TB_CB + 128 * 3 * 512 * 2, TB_DG = TB_SILU + 160 * 1024 * 2, TB_END = TB_DG + 8 * 16 * 64 * 16;
static_assert(WS_TAB + TB_END <= WS_SLAB, "tables");
static_assert(WS_XN + (size_t)M * D * 2 <= WS_Z && WS_Z + (size_t)M * NZ * 2 <= WS_YCAT && WS_YCAT + (size_t)M * D * 2 <= WS_G && WS_G + (size_t)M * WB * 2 <= WS_END && WS_U + (size_t)M * FF * 2 <= WS_TAB, "d_ws map");
constexpr int SC_ABR = 0, SC_ABI = 2048, SC_BBR = 4096, SC_BBI = 4096 + 32768, SC_RGL = 4096 + 65536, SC_END = SC_RGL + 512;
constexpr int CW_TMO = 0, CW_CODE = 1, CW_SILU = 64, CW_MOD = 1024  , CW_S5B = 128  , CW_BAR = 4096,
              CW_T1 = 8192  , CW_T2 = 12288  , CW_T1S = 16384, CW_T2S = 16448  ;

constexpr int RING_OFF = 0, RING_BYTES = 131072;
constexpr int LDSCTL_OFF = RING_BYTES, MISC_OFF = LDSCTL_OFF + 320;
constexpr int LDS_BYTES = 147456;

#define GAS __attribute__((address_space(1)))
#define LAS __attribute__((address_space(3)))
typedef unsigned short bf16;
typedef unsigned v4u __attribute__((ext_vector_type(4)));
typedef float f32x4 __attribute__((ext_vector_type(4)));
typedef GAS unsigned gu32;
#define RLX_AGENT __ATOMIC_RELAXED, __HIP_MEMORY_SCOPE_AGENT
#define LDS_WAIT() asm volatile("s_waitcnt lgkmcnt(0)" ::: "memory")
#define VM_WAIT() asm volatile("s_waitcnt vmcnt(0)" ::: "memory")
__device__ __forceinline__ unsigned f2bf(float f) { unsigned u = __builtin_bit_cast(unsigned, f); return (u + 0x7fffu + ((u >> 16) & 1u)) >> 16; }
__device__ __forceinline__ unsigned pk2(float lo, float hi) { return f2bf(lo) | (f2bf(hi) << 16); }
__device__ __forceinline__ float bf2f(bf16 v) { return __builtin_bit_cast(float, (unsigned)v << 16); }
__device__ __forceinline__ float gelu_tanh(float x) { const float t = -2.3022082f * (x + 0.044715f * x * x * x); return x * __builtin_amdgcn_rcpf(1.f + __builtin_amdgcn_exp2f(t)); }
__device__ __forceinline__ float sigmoidf_(float x) { return __builtin_amdgcn_rcpf(1.f + __builtin_amdgcn_exp2f(-1.4426950408889634f * x)); }

#define XB_TMO      128
#define XB_XCNT(j)  (256  + 64 * (j))
#define XB_XSUB(j)  (1280 + 64 * (j))
#define XB_XGEN(j)  (2304 + 64 * (j))
#define XB_TOP      3328
#define XB_TOPGEN   3392
#define XCD_BAR_WORDS 3456
#define XB_SPIN_CAP (1u << 18)
__device__ __forceinline__ unsigned xb_ld(unsigned* p)              { return __hip_atomic_load(p, __ATOMIC_RELAXED, __HIP_MEMORY_SCOPE_AGENT); }
__device__ __forceinline__ unsigned xb_add(unsigned* p, unsigned v) { return __hip_atomic_fetch_add(p, v, __ATOMIC_RELAXED, __HIP_MEMORY_SCOPE_AGENT); }
__device__ __forceinline__ unsigned xb_xcc_id() { return (unsigned)__builtin_amdgcn_s_getreg((3 << 11) | 20) & 0xFu; }
#define XB_SPIN(cond, bar) do { unsigned _sp = 0; while (cond) { __builtin_amdgcn_s_sleep(1); \
    if ((++_sp & 255u) == 0u) { if (xb_ld(&(bar)[XB_TMO])) break; if (_sp > XB_SPIN_CAP) { atomicAdd(&(bar)[XB_TMO], 1u); break; } } } } while (0)
struct XcdBarrier { unsigned* bar; unsigned x; volatile LAS unsigned* st; };
__device__ __forceinline__ XcdBarrier xcd_barrier_post(unsigned* bar, volatile LAS unsigned* st) {
    XcdBarrier b; b.bar = bar; b.x = xb_xcc_id(); b.st = st;
    if (threadIdx.x == 0) (void)xb_add(&bar[XB_XCNT(b.x)], 1u);
    return b;
}
__device__ __forceinline__ void xcd_barrier_complete(unsigned* bar, unsigned x, unsigned& nloc, unsigned& nx) {
    const unsigned G = gridDim.x * gridDim.y * gridDim.z;
    unsigned sum, cnt, mine, sp = 0u;
    for (;;) {
        sum = 0u; cnt = 0u; mine = 0u;
#pragma unroll
        for (unsigned j = 0; j < 16; ++j) { const unsigned c = xb_ld(&bar[XB_XCNT(j)]); sum += c; cnt += (c > 0u) ? 1u : 0u; mine = (j == x) ? c : mine; }
        if (sum == G) break;
        __builtin_amdgcn_s_sleep(1);
        if ((++sp & 255u) == 0u) { if (xb_ld(&bar[XB_TMO])) break; if (sp > XB_SPIN_CAP) { atomicAdd(&bar[XB_TMO], 1u); break; } }
    }
    nloc = mine > 0u ? mine : 1u; nx = cnt > 0u ? cnt : 1u;
}
__device__ __forceinline__ void xcd_barrier(const XcdBarrier& b) {
    asm volatile("s_waitcnt vmcnt(0)" ::: "memory");
    __syncthreads();
    if (threadIdx.x == 0) {
        unsigned* bar = b.bar;
        __builtin_amdgcn_s_waitcnt(0);
        unsigned nloc = b.st[0], nx = b.st[1];
        if (nloc == 0u) { xcd_barrier_complete(bar, b.x, nloc, nx); b.st[0] = nloc; b.st[1] = nx; }
        const unsigned old = xb_add(&bar[XB_XSUB(b.x)], 1u);
        const unsigned gen = old / nloc;
        if (old + 1u == (gen + 1u) * nloc) {
            __builtin_amdgcn_fence(__ATOMIC_RELEASE, "agent");
            asm volatile("s_waitcnt vmcnt(0)" ::: "memory");
            const unsigned og = xb_add(&bar[XB_TOP], 1u);
            const unsigned tg = og / nx;
            if (og + 1u == (tg + 1u) * nx) xb_add(&bar[XB_TOPGEN], 1u);
            else XB_SPIN(xb_ld(&bar[XB_TOPGEN]) == tg, bar);
            __builtin_amdgcn_fence(__ATOMIC_ACQUIRE, "agent");
            xb_add(&bar[XB_XGEN(b.x)], 1u);
            asm volatile("s_waitcnt vmcnt(0)" ::: "memory");
        } else {
            XB_SPIN(xb_ld(&bar[XB_XGEN(b.x)]) == gen, bar);
            __builtin_amdgcn_fence(__ATOMIC_ACQUIRE, "agent");
            asm volatile("s_waitcnt vmcnt(0)" ::: "memory");
        }
    }
    __syncthreads();
}

struct Frame {
    LAS unsigned char* lds;
    volatile LAS unsigned* MISC;
    gu32* ctl;
    int tid, lane, wave;
    int vcu, G;
    float* out;
    unsigned char* ws;
};
struct Args { const float* in[37]; float* out; unsigned char* ws; int ph_lo, ph_hi, li, pad; };
__device__ __forceinline__ void refresh(Frame& F) { int t = threadIdx.x; asm volatile("" : "+v"(t)); F.tid = t; F.lane = t & 63; F.wave = __builtin_amdgcn_readfirstlane(t >> 6); }
__device__ __forceinline__ void cnt_arrive(Frame& F, int word) {
    VM_WAIT(); __syncthreads();
    if (F.tid == 0) { __builtin_amdgcn_fence(__ATOMIC_RELEASE, "agent"); VM_WAIT(); (void)__hip_atomic_fetch_add((unsigned*)(F.ctl + word), 1u, RLX_AGENT); }
}
__device__ __forceinline__ void cnt_arrive_wt(Frame& F, int word) {
    VM_WAIT(); __syncthreads();
    if (F.tid == 0) (void)__hip_atomic_fetch_add((unsigned*)(F.ctl + word), 1u, RLX_AGENT);
}
__device__ __forceinline__ void cnt_wait_ge(Frame& F, int word, unsigned target) {
    if (F.tid == 0) { unsigned sp = 0; while (__hip_atomic_load((unsigned*)(F.ctl + word), RLX_AGENT) < target && ++sp < (1u << 22)) __builtin_amdgcn_s_sleep(2);
        __builtin_amdgcn_fence(__ATOMIC_ACQUIRE, "agent"); VM_WAIT(); }
    __syncthreads();
}
__device__ __forceinline__ float wave_sum(float v) {
#pragma unroll
    for (int o = 1; o < 64; o <<= 1) v += __shfl_xor(v, o);
    return v;
}
enum { I_XP = 0, I_XS, I_SCONV, I_SH, I_SSR, I_SSI, I_CP, I_CS, I_ADAW, I_ADAB, I_INPROJ, I_CONVW, I_CONVB, I_RGWR, I_RGBR, I_RGWI, I_RGBI, I_RGLAM,
       I_S5ARE, I_S5AIM, I_S5LOGDT, I_S5BRE, I_S5BIM, I_S5CRE, I_S5CIM, I_S5D, I_GLUW, I_GLUB, I_OUTPROJ, I_LN1G, I_LN1B, I_W1, I_B1, I_W2, I_B2, I_LN2G, I_LN2B };

typedef float f32x2m __attribute__((ext_vector_type(2)));
typedef __bf16 bf16x2m __attribute__((ext_vector_type(2)));
__device__ __forceinline__ unsigned pkbf0(float a, float b) { const f32x2m v = {a, b}; const bf16x2m r = __builtin_convertvector(v, bf16x2m); return __builtin_bit_cast(unsigned, r); }
typedef short bf16x8m __attribute__((ext_vector_type(8)));
typedef float f32x16m __attribute__((ext_vector_type(16)));
__device__ __forceinline__ void p0_transpose_item(const float* W, int K, int N, bf16* WT, LAS float* scr, int item, int lane) {
    const int nblk = N / 32, kb = item / nblk, nb = item % nblk, k0 = 64 * kb, n0 = 32 * nb;
#pragma unroll 8
    for (int i = 0; i < 32; ++i) { const int kk = 2 * i + (lane >> 5); scr[kk * 33 + (lane & 31)] = W[(size_t)(k0 + kk) * N + n0 + (lane & 31)]; }
    LDS_WAIT(); asm volatile("" ::: "memory");
    const int c = lane & 7;
#pragma unroll
    for (int j = 0; j < 4; ++j) { const int n = (lane >> 3) + 8 * j; const LAS float* s = scr + (8 * c) * 33 + n;
        v4u o; o.x = pk2(s[0 * 33], s[1 * 33]); o.y = pk2(s[2 * 33], s[3 * 33]); o.z = pk2(s[4 * 33], s[5 * 33]); o.w = pk2(s[6 * 33], s[7 * 33]);
        *(GAS v4u*)(WT + (size_t)(n0 + n) * K + k0 + 8 * c) = o; }
    LDS_WAIT(); asm volatile("" ::: "memory");
}

constexpr int XI_IN = (D / 64) * (NZ / 32), XI_GL = (WB / 64) * (WB / 32), XI_OU = (D / 64) * (D / 32), XI_1 = (D / 64) * (FF / 32), XI_2 = (FF / 64) * (D / 32);
constexpr int XO_OU = XI_IN + XI_GL, XO_1 = XO_OU + XI_OU, XO_2 = XO_1 + XI_1, XO_END = XO_2 + XI_2;
__device__ __forceinline__ void xpose_item(Frame& F, const Args& A, LAS float* scr, int r) {
    if (r < XI_IN) { p0_transpose_item(A.in[I_INPROJ], D, NZ, (bf16*)(F.ws + WS_WIN), scr, r, F.lane); return; } r -= XI_IN;
    if (r < XI_GL) { p0_transpose_item(A.in[I_GLUW], WB, WB, (bf16*)(F.ws + WS_WGLU), scr, r, F.lane); return; } r -= XI_GL;
    if (r < XI_OU) { p0_transpose_item(A.in[I_OUTPROJ], D, D, (bf16*)(F.ws + WS_WOUT), scr, r, F.lane); return; } r -= XI_OU;
    if (r < XI_1) { p0_transpose_item(A.in[I_W1], D, FF, (bf16*)(F.ws + WS_W1), scr, r, F.lane); return; } r -= XI_1;
    p0_transpose_item(A.in[I_W2], FF, D, (bf16*)(F.ws + WS_W2), scr, r, F.lane);
}
__device__ __forceinline__ void xpose_range(Frame& F, const Args& A, int lo, int hi, int vlo) {
    refresh(F);
    if (F.vcu < vlo) return;
    LAS float* scr = (LAS float*)(F.lds + RING_OFF + F.wave * 16384);
    const int gw = F.wave * (F.G - vlo) + (F.vcu - vlo), ngw = (F.G - vlo) * NWAVES;
    for (int it = lo + gw; it < hi; it += ngw) xpose_item(F, A, scr, it);
}
__device__ __forceinline__ void xpose_range_b(Frame& F, const Args& A, int lo, int hi, int blo) {
    refresh(F);
    LAS float* scr = (LAS float*)(F.lds + RING_OFF + F.wave * 16384);
    const int gw = F.wave * (F.G - blo) + ((int)blockIdx.x - blo), ngw = (F.G - blo) * NWAVES;
    for (int it = lo + gw; it < hi; it += ngw) xpose_item(F, A, scr, it);
}
#ifndef PROBE_P0PART
#define PROBE_P0PART 7
#endif
__device__ __forceinline__ void p0_prologue(Frame& F, const Args& A, int rep = 0) {
    refresh(F);
    const int pmask = rep ? PROBE_P0PART : 7;
    LAS float* scr = (LAS float*)(F.lds + RING_OFF + F.wave * 16384);
    const int gw = F.wave * F.G + F.vcu, NGW = F.G * NWAVES;
    {
        bf16* ST = (bf16*)(F.ws + WS_TAB + TB_SILU);
        for (int ch = F.vcu * NWAVES * 64 + F.tid; ch < 160 * 1024 / 8; ch += F.G * NWAVES * 64) { const int row = ch >> 7, k = (ch & 127) * 8; v4u o = (v4u){0u, 0u, 0u, 0u};
            if (row < NROWMOD) { const float* cp = (row < NBP ? A.in[I_CP] + (size_t)row * D : A.in[I_CS] + (size_t)(row - NBP) * D) + k; const f32x4 c0 = *(const f32x4*)cp, c1 = *(const f32x4*)(cp + 4);
                o.x = pk2(c0[0] * sigmoidf_(c0[0]), c0[1] * sigmoidf_(c0[1])); o.y = pk2(c0[2] * sigmoidf_(c0[2]), c0[3] * sigmoidf_(c0[3]));
                o.z = pk2(c1[0] * sigmoidf_(c1[0]), c1[1] * sigmoidf_(c1[1])); o.w = pk2(c1[2] * sigmoidf_(c1[2]), c1[3] * sigmoidf_(c1[3])); }
            pg8::st16_wt(ST + (size_t)ch * 8, o); }
        cnt_arrive_wt(F, CW_SILU);
    }
    constexpr int I_IN = XI_IN, I_GL = XI_GL;
    constexpr int I_S5 = GB, I_RG = WA / 64, I_RGT = HA * 2 * 2 * 4, I_CB = NBS * 3 * WA / 512, I_DG = HA * 16;
    constexpr int NITEMS = I_IN + I_GL + I_S5 + I_RG + I_RGT + I_CB + I_DG;
    float* sc = (float*)(F.ws + WS_S5C);
    for (int it = gw; it < NITEMS; it += NGW) {
        int r = it;
        if (!(pmask & 1) && it < I_IN + I_GL) continue;
        if (!(pmask & 2) && it >= I_IN + I_GL) continue;
        if (r < I_IN + I_GL) { xpose_item(F, A, scr, r); continue; } r -= I_IN + I_GL;
        if (r < I_S5) {
            const int g = r, n = F.lane, gn = g * NS5 + n;
            const double dt = exp((double)A.in[I_S5LOGDT][g]), ar = (double)A.in[I_S5ARE][gn], ai = (double)A.in[I_S5AIM][gn];
            const double mag = exp(dt * ar), abr = mag * cos(dt * ai), abi = mag * sin(dt * ai), den = ar * ar + ai * ai, nr = abr - 1.0;
            const double qr = (nr * ar + abi * ai) / den, qi = (abi * ar - nr * ai) / den;
            sc[SC_ABR + gn] = (float)abr; sc[SC_ABI + gn] = (float)abi;
            unsigned char* tab = F.ws + WS_TAB;
            bf16* BF1 = (bf16*)(tab + TB_BF1); bf16* BF2 = (bf16*)(tab + TB_BF2); float* TA = (float*)(tab + TB_TA); float* ZP = (float*)(tab + TB_ZP); float* Z16N = (float*)(tab + TB_Z16N);
            const int sh = n >> 5, v = n & 31, hh = (v >> 2) & 1, ii = (v & 3) + 4 * (v >> 3);
            for (int k = 0; k < KS5; ++k) { const double br = (double)A.in[I_S5BRE][gn * KS5 + k], bi = (double)A.in[I_S5BIM][gn * KS5 + k];
                const float vr = (float)(qr * br - qi * bi), vi = (float)(qr * bi + qi * br);
                sc[SC_BBR + gn * KS5 + k] = vr; sc[SC_BBI + gn * KS5 + k] = vi;
                const int lp = (n & 31) + 32 * (k >> 3), jj = k & 7;
                BF1[(size_t)((g * 4 + 0 + sh) * 64 + lp) * 8 + jj] = (bf16)f2bf(vr); BF1[(size_t)((g * 4 + 2 + sh) * 64 + lp) * 8 + jj] = (bf16)f2bf(vi); }
            { const int s2 = (n >> 4) & 1, jj = 4 * ((n >> 3) & 1) + (n & 3), hk = (n >> 2) & 1;
              for (int ch = 0; ch < KS5; ++ch) { const int hr_ = ch >> 3, i8 = ch & 7, R = (i8 & 3) + 8 * (i8 >> 2) + 4 * hr_, lp = R + 32 * hk;
                  const float cr = A.in[I_S5CRE][(size_t)(g * KS5 + ch) * NS5 + n], ci = A.in[I_S5CIM][(size_t)(g * KS5 + ch) * NS5 + n];
                  BF2[(size_t)((g * 8 + (0 + sh) * 2 + s2) * 64 + lp) * 8 + jj] = (bf16)f2bf(cr); BF2[(size_t)((g * 8 + (2 + sh) * 2 + s2) * 64 + lp) * 8 + jj] = (bf16)f2bf(-ci); }
              for (int z = 0; z < 4; ++z) { const int cidx = n + 64 * z, ks = cidx >> 5, r16 = cidx & 31, lp = 16 + (r16 & 15) + 32 * (r16 >> 4);
                  *(v4u*)(BF2 + (size_t)((g * 8 + ks) * 64 + lp) * 8) = (v4u){0u, 0u, 0u, 0u}; } }
            TA[((g * 2 + hh) * 2 + 0) * 32 + sh * 16 + ii] = (float)abr; TA[((g * 2 + hh) * 2 + 1) * 32 + sh * 16 + ii] = (float)abi;
            const double mg8 = exp(8.0 * dt * ar), z1r = mg8 * cos(8.0 * dt * ai), z1i = mg8 * sin(8.0 * dt * ai); double pzr = 1.0, pzi = 0.0;
            for (int e = 0; e <= 16; ++e) { const float zr = (float)pzr, zi = (float)pzi; { const double nr2 = pzr * z1r - pzi * z1i, ni2 = pzr * z1i + pzi * z1r; pzr = nr2; pzi = ni2; }
                ZP[(((g * 17 + e) * 2 + hh) * 2 + 0) * 32 + sh * 16 + ii] = zr; ZP[(((g * 17 + e) * 2 + hh) * 2 + 1) * 32 + sh * 16 + ii] = zi;
                if (e == 16) { Z16N[(g * 2 + 0) * 64 + n] = zr; Z16N[(g * 2 + 1) * 64 + n] = zi; } }
            continue; } r -= I_S5;
        if (r < I_RG) { const int c = r * 64 + F.lane; const double lam = (double)A.in[I_RGLAM][c];
          sc[SC_RGL + c] = (float)(-8.0 * log1p(exp(-lam)) * 1.4426950408889634); continue; } r -= I_RG;
        if (r >= I_RGT + I_CB) { r -= I_RGT + I_CB;
            const int k = r & 3, sp = (r >> 2) & 1, tau = (r >> 3) & 1, hd = r >> 4, R = F.lane & 31, hk = F.lane >> 5;
            unsigned wv = 0u; if ((R >> 3) == 2 * sp + hk) wv = f2bf(A.in[I_CONVW][k * WA + hd * 64 + 32 * tau + R]);
            const int jj = R & 7; v4u o = (v4u){0u, 0u, 0u, 0u}; const unsigned word = (jj & 1) ? (wv << 16) : wv;
            if ((jj >> 1) == 0) o.x = word; else if ((jj >> 1) == 1) o.y = word; else if ((jj >> 1) == 2) o.z = word; else o.w = word;
            *(v4u*)(F.ws + WS_TAB + TB_DG + (size_t)(r * 64 + F.lane) * 16) = o; continue; }
        if (r >= I_RGT) { r -= I_RGT;
            const float* src = A.in[I_SCONV] + (size_t)r * 512 + F.lane * 8; const f32x4 a0 = *(const f32x4*)src, a1 = *(const f32x4*)(src + 4);
            v4u o; o.x = pk2(a0[0], a0[1]); o.y = pk2(a0[2], a0[3]); o.z = pk2(a1[0], a1[1]); o.w = pk2(a1[2], a1[3]);
            *(v4u*)(F.ws + WS_TAB + TB_CB + ((size_t)r * 512 + F.lane * 8) * 2) = o; continue; }
        {
            const int ks = r & 3, gate = (r >> 2) & 1, jh = (r >> 3) & 1, hd = r >> 4;
            const int R = F.lane & 31, hk = F.lane >> 5;
            const float* W = A.in[gate ? I_RGWI : I_RGWR] + (size_t)(hd * 64 + 32 * (ks >> 1) + 16 * (ks & 1) + 4 * hk) * 64 + 32 * jh + R;
            v4u o; o.x = pk2(W[0], W[64]); o.y = pk2(W[128], W[192]); o.z = pk2(W[8 * 64], W[9 * 64]); o.w = pk2(W[10 * 64], W[11 * 64]);
            *(v4u*)(F.ws + WS_TAB + TB_RG + (size_t)(r * 64 + F.lane) * 16) = o;
        }
    }
    __syncthreads();
    if (F.tid == 0) {
        unsigned sp = 0; while (__hip_atomic_load((unsigned*)(F.ctl + CW_SILU), RLX_AGENT) < (unsigned)F.G && ++sp < (1u << 22)) __builtin_amdgcn_s_sleep(2);
        __builtin_amdgcn_fence(__ATOMIC_ACQUIRE, "agent"); VM_WAIT(); }
    __syncthreads();
    LAS float* RED = (LAS float*)(F.lds + RING_OFF);
    float* mod = (float*)(F.ws + WS_MOD);
    const int r32 = F.lane & 31, hh = F.lane >> 5;
    const bf16* ST = (const bf16*)(F.ws + WS_TAB + TB_SILU);
#pragma unroll 1
    for (int it = F.vcu; it < ((pmask & 4) ? NMOD / 32 : 0); it += F.G) {
        const int n0 = it * 32;
        f32x16m acc[5];
#pragma unroll
        for (int rt = 0; rt < 5; ++rt)
#pragma unroll
            for (int i = 0; i < 16; ++i) acc[rt][i] = 0.f;
#pragma unroll 1
        for (int kb = 0; kb < 4; ++kb) {
            float bw[2][8]; v4u af[2][5];
#pragma unroll
            for (int ks = 0; ks < 2; ++ks) { const int k0 = F.wave * 128 + (kb * 2 + ks) * 16 + 8 * hh;
                const float* wp = A.in[I_ADAW] + (size_t)k0 * NMOD + n0 + r32;
#pragma unroll
                for (int j = 0; j < 8; ++j) bw[ks][j] = wp[(size_t)j * NMOD];
#pragma unroll
                for (int rt = 0; rt < 5; ++rt) af[ks][rt] = *(const v4u*)(ST + (size_t)(32 * rt + r32) * D + k0); }
#pragma unroll
            for (int ks = 0; ks < 2; ++ks) {
                v4u bp; bp.x = pkbf0(bw[ks][0], bw[ks][1]); bp.y = pkbf0(bw[ks][2], bw[ks][3]); bp.z = pkbf0(bw[ks][4], bw[ks][5]); bp.w = pkbf0(bw[ks][6], bw[ks][7]);
                const bf16x8m bfr = __builtin_bit_cast(bf16x8m, bp);
#pragma unroll
                for (int rt = 0; rt < 5; ++rt) acc[rt] = __builtin_amdgcn_mfma_f32_32x32x16_bf16(__builtin_bit_cast(bf16x8m, af[ks][rt]), bfr, acc[rt], 0, 0, 0); }
        }
#pragma unroll
        for (int half = 4; half >= 1; half >>= 1) {
            if (F.wave >= half && F.wave < 2 * half) {
#pragma unroll
                for (int rt = 0; rt < 5; ++rt)
#pragma unroll
                    for (int i = 0; i < 16; ++i) RED[(F.wave - half) * 5120 + (rt * 16 + i) * 64 + F.lane] = acc[rt][i]; }
            __syncthreads();
            if (F.wave < half) {
#pragma unroll
                for (int rt = 0; rt < 5; ++rt)
#pragma unroll
                    for (int i = 0; i < 16; ++i) acc[rt][i] += RED[F.wave * 5120 + (rt * 16 + i) * 64 + F.lane]; }
            __syncthreads();
        }
        if (F.wave == 0) { const float bb = A.in[I_ADAB][n0 + r32];
#pragma unroll
            for (int rt = 0; rt < 5; ++rt)
#pragma unroll
                for (int i = 0; i < 16; ++i) { const int row = 32 * rt + (i & 3) + 8 * (i >> 2) + 4 * hh; if (row < NROWMOD) __hip_atomic_store(mod + (size_t)row * NMOD + n0 + r32, acc[rt][i] + bb, RLX_AGENT); } }
        if (n0 < 2 * D) cnt_arrive_wt(F, CW_MOD);
    }
}

__device__ __forceinline__ int mod_row(int m) { return m < MP ? (m >> 11) : NBP + ((m - MP) >> 2); }
__device__ __forceinline__ const float* x_row(const Args& A, int m) { return m < MP ? A.in[I_XP] + (size_t)m * D : A.in[I_XS] + (size_t)(m - MP) * D; }

__device__ __forceinline__ void p1_modulate(Frame& F, const Args& A, int rep = 0) {
    refresh(F);
    cnt_wait_ge(F, CW_MOD, (unsigned)(2 * D / 32));
    const int gw = F.vcu * NWAVES + F.wave, NGW = F.G * NWAVES;
    const float* mod = (const float*)(F.ws + WS_MOD); bf16* XN = (bf16*)(F.ws + WS_XN);
    for (int m = gw; m < M; m += NGW) {
        const float* xr = x_row(A, m) + 8 * F.lane; const float* mr = mod + (size_t)mod_row(m) * NMOD + 8 * F.lane;
#pragma unroll
        for (int j = 0; j < 2; ++j) { const f32x4 v0 = *(const f32x4*)(xr + 512 * j), v1 = *(const f32x4*)(xr + 512 * j + 4);
            const f32x4 a0 = *(const f32x4*)(mr + 512 * j), a1 = *(const f32x4*)(mr + 512 * j + 4), s0 = *(const f32x4*)(mr + D + 512 * j), s1 = *(const f32x4*)(mr + D + 512 * j + 4);
            const f32x4 h0 = v0 * (s0 + 1.f) + a0, h1 = v1 * (s1 + 1.f) + a1;
            v4u o; o.x = pk2(h0.x, h0.y); o.y = pk2(h0.z, h0.w); o.z = pk2(h1.x, h1.y); o.w = pk2(h1.z, h1.w);
            *(v4u*)(XN + (size_t)m * D + 512 * j + 8 * F.lane) = o; }
    }
}

__device__ __forceinline__ void unpack8(const v4u w, f32x4& a, f32x4& b) { a = (f32x4){pg8::bf_lo(w.x), pg8::bf_hi(w.x), pg8::bf_lo(w.y), pg8::bf_hi(w.y)}; b = (f32x4){pg8::bf_lo(w.z), pg8::bf_hi(w.z), pg8::bf_lo(w.w), pg8::bf_hi(w.w)}; }
__device__ __forceinline__ v4u pack8f(const f32x4 a, const f32x4 b) { v4u o; o.x = pk2(a.x, a.y); o.y = pk2(a.z, a.w); o.z = pk2(b.x, b.y); o.w = pk2(b.z, b.w); return o; }
template <bool SECOND>
__device__ __forceinline__ void ln_rows(Frame& F, const Args& A, int row_lo, int row_hi, int gw, int NGW) {
    refresh(F);
    const float* mod = (const float*)(F.ws + WS_MOD); bf16* XN = (bf16*)(F.ws + WS_XN);
    const float* gg = A.in[SECOND ? I_LN2G : I_LN1G] + 8 * F.lane; const float* gb = A.in[SECOND ? I_LN2B : I_LN1B] + 8 * F.lane;
    for (int m = row_lo + gw; m < row_hi; m += NGW) {
        float* xr = F.out + (size_t)m * D + 8 * F.lane;
        f32x4 v[2][2]; float s = 0.f;
        if (m >= MP) {
            const float* mr = mod + (size_t)mod_row(m) * NMOD + (SECOND ? 5 : 2) * D + 8 * F.lane;
            const float* bs = SECOND ? xr : A.in[I_XS] + (size_t)(m - MP) * D + 8 * F.lane;
            const float* sl = (const float*)(F.ws + WS_SLAB) + (size_t)(m - MP) * D + 8 * F.lane;
#pragma unroll
            for (int j = 0; j < 2; ++j)
#pragma unroll
                for (int h = 0; h < 2; ++h) { const int o = 512 * j + 4 * h; f32x4 a = SECOND ? *(const f32x4*)(A.in[I_B2] + 8 * F.lane + o) : (f32x4){0.f, 0.f, 0.f, 0.f};
#pragma unroll
                    for (int ks = 0; ks < (SECOND ? NS_DOWN : NS_OUT); ++ks) a += *(const f32x4*)(sl + (size_t)ks * (512 * 1024) + o);
                    v[j][h] = *(const f32x4*)(bs + o) * ALPHA + *(const f32x4*)(mr + o) * a; }
        } else {
            const bf16* tr = (const bf16*)(F.ws + (SECOND ? WS_T2 : WS_T1)) + (size_t)m * D + 8 * F.lane;
#pragma unroll
            for (int j = 0; j < 2; ++j) unpack8(*(const v4u*)(tr + 512 * j), v[j][0], v[j][1]);
        }
#pragma unroll
        for (int j = 0; j < 2; ++j)
#pragma unroll
            for (int h = 0; h < 2; ++h) s += (v[j][h].x + v[j][h].y) + (v[j][h].z + v[j][h].w);
        const float mean = wave_sum(s) * (1.f / D); float s2 = 0.f;
#pragma unroll
        for (int j = 0; j < 2; ++j)
#pragma unroll
            for (int h = 0; h < 2; ++h) { v[j][h] = v[j][h] - mean; s2 += (v[j][h].x * v[j][h].x + v[j][h].y * v[j][h].y) + (v[j][h].z * v[j][h].z + v[j][h].w * v[j][h].w); }
        const float rstd = 1.f / sqrtf(wave_sum(s2) * (1.f / D) + LN_EPS);
#pragma unroll
        for (int j = 0; j < 2; ++j)
#pragma unroll
            for (int h = 0; h < 2; ++h) v[j][h] = v[j][h] * rstd * *(const f32x4*)(gg + 512 * j + 4 * h) + *(const f32x4*)(gb + 512 * j + 4 * h);
        if (SECOND || m >= MP) {
#pragma unroll
            for (int j = 0; j < 2; ++j) { *(f32x4*)(xr + 512 * j) = v[j][0]; *(f32x4*)(xr + 512 * j + 4) = v[j][1]; }
        } else {
            bf16* x1 = (bf16*)(F.ws + WS_X1B) + (size_t)m * D + 8 * F.lane;
#pragma unroll
            for (int j = 0; j < 2; ++j) *(v4u*)(x1 + 512 * j) = pack8f(v[j][0], v[j][1]);
        }
        if (!SECOND) {
            const float* mr = mod + (size_t)mod_row(m) * NMOD + 8 * F.lane;
#pragma unroll
            for (int j = 0; j < 2; ++j) { const int o = 512 * j;
                const f32x4 h0 = v[j][0] * (*(const f32x4*)(mr + 4 * D + o) + 1.f) + *(const f32x4*)(mr + 3 * D + o), h1 = v[j][1] * (*(const f32x4*)(mr + 4 * D + o + 4) + 1.f) + *(const f32x4*)(mr + 3 * D + o + 4);
                *(v4u*)(XN + (size_t)m * D + o + 8 * F.lane) = pack8f(h0, h1); }
        }
    }
}

__device__ __forceinline__ void rg_item_ref(Frame& F, const Args& A, bool prompt, int b, int hd, LAS float* scr) {
    const int j = F.lane, c = hd * HDA + j;
    const bf16* Z = (const bf16*)(F.ws + WS_Z); bf16* Y = (bf16*)(F.ws + WS_YCAT); const float* sc = (const float*)(F.ws + WS_S5C);
    float wr[64], wi[64];
#pragma unroll
    for (int i = 0; i < 64; ++i) { wr[i] = A.in[I_RGWR][(size_t)(hd * 64 + i) * 64 + j]; wi[i] = A.in[I_RGWI][(size_t)(hd * 64 + i) * 64 + j]; }
    const float br = A.in[I_RGBR][c], bi = A.in[I_RGBI][c], L2 = sc[SC_RGL + c];
    const float w0 = A.in[I_CONVW][c], w1 = A.in[I_CONVW][WA + c], w2 = A.in[I_CONVW][2 * WA + c], w3 = A.in[I_CONVW][3 * WA + c], cb = A.in[I_CONVB][c];
    int T, m0; float x3, x2, x1, h;
    if (prompt) { T = TP; m0 = b * TP; x3 = 0.f; x2 = 0.f; x1 = 0.f; h = 0.f; }
    else { T = TS; m0 = MP + b * TS; x3 = A.in[I_SCONV][(size_t)(b * 3 + 0) * WA + c]; x2 = A.in[I_SCONV][(size_t)(b * 3 + 1) * WA + c]; x1 = A.in[I_SCONV][(size_t)(b * 3 + 2) * WA + c]; h = A.in[I_SH][(size_t)b * WA + c]; }
    for (int t = 0; t < T; ++t) {
        const size_t m = (size_t)(m0 + t);
        const float xa = bf2f(Z[m * NZ + WA + c]), gate = bf2f(Z[m * NZ + c]);
        const float xc = cb + w0 * x3 + w1 * x2 + w2 * x1 + w3 * xa; x3 = x2; x2 = x1; x1 = xa;
        scr[j] = xc; LDS_WAIT(); asm volatile("" ::: "memory");
        float rp = br, gp = bi;
#pragma unroll
        for (int i4 = 0; i4 < 16; ++i4) { const f32x4 v = *(const LAS f32x4*)(scr + 4 * i4);
            rp += v[0] * wr[4 * i4] + v[1] * wr[4 * i4 + 1] + v[2] * wr[4 * i4 + 2] + v[3] * wr[4 * i4 + 3];
            gp += v[0] * wi[4 * i4] + v[1] * wi[4 * i4 + 1] + v[2] * wi[4 * i4 + 2] + v[3] * wi[4 * i4 + 3]; }
        LDS_WAIT(); asm volatile("" ::: "memory");
        const float r = sigmoidf_(rp), gi = sigmoidf_(gp);
        const float a = exp2f(r * L2);
        float mult = sqrtf(fmaxf(1.f - a * a, 0.f));
        if (prompt && t == 0) mult = 1.f;
        h = a * h + mult * gi * xc;
        Y[m * D + c] = (bf16)f2bf(gelu_tanh(gate) * h);
    }
    float* oc = F.out + (prompt ? O_CONVP : O_CONVS); float* oh = F.out + (prompt ? O_HP : O_HS);
    oc[(size_t)(b * 3 + 0) * WA + c] = x3; oc[(size_t)(b * 3 + 1) * WA + c] = x2; oc[(size_t)(b * 3 + 2) * WA + c] = x1;
    oh[(size_t)b * WA + c] = h;
}
__device__ __forceinline__ void s5_item_ref(Frame& F, const Args& A, bool prompt, int b, int g, LAS float* scr) {
    const int n = F.lane, gn = g * NS5 + n, k = F.lane & 15, part = F.lane >> 4;
    const bf16* Z = (const bf16*)(F.ws + WS_Z); bf16* Gy = (bf16*)(F.ws + WS_G); const float* sc = (const float*)(F.ws + WS_S5C);
    float bbr[16], bbi[16], cre[16], cim[16];
#pragma unroll
    for (int i = 0; i < 16; ++i) { bbr[i] = sc[SC_BBR + gn * KS5 + i]; bbi[i] = sc[SC_BBI + gn * KS5 + i];
        cre[i] = A.in[I_S5CRE][(size_t)(g * KS5 + k) * NS5 + part * 16 + i]; cim[i] = A.in[I_S5CIM][(size_t)(g * KS5 + k) * NS5 + part * 16 + i]; }
    const float abr = sc[SC_ABR + gn], abi = sc[SC_ABI + gn], dk = A.in[I_S5D][g * KS5 + k];
    int T, m0; float hr, hi;
    if (prompt) { T = TP; m0 = b * TP; hr = 0.f; hi = 0.f; }
    else { T = TS; m0 = MP + b * TS; hr = A.in[I_SSR][(size_t)(b * GB + g) * NS5 + n]; hi = A.in[I_SSI][(size_t)(b * GB + g) * NS5 + n]; }
    for (int t = 0; t < T; ++t) {
        const size_t m = (size_t)(m0 + t);
        const bf16* zr = Z + m * NZ + 2 * WA + g * KS5;
        const v4u u0 = *(const v4u*)zr, u1 = *(const v4u*)(zr + 8);
        float u[16];
        u[0] = pg8::bf_lo(u0.x); u[1] = pg8::bf_hi(u0.x); u[2] = pg8::bf_lo(u0.y); u[3] = pg8::bf_hi(u0.y); u[4] = pg8::bf_lo(u0.z); u[5] = pg8::bf_hi(u0.z); u[6] = pg8::bf_lo(u0.w); u[7] = pg8::bf_hi(u0.w);
        u[8] = pg8::bf_lo(u1.x); u[9] = pg8::bf_hi(u1.x); u[10] = pg8::bf_lo(u1.y); u[11] = pg8::bf_hi(u1.y); u[12] = pg8::bf_lo(u1.z); u[13] = pg8::bf_hi(u1.z); u[14] = pg8::bf_lo(u1.w); u[15] = pg8::bf_hi(u1.w);
        float bur = 0.f, bui = 0.f;
#pragma unroll
        for (int i = 0; i < 16; ++i) { bur += bbr[i] * u[i]; bui += bbi[i] * u[i]; }
        const float nhr = abr * hr - abi * hi + bur, nhi = abr * hi + abi * hr + bui; hr = nhr; hi = nhi;
        scr[n] = hr; scr[64 + n] = hi; LDS_WAIT(); asm volatile("" ::: "memory");
        float p = 0.f;
#pragma unroll
        for (int i4 = 0; i4 < 4; ++i4) { const f32x4 vr = *(const LAS f32x4*)(scr + part * 16 + 4 * i4), vi = *(const LAS f32x4*)(scr + 64 + part * 16 + 4 * i4);
#pragma unroll
            for (int e = 0; e < 4; ++e) p += vr[e] * cre[4 * i4 + e] - vi[e] * cim[4 * i4 + e]; }
        LDS_WAIT(); asm volatile("" ::: "memory");
        p += __shfl_xor(p, 16); p += __shfl_xor(p, 32);
        const float uk = bf2f(zr[k]);
        if (F.lane < 16) Gy[m * WB + g * KS5 + k] = (bf16)f2bf(gelu_tanh(p + dk * uk));
    }
    float* osr = F.out + (prompt ? O_SRP : O_SRS); float* osi = F.out + (prompt ? O_SIP : O_SIS);
    osr[(size_t)(b * GB + g) * NS5 + n] = hr; osi[(size_t)(b * GB + g) * NS5 + n] = hi;
}

typedef short bf16x8v __attribute__((ext_vector_type(8)));
typedef float f32x16 __attribute__((ext_vector_type(16)));
typedef float f32x2v __attribute__((ext_vector_type(2)));
typedef __bf16 bf16x2v __attribute__((ext_vector_type(2)));
#define MFMA32(a, b, c) __builtin_amdgcn_mfma_f32_32x32x16_bf16((a), (b), (c), 0, 0, 0)
__device__ __forceinline__ unsigned pkbf(float a, float b) { const f32x2v v = {a, b}; const bf16x2v r = __builtin_convertvector(v, bf16x2v); return __builtin_bit_cast(unsigned, r); }
template <int CTRL> __device__ __forceinline__ float dppf(float old, float v) { return __builtin_bit_cast(float, __builtin_amdgcn_update_dpp(__builtin_bit_cast(int, old), __builtin_bit_cast(int, v), CTRL, 0xF, 0xF, false)); }
__device__ __forceinline__ f32x16 ld16(const float* p) { f32x16 r;
#pragma unroll
    for (int i = 0; i < 4; ++i) { const f32x4 v = *(const f32x4*)(p + 4 * i); r[4 * i] = v[0]; r[4 * i + 1] = v[1]; r[4 * i + 2] = v[2]; r[4 * i + 3] = v[3]; }
    return r; }
__device__ __forceinline__ f32x16 ld16l(const LAS float* p) { f32x16 r;
#pragma unroll
    for (int i = 0; i < 4; ++i) { const f32x4 v = *(const LAS f32x4*)(p + 4 * i); r[4 * i] = v[0]; r[4 * i + 1] = v[1]; r[4 * i + 2] = v[2]; r[4 * i + 3] = v[3]; }
    return r; }
__device__ __forceinline__ bf16x8v pack8(const f32x16& x, int s) { v4u p; p.x = pkbf(x[8 * s], x[8 * s + 1]); p.y = pkbf(x[8 * s + 2], x[8 * s + 3]); p.z = pkbf(x[8 * s + 4], x[8 * s + 5]); p.w = pkbf(x[8 * s + 6], x[8 * s + 7]); return __builtin_bit_cast(bf16x8v, p); }
template <int CTRL> __device__ __forceinline__ void s5_scan_step(f32x16& xr, f32x16& xi, const f32x16& zr, const f32x16& zi) {
#pragma unroll
    for (int i = 0; i < 16; ++i) { const float sr = dppf<CTRL>(0.f, xr[i]), si = dppf<CTRL>(0.f, xi[i]);
        xr[i] += zr[i] * sr - zi[i] * si; xi[i] += zr[i] * si + zi[i] * sr; }
}
constexpr int S5L_BF1 = 0, S5L_BF2 = 4096, S5L_TOT = 12288, S5L_CAR = 20480, S5L_ZP = 28672  , S5L_TA = 37376  , S5L_U = 38912  ;
template <bool SECOND>
__device__ __forceinline__ void s5_step(LAS unsigned char* L, int lane, const bf16x8v u, f32x16& hr0, f32x16& hr1, f32x16& hi0, f32x16& hi1,
                                        const f32x16& ar0, const f32x16& ar1, const f32x16& ai0, const f32x16& ai1, const float (&dk)[8], bf16* gout) {
    const LAS bf16x8v* a1 = (const LAS bf16x8v*)(L + S5L_BF1) + lane;
    { const f32x16 cr = ar0 * hr0 - ai0 * hi0, ci = ar0 * hi0 + ai0 * hr0; hr0 = MFMA32(a1[0], u, cr); hi0 = MFMA32(a1[128], u, ci); }
    asm volatile("" : "+v"(hr0), "+v"(hi0));
    { const f32x16 cr = ar1 * hr1 - ai1 * hi1, ci = ar1 * hi1 + ai1 * hr1; hr1 = MFMA32(a1[64], u, cr); hi1 = MFMA32(a1[192], u, ci); }
    if (SECOND) {
        const LAS bf16x8v* a2 = (const LAS bf16x8v*)(L + S5L_BF2) + lane;
        f32x16 y;
#pragma unroll
        for (int i = 0; i < 16; ++i) y[i] = 0.f;
        y = MFMA32(a2[0 * 64], pack8(hr0, 0), y); y = MFMA32(a2[1 * 64], pack8(hr0, 1), y);
        y = MFMA32(a2[2 * 64], pack8(hr1, 0), y); y = MFMA32(a2[3 * 64], pack8(hr1, 1), y);
        y = MFMA32(a2[4 * 64], pack8(hi0, 0), y); y = MFMA32(a2[5 * 64], pack8(hi0, 1), y);
        y = MFMA32(a2[6 * 64], pack8(hi1, 0), y); y = MFMA32(a2[7 * 64], pack8(hi1, 1), y);
        const v4u uw = __builtin_bit_cast(v4u, u);
        float o[8];
        o[0] = gelu_tanh(y[0] + dk[0] * pg8::bf_lo(uw.x)); o[1] = gelu_tanh(y[1] + dk[1] * pg8::bf_hi(uw.x));
        o[2] = gelu_tanh(y[2] + dk[2] * pg8::bf_lo(uw.y)); o[3] = gelu_tanh(y[3] + dk[3] * pg8::bf_hi(uw.y));
        o[4] = gelu_tanh(y[4] + dk[4] * pg8::bf_lo(uw.z)); o[5] = gelu_tanh(y[5] + dk[5] * pg8::bf_hi(uw.z));
        o[6] = gelu_tanh(y[6] + dk[6] * pg8::bf_lo(uw.w)); o[7] = gelu_tanh(y[7] + dk[7] * pg8::bf_hi(uw.w));
        v4u w; w.x = pkbf(o[0], o[1]); w.y = pkbf(o[2], o[3]); w.z = pkbf(o[4], o[5]); w.w = pkbf(o[6], o[7]);
        pg8::st16_wt(gout, w);
    }
}
__device__ __forceinline__ void s5_item_fast(Frame& F, const Args& A, int b, int g) {
    refresh(F);
    const int lane = F.lane, q = lane & 31, hh = lane >> 5, w = F.wave, c = w * 32 + q;
    LAS unsigned char* L = F.lds + RING_OFF;
    const unsigned char* tab = F.ws + WS_TAB;
    const size_t m0 = (size_t)b * TP + (size_t)8 * c;
    const bf16* zrow = (const bf16*)(F.ws + WS_Z) + m0 * NZ + 2 * WA + g * KS5 + 8 * hh;
    bf16* grow = (bf16*)(F.ws + WS_G) + m0 * WB + g * KS5 + 8 * hh;
    LAS v4u* UL = (LAS v4u*)(L + S5L_U) + F.tid;
    {
        v4u uu[8];
#pragma unroll
        for (int j = 0; j < 8; ++j) uu[j] = *(const v4u*)(zrow + (size_t)j * NZ);
        const v4u* s1 = (const v4u*)(tab + TB_BF1) + (size_t)g * 256; const v4u* s2 = (const v4u*)(tab + TB_BF2) + (size_t)g * 512;
        if (F.tid < 256) ((LAS v4u*)(L + S5L_BF1))[F.tid] = s1[F.tid];
        ((LAS v4u*)(L + S5L_BF2))[F.tid] = s2[F.tid];
        const v4u* s3 = (const v4u*)(tab + TB_ZP) + (size_t)g * (17 * 128 / 4); for (int e = F.tid; e < 17 * 128 / 4; e += NWAVES * 64) ((LAS v4u*)(L + S5L_ZP))[e] = s3[e];
        if (F.tid < 32) ((LAS v4u*)(L + S5L_TA))[F.tid] = ((const v4u*)(tab + TB_TA) + (size_t)g * 32)[F.tid];
#pragma unroll
        for (int j = 0; j < 8; ++j) UL[512 * j] = uu[j];
    }
    __syncthreads();
    const LAS float* TA = (const LAS float*)(L + S5L_TA) + hh * 64;
    f32x16 ar0 = ld16l(TA), ar1 = ld16l(TA + 16), ai0 = ld16l(TA + 32), ai1 = ld16l(TA + 48);
    f32x16 hr0, hr1, hi0, hi1;
#pragma unroll
    for (int i = 0; i < 16; ++i) { hr0[i] = 0.f; hr1[i] = 0.f; hi0[i] = 0.f; hi1[i] = 0.f; }
    float dk[8];
#pragma unroll
    for (int i = 0; i < 8; ++i) dk[i] = A.in[I_S5D][g * KS5 + 8 * hh + i];
#pragma unroll 1
    for (int j = 0; j < 8; ++j) { const bf16x8v u = __builtin_bit_cast(bf16x8v, UL[512 * j]);
        s5_step<false>(L, lane, u, hr0, hr1, hi0, hi1, ar0, ar1, ai0, ai1, dk, nullptr); }
    const LAS float* ZP = (const LAS float*)(L + S5L_ZP);
#define S5_SCAN(E, CTRL) do { const LAS float* z = ZP + (((E) * 2 + hh) * 2) * 32; \
        { const f32x16 zr = ld16l(z), zi = ld16l(z + 32); s5_scan_step<CTRL>(hr0, hi0, zr, zi); } \
        asm volatile("" : "+v"(hr0), "+v"(hi0) :: "memory"); \
        { const f32x16 zr = ld16l(z + 16), zi = ld16l(z + 48); s5_scan_step<CTRL>(hr1, hi1, zr, zi); } \
        asm volatile("" : "+v"(hr1), "+v"(hi1) :: "memory"); } while (0)
    S5_SCAN(1, 0x111); S5_SCAN(2, 0x112); S5_SCAN(4, 0x114); S5_SCAN(8, 0x118);
#undef S5_SCAN
    const int seg = w * 2 + (q >> 4);
    LAS float* TOT = (LAS float*)(L + S5L_TOT); LAS float* CAR = (LAS float*)(L + S5L_CAR);
    if ((lane & 15) == 15) {
#pragma unroll
        for (int rho = 0; rho < 4; ++rho) {
            *(LAS f32x4*)(TOT + (seg * 2 + 0) * 64 + 0 + 8 * rho + 4 * hh) = (f32x4){hr0[4 * rho], hr0[4 * rho + 1], hr0[4 * rho + 2], hr0[4 * rho + 3]};
            *(LAS f32x4*)(TOT + (seg * 2 + 0) * 64 + 32 + 8 * rho + 4 * hh) = (f32x4){hr1[4 * rho], hr1[4 * rho + 1], hr1[4 * rho + 2], hr1[4 * rho + 3]};
            *(LAS f32x4*)(TOT + (seg * 2 + 1) * 64 + 0 + 8 * rho + 4 * hh) = (f32x4){hi0[4 * rho], hi0[4 * rho + 1], hi0[4 * rho + 2], hi0[4 * rho + 3]};
            *(LAS f32x4*)(TOT + (seg * 2 + 1) * 64 + 32 + 8 * rho + 4 * hh) = (f32x4){hi1[4 * rho], hi1[4 * rho + 1], hi1[4 * rho + 2], hi1[4 * rho + 3]}; }
    }
    __syncthreads();
    if (F.tid < 64) {
        const float* z16 = (const float*)(tab + TB_Z16N) + (size_t)g * 128; const float zr = z16[F.tid], zi = z16[64 + F.tid];
        float cr = 0.f, ci = 0.f;
#pragma unroll
        for (int sg = 0; sg < 16; ++sg) { CAR[(sg * 2 + 0) * 64 + F.tid] = cr; CAR[(sg * 2 + 1) * 64 + F.tid] = ci;
            const float tr = TOT[(sg * 2 + 0) * 64 + F.tid], ti = TOT[(sg * 2 + 1) * 64 + F.tid];
            const float ncr = zr * cr - zi * ci + tr, nci = zr * ci + zi * cr + ti; cr = ncr; ci = nci; }
    }
    __syncthreads();
    {
        const LAS float* z = ZP + (((q & 15) * 2 + hh) * 2) * 32;
#define S5_EXCL(HR, HI, OFF) do { const f32x16 zr = ld16l(z + (OFF)), zi = ld16l(z + 32 + (OFF)); f32x16 kr, ki; \
        _Pragma("unroll") for (int rho = 0; rho < 4; ++rho) { \
            const f32x4 a0 = *(const LAS f32x4*)(CAR + (seg * 2 + 0) * 64 + 2 * (OFF) + 8 * rho + 4 * hh), b0 = *(const LAS f32x4*)(CAR + (seg * 2 + 1) * 64 + 2 * (OFF) + 8 * rho + 4 * hh); \
            _Pragma("unroll") for (int e = 0; e < 4; ++e) { kr[4 * rho + e] = a0[e]; ki[4 * rho + e] = b0[e]; } } \
        _Pragma("unroll") for (int i = 0; i < 16; ++i) { const float sr = dppf<0x111>(0.f, HR[i]), si = dppf<0x111>(0.f, HI[i]); \
            HR[i] = sr + zr[i] * kr[i] - zi[i] * ki[i]; HI[i] = si + zr[i] * ki[i] + zi[i] * kr[i]; } } while (0)
        S5_EXCL(hr0, hi0, 0); asm volatile("" : "+v"(hr0), "+v"(hi0) :: "memory"); S5_EXCL(hr1, hi1, 16); asm volatile("" : "+v"(hr1), "+v"(hi1) :: "memory");
#undef S5_EXCL
    }
    { int off = 0; asm volatile("" : "+v"(off)); const LAS float* TA2 = TA + off; ar0 = ld16l(TA2); ar1 = ld16l(TA2 + 16); ai0 = ld16l(TA2 + 32); ai1 = ld16l(TA2 + 48); }
#pragma unroll 1
    for (int j = 0; j < 8; ++j) { const bf16x8v u = __builtin_bit_cast(bf16x8v, UL[512 * j]);
        s5_step<true>(L, lane, u, hr0, hr1, hi0, hi1, ar0, ar1, ai0, ai1, dk, grow + (size_t)j * WB); }
    if (w == NWAVES - 1 && q == 31) {
        float* osr = F.out + O_SRP + (size_t)(b * GB + g) * NS5; float* osi = F.out + O_SIP + (size_t)(b * GB + g) * NS5;
#pragma unroll
        for (int i = 0; i < 16; ++i) { const int n = (i & 3) + 8 * (i >> 2) + 4 * hh; osr[n] = hr0[i]; osr[32 + n] = hr1[i]; osi[n] = hi0[i]; osi[32 + n] = hi1[i]; }
    }
    __syncthreads();
}

__device__ __forceinline__ void s5_item_sample(Frame& F, const Args& A, int g) {
    refresh(F);
    const int lane = F.lane, q = lane & 31, hh = lane >> 5, w = F.wave;
    LAS unsigned char* L = F.lds + RING_OFF;
    const unsigned char* tab = F.ws + WS_TAB;
    { const v4u* s1 = (const v4u*)(tab + TB_BF1) + (size_t)g * 256; const v4u* s2 = (const v4u*)(tab + TB_BF2) + (size_t)g * 512;
      if (F.tid < 256) ((LAS v4u*)(L + S5L_BF1))[F.tid] = s1[F.tid];
      ((LAS v4u*)(L + S5L_BF2))[F.tid] = s2[F.tid]; }
    __syncthreads();
    if (w < 4) {
        const int b = w * 32 + q;
        const float* TA = (const float*)(tab + TB_TA) + (size_t)((g * 2 + hh) * 2) * 32;
        const f32x16 ar0 = ld16(TA), ar1 = ld16(TA + 16), ai0 = ld16(TA + 32), ai1 = ld16(TA + 48);
        f32x16 hr0, hr1, hi0, hi1;
        const float* sr = A.in[I_SSR] + (size_t)(b * GB + g) * NS5; const float* si = A.in[I_SSI] + (size_t)(b * GB + g) * NS5;
#pragma unroll
        for (int rho = 0; rho < 4; ++rho) { const f32x4 a0 = *(const f32x4*)(sr + 8 * rho + 4 * hh), a1 = *(const f32x4*)(sr + 32 + 8 * rho + 4 * hh), b0 = *(const f32x4*)(si + 8 * rho + 4 * hh), b1 = *(const f32x4*)(si + 32 + 8 * rho + 4 * hh);
#pragma unroll
            for (int e = 0; e < 4; ++e) { hr0[4 * rho + e] = a0[e]; hr1[4 * rho + e] = a1[e]; hi0[4 * rho + e] = b0[e]; hi1[4 * rho + e] = b1[e]; } }
        float dk[8];
#pragma unroll
        for (int i = 0; i < 8; ++i) dk[i] = A.in[I_S5D][g * KS5 + 8 * hh + i];
        const size_t m0 = (size_t)MP + (size_t)b * TS;
        const bf16* zrow = (const bf16*)(F.ws + WS_Z) + m0 * NZ + 2 * WA + g * KS5 + 8 * hh;
        bf16* grow = (bf16*)(F.ws + WS_G) + m0 * WB + g * KS5 + 8 * hh;
        bf16x8v uu[TS];
#pragma unroll
        for (int j = 0; j < TS; ++j) uu[j] = *(const bf16x8v*)(zrow + (size_t)j * NZ);
#pragma unroll
        for (int j = 0; j < TS; ++j) s5_step<true>(L, lane, uu[j], hr0, hr1, hi0, hi1, ar0, ar1, ai0, ai1, dk, grow + (size_t)j * WB);
        float* osr = F.out + O_SRS + (size_t)(b * GB + g) * NS5; float* osi = F.out + O_SIS + (size_t)(b * GB + g) * NS5;
#pragma unroll
        for (int rho = 0; rho < 4; ++rho) {
            *(f32x4*)(osr + 8 * rho + 4 * hh) = (f32x4){hr0[4 * rho], hr0[4 * rho + 1], hr0[4 * rho + 2], hr0[4 * rho + 3]};
            *(f32x4*)(osr + 32 + 8 * rho + 4 * hh) = (f32x4){hr1[4 * rho], hr1[4 * rho + 1], hr1[4 * rho + 2], hr1[4 * rho + 3]};
            *(f32x4*)(osi + 8 * rho + 4 * hh) = (f32x4){hi0[4 * rho], hi0[4 * rho + 1], hi0[4 * rho + 2], hi0[4 * rho + 3]};
            *(f32x4*)(osi + 32 + 8 * rho + 4 * hh) = (f32x4){hi1[4 * rho], hi1[4 * rho + 1], hi1[4 * rho + 2], hi1[4 * rho + 3]}; }
    }
    __syncthreads();
}

template <int CTRL, int RMASK> __device__ __forceinline__ float dppm(float old, float v) { return __builtin_bit_cast(float, __builtin_amdgcn_update_dpp(__builtin_bit_cast(int, old), __builtin_bit_cast(int, v), CTRL, RMASK, 0xF, false)); }
template <int CTRL, int RMASK> __device__ __forceinline__ void rg_scan_step(f32x16& a, f32x16& b) {
#pragma unroll
    for (int i = 0; i < 16; ++i) { const float as = dppm<CTRL, RMASK>(1.f, a[i]), bs = dppm<CTRL, RMASK>(0.f, b[i]); b[i] = a[i] * bs + b[i]; a[i] = a[i] * as; }
}
constexpr int RGL_AFR = 0, RGL_DG = 8192, RGL_TOT = 24576, RGL_CST = 28672;
constexpr int RGL_XAP = 144;
constexpr int RGL_XA0 = 29696, RGL_BUF = 37376;
static_assert(259 * RGL_XAP <= RGL_BUF && RGL_XA0 + 2 * RGL_BUF <= RING_BYTES && RGL_CST + 640 <= RGL_XA0, "RG-LRU LDS map");
template <bool SAMPLE>
__device__ __forceinline__ void rg_item_fast(Frame& F, const Args& A, int b, int hd, int jh) {
    refresh(F);
    const int lane = F.lane, q = lane & 31, hh = lane >> 5, w = F.wave;
    LAS unsigned char* L = F.lds + RING_OFF;
    const float* sc = (const float*)(F.ws + WS_S5C);
    const bf16* Zb = (const bf16*)(F.ws + WS_Z) + (size_t)(SAMPLE ? MP : b * TP) * NZ; bf16* Yb = (bf16*)(F.ws + WS_YCAT) + (size_t)(SAMPLE ? MP : b * TP) * D;
    const bf16* CB = (const bf16*)(F.ws + WS_TAB + TB_CB);
    auto stage_load = [&](int T0, v4u (&st)[5]) {
#pragma unroll
        for (int k = 0; k < 5; ++k) { const int ci = F.tid + 512 * k; v4u v = (v4u){0u, 0u, 0u, 0u};
            if (ci < 2072) { const int tk = T0 - 3 + (ci >> 3); if (tk >= 0) v = *(const v4u*)(Zb + (size_t)tk * NZ + WA + hd * 64 + (ci & 7) * 8); }
            st[k] = v; } };
    auto stage_write = [&](int par, const v4u (&st)[5]) {
#pragma unroll
        for (int k = 0; k < 5; ++k) { const int ci = F.tid + 512 * k;
            if (ci < 2072) *(LAS v4u*)(L + RGL_XA0 + par * RGL_BUF + (ci >> 3) * RGL_XAP + (ci & 7) * 16) = st[k]; } };
    {
        const v4u* src = (const v4u*)(F.ws + WS_TAB + TB_RG) + (size_t)((hd * 2 + jh) * 8) * 64;
        ((LAS v4u*)(L + RGL_AFR))[F.tid] = src[F.tid];
        const v4u* sd = (const v4u*)(F.ws + WS_TAB + TB_DG) + (size_t)(hd * 16) * 64;
        ((LAS v4u*)(L + RGL_DG))[F.tid] = sd[F.tid]; ((LAS v4u*)(L + RGL_DG))[512 + F.tid] = sd[512 + F.tid];
        if (F.tid < 160) { const int h2 = F.tid / 80, kind = (F.tid % 80) / 16, i = F.tid % 16, cr = (i & 3) + 8 * (i >> 2) + 4 * h2;
            const int c = hd * 64 + 32 * jh + cr;
            ((LAS float*)(L + RGL_CST))[F.tid] = kind == 0 ? A.in[I_RGBR][c] : kind == 1 ? A.in[I_RGBI][c] : kind == 2 ? sc[SC_RGL + c] : A.in[I_CONVB][hd * 64 + 32 * (kind - 3) + cr]; }
        if (!SAMPLE && jh == 0 && F.tid < 192) { const int k = F.tid >> 6, ch = F.tid & 63;
            F.out[O_CONVP + (size_t)(b * 3 + k) * WA + hd * 64 + ch] = bf2f(((const bf16*)(F.ws + WS_Z))[(size_t)(b * TP + TP - 3 + k) * NZ + WA + hd * 64 + ch]); }
        if (SAMPLE && jh == 0) { for (int e = F.tid; e < NBS * 3 * 64; e += NWAVES * 64) { const int bb = e / 192, k = (e / 64) % 3, ch = e & 63;
            F.out[O_CONVS + (size_t)(bb * 3 + k) * WA + hd * 64 + ch] = bf2f(((const bf16*)(F.ws + WS_Z))[(size_t)(MP + bb * TS + 1 + k) * NZ + WA + hd * 64 + ch]); } }
        if (!SAMPLE) { v4u st[5]; stage_load(0, st); stage_write(0, st); }
    }
    __syncthreads();
    float hround[16];
#pragma unroll
    for (int i = 0; i < 16; ++i) hround[i] = 0.f;
    const LAS float* CST = (const LAS float*)(L + RGL_CST) + hh * 80;
    const LAS bf16x8v* af = (const LAS bf16x8v*)(L + RGL_AFR) + lane;
    const LAS bf16x8v* dg = (const LAS bf16x8v*)(L + RGL_DG) + lane;
#pragma unroll 1
    for (int rd = 0; rd < (SAMPLE ? 2 : 8); ++rd) {
        const int t = rd * 256 + w * 32 + q;
        v4u stn[5];
        if (!SAMPLE) stage_load((rd + 1) * 256, stn);
        const LAS unsigned char* XAp = L + RGL_XA0 + (rd & 1) * RGL_BUF + (w * 32 + q) * RGL_XAP + 16 * hh;
        const bf16* zsr[4];
        if (SAMPLE) {
#pragma unroll
            for (int k = 0; k < 4; ++k) { const int jx = (t & 3) + k; zsr[k] = (jx < 3 ? CB + (size_t)((t >> 2) * 3 + jx) * WA : Zb + (size_t)(t - 3 + k) * NZ + WA) + hd * 64 + 8 * hh; } }
        const bf16* gr = Zb + (size_t)t * NZ + hd * 64 + 32 * jh + 4 * hh;
        unsigned long long gq[4];
#pragma unroll
        for (int rho = 0; rho < 4; ++rho) gq[rho] = *(const unsigned long long*)(gr + 8 * rho);
        f32x16 dx0, dx1;
        { const f32x4 c0 = *(const LAS f32x4*)(CST + 48), c1 = *(const LAS f32x4*)(CST + 52), c2 = *(const LAS f32x4*)(CST + 56), c3 = *(const LAS f32x4*)(CST + 60);
          const f32x4 e0 = *(const LAS f32x4*)(CST + 64), e1 = *(const LAS f32x4*)(CST + 68), e2 = *(const LAS f32x4*)(CST + 72), e3 = *(const LAS f32x4*)(CST + 76);
#pragma unroll
          for (int e = 0; e < 4; ++e) { dx0[e] = c0[e]; dx0[4 + e] = c1[e]; dx0[8 + e] = c2[e]; dx0[12 + e] = c3[e]; dx1[e] = e0[e]; dx1[4 + e] = e1[e]; dx1[8 + e] = e2[e]; dx1[12 + e] = e3[e]; } }
#pragma unroll
        for (int k = 0; k < 4; ++k)
#pragma unroll
            for (int s4 = 0; s4 < 4; ++s4) {
                const bf16x8v xb = SAMPLE ? *(const bf16x8v*)(zsr[k] + 16 * s4) : *(const LAS bf16x8v*)(XAp + k * RGL_XAP + s4 * 32);
                if (s4 < 2) dx0 = MFMA32(dg[((0 * 2 + (s4 & 1)) * 4 + k) * 64], xb, dx0); else dx1 = MFMA32(dg[((1 * 2 + (s4 & 1)) * 4 + k) * 64], xb, dx1);
                if (s4 == 3) asm volatile("" : "+v"(dx0), "+v"(dx1) :: "memory"); }
        f32x16 dr, di;
#pragma unroll
        for (int i = 0; i < 16; ++i) { dr[i] = 0.f; di[i] = 0.f; }
        { const bf16x8v b00 = pack8(dx0, 0), b01 = pack8(dx0, 1), b10 = pack8(dx1, 0), b11 = pack8(dx1, 1);
          dr = MFMA32(af[0 * 64], b00, dr); di = MFMA32(af[4 * 64], b00, di); dr = MFMA32(af[1 * 64], b01, dr); di = MFMA32(af[5 * 64], b01, di);
          dr = MFMA32(af[2 * 64], b10, dr); di = MFMA32(af[6 * 64], b10, di); dr = MFMA32(af[3 * 64], b11, dr); di = MFMA32(af[7 * 64], b11, di); }
        f32x16 av, bv;
        const bool first = !SAMPLE && (t == 0);
#pragma unroll
        for (int i = 0; i < 16; ++i) { const float xcv = jh ? dx1[i] : dx0[i];
            const float r = sigmoidf_(dr[i] + CST[i]), gi = sigmoidf_(di[i] + CST[16 + i]);
            const float a = __builtin_amdgcn_exp2f(r * CST[32 + i]);
            float mult = __builtin_amdgcn_sqrtf(fmaxf(1.f - a * a, 0.f)); if (first) mult = 1.f;
            av[i] = a; bv[i] = mult * gi * xcv; }
        if (SAMPLE && (t & 3) == 0) {
            const float* h0 = A.in[I_SH] + (size_t)(t >> 2) * WA + hd * 64 + 32 * jh + 4 * hh;
#pragma unroll
            for (int i = 0; i < 16; ++i) { bv[i] += av[i] * h0[(i & 3) + 8 * (i >> 2)]; av[i] = 0.f; } }
        rg_scan_step<0x111, 0xF>(av, bv); rg_scan_step<0x112, 0xF>(av, bv); rg_scan_step<0x114, 0xF>(av, bv); rg_scan_step<0x118, 0xF>(av, bv);
        rg_scan_step<0x142, 0xA>(av, bv);
        float hin[16];
#pragma unroll
        for (int i = 0; i < 16; ++i) hin[i] = 0.f;
        if (!SAMPLE) {
        LAS float* TOT = (LAS float*)(L + RGL_TOT) + (rd & 1) * 512;
        if (q == 31) {
#pragma unroll
            for (int i4 = 0; i4 < 4; ++i4) { *(LAS f32x4*)(TOT + (w * 2 + 0) * 32 + hh * 16 + 4 * i4) = (f32x4){av[4 * i4], av[4 * i4 + 1], av[4 * i4 + 2], av[4 * i4 + 3]};
                                             *(LAS f32x4*)(TOT + (w * 2 + 1) * 32 + hh * 16 + 4 * i4) = (f32x4){bv[4 * i4], bv[4 * i4 + 1], bv[4 * i4 + 2], bv[4 * i4 + 3]}; }
        }
        stage_write((rd + 1) & 1, stn);
        __syncthreads();
#pragma unroll
        for (int w2 = 0; w2 < 8; ++w2) {
            if (w2 == w) {
#pragma unroll
                for (int i = 0; i < 16; ++i) hin[i] = hround[i]; }
#pragma unroll
            for (int i4 = 0; i4 < 4; ++i4) { const f32x4 p = *(const LAS f32x4*)(TOT + (w2 * 2 + 0) * 32 + hh * 16 + 4 * i4), hl = *(const LAS f32x4*)(TOT + (w2 * 2 + 1) * 32 + hh * 16 + 4 * i4);
#pragma unroll
                for (int e = 0; e < 4; ++e) hround[4 * i4 + e] = p[e] * hround[4 * i4 + e] + hl[e]; }
        }
        }
        bf16* yr = Yb + (size_t)t * D + hd * 64 + 32 * jh + 4 * hh;
#pragma unroll
        for (int rho = 0; rho < 4; ++rho) { const unsigned glo = (unsigned)gq[rho], ghi = (unsigned)(gq[rho] >> 32);
            const float o0 = gelu_tanh(pg8::bf_lo(glo)) * (bv[4 * rho] + av[4 * rho] * hin[4 * rho]), o1 = gelu_tanh(pg8::bf_hi(glo)) * (bv[4 * rho + 1] + av[4 * rho + 1] * hin[4 * rho + 1]);
            const float o2 = gelu_tanh(pg8::bf_lo(ghi)) * (bv[4 * rho + 2] + av[4 * rho + 2] * hin[4 * rho + 2]), o3 = gelu_tanh(pg8::bf_hi(ghi)) * (bv[4 * rho + 3] + av[4 * rho + 3] * hin[4 * rho + 3]);
            *(unsigned long long*)(yr + 8 * rho) = (unsigned long long)pkbf(o0, o1) | ((unsigned long long)pkbf(o2, o3) << 32); }
        if (SAMPLE && (t & 3) == 3) {
#pragma unroll
            for (int i = 0; i < 16; ++i) F.out[O_HS + (size_t)(t >> 2) * WA + hd * 64 + 32 * jh + (i & 3) + 8 * (i >> 2) + 4 * hh] = bv[i]; }
    }
    if (!SAMPLE && w == 0 && q == 0) {
#pragma unroll
        for (int i = 0; i < 16; ++i) F.out[O_HP + (size_t)b * WA + hd * 64 + 32 * jh + (i & 3) + 8 * (i >> 2) + 4 * hh] = hround[i];
    }
    __syncthreads();
}

#ifndef PROBE_P3PART
#define PROBE_P3PART 7
#endif
__device__ __forceinline__ void p3_mixers_ref(Frame& F, const Args& A, int rep = 0) {
    constexpr int N_RGP = NBP * HA, N_S5P = NBP * GB;
    const int pm = rep ? PROBE_P3PART : 7;
    bf16* GY = (bf16*)(F.ws + WS_G); bf16* YC = (bf16*)(F.ws + WS_YCAT);
    pg8::Gemm gg{GY, (const bf16*)(F.ws + WS_WGLU), M, WB, WB}; pg8::EpiGlu EG{GY, WB, YC, D, WA, A.in[I_GLUB]};
    pg8::OneUnit SG; SG.u0.pm = 0; SG.u0.pn = 0; SG.u0.k0 = 0; SG.u0.nkt = WB / 64; SG.u0.ks = 0; bool has_glu = false;
    if (F.vcu < 2 * N_RGP) {
        if (pm & 1) rg_item_fast<false>(F, A, F.vcu / (2 * HA), (F.vcu / 2) % HA, F.vcu & 1);
        if (pm & 4) { if (F.vcu < GB) { s5_item_sample(F, A, F.vcu); cnt_arrive_wt(F, CW_S5B + 64 * NBP); }
                      else if (F.vcu < GB + 2 * HA) rg_item_fast<true>(F, A, 0, (F.vcu - GB) >> 1, (F.vcu - GB) & 1);
                      else if (F.vcu < GB + 2 * HA + 4) {
                          cnt_wait_ge(F, CW_S5B + 64 * NBP, (unsigned)GB); const int u = F.vcu - GB - 2 * HA; SG.u0.pm = MP / 256 + (u >> 1); SG.u0.pn = u & 1; has_glu = true; } }
    } else {
        const int v = F.vcu - 2 * N_RGP, it = 2 * v, bb = it / GB;
        if (pm & 2) { s5_item_fast(F, A, bb, it % GB);
                      s5_item_fast(F, A, bb, (it + 1) % GB);
                      cnt_arrive_wt(F, CW_S5B + 64 * bb);
                      cnt_wait_ge(F, CW_S5B + 64 * bb, 16u);
                      const int u = v & 15; SG.u0.pm = 8 * bb + (u >> 1); SG.u0.pn = u & 1; has_glu = true; }
    }
    if (has_glu) pg8::gemm_phase<pg8::EpiGlu, pg8::OneUnit, false, PG8_SP2>(F.lds + RING_OFF, gg, SG, EG);
    if (rep == 0) xpose_range(F, A, XO_2, XO_END, 0);
}

template <bool SECOND>
__device__ __forceinline__ void ln_phase(Frame& F, const Args& A, int rep) {
    pg8::StaticOrder P; P.init(MP, D, F.G, (int)blockIdx.x, D); pg8::Unit u; P.next(0, u);
    cnt_wait_ge(F, (SECOND ? CW_T2 : CW_T1) + 64 * u.pm, 4u);
    ln_rows<SECOND>(F, A, u.pm * 256 + u.pn * 64, u.pm * 256 + u.pn * 64 + 64, F.wave, NWAVES);
    constexpr int NPC = 2 * (D / 256) * (SECOND ? NS_DOWN : NS_OUT);
    const int si = (int)blockIdx.x - (F.G - NPC);
    if (si >= 0) { cnt_wait_ge(F, SECOND ? CW_T2S : CW_T1S, (unsigned)NPC);
        ln_rows<SECOND>(F, A, MP + si * (MS / NPC), MP + (si + 1) * (MS / NPC), F.wave, NWAVES); }
}
__global__ void __launch_bounds__(NWAVES * 64, 2) fwd(Args A) {
    extern __shared__ __attribute__((aligned(16))) unsigned char lds[];
    Frame F;
    F.lds = (LAS unsigned char*)lds;
    F.MISC = (volatile LAS unsigned*)(F.lds + MISC_OFF);
    F.tid = threadIdx.x; F.lane = F.tid & 63; F.wave = __builtin_amdgcn_readfirstlane(F.tid >> 6);
    F.G = gridDim.x; { const int bx = blockIdx.x; F.vcu = (F.G % 8 == 0) ? (bx % 8) * (F.G / 8) + bx / 8 : bx; }
    F.out = A.out; F.ws = A.ws; F.ctl = (gu32*)(A.ws + WS_CTL);
    for (int u = F.tid; u < (LDS_BYTES - LDSCTL_OFF) / 4; u += NWAVES * 64) ((LAS unsigned*)(F.lds + LDSCTL_OFF))[u] = 0u;
    __syncthreads();
    XcdBarrier bar; bar.bar = (unsigned*)(F.ctl + CW_BAR); bar.x = 0; bar.st = nullptr;
    if (N_LAUNCHES == 1) bar = xcd_barrier_post((unsigned*)(F.ctl + CW_BAR), F.MISC + 8);
#define GRID_BAR() do { if (N_LAUNCHES == 1) xcd_barrier(bar); } while (0)
    const int lo = A.ph_lo, hi = A.ph_hi;
#define IN(k) (lo <= (k) && (k) < hi)
#define BOTH(k) (IN(k) && IN((k) + 1))
    bf16* XN = (bf16*)(F.ws + WS_XN); bf16* Z = (bf16*)(F.ws + WS_Z); bf16* YC = (bf16*)(F.ws + WS_YCAT); bf16* GY = (bf16*)(F.ws + WS_G); bf16* U = (bf16*)(F.ws + WS_U);
    const float* mod = (const float*)(F.ws + WS_MOD);

#define REPS(k) (((PROBE_DUP) >> (k)) & 1 ? 2 : 1)
#define PH0(rep) p0_prologue(F, A, rep)
#define PH1(rep) p1_modulate(F, A, rep)
#define PH2(rep) do {     \
        pg8::Gemm g{XN, (const bf16*)(F.ws + WS_WIN), M, NZ, D}; pg8::StaticOrder S; S.init(M, NZ, F.G, (int)blockIdx.x, D); \
        pg8::EpiBf16<0> E{Z, NZ, nullptr}; \
        pg8::gemm_phase<pg8::EpiBf16<0>, pg8::StaticOrder, PG8_ALIGN, PG8_SP2>(F.lds + RING_OFF, g, S, E); \
        if ((rep) == 0 && (int)blockIdx.x >= (M / 256) * (NZ / 256) - F.G) { __syncthreads(); xpose_range_b(F, A, XO_OU, XO_2, (M / 256) * (NZ / 256) - F.G); } } while (0)
#define PH3(rep) p3_mixers_ref(F, A, rep)
#define PH4(rep) do { } while (0)
#define PH5(rep) do {     \
        pg8::Gemm g{YC, (const bf16*)(F.ws + WS_WOUT), M, D, D}; pg8::SplitOrder S; S.init(MP, D, F.G, (int)blockIdx.x, D, NS_OUT); \
        pg8::EpiRes<false> E{A.in[I_XP], (bf16*)(F.ws + WS_T1), mod + 2 * D, nullptr, ALPHA, MP, (float*)(F.ws + WS_SLAB)}; \
        pg8::gemm_phase<pg8::EpiRes<false>, pg8::SplitOrder, PG8_ALIGN, PG8_SP2>(F.lds + RING_OFF, g, S, E); \
        { pg8::Unit u0; S.P.next(0, u0); cnt_arrive_wt(F, CW_T1 + 64 * u0.pm); if ((int)blockIdx.x >= F.G - S.nP) cnt_arrive_wt(F, CW_T1S); } } while (0)
#define PH6(rep) ln_phase<false>(F, A, rep)
#define PH7(rep) do {     \
        pg8::Gemm g{XN, (const bf16*)(F.ws + WS_W1), M, FF, D}; pg8::StaticOrder S; S.init(M, FF, F.G, (int)blockIdx.x, D); \
        pg8::EpiBf16<3> E{U, FF, A.in[I_B1]}; \
        pg8::gemm_phase<pg8::EpiBf16<3>, pg8::StaticOrder, PG8_ALIGN, PG8_SP2>(F.lds + RING_OFF, g, S, E); } while (0)
#define PH8(rep) do {     \
        pg8::Gemm g{U, (const bf16*)(F.ws + WS_W2), M, D, FF}; pg8::SplitOrder S; S.init(MP, D, F.G, (int)blockIdx.x, FF, NS_DOWN); \
        pg8::EpiRes<true> E{(const bf16*)(F.ws + WS_X1B), (bf16*)(F.ws + WS_T2), mod + 5 * D, A.in[I_B2], ALPHA, MP, (float*)(F.ws + WS_SLAB)}; \
        pg8::gemm_phase<pg8::EpiRes<true>, pg8::SplitOrder, PG8_ALIGN, PG8_SP2>(F.lds + RING_OFF, g, S, E); \
        { pg8::Unit u0; S.P.next(0, u0); cnt_arrive_wt(F, CW_T2 + 64 * u0.pm); if ((int)blockIdx.x >= F.G - S.nP) cnt_arrive_wt(F, CW_T2S); } } while (0)
#define RUNNB(k, PH) do { if (IN(k)) { PH(0); if (REPS(k) == 2) { __syncthreads(); PH(1); } } } while (0)
#define RUN(k, PH) do { if (IN(k)) { PH(0); if (REPS(k) == 2) { __syncthreads(); PH(1); } if (BOTH(k)) GRID_BAR(); } } while (0)
    if (IN(0)) { PH0(0); if (REPS(0) == 2) { __syncthreads(); PH0(1); } if (IN(0) && !IN(1)) { } }
    RUN(1, PH1); RUN(2, PH2); RUN(3, PH3); RUNNB(5, PH5); RUN(6, PH6); RUN(7, PH7); RUNNB(8, PH8);
    if (IN(9)) { ln_phase<true>(F, A, 0); }
#undef IN
#undef BOTH
}

extern "C" void kernel_launch(void* const* d_in, const int* in_sizes, int n_in, void* d_out, int out_size, void* d_ws, size_t ws_size, hipStream_t stream) {
    static int grid = 0;
    if (grid == 0) {
        if (n_in != 37 || in_sizes[0] != MP * D || out_size != (int)O_END || ws_size < WS_END) { fprintf(stderr, "kernel_launch: unexpected shapes (n_in %d, in0 %d, out %d, ws %zu)\n", n_in, n_in > 0 ? in_sizes[0] : -1, out_size, ws_size); grid = -1; return; }
        int dev = 0, cus = 0, per_cu = 0;
        if (hipGetDevice(&dev) != hipSuccess || hipDeviceGetAttribute(&cus, hipDeviceAttributeMultiprocessorCount, dev) != hipSuccess) { grid = -1; return; }
        if (hipFuncSetAttribute((const void*)fwd, hipFuncAttributeMaxDynamicSharedMemorySize, LDS_BYTES) != hipSuccess) { fprintf(stderr, "kernel_launch: hipFuncSetAttribute failed\n"); grid = -1; return; }
        if (hipOccupancyMaxActiveBlocksPerMultiprocessor(&per_cu, (const void*)fwd, NWAVES * 64, LDS_BYTES) != hipSuccess || per_cu < 1) { fprintf(stderr, "kernel_launch: occupancy query says %d\n", per_cu); }
        (void)hipGetLastError();
        grid = cus;
        if (grid < 256) { fprintf(stderr, "kernel_launch: this build needs 256 CUs (got %d)\n", grid); grid = -1; return; }
        grid = 256;
    }
    if (grid < 0) return;
    (void)hipMemsetAsync((char*)d_ws + WS_CTL, 0, CTL_ZERO_BYTES, stream);
    Args a{};
    for (int i = 0; i < 37; ++i) a.in[i] = (const float*)d_in[i];
    a.out = (float*)d_out; a.ws = (unsigned char*)d_ws;
    for (int li = 0; li < N_LAUNCHES; ++li) {
        if (N_LAUNCHES == 1) { a.ph_lo = 0; a.ph_hi = N_PHASES; } else { a.ph_lo = li; a.ph_hi = li + 1; }
        a.li = li;
        hipLaunchKernelGGL(fwd, dim3(grid), dim3(NWAVES * 64), LDS_BYTES, stream, a);
    }
}
```

```cpp
#include <hip/hip_runtime.h>
#include <cstdio>
#include <cstdint>
#include <cmath>

#ifndef MK_N_LAUNCHES
#define MK_N_LAUNCHES 1
#endif

namespace pg8 {
#define PG8_LAS __attribute__((address_space(3)))
typedef unsigned short bf16_t;
typedef short bf16x8 __attribute__((ext_vector_type(8)));
typedef float f32x4 __attribute__((ext_vector_type(4)));
typedef unsigned u32x4 __attribute__((ext_vector_type(4)));
constexpr int BM = 256, BK = 64, HALF = 128, HTB = HALF * BK * 2, STAGE_BYTES = 8 * HTB, NXCD = 8, WGM = 8;

__host__ __device__ __forceinline__ int lds_byte(int r, int c) { const int st = (r >> 4) * 2 + (c >> 5), rr = r & 15, cc = c & 31, ob = rr * 64 + cc * 2; return st * 1024 + (ob ^ (((ob >> 9) & 1) << 5)); }
__host__ __device__ __forceinline__ void stage_rc(int b, int& R, int& C) { const int st = b / 1024, sb = b % 1024, swz = sb ^ (((sb >> 9) & 1) << 5); R = (st >> 1) * 16 + swz / 64; C = (st & 1) * 32 + (swz % 64) / 2; }
__host__ __device__ __forceinline__ int perm32(int rho) { const int n = rho >> 4, i = rho & 15; return 8 * (i >> 2) + 4 * n + (i & 3); }

struct Unit { int pm, pn, k0, nkt, ks; };
struct Gemm { const bf16_t* A; const bf16_t* Bt; int M, N, K; };

struct StaticOrder {
    int nM, nN, nwg, G, c, K;
    __host__ __device__ void init(int M, int N, int G_, int c_, int K_) { nM = M / BM; nN = N / BM; nwg = nM * nN; G = G_; c = c_; K = K_; }
    __host__ __device__ __forceinline__ bool next(int i, Unit& u) const {
        const long L = (long)i * G + c; if (L >= nwg) return false;
        int wgid = (int)L; { const int q = nwg / NXCD, r = nwg % NXCD, xcd = wgid % NXCD, off = wgid / NXCD; wgid = (xcd < r ? xcd * (q + 1) : r * (q + 1) + (xcd - r) * q) + off; }
        const int nig = WGM * nN, gid = wgid / nig, fm = gid * WGM, gsz = (nM - fm) < WGM ? (nM - fm) : WGM;
        u.pm = fm + ((wgid % nig) % gsz); u.pn = (wgid % nig) / gsz; u.k0 = 0; u.nkt = K / BK; u.ks = 0; return true;
    }
    __device__ __forceinline__ void a_ready(const Unit&) const {}
    __device__ __forceinline__ void done(const Unit&) const {}
};

struct SplitOrder {
    StaticOrder P; int nN, NS, nP, G, c, K, r0;
    __host__ __device__ void init(int MPr, int N, int G_, int c_, int K_, int NS_) { P.init(MPr, N, G_, c_, K_); nN = N / BM; NS = NS_; nP = 2 * nN * NS; G = G_; c = c_; K = K_; r0 = (P.nwg + G - 1 - c) / G;   }
    __host__ __device__ __forceinline__ bool next(int i, Unit& u) const {
        Unit a; a.pm = 0; a.pn = 0; a.k0 = 0; a.nkt = K / BK; a.ks = 0;
        const bool okp = P.next(i < r0 ? i : 0, a);
        const int p = (i - r0) * G + (G - 1 - c), t = p / NS, ks = p % NS, nk = K / BK / NS;
        const bool split = i >= r0;
        u.pm = split ? P.nM + t / nN : a.pm; u.pn = split ? t % nN : a.pn; u.nkt = split ? nk : a.nkt; u.ks = split ? ks : 0; u.k0 = split ? ks * nk * BK : 0;
        return split ? (p < nP) : okp;
    }
    __device__ __forceinline__ void a_ready(const Unit&) const {}
    __device__ __forceinline__ void done(const Unit&) const {}
};

struct OneUnit {
    Unit u0;
    __host__ __device__ __forceinline__ bool next(int i, Unit& u) const { u = u0; return i == 0; }
    __device__ __forceinline__ void a_ready(const Unit&) const {}
    __device__ __forceinline__ void done(const Unit&) const {}
};
__device__ __forceinline__ void st16_wt(void* p, u32x4 v) { asm volatile("global_store_dwordx4 %0, %1, off sc1\n\ts_nop 1" :: "v"(p), "v"(v)); }
__device__ __forceinline__ void st16f_wt(void* p, f32x4 v) { asm volatile("global_store_dwordx4 %0, %1, off sc1\n\ts_nop 1" :: "v"(p), "v"(v)); }
__device__ __forceinline__ unsigned cvt_pk_bf16(float lo, float hi) { unsigned r; asm volatile("v_cvt_pk_bf16_f32 %0, %1, %2" : "=v"(r) : "v"(lo), "v"(hi)); return r; }
__device__ __forceinline__ float bf_lo(unsigned w) { return __builtin_bit_cast(float, w << 16); }
__device__ __forceinline__ float bf_hi(unsigned w) { return __builtin_bit_cast(float, w & 0xffff0000u); }

template <int ACT> struct EpiBf16 {
    static constexpr bool PERM = true, AFTER_DRAIN = false;
    bf16_t* O; int ldc; const float* bias;
    __device__ __forceinline__ void operator()(const f32x4 (&acc)[2][2][4][2], const Unit& u, int wr, int wc, int fr, int fq) const {
        const int row0 = u.pm * BM + wr * 64 + fr; const int col0 = u.pn * BM + wc * 32 + 8 * fq;
        f32x4 bv[2][2];
#pragma unroll
        for (int bj = 0; bj < 2; ++bj)
#pragma unroll
            for (int n = 0; n < 2; ++n) bv[bj][n] = bias ? *(const f32x4*)(bias + col0 + bj * HALF + 4 * n) : (f32x4){0.f, 0.f, 0.f, 0.f};
#pragma unroll
        for (int ai = 0; ai < 2; ++ai)
#pragma unroll
            for (int m = 0; m < 4; ++m) { bf16_t* rowp = O + (size_t)(row0 + ai * HALF + m * 16) * ldc + col0;
#pragma unroll
                for (int bj = 0; bj < 2; ++bj) { f32x4 v0 = acc[ai][bj][m][0] + bv[bj][0], v1 = acc[ai][bj][m][1] + bv[bj][1];
                    if (ACT == 3) {
#pragma unroll
                        for (int e = 0; e < 4; ++e) { const float a = fmaxf(v0[e], 0.f), b = fmaxf(v1[e], 0.f); v0[e] = a * a; v1[e] = b * b; } }
                    u32x4 w; w.x = cvt_pk_bf16(v0[0], v0[1]); w.y = cvt_pk_bf16(v0[2], v0[3]); w.z = cvt_pk_bf16(v1[0], v1[1]); w.w = cvt_pk_bf16(v1[2], v1[3]);
                    *(u32x4*)(rowp + bj * HALF) = w; } }
    }
};
struct EpiGlu {
    static constexpr bool PERM = true, AFTER_DRAIN = false;
    const bf16_t* Gy; int ldg; bf16_t* O; int ldc; int coff; const float* bias;
    __device__ __forceinline__ void operator()(const f32x4 (&acc)[2][2][4][2], const Unit& u, int wr, int wc, int fr, int fq) const {
        const int row0 = u.pm * BM + wr * 64 + fr; const int col0 = u.pn * BM + wc * 32 + 8 * fq;
        f32x4 bv[2][2];
#pragma unroll
        for (int bj = 0; bj < 2; ++bj)
#pragma unroll
            for (int n = 0; n < 2; ++n) bv[bj][n] = *(const f32x4*)(bias + col0 + bj * HALF + 4 * n);
#pragma unroll
        for (int ai = 0; ai < 2; ++ai)
#pragma unroll
            for (int m = 0; m < 4; ++m) { const size_t row = (size_t)(row0 + ai * HALF + m * 16);
#pragma unroll
                for (int bj = 0; bj < 2; ++bj) { const f32x4 v0 = acc[ai][bj][m][0] + bv[bj][0], v1 = acc[ai][bj][m][1] + bv[bj][1];
                    const u32x4 g = *(const u32x4*)(Gy + row * ldg + col0 + bj * HALF);
                    float o[8];
                    o[0] = bf_lo(g.x) * __builtin_amdgcn_rcpf(1.f + __builtin_amdgcn_exp2f(-1.4426950408889634f * v0[0])); o[1] = bf_hi(g.x) * __builtin_amdgcn_rcpf(1.f + __builtin_amdgcn_exp2f(-1.4426950408889634f * v0[1]));
                    o[2] = bf_lo(g.y) * __builtin_amdgcn_rcpf(1.f + __builtin_amdgcn_exp2f(-1.4426950408889634f * v0[2])); o[3] = bf_hi(g.y) * __builtin_amdgcn_rcpf(1.f + __builtin_amdgcn_exp2f(-1.4426950408889634f * v0[3]));
                    o[4] = bf_lo(g.z) * __builtin_amdgcn_rcpf(1.f + __builtin_amdgcn_exp2f(-1.4426950408889634f * v1[0])); o[5] = bf_hi(g.z) * __builtin_amdgcn_rcpf(1.f + __builtin_amdgcn_exp2f(-1.4426950408889634f * v1[1]));
                    o[6] = bf_lo(g.w) * __builtin_amdgcn_rcpf(1.f + __builtin_amdgcn_exp2f(-1.4426950408889634f * v1[2])); o[7] = bf_hi(g.w) * __builtin_amdgcn_rcpf(1.f + __builtin_amdgcn_exp2f(-1.4426950408889634f * v1[3]));
                    u32x4 w; w.x = cvt_pk_bf16(o[0], o[1]); w.y = cvt_pk_bf16(o[2], o[3]); w.z = cvt_pk_bf16(o[4], o[5]); w.w = cvt_pk_bf16(o[6], o[7]);
                    *(u32x4*)(O + row * ldc + coff + col0 + bj * HALF) = w; } }
    }
};
template <bool BASE16> struct EpiRes {
    static constexpr bool PERM = true, AFTER_DRAIN = false;
    const void* basep; bf16_t* T; const float* gate  ; const float* bias; float alpha; int MP; float* slab;
    __device__ __forceinline__ void operator()(const f32x4 (&acc)[2][2][4][2], const Unit& u, int wr, int wc, int fr, int fq) const {
        const int row0 = u.pm * BM + wr * 64 + fr, col0 = u.pn * BM + wc * 32 + 8 * fq;
        if (row0 >= MP) {
            float* sp = slab + (size_t)u.ks * 512 * 1024;
#pragma unroll
            for (int ai = 0; ai < 2; ++ai)
#pragma unroll
                for (int m = 0; m < 4; ++m) { float* op = sp + (size_t)(row0 + ai * HALF + m * 16 - MP) * 1024;
#pragma unroll
                    for (int bj = 0; bj < 2; ++bj)
#pragma unroll
                        for (int n = 0; n < 2; ++n) st16f_wt(op + col0 + bj * HALF + n * 4, acc[ai][bj][m][n]); }
            return; }
        f32x4 bv[2][2];
#pragma unroll
        for (int bj = 0; bj < 2; ++bj)
#pragma unroll
            for (int n = 0; n < 2; ++n) bv[bj][n] = bias ? *(const f32x4*)(bias + col0 + bj * HALF + n * 4) : (f32x4){0.f, 0.f, 0.f, 0.f};
        const float* gp = gate + (size_t)(row0 >> 11) * 6144;
#pragma unroll
        for (int ai = 0; ai < 2; ++ai)
#pragma unroll
            for (int m = 0; m < 4; ++m) { const int row = row0 + ai * HALF + m * 16;
                bf16_t* tp = T + (size_t)row * 1024;
#pragma unroll
                for (int bj = 0; bj < 2; ++bj) { const int c = col0 + bj * HALF;
                    f32x4 b0, b1;
                    if (BASE16) { const u32x4 bw = *(const u32x4*)((const bf16_t*)basep + (size_t)row * 1024 + c); b0 = (f32x4){bf_lo(bw.x), bf_hi(bw.x), bf_lo(bw.y), bf_hi(bw.y)}; b1 = (f32x4){bf_lo(bw.z), bf_hi(bw.z), bf_lo(bw.w), bf_hi(bw.w)}; }
                    else { const float* bp = (const float*)basep + (size_t)row * 1024; b0 = *(const f32x4*)(bp + c); b1 = *(const f32x4*)(bp + c + 4); }
                    const f32x4 g0 = *(const f32x4*)(gp + c), g1 = *(const f32x4*)(gp + c + 4);
                    const f32x4 v0 = b0 * alpha + g0 * (acc[ai][bj][m][0] + bv[bj][0]), v1 = b1 * alpha + g1 * (acc[ai][bj][m][1] + bv[bj][1]);
                    u32x4 w; w.x = cvt_pk_bf16(v0[0], v0[1]); w.y = cvt_pk_bf16(v0[2], v0[3]); w.z = cvt_pk_bf16(v1[0], v1[1]); w.w = cvt_pk_bf16(v1[2], v1[3]);
                    st16_wt(tp + c, w); } }
    }
};

template <class Epi, class Sched, bool ALIGN_EPI = false, bool SP2 = false>
__device__ __forceinline__ void gemm_phase(PG8_LAS unsigned char* lds, const Gemm g, const Sched& S, const Epi& E) {
    const int tid = threadIdx.x, wid = __builtin_amdgcn_readfirstlane(tid >> 6), lane = tid & 63, wr = wid >> 2, wc = wid & 3, fr = lane & 15, fq = lane >> 4;
    const int K = g.K;
    unsigned voffA[2], voffB[2];
#pragma unroll
    for (int i = 0; i < 2; ++i) { int R, C; stage_rc(tid * 16 + i * 8192, R, C); const int Rb = Epi::PERM ? ((R & ~31) + perm32(R & 31)) : R;
        voffA[i] = (unsigned)(R * K + C) * 2u; voffB[i] = (unsigned)(Rb * K + C) * 2u; }
    const size_t kstep = (size_t)(BK * 2);
    const size_t hstep = (size_t)HALF * K * 2;
    const size_t tstep = 2 * hstep;
    const unsigned ldsw = (unsigned)wid * 1024u;
    const int aoff = lds_byte(wr * 64 + fr, fq * 8), boff = lds_byte(wc * 32 + fr, fq * 8);
#define PG8_SA(b, h) (((b) * 2 + (h)) * HTB)
#define PG8_SB(b, h) ((4 + (b) * 2 + (h)) * HTB)
#define PG8_STAGE(bufoff, gbase, voff) do { _Pragma("unroll") for (int _i = 0; _i < 2; ++_i) \
        __builtin_amdgcn_global_load_lds((const unsigned*)((const char*)(gbase) + (voff)[_i]), (PG8_LAS unsigned*)(lds + (bufoff) + ldsw + _i * 8192), 16, 0, 0); } while (0)
#define PG8_LDA(dst, b, h) do { _Pragma("unroll") for (int m = 0; m < 4; ++m) _Pragma("unroll") for (int k = 0; k < 2; ++k) dst[m][k] = *(const PG8_LAS bf16x8*)(lds + PG8_SA(b, h) + aoff + m * 2048 + k * 1024); } while (0)
#define PG8_LDB(dst, b, h) do { _Pragma("unroll") for (int n = 0; n < 2; ++n) _Pragma("unroll") for (int k = 0; k < 2; ++k) dst[n][k] = *(const PG8_LAS bf16x8*)(lds + PG8_SB(b, h) + boff + n * 2048 + k * 1024); } while (0)
#define PG8_MMA(ai, bj, At, Bt) do { __builtin_amdgcn_s_setprio(1); _Pragma("unroll") for (int m = 0; m < 4; ++m) _Pragma("unroll") for (int n = 0; n < 2; ++n) _Pragma("unroll") for (int k = 0; k < 2; ++k) \
        acc[ai][bj][m][n] = __builtin_amdgcn_mfma_f32_16x16x32_bf16(Bt[n][k], At[m][k], acc[ai][bj][m][n], 0, 0, 0); __builtin_amdgcn_s_setprio(0); } while (0)
#define PG8_WAIT_V(n) asm volatile("s_waitcnt vmcnt(" #n ")" ::: "memory")
#define PG8_WAIT_L(n) asm volatile("s_waitcnt lgkmcnt(" #n ")" ::: "memory")
#define PG8_BAR __builtin_amdgcn_s_barrier()
#define PG8_SCHED __builtin_amdgcn_sched_barrier(0)
    Unit cur, nxt; int ui = 0;
    if (!S.next(0, cur)) return;
    f32x4 acc[2][2][4][2];
#pragma unroll
    for (int a = 0; a < 2; ++a)
#pragma unroll
        for (int b = 0; b < 2; ++b)
#pragma unroll
            for (int m = 0; m < 4; ++m)
#pragma unroll
                for (int n = 0; n < 2; ++n) acc[a][b][m][n] = (f32x4){0.f, 0.f, 0.f, 0.f};
    bf16x8 At[4][2], B0[2][2], B1[2][2];
    const char* cA = (const char*)g.A + (size_t)cur.pm * tstep + (size_t)cur.k0 * 2; const char* cB = (const char*)g.Bt + (size_t)cur.pn * tstep + (size_t)cur.k0 * 2;
    S.a_ready(cur);
    if constexpr (SP2) {
        PG8_STAGE(PG8_SB(0, 0), cB, voffB); PG8_STAGE(PG8_SB(0, 1), cB + hstep, voffB); PG8_STAGE(PG8_SA(0, 0), cA, voffA); PG8_STAGE(PG8_SA(0, 1), cA + hstep, voffA);
        if (wr == 1) PG8_BAR;
        PG8_WAIT_V(2); PG8_BAR;
        PG8_STAGE(PG8_SB(1, 0), cB + kstep, voffB); PG8_STAGE(PG8_SA(1, 0), cA + kstep, voffA); PG8_STAGE(PG8_SB(1, 1), cB + hstep + kstep, voffB);
        PG8_WAIT_V(6); PG8_BAR;
    } else {
        PG8_STAGE(PG8_SB(0, 0), cB, voffB); PG8_STAGE(PG8_SA(0, 0), cA, voffA); PG8_STAGE(PG8_SB(0, 1), cB + hstep, voffB); PG8_STAGE(PG8_SA(0, 1), cA + hstep, voffA);
        if (wr == 1) PG8_BAR;
        PG8_WAIT_V(4); PG8_BAR;
        PG8_STAGE(PG8_SB(1, 0), cB + kstep, voffB); PG8_STAGE(PG8_SA(1, 0), cA + kstep, voffA); PG8_STAGE(PG8_SB(1, 1), cB + hstep + kstep, voffB);
        PG8_WAIT_V(6); PG8_BAR;
    }
    for (;;) {
        const bool has_next = S.next(ui + 1, nxt);
        const char* nA = has_next ? (const char*)g.A + (size_t)nxt.pm * tstep + (size_t)nxt.k0 * 2 : cA; const char* nB = has_next ? (const char*)g.Bt + (size_t)nxt.pn * tstep + (size_t)nxt.k0 * 2 : cB;
        const int nt = cur.nkt;
        for (int t = 0; t < nt; t += 2) {
            const bool last = (t == nt - 2);
            const char* a1 = cA + (size_t)(t + 1) * kstep;
            const char* a2 = last ? nA : cA + (size_t)(t + 2) * kstep; const char* b2 = last ? nB : cB + (size_t)(t + 2) * kstep;
            const char* a3 = a2 + kstep; const char* b3 = b2 + kstep;
            if (last && has_next) S.a_ready(nxt);
            if constexpr (SP2) {
            PG8_LDB(B0, 0, 0); PG8_LDB(B1, 0, 1); PG8_SCHED; PG8_LDA(At, 0, 0); PG8_STAGE(PG8_SA(1, 1), a1 + hstep, voffA);
            PG8_WAIT_V(8); PG8_WAIT_L(0); PG8_BAR; PG8_MMA(0, 0, At, B0); PG8_MMA(0, 1, At, B1); PG8_BAR; PG8_SCHED;
            PG8_LDA(At, 0, 1); PG8_STAGE(PG8_SB(0, 0), b2, voffB); PG8_STAGE(PG8_SB(0, 1), b2 + hstep, voffB); PG8_STAGE(PG8_SA(0, 0), a2, voffA);
            PG8_WAIT_V(8); PG8_WAIT_L(0); PG8_BAR; PG8_MMA(1, 0, At, B0); PG8_MMA(1, 1, At, B1); PG8_BAR; PG8_SCHED;
            PG8_LDB(B0, 1, 0); PG8_LDB(B1, 1, 1); PG8_SCHED; PG8_LDA(At, 1, 0); PG8_STAGE(PG8_SA(0, 1), a2 + hstep, voffA);
            PG8_WAIT_V(8); PG8_WAIT_L(0); PG8_BAR; PG8_MMA(0, 0, At, B0); PG8_MMA(0, 1, At, B1); PG8_BAR; PG8_SCHED;
            PG8_LDA(At, 1, 1); PG8_STAGE(PG8_SB(1, 0), b3, voffB); PG8_STAGE(PG8_SB(1, 1), b3 + hstep, voffB); PG8_STAGE(PG8_SA(1, 0), a3, voffA);
            PG8_WAIT_V(8); PG8_WAIT_L(0); PG8_BAR; PG8_MMA(1, 0, At, B0); PG8_MMA(1, 1, At, B1); PG8_BAR; PG8_SCHED;
            } else {
            PG8_LDB(B0, 0, 0); PG8_SCHED; PG8_LDA(At, 0, 0); PG8_STAGE(PG8_SA(1, 1), a1 + hstep, voffA);
            PG8_WAIT_L(8); PG8_BAR; PG8_WAIT_L(0); PG8_MMA(0, 0, At, B0); PG8_BAR; PG8_SCHED;
            PG8_LDB(B1, 0, 1); PG8_STAGE(PG8_SB(0, 0), b2, voffB);
            PG8_BAR; PG8_WAIT_L(0); PG8_MMA(0, 1, At, B1); PG8_BAR;
            PG8_LDA(At, 0, 1); PG8_STAGE(PG8_SA(0, 0), a2, voffA);
            PG8_BAR; PG8_WAIT_L(0); PG8_MMA(1, 0, At, B0); PG8_BAR; PG8_SCHED;
            PG8_STAGE(PG8_SB(0, 1), b2 + hstep, voffB);
            PG8_WAIT_V(6); PG8_BAR; PG8_MMA(1, 1, At, B1); PG8_BAR;
            PG8_LDB(B0, 1, 0); PG8_SCHED; PG8_LDA(At, 1, 0); PG8_STAGE(PG8_SA(0, 1), a2 + hstep, voffA);
            PG8_WAIT_L(8); PG8_BAR; PG8_WAIT_L(0); PG8_MMA(0, 0, At, B0); PG8_BAR; PG8_SCHED;
            PG8_LDB(B1, 1, 1); PG8_STAGE(PG8_SB(1, 0), b3, voffB);
            PG8_BAR; PG8_WAIT_L(0); PG8_MMA(0, 1, At, B1); PG8_BAR;
            PG8_LDA(At, 1, 1); PG8_STAGE(PG8_SA(1, 0), a3, voffA);
            PG8_BAR; PG8_WAIT_L(0); PG8_MMA(1, 0, At, B0); PG8_BAR; PG8_SCHED;
            PG8_STAGE(PG8_SB(1, 1), b3 + hstep, voffB);
            PG8_WAIT_V(6); PG8_BAR; PG8_MMA(1, 1, At, B1); PG8_BAR;
            }
        }
        if constexpr (ALIGN_EPI) { if (wr == 0) PG8_BAR; }
        if constexpr (!Epi::AFTER_DRAIN) { E(acc, cur, wr, wc, fr, fq); S.done(cur); }
        if (!has_next) break;
#pragma unroll
        for (int a = 0; a < 2; ++a)
#pragma unroll
            for (int b = 0; b < 2; ++b)
#pragma unroll
                for (int m = 0; m < 4; ++m)
#pragma unroll
                    for (int n = 0; n < 2; ++n) acc[a][b][m][n] = (f32x4){0.f, 0.f, 0.f, 0.f};
        cur = nxt; cA = nA; cB = nB; ++ui;
        if constexpr (ALIGN_EPI) { if (wr == 1) PG8_BAR; }
    }
    PG8_WAIT_V(0);
    if constexpr (!ALIGN_EPI) { if (wr == 0) PG8_BAR; }
    PG8_BAR;
#undef PG8_SA
#undef PG8_SB
#undef PG8_STAGE
#undef PG8_LDA
#undef PG8_LDB
#undef PG8_MMA
#undef PG8_WAIT_V
#undef PG8_WAIT_L
#undef PG8_BAR
#undef PG8_SCHED
}
}

#ifndef PROBE_DUP
#define PROBE_DUP 0
#endif
#ifndef PG8_SP2
#define PG8_SP2 true
#endif
#ifndef PG8_ALIGN
#define PG8_ALIGN true
#endif

constexpr int NWAVES = 8;
constexpr int N_LAUNCHES = MK_N_LAUNCHES;
constexpr int N_PHASES = 10;
constexpr int D = 1024, MP = 16384, MS = 512, M = MP + MS, TP = 2048, NBP = 8, NBS = 128, TS = 4;
constexpr int NZ = 1536, WA = 512, WB = 512, FF = 4096, NMOD = 6 * D, NROWMOD = NBP + NBS;
constexpr int GB = 32, NS5 = 64, KS5 = 16, HA = 8, HDA = 64;
constexpr float LN_EPS = 1e-5f;
constexpr int NS_OUT = 4, NS_DOWN = 8;
constexpr float ALPHA = 1.189207115002721f;

constexpr size_t O_YP = 0, O_YS = (size_t)MP * D, O_CONVP = O_YS + (size_t)MS * D, O_HP = O_CONVP + (size_t)NBP * 3 * WA, O_SRP = O_HP + (size_t)NBP * WA,
                 O_SIP = O_SRP + (size_t)NBP * GB * NS5, O_CONVS = O_SIP + (size_t)NBP * GB * NS5, O_HS = O_CONVS + (size_t)NBS * 3 * WA, O_SRS = O_HS + (size_t)NBS * WA,
                 O_SIS = O_SRS + (size_t)NBS * GB * NS5, O_END = O_SIS + (size_t)NBS * GB * NS5;

constexpr size_t MiB = 1u << 20;
constexpr size_t WS_CTL = 0, CTL_ZERO_BYTES = 128 * 1024;
constexpr size_t WS_WIN = 1 * MiB, WS_WGLU = 4 * MiB, WS_WOUT = 5 * MiB, WS_W1 = 7 * MiB, WS_W2 = 15 * MiB;
constexpr size_t WS_MOD = 23 * MiB;
constexpr size_t WS_S5C = 27 * MiB;
constexpr size_t WS_XN = 28 * MiB;
constexpr size_t WS_Z = 61 * MiB;
constexpr size_t WS_YCAT = 111 * MiB;
constexpr size_t WS_G = 144 * MiB;
constexpr size_t WS_U = 61 * MiB;
constexpr size_t WS_T1 = WS_Z;
constexpr size_t WS_T2 = WS_XN;
constexpr size_t WS_TAB = 194 * MiB;
constexpr size_t WS_SLAB = 196 * MiB;
constexpr size_t WS_X1B = 212 * MiB;
constexpr size_t WS_END = 246 * MiB;
constexpr size_t TB_BF1 = 0, TB_BF2 = TB_BF1 + 32 * 4 * 64 * 16, TB_TA = TB_BF2 + 32 * 8 * 64 * 16, TB_ZP = TB_TA + 32 * 2 * 2 * 32 * 4, TB_Z16N = TB_ZP + 32 * 17 * 2 * 2 * 32 * 4,
                 TB_RG = TB_Z16N + 32 * 2 * 64 * 4, TB_CB = TB_RG + 8 * 2 * 2 * 4 * 64 * 16, TB_SILU = TB_CB + 128 * 3 * 512 * 2, TB_DG = TB_SILU + 160 * 1024 * 2, TB_END = TB_DG + 8 * 16 * 64 * 16;
static_assert(WS_TAB + TB_END <= WS_SLAB, "tables");
static_assert(WS_XN + (size_t)M * D * 2 <= WS_Z && WS_Z + (size_t)M * NZ * 2 <= WS_YCAT && WS_YCAT + (size_t)M * D * 2 <= WS_G && WS_G + (size_t)M * WB * 2 <= WS_END && WS_U + (size_t)M * FF * 2 <= WS_TAB, "d_ws map");
constexpr int SC_ABR = 0, SC_ABI = 2048, SC_BBR = 4096, SC_BBI = 4096 + 32768, SC_RGL = 4096 + 65536, SC_END = SC_RGL + 512;
constexpr int CW_TMO = 0, CW_CODE = 1, CW_SILU = 64, CW_MOD = 1024  , CW_S5B = 128  , CW_BAR = 4096,
              CW_T1 = 8192  , CW_T2 = 12288  , CW_T1S = 16384, CW_T2S = 16448  ;

constexpr int RING_OFF = 0, RING_BYTES = 131072;
constexpr int LDSCTL_OFF = RING_BYTES, MISC_OFF = LDSCTL_OFF + 320;
constexpr int LDS_BYTES = 147456;

#define GAS __attribute__((address_space(1)))
#define LAS __attribute__((address_space(3)))
typedef unsigned short bf16;
typedef unsigned v4u __attribute__((ext_vector_type(4)));
typedef float f32x4 __attribute__((ext_vector_type(4)));
typedef GAS unsigned gu32;
#define RLX_AGENT __ATOMIC_RELAXED, __HIP_MEMORY_SCOPE_AGENT
#define LDS_WAIT() asm volatile("s_waitcnt lgkmcnt(0)" ::: "memory")
#define VM_WAIT() asm volatile("s_waitcnt vmcnt(0)" ::: "memory")
__device__ __forceinline__ unsigned f2bf(float f) { unsigned u = __builtin_bit_cast(unsigned, f); return (u + 0x7fffu + ((u >> 16) & 1u)) >> 16; }
__device__ __forceinline__ unsigned pk2(float lo, float hi) { return f2bf(lo) | (f2bf(hi) << 16); }
__device__ __forceinline__ float bf2f(bf16 v) { return __builtin_bit_cast(float, (unsigned)v << 16); }
__device__ __forceinline__ float gelu_tanh(float x) { const float t = -2.3022082f * (x + 0.044715f * x * x * x); return x * __builtin_amdgcn_rcpf(1.f + __builtin_amdgcn_exp2f(t)); }
__device__ __forceinline__ float sigmoidf_(float x) { return __builtin_amdgcn_rcpf(1.f + __builtin_amdgcn_exp2f(-1.4426950408889634f * x)); }

#define XB_TMO      128
#define XB_XCNT(j)  (256  + 64 * (j))
#define XB_XSUB(j)  (1280 + 64 * (j))
#define XB_XGEN(j)  (2304 + 64 * (j))
#define XB_TOP      3328
#define XB_TOPGEN   3392
#define XCD_BAR_WORDS 3456
#define XB_SPIN_CAP (1u << 18)
__device__ __forceinline__ unsigned xb_ld(unsigned* p)              { return __hip_atomic_load(p, __ATOMIC_RELAXED, __HIP_MEMORY_SCOPE_AGENT); }
__device__ __forceinline__ unsigned xb_add(unsigned* p, unsigned v) { return __hip_atomic_fetch_add(p, v, __ATOMIC_RELAXED, __HIP_MEMORY_SCOPE_AGENT); }
__device__ __forceinline__ unsigned xb_xcc_id() { return (unsigned)__builtin_amdgcn_s_getreg((3 << 11) | 20) & 0xFu; }
#define XB_SPIN(cond, bar) do { unsigned _sp = 0; while (cond) { __builtin_amdgcn_s_sleep(1); \
    if ((++_sp & 255u) == 0u) { if (xb_ld(&(bar)[XB_TMO])) break; if (_sp > XB_SPIN_CAP) { atomicAdd(&(bar)[XB_TMO], 1u); break; } } } } while (0)
struct XcdBarrier { unsigned* bar; unsigned x; volatile LAS unsigned* st; };
__device__ __forceinline__ XcdBarrier xcd_barrier_post(unsigned* bar, volatile LAS unsigned* st) {
    XcdBarrier b; b.bar = bar; b.x = xb_xcc_id(); b.st = st;
    if (threadIdx.x == 0) (void)xb_add(&bar[XB_XCNT(b.x)], 1u);
    return b;
}
__device__ __forceinline__ void xcd_barrier_complete(unsigned* bar, unsigned x, unsigned& nloc, unsigned& nx) {
    const unsigned G = gridDim.x * gridDim.y * gridDim.z;
    unsigned sum, cnt, mine, sp = 0u;
    for (;;) {
        sum = 0u; cnt = 0u; mine = 0u;
#pragma unroll
        for (unsigned j = 0; j < 16; ++j) { const unsigned c = xb_ld(&bar[XB_XCNT(j)]); sum += c; cnt += (c > 0u) ? 1u : 0u; mine = (j == x) ? c : mine; }
        if (sum == G) break;
        __builtin_amdgcn_s_sleep(1);
        if ((++sp & 255u) == 0u) { if (xb_ld(&bar[XB_TMO])) break; if (sp > XB_SPIN_CAP) { atomicAdd(&bar[XB_TMO], 1u); break; } }
    }
    nloc = mine > 0u ? mine : 1u; nx = cnt > 0u ? cnt : 1u;
}
__device__ __forceinline__ void xcd_barrier(const XcdBarrier& b) {
    asm volatile("s_waitcnt vmcnt(0)" ::: "memory");
    __syncthreads();
    if (threadIdx.x == 0) {
        unsigned* bar = b.bar;
        __builtin_amdgcn_s_waitcnt(0);
        unsigned nloc = b.st[0], nx = b.st[1];
        if (nloc == 0u) { xcd_barrier_complete(bar, b.x, nloc, nx); b.st[0] = nloc; b.st[1] = nx; }
        const unsigned old = xb_add(&bar[XB_XSUB(b.x)], 1u);
        const unsigned gen = old / nloc;
        if (old + 1u == (gen + 1u) * nloc) {
            __builtin_amdgcn_fence(__ATOMIC_RELEASE, "agent");
            asm volatile("s_waitcnt vmcnt(0)" ::: "memory");
            const unsigned og = xb_add(&bar[XB_TOP], 1u);
            const unsigned tg = og / nx;
            if (og + 1u == (tg + 1u) * nx) xb_add(&bar[XB_TOPGEN], 1u);
            else XB_SPIN(xb_ld(&bar[XB_TOPGEN]) == tg, bar);
            __builtin_amdgcn_fence(__ATOMIC_ACQUIRE, "agent");
            xb_add(&bar[XB_XGEN(b.x)], 1u);
            asm volatile("s_waitcnt vmcnt(0)" ::: "memory");
        } else {
            XB_SPIN(xb_ld(&bar[XB_XGEN(b.x)]) == gen, bar);
            __builtin_amdgcn_fence(__ATOMIC_ACQUIRE, "agent");
            asm volatile("s_waitcnt vmcnt(0)" ::: "memory");
        }
    }
    __syncthreads();
}

struct Frame {
    LAS unsigned char* lds;
    volatile LAS unsigned* MISC;
    gu32* ctl;
    int tid, lane, wave;
    int vcu, G;
    float* out;
    unsigned char* ws;
};
struct Args { const float* in[37]; float* out; unsigned char* ws; int ph_lo, ph_hi, li, pad; };
__device__ __forceinline__ void refresh(Frame& F) { int t = threadIdx.x; asm volatile("" : "+v"(t)); F.tid = t; F.lane = t & 63; F.wave = __builtin_amdgcn_readfirstlane(t >> 6); }
__device__ __forceinline__ void cnt_arrive(Frame& F, int word) {
    VM_WAIT(); __syncthreads();
    if (F.tid == 0) { __builtin_amdgcn_fence(__ATOMIC_RELEASE, "agent"); VM_WAIT(); (void)__hip_atomic_fetch_add((unsigned*)(F.ctl + word), 1u, RLX_AGENT); }
}
__device__ __forceinline__ void cnt_arrive_wt(Frame& F, int word) {
    VM_WAIT(); __syncthreads();
    if (F.tid == 0) (void)__hip_atomic_fetch_add((unsigned*)(F.ctl + word), 1u, RLX_AGENT);
}
__device__ __forceinline__ void cnt_wait_ge(Frame& F, int word, unsigned target) {
    if (F.tid == 0) { unsigned sp = 0; while (__hip_atomic_load((unsigned*)(F.ctl + word), RLX_AGENT) < target && ++sp < (1u << 22)) __builtin_amdgcn_s_sleep(2);
        __builtin_amdgcn_fence(__ATOMIC_ACQUIRE, "agent"); VM_WAIT(); }
    __syncthreads();
}
__device__ __forceinline__ float wave_sum(float v) {
#pragma unroll
    for (int o = 1; o < 64; o <<= 1) v += __shfl_xor(v, o);
    return v;
}
enum { I_XP = 0, I_XS, I_SCONV, I_SH, I_SSR, I_SSI, I_CP, I_CS, I_ADAW, I_ADAB, I_INPROJ, I_CONVW, I_CONVB, I_RGWR, I_RGBR, I_RGWI, I_RGBI, I_RGLAM,
       I_S5ARE, I_S5AIM, I_S5LOGDT, I_S5BRE, I_S5BIM, I_S5CRE, I_S5CIM, I_S5D, I_GLUW, I_GLUB, I_OUTPROJ, I_LN1G, I_LN1B, I_W1, I_B1, I_W2, I_B2, I_LN2G, I_LN2B };

typedef float f32x2m __attribute__((ext_vector_type(2)));
typedef __bf16 bf16x2m __attribute__((ext_vector_type(2)));
__device__ __forceinline__ unsigned pkbf0(float a, float b) { const f32x2m v = {a, b}; const bf16x2m r = __builtin_convertvector(v, bf16x2m); return __builtin_bit_cast(unsigned, r); }
typedef short bf16x8m __attribute__((ext_vector_type(8)));
typedef float f32x16m __attribute__((ext_vector_type(16)));
__device__ __forceinline__ void p0_transpose_item(const float* W, int K, int N, bf16* WT, LAS float* scr, int item, int lane) {
    const int nblk = N / 32, kb = item / nblk, nb = item % nblk, k0 = 64 * kb, n0 = 32 * nb;
#pragma unroll 8
    for (int i = 0; i < 32; ++i) { const int kk = 2 * i + (lane >> 5); scr[kk * 33 + (lane & 31)] = W[(size_t)(k0 + kk) * N + n0 + (lane & 31)]; }
    LDS_WAIT(); asm volatile("" ::: "memory");
    const int c = lane & 7;
#pragma unroll
    for (int j = 0; j < 4; ++j) { const int n = (lane >> 3) + 8 * j; const LAS float* s = scr + (8 * c) * 33 + n;
        v4u o; o.x = pk2(s[0 * 33], s[1 * 33]); o.y = pk2(s[2 * 33], s[3 * 33]); o.z = pk2(s[4 * 33], s[5 * 33]); o.w = pk2(s[6 * 33], s[7 * 33]);
        *(GAS v4u*)(WT + (size_t)(n0 + n) * K + k0 + 8 * c) = o; }
    LDS_WAIT(); asm volatile("" ::: "memory");
}

constexpr int XI_IN = (D / 64) * (NZ / 32), XI_GL = (WB / 64) * (WB / 32), XI_OU = (D / 64) * (D / 32), XI_1 = (D / 64) * (FF / 32), XI_2 = (FF / 64) * (D / 32);
constexpr int XO_OU = XI_IN + XI_GL, XO_1 = XO_OU + XI_OU, XO_2 = XO_1 + XI_1, XO_END = XO_2 + XI_2;
__device__ __forceinline__ void xpose_item(Frame& F, const Args& A, LAS float* scr, int r) {
    if (r < XI_IN) { p0_transpose_item(A.in[I_INPROJ], D, NZ, (bf16*)(F.ws + WS_WIN), scr, r, F.lane); return; } r -= XI_IN;
    if (r < XI_GL) { p0_transpose_item(A.in[I_GLUW], WB, WB, (bf16*)(F.ws + WS_WGLU), scr, r, F.lane); return; } r -= XI_GL;
    if (r < XI_OU) { p0_transpose_item(A.in[I_OUTPROJ], D, D, (bf16*)(F.ws + WS_WOUT), scr, r, F.lane); return; } r -= XI_OU;
    if (r < XI_1) { p0_transpose_item(A.in[I_W1], D, FF, (bf16*)(F.ws + WS_W1), scr, r, F.lane); return; } r -= XI_1;
    p0_transpose_item(A.in[I_W2], FF, D, (bf16*)(F.ws + WS_W2), scr, r, F.lane);
}
__device__ __forceinline__ void xpose_range(Frame& F, const Args& A, int lo, int hi, int vlo) {
    refresh(F);
    if (F.vcu < vlo) return;
    LAS float* scr = (LAS float*)(F.lds + RING_OFF + F.wave * 16384);
    const int gw = F.wave * (F.G - vlo) + (F.vcu - vlo), ngw = (F.G - vlo) * NWAVES;
    for (int it = lo + gw; it < hi; it += ngw) xpose_item(F, A, scr, it);
}
__device__ __forceinline__ void xpose_range_b(Frame& F, const Args& A, int lo, int hi, int blo) {
    refresh(F);
    LAS float* scr = (LAS float*)(F.lds + RING_OFF + F.wave * 16384);
    const int gw = F.wave * (F.G - blo) + ((int)blockIdx.x - blo), ngw = (F.G - blo) * NWAVES;
    for (int it = lo + gw; it < hi; it += ngw) xpose_item(F, A, scr, it);
}
#ifndef PROBE_P0PART
#define PROBE_P0PART 7
#endif
__device__ __forceinline__ void p0_prologue(Frame& F, const Args& A, int rep = 0) {
    refresh(F);
    const int pmask = rep ? PROBE_P0PART : 7;
    LAS float* scr = (LAS float*)(F.lds + RING_OFF + F.wave * 16384);
    const int gw = F.wave * F.G + F.vcu, NGW = F.G * NWAVES;
    {
        bf16* ST = (bf16*)(F.ws + WS_TAB + TB_SILU);
        for (int ch = F.vcu * NWAVES * 64 + F.tid; ch < 160 * 1024 / 8; ch += F.G * NWAVES * 64) { const int row = ch >> 7, k = (ch & 127) * 8; v4u o = (v4u){0u, 0u, 0u, 0u};
            if (row < NROWMOD) { const float* cp = (row < NBP ? A.in[I_CP] + (size_t)row * D : A.in[I_CS] + (size_t)(row - NBP) * D) + k; const f32x4 c0 = *(const f32x4*)cp, c1 = *(const f32x4*)(cp + 4);
                o.x = pk2(c0[0] * sigmoidf_(c0[0]), c0[1] * sigmoidf_(c0[1])); o.y = pk2(c0[2] * sigmoidf_(c0[2]), c0[3] * sigmoidf_(c0[3]));
                o.z = pk2(c1[0] * sigmoidf_(c1[0]), c1[1] * sigmoidf_(c1[1])); o.w = pk2(c1[2] * sigmoidf_(c1[2]), c1[3] * sigmoidf_(c1[3])); }
            pg8::st16_wt(ST + (size_t)ch * 8, o); }
        cnt_arrive_wt(F, CW_SILU);
    }
    constexpr int I_IN = XI_IN, I_GL = XI_GL;
    constexpr int I_S5 = GB, I_RG = WA / 64, I_RGT = HA * 2 * 2 * 4, I_CB = NBS * 3 * WA / 512, I_DG = HA * 16;
    constexpr int NITEMS = I_IN + I_GL + I_S5 + I_RG + I_RGT + I_CB + I_DG;
    float* sc = (float*)(F.ws + WS_S5C);
    for (int it = gw; it < NITEMS; it += NGW) {
        int r = it;
        if (!(pmask & 1) && it < I_IN + I_GL) continue;
        if (!(pmask & 2) && it >= I_IN + I_GL) continue;
        if (r < I_IN + I_GL) { xpose_item(F, A, scr, r); continue; } r -= I_IN + I_GL;
        if (r < I_S5) {
            const int g = r, n = F.lane, gn = g * NS5 + n;
            const double dt = exp((double)A.in[I_S5LOGDT][g]), ar = (double)A.in[I_S5ARE][gn], ai = (double)A.in[I_S5AIM][gn];
            const double mag = exp(dt * ar), abr = mag * cos(dt * ai), abi = mag * sin(dt * ai), den = ar * ar + ai * ai, nr = abr - 1.0;
            const double qr = (nr * ar + abi * ai) / den, qi = (abi * ar - nr * ai) / den;
            sc[SC_ABR + gn] = (float)abr; sc[SC_ABI + gn] = (float)abi;
            unsigned char* tab = F.ws + WS_TAB;
            bf16* BF1 = (bf16*)(tab + TB_BF1); bf16* BF2 = (bf16*)(tab + TB_BF2); float* TA = (float*)(tab + TB_TA); float* ZP = (float*)(tab + TB_ZP); float* Z16N = (float*)(tab + TB_Z16N);
            const int sh = n >> 5, v = n & 31, hh = (v >> 2) & 1, ii = (v & 3) + 4 * (v >> 3);
            for (int k = 0; k < KS5; ++k) { const double br = (double)A.in[I_S5BRE][gn * KS5 + k], bi = (double)A.in[I_S5BIM][gn * KS5 + k];
                const float vr = (float)(qr * br - qi * bi), vi = (float)(qr * bi + qi * br);
                sc[SC_BBR + gn * KS5 + k] = vr; sc[SC_BBI + gn * KS5 + k] = vi;
                const int lp = (n & 31) + 32 * (k >> 3), jj = k & 7;
                BF1[(size_t)((g * 4 + 0 + sh) * 64 + lp) * 8 + jj] = (bf16)f2bf(vr); BF1[(size_t)((g * 4 + 2 + sh) * 64 + lp) * 8 + jj] = (bf16)f2bf(vi); }
            { const int s2 = (n >> 4) & 1, jj = 4 * ((n >> 3) & 1) + (n & 3), hk = (n >> 2) & 1;
              for (int ch = 0; ch < KS5; ++ch) { const int hr_ = ch >> 3, i8 = ch & 7, R = (i8 & 3) + 8 * (i8 >> 2) + 4 * hr_, lp = R + 32 * hk;
                  const float cr = A.in[I_S5CRE][(size_t)(g * KS5 + ch) * NS5 + n], ci = A.in[I_S5CIM][(size_t)(g * KS5 + ch) * NS5 + n];
                  BF2[(size_t)((g * 8 + (0 + sh) * 2 + s2) * 64 + lp) * 8 + jj] = (bf16)f2bf(cr); BF2[(size_t)((g * 8 + (2 + sh) * 2 + s2) * 64 + lp) * 8 + jj] = (bf16)f2bf(-ci); }
              for (int z = 0; z < 4; ++z) { const int cidx = n + 64 * z, ks = cidx >> 5, r16 = cidx & 31, lp = 16 + (r16 & 15) + 32 * (r16 >> 4);
                  *(v4u*)(BF2 + (size_t)((g * 8 + ks) * 64 + lp) * 8) = (v4u){0u, 0u, 0u, 0u}; } }
            TA[((g * 2 + hh) * 2 + 0) * 32 + sh * 16 + ii] = (float)abr; TA[((g * 2 + hh) * 2 + 1) * 32 + sh * 16 + ii] = (float)abi;
            const double mg8 = exp(8.0 * dt * ar), z1r = mg8 * cos(8.0 * dt * ai), z1i = mg8 * sin(8.0 * dt * ai); double pzr = 1.0, pzi = 0.0;
            for (int e = 0; e <= 16; ++e) { const float zr = (float)pzr, zi = (float)pzi; { const double nr2 = pzr * z1r - pzi * z1i, ni2 = pzr * z1i + pzi * z1r; pzr = nr2; pzi = ni2; }
                ZP[(((g * 17 + e) * 2 + hh) * 2 + 0) * 32 + sh * 16 + ii] = zr; ZP[(((g * 17 + e) * 2 + hh) * 2 + 1) * 32 + sh * 16 + ii] = zi;
                if (e == 16) { Z16N[(g * 2 + 0) * 64 + n] = zr; Z16N[(g * 2 + 1) * 64 + n] = zi; } }
            continue; } r -= I_S5;
        if (r < I_RG) { const int c = r * 64 + F.lane; const double lam = (double)A.in[I_RGLAM][c];
          sc[SC_RGL + c] = (float)(-8.0 * log1p(exp(-lam)) * 1.4426950408889634); continue; } r -= I_RG;
        if (r >= I_RGT + I_CB) { r -= I_RGT + I_CB;
            const int k = r & 3, sp = (r >> 2) & 1, tau = (r >> 3) & 1, hd = r >> 4, R = F.lane & 31, hk = F.lane >> 5;
            unsigned wv = 0u; if ((R >> 3) == 2 * sp + hk) wv = f2bf(A.in[I_CONVW][k * WA + hd * 64 + 32 * tau + R]);
            const int jj = R & 7; v4u o = (v4u){0u, 0u, 0u, 0u}; const unsigned word = (jj & 1) ? (wv << 16) : wv;
            if ((jj >> 1) == 0) o.x = word; else if ((jj >> 1) == 1) o.y = word; else if ((jj >> 1) == 2) o.z = word; else o.w = word;
            *(v4u*)(F.ws + WS_TAB + TB_DG + (size_t)(r * 64 + F.lane) * 16) = o; continue; }
        if (r >= I_RGT) { r -= I_RGT;
            const float* src = A.in[I_SCONV] + (size_t)r * 512 + F.lane * 8; const f32x4 a0 = *(const f32x4*)src, a1 = *(const f32x4*)(src + 4);
            v4u o; o.x = pk2(a0[0], a0[1]); o.y = pk2(a0[2], a0[3]); o.z = pk2(a1[0], a1[1]); o.w = pk2(a1[2], a1[3]);
            *(v4u*)(F.ws + WS_TAB + TB_CB + ((size_t)r * 512 + F.lane * 8) * 2) = o; continue; }
        {
            const int ks = r & 3, gate = (r >> 2) & 1, jh = (r >> 3) & 1, hd = r >> 4;
            const int R = F.lane & 31, hk = F.lane >> 5;
            const float* W = A.in[gate ? I_RGWI : I_RGWR] + (size_t)(hd * 64 + 32 * (ks >> 1) + 16 * (ks & 1) + 4 * hk) * 64 + 32 * jh + R;
            v4u o; o.x = pk2(W[0], W[64]); o.y = pk2(W[128], W[192]); o.z = pk2(W[8 * 64], W[9 * 64]); o.w = pk2(W[10 * 64], W[11 * 64]);
            *(v4u*)(F.ws + WS_TAB + TB_RG + (size_t)(r * 64 + F.lane) * 16) = o;
        }
    }
    __syncthreads();
    if (F.tid == 0) {
        unsigned sp = 0; while (__hip_atomic_load((unsigned*)(F.ctl + CW_SILU), RLX_AGENT) < (unsigned)F.G && ++sp < (1u << 22)) __builtin_amdgcn_s_sleep(2);
        __builtin_amdgcn_fence(__ATOMIC_ACQUIRE, "agent"); VM_WAIT(); }
    __syncthreads();
    LAS float* RED = (LAS float*)(F.lds + RING_OFF);
    float* mod = (float*)(F.ws + WS_MOD);
    const int r32 = F.lane & 31, hh = F.lane >> 5;
    const bf16* ST = (const bf16*)(F.ws + WS_TAB + TB_SILU);
#pragma unroll 1
    for (int it = F.vcu; it < ((pmask & 4) ? NMOD / 32 : 0); it += F.G) {
        const int n0 = it * 32;
        f32x16m acc[5];
#pragma unroll
        for (int rt = 0; rt < 5; ++rt)
#pragma unroll
            for (int i = 0; i < 16; ++i) acc[rt][i] = 0.f;
#pragma unroll 1
        for (int kb = 0; kb < 4; ++kb) {
            float bw[2][8]; v4u af[2][5];
#pragma unroll
            for (int ks = 0; ks < 2; ++ks) { const int k0 = F.wave * 128 + (kb * 2 + ks) * 16 + 8 * hh;
                const float* wp = A.in[I_ADAW] + (size_t)k0 * NMOD + n0 + r32;
#pragma unroll
                for (int j = 0; j < 8; ++j) bw[ks][j] = wp[(size_t)j * NMOD];
#pragma unroll
                for (int rt = 0; rt < 5; ++rt) af[ks][rt] = *(const v4u*)(ST + (size_t)(32 * rt + r32) * D + k0); }
#pragma unroll
            for (int ks = 0; ks < 2; ++ks) {
                v4u bp; bp.x = pkbf0(bw[ks][0], bw[ks][1]); bp.y = pkbf0(bw[ks][2], bw[ks][3]); bp.z = pkbf0(bw[ks][4], bw[ks][5]); bp.w = pkbf0(bw[ks][6], bw[ks][7]);
                const bf16x8m bfr = __builtin_bit_cast(bf16x8m, bp);
#pragma unroll
                for (int rt = 0; rt < 5; ++rt) acc[rt] = __builtin_amdgcn_mfma_f32_32x32x16_bf16(__builtin_bit_cast(bf16x8m, af[ks][rt]), bfr, acc[rt], 0, 0, 0); }
        }
#pragma unroll
        for (int half = 4; half >= 1; half >>= 1) {
            if (F.wave >= half && F.wave < 2 * half) {
#pragma unroll
                for (int rt = 0; rt < 5; ++rt)
#pragma unroll
                    for (int i = 0; i < 16; ++i) RED[(F.wave - half) * 5120 + (rt * 16 + i) * 64 + F.lane] = acc[rt][i]; }
            __syncthreads();
            if (F.wave < half) {
#pragma unroll
                for (int rt = 0; rt < 5; ++rt)
#pragma unroll
                    for (int i = 0; i < 16; ++i) acc[rt][i] += RED[F.wave * 5120 + (rt * 16 + i) * 64 + F.lane]; }
            __syncthreads();
        }
        if (F.wave == 0) { const float bb = A.in[I_ADAB][n0 + r32];
#pragma unroll
            for (int rt = 0; rt < 5; ++rt)
#pragma unroll
                for (int i = 0; i < 16; ++i) { const int row = 32 * rt + (i & 3) + 8 * (i >> 2) + 4 * hh; if (row < NROWMOD) __hip_atomic_store(mod + (size_t)row * NMOD + n0 + r32, acc[rt][i] + bb, RLX_AGENT); } }
        if (n0 < 2 * D) cnt_arrive_wt(F, CW_MOD);
    }
}

__device__ __forceinline__ int mod_row(int m) { return m < MP ? (m >> 11) : NBP + ((m - MP) >> 2); }
__device__ __forceinline__ const float* x_row(const Args& A, int m) { return m < MP ? A.in[I_XP] + (size_t)m * D : A.in[I_XS] + (size_t)(m - MP) * D; }

__device__ __forceinline__ void p1_modulate(Frame& F, const Args& A, int rep = 0) {
    refresh(F);
    cnt_wait_ge(F, CW_MOD, (unsigned)(2 * D / 32));
    const int gw = F.vcu * NWAVES + F.wave, NGW = F.G * NWAVES;
    const float* mod = (const float*)(F.ws + WS_MOD); bf16* XN = (bf16*)(F.ws + WS_XN);
    for (int m = gw; m < M; m += NGW) {
        const float* xr = x_row(A, m) + 8 * F.lane; const float* mr = mod + (size_t)mod_row(m) * NMOD + 8 * F.lane;
#pragma unroll
        for (int j = 0; j < 2; ++j) { const f32x4 v0 = *(const f32x4*)(xr + 512 * j), v1 = *(const f32x4*)(xr + 512 * j + 4);
            const f32x4 a0 = *(const f32x4*)(mr + 512 * j), a1 = *(const f32x4*)(mr + 512 * j + 4), s0 = *(const f32x4*)(mr + D + 512 * j), s1 = *(const f32x4*)(mr + D + 512 * j + 4);
            const f32x4 h0 = v0 * (s0 + 1.f) + a0, h1 = v1 * (s1 + 1.f) + a1;
            v4u o; o.x = pk2(h0.x, h0.y); o.y = pk2(h0.z, h0.w); o.z = pk2(h1.x, h1.y); o.w = pk2(h1.z, h1.w);
            *(v4u*)(XN + (size_t)m * D + 512 * j + 8 * F.lane) = o; }
    }
}

__device__ __forceinline__ void unpack8(const v4u w, f32x4& a, f32x4& b) { a = (f32x4){pg8::bf_lo(w.x), pg8::bf_hi(w.x), pg8::bf_lo(w.y), pg8::bf_hi(w.y)}; b = (f32x4){pg8::bf_lo(w.z), pg8::bf_hi(w.z), pg8::bf_lo(w.w), pg8::bf_hi(w.w)}; }
__device__ __forceinline__ v4u pack8f(const f32x4 a, const f32x4 b) { v4u o; o.x = pk2(a.x, a.y); o.y = pk2(a.z, a.w); o.z = pk2(b.x, b.y); o.w = pk2(b.z, b.w); return o; }
template <bool SECOND>
__device__ __forceinline__ void ln_rows(Frame& F, const Args& A, int row_lo, int row_hi, int gw, int NGW) {
    refresh(F);
    const float* mod = (const float*)(F.ws + WS_MOD); bf16* XN = (bf16*)(F.ws + WS_XN);
    const float* gg = A.in[SECOND ? I_LN2G : I_LN1G] + 8 * F.lane; const float* gb = A.in[SECOND ? I_LN2B : I_LN1B] + 8 * F.lane;
    for (int m = row_lo + gw; m < row_hi; m += NGW) {
        float* xr = F.out + (size_t)m * D + 8 * F.lane;
        f32x4 v[2][2]; float s = 0.f;
        if (m >= MP) {
            const float* mr = mod + (size_t)mod_row(m) * NMOD + (SECOND ? 5 : 2) * D + 8 * F.lane;
            const float* bs = SECOND ? xr : A.in[I_XS] + (size_t)(m - MP) * D + 8 * F.lane;
            const float* sl = (const float*)(F.ws + WS_SLAB) + (size_t)(m - MP) * D + 8 * F.lane;
#pragma unroll
            for (int j = 0; j < 2; ++j)
#pragma unroll
                for (int h = 0; h < 2; ++h) { const int o = 512 * j + 4 * h; f32x4 a = SECOND ? *(const f32x4*)(A.in[I_B2] + 8 * F.lane + o) : (f32x4){0.f, 0.f, 0.f, 0.f};
#pragma unroll
                    for (int ks = 0; ks < (SECOND ? NS_DOWN : NS_OUT); ++ks) a += *(const f32x4*)(sl + (size_t)ks * (512 * 1024) + o);
                    v[j][h] = *(const f32x4*)(bs + o) * ALPHA + *(const f32x4*)(mr + o) * a; }
        } else {
            const bf16* tr = (const bf16*)(F.ws + (SECOND ? WS_T2 : WS_T1)) + (size_t)m * D + 8 * F.lane;
#pragma unroll
            for (int j = 0; j < 2; ++j) unpack8(*(const v4u*)(tr + 512 * j), v[j][0], v[j][1]);
        }
#pragma unroll
        for (int j = 0; j < 2; ++j)
#pragma unroll
            for (int h = 0; h < 2; ++h) s += (v[j][h].x + v[j][h].y) + (v[j][h].z + v[j][h].w);
        const float mean = wave_sum(s) * (1.f / D); float s2 = 0.f;
#pragma unroll
        for (int j = 0; j < 2; ++j)
#pragma unroll
            for (int h = 0; h < 2; ++h) { v[j][h] = v[j][h] - mean; s2 += (v[j][h].x * v[j][h].x + v[j][h].y * v[j][h].y) + (v[j][h].z * v[j][h].z + v[j][h].w * v[j][h].w); }
        const float rstd = 1.f / sqrtf(wave_sum(s2) * (1.f / D) + LN_EPS);
#pragma unroll
        for (int j = 0; j < 2; ++j)
#pragma unroll
            for (int h = 0; h < 2; ++h) v[j][h] = v[j][h] * rstd * *(const f32x4*)(gg + 512 * j + 4 * h) + *(const f32x4*)(gb + 512 * j + 4 * h);
        if (SECOND || m >= MP) {
#pragma unroll
            for (int j = 0; j < 2; ++j) { *(f32x4*)(xr + 512 * j) = v[j][0]; *(f32x4*)(xr + 512 * j + 4) = v[j][1]; }
        } else {
            bf16* x1 = (bf16*)(F.ws + WS_X1B) + (size_t)m * D + 8 * F.lane;
#pragma unroll
            for (int j = 0; j < 2; ++j) *(v4u*)(x1 + 512 * j) = pack8f(v[j][0], v[j][1]);
        }
        if (!SECOND) {
            const float* mr = mod + (size_t)mod_row(m) * NMOD + 8 * F.lane;
#pragma unroll
            for (int j = 0; j < 2; ++j) { const int o = 512 * j;
                const f32x4 h0 = v[j][0] * (*(const f32x4*)(mr + 4 * D + o) + 1.f) + *(const f32x4*)(mr + 3 * D + o), h1 = v[j][1] * (*(const f32x4*)(mr + 4 * D + o + 4) + 1.f) + *(const f32x4*)(mr + 3 * D + o + 4);
                *(v4u*)(XN + (size_t)m * D + o + 8 * F.lane) = pack8f(h0, h1); }
        }
    }
}

__device__ __forceinline__ void rg_item_ref(Frame& F, const Args& A, bool prompt, int b, int hd, LAS float* scr) {
    const int j = F.lane, c = hd * HDA + j;
    const bf16* Z = (const bf16*)(F.ws + WS_Z); bf16* Y = (bf16*)(F.ws + WS_YCAT); const float* sc = (const float*)(F.ws + WS_S5C);
    float wr[64], wi[64];
#pragma unroll
    for (int i = 0; i < 64; ++i) { wr[i] = A.in[I_RGWR][(size_t)(hd * 64 + i) * 64 + j]; wi[i] = A.in[I_RGWI][(size_t)(hd * 64 + i) * 64 + j]; }
    const float br = A.in[I_RGBR][c], bi = A.in[I_RGBI][c], L2 = sc[SC_RGL + c];
    const float w0 = A.in[I_CONVW][c], w1 = A.in[I_CONVW][WA + c], w2 = A.in[I_CONVW][2 * WA + c], w3 = A.in[I_CONVW][3 * WA + c], cb = A.in[I_CONVB][c];
    int T, m0; float x3, x2, x1, h;
    if (prompt) { T = TP; m0 = b * TP; x3 = 0.f; x2 = 0.f; x1 = 0.f; h = 0.f; }
    else { T = TS; m0 = MP + b * TS; x3 = A.in[I_SCONV][(size_t)(b * 3 + 0) * WA + c]; x2 = A.in[I_SCONV][(size_t)(b * 3 + 1) * WA + c]; x1 = A.in[I_SCONV][(size_t)(b * 3 + 2) * WA + c]; h = A.in[I_SH][(size_t)b * WA + c]; }
    for (int t = 0; t < T; ++t) {
        const size_t m = (size_t)(m0 + t);
        const float xa = bf2f(Z[m * NZ + WA + c]), gate = bf2f(Z[m * NZ + c]);
        const float xc = cb + w0 * x3 + w1 * x2 + w2 * x1 + w3 * xa; x3 = x2; x2 = x1; x1 = xa;
        scr[j] = xc; LDS_WAIT(); asm volatile("" ::: "memory");
        float rp = br, gp = bi;
#pragma unroll
        for (int i4 = 0; i4 < 16; ++i4) { const f32x4 v = *(const LAS f32x4*)(scr + 4 * i4);
            rp += v[0] * wr[4 * i4] + v[1] * wr[4 * i4 + 1] + v[2] * wr[4 * i4 + 2] + v[3] * wr[4 * i4 + 3];
            gp += v[0] * wi[4 * i4] + v[1] * wi[4 * i4 + 1] + v[2] * wi[4 * i4 + 2] + v[3] * wi[4 * i4 + 3]; }
        LDS_WAIT(); asm volatile("" ::: "memory");
        const float r = sigmoidf_(rp), gi = sigmoidf_(gp);
        const float a = exp2f(r * L2);
        float mult = sqrtf(fmaxf(1.f - a * a, 0.f));
        if (prompt && t == 0) mult = 1.f;
        h = a * h + mult * gi * xc;
        Y[m * D + c] = (bf16)f2bf(gelu_tanh(gate) * h);
    }
    float* oc = F.out + (prompt ? O_CONVP : O_CONVS); float* oh = F.out + (prompt ? O_HP : O_HS);
    oc[(size_t)(b * 3 + 0) * WA + c] = x3; oc[(size_t)(b * 3 + 1) * WA + c] = x2; oc[(size_t)(b * 3 + 2) * WA + c] = x1;
    oh[(size_t)b * WA + c] = h;
}
__device__ __forceinline__ void s5_item_ref(Frame& F, const Args& A, bool prompt, int b, int g, LAS float* scr) {
    const int n = F.lane, gn = g * NS5 + n, k = F.lane & 15, part = F.lane >> 4;
    const bf16* Z = (const bf16*)(F.ws + WS_Z); bf16* Gy = (bf16*)(F.ws + WS_G); const float* sc = (const float*)(F.ws + WS_S5C);
    float bbr[16], bbi[16], cre[16], cim[16];
#pragma unroll
    for (int i = 0; i < 16; ++i) { bbr[i] = sc[SC_BBR + gn * KS5 + i]; bbi[i] = sc[SC_BBI + gn * KS5 + i];
        cre[i] = A.in[I_S5CRE][(size_t)(g * KS5 + k) * NS5 + part * 16 + i]; cim[i] = A.in[I_S5CIM][(size_t)(g * KS5 + k) * NS5 + part * 16 + i]; }
    const float abr = sc[SC_ABR + gn], abi = sc[SC_ABI + gn], dk = A.in[I_S5D][g * KS5 + k];
    int T, m0; float hr, hi;
    if (prompt) { T = TP; m0 = b * TP; hr = 0.f; hi = 0.f; }
    else { T = TS; m0 = MP + b * TS; hr = A.in[I_SSR][(size_t)(b * GB + g) * NS5 + n]; hi = A.in[I_SSI][(size_t)(b * GB + g) * NS5 + n]; }
    for (int t = 0; t < T; ++t) {
        const size_t m = (size_t)(m0 + t);
        const bf16* zr = Z + m * NZ + 2 * WA + g * KS5;
        const v4u u0 = *(const v4u*)zr, u1 = *(const v4u*)(zr + 8);
        float u[16];
        u[0] = pg8::bf_lo(u0.x); u[1] = pg8::bf_hi(u0.x); u[2] = pg8::bf_lo(u0.y); u[3] = pg8::bf_hi(u0.y); u[4] = pg8::bf_lo(u0.z); u[5] = pg8::bf_hi(u0.z); u[6] = pg8::bf_lo(u0.w); u[7] = pg8::bf_hi(u0.w);
        u[8] = pg8::bf_lo(u1.x); u[9] = pg8::bf_hi(u1.x); u[10] = pg8::bf_lo(u1.y); u[11] = pg8::bf_hi(u1.y); u[12] = pg8::bf_lo(u1.z); u[13] = pg8::bf_hi(u1.z); u[14] = pg8::bf_lo(u1.w); u[15] = pg8::bf_hi(u1.w);
        float bur = 0.f, bui = 0.f;
#pragma unroll
        for (int i = 0; i < 16; ++i) { bur += bbr[i] * u[i]; bui += bbi[i] * u[i]; }
        const float nhr = abr * hr - abi * hi + bur, nhi = abr * hi + abi * hr + bui; hr = nhr; hi = nhi;
        scr[n] = hr; scr[64 + n] = hi; LDS_WAIT(); asm volatile("" ::: "memory");
        float p = 0.f;
#pragma unroll
        for (int i4 = 0; i4 < 4; ++i4) { const f32x4 vr = *(const LAS f32x4*)(scr + part * 16 + 4 * i4), vi = *(const LAS f32x4*)(scr + 64 + part * 16 + 4 * i4);
#pragma unroll
            for (int e = 0; e < 4; ++e) p += vr[e] * cre[4 * i4 + e] - vi[e] * cim[4 * i4 + e]; }
        LDS_WAIT(); asm volatile("" ::: "memory");
        p += __shfl_xor(p, 16); p += __shfl_xor(p, 32);
        const float uk = bf2f(zr[k]);
        if (F.lane < 16) Gy[m * WB + g * KS5 + k] = (bf16)f2bf(gelu_tanh(p + dk * uk));
    }
    float* osr = F.out + (prompt ? O_SRP : O_SRS); float* osi = F.out + (prompt ? O_SIP : O_SIS);
    osr[(size_t)(b * GB + g) * NS5 + n] = hr; osi[(size_t)(b * GB + g) * NS5 + n] = hi;
}

typedef short bf16x8v __attribute__((ext_vector_type(8)));
typedef float f32x16 __attribute__((ext_vector_type(16)));
typedef float f32x2v __attribute__((ext_vector_type(2)));
typedef __bf16 bf16x2v __attribute__((ext_vector_type(2)));
#define MFMA32(a, b, c) __builtin_amdgcn_mfma_f32_32x32x16_bf16((a), (b), (c), 0, 0, 0)
__device__ __forceinline__ unsigned pkbf(float a, float b) { const f32x2v v = {a, b}; const bf16x2v r = __builtin_convertvector(v, bf16x2v); return __builtin_bit_cast(unsigned, r); }
template <int CTRL> __device__ __forceinline__ float dppf(float old, float v) { return __builtin_bit_cast(float, __builtin_amdgcn_update_dpp(__builtin_bit_cast(int, old), __builtin_bit_cast(int, v), CTRL, 0xF, 0xF, false)); }
__device__ __forceinline__ f32x16 ld16(const float* p) { f32x16 r;
#pragma unroll
    for (int i = 0; i < 4; ++i) { const f32x4 v = *(const f32x4*)(p + 4 * i); r[4 * i] = v[0]; r[4 * i + 1] = v[1]; r[4 * i + 2] = v[2]; r[4 * i + 3] = v[3]; }
    return r; }
__device__ __forceinline__ f32x16 ld16l(const LAS float* p) { f32x16 r;
#pragma unroll
    for (int i = 0; i < 4; ++i) { const f32x4 v = *(const LAS f32x4*)(p + 4 * i); r[4 * i] = v[0]; r[4 * i + 1] = v[1]; r[4 * i + 2] = v[2]; r[4 * i + 3] = v[3]; }
    return r; }
__device__ __forceinline__ bf16x8v pack8(const f32x16& x, int s) { v4u p; p.x = pkbf(x[8 * s], x[8 * s + 1]); p.y = pkbf(x[8 * s + 2], x[8 * s + 3]); p.z = pkbf(x[8 * s + 4], x[8 * s + 5]); p.w = pkbf(x[8 * s + 6], x[8 * s + 7]); return __builtin_bit_cast(bf16x8v, p); }
template <int CTRL> __device__ __forceinline__ void s5_scan_step(f32x16& xr, f32x16& xi, const f32x16& zr, const f32x16& zi) {
#pragma unroll
    for (int i = 0; i < 16; ++i) { const float sr = dppf<CTRL>(0.f, xr[i]), si = dppf<CTRL>(0.f, xi[i]);
        xr[i] += zr[i] * sr - zi[i] * si; xi[i] += zr[i] * si + zi[i] * sr; }
}
constexpr int S5L_BF1 = 0, S5L_BF2 = 4096, S5L_TOT = 12288, S5L_CAR = 20480, S5L_ZP = 28672  , S5L_TA = 37376  , S5L_U = 38912  ;
template <bool SECOND>
__device__ __forceinline__ void s5_step(LAS unsigned char* L, int lane, const bf16x8v u, f32x16& hr0, f32x16& hr1, f32x16& hi0, f32x16& hi1,
                                        const f32x16& ar0, const f32x16& ar1, const f32x16& ai0, const f32x16& ai1, const float (&dk)[8], bf16* gout) {
    const LAS bf16x8v* a1 = (const LAS bf16x8v*)(L + S5L_BF1) + lane;
    { const f32x16 cr = ar0 * hr0 - ai0 * hi0, ci = ar0 * hi0 + ai0 * hr0; hr0 = MFMA32(a1[0], u, cr); hi0 = MFMA32(a1[128], u, ci); }
    asm volatile("" : "+v"(hr0), "+v"(hi0));
    { const f32x16 cr = ar1 * hr1 - ai1 * hi1, ci = ar1 * hi1 + ai1 * hr1; hr1 = MFMA32(a1[64], u, cr); hi1 = MFMA32(a1[192], u, ci); }
    if (SECOND) {
        const LAS bf16x8v* a2 = (const LAS bf16x8v*)(L + S5L_BF2) + lane;
        f32x16 y;
#pragma unroll
        for (int i = 0; i < 16; ++i) y[i] = 0.f;
        y = MFMA32(a2[0 * 64], pack8(hr0, 0), y); y = MFMA32(a2[1 * 64], pack8(hr0, 1), y);
        y = MFMA32(a2[2 * 64], pack8(hr1, 0), y); y = MFMA32(a2[3 * 64], pack8(hr1, 1), y);
        y = MFMA32(a2[4 * 64], pack8(hi0, 0), y); y = MFMA32(a2[5 * 64], pack8(hi0, 1), y);
        y = MFMA32(a2[6 * 64], pack8(hi1, 0), y); y = MFMA32(a2[7 * 64], pack8(hi1, 1), y);
        const v4u uw = __builtin_bit_cast(v4u, u);
        float o[8];
        o[0] = gelu_tanh(y[0] + dk[0] * pg8::bf_lo(uw.x)); o[1] = gelu_tanh(y[1] + dk[1] * pg8::bf_hi(uw.x));
        o[2] = gelu_tanh(y[2] + dk[2] * pg8::bf_lo(uw.y)); o[3] = gelu_tanh(y[3] + dk[3] * pg8::bf_hi(uw.y));
        o[4] = gelu_tanh(y[4] + dk[4] * pg8::bf_lo(uw.z)); o[5] = gelu_tanh(y[5] + dk[5] * pg8::bf_hi(uw.z));
        o[6] = gelu_tanh(y[6] + dk[6] * pg8::bf_lo(uw.w)); o[7] = gelu_tanh(y[7] + dk[7] * pg8::bf_hi(uw.w));
        v4u w; w.x = pkbf(o[0], o[1]); w.y = pkbf(o[2], o[3]); w.z = pkbf(o[4], o[5]); w.w = pkbf(o[6], o[7]);
        pg8::st16_wt(gout, w);
    }
}
__device__ __forceinline__ void s5_item_fast(Frame& F, const Args& A, int b, int g) {
    refresh(F);
    const int lane = F.lane, q = lane & 31, hh = lane >> 5, w = F.wave, c = w * 32 + q;
    LAS unsigned char* L = F.lds + RING_OFF;
    const unsigned char* tab = F.ws + WS_TAB;
    const size_t m0 = (size_t)b * TP + (size_t)8 * c;
    const bf16* zrow = (const bf16*)(F.ws + WS_Z) + m0 * NZ + 2 * WA + g * KS5 + 8 * hh;
    bf16* grow = (bf16*)(F.ws + WS_G) + m0 * WB + g * KS5 + 8 * hh;
    LAS v4u* UL = (LAS v4u*)(L + S5L_U) + F.tid;
    {
        v4u uu[8];
#pragma unroll
        for (int j = 0; j < 8; ++j) uu[j] = *(const v4u*)(zrow + (size_t)j * NZ);
        const v4u* s1 = (const v4u*)(tab + TB_BF1) + (size_t)g * 256; const v4u* s2 = (const v4u*)(tab + TB_BF2) + (size_t)g * 512;
        if (F.tid < 256) ((LAS v4u*)(L + S5L_BF1))[F.tid] = s1[F.tid];
        ((LAS v4u*)(L + S5L_BF2))[F.tid] = s2[F.tid];
        const v4u* s3 = (const v4u*)(tab + TB_ZP) + (size_t)g * (17 * 128 / 4); for (int e = F.tid; e < 17 * 128 / 4; e += NWAVES * 64) ((LAS v4u*)(L + S5L_ZP))[e] = s3[e];
        if (F.tid < 32) ((LAS v4u*)(L + S5L_TA))[F.tid] = ((const v4u*)(tab + TB_TA) + (size_t)g * 32)[F.tid];
#pragma unroll
        for (int j = 0; j < 8; ++j) UL[512 * j] = uu[j];
    }
    __syncthreads();
    const LAS float* TA = (const LAS float*)(L + S5L_TA) + hh * 64;
    f32x16 ar0 = ld16l(TA), ar1 = ld16l(TA + 16), ai0 = ld16l(TA + 32), ai1 = ld16l(TA + 48);
    f32x16 hr0, hr1, hi0, hi1;
#pragma unroll
    for (int i = 0; i < 16; ++i) { hr0[i] = 0.f; hr1[i] = 0.f; hi0[i] = 0.f; hi1[i] = 0.f; }
    float dk[8];
#pragma unroll
    for (int i = 0; i < 8; ++i) dk[i] = A.in[I_S5D][g * KS5 + 8 * hh + i];
#pragma unroll 1
    for (int j = 0; j < 8; ++j) { const bf16x8v u = __builtin_bit_cast(bf16x8v, UL[512 * j]);
        s5_step<false>(L, lane, u, hr0, hr1, hi0, hi1, ar0, ar1, ai0, ai1, dk, nullptr); }
    const LAS float* ZP = (const LAS float*)(L + S5L_ZP);
#define S5_SCAN(E, CTRL) do { const LAS float* z = ZP + (((E) * 2 + hh) * 2) * 32; \
        { const f32x16 zr = ld16l(z), zi = ld16l(z + 32); s5_scan_step<CTRL>(hr0, hi0, zr, zi); } \
        asm volatile("" : "+v"(hr0), "+v"(hi0) :: "memory"); \
        { const f32x16 zr = ld16l(z + 16), zi = ld16l(z + 48); s5_scan_step<CTRL>(hr1, hi1, zr, zi); } \
        asm volatile("" : "+v"(hr1), "+v"(hi1) :: "memory"); } while (0)
    S5_SCAN(1, 0x111); S5_SCAN(2, 0x112); S5_SCAN(4, 0x114); S5_SCAN(8, 0x118);
#undef S5_SCAN
    const int seg = w * 2 + (q >> 4);
    LAS float* TOT = (LAS float*)(L + S5L_TOT); LAS float* CAR = (LAS float*)(L + S5L_CAR);
    if ((lane & 15) == 15) {
#pragma unroll
        for (int rho = 0; rho < 4; ++rho) {
            *(LAS f32x4*)(TOT + (seg * 2 + 0) * 64 + 0 + 8 * rho + 4 * hh) = (f32x4){hr0[4 * rho], hr0[4 * rho + 1], hr0[4 * rho + 2], hr0[4 * rho + 3]};
            *(LAS f32x4*)(TOT + (seg * 2 + 0) * 64 + 32 + 8 * rho + 4 * hh) = (f32x4){hr1[4 * rho], hr1[4 * rho + 1], hr1[4 * rho + 2], hr1[4 * rho + 3]};
            *(LAS f32x4*)(TOT + (seg * 2 + 1) * 64 + 0 + 8 * rho + 4 * hh) = (f32x4){hi0[4 * rho], hi0[4 * rho + 1], hi0[4 * rho + 2], hi0[4 * rho + 3]};
            *(LAS f32x4*)(TOT + (seg * 2 + 1) * 64 + 32 + 8 * rho + 4 * hh) = (f32x4){hi1[4 * rho], hi1[4 * rho + 1], hi1[4 * rho + 2], hi1[4 * rho + 3]}; }
    }
    __syncthreads();
    if (F.tid < 64) {
        const float* z16 = (const float*)(tab + TB_Z16N) + (size_t)g * 128; const float zr = z16[F.tid], zi = z16[64 + F.tid];
        float cr = 0.f, ci = 0.f;
#pragma unroll
        for (int sg = 0; sg < 16; ++sg) { CAR[(sg * 2 + 0) * 64 + F.tid] = cr; CAR[(sg * 2 + 1) * 64 + F.tid] = ci;
            const float tr = TOT[(sg * 2 + 0) * 64 + F.tid], ti = TOT[(sg * 2 + 1) * 64 + F.tid];
            const float ncr = zr * cr - zi * ci + tr, nci = zr * ci + zi * cr + ti; cr = ncr; ci = nci; }
    }
    __syncthreads();
    {
        const LAS float* z = ZP + (((q & 15) * 2 + hh) * 2) * 32;
#define S5_EXCL(HR, HI, OFF) do { const f32x16 zr = ld16l(z + (OFF)), zi = ld16l(z + 32 + (OFF)); f32x16 kr, ki; \
        _Pragma("unroll") for (int rho = 0; rho < 4; ++rho) { \
            const f32x4 a0 = *(const LAS f32x4*)(CAR + (seg * 2 + 0) * 64 + 2 * (OFF) + 8 * rho + 4 * hh), b0 = *(const LAS f32x4*)(CAR + (seg * 2 + 1) * 64 + 2 * (OFF) + 8 * rho + 4 * hh); \
            _Pragma("unroll") for (int e = 0; e < 4; ++e) { kr[4 * rho + e] = a0[e]; ki[4 * rho + e] = b0[e]; } } \
        _Pragma("unroll") for (int i = 0; i < 16; ++i) { const float sr = dppf<0x111>(0.f, HR[i]), si = dppf<0x111>(0.f, HI[i]); \
            HR[i] = sr + zr[i] * kr[i] - zi[i] * ki[i]; HI[i] = si + zr[i] * ki[i] + zi[i] * kr[i]; } } while (0)
        S5_EXCL(hr0, hi0, 0); asm volatile("" : "+v"(hr0), "+v"(hi0) :: "memory"); S5_EXCL(hr1, hi1, 16); asm volatile("" : "+v"(hr1), "+v"(hi1) :: "memory");
#undef S5_EXCL
    }
    { int off = 0; asm volatile("" : "+v"(off)); const LAS float* TA2 = TA + off; ar0 = ld16l(TA2); ar1 = ld16l(TA2 + 16); ai0 = ld16l(TA2 + 32); ai1 = ld16l(TA2 + 48); }
#pragma unroll 1
    for (int j = 0; j < 8; ++j) { const bf16x8v u = __builtin_bit_cast(bf16x8v, UL[512 * j]);
        s5_step<true>(L, lane, u, hr0, hr1, hi0, hi1, ar0, ar1, ai0, ai1, dk, grow + (size_t)j * WB); }
    if (w == NWAVES - 1 && q == 31) {
        float* osr = F.out + O_SRP + (size_t)(b * GB + g) * NS5; float* osi = F.out + O_SIP + (size_t)(b * GB + g) * NS5;
#pragma unroll
        for (int i = 0; i < 16; ++i) { const int n = (i & 3) + 8 * (i >> 2) + 4 * hh; osr[n] = hr0[i]; osr[32 + n] = hr1[i]; osi[n] = hi0[i]; osi[32 + n] = hi1[i]; }
    }
    __syncthreads();
}

__device__ __forceinline__ void s5_item_sample(Frame& F, const Args& A, int g) {
    refresh(F);
    const int lane = F.lane, q = lane & 31, hh = lane >> 5, w = F.wave;
    LAS unsigned char* L = F.lds + RING_OFF;
    const unsigned char* tab = F.ws + WS_TAB;
    { const v4u* s1 = (const v4u*)(tab + TB_BF1) + (size_t)g * 256; const v4u* s2 = (const v4u*)(tab + TB_BF2) + (size_t)g * 512;
      if (F.tid < 256) ((LAS v4u*)(L + S5L_BF1))[F.tid] = s1[F.tid];
      ((LAS v4u*)(L + S5L_BF2))[F.tid] = s2[F.tid]; }
    __syncthreads();
    if (w < 4) {
        const int b = w * 32 + q;
        const float* TA = (const float*)(tab + TB_TA) + (size_t)((g * 2 + hh) * 2) * 32;
        const f32x16 ar0 = ld16(TA), ar1 = ld16(TA + 16), ai0 = ld16(TA + 32), ai1 = ld16(TA + 48);
        f32x16 hr0, hr1, hi0, hi1;
        const float* sr = A.in[I_SSR] + (size_t)(b * GB + g) * NS5; const float* si = A.in[I_SSI] + (size_t)(b * GB + g) * NS5;
#pragma unroll
        for (int rho = 0; rho < 4; ++rho) { const f32x4 a0 = *(const f32x4*)(sr + 8 * rho + 4 * hh), a1 = *(const f32x4*)(sr + 32 + 8 * rho + 4 * hh), b0 = *(const f32x4*)(si + 8 * rho + 4 * hh), b1 = *(const f32x4*)(si + 32 + 8 * rho + 4 * hh);
#pragma unroll
            for (int e = 0; e < 4; ++e) { hr0[4 * rho + e] = a0[e]; hr1[4 * rho + e] = a1[e]; hi0[4 * rho + e] = b0[e]; hi1[4 * rho + e] = b1[e]; } }
        float dk[8];
#pragma unroll
        for (int i = 0; i < 8; ++i) dk[i] = A.in[I_S5D][g * KS5 + 8 * hh + i];
        const size_t m0 = (size_t)MP + (size_t)b * TS;
        const bf16* zrow = (const bf16*)(F.ws + WS_Z) + m0 * NZ + 2 * WA + g * KS5 + 8 * hh;
        bf16* grow = (bf16*)(F.ws + WS_G) + m0 * WB + g * KS5 + 8 * hh;
        bf16x8v uu[TS];
#pragma unroll
        for (int j = 0; j < TS; ++j) uu[j] = *(const bf16x8v*)(zrow + (size_t)j * NZ);
#pragma unroll
        for (int j = 0; j < TS; ++j) s5_step<true>(L, lane, uu[j], hr0, hr1, hi0, hi1, ar0, ar1, ai0, ai1, dk, grow + (size_t)j * WB);
        float* osr = F.out + O_SRS + (size_t)(b * GB + g) * NS5; float* osi = F.out + O_SIS + (size_t)(b * GB + g) * NS5;
#pragma unroll
        for (int rho = 0; rho < 4; ++rho) {
            *(f32x4*)(osr + 8 * rho + 4 * hh) = (f32x4){hr0[4 * rho], hr0[4 * rho + 1], hr0[4 * rho + 2], hr0[4 * rho + 3]};
            *(f32x4*)(osr + 32 + 8 * rho + 4 * hh) = (f32x4){hr1[4 * rho], hr1[4 * rho + 1], hr1[4 * rho + 2], hr1[4 * rho + 3]};
            *(f32x4*)(osi + 8 * rho + 4 * hh) = (f32x4){hi0[4 * rho], hi0[4 * rho + 1], hi0[4 * rho + 2], hi0[4 * rho + 3]};
            *(f32x4*)(osi + 32 + 8 * rho + 4 * hh) = (f32x4){hi1[4 * rho], hi1[4 * rho + 1], hi1[4 * rho + 2], hi1[4 * rho + 3]}; }
    }
    __syncthreads();
}

template <int CTRL, int RMASK> __device__ __forceinline__ float dppm(float old, float v) { return __builtin_bit_cast(float, __builtin_amdgcn_update_dpp(__builtin_bit_cast(int, old), __builtin_bit_cast(int, v), CTRL, RMASK, 0xF, false)); }
template <int CTRL, int RMASK> __device__ __forceinline__ void rg_scan_step(f32x16& a, f32x16& b) {
#pragma unroll
    for (int i = 0; i < 16; ++i) { const float as = dppm<CTRL, RMASK>(1.f, a[i]), bs = dppm<CTRL, RMASK>(0.f, b[i]); b[i] = a[i] * bs + b[i]; a[i] = a[i] * as; }
}
constexpr int RGL_AFR = 0, RGL_DG = 8192, RGL_TOT = 24576, RGL_CST = 28672;
constexpr int RGL_XAP = 144;
constexpr int RGL_XA0 = 29696, RGL_BUF = 37376;
static_assert(259 * RGL_XAP <= RGL_BUF && RGL_XA0 + 2 * RGL_BUF <= RING_BYTES && RGL_CST + 640 <= RGL_XA0, "RG-LRU LDS map");
template <bool SAMPLE>
__device__ __forceinline__ void rg_item_fast(Frame& F, const Args& A, int b, int hd, int jh) {
    refresh(F);
    const int lane = F.lane, q = lane & 31, hh = lane >> 5, w = F.wave;
    LAS unsigned char* L = F.lds + RING_OFF;
    const float* sc = (const float*)(F.ws + WS_S5C);
    const bf16* Zb = (const bf16*)(F.ws + WS_Z) + (size_t)(SAMPLE ? MP : b * TP) * NZ; bf16* Yb = (bf16*)(F.ws + WS_YCAT) + (size_t)(SAMPLE ? MP : b * TP) * D;
    const bf16* CB = (const bf16*)(F.ws + WS_TAB + TB_CB);
    auto stage_load = [&](int T0, v4u (&st)[5]) {
#pragma unroll
        for (int k = 0; k < 5; ++k) { const int ci = F.tid + 512 * k; v4u v = (v4u){0u, 0u, 0u, 0u};
            if (ci < 2072) { const int tk = T0 - 3 + (ci >> 3); if (tk >= 0) v = *(const v4u*)(Zb + (size_t)tk * NZ + WA + hd * 64 + (ci & 7) * 8); }
            st[k] = v; } };
    auto stage_write = [&](int par, const v4u (&st)[5]) {
#pragma unroll
        for (int k = 0; k < 5; ++k) { const int ci = F.tid + 512 * k;
            if (ci < 2072) *(LAS v4u*)(L + RGL_XA0 + par * RGL_BUF + (ci >> 3) * RGL_XAP + (ci & 7) * 16) = st[k]; } };
    {
        const v4u* src = (const v4u*)(F.ws + WS_TAB + TB_RG) + (size_t)((hd * 2 + jh) * 8) * 64;
        ((LAS v4u*)(L + RGL_AFR))[F.tid] = src[F.tid];
        const v4u* sd = (const v4u*)(F.ws + WS_TAB + TB_DG) + (size_t)(hd * 16) * 64;
        ((LAS v4u*)(L + RGL_DG))[F.tid] = sd[F.tid]; ((LAS v4u*)(L + RGL_DG))[512 + F.tid] = sd[512 + F.tid];
        if (F.tid < 160) { const int h2 = F.tid / 80, kind = (F.tid % 80) / 16, i = F.tid % 16, cr = (i & 3) + 8 * (i >> 2) + 4 * h2;
            const int c = hd * 64 + 32 * jh + cr;
            ((LAS float*)(L + RGL_CST))[F.tid] = kind == 0 ? A.in[I_RGBR][c] : kind == 1 ? A.in[I_RGBI][c] : kind == 2 ? sc[SC_RGL + c] : A.in[I_CONVB][hd * 64 + 32 * (kind - 3) + cr]; }
        if (!SAMPLE && jh == 0 && F.tid < 192) { const int k = F.tid >> 6, ch = F.tid & 63;
            F.out[O_CONVP + (size_t)(b * 3 + k) * WA + hd * 64 + ch] = bf2f(((const bf16*)(F.ws + WS_Z))[(size_t)(b * TP + TP - 3 + k) * NZ + WA + hd * 64 + ch]); }
        if (SAMPLE && jh == 0) { for (int e = F.tid; e < NBS * 3 * 64; e += NWAVES * 64) { const int bb = e / 192, k = (e / 64) % 3, ch = e & 63;
            F.out[O_CONVS + (size_t)(bb * 3 + k) * WA + hd * 64 + ch] = bf2f(((const bf16*)(F.ws + WS_Z))[(size_t)(MP + bb * TS + 1 + k) * NZ + WA + hd * 64 + ch]); } }
        if (!SAMPLE) { v4u st[5]; stage_load(0, st); stage_write(0, st); }
    }
    __syncthreads();
    float hround[16];
#pragma unroll
    for (int i = 0; i < 16; ++i) hround[i] = 0.f;
    const LAS float* CST = (const LAS float*)(L + RGL_CST) + hh * 80;
    const LAS bf16x8v* af = (const LAS bf16x8v*)(L + RGL_AFR) + lane;
    const LAS bf16x8v* dg = (const LAS bf16x8v*)(L + RGL_DG) + lane;
#pragma unroll 1
    for (int rd = 0; rd < (SAMPLE ? 2 : 8); ++rd) {
        const int t = rd * 256 + w * 32 + q;
        v4u stn[5];
        if (!SAMPLE) stage_load((rd + 1) * 256, stn);
        const LAS unsigned char* XAp = L + RGL_XA0 + (rd & 1) * RGL_BUF + (w * 32 + q) * RGL_XAP + 16 * hh;
        const bf16* zsr[4];
        if (SAMPLE) {
#pragma unroll
            for (int k = 0; k < 4; ++k) { const int jx = (t & 3) + k; zsr[k] = (jx < 3 ? CB + (size_t)((t >> 2) * 3 + jx) * WA : Zb + (size_t)(t - 3 + k) * NZ + WA) + hd * 64 + 8 * hh; } }
        const bf16* gr = Zb + (size_t)t * NZ + hd * 64 + 32 * jh + 4 * hh;
        unsigned long long gq[4];
#pragma unroll
        for (int rho = 0; rho < 4; ++rho) gq[rho] = *(const unsigned long long*)(gr + 8 * rho);
        f32x16 dx0, dx1;
        { const f32x4 c0 = *(const LAS f32x4*)(CST + 48), c1 = *(const LAS f32x4*)(CST + 52), c2 = *(const LAS f32x4*)(CST + 56), c3 = *(const LAS f32x4*)(CST + 60);
          const f32x4 e0 = *(const LAS f32x4*)(CST + 64), e1 = *(const LAS f32x4*)(CST + 68), e2 = *(const LAS f32x4*)(CST + 72), e3 = *(const LAS f32x4*)(CST + 76);
#pragma unroll
          for (int e = 0; e < 4; ++e) { dx0[e] = c0[e]; dx0[4 + e] = c1[e]; dx0[8 + e] = c2[e]; dx0[12 + e] = c3[e]; dx1[e] = e0[e]; dx1[4 + e] = e1[e]; dx1[8 + e] = e2[e]; dx1[12 + e] = e3[e]; } }
#pragma unroll
        for (int k = 0; k < 4; ++k)
#pragma unroll
            for (int s4 = 0; s4 < 4; ++s4) {
                const bf16x8v xb = SAMPLE ? *(const bf16x8v*)(zsr[k] + 16 * s4) : *(const LAS bf16x8v*)(XAp + k * RGL_XAP + s4 * 32);
                if (s4 < 2) dx0 = MFMA32(dg[((0 * 2 + (s4 & 1)) * 4 + k) * 64], xb, dx0); else dx1 = MFMA32(dg[((1 * 2 + (s4 & 1)) * 4 + k) * 64], xb, dx1);
                if (s4 == 3) asm volatile("" : "+v"(dx0), "+v"(dx1) :: "memory"); }
        f32x16 dr, di;
#pragma unroll
        for (int i = 0; i < 16; ++i) { dr[i] = 0.f; di[i] = 0.f; }
        { const bf16x8v b00 = pack8(dx0, 0), b01 = pack8(dx0, 1), b10 = pack8(dx1, 0), b11 = pack8(dx1, 1);
          dr = MFMA32(af[0 * 64], b00, dr); di = MFMA32(af[4 * 64], b00, di); dr = MFMA32(af[1 * 64], b01, dr); di = MFMA32(af[5 * 64], b01, di);
          dr = MFMA32(af[2 * 64], b10, dr); di = MFMA32(af[6 * 64], b10, di); dr = MFMA32(af[3 * 64], b11, dr); di = MFMA32(af[7 * 64], b11, di); }
        f32x16 av, bv;
        const bool first = !SAMPLE && (t == 0);
#pragma unroll
        for (int i = 0; i < 16; ++i) { const float xcv = jh ? dx1[i] : dx0[i];
            const float r = sigmoidf_(dr[i] + CST[i]), gi = sigmoidf_(di[i] + CST[16 + i]);
            const float a = __builtin_amdgcn_exp2f(r * CST[32 + i]);
            float mult = __builtin_amdgcn_sqrtf(fmaxf(1.f - a * a, 0.f)); if (first) mult = 1.f;
            av[i] = a; bv[i] = mult * gi * xcv; }
        if (SAMPLE && (t & 3) == 0) {
            const float* h0 = A.in[I_SH] + (size_t)(t >> 2) * WA + hd * 64 + 32 * jh + 4 * hh;
#pragma unroll
            for (int i = 0; i < 16; ++i) { bv[i] += av[i] * h0[(i & 3) + 8 * (i >> 2)]; av[i] = 0.f; } }
        rg_scan_step<0x111, 0xF>(av, bv); rg_scan_step<0x112, 0xF>(av, bv); rg_scan_step<0x114, 0xF>(av, bv); rg_scan_step<0x118, 0xF>(av, bv);
        rg_scan_step<0x142, 0xA>(av, bv);
        float hin[16];
#pragma unroll
        for (int i = 0; i < 16; ++i) hin[i] = 0.f;
        if (!SAMPLE) {
        LAS float* TOT = (LAS float*)(L + RGL_TOT) + (rd & 1) * 512;
        if (q == 31) {
#pragma unroll
            for (int i4 = 0; i4 < 4; ++i4) { *(LAS f32x4*)(TOT + (w * 2 + 0) * 32 + hh * 16 + 4 * i4) = (f32x4){av[4 * i4], av[4 * i4 + 1], av[4 * i4 + 2], av[4 * i4 + 3]};
                                             *(LAS f32x4*)(TOT + (w * 2 + 1) * 32 + hh * 16 + 4 * i4) = (f32x4){bv[4 * i4], bv[4 * i4 + 1], bv[4 * i4 + 2], bv[4 * i4 + 3]}; }
        }
        stage_write((rd + 1) & 1, stn);
        __syncthreads();
#pragma unroll
        for (int w2 = 0; w2 < 8; ++w2) {
            if (w2 == w) {
#pragma unroll
                for (int i = 0; i < 16; ++i) hin[i] = hround[i]; }
#pragma unroll
            for (int i4 = 0; i4 < 4; ++i4) { const f32x4 p = *(const LAS f32x4*)(TOT + (w2 * 2 + 0) * 32 + hh * 16 + 4 * i4), hl = *(const LAS f32x4*)(TOT + (w2 * 2 + 1) * 32 + hh * 16 + 4 * i4);
#pragma unroll
                for (int e = 0; e < 4; ++e) hround[4 * i4 + e] = p[e] * hround[4 * i4 + e] + hl[e]; }
        }
        }
        bf16* yr = Yb + (size_t)t * D + hd * 64 + 32 * jh + 4 * hh;
#pragma unroll
        for (int rho = 0; rho < 4; ++rho) { const unsigned glo = (unsigned)gq[rho], ghi = (unsigned)(gq[rho] >> 32);
            const float o0 = gelu_tanh(pg8::bf_lo(glo)) * (bv[4 * rho] + av[4 * rho] * hin[4 * rho]), o1 = gelu_tanh(pg8::bf_hi(glo)) * (bv[4 * rho + 1] + av[4 * rho + 1] * hin[4 * rho + 1]);
            const float o2 = gelu_tanh(pg8::bf_lo(ghi)) * (bv[4 * rho + 2] + av[4 * rho + 2] * hin[4 * rho + 2]), o3 = gelu_tanh(pg8::bf_hi(ghi)) * (bv[4 * rho + 3] + av[4 * rho + 3] * hin[4 * rho + 3]);
            *(unsigned long long*)(yr + 8 * rho) = (unsigned long long)pkbf(o0, o1) | ((unsigned long long)pkbf(o2, o3) << 32); }
        if (SAMPLE && (t & 3) == 3) {
#pragma unroll
            for (int i = 0; i < 16; ++i) F.out[O_HS + (size_t)(t >> 2) * WA + hd * 64 + 32 * jh + (i & 3) + 8 * (i >> 2) + 4 * hh] = bv[i]; }
    }
    if (!SAMPLE && w == 0 && q == 0) {
#pragma unroll
        for (int i = 0; i < 16; ++i) F.out[O_HP + (size_t)b * WA + hd * 64 + 32 * jh + (i & 3) + 8 * (i >> 2) + 4 * hh] = hround[i];
    }
    __syncthreads();
}

#ifndef PROBE_P3PART
#define PROBE_P3PART 7
#endif
__device__ __forceinline__ void p3_mixers_ref(Frame& F, const Args& A, int rep = 0) {
    constexpr int N_RGP = NBP * HA, N_S5P = NBP * GB;
    const int pm = rep ? PROBE_P3PART : 7;
    bf16* GY = (bf16*)(F.ws + WS_G); bf16* YC = (bf16*)(F.ws + WS_YCAT);
    pg8::Gemm gg{GY, (const bf16*)(F.ws + WS_WGLU), M, WB, WB}; pg8::EpiGlu EG{GY, WB, YC, D, WA, A.in[I_GLUB]};
    pg8::OneUnit SG; SG.u0.pm = 0; SG.u0.pn = 0; SG.u0.k0 = 0; SG.u0.nkt = WB / 64; SG.u0.ks = 0; bool has_glu = false;
    if (F.vcu < 2 * N_RGP) {
        if ((pm & 4) && F.vcu < GB) { s5_item_sample(F, A, F.vcu); cnt_arrive_wt(F, CW_S5B + 64 * NBP); }
        if (pm & 1) rg_item_fast<false>(F, A, F.vcu / (2 * HA), (F.vcu / 2) % HA, F.vcu & 1);
        if (pm & 4) { if (F.vcu < GB) { }
                      else if (F.vcu < GB + 2 * HA) rg_item_fast<true>(F, A, 0, (F.vcu - GB) >> 1, (F.vcu - GB) & 1);
                      else if (F.vcu < GB + 2 * HA + 4) {
                          cnt_wait_ge(F, CW_S5B + 64 * NBP, (unsigned)GB); const int u = F.vcu - GB - 2 * HA; SG.u0.pm = MP / 256 + (u >> 1); SG.u0.pn = u & 1; has_glu = true; } }
    } else {
        const int v = F.vcu - 2 * N_RGP, it = 2 * v, bb = it / GB;
        if (pm & 2) { s5_item_fast(F, A, bb, it % GB);
                      s5_item_fast(F, A, bb, (it + 1) % GB);
                      cnt_arrive_wt(F, CW_S5B + 64 * bb);
                      cnt_wait_ge(F, CW_S5B + 64 * bb, 16u);
                      const int u = v & 15; SG.u0.pm = 8 * bb + (u >> 1); SG.u0.pn = u & 1; has_glu = true; }
    }
    if (has_glu) pg8::gemm_phase<pg8::EpiGlu, pg8::OneUnit, false, PG8_SP2>(F.lds + RING_OFF, gg, SG, EG);
    if (rep == 0) xpose_range(F, A, XO_2, XO_END, 0);
}

template <bool SECOND>
__device__ __forceinline__ void ln_phase(Frame& F, const Args& A, int rep) {
    pg8::StaticOrder P; P.init(MP, D, F.G, (int)blockIdx.x, D); pg8::Unit u; P.next(0, u);
    cnt_wait_ge(F, (SECOND ? CW_T2 : CW_T1) + 64 * u.pm, 4u);
    ln_rows<SECOND>(F, A, u.pm * 256 + u.pn * 64, u.pm * 256 + u.pn * 64 + 64, F.wave, NWAVES);
    constexpr int NPC = 2 * (D / 256) * (SECOND ? NS_DOWN : NS_OUT);
    const int si = (int)blockIdx.x - (F.G - NPC);
    if (si >= 0) { cnt_wait_ge(F, SECOND ? CW_T2S : CW_T1S, (unsigned)NPC);
        ln_rows<SECOND>(F, A, MP + si * (MS / NPC), MP + (si + 1) * (MS / NPC), F.wave, NWAVES); }
}
__global__ void __launch_bounds__(NWAVES * 64, 2) fwd(Args A) {
    extern __shared__ __attribute__((aligned(16))) unsigned char lds[];
    Frame F;
    F.lds = (LAS unsigned char*)lds;
    F.MISC = (volatile LAS unsigned*)(F.lds + MISC_OFF);
    F.tid = threadIdx.x; F.lane = F.tid & 63; F.wave = __builtin_amdgcn_readfirstlane(F.tid >> 6);
    F.G = gridDim.x; { const int bx = blockIdx.x; F.vcu = (F.G % 8 == 0) ? (bx % 8) * (F.G / 8) + bx / 8 : bx; }
    F.out = A.out; F.ws = A.ws; F.ctl = (gu32*)(A.ws + WS_CTL);
    for (int u = F.tid; u < (LDS_BYTES - LDSCTL_OFF) / 4; u += NWAVES * 64) ((LAS unsigned*)(F.lds + LDSCTL_OFF))[u] = 0u;
    __syncthreads();
    XcdBarrier bar; bar.bar = (unsigned*)(F.ctl + CW_BAR); bar.x = 0; bar.st = nullptr;
    if (N_LAUNCHES == 1) bar = xcd_barrier_post((unsigned*)(F.ctl + CW_BAR), F.MISC + 8);
#define GRID_BAR() do { if (N_LAUNCHES == 1) xcd_barrier(bar); } while (0)
    const int lo = A.ph_lo, hi = A.ph_hi;
#define IN(k) (lo <= (k) && (k) < hi)
#define BOTH(k) (IN(k) && IN((k) + 1))
    bf16* XN = (bf16*)(F.ws + WS_XN); bf16* Z = (bf16*)(F.ws + WS_Z); bf16* YC = (bf16*)(F.ws + WS_YCAT); bf16* GY = (bf16*)(F.ws + WS_G); bf16* U = (bf16*)(F.ws + WS_U);
    const float* mod = (const float*)(F.ws + WS_MOD);

#define REPS(k) (((PROBE_DUP) >> (k)) & 1 ? 2 : 1)
#define PH0(rep) p0_prologue(F, A, rep)
#define PH1(rep) p1_modulate(F, A, rep)
#define PH2(rep) do {     \
        pg8::Gemm g{XN, (const bf16*)(F.ws + WS_WIN), M, NZ, D}; pg8::StaticOrder S; S.init(M, NZ, F.G, (int)blockIdx.x, D); \
        pg8::EpiBf16<0> E{Z, NZ, nullptr}; \
        pg8::gemm_phase<pg8::EpiBf16<0>, pg8::StaticOrder, PG8_ALIGN, PG8_SP2>(F.lds + RING_OFF, g, S, E); \
        if ((rep) == 0 && (int)blockIdx.x >= (M / 256) * (NZ / 256) - F.G) { __syncthreads(); xpose_range_b(F, A, XO_OU, XO_2, (M / 256) * (NZ / 256) - F.G); } } while (0)
#define PH3(rep) p3_mixers_ref(F, A, rep)
#define PH4(rep) do { } while (0)
#define PH5(rep) do {     \
        pg8::Gemm g{YC, (const bf16*)(F.ws + WS_WOUT), M, D, D}; pg8::SplitOrder S; S.init(MP, D, F.G, (int)blockIdx.x, D, NS_OUT); \
        pg8::EpiRes<false> E{A.in[I_XP], (bf16*)(F.ws + WS_T1), mod + 2 * D, nullptr, ALPHA, MP, (float*)(F.ws + WS_SLAB)}; \
        pg8::gemm_phase<pg8::EpiRes<false>, pg8::SplitOrder, PG8_ALIGN, PG8_SP2>(F.lds + RING_OFF, g, S, E); \
        { pg8::Unit u0; S.P.next(0, u0); cnt_arrive_wt(F, CW_T1 + 64 * u0.pm); if ((int)blockIdx.x >= F.G - S.nP) cnt_arrive_wt(F, CW_T1S); } } while (0)
#define PH6(rep) ln_phase<false>(F, A, rep)
#define PH7(rep) do {     \
        pg8::Gemm g{XN, (const bf16*)(F.ws + WS_W1), M, FF, D}; pg8::StaticOrder S; S.init(M, FF, F.G, (int)blockIdx.x, D); \
        pg8::EpiBf16<3> E{U, FF, A.in[I_B1]}; \
        pg8::gemm_phase<pg8::EpiBf16<3>, pg8::StaticOrder, PG8_ALIGN, PG8_SP2>(F.lds + RING_OFF, g, S, E); } while (0)
#define PH8(rep) do {     \
        pg8::Gemm g{U, (const bf16*)(F.ws + WS_W2), M, D, FF}; pg8::SplitOrder S; S.init(MP, D, F.G, (int)blockIdx.x, FF, NS_DOWN); \
        pg8::EpiRes<true> E{(const bf16*)(F.ws + WS_X1B), (bf16*)(F.ws + WS_T2), mod + 5 * D, A.in[I_B2], ALPHA, MP, (float*)(F.ws + WS_SLAB)}; \
        pg8::gemm_phase<pg8::EpiRes<true>, pg8::SplitOrder, PG8_ALIGN, PG8_SP2>(F.lds + RING_OFF, g, S, E); \
        { pg8::Unit u0; S.P.next(0, u0); cnt_arrive_wt(F, CW_T2 + 64 * u0.pm); if ((int)blockIdx.x >= F.G - S.nP) cnt_arrive_wt(F, CW_T2S); } } while (0)
#define RUNNB(k, PH) do { if (IN(k)) { PH(0); if (REPS(k) == 2) { __syncthreads(); PH(1); } } } while (0)
#define RUN(k, PH) do { if (IN(k)) { PH(0); if (REPS(k) == 2) { __syncthreads(); PH(1); } if (BOTH(k)) GRID_BAR(); } } while (0)
    if (IN(0)) { PH0(0); if (REPS(0) == 2) { __syncthreads(); PH0(1); } if (IN(0) && !IN(1)) { } }
    RUN(1, PH1); RUN(2, PH2); RUN(3, PH3); RUNNB(5, PH5); RUN(6, PH6); RUN(7, PH7); RUNNB(8, PH8);
    if (IN(9)) { ln_phase<true>(F, A, 0); }
#undef IN
#undef BOTH
}

extern "C" void kernel_launch(void* const* d_in, const int* in_sizes, int n_in, void* d_out, int out_size, void* d_ws, size_t ws_size, hipStream_t stream) {
    static int grid = 0;
    if (grid == 0) {
        if (n_in != 37 || in_sizes[0] != MP * D || out_size != (int)O_END || ws_size < WS_END) { fprintf(stderr, "kernel_launch: unexpected shapes (n_in %d, in0 %d, out %d, ws %zu)\n", n_in, n_in > 0 ? in_sizes[0] : -1, out_size, ws_size); grid = -1; return; }
        int dev = 0, cus = 0, per_cu = 0;
        if (hipGetDevice(&dev) != hipSuccess || hipDeviceGetAttribute(&cus, hipDeviceAttributeMultiprocessorCount, dev) != hipSuccess) { grid = -1; return; }
        if (hipFuncSetAttribute((const void*)fwd, hipFuncAttributeMaxDynamicSharedMemorySize, LDS_BYTES) != hipSuccess) { fprintf(stderr, "kernel_launch: hipFuncSetAttribute failed\n"); grid = -1; return; }
        if (hipOccupancyMaxActiveBlocksPerMultiprocessor(&per_cu, (const void*)fwd, NWAVES * 64, LDS_BYTES) != hipSuccess || per_cu < 1) { fprintf(stderr, "kernel_launch: occupancy query says %d\n", per_cu); }
        (void)hipGetLastError();
        grid = cus;
        if (grid < 256) { fprintf(stderr, "kernel_launch: this build needs 256 CUs (got %d)\n", grid); grid = -1; return; }
        grid = 256;
    }
    if (grid < 0) return;
    (void)hipMemsetAsync((char*)d_ws + WS_CTL, 0, CTL_ZERO_BYTES, stream);
    Args a{};
    for (int i = 0; i < 37; ++i) a.in[i] = (const float*)d_in[i];
    a.out = (float*)d_out; a.ws = (unsigned char*)d_ws;
    for (int li = 0; li < N_LAUNCHES; ++li) {
        if (N_LAUNCHES == 1) { a.ph_lo = 0; a.ph_hi = N_PHASES; } else { a.ph_lo = li; a.ph_hi = li + 1; }
        a.li = li;
        hipLaunchKernelGGL(fwd, dim3(grid), dim3(NWAVES * 64), LDS_BYTES, stream, a);
    }
}
```

```cpp
#include <hip/hip_runtime.h>
#include <cstdio>
#include <cstdint>
#include <cmath>

#ifndef MK_N_LAUNCHES
#define MK_N_LAUNCHES 1
#endif

namespace pg8 {
#define PG8_LAS __attribute__((address_space(3)))
typedef unsigned short bf16_t;
typedef short bf16x8 __attribute__((ext_vector_type(8)));
typedef float f32x4 __attribute__((ext_vector_type(4)));
typedef unsigned u32x4 __attribute__((ext_vector_type(4)));
constexpr int BM = 256, BK = 64, HALF = 128, HTB = HALF * BK * 2, STAGE_BYTES = 8 * HTB, NXCD = 8, WGM = 8;

__host__ __device__ __forceinline__ int lds_byte(int r, int c) { const int st = (r >> 4) * 2 + (c >> 5), rr = r & 15, cc = c & 31, ob = rr * 64 + cc * 2; return st * 1024 + (ob ^ (((ob >> 9) & 1) << 5)); }
__host__ __device__ __forceinline__ void stage_rc(int b, int& R, int& C) { const int st = b / 1024, sb = b % 1024, swz = sb ^ (((sb >> 9) & 1) << 5); R = (st >> 1) * 16 + swz / 64; C = (st & 1) * 32 + (swz % 64) / 2; }
__host__ __device__ __forceinline__ int perm32(int rho) { const int n = rho >> 4, i = rho & 15; return 8 * (i >> 2) + 4 * n + (i & 3); }

struct Unit { int pm, pn, k0, nkt, ks; };
struct Gemm { const bf16_t* A; const bf16_t* Bt; int M, N, K; };

struct StaticOrder {
    int nM, nN, nwg, G, c, K;
    __host__ __device__ void init(int M, int N, int G_, int c_, int K_) { nM = M / BM; nN = N / BM; nwg = nM * nN; G = G_; c = c_; K = K_; }
    __host__ __device__ __forceinline__ bool next(int i, Unit& u) const {
        const long L = (long)i * G + c; if (L >= nwg) return false;
        int wgid = (int)L; { const int q = nwg / NXCD, r = nwg % NXCD, xcd = wgid % NXCD, off = wgid / NXCD; wgid = (xcd < r ? xcd * (q + 1) : r * (q + 1) + (xcd - r) * q) + off; }
        const int nig = WGM * nN, gid = wgid / nig, fm = gid * WGM, gsz = (nM - fm) < WGM ? (nM - fm) : WGM;
        u.pm = fm + ((wgid % nig) % gsz); u.pn = (wgid % nig) / gsz; u.k0 = 0; u.nkt = K / BK; u.ks = 0; return true;
    }
    __device__ __forceinline__ void a_ready(const Unit&) const {}
    __device__ __forceinline__ void done(const Unit&) const {}
};

struct SplitOrder {
    StaticOrder P; int nN, NS, nP, G, c, K, r0;
    __host__ __device__ void init(int MPr, int N, int G_, int c_, int K_, int NS_) { P.init(MPr, N, G_, c_, K_); nN = N / BM; NS = NS_; nP = 2 * nN * NS; G = G_; c = c_; K = K_; r0 = (P.nwg + G - 1 - c) / G;   }
    __host__ __device__ __forceinline__ bool next(int i, Unit& u) const {
        Unit a; a.pm = 0; a.pn = 0; a.k0 = 0; a.nkt = K / BK; a.ks = 0;
        const bool okp = P.next(i < r0 ? i : 0, a);
        const int p = (i - r0) * G + (G - 1 - c), t = p / NS, ks = p % NS, nk = K / BK / NS;
        const bool split = i >= r0;
        u.pm = split ? P.nM + t / nN : a.pm; u.pn = split ? t % nN : a.pn; u.nkt = split ? nk : a.nkt; u.ks = split ? ks : 0; u.k0 = split ? ks * nk * BK : 0;
        return split ? (p < nP) : okp;
    }
    __device__ __forceinline__ void a_ready(const Unit&) const {}
    __device__ __forceinline__ void done(const Unit&) const {}
};

struct OneUnit {
    Unit u0;
    __host__ __device__ __forceinline__ bool next(int i, Unit& u) const { u = u0; return i == 0; }
    __device__ __forceinline__ void a_ready(const Unit&) const {}
    __device__ __forceinline__ void done(const Unit&) const {}
};
__device__ __forceinline__ void st16_wt(void* p, u32x4 v) { asm volatile("global_store_dwordx4 %0, %1, off sc1\n\ts_nop 1" :: "v"(p), "v"(v)); }
__device__ __forceinline__ void st16f_wt(void* p, f32x4 v) { asm volatile("global_store_dwordx4 %0, %1, off sc1\n\ts_nop 1" :: "v"(p), "v"(v)); }
__device__ __forceinline__ unsigned cvt_pk_bf16(float lo, float hi) { unsigned r; asm volatile("v_cvt_pk_bf16_f32 %0, %1, %2" : "=v"(r) : "v"(lo), "v"(hi)); return r; }
__device__ __forceinline__ float bf_lo(unsigned w) { return __builtin_bit_cast(float, w << 16); }
__device__ __forceinline__ float bf_hi(unsigned w) { return __builtin_bit_cast(float, w & 0xffff0000u); }

template <int ACT> struct EpiBf16 {
    static constexpr bool PERM = true, AFTER_DRAIN = false;
    bf16_t* O; int ldc; const float* bias;
    __device__ __forceinline__ void operator()(const f32x4 (&acc)[2][2][4][2], const Unit& u, int wr, int wc, int fr, int fq) const {
        const int row0 = u.pm * BM + wr * 64 + fr; const int col0 = u.pn * BM + wc * 32 + 8 * fq;
        f32x4 bv[2][2];
#pragma unroll
        for (int bj = 0; bj < 2; ++bj)
#pragma unroll
            for (int n = 0; n < 2; ++n) bv[bj][n] = bias ? *(const f32x4*)(bias + col0 + bj * HALF + 4 * n) : (f32x4){0.f, 0.f, 0.f, 0.f};
#pragma unroll
        for (int ai = 0; ai < 2; ++ai)
#pragma unroll
            for (int m = 0; m < 4; ++m) { bf16_t* rowp = O + (size_t)(row0 + ai * HALF + m * 16) * ldc + col0;
#pragma unroll
                for (int bj = 0; bj < 2; ++bj) { f32x4 v0 = acc[ai][bj][m][0] + bv[bj][0], v1 = acc[ai][bj][m][1] + bv[bj][1];
                    if (ACT == 3) {
#pragma unroll
                        for (int e = 0; e < 4; ++e) { const float a = fmaxf(v0[e], 0.f), b = fmaxf(v1[e], 0.f); v0[e] = a * a; v1[e] = b * b; } }
                    u32x4 w; w.x = cvt_pk_bf16(v0[0], v0[1]); w.y = cvt_pk_bf16(v0[2], v0[3]); w.z = cvt_pk_bf16(v1[0], v1[1]); w.w = cvt_pk_bf16(v1[2], v1[3]);
                    *(u32x4*)(rowp + bj * HALF) = w; } }
    }
};
struct EpiGlu {
    static constexpr bool PERM = true, AFTER_DRAIN = false;
    const bf16_t* Gy; int ldg; bf16_t* O; int ldc; int coff; const float* bias;
    __device__ __forceinline__ void operator()(const f32x4 (&acc)[2][2][4][2], const Unit& u, int wr, int wc, int fr, int fq) const {
        const int row0 = u.pm * BM + wr * 64 + fr; const int col0 = u.pn * BM + wc * 32 + 8 * fq;
        f32x4 bv[2][2];
#pragma unroll
        for (int bj = 0; bj < 2; ++bj)
#pragma unroll
            for (int n = 0; n < 2; ++n) bv[bj][n] = *(const f32x4*)(bias + col0 + bj * HALF + 4 * n);
#pragma unroll
        for (int ai = 0; ai < 2; ++ai)
#pragma unroll
            for (int m = 0; m < 4; ++m) { const size_t row = (size_t)(row0 + ai * HALF + m * 16);
#pragma unroll
                for (int bj = 0; bj < 2; ++bj) { const f32x4 v0 = acc[ai][bj][m][0] + bv[bj][0], v1 = acc[ai][bj][m][1] + bv[bj][1];
                    const u32x4 g = *(const u32x4*)(Gy + row * ldg + col0 + bj * HALF);
                    float o[8];
                    o[0] = bf_lo(g.x) * __builtin_amdgcn_rcpf(1.f + __builtin_amdgcn_exp2f(-1.4426950408889634f * v0[0])); o[1] = bf_hi(g.x) * __builtin_amdgcn_rcpf(1.f + __builtin_amdgcn_exp2f(-1.4426950408889634f * v0[1]));
                    o[2] = bf_lo(g.y) * __builtin_amdgcn_rcpf(1.f + __builtin_amdgcn_exp2f(-1.4426950408889634f * v0[2])); o[3] = bf_hi(g.y) * __builtin_amdgcn_rcpf(1.f + __builtin_amdgcn_exp2f(-1.4426950408889634f * v0[3]));
                    o[4] = bf_lo(g.z) * __builtin_amdgcn_rcpf(1.f + __builtin_amdgcn_exp2f(-1.4426950408889634f * v1[0])); o[5] = bf_hi(g.z) * __builtin_amdgcn_rcpf(1.f + __builtin_amdgcn_exp2f(-1.4426950408889634f * v1[1]));
                    o[6] = bf_lo(g.w) * __builtin_amdgcn_rcpf(1.f + __builtin_amdgcn_exp2f(-1.4426950408889634f * v1[2])); o[7] = bf_hi(g.w) * __builtin_amdgcn_rcpf(1.f + __builtin_amdgcn_exp2f(-1.4426950408889634f * v1[3]));
                    u32x4 w; w.x = cvt_pk_bf16(o[0], o[1]); w.y = cvt_pk_bf16(o[2], o[3]); w.z = cvt_pk_bf16(o[4], o[5]); w.w = cvt_pk_bf16(o[6], o[7]);
                    *(u32x4*)(O + row * ldc + coff + col0 + bj * HALF) = w; } }
    }
};
template <bool BASE16> struct EpiRes {
    static constexpr bool PERM = true, AFTER_DRAIN = false;
    const void* basep; bf16_t* T; const float* gate  ; const float* bias; float alpha; int MP; float* slab;
    __device__ __forceinline__ void operator()(const f32x4 (&acc)[2][2][4][2], const Unit& u, int wr, int wc, int fr, int fq) const {
        const int row0 = u.pm * BM + wr * 64 + fr, col0 = u.pn * BM + wc * 32 + 8 * fq;
        if (row0 >= MP) {
            float* sp = slab + (size_t)u.ks * 512 * 1024;
#pragma unroll
            for (int ai = 0; ai < 2; ++ai)
#pragma unroll
                for (int m = 0; m < 4; ++m) { float* op = sp + (size_t)(row0 + ai * HALF + m * 16 - MP) * 1024;
#pragma unroll
                    for (int bj = 0; bj < 2; ++bj)
#pragma unroll
                        for (int n = 0; n < 2; ++n) st16f_wt(op + col0 + bj * HALF + n * 4, acc[ai][bj][m][n]); }
            return; }
        f32x4 bv[2][2];
#pragma unroll
        for (int bj = 0; bj < 2; ++bj)
#pragma unroll
            for (int n = 0; n < 2; ++n) bv[bj][n] = bias ? *(const f32x4*)(bias + col0 + bj * HALF + n * 4) : (f32x4){0.f, 0.f, 0.f, 0.f};
        const float* gp = gate + (size_t)(row0 >> 11) * 6144;
#pragma unroll
        for (int ai = 0; ai < 2; ++ai)
#pragma unroll
            for (int m = 0; m < 4; ++m) { const int row = row0 + ai * HALF + m * 16;
                bf16_t* tp = T + (size_t)row * 1024;
#pragma unroll
                for (int bj = 0; bj < 2; ++bj) { const int c = col0 + bj * HALF;
                    f32x4 b0, b1;
                    if (BASE16) { const u32x4 bw = *(const u32x4*)((const bf16_t*)basep + (size_t)row * 1024 + c); b0 = (f32x4){bf_lo(bw.x), bf_hi(bw.x), bf_lo(bw.y), bf_hi(bw.y)}; b1 = (f32x4){bf_lo(bw.z), bf_hi(bw.z), bf_lo(bw.w), bf_hi(bw.w)}; }
                    else { const float* bp = (const float*)basep + (size_t)row * 1024; b0 = *(const f32x4*)(bp + c); b1 = *(const f32x4*)(bp + c + 4); }
                    const f32x4 g0 = *(const f32x4*)(gp + c), g1 = *(const f32x4*)(gp + c + 4);
                    const f32x4 v0 = b0 * alpha + g0 * (acc[ai][bj][m][0] + bv[bj][0]), v1 = b1 * alpha + g1 * (acc[ai][bj][m][1] + bv[bj][1]);
                    u32x4 w; w.x = cvt_pk_bf16(v0[0], v0[1]); w.y = cvt_pk_bf16(v0[2], v0[3]); w.z = cvt_pk_bf16(v1[0], v1[1]); w.w = cvt_pk_bf16(v1[2], v1[3]);
                    st16_wt(tp + c, w); } }
    }
};

template <class Epi, class Sched, bool ALIGN_EPI = false, bool SP2 = false>
__device__ __forceinline__ void gemm_phase(PG8_LAS unsigned char* lds, const Gemm g, const Sched& S, const Epi& E) {
    const int tid = threadIdx.x, wid = __builtin_amdgcn_readfirstlane(tid >> 6), lane = tid & 63, wr = wid >> 2, wc = wid & 3, fr = lane & 15, fq = lane >> 4;
    const int K = g.K;
    unsigned voffA[2], voffB[2];
#pragma unroll
    for (int i = 0; i < 2; ++i) { int R, C; stage_rc(tid * 16 + i * 8192, R, C); const int Rb = Epi::PERM ? ((R & ~31) + perm32(R & 31)) : R;
        voffA[i] = (unsigned)(R * K + C) * 2u; voffB[i] = (unsigned)(Rb * K + C) * 2u; }
    const size_t kstep = (size_t)(BK * 2);
    const size_t hstep = (size_t)HALF * K * 2;
    const size_t tstep = 2 * hstep;
    const unsigned ldsw = (unsigned)wid * 1024u;
    const int aoff = lds_byte(wr * 64 + fr, fq * 8), boff = lds_byte(wc * 32 + fr, fq * 8);
#define PG8_SA(b, h) (((b) * 2 + (h)) * HTB)
#define PG8_SB(b, h) ((4 + (b) * 2 + (h)) * HTB)
#define PG8_STAGE(bufoff, gbase, voff) do { _Pragma("unroll") for (int _i = 0; _i < 2; ++_i) \
        __builtin_amdgcn_global_load_lds((const unsigned*)((const char*)(gbase) + (voff)[_i]), (PG8_LAS unsigned*)(lds + (bufoff) + ldsw + _i * 8192), 16, 0, 0); } while (0)
#define PG8_LDA(dst, b, h) do { _Pragma("unroll") for (int m = 0; m < 4; ++m) _Pragma("unroll") for (int k = 0; k < 2; ++k) dst[m][k] = *(const PG8_LAS bf16x8*)(lds + PG8_SA(b, h) + aoff + m * 2048 + k * 1024); } while (0)
#define PG8_LDB(dst, b, h) do { _Pragma("unroll") for (int n = 0; n < 2; ++n) _Pragma("unroll") for (int k = 0; k < 2; ++k) dst[n][k] = *(const PG8_LAS bf16x8*)(lds + PG8_SB(b, h) + boff + n * 2048 + k * 1024); } while (0)
#define PG8_MMA(ai, bj, At, Bt) do { __builtin_amdgcn_s_setprio(1); _Pragma("unroll") for (int m = 0; m < 4; ++m) _Pragma("unroll") for (int n = 0; n < 2; ++n) _Pragma("unroll") for (int k = 0; k < 2; ++k) \
        acc[ai][bj][m][n] = __builtin_amdgcn_mfma_f32_16x16x32_bf16(Bt[n][k], At[m][k], acc[ai][bj][m][n], 0, 0, 0); __builtin_amdgcn_s_setprio(0); } while (0)
#define PG8_WAIT_V(n) asm volatile("s_waitcnt vmcnt(" #n ")" ::: "memory")
#define PG8_WAIT_L(n) asm volatile("s_waitcnt lgkmcnt(" #n ")" ::: "memory")
#define PG8_BAR __builtin_amdgcn_s_barrier()
#define PG8_SCHED __builtin_amdgcn_sched_barrier(0)
    Unit cur, nxt; int ui = 0;
    if (!S.next(0, cur)) return;
    f32x4 acc[2][2][4][2];
#pragma unroll
    for (int a = 0; a < 2; ++a)
#pragma unroll
        for (int b = 0; b < 2; ++b)
#pragma unroll
            for (int m = 0; m < 4; ++m)
#pragma unroll
                for (int n = 0; n < 2; ++n) acc[a][b][m][n] = (f32x4){0.f, 0.f, 0.f, 0.f};
    bf16x8 At[4][2], B0[2][2], B1[2][2];
    const char* cA = (const char*)g.A + (size_t)cur.pm * tstep + (size_t)cur.k0 * 2; const char* cB = (const char*)g.Bt + (size_t)cur.pn * tstep + (size_t)cur.k0 * 2;
    S.a_ready(cur);
    if constexpr (SP2) {
        PG8_STAGE(PG8_SB(0, 0), cB, voffB); PG8_STAGE(PG8_SB(0, 1), cB + hstep, voffB); PG8_STAGE(PG8_SA(0, 0), cA, voffA); PG8_STAGE(PG8_SA(0, 1), cA + hstep, voffA);
        if (wr == 1) PG8_BAR;
        PG8_WAIT_V(2); PG8_BAR;
        PG8_STAGE(PG8_SB(1, 0), cB + kstep, voffB); PG8_STAGE(PG8_SA(1, 0), cA + kstep, voffA); PG8_STAGE(PG8_SB(1, 1), cB + hstep + kstep, voffB);
        PG8_WAIT_V(6); PG8_BAR;
    } else {
        PG8_STAGE(PG8_SB(0, 0), cB, voffB); PG8_STAGE(PG8_SA(0, 0), cA, voffA); PG8_STAGE(PG8_SB(0, 1), cB + hstep, voffB); PG8_STAGE(PG8_SA(0, 1), cA + hstep, voffA);
        if (wr == 1) PG8_BAR;
        PG8_WAIT_V(4); PG8_BAR;
        PG8_STAGE(PG8_SB(1, 0), cB + kstep, voffB); PG8_STAGE(PG8_SA(1, 0), cA + kstep, voffA); PG8_STAGE(PG8_SB(1, 1), cB + hstep + kstep, voffB);
        PG8_WAIT_V(6); PG8_BAR;
    }
    for (;;) {
        const bool has_next = S.next(ui + 1, nxt);
        const char* nA = has_next ? (const char*)g.A + (size_t)nxt.pm * tstep + (size_t)nxt.k0 * 2 : cA; const char* nB = has_next ? (const char*)g.Bt + (size_t)nxt.pn * tstep + (size_t)nxt.k0 * 2 : cB;
        const int nt = cur.nkt;
        for (int t = 0; t < nt; t += 2) {
            const bool last = (t == nt - 2);
            const char* a1 = cA + (size_t)(t + 1) * kstep;
            const char* a2 = last ? nA : cA + (size_t)(t + 2) * kstep; const char* b2 = last ? nB : cB + (size_t)(t + 2) * kstep;
            const char* a3 = a2 + kstep; const char* b3 = b2 + kstep;
            if (last && has_next) S.a_ready(nxt);
            if constexpr (SP2) {
            PG8_LDB(B0, 0, 0); PG8_LDB(B1, 0, 1); PG8_SCHED; PG8_LDA(At, 0, 0); PG8_STAGE(PG8_SA(1, 1), a1 + hstep, voffA);
            PG8_WAIT_V(8); PG8_WAIT_L(0); PG8_BAR; PG8_MMA(0, 0, At, B0); PG8_MMA(0, 1, At, B1); PG8_BAR; PG8_SCHED;
            PG8_LDA(At, 0, 1); PG8_STAGE(PG8_SB(0, 0), b2, voffB); PG8_STAGE(PG8_SB(0, 1), b2 + hstep, voffB); PG8_STAGE(PG8_SA(0, 0), a2, voffA);
            PG8_WAIT_V(8); PG8_WAIT_L(0); PG8_BAR; PG8_MMA(1, 0, At, B0); PG8_MMA(1, 1, At, B1); PG8_BAR; PG8_SCHED;
            PG8_LDB(B0, 1, 0); PG8_LDB(B1, 1, 1); PG8_SCHED; PG8_LDA(At, 1, 0); PG8_STAGE(PG8_SA(0, 1), a2 + hstep, voffA);
            PG8_WAIT_V(8); PG8_WAIT_L(0); PG8_BAR; PG8_MMA(0, 0, At, B0); PG8_MMA(0, 1, At, B1); PG8_BAR; PG8_SCHED;
            PG8_LDA(At, 1, 1); PG8_STAGE(PG8_SB(1, 0), b3, voffB); PG8_STAGE(PG8_SB(1, 1), b3 + hstep, voffB); PG8_STAGE(PG8_SA(1, 0), a3, voffA);
            PG8_WAIT_V(8); PG8_WAIT_L(0); PG8_BAR; PG8_MMA(1, 0, At, B0); PG8_MMA(1, 1, At, B1); PG8_BAR; PG8_SCHED;
            } else {
            PG8_LDB(B0, 0, 0); PG8_SCHED; PG8_LDA(At, 0, 0); PG8_STAGE(PG8_SA(1, 1), a1 + hstep, voffA);
            PG8_WAIT_L(8); PG8_BAR; PG8_WAIT_L(0); PG8_MMA(0, 0, At, B0); PG8_BAR; PG8_SCHED;
            PG8_LDB(B1, 0, 1); PG8_STAGE(PG8_SB(0, 0), b2, voffB);
            PG8_BAR; PG8_WAIT_L(0); PG8_MMA(0, 1, At, B1); PG8_BAR;
            PG8_LDA(At, 0, 1); PG8_STAGE(PG8_SA(0, 0), a2, voffA);
            PG8_BAR; PG8_WAIT_L(0); PG8_MMA(1, 0, At, B0); PG8_BAR; PG8_SCHED;
            PG8_STAGE(PG8_SB(0, 1), b2 + hstep, voffB);
            PG8_WAIT_V(6); PG8_BAR; PG8_MMA(1, 1, At, B1); PG8_BAR;
            PG8_LDB(B0, 1, 0); PG8_SCHED; PG8_LDA(At, 1, 0); PG8_STAGE(PG8_SA(0, 1), a2 + hstep, voffA);
            PG8_WAIT_L(8); PG8_BAR; PG8_WAIT_L(0); PG8_MMA(0, 0, At, B0); PG8_BAR; PG8_SCHED;
            PG8_LDB(B1, 1, 1); PG8_STAGE(PG8_SB(1, 0), b3, voffB);
            PG8_BAR; PG8_WAIT_L(0); PG8_MMA(0, 1, At, B1); PG8_BAR;
            PG8_LDA(At, 1, 1); PG8_STAGE(PG8_SA(1, 0), a3, voffA);
            PG8_BAR; PG8_WAIT_L(0); PG8_MMA(1, 0, At, B0); PG8_BAR; PG8_SCHED;
            PG8_STAGE(PG8_SB(1, 1), b3 + hstep, voffB);
            PG8_WAIT_V(6); PG8_BAR; PG8_MMA(1, 1, At, B1); PG8_BAR;
            }
        }
        if constexpr (ALIGN_EPI) { if (wr == 0) PG8_BAR; }
        if constexpr (!Epi::AFTER_DRAIN) { E(acc, cur, wr, wc, fr, fq); S.done(cur); }
        if (!has_next) break;
#pragma unroll
        for (int a = 0; a < 2; ++a)
#pragma unroll
            for (int b = 0; b < 2; ++b)
#pragma unroll
                for (int m = 0; m < 4; ++m)
#pragma unroll
                    for (int n = 0; n < 2; ++n) acc[a][b][m][n] = (f32x4){0.f, 0.f, 0.f, 0.f};
        cur = nxt; cA = nA; cB = nB; ++ui;
        if constexpr (ALIGN_EPI) { if (wr == 1) PG8_BAR; }
    }
    PG8_WAIT_V(0);
    if constexpr (!ALIGN_EPI) { if (wr == 0) PG8_BAR; }
    PG8_BAR;
#undef PG8_SA
#undef PG8_SB
#undef PG8_STAGE
#undef PG8_LDA
#undef PG8_LDB
#undef PG8_MMA
#undef PG8_WAIT_V
#undef PG8_WAIT_L
#undef PG8_BAR
#undef PG8_SCHED
}
}

#ifndef PROBE_DUP
#define PROBE_DUP 0
#endif
#ifndef PG8_SP2
#define PG8_SP2 true
#endif
#ifndef PG8_ALIGN
#define PG8_ALIGN true
#endif

constexpr int NWAVES = 8;
constexpr int N_LAUNCHES = MK_N_LAUNCHES;
constexpr int N_PHASES = 10;
constexpr int D = 1024, MP = 16384, MS = 512, M = MP + MS, TP = 2048, NBP = 8, NBS = 128, TS = 4;
constexpr int NZ = 1536, WA = 512, WB = 512, FF = 4096, NMOD = 6 * D, NROWMOD = NBP + NBS;
constexpr int GB = 32, NS5 = 64, KS5 = 16, HA = 8, HDA = 64;
constexpr float LN_EPS = 1e-5f;
constexpr int NS_OUT = 4, NS_DOWN = 8;
constexpr float ALPHA = 1.189207115002721f;

constexpr size_t O_YP = 0, O_YS = (size_t)MP * D, O_CONVP = O_YS + (size_t)MS * D, O_HP = O_CONVP + (size_t)NBP * 3 * WA, O_SRP = O_HP + (size_t)NBP * WA,
                 O_SIP = O_SRP + (size_t)NBP * GB * NS5, O_CONVS = O_SIP + (size_t)NBP * GB * NS5, O_HS = O_CONVS + (size_t)NBS * 3 * WA, O_SRS = O_HS + (size_t)NBS * WA,
                 O_SIS = O_SRS + (size_t)NBS * GB * NS5, O_END = O_SIS + (size_t)NBS * GB * NS5;

constexpr size_t MiB = 1u << 20;
constexpr size_t WS_CTL = 0, CTL_ZERO_BYTES = 128 * 1024;
constexpr size_t WS_WIN = 1 * MiB, WS_WGLU = 4 * MiB, WS_WOUT = 5 * MiB, WS_W1 = 7 * MiB, WS_W2 = 15 * MiB;
constexpr size_t WS_MOD = 23 * MiB;
constexpr size_t WS_S5C = 27 * MiB;
constexpr size_t WS_XN = 28 * MiB;
constexpr size_t WS_Z = 61 * MiB;
constexpr size_t WS_YCAT = 111 * MiB;
constexpr size_t WS_G = 144 * MiB;
constexpr size_t WS_U = 61 * MiB;
constexpr size_t WS_T1 = WS_Z;
constexpr size_t WS_T2 = WS_XN;
constexpr size_t WS_TAB = 194 * MiB;
constexpr size_t WS_SLAB = 196 * MiB;
constexpr size_t WS_X1B = 212 * MiB;
constexpr size_t WS_END = 246 * MiB;
constexpr size_t TB_BF1 = 0, TB_BF2 = TB_BF1 + 32 * 4 * 64 * 16, TB_TA = TB_BF2 + 32 * 8 * 64 * 16, TB_ZP = TB_TA + 32 * 2 * 2 * 32 * 4, TB_Z16N = TB_ZP + 32 * 17 * 2 * 2 * 32 * 4,
                 TB_RG = TB_Z16N + 32 * 2 * 64 * 4, TB_CB = TB_RG + 8 * 2 * 2 * 4 * 64 * 16, TB_SILU = TB_CB + 128 * 3 * 512 * 2, TB_DG = TB_SILU + 160 * 1024 * 2, TB_END = TB_DG + 8 * 16 * 64 * 16;
static_assert(WS_TAB + TB_END <= WS_SLAB, "tables");
static_assert(WS_XN + (size_t)M * D * 2 <= WS_Z && WS_Z + (size_t)M * NZ * 2 <= WS_YCAT && WS_YCAT + (size_t)M * D * 2 <= WS_G && WS_G + (size_t)M * WB * 2 <= WS_END && WS_U + (size_t)M * FF * 2 <= WS_TAB, "d_ws map");
constexpr int SC_ABR = 0, SC_ABI = 2048, SC_BBR = 4096, SC_BBI = 4096 + 32768, SC_RGL = 4096 + 65536, SC_END = SC_RGL + 512;
constexpr int CW_TMO = 0, CW_CODE = 1, CW_SILU = 64, CW_MOD = 1024  , CW_S5B = 128  , CW_BAR = 4096,
              CW_T1 = 8192  , CW_T2 = 12288  , CW_T1S = 16384, CW_T2S = 16448  ;

constexpr int RING_OFF = 0, RING_BYTES = 131072;
constexpr int LDSCTL_OFF = RING_BYTES, MISC_OFF = LDSCTL_OFF + 320;
constexpr int LDS_BYTES = 147456;

#define GAS __attribute__((address_space(1)))
#define LAS __attribute__((address_space(3)))
typedef unsigned short bf16;
typedef unsigned v4u __attribute__((ext_vector_type(4)));
typedef float f32x4 __attribute__((ext_vector_type(4)));
typedef GAS unsigned gu32;
#define RLX_AGENT __ATOMIC_RELAXED, __HIP_MEMORY_SCOPE_AGENT
#define LDS_WAIT() asm volatile("s_waitcnt lgkmcnt(0)" ::: "memory")
#define VM_WAIT() asm volatile("s_waitcnt vmcnt(0)" ::: "memory")
__device__ __forceinline__ unsigned f2bf(float f) { unsigned u = __builtin_bit_cast(unsigned, f); return (u + 0x7fffu + ((u >> 16) & 1u)) >> 16; }
__device__ __forceinline__ unsigned pk2(float lo, float hi) { return f2bf(lo) | (f2bf(hi) << 16); }
__device__ __forceinline__ float bf2f(bf16 v) { return __builtin_bit_cast(float, (unsigned)v << 16); }
__device__ __forceinline__ float gelu_tanh(float x) { const float t = -2.3022082f * (x + 0.044715f * x * x * x); return x * __builtin_amdgcn_rcpf(1.f + __builtin_amdgcn_exp2f(t)); }
__device__ __forceinline__ float sigmoidf_(float x) { return __builtin_amdgcn_rcpf(1.f + __builtin_amdgcn_exp2f(-1.4426950408889634f * x)); }

#define XB_TMO      128
#define XB_XCNT(j)  (256  + 64 * (j))
#define XB_XSUB(j)  (1280 + 64 * (j))
#define XB_XGEN(j)  (2304 + 64 * (j))
#define XB_TOP      3328
#define XB_TOPGEN   3392
#define XCD_BAR_WORDS 3456
#define XB_SPIN_CAP (1u << 18)
__device__ __forceinline__ unsigned xb_ld(unsigned* p)              { return __hip_atomic_load(p, __ATOMIC_RELAXED, __HIP_MEMORY_SCOPE_AGENT); }
__device__ __forceinline__ unsigned xb_add(unsigned* p, unsigned v) { return __hip_atomic_fetch_add(p, v, __ATOMIC_RELAXED, __HIP_MEMORY_SCOPE_AGENT); }
__device__ __forceinline__ unsigned xb_xcc_id() { return (unsigned)__builtin_amdgcn_s_getreg((3 << 11) | 20) & 0xFu; }
#define XB_SPIN(cond, bar) do { unsigned _sp = 0; while (cond) { __builtin_amdgcn_s_sleep(1); \
    if ((++_sp & 255u) == 0u) { if (xb_ld(&(bar)[XB_TMO])) break; if (_sp > XB_SPIN_CAP) { atomicAdd(&(bar)[XB_TMO], 1u); break; } } } } while (0)
struct XcdBarrier { unsigned* bar; unsigned x; volatile LAS unsigned* st; };
__device__ __forceinline__ XcdBarrier xcd_barrier_post(unsigned* bar, volatile LAS unsigned* st) {
    XcdBarrier b; b.bar = bar; b.x = xb_xcc_id(); b.st = st;
    if (threadIdx.x == 0) (void)xb_add(&bar[XB_XCNT(b.x)], 1u);
    return b;
}
__device__ __forceinline__ void xcd_barrier_complete(unsigned* bar, unsigned x, unsigned& nloc, unsigned& nx) {
    const unsigned G = gridDim.x * gridDim.y * gridDim.z;
    unsigned sum, cnt, mine, sp = 0u;
    for (;;) {
        sum = 0u; cnt = 0u; mine = 0u;
#pragma unroll
        for (unsigned j = 0; j < 16; ++j) { const unsigned c = xb_ld(&bar[XB_XCNT(j)]); sum += c; cnt += (c > 0u) ? 1u : 0u; mine = (j == x) ? c : mine; }
        if (sum == G) break;
        __builtin_amdgcn_s_sleep(1);
        if ((++sp & 255u) == 0u) { if (xb_ld(&bar[XB_TMO])) break; if (sp > XB_SPIN_CAP) { atomicAdd(&bar[XB_TMO], 1u); break; } }
    }
    nloc = mine > 0u ? mine : 1u; nx = cnt > 0u ? cnt : 1u;
}
__device__ __forceinline__ void xcd_barrier(const XcdBarrier& b) {
    asm volatile("s_waitcnt vmcnt(0)" ::: "memory");
    __syncthreads();
    if (threadIdx.x == 0) {
        unsigned* bar = b.bar;
        __builtin_amdgcn_s_waitcnt(0);
        unsigned nloc = b.st[0], nx = b.st[1];
        if (nloc == 0u) { xcd_barrier_complete(bar, b.x, nloc, nx); b.st[0] = nloc; b.st[1] = nx; }
        const unsigned old = xb_add(&bar[XB_XSUB(b.x)], 1u);
        const unsigned gen = old / nloc;
        if (old + 1u == (gen + 1u) * nloc) {
            __builtin_amdgcn_fence(__ATOMIC_RELEASE, "agent");
            asm volatile("s_waitcnt vmcnt(0)" ::: "memory");
            const unsigned og = xb_add(&bar[XB_TOP], 1u);
            const unsigned tg = og / nx;
            if (og + 1u == (tg + 1u) * nx) xb_add(&bar[XB_TOPGEN], 1u);
            else XB_SPIN(xb_ld(&bar[XB_TOPGEN]) == tg, bar);
            __builtin_amdgcn_fence(__ATOMIC_ACQUIRE, "agent");
            xb_add(&bar[XB_XGEN(b.x)], 1u);
            asm volatile("s_waitcnt vmcnt(0)" ::: "memory");
        } else {
            XB_SPIN(xb_ld(&bar[XB_XGEN(b.x)]) == gen, bar);
            __builtin_amdgcn_fence(__ATOMIC_ACQUIRE, "agent");
            asm volatile("s_waitcnt vmcnt(0)" ::: "memory");
        }
    }
    __syncthreads();
}

struct Frame {
    LAS unsigned char* lds;
    volatile LAS unsigned* MISC;
    gu32* ctl;
    int tid, lane, wave;
    int vcu, G;
    float* out;
    unsigned char* ws;
};
struct Args { const float* in[37]; float* out; unsigned char* ws; int ph_lo, ph_hi, li, pad; };
__device__ __forceinline__ void refresh(Frame& F) { int t = threadIdx.x; asm volatile("" : "+v"(t)); F.tid = t; F.lane = t & 63; F.wave = __builtin_amdgcn_readfirstlane(t >> 6); }
__device__ __forceinline__ void cnt_arrive(Frame& F, int word) {
    VM_WAIT(); __syncthreads();
    if (F.tid == 0) { __builtin_amdgcn_fence(__ATOMIC_RELEASE, "agent"); VM_WAIT(); (void)__hip_atomic_fetch_add((unsigned*)(F.ctl + word), 1u, RLX_AGENT); }
}
__device__ __forceinline__ void cnt_arrive_wt(Frame& F, int word) {
    VM_WAIT(); __syncthreads();
    if (F.tid == 0) (void)__hip_atomic_fetch_add((unsigned*)(F.ctl + word), 1u, RLX_AGENT);
}
__device__ __forceinline__ void cnt_wait_ge(Frame& F, int word, unsigned target) {
    if (F.tid == 0) { unsigned sp = 0; while (__hip_atomic_load((unsigned*)(F.ctl + word), RLX_AGENT) < target && ++sp < (1u << 22)) __builtin_amdgcn_s_sleep(2);
        __builtin_amdgcn_fence(__ATOMIC_ACQUIRE, "agent"); VM_WAIT(); }
    __syncthreads();
}
__device__ __forceinline__ float wave_sum(float v) {
#pragma unroll
    for (int o = 1; o < 64; o <<= 1) v += __shfl_xor(v, o);
    return v;
}
enum { I_XP = 0, I_XS, I_SCONV, I_SH, I_SSR, I_SSI, I_CP, I_CS, I_ADAW, I_ADAB, I_INPROJ, I_CONVW, I_CONVB, I_RGWR, I_RGBR, I_RGWI, I_RGBI, I_RGLAM,
       I_S5ARE, I_S5AIM, I_S5LOGDT, I_S5BRE, I_S5BIM, I_S5CRE, I_S5CIM, I_S5D, I_GLUW, I_GLUB, I_OUTPROJ, I_LN1G, I_LN1B, I_W1, I_B1, I_W2, I_B2, I_LN2G, I_LN2B };

typedef float f32x2m __attribute__((ext_vector_type(2)));
typedef __bf16 bf16x2m __attribute__((ext_vector_type(2)));
__device__ __forceinline__ unsigned pkbf0(float a, float b) { const f32x2m v = {a, b}; const bf16x2m r = __builtin_convertvector(v, bf16x2m); return __builtin_bit_cast(unsigned, r); }
typedef short bf16x8m __attribute__((ext_vector_type(8)));
typedef float f32x16m __attribute__((ext_vector_type(16)));
__device__ __forceinline__ void p0_transpose_item(const float* W, int K, int N, bf16* WT, LAS float* scr, int item, int lane) {
    const int nblk = N / 32, kb = item / nblk, nb = item % nblk, k0 = 64 * kb, n0 = 32 * nb;
#pragma unroll 8
    for (int i = 0; i < 32; ++i) { const int kk = 2 * i + (lane >> 5); scr[kk * 33 + (lane & 31)] = W[(size_t)(k0 + kk) * N + n0 + (lane & 31)]; }
    LDS_WAIT(); asm volatile("" ::: "memory");
    const int c = lane & 7;
#pragma unroll
    for (int j = 0; j < 4; ++j) { const int n = (lane >> 3) + 8 * j; const LAS float* s = scr + (8 * c) * 33 + n;
        v4u o; o.x = pk2(s[0 * 33], s[1 * 33]); o.y = pk2(s[2 * 33], s[3 * 33]); o.z = pk2(s[4 * 33], s[5 * 33]); o.w = pk2(s[6 * 33], s[7 * 33]);
        *(GAS v4u*)(WT + (size_t)(n0 + n) * K + k0 + 8 * c) = o; }
    LDS_WAIT(); asm volatile("" ::: "memory");
}

constexpr int XI_IN = (D / 64) * (NZ / 32), XI_GL = (WB / 64) * (WB / 32), XI_OU = (D / 64) * (D / 32), XI_1 = (D / 64) * (FF / 32), XI_2 = (FF / 64) * (D / 32);
constexpr int XO_OU = XI_IN + XI_GL, XO_1 = XO_OU + XI_OU, XO_2 = XO_1 + XI_1, XO_END = XO_2 + XI_2;
__device__ __forceinline__ void xpose_item(Frame& F, const Args& A, LAS float* scr, int r) {
    if (r < XI_IN) { p0_transpose_item(A.in[I_INPROJ], D, NZ, (bf16*)(F.ws + WS_WIN), scr, r, F.lane); return; } r -= XI_IN;
    if (r < XI_GL) { p0_transpose_item(A.in[I_GLUW], WB, WB, (bf16*)(F.ws + WS_WGLU), scr, r, F.lane); return; } r -= XI_GL;
    if (r < XI_OU) { p0_transpose_item(A.in[I_OUTPROJ], D, D, (bf16*)(F.ws + WS_WOUT), scr, r, F.lane); return; } r -= XI_OU;
    if (r < XI_1) { p0_transpose_item(A.in[I_W1], D, FF, (bf16*)(F.ws + WS_W1), scr, r, F.lane); return; } r -= XI_1;
    p0_transpose_item(A.in[I_W2], FF, D, (bf16*)(F.ws + WS_W2), scr, r, F.lane);
}
__device__ __forceinline__ void xpose_range(Frame& F, const Args& A, int lo, int hi, int vlo) {
    refresh(F);
    if (F.vcu < vlo) return;
    LAS float* scr = (LAS float*)(F.lds + RING_OFF + F.wave * 16384);
    const int gw = F.wave * (F.G - vlo) + (F.vcu - vlo), ngw = (F.G - vlo) * NWAVES;
    for (int it = lo + gw; it < hi; it += ngw) xpose_item(F, A, scr, it);
}
__device__ __forceinline__ void xpose_range_b(Frame& F, const Args& A, int lo, int hi, int blo) {
    refresh(F);
    LAS float* scr = (LAS float*)(F.lds + RING_OFF + F.wave * 16384);
    const int gw = F.wave * (F.G - blo) + ((int)blockIdx.x - blo), ngw = (F.G - blo) * NWAVES;
    for (int it = lo + gw; it < hi; it += ngw) xpose_item(F, A, scr, it);
}
#ifndef PROBE_P0PART
#define PROBE_P0PART 7
#endif
__device__ __forceinline__ void p0_prologue(Frame& F, const Args& A, int rep = 0) {
    refresh(F);
    const int pmask = rep ? PROBE_P0PART : 7;
    LAS float* scr = (LAS float*)(F.lds + RING_OFF + F.wave * 16384);
    const int gw = F.wave * F.G + F.vcu, NGW = F.G * NWAVES;
    {
        bf16* ST = (bf16*)(F.ws + WS_TAB + TB_SILU);
        for (int ch = F.vcu * NWAVES * 64 + F.tid; ch < 160 * 1024 / 8; ch += F.G * NWAVES * 64) { const int row = ch >> 7, k = (ch & 127) * 8; v4u o = (v4u){0u, 0u, 0u, 0u};
            if (row < NROWMOD) { const float* cp = (row < NBP ? A.in[I_CP] + (size_t)row * D : A.in[I_CS] + (size_t)(row - NBP) * D) + k; const f32x4 c0 = *(const f32x4*)cp, c1 = *(const f32x4*)(cp + 4);
                o.x = pk2(c0[0] * sigmoidf_(c0[0]), c0[1] * sigmoidf_(c0[1])); o.y = pk2(c0[2] * sigmoidf_(c0[2]), c0[3] * sigmoidf_(c0[3]));
                o.z = pk2(c1[0] * sigmoidf_(c1[0]), c1[1] * sigmoidf_(c1[1])); o.w = pk2(c1[2] * sigmoidf_(c1[2]), c1[3] * sigmoidf_(c1[3])); }
            pg8::st16_wt(ST + (size_t)ch * 8, o); }
        cnt_arrive_wt(F, CW_SILU);
    }
    constexpr int I_IN = XI_IN, I_GL = XI_GL;
    constexpr int I_S5 = GB, I_RG = WA / 64, I_RGT = HA * 2 * 2 * 4, I_CB = NBS * 3 * WA / 512, I_DG = HA * 16;
    constexpr int NITEMS = I_IN + I_GL + I_S5 + I_RG + I_RGT + I_CB + I_DG;
    float* sc = (float*)(F.ws + WS_S5C);
    for (int it = gw; it < NITEMS; it += NGW) {
        int r = it;
        if (!(pmask & 1) && it < I_IN + I_GL) continue;
        if (!(pmask & 2) && it >= I_IN + I_GL) continue;
        if (r < I_IN + I_GL) { xpose_item(F, A, scr, r); continue; } r -= I_IN + I_GL;
        if (r < I_S5) {
            const int g = r, n = F.lane, gn = g * NS5 + n;
            const double dt = exp((double)A.in[I_S5LOGDT][g]), ar = (double)A.in[I_S5ARE][gn], ai = (double)A.in[I_S5AIM][gn];
            const double mag = exp(dt * ar), abr = mag * cos(dt * ai), abi = mag * sin(dt * ai), den = ar * ar + ai * ai, nr = abr - 1.0;
            const double qr = (nr * ar + abi * ai) / den, qi = (abi * ar - nr * ai) / den;
            sc[SC_ABR + gn] = (float)abr; sc[SC_ABI + gn] = (float)abi;
            unsigned char* tab = F.ws + WS_TAB;
            bf16* BF1 = (bf16*)(tab + TB_BF1); bf16* BF2 = (bf16*)(tab + TB_BF2); float* TA = (float*)(tab + TB_TA); float* ZP = (float*)(tab + TB_ZP); float* Z16N = (float*)(tab + TB_Z16N);
            const int sh = n >> 5, v = n & 31, hh = (v >> 2) & 1, ii = (v & 3) + 4 * (v >> 3);
            for (int k = 0; k < KS5; ++k) { const double br = (double)A.in[I_S5BRE][gn * KS5 + k], bi = (double)A.in[I_S5BIM][gn * KS5 + k];
                const float vr = (float)(qr * br - qi * bi), vi = (float)(qr * bi + qi * br);
                sc[SC_BBR + gn * KS5 + k] = vr; sc[SC_BBI + gn * KS5 + k] = vi;
                const int lp = (n & 31) + 32 * (k >> 3), jj = k & 7;
                BF1[(size_t)((g * 4 + 0 + sh) * 64 + lp) * 8 + jj] = (bf16)f2bf(vr); BF1[(size_t)((g * 4 + 2 + sh) * 64 + lp) * 8 + jj] = (bf16)f2bf(vi); }
            { const int s2 = (n >> 4) & 1, jj = 4 * ((n >> 3) & 1) + (n & 3), hk = (n >> 2) & 1;
              for (int ch = 0; ch < KS5; ++ch) { const int hr_ = ch >> 3, i8 = ch & 7, R = (i8 & 3) + 8 * (i8 >> 2) + 4 * hr_, lp = R + 32 * hk;
                  const float cr = A.in[I_S5CRE][(size_t)(g * KS5 + ch) * NS5 + n], ci = A.in[I_S5CIM][(size_t)(g * KS5 + ch) * NS5 + n];
                  BF2[(size_t)((g * 8 + (0 + sh) * 2 + s2) * 64 + lp) * 8 + jj] = (bf16)f2bf(cr); BF2[(size_t)((g * 8 + (2 + sh) * 2 + s2) * 64 + lp) * 8 + jj] = (bf16)f2bf(-ci); }
              for (int z = 0; z < 4; ++z) { const int cidx = n + 64 * z, ks = cidx >> 5, r16 = cidx & 31, lp = 16 + (r16 & 15) + 32 * (r16 >> 4);
                  *(v4u*)(BF2 + (size_t)((g * 8 + ks) * 64 + lp) * 8) = (v4u){0u, 0u, 0u, 0u}; } }
            TA[((g * 2 + hh) * 2 + 0) * 32 + sh * 16 + ii] = (float)abr; TA[((g * 2 + hh) * 2 + 1) * 32 + sh * 16 + ii] = (float)abi;
            const double mg8 = exp(8.0 * dt * ar), z1r = mg8 * cos(8.0 * dt * ai), z1i = mg8 * sin(8.0 * dt * ai); double pzr = 1.0, pzi = 0.0;
            for (int e = 0; e <= 16; ++e) { const float zr = (float)pzr, zi = (float)pzi; { const double nr2 = pzr * z1r - pzi * z1i, ni2 = pzr * z1i + pzi * z1r; pzr = nr2; pzi = ni2; }
                ZP[(((g * 17 + e) * 2 + hh) * 2 + 0) * 32 + sh * 16 + ii] = zr; ZP[(((g * 17 + e) * 2 + hh) * 2 + 1) * 32 + sh * 16 + ii] = zi;
                if (e == 16) { Z16N[(g * 2 + 0) * 64 + n] = zr; Z16N[(g * 2 + 1) * 64 + n] = zi; } }
            continue; } r -= I_S5;
        if (r < I_RG) { const int c = r * 64 + F.lane; const double lam = (double)A.in[I_RGLAM][c];
          sc[SC_RGL + c] = (float)(-8.0 * log1p(exp(-lam)) * 1.4426950408889634); continue; } r -= I_RG;
        if (r >= I_RGT + I_CB) { r -= I_RGT + I_CB;
            const int k = r & 3, sp = (r >> 2) & 1, tau = (r >> 3) & 1, hd = r >> 4, R = F.lane & 31, hk = F.lane >> 5;
            unsigned wv = 0u; if ((R >> 3) == 2 * sp + hk) wv = f2bf(A.in[I_CONVW][k * WA + hd * 64 + 32 * tau + R]);
            const int jj = R & 7; v4u o = (v4u){0u, 0u, 0u, 0u}; const unsigned word = (jj & 1) ? (wv << 16) : wv;
            if ((jj >> 1) == 0) o.x = word; else if ((jj >> 1) == 1) o.y = word; else if ((jj >> 1) == 2) o.z = word; else o.w = word;
            *(v4u*)(F.ws + WS_TAB + TB_DG + (size_t)(r * 64 + F.lane) * 16) = o; continue; }
        if (r >= I_RGT) { r -= I_RGT;
            const float* src = A.in[I_SCONV] + (size_t)r * 512 + F.lane * 8; const f32x4 a0 = *(const f32x4*)src, a1 = *(const f32x4*)(src + 4);
            v4u o; o.x = pk2(a0[0], a0[1]); o.y = pk2(a0[2], a0[3]); o.z = pk2(a1[0], a1[1]); o.w = pk2(a1[2], a1[3]);
            *(v4u*)(F.ws + WS_TAB + TB_CB + ((size_t)r * 512 + F.lane * 8) * 2) = o; continue; }
        {
            const int ks = r & 3, gate = (r >> 2) & 1, jh = (r >> 3) & 1, hd = r >> 4;
            const int R = F.lane & 31, hk = F.lane >> 5;
            const float* W = A.in[gate ? I_RGWI : I_RGWR] + (size_t)(hd * 64 + 32 * (ks >> 1) + 16 * (ks & 1) + 4 * hk) * 64 + 32 * jh + R;
            v4u o; o.x = pk2(W[0], W[64]); o.y = pk2(W[128], W[192]); o.z = pk2(W[8 * 64], W[9 * 64]); o.w = pk2(W[10 * 64], W[11 * 64]);
            *(v4u*)(F.ws + WS_TAB + TB_RG + (size_t)(r * 64 + F.lane) * 16) = o;
        }
    }
    __syncthreads();
    if (F.tid == 0) {
        unsigned sp = 0; while (__hip_atomic_load((unsigned*)(F.ctl + CW_SILU), RLX_AGENT) < (unsigned)F.G && ++sp < (1u << 22)) __builtin_amdgcn_s_sleep(2);
        __builtin_amdgcn_fence(__ATOMIC_ACQUIRE, "agent"); VM_WAIT(); }
    __syncthreads();
    LAS float* RED = (LAS float*)(F.lds + RING_OFF);
    float* mod = (float*)(F.ws + WS_MOD);
    const int r32 = F.lane & 31, hh = F.lane >> 5;
    const bf16* ST = (const bf16*)(F.ws + WS_TAB + TB_SILU);
#pragma unroll 1
    for (int it = F.vcu; it < ((pmask & 4) ? NMOD / 32 : 0); it += F.G) {
        const int n0 = it * 32;
        f32x16m acc[5];
#pragma unroll
        for (int rt = 0; rt < 5; ++rt)
#pragma unroll
            for (int i = 0; i < 16; ++i) acc[rt][i] = 0.f;
#pragma unroll 1
        for (int kb = 0; kb < 4; ++kb) {
            float bw[2][8]; v4u af[2][5];
#pragma unroll
            for (int ks = 0; ks < 2; ++ks) { const int k0 = F.wave * 128 + (kb * 2 + ks) * 16 + 8 * hh;
                const float* wp = A.in[I_ADAW] + (size_t)k0 * NMOD + n0 + r32;
#pragma unroll
                for (int j = 0; j < 8; ++j) bw[ks][j] = wp[(size_t)j * NMOD];
#pragma unroll
                for (int rt = 0; rt < 5; ++rt) af[ks][rt] = *(const v4u*)(ST + (size_t)(32 * rt + r32) * D + k0); }
#pragma unroll
            for (int ks = 0; ks < 2; ++ks) {
                v4u bp; bp.x = pkbf0(bw[ks][0], bw[ks][1]); bp.y = pkbf0(bw[ks][2], bw[ks][3]); bp.z = pkbf0(bw[ks][4], bw[ks][5]); bp.w = pkbf0(bw[ks][6], bw[ks][7]);
                const bf16x8m bfr = __builtin_bit_cast(bf16x8m, bp);
#pragma unroll
                for (int rt = 0; rt < 5; ++rt) acc[rt] = __builtin_amdgcn_mfma_f32_32x32x16_bf16(__builtin_bit_cast(bf16x8m, af[ks][rt]), bfr, acc[rt], 0, 0, 0); }
        }
#pragma unroll
        for (int half = 4; half >= 1; half >>= 1) {
            if (F.wave >= half && F.wave < 2 * half) {
#pragma unroll
                for (int rt = 0; rt < 5; ++rt)
#pragma unroll
                    for (int i = 0; i < 16; ++i) RED[(F.wave - half) * 5120 + (rt * 16 + i) * 64 + F.lane] = acc[rt][i]; }
            __syncthreads();
            if (F.wave < half) {
#pragma unroll
                for (int rt = 0; rt < 5; ++rt)
#pragma unroll
                    for (int i = 0; i < 16; ++i) acc[rt][i] += RED[F.wave * 5120 + (rt * 16 + i) * 64 + F.lane]; }
            __syncthreads();
        }
        if (F.wave == 0) { const float bb = A.in[I_ADAB][n0 + r32];
#pragma unroll
            for (int rt = 0; rt < 5; ++rt)
#pragma unroll
                for (int i = 0; i < 16; ++i) { const int row = 32 * rt + (i & 3) + 8 * (i >> 2) + 4 * hh; if (row < NROWMOD) __hip_atomic_store(mod + (size_t)row * NMOD + n0 + r32, acc[rt][i] + bb, RLX_AGENT); } }
        if (n0 < 2 * D) cnt_arrive_wt(F, CW_MOD);
    }
}

__device__ __forceinline__ int mod_row(int m) { return m < MP ? (m >> 11) : NBP + ((m - MP) >> 2); }
__device__ __forceinline__ const float* x_row(const Args& A, int m) { return m < MP ? A.in[I_XP] + (size_t)m * D : A.in[I_XS] + (size_t)(m - MP) * D; }

__device__ __forceinline__ void p1_modulate(Frame& F, const Args& A, int rep = 0) {
    refresh(F);
    cnt_wait_ge(F, CW_MOD, (unsigned)(2 * D / 32));
    const int gw = F.vcu * NWAVES + F.wave, NGW = F.G * NWAVES;
    const float* mod = (const float*)(F.ws + WS_MOD); bf16* XN = (bf16*)(F.ws + WS_XN);
    for (int m = gw; m < M; m += NGW) {
        const float* xr = x_row(A, m) + 8 * F.lane; const float* mr = mod + (size_t)mod_row(m) * NMOD + 8 * F.lane;
#pragma unroll
        for (int j = 0; j < 2; ++j) { const f32x4 v0 = *(const f32x4*)(xr + 512 * j), v1 = *(const f32x4*)(xr + 512 * j + 4);
            const f32x4 a0 = *(const f32x4*)(mr + 512 * j), a1 = *(const f32x4*)(mr + 512 * j + 4), s0 = *(const f32x4*)(mr + D + 512 * j), s1 = *(const f32x4*)(mr + D + 512 * j + 4);
            const f32x4 h0 = v0 * (s0 + 1.f) + a0, h1 = v1 * (s1 + 1.f) + a1;
            v4u o; o.x = pk2(h0.x, h0.y); o.y = pk2(h0.z, h0.w); o.z = pk2(h1.x, h1.y); o.w = pk2(h1.z, h1.w);
            *(v4u*)(XN + (size_t)m * D + 512 * j + 8 * F.lane) = o; }
    }
}

__device__ __forceinline__ void unpack8(const v4u w, f32x4& a, f32x4& b) { a = (f32x4){pg8::bf_lo(w.x), pg8::bf_hi(w.x), pg8::bf_lo(w.y), pg8::bf_hi(w.y)}; b = (f32x4){pg8::bf_lo(w.z), pg8::bf_hi(w.z), pg8::bf_lo(w.w), pg8::bf_hi(w.w)}; }
__device__ __forceinline__ v4u pack8f(const f32x4 a, const f32x4 b) { v4u o; o.x = pk2(a.x, a.y); o.y = pk2(a.z, a.w); o.z = pk2(b.x, b.y); o.w = pk2(b.z, b.w); return o; }
template <bool SECOND>
__device__ __forceinline__ void ln_rows(Frame& F, const Args& A, int row_lo, int row_hi, int gw, int NGW) {
    refresh(F);
    const float* mod = (const float*)(F.ws + WS_MOD); bf16* XN = (bf16*)(F.ws + WS_XN);
    const float* gg = A.in[SECOND ? I_LN2G : I_LN1G] + 8 * F.lane; const float* gb = A.in[SECOND ? I_LN2B : I_LN1B] + 8 * F.lane;
    for (int m = row_lo + gw; m < row_hi; m += NGW) {
        float* xr = F.out + (size_t)m * D + 8 * F.lane;
        f32x4 v[2][2]; float s = 0.f;
        if (m >= MP) {
            const float* mr = mod + (size_t)mod_row(m) * NMOD + (SECOND ? 5 : 2) * D + 8 * F.lane;
            const float* bs = SECOND ? xr : A.in[I_XS] + (size_t)(m - MP) * D + 8 * F.lane;
            const float* sl = (const float*)(F.ws + WS_SLAB) + (size_t)(m - MP) * D + 8 * F.lane;
#pragma unroll
            for (int j = 0; j < 2; ++j)
#pragma unroll
                for (int h = 0; h < 2; ++h) { const int o = 512 * j + 4 * h; f32x4 a = SECOND ? *(const f32x4*)(A.in[I_B2] + 8 * F.lane + o) : (f32x4){0.f, 0.f, 0.f, 0.f};
#pragma unroll
                    for (int ks = 0; ks < (SECOND ? NS_DOWN : NS_OUT); ++ks) a += *(const f32x4*)(sl + (size_t)ks * (512 * 1024) + o);
                    v[j][h] = *(const f32x4*)(bs + o) * ALPHA + *(const f32x4*)(mr + o) * a; }
        } else {
            const bf16* tr = (const bf16*)(F.ws + (SECOND ? WS_T2 : WS_T1)) + (size_t)m * D + 8 * F.lane;
#pragma unroll
            for (int j = 0; j < 2; ++j) unpack8(*(const v4u*)(tr + 512 * j), v[j][0], v[j][1]);
        }
#pragma unroll
        for (int j = 0; j < 2; ++j)
#pragma unroll
            for (int h = 0; h < 2; ++h) s += (v[j][h].x + v[j][h].y) + (v[j][h].z + v[j][h].w);
        const float mean = wave_sum(s) * (1.f / D); float s2 = 0.f;
#pragma unroll
        for (int j = 0; j < 2; ++j)
#pragma unroll
            for (int h = 0; h < 2; ++h) { v[j][h] = v[j][h] - mean; s2 += (v[j][h].x * v[j][h].x + v[j][h].y * v[j][h].y) + (v[j][h].z * v[j][h].z + v[j][h].w * v[j][h].w); }
        const float rstd = 1.f / sqrtf(wave_sum(s2) * (1.f / D) + LN_EPS);
#pragma unroll
        for (int j = 0; j < 2; ++j)
#pragma unroll
            for (int h = 0; h < 2; ++h) v[j][h] = v[j][h] * rstd * *(const f32x4*)(gg + 512 * j + 4 * h) + *(const f32x4*)(gb + 512 * j + 4 * h);
        if (SECOND || m >= MP) {
#pragma unroll
            for (int j = 0; j < 2; ++j) { *(f32x4*)(xr + 512 * j) = v[j][0]; *(f32x4*)(xr + 512 * j + 4) = v[j][1]; }
        } else {
            bf16* x1 = (bf16*)(F.ws + WS_X1B) + (size_t)m * D + 8 * F.lane;
#pragma unroll
            for (int j = 0; j < 2; ++j) *(v4u*)(x1 + 512 * j) = pack8f(v[j][0], v[j][1]);
        }
        if (!SECOND) {
            const float* mr = mod + (size_t)mod_row(m) * NMOD + 8 * F.lane;
#pragma unroll
            for (int j = 0; j < 2; ++j) { const int o = 512 * j;
                const f32x4 h0 = v[j][0] * (*(const f32x4*)(mr + 4 * D + o) + 1.f) + *(const f32x4*)(mr + 3 * D + o), h1 = v[j][1] * (*(const f32x4*)(mr + 4 * D + o + 4) + 1.f) + *(const f32x4*)(mr + 3 * D + o + 4);
                *(v4u*)(XN + (size_t)m * D + o + 8 * F.lane) = pack8f(h0, h1); }
        }
    }
}

__device__ __forceinline__ void rg_item_ref(Frame& F, const Args& A, bool prompt, int b, int hd, LAS float* scr) {
    const int j = F.lane, c = hd * HDA + j;
    const bf16* Z = (const bf16*)(F.ws + WS_Z); bf16* Y = (bf16*)(F.ws + WS_YCAT); const float* sc = (const float*)(F.ws + WS_S5C);
    float wr[64], wi[64];
#pragma unroll
    for (int i = 0; i < 64; ++i) { wr[i] = A.in[I_RGWR][(size_t)(hd * 64 + i) * 64 + j]; wi[i] = A.in[I_RGWI][(size_t)(hd * 64 + i) * 64 + j]; }
    const float br = A.in[I_RGBR][c], bi = A.in[I_RGBI][c], L2 = sc[SC_RGL + c];
    const float w0 = A.in[I_CONVW][c], w1 = A.in[I_CONVW][WA + c], w2 = A.in[I_CONVW][2 * WA + c], w3 = A.in[I_CONVW][3 * WA + c], cb = A.in[I_CONVB][c];
    int T, m0; float x3, x2, x1, h;
    if (prompt) { T = TP; m0 = b * TP; x3 = 0.f; x2 = 0.f; x1 = 0.f; h = 0.f; }
    else { T = TS; m0 = MP + b * TS; x3 = A.in[I_SCONV][(size_t)(b * 3 + 0) * WA + c]; x2 = A.in[I_SCONV][(size_t)(b * 3 + 1) * WA + c]; x1 = A.in[I_SCONV][(size_t)(b * 3 + 2) * WA + c]; h = A.in[I_SH][(size_t)b * WA + c]; }
    for (int t = 0; t < T; ++t) {
        const size_t m = (size_t)(m0 + t);
        const float xa = bf2f(Z[m * NZ + WA + c]), gate = bf2f(Z[m * NZ + c]);
        const float xc = cb + w0 * x3 + w1 * x2 + w2 * x1 + w3 * xa; x3 = x2; x2 = x1; x1 = xa;
        scr[j] = xc; LDS_WAIT(); asm volatile("" ::: "memory");
        float rp = br, gp = bi;
#pragma unroll
        for (int i4 = 0; i4 < 16; ++i4) { const f32x4 v = *(const LAS f32x4*)(scr + 4 * i4);
            rp += v[0] * wr[4 * i4] + v[1] * wr[4 * i4 + 1] + v[2] * wr[4 * i4 + 2] + v[3] * wr[4 * i4 + 3];
            gp += v[0] * wi[4 * i4] + v[1] * wi[4 * i4 + 1] + v[2] * wi[4 * i4 + 2] + v[3] * wi[4 * i4 + 3]; }
        LDS_WAIT(); asm volatile("" ::: "memory");
        const float r = sigmoidf_(rp), gi = sigmoidf_(gp);
        const float a = exp2f(r * L2);
        float mult = sqrtf(fmaxf(1.f - a * a, 0.f));
        if (prompt && t == 0) mult = 1.f;
        h = a * h + mult * gi * xc;
        Y[m * D + c] = (bf16)f2bf(gelu_tanh(gate) * h);
    }
    float* oc = F.out + (prompt ? O_CONVP : O_CONVS); float* oh = F.out + (prompt ? O_HP : O_HS);
    oc[(size_t)(b * 3 + 0) * WA + c] = x3; oc[(size_t)(b * 3 + 1) * WA + c] = x2; oc[(size_t)(b * 3 + 2) * WA + c] = x1;
    oh[(size_t)b * WA + c] = h;
}
__device__ __forceinline__ void s5_item_ref(Frame& F, const Args& A, bool prompt, int b, int g, LAS float* scr) {
    const int n = F.lane, gn = g * NS5 + n, k = F.lane & 15, part = F.lane >> 4;
    const bf16* Z = (const bf16*)(F.ws + WS_Z); bf16* Gy = (bf16*)(F.ws + WS_G); const float* sc = (const float*)(F.ws + WS_S5C);
    float bbr[16], bbi[16], cre[16], cim[16];
#pragma unroll
    for (int i = 0; i < 16; ++i) { bbr[i] = sc[SC_BBR + gn * KS5 + i]; bbi[i] = sc[SC_BBI + gn * KS5 + i];
        cre[i] = A.in[I_S5CRE][(size_t)(g * KS5 + k) * NS5 + part * 16 + i]; cim[i] = A.in[I_S5CIM][(size_t)(g * KS5 + k) * NS5 + part * 16 + i]; }
    const float abr = sc[SC_ABR + gn], abi = sc[SC_ABI + gn], dk = A.in[I_S5D][g * KS5 + k];
    int T, m0; float hr, hi;
    if (prompt) { T = TP; m0 = b * TP; hr = 0.f; hi = 0.f; }
    else { T = TS; m0 = MP + b * TS; hr = A.in[I_SSR][(size_t)(b * GB + g) * NS5 + n]; hi = A.in[I_SSI][(size_t)(b * GB + g) * NS5 + n]; }
    for (int t = 0; t < T; ++t) {
        const size_t m = (size_t)(m0 + t);
        const bf16* zr = Z + m * NZ + 2 * WA + g * KS5;
        const v4u u0 = *(const v4u*)zr, u1 = *(const v4u*)(zr + 8);
        float u[16];
        u[0] = pg8::bf_lo(u0.x); u[1] = pg8::bf_hi(u0.x); u[2] = pg8::bf_lo(u0.y); u[3] = pg8::bf_hi(u0.y); u[4] = pg8::bf_lo(u0.z); u[5] = pg8::bf_hi(u0.z); u[6] = pg8::bf_lo(u0.w); u[7] = pg8::bf_hi(u0.w);
        u[8] = pg8::bf_lo(u1.x); u[9] = pg8::bf_hi(u1.x); u[10] = pg8::bf_lo(u1.y); u[11] = pg8::bf_hi(u1.y); u[12] = pg8::bf_lo(u1.z); u[13] = pg8::bf_hi(u1.z); u[14] = pg8::bf_lo(u1.w); u[15] = pg8::bf_hi(u1.w);
        float bur = 0.f, bui = 0.f;
#pragma unroll
        for (int i = 0; i < 16; ++i) { bur += bbr[i] * u[i]; bui += bbi[i] * u[i]; }
        const float nhr = abr * hr - abi * hi + bur, nhi = abr * hi + abi * hr + bui; hr = nhr; hi = nhi;
        scr[n] = hr; scr[64 + n] = hi; LDS_WAIT(); asm volatile("" ::: "memory");
        float p = 0.f;
#pragma unroll
        for (int i4 = 0; i4 < 4; ++i4) { const f32x4 vr = *(const LAS f32x4*)(scr + part * 16 + 4 * i4), vi = *(const LAS f32x4*)(scr + 64 + part * 16 + 4 * i4);
#pragma unroll
            for (int e = 0; e < 4; ++e) p += vr[e] * cre[4 * i4 + e] - vi[e] * cim[4 * i4 + e]; }
        LDS_WAIT(); asm volatile("" ::: "memory");
        p += __shfl_xor(p, 16); p += __shfl_xor(p, 32);
        const float uk = bf2f(zr[k]);
        if (F.lane < 16) Gy[m * WB + g * KS5 + k] = (bf16)f2bf(gelu_tanh(p + dk * uk));
    }
    float* osr = F.out + (prompt ? O_SRP : O_SRS); float* osi = F.out + (prompt ? O_SIP : O_SIS);
    osr[(size_t)(b * GB + g) * NS5 + n] = hr; osi[(size_t)(b * GB + g) * NS5 + n] = hi;
}

typedef short bf16x8v __attribute__((ext_vector_type(8)));
typedef float f32x16 __attribute__((ext_vector_type(16)));
typedef float f32x2v __attribute__((ext_vector_type(2)));
typedef __bf16 bf16x2v __attribute__((ext_vector_type(2)));
#define MFMA32(a, b, c) __builtin_amdgcn_mfma_f32_32x32x16_bf16((a), (b), (c), 0, 0, 0)
__device__ __forceinline__ unsigned pkbf(float a, float b) { const f32x2v v = {a, b}; const bf16x2v r = __builtin_convertvector(v, bf16x2v); return __builtin_bit_cast(unsigned, r); }
template <int CTRL> __device__ __forceinline__ float dppf(float old, float v) { return __builtin_bit_cast(float, __builtin_amdgcn_update_dpp(__builtin_bit_cast(int, old), __builtin_bit_cast(int, v), CTRL, 0xF, 0xF, false)); }
__device__ __forceinline__ f32x16 ld16(const float* p) { f32x16 r;
#pragma unroll
    for (int i = 0; i < 4; ++i) { const f32x4 v = *(const f32x4*)(p + 4 * i); r[4 * i] = v[0]; r[4 * i + 1] = v[1]; r[4 * i + 2] = v[2]; r[4 * i + 3] = v[3]; }
    return r; }
__device__ __forceinline__ f32x16 ld16l(const LAS float* p) { f32x16 r;
#pragma unroll
    for (int i = 0; i < 4; ++i) { const f32x4 v = *(const LAS f32x4*)(p + 4 * i); r[4 * i] = v[0]; r[4 * i + 1] = v[1]; r[4 * i + 2] = v[2]; r[4 * i + 3] = v[3]; }
    return r; }
__device__ __forceinline__ bf16x8v pack8(const f32x16& x, int s) { v4u p; p.x = pkbf(x[8 * s], x[8 * s + 1]); p.y = pkbf(x[8 * s + 2], x[8 * s + 3]); p.z = pkbf(x[8 * s + 4], x[8 * s + 5]); p.w = pkbf(x[8 * s + 6], x[8 * s + 7]); return __builtin_bit_cast(bf16x8v, p); }
template <int CTRL> __device__ __forceinline__ void s5_scan_step(f32x16& xr, f32x16& xi, const f32x16& zr, const f32x16& zi) {
#pragma unroll
    for (int i = 0; i < 16; ++i) { const float sr = dppf<CTRL>(0.f, xr[i]), si = dppf<CTRL>(0.f, xi[i]);
        xr[i] += zr[i] * sr - zi[i] * si; xi[i] += zr[i] * si + zi[i] * sr; }
}
constexpr int S5L_BF1 = 0, S5L_BF2 = 4096, S5L_TOT = 12288, S5L_CAR = 20480, S5L_ZP = 28672  , S5L_TA = 37376  , S5L_U = 38912  ;
template <bool SECOND>
__device__ __forceinline__ void s5_step(LAS unsigned char* L, int lane, const bf16x8v u, f32x16& hr0, f32x16& hr1, f32x16& hi0, f32x16& hi1,
                                        const f32x16& ar0, const f32x16& ar1, const f32x16& ai0, const f32x16& ai1, const float (&dk)[8], bf16* gout) {
    const LAS bf16x8v* a1 = (const LAS bf16x8v*)(L + S5L_BF1) + lane;
    { const f32x16 cr = ar0 * hr0 - ai0 * hi0, ci = ar0 * hi0 + ai0 * hr0; hr0 = MFMA32(a1[0], u, cr); hi0 = MFMA32(a1[128], u, ci); }
    asm volatile("" : "+v"(hr0), "+v"(hi0));
    { const f32x16 cr = ar1 * hr1 - ai1 * hi1, ci = ar1 * hi1 + ai1 * hr1; hr1 = MFMA32(a1[64], u, cr); hi1 = MFMA32(a1[192], u, ci); }
    if (SECOND) {
        const LAS bf16x8v* a2 = (const LAS bf16x8v*)(L + S5L_BF2) + lane;
        f32x16 y;
#pragma unroll
        for (int i = 0; i < 16; ++i) y[i] = 0.f;
        y = MFMA32(a2[0 * 64], pack8(hr0, 0), y); y = MFMA32(a2[1 * 64], pack8(hr0, 1), y);
        y = MFMA32(a2[2 * 64], pack8(hr1, 0), y); y = MFMA32(a2[3 * 64], pack8(hr1, 1), y);
        y = MFMA32(a2[4 * 64], pack8(hi0, 0), y); y = MFMA32(a2[5 * 64], pack8(hi0, 1), y);
        y = MFMA32(a2[6 * 64], pack8(hi1, 0), y); y = MFMA32(a2[7 * 64], pack8(hi1, 1), y);
        const v4u uw = __builtin_bit_cast(v4u, u);
        float o[8];
        o[0] = gelu_tanh(y[0] + dk[0] * pg8::bf_lo(uw.x)); o[1] = gelu_tanh(y[1] + dk[1] * pg8::bf_hi(uw.x));
        o[2] = gelu_tanh(y[2] + dk[2] * pg8::bf_lo(uw.y)); o[3] = gelu_tanh(y[3] + dk[3] * pg8::bf_hi(uw.y));
        o[4] = gelu_tanh(y[4] + dk[4] * pg8::bf_lo(uw.z)); o[5] = gelu_tanh(y[5] + dk[5] * pg8::bf_hi(uw.z));
        o[6] = gelu_tanh(y[6] + dk[6] * pg8::bf_lo(uw.w)); o[7] = gelu_tanh(y[7] + dk[7] * pg8::bf_hi(uw.w));
        v4u w; w.x = pkbf(o[0], o[1]); w.y = pkbf(o[2], o[3]); w.z = pkbf(o[4], o[5]); w.w = pkbf(o[6], o[7]);
        pg8::st16_wt(gout, w);
    }
}
__device__ __forceinline__ void s5_item_fast(Frame& F, const Args& A, int b, int g) {
    refresh(F);
    const int lane = F.lane, q = lane & 31, hh = lane >> 5, w = F.wave, c = w * 32 + q;
    LAS unsigned char* L = F.lds + RING_OFF;
    const unsigned char* tab = F.ws + WS_TAB;
    const size_t m0 = (size_t)b * TP + (size_t)8 * c;
    const bf16* zrow = (const bf16*)(F.ws + WS_Z) + m0 * NZ + 2 * WA + g * KS5 + 8 * hh;
    bf16* grow = (bf16*)(F.ws + WS_G) + m0 * WB + g * KS5 + 8 * hh;
    LAS v4u* UL = (LAS v4u*)(L + S5L_U) + F.tid;
    {
        v4u uu[8];
#pragma unroll
        for (int j = 0; j < 8; ++j) uu[j] = *(const v4u*)(zrow + (size_t)j * NZ);
        const v4u* s1 = (const v4u*)(tab + TB_BF1) + (size_t)g * 256; const v4u* s2 = (const v4u*)(tab + TB_BF2) + (size_t)g * 512;
        if (F.tid < 256) ((LAS v4u*)(L + S5L_BF1))[F.tid] = s1[F.tid];
        ((LAS v4u*)(L + S5L_BF2))[F.tid] = s2[F.tid];
        const v4u* s3 = (const v4u*)(tab + TB_ZP) + (size_t)g * (17 * 128 / 4); for (int e = F.tid; e < 17 * 128 / 4; e += NWAVES * 64) ((LAS v4u*)(L + S5L_ZP))[e] = s3[e];
        if (F.tid < 32) ((LAS v4u*)(L + S5L_TA))[F.tid] = ((const v4u*)(tab + TB_TA) + (size_t)g * 32)[F.tid];
#pragma unroll
        for (int j = 0; j < 8; ++j) UL[512 * j] = uu[j];
    }
    __syncthreads();
    const LAS float* TA = (const LAS float*)(L + S5L_TA) + hh * 64;
    f32x16 ar0 = ld16l(TA), ar1 = ld16l(TA + 16), ai0 = ld16l(TA + 32), ai1 = ld16l(TA + 48);
    f32x16 hr0, hr1, hi0, hi1;
#pragma unroll
    for (int i = 0; i < 16; ++i) { hr0[i] = 0.f; hr1[i] = 0.f; hi0[i] = 0.f; hi1[i] = 0.f; }
    float dk[8];
#pragma unroll
    for (int i = 0; i < 8; ++i) dk[i] = A.in[I_S5D][g * KS5 + 8 * hh + i];
#pragma unroll 1
    for (int j = 0; j < 8; ++j) { const bf16x8v u = __builtin_bit_cast(bf16x8v, UL[512 * j]);
        s5_step<false>(L, lane, u, hr0, hr1, hi0, hi1, ar0, ar1, ai0, ai1, dk, nullptr); }
    const LAS float* ZP = (const LAS float*)(L + S5L_ZP);
#define S5_SCAN(E, CTRL) do { const LAS float* z = ZP + (((E) * 2 + hh) * 2) * 32; \
        { const f32x16 zr = ld16l(z), zi = ld16l(z + 32); s5_scan_step<CTRL>(hr0, hi0, zr, zi); } \
        asm volatile("" : "+v"(hr0), "+v"(hi0) :: "memory"); \
        { const f32x16 zr = ld16l(z + 16), zi = ld16l(z + 48); s5_scan_step<CTRL>(hr1, hi1, zr, zi); } \
        asm volatile("" : "+v"(hr1), "+v"(hi1) :: "memory"); } while (0)
    S5_SCAN(1, 0x111); S5_SCAN(2, 0x112); S5_SCAN(4, 0x114); S5_SCAN(8, 0x118);
#undef S5_SCAN
    const int seg = w * 2 + (q >> 4);
    LAS float* TOT = (LAS float*)(L + S5L_TOT); LAS float* CAR = (LAS float*)(L + S5L_CAR);
    if ((lane & 15) == 15) {
#pragma unroll
        for (int rho = 0; rho < 4; ++rho) {
            *(LAS f32x4*)(TOT + (seg * 2 + 0) * 64 + 0 + 8 * rho + 4 * hh) = (f32x4){hr0[4 * rho], hr0[4 * rho + 1], hr0[4 * rho + 2], hr0[4 * rho + 3]};
            *(LAS f32x4*)(TOT + (seg * 2 + 0) * 64 + 32 + 8 * rho + 4 * hh) = (f32x4){hr1[4 * rho], hr1[4 * rho + 1], hr1[4 * rho + 2], hr1[4 * rho + 3]};
            *(LAS f32x4*)(TOT + (seg * 2 + 1) * 64 + 0 + 8 * rho + 4 * hh) = (f32x4){hi0[4 * rho], hi0[4 * rho + 1], hi0[4 * rho + 2], hi0[4 * rho + 3]};
            *(LAS f32x4*)(TOT + (seg * 2 + 1) * 64 + 32 + 8 * rho + 4 * hh) = (f32x4){hi1[4 * rho], hi1[4 * rho + 1], hi1[4 * rho + 2], hi1[4 * rho + 3]}; }
    }
    __syncthreads();
    if (F.tid < 64) {
        const float* z16 = (const float*)(tab + TB_Z16N) + (size_t)g * 128; const float zr = z16[F.tid], zi = z16[64 + F.tid];
        float cr = 0.f, ci = 0.f;
#pragma unroll
        for (int sg = 0; sg < 16; ++sg) { CAR[(sg * 2 + 0) * 64 + F.tid] = cr; CAR[(sg * 2 + 1) * 64 + F.tid] = ci;
            const float tr = TOT[(sg * 2 + 0) * 64 + F.tid], ti = TOT[(sg * 2 + 1) * 64 + F.tid];
            const float ncr = zr * cr - zi * ci + tr, nci = zr * ci + zi * cr + ti; cr = ncr; ci = nci; }
    }
    __syncthreads();
    {
        const LAS float* z = ZP + (((q & 15) * 2 + hh) * 2) * 32;
#define S5_EXCL(HR, HI, OFF) do { const f32x16 zr = ld16l(z + (OFF)), zi = ld16l(z + 32 + (OFF)); f32x16 kr, ki; \
        _Pragma("unroll") for (int rho = 0; rho < 4; ++rho) { \
            const f32x4 a0 = *(const LAS f32x4*)(CAR + (seg * 2 + 0) * 64 + 2 * (OFF) + 8 * rho + 4 * hh), b0 = *(const LAS f32x4*)(CAR + (seg * 2 + 1) * 64 + 2 * (OFF) + 8 * rho + 4 * hh); \
            _Pragma("unroll") for (int e = 0; e < 4; ++e) { kr[4 * rho + e] = a0[e]; ki[4 * rho + e] = b0[e]; } } \
        _Pragma("unroll") for (int i = 0; i < 16; ++i) { const float sr = dppf<0x111>(0.f, HR[i]), si = dppf<0x111>(0.f, HI[i]); \
            HR[i] = sr + zr[i] * kr[i] - zi[i] * ki[i]; HI[i] = si + zr[i] * ki[i] + zi[i] * kr[i]; } } while (0)
        S5_EXCL(hr0, hi0, 0); asm volatile("" : "+v"(hr0), "+v"(hi0) :: "memory"); S5_EXCL(hr1, hi1, 16); asm volatile("" : "+v"(hr1), "+v"(hi1) :: "memory");
#undef S5_EXCL
    }
    { int off = 0; asm volatile("" : "+v"(off)); const LAS float* TA2 = TA + off; ar0 = ld16l(TA2); ar1 = ld16l(TA2 + 16); ai0 = ld16l(TA2 + 32); ai1 = ld16l(TA2 + 48); }
#pragma unroll 1
    for (int j = 0; j < 8; ++j) { const bf16x8v u = __builtin_bit_cast(bf16x8v, UL[512 * j]);
        s5_step<true>(L, lane, u, hr0, hr1, hi0, hi1, ar0, ar1, ai0, ai1, dk, grow + (size_t)j * WB); }
    if (w == NWAVES - 1 && q == 31) {
        float* osr = F.out + O_SRP + (size_t)(b * GB + g) * NS5; float* osi = F.out + O_SIP + (size_t)(b * GB + g) * NS5;
#pragma unroll
        for (int i = 0; i < 16; ++i) { const int n = (i & 3) + 8 * (i >> 2) + 4 * hh; osr[n] = hr0[i]; osr[32 + n] = hr1[i]; osi[n] = hi0[i]; osi[32 + n] = hi1[i]; }
    }
    __syncthreads();
}

__device__ __forceinline__ void s5_item_sample(Frame& F, const Args& A, int g) {
    refresh(F);
    const int lane = F.lane, q = lane & 31, hh = lane >> 5, w = F.wave;
    LAS unsigned char* L = F.lds + RING_OFF;
    const unsigned char* tab = F.ws + WS_TAB;
    { const v4u* s1 = (const v4u*)(tab + TB_BF1) + (size_t)g * 256; const v4u* s2 = (const v4u*)(tab + TB_BF2) + (size_t)g * 512;
      if (F.tid < 256) ((LAS v4u*)(L + S5L_BF1))[F.tid] = s1[F.tid];
      ((LAS v4u*)(L + S5L_BF2))[F.tid] = s2[F.tid]; }
    __syncthreads();
    if (w < 4) {
        const int b = w * 32 + q;
        const float* TA = (const float*)(tab + TB_TA) + (size_t)((g * 2 + hh) * 2) * 32;
        const f32x16 ar0 = ld16(TA), ar1 = ld16(TA + 16), ai0 = ld16(TA + 32), ai1 = ld16(TA + 48);
        f32x16 hr0, hr1, hi0, hi1;
        const float* sr = A.in[I_SSR] + (size_t)(b * GB + g) * NS5; const float* si = A.in[I_SSI] + (size_t)(b * GB + g) * NS5;
#pragma unroll
        for (int rho = 0; rho < 4; ++rho) { const f32x4 a0 = *(const f32x4*)(sr + 8 * rho + 4 * hh), a1 = *(const f32x4*)(sr + 32 + 8 * rho + 4 * hh), b0 = *(const f32x4*)(si + 8 * rho + 4 * hh), b1 = *(const f32x4*)(si + 32 + 8 * rho + 4 * hh);
#pragma unroll
            for (int e = 0; e < 4; ++e) { hr0[4 * rho + e] = a0[e]; hr1[4 * rho + e] = a1[e]; hi0[4 * rho + e] = b0[e]; hi1[4 * rho + e] = b1[e]; } }
        float dk[8];
#pragma unroll
        for (int i = 0; i < 8; ++i) dk[i] = A.in[I_S5D][g * KS5 + 8 * hh + i];
        const size_t m0 = (size_t)MP + (size_t)b * TS;
        const bf16* zrow = (const bf16*)(F.ws + WS_Z) + m0 * NZ + 2 * WA + g * KS5 + 8 * hh;
        bf16* grow = (bf16*)(F.ws + WS_G) + m0 * WB + g * KS5 + 8 * hh;
        bf16x8v uu[TS];
#pragma unroll
        for (int j = 0; j < TS; ++j) uu[j] = *(const bf16x8v*)(zrow + (size_t)j * NZ);
#pragma unroll
        for (int j = 0; j < TS; ++j) s5_step<true>(L, lane, uu[j], hr0, hr1, hi0, hi1, ar0, ar1, ai0, ai1, dk, grow + (size_t)j * WB);
        float* osr = F.out + O_SRS + (size_t)(b * GB + g) * NS5; float* osi = F.out + O_SIS + (size_t)(b * GB + g) * NS5;
#pragma unroll
        for (int rho = 0; rho < 4; ++rho) {
            *(f32x4*)(osr + 8 * rho + 4 * hh) = (f32x4){hr0[4 * rho], hr0[4 * rho + 1], hr0[4 * rho + 2], hr0[4 * rho + 3]};
            *(f32x4*)(osr + 32 + 8 * rho + 4 * hh) = (f32x4){hr1[4 * rho], hr1[4 * rho + 1], hr1[4 * rho + 2], hr1[4 * rho + 3]};
            *(f32x4*)(osi + 8 * rho + 4 * hh) = (f32x4){hi0[4 * rho], hi0[4 * rho + 1], hi0[4 * rho + 2], hi0[4 * rho + 3]};
            *(f32x4*)(osi + 32 + 8 * rho + 4 * hh) = (f32x4){hi1[4 * rho], hi1[4 * rho + 1], hi1[4 * rho + 2], hi1[4 * rho + 3]}; }
    }
    __syncthreads();
}

template <int CTRL, int RMASK> __device__ __forceinline__ float dppm(float old, float v) { return __builtin_bit_cast(float, __builtin_amdgcn_update_dpp(__builtin_bit_cast(int, old), __builtin_bit_cast(int, v), CTRL, RMASK, 0xF, false)); }
template <int CTRL, int RMASK> __device__ __forceinline__ void rg_scan_step(f32x16& a, f32x16& b) {
#pragma unroll
    for (int i = 0; i < 16; ++i) { const float as = dppm<CTRL, RMASK>(1.f, a[i]), bs = dppm<CTRL, RMASK>(0.f, b[i]); b[i] = a[i] * bs + b[i]; a[i] = a[i] * as; }
}
constexpr int RGL_AFR = 0, RGL_DG = 8192, RGL_TOT = 24576, RGL_CST = 28672;
constexpr int RGL_XAP = 144;
constexpr int RGL_XA0 = 29696, RGL_BUF = 37376;
static_assert(259 * RGL_XAP <= RGL_BUF && RGL_XA0 + 2 * RGL_BUF <= RING_BYTES && RGL_CST + 640 <= RGL_XA0, "RG-LRU LDS map");
template <bool SAMPLE>
__device__ __forceinline__ void rg_item_fast(Frame& F, const Args& A, int b, int hd, int jh) {
    refresh(F);
    const int lane = F.lane, q = lane & 31, hh = lane >> 5, w = F.wave;
    LAS unsigned char* L = F.lds + RING_OFF;
    const float* sc = (const float*)(F.ws + WS_S5C);
    const bf16* Zb = (const bf16*)(F.ws + WS_Z) + (size_t)(SAMPLE ? MP : b * TP) * NZ; bf16* Yb = (bf16*)(F.ws + WS_YCAT) + (size_t)(SAMPLE ? MP : b * TP) * D;
    const bf16* CB = (const bf16*)(F.ws + WS_TAB + TB_CB);
    auto stage_load = [&](int T0, v4u (&st)[5]) {
#pragma unroll
        for (int k = 0; k < 5; ++k) { const int ci = F.tid + 512 * k; v4u v = (v4u){0u, 0u, 0u, 0u};
            if (ci < 2072) { const int tk = T0 - 3 + (ci >> 3); if (tk >= 0) v = *(const v4u*)(Zb + (size_t)tk * NZ + WA + hd * 64 + (ci & 7) * 8); }
            st[k] = v; } };
    auto stage_write = [&](int par, const v4u (&st)[5]) {
#pragma unroll
        for (int k = 0; k < 5; ++k) { const int ci = F.tid + 512 * k;
            if (ci < 2072) *(LAS v4u*)(L + RGL_XA0 + par * RGL_BUF + (ci >> 3) * RGL_XAP + (ci & 7) * 16) = st[k]; } };
    {
        const v4u* src = (const v4u*)(F.ws + WS_TAB + TB_RG) + (size_t)((hd * 2 + jh) * 8) * 64;
        ((LAS v4u*)(L + RGL_AFR))[F.tid] = src[F.tid];
        const v4u* sd = (const v4u*)(F.ws + WS_TAB + TB_DG) + (size_t)(hd * 16) * 64;
        ((LAS v4u*)(L + RGL_DG))[F.tid] = sd[F.tid]; ((LAS v4u*)(L + RGL_DG))[512 + F.tid] = sd[512 + F.tid];
        if (F.tid < 160) { const int h2 = F.tid / 80, kind = (F.tid % 80) / 16, i = F.tid % 16, cr = (i & 3) + 8 * (i >> 2) + 4 * h2;
            const int c = hd * 64 + 32 * jh + cr;
            ((LAS float*)(L + RGL_CST))[F.tid] = kind == 0 ? A.in[I_RGBR][c] : kind == 1 ? A.in[I_RGBI][c] : kind == 2 ? sc[SC_RGL + c] : A.in[I_CONVB][hd * 64 + 32 * (kind - 3) + cr]; }
        if (!SAMPLE && jh == 0 && F.tid < 192) { const int k = F.tid >> 6, ch = F.tid & 63;
            F.out[O_CONVP + (size_t)(b * 3 + k) * WA + hd * 64 + ch] = bf2f(((const bf16*)(F.ws + WS_Z))[(size_t)(b * TP + TP - 3 + k) * NZ + WA + hd * 64 + ch]); }
        if (SAMPLE && jh == 0) { for (int e = F.tid; e < NBS * 3 * 64; e += NWAVES * 64) { const int bb = e / 192, k = (e / 64) % 3, ch = e & 63;
            F.out[O_CONVS + (size_t)(bb * 3 + k) * WA + hd * 64 + ch] = bf2f(((const bf16*)(F.ws + WS_Z))[(size_t)(MP + bb * TS + 1 + k) * NZ + WA + hd * 64 + ch]); } }
        if (!SAMPLE) { v4u st[5]; stage_load(0, st); stage_write(0, st); }
    }
    __syncthreads();
    float hround[16];
#pragma unroll
    for (int i = 0; i < 16; ++i) hround[i] = 0.f;
    const LAS float* CST = (const LAS float*)(L + RGL_CST) + hh * 80;
    const LAS bf16x8v* af = (const LAS bf16x8v*)(L + RGL_AFR) + lane;
    const LAS bf16x8v* dg = (const LAS bf16x8v*)(L + RGL_DG) + lane;
#pragma unroll 1
    for (int rd = 0; rd < (SAMPLE ? 2 : 8); ++rd) {
        const int t = rd * 256 + w * 32 + q;
        v4u stn[5];
        if (!SAMPLE) stage_load((rd + 1) * 256, stn);
        const LAS unsigned char* XAp = L + RGL_XA0 + (rd & 1) * RGL_BUF + (w * 32 + q) * RGL_XAP + 16 * hh;
        const bf16* zsr[4];
        if (SAMPLE) {
#pragma unroll
            for (int k = 0; k < 4; ++k) { const int jx = (t & 3) + k; zsr[k] = (jx < 3 ? CB + (size_t)((t >> 2) * 3 + jx) * WA : Zb + (size_t)(t - 3 + k) * NZ + WA) + hd * 64 + 8 * hh; } }
        const bf16* gr = Zb + (size_t)t * NZ + hd * 64 + 32 * jh + 4 * hh;
        unsigned long long gq[4];
#pragma unroll
        for (int rho = 0; rho < 4; ++rho) gq[rho] = *(const unsigned long long*)(gr + 8 * rho);
        f32x16 dx0, dx1;
        { const f32x4 c0 = *(const LAS f32x4*)(CST + 48), c1 = *(const LAS f32x4*)(CST + 52), c2 = *(const LAS f32x4*)(CST + 56), c3 = *(const LAS f32x4*)(CST + 60);
          const f32x4 e0 = *(const LAS f32x4*)(CST + 64), e1 = *(const LAS f32x4*)(CST + 68), e2 = *(const LAS f32x4*)(CST + 72), e3 = *(const LAS f32x4*)(CST + 76);
#pragma unroll
          for (int e = 0; e < 4; ++e) { dx0[e] = c0[e]; dx0[4 + e] = c1[e]; dx0[8 + e] = c2[e]; dx0[12 + e] = c3[e]; dx1[e] = e0[e]; dx1[4 + e] = e1[e]; dx1[8 + e] = e2[e]; dx1[12 + e] = e3[e]; } }
#pragma unroll
        for (int k = 0; k < 4; ++k)
#pragma unroll
            for (int s4 = 0; s4 < 4; ++s4) {
                const bf16x8v xb = SAMPLE ? *(const bf16x8v*)(zsr[k] + 16 * s4) : *(const LAS bf16x8v*)(XAp + k * RGL_XAP + s4 * 32);
                if (s4 < 2) dx0 = MFMA32(dg[((0 * 2 + (s4 & 1)) * 4 + k) * 64], xb, dx0); else dx1 = MFMA32(dg[((1 * 2 + (s4 & 1)) * 4 + k) * 64], xb, dx1);
                if (s4 == 3) asm volatile("" : "+v"(dx0), "+v"(dx1) :: "memory"); }
        f32x16 dr, di;
#pragma unroll
        for (int i = 0; i < 16; ++i) { dr[i] = 0.f; di[i] = 0.f; }
        { const bf16x8v b00 = pack8(dx0, 0), b01 = pack8(dx0, 1), b10 = pack8(dx1, 0), b11 = pack8(dx1, 1);
          dr = MFMA32(af[0 * 64], b00, dr); di = MFMA32(af[4 * 64], b00, di); dr = MFMA32(af[1 * 64], b01, dr); di = MFMA32(af[5 * 64], b01, di);
          dr = MFMA32(af[2 * 64], b10, dr); di = MFMA32(af[6 * 64], b10, di); dr = MFMA32(af[3 * 64], b11, dr); di = MFMA32(af[7 * 64], b11, di); }
        f32x16 av, bv;
        const bool first = !SAMPLE && (t == 0);
#pragma unroll
        for (int i = 0; i < 16; ++i) { const float xcv = jh ? dx1[i] : dx0[i];
            const float r = sigmoidf_(dr[i] + CST[i]), gi = sigmoidf_(di[i] + CST[16 + i]);
            const float a = __builtin_amdgcn_exp2f(r * CST[32 + i]);
            float mult = __builtin_amdgcn_sqrtf(fmaxf(1.f - a * a, 0.f)); if (first) mult = 1.f;
            av[i] = a; bv[i] = mult * gi * xcv; }
        if (SAMPLE && (t & 3) == 0) {
            const float* h0 = A.in[I_SH] + (size_t)(t >> 2) * WA + hd * 64 + 32 * jh + 4 * hh;
#pragma unroll
            for (int i = 0; i < 16; ++i) { bv[i] += av[i] * h0[(i & 3) + 8 * (i >> 2)]; av[i] = 0.f; } }
        rg_scan_step<0x111, 0xF>(av, bv); rg_scan_step<0x112, 0xF>(av, bv); rg_scan_step<0x114, 0xF>(av, bv); rg_scan_step<0x118, 0xF>(av, bv);
        rg_scan_step<0x142, 0xA>(av, bv);
        float hin[16];
#pragma unroll
        for (int i = 0; i < 16; ++i) hin[i] = 0.f;
        if (!SAMPLE) {
        LAS float* TOT = (LAS float*)(L + RGL_TOT) + (rd & 1) * 512;
        if (q == 31) {
#pragma unroll
            for (int i4 = 0; i4 < 4; ++i4) { *(LAS f32x4*)(TOT + (w * 2 + 0) * 32 + hh * 16 + 4 * i4) = (f32x4){av[4 * i4], av[4 * i4 + 1], av[4 * i4 + 2], av[4 * i4 + 3]};
                                             *(LAS f32x4*)(TOT + (w * 2 + 1) * 32 + hh * 16 + 4 * i4) = (f32x4){bv[4 * i4], bv[4 * i4 + 1], bv[4 * i4 + 2], bv[4 * i4 + 3]}; }
        }
        stage_write((rd + 1) & 1, stn);
        __syncthreads();
#pragma unroll
        for (int w2 = 0; w2 < 8; ++w2) {
            if (w2 == w) {
#pragma unroll
                for (int i = 0; i < 16; ++i) hin[i] = hround[i]; }
#pragma unroll
            for (int i4 = 0; i4 < 4; ++i4) { const f32x4 p = *(const LAS f32x4*)(TOT + (w2 * 2 + 0) * 32 + hh * 16 + 4 * i4), hl = *(const LAS f32x4*)(TOT + (w2 * 2 + 1) * 32 + hh * 16 + 4 * i4);
#pragma unroll
                for (int e = 0; e < 4; ++e) hround[4 * i4 + e] = p[e] * hround[4 * i4 + e] + hl[e]; }
        }
        }
        bf16* yr = Yb + (size_t)t * D + hd * 64 + 32 * jh + 4 * hh;
#pragma unroll
        for (int rho = 0; rho < 4; ++rho) { const unsigned glo = (unsigned)gq[rho], ghi = (unsigned)(gq[rho] >> 32);
            const float o0 = gelu_tanh(pg8::bf_lo(glo)) * (bv[4 * rho] + av[4 * rho] * hin[4 * rho]), o1 = gelu_tanh(pg8::bf_hi(glo)) * (bv[4 * rho + 1] + av[4 * rho + 1] * hin[4 * rho + 1]);
            const float o2 = gelu_tanh(pg8::bf_lo(ghi)) * (bv[4 * rho + 2] + av[4 * rho + 2] * hin[4 * rho + 2]), o3 = gelu_tanh(pg8::bf_hi(ghi)) * (bv[4 * rho + 3] + av[4 * rho + 3] * hin[4 * rho + 3]);
            *(unsigned long long*)(yr + 8 * rho) = (unsigned long long)pkbf(o0, o1) | ((unsigned long long)pkbf(o2, o3) << 32); }
        if (SAMPLE && (t & 3) == 3) {
#pragma unroll
            for (int i = 0; i < 16; ++i) F.out[O_HS + (size_t)(t >> 2) * WA + hd * 64 + 32 * jh + (i & 3) + 8 * (i >> 2) + 4 * hh] = bv[i]; }
    }
    if (!SAMPLE && w == 0 && q == 0) {
#pragma unroll
        for (int i = 0; i < 16; ++i) F.out[O_HP + (size_t)b * WA + hd * 64 + 32 * jh + (i & 3) + 8 * (i >> 2) + 4 * hh] = hround[i];
    }
    __syncthreads();
}

#ifndef PROBE_P3PART
#define PROBE_P3PART 7
#endif
__device__ __forceinline__ void p3_mixers_ref(Frame& F, const Args& A, int rep = 0) {
    constexpr int N_RGP = NBP * HA, N_S5P = NBP * GB;
    const int pm = rep ? PROBE_P3PART : 7;
    bf16* GY = (bf16*)(F.ws + WS_G); bf16* YC = (bf16*)(F.ws + WS_YCAT);
    pg8::Gemm gg{GY, (const bf16*)(F.ws + WS_WGLU), M, WB, WB}; pg8::EpiGlu EG{GY, WB, YC, D, WA, A.in[I_GLUB]};
    pg8::OneUnit SG; SG.u0.pm = 0; SG.u0.pn = 0; SG.u0.k0 = 0; SG.u0.nkt = WB / 64; SG.u0.ks = 0; bool has_glu = false;
    if (F.vcu < 2 * N_RGP) {
        if ((pm & 4) && F.vcu < GB) { s5_item_sample(F, A, F.vcu); cnt_arrive_wt(F, CW_S5B + 64 * NBP); }
        if (pm & 1) rg_item_fast<false>(F, A, F.vcu / (2 * HA), (F.vcu / 2) % HA, F.vcu & 1);
        if (pm & 4) { if (F.vcu < GB) { }
                      else if (F.vcu < GB + 2 * HA) rg_item_fast<true>(F, A, 0, (F.vcu - GB) >> 1, (F.vcu - GB) & 1);
                      else if (F.vcu < GB + 2 * HA + 4) {
                          cnt_wait_ge(F, CW_S5B + 64 * NBP, (unsigned)GB); const int u = F.vcu - GB - 2 * HA; SG.u0.pm = MP / 256 + (u >> 1); SG.u0.pn = u & 1; has_glu = true; } }
    } else {
        const int v = F.vcu - 2 * N_RGP, it = 2 * v, bb = it / GB;
        if (pm & 2) { s5_item_fast(F, A, bb, it % GB);
                      s5_item_fast(F, A, bb, (it + 1) % GB);
                      cnt_arrive_wt(F, CW_S5B + 64 * bb);
                      cnt_wait_ge(F, CW_S5B + 64 * bb, 16u);
                      const int u = v & 15; SG.u0.pm = 8 * bb + (u >> 1); SG.u0.pn = u & 1; has_glu = true; }
    }
    if (has_glu) pg8::gemm_phase<pg8::EpiGlu, pg8::OneUnit, false, PG8_SP2>(F.lds + RING_OFF, gg, SG, EG);
    if (rep == 0 && F.vcu >= GB + 2 * HA + 4 && F.vcu < 2 * N_RGP) {
        constexpr int X0 = GB + 2 * HA + 4, NX = 2 * N_RGP - X0;
        LAS float* scr = (LAS float*)(F.lds + RING_OFF + F.wave * 16384);
        for (int it = XO_2 + F.wave * NX + (F.vcu - X0); it < XO_END; it += NX * NWAVES) xpose_item(F, A, scr, it); }
}

template <bool SECOND>
__device__ __forceinline__ void ln_phase(Frame& F, const Args& A, int rep) {
    pg8::StaticOrder P; P.init(MP, D, F.G, (int)blockIdx.x, D); pg8::Unit u; P.next(0, u);
    cnt_wait_ge(F, (SECOND ? CW_T2 : CW_T1) + 64 * u.pm, 4u);
    ln_rows<SECOND>(F, A, u.pm * 256 + u.pn * 64, u.pm * 256 + u.pn * 64 + 64, F.wave, NWAVES);
    constexpr int NPC = 2 * (D / 256) * (SECOND ? NS_DOWN : NS_OUT);
    const int si = (int)blockIdx.x - (F.G - NPC);
    if (si >= 0) { cnt_wait_ge(F, SECOND ? CW_T2S : CW_T1S, (unsigned)NPC);
        ln_rows<SECOND>(F, A, MP + si * (MS / NPC), MP + (si + 1) * (MS / NPC), F.wave, NWAVES); }
}
__global__ void __launch_bounds__(NWAVES * 64, 2) fwd(Args A) {
    extern __shared__ __attribute__((aligned(16))) unsigned char lds[];
    Frame F;
    F.lds = (LAS unsigned char*)lds;
    F.MISC = (volatile LAS unsigned*)(F.lds + MISC_OFF);
    F.tid = threadIdx.x; F.lane = F.tid & 63; F.wave = __builtin_amdgcn_readfirstlane(F.tid >> 6);
    F.G = gridDim.x; { const int bx = blockIdx.x; F.vcu = (F.G % 8 == 0) ? (bx % 8) * (F.G / 8) + bx / 8 : bx; }
    F.out = A.out; F.ws = A.ws; F.ctl = (gu32*)(A.ws + WS_CTL);
    for (int u = F.tid; u < (LDS_BYTES - LDSCTL_OFF) / 4; u += NWAVES * 64) ((LAS unsigned*)(F.lds + LDSCTL_OFF))[u] = 0u;
    __syncthreads();
    XcdBarrier bar; bar.bar = (unsigned*)(F.ctl + CW_BAR); bar.x = 0; bar.st = nullptr;
    if (N_LAUNCHES == 1) bar = xcd_barrier_post((unsigned*)(F.ctl + CW_BAR), F.MISC + 8);
#define GRID_BAR() do { if (N_LAUNCHES == 1) xcd_barrier(bar); } while (0)
    const int lo = A.ph_lo, hi = A.ph_hi;
#define IN(k) (lo <= (k) && (k) < hi)
#define BOTH(k) (IN(k) && IN((k) + 1))
    bf16* XN = (bf16*)(F.ws + WS_XN); bf16* Z = (bf16*)(F.ws + WS_Z); bf16* YC = (bf16*)(F.ws + WS_YCAT); bf16* GY = (bf16*)(F.ws + WS_G); bf16* U = (bf16*)(F.ws + WS_U);
    const float* mod = (const float*)(F.ws + WS_MOD);

#define REPS(k) (((PROBE_DUP) >> (k)) & 1 ? 2 : 1)
#define PH0(rep) p0_prologue(F, A, rep)
#define PH1(rep) p1_modulate(F, A, rep)
#define PH2(rep) do {     \
        pg8::Gemm g{XN, (const bf16*)(F.ws + WS_WIN), M, NZ, D}; pg8::StaticOrder S; S.init(M, NZ, F.G, (int)blockIdx.x, D); \
        pg8::EpiBf16<0> E{Z, NZ, nullptr}; \
        pg8::gemm_phase<pg8::EpiBf16<0>, pg8::StaticOrder, PG8_ALIGN, PG8_SP2>(F.lds + RING_OFF, g, S, E); \
        if ((rep) == 0 && (int)blockIdx.x >= (M / 256) * (NZ / 256) - F.G) { __syncthreads(); xpose_range_b(F, A, XO_OU, XO_2, (M / 256) * (NZ / 256) - F.G); } } while (0)
#define PH3(rep) p3_mixers_ref(F, A, rep)
#define PH4(rep) do { } while (0)
#define PH5(rep) do {     \
        pg8::Gemm g{YC, (const bf16*)(F.ws + WS_WOUT), M, D, D}; pg8::SplitOrder S; S.init(MP, D, F.G, (int)blockIdx.x, D, NS_OUT); \
        pg8::EpiRes<false> E{A.in[I_XP], (bf16*)(F.ws + WS_T1), mod + 2 * D, nullptr, ALPHA, MP, (float*)(F.ws + WS_SLAB)}; \
        pg8::gemm_phase<pg8::EpiRes<false>, pg8::SplitOrder, PG8_ALIGN, PG8_SP2>(F.lds + RING_OFF, g, S, E); \
        { pg8::Unit u0; S.P.next(0, u0); cnt_arrive_wt(F, CW_T1 + 64 * u0.pm); if ((int)blockIdx.x >= F.G - S.nP) cnt_arrive_wt(F, CW_T1S); } } while (0)
#define PH6(rep) ln_phase<false>(F, A, rep)
#define PH7(rep) do {     \
        pg8::Gemm g{XN, (const bf16*)(F.ws + WS_W1), M, FF, D}; pg8::StaticOrder S; S.init(M, FF, F.G, (int)blockIdx.x, D); \
        pg8::EpiBf16<3> E{U, FF, A.in[I_B1]}; \
        pg8::gemm_phase<pg8::EpiBf16<3>, pg8::StaticOrder, PG8_ALIGN, PG8_SP2>(F.lds + RING_OFF, g, S, E); } while (0)
#define PH8(rep) do {     \
        pg8::Gemm g{U, (const bf16*)(F.ws + WS_W2), M, D, FF}; pg8::SplitOrder S; S.init(MP, D, F.G, (int)blockIdx.x, FF, NS_DOWN); \
        pg8::EpiRes<true> E{(const bf16*)(F.ws + WS_X1B), (bf16*)(F.ws + WS_T2), mod + 5 * D, A.in[I_B2], ALPHA, MP, (float*)(F.ws + WS_SLAB)}; \
        pg8::gemm_phase<pg8::EpiRes<true>, pg8::SplitOrder, PG8_ALIGN, PG8_SP2>(F.lds + RING_OFF, g, S, E); \
        { pg8::Unit u0; S.P.next(0, u0); cnt_arrive_wt(F, CW_T2 + 64 * u0.pm); if ((int)blockIdx.x >= F.G - S.nP) cnt_arrive_wt(F, CW_T2S); } } while (0)
#define RUNNB(k, PH) do { if (IN(k)) { PH(0); if (REPS(k) == 2) { __syncthreads(); PH(1); } } } while (0)
#define RUN(k, PH) do { if (IN(k)) { PH(0); if (REPS(k) == 2) { __syncthreads(); PH(1); } if (BOTH(k)) GRID_BAR(); } } while (0)
    if (IN(0)) { PH0(0); if (REPS(0) == 2) { __syncthreads(); PH0(1); } if (IN(0) && !IN(1)) { } }
    RUN(1, PH1); RUN(2, PH2); RUN(3, PH3); RUNNB(5, PH5); RUN(6, PH6); RUN(7, PH7); RUNNB(8, PH8);
    if (IN(9)) { ln_phase<true>(F, A, 0); }
#undef IN
#undef BOTH
}

extern "C" void kernel_launch(void* const* d_in, const int* in_sizes, int n_in, void* d_out, int out_size, void* d_ws, size_t ws_size, hipStream_t stream) {
    static int grid = 0;
    if (grid == 0) {
        if (n_in != 37 || in_sizes[0] != MP * D || out_size != (int)O_END || ws_size < WS_END) { fprintf(stderr, "kernel_launch: unexpected shapes (n_in %d, in0 %d, out %d, ws %zu)\n", n_in, n_in > 0 ? in_sizes[0] : -1, out_size, ws_size); grid = -1; return; }
        int dev = 0, cus = 0, per_cu = 0;
        if (hipGetDevice(&dev) != hipSuccess || hipDeviceGetAttribute(&cus, hipDeviceAttributeMultiprocessorCount, dev) != hipSuccess) { grid = -1; return; }
        if (hipFuncSetAttribute((const void*)fwd, hipFuncAttributeMaxDynamicSharedMemorySize, LDS_BYTES) != hipSuccess) { fprintf(stderr, "kernel_launch: hipFuncSetAttribute failed\n"); grid = -1; return; }
        if (hipOccupancyMaxActiveBlocksPerMultiprocessor(&per_cu, (const void*)fwd, NWAVES * 64, LDS_BYTES) != hipSuccess || per_cu < 1) { fprintf(stderr, "kernel_launch: occupancy query says %d\n", per_cu); }
        (void)hipGetLastError();
        grid = cus;
        if (grid < 256) { fprintf(stderr, "kernel_launch: this build needs 256 CUs (got %d)\n", grid); grid = -1; return; }
        grid = 256;
    }
    if (grid < 0) return;
    (void)hipMemsetAsync((char*)d_ws + WS_CTL, 0, CTL_ZERO_BYTES, stream);
    Args a{};
    for (int i = 0; i < 37; ++i) a.in[i] = (const float*)d_in[i];
    a.out = (float*)d_out; a.ws = (unsigned char*)d_ws;
    for (int li = 0; li < N_LAUNCHES; ++li) {
        if (N_LAUNCHES == 1) { a.ph_lo = 0; a.ph_hi = N_PHASES; } else { a.ph_lo = li; a.ph_hi = li + 1; }
        a.li = li;
        hipLaunchKernelGGL(fwd, dim3(grid), dim3(NWAVES * 64), LDS_BYTES, stream, a);
    }
}
```

```cpp
#include <hip/hip_runtime.h>
#include <cstdio>
#include <cstdint>
#include <cmath>

#ifndef MK_N_LAUNCHES
#define MK_N_LAUNCHES 1
#endif

namespace pg8 {
#define PG8_LAS __attribute__((address_space(3)))
typedef unsigned short bf16_t;
typedef short bf16x8 __attribute__((ext_vector_type(8)));
typedef float f32x4 __attribute__((ext_vector_type(4)));
typedef unsigned u32x4 __attribute__((ext_vector_type(4)));
constexpr int BM = 256, BK = 64, HALF = 128, HTB = HALF * BK * 2, STAGE_BYTES = 8 * HTB, NXCD = 8, WGM = 8;

__host__ __device__ __forceinline__ int lds_byte(int r, int c) { const int st = (r >> 4) * 2 + (c >> 5), rr = r & 15, cc = c & 31, ob = rr * 64 + cc * 2; return st * 1024 + (ob ^ (((ob >> 9) & 1) << 5)); }
__host__ __device__ __forceinline__ void stage_rc(int b, int& R, int& C) { const int st = b / 1024, sb = b % 1024, swz = sb ^ (((sb >> 9) & 1) << 5); R = (st >> 1) * 16 + swz / 64; C = (st & 1) * 32 + (swz % 64) / 2; }
__host__ __device__ __forceinline__ int perm32(int rho) { const int n = rho >> 4, i = rho & 15; return 8 * (i >> 2) + 4 * n + (i & 3); }

struct Unit { int pm, pn, k0, nkt, ks; };
struct Gemm { const bf16_t* A; const bf16_t* Bt; int M, N, K; };

struct StaticOrder {
    int nM, nN, nwg, G, c, K;
    __host__ __device__ void init(int M, int N, int G_, int c_, int K_) { nM = M / BM; nN = N / BM; nwg = nM * nN; G = G_; c = c_; K = K_; }
    __host__ __device__ __forceinline__ bool next(int i, Unit& u) const {
        const long L = (long)i * G + c; if (L >= nwg) return false;
        int wgid = (int)L; { const int q = nwg / NXCD, r = nwg % NXCD, xcd = wgid % NXCD, off = wgid / NXCD; wgid = (xcd < r ? xcd * (q + 1) : r * (q + 1) + (xcd - r) * q) + off; }
        const int nig = WGM * nN, gid = wgid / nig, fm = gid * WGM, gsz = (nM - fm) < WGM ? (nM - fm) : WGM;
        u.pm = fm + ((wgid % nig) % gsz); u.pn = (wgid % nig) / gsz; u.k0 = 0; u.nkt = K / BK; u.ks = 0; return true;
    }
    __device__ __forceinline__ void a_ready(const Unit&) const {}
    __device__ __forceinline__ void done(const Unit&) const {}
};

struct SplitOrder {
    StaticOrder P; int nN, NS, nP, G, c, K, r0;
    __host__ __device__ void init(int MPr, int N, int G_, int c_, int K_, int NS_) { P.init(MPr, N, G_, c_, K_); nN = N / BM; NS = NS_; nP = 2 * nN * NS; G = G_; c = c_; K = K_; r0 = (P.nwg + G - 1 - c) / G;   }
    __host__ __device__ __forceinline__ bool next(int i, Unit& u) const {
        Unit a; a.pm = 0; a.pn = 0; a.k0 = 0; a.nkt = K / BK; a.ks = 0;
        const bool okp = P.next(i < r0 ? i : 0, a);
        const int p = (i - r0) * G + (G - 1 - c), t = p / NS, ks = p % NS, nk = K / BK / NS;
        const bool split = i >= r0;
        u.pm = split ? P.nM + t / nN : a.pm; u.pn = split ? t % nN : a.pn; u.nkt = split ? nk : a.nkt; u.ks = split ? ks : 0; u.k0 = split ? ks * nk * BK : 0;
        return split ? (p < nP) : okp;
    }
    __device__ __forceinline__ void a_ready(const Unit&) const {}
    __device__ __forceinline__ void done(const Unit&) const {}
};

struct OneUnit {
    Unit u0;
    __host__ __device__ __forceinline__ bool next(int i, Unit& u) const { u = u0; return i == 0; }
    __device__ __forceinline__ void a_ready(const Unit&) const {}
    __device__ __forceinline__ void done(const Unit&) const {}
};
__device__ __forceinline__ void st16_wt(void* p, u32x4 v) { asm volatile("global_store_dwordx4 %0, %1, off sc1\n\ts_nop 1" :: "v"(p), "v"(v)); }
__device__ __forceinline__ void st16f_wt(void* p, f32x4 v) { asm volatile("global_store_dwordx4 %0, %1, off sc1\n\ts_nop 1" :: "v"(p), "v"(v)); }
__device__ __forceinline__ unsigned cvt_pk_bf16(float lo, float hi) { unsigned r; asm volatile("v_cvt_pk_bf16_f32 %0, %1, %2" : "=v"(r) : "v"(lo), "v"(hi)); return r; }
__device__ __forceinline__ float bf_lo(unsigned w) { return __builtin_bit_cast(float, w << 16); }
__device__ __forceinline__ float bf_hi(unsigned w) { return __builtin_bit_cast(float, w & 0xffff0000u); }

template <int ACT> struct EpiBf16 {
    static constexpr bool PERM = true, AFTER_DRAIN = false;
    bf16_t* O; int ldc; const float* bias;
    __device__ __forceinline__ void operator()(const f32x4 (&acc)[2][2][4][2], const Unit& u, int wr, int wc, int fr, int fq) const {
        const int row0 = u.pm * BM + wr * 64 + fr; const int col0 = u.pn * BM + wc * 32 + 8 * fq;
        f32x4 bv[2][2];
#pragma unroll
        for (int bj = 0; bj < 2; ++bj)
#pragma unroll
            for (int n = 0; n < 2; ++n) bv[bj][n] = bias ? *(const f32x4*)(bias + col0 + bj * HALF + 4 * n) : (f32x4){0.f, 0.f, 0.f, 0.f};
#pragma unroll
        for (int ai = 0; ai < 2; ++ai)
#pragma unroll
            for (int m = 0; m < 4; ++m) { bf16_t* rowp = O + (size_t)(row0 + ai * HALF + m * 16) * ldc + col0;
#pragma unroll
                for (int bj = 0; bj < 2; ++bj) { f32x4 v0 = acc[ai][bj][m][0] + bv[bj][0], v1 = acc[ai][bj][m][1] + bv[bj][1];
                    if (ACT == 3) {
#pragma unroll
                        for (int e = 0; e < 4; ++e) { const float a = fmaxf(v0[e], 0.f), b = fmaxf(v1[e], 0.f); v0[e] = a * a; v1[e] = b * b; } }
                    u32x4 w; w.x = cvt_pk_bf16(v0[0], v0[1]); w.y = cvt_pk_bf16(v0[2], v0[3]); w.z = cvt_pk_bf16(v1[0], v1[1]); w.w = cvt_pk_bf16(v1[2], v1[3]);
                    *(u32x4*)(rowp + bj * HALF) = w; } }
    }
};
struct EpiGlu {
    static constexpr bool PERM = true, AFTER_DRAIN = false;
    const bf16_t* Gy; int ldg; bf16_t* O; int ldc; int coff; const float* bias;
    __device__ __forceinline__ void operator()(const f32x4 (&acc)[2][2][4][2], const Unit& u, int wr, int wc, int fr, int fq) const {
        const int row0 = u.pm * BM + wr * 64 + fr; const int col0 = u.pn * BM + wc * 32 + 8 * fq;
        f32x4 bv[2][2];
#pragma unroll
        for (int bj = 0; bj < 2; ++bj)
#pragma unroll
            for (int n = 0; n < 2; ++n) bv[bj][n] = *(const f32x4*)(bias + col0 + bj * HALF + 4 * n);
#pragma unroll
        for (int ai = 0; ai < 2; ++ai)
#pragma unroll
            for (int m = 0; m < 4; ++m) { const size_t row = (size_t)(row0 + ai * HALF + m * 16);
#pragma unroll
                for (int bj = 0; bj < 2; ++bj) { const f32x4 v0 = acc[ai][bj][m][0] + bv[bj][0], v1 = acc[ai][bj][m][1] + bv[bj][1];
                    const u32x4 g = *(const u32x4*)(Gy + row * ldg + col0 + bj * HALF);
                    float o[8];
                    o[0] = bf_lo(g.x) * __builtin_amdgcn_rcpf(1.f + __builtin_amdgcn_exp2f(-1.4426950408889634f * v0[0])); o[1] = bf_hi(g.x) * __builtin_amdgcn_rcpf(1.f + __builtin_amdgcn_exp2f(-1.4426950408889634f * v0[1]));
                    o[2] = bf_lo(g.y) * __builtin_amdgcn_rcpf(1.f + __builtin_amdgcn_exp2f(-1.4426950408889634f * v0[2])); o[3] = bf_hi(g.y) * __builtin_amdgcn_rcpf(1.f + __builtin_amdgcn_exp2f(-1.4426950408889634f * v0[3]));
                    o[4] = bf_lo(g.z) * __builtin_amdgcn_rcpf(1.f + __builtin_amdgcn_exp2f(-1.4426950408889634f * v1[0])); o[5] = bf_hi(g.z) * __builtin_amdgcn_rcpf(1.f + __builtin_amdgcn_exp2f(-1.4426950408889634f * v1[1]));
                    o[6] = bf_lo(g.w) * __builtin_amdgcn_rcpf(1.f + __builtin_amdgcn_exp2f(-1.4426950408889634f * v1[2])); o[7] = bf_hi(g.w) * __builtin_amdgcn_rcpf(1.f + __builtin_amdgcn_exp2f(-1.4426950408889634f * v1[3]));
                    u32x4 w; w.x = cvt_pk_bf16(o[0], o[1]); w.y = cvt_pk_bf16(o[2], o[3]); w.z = cvt_pk_bf16(o[4], o[5]); w.w = cvt_pk_bf16(o[6], o[7]);
                    *(u32x4*)(O + row * ldc + coff + col0 + bj * HALF) = w; } }
    }
};
template <bool BASE16> struct EpiRes {
    static constexpr bool PERM = true, AFTER_DRAIN = false;
    const void* basep; bf16_t* T; const float* gate  ; const float* bias; float alpha; int MP; float* slab;
    __device__ __forceinline__ void operator()(const f32x4 (&acc)[2][2][4][2], const Unit& u, int wr, int wc, int fr, int fq) const {
        const int row0 = u.pm * BM + wr * 64 + fr, col0 = u.pn * BM + wc * 32 + 8 * fq;
        if (row0 >= MP) {
            float* sp = slab + (size_t)u.ks * 512 * 1024;
#pragma unroll
            for (int ai = 0; ai < 2; ++ai)
#pragma unroll
                for (int m = 0; m < 4; ++m) { float* op = sp + (size_t)(row0 + ai * HALF + m * 16 - MP) * 1024;
#pragma unroll
                    for (int bj = 0; bj < 2; ++bj)
#pragma unroll
                        for (int n = 0; n < 2; ++n) st16f_wt(op + col0 + bj * HALF + n * 4, acc[ai][bj][m][n]); }
            return; }
        f32x4 bv[2][2];
#pragma unroll
        for (int bj = 0; bj < 2; ++bj)
#pragma unroll
            for (int n = 0; n < 2; ++n) bv[bj][n] = bias ? *(const f32x4*)(bias + col0 + bj * HALF + n * 4) : (f32x4){0.f, 0.f, 0.f, 0.f};
        const float* gp = gate + (size_t)(row0 >> 11) * 6144;
#pragma unroll
        for (int ai = 0; ai < 2; ++ai)
#pragma unroll
            for (int m = 0; m < 4; ++m) { const int row = row0 + ai * HALF + m * 16;
                bf16_t* tp = T + (size_t)row * 1024;
#pragma unroll
                for (int bj = 0; bj < 2; ++bj) { const int c = col0 + bj * HALF;
                    f32x4 b0, b1;
                    if (BASE16) { const u32x4 bw = *(const u32x4*)((const bf16_t*)basep + (size_t)row * 1024 + c); b0 = (f32x4){bf_lo(bw.x), bf_hi(bw.x), bf_lo(bw.y), bf_hi(bw.y)}; b1 = (f32x4){bf_lo(bw.z), bf_hi(bw.z), bf_lo(bw.w), bf_hi(bw.w)}; }
                    else { const float* bp = (const float*)basep + (size_t)row * 1024; b0 = *(const f32x4*)(bp + c); b1 = *(const f32x4*)(bp + c + 4); }
                    const f32x4 g0 = *(const f32x4*)(gp + c), g1 = *(const f32x4*)(gp + c + 4);
                    const f32x4 v0 = b0 * alpha + g0 * (acc[ai][bj][m][0] + bv[bj][0]), v1 = b1 * alpha + g1 * (acc[ai][bj][m][1] + bv[bj][1]);
                    u32x4 w; w.x = cvt_pk_bf16(v0[0], v0[1]); w.y = cvt_pk_bf16(v0[2], v0[3]); w.z = cvt_pk_bf16(v1[0], v1[1]); w.w = cvt_pk_bf16(v1[2], v1[3]);
                    st16_wt(tp + c, w); } }
    }
};

template <class Epi, class Sched, bool ALIGN_EPI = false, bool SP2 = false>
__device__ __forceinline__ void gemm_phase(PG8_LAS unsigned char* lds, const Gemm g, const Sched& S, const Epi& E) {
    const int tid = threadIdx.x, wid = __builtin_amdgcn_readfirstlane(tid >> 6), lane = tid & 63, wr = wid >> 2, wc = wid & 3, fr = lane & 15, fq = lane >> 4;
    const int K = g.K;
    unsigned voffA[2], voffB[2];
#pragma unroll
    for (int i = 0; i < 2; ++i) { int R, C; stage_rc(tid * 16 + i * 8192, R, C); const int Rb = Epi::PERM ? ((R & ~31) + perm32(R & 31)) : R;
        voffA[i] = (unsigned)(R * K + C) * 2u; voffB[i] = (unsigned)(Rb * K + C) * 2u; }
    const size_t kstep = (size_t)(BK * 2);
    const size_t hstep = (size_t)HALF * K * 2;
    const size_t tstep = 2 * hstep;
    const unsigned ldsw = (unsigned)wid * 1024u;
    const int aoff = lds_byte(wr * 64 + fr, fq * 8), boff = lds_byte(wc * 32 + fr, fq * 8);
#define PG8_SA(b, h) (((b) * 2 + (h)) * HTB)
#define PG8_SB(b, h) ((4 + (b) * 2 + (h)) * HTB)
#define PG8_STAGE(bufoff, gbase, voff) do { _Pragma("unroll") for (int _i = 0; _i < 2; ++_i) \
        __builtin_amdgcn_global_load_lds((const unsigned*)((const char*)(gbase) + (voff)[_i]), (PG8_LAS unsigned*)(lds + (bufoff) + ldsw + _i * 8192), 16, 0, 0); } while (0)
#define PG8_LDA(dst, b, h) do { _Pragma("unroll") for (int m = 0; m < 4; ++m) _Pragma("unroll") for (int k = 0; k < 2; ++k) dst[m][k] = *(const PG8_LAS bf16x8*)(lds + PG8_SA(b, h) + aoff + m * 2048 + k * 1024); } while (0)
#define PG8_LDB(dst, b, h) do { _Pragma("unroll") for (int n = 0; n < 2; ++n) _Pragma("unroll") for (int k = 0; k < 2; ++k) dst[n][k] = *(const PG8_LAS bf16x8*)(lds + PG8_SB(b, h) + boff + n * 2048 + k * 1024); } while (0)
#define PG8_MMA(ai, bj, At, Bt) do { __builtin_amdgcn_s_setprio(1); _Pragma("unroll") for (int m = 0; m < 4; ++m) _Pragma("unroll") for (int n = 0; n < 2; ++n) _Pragma("unroll") for (int k = 0; k < 2; ++k) \
        acc[ai][bj][m][n] = __builtin_amdgcn_mfma_f32_16x16x32_bf16(Bt[n][k], At[m][k], acc[ai][bj][m][n], 0, 0, 0); __builtin_amdgcn_s_setprio(0); } while (0)
#define PG8_WAIT_V(n) asm volatile("s_waitcnt vmcnt(" #n ")" ::: "memory")
#define PG8_WAIT_L(n) asm volatile("s_waitcnt lgkmcnt(" #n ")" ::: "memory")
#define PG8_BAR __builtin_amdgcn_s_barrier()
#define PG8_SCHED __builtin_amdgcn_sched_barrier(0)
    Unit cur, nxt; int ui = 0;
    if (!S.next(0, cur)) return;
    f32x4 acc[2][2][4][2];
#pragma unroll
    for (int a = 0; a < 2; ++a)
#pragma unroll
        for (int b = 0; b < 2; ++b)
#pragma unroll
            for (int m = 0; m < 4; ++m)
#pragma unroll
                for (int n = 0; n < 2; ++n) acc[a][b][m][n] = (f32x4){0.f, 0.f, 0.f, 0.f};
    bf16x8 At[4][2], B0[2][2], B1[2][2];
    const char* cA = (const char*)g.A + (size_t)cur.pm * tstep + (size_t)cur.k0 * 2; const char* cB = (const char*)g.Bt + (size_t)cur.pn * tstep + (size_t)cur.k0 * 2;
    S.a_ready(cur);
    if constexpr (SP2) {
        PG8_STAGE(PG8_SB(0, 0), cB, voffB); PG8_STAGE(PG8_SB(0, 1), cB + hstep, voffB); PG8_STAGE(PG8_SA(0, 0), cA, voffA); PG8_STAGE(PG8_SA(0, 1), cA + hstep, voffA);
        if (wr == 1) PG8_BAR;
        PG8_WAIT_V(2); PG8_BAR;
        PG8_STAGE(PG8_SB(1, 0), cB + kstep, voffB); PG8_STAGE(PG8_SA(1, 0), cA + kstep, voffA); PG8_STAGE(PG8_SB(1, 1), cB + hstep + kstep, voffB);
        PG8_WAIT_V(6); PG8_BAR;
    } else {
        PG8_STAGE(PG8_SB(0, 0), cB, voffB); PG8_STAGE(PG8_SA(0, 0), cA, voffA); PG8_STAGE(PG8_SB(0, 1), cB + hstep, voffB); PG8_STAGE(PG8_SA(0, 1), cA + hstep, voffA);
        if (wr == 1) PG8_BAR;
        PG8_WAIT_V(4); PG8_BAR;
        PG8_STAGE(PG8_SB(1, 0), cB + kstep, voffB); PG8_STAGE(PG8_SA(1, 0), cA + kstep, voffA); PG8_STAGE(PG8_SB(1, 1), cB + hstep + kstep, voffB);
        PG8_WAIT_V(6); PG8_BAR;
    }
    for (;;) {
        const bool has_next = S.next(ui + 1, nxt);
        const char* nA = has_next ? (const char*)g.A + (size_t)nxt.pm * tstep + (size_t)nxt.k0 * 2 : cA; const char* nB = has_next ? (const char*)g.Bt + (size_t)nxt.pn * tstep + (size_t)nxt.k0 * 2 : cB;
        const int nt = cur.nkt;
        for (int t = 0; t < nt; t += 2) {
            const bool last = (t == nt - 2);
            const char* a1 = cA + (size_t)(t + 1) * kstep;
            const char* a2 = last ? nA : cA + (size_t)(t + 2) * kstep; const char* b2 = last ? nB : cB + (size_t)(t + 2) * kstep;
            const char* a3 = a2 + kstep; const char* b3 = b2 + kstep;
            if (last && has_next) S.a_ready(nxt);
            if constexpr (SP2) {
            PG8_LDB(B0, 0, 0); PG8_LDB(B1, 0, 1); PG8_SCHED; PG8_LDA(At, 0, 0); PG8_STAGE(PG8_SA(1, 1), a1 + hstep, voffA);
            PG8_WAIT_V(8); PG8_WAIT_L(0); PG8_BAR; PG8_MMA(0, 0, At, B0); PG8_MMA(0, 1, At, B1); PG8_BAR; PG8_SCHED;
            PG8_LDA(At, 0, 1); PG8_STAGE(PG8_SB(0, 0), b2, voffB); PG8_STAGE(PG8_SB(0, 1), b2 + hstep, voffB); PG8_STAGE(PG8_SA(0, 0), a2, voffA);
            PG8_WAIT_V(8); PG8_WAIT_L(0); PG8_BAR; PG8_MMA(1, 0, At, B0); PG8_MMA(1, 1, At, B1); PG8_BAR; PG8_SCHED;
            PG8_LDB(B0, 1, 0); PG8_LDB(B1, 1, 1); PG8_SCHED; PG8_LDA(At, 1, 0); PG8_STAGE(PG8_SA(0, 1), a2 + hstep, voffA);
            PG8_WAIT_V(8); PG8_WAIT_L(0); PG8_BAR; PG8_MMA(0, 0, At, B0); PG8_MMA(0, 1, At, B1); PG8_BAR; PG8_SCHED;
            PG8_LDA(At, 1, 1); PG8_STAGE(PG8_SB(1, 0), b3, voffB); PG8_STAGE(PG8_SB(1, 1), b3 + hstep, voffB); PG8_STAGE(PG8_SA(1, 0), a3, voffA);
            PG8_WAIT_V(8); PG8_WAIT_L(0); PG8_BAR; PG8_MMA(1, 0, At, B0); PG8_MMA(1, 1, At, B1); PG8_BAR; PG8_SCHED;
            } else {
            PG8_LDB(B0, 0, 0); PG8_SCHED; PG8_LDA(At, 0, 0); PG8_STAGE(PG8_SA(1, 1), a1 + hstep, voffA);
            PG8_WAIT_L(8); PG8_BAR; PG8_WAIT_L(0); PG8_MMA(0, 0, At, B0); PG8_BAR; PG8_SCHED;
            PG8_LDB(B1, 0, 1); PG8_STAGE(PG8_SB(0, 0), b2, voffB);
            PG8_BAR; PG8_WAIT_L(0); PG8_MMA(0, 1, At, B1); PG8_BAR;
            PG8_LDA(At, 0, 1); PG8_STAGE(PG8_SA(0, 0), a2, voffA);
            PG8_BAR; PG8_WAIT_L(0); PG8_MMA(1, 0, At, B0); PG8_BAR; PG8_SCHED;
            PG8_STAGE(PG8_SB(0, 1), b2 + hstep, voffB);
            PG8_WAIT_V(6); PG8_BAR; PG8_MMA(1, 1, At, B1); PG8_BAR;
            PG8_LDB(B0, 1, 0); PG8_SCHED; PG8_LDA(At, 1, 0); PG8_STAGE(PG8_SA(0, 1), a2 + hstep, voffA);
            PG8_WAIT_L(8); PG8_BAR; PG8_WAIT_L(0); PG8_MMA(0, 0, At, B0); PG8_BAR; PG8_SCHED;
            PG8_LDB(B1, 1, 1); PG8_STAGE(PG8_SB(1, 0), b3, voffB);
            PG8_BAR; PG8_WAIT_L(0); PG8_MMA(0, 1, At, B1); PG8_BAR;
            PG8_LDA(At, 1, 1); PG8_STAGE(PG8_SA(1, 0), a3, voffA);
            PG8_BAR; PG8_WAIT_L(0); PG8_MMA(1, 0, At, B0); PG8_BAR; PG8_SCHED;
            PG8_STAGE(PG8_SB(1, 1), b3 + hstep, voffB);
            PG8_WAIT_V(6); PG8_BAR; PG8_MMA(1, 1, At, B1); PG8_BAR;
            }
        }
        if constexpr (ALIGN_EPI) { if (wr == 0) PG8_BAR; }
        if constexpr (!Epi::AFTER_DRAIN) { E(acc, cur, wr, wc, fr, fq); S.done(cur); }
        if (!has_next) break;
#pragma unroll
        for (int a = 0; a < 2; ++a)
#pragma unroll
            for (int b = 0; b < 2; ++b)
#pragma unroll
                for (int m = 0; m < 4; ++m)
#pragma unroll
                    for (int n = 0; n < 2; ++n) acc[a][b][m][n] = (f32x4){0.f, 0.f, 0.f, 0.f};
        cur = nxt; cA = nA; cB = nB; ++ui;
        if constexpr (ALIGN_EPI) { if (wr == 1) PG8_BAR; }
    }
    PG8_WAIT_V(0);
    if constexpr (!ALIGN_EPI) { if (wr == 0) PG8_BAR; }
    PG8_BAR;
#undef PG8_SA
#undef PG8_SB
#undef PG8_STAGE
#undef PG8_LDA
#undef PG8_LDB
#undef PG8_MMA
#undef PG8_WAIT_V
#undef PG8_WAIT_L
#undef PG8_BAR
#undef PG8_SCHED
}
}

#ifndef PROBE_DUP
#define PROBE_DUP 0
#endif
#ifndef PG8_SP2
#define PG8_SP2 true
#endif
#ifndef PG8_ALIGN
#define PG8_ALIGN true
#endif

constexpr int NWAVES = 8;
constexpr int N_LAUNCHES = MK_N_LAUNCHES;
constexpr int N_PHASES = 10;
constexpr int D = 1024, MP = 16384, MS = 512, M = MP + MS, TP = 2048, NBP = 8, NBS = 128, TS = 4;
constexpr int NZ = 1536, WA = 512, WB = 512, FF = 4096, NMOD = 6 * D, NROWMOD = NBP + NBS;
constexpr int GB = 32, NS5 = 64, KS5 = 16, HA = 8, HDA = 64;
constexpr float LN_EPS = 1e-5f;
constexpr int NS_OUT = 4, NS_DOWN = 8;
constexpr float ALPHA = 1.189207115002721f;

constexpr size_t O_YP = 0, O_YS = (size_t)MP * D, O_CONVP = O_YS + (size_t)MS * D, O_HP = O_CONVP + (size_t)NBP * 3 * WA, O_SRP = O_HP + (size_t)NBP * WA,
                 O_SIP = O_SRP + (size_t)NBP * GB * NS5, O_CONVS = O_SIP + (size_t)NBP * GB * NS5, O_HS = O_CONVS + (size_t)NBS * 3 * WA, O_SRS = O_HS + (size_t)NBS * WA,
                 O_SIS = O_SRS + (size_t)NBS * GB * NS5, O_END = O_SIS + (size_t)NBS * GB * NS5;

constexpr size_t MiB = 1u << 20;
constexpr size_t WS_CTL = 0, CTL_ZERO_BYTES = 128 * 1024;
constexpr size_t WS_WIN = 1 * MiB, WS_WGLU = 4 * MiB, WS_WOUT = 5 * MiB, WS_W1 = 7 * MiB, WS_W2 = 15 * MiB;
constexpr size_t WS_MOD = 23 * MiB;
constexpr size_t WS_S5C = 27 * MiB;
constexpr size_t WS_XN = 28 * MiB;
constexpr size_t WS_Z = 61 * MiB;
constexpr size_t WS_YCAT = 111 * MiB;
constexpr size_t WS_G = 144 * MiB;
constexpr size_t WS_U = 61 * MiB;
constexpr size_t WS_T1 = WS_Z;
constexpr size_t WS_T2 = WS_XN;
constexpr size_t WS_TAB = 194 * MiB;
constexpr size_t WS_SLAB = 196 * MiB;
constexpr size_t WS_X1B = 212 * MiB;
constexpr size_t WS_END = 246 * MiB;
constexpr size_t TB_BF1 = 0, TB_BF2 = TB_BF1 + 32 * 4 * 64 * 16, TB_TA = TB_BF2 + 32 * 8 * 64 * 16, TB_ZP = TB_TA + 32 * 2 * 2 * 32 * 4, TB_Z16N = TB_ZP + 32 * 17 * 2 * 2 * 32 * 4,
                 TB_RG = TB_Z16N + 32 * 2 * 64 * 4, TB_CB = TB_RG + 8 * 2 * 2 * 4 * 64 * 16, TB_SILU = TB_CB + 128 * 3 * 512 * 2, TB_DG = TB_SILU + 160 * 1024 * 2, TB_END = TB_DG + 8 * 16 * 64 * 16;
static_assert(WS_TAB + TB_END <= WS_SLAB, "tables");
static_assert(WS_XN + (size_t)M * D * 2 <= WS_Z && WS_Z + (size_t)M * NZ * 2 <= WS_YCAT && WS_YCAT + (size_t)M * D * 2 <= WS_G && WS_G + (size_t)M * WB * 2 <= WS_END && WS_U + (size_t)M * FF * 2 <= WS_TAB, "d_ws map");
constexpr int SC_ABR = 0, SC_ABI = 2048, SC_BBR = 4096, SC_BBI = 4096 + 32768, SC_RGL = 4096 + 65536, SC_END = SC_RGL + 512;
constexpr int CW_TMO = 0, CW_CODE = 1, CW_SILU = 64, CW_MOD = 1024  , CW_S5B = 128  , CW_BAR = 4096,
              CW_T1 = 8192  , CW_T2 = 12288  , CW_T1S = 16384, CW_T2S = 16448  ;

constexpr int RING_OFF = 0, RING_BYTES = 131072;
constexpr int LDSCTL_OFF = RING_BYTES, MISC_OFF = LDSCTL_OFF + 320;
constexpr int LDS_BYTES = 147456;

#define GAS __attribute__((address_space(1)))
#define LAS __attribute__((address_space(3)))
typedef unsigned short bf16;
typedef unsigned v4u __attribute__((ext_vector_type(4)));
typedef float f32x4 __attribute__((ext_vector_type(4)));
typedef GAS unsigned gu32;
#define RLX_AGENT __ATOMIC_RELAXED, __HIP_MEMORY_SCOPE_AGENT
#define LDS_WAIT() asm volatile("s_waitcnt lgkmcnt(0)" ::: "memory")
#define VM_WAIT() asm volatile("s_waitcnt vmcnt(0)" ::: "memory")
__device__ __forceinline__ unsigned f2bf(float f) { unsigned u = __builtin_bit_cast(unsigned, f); return (u + 0x7fffu + ((u >> 16) & 1u)) >> 16; }
__device__ __forceinline__ unsigned pk2(float lo, float hi) { return f2bf(lo) | (f2bf(hi) << 16); }
__device__ __forceinline__ float bf2f(bf16 v) { return __builtin_bit_cast(float, (unsigned)v << 16); }
__device__ __forceinline__ float gelu_tanh(float x) { const float t = -2.3022082f * (x + 0.044715f * x * x * x); return x * __builtin_amdgcn_rcpf(1.f + __builtin_amdgcn_exp2f(t)); }
__device__ __forceinline__ float sigmoidf_(float x) { return __builtin_amdgcn_rcpf(1.f + __builtin_amdgcn_exp2f(-1.4426950408889634f * x)); }

#define XB_TMO      128
#define XB_XCNT(j)  (256  + 64 * (j))
#define XB_XSUB(j)  (1280 + 64 * (j))
#define XB_XGEN(j)  (2304 + 64 * (j))
#define XB_TOP      3328
#define XB_TOPGEN   3392
#define XCD_BAR_WORDS 3456
#define XB_SPIN_CAP (1u << 18)
__device__ __forceinline__ unsigned xb_ld(unsigned* p)              { return __hip_atomic_load(p, __ATOMIC_RELAXED, __HIP_MEMORY_SCOPE_AGENT); }
__device__ __forceinline__ unsigned xb_add(unsigned* p, unsigned v) { return __hip_atomic_fetch_add(p, v, __ATOMIC_RELAXED, __HIP_MEMORY_SCOPE_AGENT); }
__device__ __forceinline__ unsigned xb_xcc_id() { return (unsigned)__builtin_amdgcn_s_getreg((3 << 11) | 20) & 0xFu; }
#define XB_SPIN(cond, bar) do { unsigned _sp = 0; while (cond) { __builtin_amdgcn_s_sleep(1); \
    if ((++_sp & 255u) == 0u) { if (xb_ld(&(bar)[XB_TMO])) break; if (_sp > XB_SPIN_CAP) { atomicAdd(&(bar)[XB_TMO], 1u); break; } } } } while (0)
struct XcdBarrier { unsigned* bar; unsigned x; volatile LAS unsigned* st; };
__device__ __forceinline__ XcdBarrier xcd_barrier_post(unsigned* bar, volatile LAS unsigned* st) {
    XcdBarrier b; b.bar = bar; b.x = xb_xcc_id(); b.st = st;
    if (threadIdx.x == 0) (void)xb_add(&bar[XB_XCNT(b.x)], 1u);
    return b;
}
__device__ __forceinline__ void xcd_barrier_complete(unsigned* bar, unsigned x, unsigned& nloc, unsigned& nx) {
    const unsigned G = gridDim.x * gridDim.y * gridDim.z;
    unsigned sum, cnt, mine, sp = 0u;
    for (;;) {
        sum = 0u; cnt = 0u; mine = 0u;
#pragma unroll
        for (unsigned j = 0; j < 16; ++j) { const unsigned c = xb_ld(&bar[XB_XCNT(j)]); sum += c; cnt += (c > 0u) ? 1u : 0u; mine = (j == x) ? c : mine; }
        if (sum == G) break;
        __builtin_amdgcn_s_sleep(1);
        if ((++sp & 255u) == 0u) { if (xb_ld(&bar[XB_TMO])) break; if (sp > XB_SPIN_CAP) { atomicAdd(&bar[XB_TMO], 1u); break; } }
    }
    nloc = mine > 0u ? mine : 1u; nx = cnt > 0u ? cnt : 1u;
}
__device__ __forceinline__ void xcd_barrier(const XcdBarrier& b) {
    asm volatile("s_waitcnt vmcnt(0)" ::: "memory");
    __syncthreads();
    if (threadIdx.x == 0) {
        unsigned* bar = b.bar;
        __builtin_amdgcn_s_waitcnt(0);
        unsigned nloc = b.st[0], nx = b.st[1];
        if (nloc == 0u) { xcd_barrier_complete(bar, b.x, nloc, nx); b.st[0] = nloc; b.st[1] = nx; }
        const unsigned old = xb_add(&bar[XB_XSUB(b.x)], 1u);
        const unsigned gen = old / nloc;
        if (old + 1u == (gen + 1u) * nloc) {
            __builtin_amdgcn_fence(__ATOMIC_RELEASE, "agent");
            asm volatile("s_waitcnt vmcnt(0)" ::: "memory");
            const unsigned og = xb_add(&bar[XB_TOP], 1u);
            const unsigned tg = og / nx;
            if (og + 1u == (tg + 1u) * nx) xb_add(&bar[XB_TOPGEN], 1u);
            else XB_SPIN(xb_ld(&bar[XB_TOPGEN]) == tg, bar);
            __builtin_amdgcn_fence(__ATOMIC_ACQUIRE, "agent");
            xb_add(&bar[XB_XGEN(b.x)], 1u);
            asm volatile("s_waitcnt vmcnt(0)" ::: "memory");
        } else {
            XB_SPIN(xb_ld(&bar[XB_XGEN(b.x)]) == gen, bar);
            __builtin_amdgcn_fence(__ATOMIC_ACQUIRE, "agent");
            asm volatile("s_waitcnt vmcnt(0)" ::: "memory");
        }
    }
    __syncthreads();
}

struct Frame {
    LAS unsigned char* lds;
    volatile LAS unsigned* MISC;
    gu32* ctl;
    int tid, lane, wave;
    int vcu, G;
    float* out;
    unsigned char* ws;
};
struct Args { const float* in[37]; float* out; unsigned char* ws; int ph_lo, ph_hi, li, pad; };
__device__ __forceinline__ void refresh(Frame& F) { int t = threadIdx.x; asm volatile("" : "+v"(t)); F.tid = t; F.lane = t & 63; F.wave = __builtin_amdgcn_readfirstlane(t >> 6); }
__device__ __forceinline__ void cnt_arrive(Frame& F, int word) {
    VM_WAIT(); __syncthreads();
    if (F.tid == 0) { __builtin_amdgcn_fence(__ATOMIC_RELEASE, "agent"); VM_WAIT(); (void)__hip_atomic_fetch_add((unsigned*)(F.ctl + word), 1u, RLX_AGENT); }
}
__device__ __forceinline__ void cnt_arrive_wt(Frame& F, int word) {
    VM_WAIT(); __syncthreads();
    if (F.tid == 0) (void)__hip_atomic_fetch_add((unsigned*)(F.ctl + word), 1u, RLX_AGENT);
}
__device__ __forceinline__ void cnt_wait_ge(Frame& F, int word, unsigned target) {
    if (F.tid == 0) { unsigned sp = 0; while (__hip_atomic_load((unsigned*)(F.ctl + word), RLX_AGENT) < target && ++sp < (1u << 22)) __builtin_amdgcn_s_sleep(2);
        __builtin_amdgcn_fence(__ATOMIC_ACQUIRE, "agent"); VM_WAIT(); }
    __syncthreads();
}
__device__ __forceinline__ float wave_sum(float v) {
#pragma unroll
    for (int o = 1; o < 64; o <<= 1) v += __shfl_xor(v, o);
    return v;
}
enum { I_XP = 0, I_XS, I_SCONV, I_SH, I_SSR, I_SSI, I_CP, I_CS, I_ADAW, I_ADAB, I_INPROJ, I_CONVW, I_CONVB, I_RGWR, I_RGBR, I_RGWI, I_RGBI, I_RGLAM,
       I_S5ARE, I_S5AIM, I_S5LOGDT, I_S5BRE, I_S5BIM, I_S5CRE, I_S5CIM, I_S5D, I_GLUW, I_GLUB, I_OUTPROJ, I_LN1G, I_LN1B, I_W1, I_B1, I_W2, I_B2, I_LN2G, I_LN2B };

typedef float f32x2m __attribute__((ext_vector_type(2)));
typedef __bf16 bf16x2m __attribute__((ext_vector_type(2)));
__device__ __forceinline__ unsigned pkbf0(float a, float b) { const f32x2m v = {a, b}; const bf16x2m r = __builtin_convertvector(v, bf16x2m); return __builtin_bit_cast(unsigned, r); }
typedef short bf16x8m __attribute__((ext_vector_type(8)));
typedef float f32x16m __attribute__((ext_vector_type(16)));
__device__ __forceinline__ void p0_transpose_item(const float* W, int K, int N, bf16* WT, LAS float* scr, int item, int lane) {
    const int nblk = N / 32, kb = item / nblk, nb = item % nblk, k0 = 64 * kb, n0 = 32 * nb;
#pragma unroll 8
    for (int i = 0; i < 32; ++i) { const int kk = 2 * i + (lane >> 5); scr[kk * 33 + (lane & 31)] = W[(size_t)(k0 + kk) * N + n0 + (lane & 31)]; }
    LDS_WAIT(); asm volatile("" ::: "memory");
    const int c = lane & 7;
#pragma unroll
    for (int j = 0; j < 4; ++j) { const int n = (lane >> 3) + 8 * j; const LAS float* s = scr + (8 * c) * 33 + n;
        v4u o; o.x = pk2(s[0 * 33], s[1 * 33]); o.y = pk2(s[2 * 33], s[3 * 33]); o.z = pk2(s[4 * 33], s[5 * 33]); o.w = pk2(s[6 * 33], s[7 * 33]);
        *(GAS v4u*)(WT + (size_t)(n0 + n) * K + k0 + 8 * c) = o; }
    LDS_WAIT(); asm volatile("" ::: "memory");
}

constexpr int XI_IN = (D / 64) * (NZ / 32), XI_GL = (WB / 64) * (WB / 32), XI_OU = (D / 64) * (D / 32), XI_1 = (D / 64) * (FF / 32), XI_2 = (FF / 64) * (D / 32);
constexpr int XO_OU = XI_IN + XI_GL, XO_1 = XO_OU + XI_OU, XO_2 = XO_1 + XI_1, XO_END = XO_2 + XI_2;
__device__ __forceinline__ void xpose_item(Frame& F, const Args& A, LAS float* scr, int r) {
    if (r < XI_IN) { p0_transpose_item(A.in[I_INPROJ], D, NZ, (bf16*)(F.ws + WS_WIN), scr, r, F.lane); return; } r -= XI_IN;
    if (r < XI_GL) { p0_transpose_item(A.in[I_GLUW], WB, WB, (bf16*)(F.ws + WS_WGLU), scr, r, F.lane); return; } r -= XI_GL;
    if (r < XI_OU) { p0_transpose_item(A.in[I_OUTPROJ], D, D, (bf16*)(F.ws + WS_WOUT), scr, r, F.lane); return; } r -= XI_OU;
    if (r < XI_1) { p0_transpose_item(A.in[I_W1], D, FF, (bf16*)(F.ws + WS_W1), scr, r, F.lane); return; } r -= XI_1;
    p0_transpose_item(A.in[I_W2], FF, D, (bf16*)(F.ws + WS_W2), scr, r, F.lane);
}
__device__ __forceinline__ void xpose_range(Frame& F, const Args& A, int lo, int hi, int vlo) {
    refresh(F);
    if (F.vcu < vlo) return;
    LAS float* scr = (LAS float*)(F.lds + RING_OFF + F.wave * 16384);
    const int gw = F.wave * (F.G - vlo) + (F.vcu - vlo), ngw = (F.G - vlo) * NWAVES;
    for (int it = lo + gw; it < hi; it += ngw) xpose_item(F, A, scr, it);
}
__device__ __forceinline__ void xpose_range_b(Frame& F, const Args& A, int lo, int hi, int blo) {
    refresh(F);
    LAS float* scr = (LAS float*)(F.lds + RING_OFF + F.wave * 16384);
    const int gw = F.wave * (F.G - blo) + ((int)blockIdx.x - blo), ngw = (F.G - blo) * NWAVES;
    for (int it = lo + gw; it < hi; it += ngw) xpose_item(F, A, scr, it);
}
#ifndef PROBE_P0PART
#define PROBE_P0PART 7
#endif
__device__ __forceinline__ void p0_prologue(Frame& F, const Args& A, int rep = 0) {
    refresh(F);
    const int pmask = rep ? PROBE_P0PART : 7;
    LAS float* scr = (LAS float*)(F.lds + RING_OFF + F.wave * 16384);
    const int gw = F.wave * F.G + F.vcu, NGW = F.G * NWAVES;
    {
        bf16* ST = (bf16*)(F.ws + WS_TAB + TB_SILU);
        for (int ch = F.vcu * NWAVES * 64 + F.tid; ch < 160 * 1024 / 8; ch += F.G * NWAVES * 64) { const int row = ch >> 7, k = (ch & 127) * 8; v4u o = (v4u){0u, 0u, 0u, 0u};
            if (row < NROWMOD) { const float* cp = (row < NBP ? A.in[I_CP] + (size_t)row * D : A.in[I_CS] + (size_t)(row - NBP) * D) + k; const f32x4 c0 = *(const f32x4*)cp, c1 = *(const f32x4*)(cp + 4);
                o.x = pk2(c0[0] * sigmoidf_(c0[0]), c0[1] * sigmoidf_(c0[1])); o.y = pk2(c0[2] * sigmoidf_(c0[2]), c0[3] * sigmoidf_(c0[3]));
                o.z = pk2(c1[0] * sigmoidf_(c1[0]), c1[1] * sigmoidf_(c1[1])); o.w = pk2(c1[2] * sigmoidf_(c1[2]), c1[3] * sigmoidf_(c1[3])); }
            pg8::st16_wt(ST + (size_t)ch * 8, o); }
        cnt_arrive_wt(F, CW_SILU);
    }
    constexpr int I_IN = XI_IN, I_GL = XI_GL;
    constexpr int I_S5 = GB, I_RG = WA / 64, I_RGT = HA * 2 * 2 * 4, I_CB = NBS * 3 * WA / 512, I_DG = HA * 16;
    constexpr int NITEMS = I_IN + I_GL + I_S5 + I_RG + I_RGT + I_CB + I_DG;
    float* sc = (float*)(F.ws + WS_S5C);
    constexpr int VW0 = 2 * D / 32;
    for (int it = F.vcu >= VW0 ? F.wave * (F.G - VW0) + (F.vcu - VW0) : NITEMS; it < NITEMS; it += (F.G - VW0) * NWAVES) {
        int r = it;
        if (!(pmask & 1) && it < I_IN + I_GL) continue;
        if (!(pmask & 2) && it >= I_IN + I_GL) continue;
        if (r < I_IN + I_GL) { xpose_item(F, A, scr, r); continue; } r -= I_IN + I_GL;
        if (r < I_S5) {
            const int g = r, n = F.lane, gn = g * NS5 + n;
            const double dt = exp((double)A.in[I_S5LOGDT][g]), ar = (double)A.in[I_S5ARE][gn], ai = (double)A.in[I_S5AIM][gn];
            const double mag = exp(dt * ar), abr = mag * cos(dt * ai), abi = mag * sin(dt * ai), den = ar * ar + ai * ai, nr = abr - 1.0;
            const double qr = (nr * ar + abi * ai) / den, qi = (abi * ar - nr * ai) / den;
            sc[SC_ABR + gn] = (float)abr; sc[SC_ABI + gn] = (float)abi;
            unsigned char* tab = F.ws + WS_TAB;
            bf16* BF1 = (bf16*)(tab + TB_BF1); bf16* BF2 = (bf16*)(tab + TB_BF2); float* TA = (float*)(tab + TB_TA); float* ZP = (float*)(tab + TB_ZP); float* Z16N = (float*)(tab + TB_Z16N);
            const int sh = n >> 5, v = n & 31, hh = (v >> 2) & 1, ii = (v & 3) + 4 * (v >> 3);
            for (int k = 0; k < KS5; ++k) { const double br = (double)A.in[I_S5BRE][gn * KS5 + k], bi = (double)A.in[I_S5BIM][gn * KS5 + k];
                const float vr = (float)(qr * br - qi * bi), vi = (float)(qr * bi + qi * br);
                sc[SC_BBR + gn * KS5 + k] = vr; sc[SC_BBI + gn * KS5 + k] = vi;
                const int lp = (n & 31) + 32 * (k >> 3), jj = k & 7;
                BF1[(size_t)((g * 4 + 0 + sh) * 64 + lp) * 8 + jj] = (bf16)f2bf(vr); BF1[(size_t)((g * 4 + 2 + sh) * 64 + lp) * 8 + jj] = (bf16)f2bf(vi); }
            { const int s2 = (n >> 4) & 1, jj = 4 * ((n >> 3) & 1) + (n & 3), hk = (n >> 2) & 1;
              for (int ch = 0; ch < KS5; ++ch) { const int hr_ = ch >> 3, i8 = ch & 7, R = (i8 & 3) + 8 * (i8 >> 2) + 4 * hr_, lp = R + 32 * hk;
                  const float cr = A.in[I_S5CRE][(size_t)(g * KS5 + ch) * NS5 + n], ci = A.in[I_S5CIM][(size_t)(g * KS5 + ch) * NS5 + n];
                  BF2[(size_t)((g * 8 + (0 + sh) * 2 + s2) * 64 + lp) * 8 + jj] = (bf16)f2bf(cr); BF2[(size_t)((g * 8 + (2 + sh) * 2 + s2) * 64 + lp) * 8 + jj] = (bf16)f2bf(-ci); }
              for (int z = 0; z < 4; ++z) { const int cidx = n + 64 * z, ks = cidx >> 5, r16 = cidx & 31, lp = 16 + (r16 & 15) + 32 * (r16 >> 4);
                  *(v4u*)(BF2 + (size_t)((g * 8 + ks) * 64 + lp) * 8) = (v4u){0u, 0u, 0u, 0u}; } }
            TA[((g * 2 + hh) * 2 + 0) * 32 + sh * 16 + ii] = (float)abr; TA[((g * 2 + hh) * 2 + 1) * 32 + sh * 16 + ii] = (float)abi;
            const double mg8 = exp(8.0 * dt * ar), z1r = mg8 * cos(8.0 * dt * ai), z1i = mg8 * sin(8.0 * dt * ai); double pzr = 1.0, pzi = 0.0;
            for (int e = 0; e <= 16; ++e) { const float zr = (float)pzr, zi = (float)pzi; { const double nr2 = pzr * z1r - pzi * z1i, ni2 = pzr * z1i + pzi * z1r; pzr = nr2; pzi = ni2; }
                ZP[(((g * 17 + e) * 2 + hh) * 2 + 0) * 32 + sh * 16 + ii] = zr; ZP[(((g * 17 + e) * 2 + hh) * 2 + 1) * 32 + sh * 16 + ii] = zi;
                if (e == 16) { Z16N[(g * 2 + 0) * 64 + n] = zr; Z16N[(g * 2 + 1) * 64 + n] = zi; } }
            continue; } r -= I_S5;
        if (r < I_RG) { const int c = r * 64 + F.lane; const double lam = (double)A.in[I_RGLAM][c];
          sc[SC_RGL + c] = (float)(-8.0 * log1p(exp(-lam)) * 1.4426950408889634); continue; } r -= I_RG;
        if (r >= I_RGT + I_CB) { r -= I_RGT + I_CB;
            const int k = r & 3, sp = (r >> 2) & 1, tau = (r >> 3) & 1, hd = r >> 4, R = F.lane & 31, hk = F.lane >> 5;
            unsigned wv = 0u; if ((R >> 3) == 2 * sp + hk) wv = f2bf(A.in[I_CONVW][k * WA + hd * 64 + 32 * tau + R]);
            const int jj = R & 7; v4u o = (v4u){0u, 0u, 0u, 0u}; const unsigned word = (jj & 1) ? (wv << 16) : wv;
            if ((jj >> 1) == 0) o.x = word; else if ((jj >> 1) == 1) o.y = word; else if ((jj >> 1) == 2) o.z = word; else o.w = word;
            *(v4u*)(F.ws + WS_TAB + TB_DG + (size_t)(r * 64 + F.lane) * 16) = o; continue; }
        if (r >= I_RGT) { r -= I_RGT;
            const float* src = A.in[I_SCONV] + (size_t)r * 512 + F.lane * 8; const f32x4 a0 = *(const f32x4*)src, a1 = *(const f32x4*)(src + 4);
            v4u o; o.x = pk2(a0[0], a0[1]); o.y = pk2(a0[2], a0[3]); o.z = pk2(a1[0], a1[1]); o.w = pk2(a1[2], a1[3]);
            *(v4u*)(F.ws + WS_TAB + TB_CB + ((size_t)r * 512 + F.lane * 8) * 2) = o; continue; }
        {
            const int ks = r & 3, gate = (r >> 2) & 1, jh = (r >> 3) & 1, hd = r >> 4;
            const int R = F.lane & 31, hk = F.lane >> 5;
            const float* W = A.in[gate ? I_RGWI : I_RGWR] + (size_t)(hd * 64 + 32 * (ks >> 1) + 16 * (ks & 1) + 4 * hk) * 64 + 32 * jh + R;
            v4u o; o.x = pk2(W[0], W[64]); o.y = pk2(W[128], W[192]); o.z = pk2(W[8 * 64], W[9 * 64]); o.w = pk2(W[10 * 64], W[11 * 64]);
            *(v4u*)(F.ws + WS_TAB + TB_RG + (size_t)(r * 64 + F.lane) * 16) = o;
        }
    }
    __syncthreads();
    if (F.tid == 0) {
        unsigned sp = 0; while (__hip_atomic_load((unsigned*)(F.ctl + CW_SILU), RLX_AGENT) < (unsigned)F.G && ++sp < (1u << 22)) __builtin_amdgcn_s_sleep(2);
        __builtin_amdgcn_fence(__ATOMIC_ACQUIRE, "agent"); VM_WAIT(); }
    __syncthreads();
    LAS float* RED = (LAS float*)(F.lds + RING_OFF);
    float* mod = (float*)(F.ws + WS_MOD);
    const int r32 = F.lane & 31, hh = F.lane >> 5;
    const bf16* ST = (const bf16*)(F.ws + WS_TAB + TB_SILU);
#pragma unroll 1
    for (int it = F.vcu; it < ((pmask & 4) ? NMOD / 32 : 0); it += F.G) {
        const int n0 = it * 32;
        f32x16m acc[5];
#pragma unroll
        for (int rt = 0; rt < 5; ++rt)
#pragma unroll
            for (int i = 0; i < 16; ++i) acc[rt][i] = 0.f;
#pragma unroll 1
        for (int kb = 0; kb < 4; ++kb) {
            float bw[2][8]; v4u af[2][5];
#pragma unroll
            for (int ks = 0; ks < 2; ++ks) { const int k0 = F.wave * 128 + (kb * 2 + ks) * 16 + 8 * hh;
                const float* wp = A.in[I_ADAW] + (size_t)k0 * NMOD + n0 + r32;
#pragma unroll
                for (int j = 0; j < 8; ++j) bw[ks][j] = wp[(size_t)j * NMOD];
#pragma unroll
                for (int rt = 0; rt < 5; ++rt) af[ks][rt] = *(const v4u*)(ST + (size_t)(32 * rt + r32) * D + k0); }
#pragma unroll
            for (int ks = 0; ks < 2; ++ks) {
                v4u bp; bp.x = pkbf0(bw[ks][0], bw[ks][1]); bp.y = pkbf0(bw[ks][2], bw[ks][3]); bp.z = pkbf0(bw[ks][4], bw[ks][5]); bp.w = pkbf0(bw[ks][6], bw[ks][7]);
                const bf16x8m bfr = __builtin_bit_cast(bf16x8m, bp);
#pragma unroll
                for (int rt = 0; rt < 5; ++rt) acc[rt] = __builtin_amdgcn_mfma_f32_32x32x16_bf16(__builtin_bit_cast(bf16x8m, af[ks][rt]), bfr, acc[rt], 0, 0, 0); }
        }
#pragma unroll
        for (int half = 4; half >= 1; half >>= 1) {
            if (F.wave >= half && F.wave < 2 * half) {
#pragma unroll
                for (int rt = 0; rt < 5; ++rt)
#pragma unroll
                    for (int i = 0; i < 16; ++i) RED[(F.wave - half) * 5120 + (rt * 16 + i) * 64 + F.lane] = acc[rt][i]; }
            __syncthreads();
            if (F.wave < half) {
#pragma unroll
                for (int rt = 0; rt < 5; ++rt)
#pragma unroll
                    for (int i = 0; i < 16; ++i) acc[rt][i] += RED[F.wave * 5120 + (rt * 16 + i) * 64 + F.lane]; }
            __syncthreads();
        }
        if (F.wave == 0) { const float bb = A.in[I_ADAB][n0 + r32];
#pragma unroll
            for (int rt = 0; rt < 5; ++rt)
#pragma unroll
                for (int i = 0; i < 16; ++i) { const int row = 32 * rt + (i & 3) + 8 * (i >> 2) + 4 * hh; if (row < NROWMOD) __hip_atomic_store(mod + (size_t)row * NMOD + n0 + r32, acc[rt][i] + bb, RLX_AGENT); } }
        if (n0 < 2 * D) cnt_arrive_wt(F, CW_MOD);
    }
}

__device__ __forceinline__ int mod_row(int m) { return m < MP ? (m >> 11) : NBP + ((m - MP) >> 2); }
__device__ __forceinline__ const float* x_row(const Args& A, int m) { return m < MP ? A.in[I_XP] + (size_t)m * D : A.in[I_XS] + (size_t)(m - MP) * D; }

__device__ __forceinline__ void p1_modulate(Frame& F, const Args& A, int rep = 0) {
    refresh(F);
    cnt_wait_ge(F, CW_MOD, (unsigned)(2 * D / 32));
    const int gw = F.vcu * NWAVES + F.wave, NGW = F.G * NWAVES;
    const float* mod = (const float*)(F.ws + WS_MOD); bf16* XN = (bf16*)(F.ws + WS_XN);
    for (int m = gw; m < M; m += NGW) {
        const float* xr = x_row(A, m) + 8 * F.lane; const float* mr = mod + (size_t)mod_row(m) * NMOD + 8 * F.lane;
#pragma unroll
        for (int j = 0; j < 2; ++j) { const f32x4 v0 = *(const f32x4*)(xr + 512 * j), v1 = *(const f32x4*)(xr + 512 * j + 4);
            const f32x4 a0 = *(const f32x4*)(mr + 512 * j), a1 = *(const f32x4*)(mr + 512 * j + 4), s0 = *(const f32x4*)(mr + D + 512 * j), s1 = *(const f32x4*)(mr + D + 512 * j + 4);
            const f32x4 h0 = v0 * (s0 + 1.f) + a0, h1 = v1 * (s1 + 1.f) + a1;
            v4u o; o.x = pk2(h0.x, h0.y); o.y = pk2(h0.z, h0.w); o.z = pk2(h1.x, h1.y); o.w = pk2(h1.z, h1.w);
            *(v4u*)(XN + (size_t)m * D + 512 * j + 8 * F.lane) = o; }
    }
}

__device__ __forceinline__ void unpack8(const v4u w, f32x4& a, f32x4& b) { a = (f32x4){pg8::bf_lo(w.x), pg8::bf_hi(w.x), pg8::bf_lo(w.y), pg8::bf_hi(w.y)}; b = (f32x4){pg8::bf_lo(w.z), pg8::bf_hi(w.z), pg8::bf_lo(w.w), pg8::bf_hi(w.w)}; }
__device__ __forceinline__ v4u pack8f(const f32x4 a, const f32x4 b) { v4u o; o.x = pk2(a.x, a.y); o.y = pk2(a.z, a.w); o.z = pk2(b.x, b.y); o.w = pk2(b.z, b.w); return o; }
template <bool SECOND>
__device__ __forceinline__ void ln_rows(Frame& F, const Args& A, int row_lo, int row_hi, int gw, int NGW) {
    refresh(F);
    const float* mod = (const float*)(F.ws + WS_MOD); bf16* XN = (bf16*)(F.ws + WS_XN);
    const float* gg = A.in[SECOND ? I_LN2G : I_LN1G] + 8 * F.lane; const float* gb = A.in[SECOND ? I_LN2B : I_LN1B] + 8 * F.lane;
    for (int m = row_lo + gw; m < row_hi; m += NGW) {
        float* xr = F.out + (size_t)m * D + 8 * F.lane;
        f32x4 v[2][2]; float s = 0.f;
        if (m >= MP) {
            const float* mr = mod + (size_t)mod_row(m) * NMOD + (SECOND ? 5 : 2) * D + 8 * F.lane;
            const float* bs = SECOND ? xr : A.in[I_XS] + (size_t)(m - MP) * D + 8 * F.lane;
            const float* sl = (const float*)(F.ws + WS_SLAB) + (size_t)(m - MP) * D + 8 * F.lane;
#pragma unroll
            for (int j = 0; j < 2; ++j)
#pragma unroll
                for (int h = 0; h < 2; ++h) { const int o = 512 * j + 4 * h; f32x4 a = SECOND ? *(const f32x4*)(A.in[I_B2] + 8 * F.lane + o) : (f32x4){0.f, 0.f, 0.f, 0.f};
#pragma unroll
                    for (int ks = 0; ks < (SECOND ? NS_DOWN : NS_OUT); ++ks) a += *(const f32x4*)(sl + (size_t)ks * (512 * 1024) + o);
                    v[j][h] = *(const f32x4*)(bs + o) * ALPHA + *(const f32x4*)(mr + o) * a; }
        } else {
            const bf16* tr = (const bf16*)(F.ws + (SECOND ? WS_T2 : WS_T1)) + (size_t)m * D + 8 * F.lane;
#pragma unroll
            for (int j = 0; j < 2; ++j) unpack8(*(const v4u*)(tr + 512 * j), v[j][0], v[j][1]);
        }
#pragma unroll
        for (int j = 0; j < 2; ++j)
#pragma unroll
            for (int h = 0; h < 2; ++h) s += (v[j][h].x + v[j][h].y) + (v[j][h].z + v[j][h].w);
        const float mean = wave_sum(s) * (1.f / D); float s2 = 0.f;
#pragma unroll
        for (int j = 0; j < 2; ++j)
#pragma unroll
            for (int h = 0; h < 2; ++h) { v[j][h] = v[j][h] - mean; s2 += (v[j][h].x * v[j][h].x + v[j][h].y * v[j][h].y) + (v[j][h].z * v[j][h].z + v[j][h].w * v[j][h].w); }
        const float rstd = 1.f / sqrtf(wave_sum(s2) * (1.f / D) + LN_EPS);
#pragma unroll
        for (int j = 0; j < 2; ++j)
#pragma unroll
            for (int h = 0; h < 2; ++h) v[j][h] = v[j][h] * rstd * *(const f32x4*)(gg + 512 * j + 4 * h) + *(const f32x4*)(gb + 512 * j + 4 * h);
        if (SECOND || m >= MP) {
#pragma unroll
            for (int j = 0; j < 2; ++j) { *(f32x4*)(xr + 512 * j) = v[j][0]; *(f32x4*)(xr + 512 * j + 4) = v[j][1]; }
        } else {
            bf16* x1 = (bf16*)(F.ws + WS_X1B) + (size_t)m * D + 8 * F.lane;
#pragma unroll
            for (int j = 0; j < 2; ++j) *(v4u*)(x1 + 512 * j) = pack8f(v[j][0], v[j][1]);
        }
        if (!SECOND) {
            const float* mr = mod + (size_t)mod_row(m) * NMOD + 8 * F.lane;
#pragma unroll
            for (int j = 0; j < 2; ++j) { const int o = 512 * j;
                const f32x4 h0 = v[j][0] * (*(const f32x4*)(mr + 4 * D + o) + 1.f) + *(const f32x4*)(mr + 3 * D + o), h1 = v[j][1] * (*(const f32x4*)(mr + 4 * D + o + 4) + 1.f) + *(const f32x4*)(mr + 3 * D + o + 4);
                *(v4u*)(XN + (size_t)m * D + o + 8 * F.lane) = pack8f(h0, h1); }
        }
    }
}

__device__ __forceinline__ void rg_item_ref(Frame& F, const Args& A, bool prompt, int b, int hd, LAS float* scr) {
    const int j = F.lane, c = hd * HDA + j;
    const bf16* Z = (const bf16*)(F.ws + WS_Z); bf16* Y = (bf16*)(F.ws + WS_YCAT); const float* sc = (const float*)(F.ws + WS_S5C);
    float wr[64], wi[64];
#pragma unroll
    for (int i = 0; i < 64; ++i) { wr[i] = A.in[I_RGWR][(size_t)(hd * 64 + i) * 64 + j]; wi[i] = A.in[I_RGWI][(size_t)(hd * 64 + i) * 64 + j]; }
    const float br = A.in[I_RGBR][c], bi = A.in[I_RGBI][c], L2 = sc[SC_RGL + c];
    const float w0 = A.in[I_CONVW][c], w1 = A.in[I_CONVW][WA + c], w2 = A.in[I_CONVW][2 * WA + c], w3 = A.in[I_CONVW][3 * WA + c], cb = A.in[I_CONVB][c];
    int T, m0; float x3, x2, x1, h;
    if (prompt) { T = TP; m0 = b * TP; x3 = 0.f; x2 = 0.f; x1 = 0.f; h = 0.f; }
    else { T = TS; m0 = MP + b * TS; x3 = A.in[I_SCONV][(size_t)(b * 3 + 0) * WA + c]; x2 = A.in[I_SCONV][(size_t)(b * 3 + 1) * WA + c]; x1 = A.in[I_SCONV][(size_t)(b * 3 + 2) * WA + c]; h = A.in[I_SH][(size_t)b * WA + c]; }
    for (int t = 0; t < T; ++t) {
        const size_t m = (size_t)(m0 + t);
        const float xa = bf2f(Z[m * NZ + WA + c]), gate = bf2f(Z[m * NZ + c]);
        const float xc = cb + w0 * x3 + w1 * x2 + w2 * x1 + w3 * xa; x3 = x2; x2 = x1; x1 = xa;
        scr[j] = xc; LDS_WAIT(); asm volatile("" ::: "memory");
        float rp = br, gp = bi;
#pragma unroll
        for (int i4 = 0; i4 < 16; ++i4) { const f32x4 v = *(const LAS f32x4*)(scr + 4 * i4);
            rp += v[0] * wr[4 * i4] + v[1] * wr[4 * i4 + 1] + v[2] * wr[4 * i4 + 2] + v[3] * wr[4 * i4 + 3];
            gp += v[0] * wi[4 * i4] + v[1] * wi[4 * i4 + 1] + v[2] * wi[4 * i4 + 2] + v[3] * wi[4 * i4 + 3]; }
        LDS_WAIT(); asm volatile("" ::: "memory");
        const float r = sigmoidf_(rp), gi = sigmoidf_(gp);
        const float a = exp2f(r * L2);
        float mult = sqrtf(fmaxf(1.f - a * a, 0.f));
        if (prompt && t == 0) mult = 1.f;
        h = a * h + mult * gi * xc;
        Y[m * D + c] = (bf16)f2bf(gelu_tanh(gate) * h);
    }
    float* oc = F.out + (prompt ? O_CONVP : O_CONVS); float* oh = F.out + (prompt ? O_HP : O_HS);
    oc[(size_t)(b * 3 + 0) * WA + c] = x3; oc[(size_t)(b * 3 + 1) * WA + c] = x2; oc[(size_t)(b * 3 + 2) * WA + c] = x1;
    oh[(size_t)b * WA + c] = h;
}
__device__ __forceinline__ void s5_item_ref(Frame& F, const Args& A, bool prompt, int b, int g, LAS float* scr) {
    const int n = F.lane, gn = g * NS5 + n, k = F.lane & 15, part = F.lane >> 4;
    const bf16* Z = (const bf16*)(F.ws + WS_Z); bf16* Gy = (bf16*)(F.ws + WS_G); const float* sc = (const float*)(F.ws + WS_S5C);
    float bbr[16], bbi[16], cre[16], cim[16];
#pragma unroll
    for (int i = 0; i < 16; ++i) { bbr[i] = sc[SC_BBR + gn * KS5 + i]; bbi[i] = sc[SC_BBI + gn * KS5 + i];
        cre[i] = A.in[I_S5CRE][(size_t)(g * KS5 + k) * NS5 + part * 16 + i]; cim[i] = A.in[I_S5CIM][(size_t)(g * KS5 + k) * NS5 + part * 16 + i]; }
    const float abr = sc[SC_ABR + gn], abi = sc[SC_ABI + gn], dk = A.in[I_S5D][g * KS5 + k];
    int T, m0; float hr, hi;
    if (prompt) { T = TP; m0 = b * TP; hr = 0.f; hi = 0.f; }
    else { T = TS; m0 = MP + b * TS; hr = A.in[I_SSR][(size_t)(b * GB + g) * NS5 + n]; hi = A.in[I_SSI][(size_t)(b * GB + g) * NS5 + n]; }
    for (int t = 0; t < T; ++t) {
        const size_t m = (size_t)(m0 + t);
        const bf16* zr = Z + m * NZ + 2 * WA + g * KS5;
        const v4u u0 = *(const v4u*)zr, u1 = *(const v4u*)(zr + 8);
        float u[16];
        u[0] = pg8::bf_lo(u0.x); u[1] = pg8::bf_hi(u0.x); u[2] = pg8::bf_lo(u0.y); u[3] = pg8::bf_hi(u0.y); u[4] = pg8::bf_lo(u0.z); u[5] = pg8::bf_hi(u0.z); u[6] = pg8::bf_lo(u0.w); u[7] = pg8::bf_hi(u0.w);
        u[8] = pg8::bf_lo(u1.x); u[9] = pg8::bf_hi(u1.x); u[10] = pg8::bf_lo(u1.y); u[11] = pg8::bf_hi(u1.y); u[12] = pg8::bf_lo(u1.z); u[13] = pg8::bf_hi(u1.z); u[14] = pg8::bf_lo(u1.w); u[15] = pg8::bf_hi(u1.w);
        float bur = 0.f, bui = 0.f;
#pragma unroll
        for (int i = 0; i < 16; ++i) { bur += bbr[i] * u[i]; bui += bbi[i] * u[i]; }
        const float nhr = abr * hr - abi * hi + bur, nhi = abr * hi + abi * hr + bui; hr = nhr; hi = nhi;
        scr[n] = hr; scr[64 + n] = hi; LDS_WAIT(); asm volatile("" ::: "memory");
        float p = 0.f;
#pragma unroll
        for (int i4 = 0; i4 < 4; ++i4) { const f32x4 vr = *(const LAS f32x4*)(scr + part * 16 + 4 * i4), vi = *(const LAS f32x4*)(scr + 64 + part * 16 + 4 * i4);
#pragma unroll
            for (int e = 0; e < 4; ++e) p += vr[e] * cre[4 * i4 + e] - vi[e] * cim[4 * i4 + e]; }
        LDS_WAIT(); asm volatile("" ::: "memory");
        p += __shfl_xor(p, 16); p += __shfl_xor(p, 32);
        const float uk = bf2f(zr[k]);
        if (F.lane < 16) Gy[m * WB + g * KS5 + k] = (bf16)f2bf(gelu_tanh(p + dk * uk));
    }
    float* osr = F.out + (prompt ? O_SRP : O_SRS); float* osi = F.out + (prompt ? O_SIP : O_SIS);
    osr[(size_t)(b * GB + g) * NS5 + n] = hr; osi[(size_t)(b * GB + g) * NS5 + n] = hi;
}

typedef short bf16x8v __attribute__((ext_vector_type(8)));
typedef float f32x16 __attribute__((ext_vector_type(16)));
typedef float f32x2v __attribute__((ext_vector_type(2)));
typedef __bf16 bf16x2v __attribute__((ext_vector_type(2)));
#define MFMA32(a, b, c) __builtin_amdgcn_mfma_f32_32x32x16_bf16((a), (b), (c), 0, 0, 0)
__device__ __forceinline__ unsigned pkbf(float a, float b) { const f32x2v v = {a, b}; const bf16x2v r = __builtin_convertvector(v, bf16x2v); return __builtin_bit_cast(unsigned, r); }
template <int CTRL> __device__ __forceinline__ float dppf(float old, float v) { return __builtin_bit_cast(float, __builtin_amdgcn_update_dpp(__builtin_bit_cast(int, old), __builtin_bit_cast(int, v), CTRL, 0xF, 0xF, false)); }
__device__ __forceinline__ f32x16 ld16(const float* p) { f32x16 r;
#pragma unroll
    for (int i = 0; i < 4; ++i) { const f32x4 v = *(const f32x4*)(p + 4 * i); r[4 * i] = v[0]; r[4 * i + 1] = v[1]; r[4 * i + 2] = v[2]; r[4 * i + 3] = v[3]; }
    return r; }
__device__ __forceinline__ f32x16 ld16l(const LAS float* p) { f32x16 r;
#pragma unroll
    for (int i = 0; i < 4; ++i) { const f32x4 v = *(const LAS f32x4*)(p + 4 * i); r[4 * i] = v[0]; r[4 * i + 1] = v[1]; r[4 * i + 2] = v[2]; r[4 * i + 3] = v[3]; }
    return r; }
__device__ __forceinline__ bf16x8v pack8(const f32x16& x, int s) { v4u p; p.x = pkbf(x[8 * s], x[8 * s + 1]); p.y = pkbf(x[8 * s + 2], x[8 * s + 3]); p.z = pkbf(x[8 * s + 4], x[8 * s + 5]); p.w = pkbf(x[8 * s + 6], x[8 * s + 7]); return __builtin_bit_cast(bf16x8v, p); }
template <int CTRL> __device__ __forceinline__ void s5_scan_step(f32x16& xr, f32x16& xi, const f32x16& zr, const f32x16& zi) {
#pragma unroll
    for (int i = 0; i < 16; ++i) { const float sr = dppf<CTRL>(0.f, xr[i]), si = dppf<CTRL>(0.f, xi[i]);
        xr[i] += zr[i] * sr - zi[i] * si; xi[i] += zr[i] * si + zi[i] * sr; }
}
constexpr int S5L_BF1 = 0, S5L_BF2 = 4096, S5L_TOT = 12288, S5L_CAR = 20480, S5L_ZP = 28672  , S5L_TA = 37376  , S5L_U = 38912  ;
template <bool SECOND>
__device__ __forceinline__ void s5_step(LAS unsigned char* L, int lane, const bf16x8v u, f32x16& hr0, f32x16& hr1, f32x16& hi0, f32x16& hi1,
                                        const f32x16& ar0, const f32x16& ar1, const f32x16& ai0, const f32x16& ai1, const float (&dk)[8], bf16* gout) {
    const LAS bf16x8v* a1 = (const LAS bf16x8v*)(L + S5L_BF1) + lane;
    { const f32x16 cr = ar0 * hr0 - ai0 * hi0, ci = ar0 * hi0 + ai0 * hr0; hr0 = MFMA32(a1[0], u, cr); hi0 = MFMA32(a1[128], u, ci); }
    asm volatile("" : "+v"(hr0), "+v"(hi0));
    { const f32x16 cr = ar1 * hr1 - ai1 * hi1, ci = ar1 * hi1 + ai1 * hr1; hr1 = MFMA32(a1[64], u, cr); hi1 = MFMA32(a1[192], u, ci); }
    if (SECOND) {
        const LAS bf16x8v* a2 = (const LAS bf16x8v*)(L + S5L_BF2) + lane;
        f32x16 y;
#pragma unroll
        for (int i = 0; i < 16; ++i) y[i] = 0.f;
        y = MFMA32(a2[0 * 64], pack8(hr0, 0), y); y = MFMA32(a2[1 * 64], pack8(hr0, 1), y);
        y = MFMA32(a2[2 * 64], pack8(hr1, 0), y); y = MFMA32(a2[3 * 64], pack8(hr1, 1), y);
        y = MFMA32(a2[4 * 64], pack8(hi0, 0), y); y = MFMA32(a2[5 * 64], pack8(hi0, 1), y);
        y = MFMA32(a2[6 * 64], pack8(hi1, 0), y); y = MFMA32(a2[7 * 64], pack8(hi1, 1), y);
        const v4u uw = __builtin_bit_cast(v4u, u);
        float o[8];
        o[0] = gelu_tanh(y[0] + dk[0] * pg8::bf_lo(uw.x)); o[1] = gelu_tanh(y[1] + dk[1] * pg8::bf_hi(uw.x));
        o[2] = gelu_tanh(y[2] + dk[2] * pg8::bf_lo(uw.y)); o[3] = gelu_tanh(y[3] + dk[3] * pg8::bf_hi(uw.y));
        o[4] = gelu_tanh(y[4] + dk[4] * pg8::bf_lo(uw.z)); o[5] = gelu_tanh(y[5] + dk[5] * pg8::bf_hi(uw.z));
        o[6] = gelu_tanh(y[6] + dk[6] * pg8::bf_lo(uw.w)); o[7] = gelu_tanh(y[7] + dk[7] * pg8::bf_hi(uw.w));
        v4u w; w.x = pkbf(o[0], o[1]); w.y = pkbf(o[2], o[3]); w.z = pkbf(o[4], o[5]); w.w = pkbf(o[6], o[7]);
        pg8::st16_wt(gout, w);
    }
}
__device__ __forceinline__ void s5_item_fast(Frame& F, const Args& A, int b, int g) {
    refresh(F);
    const int lane = F.lane, q = lane & 31, hh = lane >> 5, w = F.wave, c = w * 32 + q;
    LAS unsigned char* L = F.lds + RING_OFF;
    const unsigned char* tab = F.ws + WS_TAB;
    const size_t m0 = (size_t)b * TP + (size_t)8 * c;
    const bf16* zrow = (const bf16*)(F.ws + WS_Z) + m0 * NZ + 2 * WA + g * KS5 + 8 * hh;
    bf16* grow = (bf16*)(F.ws + WS_G) + m0 * WB + g * KS5 + 8 * hh;
    LAS v4u* UL = (LAS v4u*)(L + S5L_U) + F.tid;
    {
        v4u uu[8];
#pragma unroll
        for (int j = 0; j < 8; ++j) uu[j] = *(const v4u*)(zrow + (size_t)j * NZ);
        const v4u* s1 = (const v4u*)(tab + TB_BF1) + (size_t)g * 256; const v4u* s2 = (const v4u*)(tab + TB_BF2) + (size_t)g * 512;
        if (F.tid < 256) ((LAS v4u*)(L + S5L_BF1))[F.tid] = s1[F.tid];
        ((LAS v4u*)(L + S5L_BF2))[F.tid] = s2[F.tid];
        const v4u* s3 = (const v4u*)(tab + TB_ZP) + (size_t)g * (17 * 128 / 4); for (int e = F.tid; e < 17 * 128 / 4; e += NWAVES * 64) ((LAS v4u*)(L + S5L_ZP))[e] = s3[e];
        if (F.tid < 32) ((LAS v4u*)(L + S5L_TA))[F.tid] = ((const v4u*)(tab + TB_TA) + (size_t)g * 32)[F.tid];
#pragma unroll
        for (int j = 0; j < 8; ++j) UL[512 * j] = uu[j];
    }
    __syncthreads();
    const LAS float* TA = (const LAS float*)(L + S5L_TA) + hh * 64;
    f32x16 ar0 = ld16l(TA), ar1 = ld16l(TA + 16), ai0 = ld16l(TA + 32), ai1 = ld16l(TA + 48);
    f32x16 hr0, hr1, hi0, hi1;
#pragma unroll
    for (int i = 0; i < 16; ++i) { hr0[i] = 0.f; hr1[i] = 0.f; hi0[i] = 0.f; hi1[i] = 0.f; }
    float dk[8];
#pragma unroll
    for (int i = 0; i < 8; ++i) dk[i] = A.in[I_S5D][g * KS5 + 8 * hh + i];
#pragma unroll 1
    for (int j = 0; j < 8; ++j) { const bf16x8v u = __builtin_bit_cast(bf16x8v, UL[512 * j]);
        s5_step<false>(L, lane, u, hr0, hr1, hi0, hi1, ar0, ar1, ai0, ai1, dk, nullptr); }
    const LAS float* ZP = (const LAS float*)(L + S5L_ZP);
#define S5_SCAN(E, CTRL) do { const LAS float* z = ZP + (((E) * 2 + hh) * 2) * 32; \
        { const f32x16 zr = ld16l(z), zi = ld16l(z + 32); s5_scan_step<CTRL>(hr0, hi0, zr, zi); } \
        asm volatile("" : "+v"(hr0), "+v"(hi0) :: "memory"); \
        { const f32x16 zr = ld16l(z + 16), zi = ld16l(z + 48); s5_scan_step<CTRL>(hr1, hi1, zr, zi); } \
        asm volatile("" : "+v"(hr1), "+v"(hi1) :: "memory"); } while (0)
    S5_SCAN(1, 0x111); S5_SCAN(2, 0x112); S5_SCAN(4, 0x114); S5_SCAN(8, 0x118);
#undef S5_SCAN
    const int seg = w * 2 + (q >> 4);
    LAS float* TOT = (LAS float*)(L + S5L_TOT); LAS float* CAR = (LAS float*)(L + S5L_CAR);
    if ((lane & 15) == 15) {
#pragma unroll
        for (int rho = 0; rho < 4; ++rho) {
            *(LAS f32x4*)(TOT + (seg * 2 + 0) * 64 + 0 + 8 * rho + 4 * hh) = (f32x4){hr0[4 * rho], hr0[4 * rho + 1], hr0[4 * rho + 2], hr0[4 * rho + 3]};
            *(LAS f32x4*)(TOT + (seg * 2 + 0) * 64 + 32 + 8 * rho + 4 * hh) = (f32x4){hr1[4 * rho], hr1[4 * rho + 1], hr1[4 * rho + 2], hr1[4 * rho + 3]};
            *(LAS f32x4*)(TOT + (seg * 2 + 1) * 64 + 0 + 8 * rho + 4 * hh) = (f32x4){hi0[4 * rho], hi0[4 * rho + 1], hi0[4 * rho + 2], hi0[4 * rho + 3]};
            *(LAS f32x4*)(TOT + (seg * 2 + 1) * 64 + 32 + 8 * rho + 4 * hh) = (f32x4){hi1[4 * rho], hi1[4 * rho + 1], hi1[4 * rho + 2], hi1[4 * rho + 3]}; }
    }
    __syncthreads();
    if (F.tid < 64) {
        const float* z16 = (const float*)(tab + TB_Z16N) + (size_t)g * 128; const float zr = z16[F.tid], zi = z16[64 + F.tid];
        float cr = 0.f, ci = 0.f;
#pragma unroll
        for (int sg = 0; sg < 16; ++sg) { CAR[(sg * 2 + 0) * 64 + F.tid] = cr; CAR[(sg * 2 + 1) * 64 + F.tid] = ci;
            const float tr = TOT[(sg * 2 + 0) * 64 + F.tid], ti = TOT[(sg * 2 + 1) * 64 + F.tid];
            const float ncr = zr * cr - zi * ci + tr, nci = zr * ci + zi * cr + ti; cr = ncr; ci = nci; }
    }
    __syncthreads();
    {
        const LAS float* z = ZP + (((q & 15) * 2 + hh) * 2) * 32;
#define S5_EXCL(HR, HI, OFF) do { const f32x16 zr = ld16l(z + (OFF)), zi = ld16l(z + 32 + (OFF)); f32x16 kr, ki; \
        _Pragma("unroll") for (int rho = 0; rho < 4; ++rho) { \
            const f32x4 a0 = *(const LAS f32x4*)(CAR + (seg * 2 + 0) * 64 + 2 * (OFF) + 8 * rho + 4 * hh), b0 = *(const LAS f32x4*)(CAR + (seg * 2 + 1) * 64 + 2 * (OFF) + 8 * rho + 4 * hh); \
            _Pragma("unroll") for (int e = 0; e < 4; ++e) { kr[4 * rho + e] = a0[e]; ki[4 * rho + e] = b0[e]; } } \
        _Pragma("unroll") for (int i = 0; i < 16; ++i) { const float sr = dppf<0x111>(0.f, HR[i]), si = dppf<0x111>(0.f, HI[i]); \
            HR[i] = sr + zr[i] * kr[i] - zi[i] * ki[i]; HI[i] = si + zr[i] * ki[i] + zi[i] * kr[i]; } } while (0)
        S5_EXCL(hr0, hi0, 0); asm volatile("" : "+v"(hr0), "+v"(hi0) :: "memory"); S5_EXCL(hr1, hi1, 16); asm volatile("" : "+v"(hr1), "+v"(hi1) :: "memory");
#undef S5_EXCL
    }
    { int off = 0; asm volatile("" : "+v"(off)); const LAS float* TA2 = TA + off; ar0 = ld16l(TA2); ar1 = ld16l(TA2 + 16); ai0 = ld16l(TA2 + 32); ai1 = ld16l(TA2 + 48); }
#pragma unroll 1
    for (int j = 0; j < 8; ++j) { const bf16x8v u = __builtin_bit_cast(bf16x8v, UL[512 * j]);
        s5_step<true>(L, lane, u, hr0, hr1, hi0, hi1, ar0, ar1, ai0, ai1, dk, grow + (size_t)j * WB); }
    if (w == NWAVES - 1 && q == 31) {
        float* osr = F.out + O_SRP + (size_t)(b * GB + g) * NS5; float* osi = F.out + O_SIP + (size_t)(b * GB + g) * NS5;
#pragma unroll
        for (int i = 0; i < 16; ++i) { const int n = (i & 3) + 8 * (i >> 2) + 4 * hh; osr[n] = hr0[i]; osr[32 + n] = hr1[i]; osi[n] = hi0[i]; osi[32 + n] = hi1[i]; }
    }
    __syncthreads();
}

__device__ __forceinline__ void s5_item_sample(Frame& F, const Args& A, int g) {
    refresh(F);
    const int lane = F.lane, q = lane & 31, hh = lane >> 5, w = F.wave;
    LAS unsigned char* L = F.lds + RING_OFF;
    const unsigned char* tab = F.ws + WS_TAB;
    { const v4u* s1 = (const v4u*)(tab + TB_BF1) + (size_t)g * 256; const v4u* s2 = (const v4u*)(tab + TB_BF2) + (size_t)g * 512;
      if (F.tid < 256) ((LAS v4u*)(L + S5L_BF1))[F.tid] = s1[F.tid];
      ((LAS v4u*)(L + S5L_BF2))[F.tid] = s2[F.tid]; }
    __syncthreads();
    if (w < 4) {
        const int b = w * 32 + q;
        const float* TA = (const float*)(tab + TB_TA) + (size_t)((g * 2 + hh) * 2) * 32;
        const f32x16 ar0 = ld16(TA), ar1 = ld16(TA + 16), ai0 = ld16(TA + 32), ai1 = ld16(TA + 48);
        f32x16 hr0, hr1, hi0, hi1;
        const float* sr = A.in[I_SSR] + (size_t)(b * GB + g) * NS5; const float* si = A.in[I_SSI] + (size_t)(b * GB + g) * NS5;
#pragma unroll
        for (int rho = 0; rho < 4; ++rho) { const f32x4 a0 = *(const f32x4*)(sr + 8 * rho + 4 * hh), a1 = *(const f32x4*)(sr + 32 + 8 * rho + 4 * hh), b0 = *(const f32x4*)(si + 8 * rho + 4 * hh), b1 = *(const f32x4*)(si + 32 + 8 * rho + 4 * hh);
#pragma unroll
            for (int e = 0; e < 4; ++e) { hr0[4 * rho + e] = a0[e]; hr1[4 * rho + e] = a1[e]; hi0[4 * rho + e] = b0[e]; hi1[4 * rho + e] = b1[e]; } }
        float dk[8];
#pragma unroll
        for (int i = 0; i < 8; ++i) dk[i] = A.in[I_S5D][g * KS5 + 8 * hh + i];
        const size_t m0 = (size_t)MP + (size_t)b * TS;
        const bf16* zrow = (const bf16*)(F.ws + WS_Z) + m0 * NZ + 2 * WA + g * KS5 + 8 * hh;
        bf16* grow = (bf16*)(F.ws + WS_G) + m0 * WB + g * KS5 + 8 * hh;
        bf16x8v uu[TS];
#pragma unroll
        for (int j = 0; j < TS; ++j) uu[j] = *(const bf16x8v*)(zrow + (size_t)j * NZ);
#pragma unroll
        for (int j = 0; j < TS; ++j) s5_step<true>(L, lane, uu[j], hr0, hr1, hi0, hi1, ar0, ar1, ai0, ai1, dk, grow + (size_t)j * WB);
        float* osr = F.out + O_SRS + (size_t)(b * GB + g) * NS5; float* osi = F.out + O_SIS + (size_t)(b * GB + g) * NS5;
#pragma unroll
        for (int rho = 0; rho < 4; ++rho) {
            *(f32x4*)(osr + 8 * rho + 4 * hh) = (f32x4){hr0[4 * rho], hr0[4 * rho + 1], hr0[4 * rho + 2], hr0[4 * rho + 3]};
            *(f32x4*)(osr + 32 + 8 * rho + 4 * hh) = (f32x4){hr1[4 * rho], hr1[4 * rho + 1], hr1[4 * rho + 2], hr1[4 * rho + 3]};
            *(f32x4*)(osi + 8 * rho + 4 * hh) = (f32x4){hi0[4 * rho], hi0[4 * rho + 1], hi0[4 * rho + 2], hi0[4 * rho + 3]};
            *(f32x4*)(osi + 32 + 8 * rho + 4 * hh) = (f32x4){hi1[4 * rho], hi1[4 * rho + 1], hi1[4 * rho + 2], hi1[4 * rho + 3]}; }
    }
    __syncthreads();
}

template <int CTRL, int RMASK> __device__ __forceinline__ float dppm(float old, float v) { return __builtin_bit_cast(float, __builtin_amdgcn_update_dpp(__builtin_bit_cast(int, old), __builtin_bit_cast(int, v), CTRL, RMASK, 0xF, false)); }
template <int CTRL, int RMASK> __device__ __forceinline__ void rg_scan_step(f32x16& a, f32x16& b) {
#pragma unroll
    for (int i = 0; i < 16; ++i) { const float as = dppm<CTRL, RMASK>(1.f, a[i]), bs = dppm<CTRL, RMASK>(0.f, b[i]); b[i] = a[i] * bs + b[i]; a[i] = a[i] * as; }
}
constexpr int RGL_AFR = 0, RGL_DG = 8192, RGL_TOT = 24576, RGL_CST = 28672;
constexpr int RGL_XAP = 144;
constexpr int RGL_XA0 = 29696, RGL_BUF = 37376;
static_assert(259 * RGL_XAP <= RGL_BUF && RGL_XA0 + 2 * RGL_BUF <= RING_BYTES && RGL_CST + 640 <= RGL_XA0, "RG-LRU LDS map");
template <bool SAMPLE>
__device__ __forceinline__ void rg_item_fast(Frame& F, const Args& A, int b, int hd, int jh) {
    refresh(F);
    const int lane = F.lane, q = lane & 31, hh = lane >> 5, w = F.wave;
    LAS unsigned char* L = F.lds + RING_OFF;
    const float* sc = (const float*)(F.ws + WS_S5C);
    const bf16* Zb = (const bf16*)(F.ws + WS_Z) + (size_t)(SAMPLE ? MP : b * TP) * NZ; bf16* Yb = (bf16*)(F.ws + WS_YCAT) + (size_t)(SAMPLE ? MP : b * TP) * D;
    const bf16* CB = (const bf16*)(F.ws + WS_TAB + TB_CB);
    auto stage_load = [&](int T0, v4u (&st)[5]) {
#pragma unroll
        for (int k = 0; k < 5; ++k) { const int ci = F.tid + 512 * k; v4u v = (v4u){0u, 0u, 0u, 0u};
            if (ci < 2072) { const int tk = T0 - 3 + (ci >> 3); if (tk >= 0) v = *(const v4u*)(Zb + (size_t)tk * NZ + WA + hd * 64 + (ci & 7) * 8); }
            st[k] = v; } };
    auto stage_write = [&](int par, const v4u (&st)[5]) {
#pragma unroll
        for (int k = 0; k < 5; ++k) { const int ci = F.tid + 512 * k;
            if (ci < 2072) *(LAS v4u*)(L + RGL_XA0 + par * RGL_BUF + (ci >> 3) * RGL_XAP + (ci & 7) * 16) = st[k]; } };
    {
        const v4u* src = (const v4u*)(F.ws + WS_TAB + TB_RG) + (size_t)((hd * 2 + jh) * 8) * 64;
        ((LAS v4u*)(L + RGL_AFR))[F.tid] = src[F.tid];
        const v4u* sd = (const v4u*)(F.ws + WS_TAB + TB_DG) + (size_t)(hd * 16) * 64;
        ((LAS v4u*)(L + RGL_DG))[F.tid] = sd[F.tid]; ((LAS v4u*)(L + RGL_DG))[512 + F.tid] = sd[512 + F.tid];
        if (F.tid < 160) { const int h2 = F.tid / 80, kind = (F.tid % 80) / 16, i = F.tid % 16, cr = (i & 3) + 8 * (i >> 2) + 4 * h2;
            const int c = hd * 64 + 32 * jh + cr;
            ((LAS float*)(L + RGL_CST))[F.tid] = kind == 0 ? A.in[I_RGBR][c] : kind == 1 ? A.in[I_RGBI][c] : kind == 2 ? sc[SC_RGL + c] : A.in[I_CONVB][hd * 64 + 32 * (kind - 3) + cr]; }
        if (!SAMPLE && jh == 0 && F.tid < 192) { const int k = F.tid >> 6, ch = F.tid & 63;
            F.out[O_CONVP + (size_t)(b * 3 + k) * WA + hd * 64 + ch] = bf2f(((const bf16*)(F.ws + WS_Z))[(size_t)(b * TP + TP - 3 + k) * NZ + WA + hd * 64 + ch]); }
        if (SAMPLE && jh == 0) { for (int e = F.tid; e < NBS * 3 * 64; e += NWAVES * 64) { const int bb = e / 192, k = (e / 64) % 3, ch = e & 63;
            F.out[O_CONVS + (size_t)(bb * 3 + k) * WA + hd * 64 + ch] = bf2f(((const bf16*)(F.ws + WS_Z))[(size_t)(MP + bb * TS + 1 + k) * NZ + WA + hd * 64 + ch]); } }
        if (!SAMPLE) { v4u st[5]; stage_load(0, st); stage_write(0, st); }
    }
    __syncthreads();
    float hround[16];
#pragma unroll
    for (int i = 0; i < 16; ++i) hround[i] = 0.f;
    const LAS float* CST = (const LAS float*)(L + RGL_CST) + hh * 80;
    const LAS bf16x8v* af = (const LAS bf16x8v*)(L + RGL_AFR) + lane;
    const LAS bf16x8v* dg = (const LAS bf16x8v*)(L + RGL_DG) + lane;
#pragma unroll 1
    for (int rd = 0; rd < (SAMPLE ? 2 : 8); ++rd) {
        const int t = rd * 256 + w * 32 + q;
        v4u stn[5];
        if (!SAMPLE) stage_load((rd + 1) * 256, stn);
        const LAS unsigned char* XAp = L + RGL_XA0 + (rd & 1) * RGL_BUF + (w * 32 + q) * RGL_XAP + 16 * hh;
        const bf16* zsr[4];
        if (SAMPLE) {
#pragma unroll
            for (int k = 0; k < 4; ++k) { const int jx = (t & 3) + k; zsr[k] = (jx < 3 ? CB + (size_t)((t >> 2) * 3 + jx) * WA : Zb + (size_t)(t - 3 + k) * NZ + WA) + hd * 64 + 8 * hh; } }
        const bf16* gr = Zb + (size_t)t * NZ + hd * 64 + 32 * jh + 4 * hh;
        unsigned long long gq[4];
#pragma unroll
        for (int rho = 0; rho < 4; ++rho) gq[rho] = *(const unsigned long long*)(gr + 8 * rho);
        f32x16 dx0, dx1;
        { const f32x4 c0 = *(const LAS f32x4*)(CST + 48), c1 = *(const LAS f32x4*)(CST + 52), c2 = *(const LAS f32x4*)(CST + 56), c3 = *(const LAS f32x4*)(CST + 60);
          const f32x4 e0 = *(const LAS f32x4*)(CST + 64), e1 = *(const LAS f32x4*)(CST + 68), e2 = *(const LAS f32x4*)(CST + 72), e3 = *(const LAS f32x4*)(CST + 76);
#pragma unroll
          for (int e = 0; e < 4; ++e) { dx0[e] = c0[e]; dx0[4 + e] = c1[e]; dx0[8 + e] = c2[e]; dx0[12 + e] = c3[e]; dx1[e] = e0[e]; dx1[4 + e] = e1[e]; dx1[8 + e] = e2[e]; dx1[12 + e] = e3[e]; } }
#pragma unroll
        for (int k = 0; k < 4; ++k)
#pragma unroll
            for (int s4 = 0; s4 < 4; ++s4) {
                const bf16x8v xb = SAMPLE ? *(const bf16x8v*)(zsr[k] + 16 * s4) : *(const LAS bf16x8v*)(XAp + k * RGL_XAP + s4 * 32);
                if (s4 < 2) dx0 = MFMA32(dg[((0 * 2 + (s4 & 1)) * 4 + k) * 64], xb, dx0); else dx1 = MFMA32(dg[((1 * 2 + (s4 & 1)) * 4 + k) * 64], xb, dx1);
                if (s4 == 3) asm volatile("" : "+v"(dx0), "+v"(dx1) :: "memory"); }
        f32x16 dr, di;
#pragma unroll
        for (int i = 0; i < 16; ++i) { dr[i] = 0.f; di[i] = 0.f; }
        { const bf16x8v b00 = pack8(dx0, 0), b01 = pack8(dx0, 1), b10 = pack8(dx1, 0), b11 = pack8(dx1, 1);
          dr = MFMA32(af[0 * 64], b00, dr); di = MFMA32(af[4 * 64], b00, di); dr = MFMA32(af[1 * 64], b01, dr); di = MFMA32(af[5 * 64], b01, di);
          dr = MFMA32(af[2 * 64], b10, dr); di = MFMA32(af[6 * 64], b10, di); dr = MFMA32(af[3 * 64], b11, dr); di = MFMA32(af[7 * 64], b11, di); }
        f32x16 av, bv;
        const bool first = !SAMPLE && (t == 0);
#pragma unroll
        for (int i = 0; i < 16; ++i) { const float xcv = jh ? dx1[i] : dx0[i];
            const float r = sigmoidf_(dr[i] + CST[i]), gi = sigmoidf_(di[i] + CST[16 + i]);
            const float a = __builtin_amdgcn_exp2f(r * CST[32 + i]);
            float mult = __builtin_amdgcn_sqrtf(fmaxf(1.f - a * a, 0.f)); if (first) mult = 1.f;
            av[i] = a; bv[i] = mult * gi * xcv; }
        if (SAMPLE && (t & 3) == 0) {
            const float* h0 = A.in[I_SH] + (size_t)(t >> 2) * WA + hd * 64 + 32 * jh + 4 * hh;
#pragma unroll
            for (int i = 0; i < 16; ++i) { bv[i] += av[i] * h0[(i & 3) + 8 * (i >> 2)]; av[i] = 0.f; } }
        rg_scan_step<0x111, 0xF>(av, bv); rg_scan_step<0x112, 0xF>(av, bv); rg_scan_step<0x114, 0xF>(av, bv); rg_scan_step<0x118, 0xF>(av, bv);
        rg_scan_step<0x142, 0xA>(av, bv);
        float hin[16];
#pragma unroll
        for (int i = 0; i < 16; ++i) hin[i] = 0.f;
        if (!SAMPLE) {
        LAS float* TOT = (LAS float*)(L + RGL_TOT) + (rd & 1) * 512;
        if (q == 31) {
#pragma unroll
            for (int i4 = 0; i4 < 4; ++i4) { *(LAS f32x4*)(TOT + (w * 2 + 0) * 32 + hh * 16 + 4 * i4) = (f32x4){av[4 * i4], av[4 * i4 + 1], av[4 * i4 + 2], av[4 * i4 + 3]};
                                             *(LAS f32x4*)(TOT + (w * 2 + 1) * 32 + hh * 16 + 4 * i4) = (f32x4){bv[4 * i4], bv[4 * i4 + 1], bv[4 * i4 + 2], bv[4 * i4 + 3]}; }
        }
        stage_write((rd + 1) & 1, stn);
        __syncthreads();
#pragma unroll
        for (int w2 = 0; w2 < 8; ++w2) {
            if (w2 == w) {
#pragma unroll
                for (int i = 0; i < 16; ++i) hin[i] = hround[i]; }
#pragma unroll
            for (int i4 = 0; i4 < 4; ++i4) { const f32x4 p = *(const LAS f32x4*)(TOT + (w2 * 2 + 0) * 32 + hh * 16 + 4 * i4), hl = *(const LAS f32x4*)(TOT + (w2 * 2 + 1) * 32 + hh * 16 + 4 * i4);
#pragma unroll
                for (int e = 0; e < 4; ++e) hround[4 * i4 + e] = p[e] * hround[4 * i4 + e] + hl[e]; }
        }
        }
        bf16* yr = Yb + (size_t)t * D + hd * 64 + 32 * jh + 4 * hh;
#pragma unroll
        for (int rho = 0; rho < 4; ++rho) { const unsigned glo = (unsigned)gq[rho], ghi = (unsigned)(gq[rho] >> 32);
            const float o0 = gelu_tanh(pg8::bf_lo(glo)) * (bv[4 * rho] + av[4 * rho] * hin[4 * rho]), o1 = gelu_tanh(pg8::bf_hi(glo)) * (bv[4 * rho + 1] + av[4 * rho + 1] * hin[4 * rho + 1]);
            const float o2 = gelu_tanh(pg8::bf_lo(ghi)) * (bv[4 * rho + 2] + av[4 * rho + 2] * hin[4 * rho + 2]), o3 = gelu_tanh(pg8::bf_hi(ghi)) * (bv[4 * rho + 3] + av[4 * rho + 3] * hin[4 * rho + 3]);
            *(unsigned long long*)(yr + 8 * rho) = (unsigned long long)pkbf(o0, o1) | ((unsigned long long)pkbf(o2, o3) << 32); }
        if (SAMPLE && (t & 3) == 3) {
#pragma unroll
            for (int i = 0; i < 16; ++i) F.out[O_HS + (size_t)(t >> 2) * WA + hd * 64 + 32 * jh + (i & 3) + 8 * (i >> 2) + 4 * hh] = bv[i]; }
    }
    if (!SAMPLE && w == 0 && q == 0) {
#pragma unroll
        for (int i = 0; i < 16; ++i) F.out[O_HP + (size_t)b * WA + hd * 64 + 32 * jh + (i & 3) + 8 * (i >> 2) + 4 * hh] = hround[i];
    }
    __syncthreads();
}

#ifndef PROBE_P3PART
#define PROBE_P3PART 7
#endif
__device__ __forceinline__ void p3_mixers_ref(Frame& F, const Args& A, int rep = 0) {
    constexpr int N_RGP = NBP * HA, N_S5P = NBP * GB;
    const int pm = rep ? PROBE_P3PART : 7;
    bf16* GY = (bf16*)(F.ws + WS_G); bf16* YC = (bf16*)(F.ws + WS_YCAT);
    pg8::Gemm gg{GY, (const bf16*)(F.ws + WS_WGLU), M, WB, WB}; pg8::EpiGlu EG{GY, WB, YC, D, WA, A.in[I_GLUB]};
    pg8::OneUnit SG; SG.u0.pm = 0; SG.u0.pn = 0; SG.u0.k0 = 0; SG.u0.nkt = WB / 64; SG.u0.ks = 0; bool has_glu = false;
    if (F.vcu < 2 * N_RGP) {
        if ((pm & 4) && F.vcu < GB) { s5_item_sample(F, A, F.vcu); cnt_arrive_wt(F, CW_S5B + 64 * NBP); }
        if (pm & 1) rg_item_fast<false>(F, A, F.vcu / (2 * HA), (F.vcu / 2) % HA, F.vcu & 1);
        if (pm & 4) { if (F.vcu < GB) { }
                      else if (F.vcu < GB + 2 * HA) rg_item_fast<true>(F, A, 0, (F.vcu - GB) >> 1, (F.vcu - GB) & 1);
                      else if (F.vcu < GB + 2 * HA + 4) {
                          cnt_wait_ge(F, CW_S5B + 64 * NBP, (unsigned)GB); const int u = F.vcu - GB - 2 * HA; SG.u0.pm = MP / 256 + (u >> 1); SG.u0.pn = u & 1; has_glu = true; } }
    } else {
        const int v = F.vcu - 2 * N_RGP, it = 2 * v, bb = it / GB;
        if (pm & 2) { s5_item_fast(F, A, bb, it % GB);
                      s5_item_fast(F, A, bb, (it + 1) % GB);
                      cnt_arrive_wt(F, CW_S5B + 64 * bb);
                      cnt_wait_ge(F, CW_S5B + 64 * bb, 16u);
                      const int u = v & 15; SG.u0.pm = 8 * bb + (u >> 1); SG.u0.pn = u & 1; has_glu = true; }
    }
    if (has_glu) pg8::gemm_phase<pg8::EpiGlu, pg8::OneUnit, false, PG8_SP2>(F.lds + RING_OFF, gg, SG, EG);
    if (rep == 0 && F.vcu >= GB + 2 * HA + 4 && F.vcu < 2 * N_RGP) {
        constexpr int X0 = GB + 2 * HA + 4, NX = 2 * N_RGP - X0;
        LAS float* scr = (LAS float*)(F.lds + RING_OFF + F.wave * 16384);
        for (int it = XO_2 + F.wave * NX + (F.vcu - X0); it < XO_END; it += NX * NWAVES) xpose_item(F, A, scr, it); }
}

template <bool SECOND>
__device__ __forceinline__ void ln_phase(Frame& F, const Args& A, int rep) {
    pg8::StaticOrder P; P.init(MP, D, F.G, (int)blockIdx.x, D); pg8::Unit u; P.next(0, u);
    cnt_wait_ge(F, (SECOND ? CW_T2 : CW_T1) + 64 * u.pm, 4u);
    ln_rows<SECOND>(F, A, u.pm * 256 + u.pn * 64, u.pm * 256 + u.pn * 64 + 64, F.wave, NWAVES);
    constexpr int NPC = 2 * (D / 256) * (SECOND ? NS_DOWN : NS_OUT);
    const int si = (int)blockIdx.x - (F.G - NPC);
    if (si >= 0) { cnt_wait_ge(F, SECOND ? CW_T2S : CW_T1S, (unsigned)NPC);
        ln_rows<SECOND>(F, A, MP + si * (MS / NPC), MP + (si + 1) * (MS / NPC), F.wave, NWAVES); }
}
__global__ void __launch_bounds__(NWAVES * 64, 2) fwd(Args A) {
    extern __shared__ __attribute__((aligned(16))) unsigned char lds[];
    Frame F;
    F.lds = (LAS unsigned char*)lds;
    F.MISC = (volatile LAS unsigned*)(F.lds + MISC_OFF);
    F.tid = threadIdx.x; F.lane = F.tid & 63; F.wave = __builtin_amdgcn_readfirstlane(F.tid >> 6);
    F.G = gridDim.x; { const int bx = blockIdx.x; F.vcu = (F.G % 8 == 0) ? (bx % 8) * (F.G / 8) + bx / 8 : bx; }
    F.out = A.out; F.ws = A.ws; F.ctl = (gu32*)(A.ws + WS_CTL);
    for (int u = F.tid; u < (LDS_BYTES - LDSCTL_OFF) / 4; u += NWAVES * 64) ((LAS unsigned*)(F.lds + LDSCTL_OFF))[u] = 0u;
    __syncthreads();
    XcdBarrier bar; bar.bar = (unsigned*)(F.ctl + CW_BAR); bar.x = 0; bar.st = nullptr;
    if (N_LAUNCHES == 1) bar = xcd_barrier_post((unsigned*)(F.ctl + CW_BAR), F.MISC + 8);
#define GRID_BAR() do { if (N_LAUNCHES == 1) xcd_barrier(bar); } while (0)
    const int lo = A.ph_lo, hi = A.ph_hi;
#define IN(k) (lo <= (k) && (k) < hi)
#define BOTH(k) (IN(k) && IN((k) + 1))
    bf16* XN = (bf16*)(F.ws + WS_XN); bf16* Z = (bf16*)(F.ws + WS_Z); bf16* YC = (bf16*)(F.ws + WS_YCAT); bf16* GY = (bf16*)(F.ws + WS_G); bf16* U = (bf16*)(F.ws + WS_U);
    const float* mod = (const float*)(F.ws + WS_MOD);

#define REPS(k) (((PROBE_DUP) >> (k)) & 1 ? 2 : 1)
#define PH0(rep) p0_prologue(F, A, rep)
#define PH1(rep) p1_modulate(F, A, rep)
#define PH2(rep) do {     \
        pg8::Gemm g{XN, (const bf16*)(F.ws + WS_WIN), M, NZ, D}; pg8::StaticOrder S; S.init(M, NZ, F.G, (int)blockIdx.x, D); \
        pg8::EpiBf16<0> E{Z, NZ, nullptr}; \
        pg8::gemm_phase<pg8::EpiBf16<0>, pg8::StaticOrder, PG8_ALIGN, PG8_SP2>(F.lds + RING_OFF, g, S, E); \
        if ((rep) == 0 && (int)blockIdx.x >= (M / 256) * (NZ / 256) - F.G) { __syncthreads(); xpose_range_b(F, A, XO_OU, XO_2, (M / 256) * (NZ / 256) - F.G); } } while (0)
#define PH3(rep) p3_mixers_ref(F, A, rep)
#define PH4(rep) do { } while (0)
#define PH5(rep) do {     \
        pg8::Gemm g{YC, (const bf16*)(F.ws + WS_WOUT), M, D, D}; pg8::SplitOrder S; S.init(MP, D, F.G, (int)blockIdx.x, D, NS_OUT); \
        pg8::EpiRes<false> E{A.in[I_XP], (bf16*)(F.ws + WS_T1), mod + 2 * D, nullptr, ALPHA, MP, (float*)(F.ws + WS_SLAB)}; \
        pg8::gemm_phase<pg8::EpiRes<false>, pg8::SplitOrder, PG8_ALIGN, PG8_SP2>(F.lds + RING_OFF, g, S, E); \
        { pg8::Unit u0; S.P.next(0, u0); cnt_arrive_wt(F, CW_T1 + 64 * u0.pm); if ((int)blockIdx.x >= F.G - S.nP) cnt_arrive_wt(F, CW_T1S); } } while (0)
#define PH6(rep) ln_phase<false>(F, A, rep)
#define PH7(rep) do {     \
        pg8::Gemm g{XN, (const bf16*)(F.ws + WS_W1), M, FF, D}; pg8::StaticOrder S; S.init(M, FF, F.G, (int)blockIdx.x, D); \
        pg8::EpiBf16<3> E{U, FF, A.in[I_B1]}; \
        pg8::gemm_phase<pg8::EpiBf16<3>, pg8::StaticOrder, PG8_ALIGN, PG8_SP2>(F.lds + RING_OFF, g, S, E); } while (0)
#define PH8(rep) do {     \
        pg8::Gemm g{U, (const bf16*)(F.ws + WS_W2), M, D, FF}; pg8::SplitOrder S; S.init(MP, D, F.G, (int)blockIdx.x, FF, NS_DOWN); \
        pg8::EpiRes<true> E{(const bf16*)(F.ws + WS_X1B), (bf16*)(F.ws + WS_T2), mod + 5 * D, A.in[I_B2], ALPHA, MP, (float*)(F.ws + WS_SLAB)}; \
        pg8::gemm_phase<pg8::EpiRes<true>, pg8::SplitOrder, PG8_ALIGN, PG8_SP2>(F.lds + RING_OFF, g, S, E); \
        { pg8::Unit u0; S.P.next(0, u0); cnt_arrive_wt(F, CW_T2 + 64 * u0.pm); if ((int)blockIdx.x >= F.G - S.nP) cnt_arrive_wt(F, CW_T2S); } } while (0)
#define RUNNB(k, PH) do { if (IN(k)) { PH(0); if (REPS(k) == 2) { __syncthreads(); PH(1); } } } while (0)
#define RUN(k, PH) do { if (IN(k)) { PH(0); if (REPS(k) == 2) { __syncthreads(); PH(1); } if (BOTH(k)) GRID_BAR(); } } while (0)
    if (IN(0)) { PH0(0); if (REPS(0) == 2) { __syncthreads(); PH0(1); } if (IN(0) && !IN(1)) { } }
    RUN(1, PH1); RUN(2, PH2); RUN(3, PH3); RUNNB(5, PH5); RUN(6, PH6); RUN(7, PH7); RUNNB(8, PH8);
    if (IN(9)) { ln_phase<true>(F, A, 0); }
#undef IN
#undef BOTH
}

extern "C" void kernel_launch(void* const* d_in, const int* in_sizes, int n_in, void* d_out, int out_size, void* d_ws, size_t ws_size, hipStream_t stream) {
    static int grid = 0;
    if (grid == 0) {
        if (n_in != 37 || in_sizes[0] != MP * D || out_size != (int)O_END || ws_size < WS_END) { fprintf(stderr, "kernel_launch: unexpected shapes (n_in %d, in0 %d, out %d, ws %zu)\n", n_in, n_in > 0 ? in_sizes[0] : -1, out_size, ws_size); grid = -1; return; }
        int dev = 0, cus = 0, per_cu = 0;
        if (hipGetDevice(&dev) != hipSuccess || hipDeviceGetAttribute(&cus, hipDeviceAttributeMultiprocessorCount, dev) != hipSuccess) { grid = -1; return; }
        if (hipFuncSetAttribute((const void*)fwd, hipFuncAttributeMaxDynamicSharedMemorySize, LDS_BYTES) != hipSuccess) { fprintf(stderr, "kernel_launch: hipFuncSetAttribute failed\n"); grid = -1; return; }
        if (hipOccupancyMaxActiveBlocksPerMultiprocessor(&per_cu, (const void*)fwd, NWAVES * 64, LDS_BYTES) != hipSuccess || per_cu < 1) { fprintf(stderr, "kernel_launch: occupancy query says %d\n", per_cu); }
        (void)hipGetLastError();
        grid = cus;
        if (grid < 256) { fprintf(stderr, "kernel_launch: this build needs 256 CUs (got %d)\n", grid); grid = -1; return; }
        grid = 256;
    }
    if (grid < 0) return;
    (void)hipMemsetAsync((char*)d_ws + WS_CTL, 0, CTL_ZERO_BYTES, stream);
    Args a{};
    for (int i = 0; i < 37; ++i) a.in[i] = (const float*)d_in[i];
    a.out = (float*)d_out; a.ws = (unsigned char*)d_ws;
    for (int li = 0; li < N_LAUNCHES; ++li) {
        if (N_LAUNCHES == 1) { a.ph_lo = 0; a.ph_hi = N_PHASES; } else { a.ph_lo = li; a.ph_hi = li + 1; }
        a.li = li;
        hipLaunchKernelGGL(fwd, dim3(grid), dim3(NWAVES * 64), LDS_BYTES, stream, a);
    }
}
```

```cpp
#include <hip/hip_runtime.h>
#include <cstdio>
#include <cstdint>
#include <cmath>

#ifndef MK_N_LAUNCHES
#define MK_N_LAUNCHES 1
#endif

namespace pg8 {
#define PG8_LAS __attribute__((address_space(3)))
typedef unsigned short bf16_t;
typedef short bf16x8 __attribute__((ext_vector_type(8)));
typedef float f32x4 __attribute__((ext_vector_type(4)));
typedef unsigned u32x4 __attribute__((ext_vector_type(4)));
constexpr int BM = 256, BK = 64, HALF = 128, HTB = HALF * BK * 2, STAGE_BYTES = 8 * HTB, NXCD = 8, WGM = 8;

__host__ __device__ __forceinline__ int lds_byte(int r, int c) { const int st = (r >> 4) * 2 + (c >> 5), rr = r & 15, cc = c & 31, ob = rr * 64 + cc * 2; return st * 1024 + (ob ^ (((ob >> 9) & 1) << 5)); }
__host__ __device__ __forceinline__ void stage_rc(int b, int& R, int& C) { const int st = b / 1024, sb = b % 1024, swz = sb ^ (((sb >> 9) & 1) << 5); R = (st >> 1) * 16 + swz / 64; C = (st & 1) * 32 + (swz % 64) / 2; }
__host__ __device__ __forceinline__ int perm32(int rho) { const int n = rho >> 4, i = rho & 15; return 8 * (i >> 2) + 4 * n + (i & 3); }

struct Unit { int pm, pn, k0, nkt, ks; };
struct Gemm { const bf16_t* A; const bf16_t* Bt; int M, N, K; };

struct StaticOrder {
    int nM, nN, nwg, G, c, K;
    __host__ __device__ void init(int M, int N, int G_, int c_, int K_) { nM = M / BM; nN = N / BM; nwg = nM * nN; G = G_; c = c_; K = K_; }
    __host__ __device__ __forceinline__ bool next(int i, Unit& u) const {
        const long L = (long)i * G + c; if (L >= nwg) return false;
        int wgid = (int)L; { const int q = nwg / NXCD, r = nwg % NXCD, xcd = wgid % NXCD, off = wgid / NXCD; wgid = (xcd < r ? xcd * (q + 1) : r * (q + 1) + (xcd - r) * q) + off; }
        const int nig = WGM * nN, gid = wgid / nig, fm = gid * WGM, gsz = (nM - fm) < WGM ? (nM - fm) : WGM;
        u.pm = fm + ((wgid % nig) % gsz); u.pn = (wgid % nig) / gsz; u.k0 = 0; u.nkt = K / BK; u.ks = 0; return true;
    }
    __device__ __forceinline__ void a_ready(const Unit&) const {}
    __device__ __forceinline__ void done(const Unit&) const {}
};

struct SplitOrder {
    StaticOrder P; int nN, NS, nP, G, c, K, r0;
    __host__ __device__ void init(int MPr, int N, int G_, int c_, int K_, int NS_) { P.init(MPr, N, G_, c_, K_); nN = N / BM; NS = NS_; nP = 2 * nN * NS; G = G_; c = c_; K = K_; r0 = (P.nwg + G - 1 - c) / G;   }
    __host__ __device__ __forceinline__ bool next(int i, Unit& u) const {
        Unit a; a.pm = 0; a.pn = 0; a.k0 = 0; a.nkt = K / BK; a.ks = 0;
        const bool okp = P.next(i < r0 ? i : 0, a);
        const int p = (i - r0) * G + (G - 1 - c), t = p / NS, ks = p % NS, nk = K / BK / NS;
        const bool split = i >= r0;
        u.pm = split ? P.nM + t / nN : a.pm; u.pn = split ? t % nN : a.pn; u.nkt = split ? nk : a.nkt; u.ks = split ? ks : 0; u.k0 = split ? ks * nk * BK : 0;
        return split ? (p < nP) : okp;
    }
    __device__ __forceinline__ void a_ready(const Unit&) const {}
    __device__ __forceinline__ void done(const Unit&) const {}
};

struct OneUnit {
    Unit u0;
    __host__ __device__ __forceinline__ bool next(int i, Unit& u) const { u = u0; return i == 0; }
    __device__ __forceinline__ void a_ready(const Unit&) const {}
    __device__ __forceinline__ void done(const Unit&) const {}
};
__device__ __forceinline__ void st16_wt(void* p, u32x4 v) { asm volatile("global_store_dwordx4 %0, %1, off sc1\n\ts_nop 1" :: "v"(p), "v"(v)); }
__device__ __forceinline__ void st8_wt(void* p, unsigned long long v) { asm volatile("global_store_dwordx2 %0, %1, off sc1\n\ts_nop 1" :: "v"(p), "v"(v)); }
__device__ __forceinline__ void st16f_wt(void* p, f32x4 v) { asm volatile("global_store_dwordx4 %0, %1, off sc1\n\ts_nop 1" :: "v"(p), "v"(v)); }
__device__ __forceinline__ unsigned cvt_pk_bf16(float lo, float hi) { unsigned r; asm volatile("v_cvt_pk_bf16_f32 %0, %1, %2" : "=v"(r) : "v"(lo), "v"(hi)); return r; }
__device__ __forceinline__ float bf_lo(unsigned w) { return __builtin_bit_cast(float, w << 16); }
__device__ __forceinline__ float bf_hi(unsigned w) { return __builtin_bit_cast(float, w & 0xffff0000u); }

template <int ACT> struct EpiBf16 {
    static constexpr bool PERM = true, AFTER_DRAIN = false;
    bf16_t* O; int ldc; const float* bias; bf16_t* Os = nullptr; int MPs = 0x7fffffff;
    __device__ __forceinline__ void operator()(const f32x4 (&acc)[2][2][4][2], const Unit& u, int wr, int wc, int fr, int fq) const {
        const int row0 = u.pm * BM + wr * 64 + fr; const int col0 = u.pn * BM + wc * 32 + 8 * fq;
        bf16_t* const Ob = row0 >= MPs ? Os - (size_t)MPs * ldc : O;
        f32x4 bv[2][2];
#pragma unroll
        for (int bj = 0; bj < 2; ++bj)
#pragma unroll
            for (int n = 0; n < 2; ++n) bv[bj][n] = bias ? *(const f32x4*)(bias + col0 + bj * HALF + 4 * n) : (f32x4){0.f, 0.f, 0.f, 0.f};
#pragma unroll
        for (int ai = 0; ai < 2; ++ai)
#pragma unroll
            for (int m = 0; m < 4; ++m) { bf16_t* rowp = Ob + (size_t)(row0 + ai * HALF + m * 16) * ldc + col0;
#pragma unroll
                for (int bj = 0; bj < 2; ++bj) { f32x4 v0 = acc[ai][bj][m][0] + bv[bj][0], v1 = acc[ai][bj][m][1] + bv[bj][1];
                    if (ACT == 3) {
#pragma unroll
                        for (int e = 0; e < 4; ++e) { const float a = fmaxf(v0[e], 0.f), b = fmaxf(v1[e], 0.f); v0[e] = a * a; v1[e] = b * b; } }
                    u32x4 w; w.x = cvt_pk_bf16(v0[0], v0[1]); w.y = cvt_pk_bf16(v0[2], v0[3]); w.z = cvt_pk_bf16(v1[0], v1[1]); w.w = cvt_pk_bf16(v1[2], v1[3]);
                    *(u32x4*)(rowp + bj * HALF) = w; } }
    }
};
template <bool WT = false> struct EpiGlu {
    static constexpr bool PERM = true, AFTER_DRAIN = false;
    const bf16_t* Gy; int ldg; bf16_t* O; int ldc; int coff; const float* bias;
    __device__ __forceinline__ void operator()(const f32x4 (&acc)[2][2][4][2], const Unit& u, int wr, int wc, int fr, int fq) const {
        const int row0 = u.pm * BM + wr * 64 + fr; const int col0 = u.pn * BM + wc * 32 + 8 * fq;
        f32x4 bv[2][2];
#pragma unroll
        for (int bj = 0; bj < 2; ++bj)
#pragma unroll
            for (int n = 0; n < 2; ++n) bv[bj][n] = *(const f32x4*)(bias + col0 + bj * HALF + 4 * n);
        constexpr int DEPTH = 4;
        u32x4 pg[DEPTH];
#define EPG_ROW(g) ((size_t)(row0 + ((g) >> 3) * HALF + (((g) >> 1) & 3) * 16))
#define EPG_COL(g) (col0 + ((g) & 1) * HALF)
#pragma unroll
        for (int g = 0; g < DEPTH; ++g) pg[g] = *(const u32x4*)(Gy + EPG_ROW(g) * ldg + EPG_COL(g));
#pragma unroll
        for (int gi = 0; gi < 16; ++gi) { const int ai = gi >> 3, m = (gi >> 1) & 3, bj = gi & 1;
            const u32x4 g = pg[gi % DEPTH];
            if (gi + DEPTH < 16) pg[gi % DEPTH] = *(const u32x4*)(Gy + EPG_ROW(gi + DEPTH) * ldg + EPG_COL(gi + DEPTH));
            const f32x4 v0 = acc[ai][bj][m][0] + bv[bj][0], v1 = acc[ai][bj][m][1] + bv[bj][1];
            float o[8];
            o[0] = bf_lo(g.x) * __builtin_amdgcn_rcpf(1.f + __builtin_amdgcn_exp2f(-1.4426950408889634f * v0[0])); o[1] = bf_hi(g.x) * __builtin_amdgcn_rcpf(1.f + __builtin_amdgcn_exp2f(-1.4426950408889634f * v0[1]));
            o[2] = bf_lo(g.y) * __builtin_amdgcn_rcpf(1.f + __builtin_amdgcn_exp2f(-1.4426950408889634f * v0[2])); o[3] = bf_hi(g.y) * __builtin_amdgcn_rcpf(1.f + __builtin_amdgcn_exp2f(-1.4426950408889634f * v0[3]));
            o[4] = bf_lo(g.z) * __builtin_amdgcn_rcpf(1.f + __builtin_amdgcn_exp2f(-1.4426950408889634f * v1[0])); o[5] = bf_hi(g.z) * __builtin_amdgcn_rcpf(1.f + __builtin_amdgcn_exp2f(-1.4426950408889634f * v1[1]));
            o[6] = bf_lo(g.w) * __builtin_amdgcn_rcpf(1.f + __builtin_amdgcn_exp2f(-1.4426950408889634f * v1[2])); o[7] = bf_hi(g.w) * __builtin_amdgcn_rcpf(1.f + __builtin_amdgcn_exp2f(-1.4426950408889634f * v1[3]));
            u32x4 w; w.x = cvt_pk_bf16(o[0], o[1]); w.y = cvt_pk_bf16(o[2], o[3]); w.z = cvt_pk_bf16(o[4], o[5]); w.w = cvt_pk_bf16(o[6], o[7]);
            if (WT) st16_wt(O + EPG_ROW(gi) * ldc + coff + EPG_COL(gi), w); else *(u32x4*)(O + EPG_ROW(gi) * ldc + coff + EPG_COL(gi)) = w; }
#undef EPG_ROW
#undef EPG_COL
    }
};
template <bool BASE16> struct EpiRes {
    static constexpr bool PERM = true, AFTER_DRAIN = false;
    const void* basep; bf16_t* T; const float* gate  ; const float* bias; float alpha; int MP; float* slab;
    __device__ __forceinline__ void operator()(const f32x4 (&acc)[2][2][4][2], const Unit& u, int wr, int wc, int fr, int fq) const {
        const int row0 = u.pm * BM + wr * 64 + fr, col0 = u.pn * BM + wc * 32 + 8 * fq;
        if (row0 >= MP) {
            float* sp = slab + (size_t)u.ks * 512 * 1024;
#pragma unroll
            for (int ai = 0; ai < 2; ++ai)
#pragma unroll
                for (int m = 0; m < 4; ++m) { float* op = sp + (size_t)(row0 + ai * HALF + m * 16 - MP) * 1024;
#pragma unroll
                    for (int bj = 0; bj < 2; ++bj)
#pragma unroll
                        for (int n = 0; n < 2; ++n) st16f_wt(op + col0 + bj * HALF + n * 4, acc[ai][bj][m][n]); }
            return; }
        f32x4 bv[2][2], gv[2][2];
        const float* gp = gate + (size_t)(row0 >> 11) * 6144;
#pragma unroll
        for (int bj = 0; bj < 2; ++bj)
#pragma unroll
            for (int n = 0; n < 2; ++n) { bv[bj][n] = bias ? *(const f32x4*)(bias + col0 + bj * HALF + n * 4) : (f32x4){0.f, 0.f, 0.f, 0.f}; gv[bj][n] = *(const f32x4*)(gp + col0 + bj * HALF + n * 4); }
        constexpr int DEPTH = 3;
        f32x4 pb[DEPTH][2]; u32x4 pw[DEPTH];
#define EPR_ROW(g) (row0 + ((g) >> 3) * HALF + (((g) >> 1) & 3) * 16)
#define EPR_COL(g) (col0 + ((g) & 1) * HALF)
#define EPR_LOAD(g) do { if (BASE16) pw[(g) % DEPTH] = *(const u32x4*)((const bf16_t*)basep + (size_t)EPR_ROW(g) * 1024 + EPR_COL(g)); \
            else { const float* bp_ = (const float*)basep + (size_t)EPR_ROW(g) * 1024 + EPR_COL(g); pb[(g) % DEPTH][0] = *(const f32x4*)bp_; pb[(g) % DEPTH][1] = *(const f32x4*)(bp_ + 4); } } while (0)
#pragma unroll
        for (int g = 0; g < DEPTH; ++g) EPR_LOAD(g);
#pragma unroll
        for (int g = 0; g < 16; ++g) { const int ai = g >> 3, m = (g >> 1) & 3, bj = g & 1;
            f32x4 b0, b1;
            if (BASE16) { const u32x4 bw = pw[g % DEPTH]; b0 = (f32x4){bf_lo(bw.x), bf_hi(bw.x), bf_lo(bw.y), bf_hi(bw.y)}; b1 = (f32x4){bf_lo(bw.z), bf_hi(bw.z), bf_lo(bw.w), bf_hi(bw.w)}; }
            else { b0 = pb[g % DEPTH][0]; b1 = pb[g % DEPTH][1]; }
            if (g + DEPTH < 16) EPR_LOAD(g + DEPTH);
            const f32x4 v0 = b0 * alpha + gv[bj][0] * (acc[ai][bj][m][0] + bv[bj][0]), v1 = b1 * alpha + gv[bj][1] * (acc[ai][bj][m][1] + bv[bj][1]);
            u32x4 w; w.x = cvt_pk_bf16(v0[0], v0[1]); w.y = cvt_pk_bf16(v0[2], v0[3]); w.z = cvt_pk_bf16(v1[0], v1[1]); w.w = cvt_pk_bf16(v1[2], v1[3]);
            st16_wt(T + (size_t)EPR_ROW(g) * 1024 + EPR_COL(g), w); }
#undef EPR_ROW
#undef EPR_COL
#undef EPR_LOAD
    }
};

struct PieceOrder {
    int nN, NS, nP, G, c, K, nM;
    __host__ __device__ void init(int MPr, int N, int G_, int c_, int K_, int NS_) { nM = MPr / BM; nN = N / BM; NS = NS_; nP = 2 * nN * NS; G = G_; c = c_; K = K_; }
    __host__ __device__ __forceinline__ bool next(int i, Unit& u) const {
        const int p = G - 1 - c, t = p / NS, ks = p % NS, nk = K / BK / NS;
        u.pm = nM + t / nN; u.pn = t % nN; u.nkt = nk; u.ks = ks; u.k0 = ks * nk * BK; return i == 0 && p < nP;
    }
    __device__ __forceinline__ void a_ready(const Unit&) const {}
    __device__ __forceinline__ void done(const Unit&) const {}
};
struct EpiSlab {
    static constexpr bool PERM = true, AFTER_DRAIN = false;
    float* slab; int MP;
    __device__ __forceinline__ void operator()(const f32x4 (&acc)[2][2][4][2], const Unit& u, int wr, int wc, int fr, int fq) const {
        const int row0 = u.pm * BM + wr * 64 + fr, col0 = u.pn * BM + wc * 32 + 8 * fq;
        float* sp = slab + (size_t)u.ks * 512 * 1024;
#pragma unroll
        for (int ai = 0; ai < 2; ++ai)
#pragma unroll
            for (int m = 0; m < 4; ++m) { float* op = sp + (size_t)(row0 + ai * HALF + m * 16 - MP) * 1024;
#pragma unroll
                for (int bj = 0; bj < 2; ++bj)
#pragma unroll
                    for (int n = 0; n < 2; ++n) st16f_wt(op + col0 + bj * HALF + n * 4, acc[ai][bj][m][n]); }
    }
};
template <bool SECOND> struct EpiLnFused {
    static constexpr bool PERM = true, AFTER_DRAIN = true;
    const void* basep; const float* gate; const float* bias; float alpha; const float* lng; const float* lnb; const float* mod2  ;
    float* out; bf16_t* x1; bf16_t* xn; float* stat; unsigned* cnt; float eps;
    __device__ __forceinline__ void fused(f32x4 (&acc)[2][2][4][2], const Unit& u, int wr, int wc, int fr, int fq, PG8_LAS unsigned char* lds, int wid, int lane) const {
        const int row0 = u.pm * BM + wr * 64 + fr, col0 = u.pn * BM + wc * 32 + 8 * fq, tid = wid * 64 + lane;
        {
            const float* gp = gate + (size_t)(row0 >> 11) * 6144;
#pragma unroll
            for (int bj = 0; bj < 2; ++bj) { const int c = col0 + bj * HALF;
                const f32x4 g0 = *(const f32x4*)(gp + c), g1 = *(const f32x4*)(gp + c + 4);
                const f32x4 v0 = bias ? *(const f32x4*)(bias + c) : (f32x4){0.f, 0.f, 0.f, 0.f}, v1 = bias ? *(const f32x4*)(bias + c + 4) : (f32x4){0.f, 0.f, 0.f, 0.f};
                constexpr int DEPTH = 2; f32x4 pb[DEPTH][2]; u32x4 pw[DEPTH];
#define EPF_ROW(g) (row0 + ((g) >> 2) * HALF + ((g) & 3) * 16)
#define EPF_LOAD(g) do { if (SECOND) pw[(g) % DEPTH] = *(const u32x4*)((const bf16_t*)basep + (size_t)EPF_ROW(g) * 1024 + c); \
                else { const float* bp_ = (const float*)basep + (size_t)EPF_ROW(g) * 1024 + c; pb[(g) % DEPTH][0] = *(const f32x4*)bp_; pb[(g) % DEPTH][1] = *(const f32x4*)(bp_ + 4); } } while (0)
#pragma unroll
                for (int g = 0; g < DEPTH; ++g) EPF_LOAD(g);
#pragma unroll
                for (int g = 0; g < 8; ++g) { const int ai = g >> 2, m = g & 3; f32x4 b0, b1;
                    if (SECOND) { const u32x4 bw = pw[g % DEPTH]; b0 = (f32x4){bf_lo(bw.x), bf_hi(bw.x), bf_lo(bw.y), bf_hi(bw.y)}; b1 = (f32x4){bf_lo(bw.z), bf_hi(bw.z), bf_lo(bw.w), bf_hi(bw.w)}; }
                    else { b0 = pb[g % DEPTH][0]; b1 = pb[g % DEPTH][1]; }
                    if (g + DEPTH < 8) EPF_LOAD(g + DEPTH);
                    acc[ai][bj][m][0] = b0 * alpha + g0 * (acc[ai][bj][m][0] + v0); acc[ai][bj][m][1] = b1 * alpha + g1 * (acc[ai][bj][m][1] + v1);
                    asm volatile("" : "+v"(acc[ai][bj][m][0]), "+v"(acc[ai][bj][m][1]) :: "memory"); }
#undef EPF_LOAD
#undef EPF_ROW
            }
        }
        typedef float f32x2v __attribute__((ext_vector_type(2)));
        PG8_LAS f32x2v* RS = (PG8_LAS f32x2v*)lds;
        PG8_LAS f32x2v* MR = (PG8_LAS f32x2v*)(lds + 8192);
#pragma unroll
        for (int ai = 0; ai < 2; ++ai)
#pragma unroll
            for (int m = 0; m < 4; ++m) { float sa = 0.f, sq = 0.f;
#pragma unroll
                for (int bj = 0; bj < 2; ++bj)
#pragma unroll
                    for (int n = 0; n < 2; ++n) { const f32x4 x = acc[ai][bj][m][n]; sa += (x[0] + x[1]) + (x[2] + x[3]); sq += (x[0] * x[0] + x[1] * x[1]) + (x[2] * x[2] + x[3] * x[3]); }
                sa += __shfl_xor(sa, 16); sa += __shfl_xor(sa, 32); sq += __shfl_xor(sq, 16); sq += __shfl_xor(sq, 32);
                if (fq == 0) RS[(ai * HALF + wr * 64 + m * 16 + fr) * 4 + wc] = (f32x2v){sa, sq}; }
        asm volatile("s_waitcnt lgkmcnt(0)" ::: "memory"); __builtin_amdgcn_s_barrier(); asm volatile("" ::: "memory");
        if (tid < 256) { const f32x2v a = RS[tid * 4 + 0], b = RS[tid * 4 + 1], c = RS[tid * 4 + 2], d = RS[tid * 4 + 3];
            unsigned long long* slot = (unsigned long long*)stat + ((size_t)(u.pm * 4 + u.pn) * 256 + tid);
            __hip_atomic_store(slot, ((unsigned long long)__builtin_bit_cast(unsigned, (a.y + b.y) + (c.y + d.y)) << 32) | __builtin_bit_cast(unsigned, (a.x + b.x) + (c.x + d.x)), __ATOMIC_RELAXED, __HIP_MEMORY_SCOPE_AGENT); }
        asm volatile("s_waitcnt vmcnt(0)" ::: "memory"); __builtin_amdgcn_s_barrier(); asm volatile("" ::: "memory");
        if (tid == 0) { (void)__hip_atomic_fetch_add(cnt + 64 * u.pm, 1u, __ATOMIC_RELAXED, __HIP_MEMORY_SCOPE_AGENT);
            unsigned sp = 0; while (__hip_atomic_load(cnt + 64 * u.pm, __ATOMIC_RELAXED, __HIP_MEMORY_SCOPE_AGENT) < 4u && ++sp < (1u << 22)) __builtin_amdgcn_s_sleep(2);
            __builtin_amdgcn_fence(__ATOMIC_ACQUIRE, "agent"); asm volatile("s_waitcnt vmcnt(0)" ::: "memory"); }
        __builtin_amdgcn_s_barrier(); asm volatile("" ::: "memory");
        if (tid < 256) { float S = 0.f, Q = 0.f;
#pragma unroll
            for (int p = 0; p < 4; ++p) { const unsigned long long w = __hip_atomic_load((const unsigned long long*)stat + ((size_t)(u.pm * 4 + p) * 256 + tid), __ATOMIC_RELAXED, __HIP_MEMORY_SCOPE_AGENT);
                S += __builtin_bit_cast(float, (unsigned)w); Q += __builtin_bit_cast(float, (unsigned)(w >> 32)); }
            const float mean = S * (1.f / 1024.f), var = fmaxf(Q * (1.f / 1024.f) - mean * mean, 0.f);
            MR[tid] = (f32x2v){mean, 1.0f / sqrtf(var + eps)}; }
        asm volatile("s_waitcnt lgkmcnt(0)" ::: "memory"); __builtin_amdgcn_s_barrier(); asm volatile("" ::: "memory");
#pragma unroll
        for (int bj = 0; bj < 2; ++bj) { const int c = col0 + bj * HALF;
            const f32x4 g0 = *(const f32x4*)(lng + c), g1 = *(const f32x4*)(lng + c + 4), b0 = *(const f32x4*)(lnb + c), b1 = *(const f32x4*)(lnb + c + 4);
            f32x4 s0, s1, h0, h1;
            if (!SECOND) { const float* mp = mod2 + (size_t)(row0 >> 11) * 6144 + c; h0 = *(const f32x4*)mp; h1 = *(const f32x4*)(mp + 4); s0 = *(const f32x4*)(mp + 1024) + 1.f; s1 = *(const f32x4*)(mp + 1028) + 1.f; }
#pragma unroll
            for (int ai = 0; ai < 2; ++ai)
#pragma unroll
                for (int m = 0; m < 4; ++m) { const int rl = ai * HALF + wr * 64 + m * 16 + fr; const size_t row = (size_t)(u.pm * BM + rl); const f32x2v mr = MR[rl];
                    const f32x4 y0 = (acc[ai][bj][m][0] - mr.x) * mr.y * g0 + b0, y1 = (acc[ai][bj][m][1] - mr.x) * mr.y * g1 + b1;
                    if (SECOND) { *(f32x4*)(out + row * 1024 + c) = y0; *(f32x4*)(out + row * 1024 + c + 4) = y1; }
                    else { u32x4 w; w.x = cvt_pk_bf16(y0[0], y0[1]); w.y = cvt_pk_bf16(y0[2], y0[3]); w.z = cvt_pk_bf16(y1[0], y1[1]); w.w = cvt_pk_bf16(y1[2], y1[3]);
                           *(u32x4*)(x1 + row * 1024 + c) = w;
                           const f32x4 z0 = y0 * s0 + h0, z1 = y1 * s1 + h1;
                           u32x4 v; v.x = cvt_pk_bf16(z0[0], z0[1]); v.y = cvt_pk_bf16(z0[2], z0[3]); v.z = cvt_pk_bf16(z1[0], z1[1]); v.w = cvt_pk_bf16(z1[2], z1[3]);
                           *(u32x4*)(xn + row * 1024 + c) = v; } } }
        asm volatile("s_waitcnt lgkmcnt(0)" ::: "memory"); __builtin_amdgcn_s_barrier(); asm volatile("" ::: "memory");
    }
};

template <class Epi, class Sched, bool ALIGN_EPI = false, bool SP2 = false>
__device__ __forceinline__ void gemm_phase(PG8_LAS unsigned char* lds, const Gemm g, const Sched& S, const Epi& E) {
    const int tid = threadIdx.x, wid = __builtin_amdgcn_readfirstlane(tid >> 6), lane = tid & 63, wr = wid >> 2, wc = wid & 3, fr = lane & 15, fq = lane >> 4;
    const int K = g.K;
    unsigned voffA[2], voffB[2];
#pragma unroll
    for (int i = 0; i < 2; ++i) { int R, C; stage_rc(tid * 16 + i * 8192, R, C); const int Rb = Epi::PERM ? ((R & ~31) + perm32(R & 31)) : R;
        voffA[i] = (unsigned)(R * K + C) * 2u; voffB[i] = (unsigned)(Rb * K + C) * 2u; }
    const size_t kstep = (size_t)(BK * 2);
    const size_t hstep = (size_t)HALF * K * 2;
    const size_t tstep = 2 * hstep;
    const unsigned ldsw = (unsigned)wid * 1024u;
    const int aoff = lds_byte(wr * 64 + fr, fq * 8), boff = lds_byte(wc * 32 + fr, fq * 8);
#define PG8_SA(b, h) (((b) * 2 + (h)) * HTB)
#define PG8_SB(b, h) ((4 + (b) * 2 + (h)) * HTB)
#define PG8_STAGE(bufoff, gbase, voff) do { _Pragma("unroll") for (int _i = 0; _i < 2; ++_i) \
        __builtin_amdgcn_global_load_lds((const unsigned*)((const char*)(gbase) + (voff)[_i]), (PG8_LAS unsigned*)(lds + (bufoff) + ldsw + _i * 8192), 16, 0, 0); } while (0)
#define PG8_LDA(dst, b, h) do { _Pragma("unroll") for (int m = 0; m < 4; ++m) _Pragma("unroll") for (int k = 0; k < 2; ++k) dst[m][k] = *(const PG8_LAS bf16x8*)(lds + PG8_SA(b, h) + aoff + m * 2048 + k * 1024); } while (0)
#define PG8_LDB(dst, b, h) do { _Pragma("unroll") for (int n = 0; n < 2; ++n) _Pragma("unroll") for (int k = 0; k < 2; ++k) dst[n][k] = *(const PG8_LAS bf16x8*)(lds + PG8_SB(b, h) + boff + n * 2048 + k * 1024); } while (0)
#define PG8_MMA(ai, bj, At, Bt) do { __builtin_amdgcn_s_setprio(1); _Pragma("unroll") for (int m = 0; m < 4; ++m) _Pragma("unroll") for (int n = 0; n < 2; ++n) _Pragma("unroll") for (int k = 0; k < 2; ++k) \
        acc[ai][bj][m][n] = __builtin_amdgcn_mfma_f32_16x16x32_bf16(Bt[n][k], At[m][k], acc[ai][bj][m][n], 0, 0, 0); __builtin_amdgcn_s_setprio(0); } while (0)
#define PG8_WAIT_V(n) asm volatile("s_waitcnt vmcnt(" #n ")" ::: "memory")
#define PG8_WAIT_L(n) asm volatile("s_waitcnt lgkmcnt(" #n ")" ::: "memory")
#define PG8_BAR __builtin_amdgcn_s_barrier()
#define PG8_SCHED __builtin_amdgcn_sched_barrier(0)
    Unit cur, nxt; int ui = 0;
    if (!S.next(0, cur)) return;
    f32x4 acc[2][2][4][2];
#pragma unroll
    for (int a = 0; a < 2; ++a)
#pragma unroll
        for (int b = 0; b < 2; ++b)
#pragma unroll
            for (int m = 0; m < 4; ++m)
#pragma unroll
                for (int n = 0; n < 2; ++n) acc[a][b][m][n] = (f32x4){0.f, 0.f, 0.f, 0.f};
    bf16x8 At[4][2], B0[2][2], B1[2][2];
    const char* cA = (const char*)g.A + (size_t)cur.pm * tstep + (size_t)cur.k0 * 2; const char* cB = (const char*)g.Bt + (size_t)cur.pn * tstep + (size_t)cur.k0 * 2;
    S.a_ready(cur);
    if constexpr (SP2) {
        PG8_STAGE(PG8_SB(0, 0), cB, voffB); PG8_STAGE(PG8_SB(0, 1), cB + hstep, voffB); PG8_STAGE(PG8_SA(0, 0), cA, voffA); PG8_STAGE(PG8_SA(0, 1), cA + hstep, voffA);
        if (wr == 1) PG8_BAR;
        PG8_WAIT_V(2); PG8_BAR;
        PG8_STAGE(PG8_SB(1, 0), cB + kstep, voffB); PG8_STAGE(PG8_SA(1, 0), cA + kstep, voffA); PG8_STAGE(PG8_SB(1, 1), cB + hstep + kstep, voffB);
        PG8_WAIT_V(6); PG8_BAR;
    } else {
        PG8_STAGE(PG8_SB(0, 0), cB, voffB); PG8_STAGE(PG8_SA(0, 0), cA, voffA); PG8_STAGE(PG8_SB(0, 1), cB + hstep, voffB); PG8_STAGE(PG8_SA(0, 1), cA + hstep, voffA);
        if (wr == 1) PG8_BAR;
        PG8_WAIT_V(4); PG8_BAR;
        PG8_STAGE(PG8_SB(1, 0), cB + kstep, voffB); PG8_STAGE(PG8_SA(1, 0), cA + kstep, voffA); PG8_STAGE(PG8_SB(1, 1), cB + hstep + kstep, voffB);
        PG8_WAIT_V(6); PG8_BAR;
    }
    for (;;) {
        const bool has_next = S.next(ui + 1, nxt);
        const char* nA = has_next ? (const char*)g.A + (size_t)nxt.pm * tstep + (size_t)nxt.k0 * 2 : cA; const char* nB = has_next ? (const char*)g.Bt + (size_t)nxt.pn * tstep + (size_t)nxt.k0 * 2 : cB;
        const int nt = cur.nkt;
        for (int t = 0; t < nt; t += 2) {
            const bool last = (t == nt - 2);
            const char* a1 = cA + (size_t)(t + 1) * kstep;
            const char* a2 = last ? nA : cA + (size_t)(t + 2) * kstep; const char* b2 = last ? nB : cB + (size_t)(t + 2) * kstep;
            const char* a3 = a2 + kstep; const char* b3 = b2 + kstep;
            if (last && has_next) S.a_ready(nxt);
            if constexpr (SP2) {
            PG8_LDB(B0, 0, 0); PG8_LDB(B1, 0, 1); PG8_SCHED; PG8_LDA(At, 0, 0); PG8_STAGE(PG8_SA(1, 1), a1 + hstep, voffA);
            PG8_WAIT_V(8); PG8_WAIT_L(0); PG8_BAR; PG8_MMA(0, 0, At, B0); PG8_MMA(0, 1, At, B1); PG8_BAR; PG8_SCHED;
            PG8_LDA(At, 0, 1); PG8_STAGE(PG8_SB(0, 0), b2, voffB); PG8_STAGE(PG8_SB(0, 1), b2 + hstep, voffB); PG8_STAGE(PG8_SA(0, 0), a2, voffA);
            PG8_WAIT_V(8); PG8_WAIT_L(0); PG8_BAR; PG8_MMA(1, 0, At, B0); PG8_MMA(1, 1, At, B1); PG8_BAR; PG8_SCHED;
            PG8_LDB(B0, 1, 0); PG8_LDB(B1, 1, 1); PG8_SCHED; PG8_LDA(At, 1, 0); PG8_STAGE(PG8_SA(0, 1), a2 + hstep, voffA);
            PG8_WAIT_V(8); PG8_WAIT_L(0); PG8_BAR; PG8_MMA(0, 0, At, B0); PG8_MMA(0, 1, At, B1); PG8_BAR; PG8_SCHED;
            PG8_LDA(At, 1, 1); PG8_STAGE(PG8_SB(1, 0), b3, voffB); PG8_STAGE(PG8_SB(1, 1), b3 + hstep, voffB); PG8_STAGE(PG8_SA(1, 0), a3, voffA);
            PG8_WAIT_V(8); PG8_WAIT_L(0); PG8_BAR; PG8_MMA(1, 0, At, B0); PG8_MMA(1, 1, At, B1); PG8_BAR; PG8_SCHED;
            } else {
            PG8_LDB(B0, 0, 0); PG8_SCHED; PG8_LDA(At, 0, 0); PG8_STAGE(PG8_SA(1, 1), a1 + hstep, voffA);
            PG8_WAIT_L(8); PG8_BAR; PG8_WAIT_L(0); PG8_MMA(0, 0, At, B0); PG8_BAR; PG8_SCHED;
            PG8_LDB(B1, 0, 1); PG8_STAGE(PG8_SB(0, 0), b2, voffB);
            PG8_BAR; PG8_WAIT_L(0); PG8_MMA(0, 1, At, B1); PG8_BAR;
            PG8_LDA(At, 0, 1); PG8_STAGE(PG8_SA(0, 0), a2, voffA);
            PG8_BAR; PG8_WAIT_L(0); PG8_MMA(1, 0, At, B0); PG8_BAR; PG8_SCHED;
            PG8_STAGE(PG8_SB(0, 1), b2 + hstep, voffB);
            PG8_WAIT_V(6); PG8_BAR; PG8_MMA(1, 1, At, B1); PG8_BAR;
            PG8_LDB(B0, 1, 0); PG8_SCHED; PG8_LDA(At, 1, 0); PG8_STAGE(PG8_SA(0, 1), a2 + hstep, voffA);
            PG8_WAIT_L(8); PG8_BAR; PG8_WAIT_L(0); PG8_MMA(0, 0, At, B0); PG8_BAR; PG8_SCHED;
            PG8_LDB(B1, 1, 1); PG8_STAGE(PG8_SB(1, 0), b3, voffB);
            PG8_BAR; PG8_WAIT_L(0); PG8_MMA(0, 1, At, B1); PG8_BAR;
            PG8_LDA(At, 1, 1); PG8_STAGE(PG8_SA(1, 0), a3, voffA);
            PG8_BAR; PG8_WAIT_L(0); PG8_MMA(1, 0, At, B0); PG8_BAR; PG8_SCHED;
            PG8_STAGE(PG8_SB(1, 1), b3 + hstep, voffB);
            PG8_WAIT_V(6); PG8_BAR; PG8_MMA(1, 1, At, B1); PG8_BAR;
            }
        }
        if constexpr (ALIGN_EPI) { if (wr == 0) PG8_BAR; }
        if constexpr (!Epi::AFTER_DRAIN) { E(acc, cur, wr, wc, fr, fq); S.done(cur); }
        if (!has_next) break;
#pragma unroll
        for (int a = 0; a < 2; ++a)
#pragma unroll
            for (int b = 0; b < 2; ++b)
#pragma unroll
                for (int m = 0; m < 4; ++m)
#pragma unroll
                    for (int n = 0; n < 2; ++n) acc[a][b][m][n] = (f32x4){0.f, 0.f, 0.f, 0.f};
        cur = nxt; cA = nA; cB = nB; ++ui;
        if constexpr (ALIGN_EPI) { if (wr == 1) PG8_BAR; }
    }
    PG8_WAIT_V(0);
    if constexpr (!ALIGN_EPI) { if (wr == 0) PG8_BAR; }
    PG8_BAR;
    if constexpr (Epi::AFTER_DRAIN) { E.fused(acc, cur, wr, wc, fr, fq, lds, wid, lane); S.done(cur); }
#undef PG8_SA
#undef PG8_SB
#undef PG8_STAGE
#undef PG8_LDA
#undef PG8_LDB
#undef PG8_MMA
#undef PG8_WAIT_V
#undef PG8_WAIT_L
#undef PG8_BAR
#undef PG8_SCHED
}
}

#ifndef PROBE_DUP
#define PROBE_DUP 0
#endif
#ifndef PG8_SP2
#define PG8_SP2 true
#endif
#ifndef PG8_ALIGN
#define PG8_ALIGN true
#endif

constexpr int NWAVES = 8;
constexpr int N_LAUNCHES = MK_N_LAUNCHES;
constexpr int N_PHASES = 10;
constexpr int D = 1024, MP = 16384, MS = 512, M = MP + MS, TP = 2048, NBP = 8, NBS = 128, TS = 4;
constexpr int NZ = 1536, WA = 512, WB = 512, FF = 4096, NMOD = 6 * D, NROWMOD = NBP + NBS;
constexpr int GB = 32, NS5 = 64, KS5 = 16, HA = 8, HDA = 64;
constexpr float LN_EPS = 1e-5f;
constexpr int NS_OUT = 4, NS_DOWN = 8;
constexpr float ALPHA = 1.189207115002721f;

constexpr size_t O_YP = 0, O_YS = (size_t)MP * D, O_CONVP = O_YS + (size_t)MS * D, O_HP = O_CONVP + (size_t)NBP * 3 * WA, O_SRP = O_HP + (size_t)NBP * WA,
                 O_SIP = O_SRP + (size_t)NBP * GB * NS5, O_CONVS = O_SIP + (size_t)NBP * GB * NS5, O_HS = O_CONVS + (size_t)NBS * 3 * WA, O_SRS = O_HS + (size_t)NBS * WA,
                 O_SIS = O_SRS + (size_t)NBS * GB * NS5, O_END = O_SIS + (size_t)NBS * GB * NS5;

constexpr size_t MiB = 1u << 20;
constexpr size_t WS_CTL = 0, CTL_ZERO_BYTES = 128 * 1024;
constexpr size_t WS_WIN = 1 * MiB, WS_WGLU = 4 * MiB, WS_WOUT = 5 * MiB, WS_W1 = 7 * MiB, WS_W2 = 15 * MiB;
constexpr size_t WS_MOD = 23 * MiB;
constexpr size_t WS_S5C = 27 * MiB;
constexpr size_t WS_STAT = 27 * MiB + 512 * 1024;
constexpr size_t WS_XN = 28 * MiB;
constexpr size_t WS_Z = 61 * MiB;
constexpr size_t WS_YCAT = 111 * MiB;
constexpr size_t WS_G = 144 * MiB;
constexpr size_t WS_U = 61 * MiB;
constexpr size_t WS_T1 = WS_Z;
constexpr size_t WS_T2 = WS_XN;
constexpr size_t WS_TAB = 246 * MiB;
constexpr size_t WS_SLAB = 194 * MiB;
constexpr size_t WS_X1B = 210 * MiB;
constexpr size_t WS_ZS = 242 * MiB, WS_YCS = 244 * MiB, WS_GS = 245 * MiB;
constexpr size_t WS_END = 252 * MiB;
constexpr size_t TB_BF1 = 0, TB_BF2 = TB_BF1 + 32 * 4 * 64 * 16, TB_TA = TB_BF2 + 32 * 8 * 64 * 16, TB_ZP = TB_TA + 32 * 2 * 2 * 32 * 4, TB_Z16N = TB_ZP + 32 * 17 * 2 * 2 * 32 * 4,
                 TB_RG = TB_Z16N + 32 * 2 * 64 * 4, TB_CB = TB_RG + 8 * 2 * 2 * 4 * 64 * 16, TB_SILU = TB_CB + 128 * 3 * 512 * 2, TB_DG = TB_SILU + 160 * 1024 * 2, TB_W1 = TB_DG + 8 * 16 * 64 * 16, TB_C2 = TB_W1 + 32 * 8 * 4 * 64 * 16, TB_END = TB_C2 + (size_t)32 * 8 * 8 * 64 * 16;
static_assert(WS_SLAB + (size_t)8 * 512 * 1024 * 4 <= WS_X1B && WS_X1B + (size_t)MP * D * 2 <= WS_TAB && WS_TAB + TB_END <= WS_END, "tables");
static_assert(WS_XN + (size_t)M * D * 2 <= WS_Z && WS_Z + (size_t)M * NZ * 2 <= WS_YCAT && WS_YCAT + (size_t)M * D * 2 <= WS_G && WS_G + (size_t)M * WB * 2 <= WS_END && WS_U + (size_t)M * FF * 2 <= WS_SLAB, "d_ws map");
constexpr int SC_ABR = 0, SC_ABI = 2048, SC_BBR = 4096, SC_BBI = 4096 + 32768, SC_RGL = 4096 + 65536, SC_END = SC_RGL + 512;
constexpr int CW_TMO = 0, CW_CODE = 1, CW_SILU = 64, CW_MOD = 1024  , CW_S5B = 128  , CW_BAR = 4096,
              CW_T1 = 8192  , CW_T2 = 12288  , CW_T1S = 16384, CW_T2S = 16448  , CW_XNS = 16512  , CW_YCS = 16576  ;

constexpr int RING_OFF = 0, RING_BYTES = 131072;
constexpr int LDSCTL_OFF = RING_BYTES, MISC_OFF = LDSCTL_OFF + 320;
constexpr int LDS_BYTES = 147456;

#define GAS __attribute__((address_space(1)))
#define LAS __attribute__((address_space(3)))
typedef unsigned short bf16;
typedef unsigned v4u __attribute__((ext_vector_type(4)));
typedef float f32x4 __attribute__((ext_vector_type(4)));
typedef GAS unsigned gu32;
#define RLX_AGENT __ATOMIC_RELAXED, __HIP_MEMORY_SCOPE_AGENT
#define LDS_WAIT() asm volatile("s_waitcnt lgkmcnt(0)" ::: "memory")
#define VM_WAIT() asm volatile("s_waitcnt vmcnt(0)" ::: "memory")
__device__ __forceinline__ unsigned f2bf(float f) { unsigned u = __builtin_bit_cast(unsigned, f); return (u + 0x7fffu + ((u >> 16) & 1u)) >> 16; }
__device__ __forceinline__ unsigned pk2(float lo, float hi) { return f2bf(lo) | (f2bf(hi) << 16); }
__device__ __forceinline__ float bf2f(bf16 v) { return __builtin_bit_cast(float, (unsigned)v << 16); }
__device__ __forceinline__ float gelu_tanh(float x) { const float t = -2.3022082f * (x + 0.044715f * x * x * x); return x * __builtin_amdgcn_rcpf(1.f + __builtin_amdgcn_exp2f(t)); }
__device__ __forceinline__ float sigmoidf_(float x) { return __builtin_amdgcn_rcpf(1.f + __builtin_amdgcn_exp2f(-1.4426950408889634f * x)); }

#define XB_TMO      128
#define XB_XCNT(j)  (256  + 64 * (j))
#define XB_XSUB(j)  (1280 + 64 * (j))
#define XB_XGEN(j)  (2304 + 64 * (j))
#define XB_TOP      3328
#define XB_TOPGEN   3392
#define XCD_BAR_WORDS 3456
#define XB_SPIN_CAP (1u << 18)
__device__ __forceinline__ unsigned xb_ld(unsigned* p)              { return __hip_atomic_load(p, __ATOMIC_RELAXED, __HIP_MEMORY_SCOPE_AGENT); }
__device__ __forceinline__ unsigned xb_add(unsigned* p, unsigned v) { return __hip_atomic_fetch_add(p, v, __ATOMIC_RELAXED, __HIP_MEMORY_SCOPE_AGENT); }
__device__ __forceinline__ unsigned xb_xcc_id() { return (unsigned)__builtin_amdgcn_s_getreg((3 << 11) | 20) & 0xFu; }
#define XB_SPIN(cond, bar) do { unsigned _sp = 0; while (cond) { __builtin_amdgcn_s_sleep(1); \
    if ((++_sp & 255u) == 0u) { if (xb_ld(&(bar)[XB_TMO])) break; if (_sp > XB_SPIN_CAP) { atomicAdd(&(bar)[XB_TMO], 1u); break; } } } } while (0)
struct XcdBarrier { unsigned* bar; unsigned x; volatile LAS unsigned* st; };
__device__ __forceinline__ XcdBarrier xcd_barrier_post(unsigned* bar, volatile LAS unsigned* st) {
    XcdBarrier b; b.bar = bar; b.x = xb_xcc_id(); b.st = st;
    if (threadIdx.x == 0) (void)xb_add(&bar[XB_XCNT(b.x)], 1u);
    return b;
}
__device__ __forceinline__ void xcd_barrier_complete(unsigned* bar, unsigned x, unsigned& nloc, unsigned& nx) {
    const unsigned G = gridDim.x * gridDim.y * gridDim.z;
    unsigned sum, cnt, mine, sp = 0u;
    for (;;) {
        sum = 0u; cnt = 0u; mine = 0u;
#pragma unroll
        for (unsigned j = 0; j < 16; ++j) { const unsigned c = xb_ld(&bar[XB_XCNT(j)]); sum += c; cnt += (c > 0u) ? 1u : 0u; mine = (j == x) ? c : mine; }
        if (sum == G) break;
        __builtin_amdgcn_s_sleep(1);
        if ((++sp & 255u) == 0u) { if (xb_ld(&bar[XB_TMO])) break; if (sp > XB_SPIN_CAP) { atomicAdd(&bar[XB_TMO], 1u); break; } }
    }
    nloc = mine > 0u ? mine : 1u; nx = cnt > 0u ? cnt : 1u;
}
__device__ __forceinline__ void xcd_barrier(const XcdBarrier& b) {
    asm volatile("s_waitcnt vmcnt(0)" ::: "memory");
    __syncthreads();
    if (threadIdx.x == 0) {
        unsigned* bar = b.bar;
        __builtin_amdgcn_s_waitcnt(0);
        unsigned nloc = b.st[0], nx = b.st[1];
        if (nloc == 0u) { xcd_barrier_complete(bar, b.x, nloc, nx); b.st[0] = nloc; b.st[1] = nx; }
        const unsigned old = xb_add(&bar[XB_XSUB(b.x)], 1u);
        const unsigned gen = old / nloc;
        if (old + 1u == (gen + 1u) * nloc) {
            __builtin_amdgcn_fence(__ATOMIC_RELEASE, "agent");
            asm volatile("s_waitcnt vmcnt(0)" ::: "memory");
            const unsigned og = xb_add(&bar[XB_TOP], 1u);
            const unsigned tg = og / nx;
            if (og + 1u == (tg + 1u) * nx) xb_add(&bar[XB_TOPGEN], 1u);
            else XB_SPIN(xb_ld(&bar[XB_TOPGEN]) == tg, bar);
            __builtin_amdgcn_fence(__ATOMIC_ACQUIRE, "agent");
            xb_add(&bar[XB_XGEN(b.x)], 1u);
            asm volatile("s_waitcnt vmcnt(0)" ::: "memory");
        } else {
            XB_SPIN(xb_ld(&bar[XB_XGEN(b.x)]) == gen, bar);
            __builtin_amdgcn_fence(__ATOMIC_ACQUIRE, "agent");
            asm volatile("s_waitcnt vmcnt(0)" ::: "memory");
        }
    }
    __syncthreads();
}

struct Frame {
    LAS unsigned char* lds;
    volatile LAS unsigned* MISC;
    gu32* ctl;
    int tid, lane, wave;
    int vcu, G;
    float* out;
    unsigned char* ws;
};
struct Args { const float* in[37]; float* out; unsigned char* ws; int ph_lo, ph_hi, li, pad; };
__device__ __forceinline__ void refresh(Frame& F) { int t = threadIdx.x; asm volatile("" : "+v"(t)); F.tid = t; F.lane = t & 63; F.wave = __builtin_amdgcn_readfirstlane(t >> 6); }
__device__ __forceinline__ void cnt_arrive(Frame& F, int word) {
    VM_WAIT(); __syncthreads();
    if (F.tid == 0) { __builtin_amdgcn_fence(__ATOMIC_RELEASE, "agent"); VM_WAIT(); (void)__hip_atomic_fetch_add((unsigned*)(F.ctl + word), 1u, RLX_AGENT); }
}
__device__ __forceinline__ void cnt_arrive_wt(Frame& F, int word) {
    VM_WAIT(); __syncthreads();
    if (F.tid == 0) (void)__hip_atomic_fetch_add((unsigned*)(F.ctl + word), 1u, RLX_AGENT);
}
__device__ __forceinline__ void cnt_wait_ge(Frame& F, int word, unsigned target) {
    if (F.tid == 0) { unsigned sp = 0; while (__hip_atomic_load((unsigned*)(F.ctl + word), RLX_AGENT) < target && ++sp < (1u << 22)) __builtin_amdgcn_s_sleep(2);
        __builtin_amdgcn_fence(__ATOMIC_ACQUIRE, "agent"); VM_WAIT(); }
    __syncthreads();
}
__device__ __forceinline__ float wave_sum(float v) {
#pragma unroll
    for (int o = 1; o < 64; o <<= 1) v += __shfl_xor(v, o);
    return v;
}
enum { I_XP = 0, I_XS, I_SCONV, I_SH, I_SSR, I_SSI, I_CP, I_CS, I_ADAW, I_ADAB, I_INPROJ, I_CONVW, I_CONVB, I_RGWR, I_RGBR, I_RGWI, I_RGBI, I_RGLAM,
       I_S5ARE, I_S5AIM, I_S5LOGDT, I_S5BRE, I_S5BIM, I_S5CRE, I_S5CIM, I_S5D, I_GLUW, I_GLUB, I_OUTPROJ, I_LN1G, I_LN1B, I_W1, I_B1, I_W2, I_B2, I_LN2G, I_LN2B };

typedef float f32x2m __attribute__((ext_vector_type(2)));
typedef __bf16 bf16x2m __attribute__((ext_vector_type(2)));
__device__ __forceinline__ unsigned pkbf0(float a, float b) { const f32x2m v = {a, b}; const bf16x2m r = __builtin_convertvector(v, bf16x2m); return __builtin_bit_cast(unsigned, r); }
typedef short bf16x8m __attribute__((ext_vector_type(8)));
typedef float f32x16m __attribute__((ext_vector_type(16)));
__device__ __forceinline__ void p0_transpose_item(const float* W, int K, int N, bf16* WT, LAS float* scr, int item, int lane) {
    const int nblk = N / 32, kb = item / nblk, nb = item % nblk, k0 = 64 * kb, n0 = 32 * nb;
#pragma unroll 8
    for (int i = 0; i < 32; ++i) { const int kk = 2 * i + (lane >> 5); scr[kk * 33 + (lane & 31)] = W[(size_t)(k0 + kk) * N + n0 + (lane & 31)]; }
    LDS_WAIT(); asm volatile("" ::: "memory");
    const int c = lane & 7;
#pragma unroll
    for (int j = 0; j < 4; ++j) { const int n = (lane >> 3) + 8 * j; const LAS float* s = scr + (8 * c) * 33 + n;
        v4u o; o.x = pk2(s[0 * 33], s[1 * 33]); o.y = pk2(s[2 * 33], s[3 * 33]); o.z = pk2(s[4 * 33], s[5 * 33]); o.w = pk2(s[6 * 33], s[7 * 33]);
        *(GAS v4u*)(WT + (size_t)(n0 + n) * K + k0 + 8 * c) = o; }
    LDS_WAIT(); asm volatile("" ::: "memory");
}

constexpr int XI_IN = (D / 64) * (NZ / 32), XI_GL = (WB / 64) * (WB / 32), XI_OU = (D / 64) * (D / 32), XI_1 = (D / 64) * (FF / 32), XI_2 = (FF / 64) * (D / 32);
constexpr int XO_OU = XI_IN + XI_GL, XO_1 = XO_OU + XI_OU, XO_2 = XO_1 + XI_1, XO_END = XO_2 + XI_2;
__device__ __forceinline__ void xpose_item(Frame& F, const Args& A, LAS float* scr, int r) {
    if (r < XI_IN) { p0_transpose_item(A.in[I_INPROJ], D, NZ, (bf16*)(F.ws + WS_WIN), scr, r, F.lane); return; } r -= XI_IN;
    if (r < XI_GL) { p0_transpose_item(A.in[I_GLUW], WB, WB, (bf16*)(F.ws + WS_WGLU), scr, r, F.lane); return; } r -= XI_GL;
    if (r < XI_OU) { p0_transpose_item(A.in[I_OUTPROJ], D, D, (bf16*)(F.ws + WS_WOUT), scr, r, F.lane); return; } r -= XI_OU;
    if (r < XI_1) { p0_transpose_item(A.in[I_W1], D, FF, (bf16*)(F.ws + WS_W1), scr, r, F.lane); return; } r -= XI_1;
    p0_transpose_item(A.in[I_W2], FF, D, (bf16*)(F.ws + WS_W2), scr, r, F.lane);
}
__device__ __forceinline__ void xpose_range(Frame& F, const Args& A, int lo, int hi, int vlo) {
    refresh(F);
    if (F.vcu < vlo) return;
    LAS float* scr = (LAS float*)(F.lds + RING_OFF + F.wave * 16384);
    const int gw = F.wave * (F.G - vlo) + (F.vcu - vlo), ngw = (F.G - vlo) * NWAVES;
    for (int it = lo + gw; it < hi; it += ngw) xpose_item(F, A, scr, it);
}
__device__ __forceinline__ void xpose_range_b(Frame& F, const Args& A, int lo, int hi, int blo) {
    refresh(F);
    LAS float* scr = (LAS float*)(F.lds + RING_OFF + F.wave * 16384);
    const int gw = F.wave * (F.G - blo) + ((int)blockIdx.x - blo), ngw = (F.G - blo) * NWAVES;
    for (int it = lo + gw; it < hi; it += ngw) xpose_item(F, A, scr, it);
}
#ifndef PROBE_P0PART
#define PROBE_P0PART 7
#endif
__device__ __forceinline__ void p0_prologue(Frame& F, const Args& A, int rep = 0) {
    refresh(F);
    const int pmask = rep ? PROBE_P0PART : 7;
    LAS float* scr = (LAS float*)(F.lds + RING_OFF + F.wave * 16384);
    const int gw = F.wave * F.G + F.vcu, NGW = F.G * NWAVES;
    {
        bf16* ST = (bf16*)(F.ws + WS_TAB + TB_SILU);
        for (int ch = F.vcu * NWAVES * 64 + F.tid; ch < 160 * 1024 / 8; ch += F.G * NWAVES * 64) { const int row = ch >> 7, k = (ch & 127) * 8; v4u o = (v4u){0u, 0u, 0u, 0u};
            if (row < NROWMOD) { const float* cp = (row < NBP ? A.in[I_CP] + (size_t)row * D : A.in[I_CS] + (size_t)(row - NBP) * D) + k; const f32x4 c0 = *(const f32x4*)cp, c1 = *(const f32x4*)(cp + 4);
                o.x = pk2(c0[0] * sigmoidf_(c0[0]), c0[1] * sigmoidf_(c0[1])); o.y = pk2(c0[2] * sigmoidf_(c0[2]), c0[3] * sigmoidf_(c0[3]));
                o.z = pk2(c1[0] * sigmoidf_(c1[0]), c1[1] * sigmoidf_(c1[1])); o.w = pk2(c1[2] * sigmoidf_(c1[2]), c1[3] * sigmoidf_(c1[3])); }
            pg8::st16_wt(ST + (size_t)ch * 8, o); }
        cnt_arrive_wt(F, CW_SILU);
    }
    constexpr int I_IN = XI_IN, I_GL = XI_GL;
    constexpr int I_S5 = GB, I_RG = WA / 64, I_RGT = HA * 2 * 2 * 4, I_CB = NBS * 3 * WA / 512, I_DG = HA * 16, I_S5J = GB * 8;
    constexpr int NITEMS = I_IN + I_GL + I_S5 + I_RG + I_RGT + I_CB + I_DG + I_S5J;
    float* sc = (float*)(F.ws + WS_S5C);
    constexpr int VW0 = 2 * D / 32;
    for (int it = F.vcu >= VW0 ? F.wave * (F.G - VW0) + (F.vcu - VW0) : NITEMS; it < NITEMS; it += (F.G - VW0) * NWAVES) {
        int r = it;
        if (!(pmask & 1) && it < I_IN + I_GL) continue;
        if (!(pmask & 2) && it >= I_IN + I_GL) continue;
        if (r < I_IN + I_GL) { xpose_item(F, A, scr, r); continue; } r -= I_IN + I_GL;
        if (r < I_S5) {
            const int g = r, n = F.lane, gn = g * NS5 + n;
            const double dt = exp((double)A.in[I_S5LOGDT][g]), ar = (double)A.in[I_S5ARE][gn], ai = (double)A.in[I_S5AIM][gn];
            const double mag = exp(dt * ar), abr = mag * cos(dt * ai), abi = mag * sin(dt * ai), den = ar * ar + ai * ai, nr = abr - 1.0;
            const double qr = (nr * ar + abi * ai) / den, qi = (abi * ar - nr * ai) / den;
            sc[SC_ABR + gn] = (float)abr; sc[SC_ABI + gn] = (float)abi;
            unsigned char* tab = F.ws + WS_TAB;
            float* TA = (float*)(tab + TB_TA); float* ZP = (float*)(tab + TB_ZP); float* Z16N = (float*)(tab + TB_Z16N);
            const int sh = n >> 5, v = n & 31, hh = (v >> 2) & 1, ii = (v & 3) + 4 * (v >> 3);
            double bbr_[KS5], bbi_[KS5];
            for (int k = 0; k < KS5; ++k) { const double br = (double)A.in[I_S5BRE][gn * KS5 + k], bi = (double)A.in[I_S5BIM][gn * KS5 + k];
                bbr_[k] = qr * br - qi * bi; bbi_[k] = qr * bi + qi * br;
                sc[SC_BBR + gn * KS5 + k] = (float)bbr_[k]; sc[SC_BBI + gn * KS5 + k] = (float)bbi_[k]; }
            { double pr = abr, pi = abi; for (int e = 0; e < 2; ++e) { const double t = pr * pr - pi * pi; pi = 2.0 * pr * pi; pr = t; }
              TA[((g * 2 + hh) * 2 + 0) * 32 + sh * 16 + ii] = (float)pr; TA[((g * 2 + hh) * 2 + 1) * 32 + sh * 16 + ii] = (float)pi; }
            const double mg8 = exp(8.0 * dt * ar), z1r = mg8 * cos(8.0 * dt * ai), z1i = mg8 * sin(8.0 * dt * ai); double pzr = 1.0, pzi = 0.0;
            for (int e = 0; e <= 16; ++e) { const float zr = (float)pzr, zi = (float)pzi; { const double nr2 = pzr * z1r - pzi * z1i, ni2 = pzr * z1i + pzi * z1r; pzr = nr2; pzi = ni2; }
                ZP[(((g * 17 + e) * 2 + hh) * 2 + 0) * 32 + sh * 16 + ii] = zr; ZP[(((g * 17 + e) * 2 + hh) * 2 + 1) * 32 + sh * 16 + ii] = zi;
                if (e == 16) { Z16N[(g * 2 + 0) * 64 + n] = zr; Z16N[(g * 2 + 1) * 64 + n] = zi; } }
            continue; } r -= I_S5;
        if (r < I_RG) { const int c = r * 64 + F.lane; const double lam = (double)A.in[I_RGLAM][c];
          sc[SC_RGL + c] = (float)(-8.0 * log1p(exp(-lam)) * 1.4426950408889634); continue; } r -= I_RG;
        if (r >= I_RGT + I_CB + I_DG) { r -= I_RGT + I_CB + I_DG;
            const int g = r >> 3, j = r & 7, n = F.lane, gn = g * NS5 + n, sh = n >> 5;
            const double dt = exp((double)A.in[I_S5LOGDT][g]), ar = (double)A.in[I_S5ARE][gn], ai = (double)A.in[I_S5AIM][gn];
            const double mag = exp(dt * ar), abr = mag * cos(dt * ai), abi = mag * sin(dt * ai), den = ar * ar + ai * ai, nr0 = abr - 1.0;
            const double qr = (nr0 * ar + abi * ai) / den, qi = (abi * ar - nr0 * ai) / den;
            const double mgp = exp((double)(j + 1) * dt * ar), anp = (double)(j + 1) * dt * ai, pr = mgp * cos(anp), pi = mgp * sin(anp);
            const double pm2 = pr * pr + pi * pi, nr_ = pr / pm2, ni_ = -pi / pm2;
            bf16* W1T = (bf16*)(F.ws + WS_TAB + TB_W1); bf16* C2T = (bf16*)(F.ws + WS_TAB + TB_C2);
            const int s2 = (n >> 4) & 1, jj2 = 4 * ((n >> 3) & 1) + (n & 3), hk2 = (n >> 2) & 1;
#pragma unroll 4
            for (int k = 0; k < KS5; ++k) { const double br = (double)A.in[I_S5BRE][gn * KS5 + k], bi = (double)A.in[I_S5BIM][gn * KS5 + k];
                const double bbr = qr * br - qi * bi, bbi = qr * bi + qi * br;
                const float wr = (float)(nr_ * bbr - ni_ * bbi), wi = (float)(nr_ * bbi + ni_ * bbr);
                const int lp = (n & 31) + 32 * (k >> 3), jj = k & 7;
                W1T[(size_t)(((g * 8 + j) * 4 + 0 + sh) * 64 + lp) * 8 + jj] = (bf16)f2bf(wr); W1T[(size_t)(((g * 8 + j) * 4 + 2 + sh) * 64 + lp) * 8 + jj] = (bf16)f2bf(wi); }
#pragma unroll 4
            for (int ch = 0; ch < KS5; ++ch) { const int hr_ = ch >> 3, i8 = ch & 7, R = (i8 & 3) + 8 * (i8 >> 2) + 4 * hr_, lp = R + 32 * hk2;
                const double cr = (double)A.in[I_S5CRE][(size_t)(g * KS5 + ch) * NS5 + n], ci = (double)A.in[I_S5CIM][(size_t)(g * KS5 + ch) * NS5 + n];
                const float c2r = (float)(cr * pr - ci * pi), c2i = (float)(cr * pi + ci * pr);
                C2T[(size_t)(((g * 8 + j) * 8 + (0 + sh) * 2 + s2) * 64 + lp) * 8 + jj2] = (bf16)f2bf(c2r); C2T[(size_t)(((g * 8 + j) * 8 + (2 + sh) * 2 + s2) * 64 + lp) * 8 + jj2] = (bf16)f2bf(-c2i); }
            for (int z = 0; z < 4; ++z) { const int cidx = n + 64 * z, ks = cidx >> 5, r16 = cidx & 31, lp = 16 + (r16 & 15) + 32 * (r16 >> 4);
                *(v4u*)(C2T + (size_t)(((g * 8 + j) * 8 + ks) * 64 + lp) * 8) = (v4u){0u, 0u, 0u, 0u}; }
            continue; }
        if (r >= I_RGT + I_CB) { r -= I_RGT + I_CB;
            const int k = r & 3, sp = (r >> 2) & 1, tau = (r >> 3) & 1, hd = r >> 4, R = F.lane & 31, hk = F.lane >> 5;
            unsigned wv = 0u; if ((R >> 3) == 2 * sp + hk) wv = f2bf(A.in[I_CONVW][k * WA + hd * 64 + 32 * tau + R]);
            const int jj = R & 7; v4u o = (v4u){0u, 0u, 0u, 0u}; const unsigned word = (jj & 1) ? (wv << 16) : wv;
            if ((jj >> 1) == 0) o.x = word; else if ((jj >> 1) == 1) o.y = word; else if ((jj >> 1) == 2) o.z = word; else o.w = word;
            *(v4u*)(F.ws + WS_TAB + TB_DG + (size_t)(r * 64 + F.lane) * 16) = o; continue; }
        if (r >= I_RGT) { r -= I_RGT;
            const float* src = A.in[I_SCONV] + (size_t)r * 512 + F.lane * 8; const f32x4 a0 = *(const f32x4*)src, a1 = *(const f32x4*)(src + 4);
            v4u o; o.x = pk2(a0[0], a0[1]); o.y = pk2(a0[2], a0[3]); o.z = pk2(a1[0], a1[1]); o.w = pk2(a1[2], a1[3]);
            *(v4u*)(F.ws + WS_TAB + TB_CB + ((size_t)r * 512 + F.lane * 8) * 2) = o; continue; }
        {
            const int ks = r & 3, gate = (r >> 2) & 1, jh = (r >> 3) & 1, hd = r >> 4;
            const int R = F.lane & 31, hk = F.lane >> 5;
            const float* W = A.in[gate ? I_RGWI : I_RGWR] + (size_t)(hd * 64 + 32 * (ks >> 1) + 16 * (ks & 1) + 4 * hk) * 64 + 32 * jh + R;
            v4u o; o.x = pk2(W[0], W[64]); o.y = pk2(W[128], W[192]); o.z = pk2(W[8 * 64], W[9 * 64]); o.w = pk2(W[10 * 64], W[11 * 64]);
            *(v4u*)(F.ws + WS_TAB + TB_RG + (size_t)(r * 64 + F.lane) * 16) = o;
        }
    }
    __syncthreads();
    if (F.tid == 0) {
        unsigned sp = 0; while (__hip_atomic_load((unsigned*)(F.ctl + CW_SILU), RLX_AGENT) < (unsigned)F.G && ++sp < (1u << 22)) __builtin_amdgcn_s_sleep(2);
        __builtin_amdgcn_fence(__ATOMIC_ACQUIRE, "agent"); VM_WAIT(); }
    __syncthreads();
    LAS float* RED = (LAS float*)(F.lds + RING_OFF);
    float* mod = (float*)(F.ws + WS_MOD);
    const int r32 = F.lane & 31, hh = F.lane >> 5;
    const bf16* ST = (const bf16*)(F.ws + WS_TAB + TB_SILU);
#pragma unroll 1
    for (int it = F.vcu; it < ((pmask & 4) ? NMOD / 32 : 0); it += F.G) {
        const int n0 = it * 32;
        f32x16m acc[5];
#pragma unroll
        for (int rt = 0; rt < 5; ++rt)
#pragma unroll
            for (int i = 0; i < 16; ++i) acc[rt][i] = 0.f;
#pragma unroll 1
        for (int kb = 0; kb < 4; ++kb) {
            float bw[2][8]; v4u af[2][5];
#pragma unroll
            for (int ks = 0; ks < 2; ++ks) { const int k0 = F.wave * 128 + (kb * 2 + ks) * 16 + 8 * hh;
                const float* wp = A.in[I_ADAW] + (size_t)k0 * NMOD + n0 + r32;
#pragma unroll
                for (int j = 0; j < 8; ++j) bw[ks][j] = wp[(size_t)j * NMOD];
#pragma unroll
                for (int rt = 0; rt < 5; ++rt) af[ks][rt] = *(const v4u*)(ST + (size_t)(32 * rt + r32) * D + k0); }
#pragma unroll
            for (int ks = 0; ks < 2; ++ks) {
                v4u bp; bp.x = pkbf0(bw[ks][0], bw[ks][1]); bp.y = pkbf0(bw[ks][2], bw[ks][3]); bp.z = pkbf0(bw[ks][4], bw[ks][5]); bp.w = pkbf0(bw[ks][6], bw[ks][7]);
                const bf16x8m bfr = __builtin_bit_cast(bf16x8m, bp);
#pragma unroll
                for (int rt = 0; rt < 5; ++rt) acc[rt] = __builtin_amdgcn_mfma_f32_32x32x16_bf16(__builtin_bit_cast(bf16x8m, af[ks][rt]), bfr, acc[rt], 0, 0, 0); }
        }
#pragma unroll
        for (int half = 4; half >= 1; half >>= 1) {
            if (F.wave >= half && F.wave < 2 * half) {
#pragma unroll
                for (int rt = 0; rt < 5; ++rt)
#pragma unroll
                    for (int i = 0; i < 16; ++i) RED[(F.wave - half) * 5120 + (rt * 16 + i) * 64 + F.lane] = acc[rt][i]; }
            __syncthreads();
            if (F.wave < half) {
#pragma unroll
                for (int rt = 0; rt < 5; ++rt)
#pragma unroll
                    for (int i = 0; i < 16; ++i) acc[rt][i] += RED[F.wave * 5120 + (rt * 16 + i) * 64 + F.lane]; }
            __syncthreads();
        }
        if (F.wave == 0) { const float bb = A.in[I_ADAB][n0 + r32];
#pragma unroll
            for (int rt = 0; rt < 5; ++rt)
#pragma unroll
                for (int i = 0; i < 16; ++i) { const int row = 32 * rt + (i & 3) + 8 * (i >> 2) + 4 * hh; if (row < NROWMOD) __hip_atomic_store(mod + (size_t)row * NMOD + n0 + r32, acc[rt][i] + bb, RLX_AGENT); } }
        if (n0 < 2 * D) cnt_arrive_wt(F, CW_MOD);
    }
}

__device__ __forceinline__ int mod_row(int m) { return m < MP ? (m >> 11) : NBP + ((m - MP) >> 2); }
__device__ __forceinline__ const float* x_row(const Args& A, int m) { return m < MP ? A.in[I_XP] + (size_t)m * D : A.in[I_XS] + (size_t)(m - MP) * D; }

__device__ __forceinline__ void p1_modulate(Frame& F, const Args& A, int rep = 0) {
    refresh(F);
    cnt_wait_ge(F, CW_MOD, (unsigned)(2 * D / 32));
    const int gw = F.vcu * NWAVES + F.wave, NGW = F.G * NWAVES;
    const float* mod = (const float*)(F.ws + WS_MOD); bf16* XN = (bf16*)(F.ws + WS_XN);
    for (int m = gw; m < M; m += NGW) {
        const float* xr = x_row(A, m) + 8 * F.lane; const float* mr = mod + (size_t)mod_row(m) * NMOD + 8 * F.lane;
#pragma unroll
        for (int j = 0; j < 2; ++j) { const f32x4 v0 = *(const f32x4*)(xr + 512 * j), v1 = *(const f32x4*)(xr + 512 * j + 4);
            const f32x4 a0 = *(const f32x4*)(mr + 512 * j), a1 = *(const f32x4*)(mr + 512 * j + 4), s0 = *(const f32x4*)(mr + D + 512 * j), s1 = *(const f32x4*)(mr + D + 512 * j + 4);
            const f32x4 h0 = v0 * (s0 + 1.f) + a0, h1 = v1 * (s1 + 1.f) + a1;
            v4u o; o.x = pk2(h0.x, h0.y); o.y = pk2(h0.z, h0.w); o.z = pk2(h1.x, h1.y); o.w = pk2(h1.z, h1.w);
            *(v4u*)(XN + (size_t)m * D + 512 * j + 8 * F.lane) = o; }
    }
}

__device__ __forceinline__ void unpack8(const v4u w, f32x4& a, f32x4& b) { a = (f32x4){pg8::bf_lo(w.x), pg8::bf_hi(w.x), pg8::bf_lo(w.y), pg8::bf_hi(w.y)}; b = (f32x4){pg8::bf_lo(w.z), pg8::bf_hi(w.z), pg8::bf_lo(w.w), pg8::bf_hi(w.w)}; }
__device__ __forceinline__ v4u pack8f(const f32x4 a, const f32x4 b) { v4u o; o.x = pk2(a.x, a.y); o.y = pk2(a.z, a.w); o.z = pk2(b.x, b.y); o.w = pk2(b.z, b.w); return o; }
template <bool SECOND>
__device__ __forceinline__ void ln_rows(Frame& F, const Args& A, int row_lo, int row_hi, int gw, int NGW) {
    refresh(F);
    const float* mod = (const float*)(F.ws + WS_MOD); bf16* XN = (bf16*)(F.ws + WS_XN);
    const float* gg = A.in[SECOND ? I_LN2G : I_LN1G] + 8 * F.lane; const float* gb = A.in[SECOND ? I_LN2B : I_LN1B] + 8 * F.lane;
    for (int m = row_lo + gw; m < row_hi; m += NGW) {
        float* xr = F.out + (size_t)m * D + 8 * F.lane;
        f32x4 v[2][2]; float s = 0.f;
        if (m >= MP) {
            const float* mr = mod + (size_t)mod_row(m) * NMOD + (SECOND ? 5 : 2) * D + 8 * F.lane;
            const float* bs = SECOND ? xr : A.in[I_XS] + (size_t)(m - MP) * D + 8 * F.lane;
            const float* sl = (const float*)(F.ws + WS_SLAB) + (size_t)(m - MP) * D + 8 * F.lane;
#pragma unroll
            for (int j = 0; j < 2; ++j)
#pragma unroll
                for (int h = 0; h < 2; ++h) { const int o = 512 * j + 4 * h; f32x4 a = SECOND ? *(const f32x4*)(A.in[I_B2] + 8 * F.lane + o) : (f32x4){0.f, 0.f, 0.f, 0.f};
#pragma unroll
                    for (int ks = 0; ks < (SECOND ? NS_DOWN : NS_OUT); ++ks) a += *(const f32x4*)(sl + (size_t)ks * (512 * 1024) + o);
                    v[j][h] = *(const f32x4*)(bs + o) * ALPHA + *(const f32x4*)(mr + o) * a; }
        } else {
            const bf16* tr = (const bf16*)(F.ws + (SECOND ? WS_T2 : WS_T1)) + (size_t)m * D + 8 * F.lane;
#pragma unroll
            for (int j = 0; j < 2; ++j) unpack8(*(const v4u*)(tr + 512 * j), v[j][0], v[j][1]);
        }
#pragma unroll
        for (int j = 0; j < 2; ++j)
#pragma unroll
            for (int h = 0; h < 2; ++h) s += (v[j][h].x + v[j][h].y) + (v[j][h].z + v[j][h].w);
        const float mean = wave_sum(s) * (1.f / D); float s2 = 0.f;
#pragma unroll
        for (int j = 0; j < 2; ++j)
#pragma unroll
            for (int h = 0; h < 2; ++h) { v[j][h] = v[j][h] - mean; s2 += (v[j][h].x * v[j][h].x + v[j][h].y * v[j][h].y) + (v[j][h].z * v[j][h].z + v[j][h].w * v[j][h].w); }
        const float rstd = 1.f / sqrtf(wave_sum(s2) * (1.f / D) + LN_EPS);
#pragma unroll
        for (int j = 0; j < 2; ++j)
#pragma unroll
            for (int h = 0; h < 2; ++h) v[j][h] = v[j][h] * rstd * *(const f32x4*)(gg + 512 * j + 4 * h) + *(const f32x4*)(gb + 512 * j + 4 * h);
        if (SECOND || m >= MP) {
#pragma unroll
            for (int j = 0; j < 2; ++j) { *(f32x4*)(xr + 512 * j) = v[j][0]; *(f32x4*)(xr + 512 * j + 4) = v[j][1]; }
        } else {
            bf16* x1 = (bf16*)(F.ws + WS_X1B) + (size_t)m * D + 8 * F.lane;
#pragma unroll
            for (int j = 0; j < 2; ++j) *(v4u*)(x1 + 512 * j) = pack8f(v[j][0], v[j][1]);
        }
        if (!SECOND) {
            const float* mr = mod + (size_t)mod_row(m) * NMOD + 8 * F.lane;
#pragma unroll
            for (int j = 0; j < 2; ++j) { const int o = 512 * j;
                const f32x4 h0 = v[j][0] * (*(const f32x4*)(mr + 4 * D + o) + 1.f) + *(const f32x4*)(mr + 3 * D + o), h1 = v[j][1] * (*(const f32x4*)(mr + 4 * D + o + 4) + 1.f) + *(const f32x4*)(mr + 3 * D + o + 4);
                pg8::st16_wt(XN + (size_t)m * D + o + 8 * F.lane, pack8f(h0, h1)); }
        }
    }
}

__device__ __forceinline__ void rg_item_ref(Frame& F, const Args& A, bool prompt, int b, int hd, LAS float* scr) {
    const int j = F.lane, c = hd * HDA + j;
    const bf16* Z = (const bf16*)(F.ws + WS_Z); bf16* Y = (bf16*)(F.ws + WS_YCAT); const float* sc = (const float*)(F.ws + WS_S5C);
    float wr[64], wi[64];
#pragma unroll
    for (int i = 0; i < 64; ++i) { wr[i] = A.in[I_RGWR][(size_t)(hd * 64 + i) * 64 + j]; wi[i] = A.in[I_RGWI][(size_t)(hd * 64 + i) * 64 + j]; }
    const float br = A.in[I_RGBR][c], bi = A.in[I_RGBI][c], L2 = sc[SC_RGL + c];
    const float w0 = A.in[I_CONVW][c], w1 = A.in[I_CONVW][WA + c], w2 = A.in[I_CONVW][2 * WA + c], w3 = A.in[I_CONVW][3 * WA + c], cb = A.in[I_CONVB][c];
    int T, m0; float x3, x2, x1, h;
    if (prompt) { T = TP; m0 = b * TP; x3 = 0.f; x2 = 0.f; x1 = 0.f; h = 0.f; }
    else { T = TS; m0 = MP + b * TS; x3 = A.in[I_SCONV][(size_t)(b * 3 + 0) * WA + c]; x2 = A.in[I_SCONV][(size_t)(b * 3 + 1) * WA + c]; x1 = A.in[I_SCONV][(size_t)(b * 3 + 2) * WA + c]; h = A.in[I_SH][(size_t)b * WA + c]; }
    for (int t = 0; t < T; ++t) {
        const size_t m = (size_t)(m0 + t);
        const float xa = bf2f(Z[m * NZ + WA + c]), gate = bf2f(Z[m * NZ + c]);
        const float xc = cb + w0 * x3 + w1 * x2 + w2 * x1 + w3 * xa; x3 = x2; x2 = x1; x1 = xa;
        scr[j] = xc; LDS_WAIT(); asm volatile("" ::: "memory");
        float rp = br, gp = bi;
#pragma unroll
        for (int i4 = 0; i4 < 16; ++i4) { const f32x4 v = *(const LAS f32x4*)(scr + 4 * i4);
            rp += v[0] * wr[4 * i4] + v[1] * wr[4 * i4 + 1] + v[2] * wr[4 * i4 + 2] + v[3] * wr[4 * i4 + 3];
            gp += v[0] * wi[4 * i4] + v[1] * wi[4 * i4 + 1] + v[2] * wi[4 * i4 + 2] + v[3] * wi[4 * i4 + 3]; }
        LDS_WAIT(); asm volatile("" ::: "memory");
        const float r = sigmoidf_(rp), gi = sigmoidf_(gp);
        const float a = exp2f(r * L2);
        float mult = sqrtf(fmaxf(1.f - a * a, 0.f));
        if (prompt && t == 0) mult = 1.f;
        h = a * h + mult * gi * xc;
        Y[m * D + c] = (bf16)f2bf(gelu_tanh(gate) * h);
    }
    float* oc = F.out + (prompt ? O_CONVP : O_CONVS); float* oh = F.out + (prompt ? O_HP : O_HS);
    oc[(size_t)(b * 3 + 0) * WA + c] = x3; oc[(size_t)(b * 3 + 1) * WA + c] = x2; oc[(size_t)(b * 3 + 2) * WA + c] = x1;
    oh[(size_t)b * WA + c] = h;
}
__device__ __forceinline__ void s5_item_ref(Frame& F, const Args& A, bool prompt, int b, int g, LAS float* scr) {
    const int n = F.lane, gn = g * NS5 + n, k = F.lane & 15, part = F.lane >> 4;
    const bf16* Z = (const bf16*)(F.ws + WS_Z); bf16* Gy = (bf16*)(F.ws + WS_G); const float* sc = (const float*)(F.ws + WS_S5C);
    float bbr[16], bbi[16], cre[16], cim[16];
#pragma unroll
    for (int i = 0; i < 16; ++i) { bbr[i] = sc[SC_BBR + gn * KS5 + i]; bbi[i] = sc[SC_BBI + gn * KS5 + i];
        cre[i] = A.in[I_S5CRE][(size_t)(g * KS5 + k) * NS5 + part * 16 + i]; cim[i] = A.in[I_S5CIM][(size_t)(g * KS5 + k) * NS5 + part * 16 + i]; }
    const float abr = sc[SC_ABR + gn], abi = sc[SC_ABI + gn], dk = A.in[I_S5D][g * KS5 + k];
    int T, m0; float hr, hi;
    if (prompt) { T = TP; m0 = b * TP; hr = 0.f; hi = 0.f; }
    else { T = TS; m0 = MP + b * TS; hr = A.in[I_SSR][(size_t)(b * GB + g) * NS5 + n]; hi = A.in[I_SSI][(size_t)(b * GB + g) * NS5 + n]; }
    for (int t = 0; t < T; ++t) {
        const size_t m = (size_t)(m0 + t);
        const bf16* zr = Z + m * NZ + 2 * WA + g * KS5;
        const v4u u0 = *(const v4u*)zr, u1 = *(const v4u*)(zr + 8);
        float u[16];
        u[0] = pg8::bf_lo(u0.x); u[1] = pg8::bf_hi(u0.x); u[2] = pg8::bf_lo(u0.y); u[3] = pg8::bf_hi(u0.y); u[4] = pg8::bf_lo(u0.z); u[5] = pg8::bf_hi(u0.z); u[6] = pg8::bf_lo(u0.w); u[7] = pg8::bf_hi(u0.w);
        u[8] = pg8::bf_lo(u1.x); u[9] = pg8::bf_hi(u1.x); u[10] = pg8::bf_lo(u1.y); u[11] = pg8::bf_hi(u1.y); u[12] = pg8::bf_lo(u1.z); u[13] = pg8::bf_hi(u1.z); u[14] = pg8::bf_lo(u1.w); u[15] = pg8::bf_hi(u1.w);
        float bur = 0.f, bui = 0.f;
#pragma unroll
        for (int i = 0; i < 16; ++i) { bur += bbr[i] * u[i]; bui += bbi[i] * u[i]; }
        const float nhr = abr * hr - abi * hi + bur, nhi = abr * hi + abi * hr + bui; hr = nhr; hi = nhi;
        scr[n] = hr; scr[64 + n] = hi; LDS_WAIT(); asm volatile("" ::: "memory");
        float p = 0.f;
#pragma unroll
        for (int i4 = 0; i4 < 4; ++i4) { const f32x4 vr = *(const LAS f32x4*)(scr + part * 16 + 4 * i4), vi = *(const LAS f32x4*)(scr + 64 + part * 16 + 4 * i4);
#pragma unroll
            for (int e = 0; e < 4; ++e) p += vr[e] * cre[4 * i4 + e] - vi[e] * cim[4 * i4 + e]; }
        LDS_WAIT(); asm volatile("" ::: "memory");
        p += __shfl_xor(p, 16); p += __shfl_xor(p, 32);
        const float uk = bf2f(zr[k]);
        if (F.lane < 16) Gy[m * WB + g * KS5 + k] = (bf16)f2bf(gelu_tanh(p + dk * uk));
    }
    float* osr = F.out + (prompt ? O_SRP : O_SRS); float* osi = F.out + (prompt ? O_SIP : O_SIS);
    osr[(size_t)(b * GB + g) * NS5 + n] = hr; osi[(size_t)(b * GB + g) * NS5 + n] = hi;
}

typedef short bf16x8v __attribute__((ext_vector_type(8)));
typedef float f32x16 __attribute__((ext_vector_type(16)));
typedef float f32x2v __attribute__((ext_vector_type(2)));
typedef __bf16 bf16x2v __attribute__((ext_vector_type(2)));
#define MFMA32(a, b, c) __builtin_amdgcn_mfma_f32_32x32x16_bf16((a), (b), (c), 0, 0, 0)
__device__ __forceinline__ unsigned pkbf(float a, float b) { const f32x2v v = {a, b}; const bf16x2v r = __builtin_convertvector(v, bf16x2v); return __builtin_bit_cast(unsigned, r); }
template <int CTRL> __device__ __forceinline__ float dppf(float old, float v) { return __builtin_bit_cast(float, __builtin_amdgcn_update_dpp(__builtin_bit_cast(int, old), __builtin_bit_cast(int, v), CTRL, 0xF, 0xF, false)); }
__device__ __forceinline__ f32x16 ld16(const float* p) { f32x16 r;
#pragma unroll
    for (int i = 0; i < 4; ++i) { const f32x4 v = *(const f32x4*)(p + 4 * i); r[4 * i] = v[0]; r[4 * i + 1] = v[1]; r[4 * i + 2] = v[2]; r[4 * i + 3] = v[3]; }
    return r; }
__device__ __forceinline__ f32x16 ld16l(const LAS float* p) { f32x16 r;
#pragma unroll
    for (int i = 0; i < 4; ++i) { const f32x4 v = *(const LAS f32x4*)(p + 4 * i); r[4 * i] = v[0]; r[4 * i + 1] = v[1]; r[4 * i + 2] = v[2]; r[4 * i + 3] = v[3]; }
    return r; }
__device__ __forceinline__ bf16x8v pack8(const f32x16& x, int s) { v4u p; p.x = pkbf(x[8 * s], x[8 * s + 1]); p.y = pkbf(x[8 * s + 2], x[8 * s + 3]); p.z = pkbf(x[8 * s + 4], x[8 * s + 5]); p.w = pkbf(x[8 * s + 6], x[8 * s + 7]); return __builtin_bit_cast(bf16x8v, p); }
template <int CTRL> __device__ __forceinline__ void s5_scan_step(f32x16& xr, f32x16& xi, const f32x16& zr, const f32x16& zi) {
#pragma unroll
    for (int i = 0; i < 16; ++i) { const float sr = dppf<CTRL>(0.f, xr[i]), si = dppf<CTRL>(0.f, xi[i]);
        xr[i] += zr[i] * sr - zi[i] * si; xi[i] += zr[i] * si + zi[i] * sr; }
}
constexpr int S5L_W1 = 0, S5L_C2 = 32768, S5L_TOT = 98304, S5L_CAR = 106496, S5L_ZP = 114688, S5L_TA = 123392;
static_assert(S5L_TA + 512 <= RING_BYTES, "S5 LDS map");
template <bool SECOND>
__device__ __forceinline__ void s5_step(LAS unsigned char* L, int lane, int j, const bf16x8v u, f32x16& gr0, f32x16& gr1, f32x16& gi0, f32x16& gi1, const float (&dk)[8], bf16* gout) {
    const LAS bf16x8v* a1 = (const LAS bf16x8v*)(L + S5L_W1) + j * 256 + lane;
    gr0 = MFMA32(a1[0], u, gr0); gr1 = MFMA32(a1[64], u, gr1); gi0 = MFMA32(a1[128], u, gi0); gi1 = MFMA32(a1[192], u, gi1);
    if (SECOND) {
        const LAS bf16x8v* a2 = (const LAS bf16x8v*)(L + S5L_C2) + j * 512 + lane;
        f32x16 y;
#pragma unroll
        for (int i = 0; i < 16; ++i) y[i] = 0.f;
        y = MFMA32(a2[0 * 64], pack8(gr0, 0), y); y = MFMA32(a2[1 * 64], pack8(gr0, 1), y);
        y = MFMA32(a2[2 * 64], pack8(gr1, 0), y); y = MFMA32(a2[3 * 64], pack8(gr1, 1), y);
        y = MFMA32(a2[4 * 64], pack8(gi0, 0), y); y = MFMA32(a2[5 * 64], pack8(gi0, 1), y);
        y = MFMA32(a2[6 * 64], pack8(gi1, 0), y); y = MFMA32(a2[7 * 64], pack8(gi1, 1), y);
        const v4u uw = __builtin_bit_cast(v4u, u);
        float o[8];
        o[0] = gelu_tanh(y[0] + dk[0] * pg8::bf_lo(uw.x)); o[1] = gelu_tanh(y[1] + dk[1] * pg8::bf_hi(uw.x));
        o[2] = gelu_tanh(y[2] + dk[2] * pg8::bf_lo(uw.y)); o[3] = gelu_tanh(y[3] + dk[3] * pg8::bf_hi(uw.y));
        o[4] = gelu_tanh(y[4] + dk[4] * pg8::bf_lo(uw.z)); o[5] = gelu_tanh(y[5] + dk[5] * pg8::bf_hi(uw.z));
        o[6] = gelu_tanh(y[6] + dk[6] * pg8::bf_lo(uw.w)); o[7] = gelu_tanh(y[7] + dk[7] * pg8::bf_hi(uw.w));
        v4u w; w.x = pkbf(o[0], o[1]); w.y = pkbf(o[2], o[3]); w.z = pkbf(o[4], o[5]); w.w = pkbf(o[6], o[7]);
        pg8::st16_wt(gout, w);
    }
}
__device__ __forceinline__ void s5_cmul(const LAS float* p, f32x16& r0, f32x16& r1, f32x16& i0, f32x16& i1) {
    { const f32x16 zr = ld16l(p), zi = ld16l(p + 32); const f32x16 t = zr * r0 - zi * i0; i0 = zr * i0 + zi * r0; r0 = t; }
    asm volatile("" : "+v"(r0), "+v"(i0) :: "memory");
    { const f32x16 zr = ld16l(p + 16), zi = ld16l(p + 48); const f32x16 t = zr * r1 - zi * i1; i1 = zr * i1 + zi * r1; r1 = t; }
    asm volatile("" : "+v"(r1), "+v"(i1) :: "memory");
}
__device__ __forceinline__ void s5_stage_tables(Frame& F, LAS unsigned char* L, const unsigned char* tab, int g) {
    const v4u* s1 = (const v4u*)(tab + TB_W1) + (size_t)g * 2048; const v4u* s2 = (const v4u*)(tab + TB_C2) + (size_t)g * 4096;
#pragma unroll
    for (int k = 0; k < 4; ++k) ((LAS v4u*)(L + S5L_W1))[F.tid + 512 * k] = s1[F.tid + 512 * k];
#pragma unroll
    for (int k = 0; k < 8; ++k) ((LAS v4u*)(L + S5L_C2))[F.tid + 512 * k] = s2[F.tid + 512 * k];
    const v4u* s3 = (const v4u*)(tab + TB_ZP) + (size_t)g * (17 * 128 / 4); for (int e = F.tid; e < 17 * 128 / 4; e += NWAVES * 64) ((LAS v4u*)(L + S5L_ZP))[e] = s3[e];
    if (F.tid < 32) ((LAS v4u*)(L + S5L_TA))[F.tid] = ((const v4u*)(tab + TB_TA) + (size_t)g * 32)[F.tid];
}
__device__ __forceinline__ void s5_item_fast(Frame& F, const Args& A, int b, int g) {
    refresh(F);
    const int lane = F.lane, q = lane & 31, hh = lane >> 5, w = F.wave, c = w * 32 + q;
    LAS unsigned char* L = F.lds + RING_OFF;
    const unsigned char* tab = F.ws + WS_TAB;
    const size_t m0 = (size_t)b * TP + (size_t)8 * c;
    const bf16* zrow = (const bf16*)(F.ws + WS_Z) + m0 * NZ + 2 * WA + g * KS5 + 8 * hh;
    bf16* grow = (bf16*)(F.ws + WS_G) + m0 * WB + g * KS5 + 8 * hh;
    bf16x8v uu[8];
#pragma unroll
    for (int j = 0; j < 8; ++j) uu[j] = *(const bf16x8v*)(zrow + (size_t)j * NZ);
    s5_stage_tables(F, L, tab, g);
    __syncthreads();
    f32x16 hr0, hr1, hi0, hi1;
#pragma unroll
    for (int i = 0; i < 16; ++i) { hr0[i] = 0.f; hr1[i] = 0.f; hi0[i] = 0.f; hi1[i] = 0.f; }
    float dk[8];
#pragma unroll
    for (int i = 0; i < 8; ++i) dk[i] = A.in[I_S5D][g * KS5 + 8 * hh + i];
#pragma unroll
    for (int j = 0; j < 8; ++j) s5_step<false>(L, lane, j, uu[j], hr0, hr1, hi0, hi1, dk, nullptr);
    const LAS float* ZP = (const LAS float*)(L + S5L_ZP);
    s5_cmul(ZP + ((1 * 2 + hh) * 2) * 32, hr0, hr1, hi0, hi1);
#define S5_SCAN(E, CTRL) do { const LAS float* z = ZP + (((E) * 2 + hh) * 2) * 32; \
        { const f32x16 zr = ld16l(z), zi = ld16l(z + 32); s5_scan_step<CTRL>(hr0, hi0, zr, zi); } \
        asm volatile("" : "+v"(hr0), "+v"(hi0) :: "memory"); \
        { const f32x16 zr = ld16l(z + 16), zi = ld16l(z + 48); s5_scan_step<CTRL>(hr1, hi1, zr, zi); } \
        asm volatile("" : "+v"(hr1), "+v"(hi1) :: "memory"); } while (0)
    S5_SCAN(1, 0x111); S5_SCAN(2, 0x112); S5_SCAN(4, 0x114); S5_SCAN(8, 0x118);
#undef S5_SCAN
    const int seg = w * 2 + (q >> 4);
    LAS float* TOT = (LAS float*)(L + S5L_TOT); LAS float* CAR = (LAS float*)(L + S5L_CAR);
    if ((lane & 15) == 15) {
#pragma unroll
        for (int rho = 0; rho < 4; ++rho) {
            *(LAS f32x4*)(TOT + (seg * 2 + 0) * 64 + 0 + 8 * rho + 4 * hh) = (f32x4){hr0[4 * rho], hr0[4 * rho + 1], hr0[4 * rho + 2], hr0[4 * rho + 3]};
            *(LAS f32x4*)(TOT + (seg * 2 + 0) * 64 + 32 + 8 * rho + 4 * hh) = (f32x4){hr1[4 * rho], hr1[4 * rho + 1], hr1[4 * rho + 2], hr1[4 * rho + 3]};
            *(LAS f32x4*)(TOT + (seg * 2 + 1) * 64 + 0 + 8 * rho + 4 * hh) = (f32x4){hi0[4 * rho], hi0[4 * rho + 1], hi0[4 * rho + 2], hi0[4 * rho + 3]};
            *(LAS f32x4*)(TOT + (seg * 2 + 1) * 64 + 32 + 8 * rho + 4 * hh) = (f32x4){hi1[4 * rho], hi1[4 * rho + 1], hi1[4 * rho + 2], hi1[4 * rho + 3]}; }
    }
    __syncthreads();
    if (F.tid < 64) {
        const float* z16 = (const float*)(tab + TB_Z16N) + (size_t)g * 128; const float zr = z16[F.tid], zi = z16[64 + F.tid];
        float cr = 0.f, ci = 0.f;
#pragma unroll
        for (int sg = 0; sg < 16; ++sg) { CAR[(sg * 2 + 0) * 64 + F.tid] = cr; CAR[(sg * 2 + 1) * 64 + F.tid] = ci;
            const float tr = TOT[(sg * 2 + 0) * 64 + F.tid], ti = TOT[(sg * 2 + 1) * 64 + F.tid];
            const float ncr = zr * cr - zi * ci + tr, nci = zr * ci + zi * cr + ti; cr = ncr; ci = nci; }
    }
    __syncthreads();
    {
        const LAS float* z = ZP + (((q & 15) * 2 + hh) * 2) * 32;
#define S5_EXCL(HR, HI, OFF) do { const f32x16 zr = ld16l(z + (OFF)), zi = ld16l(z + 32 + (OFF)); f32x16 kr, ki; \
        _Pragma("unroll") for (int rho = 0; rho < 4; ++rho) { \
            const f32x4 a0 = *(const LAS f32x4*)(CAR + (seg * 2 + 0) * 64 + 2 * (OFF) + 8 * rho + 4 * hh), b0 = *(const LAS f32x4*)(CAR + (seg * 2 + 1) * 64 + 2 * (OFF) + 8 * rho + 4 * hh); \
            _Pragma("unroll") for (int e = 0; e < 4; ++e) { kr[4 * rho + e] = a0[e]; ki[4 * rho + e] = b0[e]; } } \
        _Pragma("unroll") for (int i = 0; i < 16; ++i) { const float sr = dppf<0x111>(0.f, HR[i]), si = dppf<0x111>(0.f, HI[i]); \
            HR[i] = sr + zr[i] * kr[i] - zi[i] * ki[i]; HI[i] = si + zr[i] * ki[i] + zi[i] * kr[i]; } } while (0)
        S5_EXCL(hr0, hi0, 0); asm volatile("" : "+v"(hr0), "+v"(hi0) :: "memory"); S5_EXCL(hr1, hi1, 16); asm volatile("" : "+v"(hr1), "+v"(hi1) :: "memory");
#undef S5_EXCL
    }
#pragma unroll
    for (int j = 0; j < 8; ++j) s5_step<true>(L, lane, j, uu[j], hr0, hr1, hi0, hi1, dk, grow + (size_t)j * WB);
    if (w == NWAVES - 1 && q == 31) {
        s5_cmul(ZP + ((1 * 2 + hh) * 2) * 32, hr0, hr1, hi0, hi1);
        float* osr = F.out + O_SRP + (size_t)(b * GB + g) * NS5; float* osi = F.out + O_SIP + (size_t)(b * GB + g) * NS5;
#pragma unroll
        for (int i = 0; i < 16; ++i) { const int n = (i & 3) + 8 * (i >> 2) + 4 * hh; osr[n] = hr0[i]; osr[32 + n] = hr1[i]; osi[n] = hi0[i]; osi[32 + n] = hi1[i]; }
    }
    __syncthreads();
}

__device__ __forceinline__ void s5_item_sample(Frame& F, const Args& A, int g) {
    refresh(F);
    const int lane = F.lane, q = lane & 31, hh = lane >> 5, w = F.wave;
    LAS unsigned char* L = F.lds + RING_OFF;
    const unsigned char* tab = F.ws + WS_TAB;
    s5_stage_tables(F, L, tab, g);
    __syncthreads();
    if (w < 4) {
        const int b = w * 32 + q;
        f32x16 hr0, hr1, hi0, hi1;
        const float* sr = A.in[I_SSR] + (size_t)(b * GB + g) * NS5; const float* si = A.in[I_SSI] + (size_t)(b * GB + g) * NS5;
#pragma unroll
        for (int rho = 0; rho < 4; ++rho) { const f32x4 a0 = *(const f32x4*)(sr + 8 * rho + 4 * hh), a1 = *(const f32x4*)(sr + 32 + 8 * rho + 4 * hh), b0 = *(const f32x4*)(si + 8 * rho + 4 * hh), b1 = *(const f32x4*)(si + 32 + 8 * rho + 4 * hh);
#pragma unroll
            for (int e = 0; e < 4; ++e) { hr0[4 * rho + e] = a0[e]; hr1[4 * rho + e] = a1[e]; hi0[4 * rho + e] = b0[e]; hi1[4 * rho + e] = b1[e]; } }
        float dk[8];
#pragma unroll
        for (int i = 0; i < 8; ++i) dk[i] = A.in[I_S5D][g * KS5 + 8 * hh + i];
        const size_t m0 = (size_t)b * TS;
        const bf16* zrow = (const bf16*)(F.ws + WS_ZS) + m0 * NZ + 2 * WA + g * KS5 + 8 * hh;
        bf16* grow = (bf16*)(F.ws + WS_GS) + m0 * WB + g * KS5 + 8 * hh;
        bf16x8v uu[TS];
#pragma unroll
        for (int j = 0; j < TS; ++j) uu[j] = *(const bf16x8v*)(zrow + (size_t)j * NZ);
#pragma unroll
        for (int j = 0; j < TS; ++j) s5_step<true>(L, lane, j, uu[j], hr0, hr1, hi0, hi1, dk, grow + (size_t)j * WB);
        s5_cmul((const LAS float*)(L + S5L_TA) + hh * 64, hr0, hr1, hi0, hi1);
        float* osr = F.out + O_SRS + (size_t)(b * GB + g) * NS5; float* osi = F.out + O_SIS + (size_t)(b * GB + g) * NS5;
#pragma unroll
        for (int rho = 0; rho < 4; ++rho) {
            *(f32x4*)(osr + 8 * rho + 4 * hh) = (f32x4){hr0[4 * rho], hr0[4 * rho + 1], hr0[4 * rho + 2], hr0[4 * rho + 3]};
            *(f32x4*)(osr + 32 + 8 * rho + 4 * hh) = (f32x4){hr1[4 * rho], hr1[4 * rho + 1], hr1[4 * rho + 2], hr1[4 * rho + 3]};
            *(f32x4*)(osi + 8 * rho + 4 * hh) = (f32x4){hi0[4 * rho], hi0[4 * rho + 1], hi0[4 * rho + 2], hi0[4 * rho + 3]};
            *(f32x4*)(osi + 32 + 8 * rho + 4 * hh) = (f32x4){hi1[4 * rho], hi1[4 * rho + 1], hi1[4 * rho + 2], hi1[4 * rho + 3]}; }
    }
    __syncthreads();
}

template <int CTRL, int RMASK> __device__ __forceinline__ float dppm(float old, float v) { return __builtin_bit_cast(float, __builtin_amdgcn_update_dpp(__builtin_bit_cast(int, old), __builtin_bit_cast(int, v), CTRL, RMASK, 0xF, false)); }
template <int CTRL, int RMASK> __device__ __forceinline__ void rg_scan_step(f32x16& a, f32x16& b) {
#pragma unroll
    for (int i = 0; i < 16; ++i) { const float as = dppm<CTRL, RMASK>(1.f, a[i]), bs = dppm<CTRL, RMASK>(0.f, b[i]); b[i] = a[i] * bs + b[i]; a[i] = a[i] * as; }
}
constexpr int RGL_AFR = 0, RGL_DG = 8192, RGL_TOT = 24576, RGL_CST = 28672;
constexpr int RGL_XAP = 144;
constexpr int RGL_XA0 = 29696, RGL_BUF = 37376;
static_assert(259 * RGL_XAP <= RGL_BUF && RGL_XA0 + 2 * RGL_BUF <= RING_BYTES && RGL_CST + 640 <= RGL_XA0, "RG-LRU LDS map");
template <bool SAMPLE>
__device__ __forceinline__ void rg_item_fast(Frame& F, const Args& A, int b, int hd, int jh) {
    refresh(F);
    const int lane = F.lane, q = lane & 31, hh = lane >> 5, w = F.wave;
    LAS unsigned char* L = F.lds + RING_OFF;
    const float* sc = (const float*)(F.ws + WS_S5C);
    const bf16* Zb = SAMPLE ? (const bf16*)(F.ws + WS_ZS) : (const bf16*)(F.ws + WS_Z) + (size_t)(b * TP) * NZ; bf16* Yb = SAMPLE ? (bf16*)(F.ws + WS_YCS) : (bf16*)(F.ws + WS_YCAT) + (size_t)(b * TP) * D;
    const bf16* CB = (const bf16*)(F.ws + WS_TAB + TB_CB);
    auto stage_load = [&](int T0, v4u (&st)[5]) {
#pragma unroll
        for (int k = 0; k < 5; ++k) { const int ci = F.tid + 512 * k; v4u v = (v4u){0u, 0u, 0u, 0u};
            if (ci < 2072) { const int tk = T0 - 3 + (ci >> 3); if (tk >= 0) v = *(const v4u*)(Zb + (size_t)tk * NZ + WA + hd * 64 + (ci & 7) * 8); }
            st[k] = v; } };
    auto stage_write = [&](int par, const v4u (&st)[5]) {
#pragma unroll
        for (int k = 0; k < 5; ++k) { const int ci = F.tid + 512 * k;
            if (ci < 2072) *(LAS v4u*)(L + RGL_XA0 + par * RGL_BUF + (ci >> 3) * RGL_XAP + (ci & 7) * 16) = st[k]; } };
    {
        const v4u* src = (const v4u*)(F.ws + WS_TAB + TB_RG) + (size_t)((hd * 2 + jh) * 8) * 64;
        ((LAS v4u*)(L + RGL_AFR))[F.tid] = src[F.tid];
        const v4u* sd = (const v4u*)(F.ws + WS_TAB + TB_DG) + (size_t)(hd * 16) * 64;
        ((LAS v4u*)(L + RGL_DG))[F.tid] = sd[F.tid]; ((LAS v4u*)(L + RGL_DG))[512 + F.tid] = sd[512 + F.tid];
        if (F.tid < 160) { const int h2 = F.tid / 80, kind = (F.tid % 80) / 16, i = F.tid % 16, cr = (i & 3) + 8 * (i >> 2) + 4 * h2;
            const int c = hd * 64 + 32 * jh + cr;
            ((LAS float*)(L + RGL_CST))[F.tid] = kind == 0 ? A.in[I_RGBR][c] : kind == 1 ? A.in[I_RGBI][c] : kind == 2 ? sc[SC_RGL + c] : A.in[I_CONVB][hd * 64 + 32 * (kind - 3) + cr]; }
        if (!SAMPLE && jh == 0 && F.tid < 192) { const int k = F.tid >> 6, ch = F.tid & 63;
            F.out[O_CONVP + (size_t)(b * 3 + k) * WA + hd * 64 + ch] = bf2f(((const bf16*)(F.ws + WS_Z))[(size_t)(b * TP + TP - 3 + k) * NZ + WA + hd * 64 + ch]); }
        if (SAMPLE && jh == 0) { for (int e = F.tid; e < NBS * 3 * 64; e += NWAVES * 64) { const int bb = e / 192, k = (e / 64) % 3, ch = e & 63;
            F.out[O_CONVS + (size_t)(bb * 3 + k) * WA + hd * 64 + ch] = bf2f(((const bf16*)(F.ws + WS_ZS))[(size_t)(bb * TS + 1 + k) * NZ + WA + hd * 64 + ch]); } }
        if (!SAMPLE) { v4u st[5]; stage_load(0, st); stage_write(0, st); }
    }
    __syncthreads();
    float hround[16];
#pragma unroll
    for (int i = 0; i < 16; ++i) hround[i] = 0.f;
    const LAS float* CST = (const LAS float*)(L + RGL_CST) + hh * 80;
    const LAS bf16x8v* af = (const LAS bf16x8v*)(L + RGL_AFR) + lane;
    const LAS bf16x8v* dg = (const LAS bf16x8v*)(L + RGL_DG) + lane;
#pragma unroll 1
    for (int rd = 0; rd < (SAMPLE ? 2 : 8); ++rd) {
        const int t = rd * 256 + w * 32 + q;
        v4u stn[5];
        if (!SAMPLE) stage_load((rd + 1) * 256, stn);
        const LAS unsigned char* XAp = L + RGL_XA0 + (rd & 1) * RGL_BUF + (w * 32 + q) * RGL_XAP + 16 * hh;
        const bf16* zsr[4];
        if (SAMPLE) {
#pragma unroll
            for (int k = 0; k < 4; ++k) { const int jx = (t & 3) + k; zsr[k] = (jx < 3 ? CB + (size_t)((t >> 2) * 3 + jx) * WA : Zb + (size_t)(t - 3 + k) * NZ + WA) + hd * 64 + 8 * hh; } }
        const bf16* gr = Zb + (size_t)t * NZ + hd * 64 + 32 * jh + 4 * hh;
        unsigned long long gq[4];
#pragma unroll
        for (int rho = 0; rho < 4; ++rho) gq[rho] = *(const unsigned long long*)(gr + 8 * rho);
        f32x16 dx0, dx1;
        { const f32x4 c0 = *(const LAS f32x4*)(CST + 48), c1 = *(const LAS f32x4*)(CST + 52), c2 = *(const LAS f32x4*)(CST + 56), c3 = *(const LAS f32x4*)(CST + 60);
          const f32x4 e0 = *(const LAS f32x4*)(CST + 64), e1 = *(const LAS f32x4*)(CST + 68), e2 = *(const LAS f32x4*)(CST + 72), e3 = *(const LAS f32x4*)(CST + 76);
#pragma unroll
          for (int e = 0; e < 4; ++e) { dx0[e] = c0[e]; dx0[4 + e] = c1[e]; dx0[8 + e] = c2[e]; dx0[12 + e] = c3[e]; dx1[e] = e0[e]; dx1[4 + e] = e1[e]; dx1[8 + e] = e2[e]; dx1[12 + e] = e3[e]; } }
#pragma unroll
        for (int k = 0; k < 4; ++k)
#pragma unroll
            for (int s4 = 0; s4 < 4; ++s4) {
                const bf16x8v xb = SAMPLE ? *(const bf16x8v*)(zsr[k] + 16 * s4) : *(const LAS bf16x8v*)(XAp + k * RGL_XAP + s4 * 32);
                if (s4 < 2) dx0 = MFMA32(dg[((0 * 2 + (s4 & 1)) * 4 + k) * 64], xb, dx0); else dx1 = MFMA32(dg[((1 * 2 + (s4 & 1)) * 4 + k) * 64], xb, dx1);
                if (s4 == 3) asm volatile("" : "+v"(dx0), "+v"(dx1) :: "memory"); }
        f32x16 dr, di;
#pragma unroll
        for (int i = 0; i < 16; ++i) { dr[i] = 0.f; di[i] = 0.f; }
        { const bf16x8v b00 = pack8(dx0, 0), b01 = pack8(dx0, 1), b10 = pack8(dx1, 0), b11 = pack8(dx1, 1);
          dr = MFMA32(af[0 * 64], b00, dr); di = MFMA32(af[4 * 64], b00, di); dr = MFMA32(af[1 * 64], b01, dr); di = MFMA32(af[5 * 64], b01, di);
          dr = MFMA32(af[2 * 64], b10, dr); di = MFMA32(af[6 * 64], b10, di); dr = MFMA32(af[3 * 64], b11, dr); di = MFMA32(af[7 * 64], b11, di); }
        f32x16 av, bv;
        const bool first = !SAMPLE && (t == 0);
#pragma unroll
        for (int i = 0; i < 16; ++i) { const float xcv = jh ? dx1[i] : dx0[i];
            const float r = sigmoidf_(dr[i] + CST[i]), gi = sigmoidf_(di[i] + CST[16 + i]);
            const float a = __builtin_amdgcn_exp2f(r * CST[32 + i]);
            float mult = __builtin_amdgcn_sqrtf(fmaxf(1.f - a * a, 0.f)); if (first) mult = 1.f;
            av[i] = a; bv[i] = mult * gi * xcv; }
        if (SAMPLE && (t & 3) == 0) {
            const float* h0 = A.in[I_SH] + (size_t)(t >> 2) * WA + hd * 64 + 32 * jh + 4 * hh;
#pragma unroll
            for (int i = 0; i < 16; ++i) { bv[i] += av[i] * h0[(i & 3) + 8 * (i >> 2)]; av[i] = 0.f; } }
        rg_scan_step<0x111, 0xF>(av, bv); rg_scan_step<0x112, 0xF>(av, bv); rg_scan_step<0x114, 0xF>(av, bv); rg_scan_step<0x118, 0xF>(av, bv);
        rg_scan_step<0x142, 0xA>(av, bv);
        float hin[16];
#pragma unroll
        for (int i = 0; i < 16; ++i) hin[i] = 0.f;
        if (!SAMPLE) {
        LAS float* TOT = (LAS float*)(L + RGL_TOT) + (rd & 1) * 512;
        if (q == 31) {
#pragma unroll
            for (int i4 = 0; i4 < 4; ++i4) { *(LAS f32x4*)(TOT + (w * 2 + 0) * 32 + hh * 16 + 4 * i4) = (f32x4){av[4 * i4], av[4 * i4 + 1], av[4 * i4 + 2], av[4 * i4 + 3]};
                                             *(LAS f32x4*)(TOT + (w * 2 + 1) * 32 + hh * 16 + 4 * i4) = (f32x4){bv[4 * i4], bv[4 * i4 + 1], bv[4 * i4 + 2], bv[4 * i4 + 3]}; }
        }
        stage_write((rd + 1) & 1, stn);
        __syncthreads();
#pragma unroll
        for (int w2 = 0; w2 < 8; ++w2) {
            if (w2 == w) {
#pragma unroll
                for (int i = 0; i < 16; ++i) hin[i] = hround[i]; }
#pragma unroll
            for (int i4 = 0; i4 < 4; ++i4) { const f32x4 p = *(const LAS f32x4*)(TOT + (w2 * 2 + 0) * 32 + hh * 16 + 4 * i4), hl = *(const LAS f32x4*)(TOT + (w2 * 2 + 1) * 32 + hh * 16 + 4 * i4);
#pragma unroll
                for (int e = 0; e < 4; ++e) hround[4 * i4 + e] = p[e] * hround[4 * i4 + e] + hl[e]; }
        }
        }
        bf16* yr = Yb + (size_t)t * D + hd * 64 + 32 * jh + 4 * hh;
#pragma unroll
        for (int rho = 0; rho < 4; ++rho) { const unsigned glo = (unsigned)gq[rho], ghi = (unsigned)(gq[rho] >> 32);
            const float o0 = gelu_tanh(pg8::bf_lo(glo)) * (bv[4 * rho] + av[4 * rho] * hin[4 * rho]), o1 = gelu_tanh(pg8::bf_hi(glo)) * (bv[4 * rho + 1] + av[4 * rho + 1] * hin[4 * rho + 1]);
            const float o2 = gelu_tanh(pg8::bf_lo(ghi)) * (bv[4 * rho + 2] + av[4 * rho + 2] * hin[4 * rho + 2]), o3 = gelu_tanh(pg8::bf_hi(ghi)) * (bv[4 * rho + 3] + av[4 * rho + 3] * hin[4 * rho + 3]);
            const unsigned long long yv = (unsigned long long)pkbf(o0, o1) | ((unsigned long long)pkbf(o2, o3) << 32);
            if (SAMPLE) pg8::st8_wt(yr + 8 * rho, yv); else *(unsigned long long*)(yr + 8 * rho) = yv; }
        if (SAMPLE && (t & 3) == 3) {
#pragma unroll
            for (int i = 0; i < 16; ++i) F.out[O_HS + (size_t)(t >> 2) * WA + hd * 64 + 32 * jh + (i & 3) + 8 * (i >> 2) + 4 * hh] = bv[i]; }
    }
    if (!SAMPLE && w == 0 && q == 0) {
#pragma unroll
        for (int i = 0; i < 16; ++i) F.out[O_HP + (size_t)b * WA + hd * 64 + 32 * jh + (i & 3) + 8 * (i >> 2) + 4 * hh] = hround[i];
    }
    __syncthreads();
}

#ifndef PROBE_P3PART
#define PROBE_P3PART 7
#endif
__device__ __forceinline__ void p3_mixers_ref(Frame& F, const Args& A, int rep = 0) {
    constexpr int N_RGP = NBP * HA, N_S5P = NBP * GB;
    const int pm = rep ? PROBE_P3PART : 7;
    bf16* GY = (bf16*)(F.ws + WS_G); bf16* YC = (bf16*)(F.ws + WS_YCAT);
    pg8::Gemm gg{GY, (const bf16*)(F.ws + WS_WGLU), M, WB, WB}; pg8::EpiGlu<false> EG{GY, WB, YC, D, WA, A.in[I_GLUB]};
    pg8::OneUnit SG; SG.u0.pm = 0; SG.u0.pn = 0; SG.u0.k0 = 0; SG.u0.nkt = WB / 64; SG.u0.ks = 0;
    if (F.vcu < 2 * N_RGP) {
        if (pm & 1) rg_item_fast<false>(F, A, F.vcu / (2 * HA), (F.vcu / 2) % HA, F.vcu & 1);
    } else {
        const int v = F.vcu - 2 * N_RGP, it = 2 * v, bb = it / GB;
        if (pm & 2) { s5_item_fast(F, A, bb, it % GB);
                      s5_item_fast(F, A, bb, (it + 1) % GB);
                      cnt_arrive_wt(F, CW_S5B + 64 * bb); }
        if ((pm & 4) && v < GB) s5_item_sample(F, A, v);
        if (pm & 2) { cnt_wait_ge(F, CW_S5B + 64 * bb, 16u);
                      const int u = v & 15; SG.u0.pm = 8 * bb + (u >> 1); SG.u0.pn = u & 1;
                      pg8::gemm_phase<pg8::EpiGlu<false>, pg8::OneUnit, false, PG8_SP2>(F.lds + RING_OFF, gg, SG, EG); }
    }
}
__device__ __forceinline__ void p5_tail_items(Frame& F, const Args& A) {
    const int bx = (int)blockIdx.x;
    if (bx >= GB && bx < GB + 2 * HA) { rg_item_fast<true>(F, A, 0, (bx - GB) >> 1, (bx - GB) & 1); cnt_arrive_wt(F, CW_YCS); }
    else if (bx >= GB + 2 * HA && bx < GB + 2 * HA + 4) {
        bf16* GY = (bf16*)(F.ws + WS_GS) - (size_t)MP * WB; bf16* YC = (bf16*)(F.ws + WS_YCS) - (size_t)MP * D;
        pg8::Gemm gg{GY, (const bf16*)(F.ws + WS_WGLU), M, WB, WB}; pg8::EpiGlu<true> EG{GY, WB, YC, D, WA, A.in[I_GLUB]};
        const int u = bx - GB - 2 * HA; pg8::OneUnit SG; SG.u0.pm = MP / 256 + (u >> 1); SG.u0.pn = u & 1; SG.u0.k0 = 0; SG.u0.nkt = WB / 64; SG.u0.ks = 0;
        pg8::gemm_phase<pg8::EpiGlu<true>, pg8::OneUnit, false, PG8_SP2>(F.lds + RING_OFF, gg, SG, EG); cnt_arrive_wt(F, CW_YCS); }
    else if (bx >= 64 && bx < 224) { refresh(F); LAS float* scr = (LAS float*)(F.lds + RING_OFF + F.wave * 16384);
        for (int it = XO_2 + F.wave * 160 + (bx - 64); it < XO_END; it += 160 * NWAVES) xpose_item(F, A, scr, it); }
    __syncthreads();
}

template <bool SECOND>
__device__ __forceinline__ void ln_phase(Frame& F, const Args& A, int rep) {
    pg8::StaticOrder P; P.init(MP, D, F.G, (int)blockIdx.x, D); pg8::Unit u; P.next(0, u);
    cnt_wait_ge(F, (SECOND ? CW_T2 : CW_T1) + 64 * u.pm, 4u);
    ln_rows<SECOND>(F, A, u.pm * 256 + u.pn * 64, u.pm * 256 + u.pn * 64 + 64, F.wave, NWAVES);
    constexpr int NPC = 2 * (D / 256) * (SECOND ? NS_DOWN : NS_OUT);
    const int si = (int)blockIdx.x - (F.G - NPC);
    if (si >= 0) { cnt_wait_ge(F, SECOND ? CW_T2S : CW_T1S, (unsigned)NPC);
        ln_rows<SECOND>(F, A, MP + si * (MS / NPC), MP + (si + 1) * (MS / NPC), F.wave, NWAVES); }
}
__global__ void __launch_bounds__(NWAVES * 64, 2) fwd(Args A) {
    extern __shared__ __attribute__((aligned(16))) unsigned char lds[];
    Frame F;
    F.lds = (LAS unsigned char*)lds;
    F.MISC = (volatile LAS unsigned*)(F.lds + MISC_OFF);
    F.tid = threadIdx.x; F.lane = F.tid & 63; F.wave = __builtin_amdgcn_readfirstlane(F.tid >> 6);
    F.G = gridDim.x; { const int bx = blockIdx.x; F.vcu = (F.G % 8 == 0) ? (bx % 8) * (F.G / 8) + bx / 8 : bx; }
    F.out = A.out; F.ws = A.ws; F.ctl = (gu32*)(A.ws + WS_CTL);
    for (int u = F.tid; u < (LDS_BYTES - LDSCTL_OFF) / 4; u += NWAVES * 64) ((LAS unsigned*)(F.lds + LDSCTL_OFF))[u] = 0u;
    __syncthreads();
    XcdBarrier bar; bar.bar = (unsigned*)(F.ctl + CW_BAR); bar.x = 0; bar.st = nullptr;
    if (N_LAUNCHES == 1) bar = xcd_barrier_post((unsigned*)(F.ctl + CW_BAR), F.MISC + 8);
#define GRID_BAR() do { if (N_LAUNCHES == 1) xcd_barrier(bar); } while (0)
    const int lo = A.ph_lo, hi = A.ph_hi;
#define IN(k) (lo <= (k) && (k) < hi)
#define BOTH(k) (IN(k) && IN((k) + 1))
    bf16* XN = (bf16*)(F.ws + WS_XN); bf16* Z = (bf16*)(F.ws + WS_Z); bf16* YC = (bf16*)(F.ws + WS_YCAT); bf16* GY = (bf16*)(F.ws + WS_G); bf16* U = (bf16*)(F.ws + WS_U);
    const float* mod = (const float*)(F.ws + WS_MOD);

#define REPS(k) (((PROBE_DUP) >> (k)) & 1 ? 2 : 1)
#define PH0(rep) p0_prologue(F, A, rep)
#define PH1(rep) p1_modulate(F, A, rep)
#define PH2(rep) do {     \
        pg8::Gemm g{XN, (const bf16*)(F.ws + WS_WIN), M, NZ, D}; pg8::StaticOrder S; S.init(M, NZ, F.G, (int)blockIdx.x, D); \
        pg8::EpiBf16<0> E{Z, NZ, nullptr, (bf16*)(F.ws + WS_ZS), MP}; \
        pg8::gemm_phase<pg8::EpiBf16<0>, pg8::StaticOrder, PG8_ALIGN, PG8_SP2>(F.lds + RING_OFF, g, S, E); \
        if ((rep) == 0 && (int)blockIdx.x >= (M / 256) * (NZ / 256) - F.G) { __syncthreads(); xpose_range_b(F, A, XO_OU, XO_2, (M / 256) * (NZ / 256) - F.G); } } while (0)
#define PH3(rep) p3_mixers_ref(F, A, rep)
#define PH4(rep) do { } while (0)
#define PH5(rep) do {     \
        pg8::Gemm g{YC, (const bf16*)(F.ws + WS_WOUT), M, D, D}; \
        { pg8::StaticOrder S; S.init(MP, D, F.G, (int)blockIdx.x, D); \
          pg8::EpiLnFused<false> E{A.in[I_XP], mod + 2 * D, nullptr, ALPHA, A.in[I_LN1G], A.in[I_LN1B], mod + 3 * D, nullptr, (bf16*)(F.ws + WS_X1B), XN, (float*)(F.ws + WS_STAT), (unsigned*)(F.ctl + CW_T1), LN_EPS}; \
          pg8::gemm_phase<pg8::EpiLnFused<false>, pg8::StaticOrder, false, PG8_SP2>(F.lds + RING_OFF, g, S, E); } \
        GRID_BAR();     \
        if ((rep) == 0) p5_tail_items(F, A); \
        { pg8::PieceOrder S; S.init(MP, D, F.G, (int)blockIdx.x, D, NS_OUT); pg8::EpiSlab E{(float*)(F.ws + WS_SLAB), MP}; \
          pg8::Gemm gs{(const bf16*)(F.ws + WS_YCS) - (size_t)MP * D, (const bf16*)(F.ws + WS_WOUT), M, D, D};     \
          if ((int)blockIdx.x >= F.G - S.nP) cnt_wait_ge(F, CW_YCS, (unsigned)(2 * HA + 4));     \
          pg8::gemm_phase<pg8::EpiSlab, pg8::PieceOrder, false, PG8_SP2>(F.lds + RING_OFF, gs, S, E); \
          if ((int)blockIdx.x >= F.G - S.nP) cnt_arrive_wt(F, CW_T1S); } } while (0)
#define PH6(rep) do {     \
        constexpr int NPC1 = 2 * (D / 256) * NS_OUT; const int si1 = (int)blockIdx.x - (F.G - NPC1); \
        if (si1 >= 0) { cnt_wait_ge(F, CW_T1S, (unsigned)NPC1); ln_rows<false>(F, A, MP + si1 * (MS / NPC1), MP + (si1 + 1) * (MS / NPC1), F.wave, NWAVES); cnt_arrive_wt(F, CW_XNS); } } while (0)
#define PH7(rep) do {     \
        pg8::Gemm g{XN, (const bf16*)(F.ws + WS_W1), M, FF, D}; pg8::EpiBf16<3> E{U, FF, A.in[I_B1]}; \
        { pg8::StaticOrder S; S.init(MP, FF, F.G, (int)blockIdx.x, D); \
          pg8::gemm_phase<pg8::EpiBf16<3>, pg8::StaticOrder, PG8_ALIGN, PG8_SP2>(F.lds + RING_OFF, g, S, E); } \
        if ((int)blockIdx.x < 2 * (FF / 256)) { cnt_wait_ge(F, CW_XNS, (unsigned)(2 * (D / 256) * NS_OUT)); \
          pg8::OneUnit S; S.u0.pm = MP / 256 + (int)blockIdx.x / (FF / 256); S.u0.pn = (int)blockIdx.x % (FF / 256); S.u0.k0 = 0; S.u0.nkt = D / 64; S.u0.ks = 0; \
          pg8::gemm_phase<pg8::EpiBf16<3>, pg8::OneUnit, false, PG8_SP2>(F.lds + RING_OFF, g, S, E); } } while (0)
#define PH8(rep) do {     \
        pg8::Gemm g{U, (const bf16*)(F.ws + WS_W2), M, D, FF}; \
        { pg8::StaticOrder S; S.init(MP, D, F.G, (int)blockIdx.x, FF); \
          pg8::EpiLnFused<true> E{(const bf16*)(F.ws + WS_X1B), mod + 5 * D, A.in[I_B2], ALPHA, A.in[I_LN2G], A.in[I_LN2B], nullptr, F.out, nullptr, nullptr, (float*)(F.ws + WS_STAT), (unsigned*)(F.ctl + CW_T2), LN_EPS}; \
          pg8::gemm_phase<pg8::EpiLnFused<true>, pg8::StaticOrder, false, PG8_SP2>(F.lds + RING_OFF, g, S, E); } \
        { pg8::PieceOrder S; S.init(MP, D, F.G, (int)blockIdx.x, FF, NS_DOWN); pg8::EpiSlab E{(float*)(F.ws + WS_SLAB), MP}; \
          pg8::gemm_phase<pg8::EpiSlab, pg8::PieceOrder, false, PG8_SP2>(F.lds + RING_OFF, g, S, E); \
          if ((int)blockIdx.x >= F.G - S.nP) cnt_arrive_wt(F, CW_T2S); } } while (0)
#define RUNNB(k, PH) do { if (IN(k)) { PH(0); if (REPS(k) == 2) { __syncthreads(); PH(1); } } } while (0)
#define RUN(k, PH) do { if (IN(k)) { PH(0); if (REPS(k) == 2) { __syncthreads(); PH(1); } if (BOTH(k)) GRID_BAR(); } } while (0)
    if (IN(0)) { PH0(0); if (REPS(0) == 2) { __syncthreads(); PH0(1); } if (IN(0) && !IN(1)) { } }
    RUN(1, PH1); RUN(2, PH2); RUN(3, PH3); RUNNB(5, PH5); RUNNB(6, PH6); RUN(7, PH7); RUNNB(8, PH8);
    if (IN(9)) {
        constexpr int NPC = 2 * (D / 256) * NS_DOWN; const int si = (int)blockIdx.x - (F.G - NPC);
        if (si >= 0) { cnt_wait_ge(F, CW_T2S, (unsigned)NPC); ln_rows<true>(F, A, MP + si * (MS / NPC), MP + (si + 1) * (MS / NPC), F.wave, NWAVES); } }
#undef IN
#undef BOTH
}

extern "C" void kernel_launch(void* const* d_in, const int* in_sizes, int n_in, void* d_out, int out_size, void* d_ws, size_t ws_size, hipStream_t stream) {
    static int grid = 0;
    if (grid == 0) {
        if (n_in != 37 || in_sizes[0] != MP * D || out_size != (int)O_END || ws_size < WS_END) { fprintf(stderr, "kernel_launch: unexpected shapes (n_in %d, in0 %d, out %d, ws %zu)\n", n_in, n_in > 0 ? in_sizes[0] : -1, out_size, ws_size); grid = -1; return; }
        int dev = 0, cus = 0, per_cu = 0;
        if (hipGetDevice(&dev) != hipSuccess || hipDeviceGetAttribute(&cus, hipDeviceAttributeMultiprocessorCount, dev) != hipSuccess) { grid = -1; return; }
        if (hipFuncSetAttribute((const void*)fwd, hipFuncAttributeMaxDynamicSharedMemorySize, LDS_BYTES) != hipSuccess) { fprintf(stderr, "kernel_launch: hipFuncSetAttribute failed\n"); grid = -1; return; }
        if (hipOccupancyMaxActiveBlocksPerMultiprocessor(&per_cu, (const void*)fwd, NWAVES * 64, LDS_BYTES) != hipSuccess || per_cu < 1) { fprintf(stderr, "kernel_launch: occupancy query says %d\n", per_cu); }
        (void)hipGetLastError();
        grid = cus;
        if (grid < 256) { fprintf(stderr, "kernel_launch: this build needs 256 CUs (got %d)\n", grid); grid = -1; return; }
        grid = 256;
    }
    if (grid < 0) return;
    (void)hipMemsetAsync((char*)d_ws + WS_CTL, 0, CTL_ZERO_BYTES, stream);
    Args a{};
    for (int i = 0; i < 37; ++i) a.in[i] = (const float*)d_in[i];
    a.out = (float*)d_out; a.ws = (unsigned char*)d_ws;
    for (int li = 0; li < N_LAUNCHES; ++li) {
        if (N_LAUNCHES == 1) { a.ph_lo = 0; a.ph_hi = N_PHASES; } else { a.ph_lo = li; a.ph_hi = li + 1; }
        a.li = li;
        hipLaunchKernelGGL(fwd, dim3(grid), dim3(NWAVES * 64), LDS_BYTES, stream, a);
    }
}
```

```cpp
#include <hip/hip_runtime.h>
#include <cstdio>
#include <cstdint>
#include <cmath>

#ifndef MK_N_LAUNCHES
#define MK_N_LAUNCHES 1
#endif

namespace pg8 {
#define PG8_LAS __attribute__((address_space(3)))
typedef unsigned short bf16_t;
typedef short bf16x8 __attribute__((ext_vector_type(8)));
typedef float f32x4 __attribute__((ext_vector_type(4)));
typedef unsigned u32x4 __attribute__((ext_vector_type(4)));
constexpr int BM = 256, BK = 64, HALF = 128, HTB = HALF * BK * 2, STAGE_BYTES = 8 * HTB, NXCD = 8, WGM = 8;

__host__ __device__ __forceinline__ int lds_byte(int r, int c) { const int st = (r >> 4) * 2 + (c >> 5), rr = r & 15, cc = c & 31, ob = rr * 64 + cc * 2; return st * 1024 + (ob ^ (((ob >> 9) & 1) << 5)); }
__host__ __device__ __forceinline__ void stage_rc(int b, int& R, int& C) { const int st = b / 1024, sb = b % 1024, swz = sb ^ (((sb >> 9) & 1) << 5); R = (st >> 1) * 16 + swz / 64; C = (st & 1) * 32 + (swz % 64) / 2; }
__host__ __device__ __forceinline__ int perm32(int rho) { const int n = rho >> 4, i = rho & 15; return 8 * (i >> 2) + 4 * n + (i & 3); }

struct Unit { int pm, pn, k0, nkt, ks; };
struct Gemm { const bf16_t* A; const bf16_t* Bt; int M, N, K; };

struct StaticOrder {
    int nM, nN, nwg, G, c, K;
    __host__ __device__ void init(int M, int N, int G_, int c_, int K_) { nM = M / BM; nN = N / BM; nwg = nM * nN; G = G_; c = c_; K = K_; }
    __host__ __device__ __forceinline__ bool next(int i, Unit& u) const {
        const long L = (long)i * G + c; if (L >= nwg) return false;
        int wgid = (int)L; { const int q = nwg / NXCD, r = nwg % NXCD, xcd = wgid % NXCD, off = wgid / NXCD; wgid = (xcd < r ? xcd * (q + 1) : r * (q + 1) + (xcd - r) * q) + off; }
        const int nig = WGM * nN, gid = wgid / nig, fm = gid * WGM, gsz = (nM - fm) < WGM ? (nM - fm) : WGM;
        u.pm = fm + ((wgid % nig) % gsz); u.pn = (wgid % nig) / gsz; u.k0 = 0; u.nkt = K / BK; u.ks = 0; return true;
    }
    __device__ __forceinline__ void a_ready(const Unit&) const {}
    __device__ __forceinline__ void done(const Unit&) const {}
};

struct SplitOrder {
    StaticOrder P; int nN, NS, nP, G, c, K, r0;
    __host__ __device__ void init(int MPr, int N, int G_, int c_, int K_, int NS_) { P.init(MPr, N, G_, c_, K_); nN = N / BM; NS = NS_; nP = 2 * nN * NS; G = G_; c = c_; K = K_; r0 = (P.nwg + G - 1 - c) / G;   }
    __host__ __device__ __forceinline__ bool next(int i, Unit& u) const {
        Unit a; a.pm = 0; a.pn = 0; a.k0 = 0; a.nkt = K / BK; a.ks = 0;
        const bool okp = P.next(i < r0 ? i : 0, a);
        const int p = (i - r0) * G + (G - 1 - c), t = p / NS, ks = p % NS, nk = K / BK / NS;
        const bool split = i >= r0;
        u.pm = split ? P.nM + t / nN : a.pm; u.pn = split ? t % nN : a.pn; u.nkt = split ? nk : a.nkt; u.ks = split ? ks : 0; u.k0 = split ? ks * nk * BK : 0;
        return split ? (p < nP) : okp;
    }
    __device__ __forceinline__ void a_ready(const Unit&) const {}
    __device__ __forceinline__ void done(const Unit&) const {}
};

struct OneUnit {
    Unit u0;
    __host__ __device__ __forceinline__ bool next(int i, Unit& u) const { u = u0; return i == 0; }
    __device__ __forceinline__ void a_ready(const Unit&) const {}
    __device__ __forceinline__ void done(const Unit&) const {}
};
__device__ __forceinline__ void st16_wt(void* p, u32x4 v) { asm volatile("global_store_dwordx4 %0, %1, off sc1\n\ts_nop 1" :: "v"(p), "v"(v)); }
__device__ __forceinline__ void st16f_wt(void* p, f32x4 v) { asm volatile("global_store_dwordx4 %0, %1, off sc1\n\ts_nop 1" :: "v"(p), "v"(v)); }
__device__ __forceinline__ unsigned cvt_pk_bf16(float lo, float hi) { unsigned r; asm volatile("v_cvt_pk_bf16_f32 %0, %1, %2" : "=v"(r) : "v"(lo), "v"(hi)); return r; }
__device__ __forceinline__ float bf_lo(unsigned w) { return __builtin_bit_cast(float, w << 16); }
__device__ __forceinline__ float bf_hi(unsigned w) { return __builtin_bit_cast(float, w & 0xffff0000u); }

template <int ACT> struct EpiBf16 {
    static constexpr bool PERM = true, AFTER_DRAIN = false;
    bf16_t* O; int ldc; const float* bias;
    __device__ __forceinline__ void operator()(const f32x4 (&acc)[2][2][4][2], const Unit& u, int wr, int wc, int fr, int fq) const {
        const int row0 = u.pm * BM + wr * 64 + fr; const int col0 = u.pn * BM + wc * 32 + 8 * fq;
        f32x4 bv[2][2];
#pragma unroll
        for (int bj = 0; bj < 2; ++bj)
#pragma unroll
            for (int n = 0; n < 2; ++n) bv[bj][n] = bias ? *(const f32x4*)(bias + col0 + bj * HALF + 4 * n) : (f32x4){0.f, 0.f, 0.f, 0.f};
#pragma unroll
        for (int ai = 0; ai < 2; ++ai)
#pragma unroll
            for (int m = 0; m < 4; ++m) { bf16_t* rowp = O + (size_t)(row0 + ai * HALF + m * 16) * ldc + col0;
#pragma unroll
                for (int bj = 0; bj < 2; ++bj) { f32x4 v0 = acc[ai][bj][m][0] + bv[bj][0], v1 = acc[ai][bj][m][1] + bv[bj][1];
                    if (ACT == 3) {
#pragma unroll
                        for (int e = 0; e < 4; ++e) { const float a = fmaxf(v0[e], 0.f), b = fmaxf(v1[e], 0.f); v0[e] = a * a; v1[e] = b * b; } }
                    u32x4 w; w.x = cvt_pk_bf16(v0[0], v0[1]); w.y = cvt_pk_bf16(v0[2], v0[3]); w.z = cvt_pk_bf16(v1[0], v1[1]); w.w = cvt_pk_bf16(v1[2], v1[3]);
                    *(u32x4*)(rowp + bj * HALF) = w; } }
    }
};
struct EpiGlu {
    static constexpr bool PERM = true, AFTER_DRAIN = false;
    const bf16_t* Gy; int ldg; bf16_t* O; int ldc; int coff; const float* bias; bf16_t* Os; int MPs;
    __device__ __forceinline__ void operator()(const f32x4 (&acc)[2][2][4][2], const Unit& u, int wr, int wc, int fr, int fq) const {
        const int row0 = u.pm * BM + wr * 64 + fr; const int col0 = u.pn * BM + wc * 32 + 8 * fq;
        bf16_t* const Ob = u.pm * BM >= MPs ? Os - (size_t)MPs * ldc : O;
        f32x4 bv[2][2];
#pragma unroll
        for (int bj = 0; bj < 2; ++bj)
#pragma unroll
            for (int n = 0; n < 2; ++n) bv[bj][n] = *(const f32x4*)(bias + col0 + bj * HALF + 4 * n);
        constexpr int DEPTH = 4;
        u32x4 pg[DEPTH];
#define EPG_ROW(g) ((size_t)(row0 + ((g) >> 3) * HALF + (((g) >> 1) & 3) * 16))
#define EPG_COL(g) (col0 + ((g) & 1) * HALF)
#pragma unroll
        for (int g = 0; g < DEPTH; ++g) pg[g] = *(const u32x4*)(Gy + EPG_ROW(g) * ldg + EPG_COL(g));
#pragma unroll
        for (int gi = 0; gi < 16; ++gi) { const int ai = gi >> 3, m = (gi >> 1) & 3, bj = gi & 1;
            const u32x4 g = pg[gi % DEPTH];
            if (gi + DEPTH < 16) pg[gi % DEPTH] = *(const u32x4*)(Gy + EPG_ROW(gi + DEPTH) * ldg + EPG_COL(gi + DEPTH));
            const f32x4 v0 = acc[ai][bj][m][0] + bv[bj][0], v1 = acc[ai][bj][m][1] + bv[bj][1];
            float o[8];
            o[0] = bf_lo(g.x) * __builtin_amdgcn_rcpf(1.f + __builtin_amdgcn_exp2f(-1.4426950408889634f * v0[0])); o[1] = bf_hi(g.x) * __builtin_amdgcn_rcpf(1.f + __builtin_amdgcn_exp2f(-1.4426950408889634f * v0[1]));
            o[2] = bf_lo(g.y) * __builtin_amdgcn_rcpf(1.f + __builtin_amdgcn_exp2f(-1.4426950408889634f * v0[2])); o[3] = bf_hi(g.y) * __builtin_amdgcn_rcpf(1.f + __builtin_amdgcn_exp2f(-1.4426950408889634f * v0[3]));
            o[4] = bf_lo(g.z) * __builtin_amdgcn_rcpf(1.f + __builtin_amdgcn_exp2f(-1.4426950408889634f * v1[0])); o[5] = bf_hi(g.z) * __builtin_amdgcn_rcpf(1.f + __builtin_amdgcn_exp2f(-1.4426950408889634f * v1[1]));
            o[6] = bf_lo(g.w) * __builtin_amdgcn_rcpf(1.f + __builtin_amdgcn_exp2f(-1.4426950408889634f * v1[2])); o[7] = bf_hi(g.w) * __builtin_amdgcn_rcpf(1.f + __builtin_amdgcn_exp2f(-1.4426950408889634f * v1[3]));
            u32x4 w; w.x = cvt_pk_bf16(o[0], o[1]); w.y = cvt_pk_bf16(o[2], o[3]); w.z = cvt_pk_bf16(o[4], o[5]); w.w = cvt_pk_bf16(o[6], o[7]);
            *(u32x4*)(Ob + EPG_ROW(gi) * ldc + coff + EPG_COL(gi)) = w; }
#undef EPG_ROW
#undef EPG_COL
    }
};
template <bool BASE16> struct EpiRes {
    static constexpr bool PERM = true, AFTER_DRAIN = false;
    const void* basep; bf16_t* T; const float* gate  ; const float* bias; float alpha; int MP; float* slab;
    __device__ __forceinline__ void operator()(const f32x4 (&acc)[2][2][4][2], const Unit& u, int wr, int wc, int fr, int fq) const {
        const int row0 = u.pm * BM + wr * 64 + fr, col0 = u.pn * BM + wc * 32 + 8 * fq;
        if (row0 >= MP) {
            float* sp = slab + (size_t)u.ks * 512 * 1024;
#pragma unroll
            for (int ai = 0; ai < 2; ++ai)
#pragma unroll
                for (int m = 0; m < 4; ++m) { float* op = sp + (size_t)(row0 + ai * HALF + m * 16 - MP) * 1024;
#pragma unroll
                    for (int bj = 0; bj < 2; ++bj)
#pragma unroll
                        for (int n = 0; n < 2; ++n) st16f_wt(op + col0 + bj * HALF + n * 4, acc[ai][bj][m][n]); }
            return; }
        f32x4 bv[2][2], gv[2][2];
        const float* gp = gate + (size_t)(row0 >> 11) * 6144;
#pragma unroll
        for (int bj = 0; bj < 2; ++bj)
#pragma unroll
            for (int n = 0; n < 2; ++n) { bv[bj][n] = bias ? *(const f32x4*)(bias + col0 + bj * HALF + n * 4) : (f32x4){0.f, 0.f, 0.f, 0.f}; gv[bj][n] = *(const f32x4*)(gp + col0 + bj * HALF + n * 4); }
        constexpr int DEPTH = 3;
        f32x4 pb[DEPTH][2]; u32x4 pw[DEPTH];
#define EPR_ROW(g) (row0 + ((g) >> 3) * HALF + (((g) >> 1) & 3) * 16)
#define EPR_COL(g) (col0 + ((g) & 1) * HALF)
#define EPR_LOAD(g) do { if (BASE16) pw[(g) % DEPTH] = *(const u32x4*)((const bf16_t*)basep + (size_t)EPR_ROW(g) * 1024 + EPR_COL(g)); \
            else { const float* bp_ = (const float*)basep + (size_t)EPR_ROW(g) * 1024 + EPR_COL(g); pb[(g) % DEPTH][0] = *(const f32x4*)bp_; pb[(g) % DEPTH][1] = *(const f32x4*)(bp_ + 4); } } while (0)
#pragma unroll
        for (int g = 0; g < DEPTH; ++g) EPR_LOAD(g);
#pragma unroll
        for (int g = 0; g < 16; ++g) { const int ai = g >> 3, m = (g >> 1) & 3, bj = g & 1;
            f32x4 b0, b1;
            if (BASE16) { const u32x4 bw = pw[g % DEPTH]; b0 = (f32x4){bf_lo(bw.x), bf_hi(bw.x), bf_lo(bw.y), bf_hi(bw.y)}; b1 = (f32x4){bf_lo(bw.z), bf_hi(bw.z), bf_lo(bw.w), bf_hi(bw.w)}; }
            else { b0 = pb[g % DEPTH][0]; b1 = pb[g % DEPTH][1]; }
            if (g + DEPTH < 16) EPR_LOAD(g + DEPTH);
            const f32x4 v0 = b0 * alpha + gv[bj][0] * (acc[ai][bj][m][0] + bv[bj][0]), v1 = b1 * alpha + gv[bj][1] * (acc[ai][bj][m][1] + bv[bj][1]);
            u32x4 w; w.x = cvt_pk_bf16(v0[0], v0[1]); w.y = cvt_pk_bf16(v0[2], v0[3]); w.z = cvt_pk_bf16(v1[0], v1[1]); w.w = cvt_pk_bf16(v1[2], v1[3]);
            st16_wt(T + (size_t)EPR_ROW(g) * 1024 + EPR_COL(g), w); }
#undef EPR_ROW
#undef EPR_COL
#undef EPR_LOAD
    }
};

struct PieceOrder {
    int nN, NS, nP, G, c, K, nM;
    __host__ __device__ void init(int MPr, int N, int G_, int c_, int K_, int NS_) { nM = MPr / BM; nN = N / BM; NS = NS_; nP = 2 * nN * NS; G = G_; c = c_; K = K_; }
    __host__ __device__ __forceinline__ bool next(int i, Unit& u) const {
        const int p = G - 1 - c, t = p / NS, ks = p % NS, nk = K / BK / NS;
        u.pm = nM + t / nN; u.pn = t % nN; u.nkt = nk; u.ks = ks; u.k0 = ks * nk * BK; return i == 0 && p < nP;
    }
    __device__ __forceinline__ void a_ready(const Unit&) const {}
    __device__ __forceinline__ void done(const Unit&) const {}
};
struct EpiSlab {
    static constexpr bool PERM = true, AFTER_DRAIN = false;
    float* slab; int MP;
    __device__ __forceinline__ void operator()(const f32x4 (&acc)[2][2][4][2], const Unit& u, int wr, int wc, int fr, int fq) const {
        const int row0 = u.pm * BM + wr * 64 + fr, col0 = u.pn * BM + wc * 32 + 8 * fq;
        float* sp = slab + (size_t)u.ks * 512 * 1024;
#pragma unroll
        for (int ai = 0; ai < 2; ++ai)
#pragma unroll
            for (int m = 0; m < 4; ++m) { float* op = sp + (size_t)(row0 + ai * HALF + m * 16 - MP) * 1024;
#pragma unroll
                for (int bj = 0; bj < 2; ++bj)
#pragma unroll
                    for (int n = 0; n < 2; ++n) st16f_wt(op + col0 + bj * HALF + n * 4, acc[ai][bj][m][n]); }
    }
};
template <bool SECOND> struct EpiLnFused {
    static constexpr bool PERM = true, AFTER_DRAIN = true;
    const void* basep; const float* gate; const float* bias; float alpha; const float* lng; const float* lnb; const float* mod2  ;
    float* out; bf16_t* x1; bf16_t* xn; float* stat; unsigned* cnt; float eps;
    __device__ __forceinline__ void fused(f32x4 (&acc)[2][2][4][2], const Unit& u, int wr, int wc, int fr, int fq, PG8_LAS unsigned char* lds, int wid, int lane) const {
        const int row0 = u.pm * BM + wr * 64 + fr, col0 = u.pn * BM + wc * 32 + 8 * fq, tid = wid * 64 + lane;
        {
            const float* gp = gate + (size_t)(row0 >> 11) * 6144;
#pragma unroll
            for (int bj = 0; bj < 2; ++bj) { const int c = col0 + bj * HALF;
                const f32x4 g0 = *(const f32x4*)(gp + c), g1 = *(const f32x4*)(gp + c + 4);
                const f32x4 v0 = bias ? *(const f32x4*)(bias + c) : (f32x4){0.f, 0.f, 0.f, 0.f}, v1 = bias ? *(const f32x4*)(bias + c + 4) : (f32x4){0.f, 0.f, 0.f, 0.f};
                constexpr int DEPTH = 2; f32x4 pb[DEPTH][2]; u32x4 pw[DEPTH];
#define EPF_ROW(g) (row0 + ((g) >> 2) * HALF + ((g) & 3) * 16)
#define EPF_LOAD(g) do { if (SECOND) pw[(g) % DEPTH] = *(const u32x4*)((const bf16_t*)basep + (size_t)EPF_ROW(g) * 1024 + c); \
                else { const float* bp_ = (const float*)basep + (size_t)EPF_ROW(g) * 1024 + c; pb[(g) % DEPTH][0] = *(const f32x4*)bp_; pb[(g) % DEPTH][1] = *(const f32x4*)(bp_ + 4); } } while (0)
#pragma unroll
                for (int g = 0; g < DEPTH; ++g) EPF_LOAD(g);
#pragma unroll
                for (int g = 0; g < 8; ++g) { const int ai = g >> 2, m = g & 3; f32x4 b0, b1;
                    if (SECOND) { const u32x4 bw = pw[g % DEPTH]; b0 = (f32x4){bf_lo(bw.x), bf_hi(bw.x), bf_lo(bw.y), bf_hi(bw.y)}; b1 = (f32x4){bf_lo(bw.z), bf_hi(bw.z), bf_lo(bw.w), bf_hi(bw.w)}; }
                    else { b0 = pb[g % DEPTH][0]; b1 = pb[g % DEPTH][1]; }
                    if (g + DEPTH < 8) EPF_LOAD(g + DEPTH);
                    acc[ai][bj][m][0] = b0 * alpha + g0 * (acc[ai][bj][m][0] + v0); acc[ai][bj][m][1] = b1 * alpha + g1 * (acc[ai][bj][m][1] + v1);
                    asm volatile("" : "+v"(acc[ai][bj][m][0]), "+v"(acc[ai][bj][m][1]) :: "memory"); }
#undef EPF_LOAD
#undef EPF_ROW
            }
        }
        typedef float f32x2v __attribute__((ext_vector_type(2)));
        PG8_LAS f32x2v* RS = (PG8_LAS f32x2v*)lds;
        PG8_LAS f32x2v* MR = (PG8_LAS f32x2v*)(lds + 8192);
#pragma unroll
        for (int ai = 0; ai < 2; ++ai)
#pragma unroll
            for (int m = 0; m < 4; ++m) { float sa = 0.f, sq = 0.f;
#pragma unroll
                for (int bj = 0; bj < 2; ++bj)
#pragma unroll
                    for (int n = 0; n < 2; ++n) { const f32x4 x = acc[ai][bj][m][n]; sa += (x[0] + x[1]) + (x[2] + x[3]); sq += (x[0] * x[0] + x[1] * x[1]) + (x[2] * x[2] + x[3] * x[3]); }
                sa += __shfl_xor(sa, 16); sa += __shfl_xor(sa, 32); sq += __shfl_xor(sq, 16); sq += __shfl_xor(sq, 32);
                if (fq == 0) RS[(ai * HALF + wr * 64 + m * 16 + fr) * 4 + wc] = (f32x2v){sa, sq}; }
        asm volatile("s_waitcnt lgkmcnt(0)" ::: "memory"); __builtin_amdgcn_s_barrier(); asm volatile("" ::: "memory");
        if (tid < 256) { const f32x2v a = RS[tid * 4 + 0], b = RS[tid * 4 + 1], c = RS[tid * 4 + 2], d = RS[tid * 4 + 3];
            unsigned long long* slot = (unsigned long long*)stat + ((size_t)(u.pm * 4 + u.pn) * 256 + tid);
            __hip_atomic_store(slot, ((unsigned long long)__builtin_bit_cast(unsigned, (a.y + b.y) + (c.y + d.y)) << 32) | __builtin_bit_cast(unsigned, (a.x + b.x) + (c.x + d.x)), __ATOMIC_RELAXED, __HIP_MEMORY_SCOPE_AGENT); }
        asm volatile("s_waitcnt vmcnt(0)" ::: "memory"); __builtin_amdgcn_s_barrier(); asm volatile("" ::: "memory");
        if (tid == 0) { (void)__hip_atomic_fetch_add(cnt + 64 * u.pm, 1u, __ATOMIC_RELAXED, __HIP_MEMORY_SCOPE_AGENT);
            unsigned sp = 0; while (__hip_atomic_load(cnt + 64 * u.pm, __ATOMIC_RELAXED, __HIP_MEMORY_SCOPE_AGENT) < 4u && ++sp < (1u << 22)) __builtin_amdgcn_s_sleep(2);
            __builtin_amdgcn_fence(__ATOMIC_ACQUIRE, "agent"); asm volatile("s_waitcnt vmcnt(0)" ::: "memory"); }
        __builtin_amdgcn_s_barrier(); asm volatile("" ::: "memory");
        if (tid < 256) { float S = 0.f, Q = 0.f;
#pragma unroll
            for (int p = 0; p < 4; ++p) { const unsigned long long w = __hip_atomic_load((const unsigned long long*)stat + ((size_t)(u.pm * 4 + p) * 256 + tid), __ATOMIC_RELAXED, __HIP_MEMORY_SCOPE_AGENT);
                S += __builtin_bit_cast(float, (unsigned)w); Q += __builtin_bit_cast(float, (unsigned)(w >> 32)); }
            const float mean = S * (1.f / 1024.f), var = fmaxf(Q * (1.f / 1024.f) - mean * mean, 0.f);
            MR[tid] = (f32x2v){mean, 1.0f / sqrtf(var + eps)}; }
        asm volatile("s_waitcnt lgkmcnt(0)" ::: "memory"); __builtin_amdgcn_s_barrier(); asm volatile("" ::: "memory");
#pragma unroll
        for (int bj = 0; bj < 2; ++bj) { const int c = col0 + bj * HALF;
            const f32x4 g0 = *(const f32x4*)(lng + c), g1 = *(const f32x4*)(lng + c + 4), b0 = *(const f32x4*)(lnb + c), b1 = *(const f32x4*)(lnb + c + 4);
            f32x4 s0, s1, h0, h1;
            if (!SECOND) { const float* mp = mod2 + (size_t)(row0 >> 11) * 6144 + c; h0 = *(const f32x4*)mp; h1 = *(const f32x4*)(mp + 4); s0 = *(const f32x4*)(mp + 1024) + 1.f; s1 = *(const f32x4*)(mp + 1028) + 1.f; }
#pragma unroll
            for (int ai = 0; ai < 2; ++ai)
#pragma unroll
                for (int m = 0; m < 4; ++m) { const int rl = ai * HALF + wr * 64 + m * 16 + fr; const size_t row = (size_t)(u.pm * BM + rl); const f32x2v mr = MR[rl];
                    const f32x4 y0 = (acc[ai][bj][m][0] - mr.x) * mr.y * g0 + b0, y1 = (acc[ai][bj][m][1] - mr.x) * mr.y * g1 + b1;
                    if (SECOND) { *(f32x4*)(out + row * 1024 + c) = y0; *(f32x4*)(out + row * 1024 + c + 4) = y1; }
                    else { u32x4 w; w.x = cvt_pk_bf16(y0[0], y0[1]); w.y = cvt_pk_bf16(y0[2], y0[3]); w.z = cvt_pk_bf16(y1[0], y1[1]); w.w = cvt_pk_bf16(y1[2], y1[3]);
                           *(u32x4*)(x1 + row * 1024 + c) = w;
                           const f32x4 z0 = y0 * s0 + h0, z1 = y1 * s1 + h1;
                           u32x4 v; v.x = cvt_pk_bf16(z0[0], z0[1]); v.y = cvt_pk_bf16(z0[2], z0[3]); v.z = cvt_pk_bf16(z1[0], z1[1]); v.w = cvt_pk_bf16(z1[2], z1[3]);
                           *(u32x4*)(xn + row * 1024 + c) = v; } } }
        asm volatile("s_waitcnt lgkmcnt(0)" ::: "memory"); __builtin_amdgcn_s_barrier(); asm volatile("" ::: "memory");
    }
};

template <class Epi, class Sched, bool ALIGN_EPI = false, bool SP2 = false>
__device__ __forceinline__ void gemm_phase(PG8_LAS unsigned char* lds, const Gemm g, const Sched& S, const Epi& E) {
    const int tid = threadIdx.x, wid = __builtin_amdgcn_readfirstlane(tid >> 6), lane = tid & 63, wr = wid >> 2, wc = wid & 3, fr = lane & 15, fq = lane >> 4;
    const int K = g.K;
    unsigned voffA[2], voffB[2];
#pragma unroll
    for (int i = 0; i < 2; ++i) { int R, C; stage_rc(tid * 16 + i * 8192, R, C); const int Rb = Epi::PERM ? ((R & ~31) + perm32(R & 31)) : R;
        voffA[i] = (unsigned)(R * K + C) * 2u; voffB[i] = (unsigned)(Rb * K + C) * 2u; }
    const size_t kstep = (size_t)(BK * 2);
    const size_t hstep = (size_t)HALF * K * 2;
    const size_t tstep = 2 * hstep;
    const unsigned ldsw = (unsigned)wid * 1024u;
    const int aoff = lds_byte(wr * 64 + fr, fq * 8), boff = lds_byte(wc * 32 + fr, fq * 8);
#define PG8_SA(b, h) (((b) * 2 + (h)) * HTB)
#define PG8_SB(b, h) ((4 + (b) * 2 + (h)) * HTB)
#define PG8_STAGE(bufoff, gbase, voff) do { _Pragma("unroll") for (int _i = 0; _i < 2; ++_i) \
        __builtin_amdgcn_global_load_lds((const unsigned*)((const char*)(gbase) + (voff)[_i]), (PG8_LAS unsigned*)(lds + (bufoff) + ldsw + _i * 8192), 16, 0, 0); } while (0)
#define PG8_LDA(dst, b, h) do { _Pragma("unroll") for (int m = 0; m < 4; ++m) _Pragma("unroll") for (int k = 0; k < 2; ++k) dst[m][k] = *(const PG8_LAS bf16x8*)(lds + PG8_SA(b, h) + aoff + m * 2048 + k * 1024); } while (0)
#define PG8_LDB(dst, b, h) do { _Pragma("unroll") for (int n = 0; n < 2; ++n) _Pragma("unroll") for (int k = 0; k < 2; ++k) dst[n][k] = *(const PG8_LAS bf16x8*)(lds + PG8_SB(b, h) + boff + n * 2048 + k * 1024); } while (0)
#define PG8_MMA(ai, bj, At, Bt) do { __builtin_amdgcn_s_setprio(1); _Pragma("unroll") for (int m = 0; m < 4; ++m) _Pragma("unroll") for (int n = 0; n < 2; ++n) _Pragma("unroll") for (int k = 0; k < 2; ++k) \
        acc[ai][bj][m][n] = __builtin_amdgcn_mfma_f32_16x16x32_bf16(Bt[n][k], At[m][k], acc[ai][bj][m][n], 0, 0, 0); __builtin_amdgcn_s_setprio(0); } while (0)
#define PG8_WAIT_V(n) asm volatile("s_waitcnt vmcnt(" #n ")" ::: "memory")
#define PG8_WAIT_L(n) asm volatile("s_waitcnt lgkmcnt(" #n ")" ::: "memory")
#define PG8_BAR __builtin_amdgcn_s_barrier()
#define PG8_SCHED __builtin_amdgcn_sched_barrier(0)
    Unit cur, nxt; int ui = 0;
    if (!S.next(0, cur)) return;
    f32x4 acc[2][2][4][2];
#pragma unroll
    for (int a = 0; a < 2; ++a)
#pragma unroll
        for (int b = 0; b < 2; ++b)
#pragma unroll
            for (int m = 0; m < 4; ++m)
#pragma unroll
                for (int n = 0; n < 2; ++n) acc[a][b][m][n] = (f32x4){0.f, 0.f, 0.f, 0.f};
    bf16x8 At[4][2], B0[2][2], B1[2][2];
    const char* cA = (const char*)g.A + (size_t)cur.pm * tstep + (size_t)cur.k0 * 2; const char* cB = (const char*)g.Bt + (size_t)cur.pn * tstep + (size_t)cur.k0 * 2;
    S.a_ready(cur);
    if constexpr (SP2) {
        PG8_STAGE(PG8_SB(0, 0), cB, voffB); PG8_STAGE(PG8_SB(0, 1), cB + hstep, voffB); PG8_STAGE(PG8_SA(0, 0), cA, voffA); PG8_STAGE(PG8_SA(0, 1), cA + hstep, voffA);
        if (wr == 1) PG8_BAR;
        PG8_WAIT_V(2); PG8_BAR;
        PG8_STAGE(PG8_SB(1, 0), cB + kstep, voffB); PG8_STAGE(PG8_SA(1, 0), cA + kstep, voffA); PG8_STAGE(PG8_SB(1, 1), cB + hstep + kstep, voffB);
        PG8_WAIT_V(6); PG8_BAR;
    } else {
        PG8_STAGE(PG8_SB(0, 0), cB, voffB); PG8_STAGE(PG8_SA(0, 0), cA, voffA); PG8_STAGE(PG8_SB(0, 1), cB + hstep, voffB); PG8_STAGE(PG8_SA(0, 1), cA + hstep, voffA);
        if (wr == 1) PG8_BAR;
        PG8_WAIT_V(4); PG8_BAR;
        PG8_STAGE(PG8_SB(1, 0), cB + kstep, voffB); PG8_STAGE(PG8_SA(1, 0), cA + kstep, voffA); PG8_STAGE(PG8_SB(1, 1), cB + hstep + kstep, voffB);
        PG8_WAIT_V(6); PG8_BAR;
    }
    for (;;) {
        const bool has_next = S.next(ui + 1, nxt);
        const char* nA = has_next ? (const char*)g.A + (size_t)nxt.pm * tstep + (size_t)nxt.k0 * 2 : cA; const char* nB = has_next ? (const char*)g.Bt + (size_t)nxt.pn * tstep + (size_t)nxt.k0 * 2 : cB;
        const int nt = cur.nkt;
        for (int t = 0; t < nt; t += 2) {
            const bool last = (t == nt - 2);
            const char* a1 = cA + (size_t)(t + 1) * kstep;
            const char* a2 = last ? nA : cA + (size_t)(t + 2) * kstep; const char* b2 = last ? nB : cB + (size_t)(t + 2) * kstep;
            const char* a3 = a2 + kstep; const char* b3 = b2 + kstep;
            if (last && has_next) S.a_ready(nxt);
            if constexpr (SP2) {
            PG8_LDB(B0, 0, 0); PG8_LDB(B1, 0, 1); PG8_SCHED; PG8_LDA(At, 0, 0); PG8_STAGE(PG8_SA(1, 1), a1 + hstep, voffA);
            PG8_WAIT_V(8); PG8_WAIT_L(0); PG8_BAR; PG8_MMA(0, 0, At, B0); PG8_MMA(0, 1, At, B1); PG8_BAR; PG8_SCHED;
            PG8_LDA(At, 0, 1); PG8_STAGE(PG8_SB(0, 0), b2, voffB); PG8_STAGE(PG8_SB(0, 1), b2 + hstep, voffB); PG8_STAGE(PG8_SA(0, 0), a2, voffA);
            PG8_WAIT_V(8); PG8_WAIT_L(0); PG8_BAR; PG8_MMA(1, 0, At, B0); PG8_MMA(1, 1, At, B1); PG8_BAR; PG8_SCHED;
            PG8_LDB(B0, 1, 0); PG8_LDB(B1, 1, 1); PG8_SCHED; PG8_LDA(At, 1, 0); PG8_STAGE(PG8_SA(0, 1), a2 + hstep, voffA);
            PG8_WAIT_V(8); PG8_WAIT_L(0); PG8_BAR; PG8_MMA(0, 0, At, B0); PG8_MMA(0, 1, At, B1); PG8_BAR; PG8_SCHED;
            PG8_LDA(At, 1, 1); PG8_STAGE(PG8_SB(1, 0), b3, voffB); PG8_STAGE(PG8_SB(1, 1), b3 + hstep, voffB); PG8_STAGE(PG8_SA(1, 0), a3, voffA);
            PG8_WAIT_V(8); PG8_WAIT_L(0); PG8_BAR; PG8_MMA(1, 0, At, B0); PG8_MMA(1, 1, At, B1); PG8_BAR; PG8_SCHED;
            } else {
            PG8_LDB(B0, 0, 0); PG8_SCHED; PG8_LDA(At, 0, 0); PG8_STAGE(PG8_SA(1, 1), a1 + hstep, voffA);
            PG8_WAIT_L(8); PG8_BAR; PG8_WAIT_L(0); PG8_MMA(0, 0, At, B0); PG8_BAR; PG8_SCHED;
            PG8_LDB(B1, 0, 1); PG8_STAGE(PG8_SB(0, 0), b2, voffB);
            PG8_BAR; PG8_WAIT_L(0); PG8_MMA(0, 1, At, B1); PG8_BAR;
            PG8_LDA(At, 0, 1); PG8_STAGE(PG8_SA(0, 0), a2, voffA);
            PG8_BAR; PG8_WAIT_L(0); PG8_MMA(1, 0, At, B0); PG8_BAR; PG8_SCHED;
            PG8_STAGE(PG8_SB(0, 1), b2 + hstep, voffB);
            PG8_WAIT_V(6); PG8_BAR; PG8_MMA(1, 1, At, B1); PG8_BAR;
            PG8_LDB(B0, 1, 0); PG8_SCHED; PG8_LDA(At, 1, 0); PG8_STAGE(PG8_SA(0, 1), a2 + hstep, voffA);
            PG8_WAIT_L(8); PG8_BAR; PG8_WAIT_L(0); PG8_MMA(0, 0, At, B0); PG8_BAR; PG8_SCHED;
            PG8_LDB(B1, 1, 1); PG8_STAGE(PG8_SB(1, 0), b3, voffB);
            PG8_BAR; PG8_WAIT_L(0); PG8_MMA(0, 1, At, B1); PG8_BAR;
            PG8_LDA(At, 1, 1); PG8_STAGE(PG8_SA(1, 0), a3, voffA);
            PG8_BAR; PG8_WAIT_L(0); PG8_MMA(1, 0, At, B0); PG8_BAR; PG8_SCHED;
            PG8_STAGE(PG8_SB(1, 1), b3 + hstep, voffB);
            PG8_WAIT_V(6); PG8_BAR; PG8_MMA(1, 1, At, B1); PG8_BAR;
            }
        }
        if constexpr (ALIGN_EPI) { if (wr == 0) PG8_BAR; }
        if constexpr (!Epi::AFTER_DRAIN) { E(acc, cur, wr, wc, fr, fq); S.done(cur); }
        if (!has_next) break;
#pragma unroll
        for (int a = 0; a < 2; ++a)
#pragma unroll
            for (int b = 0; b < 2; ++b)
#pragma unroll
                for (int m = 0; m < 4; ++m)
#pragma unroll
                    for (int n = 0; n < 2; ++n) acc[a][b][m][n] = (f32x4){0.f, 0.f, 0.f, 0.f};
        cur = nxt; cA = nA; cB = nB; ++ui;
        if constexpr (ALIGN_EPI) { if (wr == 1) PG8_BAR; }
    }
    PG8_WAIT_V(0);
    if constexpr (!ALIGN_EPI) { if (wr == 0) PG8_BAR; }
    PG8_BAR;
    if constexpr (Epi::AFTER_DRAIN) { E.fused(acc, cur, wr, wc, fr, fq, lds, wid, lane); S.done(cur); }
#undef PG8_SA
#undef PG8_SB
#undef PG8_STAGE
#undef PG8_LDA
#undef PG8_LDB
#undef PG8_MMA
#undef PG8_WAIT_V
#undef PG8_WAIT_L
#undef PG8_BAR
#undef PG8_SCHED
}
}

#ifndef PROBE_DUP
#define PROBE_DUP 0
#endif
#ifndef PG8_SP2
#define PG8_SP2 true
#endif
#ifndef PG8_ALIGN
#define PG8_ALIGN true
#endif

constexpr int NWAVES = 8;
constexpr int N_LAUNCHES = MK_N_LAUNCHES;
constexpr int N_PHASES = 10;
constexpr int D = 1024, MP = 16384, MS = 512, M = MP + MS, TP = 2048, NBP = 8, NBS = 128, TS = 4;
constexpr int NZ = 1536, WA = 512, WB = 512, FF = 4096, NMOD = 6 * D, NROWMOD = NBP + NBS;
constexpr int GB = 32, NS5 = 64, KS5 = 16, HA = 8, HDA = 64;
constexpr float LN_EPS = 1e-5f;
constexpr int NS_OUT = 4, NS_DOWN = 8;
constexpr float ALPHA = 1.189207115002721f;

constexpr size_t O_YP = 0, O_YS = (size_t)MP * D, O_CONVP = O_YS + (size_t)MS * D, O_HP = O_CONVP + (size_t)NBP * 3 * WA, O_SRP = O_HP + (size_t)NBP * WA,
                 O_SIP = O_SRP + (size_t)NBP * GB * NS5, O_CONVS = O_SIP + (size_t)NBP * GB * NS5, O_HS = O_CONVS + (size_t)NBS * 3 * WA, O_SRS = O_HS + (size_t)NBS * WA,
                 O_SIS = O_SRS + (size_t)NBS * GB * NS5, O_END = O_SIS + (size_t)NBS * GB * NS5;

constexpr size_t MiB = 1u << 20;
constexpr size_t WS_CTL = 0, CTL_ZERO_BYTES = 128 * 1024;
constexpr size_t WS_WIN = 1 * MiB, WS_WGLU = 4 * MiB, WS_WOUT = 5 * MiB, WS_W1 = 7 * MiB, WS_W2 = 15 * MiB;
constexpr size_t WS_MOD = 23 * MiB;
constexpr size_t WS_S5C = 27 * MiB;
constexpr size_t WS_STAT = 27 * MiB + 512 * 1024;
constexpr size_t WS_XN = 28 * MiB;
constexpr size_t WS_Z = 61 * MiB;
constexpr size_t WS_YCAT = 111 * MiB;
constexpr size_t WS_G = 144 * MiB;
constexpr size_t WS_U = 61 * MiB;
constexpr size_t WS_T1 = WS_Z;
constexpr size_t WS_T2 = WS_XN;
constexpr size_t WS_TAB = 246 * MiB;
constexpr size_t WS_SLAB = 194 * MiB;
constexpr size_t WS_X1B = 210 * MiB;
constexpr size_t WS_YCS = 244 * MiB;
constexpr size_t WS_END = 252 * MiB;
constexpr size_t TB_BF1 = 0, TB_BF2 = TB_BF1 + 32 * 4 * 64 * 16, TB_TA = TB_BF2 + 32 * 8 * 64 * 16, TB_ZP = TB_TA + 32 * 2 * 2 * 32 * 4, TB_Z16N = TB_ZP + 32 * 17 * 2 * 2 * 32 * 4,
                 TB_RG = TB_Z16N + 32 * 2 * 64 * 4, TB_CB = TB_RG + 8 * 2 * 2 * 4 * 64 * 16, TB_SILU = TB_CB + 128 * 3 * 512 * 2, TB_DG = TB_SILU + 160 * 1024 * 2, TB_W1 = TB_DG + 8 * 16 * 64 * 16, TB_C2 = TB_W1 + 32 * 8 * 4 * 64 * 16, TB_END = TB_C2 + (size_t)32 * 8 * 8 * 64 * 16;
static_assert(WS_SLAB + (size_t)8 * 512 * 1024 * 4 <= WS_X1B && WS_X1B + (size_t)MP * D * 2 <= WS_TAB && WS_TAB + TB_END <= WS_END, "tables");
static_assert(WS_XN + (size_t)M * D * 2 <= WS_Z && WS_Z + (size_t)M * NZ * 2 <= WS_YCAT && WS_YCAT + (size_t)M * D * 2 <= WS_G && WS_G + (size_t)M * WB * 2 <= WS_END && WS_U + (size_t)M * FF * 2 <= WS_SLAB, "d_ws map");
constexpr int SC_ABR = 0, SC_ABI = 2048, SC_BBR = 4096, SC_BBI = 4096 + 32768, SC_RGL = 4096 + 65536, SC_END = SC_RGL + 512;
constexpr int CW_TMO = 0, CW_CODE = 1, CW_SILU = 64, CW_MOD = 1024  , CW_S5B = 128  , CW_BAR = 4096,
              CW_T1 = 8192  , CW_T2 = 12288  , CW_T1S = 16384, CW_T2S = 16448  , CW_XNS = 16512  ;

constexpr int RING_OFF = 0, RING_BYTES = 131072;
constexpr int LDSCTL_OFF = RING_BYTES, MISC_OFF = LDSCTL_OFF + 320;
constexpr int LDS_BYTES = 147456;

#define GAS __attribute__((address_space(1)))
#define LAS __attribute__((address_space(3)))
typedef unsigned short bf16;
typedef unsigned v4u __attribute__((ext_vector_type(4)));
typedef float f32x4 __attribute__((ext_vector_type(4)));
typedef GAS unsigned gu32;
#define RLX_AGENT __ATOMIC_RELAXED, __HIP_MEMORY_SCOPE_AGENT
#define LDS_WAIT() asm volatile("s_waitcnt lgkmcnt(0)" ::: "memory")
#define VM_WAIT() asm volatile("s_waitcnt vmcnt(0)" ::: "memory")
__device__ __forceinline__ unsigned f2bf(float f) { unsigned u = __builtin_bit_cast(unsigned, f); return (u + 0x7fffu + ((u >> 16) & 1u)) >> 16; }
__device__ __forceinline__ unsigned pk2(float lo, float hi) { return f2bf(lo) | (f2bf(hi) << 16); }
__device__ __forceinline__ float bf2f(bf16 v) { return __builtin_bit_cast(float, (unsigned)v << 16); }
__device__ __forceinline__ float gelu_tanh(float x) { const float t = -2.3022082f * (x + 0.044715f * x * x * x); return x * __builtin_amdgcn_rcpf(1.f + __builtin_amdgcn_exp2f(t)); }
__device__ __forceinline__ float sigmoidf_(float x) { return __builtin_amdgcn_rcpf(1.f + __builtin_amdgcn_exp2f(-1.4426950408889634f * x)); }

#define XB_TMO      128
#define XB_XCNT(j)  (256  + 64 * (j))
#define XB_XSUB(j)  (1280 + 64 * (j))
#define XB_XGEN(j)  (2304 + 64 * (j))
#define XB_TOP      3328
#define XB_TOPGEN   3392
#define XCD_BAR_WORDS 3456
#define XB_SPIN_CAP (1u << 18)
__device__ __forceinline__ unsigned xb_ld(unsigned* p)              { return __hip_atomic_load(p, __ATOMIC_RELAXED, __HIP_MEMORY_SCOPE_AGENT); }
__device__ __forceinline__ unsigned xb_add(unsigned* p, unsigned v) { return __hip_atomic_fetch_add(p, v, __ATOMIC_RELAXED, __HIP_MEMORY_SCOPE_AGENT); }
__device__ __forceinline__ unsigned xb_xcc_id() { return (unsigned)__builtin_amdgcn_s_getreg((3 << 11) | 20) & 0xFu; }
#define XB_SPIN(cond, bar) do { unsigned _sp = 0; while (cond) { __builtin_amdgcn_s_sleep(1); \
    if ((++_sp & 255u) == 0u) { if (xb_ld(&(bar)[XB_TMO])) break; if (_sp > XB_SPIN_CAP) { atomicAdd(&(bar)[XB_TMO], 1u); break; } } } } while (0)
struct XcdBarrier { unsigned* bar; unsigned x; volatile LAS unsigned* st; };
__device__ __forceinline__ XcdBarrier xcd_barrier_post(unsigned* bar, volatile LAS unsigned* st) {
    XcdBarrier b; b.bar = bar; b.x = xb_xcc_id(); b.st = st;
    if (threadIdx.x == 0) (void)xb_add(&bar[XB_XCNT(b.x)], 1u);
    return b;
}
__device__ __forceinline__ void xcd_barrier_complete(unsigned* bar, unsigned x, unsigned& nloc, unsigned& nx) {
    const unsigned G = gridDim.x * gridDim.y * gridDim.z;
    unsigned sum, cnt, mine, sp = 0u;
    for (;;) {
        sum = 0u; cnt = 0u; mine = 0u;
#pragma unroll
        for (unsigned j = 0; j < 16; ++j) { const unsigned c = xb_ld(&bar[XB_XCNT(j)]); sum += c; cnt += (c > 0u) ? 1u : 0u; mine = (j == x) ? c : mine; }
        if (sum == G) break;
        __builtin_amdgcn_s_sleep(1);
        if ((++sp & 255u) == 0u) { if (xb_ld(&bar[XB_TMO])) break; if (sp > XB_SPIN_CAP) { atomicAdd(&bar[XB_TMO], 1u); break; } }
    }
    nloc = mine > 0u ? mine : 1u; nx = cnt > 0u ? cnt : 1u;
}
__device__ __forceinline__ void xcd_barrier(const XcdBarrier& b) {
    asm volatile("s_waitcnt vmcnt(0)" ::: "memory");
    __syncthreads();
    if (threadIdx.x == 0) {
        unsigned* bar = b.bar;
        __builtin_amdgcn_s_waitcnt(0);
        unsigned nloc = b.st[0], nx = b.st[1];
        if (nloc == 0u) { xcd_barrier_complete(bar, b.x, nloc, nx); b.st[0] = nloc; b.st[1] = nx; }
        const unsigned old = xb_add(&bar[XB_XSUB(b.x)], 1u);
        const unsigned gen = old / nloc;
        if (old + 1u == (gen + 1u) * nloc) {
            __builtin_amdgcn_fence(__ATOMIC_RELEASE, "agent");
            asm volatile("s_waitcnt vmcnt(0)" ::: "memory");
            const unsigned og = xb_add(&bar[XB_TOP], 1u);
            const unsigned tg = og / nx;
            if (og + 1u == (tg + 1u) * nx) xb_add(&bar[XB_TOPGEN], 1u);
            else XB_SPIN(xb_ld(&bar[XB_TOPGEN]) == tg, bar);
            __builtin_amdgcn_fence(__ATOMIC_ACQUIRE, "agent");
            xb_add(&bar[XB_XGEN(b.x)], 1u);
            asm volatile("s_waitcnt vmcnt(0)" ::: "memory");
        } else {
            XB_SPIN(xb_ld(&bar[XB_XGEN(b.x)]) == gen, bar);
            __builtin_amdgcn_fence(__ATOMIC_ACQUIRE, "agent");
            asm volatile("s_waitcnt vmcnt(0)" ::: "memory");
        }
    }
    __syncthreads();
}

struct Frame {
    LAS unsigned char* lds;
    volatile LAS unsigned* MISC;
    gu32* ctl;
    int tid, lane, wave;
    int vcu, G;
    float* out;
    unsigned char* ws;
};
struct Args { const float* in[37]; float* out; unsigned char* ws; int ph_lo, ph_hi, li, pad; };
__device__ __forceinline__ void refresh(Frame& F) { int t = threadIdx.x; asm volatile("" : "+v"(t)); F.tid = t; F.lane = t & 63; F.wave = __builtin_amdgcn_readfirstlane(t >> 6); }
__device__ __forceinline__ void cnt_arrive(Frame& F, int word) {
    VM_WAIT(); __syncthreads();
    if (F.tid == 0) { __builtin_amdgcn_fence(__ATOMIC_RELEASE, "agent"); VM_WAIT(); (void)__hip_atomic_fetch_add((unsigned*)(F.ctl + word), 1u, RLX_AGENT); }
}
__device__ __forceinline__ void cnt_arrive_wt(Frame& F, int word) {
    VM_WAIT(); __syncthreads();
    if (F.tid == 0) (void)__hip_atomic_fetch_add((unsigned*)(F.ctl + word), 1u, RLX_AGENT);
}
__device__ __forceinline__ void cnt_wait_ge(Frame& F, int word, unsigned target) {
    if (F.tid == 0) { unsigned sp = 0; while (__hip_atomic_load((unsigned*)(F.ctl + word), RLX_AGENT) < target && ++sp < (1u << 22)) __builtin_amdgcn_s_sleep(2);
        __builtin_amdgcn_fence(__ATOMIC_ACQUIRE, "agent"); VM_WAIT(); }
    __syncthreads();
}
__device__ __forceinline__ float wave_sum(float v) {
#pragma unroll
    for (int o = 1; o < 64; o <<= 1) v += __shfl_xor(v, o);
    return v;
}
enum { I_XP = 0, I_XS, I_SCONV, I_SH, I_SSR, I_SSI, I_CP, I_CS, I_ADAW, I_ADAB, I_INPROJ, I_CONVW, I_CONVB, I_RGWR, I_RGBR, I_RGWI, I_RGBI, I_RGLAM,
       I_S5ARE, I_S5AIM, I_S5LOGDT, I_S5BRE, I_S5BIM, I_S5CRE, I_S5CIM, I_S5D, I_GLUW, I_GLUB, I_OUTPROJ, I_LN1G, I_LN1B, I_W1, I_B1, I_W2, I_B2, I_LN2G, I_LN2B };

typedef float f32x2m __attribute__((ext_vector_type(2)));
typedef __bf16 bf16x2m __attribute__((ext_vector_type(2)));
__device__ __forceinline__ unsigned pkbf0(float a, float b) { const f32x2m v = {a, b}; const bf16x2m r = __builtin_convertvector(v, bf16x2m); return __builtin_bit_cast(unsigned, r); }
typedef short bf16x8m __attribute__((ext_vector_type(8)));
typedef float f32x16m __attribute__((ext_vector_type(16)));
__device__ __forceinline__ void p0_transpose_item(const float* W, int K, int N, bf16* WT, LAS float* scr, int item, int lane) {
    const int nblk = N / 32, kb = item / nblk, nb = item % nblk, k0 = 64 * kb, n0 = 32 * nb;
#pragma unroll 8
    for (int i = 0; i < 32; ++i) { const int kk = 2 * i + (lane >> 5); scr[kk * 33 + (lane & 31)] = W[(size_t)(k0 + kk) * N + n0 + (lane & 31)]; }
    LDS_WAIT(); asm volatile("" ::: "memory");
    const int c = lane & 7;
#pragma unroll
    for (int j = 0; j < 4; ++j) { const int n = (lane >> 3) + 8 * j; const LAS float* s = scr + (8 * c) * 33 + n;
        v4u o; o.x = pk2(s[0 * 33], s[1 * 33]); o.y = pk2(s[2 * 33], s[3 * 33]); o.z = pk2(s[4 * 33], s[5 * 33]); o.w = pk2(s[6 * 33], s[7 * 33]);
        *(GAS v4u*)(WT + (size_t)(n0 + n) * K + k0 + 8 * c) = o; }
    LDS_WAIT(); asm volatile("" ::: "memory");
}

constexpr int XI_IN = (D / 64) * (NZ / 32), XI_GL = (WB / 64) * (WB / 32), XI_OU = (D / 64) * (D / 32), XI_1 = (D / 64) * (FF / 32), XI_2 = (FF / 64) * (D / 32);
constexpr int XO_OU = XI_IN + XI_GL, XO_1 = XO_OU + XI_OU, XO_2 = XO_1 + XI_1, XO_END = XO_2 + XI_2;
__device__ __forceinline__ void xpose_item(Frame& F, const Args& A, LAS float* scr, int r) {
    if (r < XI_IN) { p0_transpose_item(A.in[I_INPROJ], D, NZ, (bf16*)(F.ws + WS_WIN), scr, r, F.lane); return; } r -= XI_IN;
    if (r < XI_GL) { p0_transpose_item(A.in[I_GLUW], WB, WB, (bf16*)(F.ws + WS_WGLU), scr, r, F.lane); return; } r -= XI_GL;
    if (r < XI_OU) { p0_transpose_item(A.in[I_OUTPROJ], D, D, (bf16*)(F.ws + WS_WOUT), scr, r, F.lane); return; } r -= XI_OU;
    if (r < XI_1) { p0_transpose_item(A.in[I_W1], D, FF, (bf16*)(F.ws + WS_W1), scr, r, F.lane); return; } r -= XI_1;
    p0_transpose_item(A.in[I_W2], FF, D, (bf16*)(F.ws + WS_W2), scr, r, F.lane);
}
__device__ __forceinline__ void xpose_range(Frame& F, const Args& A, int lo, int hi, int vlo) {
    refresh(F);
    if (F.vcu < vlo) return;
    LAS float* scr = (LAS float*)(F.lds + RING_OFF + F.wave * 16384);
    const int gw = F.wave * (F.G - vlo) + (F.vcu - vlo), ngw = (F.G - vlo) * NWAVES;
    for (int it = lo + gw; it < hi; it += ngw) xpose_item(F, A, scr, it);
}
__device__ __forceinline__ void xpose_range_b(Frame& F, const Args& A, int lo, int hi, int blo) {
    refresh(F);
    LAS float* scr = (LAS float*)(F.lds + RING_OFF + F.wave * 16384);
    const int gw = F.wave * (F.G - blo) + ((int)blockIdx.x - blo), ngw = (F.G - blo) * NWAVES;
    for (int it = lo + gw; it < hi; it += ngw) xpose_item(F, A, scr, it);
}
#ifndef PROBE_P0PART
#define PROBE_P0PART 7
#endif
__device__ __forceinline__ void p0_prologue(Frame& F, const Args& A, int rep = 0) {
    refresh(F);
    const int pmask = rep ? PROBE_P0PART : 7;
    LAS float* scr = (LAS float*)(F.lds + RING_OFF + F.wave * 16384);
    const int gw = F.wave * F.G + F.vcu, NGW = F.G * NWAVES;
    {
        bf16* ST = (bf16*)(F.ws + WS_TAB + TB_SILU);
        for (int ch = F.vcu * NWAVES * 64 + F.tid; ch < 160 * 1024 / 8; ch += F.G * NWAVES * 64) { const int row = ch >> 7, k = (ch & 127) * 8; v4u o = (v4u){0u, 0u, 0u, 0u};
            if (row < NROWMOD) { const float* cp = (row < NBP ? A.in[I_CP] + (size_t)row * D : A.in[I_CS] + (size_t)(row - NBP) * D) + k; const f32x4 c0 = *(const f32x4*)cp, c1 = *(const f32x4*)(cp + 4);
                o.x = pk2(c0[0] * sigmoidf_(c0[0]), c0[1] * sigmoidf_(c0[1])); o.y = pk2(c0[2] * sigmoidf_(c0[2]), c0[3] * sigmoidf_(c0[3]));
                o.z = pk2(c1[0] * sigmoidf_(c1[0]), c1[1] * sigmoidf_(c1[1])); o.w = pk2(c1[2] * sigmoidf_(c1[2]), c1[3] * sigmoidf_(c1[3])); }
            pg8::st16_wt(ST + (size_t)ch * 8, o); }
        cnt_arrive_wt(F, CW_SILU);
    }
    constexpr int I_IN = XI_IN, I_GL = XI_GL;
    constexpr int I_S5 = GB, I_RG = WA / 64, I_RGT = HA * 2 * 2 * 4, I_CB = NBS * 3 * WA / 512, I_DG = HA * 16, I_S5J = GB * 8;
    constexpr int NITEMS = I_IN + I_GL + I_S5 + I_RG + I_RGT + I_CB + I_DG + I_S5J;
    float* sc = (float*)(F.ws + WS_S5C);
    constexpr int VW0 = 2 * D / 32;
    for (int it = F.vcu >= VW0 ? F.wave * (F.G - VW0) + (F.vcu - VW0) : NITEMS; it < NITEMS; it += (F.G - VW0) * NWAVES) {
        int r = it;
        if (!(pmask & 1) && it < I_IN + I_GL) continue;
        if (!(pmask & 2) && it >= I_IN + I_GL) continue;
        if (r < I_IN + I_GL) { xpose_item(F, A, scr, r); continue; } r -= I_IN + I_GL;
        if (r < I_S5) {
            const int g = r, n = F.lane, gn = g * NS5 + n;
            const double dt = exp((double)A.in[I_S5LOGDT][g]), ar = (double)A.in[I_S5ARE][gn], ai = (double)A.in[I_S5AIM][gn];
            const double mag = exp(dt * ar), abr = mag * cos(dt * ai), abi = mag * sin(dt * ai), den = ar * ar + ai * ai, nr = abr - 1.0;
            const double qr = (nr * ar + abi * ai) / den, qi = (abi * ar - nr * ai) / den;
            sc[SC_ABR + gn] = (float)abr; sc[SC_ABI + gn] = (float)abi;
            unsigned char* tab = F.ws + WS_TAB;
            float* TA = (float*)(tab + TB_TA); float* ZP = (float*)(tab + TB_ZP); float* Z16N = (float*)(tab + TB_Z16N);
            const int sh = n >> 5, v = n & 31, hh = (v >> 2) & 1, ii = (v & 3) + 4 * (v >> 3);
            double bbr_[KS5], bbi_[KS5];
            for (int k = 0; k < KS5; ++k) { const double br = (double)A.in[I_S5BRE][gn * KS5 + k], bi = (double)A.in[I_S5BIM][gn * KS5 + k];
                bbr_[k] = qr * br - qi * bi; bbi_[k] = qr * bi + qi * br;
                sc[SC_BBR + gn * KS5 + k] = (float)bbr_[k]; sc[SC_BBI + gn * KS5 + k] = (float)bbi_[k]; }
            { double pr = abr, pi = abi; for (int e = 0; e < 2; ++e) { const double t = pr * pr - pi * pi; pi = 2.0 * pr * pi; pr = t; }
              TA[((g * 2 + hh) * 2 + 0) * 32 + sh * 16 + ii] = (float)pr; TA[((g * 2 + hh) * 2 + 1) * 32 + sh * 16 + ii] = (float)pi; }
            const double mg8 = exp(8.0 * dt * ar), z1r = mg8 * cos(8.0 * dt * ai), z1i = mg8 * sin(8.0 * dt * ai); double pzr = 1.0, pzi = 0.0;
            for (int e = 0; e <= 16; ++e) { const float zr = (float)pzr, zi = (float)pzi; { const double nr2 = pzr * z1r - pzi * z1i, ni2 = pzr * z1i + pzi * z1r; pzr = nr2; pzi = ni2; }
                ZP[(((g * 17 + e) * 2 + hh) * 2 + 0) * 32 + sh * 16 + ii] = zr; ZP[(((g * 17 + e) * 2 + hh) * 2 + 1) * 32 + sh * 16 + ii] = zi;
                if (e == 16) { Z16N[(g * 2 + 0) * 64 + n] = zr; Z16N[(g * 2 + 1) * 64 + n] = zi; } }
            continue; } r -= I_S5;
        if (r < I_RG) { const int c = r * 64 + F.lane; const double lam = (double)A.in[I_RGLAM][c];
          sc[SC_RGL + c] = (float)(-8.0 * log1p(exp(-lam)) * 1.4426950408889634); continue; } r -= I_RG;
        if (r >= I_RGT + I_CB + I_DG) { r -= I_RGT + I_CB + I_DG;
            const int g = r >> 3, j = r & 7, n = F.lane, gn = g * NS5 + n, sh = n >> 5;
            const double dt = exp((double)A.in[I_S5LOGDT][g]), ar = (double)A.in[I_S5ARE][gn], ai = (double)A.in[I_S5AIM][gn];
            const double mag = exp(dt * ar), abr = mag * cos(dt * ai), abi = mag * sin(dt * ai), den = ar * ar + ai * ai, nr0 = abr - 1.0;
            const double qr = (nr0 * ar + abi * ai) / den, qi = (abi * ar - nr0 * ai) / den;
            const double mgp = exp((double)(j + 1) * dt * ar), anp = (double)(j + 1) * dt * ai, pr = mgp * cos(anp), pi = mgp * sin(anp);
            const double pm2 = pr * pr + pi * pi, nr_ = pr / pm2, ni_ = -pi / pm2;
            bf16* W1T = (bf16*)(F.ws + WS_TAB + TB_W1); bf16* C2T = (bf16*)(F.ws + WS_TAB + TB_C2);
            const int s2 = (n >> 4) & 1, jj2 = 4 * ((n >> 3) & 1) + (n & 3), hk2 = (n >> 2) & 1;
#pragma unroll 4
            for (int k = 0; k < KS5; ++k) { const double br = (double)A.in[I_S5BRE][gn * KS5 + k], bi = (double)A.in[I_S5BIM][gn * KS5 + k];
                const double bbr = qr * br - qi * bi, bbi = qr * bi + qi * br;
                const float wr = (float)(nr_ * bbr - ni_ * bbi), wi = (float)(nr_ * bbi + ni_ * bbr);
                const int lp = (n & 31) + 32 * (k >> 3), jj = k & 7;
                W1T[(size_t)(((g * 8 + j) * 4 + 0 + sh) * 64 + lp) * 8 + jj] = (bf16)f2bf(wr); W1T[(size_t)(((g * 8 + j) * 4 + 2 + sh) * 64 + lp) * 8 + jj] = (bf16)f2bf(wi); }
#pragma unroll 4
            for (int ch = 0; ch < KS5; ++ch) { const int hr_ = ch >> 3, i8 = ch & 7, R = (i8 & 3) + 8 * (i8 >> 2) + 4 * hr_, lp = R + 32 * hk2;
                const double cr = (double)A.in[I_S5CRE][(size_t)(g * KS5 + ch) * NS5 + n], ci = (double)A.in[I_S5CIM][(size_t)(g * KS5 + ch) * NS5 + n];
                const float c2r = (float)(cr * pr - ci * pi), c2i = (float)(cr * pi + ci * pr);
                C2T[(size_t)(((g * 8 + j) * 8 + (0 + sh) * 2 + s2) * 64 + lp) * 8 + jj2] = (bf16)f2bf(c2r); C2T[(size_t)(((g * 8 + j) * 8 + (2 + sh) * 2 + s2) * 64 + lp) * 8 + jj2] = (bf16)f2bf(-c2i); }
            for (int z = 0; z < 4; ++z) { const int cidx = n + 64 * z, ks = cidx >> 5, r16 = cidx & 31, lp = 16 + (r16 & 15) + 32 * (r16 >> 4);
                *(v4u*)(C2T + (size_t)(((g * 8 + j) * 8 + ks) * 64 + lp) * 8) = (v4u){0u, 0u, 0u, 0u}; }
            continue; }
        if (r >= I_RGT + I_CB) { r -= I_RGT + I_CB;
            const int k = r & 3, sp = (r >> 2) & 1, tau = (r >> 3) & 1, hd = r >> 4, R = F.lane & 31, hk = F.lane >> 5;
            unsigned wv = 0u; if ((R >> 3) == 2 * sp + hk) wv = f2bf(A.in[I_CONVW][k * WA + hd * 64 + 32 * tau + R]);
            const int jj = R & 7; v4u o = (v4u){0u, 0u, 0u, 0u}; const unsigned word = (jj & 1) ? (wv << 16) : wv;
            if ((jj >> 1) == 0) o.x = word; else if ((jj >> 1) == 1) o.y = word; else if ((jj >> 1) == 2) o.z = word; else o.w = word;
            *(v4u*)(F.ws + WS_TAB + TB_DG + (size_t)(r * 64 + F.lane) * 16) = o; continue; }
        if (r >= I_RGT) { r -= I_RGT;
            const float* src = A.in[I_SCONV] + (size_t)r * 512 + F.lane * 8; const f32x4 a0 = *(const f32x4*)src, a1 = *(const f32x4*)(src + 4);
            v4u o; o.x = pk2(a0[0], a0[1]); o.y = pk2(a0[2], a0[3]); o.z = pk2(a1[0], a1[1]); o.w = pk2(a1[2], a1[3]);
            *(v4u*)(F.ws + WS_TAB + TB_CB + ((size_t)r * 512 + F.lane * 8) * 2) = o; continue; }
        {
            const int ks = r & 3, gate = (r >> 2) & 1, jh = (r >> 3) & 1, hd = r >> 4;
            const int R = F.lane & 31, hk = F.lane >> 5;
            const float* W = A.in[gate ? I_RGWI : I_RGWR] + (size_t)(hd * 64 + 32 * (ks >> 1) + 16 * (ks & 1) + 4 * hk) * 64 + 32 * jh + R;
            v4u o; o.x = pk2(W[0], W[64]); o.y = pk2(W[128], W[192]); o.z = pk2(W[8 * 64], W[9 * 64]); o.w = pk2(W[10 * 64], W[11 * 64]);
            *(v4u*)(F.ws + WS_TAB + TB_RG + (size_t)(r * 64 + F.lane) * 16) = o;
        }
    }
    __syncthreads();
    if (F.tid == 0) {
        unsigned sp = 0; while (__hip_atomic_load((unsigned*)(F.ctl + CW_SILU), RLX_AGENT) < (unsigned)F.G && ++sp < (1u << 22)) __builtin_amdgcn_s_sleep(2);
        __builtin_amdgcn_fence(__ATOMIC_ACQUIRE, "agent"); VM_WAIT(); }
    __syncthreads();
    LAS float* RED = (LAS float*)(F.lds + RING_OFF);
    float* mod = (float*)(F.ws + WS_MOD);
    const int r32 = F.lane & 31, hh = F.lane >> 5;
    const bf16* ST = (const bf16*)(F.ws + WS_TAB + TB_SILU);
#pragma unroll 1
    for (int it = F.vcu; it < ((pmask & 4) ? NMOD / 32 : 0); it += F.G) {
        const int n0 = it * 32;
        f32x16m acc[5];
#pragma unroll
        for (int rt = 0; rt < 5; ++rt)
#pragma unroll
            for (int i = 0; i < 16; ++i) acc[rt][i] = 0.f;
#pragma unroll 1
        for (int kb = 0; kb < 4; ++kb) {
            float bw[2][8]; v4u af[2][5];
#pragma unroll
            for (int ks = 0; ks < 2; ++ks) { const int k0 = F.wave * 128 + (kb * 2 + ks) * 16 + 8 * hh;
                const float* wp = A.in[I_ADAW] + (size_t)k0 * NMOD + n0 + r32;
#pragma unroll
                for (int j = 0; j < 8; ++j) bw[ks][j] = wp[(size_t)j * NMOD];
#pragma unroll
                for (int rt = 0; rt < 5; ++rt) af[ks][rt] = *(const v4u*)(ST + (size_t)(32 * rt + r32) * D + k0); }
#pragma unroll
            for (int ks = 0; ks < 2; ++ks) {
                v4u bp; bp.x = pkbf0(bw[ks][0], bw[ks][1]); bp.y = pkbf0(bw[ks][2], bw[ks][3]); bp.z = pkbf0(bw[ks][4], bw[ks][5]); bp.w = pkbf0(bw[ks][6], bw[ks][7]);
                const bf16x8m bfr = __builtin_bit_cast(bf16x8m, bp);
#pragma unroll
                for (int rt = 0; rt < 5; ++rt) acc[rt] = __builtin_amdgcn_mfma_f32_32x32x16_bf16(__builtin_bit_cast(bf16x8m, af[ks][rt]), bfr, acc[rt], 0, 0, 0); }
        }
#pragma unroll
        for (int half = 4; half >= 1; half >>= 1) {
            if (F.wave >= half && F.wave < 2 * half) {
#pragma unroll
                for (int rt = 0; rt < 5; ++rt)
#pragma unroll
                    for (int i = 0; i < 16; ++i) RED[(F.wave - half) * 5120 + (rt * 16 + i) * 64 + F.lane] = acc[rt][i]; }
            __syncthreads();
            if (F.wave < half) {
#pragma unroll
                for (int rt = 0; rt < 5; ++rt)
#pragma unroll
                    for (int i = 0; i < 16; ++i) acc[rt][i] += RED[F.wave * 5120 + (rt * 16 + i) * 64 + F.lane]; }
            __syncthreads();
        }
        if (F.wave == 0) { const float bb = A.in[I_ADAB][n0 + r32];
#pragma unroll
            for (int rt = 0; rt < 5; ++rt)
#pragma unroll
                for (int i = 0; i < 16; ++i) { const int row = 32 * rt + (i & 3) + 8 * (i >> 2) + 4 * hh; if (row < NROWMOD) __hip_atomic_store(mod + (size_t)row * NMOD + n0 + r32, acc[rt][i] + bb, RLX_AGENT); } }
        if (n0 < 2 * D) cnt_arrive_wt(F, CW_MOD);
    }
}

__device__ __forceinline__ int mod_row(int m) { return m < MP ? (m >> 11) : NBP + ((m - MP) >> 2); }
__device__ __forceinline__ const float* x_row(const Args& A, int m) { return m < MP ? A.in[I_XP] + (size_t)m * D : A.in[I_XS] + (size_t)(m - MP) * D; }

__device__ __forceinline__ void p1_modulate(Frame& F, const Args& A, int rep = 0) {
    refresh(F);
    cnt_wait_ge(F, CW_MOD, (unsigned)(2 * D / 32));
    const int gw = F.vcu * NWAVES + F.wave, NGW = F.G * NWAVES;
    const float* mod = (const float*)(F.ws + WS_MOD); bf16* XN = (bf16*)(F.ws + WS_XN);
    for (int m = gw; m < M; m += NGW) {
        const float* xr = x_row(A, m) + 8 * F.lane; const float* mr = mod + (size_t)mod_row(m) * NMOD + 8 * F.lane;
#pragma unroll
        for (int j = 0; j < 2; ++j) { const f32x4 v0 = *(const f32x4*)(xr + 512 * j), v1 = *(const f32x4*)(xr + 512 * j + 4);
            const f32x4 a0 = *(const f32x4*)(mr + 512 * j), a1 = *(const f32x4*)(mr + 512 * j + 4), s0 = *(const f32x4*)(mr + D + 512 * j), s1 = *(const f32x4*)(mr + D + 512 * j + 4);
            const f32x4 h0 = v0 * (s0 + 1.f) + a0, h1 = v1 * (s1 + 1.f) + a1;
            v4u o; o.x = pk2(h0.x, h0.y); o.y = pk2(h0.z, h0.w); o.z = pk2(h1.x, h1.y); o.w = pk2(h1.z, h1.w);
            *(v4u*)(XN + (size_t)m * D + 512 * j + 8 * F.lane) = o; }
    }
}

__device__ __forceinline__ void unpack8(const v4u w, f32x4& a, f32x4& b) { a = (f32x4){pg8::bf_lo(w.x), pg8::bf_hi(w.x), pg8::bf_lo(w.y), pg8::bf_hi(w.y)}; b = (f32x4){pg8::bf_lo(w.z), pg8::bf_hi(w.z), pg8::bf_lo(w.w), pg8::bf_hi(w.w)}; }
__device__ __forceinline__ v4u pack8f(const f32x4 a, const f32x4 b) { v4u o; o.x = pk2(a.x, a.y); o.y = pk2(a.z, a.w); o.z = pk2(b.x, b.y); o.w = pk2(b.z, b.w); return o; }
template <bool SECOND>
__device__ __forceinline__ void ln_rows(Frame& F, const Args& A, int row_lo, int row_hi, int gw, int NGW) {
    refresh(F);
    const float* mod = (const float*)(F.ws + WS_MOD); bf16* XN = (bf16*)(F.ws + WS_XN);
    const float* gg = A.in[SECOND ? I_LN2G : I_LN1G] + 8 * F.lane; const float* gb = A.in[SECOND ? I_LN2B : I_LN1B] + 8 * F.lane;
    for (int m = row_lo + gw; m < row_hi; m += NGW) {
        float* xr = F.out + (size_t)m * D + 8 * F.lane;
        f32x4 v[2][2]; float s = 0.f;
        if (m >= MP) {
            const float* mr = mod + (size_t)mod_row(m) * NMOD + (SECOND ? 5 : 2) * D + 8 * F.lane;
            const float* bs = SECOND ? xr : A.in[I_XS] + (size_t)(m - MP) * D + 8 * F.lane;
            const float* sl = (const float*)(F.ws + WS_SLAB) + (size_t)(m - MP) * D + 8 * F.lane;
#pragma unroll
            for (int j = 0; j < 2; ++j)
#pragma unroll
                for (int h = 0; h < 2; ++h) { const int o = 512 * j + 4 * h; f32x4 a = SECOND ? *(const f32x4*)(A.in[I_B2] + 8 * F.lane + o) : (f32x4){0.f, 0.f, 0.f, 0.f};
#pragma unroll
                    for (int ks = 0; ks < (SECOND ? NS_DOWN : NS_OUT); ++ks) a += *(const f32x4*)(sl + (size_t)ks * (512 * 1024) + o);
                    v[j][h] = *(const f32x4*)(bs + o) * ALPHA + *(const f32x4*)(mr + o) * a; }
        } else {
            const bf16* tr = (const bf16*)(F.ws + (SECOND ? WS_T2 : WS_T1)) + (size_t)m * D + 8 * F.lane;
#pragma unroll
            for (int j = 0; j < 2; ++j) unpack8(*(const v4u*)(tr + 512 * j), v[j][0], v[j][1]);
        }
#pragma unroll
        for (int j = 0; j < 2; ++j)
#pragma unroll
            for (int h = 0; h < 2; ++h) s += (v[j][h].x + v[j][h].y) + (v[j][h].z + v[j][h].w);
        const float mean = wave_sum(s) * (1.f / D); float s2 = 0.f;
#pragma unroll
        for (int j = 0; j < 2; ++j)
#pragma unroll
            for (int h = 0; h < 2; ++h) { v[j][h] = v[j][h] - mean; s2 += (v[j][h].x * v[j][h].x + v[j][h].y * v[j][h].y) + (v[j][h].z * v[j][h].z + v[j][h].w * v[j][h].w); }
        const float rstd = 1.f / sqrtf(wave_sum(s2) * (1.f / D) + LN_EPS);
#pragma unroll
        for (int j = 0; j < 2; ++j)
#pragma unroll
            for (int h = 0; h < 2; ++h) v[j][h] = v[j][h] * rstd * *(const f32x4*)(gg + 512 * j + 4 * h) + *(const f32x4*)(gb + 512 * j + 4 * h);
        if (SECOND || m >= MP) {
#pragma unroll
            for (int j = 0; j < 2; ++j) { *(f32x4*)(xr + 512 * j) = v[j][0]; *(f32x4*)(xr + 512 * j + 4) = v[j][1]; }
        } else {
            bf16* x1 = (bf16*)(F.ws + WS_X1B) + (size_t)m * D + 8 * F.lane;
#pragma unroll
            for (int j = 0; j < 2; ++j) *(v4u*)(x1 + 512 * j) = pack8f(v[j][0], v[j][1]);
        }
        if (!SECOND) {
            const float* mr = mod + (size_t)mod_row(m) * NMOD + 8 * F.lane;
#pragma unroll
            for (int j = 0; j < 2; ++j) { const int o = 512 * j;
                const f32x4 h0 = v[j][0] * (*(const f32x4*)(mr + 4 * D + o) + 1.f) + *(const f32x4*)(mr + 3 * D + o), h1 = v[j][1] * (*(const f32x4*)(mr + 4 * D + o + 4) + 1.f) + *(const f32x4*)(mr + 3 * D + o + 4);
                pg8::st16_wt(XN + (size_t)m * D + o + 8 * F.lane, pack8f(h0, h1)); }
        }
    }
}

__device__ __forceinline__ void rg_item_ref(Frame& F, const Args& A, bool prompt, int b, int hd, LAS float* scr) {
    const int j = F.lane, c = hd * HDA + j;
    const bf16* Z = (const bf16*)(F.ws + WS_Z); bf16* Y = (bf16*)(F.ws + WS_YCAT); const float* sc = (const float*)(F.ws + WS_S5C);
    float wr[64], wi[64];
#pragma unroll
    for (int i = 0; i < 64; ++i) { wr[i] = A.in[I_RGWR][(size_t)(hd * 64 + i) * 64 + j]; wi[i] = A.in[I_RGWI][(size_t)(hd * 64 + i) * 64 + j]; }
    const float br = A.in[I_RGBR][c], bi = A.in[I_RGBI][c], L2 = sc[SC_RGL + c];
    const float w0 = A.in[I_CONVW][c], w1 = A.in[I_CONVW][WA + c], w2 = A.in[I_CONVW][2 * WA + c], w3 = A.in[I_CONVW][3 * WA + c], cb = A.in[I_CONVB][c];
    int T, m0; float x3, x2, x1, h;
    if (prompt) { T = TP; m0 = b * TP; x3 = 0.f; x2 = 0.f; x1 = 0.f; h = 0.f; }
    else { T = TS; m0 = MP + b * TS; x3 = A.in[I_SCONV][(size_t)(b * 3 + 0) * WA + c]; x2 = A.in[I_SCONV][(size_t)(b * 3 + 1) * WA + c]; x1 = A.in[I_SCONV][(size_t)(b * 3 + 2) * WA + c]; h = A.in[I_SH][(size_t)b * WA + c]; }
    for (int t = 0; t < T; ++t) {
        const size_t m = (size_t)(m0 + t);
        const float xa = bf2f(Z[m * NZ + WA + c]), gate = bf2f(Z[m * NZ + c]);
        const float xc = cb + w0 * x3 + w1 * x2 + w2 * x1 + w3 * xa; x3 = x2; x2 = x1; x1 = xa;
        scr[j] = xc; LDS_WAIT(); asm volatile("" ::: "memory");
        float rp = br, gp = bi;
#pragma unroll
        for (int i4 = 0; i4 < 16; ++i4) { const f32x4 v = *(const LAS f32x4*)(scr + 4 * i4);
            rp += v[0] * wr[4 * i4] + v[1] * wr[4 * i4 + 1] + v[2] * wr[4 * i4 + 2] + v[3] * wr[4 * i4 + 3];
            gp += v[0] * wi[4 * i4] + v[1] * wi[4 * i4 + 1] + v[2] * wi[4 * i4 + 2] + v[3] * wi[4 * i4 + 3]; }
        LDS_WAIT(); asm volatile("" ::: "memory");
        const float r = sigmoidf_(rp), gi = sigmoidf_(gp);
        const float a = exp2f(r * L2);
        float mult = sqrtf(fmaxf(1.f - a * a, 0.f));
        if (prompt && t == 0) mult = 1.f;
        h = a * h + mult * gi * xc;
        Y[m * D + c] = (bf16)f2bf(gelu_tanh(gate) * h);
    }
    float* oc = F.out + (prompt ? O_CONVP : O_CONVS); float* oh = F.out + (prompt ? O_HP : O_HS);
    oc[(size_t)(b * 3 + 0) * WA + c] = x3; oc[(size_t)(b * 3 + 1) * WA + c] = x2; oc[(size_t)(b * 3 + 2) * WA + c] = x1;
    oh[(size_t)b * WA + c] = h;
}
__device__ __forceinline__ void s5_item_ref(Frame& F, const Args& A, bool prompt, int b, int g, LAS float* scr) {
    const int n = F.lane, gn = g * NS5 + n, k = F.lane & 15, part = F.lane >> 4;
    const bf16* Z = (const bf16*)(F.ws + WS_Z); bf16* Gy = (bf16*)(F.ws + WS_G); const float* sc = (const float*)(F.ws + WS_S5C);
    float bbr[16], bbi[16], cre[16], cim[16];
#pragma unroll
    for (int i = 0; i < 16; ++i) { bbr[i] = sc[SC_BBR + gn * KS5 + i]; bbi[i] = sc[SC_BBI + gn * KS5 + i];
        cre[i] = A.in[I_S5CRE][(size_t)(g * KS5 + k) * NS5 + part * 16 + i]; cim[i] = A.in[I_S5CIM][(size_t)(g * KS5 + k) * NS5 + part * 16 + i]; }
    const float abr = sc[SC_ABR + gn], abi = sc[SC_ABI + gn], dk = A.in[I_S5D][g * KS5 + k];
    int T, m0; float hr, hi;
    if (prompt) { T = TP; m0 = b * TP; hr = 0.f; hi = 0.f; }
    else { T = TS; m0 = MP + b * TS; hr = A.in[I_SSR][(size_t)(b * GB + g) * NS5 + n]; hi = A.in[I_SSI][(size_t)(b * GB + g) * NS5 + n]; }
    for (int t = 0; t < T; ++t) {
        const size_t m = (size_t)(m0 + t);
        const bf16* zr = Z + m * NZ + 2 * WA + g * KS5;
        const v4u u0 = *(const v4u*)zr, u1 = *(const v4u*)(zr + 8);
        float u[16];
        u[0] = pg8::bf_lo(u0.x); u[1] = pg8::bf_hi(u0.x); u[2] = pg8::bf_lo(u0.y); u[3] = pg8::bf_hi(u0.y); u[4] = pg8::bf_lo(u0.z); u[5] = pg8::bf_hi(u0.z); u[6] = pg8::bf_lo(u0.w); u[7] = pg8::bf_hi(u0.w);
        u[8] = pg8::bf_lo(u1.x); u[9] = pg8::bf_hi(u1.x); u[10] = pg8::bf_lo(u1.y); u[11] = pg8::bf_hi(u1.y); u[12] = pg8::bf_lo(u1.z); u[13] = pg8::bf_hi(u1.z); u[14] = pg8::bf_lo(u1.w); u[15] = pg8::bf_hi(u1.w);
        float bur = 0.f, bui = 0.f;
#pragma unroll
        for (int i = 0; i < 16; ++i) { bur += bbr[i] * u[i]; bui += bbi[i] * u[i]; }
        const float nhr = abr * hr - abi * hi + bur, nhi = abr * hi + abi * hr + bui; hr = nhr; hi = nhi;
        scr[n] = hr; scr[64 + n] = hi; LDS_WAIT(); asm volatile("" ::: "memory");
        float p = 0.f;
#pragma unroll
        for (int i4 = 0; i4 < 4; ++i4) { const f32x4 vr = *(const LAS f32x4*)(scr + part * 16 + 4 * i4), vi = *(const LAS f32x4*)(scr + 64 + part * 16 + 4 * i4);
#pragma unroll
            for (int e = 0; e < 4; ++e) p += vr[e] * cre[4 * i4 + e] - vi[e] * cim[4 * i4 + e]; }
        LDS_WAIT(); asm volatile("" ::: "memory");
        p += __shfl_xor(p, 16); p += __shfl_xor(p, 32);
        const float uk = bf2f(zr[k]);
        if (F.lane < 16) Gy[m * WB + g * KS5 + k] = (bf16)f2bf(gelu_tanh(p + dk * uk));
    }
    float* osr = F.out + (prompt ? O_SRP : O_SRS); float* osi = F.out + (prompt ? O_SIP : O_SIS);
    osr[(size_t)(b * GB + g) * NS5 + n] = hr; osi[(size_t)(b * GB + g) * NS5 + n] = hi;
}

typedef short bf16x8v __attribute__((ext_vector_type(8)));
typedef float f32x16 __attribute__((ext_vector_type(16)));
typedef float f32x2v __attribute__((ext_vector_type(2)));
typedef __bf16 bf16x2v __attribute__((ext_vector_type(2)));
#define MFMA32(a, b, c) __builtin_amdgcn_mfma_f32_32x32x16_bf16((a), (b), (c), 0, 0, 0)
__device__ __forceinline__ unsigned pkbf(float a, float b) { const f32x2v v = {a, b}; const bf16x2v r = __builtin_convertvector(v, bf16x2v); return __builtin_bit_cast(unsigned, r); }
template <int CTRL> __device__ __forceinline__ float dppf(float old, float v) { return __builtin_bit_cast(float, __builtin_amdgcn_update_dpp(__builtin_bit_cast(int, old), __builtin_bit_cast(int, v), CTRL, 0xF, 0xF, false)); }
__device__ __forceinline__ f32x16 ld16(const float* p) { f32x16 r;
#pragma unroll
    for (int i = 0; i < 4; ++i) { const f32x4 v = *(const f32x4*)(p + 4 * i); r[4 * i] = v[0]; r[4 * i + 1] = v[1]; r[4 * i + 2] = v[2]; r[4 * i + 3] = v[3]; }
    return r; }
__device__ __forceinline__ f32x16 ld16l(const LAS float* p) { f32x16 r;
#pragma unroll
    for (int i = 0; i < 4; ++i) { const f32x4 v = *(const LAS f32x4*)(p + 4 * i); r[4 * i] = v[0]; r[4 * i + 1] = v[1]; r[4 * i + 2] = v[2]; r[4 * i + 3] = v[3]; }
    return r; }
__device__ __forceinline__ bf16x8v pack8(const f32x16& x, int s) { v4u p; p.x = pkbf(x[8 * s], x[8 * s + 1]); p.y = pkbf(x[8 * s + 2], x[8 * s + 3]); p.z = pkbf(x[8 * s + 4], x[8 * s + 5]); p.w = pkbf(x[8 * s + 6], x[8 * s + 7]); return __builtin_bit_cast(bf16x8v, p); }
template <int CTRL> __device__ __forceinline__ void s5_scan_step(f32x16& xr, f32x16& xi, const f32x16& zr, const f32x16& zi) {
#pragma unroll
    for (int i = 0; i < 16; ++i) { const float sr = dppf<CTRL>(0.f, xr[i]), si = dppf<CTRL>(0.f, xi[i]);
        xr[i] += zr[i] * sr - zi[i] * si; xi[i] += zr[i] * si + zi[i] * sr; }
}
constexpr int S5L_W1 = 0, S5L_C2 = 32768, S5L_TOT = 98304, S5L_CAR = 106496, S5L_ZP = 114688, S5L_TA = 123392;
static_assert(S5L_TA + 512 <= RING_BYTES, "S5 LDS map");
template <bool SECOND>
__device__ __forceinline__ void s5_step(LAS unsigned char* L, int lane, int j, const bf16x8v u, f32x16& gr0, f32x16& gr1, f32x16& gi0, f32x16& gi1, const float (&dk)[8], bf16* gout) {
    const LAS bf16x8v* a1 = (const LAS bf16x8v*)(L + S5L_W1) + j * 256 + lane;
    gr0 = MFMA32(a1[0], u, gr0); gr1 = MFMA32(a1[64], u, gr1); gi0 = MFMA32(a1[128], u, gi0); gi1 = MFMA32(a1[192], u, gi1);
    if (SECOND) {
        const LAS bf16x8v* a2 = (const LAS bf16x8v*)(L + S5L_C2) + j * 512 + lane;
        f32x16 y;
#pragma unroll
        for (int i = 0; i < 16; ++i) y[i] = 0.f;
        y = MFMA32(a2[0 * 64], pack8(gr0, 0), y); y = MFMA32(a2[1 * 64], pack8(gr0, 1), y);
        y = MFMA32(a2[2 * 64], pack8(gr1, 0), y); y = MFMA32(a2[3 * 64], pack8(gr1, 1), y);
        y = MFMA32(a2[4 * 64], pack8(gi0, 0), y); y = MFMA32(a2[5 * 64], pack8(gi0, 1), y);
        y = MFMA32(a2[6 * 64], pack8(gi1, 0), y); y = MFMA32(a2[7 * 64], pack8(gi1, 1), y);
        const v4u uw = __builtin_bit_cast(v4u, u);
        float o[8];
        o[0] = gelu_tanh(y[0] + dk[0] * pg8::bf_lo(uw.x)); o[1] = gelu_tanh(y[1] + dk[1] * pg8::bf_hi(uw.x));
        o[2] = gelu_tanh(y[2] + dk[2] * pg8::bf_lo(uw.y)); o[3] = gelu_tanh(y[3] + dk[3] * pg8::bf_hi(uw.y));
        o[4] = gelu_tanh(y[4] + dk[4] * pg8::bf_lo(uw.z)); o[5] = gelu_tanh(y[5] + dk[5] * pg8::bf_hi(uw.z));
        o[6] = gelu_tanh(y[6] + dk[6] * pg8::bf_lo(uw.w)); o[7] = gelu_tanh(y[7] + dk[7] * pg8::bf_hi(uw.w));
        v4u w; w.x = pkbf(o[0], o[1]); w.y = pkbf(o[2], o[3]); w.z = pkbf(o[4], o[5]); w.w = pkbf(o[6], o[7]);
        pg8::st16_wt(gout, w);
    }
}
__device__ __forceinline__ void s5_cmul(const LAS float* p, f32x16& r0, f32x16& r1, f32x16& i0, f32x16& i1) {
    { const f32x16 zr = ld16l(p), zi = ld16l(p + 32); const f32x16 t = zr * r0 - zi * i0; i0 = zr * i0 + zi * r0; r0 = t; }
    asm volatile("" : "+v"(r0), "+v"(i0) :: "memory");
    { const f32x16 zr = ld16l(p + 16), zi = ld16l(p + 48); const f32x16 t = zr * r1 - zi * i1; i1 = zr * i1 + zi * r1; r1 = t; }
    asm volatile("" : "+v"(r1), "+v"(i1) :: "memory");
}
__device__ __forceinline__ void s5_stage_tables(Frame& F, LAS unsigned char* L, const unsigned char* tab, int g) {
    const v4u* s1 = (const v4u*)(tab + TB_W1) + (size_t)g * 2048; const v4u* s2 = (const v4u*)(tab + TB_C2) + (size_t)g * 4096;
#pragma unroll
    for (int k = 0; k < 4; ++k) ((LAS v4u*)(L + S5L_W1))[F.tid + 512 * k] = s1[F.tid + 512 * k];
#pragma unroll
    for (int k = 0; k < 8; ++k) ((LAS v4u*)(L + S5L_C2))[F.tid + 512 * k] = s2[F.tid + 512 * k];
    const v4u* s3 = (const v4u*)(tab + TB_ZP) + (size_t)g * (17 * 128 / 4); for (int e = F.tid; e < 17 * 128 / 4; e += NWAVES * 64) ((LAS v4u*)(L + S5L_ZP))[e] = s3[e];
    if (F.tid < 32) ((LAS v4u*)(L + S5L_TA))[F.tid] = ((const v4u*)(tab + TB_TA) + (size_t)g * 32)[F.tid];
}
__device__ __forceinline__ void s5_item_fast(Frame& F, const Args& A, int b, int g) {
    refresh(F);
    const int lane = F.lane, q = lane & 31, hh = lane >> 5, w = F.wave, c = w * 32 + q;
    LAS unsigned char* L = F.lds + RING_OFF;
    const unsigned char* tab = F.ws + WS_TAB;
    const size_t m0 = (size_t)b * TP + (size_t)8 * c;
    const bf16* zrow = (const bf16*)(F.ws + WS_Z) + m0 * NZ + 2 * WA + g * KS5 + 8 * hh;
    bf16* grow = (bf16*)(F.ws + WS_G) + m0 * WB + g * KS5 + 8 * hh;
    bf16x8v uu[8];
#pragma unroll
    for (int j = 0; j < 8; ++j) uu[j] = *(const bf16x8v*)(zrow + (size_t)j * NZ);
    s5_stage_tables(F, L, tab, g);
    __syncthreads();
    f32x16 hr0, hr1, hi0, hi1;
#pragma unroll
    for (int i = 0; i < 16; ++i) { hr0[i] = 0.f; hr1[i] = 0.f; hi0[i] = 0.f; hi1[i] = 0.f; }
    float dk[8];
#pragma unroll
    for (int i = 0; i < 8; ++i) dk[i] = A.in[I_S5D][g * KS5 + 8 * hh + i];
#pragma unroll
    for (int j = 0; j < 8; ++j) s5_step<false>(L, lane, j, uu[j], hr0, hr1, hi0, hi1, dk, nullptr);
    const LAS float* ZP = (const LAS float*)(L + S5L_ZP);
    s5_cmul(ZP + ((1 * 2 + hh) * 2) * 32, hr0, hr1, hi0, hi1);
#define S5_SCAN(E, CTRL) do { const LAS float* z = ZP + (((E) * 2 + hh) * 2) * 32; \
        { const f32x16 zr = ld16l(z), zi = ld16l(z + 32); s5_scan_step<CTRL>(hr0, hi0, zr, zi); } \
        asm volatile("" : "+v"(hr0), "+v"(hi0) :: "memory"); \
        { const f32x16 zr = ld16l(z + 16), zi = ld16l(z + 48); s5_scan_step<CTRL>(hr1, hi1, zr, zi); } \
        asm volatile("" : "+v"(hr1), "+v"(hi1) :: "memory"); } while (0)
    S5_SCAN(1, 0x111); S5_SCAN(2, 0x112); S5_SCAN(4, 0x114); S5_SCAN(8, 0x118);
#undef S5_SCAN
    const int seg = w * 2 + (q >> 4);
    LAS float* TOT = (LAS float*)(L + S5L_TOT); LAS float* CAR = (LAS float*)(L + S5L_CAR);
    if ((lane & 15) == 15) {
#pragma unroll
        for (int rho = 0; rho < 4; ++rho) {
            *(LAS f32x4*)(TOT + (seg * 2 + 0) * 64 + 0 + 8 * rho + 4 * hh) = (f32x4){hr0[4 * rho], hr0[4 * rho + 1], hr0[4 * rho + 2], hr0[4 * rho + 3]};
            *(LAS f32x4*)(TOT + (seg * 2 + 0) * 64 + 32 + 8 * rho + 4 * hh) = (f32x4){hr1[4 * rho], hr1[4 * rho + 1], hr1[4 * rho + 2], hr1[4 * rho + 3]};
            *(LAS f32x4*)(TOT + (seg * 2 + 1) * 64 + 0 + 8 * rho + 4 * hh) = (f32x4){hi0[4 * rho], hi0[4 * rho + 1], hi0[4 * rho + 2], hi0[4 * rho + 3]};
            *(LAS f32x4*)(TOT + (seg * 2 + 1) * 64 + 32 + 8 * rho + 4 * hh) = (f32x4){hi1[4 * rho], hi1[4 * rho + 1], hi1[4 * rho + 2], hi1[4 * rho + 3]}; }
    }
    __syncthreads();
    if (F.tid < 64) {
        const float* z16 = (const float*)(tab + TB_Z16N) + (size_t)g * 128; const float zr = z16[F.tid], zi = z16[64 + F.tid];
        float cr = 0.f, ci = 0.f;
#pragma unroll
        for (int sg = 0; sg < 16; ++sg) { CAR[(sg * 2 + 0) * 64 + F.tid] = cr; CAR[(sg * 2 + 1) * 64 + F.tid] = ci;
            const float tr = TOT[(sg * 2 + 0) * 64 + F.tid], ti = TOT[(sg * 2 + 1) * 64 + F.tid];
            const float ncr = zr * cr - zi * ci + tr, nci = zr * ci + zi * cr + ti; cr = ncr; ci = nci; }
    }
    __syncthreads();
    {
        const LAS float* z = ZP + (((q & 15) * 2 + hh) * 2) * 32;
#define S5_EXCL(HR, HI, OFF) do { const f32x16 zr = ld16l(z + (OFF)), zi = ld16l(z + 32 + (OFF)); f32x16 kr, ki; \
        _Pragma("unroll") for (int rho = 0; rho < 4; ++rho) { \
            const f32x4 a0 = *(const LAS f32x4*)(CAR + (seg * 2 + 0) * 64 + 2 * (OFF) + 8 * rho + 4 * hh), b0 = *(const LAS f32x4*)(CAR + (seg * 2 + 1) * 64 + 2 * (OFF) + 8 * rho + 4 * hh); \
            _Pragma("unroll") for (int e = 0; e < 4; ++e) { kr[4 * rho + e] = a0[e]; ki[4 * rho + e] = b0[e]; } } \
        _Pragma("unroll") for (int i = 0; i < 16; ++i) { const float sr = dppf<0x111>(0.f, HR[i]), si = dppf<0x111>(0.f, HI[i]); \
            HR[i] = sr + zr[i] * kr[i] - zi[i] * ki[i]; HI[i] = si + zr[i] * ki[i] + zi[i] * kr[i]; } } while (0)
        S5_EXCL(hr0, hi0, 0); asm volatile("" : "+v"(hr0), "+v"(hi0) :: "memory"); S5_EXCL(hr1, hi1, 16); asm volatile("" : "+v"(hr1), "+v"(hi1) :: "memory");
#undef S5_EXCL
    }
#pragma unroll
    for (int j = 0; j < 8; ++j) s5_step<true>(L, lane, j, uu[j], hr0, hr1, hi0, hi1, dk, grow + (size_t)j * WB);
    if (w == NWAVES - 1 && q == 31) {
        s5_cmul(ZP + ((1 * 2 + hh) * 2) * 32, hr0, hr1, hi0, hi1);
        float* osr = F.out + O_SRP + (size_t)(b * GB + g) * NS5; float* osi = F.out + O_SIP + (size_t)(b * GB + g) * NS5;
#pragma unroll
        for (int i = 0; i < 16; ++i) { const int n = (i & 3) + 8 * (i >> 2) + 4 * hh; osr[n] = hr0[i]; osr[32 + n] = hr1[i]; osi[n] = hi0[i]; osi[32 + n] = hi1[i]; }
    }
    __syncthreads();
}

__device__ __forceinline__ void s5_item_sample(Frame& F, const Args& A, int g) {
    refresh(F);
    const int lane = F.lane, q = lane & 31, hh = lane >> 5, w = F.wave;
    LAS unsigned char* L = F.lds + RING_OFF;
    const unsigned char* tab = F.ws + WS_TAB;
    s5_stage_tables(F, L, tab, g);
    __syncthreads();
    if (w < 4) {
        const int b = w * 32 + q;
        f32x16 hr0, hr1, hi0, hi1;
        const float* sr = A.in[I_SSR] + (size_t)(b * GB + g) * NS5; const float* si = A.in[I_SSI] + (size_t)(b * GB + g) * NS5;
#pragma unroll
        for (int rho = 0; rho < 4; ++rho) { const f32x4 a0 = *(const f32x4*)(sr + 8 * rho + 4 * hh), a1 = *(const f32x4*)(sr + 32 + 8 * rho + 4 * hh), b0 = *(const f32x4*)(si + 8 * rho + 4 * hh), b1 = *(const f32x4*)(si + 32 + 8 * rho + 4 * hh);
#pragma unroll
            for (int e = 0; e < 4; ++e) { hr0[4 * rho + e] = a0[e]; hr1[4 * rho + e] = a1[e]; hi0[4 * rho + e] = b0[e]; hi1[4 * rho + e] = b1[e]; } }
        float dk[8];
#pragma unroll
        for (int i = 0; i < 8; ++i) dk[i] = A.in[I_S5D][g * KS5 + 8 * hh + i];
        const size_t m0 = (size_t)MP + (size_t)b * TS;
        const bf16* zrow = (const bf16*)(F.ws + WS_Z) + m0 * NZ + 2 * WA + g * KS5 + 8 * hh;
        bf16* grow = (bf16*)(F.ws + WS_G) + m0 * WB + g * KS5 + 8 * hh;
        bf16x8v uu[TS];
#pragma unroll
        for (int j = 0; j < TS; ++j) uu[j] = *(const bf16x8v*)(zrow + (size_t)j * NZ);
#pragma unroll
        for (int j = 0; j < TS; ++j) s5_step<true>(L, lane, j, uu[j], hr0, hr1, hi0, hi1, dk, grow + (size_t)j * WB);
        s5_cmul((const LAS float*)(L + S5L_TA) + hh * 64, hr0, hr1, hi0, hi1);
        float* osr = F.out + O_SRS + (size_t)(b * GB + g) * NS5; float* osi = F.out + O_SIS + (size_t)(b * GB + g) * NS5;
#pragma unroll
        for (int rho = 0; rho < 4; ++rho) {
            *(f32x4*)(osr + 8 * rho + 4 * hh) = (f32x4){hr0[4 * rho], hr0[4 * rho + 1], hr0[4 * rho + 2], hr0[4 * rho + 3]};
            *(f32x4*)(osr + 32 + 8 * rho + 4 * hh) = (f32x4){hr1[4 * rho], hr1[4 * rho + 1], hr1[4 * rho + 2], hr1[4 * rho + 3]};
            *(f32x4*)(osi + 8 * rho + 4 * hh) = (f32x4){hi0[4 * rho], hi0[4 * rho + 1], hi0[4 * rho + 2], hi0[4 * rho + 3]};
            *(f32x4*)(osi + 32 + 8 * rho + 4 * hh) = (f32x4){hi1[4 * rho], hi1[4 * rho + 1], hi1[4 * rho + 2], hi1[4 * rho + 3]}; }
    }
    __syncthreads();
}

template <int CTRL, int RMASK> __device__ __forceinline__ float dppm(float old, float v) { return __builtin_bit_cast(float, __builtin_amdgcn_update_dpp(__builtin_bit_cast(int, old), __builtin_bit_cast(int, v), CTRL, RMASK, 0xF, false)); }
template <int CTRL, int RMASK> __device__ __forceinline__ void rg_scan_step(f32x16& a, f32x16& b) {
#pragma unroll
    for (int i = 0; i < 16; ++i) { const float as = dppm<CTRL, RMASK>(1.f, a[i]), bs = dppm<CTRL, RMASK>(0.f, b[i]); b[i] = a[i] * bs + b[i]; a[i] = a[i] * as; }
}
constexpr int RGL_AFR = 0, RGL_DG = 8192, RGL_TOT = 24576, RGL_CST = 28672;
constexpr int RGL_XAP = 144;
constexpr int RGL_XA0 = 29696, RGL_BUF = 37376;
static_assert(259 * RGL_XAP <= RGL_BUF && RGL_XA0 + 2 * RGL_BUF <= RING_BYTES && RGL_CST + 640 <= RGL_XA0, "RG-LRU LDS map");
template <bool SAMPLE>
__device__ __forceinline__ void rg_item_fast(Frame& F, const Args& A, int b, int hd, int jh) {
    refresh(F);
    const int lane = F.lane, q = lane & 31, hh = lane >> 5, w = F.wave;
    LAS unsigned char* L = F.lds + RING_OFF;
    const float* sc = (const float*)(F.ws + WS_S5C);
    const bf16* Zb = (const bf16*)(F.ws + WS_Z) + (size_t)(SAMPLE ? MP : b * TP) * NZ; bf16* Yb = SAMPLE ? (bf16*)(F.ws + WS_YCS) : (bf16*)(F.ws + WS_YCAT) + (size_t)(b * TP) * D;
    const bf16* CB = (const bf16*)(F.ws + WS_TAB + TB_CB);
    auto stage_load = [&](int T0, v4u (&st)[5]) {
#pragma unroll
        for (int k = 0; k < 5; ++k) { const int ci = F.tid + 512 * k; v4u v = (v4u){0u, 0u, 0u, 0u};
            if (ci < 2072) { const int tk = T0 - 3 + (ci >> 3); if (tk >= 0) v = *(const v4u*)(Zb + (size_t)tk * NZ + WA + hd * 64 + (ci & 7) * 8); }
            st[k] = v; } };
    auto stage_write = [&](int par, const v4u (&st)[5]) {
#pragma unroll
        for (int k = 0; k < 5; ++k) { const int ci = F.tid + 512 * k;
            if (ci < 2072) *(LAS v4u*)(L + RGL_XA0 + par * RGL_BUF + (ci >> 3) * RGL_XAP + (ci & 7) * 16) = st[k]; } };
    {
        const v4u* src = (const v4u*)(F.ws + WS_TAB + TB_RG) + (size_t)((hd * 2 + jh) * 8) * 64;
        ((LAS v4u*)(L + RGL_AFR))[F.tid] = src[F.tid];
        const v4u* sd = (const v4u*)(F.ws + WS_TAB + TB_DG) + (size_t)(hd * 16) * 64;
        ((LAS v4u*)(L + RGL_DG))[F.tid] = sd[F.tid]; ((LAS v4u*)(L + RGL_DG))[512 + F.tid] = sd[512 + F.tid];
        if (F.tid < 160) { const int h2 = F.tid / 80, kind = (F.tid % 80) / 16, i = F.tid % 16, cr = (i & 3) + 8 * (i >> 2) + 4 * h2;
            const int c = hd * 64 + 32 * jh + cr;
            ((LAS float*)(L + RGL_CST))[F.tid] = kind == 0 ? A.in[I_RGBR][c] : kind == 1 ? A.in[I_RGBI][c] : kind == 2 ? sc[SC_RGL + c] : A.in[I_CONVB][hd * 64 + 32 * (kind - 3) + cr]; }
        if (!SAMPLE && jh == 0 && F.tid < 192) { const int k = F.tid >> 6, ch = F.tid & 63;
            F.out[O_CONVP + (size_t)(b * 3 + k) * WA + hd * 64 + ch] = bf2f(((const bf16*)(F.ws + WS_Z))[(size_t)(b * TP + TP - 3 + k) * NZ + WA + hd * 64 + ch]); }
        if (SAMPLE && jh == 0) { for (int e = F.tid; e < NBS * 3 * 64; e += NWAVES * 64) { const int bb = e / 192, k = (e / 64) % 3, ch = e & 63;
            F.out[O_CONVS + (size_t)(bb * 3 + k) * WA + hd * 64 + ch] = bf2f(((const bf16*)(F.ws + WS_Z))[(size_t)(MP + bb * TS + 1 + k) * NZ + WA + hd * 64 + ch]); } }
        if (!SAMPLE) { v4u st[5]; stage_load(0, st); stage_write(0, st); }
    }
    __syncthreads();
    float hround[16];
#pragma unroll
    for (int i = 0; i < 16; ++i) hround[i] = 0.f;
    const LAS float* CST = (const LAS float*)(L + RGL_CST) + hh * 80;
    const LAS bf16x8v* af = (const LAS bf16x8v*)(L + RGL_AFR) + lane;
    const LAS bf16x8v* dg = (const LAS bf16x8v*)(L + RGL_DG) + lane;
#pragma unroll 1
    for (int rd = 0; rd < (SAMPLE ? 2 : 8); ++rd) {
        const int t = rd * 256 + w * 32 + q;
        v4u stn[5];
        if (!SAMPLE) stage_load((rd + 1) * 256, stn);
        const LAS unsigned char* XAp = L + RGL_XA0 + (rd & 1) * RGL_BUF + (w * 32 + q) * RGL_XAP + 16 * hh;
        const bf16* zsr[4];
        if (SAMPLE) {
#pragma unroll
            for (int k = 0; k < 4; ++k) { const int jx = (t & 3) + k; zsr[k] = (jx < 3 ? CB + (size_t)((t >> 2) * 3 + jx) * WA : Zb + (size_t)(t - 3 + k) * NZ + WA) + hd * 64 + 8 * hh; } }
        const bf16* gr = Zb + (size_t)t * NZ + hd * 64 + 32 * jh + 4 * hh;
        unsigned long long gq[4];
#pragma unroll
        for (int rho = 0; rho < 4; ++rho) gq[rho] = *(const unsigned long long*)(gr + 8 * rho);
        f32x16 dx0, dx1;
        { const f32x4 c0 = *(const LAS f32x4*)(CST + 48), c1 = *(const LAS f32x4*)(CST + 52), c2 = *(const LAS f32x4*)(CST + 56), c3 = *(const LAS f32x4*)(CST + 60);
          const f32x4 e0 = *(const LAS f32x4*)(CST + 64), e1 = *(const LAS f32x4*)(CST + 68), e2 = *(const LAS f32x4*)(CST + 72), e3 = *(const LAS f32x4*)(CST + 76);
#pragma unroll
          for (int e = 0; e < 4; ++e) { dx0[e] = c0[e]; dx0[4 + e] = c1[e]; dx0[8 + e] = c2[e]; dx0[12 + e] = c3[e]; dx1[e] = e0[e]; dx1[4 + e] = e1[e]; dx1[8 + e] = e2[e]; dx1[12 + e] = e3[e]; } }
#pragma unroll
        for (int k = 0; k < 4; ++k)
#pragma unroll
            for (int s4 = 0; s4 < 4; ++s4) {
                const bf16x8v xb = SAMPLE ? *(const bf16x8v*)(zsr[k] + 16 * s4) : *(const LAS bf16x8v*)(XAp + k * RGL_XAP + s4 * 32);
                if (s4 < 2) dx0 = MFMA32(dg[((0 * 2 + (s4 & 1)) * 4 + k) * 64], xb, dx0); else dx1 = MFMA32(dg[((1 * 2 + (s4 & 1)) * 4 + k) * 64], xb, dx1);
                if (s4 == 3) asm volatile("" : "+v"(dx0), "+v"(dx1) :: "memory"); }
        f32x16 dr, di;
#pragma unroll
        for (int i = 0; i < 16; ++i) { dr[i] = 0.f; di[i] = 0.f; }
        { const bf16x8v b00 = pack8(dx0, 0), b01 = pack8(dx0, 1), b10 = pack8(dx1, 0), b11 = pack8(dx1, 1);
          dr = MFMA32(af[0 * 64], b00, dr); di = MFMA32(af[4 * 64], b00, di); dr = MFMA32(af[1 * 64], b01, dr); di = MFMA32(af[5 * 64], b01, di);
          dr = MFMA32(af[2 * 64], b10, dr); di = MFMA32(af[6 * 64], b10, di); dr = MFMA32(af[3 * 64], b11, dr); di = MFMA32(af[7 * 64], b11, di); }
        f32x16 av, bv;
        const bool first = !SAMPLE && (t == 0);
#pragma unroll
        for (int i = 0; i < 16; ++i) { const float xcv = jh ? dx1[i] : dx0[i];
            const float r = sigmoidf_(dr[i] + CST[i]), gi = sigmoidf_(di[i] + CST[16 + i]);
            const float a = __builtin_amdgcn_exp2f(r * CST[32 + i]);
            float mult = __builtin_amdgcn_sqrtf(fmaxf(1.f - a * a, 0.f)); if (first) mult = 1.f;
            av[i] = a; bv[i] = mult * gi * xcv; }
        if (SAMPLE && (t & 3) == 0) {
            const float* h0 = A.in[I_SH] + (size_t)(t >> 2) * WA + hd * 64 + 32 * jh + 4 * hh;
#pragma unroll
            for (int i = 0; i < 16; ++i) { bv[i] += av[i] * h0[(i & 3) + 8 * (i >> 2)]; av[i] = 0.f; } }
        rg_scan_step<0x111, 0xF>(av, bv); rg_scan_step<0x112, 0xF>(av, bv); rg_scan_step<0x114, 0xF>(av, bv); rg_scan_step<0x118, 0xF>(av, bv);
        rg_scan_step<0x142, 0xA>(av, bv);
        float hin[16];
#pragma unroll
        for (int i = 0; i < 16; ++i) hin[i] = 0.f;
        if (!SAMPLE) {
        LAS float* TOT = (LAS float*)(L + RGL_TOT) + (rd & 1) * 512;
        if (q == 31) {
#pragma unroll
            for (int i4 = 0; i4 < 4; ++i4) { *(LAS f32x4*)(TOT + (w * 2 + 0) * 32 + hh * 16 + 4 * i4) = (f32x4){av[4 * i4], av[4 * i4 + 1], av[4 * i4 + 2], av[4 * i4 + 3]};
                                             *(LAS f32x4*)(TOT + (w * 2 + 1) * 32 + hh * 16 + 4 * i4) = (f32x4){bv[4 * i4], bv[4 * i4 + 1], bv[4 * i4 + 2], bv[4 * i4 + 3]}; }
        }
        stage_write((rd + 1) & 1, stn);
        __syncthreads();
#pragma unroll
        for (int w2 = 0; w2 < 8; ++w2) {
            if (w2 == w) {
#pragma unroll
                for (int i = 0; i < 16; ++i) hin[i] = hround[i]; }
#pragma unroll
            for (int i4 = 0; i4 < 4; ++i4) { const f32x4 p = *(const LAS f32x4*)(TOT + (w2 * 2 + 0) * 32 + hh * 16 + 4 * i4), hl = *(const LAS f32x4*)(TOT + (w2 * 2 + 1) * 32 + hh * 16 + 4 * i4);
#pragma unroll
                for (int e = 0; e < 4; ++e) hround[4 * i4 + e] = p[e] * hround[4 * i4 + e] + hl[e]; }
        }
        }
        bf16* yr = Yb + (size_t)t * D + hd * 64 + 32 * jh + 4 * hh;
#pragma unroll
        for (int rho = 0; rho < 4; ++rho) { const unsigned glo = (unsigned)gq[rho], ghi = (unsigned)(gq[rho] >> 32);
            const float o0 = gelu_tanh(pg8::bf_lo(glo)) * (bv[4 * rho] + av[4 * rho] * hin[4 * rho]), o1 = gelu_tanh(pg8::bf_hi(glo)) * (bv[4 * rho + 1] + av[4 * rho + 1] * hin[4 * rho + 1]);
            const float o2 = gelu_tanh(pg8::bf_lo(ghi)) * (bv[4 * rho + 2] + av[4 * rho + 2] * hin[4 * rho + 2]), o3 = gelu_tanh(pg8::bf_hi(ghi)) * (bv[4 * rho + 3] + av[4 * rho + 3] * hin[4 * rho + 3]);
            *(unsigned long long*)(yr + 8 * rho) = (unsigned long long)pkbf(o0, o1) | ((unsigned long long)pkbf(o2, o3) << 32); }
        if (SAMPLE && (t & 3) == 3) {
#pragma unroll
            for (int i = 0; i < 16; ++i) F.out[O_HS + (size_t)(t >> 2) * WA + hd * 64 + 32 * jh + (i & 3) + 8 * (i >> 2) + 4 * hh] = bv[i]; }
    }
    if (!SAMPLE && w == 0 && q == 0) {
#pragma unroll
        for (int i = 0; i < 16; ++i) F.out[O_HP + (size_t)b * WA + hd * 64 + 32 * jh + (i & 3) + 8 * (i >> 2) + 4 * hh] = hround[i];
    }
    __syncthreads();
}

#ifndef PROBE_P3PART
#define PROBE_P3PART 7
#endif
__device__ __forceinline__ void p3_mixers_ref(Frame& F, const Args& A, int rep = 0) {
    constexpr int N_RGP = NBP * HA, N_S5P = NBP * GB;
    const int pm = rep ? PROBE_P3PART : 7;
    bf16* GY = (bf16*)(F.ws + WS_G); bf16* YC = (bf16*)(F.ws + WS_YCAT);
    pg8::Gemm gg{GY, (const bf16*)(F.ws + WS_WGLU), M, WB, WB}; pg8::EpiGlu EG{GY, WB, YC, D, WA, A.in[I_GLUB], (bf16*)(F.ws + WS_YCS), MP};
    pg8::OneUnit SG; SG.u0.pm = 0; SG.u0.pn = 0; SG.u0.k0 = 0; SG.u0.nkt = WB / 64; SG.u0.ks = 0; bool has_glu = false;
    if (F.vcu < 2 * N_RGP) {
        if ((pm & 4) && F.vcu < GB) { s5_item_sample(F, A, F.vcu); cnt_arrive_wt(F, CW_S5B + 64 * NBP); }
        if (pm & 1) rg_item_fast<false>(F, A, F.vcu / (2 * HA), (F.vcu / 2) % HA, F.vcu & 1);
        if (pm & 4) { if (F.vcu < GB) { }
                      else if (F.vcu < GB + 2 * HA) rg_item_fast<true>(F, A, 0, (F.vcu - GB) >> 1, (F.vcu - GB) & 1);
                      else if (F.vcu < GB + 2 * HA + 4) {
                          cnt_wait_ge(F, CW_S5B + 64 * NBP, (unsigned)GB); const int u = F.vcu - GB - 2 * HA; SG.u0.pm = MP / 256 + (u >> 1); SG.u0.pn = u & 1; has_glu = true; } }
    } else {
        const int v = F.vcu - 2 * N_RGP, it = 2 * v, bb = it / GB;
        if (pm & 2) { s5_item_fast(F, A, bb, it % GB);
                      s5_item_fast(F, A, bb, (it + 1) % GB);
                      cnt_arrive_wt(F, CW_S5B + 64 * bb);
                      cnt_wait_ge(F, CW_S5B + 64 * bb, 16u);
                      const int u = v & 15; SG.u0.pm = 8 * bb + (u >> 1); SG.u0.pn = u & 1; has_glu = true; }
    }
    if (has_glu) pg8::gemm_phase<pg8::EpiGlu, pg8::OneUnit, false, PG8_SP2>(F.lds + RING_OFF, gg, SG, EG);
    if (rep == 0 && F.vcu >= GB + 2 * HA + 4 && F.vcu < 2 * N_RGP) {
        constexpr int X0 = GB + 2 * HA + 4, NX = 2 * N_RGP - X0;
        LAS float* scr = (LAS float*)(F.lds + RING_OFF + F.wave * 16384);
        for (int it = XO_2 + F.wave * NX + (F.vcu - X0); it < XO_END; it += NX * NWAVES) xpose_item(F, A, scr, it); }
}

template <bool SECOND>
__device__ __forceinline__ void ln_phase(Frame& F, const Args& A, int rep) {
    pg8::StaticOrder P; P.init(MP, D, F.G, (int)blockIdx.x, D); pg8::Unit u; P.next(0, u);
    cnt_wait_ge(F, (SECOND ? CW_T2 : CW_T1) + 64 * u.pm, 4u);
    ln_rows<SECOND>(F, A, u.pm * 256 + u.pn * 64, u.pm * 256 + u.pn * 64 + 64, F.wave, NWAVES);
    constexpr int NPC = 2 * (D / 256) * (SECOND ? NS_DOWN : NS_OUT);
    const int si = (int)blockIdx.x - (F.G - NPC);
    if (si >= 0) { cnt_wait_ge(F, SECOND ? CW_T2S : CW_T1S, (unsigned)NPC);
        ln_rows<SECOND>(F, A, MP + si * (MS / NPC), MP + (si + 1) * (MS / NPC), F.wave, NWAVES); }
}
__global__ void __launch_bounds__(NWAVES * 64, 2) fwd(Args A) {
    extern __shared__ __attribute__((aligned(16))) unsigned char lds[];
    Frame F;
    F.lds = (LAS unsigned char*)lds;
    F.MISC = (volatile LAS unsigned*)(F.lds + MISC_OFF);
    F.tid = threadIdx.x; F.lane = F.tid & 63; F.wave = __builtin_amdgcn_readfirstlane(F.tid >> 6);
    F.G = gridDim.x; { const int bx = blockIdx.x; F.vcu = (F.G % 8 == 0) ? (bx % 8) * (F.G / 8) + bx / 8 : bx; }
    F.out = A.out; F.ws = A.ws; F.ctl = (gu32*)(A.ws + WS_CTL);
    for (int u = F.tid; u < (LDS_BYTES - LDSCTL_OFF) / 4; u += NWAVES * 64) ((LAS unsigned*)(F.lds + LDSCTL_OFF))[u] = 0u;
    __syncthreads();
    XcdBarrier bar; bar.bar = (unsigned*)(F.ctl + CW_BAR); bar.x = 0; bar.st = nullptr;
    if (N_LAUNCHES == 1) bar = xcd_barrier_post((unsigned*)(F.ctl + CW_BAR), F.MISC + 8);
#define GRID_BAR() do { if (N_LAUNCHES == 1) xcd_barrier(bar); } while (0)
    const int lo = A.ph_lo, hi = A.ph_hi;
#define IN(k) (lo <= (k) && (k) < hi)
#define BOTH(k) (IN(k) && IN((k) + 1))
    bf16* XN = (bf16*)(F.ws + WS_XN); bf16* Z = (bf16*)(F.ws + WS_Z); bf16* YC = (bf16*)(F.ws + WS_YCAT); bf16* GY = (bf16*)(F.ws + WS_G); bf16* U = (bf16*)(F.ws + WS_U);
    const float* mod = (const float*)(F.ws + WS_MOD);

#define REPS(k) (((PROBE_DUP) >> (k)) & 1 ? 2 : 1)
#define PH0(rep) p0_prologue(F, A, rep)
#define PH1(rep) p1_modulate(F, A, rep)
#define PH2(rep) do {     \
        pg8::Gemm g{XN, (const bf16*)(F.ws + WS_WIN), M, NZ, D}; pg8::StaticOrder S; S.init(M, NZ, F.G, (int)blockIdx.x, D); \
        pg8::EpiBf16<0> E{Z, NZ, nullptr}; \
        pg8::gemm_phase<pg8::EpiBf16<0>, pg8::StaticOrder, PG8_ALIGN, PG8_SP2>(F.lds + RING_OFF, g, S, E); \
        if ((rep) == 0 && (int)blockIdx.x >= (M / 256) * (NZ / 256) - F.G) { __syncthreads(); xpose_range_b(F, A, XO_OU, XO_2, (M / 256) * (NZ / 256) - F.G); } } while (0)
#define PH3(rep) p3_mixers_ref(F, A, rep)
#define PH4(rep) do { } while (0)
#define PH5(rep) do {     \
        pg8::Gemm g{YC, (const bf16*)(F.ws + WS_WOUT), M, D, D}; \
        { pg8::StaticOrder S; S.init(MP, D, F.G, (int)blockIdx.x, D); \
          pg8::EpiLnFused<false> E{A.in[I_XP], mod + 2 * D, nullptr, ALPHA, A.in[I_LN1G], A.in[I_LN1B], mod + 3 * D, nullptr, (bf16*)(F.ws + WS_X1B), XN, (float*)(F.ws + WS_STAT), (unsigned*)(F.ctl + CW_T1), LN_EPS}; \
          pg8::gemm_phase<pg8::EpiLnFused<false>, pg8::StaticOrder, false, PG8_SP2>(F.lds + RING_OFF, g, S, E); } \
        GRID_BAR();     \
        { pg8::PieceOrder S; S.init(MP, D, F.G, (int)blockIdx.x, D, NS_OUT); pg8::EpiSlab E{(float*)(F.ws + WS_SLAB), MP}; \
          pg8::Gemm gs{(const bf16*)(F.ws + WS_YCS) - (size_t)MP * D, (const bf16*)(F.ws + WS_WOUT), M, D, D};     \
          pg8::gemm_phase<pg8::EpiSlab, pg8::PieceOrder, false, PG8_SP2>(F.lds + RING_OFF, gs, S, E); \
          if ((int)blockIdx.x >= F.G - S.nP) cnt_arrive_wt(F, CW_T1S); } } while (0)
#define PH6(rep) do {     \
        constexpr int NPC1 = 2 * (D / 256) * NS_OUT; const int si1 = (int)blockIdx.x - (F.G - NPC1); \
        if (si1 >= 0) { cnt_wait_ge(F, CW_T1S, (unsigned)NPC1); ln_rows<false>(F, A, MP + si1 * (MS / NPC1), MP + (si1 + 1) * (MS / NPC1), F.wave, NWAVES); cnt_arrive_wt(F, CW_XNS); } } while (0)
#define PH7(rep) do {     \
        pg8::Gemm g{XN, (const bf16*)(F.ws + WS_W1), M, FF, D}; pg8::EpiBf16<3> E{U, FF, A.in[I_B1]}; \
        { pg8::StaticOrder S; S.init(MP, FF, F.G, (int)blockIdx.x, D); \
          pg8::gemm_phase<pg8::EpiBf16<3>, pg8::StaticOrder, PG8_ALIGN, PG8_SP2>(F.lds + RING_OFF, g, S, E); } \
        if ((int)blockIdx.x < 2 * (FF / 256)) { cnt_wait_ge(F, CW_XNS, (unsigned)(2 * (D / 256) * NS_OUT)); \
          pg8::OneUnit S; S.u0.pm = MP / 256 + (int)blockIdx.x / (FF / 256); S.u0.pn = (int)blockIdx.x % (FF / 256); S.u0.k0 = 0; S.u0.nkt = D / 64; S.u0.ks = 0; \
          pg8::gemm_phase<pg8::EpiBf16<3>, pg8::OneUnit, false, PG8_SP2>(F.lds + RING_OFF, g, S, E); } } while (0)
#define PH8(rep) do {     \
        pg8::Gemm g{U, (const bf16*)(F.ws + WS_W2), M, D, FF}; \
        { pg8::StaticOrder S; S.init(MP, D, F.G, (int)blockIdx.x, FF); \
          pg8::EpiLnFused<true> E{(const bf16*)(F.ws + WS_X1B), mod + 5 * D, A.in[I_B2], ALPHA, A.in[I_LN2G], A.in[I_LN2B], nullptr, F.out, nullptr, nullptr, (float*)(F.ws + WS_STAT), (unsigned*)(F.ctl + CW_T2), LN_EPS}; \
          pg8::gemm_phase<pg8::EpiLnFused<true>, pg8::StaticOrder, false, PG8_SP2>(F.lds + RING_OFF, g, S, E); } \
        { pg8::PieceOrder S; S.init(MP, D, F.G, (int)blockIdx.x, FF, NS_DOWN); pg8::EpiSlab E{(float*)(F.ws + WS_SLAB), MP}; \
          pg8::gemm_phase<pg8::EpiSlab, pg8::PieceOrder, false, PG8_SP2>(F.lds + RING_OFF, g, S, E); \
          if ((int)blockIdx.x >= F.G - S.nP) cnt_arrive_wt(F, CW_T2S); } } while (0)
#define RUNNB(k, PH) do { if (IN(k)) { PH(0); if (REPS(k) == 2) { __syncthreads(); PH(1); } } } while (0)
#define RUN(k, PH) do { if (IN(k)) { PH(0); if (REPS(k) == 2) { __syncthreads(); PH(1); } if (BOTH(k)) GRID_BAR(); } } while (0)
    if (IN(0)) { PH0(0); if (REPS(0) == 2) { __syncthreads(); PH0(1); } if (IN(0) && !IN(1)) { } }
    RUN(1, PH1); RUN(2, PH2); RUN(3, PH3); RUNNB(5, PH5); RUNNB(6, PH6); RUN(7, PH7); RUNNB(8, PH8);
    if (IN(9)) {
        constexpr int NPC = 2 * (D / 256) * NS_DOWN; const int si = (int)blockIdx.x - (F.G - NPC);
        if (si >= 0) { cnt_wait_ge(F, CW_T2S, (unsigned)NPC); ln_rows<true>(F, A, MP + si * (MS / NPC), MP + (si + 1) * (MS / NPC), F.wave, NWAVES); } }
#undef IN
#undef BOTH
}

extern "C" void kernel_launch(void* const* d_in, const int* in_sizes, int n_in, void* d_out, int out_size, void* d_ws, size_t ws_size, hipStream_t stream) {
    static int grid = 0;
    if (grid == 0) {
        if (n_in != 37 || in_sizes[0] != MP * D || out_size != (int)O_END || ws_size < WS_END) { fprintf(stderr, "kernel_launch: unexpected shapes (n_in %d, in0 %d, out %d, ws %zu)\n", n_in, n_in > 0 ? in_sizes[0] : -1, out_size, ws_size); grid = -1; return; }
        int dev = 0, cus = 0, per_cu = 0;
        if (hipGetDevice(&dev) != hipSuccess || hipDeviceGetAttribute(&cus, hipDeviceAttributeMultiprocessorCount, dev) != hipSuccess) { grid = -1; return; }
        if (hipFuncSetAttribute((const void*)fwd, hipFuncAttributeMaxDynamicSharedMemorySize, LDS_BYTES) != hipSuccess) { fprintf(stderr, "kernel_launch: hipFuncSetAttribute failed\n"); grid = -1; return; }
        if (hipOccupancyMaxActiveBlocksPerMultiprocessor(&per_cu, (const void*)fwd, NWAVES * 64, LDS_BYTES) != hipSuccess || per_cu < 1) { fprintf(stderr, "kernel_launch: occupancy query says %d\n", per_cu); }
        (void)hipGetLastError();
        grid = cus;
        if (grid < 256) { fprintf(stderr, "kernel_launch: this build needs 256 CUs (got %d)\n", grid); grid = -1; return; }
        grid = 256;
    }
    if (grid < 0) return;
    (void)hipMemsetAsync((char*)d_ws + WS_CTL, 0, CTL_ZERO_BYTES, stream);
    Args a{};
    for (int i = 0; i < 37; ++i) a.in[i] = (const float*)d_in[i];
    a.out = (float*)d_out; a.ws = (unsigned char*)d_ws;
    for (int li = 0; li < N_LAUNCHES; ++li) {
        if (N_LAUNCHES == 1) { a.ph_lo = 0; a.ph_hi = N_PHASES; } else { a.ph_lo = li; a.ph_hi = li + 1; }
        a.li = li;
        hipLaunchKernelGGL(fwd, dim3(grid), dim3(NWAVES * 64), LDS_BYTES, stream, a);
    }
}
```

```cpp
#include <hip/hip_runtime.h>
#include <cstdio>
#include <cstdint>
#include <cmath>

#ifndef MK_N_LAUNCHES
#define MK_N_LAUNCHES 1
#endif

namespace pg8 {
#define PG8_LAS __attribute__((address_space(3)))
typedef unsigned short bf16_t;
typedef short bf16x8 __attribute__((ext_vector_type(8)));
typedef float f32x4 __attribute__((ext_vector_type(4)));
typedef unsigned u32x4 __attribute__((ext_vector_type(4)));
constexpr int BM = 256, BK = 64, HALF = 128, HTB = HALF * BK * 2, STAGE_BYTES = 8 * HTB, NXCD = 8, WGM = 8;

__host__ __device__ __forceinline__ int lds_byte(int r, int c) { const int st = (r >> 4) * 2 + (c >> 5), rr = r & 15, cc = c & 31, ob = rr * 64 + cc * 2; return st * 1024 + (ob ^ (((ob >> 9) & 1) << 5)); }
__host__ __device__ __forceinline__ void stage_rc(int b, int& R, int& C) { const int st = b / 1024, sb = b % 1024, swz = sb ^ (((sb >> 9) & 1) << 5); R = (st >> 1) * 16 + swz / 64; C = (st & 1) * 32 + (swz % 64) / 2; }
__host__ __device__ __forceinline__ int perm32(int rho) { const int n = rho >> 4, i = rho & 15; return 8 * (i >> 2) + 4 * n + (i & 3); }

struct Unit { int pm, pn, k0, nkt, ks; };
struct Gemm { const bf16_t* A; const bf16_t* Bt; int M, N, K; };

struct StaticOrder {
    int nM, nN, nwg, G, c, K;
    __host__ __device__ void init(int M, int N, int G_, int c_, int K_) { nM = M / BM; nN = N / BM; nwg = nM * nN; G = G_; c = c_; K = K_; }
    __host__ __device__ __forceinline__ bool next(int i, Unit& u) const {
        const long L = (long)i * G + c; if (L >= nwg) return false;
        int wgid = (int)L; { const int q = nwg / NXCD, r = nwg % NXCD, xcd = wgid % NXCD, off = wgid / NXCD; wgid = (xcd < r ? xcd * (q + 1) : r * (q + 1) + (xcd - r) * q) + off; }
        const int nig = WGM * nN, gid = wgid / nig, fm = gid * WGM, gsz = (nM - fm) < WGM ? (nM - fm) : WGM;
        u.pm = fm + ((wgid % nig) % gsz); u.pn = (wgid % nig) / gsz; u.k0 = 0; u.nkt = K / BK; u.ks = 0; return true;
    }
    __device__ __forceinline__ void a_ready(const Unit&) const {}
    __device__ __forceinline__ void done(const Unit&) const {}
};

struct SplitOrder {
    StaticOrder P; int nN, NS, nP, G, c, K, r0;
    __host__ __device__ void init(int MPr, int N, int G_, int c_, int K_, int NS_) { P.init(MPr, N, G_, c_, K_); nN = N / BM; NS = NS_; nP = 2 * nN * NS; G = G_; c = c_; K = K_; r0 = (P.nwg + G - 1 - c) / G;   }
    __host__ __device__ __forceinline__ bool next(int i, Unit& u) const {
        Unit a; a.pm = 0; a.pn = 0; a.k0 = 0; a.nkt = K / BK; a.ks = 0;
        const bool okp = P.next(i < r0 ? i : 0, a);
        const int p = (i - r0) * G + (G - 1 - c), t = p / NS, ks = p % NS, nk = K / BK / NS;
        const bool split = i >= r0;
        u.pm = split ? P.nM + t / nN : a.pm; u.pn = split ? t % nN : a.pn; u.nkt = split ? nk : a.nkt; u.ks = split ? ks : 0; u.k0 = split ? ks * nk * BK : 0;
        return split ? (p < nP) : okp;
    }
    __device__ __forceinline__ void a_ready(const Unit&) const {}
    __device__ __forceinline__ void done(const Unit&) const {}
};

struct OneUnit {
    Unit u0;
    __host__ __device__ __forceinline__ bool next(int i, Unit& u) const { u = u0; return i == 0; }
    __device__ __forceinline__ void a_ready(const Unit&) const {}
    __device__ __forceinline__ void done(const Unit&) const {}
};
__device__ __forceinline__ void st16_wt(void* p, u32x4 v) { asm volatile("global_store_dwordx4 %0, %1, off sc1\n\ts_nop 1" :: "v"(p), "v"(v)); }
__device__ __forceinline__ void st16f_wt(void* p, f32x4 v) { asm volatile("global_store_dwordx4 %0, %1, off sc1\n\ts_nop 1" :: "v"(p), "v"(v)); }
__device__ __forceinline__ unsigned cvt_pk_bf16(float lo, float hi) { unsigned r; asm volatile("v_cvt_pk_bf16_f32 %0, %1, %2" : "=v"(r) : "v"(lo), "v"(hi)); return r; }
__device__ __forceinline__ float bf_lo(unsigned w) { return __builtin_bit_cast(float, w << 16); }
__device__ __forceinline__ float bf_hi(unsigned w) { return __builtin_bit_cast(float, w & 0xffff0000u); }

template <int ACT, bool WT = false> struct EpiBf16 {
    static constexpr bool PERM = true, AFTER_DRAIN = false;
    bf16_t* O; int ldc; const float* bias;
    __device__ __forceinline__ void operator()(const f32x4 (&acc)[2][2][4][2], const Unit& u, int wr, int wc, int fr, int fq) const {
        const int row0 = u.pm * BM + wr * 64 + fr; const int col0 = u.pn * BM + wc * 32 + 8 * fq;
        f32x4 bv[2][2];
#pragma unroll
        for (int bj = 0; bj < 2; ++bj)
#pragma unroll
            for (int n = 0; n < 2; ++n) bv[bj][n] = bias ? *(const f32x4*)(bias + col0 + bj * HALF + 4 * n) : (f32x4){0.f, 0.f, 0.f, 0.f};
#pragma unroll
        for (int ai = 0; ai < 2; ++ai)
#pragma unroll
            for (int m = 0; m < 4; ++m) { bf16_t* rowp = O + (size_t)(row0 + ai * HALF + m * 16) * ldc + col0;
#pragma unroll
                for (int bj = 0; bj < 2; ++bj) { f32x4 v0 = acc[ai][bj][m][0] + bv[bj][0], v1 = acc[ai][bj][m][1] + bv[bj][1];
                    if (ACT == 3) {
#pragma unroll
                        for (int e = 0; e < 4; ++e) { const float a = fmaxf(v0[e], 0.f), b = fmaxf(v1[e], 0.f); v0[e] = a * a; v1[e] = b * b; } }
                    u32x4 w; w.x = cvt_pk_bf16(v0[0], v0[1]); w.y = cvt_pk_bf16(v0[2], v0[3]); w.z = cvt_pk_bf16(v1[0], v1[1]); w.w = cvt_pk_bf16(v1[2], v1[3]);
                    if (WT) st16_wt(rowp + bj * HALF, w); else *(u32x4*)(rowp + bj * HALF) = w; } }
    }
};
struct EpiGlu {
    static constexpr bool PERM = true, AFTER_DRAIN = false;
    const bf16_t* Gy; int ldg; bf16_t* O; int ldc; int coff; const float* bias; bf16_t* Os; int MPs;
    __device__ __forceinline__ void operator()(const f32x4 (&acc)[2][2][4][2], const Unit& u, int wr, int wc, int fr, int fq) const {
        const int row0 = u.pm * BM + wr * 64 + fr; const int col0 = u.pn * BM + wc * 32 + 8 * fq;
        bf16_t* const Ob = u.pm * BM >= MPs ? Os - (size_t)MPs * ldc : O;
        f32x4 bv[2][2];
#pragma unroll
        for (int bj = 0; bj < 2; ++bj)
#pragma unroll
            for (int n = 0; n < 2; ++n) bv[bj][n] = *(const f32x4*)(bias + col0 + bj * HALF + 4 * n);
        constexpr int DEPTH = 4;
        u32x4 pg[DEPTH];
#define EPG_ROW(g) ((size_t)(row0 + ((g) >> 3) * HALF + (((g) >> 1) & 3) * 16))
#define EPG_COL(g) (col0 + ((g) & 1) * HALF)
#pragma unroll
        for (int g = 0; g < DEPTH; ++g) pg[g] = *(const u32x4*)(Gy + EPG_ROW(g) * ldg + EPG_COL(g));
#pragma unroll
        for (int gi = 0; gi < 16; ++gi) { const int ai = gi >> 3, m = (gi >> 1) & 3, bj = gi & 1;
            const u32x4 g = pg[gi % DEPTH];
            if (gi + DEPTH < 16) pg[gi % DEPTH] = *(const u32x4*)(Gy + EPG_ROW(gi + DEPTH) * ldg + EPG_COL(gi + DEPTH));
            const f32x4 v0 = acc[ai][bj][m][0] + bv[bj][0], v1 = acc[ai][bj][m][1] + bv[bj][1];
            float o[8];
            o[0] = bf_lo(g.x) * __builtin_amdgcn_rcpf(1.f + __builtin_amdgcn_exp2f(-1.4426950408889634f * v0[0])); o[1] = bf_hi(g.x) * __builtin_amdgcn_rcpf(1.f + __builtin_amdgcn_exp2f(-1.4426950408889634f * v0[1]));
            o[2] = bf_lo(g.y) * __builtin_amdgcn_rcpf(1.f + __builtin_amdgcn_exp2f(-1.4426950408889634f * v0[2])); o[3] = bf_hi(g.y) * __builtin_amdgcn_rcpf(1.f + __builtin_amdgcn_exp2f(-1.4426950408889634f * v0[3]));
            o[4] = bf_lo(g.z) * __builtin_amdgcn_rcpf(1.f + __builtin_amdgcn_exp2f(-1.4426950408889634f * v1[0])); o[5] = bf_hi(g.z) * __builtin_amdgcn_rcpf(1.f + __builtin_amdgcn_exp2f(-1.4426950408889634f * v1[1]));
            o[6] = bf_lo(g.w) * __builtin_amdgcn_rcpf(1.f + __builtin_amdgcn_exp2f(-1.4426950408889634f * v1[2])); o[7] = bf_hi(g.w) * __builtin_amdgcn_rcpf(1.f + __builtin_amdgcn_exp2f(-1.4426950408889634f * v1[3]));
            u32x4 w; w.x = cvt_pk_bf16(o[0], o[1]); w.y = cvt_pk_bf16(o[2], o[3]); w.z = cvt_pk_bf16(o[4], o[5]); w.w = cvt_pk_bf16(o[6], o[7]);
            *(u32x4*)(Ob + EPG_ROW(gi) * ldc + coff + EPG_COL(gi)) = w; }
#undef EPG_ROW
#undef EPG_COL
    }
};
template <bool BASE16> struct EpiRes {
    static constexpr bool PERM = true, AFTER_DRAIN = false;
    const void* basep; bf16_t* T; const float* gate  ; const float* bias; float alpha; int MP; float* slab;
    __device__ __forceinline__ void operator()(const f32x4 (&acc)[2][2][4][2], const Unit& u, int wr, int wc, int fr, int fq) const {
        const int row0 = u.pm * BM + wr * 64 + fr, col0 = u.pn * BM + wc * 32 + 8 * fq;
        if (row0 >= MP) {
            float* sp = slab + (size_t)u.ks * 512 * 1024;
#pragma unroll
            for (int ai = 0; ai < 2; ++ai)
#pragma unroll
                for (int m = 0; m < 4; ++m) { float* op = sp + (size_t)(row0 + ai * HALF + m * 16 - MP) * 1024;
#pragma unroll
                    for (int bj = 0; bj < 2; ++bj)
#pragma unroll
                        for (int n = 0; n < 2; ++n) st16f_wt(op + col0 + bj * HALF + n * 4, acc[ai][bj][m][n]); }
            return; }
        f32x4 bv[2][2], gv[2][2];
        const float* gp = gate + (size_t)(row0 >> 11) * 6144;
#pragma unroll
        for (int bj = 0; bj < 2; ++bj)
#pragma unroll
            for (int n = 0; n < 2; ++n) { bv[bj][n] = bias ? *(const f32x4*)(bias + col0 + bj * HALF + n * 4) : (f32x4){0.f, 0.f, 0.f, 0.f}; gv[bj][n] = *(const f32x4*)(gp + col0 + bj * HALF + n * 4); }
        constexpr int DEPTH = 3;
        f32x4 pb[DEPTH][2]; u32x4 pw[DEPTH];
#define EPR_ROW(g) (row0 + ((g) >> 3) * HALF + (((g) >> 1) & 3) * 16)
#define EPR_COL(g) (col0 + ((g) & 1) * HALF)
#define EPR_LOAD(g) do { if (BASE16) pw[(g) % DEPTH] = *(const u32x4*)((const bf16_t*)basep + (size_t)EPR_ROW(g) * 1024 + EPR_COL(g)); \
            else { const float* bp_ = (const float*)basep + (size_t)EPR_ROW(g) * 1024 + EPR_COL(g); pb[(g) % DEPTH][0] = *(const f32x4*)bp_; pb[(g) % DEPTH][1] = *(const f32x4*)(bp_ + 4); } } while (0)
#pragma unroll
        for (int g = 0; g < DEPTH; ++g) EPR_LOAD(g);
#pragma unroll
        for (int g = 0; g < 16; ++g) { const int ai = g >> 3, m = (g >> 1) & 3, bj = g & 1;
            f32x4 b0, b1;
            if (BASE16) { const u32x4 bw = pw[g % DEPTH]; b0 = (f32x4){bf_lo(bw.x), bf_hi(bw.x), bf_lo(bw.y), bf_hi(bw.y)}; b1 = (f32x4){bf_lo(bw.z), bf_hi(bw.z), bf_lo(bw.w), bf_hi(bw.w)}; }
            else { b0 = pb[g % DEPTH][0]; b1 = pb[g % DEPTH][1]; }
            if (g + DEPTH < 16) EPR_LOAD(g + DEPTH);
            const f32x4 v0 = b0 * alpha + gv[bj][0] * (acc[ai][bj][m][0] + bv[bj][0]), v1 = b1 * alpha + gv[bj][1] * (acc[ai][bj][m][1] + bv[bj][1]);
            u32x4 w; w.x = cvt_pk_bf16(v0[0], v0[1]); w.y = cvt_pk_bf16(v0[2], v0[3]); w.z = cvt_pk_bf16(v1[0], v1[1]); w.w = cvt_pk_bf16(v1[2], v1[3]);
            st16_wt(T + (size_t)EPR_ROW(g) * 1024 + EPR_COL(g), w); }
#undef EPR_ROW
#undef EPR_COL
#undef EPR_LOAD
    }
};

struct PieceOrder {
    int nN, NS, nP, G, c, K, nM;
    __host__ __device__ void init(int MPr, int N, int G_, int c_, int K_, int NS_) { nM = MPr / BM; nN = N / BM; NS = NS_; nP = 2 * nN * NS; G = G_; c = c_; K = K_; }
    __host__ __device__ __forceinline__ bool next(int i, Unit& u) const {
        const int p = G - 1 - c, t = p / NS, ks = p % NS, nk = K / BK / NS;
        u.pm = nM + t / nN; u.pn = t % nN; u.nkt = nk; u.ks = ks; u.k0 = ks * nk * BK; return i == 0 && p < nP;
    }
    __device__ __forceinline__ void a_ready(const Unit&) const {}
    __device__ __forceinline__ void done(const Unit&) const {}
};
struct EpiSlab {
    static constexpr bool PERM = true, AFTER_DRAIN = false;
    float* slab; int MP;
    __device__ __forceinline__ void operator()(const f32x4 (&acc)[2][2][4][2], const Unit& u, int wr, int wc, int fr, int fq) const {
        const int row0 = u.pm * BM + wr * 64 + fr, col0 = u.pn * BM + wc * 32 + 8 * fq;
        float* sp = slab + (size_t)u.ks * 512 * 1024;
#pragma unroll
        for (int ai = 0; ai < 2; ++ai)
#pragma unroll
            for (int m = 0; m < 4; ++m) { float* op = sp + (size_t)(row0 + ai * HALF + m * 16 - MP) * 1024;
#pragma unroll
                for (int bj = 0; bj < 2; ++bj)
#pragma unroll
                    for (int n = 0; n < 2; ++n) st16f_wt(op + col0 + bj * HALF + n * 4, acc[ai][bj][m][n]); }
    }
};
template <bool SECOND> struct EpiLnFused {
    static constexpr bool PERM = true, AFTER_DRAIN = true;
    const void* basep; const float* gate; const float* bias; float alpha; const float* lng; const float* lnb; const float* mod2  ;
    float* out; bf16_t* x1; bf16_t* xn; float* stat; unsigned* cnt; float eps;
    __device__ __forceinline__ void fused(f32x4 (&acc)[2][2][4][2], const Unit& u, int wr, int wc, int fr, int fq, PG8_LAS unsigned char* lds, int wid, int lane) const {
        const int row0 = u.pm * BM + wr * 64 + fr, col0 = u.pn * BM + wc * 32 + 8 * fq, tid = wid * 64 + lane;
        {
            const float* gp = gate + (size_t)(row0 >> 11) * 6144;
#pragma unroll
            for (int bj = 0; bj < 2; ++bj) { const int c = col0 + bj * HALF;
                const f32x4 g0 = *(const f32x4*)(gp + c), g1 = *(const f32x4*)(gp + c + 4);
                const f32x4 v0 = bias ? *(const f32x4*)(bias + c) : (f32x4){0.f, 0.f, 0.f, 0.f}, v1 = bias ? *(const f32x4*)(bias + c + 4) : (f32x4){0.f, 0.f, 0.f, 0.f};
                constexpr int DEPTH = 2; f32x4 pb[DEPTH][2]; u32x4 pw[DEPTH];
#define EPF_ROW(g) (row0 + ((g) >> 2) * HALF + ((g) & 3) * 16)
#define EPF_LOAD(g) do { if (SECOND) pw[(g) % DEPTH] = *(const u32x4*)((const bf16_t*)basep + (size_t)EPF_ROW(g) * 1024 + c); \
                else { const float* bp_ = (const float*)basep + (size_t)EPF_ROW(g) * 1024 + c; pb[(g) % DEPTH][0] = *(const f32x4*)bp_; pb[(g) % DEPTH][1] = *(const f32x4*)(bp_ + 4); } } while (0)
#pragma unroll
                for (int g = 0; g < DEPTH; ++g) EPF_LOAD(g);
#pragma unroll
                for (int g = 0; g < 8; ++g) { const int ai = g >> 2, m = g & 3; f32x4 b0, b1;
                    if (SECOND) { const u32x4 bw = pw[g % DEPTH]; b0 = (f32x4){bf_lo(bw.x), bf_hi(bw.x), bf_lo(bw.y), bf_hi(bw.y)}; b1 = (f32x4){bf_lo(bw.z), bf_hi(bw.z), bf_lo(bw.w), bf_hi(bw.w)}; }
                    else { b0 = pb[g % DEPTH][0]; b1 = pb[g % DEPTH][1]; }
                    if (g + DEPTH < 8) EPF_LOAD(g + DEPTH);
                    acc[ai][bj][m][0] = b0 * alpha + g0 * (acc[ai][bj][m][0] + v0); acc[ai][bj][m][1] = b1 * alpha + g1 * (acc[ai][bj][m][1] + v1);
                    asm volatile("" : "+v"(acc[ai][bj][m][0]), "+v"(acc[ai][bj][m][1]) :: "memory"); }
#undef EPF_LOAD
#undef EPF_ROW
            }
        }
        typedef float f32x2v __attribute__((ext_vector_type(2)));
        PG8_LAS f32x2v* RS = (PG8_LAS f32x2v*)lds;
        PG8_LAS f32x2v* MR = (PG8_LAS f32x2v*)(lds + 8192);
#pragma unroll
        for (int ai = 0; ai < 2; ++ai)
#pragma unroll
            for (int m = 0; m < 4; ++m) { float sa = 0.f, sq = 0.f;
#pragma unroll
                for (int bj = 0; bj < 2; ++bj)
#pragma unroll
                    for (int n = 0; n < 2; ++n) { const f32x4 x = acc[ai][bj][m][n]; sa += (x[0] + x[1]) + (x[2] + x[3]); sq += (x[0] * x[0] + x[1] * x[1]) + (x[2] * x[2] + x[3] * x[3]); }
                sa += __shfl_xor(sa, 16); sa += __shfl_xor(sa, 32); sq += __shfl_xor(sq, 16); sq += __shfl_xor(sq, 32);
                if (fq == 0) RS[(ai * HALF + wr * 64 + m * 16 + fr) * 4 + wc] = (f32x2v){sa, sq}; }
        asm volatile("s_waitcnt lgkmcnt(0)" ::: "memory"); __builtin_amdgcn_s_barrier(); asm volatile("" ::: "memory");
        if (tid < 256) { const f32x2v a = RS[tid * 4 + 0], b = RS[tid * 4 + 1], c = RS[tid * 4 + 2], d = RS[tid * 4 + 3];
            unsigned long long* slot = (unsigned long long*)stat + ((size_t)(u.pm * 4 + u.pn) * 256 + tid);
            __hip_atomic_store(slot, ((unsigned long long)__builtin_bit_cast(unsigned, (a.y + b.y) + (c.y + d.y)) << 32) | __builtin_bit_cast(unsigned, (a.x + b.x) + (c.x + d.x)), __ATOMIC_RELAXED, __HIP_MEMORY_SCOPE_AGENT); }
        asm volatile("s_waitcnt vmcnt(0)" ::: "memory"); __builtin_amdgcn_s_barrier(); asm volatile("" ::: "memory");
        if (tid == 0) { (void)__hip_atomic_fetch_add(cnt + 64 * u.pm, 1u, __ATOMIC_RELAXED, __HIP_MEMORY_SCOPE_AGENT);
            unsigned sp = 0; while (__hip_atomic_load(cnt + 64 * u.pm, __ATOMIC_RELAXED, __HIP_MEMORY_SCOPE_AGENT) < 4u && ++sp < (1u << 22)) __builtin_amdgcn_s_sleep(2);
            __builtin_amdgcn_fence(__ATOMIC_ACQUIRE, "agent"); asm volatile("s_waitcnt vmcnt(0)" ::: "memory"); }
        __builtin_amdgcn_s_barrier(); asm volatile("" ::: "memory");
        if (tid < 256) { float S = 0.f, Q = 0.f;
#pragma unroll
            for (int p = 0; p < 4; ++p) { const unsigned long long w = __hip_atomic_load((const unsigned long long*)stat + ((size_t)(u.pm * 4 + p) * 256 + tid), __ATOMIC_RELAXED, __HIP_MEMORY_SCOPE_AGENT);
                S += __builtin_bit_cast(float, (unsigned)w); Q += __builtin_bit_cast(float, (unsigned)(w >> 32)); }
            const float mean = S * (1.f / 1024.f), var = fmaxf(Q * (1.f / 1024.f) - mean * mean, 0.f);
            MR[tid] = (f32x2v){mean, 1.0f / sqrtf(var + eps)}; }
        asm volatile("s_waitcnt lgkmcnt(0)" ::: "memory"); __builtin_amdgcn_s_barrier(); asm volatile("" ::: "memory");
#pragma unroll
        for (int bj = 0; bj < 2; ++bj) { const int c = col0 + bj * HALF;
            const f32x4 g0 = *(const f32x4*)(lng + c), g1 = *(const f32x4*)(lng + c + 4), b0 = *(const f32x4*)(lnb + c), b1 = *(const f32x4*)(lnb + c + 4);
            f32x4 s0, s1, h0, h1;
            if (!SECOND) { const float* mp = mod2 + (size_t)(row0 >> 11) * 6144 + c; h0 = *(const f32x4*)mp; h1 = *(const f32x4*)(mp + 4); s0 = *(const f32x4*)(mp + 1024) + 1.f; s1 = *(const f32x4*)(mp + 1028) + 1.f; }
#pragma unroll
            for (int ai = 0; ai < 2; ++ai)
#pragma unroll
                for (int m = 0; m < 4; ++m) { const int rl = ai * HALF + wr * 64 + m * 16 + fr; const size_t row = (size_t)(u.pm * BM + rl); const f32x2v mr = MR[rl];
                    const f32x4 y0 = (acc[ai][bj][m][0] - mr.x) * mr.y * g0 + b0, y1 = (acc[ai][bj][m][1] - mr.x) * mr.y * g1 + b1;
                    if (SECOND) { *(f32x4*)(out + row * 1024 + c) = y0; *(f32x4*)(out + row * 1024 + c + 4) = y1; }
                    else { u32x4 w; w.x = cvt_pk_bf16(y0[0], y0[1]); w.y = cvt_pk_bf16(y0[2], y0[3]); w.z = cvt_pk_bf16(y1[0], y1[1]); w.w = cvt_pk_bf16(y1[2], y1[3]);
                           *(u32x4*)(x1 + row * 1024 + c) = w;
                           const f32x4 z0 = y0 * s0 + h0, z1 = y1 * s1 + h1;
                           u32x4 v; v.x = cvt_pk_bf16(z0[0], z0[1]); v.y = cvt_pk_bf16(z0[2], z0[3]); v.z = cvt_pk_bf16(z1[0], z1[1]); v.w = cvt_pk_bf16(z1[2], z1[3]);
                           *(u32x4*)(xn + row * 1024 + c) = v; } } }
        asm volatile("s_waitcnt lgkmcnt(0)" ::: "memory"); __builtin_amdgcn_s_barrier(); asm volatile("" ::: "memory");
    }
};

template <class Epi, class Sched, bool ALIGN_EPI = false, bool SP2 = false>
__device__ __forceinline__ void gemm_phase(PG8_LAS unsigned char* lds, const Gemm g, const Sched& S, const Epi& E) {
    const int tid = threadIdx.x, wid = __builtin_amdgcn_readfirstlane(tid >> 6), lane = tid & 63, wr = wid >> 2, wc = wid & 3, fr = lane & 15, fq = lane >> 4;
    const int K = g.K;
    unsigned voffA[2], voffB[2];
#pragma unroll
    for (int i = 0; i < 2; ++i) { int R, C; stage_rc(tid * 16 + i * 8192, R, C); const int Rb = Epi::PERM ? ((R & ~31) + perm32(R & 31)) : R;
        voffA[i] = (unsigned)(R * K + C) * 2u; voffB[i] = (unsigned)(Rb * K + C) * 2u; }
    const size_t kstep = (size_t)(BK * 2);
    const size_t hstep = (size_t)HALF * K * 2;
    const size_t tstep = 2 * hstep;
    const unsigned ldsw = (unsigned)wid * 1024u;
    const int aoff = lds_byte(wr * 64 + fr, fq * 8), boff = lds_byte(wc * 32 + fr, fq * 8);
#define PG8_SA(b, h) (((b) * 2 + (h)) * HTB)
#define PG8_SB(b, h) ((4 + (b) * 2 + (h)) * HTB)
#define PG8_STAGE(bufoff, gbase, voff) do { _Pragma("unroll") for (int _i = 0; _i < 2; ++_i) \
        __builtin_amdgcn_global_load_lds((const unsigned*)((const char*)(gbase) + (voff)[_i]), (PG8_LAS unsigned*)(lds + (bufoff) + ldsw + _i * 8192), 16, 0, 0); } while (0)
#define PG8_LDA(dst, b, h) do { _Pragma("unroll") for (int m = 0; m < 4; ++m) _Pragma("unroll") for (int k = 0; k < 2; ++k) dst[m][k] = *(const PG8_LAS bf16x8*)(lds + PG8_SA(b, h) + aoff + m * 2048 + k * 1024); } while (0)
#define PG8_LDB(dst, b, h) do { _Pragma("unroll") for (int n = 0; n < 2; ++n) _Pragma("unroll") for (int k = 0; k < 2; ++k) dst[n][k] = *(const PG8_LAS bf16x8*)(lds + PG8_SB(b, h) + boff + n * 2048 + k * 1024); } while (0)
#define PG8_MMA(ai, bj, At, Bt) do { __builtin_amdgcn_s_setprio(1); _Pragma("unroll") for (int m = 0; m < 4; ++m) _Pragma("unroll") for (int n = 0; n < 2; ++n) _Pragma("unroll") for (int k = 0; k < 2; ++k) \
        acc[ai][bj][m][n] = __builtin_amdgcn_mfma_f32_16x16x32_bf16(Bt[n][k], At[m][k], acc[ai][bj][m][n], 0, 0, 0); __builtin_amdgcn_s_setprio(0); } while (0)
#define PG8_WAIT_V(n) asm volatile("s_waitcnt vmcnt(" #n ")" ::: "memory")
#define PG8_WAIT_L(n) asm volatile("s_waitcnt lgkmcnt(" #n ")" ::: "memory")
#define PG8_BAR __builtin_amdgcn_s_barrier()
#define PG8_SCHED __builtin_amdgcn_sched_barrier(0)
    Unit cur, nxt; int ui = 0;
    if (!S.next(0, cur)) return;
    f32x4 acc[2][2][4][2];
#pragma unroll
    for (int a = 0; a < 2; ++a)
#pragma unroll
        for (int b = 0; b < 2; ++b)
#pragma unroll
            for (int m = 0; m < 4; ++m)
#pragma unroll
                for (int n = 0; n < 2; ++n) acc[a][b][m][n] = (f32x4){0.f, 0.f, 0.f, 0.f};
    bf16x8 At[4][2], B0[2][2], B1[2][2];
    const char* cA = (const char*)g.A + (size_t)cur.pm * tstep + (size_t)cur.k0 * 2; const char* cB = (const char*)g.Bt + (size_t)cur.pn * tstep + (size_t)cur.k0 * 2;
    S.a_ready(cur);
    if constexpr (SP2) {
        PG8_STAGE(PG8_SB(0, 0), cB, voffB); PG8_STAGE(PG8_SB(0, 1), cB + hstep, voffB); PG8_STAGE(PG8_SA(0, 0), cA, voffA); PG8_STAGE(PG8_SA(0, 1), cA + hstep, voffA);
        if (wr == 1) PG8_BAR;
        PG8_WAIT_V(2); PG8_BAR;
        PG8_STAGE(PG8_SB(1, 0), cB + kstep, voffB); PG8_STAGE(PG8_SA(1, 0), cA + kstep, voffA); PG8_STAGE(PG8_SB(1, 1), cB + hstep + kstep, voffB);
        PG8_WAIT_V(6); PG8_BAR;
    } else {
        PG8_STAGE(PG8_SB(0, 0), cB, voffB); PG8_STAGE(PG8_SA(0, 0), cA, voffA); PG8_STAGE(PG8_SB(0, 1), cB + hstep, voffB); PG8_STAGE(PG8_SA(0, 1), cA + hstep, voffA);
        if (wr == 1) PG8_BAR;
        PG8_WAIT_V(4); PG8_BAR;
        PG8_STAGE(PG8_SB(1, 0), cB + kstep, voffB); PG8_STAGE(PG8_SA(1, 0), cA + kstep, voffA); PG8_STAGE(PG8_SB(1, 1), cB + hstep + kstep, voffB);
        PG8_WAIT_V(6); PG8_BAR;
    }
    for (;;) {
        const bool has_next = S.next(ui + 1, nxt);
        const char* nA = has_next ? (const char*)g.A + (size_t)nxt.pm * tstep + (size_t)nxt.k0 * 2 : cA; const char* nB = has_next ? (const char*)g.Bt + (size_t)nxt.pn * tstep + (size_t)nxt.k0 * 2 : cB;
        const int nt = cur.nkt;
        for (int t = 0; t < nt; t += 2) {
            const bool last = (t == nt - 2);
            const char* a1 = cA + (size_t)(t + 1) * kstep;
            const char* a2 = last ? nA : cA + (size_t)(t + 2) * kstep; const char* b2 = last ? nB : cB + (size_t)(t + 2) * kstep;
            const char* a3 = a2 + kstep; const char* b3 = b2 + kstep;
            if (last && has_next) S.a_ready(nxt);
            if constexpr (SP2) {
            PG8_LDB(B0, 0, 0); PG8_LDB(B1, 0, 1); PG8_SCHED; PG8_LDA(At, 0, 0); PG8_STAGE(PG8_SA(1, 1), a1 + hstep, voffA);
            PG8_WAIT_V(8); PG8_WAIT_L(0); PG8_BAR; PG8_MMA(0, 0, At, B0); PG8_MMA(0, 1, At, B1); PG8_BAR; PG8_SCHED;
            PG8_LDA(At, 0, 1); PG8_STAGE(PG8_SB(0, 0), b2, voffB); PG8_STAGE(PG8_SB(0, 1), b2 + hstep, voffB); PG8_STAGE(PG8_SA(0, 0), a2, voffA);
            PG8_WAIT_V(8); PG8_WAIT_L(0); PG8_BAR; PG8_MMA(1, 0, At, B0); PG8_MMA(1, 1, At, B1); PG8_BAR; PG8_SCHED;
            PG8_LDB(B0, 1, 0); PG8_LDB(B1, 1, 1); PG8_SCHED; PG8_LDA(At, 1, 0); PG8_STAGE(PG8_SA(0, 1), a2 + hstep, voffA);
            PG8_WAIT_V(8); PG8_WAIT_L(0); PG8_BAR; PG8_MMA(0, 0, At, B0); PG8_MMA(0, 1, At, B1); PG8_BAR; PG8_SCHED;
            PG8_LDA(At, 1, 1); PG8_STAGE(PG8_SB(1, 0), b3, voffB); PG8_STAGE(PG8_SB(1, 1), b3 + hstep, voffB); PG8_STAGE(PG8_SA(1, 0), a3, voffA);
            PG8_WAIT_V(8); PG8_WAIT_L(0); PG8_BAR; PG8_MMA(1, 0, At, B0); PG8_MMA(1, 1, At, B1); PG8_BAR; PG8_SCHED;
            } else {
            PG8_LDB(B0, 0, 0); PG8_SCHED; PG8_LDA(At, 0, 0); PG8_STAGE(PG8_SA(1, 1), a1 + hstep, voffA);
            PG8_WAIT_L(8); PG8_BAR; PG8_WAIT_L(0); PG8_MMA(0, 0, At, B0); PG8_BAR; PG8_SCHED;
            PG8_LDB(B1, 0, 1); PG8_STAGE(PG8_SB(0, 0), b2, voffB);
            PG8_BAR; PG8_WAIT_L(0); PG8_MMA(0, 1, At, B1); PG8_BAR;
            PG8_LDA(At, 0, 1); PG8_STAGE(PG8_SA(0, 0), a2, voffA);
            PG8_BAR; PG8_WAIT_L(0); PG8_MMA(1, 0, At, B0); PG8_BAR; PG8_SCHED;
            PG8_STAGE(PG8_SB(0, 1), b2 + hstep, voffB);
            PG8_WAIT_V(6); PG8_BAR; PG8_MMA(1, 1, At, B1); PG8_BAR;
            PG8_LDB(B0, 1, 0); PG8_SCHED; PG8_LDA(At, 1, 0); PG8_STAGE(PG8_SA(0, 1), a2 + hstep, voffA);
            PG8_WAIT_L(8); PG8_BAR; PG8_WAIT_L(0); PG8_MMA(0, 0, At, B0); PG8_BAR; PG8_SCHED;
            PG8_LDB(B1, 1, 1); PG8_STAGE(PG8_SB(1, 0), b3, voffB);
            PG8_BAR; PG8_WAIT_L(0); PG8_MMA(0, 1, At, B1); PG8_BAR;
            PG8_LDA(At, 1, 1); PG8_STAGE(PG8_SA(1, 0), a3, voffA);
            PG8_BAR; PG8_WAIT_L(0); PG8_MMA(1, 0, At, B0); PG8_BAR; PG8_SCHED;
            PG8_STAGE(PG8_SB(1, 1), b3 + hstep, voffB);
            PG8_WAIT_V(6); PG8_BAR; PG8_MMA(1, 1, At, B1); PG8_BAR;
            }
        }
        if constexpr (ALIGN_EPI) { if (wr == 0) PG8_BAR; }
        if constexpr (!Epi::AFTER_DRAIN) { E(acc, cur, wr, wc, fr, fq); S.done(cur); }
        if (!has_next) break;
#pragma unroll
        for (int a = 0; a < 2; ++a)
#pragma unroll
            for (int b = 0; b < 2; ++b)
#pragma unroll
                for (int m = 0; m < 4; ++m)
#pragma unroll
                    for (int n = 0; n < 2; ++n) acc[a][b][m][n] = (f32x4){0.f, 0.f, 0.f, 0.f};
        cur = nxt; cA = nA; cB = nB; ++ui;
        if constexpr (ALIGN_EPI) { if (wr == 1) PG8_BAR; }
    }
    PG8_WAIT_V(0);
    if constexpr (!ALIGN_EPI) { if (wr == 0) PG8_BAR; }
    PG8_BAR;
    if constexpr (Epi::AFTER_DRAIN) { E.fused(acc, cur, wr, wc, fr, fq, lds, wid, lane); S.done(cur); }
#undef PG8_SA
#undef PG8_SB
#undef PG8_STAGE
#undef PG8_LDA
#undef PG8_LDB
#undef PG8_MMA
#undef PG8_WAIT_V
#undef PG8_WAIT_L
#undef PG8_BAR
#undef PG8_SCHED
}
}

#ifndef PROBE_DUP
#define PROBE_DUP 0
#endif
#ifndef PG8_SP2
#define PG8_SP2 true
#endif
#ifndef PG8_ALIGN
#define PG8_ALIGN true
#endif

constexpr int NWAVES = 8;
constexpr int N_LAUNCHES = MK_N_LAUNCHES;
constexpr int N_PHASES = 10;
constexpr int D = 1024, MP = 16384, MS = 512, M = MP + MS, TP = 2048, NBP = 8, NBS = 128, TS = 4;
constexpr int NZ = 1536, WA = 512, WB = 512, FF = 4096, NMOD = 6 * D, NROWMOD = NBP + NBS;
constexpr int GB = 32, NS5 = 64, KS5 = 16, HA = 8, HDA = 64;
constexpr float LN_EPS = 1e-5f;
constexpr int NS_OUT = 4, NS_DOWN = 8;
constexpr float ALPHA = 1.189207115002721f;

constexpr size_t O_YP = 0, O_YS = (size_t)MP * D, O_CONVP = O_YS + (size_t)MS * D, O_HP = O_CONVP + (size_t)NBP * 3 * WA, O_SRP = O_HP + (size_t)NBP * WA,
                 O_SIP = O_SRP + (size_t)NBP * GB * NS5, O_CONVS = O_SIP + (size_t)NBP * GB * NS5, O_HS = O_CONVS + (size_t)NBS * 3 * WA, O_SRS = O_HS + (size_t)NBS * WA,
                 O_SIS = O_SRS + (size_t)NBS * GB * NS5, O_END = O_SIS + (size_t)NBS * GB * NS5;

constexpr size_t MiB = 1u << 20;
constexpr size_t WS_CTL = 0, CTL_ZERO_BYTES = 128 * 1024;
constexpr size_t WS_WIN = 1 * MiB, WS_WGLU = 4 * MiB, WS_WOUT = 5 * MiB, WS_W1 = 7 * MiB, WS_W2 = 15 * MiB;
constexpr size_t WS_MOD = 23 * MiB;
constexpr size_t WS_S5C = 27 * MiB;
constexpr size_t WS_STAT = 27 * MiB + 512 * 1024;
constexpr size_t WS_XN = 28 * MiB;
constexpr size_t WS_Z = 61 * MiB;
constexpr size_t WS_YCAT = WS_XN;
constexpr size_t WS_G = 144 * MiB;
constexpr size_t WS_U = 61 * MiB;
constexpr size_t WS_T1 = WS_Z;
constexpr size_t WS_T2 = WS_XN;
constexpr size_t WS_TAB = 246 * MiB;
constexpr size_t WS_SLAB = 194 * MiB;
constexpr size_t WS_X1B = 210 * MiB;
constexpr size_t WS_YCS = 244 * MiB;
constexpr size_t WS_END = 252 * MiB;
constexpr size_t TB_BF1 = 0, TB_BF2 = TB_BF1 + 32 * 4 * 64 * 16, TB_TA = TB_BF2 + 32 * 8 * 64 * 16, TB_ZP = TB_TA + 32 * 2 * 2 * 32 * 4, TB_Z16N = TB_ZP + 32 * 17 * 2 * 2 * 32 * 4,
                 TB_RG = TB_Z16N + 32 * 2 * 64 * 4, TB_CB = TB_RG + 8 * 2 * 2 * 4 * 64 * 16, TB_SILU = TB_CB + 128 * 3 * 512 * 2, TB_DG = TB_SILU + 160 * 1024 * 2, TB_W1 = TB_DG + 8 * 16 * 64 * 16, TB_C2 = TB_W1 + 32 * 8 * 4 * 64 * 16, TB_END = TB_C2 + (size_t)32 * 8 * 8 * 64 * 16;
static_assert(WS_SLAB + (size_t)8 * 512 * 1024 * 4 <= WS_X1B && WS_X1B + (size_t)MP * D * 2 <= WS_TAB && WS_TAB + TB_END <= WS_END, "tables");
static_assert(WS_XN + (size_t)M * D * 2 <= WS_Z && WS_Z + (size_t)M * NZ * 2 <= WS_G && WS_G + (size_t)M * WB * 2 <= WS_END && WS_U + (size_t)M * FF * 2 <= WS_SLAB, "d_ws map");
constexpr int SC_ABR = 0, SC_ABI = 2048, SC_BBR = 4096, SC_BBI = 4096 + 32768, SC_RGL = 4096 + 65536, SC_END = SC_RGL + 512;
constexpr int CW_TMO = 0, CW_CODE = 1, CW_SILU = 64, CW_MOD = 1024  , CW_S5B = 128  , CW_BAR = 4096,
              CW_T1 = 8192  , CW_T2 = 12288  , CW_T1S = 16384, CW_T2S = 16448  , CW_XNS = 16512  , CW_US = 16640  ,
              CW_G1 = 20480  , CW_G2 = 24576  ;

constexpr int RING_OFF = 0, RING_BYTES = 131072;
constexpr int LDSCTL_OFF = RING_BYTES, MISC_OFF = LDSCTL_OFF + 320;
constexpr int LDS_BYTES = 147456;

#define GAS __attribute__((address_space(1)))
#define LAS __attribute__((address_space(3)))
typedef unsigned short bf16;
typedef unsigned v4u __attribute__((ext_vector_type(4)));
typedef float f32x4 __attribute__((ext_vector_type(4)));
typedef GAS unsigned gu32;
#define RLX_AGENT __ATOMIC_RELAXED, __HIP_MEMORY_SCOPE_AGENT
#define LDS_WAIT() asm volatile("s_waitcnt lgkmcnt(0)" ::: "memory")
#define VM_WAIT() asm volatile("s_waitcnt vmcnt(0)" ::: "memory")
__device__ __forceinline__ unsigned f2bf(float f) { unsigned u = __builtin_bit_cast(unsigned, f); return (u + 0x7fffu + ((u >> 16) & 1u)) >> 16; }
__device__ __forceinline__ unsigned pk2(float lo, float hi) { return f2bf(lo) | (f2bf(hi) << 16); }
__device__ __forceinline__ float bf2f(bf16 v) { return __builtin_bit_cast(float, (unsigned)v << 16); }
__device__ __forceinline__ float gelu_tanh(float x) { const float t = -2.3022082f * (x + 0.044715f * x * x * x); return x * __builtin_amdgcn_rcpf(1.f + __builtin_amdgcn_exp2f(t)); }
__device__ __forceinline__ float sigmoidf_(float x) { return __builtin_amdgcn_rcpf(1.f + __builtin_amdgcn_exp2f(-1.4426950408889634f * x)); }

#define XB_TMO      128
#define XB_XCNT(j)  (256  + 64 * (j))
#define XB_XSUB(j)  (1280 + 64 * (j))
#define XB_XGEN(j)  (2304 + 64 * (j))
#define XB_TOP      3328
#define XB_TOPGEN   3392
#define XCD_BAR_WORDS 3456
#define XB_SPIN_CAP (1u << 18)
__device__ __forceinline__ unsigned xb_ld(unsigned* p)              { return __hip_atomic_load(p, __ATOMIC_RELAXED, __HIP_MEMORY_SCOPE_AGENT); }
__device__ __forceinline__ unsigned xb_add(unsigned* p, unsigned v) { return __hip_atomic_fetch_add(p, v, __ATOMIC_RELAXED, __HIP_MEMORY_SCOPE_AGENT); }
__device__ __forceinline__ unsigned xb_xcc_id() { return (unsigned)__builtin_amdgcn_s_getreg((3 << 11) | 20) & 0xFu; }
#define XB_SPIN(cond, bar) do { unsigned _sp = 0; while (cond) { __builtin_amdgcn_s_sleep(1); \
    if ((++_sp & 255u) == 0u) { if (xb_ld(&(bar)[XB_TMO])) break; if (_sp > XB_SPIN_CAP) { atomicAdd(&(bar)[XB_TMO], 1u); break; } } } } while (0)
struct XcdBarrier { unsigned* bar; unsigned x; volatile LAS unsigned* st; };
__device__ __forceinline__ XcdBarrier xcd_barrier_post(unsigned* bar, volatile LAS unsigned* st) {
    XcdBarrier b; b.bar = bar; b.x = xb_xcc_id(); b.st = st;
    if (threadIdx.x == 0) (void)xb_add(&bar[XB_XCNT(b.x)], 1u);
    return b;
}
__device__ __forceinline__ void xcd_barrier_complete(unsigned* bar, unsigned x, unsigned& nloc, unsigned& nx) {
    const unsigned G = gridDim.x * gridDim.y * gridDim.z;
    unsigned sum, cnt, mine, sp = 0u;
    for (;;) {
        sum = 0u; cnt = 0u; mine = 0u;
#pragma unroll
        for (unsigned j = 0; j < 16; ++j) { const unsigned c = xb_ld(&bar[XB_XCNT(j)]); sum += c; cnt += (c > 0u) ? 1u : 0u; mine = (j == x) ? c : mine; }
        if (sum == G) break;
        __builtin_amdgcn_s_sleep(1);
        if ((++sp & 255u) == 0u) { if (xb_ld(&bar[XB_TMO])) break; if (sp > XB_SPIN_CAP) { atomicAdd(&bar[XB_TMO], 1u); break; } }
    }
    nloc = mine > 0u ? mine : 1u; nx = cnt > 0u ? cnt : 1u;
}
__device__ __forceinline__ void xcd_barrier(const XcdBarrier& b) {
    asm volatile("s_waitcnt vmcnt(0)" ::: "memory");
    __syncthreads();
    if (threadIdx.x == 0) {
        unsigned* bar = b.bar;
        __builtin_amdgcn_s_waitcnt(0);
        unsigned nloc = b.st[0], nx = b.st[1];
        if (nloc == 0u) { xcd_barrier_complete(bar, b.x, nloc, nx); b.st[0] = nloc; b.st[1] = nx; }
        const unsigned old = xb_add(&bar[XB_XSUB(b.x)], 1u);
        const unsigned gen = old / nloc;
        if (old + 1u == (gen + 1u) * nloc) {
            __builtin_amdgcn_fence(__ATOMIC_RELEASE, "agent");
            asm volatile("s_waitcnt vmcnt(0)" ::: "memory");
            const unsigned og = xb_add(&bar[XB_TOP], 1u);
            const unsigned tg = og / nx;
            if (og + 1u == (tg + 1u) * nx) xb_add(&bar[XB_TOPGEN], 1u);
            else XB_SPIN(xb_ld(&bar[XB_TOPGEN]) == tg, bar);
            __builtin_amdgcn_fence(__ATOMIC_ACQUIRE, "agent");
            xb_add(&bar[XB_XGEN(b.x)], 1u);
            asm volatile("s_waitcnt vmcnt(0)" ::: "memory");
        } else {
            XB_SPIN(xb_ld(&bar[XB_XGEN(b.x)]) == gen, bar);
            __builtin_amdgcn_fence(__ATOMIC_ACQUIRE, "agent");
            asm volatile("s_waitcnt vmcnt(0)" ::: "memory");
        }
    }
    __syncthreads();
}

struct Frame {
    LAS unsigned char* lds;
    volatile LAS unsigned* MISC;
    gu32* ctl;
    int tid, lane, wave;
    int vcu, G;
    float* out;
    unsigned char* ws;
};
struct Args { const float* in[37]; float* out; unsigned char* ws; int ph_lo, ph_hi, li, pad; };
__device__ __forceinline__ void refresh(Frame& F) { int t = threadIdx.x; asm volatile("" : "+v"(t)); F.tid = t; F.lane = t & 63; F.wave = __builtin_amdgcn_readfirstlane(t >> 6); }
__device__ __forceinline__ void cnt_arrive(Frame& F, int word, unsigned n = 1u) {
    VM_WAIT(); __syncthreads();
    if (F.tid == 0) { __builtin_amdgcn_fence(__ATOMIC_RELEASE, "agent"); VM_WAIT(); (void)__hip_atomic_fetch_add((unsigned*)(F.ctl + word), n, RLX_AGENT); }
}
__device__ __forceinline__ void cnt_arrive_wt(Frame& F, int word) {
    VM_WAIT(); __syncthreads();
    if (F.tid == 0) (void)__hip_atomic_fetch_add((unsigned*)(F.ctl + word), 1u, RLX_AGENT);
}
__device__ __forceinline__ void cnt_wait_ge(Frame& F, int word, unsigned target) {
    if (F.tid == 0) { unsigned sp = 0; while (__hip_atomic_load((unsigned*)(F.ctl + word), RLX_AGENT) < target && ++sp < (1u << 22)) __builtin_amdgcn_s_sleep(2);
        __builtin_amdgcn_fence(__ATOMIC_ACQUIRE, "agent"); VM_WAIT(); }
    __syncthreads();
}
__device__ __forceinline__ float wave_sum(float v) {
#pragma unroll
    for (int o = 1; o < 64; o <<= 1) v += __shfl_xor(v, o);
    return v;
}
enum { I_XP = 0, I_XS, I_SCONV, I_SH, I_SSR, I_SSI, I_CP, I_CS, I_ADAW, I_ADAB, I_INPROJ, I_CONVW, I_CONVB, I_RGWR, I_RGBR, I_RGWI, I_RGBI, I_RGLAM,
       I_S5ARE, I_S5AIM, I_S5LOGDT, I_S5BRE, I_S5BIM, I_S5CRE, I_S5CIM, I_S5D, I_GLUW, I_GLUB, I_OUTPROJ, I_LN1G, I_LN1B, I_W1, I_B1, I_W2, I_B2, I_LN2G, I_LN2B };

typedef float f32x2m __attribute__((ext_vector_type(2)));
typedef __bf16 bf16x2m __attribute__((ext_vector_type(2)));
__device__ __forceinline__ unsigned pkbf0(float a, float b) { const f32x2m v = {a, b}; const bf16x2m r = __builtin_convertvector(v, bf16x2m); return __builtin_bit_cast(unsigned, r); }
typedef short bf16x8m __attribute__((ext_vector_type(8)));
typedef float f32x16m __attribute__((ext_vector_type(16)));
__device__ __forceinline__ void p0_transpose_item(const float* W, int K, int N, bf16* WT, LAS float* scr, int item, int lane) {
    const int nblk = N / 32, kb = item / nblk, nb = item % nblk, k0 = 64 * kb, n0 = 32 * nb;
#pragma unroll 8
    for (int i = 0; i < 32; ++i) { const int kk = 2 * i + (lane >> 5); scr[kk * 33 + (lane & 31)] = W[(size_t)(k0 + kk) * N + n0 + (lane & 31)]; }
    LDS_WAIT(); asm volatile("" ::: "memory");
    const int c = lane & 7;
#pragma unroll
    for (int j = 0; j < 4; ++j) { const int n = (lane >> 3) + 8 * j; const LAS float* s = scr + (8 * c) * 33 + n;
        v4u o; o.x = pk2(s[0 * 33], s[1 * 33]); o.y = pk2(s[2 * 33], s[3 * 33]); o.z = pk2(s[4 * 33], s[5 * 33]); o.w = pk2(s[6 * 33], s[7 * 33]);
        *(GAS v4u*)(WT + (size_t)(n0 + n) * K + k0 + 8 * c) = o; }
    LDS_WAIT(); asm volatile("" ::: "memory");
}

constexpr int XI_IN = (D / 64) * (NZ / 32), XI_GL = (WB / 64) * (WB / 32), XI_OU = (D / 64) * (D / 32), XI_1 = (D / 64) * (FF / 32), XI_2 = (FF / 64) * (D / 32);
constexpr int XO_OU = XI_IN + XI_GL, XO_1 = XO_OU + XI_OU, XO_2 = XO_1 + XI_1, XO_END = XO_2 + XI_2;
__device__ __forceinline__ void xpose_item(Frame& F, const Args& A, LAS float* scr, int r) {
    if (r < XI_IN) { p0_transpose_item(A.in[I_INPROJ], D, NZ, (bf16*)(F.ws + WS_WIN), scr, r, F.lane); return; } r -= XI_IN;
    if (r < XI_GL) { p0_transpose_item(A.in[I_GLUW], WB, WB, (bf16*)(F.ws + WS_WGLU), scr, r, F.lane); return; } r -= XI_GL;
    if (r < XI_OU) { p0_transpose_item(A.in[I_OUTPROJ], D, D, (bf16*)(F.ws + WS_WOUT), scr, r, F.lane); return; } r -= XI_OU;
    if (r < XI_1) { p0_transpose_item(A.in[I_W1], D, FF, (bf16*)(F.ws + WS_W1), scr, r, F.lane); return; } r -= XI_1;
    p0_transpose_item(A.in[I_W2], FF, D, (bf16*)(F.ws + WS_W2), scr, r, F.lane);
}
__device__ __forceinline__ void xpose_range(Frame& F, const Args& A, int lo, int hi, int vlo) {
    refresh(F);
    if (F.vcu < vlo) return;
    LAS float* scr = (LAS float*)(F.lds + RING_OFF + F.wave * 16384);
    const int gw = F.wave * (F.G - vlo) + (F.vcu - vlo), ngw = (F.G - vlo) * NWAVES;
    for (int it = lo + gw; it < hi; it += ngw) xpose_item(F, A, scr, it);
}
__device__ __forceinline__ void xpose_range_b(Frame& F, const Args& A, int lo, int hi, int blo) {
    refresh(F);
    LAS float* scr = (LAS float*)(F.lds + RING_OFF + F.wave * 16384);
    const int gw = F.wave * (F.G - blo) + ((int)blockIdx.x - blo), ngw = (F.G - blo) * NWAVES;
    for (int it = lo + gw; it < hi; it += ngw) xpose_item(F, A, scr, it);
}
#ifndef PROBE_P0PART
#define PROBE_P0PART 7
#endif
__device__ __forceinline__ void p0_prologue(Frame& F, const Args& A, int rep = 0) {
    refresh(F);
    const int pmask = rep ? PROBE_P0PART : 7;
    LAS float* scr = (LAS float*)(F.lds + RING_OFF + F.wave * 16384);
    const int gw = F.wave * F.G + F.vcu, NGW = F.G * NWAVES;
    {
        bf16* ST = (bf16*)(F.ws + WS_TAB + TB_SILU);
        for (int ch = F.vcu * NWAVES * 64 + F.tid; ch < 160 * 1024 / 8; ch += F.G * NWAVES * 64) { const int row = ch >> 7, k = (ch & 127) * 8; v4u o = (v4u){0u, 0u, 0u, 0u};
            if (row < NROWMOD) { const float* cp = (row < NBP ? A.in[I_CP] + (size_t)row * D : A.in[I_CS] + (size_t)(row - NBP) * D) + k; const f32x4 c0 = *(const f32x4*)cp, c1 = *(const f32x4*)(cp + 4);
                o.x = pk2(c0[0] * sigmoidf_(c0[0]), c0[1] * sigmoidf_(c0[1])); o.y = pk2(c0[2] * sigmoidf_(c0[2]), c0[3] * sigmoidf_(c0[3]));
                o.z = pk2(c1[0] * sigmoidf_(c1[0]), c1[1] * sigmoidf_(c1[1])); o.w = pk2(c1[2] * sigmoidf_(c1[2]), c1[3] * sigmoidf_(c1[3])); }
            pg8::st16_wt(ST + (size_t)ch * 8, o); }
        cnt_arrive_wt(F, CW_SILU);
    }
    constexpr int I_IN = XI_IN, I_GL = XI_GL;
    constexpr int I_S5 = GB, I_RG = WA / 64, I_RGT = HA * 2 * 2 * 4, I_CB = NBS * 3 * WA / 512, I_DG = HA * 16, I_S5J = GB * 8;
    constexpr int NITEMS = I_IN + I_GL + I_S5 + I_RG + I_RGT + I_CB + I_DG + I_S5J;
    float* sc = (float*)(F.ws + WS_S5C);
    constexpr int VW0 = 2 * D / 32;
    for (int it = F.vcu >= VW0 ? F.wave * (F.G - VW0) + (F.vcu - VW0) : NITEMS; it < NITEMS; it += (F.G - VW0) * NWAVES) {
        int r = it;
        if (!(pmask & 1) && it < I_IN + I_GL) continue;
        if (!(pmask & 2) && it >= I_IN + I_GL) continue;
        if (r < I_IN + I_GL) { xpose_item(F, A, scr, r); continue; } r -= I_IN + I_GL;
        if (r < I_S5) {
            const int g = r, n = F.lane, gn = g * NS5 + n;
            const double dt = exp((double)A.in[I_S5LOGDT][g]), ar = (double)A.in[I_S5ARE][gn], ai = (double)A.in[I_S5AIM][gn];
            const double mag = exp(dt * ar), abr = mag * cos(dt * ai), abi = mag * sin(dt * ai), den = ar * ar + ai * ai, nr = abr - 1.0;
            const double qr = (nr * ar + abi * ai) / den, qi = (abi * ar - nr * ai) / den;
            sc[SC_ABR + gn] = (float)abr; sc[SC_ABI + gn] = (float)abi;
            unsigned char* tab = F.ws + WS_TAB;
            float* TA = (float*)(tab + TB_TA); float* ZP = (float*)(tab + TB_ZP); float* Z16N = (float*)(tab + TB_Z16N);
            const int sh = n >> 5, v = n & 31, hh = (v >> 2) & 1, ii = (v & 3) + 4 * (v >> 3);
            double bbr_[KS5], bbi_[KS5];
            for (int k = 0; k < KS5; ++k) { const double br = (double)A.in[I_S5BRE][gn * KS5 + k], bi = (double)A.in[I_S5BIM][gn * KS5 + k];
                bbr_[k] = qr * br - qi * bi; bbi_[k] = qr * bi + qi * br;
                sc[SC_BBR + gn * KS5 + k] = (float)bbr_[k]; sc[SC_BBI + gn * KS5 + k] = (float)bbi_[k]; }
            { double pr = abr, pi = abi; for (int e = 0; e < 2; ++e) { const double t = pr * pr - pi * pi; pi = 2.0 * pr * pi; pr = t; }
              TA[((g * 2 + hh) * 2 + 0) * 32 + sh * 16 + ii] = (float)pr; TA[((g * 2 + hh) * 2 + 1) * 32 + sh * 16 + ii] = (float)pi; }
            const double mg8 = exp(8.0 * dt * ar), z1r = mg8 * cos(8.0 * dt * ai), z1i = mg8 * sin(8.0 * dt * ai); double pzr = 1.0, pzi = 0.0;
            for (int e = 0; e <= 16; ++e) { const float zr = (float)pzr, zi = (float)pzi; { const double nr2 = pzr * z1r - pzi * z1i, ni2 = pzr * z1i + pzi * z1r; pzr = nr2; pzi = ni2; }
                ZP[(((g * 17 + e) * 2 + hh) * 2 + 0) * 32 + sh * 16 + ii] = zr; ZP[(((g * 17 + e) * 2 + hh) * 2 + 1) * 32 + sh * 16 + ii] = zi;
                if (e == 16) { Z16N[(g * 2 + 0) * 64 + n] = zr; Z16N[(g * 2 + 1) * 64 + n] = zi; } }
            continue; } r -= I_S5;
        if (r < I_RG) { const int c = r * 64 + F.lane; const double lam = (double)A.in[I_RGLAM][c];
          sc[SC_RGL + c] = (float)(-8.0 * log1p(exp(-lam)) * 1.4426950408889634); continue; } r -= I_RG;
        if (r >= I_RGT + I_CB + I_DG) { r -= I_RGT + I_CB + I_DG;
            const int g = r >> 3, j = r & 7, n = F.lane, gn = g * NS5 + n, sh = n >> 5;
            const double dt = exp((double)A.in[I_S5LOGDT][g]), ar = (double)A.in[I_S5ARE][gn], ai = (double)A.in[I_S5AIM][gn];
            const double mag = exp(dt * ar), abr = mag * cos(dt * ai), abi = mag * sin(dt * ai), den = ar * ar + ai * ai, nr0 = abr - 1.0;
            const double qr = (nr0 * ar + abi * ai) / den, qi = (abi * ar - nr0 * ai) / den;
            const double mgp = exp((double)(j + 1) * dt * ar), anp = (double)(j + 1) * dt * ai, pr = mgp * cos(anp), pi = mgp * sin(anp);
            const double pm2 = pr * pr + pi * pi, nr_ = pr / pm2, ni_ = -pi / pm2;
            bf16* W1T = (bf16*)(F.ws + WS_TAB + TB_W1); bf16* C2T = (bf16*)(F.ws + WS_TAB + TB_C2);
            const int s2 = (n >> 4) & 1, jj2 = 4 * ((n >> 3) & 1) + (n & 3), hk2 = (n >> 2) & 1;
#pragma unroll 4
            for (int k = 0; k < KS5; ++k) { const double br = (double)A.in[I_S5BRE][gn * KS5 + k], bi = (double)A.in[I_S5BIM][gn * KS5 + k];
                const double bbr = qr * br - qi * bi, bbi = qr * bi + qi * br;
                const float wr = (float)(nr_ * bbr - ni_ * bbi), wi = (float)(nr_ * bbi + ni_ * bbr);
                const int lp = (n & 31) + 32 * (k >> 3), jj = k & 7;
                W1T[(size_t)(((g * 8 + j) * 4 + 0 + sh) * 64 + lp) * 8 + jj] = (bf16)f2bf(wr); W1T[(size_t)(((g * 8 + j) * 4 + 2 + sh) * 64 + lp) * 8 + jj] = (bf16)f2bf(wi); }
#pragma unroll 4
            for (int ch = 0; ch < KS5; ++ch) { const int hr_ = ch >> 3, i8 = ch & 7, R = (i8 & 3) + 8 * (i8 >> 2) + 4 * hr_, lp = R + 32 * hk2;
                const double cr = (double)A.in[I_S5CRE][(size_t)(g * KS5 + ch) * NS5 + n], ci = (double)A.in[I_S5CIM][(size_t)(g * KS5 + ch) * NS5 + n];
                const float c2r = (float)(cr * pr - ci * pi), c2i = (float)(cr * pi + ci * pr);
                C2T[(size_t)(((g * 8 + j) * 8 + (0 + sh) * 2 + s2) * 64 + lp) * 8 + jj2] = (bf16)f2bf(c2r); C2T[(size_t)(((g * 8 + j) * 8 + (2 + sh) * 2 + s2) * 64 + lp) * 8 + jj2] = (bf16)f2bf(-c2i); }
            for (int z = 0; z < 4; ++z) { const int cidx = n + 64 * z, ks = cidx >> 5, r16 = cidx & 31, lp = 16 + (r16 & 15) + 32 * (r16 >> 4);
                *(v4u*)(C2T + (size_t)(((g * 8 + j) * 8 + ks) * 64 + lp) * 8) = (v4u){0u, 0u, 0u, 0u}; }
            continue; }
        if (r >= I_RGT + I_CB) { r -= I_RGT + I_CB;
            const int k = r & 3, sp = (r >> 2) & 1, tau = (r >> 3) & 1, hd = r >> 4, R = F.lane & 31, hk = F.lane >> 5;
            unsigned wv = 0u; if ((R >> 3) == 2 * sp + hk) wv = f2bf(A.in[I_CONVW][k * WA + hd * 64 + 32 * tau + R]);
            const int jj = R & 7; v4u o = (v4u){0u, 0u, 0u, 0u}; const unsigned word = (jj & 1) ? (wv << 16) : wv;
            if ((jj >> 1) == 0) o.x = word; else if ((jj >> 1) == 1) o.y = word; else if ((jj >> 1) == 2) o.z = word; else o.w = word;
            *(v4u*)(F.ws + WS_TAB + TB_DG + (size_t)(r * 64 + F.lane) * 16) = o; continue; }
        if (r >= I_RGT) { r -= I_RGT;
            const float* src = A.in[I_SCONV] + (size_t)r * 512 + F.lane * 8; const f32x4 a0 = *(const f32x4*)src, a1 = *(const f32x4*)(src + 4);
            v4u o; o.x = pk2(a0[0], a0[1]); o.y = pk2(a0[2], a0[3]); o.z = pk2(a1[0], a1[1]); o.w = pk2(a1[2], a1[3]);
            *(v4u*)(F.ws + WS_TAB + TB_CB + ((size_t)r * 512 + F.lane * 8) * 2) = o; continue; }
        {
            const int ks = r & 3, gate = (r >> 2) & 1, jh = (r >> 3) & 1, hd = r >> 4;
            const int R = F.lane & 31, hk = F.lane >> 5;
            const float* W = A.in[gate ? I_RGWI : I_RGWR] + (size_t)(hd * 64 + 32 * (ks >> 1) + 16 * (ks & 1) + 4 * hk) * 64 + 32 * jh + R;
            v4u o; o.x = pk2(W[0], W[64]); o.y = pk2(W[128], W[192]); o.z = pk2(W[8 * 64], W[9 * 64]); o.w = pk2(W[10 * 64], W[11 * 64]);
            *(v4u*)(F.ws + WS_TAB + TB_RG + (size_t)(r * 64 + F.lane) * 16) = o;
        }
    }
    __syncthreads();
    if (F.tid == 0) {
        unsigned sp = 0; while (__hip_atomic_load((unsigned*)(F.ctl + CW_SILU), RLX_AGENT) < (unsigned)F.G && ++sp < (1u << 22)) __builtin_amdgcn_s_sleep(2);
        __builtin_amdgcn_fence(__ATOMIC_ACQUIRE, "agent"); VM_WAIT(); }
    __syncthreads();
    LAS float* RED = (LAS float*)(F.lds + RING_OFF);
    float* mod = (float*)(F.ws + WS_MOD);
    const int r32 = F.lane & 31, hh = F.lane >> 5;
    const bf16* ST = (const bf16*)(F.ws + WS_TAB + TB_SILU);
#pragma unroll 1
    for (int it = F.vcu; it < ((pmask & 4) ? NMOD / 32 : 0); it += F.G) {
        const int n0 = it * 32;
        f32x16m acc[5];
#pragma unroll
        for (int rt = 0; rt < 5; ++rt)
#pragma unroll
            for (int i = 0; i < 16; ++i) acc[rt][i] = 0.f;
#pragma unroll 1
        for (int kb = 0; kb < 4; ++kb) {
            float bw[2][8]; v4u af[2][5];
#pragma unroll
            for (int ks = 0; ks < 2; ++ks) { const int k0 = F.wave * 128 + (kb * 2 + ks) * 16 + 8 * hh;
                const float* wp = A.in[I_ADAW] + (size_t)k0 * NMOD + n0 + r32;
#pragma unroll
                for (int j = 0; j < 8; ++j) bw[ks][j] = wp[(size_t)j * NMOD];
#pragma unroll
                for (int rt = 0; rt < 5; ++rt) af[ks][rt] = *(const v4u*)(ST + (size_t)(32 * rt + r32) * D + k0); }
#pragma unroll
            for (int ks = 0; ks < 2; ++ks) {
                v4u bp; bp.x = pkbf0(bw[ks][0], bw[ks][1]); bp.y = pkbf0(bw[ks][2], bw[ks][3]); bp.z = pkbf0(bw[ks][4], bw[ks][5]); bp.w = pkbf0(bw[ks][6], bw[ks][7]);
                const bf16x8m bfr = __builtin_bit_cast(bf16x8m, bp);
#pragma unroll
                for (int rt = 0; rt < 5; ++rt) acc[rt] = __builtin_amdgcn_mfma_f32_32x32x16_bf16(__builtin_bit_cast(bf16x8m, af[ks][rt]), bfr, acc[rt], 0, 0, 0); }
        }
#pragma unroll
        for (int half = 4; half >= 1; half >>= 1) {
            if (F.wave >= half && F.wave < 2 * half) {
#pragma unroll
                for (int rt = 0; rt < 5; ++rt)
#pragma unroll
                    for (int i = 0; i < 16; ++i) RED[(F.wave - half) * 5120 + (rt * 16 + i) * 64 + F.lane] = acc[rt][i]; }
            __syncthreads();
            if (F.wave < half) {
#pragma unroll
                for (int rt = 0; rt < 5; ++rt)
#pragma unroll
                    for (int i = 0; i < 16; ++i) acc[rt][i] += RED[F.wave * 5120 + (rt * 16 + i) * 64 + F.lane]; }
            __syncthreads();
        }
        if (F.wave == 0) { const float bb = A.in[I_ADAB][n0 + r32];
#pragma unroll
            for (int rt = 0; rt < 5; ++rt)
#pragma unroll
                for (int i = 0; i < 16; ++i) { const int row = 32 * rt + (i & 3) + 8 * (i >> 2) + 4 * hh; if (row < NROWMOD) __hip_atomic_store(mod + (size_t)row * NMOD + n0 + r32, acc[rt][i] + bb, RLX_AGENT); } }
        if (n0 < 2 * D) cnt_arrive_wt(F, CW_MOD);
    }
}

__device__ __forceinline__ int mod_row(int m) { return m < MP ? (m >> 11) : NBP + ((m - MP) >> 2); }
__device__ __forceinline__ const float* x_row(const Args& A, int m) { return m < MP ? A.in[I_XP] + (size_t)m * D : A.in[I_XS] + (size_t)(m - MP) * D; }

__device__ __forceinline__ void p1_modulate(Frame& F, const Args& A, int rep = 0) {
    refresh(F);
    cnt_wait_ge(F, CW_MOD, (unsigned)(2 * D / 32));
    const int gw = F.vcu * NWAVES + F.wave, NGW = F.G * NWAVES;
    const float* mod = (const float*)(F.ws + WS_MOD); bf16* XN = (bf16*)(F.ws + WS_XN);
    for (int m = gw; m < M; m += NGW) {
        const float* xr = x_row(A, m) + 8 * F.lane; const float* mr = mod + (size_t)mod_row(m) * NMOD + 8 * F.lane;
#pragma unroll
        for (int j = 0; j < 2; ++j) { const f32x4 v0 = *(const f32x4*)(xr + 512 * j), v1 = *(const f32x4*)(xr + 512 * j + 4);
            const f32x4 a0 = *(const f32x4*)(mr + 512 * j), a1 = *(const f32x4*)(mr + 512 * j + 4), s0 = *(const f32x4*)(mr + D + 512 * j), s1 = *(const f32x4*)(mr + D + 512 * j + 4);
            const f32x4 h0 = v0 * (s0 + 1.f) + a0, h1 = v1 * (s1 + 1.f) + a1;
            v4u o; o.x = pk2(h0.x, h0.y); o.y = pk2(h0.z, h0.w); o.z = pk2(h1.x, h1.y); o.w = pk2(h1.z, h1.w);
            *(v4u*)(XN + (size_t)m * D + 512 * j + 8 * F.lane) = o; }
    }
}

__device__ __forceinline__ void unpack8(const v4u w, f32x4& a, f32x4& b) { a = (f32x4){pg8::bf_lo(w.x), pg8::bf_hi(w.x), pg8::bf_lo(w.y), pg8::bf_hi(w.y)}; b = (f32x4){pg8::bf_lo(w.z), pg8::bf_hi(w.z), pg8::bf_lo(w.w), pg8::bf_hi(w.w)}; }
__device__ __forceinline__ v4u pack8f(const f32x4 a, const f32x4 b) { v4u o; o.x = pk2(a.x, a.y); o.y = pk2(a.z, a.w); o.z = pk2(b.x, b.y); o.w = pk2(b.z, b.w); return o; }
template <bool SECOND>
__device__ __forceinline__ void ln_rows(Frame& F, const Args& A, int row_lo, int row_hi, int gw, int NGW) {
    refresh(F);
    const float* mod = (const float*)(F.ws + WS_MOD); bf16* XN = (bf16*)(F.ws + WS_XN);
    const float* gg = A.in[SECOND ? I_LN2G : I_LN1G] + 8 * F.lane; const float* gb = A.in[SECOND ? I_LN2B : I_LN1B] + 8 * F.lane;
    for (int m = row_lo + gw; m < row_hi; m += NGW) {
        float* xr = F.out + (size_t)m * D + 8 * F.lane;
        f32x4 v[2][2]; float s = 0.f;
        if (m >= MP) {
            const float* mr = mod + (size_t)mod_row(m) * NMOD + (SECOND ? 5 : 2) * D + 8 * F.lane;
            const float* bs = SECOND ? xr : A.in[I_XS] + (size_t)(m - MP) * D + 8 * F.lane;
            const float* sl = (const float*)(F.ws + WS_SLAB) + (size_t)(m - MP) * D + 8 * F.lane;
#pragma unroll
            for (int j = 0; j < 2; ++j)
#pragma unroll
                for (int h = 0; h < 2; ++h) { const int o = 512 * j + 4 * h; f32x4 a = SECOND ? *(const f32x4*)(A.in[I_B2] + 8 * F.lane + o) : (f32x4){0.f, 0.f, 0.f, 0.f};
#pragma unroll
                    for (int ks = 0; ks < (SECOND ? NS_DOWN : NS_OUT); ++ks) a += *(const f32x4*)(sl + (size_t)ks * (512 * 1024) + o);
                    v[j][h] = *(const f32x4*)(bs + o) * ALPHA + *(const f32x4*)(mr + o) * a; }
        } else {
            const bf16* tr = (const bf16*)(F.ws + (SECOND ? WS_T2 : WS_T1)) + (size_t)m * D + 8 * F.lane;
#pragma unroll
            for (int j = 0; j < 2; ++j) unpack8(*(const v4u*)(tr + 512 * j), v[j][0], v[j][1]);
        }
#pragma unroll
        for (int j = 0; j < 2; ++j)
#pragma unroll
            for (int h = 0; h < 2; ++h) s += (v[j][h].x + v[j][h].y) + (v[j][h].z + v[j][h].w);
        const float mean = wave_sum(s) * (1.f / D); float s2 = 0.f;
#pragma unroll
        for (int j = 0; j < 2; ++j)
#pragma unroll
            for (int h = 0; h < 2; ++h) { v[j][h] = v[j][h] - mean; s2 += (v[j][h].x * v[j][h].x + v[j][h].y * v[j][h].y) + (v[j][h].z * v[j][h].z + v[j][h].w * v[j][h].w); }
        const float rstd = 1.f / sqrtf(wave_sum(s2) * (1.f / D) + LN_EPS);
#pragma unroll
        for (int j = 0; j < 2; ++j)
#pragma unroll
            for (int h = 0; h < 2; ++h) v[j][h] = v[j][h] * rstd * *(const f32x4*)(gg + 512 * j + 4 * h) + *(const f32x4*)(gb + 512 * j + 4 * h);
        if (SECOND || m >= MP) {
#pragma unroll
            for (int j = 0; j < 2; ++j) { *(f32x4*)(xr + 512 * j) = v[j][0]; *(f32x4*)(xr + 512 * j + 4) = v[j][1]; }
        } else {
            bf16* x1 = (bf16*)(F.ws + WS_X1B) + (size_t)m * D + 8 * F.lane;
#pragma unroll
            for (int j = 0; j < 2; ++j) *(v4u*)(x1 + 512 * j) = pack8f(v[j][0], v[j][1]);
        }
        if (!SECOND) {
            const float* mr = mod + (size_t)mod_row(m) * NMOD + 8 * F.lane;
#pragma unroll
            for (int j = 0; j < 2; ++j) { const int o = 512 * j;
                const f32x4 h0 = v[j][0] * (*(const f32x4*)(mr + 4 * D + o) + 1.f) + *(const f32x4*)(mr + 3 * D + o), h1 = v[j][1] * (*(const f32x4*)(mr + 4 * D + o + 4) + 1.f) + *(const f32x4*)(mr + 3 * D + o + 4);
                pg8::st16_wt(XN + (size_t)m * D + o + 8 * F.lane, pack8f(h0, h1)); }
        }
    }
}

__device__ __forceinline__ void rg_item_ref(Frame& F, const Args& A, bool prompt, int b, int hd, LAS float* scr) {
    const int j = F.lane, c = hd * HDA + j;
    const bf16* Z = (const bf16*)(F.ws + WS_Z); bf16* Y = (bf16*)(F.ws + WS_YCAT); const float* sc = (const float*)(F.ws + WS_S5C);
    float wr[64], wi[64];
#pragma unroll
    for (int i = 0; i < 64; ++i) { wr[i] = A.in[I_RGWR][(size_t)(hd * 64 + i) * 64 + j]; wi[i] = A.in[I_RGWI][(size_t)(hd * 64 + i) * 64 + j]; }
    const float br = A.in[I_RGBR][c], bi = A.in[I_RGBI][c], L2 = sc[SC_RGL + c];
    const float w0 = A.in[I_CONVW][c], w1 = A.in[I_CONVW][WA + c], w2 = A.in[I_CONVW][2 * WA + c], w3 = A.in[I_CONVW][3 * WA + c], cb = A.in[I_CONVB][c];
    int T, m0; float x3, x2, x1, h;
    if (prompt) { T = TP; m0 = b * TP; x3 = 0.f; x2 = 0.f; x1 = 0.f; h = 0.f; }
    else { T = TS; m0 = MP + b * TS; x3 = A.in[I_SCONV][(size_t)(b * 3 + 0) * WA + c]; x2 = A.in[I_SCONV][(size_t)(b * 3 + 1) * WA + c]; x1 = A.in[I_SCONV][(size_t)(b * 3 + 2) * WA + c]; h = A.in[I_SH][(size_t)b * WA + c]; }
    for (int t = 0; t < T; ++t) {
        const size_t m = (size_t)(m0 + t);
        const float xa = bf2f(Z[m * NZ + WA + c]), gate = bf2f(Z[m * NZ + c]);
        const float xc = cb + w0 * x3 + w1 * x2 + w2 * x1 + w3 * xa; x3 = x2; x2 = x1; x1 = xa;
        scr[j] = xc; LDS_WAIT(); asm volatile("" ::: "memory");
        float rp = br, gp = bi;
#pragma unroll
        for (int i4 = 0; i4 < 16; ++i4) { const f32x4 v = *(const LAS f32x4*)(scr + 4 * i4);
            rp += v[0] * wr[4 * i4] + v[1] * wr[4 * i4 + 1] + v[2] * wr[4 * i4 + 2] + v[3] * wr[4 * i4 + 3];
            gp += v[0] * wi[4 * i4] + v[1] * wi[4 * i4 + 1] + v[2] * wi[4 * i4 + 2] + v[3] * wi[4 * i4 + 3]; }
        LDS_WAIT(); asm volatile("" ::: "memory");
        const float r = sigmoidf_(rp), gi = sigmoidf_(gp);
        const float a = exp2f(r * L2);
        float mult = sqrtf(fmaxf(1.f - a * a, 0.f));
        if (prompt && t == 0) mult = 1.f;
        h = a * h + mult * gi * xc;
        Y[m * D + c] = (bf16)f2bf(gelu_tanh(gate) * h);
    }
    float* oc = F.out + (prompt ? O_CONVP : O_CONVS); float* oh = F.out + (prompt ? O_HP : O_HS);
    oc[(size_t)(b * 3 + 0) * WA + c] = x3; oc[(size_t)(b * 3 + 1) * WA + c] = x2; oc[(size_t)(b * 3 + 2) * WA + c] = x1;
    oh[(size_t)b * WA + c] = h;
}
__device__ __forceinline__ void s5_item_ref(Frame& F, const Args& A, bool prompt, int b, int g, LAS float* scr) {
    const int n = F.lane, gn = g * NS5 + n, k = F.lane & 15, part = F.lane >> 4;
    const bf16* Z = (const bf16*)(F.ws + WS_Z); bf16* Gy = (bf16*)(F.ws + WS_G); const float* sc = (const float*)(F.ws + WS_S5C);
    float bbr[16], bbi[16], cre[16], cim[16];
#pragma unroll
    for (int i = 0; i < 16; ++i) { bbr[i] = sc[SC_BBR + gn * KS5 + i]; bbi[i] = sc[SC_BBI + gn * KS5 + i];
        cre[i] = A.in[I_S5CRE][(size_t)(g * KS5 + k) * NS5 + part * 16 + i]; cim[i] = A.in[I_S5CIM][(size_t)(g * KS5 + k) * NS5 + part * 16 + i]; }
    const float abr = sc[SC_ABR + gn], abi = sc[SC_ABI + gn], dk = A.in[I_S5D][g * KS5 + k];
    int T, m0; float hr, hi;
    if (prompt) { T = TP; m0 = b * TP; hr = 0.f; hi = 0.f; }
    else { T = TS; m0 = MP + b * TS; hr = A.in[I_SSR][(size_t)(b * GB + g) * NS5 + n]; hi = A.in[I_SSI][(size_t)(b * GB + g) * NS5 + n]; }
    for (int t = 0; t < T; ++t) {
        const size_t m = (size_t)(m0 + t);
        const bf16* zr = Z + m * NZ + 2 * WA + g * KS5;
        const v4u u0 = *(const v4u*)zr, u1 = *(const v4u*)(zr + 8);
        float u[16];
        u[0] = pg8::bf_lo(u0.x); u[1] = pg8::bf_hi(u0.x); u[2] = pg8::bf_lo(u0.y); u[3] = pg8::bf_hi(u0.y); u[4] = pg8::bf_lo(u0.z); u[5] = pg8::bf_hi(u0.z); u[6] = pg8::bf_lo(u0.w); u[7] = pg8::bf_hi(u0.w);
        u[8] = pg8::bf_lo(u1.x); u[9] = pg8::bf_hi(u1.x); u[10] = pg8::bf_lo(u1.y); u[11] = pg8::bf_hi(u1.y); u[12] = pg8::bf_lo(u1.z); u[13] = pg8::bf_hi(u1.z); u[14] = pg8::bf_lo(u1.w); u[15] = pg8::bf_hi(u1.w);
        float bur = 0.f, bui = 0.f;
#pragma unroll
        for (int i = 0; i < 16; ++i) { bur += bbr[i] * u[i]; bui += bbi[i] * u[i]; }
        const float nhr = abr * hr - abi * hi + bur, nhi = abr * hi + abi * hr + bui; hr = nhr; hi = nhi;
        scr[n] = hr; scr[64 + n] = hi; LDS_WAIT(); asm volatile("" ::: "memory");
        float p = 0.f;
#pragma unroll
        for (int i4 = 0; i4 < 4; ++i4) { const f32x4 vr = *(const LAS f32x4*)(scr + part * 16 + 4 * i4), vi = *(const LAS f32x4*)(scr + 64 + part * 16 + 4 * i4);
#pragma unroll
            for (int e = 0; e < 4; ++e) p += vr[e] * cre[4 * i4 + e] - vi[e] * cim[4 * i4 + e]; }
        LDS_WAIT(); asm volatile("" ::: "memory");
        p += __shfl_xor(p, 16); p += __shfl_xor(p, 32);
        const float uk = bf2f(zr[k]);
        if (F.lane < 16) Gy[m * WB + g * KS5 + k] = (bf16)f2bf(gelu_tanh(p + dk * uk));
    }
    float* osr = F.out + (prompt ? O_SRP : O_SRS); float* osi = F.out + (prompt ? O_SIP : O_SIS);
    osr[(size_t)(b * GB + g) * NS5 + n] = hr; osi[(size_t)(b * GB + g) * NS5 + n] = hi;
}

typedef short bf16x8v __attribute__((ext_vector_type(8)));
typedef float f32x16 __attribute__((ext_vector_type(16)));
typedef float f32x2v __attribute__((ext_vector_type(2)));
typedef __bf16 bf16x2v __attribute__((ext_vector_type(2)));
#define MFMA32(a, b, c) __builtin_amdgcn_mfma_f32_32x32x16_bf16((a), (b), (c), 0, 0, 0)
__device__ __forceinline__ unsigned pkbf(float a, float b) { const f32x2v v = {a, b}; const bf16x2v r = __builtin_convertvector(v, bf16x2v); return __builtin_bit_cast(unsigned, r); }
template <int CTRL> __device__ __forceinline__ float dppf(float old, float v) { return __builtin_bit_cast(float, __builtin_amdgcn_update_dpp(__builtin_bit_cast(int, old), __builtin_bit_cast(int, v), CTRL, 0xF, 0xF, false)); }
__device__ __forceinline__ f32x16 ld16(const float* p) { f32x16 r;
#pragma unroll
    for (int i = 0; i < 4; ++i) { const f32x4 v = *(const f32x4*)(p + 4 * i); r[4 * i] = v[0]; r[4 * i + 1] = v[1]; r[4 * i + 2] = v[2]; r[4 * i + 3] = v[3]; }
    return r; }
__device__ __forceinline__ f32x16 ld16l(const LAS float* p) { f32x16 r;
#pragma unroll
    for (int i = 0; i < 4; ++i) { const f32x4 v = *(const LAS f32x4*)(p + 4 * i); r[4 * i] = v[0]; r[4 * i + 1] = v[1]; r[4 * i + 2] = v[2]; r[4 * i + 3] = v[3]; }
    return r; }
__device__ __forceinline__ bf16x8v pack8(const f32x16& x, int s) { v4u p; p.x = pkbf(x[8 * s], x[8 * s + 1]); p.y = pkbf(x[8 * s + 2], x[8 * s + 3]); p.z = pkbf(x[8 * s + 4], x[8 * s + 5]); p.w = pkbf(x[8 * s + 6], x[8 * s + 7]); return __builtin_bit_cast(bf16x8v, p); }
template <int CTRL> __device__ __forceinline__ void s5_scan_step(f32x16& xr, f32x16& xi, const f32x16& zr, const f32x16& zi) {
#pragma unroll
    for (int i = 0; i < 16; ++i) { const float sr = dppf<CTRL>(0.f, xr[i]), si = dppf<CTRL>(0.f, xi[i]);
        xr[i] += zr[i] * sr - zi[i] * si; xi[i] += zr[i] * si + zi[i] * sr; }
}
constexpr int S5L_W1 = 0, S5L_C2 = 32768, S5L_TOT = 98304, S5L_CAR = 106496, S5L_ZP = 114688, S5L_TA = 123392;
static_assert(S5L_TA + 512 <= RING_BYTES, "S5 LDS map");
template <bool SECOND>
__device__ __forceinline__ void s5_step(LAS unsigned char* L, int lane, int j, const bf16x8v u, f32x16& gr0, f32x16& gr1, f32x16& gi0, f32x16& gi1, const float (&dk)[8], bf16* gout) {
    const LAS bf16x8v* a1 = (const LAS bf16x8v*)(L + S5L_W1) + j * 256 + lane;
    gr0 = MFMA32(a1[0], u, gr0); gr1 = MFMA32(a1[64], u, gr1); gi0 = MFMA32(a1[128], u, gi0); gi1 = MFMA32(a1[192], u, gi1);
    if (SECOND) {
        const LAS bf16x8v* a2 = (const LAS bf16x8v*)(L + S5L_C2) + j * 512 + lane;
        f32x16 y;
#pragma unroll
        for (int i = 0; i < 16; ++i) y[i] = 0.f;
        y = MFMA32(a2[0 * 64], pack8(gr0, 0), y); y = MFMA32(a2[1 * 64], pack8(gr0, 1), y);
        y = MFMA32(a2[2 * 64], pack8(gr1, 0), y); y = MFMA32(a2[3 * 64], pack8(gr1, 1), y);
        y = MFMA32(a2[4 * 64], pack8(gi0, 0), y); y = MFMA32(a2[5 * 64], pack8(gi0, 1), y);
        y = MFMA32(a2[6 * 64], pack8(gi1, 0), y); y = MFMA32(a2[7 * 64], pack8(gi1, 1), y);
        const v4u uw = __builtin_bit_cast(v4u, u);
        float o[8];
        o[0] = gelu_tanh(y[0] + dk[0] * pg8::bf_lo(uw.x)); o[1] = gelu_tanh(y[1] + dk[1] * pg8::bf_hi(uw.x));
        o[2] = gelu_tanh(y[2] + dk[2] * pg8::bf_lo(uw.y)); o[3] = gelu_tanh(y[3] + dk[3] * pg8::bf_hi(uw.y));
        o[4] = gelu_tanh(y[4] + dk[4] * pg8::bf_lo(uw.z)); o[5] = gelu_tanh(y[5] + dk[5] * pg8::bf_hi(uw.z));
        o[6] = gelu_tanh(y[6] + dk[6] * pg8::bf_lo(uw.w)); o[7] = gelu_tanh(y[7] + dk[7] * pg8::bf_hi(uw.w));
        v4u w; w.x = pkbf(o[0], o[1]); w.y = pkbf(o[2], o[3]); w.z = pkbf(o[4], o[5]); w.w = pkbf(o[6], o[7]);
        pg8::st16_wt(gout, w);
    }
}
__device__ __forceinline__ void s5_cmul(const LAS float* p, f32x16& r0, f32x16& r1, f32x16& i0, f32x16& i1) {
    { const f32x16 zr = ld16l(p), zi = ld16l(p + 32); const f32x16 t = zr * r0 - zi * i0; i0 = zr * i0 + zi * r0; r0 = t; }
    asm volatile("" : "+v"(r0), "+v"(i0) :: "memory");
    { const f32x16 zr = ld16l(p + 16), zi = ld16l(p + 48); const f32x16 t = zr * r1 - zi * i1; i1 = zr * i1 + zi * r1; r1 = t; }
    asm volatile("" : "+v"(r1), "+v"(i1) :: "memory");
}
__device__ __forceinline__ void s5_stage_tables(Frame& F, LAS unsigned char* L, const unsigned char* tab, int g) {
    const v4u* s1 = (const v4u*)(tab + TB_W1) + (size_t)g * 2048; const v4u* s2 = (const v4u*)(tab + TB_C2) + (size_t)g * 4096;
#pragma unroll
    for (int k = 0; k < 4; ++k) ((LAS v4u*)(L + S5L_W1))[F.tid + 512 * k] = s1[F.tid + 512 * k];
#pragma unroll
    for (int k = 0; k < 8; ++k) ((LAS v4u*)(L + S5L_C2))[F.tid + 512 * k] = s2[F.tid + 512 * k];
    const v4u* s3 = (const v4u*)(tab + TB_ZP) + (size_t)g * (17 * 128 / 4); for (int e = F.tid; e < 17 * 128 / 4; e += NWAVES * 64) ((LAS v4u*)(L + S5L_ZP))[e] = s3[e];
    if (F.tid < 32) ((LAS v4u*)(L + S5L_TA))[F.tid] = ((const v4u*)(tab + TB_TA) + (size_t)g * 32)[F.tid];
}
__device__ __forceinline__ void s5_item_fast(Frame& F, const Args& A, int b, int g) {
    refresh(F);
    const int lane = F.lane, q = lane & 31, hh = lane >> 5, w = F.wave, c = w * 32 + q;
    LAS unsigned char* L = F.lds + RING_OFF;
    const unsigned char* tab = F.ws + WS_TAB;
    const size_t m0 = (size_t)b * TP + (size_t)8 * c;
    const bf16* zrow = (const bf16*)(F.ws + WS_Z) + m0 * NZ + 2 * WA + g * KS5 + 8 * hh;
    bf16* grow = (bf16*)(F.ws + WS_G) + m0 * WB + g * KS5 + 8 * hh;
    bf16x8v uu[8];
#pragma unroll
    for (int j = 0; j < 8; ++j) uu[j] = *(const bf16x8v*)(zrow + (size_t)j * NZ);
    s5_stage_tables(F, L, tab, g);
    __syncthreads();
    f32x16 hr0, hr1, hi0, hi1;
#pragma unroll
    for (int i = 0; i < 16; ++i) { hr0[i] = 0.f; hr1[i] = 0.f; hi0[i] = 0.f; hi1[i] = 0.f; }
    float dk[8];
#pragma unroll
    for (int i = 0; i < 8; ++i) dk[i] = A.in[I_S5D][g * KS5 + 8 * hh + i];
#pragma unroll
    for (int j = 0; j < 8; ++j) s5_step<false>(L, lane, j, uu[j], hr0, hr1, hi0, hi1, dk, nullptr);
    const LAS float* ZP = (const LAS float*)(L + S5L_ZP);
    s5_cmul(ZP + ((1 * 2 + hh) * 2) * 32, hr0, hr1, hi0, hi1);
#define S5_SCAN(E, CTRL) do { const LAS float* z = ZP + (((E) * 2 + hh) * 2) * 32; \
        { const f32x16 zr = ld16l(z), zi = ld16l(z + 32); s5_scan_step<CTRL>(hr0, hi0, zr, zi); } \
        asm volatile("" : "+v"(hr0), "+v"(hi0) :: "memory"); \
        { const f32x16 zr = ld16l(z + 16), zi = ld16l(z + 48); s5_scan_step<CTRL>(hr1, hi1, zr, zi); } \
        asm volatile("" : "+v"(hr1), "+v"(hi1) :: "memory"); } while (0)
    S5_SCAN(1, 0x111); S5_SCAN(2, 0x112); S5_SCAN(4, 0x114); S5_SCAN(8, 0x118);
#undef S5_SCAN
    const int seg = w * 2 + (q >> 4);
    LAS float* TOT = (LAS float*)(L + S5L_TOT); LAS float* CAR = (LAS float*)(L + S5L_CAR);
    if ((lane & 15) == 15) {
#pragma unroll
        for (int rho = 0; rho < 4; ++rho) {
            *(LAS f32x4*)(TOT + (seg * 2 + 0) * 64 + 0 + 8 * rho + 4 * hh) = (f32x4){hr0[4 * rho], hr0[4 * rho + 1], hr0[4 * rho + 2], hr0[4 * rho + 3]};
            *(LAS f32x4*)(TOT + (seg * 2 + 0) * 64 + 32 + 8 * rho + 4 * hh) = (f32x4){hr1[4 * rho], hr1[4 * rho + 1], hr1[4 * rho + 2], hr1[4 * rho + 3]};
            *(LAS f32x4*)(TOT + (seg * 2 + 1) * 64 + 0 + 8 * rho + 4 * hh) = (f32x4){hi0[4 * rho], hi0[4 * rho + 1], hi0[4 * rho + 2], hi0[4 * rho + 3]};
            *(LAS f32x4*)(TOT + (seg * 2 + 1) * 64 + 32 + 8 * rho + 4 * hh) = (f32x4){hi1[4 * rho], hi1[4 * rho + 1], hi1[4 * rho + 2], hi1[4 * rho + 3]}; }
    }
    __syncthreads();
    if (F.tid < 64) {
        const float* z16 = (const float*)(tab + TB_Z16N) + (size_t)g * 128; const float zr = z16[F.tid], zi = z16[64 + F.tid];
        float cr = 0.f, ci = 0.f;
#pragma unroll
        for (int sg = 0; sg < 16; ++sg) { CAR[(sg * 2 + 0) * 64 + F.tid] = cr; CAR[(sg * 2 + 1) * 64 + F.tid] = ci;
            const float tr = TOT[(sg * 2 + 0) * 64 + F.tid], ti = TOT[(sg * 2 + 1) * 64 + F.tid];
            const float ncr = zr * cr - zi * ci + tr, nci = zr * ci + zi * cr + ti; cr = ncr; ci = nci; }
    }
    __syncthreads();
    {
        const LAS float* z = ZP + (((q & 15) * 2 + hh) * 2) * 32;
#define S5_EXCL(HR, HI, OFF) do { const f32x16 zr = ld16l(z + (OFF)), zi = ld16l(z + 32 + (OFF)); f32x16 kr, ki; \
        _Pragma("unroll") for (int rho = 0; rho < 4; ++rho) { \
            const f32x4 a0 = *(const LAS f32x4*)(CAR + (seg * 2 + 0) * 64 + 2 * (OFF) + 8 * rho + 4 * hh), b0 = *(const LAS f32x4*)(CAR + (seg * 2 + 1) * 64 + 2 * (OFF) + 8 * rho + 4 * hh); \
            _Pragma("unroll") for (int e = 0; e < 4; ++e) { kr[4 * rho + e] = a0[e]; ki[4 * rho + e] = b0[e]; } } \
        _Pragma("unroll") for (int i = 0; i < 16; ++i) { const float sr = dppf<0x111>(0.f, HR[i]), si = dppf<0x111>(0.f, HI[i]); \
            HR[i] = sr + zr[i] * kr[i] - zi[i] * ki[i]; HI[i] = si + zr[i] * ki[i] + zi[i] * kr[i]; } } while (0)
        S5_EXCL(hr0, hi0, 0); asm volatile("" : "+v"(hr0), "+v"(hi0) :: "memory"); S5_EXCL(hr1, hi1, 16); asm volatile("" : "+v"(hr1), "+v"(hi1) :: "memory");
#undef S5_EXCL
    }
#pragma unroll
    for (int j = 0; j < 8; ++j) s5_step<true>(L, lane, j, uu[j], hr0, hr1, hi0, hi1, dk, grow + (size_t)j * WB);
    if (w == NWAVES - 1 && q == 31) {
        s5_cmul(ZP + ((1 * 2 + hh) * 2) * 32, hr0, hr1, hi0, hi1);
        float* osr = F.out + O_SRP + (size_t)(b * GB + g) * NS5; float* osi = F.out + O_SIP + (size_t)(b * GB + g) * NS5;
#pragma unroll
        for (int i = 0; i < 16; ++i) { const int n = (i & 3) + 8 * (i >> 2) + 4 * hh; osr[n] = hr0[i]; osr[32 + n] = hr1[i]; osi[n] = hi0[i]; osi[32 + n] = hi1[i]; }
    }
    __syncthreads();
}

__device__ __forceinline__ void s5_item_sample(Frame& F, const Args& A, int g) {
    refresh(F);
    const int lane = F.lane, q = lane & 31, hh = lane >> 5, w = F.wave;
    LAS unsigned char* L = F.lds + RING_OFF;
    const unsigned char* tab = F.ws + WS_TAB;
    s5_stage_tables(F, L, tab, g);
    __syncthreads();
    if (w < 4) {
        const int b = w * 32 + q;
        f32x16 hr0, hr1, hi0, hi1;
        const float* sr = A.in[I_SSR] + (size_t)(b * GB + g) * NS5; const float* si = A.in[I_SSI] + (size_t)(b * GB + g) * NS5;
#pragma unroll
        for (int rho = 0; rho < 4; ++rho) { const f32x4 a0 = *(const f32x4*)(sr + 8 * rho + 4 * hh), a1 = *(const f32x4*)(sr + 32 + 8 * rho + 4 * hh), b0 = *(const f32x4*)(si + 8 * rho + 4 * hh), b1 = *(const f32x4*)(si + 32 + 8 * rho + 4 * hh);
#pragma unroll
            for (int e = 0; e < 4; ++e) { hr0[4 * rho + e] = a0[e]; hr1[4 * rho + e] = a1[e]; hi0[4 * rho + e] = b0[e]; hi1[4 * rho + e] = b1[e]; } }
        float dk[8];
#pragma unroll
        for (int i = 0; i < 8; ++i) dk[i] = A.in[I_S5D][g * KS5 + 8 * hh + i];
        const size_t m0 = (size_t)MP + (size_t)b * TS;
        const bf16* zrow = (const bf16*)(F.ws + WS_Z) + m0 * NZ + 2 * WA + g * KS5 + 8 * hh;
        bf16* grow = (bf16*)(F.ws + WS_G) + m0 * WB + g * KS5 + 8 * hh;
        bf16x8v uu[TS];
#pragma unroll
        for (int j = 0; j < TS; ++j) uu[j] = *(const bf16x8v*)(zrow + (size_t)j * NZ);
#pragma unroll
        for (int j = 0; j < TS; ++j) s5_step<true>(L, lane, j, uu[j], hr0, hr1, hi0, hi1, dk, grow + (size_t)j * WB);
        s5_cmul((const LAS float*)(L + S5L_TA) + hh * 64, hr0, hr1, hi0, hi1);
        float* osr = F.out + O_SRS + (size_t)(b * GB + g) * NS5; float* osi = F.out + O_SIS + (size_t)(b * GB + g) * NS5;
#pragma unroll
        for (int rho = 0; rho < 4; ++rho) {
            *(f32x4*)(osr + 8 * rho + 4 * hh) = (f32x4){hr0[4 * rho], hr0[4 * rho + 1], hr0[4 * rho + 2], hr0[4 * rho + 3]};
            *(f32x4*)(osr + 32 + 8 * rho + 4 * hh) = (f32x4){hr1[4 * rho], hr1[4 * rho + 1], hr1[4 * rho + 2], hr1[4 * rho + 3]};
            *(f32x4*)(osi + 8 * rho + 4 * hh) = (f32x4){hi0[4 * rho], hi0[4 * rho + 1], hi0[4 * rho + 2], hi0[4 * rho + 3]};
            *(f32x4*)(osi + 32 + 8 * rho + 4 * hh) = (f32x4){hi1[4 * rho], hi1[4 * rho + 1], hi1[4 * rho + 2], hi1[4 * rho + 3]}; }
    }
    __syncthreads();
}

template <int CTRL, int RMASK> __device__ __forceinline__ float dppm(float old, float v) { return __builtin_bit_cast(float, __builtin_amdgcn_update_dpp(__builtin_bit_cast(int, old), __builtin_bit_cast(int, v), CTRL, RMASK, 0xF, false)); }
template <int CTRL, int RMASK> __device__ __forceinline__ void rg_scan_step(f32x16& a, f32x16& b) {
#pragma unroll
    for (int i = 0; i < 16; ++i) { const float as = dppm<CTRL, RMASK>(1.f, a[i]), bs = dppm<CTRL, RMASK>(0.f, b[i]); b[i] = a[i] * bs + b[i]; a[i] = a[i] * as; }
}
constexpr int RGL_AFR = 0, RGL_DG = 8192, RGL_TOT = 24576, RGL_CST = 28672;
constexpr int RGL_XAP = 144;
constexpr int RGL_XA0 = 29696, RGL_BUF = 37376;
static_assert(259 * RGL_XAP <= RGL_BUF && RGL_XA0 + 2 * RGL_BUF <= RING_BYTES && RGL_CST + 640 <= RGL_XA0, "RG-LRU LDS map");
template <bool SAMPLE>
__device__ __forceinline__ void rg_item_fast(Frame& F, const Args& A, int b, int hd, int jh) {
    refresh(F);
    const int lane = F.lane, q = lane & 31, hh = lane >> 5, w = F.wave;
    LAS unsigned char* L = F.lds + RING_OFF;
    const float* sc = (const float*)(F.ws + WS_S5C);
    const bf16* Zb = (const bf16*)(F.ws + WS_Z) + (size_t)(SAMPLE ? MP : b * TP) * NZ; bf16* Yb = SAMPLE ? (bf16*)(F.ws + WS_YCS) : (bf16*)(F.ws + WS_YCAT) + (size_t)(b * TP) * D;
    const bf16* CB = (const bf16*)(F.ws + WS_TAB + TB_CB);
    auto stage_load = [&](int T0, v4u (&st)[5]) {
#pragma unroll
        for (int k = 0; k < 5; ++k) { const int ci = F.tid + 512 * k; v4u v = (v4u){0u, 0u, 0u, 0u};
            if (ci < 2072) { const int tk = T0 - 3 + (ci >> 3); if (tk >= 0) v = *(const v4u*)(Zb + (size_t)tk * NZ + WA + hd * 64 + (ci & 7) * 8); }
            st[k] = v; } };
    auto stage_write = [&](int par, const v4u (&st)[5]) {
#pragma unroll
        for (int k = 0; k < 5; ++k) { const int ci = F.tid + 512 * k;
            if (ci < 2072) *(LAS v4u*)(L + RGL_XA0 + par * RGL_BUF + (ci >> 3) * RGL_XAP + (ci & 7) * 16) = st[k]; } };
    {
        const v4u* src = (const v4u*)(F.ws + WS_TAB + TB_RG) + (size_t)((hd * 2 + jh) * 8) * 64;
        ((LAS v4u*)(L + RGL_AFR))[F.tid] = src[F.tid];
        const v4u* sd = (const v4u*)(F.ws + WS_TAB + TB_DG) + (size_t)(hd * 16) * 64;
        ((LAS v4u*)(L + RGL_DG))[F.tid] = sd[F.tid]; ((LAS v4u*)(L + RGL_DG))[512 + F.tid] = sd[512 + F.tid];
        if (F.tid < 160) { const int h2 = F.tid / 80, kind = (F.tid % 80) / 16, i = F.tid % 16, cr = (i & 3) + 8 * (i >> 2) + 4 * h2;
            const int c = hd * 64 + 32 * jh + cr;
            ((LAS float*)(L + RGL_CST))[F.tid] = kind == 0 ? A.in[I_RGBR][c] : kind == 1 ? A.in[I_RGBI][c] : kind == 2 ? sc[SC_RGL + c] : A.in[I_CONVB][hd * 64 + 32 * (kind - 3) + cr]; }
        if (!SAMPLE && jh == 0 && F.tid < 192) { const int k = F.tid >> 6, ch = F.tid & 63;
            F.out[O_CONVP + (size_t)(b * 3 + k) * WA + hd * 64 + ch] = bf2f(((const bf16*)(F.ws + WS_Z))[(size_t)(b * TP + TP - 3 + k) * NZ + WA + hd * 64 + ch]); }
        if (SAMPLE && jh == 0) { for (int e = F.tid; e < NBS * 3 * 64; e += NWAVES * 64) { const int bb = e / 192, k = (e / 64) % 3, ch = e & 63;
            F.out[O_CONVS + (size_t)(bb * 3 + k) * WA + hd * 64 + ch] = bf2f(((const bf16*)(F.ws + WS_Z))[(size_t)(MP + bb * TS + 1 + k) * NZ + WA + hd * 64 + ch]); } }
        if (!SAMPLE) { v4u st[5]; stage_load(0, st); stage_write(0, st); }
    }
    __syncthreads();
    float hround[16];
#pragma unroll
    for (int i = 0; i < 16; ++i) hround[i] = 0.f;
    const LAS float* CST = (const LAS float*)(L + RGL_CST) + hh * 80;
    const LAS bf16x8v* af = (const LAS bf16x8v*)(L + RGL_AFR) + lane;
    const LAS bf16x8v* dg = (const LAS bf16x8v*)(L + RGL_DG) + lane;
#pragma unroll 1
    for (int rd = 0; rd < (SAMPLE ? 2 : 8); ++rd) {
        const int t = rd * 256 + w * 32 + q;
        v4u stn[5];
        if (!SAMPLE) stage_load((rd + 1) * 256, stn);
        const LAS unsigned char* XAp = L + RGL_XA0 + (rd & 1) * RGL_BUF + (w * 32 + q) * RGL_XAP + 16 * hh;
        const bf16* zsr[4];
        if (SAMPLE) {
#pragma unroll
            for (int k = 0; k < 4; ++k) { const int jx = (t & 3) + k; zsr[k] = (jx < 3 ? CB + (size_t)((t >> 2) * 3 + jx) * WA : Zb + (size_t)(t - 3 + k) * NZ + WA) + hd * 64 + 8 * hh; } }
        const bf16* gr = Zb + (size_t)t * NZ + hd * 64 + 32 * jh + 4 * hh;
        unsigned long long gq[4];
#pragma unroll
        for (int rho = 0; rho < 4; ++rho) gq[rho] = *(const unsigned long long*)(gr + 8 * rho);
        f32x16 dx0, dx1;
        { const f32x4 c0 = *(const LAS f32x4*)(CST + 48), c1 = *(const LAS f32x4*)(CST + 52), c2 = *(const LAS f32x4*)(CST + 56), c3 = *(const LAS f32x4*)(CST + 60);
          const f32x4 e0 = *(const LAS f32x4*)(CST + 64), e1 = *(const LAS f32x4*)(CST + 68), e2 = *(const LAS f32x4*)(CST + 72), e3 = *(const LAS f32x4*)(CST + 76);
#pragma unroll
          for (int e = 0; e < 4; ++e) { dx0[e] = c0[e]; dx0[4 + e] = c1[e]; dx0[8 + e] = c2[e]; dx0[12 + e] = c3[e]; dx1[e] = e0[e]; dx1[4 + e] = e1[e]; dx1[8 + e] = e2[e]; dx1[12 + e] = e3[e]; } }
#pragma unroll
        for (int k = 0; k < 4; ++k)
#pragma unroll
            for (int s4 = 0; s4 < 4; ++s4) {
                const bf16x8v xb = SAMPLE ? *(const bf16x8v*)(zsr[k] + 16 * s4) : *(const LAS bf16x8v*)(XAp + k * RGL_XAP + s4 * 32);
                if (s4 < 2) dx0 = MFMA32(dg[((0 * 2 + (s4 & 1)) * 4 + k) * 64], xb, dx0); else dx1 = MFMA32(dg[((1 * 2 + (s4 & 1)) * 4 + k) * 64], xb, dx1);
                if (s4 == 3) asm volatile("" : "+v"(dx0), "+v"(dx1) :: "memory"); }
        f32x16 dr, di;
#pragma unroll
        for (int i = 0; i < 16; ++i) { dr[i] = 0.f; di[i] = 0.f; }
        { const bf16x8v b00 = pack8(dx0, 0), b01 = pack8(dx0, 1), b10 = pack8(dx1, 0), b11 = pack8(dx1, 1);
          dr = MFMA32(af[0 * 64], b00, dr); di = MFMA32(af[4 * 64], b00, di); dr = MFMA32(af[1 * 64], b01, dr); di = MFMA32(af[5 * 64], b01, di);
          dr = MFMA32(af[2 * 64], b10, dr); di = MFMA32(af[6 * 64], b10, di); dr = MFMA32(af[3 * 64], b11, dr); di = MFMA32(af[7 * 64], b11, di); }
        f32x16 av, bv;
        const bool first = !SAMPLE && (t == 0);
#pragma unroll
        for (int i = 0; i < 16; ++i) { const float xcv = jh ? dx1[i] : dx0[i];
            const float r = sigmoidf_(dr[i] + CST[i]), gi = sigmoidf_(di[i] + CST[16 + i]);
            const float a = __builtin_amdgcn_exp2f(r * CST[32 + i]);
            float mult = __builtin_amdgcn_sqrtf(fmaxf(1.f - a * a, 0.f)); if (first) mult = 1.f;
            av[i] = a; bv[i] = mult * gi * xcv; }
        if (SAMPLE && (t & 3) == 0) {
            const float* h0 = A.in[I_SH] + (size_t)(t >> 2) * WA + hd * 64 + 32 * jh + 4 * hh;
#pragma unroll
            for (int i = 0; i < 16; ++i) { bv[i] += av[i] * h0[(i & 3) + 8 * (i >> 2)]; av[i] = 0.f; } }
        rg_scan_step<0x111, 0xF>(av, bv); rg_scan_step<0x112, 0xF>(av, bv); rg_scan_step<0x114, 0xF>(av, bv); rg_scan_step<0x118, 0xF>(av, bv);
        rg_scan_step<0x142, 0xA>(av, bv);
        float hin[16];
#pragma unroll
        for (int i = 0; i < 16; ++i) hin[i] = 0.f;
        if (!SAMPLE) {
        LAS float* TOT = (LAS float*)(L + RGL_TOT) + (rd & 1) * 512;
        if (q == 31) {
#pragma unroll
            for (int i4 = 0; i4 < 4; ++i4) { *(LAS f32x4*)(TOT + (w * 2 + 0) * 32 + hh * 16 + 4 * i4) = (f32x4){av[4 * i4], av[4 * i4 + 1], av[4 * i4 + 2], av[4 * i4 + 3]};
                                             *(LAS f32x4*)(TOT + (w * 2 + 1) * 32 + hh * 16 + 4 * i4) = (f32x4){bv[4 * i4], bv[4 * i4 + 1], bv[4 * i4 + 2], bv[4 * i4 + 3]}; }
        }
        stage_write((rd + 1) & 1, stn);
        __syncthreads();
#pragma unroll
        for (int w2 = 0; w2 < 8; ++w2) {
            if (w2 == w) {
#pragma unroll
                for (int i = 0; i < 16; ++i) hin[i] = hround[i]; }
#pragma unroll
            for (int i4 = 0; i4 < 4; ++i4) { const f32x4 p = *(const LAS f32x4*)(TOT + (w2 * 2 + 0) * 32 + hh * 16 + 4 * i4), hl = *(const LAS f32x4*)(TOT + (w2 * 2 + 1) * 32 + hh * 16 + 4 * i4);
#pragma unroll
                for (int e = 0; e < 4; ++e) hround[4 * i4 + e] = p[e] * hround[4 * i4 + e] + hl[e]; }
        }
        }
        bf16* yr = Yb + (size_t)t * D + hd * 64 + 32 * jh + 4 * hh;
#pragma unroll
        for (int rho = 0; rho < 4; ++rho) { const unsigned glo = (unsigned)gq[rho], ghi = (unsigned)(gq[rho] >> 32);
            const float o0 = gelu_tanh(pg8::bf_lo(glo)) * (bv[4 * rho] + av[4 * rho] * hin[4 * rho]), o1 = gelu_tanh(pg8::bf_hi(glo)) * (bv[4 * rho + 1] + av[4 * rho + 1] * hin[4 * rho + 1]);
            const float o2 = gelu_tanh(pg8::bf_lo(ghi)) * (bv[4 * rho + 2] + av[4 * rho + 2] * hin[4 * rho + 2]), o3 = gelu_tanh(pg8::bf_hi(ghi)) * (bv[4 * rho + 3] + av[4 * rho + 3] * hin[4 * rho + 3]);
            *(unsigned long long*)(yr + 8 * rho) = (unsigned long long)pkbf(o0, o1) | ((unsigned long long)pkbf(o2, o3) << 32); }
        if (SAMPLE && (t & 3) == 3) {
#pragma unroll
            for (int i = 0; i < 16; ++i) F.out[O_HS + (size_t)(t >> 2) * WA + hd * 64 + 32 * jh + (i & 3) + 8 * (i >> 2) + 4 * hh] = bv[i]; }
    }
    if (!SAMPLE && w == 0 && q == 0) {
#pragma unroll
        for (int i = 0; i < 16; ++i) F.out[O_HP + (size_t)b * WA + hd * 64 + 32 * jh + (i & 3) + 8 * (i >> 2) + 4 * hh] = hround[i];
    }
    __syncthreads();
}

#ifndef PROBE_P3PART
#define PROBE_P3PART 7
#endif
__device__ __forceinline__ void p3_mixers_ref(Frame& F, const Args& A, int rep = 0) {
    constexpr int N_RGP = NBP * HA, N_S5P = NBP * GB;
    const int pm = rep ? PROBE_P3PART : 7;
    bf16* GY = (bf16*)(F.ws + WS_G); bf16* YC = (bf16*)(F.ws + WS_YCAT);
    pg8::Gemm gg{GY, (const bf16*)(F.ws + WS_WGLU), M, WB, WB}; pg8::EpiGlu EG{GY, WB, YC, D, WA, A.in[I_GLUB], (bf16*)(F.ws + WS_YCS), MP};
    pg8::OneUnit SG; SG.u0.pm = 0; SG.u0.pn = 0; SG.u0.k0 = 0; SG.u0.nkt = WB / 64; SG.u0.ks = 0; bool has_glu = false;
    if (F.vcu < 2 * N_RGP) {
        if ((pm & 4) && F.vcu < GB) { s5_item_sample(F, A, F.vcu); cnt_arrive_wt(F, CW_S5B + 64 * NBP); }
        if (pm & 1) rg_item_fast<false>(F, A, F.vcu / (2 * HA), (F.vcu / 2) % HA, F.vcu & 1);
        if (pm & 4) { if (F.vcu < GB) { }
                      else if (F.vcu < GB + 2 * HA) rg_item_fast<true>(F, A, 0, (F.vcu - GB) >> 1, (F.vcu - GB) & 1);
                      else if (F.vcu < GB + 2 * HA + 4) {
                          cnt_wait_ge(F, CW_S5B + 64 * NBP, (unsigned)GB); const int u = F.vcu - GB - 2 * HA; SG.u0.pm = MP / 256 + (u >> 1); SG.u0.pn = u & 1; has_glu = true; } }
    } else {
        const int v = F.vcu - 2 * N_RGP, it = 2 * v, bb = it / GB;
        if (pm & 2) { s5_item_fast(F, A, bb, it % GB);
                      s5_item_fast(F, A, bb, (it + 1) % GB);
                      cnt_arrive_wt(F, CW_S5B + 64 * bb);
                      cnt_wait_ge(F, CW_S5B + 64 * bb, 16u);
                      const int u = v & 15; SG.u0.pm = 8 * bb + (u >> 1); SG.u0.pn = u & 1; has_glu = true; }
    }
    if (has_glu) pg8::gemm_phase<pg8::EpiGlu, pg8::OneUnit, false, PG8_SP2>(F.lds + RING_OFF, gg, SG, EG);
    if (rep == 0 && F.vcu >= GB + 2 * HA + 4 && F.vcu < 2 * N_RGP) {
        constexpr int X0 = GB + 2 * HA + 4, NX = 2 * N_RGP - X0;
        LAS float* scr = (LAS float*)(F.lds + RING_OFF + F.wave * 16384);
        for (int it = XO_2 + F.wave * NX + (F.vcu - X0); it < XO_END; it += NX * NWAVES) xpose_item(F, A, scr, it); }
}

template <bool SECOND>
__device__ __forceinline__ void ln_phase(Frame& F, const Args& A, int rep) {
    pg8::StaticOrder P; P.init(MP, D, F.G, (int)blockIdx.x, D); pg8::Unit u; P.next(0, u);
    cnt_wait_ge(F, (SECOND ? CW_T2 : CW_T1) + 64 * u.pm, 4u);
    ln_rows<SECOND>(F, A, u.pm * 256 + u.pn * 64, u.pm * 256 + u.pn * 64 + 64, F.wave, NWAVES);
    constexpr int NPC = 2 * (D / 256) * (SECOND ? NS_DOWN : NS_OUT);
    const int si = (int)blockIdx.x - (F.G - NPC);
    if (si >= 0) { cnt_wait_ge(F, SECOND ? CW_T2S : CW_T1S, (unsigned)NPC);
        ln_rows<SECOND>(F, A, MP + si * (MS / NPC), MP + (si + 1) * (MS / NPC), F.wave, NWAVES); }
}
__device__ __forceinline__ int down_piece_of(int bx) { return (bx >= 32 && bx < 64) ? bx - 32 : (bx >= 96 && bx < 128) ? bx - 64 : -1; }
__global__ void __launch_bounds__(NWAVES * 64, 2) fwd(Args A) {
    extern __shared__ __attribute__((aligned(16))) unsigned char lds[];
    Frame F;
    F.lds = (LAS unsigned char*)lds;
    F.MISC = (volatile LAS unsigned*)(F.lds + MISC_OFF);
    F.tid = threadIdx.x; F.lane = F.tid & 63; F.wave = __builtin_amdgcn_readfirstlane(F.tid >> 6);
    F.G = gridDim.x; { const int bx = blockIdx.x; F.vcu = (F.G % 8 == 0) ? (bx % 8) * (F.G / 8) + bx / 8 : bx; }
    F.out = A.out; F.ws = A.ws; F.ctl = (gu32*)(A.ws + WS_CTL);
    for (int u = F.tid; u < (LDS_BYTES - LDSCTL_OFF) / 4; u += NWAVES * 64) ((LAS unsigned*)(F.lds + LDSCTL_OFF))[u] = 0u;
    __syncthreads();
    XcdBarrier bar; bar.bar = (unsigned*)(F.ctl + CW_BAR); bar.x = 0; bar.st = nullptr;
    if (N_LAUNCHES == 1) bar = xcd_barrier_post((unsigned*)(F.ctl + CW_BAR), F.MISC + 8);
#define GRID_BAR() do { if (N_LAUNCHES == 1) xcd_barrier(bar); } while (0)
    const int lo = A.ph_lo, hi = A.ph_hi;
#define IN(k) (lo <= (k) && (k) < hi)
#define BOTH(k) (IN(k) && IN((k) + 1))
    bf16* XN = (bf16*)(F.ws + WS_XN); bf16* Z = (bf16*)(F.ws + WS_Z); bf16* YC = (bf16*)(F.ws + WS_YCAT); bf16* GY = (bf16*)(F.ws + WS_G); bf16* U = (bf16*)(F.ws + WS_U);
    const float* mod = (const float*)(F.ws + WS_MOD);

#define REPS(k) (((PROBE_DUP) >> (k)) & 1 ? 2 : 1)
#define PH0(rep) p0_prologue(F, A, rep)
#define PH1(rep) p1_modulate(F, A, rep)
#define PH2(rep) do {     \
        pg8::Gemm g{XN, (const bf16*)(F.ws + WS_WIN), M, NZ, D}; pg8::StaticOrder S; S.init(M, NZ, F.G, (int)blockIdx.x, D); \
        pg8::EpiBf16<0> E{Z, NZ, nullptr}; \
        pg8::gemm_phase<pg8::EpiBf16<0>, pg8::StaticOrder, PG8_ALIGN, PG8_SP2>(F.lds + RING_OFF, g, S, E); \
        if ((rep) == 0 && (int)blockIdx.x >= (M / 256) * (NZ / 256) - F.G) { __syncthreads(); xpose_range_b(F, A, XO_OU, XO_2, (M / 256) * (NZ / 256) - F.G); } } while (0)
#define PH3(rep) p3_mixers_ref(F, A, rep)
#define PH4(rep) do { } while (0)
#define PH5(rep) do {     \
        pg8::Gemm g{YC, (const bf16*)(F.ws + WS_WOUT), M, D, D}; \
        { pg8::StaticOrder S; S.init(MP, D, F.G, (int)blockIdx.x, D); \
          pg8::EpiLnFused<false> E{A.in[I_XP], mod + 2 * D, nullptr, ALPHA, A.in[I_LN1G], A.in[I_LN1B], mod + 3 * D, nullptr, (bf16*)(F.ws + WS_X1B), XN, (float*)(F.ws + WS_STAT), (unsigned*)(F.ctl + CW_T1), LN_EPS}; \
          pg8::gemm_phase<pg8::EpiLnFused<false>, pg8::StaticOrder, false, PG8_SP2>(F.lds + RING_OFF, g, S, E); \
          pg8::Unit u5; if (S.next(0, u5)) cnt_arrive(F, CW_G1 + 64 * u5.pm); }     \
        { pg8::PieceOrder S; S.init(MP, D, F.G, (int)blockIdx.x, D, NS_OUT); pg8::EpiSlab E{(float*)(F.ws + WS_SLAB), MP}; \
          pg8::Gemm gs{(const bf16*)(F.ws + WS_YCS) - (size_t)MP * D, (const bf16*)(F.ws + WS_WOUT), M, D, D};     \
          pg8::gemm_phase<pg8::EpiSlab, pg8::PieceOrder, false, PG8_SP2>(F.lds + RING_OFF, gs, S, E); \
          if ((int)blockIdx.x >= F.G - S.nP) cnt_arrive_wt(F, CW_T1S); } } while (0)
#define PH6(rep) do {     \
        constexpr int NPC1 = 2 * (D / 256) * NS_OUT; const int si1 = (int)blockIdx.x - (F.G - NPC1); \
        if (si1 >= 0) { cnt_wait_ge(F, CW_T1S, (unsigned)NPC1); ln_rows<false>(F, A, MP + si1 * (MS / NPC1), MP + (si1 + 1) * (MS / NPC1), F.wave, NWAVES); cnt_arrive_wt(F, CW_XNS); } } while (0)
#define PH7(rep) do {     \
        pg8::Gemm g{XN, (const bf16*)(F.ws + WS_W1), M, FF, D}; pg8::EpiBf16<3> E{U, FF, A.in[I_B1]}; \
        { pg8::StaticOrder S; S.init(MP, FF, F.G, (int)blockIdx.x, D); pg8::Unit u7; \
          { int prev = -1; for (int i = 0; S.next(i, u7); ++i) if (u7.pm != prev) { prev = u7.pm; cnt_wait_ge(F, CW_G1 + 64 * prev, (unsigned)(D / 256)); } }     \
          pg8::gemm_phase<pg8::EpiBf16<3>, pg8::StaticOrder, PG8_ALIGN, PG8_SP2>(F.lds + RING_OFF, g, S, E); \
          { int prev = -1, n = 0; for (int i = 0; S.next(i, u7); ++i) { if (u7.pm != prev && n) { cnt_arrive(F, CW_G2 + 64 * prev, (unsigned)n); n = 0; } prev = u7.pm; ++n; } \
            if (n) cnt_arrive(F, CW_G2 + 64 * prev, (unsigned)n); } }     \
        if ((int)blockIdx.x < 2 * (FF / 256)) { cnt_wait_ge(F, CW_XNS, (unsigned)(2 * (D / 256) * NS_OUT)); \
          pg8::OneUnit S; S.u0.pm = MP / 256 + (int)blockIdx.x / (FF / 256); S.u0.pn = (int)blockIdx.x % (FF / 256); S.u0.k0 = 0; S.u0.nkt = D / 64; S.u0.ks = 0; \
          pg8::EpiBf16<3, true> EW{U, FF, A.in[I_B1]}; \
          pg8::gemm_phase<pg8::EpiBf16<3, true>, pg8::OneUnit, false, PG8_SP2>(F.lds + RING_OFF, g, S, EW); cnt_arrive_wt(F, CW_US); } } while (0)
#define PH8(rep) do {     \
        pg8::Gemm g{U, (const bf16*)(F.ws + WS_W2), M, D, FF}; \
        { pg8::StaticOrder S; S.init(MP, D, F.G, (int)blockIdx.x, FF); \
          { pg8::Unit u8; if (S.next(0, u8)) cnt_wait_ge(F, CW_G2 + 64 * u8.pm, (unsigned)(FF / 256)); }     \
          pg8::EpiLnFused<true> E{(const bf16*)(F.ws + WS_X1B), mod + 5 * D, A.in[I_B2], ALPHA, A.in[I_LN2G], A.in[I_LN2B], nullptr, F.out, nullptr, nullptr, (float*)(F.ws + WS_STAT), (unsigned*)(F.ctl + CW_T2), LN_EPS}; \
          pg8::gemm_phase<pg8::EpiLnFused<true>, pg8::StaticOrder, false, PG8_SP2>(F.lds + RING_OFF, g, S, E); } \
        { const int dp = down_piece_of((int)blockIdx.x);     \
          pg8::PieceOrder S; S.init(MP, D, F.G, dp >= 0 ? F.G - 1 - dp : F.G - 1 - 2 * (D / 256) * NS_DOWN, FF, NS_DOWN); pg8::EpiSlab E{(float*)(F.ws + WS_SLAB), MP}; \
          if (dp >= 0) cnt_wait_ge(F, CW_US, (unsigned)(2 * (FF / 256)));     \
          pg8::gemm_phase<pg8::EpiSlab, pg8::PieceOrder, false, PG8_SP2>(F.lds + RING_OFF, g, S, E); \
          if (dp >= 0) cnt_arrive_wt(F, CW_T2S); } } while (0)
#define RUNNB(k, PH) do { if (IN(k)) { PH(0); if (REPS(k) == 2) { __syncthreads(); PH(1); } } } while (0)
#define RUN(k, PH) do { if (IN(k)) { PH(0); if (REPS(k) == 2) { __syncthreads(); PH(1); } if (BOTH(k)) GRID_BAR(); } } while (0)
    if (IN(0)) { PH0(0); if (REPS(0) == 2) { __syncthreads(); PH0(1); } if (IN(0) && !IN(1)) { } }
    RUN(1, PH1); RUN(2, PH2); RUN(3, PH3); RUNNB(5, PH5); RUNNB(6, PH6); RUNNB(7, PH7); RUNNB(8, PH8);
    if (IN(9)) {
        constexpr int NPC = 2 * (D / 256) * NS_DOWN; const int si = down_piece_of((int)blockIdx.x);
        if (si >= 0) { cnt_wait_ge(F, CW_T2S, (unsigned)NPC); ln_rows<true>(F, A, MP + si * (MS / NPC), MP + (si + 1) * (MS / NPC), F.wave, NWAVES); } }
#undef IN
#undef BOTH
}

extern "C" void kernel_launch(void* const* d_in, const int* in_sizes, int n_in, void* d_out, int out_size, void* d_ws, size_t ws_size, hipStream_t stream) {
    static int grid = 0;
    if (grid == 0) {
        if (n_in != 37 || in_sizes[0] != MP * D || out_size != (int)O_END || ws_size < WS_END) { fprintf(stderr, "kernel_launch: unexpected shapes (n_in %d, in0 %d, out %d, ws %zu)\n", n_in, n_in > 0 ? in_sizes[0] : -1, out_size, ws_size); grid = -1; return; }
        int dev = 0, cus = 0, per_cu = 0;
        if (hipGetDevice(&dev) != hipSuccess || hipDeviceGetAttribute(&cus, hipDeviceAttributeMultiprocessorCount, dev) != hipSuccess) { grid = -1; return; }
        if (hipFuncSetAttribute((const void*)fwd, hipFuncAttributeMaxDynamicSharedMemorySize, LDS_BYTES) != hipSuccess) { fprintf(stderr, "kernel_launch: hipFuncSetAttribute failed\n"); grid = -1; return; }
        if (hipOccupancyMaxActiveBlocksPerMultiprocessor(&per_cu, (const void*)fwd, NWAVES * 64, LDS_BYTES) != hipSuccess || per_cu < 1) { fprintf(stderr, "kernel_launch: occupancy query says %d\n", per_cu); }
        (void)hipGetLastError();
        grid = cus;
        if (grid < 256) { fprintf(stderr, "kernel_launch: this build needs 256 CUs (got %d)\n", grid); grid = -1; return; }
        grid = 256;
    }
    if (grid < 0) return;
    (void)hipMemsetAsync((char*)d_ws + WS_CTL, 0, CTL_ZERO_BYTES, stream);
    Args a{};
    for (int i = 0; i < 37; ++i) a.in[i] = (const float*)d_in[i];
    a.out = (float*)d_out; a.ws = (unsigned char*)d_ws;
    for (int li = 0; li < N_LAUNCHES; ++li) {
        if (N_LAUNCHES == 1) { a.ph_lo = 0; a.ph_hi = N_PHASES; } else { a.ph_lo = li; a.ph_hi = li + 1; }
        a.li = li;
        hipLaunchKernelGGL(fwd, dim3(grid), dim3(NWAVES * 64), LDS_BYTES, stream, a);
    }
}
```

```cpp
#include <hip/hip_runtime.h>
#include <cstdio>
#include <cstdint>
#include <cmath>

#ifndef MK_N_LAUNCHES
#define MK_N_LAUNCHES 1
#endif

namespace pg8 {
#define PG8_LAS __attribute__((address_space(3)))
typedef unsigned short bf16_t;
typedef short bf16x8 __attribute__((ext_vector_type(8)));
typedef float f32x4 __attribute__((ext_vector_type(4)));
typedef unsigned u32x4 __attribute__((ext_vector_type(4)));
constexpr int BM = 256, BK = 64, HALF = 128, HTB = HALF * BK * 2, STAGE_BYTES = 8 * HTB, NXCD = 8, WGM = 8;

__host__ __device__ __forceinline__ int lds_byte(int r, int c) { const int st = (r >> 4) * 2 + (c >> 5), rr = r & 15, cc = c & 31, ob = rr * 64 + cc * 2; return st * 1024 + (ob ^ (((ob >> 9) & 1) << 5)); }
__host__ __device__ __forceinline__ void stage_rc(int b, int& R, int& C) { const int st = b / 1024, sb = b % 1024, swz = sb ^ (((sb >> 9) & 1) << 5); R = (st >> 1) * 16 + swz / 64; C = (st & 1) * 32 + (swz % 64) / 2; }
__host__ __device__ __forceinline__ int perm32(int rho) { const int n = rho >> 4, i = rho & 15; return 8 * (i >> 2) + 4 * n + (i & 3); }

struct Unit { int pm, pn, k0, nkt, ks; };
struct Gemm { const bf16_t* A; const bf16_t* Bt; int M, N, K; };

struct StaticOrder {
    int nM, nN, nwg, G, c, K;
    __host__ __device__ void init(int M, int N, int G_, int c_, int K_) { nM = M / BM; nN = N / BM; nwg = nM * nN; G = G_; c = c_; K = K_; }
    __host__ __device__ __forceinline__ bool next(int i, Unit& u) const {
        const long L = (long)i * G + c; if (L >= nwg) return false;
        int wgid = (int)L; { const int q = nwg / NXCD, r = nwg % NXCD, xcd = wgid % NXCD, off = wgid / NXCD; wgid = (xcd < r ? xcd * (q + 1) : r * (q + 1) + (xcd - r) * q) + off; }
        const int nig = WGM * nN, gid = wgid / nig, fm = gid * WGM, gsz = (nM - fm) < WGM ? (nM - fm) : WGM;
        u.pm = fm + ((wgid % nig) % gsz); u.pn = (wgid % nig) / gsz; u.k0 = 0; u.nkt = K / BK; u.ks = 0; return true;
    }
    __device__ __forceinline__ void a_ready(const Unit&) const {}
    __device__ __forceinline__ void done(const Unit&) const {}
};

struct SplitOrder {
    StaticOrder P; int nN, NS, nP, G, c, K, r0;
    __host__ __device__ void init(int MPr, int N, int G_, int c_, int K_, int NS_) { P.init(MPr, N, G_, c_, K_); nN = N / BM; NS = NS_; nP = 2 * nN * NS; G = G_; c = c_; K = K_; r0 = (P.nwg + G - 1 - c) / G;   }
    __host__ __device__ __forceinline__ bool next(int i, Unit& u) const {
        Unit a; a.pm = 0; a.pn = 0; a.k0 = 0; a.nkt = K / BK; a.ks = 0;
        const bool okp = P.next(i < r0 ? i : 0, a);
        const int p = (i - r0) * G + (G - 1 - c), t = p / NS, ks = p % NS, nk = K / BK / NS;
        const bool split = i >= r0;
        u.pm = split ? P.nM + t / nN : a.pm; u.pn = split ? t % nN : a.pn; u.nkt = split ? nk : a.nkt; u.ks = split ? ks : 0; u.k0 = split ? ks * nk * BK : 0;
        return split ? (p < nP) : okp;
    }
    __device__ __forceinline__ void a_ready(const Unit&) const {}
    __device__ __forceinline__ void done(const Unit&) const {}
};

struct OneUnit {
    Unit u0;
    __host__ __device__ __forceinline__ bool next(int i, Unit& u) const { u = u0; return i == 0; }
    __device__ __forceinline__ void a_ready(const Unit&) const {}
    __device__ __forceinline__ void done(const Unit&) const {}
};
__device__ __forceinline__ void st16_wt(void* p, u32x4 v) { asm volatile("global_store_dwordx4 %0, %1, off sc1\n\ts_nop 1" :: "v"(p), "v"(v)); }
__device__ __forceinline__ void st16f_wt(void* p, f32x4 v) { asm volatile("global_store_dwordx4 %0, %1, off sc1\n\ts_nop 1" :: "v"(p), "v"(v)); }
__device__ __forceinline__ unsigned cvt_pk_bf16(float lo, float hi) { unsigned r; asm volatile("v_cvt_pk_bf16_f32 %0, %1, %2" : "=v"(r) : "v"(lo), "v"(hi)); return r; }
__device__ __forceinline__ float bf_lo(unsigned w) { return __builtin_bit_cast(float, w << 16); }
__device__ __forceinline__ float bf_hi(unsigned w) { return __builtin_bit_cast(float, w & 0xffff0000u); }

template <int ACT, bool WT = false> struct EpiBf16 {
    static constexpr bool PERM = true, AFTER_DRAIN = false;
    bf16_t* O; int ldc; const float* bias;
    __device__ __forceinline__ void operator()(const f32x4 (&acc)[2][2][4][2], const Unit& u, int wr, int wc, int fr, int fq) const {
        const int row0 = u.pm * BM + wr * 64 + fr; const int col0 = u.pn * BM + wc * 32 + 8 * fq;
        f32x4 bv[2][2];
#pragma unroll
        for (int bj = 0; bj < 2; ++bj)
#pragma unroll
            for (int n = 0; n < 2; ++n) bv[bj][n] = bias ? *(const f32x4*)(bias + col0 + bj * HALF + 4 * n) : (f32x4){0.f, 0.f, 0.f, 0.f};
#pragma unroll
        for (int ai = 0; ai < 2; ++ai)
#pragma unroll
            for (int m = 0; m < 4; ++m) { bf16_t* rowp = O + (size_t)(row0 + ai * HALF + m * 16) * ldc + col0;
#pragma unroll
                for (int bj = 0; bj < 2; ++bj) { f32x4 v0 = acc[ai][bj][m][0] + bv[bj][0], v1 = acc[ai][bj][m][1] + bv[bj][1];
                    if (ACT == 3) {
#pragma unroll
                        for (int e = 0; e < 4; ++e) { const float a = fmaxf(v0[e], 0.f), b = fmaxf(v1[e], 0.f); v0[e] = a * a; v1[e] = b * b; } }
                    u32x4 w; w.x = cvt_pk_bf16(v0[0], v0[1]); w.y = cvt_pk_bf16(v0[2], v0[3]); w.z = cvt_pk_bf16(v1[0], v1[1]); w.w = cvt_pk_bf16(v1[2], v1[3]);
                    if (WT) st16_wt(rowp + bj * HALF, w); else *(u32x4*)(rowp + bj * HALF) = w; } }
    }
};
struct EpiGlu {
    static constexpr bool PERM = true, AFTER_DRAIN = false;
    const bf16_t* Gy; int ldg; bf16_t* O; int ldc; int coff; const float* bias; bf16_t* Os; int MPs;
    __device__ __forceinline__ void operator()(const f32x4 (&acc)[2][2][4][2], const Unit& u, int wr, int wc, int fr, int fq) const {
        const int row0 = u.pm * BM + wr * 64 + fr; const int col0 = u.pn * BM + wc * 32 + 8 * fq;
        bf16_t* const Ob = u.pm * BM >= MPs ? Os - (size_t)MPs * ldc : O;
        f32x4 bv[2][2];
#pragma unroll
        for (int bj = 0; bj < 2; ++bj)
#pragma unroll
            for (int n = 0; n < 2; ++n) bv[bj][n] = *(const f32x4*)(bias + col0 + bj * HALF + 4 * n);
        constexpr int DEPTH = 4;
        u32x4 pg[DEPTH];
#define EPG_ROW(g) ((size_t)(row0 + ((g) >> 3) * HALF + (((g) >> 1) & 3) * 16))
#define EPG_COL(g) (col0 + ((g) & 1) * HALF)
#pragma unroll
        for (int g = 0; g < DEPTH; ++g) pg[g] = *(const u32x4*)(Gy + EPG_ROW(g) * ldg + EPG_COL(g));
#pragma unroll
        for (int gi = 0; gi < 16; ++gi) { const int ai = gi >> 3, m = (gi >> 1) & 3, bj = gi & 1;
            const u32x4 g = pg[gi % DEPTH];
            if (gi + DEPTH < 16) pg[gi % DEPTH] = *(const u32x4*)(Gy + EPG_ROW(gi + DEPTH) * ldg + EPG_COL(gi + DEPTH));
            const f32x4 v0 = acc[ai][bj][m][0] + bv[bj][0], v1 = acc[ai][bj][m][1] + bv[bj][1];
            float o[8];
            o[0] = bf_lo(g.x) * __builtin_amdgcn_rcpf(1.f + __builtin_amdgcn_exp2f(-1.4426950408889634f * v0[0])); o[1] = bf_hi(g.x) * __builtin_amdgcn_rcpf(1.f + __builtin_amdgcn_exp2f(-1.4426950408889634f * v0[1]));
            o[2] = bf_lo(g.y) * __builtin_amdgcn_rcpf(1.f + __builtin_amdgcn_exp2f(-1.4426950408889634f * v0[2])); o[3] = bf_hi(g.y) * __builtin_amdgcn_rcpf(1.f + __builtin_amdgcn_exp2f(-1.4426950408889634f * v0[3]));
            o[4] = bf_lo(g.z) * __builtin_amdgcn_rcpf(1.f + __builtin_amdgcn_exp2f(-1.4426950408889634f * v1[0])); o[5] = bf_hi(g.z) * __builtin_amdgcn_rcpf(1.f + __builtin_amdgcn_exp2f(-1.4426950408889634f * v1[1]));
            o[6] = bf_lo(g.w) * __builtin_amdgcn_rcpf(1.f + __builtin_amdgcn_exp2f(-1.4426950408889634f * v1[2])); o[7] = bf_hi(g.w) * __builtin_amdgcn_rcpf(1.f + __builtin_amdgcn_exp2f(-1.4426950408889634f * v1[3]));
            u32x4 w; w.x = cvt_pk_bf16(o[0], o[1]); w.y = cvt_pk_bf16(o[2], o[3]); w.z = cvt_pk_bf16(o[4], o[5]); w.w = cvt_pk_bf16(o[6], o[7]);
            *(u32x4*)(Ob + EPG_ROW(gi) * ldc + coff + EPG_COL(gi)) = w; }
#undef EPG_ROW
#undef EPG_COL
    }
};
template <bool BASE16> struct EpiRes {
    static constexpr bool PERM = true, AFTER_DRAIN = false;
    const void* basep; bf16_t* T; const float* gate  ; const float* bias; float alpha; int MP; float* slab;
    __device__ __forceinline__ void operator()(const f32x4 (&acc)[2][2][4][2], const Unit& u, int wr, int wc, int fr, int fq) const {
        const int row0 = u.pm * BM + wr * 64 + fr, col0 = u.pn * BM + wc * 32 + 8 * fq;
        if (row0 >= MP) {
            float* sp = slab + (size_t)u.ks * 512 * 1024;
#pragma unroll
            for (int ai = 0; ai < 2; ++ai)
#pragma unroll
                for (int m = 0; m < 4; ++m) { float* op = sp + (size_t)(row0 + ai * HALF + m * 16 - MP) * 1024;
#pragma unroll
                    for (int bj = 0; bj < 2; ++bj)
#pragma unroll
                        for (int n = 0; n < 2; ++n) st16f_wt(op + col0 + bj * HALF + n * 4, acc[ai][bj][m][n]); }
            return; }
        f32x4 bv[2][2], gv[2][2];
        const float* gp = gate + (size_t)(row0 >> 11) * 6144;
#pragma unroll
        for (int bj = 0; bj < 2; ++bj)
#pragma unroll
            for (int n = 0; n < 2; ++n) { bv[bj][n] = bias ? *(const f32x4*)(bias + col0 + bj * HALF + n * 4) : (f32x4){0.f, 0.f, 0.f, 0.f}; gv[bj][n] = *(const f32x4*)(gp + col0 + bj * HALF + n * 4); }
        constexpr int DEPTH = 3;
        f32x4 pb[DEPTH][2]; u32x4 pw[DEPTH];
#define EPR_ROW(g) (row0 + ((g) >> 3) * HALF + (((g) >> 1) & 3) * 16)
#define EPR_COL(g) (col0 + ((g) & 1) * HALF)
#define EPR_LOAD(g) do { if (BASE16) pw[(g) % DEPTH] = *(const u32x4*)((const bf16_t*)basep + (size_t)EPR_ROW(g) * 1024 + EPR_COL(g)); \
            else { const float* bp_ = (const float*)basep + (size_t)EPR_ROW(g) * 1024 + EPR_COL(g); pb[(g) % DEPTH][0] = *(const f32x4*)bp_; pb[(g) % DEPTH][1] = *(const f32x4*)(bp_ + 4); } } while (0)
#pragma unroll
        for (int g = 0; g < DEPTH; ++g) EPR_LOAD(g);
#pragma unroll
        for (int g = 0; g < 16; ++g) { const int ai = g >> 3, m = (g >> 1) & 3, bj = g & 1;
            f32x4 b0, b1;
            if (BASE16) { const u32x4 bw = pw[g % DEPTH]; b0 = (f32x4){bf_lo(bw.x), bf_hi(bw.x), bf_lo(bw.y), bf_hi(bw.y)}; b1 = (f32x4){bf_lo(bw.z), bf_hi(bw.z), bf_lo(bw.w), bf_hi(bw.w)}; }
            else { b0 = pb[g % DEPTH][0]; b1 = pb[g % DEPTH][1]; }
            if (g + DEPTH < 16) EPR_LOAD(g + DEPTH);
            const f32x4 v0 = b0 * alpha + gv[bj][0] * (acc[ai][bj][m][0] + bv[bj][0]), v1 = b1 * alpha + gv[bj][1] * (acc[ai][bj][m][1] + bv[bj][1]);
            u32x4 w; w.x = cvt_pk_bf16(v0[0], v0[1]); w.y = cvt_pk_bf16(v0[2], v0[3]); w.z = cvt_pk_bf16(v1[0], v1[1]); w.w = cvt_pk_bf16(v1[2], v1[3]);
            st16_wt(T + (size_t)EPR_ROW(g) * 1024 + EPR_COL(g), w); }
#undef EPR_ROW
#undef EPR_COL
#undef EPR_LOAD
    }
};

struct PieceOrder {
    int nN, NS, nP, G, c, K, nM;
    __host__ __device__ void init(int MPr, int N, int G_, int c_, int K_, int NS_) { nM = MPr / BM; nN = N / BM; NS = NS_; nP = 2 * nN * NS; G = G_; c = c_; K = K_; }
    __host__ __device__ __forceinline__ bool next(int i, Unit& u) const {
        const int p = G - 1 - c, t = p / NS, ks = p % NS, nk = K / BK / NS;
        u.pm = nM + t / nN; u.pn = t % nN; u.nkt = nk; u.ks = ks; u.k0 = ks * nk * BK; return i == 0 && p < nP;
    }
    __device__ __forceinline__ void a_ready(const Unit&) const {}
    __device__ __forceinline__ void done(const Unit&) const {}
};
struct EpiSlab {
    static constexpr bool PERM = true, AFTER_DRAIN = false;
    float* slab; int MP;
    __device__ __forceinline__ void operator()(const f32x4 (&acc)[2][2][4][2], const Unit& u, int wr, int wc, int fr, int fq) const {
        const int row0 = u.pm * BM + wr * 64 + fr, col0 = u.pn * BM + wc * 32 + 8 * fq;
        float* sp = slab + (size_t)u.ks * 512 * 1024;
#pragma unroll
        for (int ai = 0; ai < 2; ++ai)
#pragma unroll
            for (int m = 0; m < 4; ++m) { float* op = sp + (size_t)(row0 + ai * HALF + m * 16 - MP) * 1024;
#pragma unroll
                for (int bj = 0; bj < 2; ++bj)
#pragma unroll
                    for (int n = 0; n < 2; ++n) st16f_wt(op + col0 + bj * HALF + n * 4, acc[ai][bj][m][n]); }
    }
};
template <bool SECOND> struct EpiLnFused {
    static constexpr bool PERM = true, AFTER_DRAIN = true;
    const void* basep; const float* gate; const float* bias; float alpha; const float* lng; const float* lnb; const float* mod2  ;
    float* out; bf16_t* x1; bf16_t* xn; float* stat; unsigned* cnt; float eps;
    __device__ __forceinline__ void fused(f32x4 (&acc)[2][2][4][2], const Unit& u, int wr, int wc, int fr, int fq, PG8_LAS unsigned char* lds, int wid, int lane) const {
        const int row0 = u.pm * BM + wr * 64 + fr, col0 = u.pn * BM + wc * 32 + 8 * fq, tid = wid * 64 + lane;
        {
            const float* gp = gate + (size_t)(row0 >> 11) * 6144;
#pragma unroll
            for (int bj = 0; bj < 2; ++bj) { const int c = col0 + bj * HALF;
                const f32x4 g0 = *(const f32x4*)(gp + c), g1 = *(const f32x4*)(gp + c + 4);
                const f32x4 v0 = bias ? *(const f32x4*)(bias + c) : (f32x4){0.f, 0.f, 0.f, 0.f}, v1 = bias ? *(const f32x4*)(bias + c + 4) : (f32x4){0.f, 0.f, 0.f, 0.f};
                constexpr int DEPTH = 2; f32x4 pb[DEPTH][2]; u32x4 pw[DEPTH];
#define EPF_ROW(g) (row0 + ((g) >> 2) * HALF + ((g) & 3) * 16)
#define EPF_LOAD(g) do { if (SECOND) pw[(g) % DEPTH] = *(const u32x4*)((const bf16_t*)basep + (size_t)EPF_ROW(g) * 1024 + c); \
                else { const float* bp_ = (const float*)basep + (size_t)EPF_ROW(g) * 1024 + c; pb[(g) % DEPTH][0] = *(const f32x4*)bp_; pb[(g) % DEPTH][1] = *(const f32x4*)(bp_ + 4); } } while (0)
#pragma unroll
                for (int g = 0; g < DEPTH; ++g) EPF_LOAD(g);
#pragma unroll
                for (int g = 0; g < 8; ++g) { const int ai = g >> 2, m = g & 3; f32x4 b0, b1;
                    if (SECOND) { const u32x4 bw = pw[g % DEPTH]; b0 = (f32x4){bf_lo(bw.x), bf_hi(bw.x), bf_lo(bw.y), bf_hi(bw.y)}; b1 = (f32x4){bf_lo(bw.z), bf_hi(bw.z), bf_lo(bw.w), bf_hi(bw.w)}; }
                    else { b0 = pb[g % DEPTH][0]; b1 = pb[g % DEPTH][1]; }
                    if (g + DEPTH < 8) EPF_LOAD(g + DEPTH);
                    acc[ai][bj][m][0] = b0 * alpha + g0 * (acc[ai][bj][m][0] + v0); acc[ai][bj][m][1] = b1 * alpha + g1 * (acc[ai][bj][m][1] + v1);
                    asm volatile("" : "+v"(acc[ai][bj][m][0]), "+v"(acc[ai][bj][m][1]) :: "memory"); }
#undef EPF_LOAD
#undef EPF_ROW
            }
        }
        typedef float f32x2v __attribute__((ext_vector_type(2)));
        PG8_LAS f32x2v* RS = (PG8_LAS f32x2v*)lds;
        PG8_LAS f32x2v* MR = (PG8_LAS f32x2v*)(lds + 8192);
#pragma unroll
        for (int ai = 0; ai < 2; ++ai)
#pragma unroll
            for (int m = 0; m < 4; ++m) { float sa = 0.f, sq = 0.f;
#pragma unroll
                for (int bj = 0; bj < 2; ++bj)
#pragma unroll
                    for (int n = 0; n < 2; ++n) { const f32x4 x = acc[ai][bj][m][n]; sa += (x[0] + x[1]) + (x[2] + x[3]); sq += (x[0] * x[0] + x[1] * x[1]) + (x[2] * x[2] + x[3] * x[3]); }
                sa += __shfl_xor(sa, 16); sa += __shfl_xor(sa, 32); sq += __shfl_xor(sq, 16); sq += __shfl_xor(sq, 32);
                if (fq == 0) RS[(ai * HALF + wr * 64 + m * 16 + fr) * 4 + wc] = (f32x2v){sa, sq}; }
        asm volatile("s_waitcnt lgkmcnt(0)" ::: "memory"); __builtin_amdgcn_s_barrier(); asm volatile("" ::: "memory");
        if (tid < 256) { const f32x2v a = RS[tid * 4 + 0], b = RS[tid * 4 + 1], c = RS[tid * 4 + 2], d = RS[tid * 4 + 3];
            unsigned long long* slot = (unsigned long long*)stat + ((size_t)(u.pm * 4 + u.pn) * 256 + tid);
            __hip_atomic_store(slot, ((unsigned long long)__builtin_bit_cast(unsigned, (a.y + b.y) + (c.y + d.y)) << 32) | __builtin_bit_cast(unsigned, (a.x + b.x) + (c.x + d.x)), __ATOMIC_RELAXED, __HIP_MEMORY_SCOPE_AGENT); }
        asm volatile("s_waitcnt vmcnt(0)" ::: "memory"); __builtin_amdgcn_s_barrier(); asm volatile("" ::: "memory");
        if (tid == 0) { (void)__hip_atomic_fetch_add(cnt + 64 * u.pm, 1u, __ATOMIC_RELAXED, __HIP_MEMORY_SCOPE_AGENT);
            unsigned sp = 0; while (__hip_atomic_load(cnt + 64 * u.pm, __ATOMIC_RELAXED, __HIP_MEMORY_SCOPE_AGENT) < 4u && ++sp < (1u << 22)) __builtin_amdgcn_s_sleep(2);
            __builtin_amdgcn_fence(__ATOMIC_ACQUIRE, "agent"); asm volatile("s_waitcnt vmcnt(0)" ::: "memory"); }
        __builtin_amdgcn_s_barrier(); asm volatile("" ::: "memory");
        if (tid < 256) { float S = 0.f, Q = 0.f;
#pragma unroll
            for (int p = 0; p < 4; ++p) { const unsigned long long w = __hip_atomic_load((const unsigned long long*)stat + ((size_t)(u.pm * 4 + p) * 256 + tid), __ATOMIC_RELAXED, __HIP_MEMORY_SCOPE_AGENT);
                S += __builtin_bit_cast(float, (unsigned)w); Q += __builtin_bit_cast(float, (unsigned)(w >> 32)); }
            const float mean = S * (1.f / 1024.f), var = fmaxf(Q * (1.f / 1024.f) - mean * mean, 0.f);
            MR[tid] = (f32x2v){mean, 1.0f / sqrtf(var + eps)}; }
        asm volatile("s_waitcnt lgkmcnt(0)" ::: "memory"); __builtin_amdgcn_s_barrier(); asm volatile("" ::: "memory");
#pragma unroll
        for (int bj = 0; bj < 2; ++bj) { const int c = col0 + bj * HALF;
            const f32x4 g0 = *(const f32x4*)(lng + c), g1 = *(const f32x4*)(lng + c + 4), b0 = *(const f32x4*)(lnb + c), b1 = *(const f32x4*)(lnb + c + 4);
            f32x4 s0, s1, h0, h1;
            if (!SECOND) { const float* mp = mod2 + (size_t)(row0 >> 11) * 6144 + c; h0 = *(const f32x4*)mp; h1 = *(const f32x4*)(mp + 4); s0 = *(const f32x4*)(mp + 1024) + 1.f; s1 = *(const f32x4*)(mp + 1028) + 1.f; }
#pragma unroll
            for (int ai = 0; ai < 2; ++ai)
#pragma unroll
                for (int m = 0; m < 4; ++m) { const int rl = ai * HALF + wr * 64 + m * 16 + fr; const size_t row = (size_t)(u.pm * BM + rl); const f32x2v mr = MR[rl];
                    const f32x4 y0 = (acc[ai][bj][m][0] - mr.x) * mr.y * g0 + b0, y1 = (acc[ai][bj][m][1] - mr.x) * mr.y * g1 + b1;
                    if (SECOND) { *(f32x4*)(out + row * 1024 + c) = y0; *(f32x4*)(out + row * 1024 + c + 4) = y1; }
                    else { u32x4 w; w.x = cvt_pk_bf16(y0[0], y0[1]); w.y = cvt_pk_bf16(y0[2], y0[3]); w.z = cvt_pk_bf16(y1[0], y1[1]); w.w = cvt_pk_bf16(y1[2], y1[3]);
                           *(u32x4*)(x1 + row * 1024 + c) = w;
                           const f32x4 z0 = y0 * s0 + h0, z1 = y1 * s1 + h1;
                           u32x4 v; v.x = cvt_pk_bf16(z0[0], z0[1]); v.y = cvt_pk_bf16(z0[2], z0[3]); v.z = cvt_pk_bf16(z1[0], z1[1]); v.w = cvt_pk_bf16(z1[2], z1[3]);
                           *(u32x4*)(xn + row * 1024 + c) = v; } } }
        asm volatile("s_waitcnt lgkmcnt(0)" ::: "memory"); __builtin_amdgcn_s_barrier(); asm volatile("" ::: "memory");
    }
};

template <class Epi, class Sched, bool ALIGN_EPI = false, bool SP2 = false>
__device__ __forceinline__ void gemm_phase(PG8_LAS unsigned char* lds, const Gemm g, const Sched& S, const Epi& E) {
    const int tid = threadIdx.x, wid = __builtin_amdgcn_readfirstlane(tid >> 6), lane = tid & 63, wr = wid >> 2, wc = wid & 3, fr = lane & 15, fq = lane >> 4;
    const int K = g.K;
    unsigned voffA[2], voffB[2];
#pragma unroll
    for (int i = 0; i < 2; ++i) { int R, C; stage_rc(tid * 16 + i * 8192, R, C); const int Rb = Epi::PERM ? ((R & ~31) + perm32(R & 31)) : R;
        voffA[i] = (unsigned)(R * K + C) * 2u; voffB[i] = (unsigned)(Rb * K + C) * 2u; }
    const size_t kstep = (size_t)(BK * 2);
    const size_t hstep = (size_t)HALF * K * 2;
    const size_t tstep = 2 * hstep;
    const unsigned ldsw = (unsigned)wid * 1024u;
    const int aoff = lds_byte(wr * 64 + fr, fq * 8), boff = lds_byte(wc * 32 + fr, fq * 8);
#define PG8_SA(b, h) (((b) * 2 + (h)) * HTB)
#define PG8_SB(b, h) ((4 + (b) * 2 + (h)) * HTB)
#define PG8_STAGE(bufoff, gbase, voff) do { _Pragma("unroll") for (int _i = 0; _i < 2; ++_i) \
        __builtin_amdgcn_global_load_lds((const unsigned*)((const char*)(gbase) + (voff)[_i]), (PG8_LAS unsigned*)(lds + (bufoff) + ldsw + _i * 8192), 16, 0, 0); } while (0)
#define PG8_LDA(dst, b, h) do { _Pragma("unroll") for (int m = 0; m < 4; ++m) _Pragma("unroll") for (int k = 0; k < 2; ++k) dst[m][k] = *(const PG8_LAS bf16x8*)(lds + PG8_SA(b, h) + aoff + m * 2048 + k * 1024); } while (0)
#define PG8_LDB(dst, b, h) do { _Pragma("unroll") for (int n = 0; n < 2; ++n) _Pragma("unroll") for (int k = 0; k < 2; ++k) dst[n][k] = *(const PG8_LAS bf16x8*)(lds + PG8_SB(b, h) + boff + n * 2048 + k * 1024); } while (0)
#define PG8_MMA(ai, bj, At, Bt) do { __builtin_amdgcn_s_setprio(1); _Pragma("unroll") for (int m = 0; m < 4; ++m) _Pragma("unroll") for (int n = 0; n < 2; ++n) _Pragma("unroll") for (int k = 0; k < 2; ++k) \
        acc[ai][bj][m][n] = __builtin_amdgcn_mfma_f32_16x16x32_bf16(Bt[n][k], At[m][k], acc[ai][bj][m][n], 0, 0, 0); __builtin_amdgcn_s_setprio(0); } while (0)
#define PG8_WAIT_V(n) asm volatile("s_waitcnt vmcnt(" #n ")" ::: "memory")
#define PG8_WAIT_L(n) asm volatile("s_waitcnt lgkmcnt(" #n ")" ::: "memory")
#define PG8_BAR __builtin_amdgcn_s_barrier()
#define PG8_SCHED __builtin_amdgcn_sched_barrier(0)
    Unit cur, nxt; int ui = 0;
    if (!S.next(0, cur)) return;
    f32x4 acc[2][2][4][2];
#pragma unroll
    for (int a = 0; a < 2; ++a)
#pragma unroll
        for (int b = 0; b < 2; ++b)
#pragma unroll
            for (int m = 0; m < 4; ++m)
#pragma unroll
                for (int n = 0; n < 2; ++n) acc[a][b][m][n] = (f32x4){0.f, 0.f, 0.f, 0.f};
    bf16x8 At[4][2], B0[2][2], B1[2][2];
    const char* cA = (const char*)g.A + (size_t)cur.pm * tstep + (size_t)cur.k0 * 2; const char* cB = (const char*)g.Bt + (size_t)cur.pn * tstep + (size_t)cur.k0 * 2;
    S.a_ready(cur);
    if constexpr (SP2) {
        PG8_STAGE(PG8_SB(0, 0), cB, voffB); PG8_STAGE(PG8_SB(0, 1), cB + hstep, voffB); PG8_STAGE(PG8_SA(0, 0), cA, voffA); PG8_STAGE(PG8_SA(0, 1), cA + hstep, voffA);
        if (wr == 1) PG8_BAR;
        PG8_WAIT_V(2); PG8_BAR;
        PG8_STAGE(PG8_SB(1, 0), cB + kstep, voffB); PG8_STAGE(PG8_SA(1, 0), cA + kstep, voffA); PG8_STAGE(PG8_SB(1, 1), cB + hstep + kstep, voffB);
        PG8_WAIT_V(6); PG8_BAR;
    } else {
        PG8_STAGE(PG8_SB(0, 0), cB, voffB); PG8_STAGE(PG8_SA(0, 0), cA, voffA); PG8_STAGE(PG8_SB(0, 1), cB + hstep, voffB); PG8_STAGE(PG8_SA(0, 1), cA + hstep, voffA);
        if (wr == 1) PG8_BAR;
        PG8_WAIT_V(4); PG8_BAR;
        PG8_STAGE(PG8_SB(1, 0), cB + kstep, voffB); PG8_STAGE(PG8_SA(1, 0), cA + kstep, voffA); PG8_STAGE(PG8_SB(1, 1), cB + hstep + kstep, voffB);
        PG8_WAIT_V(6); PG8_BAR;
    }
    for (;;) {
        const bool has_next = S.next(ui + 1, nxt);
        const char* nA = has_next ? (const char*)g.A + (size_t)nxt.pm * tstep + (size_t)nxt.k0 * 2 : cA; const char* nB = has_next ? (const char*)g.Bt + (size_t)nxt.pn * tstep + (size_t)nxt.k0 * 2 : cB;
        const int nt = cur.nkt;
        for (int t = 0; t < nt; t += 2) {
            const bool last = (t == nt - 2);
            const char* a1 = cA + (size_t)(t + 1) * kstep;
            const char* a2 = last ? nA : cA + (size_t)(t + 2) * kstep; const char* b2 = last ? nB : cB + (size_t)(t + 2) * kstep;
            const char* a3 = a2 + kstep; const char* b3 = b2 + kstep;
            if (last && has_next) S.a_ready(nxt);
            if constexpr (SP2) {
            PG8_LDB(B0, 0, 0); PG8_LDB(B1, 0, 1); PG8_SCHED; PG8_LDA(At, 0, 0); PG8_STAGE(PG8_SA(1, 1), a1 + hstep, voffA);
            PG8_WAIT_V(8); PG8_WAIT_L(0); PG8_BAR; PG8_MMA(0, 0, At, B0); PG8_MMA(0, 1, At, B1); PG8_BAR; PG8_SCHED;
            PG8_LDA(At, 0, 1); PG8_STAGE(PG8_SB(0, 0), b2, voffB); PG8_STAGE(PG8_SB(0, 1), b2 + hstep, voffB); PG8_STAGE(PG8_SA(0, 0), a2, voffA);
            PG8_WAIT_V(8); PG8_WAIT_L(0); PG8_BAR; PG8_MMA(1, 0, At, B0); PG8_MMA(1, 1, At, B1); PG8_BAR; PG8_SCHED;
            PG8_LDB(B0, 1, 0); PG8_LDB(B1, 1, 1); PG8_SCHED; PG8_LDA(At, 1, 0); PG8_STAGE(PG8_SA(0, 1), a2 + hstep, voffA);
            PG8_WAIT_V(8); PG8_WAIT_L(0); PG8_BAR; PG8_MMA(0, 0, At, B0); PG8_MMA(0, 1, At, B1); PG8_BAR; PG8_SCHED;
            PG8_LDA(At, 1, 1); PG8_STAGE(PG8_SB(1, 0), b3, voffB); PG8_STAGE(PG8_SB(1, 1), b3 + hstep, voffB); PG8_STAGE(PG8_SA(1, 0), a3, voffA);
            PG8_WAIT_V(8); PG8_WAIT_L(0); PG8_BAR; PG8_MMA(1, 0, At, B0); PG8_MMA(1, 1, At, B1); PG8_BAR; PG8_SCHED;
            } else {
            PG8_LDB(B0, 0, 0); PG8_SCHED; PG8_LDA(At, 0, 0); PG8_STAGE(PG8_SA(1, 1), a1 + hstep, voffA);
            PG8_WAIT_L(8); PG8_BAR; PG8_WAIT_L(0); PG8_MMA(0, 0, At, B0); PG8_BAR; PG8_SCHED;
            PG8_LDB(B1, 0, 1); PG8_STAGE(PG8_SB(0, 0), b2, voffB);
            PG8_BAR; PG8_WAIT_L(0); PG8_MMA(0, 1, At, B1); PG8_BAR;
            PG8_LDA(At, 0, 1); PG8_STAGE(PG8_SA(0, 0), a2, voffA);
            PG8_BAR; PG8_WAIT_L(0); PG8_MMA(1, 0, At, B0); PG8_BAR; PG8_SCHED;
            PG8_STAGE(PG8_SB(0, 1), b2 + hstep, voffB);
            PG8_WAIT_V(6); PG8_BAR; PG8_MMA(1, 1, At, B1); PG8_BAR;
            PG8_LDB(B0, 1, 0); PG8_SCHED; PG8_LDA(At, 1, 0); PG8_STAGE(PG8_SA(0, 1), a2 + hstep, voffA);
            PG8_WAIT_L(8); PG8_BAR; PG8_WAIT_L(0); PG8_MMA(0, 0, At, B0); PG8_BAR; PG8_SCHED;
            PG8_LDB(B1, 1, 1); PG8_STAGE(PG8_SB(1, 0), b3, voffB);
            PG8_BAR; PG8_WAIT_L(0); PG8_MMA(0, 1, At, B1); PG8_BAR;
            PG8_LDA(At, 1, 1); PG8_STAGE(PG8_SA(1, 0), a3, voffA);
            PG8_BAR; PG8_WAIT_L(0); PG8_MMA(1, 0, At, B0); PG8_BAR; PG8_SCHED;
            PG8_STAGE(PG8_SB(1, 1), b3 + hstep, voffB);
            PG8_WAIT_V(6); PG8_BAR; PG8_MMA(1, 1, At, B1); PG8_BAR;
            }
        }
        if constexpr (ALIGN_EPI) { if (wr == 0) PG8_BAR; }
        if constexpr (!Epi::AFTER_DRAIN) { E(acc, cur, wr, wc, fr, fq); S.done(cur); }
        if (!has_next) break;
#pragma unroll
        for (int a = 0; a < 2; ++a)
#pragma unroll
            for (int b = 0; b < 2; ++b)
#pragma unroll
                for (int m = 0; m < 4; ++m)
#pragma unroll
                    for (int n = 0; n < 2; ++n) acc[a][b][m][n] = (f32x4){0.f, 0.f, 0.f, 0.f};
        cur = nxt; cA = nA; cB = nB; ++ui;
        if constexpr (ALIGN_EPI) { if (wr == 1) PG8_BAR; }
    }
    PG8_WAIT_V(0);
    if constexpr (!ALIGN_EPI) { if (wr == 0) PG8_BAR; }
    PG8_BAR;
    if constexpr (Epi::AFTER_DRAIN) { E.fused(acc, cur, wr, wc, fr, fq, lds, wid, lane); S.done(cur); }
#undef PG8_SA
#undef PG8_SB
#undef PG8_STAGE
#undef PG8_LDA
#undef PG8_LDB
#undef PG8_MMA
#undef PG8_WAIT_V
#undef PG8_WAIT_L
#undef PG8_BAR
#undef PG8_SCHED
}
}

#ifndef PROBE_DUP
#define PROBE_DUP 0
#endif
#ifndef PG8_SP2
#define PG8_SP2 true
#endif
#ifndef PG8_ALIGN
#define PG8_ALIGN true
#endif

constexpr int NWAVES = 8;
constexpr int N_LAUNCHES = MK_N_LAUNCHES;
constexpr int N_PHASES = 10;
constexpr int D = 1024, MP = 16384, MS = 512, M = MP + MS, TP = 2048, NBP = 8, NBS = 128, TS = 4;
constexpr int NZ = 1536, WA = 512, WB = 512, FF = 4096, NMOD = 6 * D, NROWMOD = NBP + NBS;
constexpr int GB = 32, NS5 = 64, KS5 = 16, HA = 8, HDA = 64;
constexpr float LN_EPS = 1e-5f;
constexpr int NS_OUT = 4, NS_DOWN = 8;
constexpr float ALPHA = 1.189207115002721f;

constexpr size_t O_YP = 0, O_YS = (size_t)MP * D, O_CONVP = O_YS + (size_t)MS * D, O_HP = O_CONVP + (size_t)NBP * 3 * WA, O_SRP = O_HP + (size_t)NBP * WA,
                 O_SIP = O_SRP + (size_t)NBP * GB * NS5, O_CONVS = O_SIP + (size_t)NBP * GB * NS5, O_HS = O_CONVS + (size_t)NBS * 3 * WA, O_SRS = O_HS + (size_t)NBS * WA,
                 O_SIS = O_SRS + (size_t)NBS * GB * NS5, O_END = O_SIS + (size_t)NBS * GB * NS5;

constexpr size_t MiB = 1u << 20;
constexpr size_t WS_CTL = 0, CTL_ZERO_BYTES = 128 * 1024;
constexpr size_t WS_WIN = 1 * MiB, WS_WGLU = 4 * MiB, WS_WOUT = 5 * MiB, WS_W1 = 7 * MiB, WS_W2 = 15 * MiB;
constexpr size_t WS_MOD = 23 * MiB;
constexpr size_t WS_S5C = 27 * MiB;
constexpr size_t WS_STAT = 27 * MiB + 512 * 1024;
constexpr size_t WS_XN = 28 * MiB;
constexpr size_t WS_Z = 61 * MiB;
constexpr size_t WS_YCAT = WS_XN;
constexpr size_t WS_G = 144 * MiB;
constexpr size_t WS_U = 61 * MiB;
constexpr size_t WS_T1 = WS_Z;
constexpr size_t WS_T2 = WS_XN;
constexpr size_t WS_TAB = 246 * MiB;
constexpr size_t WS_SLAB = 194 * MiB;
constexpr size_t WS_X1B = 210 * MiB;
constexpr size_t WS_YCS = 244 * MiB;
constexpr size_t WS_END = 252 * MiB;
constexpr size_t TB_BF1 = 0, TB_BF2 = TB_BF1 + 32 * 4 * 64 * 16, TB_TA = TB_BF2 + 32 * 8 * 64 * 16, TB_ZP = TB_TA + 32 * 2 * 2 * 32 * 4, TB_Z16N = TB_ZP + 32 * 17 * 2 * 2 * 32 * 4,
                 TB_RG = TB_Z16N + 32 * 2 * 64 * 4, TB_CB = TB_RG + 8 * 2 * 2 * 4 * 64 * 16, TB_SILU = TB_CB + 128 * 3 * 512 * 2, TB_DG = TB_SILU + 160 * 1024 * 2, TB_W1 = TB_DG + 8 * 16 * 64 * 16, TB_C2 = TB_W1 + 32 * 8 * 4 * 64 * 16, TB_END = TB_C2 + (size_t)32 * 8 * 8 * 64 * 16;
static_assert(WS_SLAB + (size_t)8 * 512 * 1024 * 4 <= WS_X1B && WS_X1B + (size_t)MP * D * 2 <= WS_TAB && WS_TAB + TB_END <= WS_END, "tables");
static_assert(WS_XN + (size_t)M * D * 2 <= WS_Z && WS_Z + (size_t)M * NZ * 2 <= WS_G && WS_G + (size_t)M * WB * 2 <= WS_END && WS_U + (size_t)M * FF * 2 <= WS_SLAB, "d_ws map");
constexpr int SC_ABR = 0, SC_ABI = 2048, SC_BBR = 4096, SC_BBI = 4096 + 32768, SC_RGL = 4096 + 65536, SC_END = SC_RGL + 512;
constexpr int CW_TMO = 0, CW_CODE = 1, CW_SILU = 64, CW_MOD = 1024  , CW_S5B = 128  , CW_BAR = 4096,
              CW_T1 = 8192  , CW_T2 = 12288  , CW_T1S = 16384, CW_T2S = 16448  , CW_XNS = 16512  , CW_US = 16640  ,
              CW_G1 = 20480  , CW_G2 = 24576  ;

constexpr int RING_OFF = 0, RING_BYTES = 131072;
constexpr int LDSCTL_OFF = RING_BYTES, MISC_OFF = LDSCTL_OFF + 320;
constexpr int LDS_BYTES = 147456;

#define GAS __attribute__((address_space(1)))
#define LAS __attribute__((address_space(3)))
typedef unsigned short bf16;
typedef unsigned v4u __attribute__((ext_vector_type(4)));
typedef float f32x4 __attribute__((ext_vector_type(4)));
typedef GAS unsigned gu32;
#define RLX_AGENT __ATOMIC_RELAXED, __HIP_MEMORY_SCOPE_AGENT
#define LDS_WAIT() asm volatile("s_waitcnt lgkmcnt(0)" ::: "memory")
#define VM_WAIT() asm volatile("s_waitcnt vmcnt(0)" ::: "memory")
__device__ __forceinline__ unsigned f2bf(float f) { unsigned u = __builtin_bit_cast(unsigned, f); return (u + 0x7fffu + ((u >> 16) & 1u)) >> 16; }
__device__ __forceinline__ unsigned pk2(float lo, float hi) { return f2bf(lo) | (f2bf(hi) << 16); }
__device__ __forceinline__ float bf2f(bf16 v) { return __builtin_bit_cast(float, (unsigned)v << 16); }
__device__ __forceinline__ float gelu_tanh(float x) { const float t = -2.3022082f * (x + 0.044715f * x * x * x); return x * __builtin_amdgcn_rcpf(1.f + __builtin_amdgcn_exp2f(t)); }
__device__ __forceinline__ float sigmoidf_(float x) { return __builtin_amdgcn_rcpf(1.f + __builtin_amdgcn_exp2f(-1.4426950408889634f * x)); }

#define XB_TMO      128
#define XB_XCNT(j)  (256  + 64 * (j))
#define XB_XSUB(j)  (1280 + 64 * (j))
#define XB_XGEN(j)  (2304 + 64 * (j))
#define XB_TOP      3328
#define XB_TOPGEN   3392
#define XCD_BAR_WORDS 3456
#define XB_SPIN_CAP (1u << 18)
__device__ __forceinline__ unsigned xb_ld(unsigned* p)              { return __hip_atomic_load(p, __ATOMIC_RELAXED, __HIP_MEMORY_SCOPE_AGENT); }
__device__ __forceinline__ unsigned xb_add(unsigned* p, unsigned v) { return __hip_atomic_fetch_add(p, v, __ATOMIC_RELAXED, __HIP_MEMORY_SCOPE_AGENT); }
__device__ __forceinline__ unsigned xb_xcc_id() { return (unsigned)__builtin_amdgcn_s_getreg((3 << 11) | 20) & 0xFu; }
#define XB_SPIN(cond, bar) do { unsigned _sp = 0; while (cond) { __builtin_amdgcn_s_sleep(1); \
    if ((++_sp & 255u) == 0u) { if (xb_ld(&(bar)[XB_TMO])) break; if (_sp > XB_SPIN_CAP) { atomicAdd(&(bar)[XB_TMO], 1u); break; } } } } while (0)
struct XcdBarrier { unsigned* bar; unsigned x; volatile LAS unsigned* st; };
__device__ __forceinline__ XcdBarrier xcd_barrier_post(unsigned* bar, volatile LAS unsigned* st) {
    XcdBarrier b; b.bar = bar; b.x = xb_xcc_id(); b.st = st;
    if (threadIdx.x == 0) (void)xb_add(&bar[XB_XCNT(b.x)], 1u);
    return b;
}
__device__ __forceinline__ void xcd_barrier_complete(unsigned* bar, unsigned x, unsigned& nloc, unsigned& nx) {
    const unsigned G = gridDim.x * gridDim.y * gridDim.z;
    unsigned sum, cnt, mine, sp = 0u;
    for (;;) {
        sum = 0u; cnt = 0u; mine = 0u;
#pragma unroll
        for (unsigned j = 0; j < 16; ++j) { const unsigned c = xb_ld(&bar[XB_XCNT(j)]); sum += c; cnt += (c > 0u) ? 1u : 0u; mine = (j == x) ? c : mine; }
        if (sum == G) break;
        __builtin_amdgcn_s_sleep(1);
        if ((++sp & 255u) == 0u) { if (xb_ld(&bar[XB_TMO])) break; if (sp > XB_SPIN_CAP) { atomicAdd(&bar[XB_TMO], 1u); break; } }
    }
    nloc = mine > 0u ? mine : 1u; nx = cnt > 0u ? cnt : 1u;
}
__device__ __forceinline__ void xcd_barrier(const XcdBarrier& b) {
    asm volatile("s_waitcnt vmcnt(0)" ::: "memory");
    __syncthreads();
    if (threadIdx.x == 0) {
        unsigned* bar = b.bar;
        __builtin_amdgcn_s_waitcnt(0);
        unsigned nloc = b.st[0], nx = b.st[1];
        if (nloc == 0u) { xcd_barrier_complete(bar, b.x, nloc, nx); b.st[0] = nloc; b.st[1] = nx; }
        const unsigned old = xb_add(&bar[XB_XSUB(b.x)], 1u);
        const unsigned gen = old / nloc;
        if (old + 1u == (gen + 1u) * nloc) {
            __builtin_amdgcn_fence(__ATOMIC_RELEASE, "agent");
            asm volatile("s_waitcnt vmcnt(0)" ::: "memory");
            const unsigned og = xb_add(&bar[XB_TOP], 1u);
            const unsigned tg = og / nx;
            if (og + 1u == (tg + 1u) * nx) xb_add(&bar[XB_TOPGEN], 1u);
            else XB_SPIN(xb_ld(&bar[XB_TOPGEN]) == tg, bar);
            __builtin_amdgcn_fence(__ATOMIC_ACQUIRE, "agent");
            xb_add(&bar[XB_XGEN(b.x)], 1u);
            asm volatile("s_waitcnt vmcnt(0)" ::: "memory");
        } else {
            XB_SPIN(xb_ld(&bar[XB_XGEN(b.x)]) == gen, bar);
            __builtin_amdgcn_fence(__ATOMIC_ACQUIRE, "agent");
            asm volatile("s_waitcnt vmcnt(0)" ::: "memory");
        }
    }
    __syncthreads();
}

struct Frame {
    LAS unsigned char* lds;
    volatile LAS unsigned* MISC;
    gu32* ctl;
    int tid, lane, wave;
    int vcu, G;
    float* out;
    unsigned char* ws;
};
struct Args { const float* in[37]; float* out; unsigned char* ws; int ph_lo, ph_hi, li, pad; };
__device__ __forceinline__ void refresh(Frame& F) { int t = threadIdx.x; asm volatile("" : "+v"(t)); F.tid = t; F.lane = t & 63; F.wave = __builtin_amdgcn_readfirstlane(t >> 6); }
__device__ __forceinline__ void cnt_arrive(Frame& F, int word, unsigned n = 1u) {
    VM_WAIT(); __syncthreads();
    if (F.tid == 0) { __builtin_amdgcn_fence(__ATOMIC_RELEASE, "agent"); VM_WAIT(); (void)__hip_atomic_fetch_add((unsigned*)(F.ctl + word), n, RLX_AGENT); }
}
__device__ __forceinline__ void cnt_arrive_wt(Frame& F, int word) {
    VM_WAIT(); __syncthreads();
    if (F.tid == 0) (void)__hip_atomic_fetch_add((unsigned*)(F.ctl + word), 1u, RLX_AGENT);
}
__device__ __forceinline__ void cnt_wait_ge(Frame& F, int word, unsigned target) {
    if (F.tid == 0) { unsigned sp = 0; while (__hip_atomic_load((unsigned*)(F.ctl + word), RLX_AGENT) < target && ++sp < (1u << 22)) __builtin_amdgcn_s_sleep(2);
        __builtin_amdgcn_fence(__ATOMIC_ACQUIRE, "agent"); VM_WAIT(); }
    __syncthreads();
}
__device__ __forceinline__ float wave_sum(float v) {
#pragma unroll
    for (int o = 1; o < 64; o <<= 1) v += __shfl_xor(v, o);
    return v;
}
enum { I_XP = 0, I_XS, I_SCONV, I_SH, I_SSR, I_SSI, I_CP, I_CS, I_ADAW, I_ADAB, I_INPROJ, I_CONVW, I_CONVB, I_RGWR, I_RGBR, I_RGWI, I_RGBI, I_RGLAM,
       I_S5ARE, I_S5AIM, I_S5LOGDT, I_S5BRE, I_S5BIM, I_S5CRE, I_S5CIM, I_S5D, I_GLUW, I_GLUB, I_OUTPROJ, I_LN1G, I_LN1B, I_W1, I_B1, I_W2, I_B2, I_LN2G, I_LN2B };

typedef float f32x2m __attribute__((ext_vector_type(2)));
typedef __bf16 bf16x2m __attribute__((ext_vector_type(2)));
__device__ __forceinline__ unsigned pkbf0(float a, float b) { const f32x2m v = {a, b}; const bf16x2m r = __builtin_convertvector(v, bf16x2m); return __builtin_bit_cast(unsigned, r); }
typedef short bf16x8m __attribute__((ext_vector_type(8)));
typedef float f32x16m __attribute__((ext_vector_type(16)));
__device__ __forceinline__ void p0_transpose_item(const float* W, int K, int N, bf16* WT, LAS float* scr, int item, int lane) {
    const int nblk = N / 32, kb = item / nblk, nb = item % nblk, k0 = 64 * kb, n0 = 32 * nb;
#pragma unroll 8
    for (int i = 0; i < 32; ++i) { const int kk = 2 * i + (lane >> 5); scr[kk * 33 + (lane & 31)] = W[(size_t)(k0 + kk) * N + n0 + (lane & 31)]; }
    LDS_WAIT(); asm volatile("" ::: "memory");
    const int c = lane & 7;
#pragma unroll
    for (int j = 0; j < 4; ++j) { const int n = (lane >> 3) + 8 * j; const LAS float* s = scr + (8 * c) * 33 + n;
        v4u o; o.x = pk2(s[0 * 33], s[1 * 33]); o.y = pk2(s[2 * 33], s[3 * 33]); o.z = pk2(s[4 * 33], s[5 * 33]); o.w = pk2(s[6 * 33], s[7 * 33]);
        *(GAS v4u*)(WT + (size_t)(n0 + n) * K + k0 + 8 * c) = o; }
    LDS_WAIT(); asm volatile("" ::: "memory");
}

constexpr int XI_IN = (D / 64) * (NZ / 32), XI_GL = (WB / 64) * (WB / 32), XI_OU = (D / 64) * (D / 32), XI_1 = (D / 64) * (FF / 32), XI_2 = (FF / 64) * (D / 32);
constexpr int XO_OU = XI_IN + XI_GL, XO_1 = XO_OU + XI_OU, XO_2 = XO_1 + XI_1, XO_END = XO_2 + XI_2;
__device__ __forceinline__ void xpose_item(Frame& F, const Args& A, LAS float* scr, int r) {
    if (r < XI_IN) { p0_transpose_item(A.in[I_INPROJ], D, NZ, (bf16*)(F.ws + WS_WIN), scr, r, F.lane); return; } r -= XI_IN;
    if (r < XI_GL) { p0_transpose_item(A.in[I_GLUW], WB, WB, (bf16*)(F.ws + WS_WGLU), scr, r, F.lane); return; } r -= XI_GL;
    if (r < XI_OU) { p0_transpose_item(A.in[I_OUTPROJ], D, D, (bf16*)(F.ws + WS_WOUT), scr, r, F.lane); return; } r -= XI_OU;
    if (r < XI_1) { p0_transpose_item(A.in[I_W1], D, FF, (bf16*)(F.ws + WS_W1), scr, r, F.lane); return; } r -= XI_1;
    p0_transpose_item(A.in[I_W2], FF, D, (bf16*)(F.ws + WS_W2), scr, r, F.lane);
}
__device__ __forceinline__ void xpose_range(Frame& F, const Args& A, int lo, int hi, int vlo) {
    refresh(F);
    if (F.vcu < vlo) return;
    LAS float* scr = (LAS float*)(F.lds + RING_OFF + F.wave * 16384);
    const int gw = F.wave * (F.G - vlo) + (F.vcu - vlo), ngw = (F.G - vlo) * NWAVES;
    for (int it = lo + gw; it < hi; it += ngw) xpose_item(F, A, scr, it);
}
__device__ __forceinline__ void xpose_range_b(Frame& F, const Args& A, int lo, int hi, int blo) {
    refresh(F);
    LAS float* scr = (LAS float*)(F.lds + RING_OFF + F.wave * 16384);
    const int gw = F.wave * (F.G - blo) + ((int)blockIdx.x - blo), ngw = (F.G - blo) * NWAVES;
    for (int it = lo + gw; it < hi; it += ngw) xpose_item(F, A, scr, it);
}
#ifndef PROBE_P0PART
#define PROBE_P0PART 7
#endif
__device__ __forceinline__ void p0_prologue(Frame& F, const Args& A, int rep = 0) {
    refresh(F);
    const int pmask = rep ? PROBE_P0PART : 7;
    LAS float* scr = (LAS float*)(F.lds + RING_OFF + F.wave * 16384);
    const int gw = F.wave * F.G + F.vcu, NGW = F.G * NWAVES;
    {
        bf16* ST = (bf16*)(F.ws + WS_TAB + TB_SILU);
        for (int ch = F.vcu * NWAVES * 64 + F.tid; ch < 160 * 1024 / 8; ch += F.G * NWAVES * 64) { const int row = ch >> 7, k = (ch & 127) * 8; v4u o = (v4u){0u, 0u, 0u, 0u};
            if (row < NROWMOD) { const float* cp = (row < NBP ? A.in[I_CP] + (size_t)row * D : A.in[I_CS] + (size_t)(row - NBP) * D) + k; const f32x4 c0 = *(const f32x4*)cp, c1 = *(const f32x4*)(cp + 4);
                o.x = pk2(c0[0] * sigmoidf_(c0[0]), c0[1] * sigmoidf_(c0[1])); o.y = pk2(c0[2] * sigmoidf_(c0[2]), c0[3] * sigmoidf_(c0[3]));
                o.z = pk2(c1[0] * sigmoidf_(c1[0]), c1[1] * sigmoidf_(c1[1])); o.w = pk2(c1[2] * sigmoidf_(c1[2]), c1[3] * sigmoidf_(c1[3])); }
            pg8::st16_wt(ST + (size_t)ch * 8, o); }
        cnt_arrive_wt(F, CW_SILU);
    }
    constexpr int I_IN = XI_IN, I_GL = XI_GL;
    constexpr int I_S5 = GB, I_RG = WA / 64, I_RGT = HA * 2 * 2 * 4, I_CB = NBS * 3 * WA / 512, I_DG = HA * 16, I_S5J = GB * 8;
    constexpr int NITEMS = I_IN + I_GL + I_S5 + I_RG + I_RGT + I_CB + I_DG + I_S5J;
    float* sc = (float*)(F.ws + WS_S5C);
    constexpr int VW0 = 2 * D / 32;
    for (int it = F.vcu >= VW0 ? F.wave * (F.G - VW0) + (F.vcu - VW0) : NITEMS; it < NITEMS; it += (F.G - VW0) * NWAVES) {
        int r = it;
        if (!(pmask & 1) && it < I_IN + I_GL) continue;
        if (!(pmask & 2) && it >= I_IN + I_GL) continue;
        if (r < I_IN + I_GL) { xpose_item(F, A, scr, r); continue; } r -= I_IN + I_GL;
        if (r < I_S5) {
            const int g = r, n = F.lane, gn = g * NS5 + n;
            const double dt = exp((double)A.in[I_S5LOGDT][g]), ar = (double)A.in[I_S5ARE][gn], ai = (double)A.in[I_S5AIM][gn];
            const double mag = exp(dt * ar), abr = mag * cos(dt * ai), abi = mag * sin(dt * ai), den = ar * ar + ai * ai, nr = abr - 1.0;
            const double qr = (nr * ar + abi * ai) / den, qi = (abi * ar - nr * ai) / den;
            sc[SC_ABR + gn] = (float)abr; sc[SC_ABI + gn] = (float)abi;
            unsigned char* tab = F.ws + WS_TAB;
            float* TA = (float*)(tab + TB_TA); float* ZP = (float*)(tab + TB_ZP); float* Z16N = (float*)(tab + TB_Z16N);
            const int sh = n >> 5, v = n & 31, hh = (v >> 2) & 1, ii = (v & 3) + 4 * (v >> 3);
            double bbr_[KS5], bbi_[KS5];
            for (int k = 0; k < KS5; ++k) { const double br = (double)A.in[I_S5BRE][gn * KS5 + k], bi = (double)A.in[I_S5BIM][gn * KS5 + k];
                bbr_[k] = qr * br - qi * bi; bbi_[k] = qr * bi + qi * br;
                sc[SC_BBR + gn * KS5 + k] = (float)bbr_[k]; sc[SC_BBI + gn * KS5 + k] = (float)bbi_[k]; }
            { double pr = abr, pi = abi; for (int e = 0; e < 2; ++e) { const double t = pr * pr - pi * pi; pi = 2.0 * pr * pi; pr = t; }
              TA[((g * 2 + hh) * 2 + 0) * 32 + sh * 16 + ii] = (float)pr; TA[((g * 2 + hh) * 2 + 1) * 32 + sh * 16 + ii] = (float)pi; }
            const double mg8 = exp(8.0 * dt * ar), z1r = mg8 * cos(8.0 * dt * ai), z1i = mg8 * sin(8.0 * dt * ai); double pzr = 1.0, pzi = 0.0;
            for (int e = 0; e <= 16; ++e) { const float zr = (float)pzr, zi = (float)pzi; { const double nr2 = pzr * z1r - pzi * z1i, ni2 = pzr * z1i + pzi * z1r; pzr = nr2; pzi = ni2; }
                ZP[(((g * 17 + e) * 2 + hh) * 2 + 0) * 32 + sh * 16 + ii] = zr; ZP[(((g * 17 + e) * 2 + hh) * 2 + 1) * 32 + sh * 16 + ii] = zi;
                if (e == 16) { Z16N[(g * 2 + 0) * 64 + n] = zr; Z16N[(g * 2 + 1) * 64 + n] = zi; } }
            continue; } r -= I_S5;
        if (r < I_RG) { const int c = r * 64 + F.lane; const double lam = (double)A.in[I_RGLAM][c];
          sc[SC_RGL + c] = (float)(-8.0 * log1p(exp(-lam)) * 1.4426950408889634); continue; } r -= I_RG;
        if (r >= I_RGT + I_CB + I_DG) { r -= I_RGT + I_CB + I_DG;
            const int g = r >> 3, j = r & 7, n = F.lane, gn = g * NS5 + n, sh = n >> 5;
            const double dt = exp((double)A.in[I_S5LOGDT][g]), ar = (double)A.in[I_S5ARE][gn], ai = (double)A.in[I_S5AIM][gn];
            const double mag = exp(dt * ar), abr = mag * cos(dt * ai), abi = mag * sin(dt * ai), den = ar * ar + ai * ai, nr0 = abr - 1.0;
            const double qr = (nr0 * ar + abi * ai) / den, qi = (abi * ar - nr0 * ai) / den;
            const double mgp = exp((double)(j + 1) * dt * ar), anp = (double)(j + 1) * dt * ai, pr = mgp * cos(anp), pi = mgp * sin(anp);
            const double pm2 = pr * pr + pi * pi, nr_ = pr / pm2, ni_ = -pi / pm2;
            bf16* W1T = (bf16*)(F.ws + WS_TAB + TB_W1); bf16* C2T = (bf16*)(F.ws + WS_TAB + TB_C2);
            const int s2 = (n >> 4) & 1, jj2 = 4 * ((n >> 3) & 1) + (n & 3), hk2 = (n >> 2) & 1;
#pragma unroll 4
            for (int k = 0; k < KS5; ++k) { const double br = (double)A.in[I_S5BRE][gn * KS5 + k], bi = (double)A.in[I_S5BIM][gn * KS5 + k];
                const double bbr = qr * br - qi * bi, bbi = qr * bi + qi * br;
                const float wr = (float)(nr_ * bbr - ni_ * bbi), wi = (float)(nr_ * bbi + ni_ * bbr);
                const int lp = (n & 31) + 32 * (k >> 3), jj = k & 7;
                W1T[(size_t)(((g * 8 + j) * 4 + 0 + sh) * 64 + lp) * 8 + jj] = (bf16)f2bf(wr); W1T[(size_t)(((g * 8 + j) * 4 + 2 + sh) * 64 + lp) * 8 + jj] = (bf16)f2bf(wi); }
#pragma unroll 4
            for (int ch = 0; ch < KS5; ++ch) { const int hr_ = ch >> 3, i8 = ch & 7, R = (i8 & 3) + 8 * (i8 >> 2) + 4 * hr_, lp = R + 32 * hk2;
                const double cr = (double)A.in[I_S5CRE][(size_t)(g * KS5 + ch) * NS5 + n], ci = (double)A.in[I_S5CIM][(size_t)(g * KS5 + ch) * NS5 + n];
                const float c2r = (float)(cr * pr - ci * pi), c2i = (float)(cr * pi + ci * pr);
                C2T[(size_t)(((g * 8 + j) * 8 + (0 + sh) * 2 + s2) * 64 + lp) * 8 + jj2] = (bf16)f2bf(c2r); C2T[(size_t)(((g * 8 + j) * 8 + (2 + sh) * 2 + s2) * 64 + lp) * 8 + jj2] = (bf16)f2bf(-c2i); }
            for (int z = 0; z < 4; ++z) { const int cidx = n + 64 * z, ks = cidx >> 5, r16 = cidx & 31, lp = 16 + (r16 & 15) + 32 * (r16 >> 4);
                *(v4u*)(C2T + (size_t)(((g * 8 + j) * 8 + ks) * 64 + lp) * 8) = (v4u){0u, 0u, 0u, 0u}; }
            continue; }
        if (r >= I_RGT + I_CB) { r -= I_RGT + I_CB;
            const int k = r & 3, sp = (r >> 2) & 1, tau = (r >> 3) & 1, hd = r >> 4, R = F.lane & 31, hk = F.lane >> 5;
            unsigned wv = 0u; if ((R >> 3) == 2 * sp + hk) wv = f2bf(A.in[I_CONVW][k * WA + hd * 64 + 32 * tau + R]);
            const int jj = R & 7; v4u o = (v4u){0u, 0u, 0u, 0u}; const unsigned word = (jj & 1) ? (wv << 16) : wv;
            if ((jj >> 1) == 0) o.x = word; else if ((jj >> 1) == 1) o.y = word; else if ((jj >> 1) == 2) o.z = word; else o.w = word;
            *(v4u*)(F.ws + WS_TAB + TB_DG + (size_t)(r * 64 + F.lane) * 16) = o; continue; }
        if (r >= I_RGT) { r -= I_RGT;
            const float* src = A.in[I_SCONV] + (size_t)r * 512 + F.lane * 8; const f32x4 a0 = *(const f32x4*)src, a1 = *(const f32x4*)(src + 4);
            v4u o; o.x = pk2(a0[0], a0[1]); o.y = pk2(a0[2], a0[3]); o.z = pk2(a1[0], a1[1]); o.w = pk2(a1[2], a1[3]);
            *(v4u*)(F.ws + WS_TAB + TB_CB + ((size_t)r * 512 + F.lane * 8) * 2) = o; continue; }
        {
            const int ks = r & 3, gate = (r >> 2) & 1, jh = (r >> 3) & 1, hd = r >> 4;
            const int R = F.lane & 31, hk = F.lane >> 5;
            const float* W = A.in[gate ? I_RGWI : I_RGWR] + (size_t)(hd * 64 + 32 * (ks >> 1) + 16 * (ks & 1) + 4 * hk) * 64 + 32 * jh + R;
            v4u o; o.x = pk2(W[0], W[64]); o.y = pk2(W[128], W[192]); o.z = pk2(W[8 * 64], W[9 * 64]); o.w = pk2(W[10 * 64], W[11 * 64]);
            *(v4u*)(F.ws + WS_TAB + TB_RG + (size_t)(r * 64 + F.lane) * 16) = o;
        }
    }
    __syncthreads();
    if (F.tid == 0) {
        unsigned sp = 0; while (__hip_atomic_load((unsigned*)(F.ctl + CW_SILU), RLX_AGENT) < (unsigned)F.G && ++sp < (1u << 22)) __builtin_amdgcn_s_sleep(2);
        __builtin_amdgcn_fence(__ATOMIC_ACQUIRE, "agent"); VM_WAIT(); }
    __syncthreads();
    LAS float* RED = (LAS float*)(F.lds + RING_OFF);
    float* mod = (float*)(F.ws + WS_MOD);
    const int r32 = F.lane & 31, hh = F.lane >> 5;
    const bf16* ST = (const bf16*)(F.ws + WS_TAB + TB_SILU);
#pragma unroll 1
    for (int it = F.vcu; it < ((pmask & 4) ? NMOD / 32 : 0); it += F.G) {
        const int n0 = it * 32;
        f32x16m acc[5];
#pragma unroll
        for (int rt = 0; rt < 5; ++rt)
#pragma unroll
            for (int i = 0; i < 16; ++i) acc[rt][i] = 0.f;
#pragma unroll 1
        for (int kb = 0; kb < 4; ++kb) {
            float bw[2][8]; v4u af[2][5];
#pragma unroll
            for (int ks = 0; ks < 2; ++ks) { const int k0 = F.wave * 128 + (kb * 2 + ks) * 16 + 8 * hh;
                const float* wp = A.in[I_ADAW] + (size_t)k0 * NMOD + n0 + r32;
#pragma unroll
                for (int j = 0; j < 8; ++j) bw[ks][j] = wp[(size_t)j * NMOD];
#pragma unroll
                for (int rt = 0; rt < 5; ++rt) af[ks][rt] = *(const v4u*)(ST + (size_t)(32 * rt + r32) * D + k0); }
#pragma unroll
            for (int ks = 0; ks < 2; ++ks) {
                v4u bp; bp.x = pkbf0(bw[ks][0], bw[ks][1]); bp.y = pkbf0(bw[ks][2], bw[ks][3]); bp.z = pkbf0(bw[ks][4], bw[ks][5]); bp.w = pkbf0(bw[ks][6], bw[ks][7]);
                const bf16x8m bfr = __builtin_bit_cast(bf16x8m, bp);
#pragma unroll
                for (int rt = 0; rt < 5; ++rt) acc[rt] = __builtin_amdgcn_mfma_f32_32x32x16_bf16(__builtin_bit_cast(bf16x8m, af[ks][rt]), bfr, acc[rt], 0, 0, 0); }
        }
#pragma unroll
        for (int half = 4; half >= 1; half >>= 1) {
            if (F.wave >= half && F.wave < 2 * half) {
#pragma unroll
                for (int rt = 0; rt < 5; ++rt)
#pragma unroll
                    for (int i = 0; i < 16; ++i) RED[(F.wave - half) * 5120 + (rt * 16 + i) * 64 + F.lane] = acc[rt][i]; }
            __syncthreads();
            if (F.wave < half) {
#pragma unroll
                for (int rt = 0; rt < 5; ++rt)
#pragma unroll
                    for (int i = 0; i < 16; ++i) acc[rt][i] += RED[F.wave * 5120 + (rt * 16 + i) * 64 + F.lane]; }
            __syncthreads();
        }
        if (F.wave == 0) { const float bb = A.in[I_ADAB][n0 + r32];
#pragma unroll
            for (int rt = 0; rt < 5; ++rt)
#pragma unroll
                for (int i = 0; i < 16; ++i) { const int row = 32 * rt + (i & 3) + 8 * (i >> 2) + 4 * hh; if (row < NROWMOD) __hip_atomic_store(mod + (size_t)row * NMOD + n0 + r32, acc[rt][i] + bb, RLX_AGENT); } }
        if (n0 < 2 * D) cnt_arrive_wt(F, CW_MOD);
    }
}

__device__ __forceinline__ int mod_row(int m) { return m < MP ? (m >> 11) : NBP + ((m - MP) >> 2); }
__device__ __forceinline__ const float* x_row(const Args& A, int m) { return m < MP ? A.in[I_XP] + (size_t)m * D : A.in[I_XS] + (size_t)(m - MP) * D; }

__device__ __forceinline__ void p1_modulate(Frame& F, const Args& A, int rep = 0) {
    refresh(F);
    cnt_wait_ge(F, CW_MOD, (unsigned)(2 * D / 32));
    const int gw = F.vcu * NWAVES + F.wave, NGW = F.G * NWAVES;
    const float* mod = (const float*)(F.ws + WS_MOD); bf16* XN = (bf16*)(F.ws + WS_XN);
    for (int m = gw; m < M; m += NGW) {
        const float* xr = x_row(A, m) + 8 * F.lane; const float* mr = mod + (size_t)mod_row(m) * NMOD + 8 * F.lane;
#pragma unroll
        for (int j = 0; j < 2; ++j) { const f32x4 v0 = *(const f32x4*)(xr + 512 * j), v1 = *(const f32x4*)(xr + 512 * j + 4);
            const f32x4 a0 = *(const f32x4*)(mr + 512 * j), a1 = *(const f32x4*)(mr + 512 * j + 4), s0 = *(const f32x4*)(mr + D + 512 * j), s1 = *(const f32x4*)(mr + D + 512 * j + 4);
            const f32x4 h0 = v0 * (s0 + 1.f) + a0, h1 = v1 * (s1 + 1.f) + a1;
            v4u o; o.x = pk2(h0.x, h0.y); o.y = pk2(h0.z, h0.w); o.z = pk2(h1.x, h1.y); o.w = pk2(h1.z, h1.w);
            *(v4u*)(XN + (size_t)m * D + 512 * j + 8 * F.lane) = o; }
    }
}

__device__ __forceinline__ void unpack8(const v4u w, f32x4& a, f32x4& b) { a = (f32x4){pg8::bf_lo(w.x), pg8::bf_hi(w.x), pg8::bf_lo(w.y), pg8::bf_hi(w.y)}; b = (f32x4){pg8::bf_lo(w.z), pg8::bf_hi(w.z), pg8::bf_lo(w.w), pg8::bf_hi(w.w)}; }
__device__ __forceinline__ v4u pack8f(const f32x4 a, const f32x4 b) { v4u o; o.x = pk2(a.x, a.y); o.y = pk2(a.z, a.w); o.z = pk2(b.x, b.y); o.w = pk2(b.z, b.w); return o; }
template <bool SECOND>
__device__ __forceinline__ void ln_rows(Frame& F, const Args& A, int row_lo, int row_hi, int gw, int NGW) {
    refresh(F);
    const float* mod = (const float*)(F.ws + WS_MOD); bf16* XN = (bf16*)(F.ws + WS_XN);
    const float* gg = A.in[SECOND ? I_LN2G : I_LN1G] + 8 * F.lane; const float* gb = A.in[SECOND ? I_LN2B : I_LN1B] + 8 * F.lane;
    for (int m = row_lo + gw; m < row_hi; m += NGW) {
        float* xr = F.out + (size_t)m * D + 8 * F.lane;
        f32x4 v[2][2]; float s = 0.f;
        if (m >= MP) {
            const float* mr = mod + (size_t)mod_row(m) * NMOD + (SECOND ? 5 : 2) * D + 8 * F.lane;
            const float* bs = SECOND ? xr : A.in[I_XS] + (size_t)(m - MP) * D + 8 * F.lane;
            const float* sl = (const float*)(F.ws + WS_SLAB) + (size_t)(m - MP) * D + 8 * F.lane;
#pragma unroll
            for (int j = 0; j < 2; ++j)
#pragma unroll
                for (int h = 0; h < 2; ++h) { const int o = 512 * j + 4 * h; f32x4 a = SECOND ? *(const f32x4*)(A.in[I_B2] + 8 * F.lane + o) : (f32x4){0.f, 0.f, 0.f, 0.f};
#pragma unroll
                    for (int ks = 0; ks < (SECOND ? NS_DOWN : NS_OUT); ++ks) a += *(const f32x4*)(sl + (size_t)ks * (512 * 1024) + o);
                    v[j][h] = *(const f32x4*)(bs + o) * ALPHA + *(const f32x4*)(mr + o) * a; }
        } else {
            const bf16* tr = (const bf16*)(F.ws + (SECOND ? WS_T2 : WS_T1)) + (size_t)m * D + 8 * F.lane;
#pragma unroll
            for (int j = 0; j < 2; ++j) unpack8(*(const v4u*)(tr + 512 * j), v[j][0], v[j][1]);
        }
#pragma unroll
        for (int j = 0; j < 2; ++j)
#pragma unroll
            for (int h = 0; h < 2; ++h) s += (v[j][h].x + v[j][h].y) + (v[j][h].z + v[j][h].w);
        const float mean = wave_sum(s) * (1.f / D); float s2 = 0.f;
#pragma unroll
        for (int j = 0; j < 2; ++j)
#pragma unroll
            for (int h = 0; h < 2; ++h) { v[j][h] = v[j][h] - mean; s2 += (v[j][h].x * v[j][h].x + v[j][h].y * v[j][h].y) + (v[j][h].z * v[j][h].z + v[j][h].w * v[j][h].w); }
        const float rstd = 1.f / sqrtf(wave_sum(s2) * (1.f / D) + LN_EPS);
#pragma unroll
        for (int j = 0; j < 2; ++j)
#pragma unroll
            for (int h = 0; h < 2; ++h) v[j][h] = v[j][h] * rstd * *(const f32x4*)(gg + 512 * j + 4 * h) + *(const f32x4*)(gb + 512 * j + 4 * h);
        if (SECOND || m >= MP) {
#pragma unroll
            for (int j = 0; j < 2; ++j) { *(f32x4*)(xr + 512 * j) = v[j][0]; *(f32x4*)(xr + 512 * j + 4) = v[j][1]; }
        } else {
            bf16* x1 = (bf16*)(F.ws + WS_X1B) + (size_t)m * D + 8 * F.lane;
#pragma unroll
            for (int j = 0; j < 2; ++j) *(v4u*)(x1 + 512 * j) = pack8f(v[j][0], v[j][1]);
        }
        if (!SECOND) {
            const float* mr = mod + (size_t)mod_row(m) * NMOD + 8 * F.lane;
#pragma unroll
            for (int j = 0; j < 2; ++j) { const int o = 512 * j;
                const f32x4 h0 = v[j][0] * (*(const f32x4*)(mr + 4 * D + o) + 1.f) + *(const f32x4*)(mr + 3 * D + o), h1 = v[j][1] * (*(const f32x4*)(mr + 4 * D + o + 4) + 1.f) + *(const f32x4*)(mr + 3 * D + o + 4);
                pg8::st16_wt(XN + (size_t)m * D + o + 8 * F.lane, pack8f(h0, h1)); }
        }
    }
}

__device__ __forceinline__ void rg_item_ref(Frame& F, const Args& A, bool prompt, int b, int hd, LAS float* scr) {
    const int j = F.lane, c = hd * HDA + j;
    const bf16* Z = (const bf16*)(F.ws + WS_Z); bf16* Y = (bf16*)(F.ws + WS_YCAT); const float* sc = (const float*)(F.ws + WS_S5C);
    float wr[64], wi[64];
#pragma unroll
    for (int i = 0; i < 64; ++i) { wr[i] = A.in[I_RGWR][(size_t)(hd * 64 + i) * 64 + j]; wi[i] = A.in[I_RGWI][(size_t)(hd * 64 + i) * 64 + j]; }
    const float br = A.in[I_RGBR][c], bi = A.in[I_RGBI][c], L2 = sc[SC_RGL + c];
    const float w0 = A.in[I_CONVW][c], w1 = A.in[I_CONVW][WA + c], w2 = A.in[I_CONVW][2 * WA + c], w3 = A.in[I_CONVW][3 * WA + c], cb = A.in[I_CONVB][c];
    int T, m0; float x3, x2, x1, h;
    if (prompt) { T = TP; m0 = b * TP; x3 = 0.f; x2 = 0.f; x1 = 0.f; h = 0.f; }
    else { T = TS; m0 = MP + b * TS; x3 = A.in[I_SCONV][(size_t)(b * 3 + 0) * WA + c]; x2 = A.in[I_SCONV][(size_t)(b * 3 + 1) * WA + c]; x1 = A.in[I_SCONV][(size_t)(b * 3 + 2) * WA + c]; h = A.in[I_SH][(size_t)b * WA + c]; }
    for (int t = 0; t < T; ++t) {
        const size_t m = (size_t)(m0 + t);
        const float xa = bf2f(Z[m * NZ + WA + c]), gate = bf2f(Z[m * NZ + c]);
        const float xc = cb + w0 * x3 + w1 * x2 + w2 * x1 + w3 * xa; x3 = x2; x2 = x1; x1 = xa;
        scr[j] = xc; LDS_WAIT(); asm volatile("" ::: "memory");
        float rp = br, gp = bi;
#pragma unroll
        for (int i4 = 0; i4 < 16; ++i4) { const f32x4 v = *(const LAS f32x4*)(scr + 4 * i4);
            rp += v[0] * wr[4 * i4] + v[1] * wr[4 * i4 + 1] + v[2] * wr[4 * i4 + 2] + v[3] * wr[4 * i4 + 3];
            gp += v[0] * wi[4 * i4] + v[1] * wi[4 * i4 + 1] + v[2] * wi[4 * i4 + 2] + v[3] * wi[4 * i4 + 3]; }
        LDS_WAIT(); asm volatile("" ::: "memory");
        const float r = sigmoidf_(rp), gi = sigmoidf_(gp);
        const float a = exp2f(r * L2);
        float mult = sqrtf(fmaxf(1.f - a * a, 0.f));
        if (prompt && t == 0) mult = 1.f;
        h = a * h + mult * gi * xc;
        Y[m * D + c] = (bf16)f2bf(gelu_tanh(gate) * h);
    }
    float* oc = F.out + (prompt ? O_CONVP : O_CONVS); float* oh = F.out + (prompt ? O_HP : O_HS);
    oc[(size_t)(b * 3 + 0) * WA + c] = x3; oc[(size_t)(b * 3 + 1) * WA + c] = x2; oc[(size_t)(b * 3 + 2) * WA + c] = x1;
    oh[(size_t)b * WA + c] = h;
}
__device__ __forceinline__ void s5_item_ref(Frame& F, const Args& A, bool prompt, int b, int g, LAS float* scr) {
    const int n = F.lane, gn = g * NS5 + n, k = F.lane & 15, part = F.lane >> 4;
    const bf16* Z = (const bf16*)(F.ws + WS_Z); bf16* Gy = (bf16*)(F.ws + WS_G); const float* sc = (const float*)(F.ws + WS_S5C);
    float bbr[16], bbi[16], cre[16], cim[16];
#pragma unroll
    for (int i = 0; i < 16; ++i) { bbr[i] = sc[SC_BBR + gn * KS5 + i]; bbi[i] = sc[SC_BBI + gn * KS5 + i];
        cre[i] = A.in[I_S5CRE][(size_t)(g * KS5 + k) * NS5 + part * 16 + i]; cim[i] = A.in[I_S5CIM][(size_t)(g * KS5 + k) * NS5 + part * 16 + i]; }
    const float abr = sc[SC_ABR + gn], abi = sc[SC_ABI + gn], dk = A.in[I_S5D][g * KS5 + k];
    int T, m0; float hr, hi;
    if (prompt) { T = TP; m0 = b * TP; hr = 0.f; hi = 0.f; }
    else { T = TS; m0 = MP + b * TS; hr = A.in[I_SSR][(size_t)(b * GB + g) * NS5 + n]; hi = A.in[I_SSI][(size_t)(b * GB + g) * NS5 + n]; }
    for (int t = 0; t < T; ++t) {
        const size_t m = (size_t)(m0 + t);
        const bf16* zr = Z + m * NZ + 2 * WA + g * KS5;
        const v4u u0 = *(const v4u*)zr, u1 = *(const v4u*)(zr + 8);
        float u[16];
        u[0] = pg8::bf_lo(u0.x); u[1] = pg8::bf_hi(u0.x); u[2] = pg8::bf_lo(u0.y); u[3] = pg8::bf_hi(u0.y); u[4] = pg8::bf_lo(u0.z); u[5] = pg8::bf_hi(u0.z); u[6] = pg8::bf_lo(u0.w); u[7] = pg8::bf_hi(u0.w);
        u[8] = pg8::bf_lo(u1.x); u[9] = pg8::bf_hi(u1.x); u[10] = pg8::bf_lo(u1.y); u[11] = pg8::bf_hi(u1.y); u[12] = pg8::bf_lo(u1.z); u[13] = pg8::bf_hi(u1.z); u[14] = pg8::bf_lo(u1.w); u[15] = pg8::bf_hi(u1.w);
        float bur = 0.f, bui = 0.f;
#pragma unroll
        for (int i = 0; i < 16; ++i) { bur += bbr[i] * u[i]; bui += bbi[i] * u[i]; }
        const float nhr = abr * hr - abi * hi + bur, nhi = abr * hi + abi * hr + bui; hr = nhr; hi = nhi;
        scr[n] = hr; scr[64 + n] = hi; LDS_WAIT(); asm volatile("" ::: "memory");
        float p = 0.f;
#pragma unroll
        for (int i4 = 0; i4 < 4; ++i4) { const f32x4 vr = *(const LAS f32x4*)(scr + part * 16 + 4 * i4), vi = *(const LAS f32x4*)(scr + 64 + part * 16 + 4 * i4);
#pragma unroll
            for (int e = 0; e < 4; ++e) p += vr[e] * cre[4 * i4 + e] - vi[e] * cim[4 * i4 + e]; }
        LDS_WAIT(); asm volatile("" ::: "memory");
        p += __shfl_xor(p, 16); p += __shfl_xor(p, 32);
        const float uk = bf2f(zr[k]);
        if (F.lane < 16) Gy[m * WB + g * KS5 + k] = (bf16)f2bf(gelu_tanh(p + dk * uk));
    }
    float* osr = F.out + (prompt ? O_SRP : O_SRS); float* osi = F.out + (prompt ? O_SIP : O_SIS);
    osr[(size_t)(b * GB + g) * NS5 + n] = hr; osi[(size_t)(b * GB + g) * NS5 + n] = hi;
}

typedef short bf16x8v __attribute__((ext_vector_type(8)));
typedef float f32x16 __attribute__((ext_vector_type(16)));
typedef float f32x2v __attribute__((ext_vector_type(2)));
typedef __bf16 bf16x2v __attribute__((ext_vector_type(2)));
#define MFMA32(a, b, c) __builtin_amdgcn_mfma_f32_32x32x16_bf16((a), (b), (c), 0, 0, 0)
__device__ __forceinline__ unsigned pkbf(float a, float b) { const f32x2v v = {a, b}; const bf16x2v r = __builtin_convertvector(v, bf16x2v); return __builtin_bit_cast(unsigned, r); }
template <int CTRL> __device__ __forceinline__ float dppf(float old, float v) { return __builtin_bit_cast(float, __builtin_amdgcn_update_dpp(__builtin_bit_cast(int, old), __builtin_bit_cast(int, v), CTRL, 0xF, 0xF, false)); }
__device__ __forceinline__ f32x16 ld16(const float* p) { f32x16 r;
#pragma unroll
    for (int i = 0; i < 4; ++i) { const f32x4 v = *(const f32x4*)(p + 4 * i); r[4 * i] = v[0]; r[4 * i + 1] = v[1]; r[4 * i + 2] = v[2]; r[4 * i + 3] = v[3]; }
    return r; }
__device__ __forceinline__ f32x16 ld16l(const LAS float* p) { f32x16 r;
#pragma unroll
    for (int i = 0; i < 4; ++i) { const f32x4 v = *(const LAS f32x4*)(p + 4 * i); r[4 * i] = v[0]; r[4 * i + 1] = v[1]; r[4 * i + 2] = v[2]; r[4 * i + 3] = v[3]; }
    return r; }
__device__ __forceinline__ bf16x8v pack8(const f32x16& x, int s) { v4u p; p.x = pkbf(x[8 * s], x[8 * s + 1]); p.y = pkbf(x[8 * s + 2], x[8 * s + 3]); p.z = pkbf(x[8 * s + 4], x[8 * s + 5]); p.w = pkbf(x[8 * s + 6], x[8 * s + 7]); return __builtin_bit_cast(bf16x8v, p); }
template <int CTRL> __device__ __forceinline__ void s5_scan_step(f32x16& xr, f32x16& xi, const f32x16& zr, const f32x16& zi) {
#pragma unroll
    for (int i = 0; i < 16; ++i) { const float sr = dppf<CTRL>(0.f, xr[i]), si = dppf<CTRL>(0.f, xi[i]);
        xr[i] += zr[i] * sr - zi[i] * si; xi[i] += zr[i] * si + zi[i] * sr; }
}
constexpr int S5L_W1 = 0, S5L_C2 = 32768, S5L_TOT = 98304, S5L_CAR = 106496, S5L_ZP = 114688, S5L_TA = 123392;
static_assert(S5L_TA + 512 <= RING_BYTES, "S5 LDS map");
template <bool SECOND>
__device__ __forceinline__ void s5_step(LAS unsigned char* L, int lane, int j, const bf16x8v u, f32x16& gr0, f32x16& gr1, f32x16& gi0, f32x16& gi1, const float (&dk)[8], bf16* gout) {
    const LAS bf16x8v* a1 = (const LAS bf16x8v*)(L + S5L_W1) + j * 256 + lane;
    gr0 = MFMA32(a1[0], u, gr0); gr1 = MFMA32(a1[64], u, gr1); gi0 = MFMA32(a1[128], u, gi0); gi1 = MFMA32(a1[192], u, gi1);
    if (SECOND) {
        const LAS bf16x8v* a2 = (const LAS bf16x8v*)(L + S5L_C2) + j * 512 + lane;
        f32x16 y;
#pragma unroll
        for (int i = 0; i < 16; ++i) y[i] = 0.f;
        y = MFMA32(a2[0 * 64], pack8(gr0, 0), y); y = MFMA32(a2[1 * 64], pack8(gr0, 1), y);
        y = MFMA32(a2[2 * 64], pack8(gr1, 0), y); y = MFMA32(a2[3 * 64], pack8(gr1, 1), y);
        y = MFMA32(a2[4 * 64], pack8(gi0, 0), y); y = MFMA32(a2[5 * 64], pack8(gi0, 1), y);
        y = MFMA32(a2[6 * 64], pack8(gi1, 0), y); y = MFMA32(a2[7 * 64], pack8(gi1, 1), y);
        const v4u uw = __builtin_bit_cast(v4u, u);
        float o[8];
        o[0] = gelu_tanh(y[0] + dk[0] * pg8::bf_lo(uw.x)); o[1] = gelu_tanh(y[1] + dk[1] * pg8::bf_hi(uw.x));
        o[2] = gelu_tanh(y[2] + dk[2] * pg8::bf_lo(uw.y)); o[3] = gelu_tanh(y[3] + dk[3] * pg8::bf_hi(uw.y));
        o[4] = gelu_tanh(y[4] + dk[4] * pg8::bf_lo(uw.z)); o[5] = gelu_tanh(y[5] + dk[5] * pg8::bf_hi(uw.z));
        o[6] = gelu_tanh(y[6] + dk[6] * pg8::bf_lo(uw.w)); o[7] = gelu_tanh(y[7] + dk[7] * pg8::bf_hi(uw.w));
        v4u w; w.x = pkbf(o[0], o[1]); w.y = pkbf(o[2], o[3]); w.z = pkbf(o[4], o[5]); w.w = pkbf(o[6], o[7]);
        pg8::st16_wt(gout, w);
    }
}
__device__ __forceinline__ void s5_cmul(const LAS float* p, f32x16& r0, f32x16& r1, f32x16& i0, f32x16& i1) {
    { const f32x16 zr = ld16l(p), zi = ld16l(p + 32); const f32x16 t = zr * r0 - zi * i0; i0 = zr * i0 + zi * r0; r0 = t; }
    asm volatile("" : "+v"(r0), "+v"(i0) :: "memory");
    { const f32x16 zr = ld16l(p + 16), zi = ld16l(p + 48); const f32x16 t = zr * r1 - zi * i1; i1 = zr * i1 + zi * r1; r1 = t; }
    asm volatile("" : "+v"(r1), "+v"(i1) :: "memory");
}
__device__ __forceinline__ void s5_stage_tables(Frame& F, LAS unsigned char* L, const unsigned char* tab, int g) {
    const v4u* s1 = (const v4u*)(tab + TB_W1) + (size_t)g * 2048; const v4u* s2 = (const v4u*)(tab + TB_C2) + (size_t)g * 4096;
#pragma unroll
    for (int k = 0; k < 4; ++k) ((LAS v4u*)(L + S5L_W1))[F.tid + 512 * k] = s1[F.tid + 512 * k];
#pragma unroll
    for (int k = 0; k < 8; ++k) ((LAS v4u*)(L + S5L_C2))[F.tid + 512 * k] = s2[F.tid + 512 * k];
    const v4u* s3 = (const v4u*)(tab + TB_ZP) + (size_t)g * (17 * 128 / 4); for (int e = F.tid; e < 17 * 128 / 4; e += NWAVES * 64) ((LAS v4u*)(L + S5L_ZP))[e] = s3[e];
    if (F.tid < 32) ((LAS v4u*)(L + S5L_TA))[F.tid] = ((const v4u*)(tab + TB_TA) + (size_t)g * 32)[F.tid];
}
__device__ __forceinline__ void s5_item_fast(Frame& F, const Args& A, int b, int g) {
    refresh(F);
    const int lane = F.lane, q = lane & 31, hh = lane >> 5, w = F.wave, c = w * 32 + q;
    LAS unsigned char* L = F.lds + RING_OFF;
    const unsigned char* tab = F.ws + WS_TAB;
    const size_t m0 = (size_t)b * TP + (size_t)8 * c;
    const bf16* zrow = (const bf16*)(F.ws + WS_Z) + m0 * NZ + 2 * WA + g * KS5 + 8 * hh;
    bf16* grow = (bf16*)(F.ws + WS_G) + m0 * WB + g * KS5 + 8 * hh;
    bf16x8v uu[8];
#pragma unroll
    for (int j = 0; j < 8; ++j) uu[j] = *(const bf16x8v*)(zrow + (size_t)j * NZ);
    s5_stage_tables(F, L, tab, g);
    __syncthreads();
    f32x16 hr0, hr1, hi0, hi1;
#pragma unroll
    for (int i = 0; i < 16; ++i) { hr0[i] = 0.f; hr1[i] = 0.f; hi0[i] = 0.f; hi1[i] = 0.f; }
    float dk[8];
#pragma unroll
    for (int i = 0; i < 8; ++i) dk[i] = A.in[I_S5D][g * KS5 + 8 * hh + i];
#pragma unroll
    for (int j = 0; j < 8; ++j) s5_step<false>(L, lane, j, uu[j], hr0, hr1, hi0, hi1, dk, nullptr);
    const LAS float* ZP = (const LAS float*)(L + S5L_ZP);
    s5_cmul(ZP + ((1 * 2 + hh) * 2) * 32, hr0, hr1, hi0, hi1);
#define S5_SCAN(E, CTRL) do { const LAS float* z = ZP + (((E) * 2 + hh) * 2) * 32; \
        { const f32x16 zr = ld16l(z), zi = ld16l(z + 32); s5_scan_step<CTRL>(hr0, hi0, zr, zi); } \
        asm volatile("" : "+v"(hr0), "+v"(hi0) :: "memory"); \
        { const f32x16 zr = ld16l(z + 16), zi = ld16l(z + 48); s5_scan_step<CTRL>(hr1, hi1, zr, zi); } \
        asm volatile("" : "+v"(hr1), "+v"(hi1) :: "memory"); } while (0)
    S5_SCAN(1, 0x111); S5_SCAN(2, 0x112); S5_SCAN(4, 0x114); S5_SCAN(8, 0x118);
#undef S5_SCAN
    const int seg = w * 2 + (q >> 4);
    LAS float* TOT = (LAS float*)(L + S5L_TOT); LAS float* CAR = (LAS float*)(L + S5L_CAR);
    if ((lane & 15) == 15) {
#pragma unroll
        for (int rho = 0; rho < 4; ++rho) {
            *(LAS f32x4*)(TOT + (seg * 2 + 0) * 64 + 0 + 8 * rho + 4 * hh) = (f32x4){hr0[4 * rho], hr0[4 * rho + 1], hr0[4 * rho + 2], hr0[4 * rho + 3]};
            *(LAS f32x4*)(TOT + (seg * 2 + 0) * 64 + 32 + 8 * rho + 4 * hh) = (f32x4){hr1[4 * rho], hr1[4 * rho + 1], hr1[4 * rho + 2], hr1[4 * rho + 3]};
            *(LAS f32x4*)(TOT + (seg * 2 + 1) * 64 + 0 + 8 * rho + 4 * hh) = (f32x4){hi0[4 * rho], hi0[4 * rho + 1], hi0[4 * rho + 2], hi0[4 * rho + 3]};
            *(LAS f32x4*)(TOT + (seg * 2 + 1) * 64 + 32 + 8 * rho + 4 * hh) = (f32x4){hi1[4 * rho], hi1[4 * rho + 1], hi1[4 * rho + 2], hi1[4 * rho + 3]}; }
    }
    __syncthreads();
    if (F.tid < 64) {
        const float* z16 = (const float*)(tab + TB_Z16N) + (size_t)g * 128; const float zr = z16[F.tid], zi = z16[64 + F.tid];
        float cr = 0.f, ci = 0.f;
#pragma unroll
        for (int sg = 0; sg < 16; ++sg) { CAR[(sg * 2 + 0) * 64 + F.tid] = cr; CAR[(sg * 2 + 1) * 64 + F.tid] = ci;
            const float tr = TOT[(sg * 2 + 0) * 64 + F.tid], ti = TOT[(sg * 2 + 1) * 64 + F.tid];
            const float ncr = zr * cr - zi * ci + tr, nci = zr * ci + zi * cr + ti; cr = ncr; ci = nci; }
    }
    __syncthreads();
    {
        const LAS float* z = ZP + (((q & 15) * 2 + hh) * 2) * 32;
#define S5_EXCL(HR, HI, OFF) do { const f32x16 zr = ld16l(z + (OFF)), zi = ld16l(z + 32 + (OFF)); f32x16 kr, ki; \
        _Pragma("unroll") for (int rho = 0; rho < 4; ++rho) { \
            const f32x4 a0 = *(const LAS f32x4*)(CAR + (seg * 2 + 0) * 64 + 2 * (OFF) + 8 * rho + 4 * hh), b0 = *(const LAS f32x4*)(CAR + (seg * 2 + 1) * 64 + 2 * (OFF) + 8 * rho + 4 * hh); \
            _Pragma("unroll") for (int e = 0; e < 4; ++e) { kr[4 * rho + e] = a0[e]; ki[4 * rho + e] = b0[e]; } } \
        _Pragma("unroll") for (int i = 0; i < 16; ++i) { const float sr = dppf<0x111>(0.f, HR[i]), si = dppf<0x111>(0.f, HI[i]); \
            HR[i] = sr + zr[i] * kr[i] - zi[i] * ki[i]; HI[i] = si + zr[i] * ki[i] + zi[i] * kr[i]; } } while (0)
        S5_EXCL(hr0, hi0, 0); asm volatile("" : "+v"(hr0), "+v"(hi0) :: "memory"); S5_EXCL(hr1, hi1, 16); asm volatile("" : "+v"(hr1), "+v"(hi1) :: "memory");
#undef S5_EXCL
    }
#pragma unroll
    for (int j = 0; j < 8; ++j) s5_step<true>(L, lane, j, uu[j], hr0, hr1, hi0, hi1, dk, grow + (size_t)j * WB);
    if (w == NWAVES - 1 && q == 31) {
        s5_cmul(ZP + ((1 * 2 + hh) * 2) * 32, hr0, hr1, hi0, hi1);
        float* osr = F.out + O_SRP + (size_t)(b * GB + g) * NS5; float* osi = F.out + O_SIP + (size_t)(b * GB + g) * NS5;
#pragma unroll
        for (int i = 0; i < 16; ++i) { const int n = (i & 3) + 8 * (i >> 2) + 4 * hh; osr[n] = hr0[i]; osr[32 + n] = hr1[i]; osi[n] = hi0[i]; osi[32 + n] = hi1[i]; }
    }
    __syncthreads();
}

__device__ __forceinline__ void s5_item_sample(Frame& F, const Args& A, int g) {
    refresh(F);
    const int lane = F.lane, q = lane & 31, hh = lane >> 5, w = F.wave;
    LAS unsigned char* L = F.lds + RING_OFF;
    const unsigned char* tab = F.ws + WS_TAB;
    s5_stage_tables(F, L, tab, g);
    __syncthreads();
    if (w < 4) {
        const int b = w * 32 + q;
        f32x16 hr0, hr1, hi0, hi1;
        const float* sr = A.in[I_SSR] + (size_t)(b * GB + g) * NS5; const float* si = A.in[I_SSI] + (size_t)(b * GB + g) * NS5;
#pragma unroll
        for (int rho = 0; rho < 4; ++rho) { const f32x4 a0 = *(const f32x4*)(sr + 8 * rho + 4 * hh), a1 = *(const f32x4*)(sr + 32 + 8 * rho + 4 * hh), b0 = *(const f32x4*)(si + 8 * rho + 4 * hh), b1 = *(const f32x4*)(si + 32 + 8 * rho + 4 * hh);
#pragma unroll
            for (int e = 0; e < 4; ++e) { hr0[4 * rho + e] = a0[e]; hr1[4 * rho + e] = a1[e]; hi0[4 * rho + e] = b0[e]; hi1[4 * rho + e] = b1[e]; } }
        float dk[8];
#pragma unroll
        for (int i = 0; i < 8; ++i) dk[i] = A.in[I_S5D][g * KS5 + 8 * hh + i];
        const size_t m0 = (size_t)MP + (size_t)b * TS;
        const bf16* zrow = (const bf16*)(F.ws + WS_Z) + m0 * NZ + 2 * WA + g * KS5 + 8 * hh;
        bf16* grow = (bf16*)(F.ws + WS_G) + m0 * WB + g * KS5 + 8 * hh;
        bf16x8v uu[TS];
#pragma unroll
        for (int j = 0; j < TS; ++j) uu[j] = *(const bf16x8v*)(zrow + (size_t)j * NZ);
#pragma unroll
        for (int j = 0; j < TS; ++j) s5_step<true>(L, lane, j, uu[j], hr0, hr1, hi0, hi1, dk, grow + (size_t)j * WB);
        s5_cmul((const LAS float*)(L + S5L_TA) + hh * 64, hr0, hr1, hi0, hi1);
        float* osr = F.out + O_SRS + (size_t)(b * GB + g) * NS5; float* osi = F.out + O_SIS + (size_t)(b * GB + g) * NS5;
#pragma unroll
        for (int rho = 0; rho < 4; ++rho) {
            *(f32x4*)(osr + 8 * rho + 4 * hh) = (f32x4){hr0[4 * rho], hr0[4 * rho + 1], hr0[4 * rho + 2], hr0[4 * rho + 3]};
            *(f32x4*)(osr + 32 + 8 * rho + 4 * hh) = (f32x4){hr1[4 * rho], hr1[4 * rho + 1], hr1[4 * rho + 2], hr1[4 * rho + 3]};
            *(f32x4*)(osi + 8 * rho + 4 * hh) = (f32x4){hi0[4 * rho], hi0[4 * rho + 1], hi0[4 * rho + 2], hi0[4 * rho + 3]};
            *(f32x4*)(osi + 32 + 8 * rho + 4 * hh) = (f32x4){hi1[4 * rho], hi1[4 * rho + 1], hi1[4 * rho + 2], hi1[4 * rho + 3]}; }
    }
    __syncthreads();
}

template <int CTRL, int RMASK> __device__ __forceinline__ float dppm(float old, float v) { return __builtin_bit_cast(float, __builtin_amdgcn_update_dpp(__builtin_bit_cast(int, old), __builtin_bit_cast(int, v), CTRL, RMASK, 0xF, false)); }
template <int CTRL, int RMASK> __device__ __forceinline__ void rg_scan_step(f32x16& a, f32x16& b) {
#pragma unroll
    for (int i = 0; i < 16; ++i) { const float as = dppm<CTRL, RMASK>(1.f, a[i]), bs = dppm<CTRL, RMASK>(0.f, b[i]); b[i] = a[i] * bs + b[i]; a[i] = a[i] * as; }
}
constexpr int RGL_AFR = 0, RGL_DG = 8192, RGL_TOT = 24576, RGL_CST = 28672;
constexpr int RGL_XAP = 144;
constexpr int RGL_XA0 = 29696, RGL_BUF = 37376;
static_assert(259 * RGL_XAP <= RGL_BUF && RGL_XA0 + 2 * RGL_BUF <= RING_BYTES && RGL_CST + 640 <= RGL_XA0, "RG-LRU LDS map");
template <bool SAMPLE>
__device__ __forceinline__ void rg_item_fast(Frame& F, const Args& A, int b, int hd, int jh) {
    refresh(F);
    const int lane = F.lane, q = lane & 31, hh = lane >> 5, w = F.wave;
    LAS unsigned char* L = F.lds + RING_OFF;
    const float* sc = (const float*)(F.ws + WS_S5C);
    const bf16* Zb = (const bf16*)(F.ws + WS_Z) + (size_t)(SAMPLE ? MP : b * TP) * NZ; bf16* Yb = SAMPLE ? (bf16*)(F.ws + WS_YCS) : (bf16*)(F.ws + WS_YCAT) + (size_t)(b * TP) * D;
    const bf16* CB = (const bf16*)(F.ws + WS_TAB + TB_CB);
    auto stage_load = [&](int T0, v4u (&st)[5]) {
#pragma unroll
        for (int k = 0; k < 5; ++k) { const int ci = F.tid + 512 * k; v4u v = (v4u){0u, 0u, 0u, 0u};
            if (ci < 2072) { const int tk = T0 - 3 + (ci >> 3); if (tk >= 0) v = *(const v4u*)(Zb + (size_t)tk * NZ + WA + hd * 64 + (ci & 7) * 8); }
            st[k] = v; } };
    auto stage_write = [&](int par, const v4u (&st)[5]) {
#pragma unroll
        for (int k = 0; k < 5; ++k) { const int ci = F.tid + 512 * k;
            if (ci < 2072) *(LAS v4u*)(L + RGL_XA0 + par * RGL_BUF + (ci >> 3) * RGL_XAP + (ci & 7) * 16) = st[k]; } };
    {
        const v4u* src = (const v4u*)(F.ws + WS_TAB + TB_RG) + (size_t)((hd * 2 + jh) * 8) * 64;
        ((LAS v4u*)(L + RGL_AFR))[F.tid] = src[F.tid];
        const v4u* sd = (const v4u*)(F.ws + WS_TAB + TB_DG) + (size_t)(hd * 16) * 64;
        ((LAS v4u*)(L + RGL_DG))[F.tid] = sd[F.tid]; ((LAS v4u*)(L + RGL_DG))[512 + F.tid] = sd[512 + F.tid];
        if (F.tid < 160) { const int h2 = F.tid / 80, kind = (F.tid % 80) / 16, i = F.tid % 16, cr = (i & 3) + 8 * (i >> 2) + 4 * h2;
            const int c = hd * 64 + 32 * jh + cr;
            ((LAS float*)(L + RGL_CST))[F.tid] = kind == 0 ? A.in[I_RGBR][c] : kind == 1 ? A.in[I_RGBI][c] : kind == 2 ? sc[SC_RGL + c] : A.in[I_CONVB][hd * 64 + 32 * (kind - 3) + cr]; }
        if (!SAMPLE && jh == 0 && F.tid < 192) { const int k = F.tid >> 6, ch = F.tid & 63;
            F.out[O_CONVP + (size_t)(b * 3 + k) * WA + hd * 64 + ch] = bf2f(((const bf16*)(F.ws + WS_Z))[(size_t)(b * TP + TP - 3 + k) * NZ + WA + hd * 64 + ch]); }
        if (SAMPLE && jh == 0) { for (int e = F.tid; e < NBS * 3 * 64; e += NWAVES * 64) { const int bb = e / 192, k = (e / 64) % 3, ch = e & 63;
            F.out[O_CONVS + (size_t)(bb * 3 + k) * WA + hd * 64 + ch] = bf2f(((const bf16*)(F.ws + WS_Z))[(size_t)(MP + bb * TS + 1 + k) * NZ + WA + hd * 64 + ch]); } }
        if (!SAMPLE) { v4u st[5]; stage_load(0, st); stage_write(0, st); }
    }
    __syncthreads();
    float hround[16];
#pragma unroll
    for (int i = 0; i < 16; ++i) hround[i] = 0.f;
    const LAS float* CST = (const LAS float*)(L + RGL_CST) + hh * 80;
    const LAS bf16x8v* af = (const LAS bf16x8v*)(L + RGL_AFR) + lane;
    const LAS bf16x8v* dg = (const LAS bf16x8v*)(L + RGL_DG) + lane;
#pragma unroll 1
    for (int rd = 0; rd < (SAMPLE ? 2 : 8); ++rd) {
        const int t = rd * 256 + w * 32 + q;
        v4u stn[5];
        if (!SAMPLE) stage_load((rd + 1) * 256, stn);
        const LAS unsigned char* XAp = L + RGL_XA0 + (rd & 1) * RGL_BUF + (w * 32 + q) * RGL_XAP + 16 * hh;
        const bf16* zsr[4];
        if (SAMPLE) {
#pragma unroll
            for (int k = 0; k < 4; ++k) { const int jx = (t & 3) + k; zsr[k] = (jx < 3 ? CB + (size_t)((t >> 2) * 3 + jx) * WA : Zb + (size_t)(t - 3 + k) * NZ + WA) + hd * 64 + 8 * hh; } }
        const bf16* gr = Zb + (size_t)t * NZ + hd * 64 + 32 * jh + 4 * hh;
        unsigned long long gq[4];
#pragma unroll
        for (int rho = 0; rho < 4; ++rho) gq[rho] = *(const unsigned long long*)(gr + 8 * rho);
        f32x16 dx0, dx1;
        { const f32x4 c0 = *(const LAS f32x4*)(CST + 48), c1 = *(const LAS f32x4*)(CST + 52), c2 = *(const LAS f32x4*)(CST + 56), c3 = *(const LAS f32x4*)(CST + 60);
          const f32x4 e0 = *(const LAS f32x4*)(CST + 64), e1 = *(const LAS f32x4*)(CST + 68), e2 = *(const LAS f32x4*)(CST + 72), e3 = *(const LAS f32x4*)(CST + 76);
#pragma unroll
          for (int e = 0; e < 4; ++e) { dx0[e] = c0[e]; dx0[4 + e] = c1[e]; dx0[8 + e] = c2[e]; dx0[12 + e] = c3[e]; dx1[e] = e0[e]; dx1[4 + e] = e1[e]; dx1[8 + e] = e2[e]; dx1[12 + e] = e3[e]; } }
#pragma unroll
        for (int k = 0; k < 4; ++k)
#pragma unroll
            for (int s4 = 0; s4 < 4; ++s4) {
                const bf16x8v xb = SAMPLE ? *(const bf16x8v*)(zsr[k] + 16 * s4) : *(const LAS bf16x8v*)(XAp + k * RGL_XAP + s4 * 32);
                if (s4 < 2) dx0 = MFMA32(dg[((0 * 2 + (s4 & 1)) * 4 + k) * 64], xb, dx0); else dx1 = MFMA32(dg[((1 * 2 + (s4 & 1)) * 4 + k) * 64], xb, dx1);
                if (s4 == 3) asm volatile("" : "+v"(dx0), "+v"(dx1) :: "memory"); }
        f32x16 dr, di;
#pragma unroll
        for (int i = 0; i < 16; ++i) { dr[i] = 0.f; di[i] = 0.f; }
        { const bf16x8v b00 = pack8(dx0, 0), b01 = pack8(dx0, 1), b10 = pack8(dx1, 0), b11 = pack8(dx1, 1);
          dr = MFMA32(af[0 * 64], b00, dr); di = MFMA32(af[4 * 64], b00, di); dr = MFMA32(af[1 * 64], b01, dr); di = MFMA32(af[5 * 64], b01, di);
          dr = MFMA32(af[2 * 64], b10, dr); di = MFMA32(af[6 * 64], b10, di); dr = MFMA32(af[3 * 64], b11, dr); di = MFMA32(af[7 * 64], b11, di); }
        f32x16 av, bv;
        const bool first = !SAMPLE && (t == 0);
#pragma unroll
        for (int i = 0; i < 16; ++i) { const float xcv = jh ? dx1[i] : dx0[i];
            const float r = sigmoidf_(dr[i] + CST[i]), gi = sigmoidf_(di[i] + CST[16 + i]);
            const float a = __builtin_amdgcn_exp2f(r * CST[32 + i]);
            float mult = __builtin_amdgcn_sqrtf(fmaxf(1.f - a * a, 0.f)); if (first) mult = 1.f;
            av[i] = a; bv[i] = mult * gi * xcv; }
        if (SAMPLE && (t & 3) == 0) {
            const float* h0 = A.in[I_SH] + (size_t)(t >> 2) * WA + hd * 64 + 32 * jh + 4 * hh;
#pragma unroll
            for (int i = 0; i < 16; ++i) { bv[i] += av[i] * h0[(i & 3) + 8 * (i >> 2)]; av[i] = 0.f; } }
        rg_scan_step<0x111, 0xF>(av, bv); rg_scan_step<0x112, 0xF>(av, bv); rg_scan_step<0x114, 0xF>(av, bv); rg_scan_step<0x118, 0xF>(av, bv);
        rg_scan_step<0x142, 0xA>(av, bv);
        float hin[16];
#pragma unroll
        for (int i = 0; i < 16; ++i) hin[i] = 0.f;
        if (!SAMPLE) {
        LAS float* TOT = (LAS float*)(L + RGL_TOT) + (rd & 1) * 512;
        if (q == 31) {
#pragma unroll
            for (int i4 = 0; i4 < 4; ++i4) { *(LAS f32x4*)(TOT + (w * 2 + 0) * 32 + hh * 16 + 4 * i4) = (f32x4){av[4 * i4], av[4 * i4 + 1], av[4 * i4 + 2], av[4 * i4 + 3]};
                                             *(LAS f32x4*)(TOT + (w * 2 + 1) * 32 + hh * 16 + 4 * i4) = (f32x4){bv[4 * i4], bv[4 * i4 + 1], bv[4 * i4 + 2], bv[4 * i4 + 3]}; }
        }
        stage_write((rd + 1) & 1, stn);
        __syncthreads();
#pragma unroll
        for (int w2 = 0; w2 < 8; ++w2) {
            if (w2 == w) {
#pragma unroll
                for (int i = 0; i < 16; ++i) hin[i] = hround[i]; }
#pragma unroll
            for (int i4 = 0; i4 < 4; ++i4) { const f32x4 p = *(const LAS f32x4*)(TOT + (w2 * 2 + 0) * 32 + hh * 16 + 4 * i4), hl = *(const LAS f32x4*)(TOT + (w2 * 2 + 1) * 32 + hh * 16 + 4 * i4);
#pragma unroll
                for (int e = 0; e < 4; ++e) hround[4 * i4 + e] = p[e] * hround[4 * i4 + e] + hl[e]; }
        }
        }
        bf16* yr = Yb + (size_t)t * D + hd * 64 + 32 * jh + 4 * hh;
#pragma unroll
        for (int rho = 0; rho < 4; ++rho) { const unsigned glo = (unsigned)gq[rho], ghi = (unsigned)(gq[rho] >> 32);
            const float o0 = gelu_tanh(pg8::bf_lo(glo)) * (bv[4 * rho] + av[4 * rho] * hin[4 * rho]), o1 = gelu_tanh(pg8::bf_hi(glo)) * (bv[4 * rho + 1] + av[4 * rho + 1] * hin[4 * rho + 1]);
            const float o2 = gelu_tanh(pg8::bf_lo(ghi)) * (bv[4 * rho + 2] + av[4 * rho + 2] * hin[4 * rho + 2]), o3 = gelu_tanh(pg8::bf_hi(ghi)) * (bv[4 * rho + 3] + av[4 * rho + 3] * hin[4 * rho + 3]);
            *(unsigned long long*)(yr + 8 * rho) = (unsigned long long)pkbf(o0, o1) | ((unsigned long long)pkbf(o2, o3) << 32); }
        if (SAMPLE && (t & 3) == 3) {
#pragma unroll
            for (int i = 0; i < 16; ++i) F.out[O_HS + (size_t)(t >> 2) * WA + hd * 64 + 32 * jh + (i & 3) + 8 * (i >> 2) + 4 * hh] = bv[i]; }
    }
    if (!SAMPLE && w == 0 && q == 0) {
#pragma unroll
        for (int i = 0; i < 16; ++i) F.out[O_HP + (size_t)b * WA + hd * 64 + 32 * jh + (i & 3) + 8 * (i >> 2) + 4 * hh] = hround[i];
    }
    __syncthreads();
}

#ifndef PROBE_P3PART
#define PROBE_P3PART 7
#endif
__device__ __forceinline__ void p3_mixers_ref(Frame& F, const Args& A, int rep = 0) {
    constexpr int N_RGP = NBP * HA, N_S5P = NBP * GB;
    const int pm = rep ? PROBE_P3PART : 7;
    bf16* GY = (bf16*)(F.ws + WS_G); bf16* YC = (bf16*)(F.ws + WS_YCAT);
    pg8::Gemm gg{GY, (const bf16*)(F.ws + WS_WGLU), M, WB, WB}; pg8::EpiGlu EG{GY, WB, YC, D, WA, A.in[I_GLUB], (bf16*)(F.ws + WS_YCS), MP};
    pg8::OneUnit SG; SG.u0.pm = 0; SG.u0.pn = 0; SG.u0.k0 = 0; SG.u0.nkt = WB / 64; SG.u0.ks = 0; bool has_glu = false;
    if (F.vcu < 2 * N_RGP) {
        if ((pm & 4) && F.vcu < GB) { s5_item_sample(F, A, F.vcu); cnt_arrive_wt(F, CW_S5B + 64 * NBP); }
        if (pm & 1) rg_item_fast<false>(F, A, F.vcu / (2 * HA), (F.vcu / 2) % HA, F.vcu & 1);
        if (pm & 4) { if (F.vcu < GB) { }
                      else if (F.vcu < GB + 2 * HA) rg_item_fast<true>(F, A, 0, (F.vcu - GB) >> 1, (F.vcu - GB) & 1);
                      else if (F.vcu < GB + 2 * HA + 4) {
                          cnt_wait_ge(F, CW_S5B + 64 * NBP, (unsigned)GB); const int u = F.vcu - GB - 2 * HA; SG.u0.pm = MP / 256 + (u >> 1); SG.u0.pn = u & 1; has_glu = true; } }
    } else {
        const int v = F.vcu - 2 * N_RGP, it = 2 * v, bb = it / GB;
        if (pm & 2) { s5_item_fast(F, A, bb, it % GB);
                      s5_item_fast(F, A, bb, (it + 1) % GB);
                      cnt_arrive_wt(F, CW_S5B + 64 * bb);
                      cnt_wait_ge(F, CW_S5B + 64 * bb, 16u);
                      const int u = v & 15; SG.u0.pm = 8 * bb + (u >> 1); SG.u0.pn = u & 1; has_glu = true; }
    }
    if (has_glu) pg8::gemm_phase<pg8::EpiGlu, pg8::OneUnit, false, PG8_SP2>(F.lds + RING_OFF, gg, SG, EG);
    if (rep == 0 && F.vcu >= GB + 2 * HA + 4 && F.vcu < 2 * N_RGP) {
        constexpr int X0 = GB + 2 * HA + 4, NX = 2 * N_RGP - X0;
        LAS float* scr = (LAS float*)(F.lds + RING_OFF + F.wave * 16384);
        for (int it = XO_2 + F.wave * NX + (F.vcu - X0); it < XO_END; it += NX * NWAVES) xpose_item(F, A, scr, it); }
}

template <bool SECOND>
__device__ __forceinline__ void ln_phase(Frame& F, const Args& A, int rep) {
    pg8::StaticOrder P; P.init(MP, D, F.G, (int)blockIdx.x, D); pg8::Unit u; P.next(0, u);
    cnt_wait_ge(F, (SECOND ? CW_T2 : CW_T1) + 64 * u.pm, 4u);
    ln_rows<SECOND>(F, A, u.pm * 256 + u.pn * 64, u.pm * 256 + u.pn * 64 + 64, F.wave, NWAVES);
    constexpr int NPC = 2 * (D / 256) * (SECOND ? NS_DOWN : NS_OUT);
    const int si = (int)blockIdx.x - (F.G - NPC);
    if (si >= 0) { cnt_wait_ge(F, SECOND ? CW_T2S : CW_T1S, (unsigned)NPC);
        ln_rows<SECOND>(F, A, MP + si * (MS / NPC), MP + (si + 1) * (MS / NPC), F.wave, NWAVES); }
}
__device__ __forceinline__ int out_piece_of(int bx) { return (bx >= 192 && bx < 224) ? bx - 192 : -1; }
__device__ __forceinline__ int down_piece_of(int bx) { return (bx >= 32 && bx < 64) ? bx - 32 : (bx >= 96 && bx < 128) ? bx - 64 : -1; }
__global__ void __launch_bounds__(NWAVES * 64, 2) fwd(Args A) {
    extern __shared__ __attribute__((aligned(16))) unsigned char lds[];
    Frame F;
    F.lds = (LAS unsigned char*)lds;
    F.MISC = (volatile LAS unsigned*)(F.lds + MISC_OFF);
    F.tid = threadIdx.x; F.lane = F.tid & 63; F.wave = __builtin_amdgcn_readfirstlane(F.tid >> 6);
    F.G = gridDim.x; { const int bx = blockIdx.x; F.vcu = (F.G % 8 == 0) ? (bx % 8) * (F.G / 8) + bx / 8 : bx; }
    F.out = A.out; F.ws = A.ws; F.ctl = (gu32*)(A.ws + WS_CTL);
    for (int u = F.tid; u < (LDS_BYTES - LDSCTL_OFF) / 4; u += NWAVES * 64) ((LAS unsigned*)(F.lds + LDSCTL_OFF))[u] = 0u;
    __syncthreads();
    XcdBarrier bar; bar.bar = (unsigned*)(F.ctl + CW_BAR); bar.x = 0; bar.st = nullptr;
    if (N_LAUNCHES == 1) bar = xcd_barrier_post((unsigned*)(F.ctl + CW_BAR), F.MISC + 8);
#define GRID_BAR() do { if (N_LAUNCHES == 1) xcd_barrier(bar); } while (0)
    const int lo = A.ph_lo, hi = A.ph_hi;
#define IN(k) (lo <= (k) && (k) < hi)
#define BOTH(k) (IN(k) && IN((k) + 1))
    bf16* XN = (bf16*)(F.ws + WS_XN); bf16* Z = (bf16*)(F.ws + WS_Z); bf16* YC = (bf16*)(F.ws + WS_YCAT); bf16* GY = (bf16*)(F.ws + WS_G); bf16* U = (bf16*)(F.ws + WS_U);
    const float* mod = (const float*)(F.ws + WS_MOD);

#define REPS(k) (((PROBE_DUP) >> (k)) & 1 ? 2 : 1)
#define PH0(rep) p0_prologue(F, A, rep)
#define PH1(rep) p1_modulate(F, A, rep)
#define PH2(rep) do {     \
        pg8::Gemm g{XN, (const bf16*)(F.ws + WS_WIN), M, NZ, D}; pg8::StaticOrder S; S.init(M, NZ, F.G, (int)blockIdx.x, D); \
        pg8::EpiBf16<0> E{Z, NZ, nullptr}; \
        pg8::gemm_phase<pg8::EpiBf16<0>, pg8::StaticOrder, PG8_ALIGN, PG8_SP2>(F.lds + RING_OFF, g, S, E); \
        if ((rep) == 0 && (int)blockIdx.x >= (M / 256) * (NZ / 256) - F.G) { __syncthreads(); xpose_range_b(F, A, XO_OU, XO_2, (M / 256) * (NZ / 256) - F.G); } } while (0)
#define PH3(rep) p3_mixers_ref(F, A, rep)
#define PH4(rep) do { } while (0)
#define PH5(rep) do {     \
        pg8::Gemm g{YC, (const bf16*)(F.ws + WS_WOUT), M, D, D}; \
        { pg8::StaticOrder S; S.init(MP, D, F.G, (int)blockIdx.x, D); \
          pg8::EpiLnFused<false> E{A.in[I_XP], mod + 2 * D, nullptr, ALPHA, A.in[I_LN1G], A.in[I_LN1B], mod + 3 * D, nullptr, (bf16*)(F.ws + WS_X1B), XN, (float*)(F.ws + WS_STAT), (unsigned*)(F.ctl + CW_T1), LN_EPS}; \
          pg8::gemm_phase<pg8::EpiLnFused<false>, pg8::StaticOrder, false, PG8_SP2>(F.lds + RING_OFF, g, S, E); \
          pg8::Unit u5; if (S.next(0, u5)) cnt_arrive(F, CW_G1 + 64 * u5.pm); }     \
        { const int op = out_piece_of((int)blockIdx.x);     \
          pg8::PieceOrder S; S.init(MP, D, F.G, op >= 0 ? F.G - 1 - op : F.G - 1 - 2 * (D / 256) * NS_OUT, D, NS_OUT); pg8::EpiSlab E{(float*)(F.ws + WS_SLAB), MP}; \
          pg8::Gemm gs{(const bf16*)(F.ws + WS_YCS) - (size_t)MP * D, (const bf16*)(F.ws + WS_WOUT), M, D, D};     \
          pg8::gemm_phase<pg8::EpiSlab, pg8::PieceOrder, false, PG8_SP2>(F.lds + RING_OFF, gs, S, E); \
          if (op >= 0) cnt_arrive_wt(F, CW_T1S); } } while (0)
#define PH6(rep) do {     \
        constexpr int NPC1 = 2 * (D / 256) * NS_OUT; const int si1 = out_piece_of((int)blockIdx.x); \
        if (si1 >= 0) { cnt_wait_ge(F, CW_T1S, (unsigned)NPC1); ln_rows<false>(F, A, MP + si1 * (MS / NPC1), MP + (si1 + 1) * (MS / NPC1), F.wave, NWAVES); cnt_arrive_wt(F, CW_XNS); } } while (0)
#define PH7(rep) do {     \
        pg8::Gemm g{XN, (const bf16*)(F.ws + WS_W1), M, FF, D}; pg8::EpiBf16<3> E{U, FF, A.in[I_B1]}; \
        { pg8::StaticOrder S; S.init(MP, FF, F.G, (int)blockIdx.x, D); pg8::Unit u7; \
          { int prev = -1; for (int i = 0; S.next(i, u7); ++i) if (u7.pm != prev) { prev = u7.pm; cnt_wait_ge(F, CW_G1 + 64 * prev, (unsigned)(D / 256)); } }     \
          pg8::gemm_phase<pg8::EpiBf16<3>, pg8::StaticOrder, PG8_ALIGN, PG8_SP2>(F.lds + RING_OFF, g, S, E); \
          { int prev = -1, n = 0; for (int i = 0; S.next(i, u7); ++i) { if (u7.pm != prev && n) { cnt_arrive(F, CW_G2 + 64 * prev, (unsigned)n); n = 0; } prev = u7.pm; ++n; } \
            if (n) cnt_arrive(F, CW_G2 + 64 * prev, (unsigned)n); } }     \
        if ((int)blockIdx.x < 2 * (FF / 256)) { cnt_wait_ge(F, CW_XNS, (unsigned)(2 * (D / 256) * NS_OUT)); \
          pg8::OneUnit S; S.u0.pm = MP / 256 + (int)blockIdx.x / (FF / 256); S.u0.pn = (int)blockIdx.x % (FF / 256); S.u0.k0 = 0; S.u0.nkt = D / 64; S.u0.ks = 0; \
          pg8::EpiBf16<3, true> EW{U, FF, A.in[I_B1]}; \
          pg8::gemm_phase<pg8::EpiBf16<3, true>, pg8::OneUnit, false, PG8_SP2>(F.lds + RING_OFF, g, S, EW); cnt_arrive_wt(F, CW_US); } } while (0)
#define PH8(rep) do {     \
        pg8::Gemm g{U, (const bf16*)(F.ws + WS_W2), M, D, FF}; \
        { pg8::StaticOrder S; S.init(MP, D, F.G, (int)blockIdx.x, FF); \
          { pg8::Unit u8; if (S.next(0, u8)) cnt_wait_ge(F, CW_G2 + 64 * u8.pm, (unsigned)(FF / 256)); }     \
          pg8::EpiLnFused<true> E{(const bf16*)(F.ws + WS_X1B), mod + 5 * D, A.in[I_B2], ALPHA, A.in[I_LN2G], A.in[I_LN2B], nullptr, F.out, nullptr, nullptr, (float*)(F.ws + WS_STAT), (unsigned*)(F.ctl + CW_T2), LN_EPS}; \
          pg8::gemm_phase<pg8::EpiLnFused<true>, pg8::StaticOrder, false, PG8_SP2>(F.lds + RING_OFF, g, S, E); } \
        { const int dp = down_piece_of((int)blockIdx.x);     \
          pg8::PieceOrder S; S.init(MP, D, F.G, dp >= 0 ? F.G - 1 - dp : F.G - 1 - 2 * (D / 256) * NS_DOWN, FF, NS_DOWN); pg8::EpiSlab E{(float*)(F.ws + WS_SLAB), MP}; \
          if (dp >= 0) cnt_wait_ge(F, CW_US, (unsigned)(2 * (FF / 256)));     \
          pg8::gemm_phase<pg8::EpiSlab, pg8::PieceOrder, false, PG8_SP2>(F.lds + RING_OFF, g, S, E); \
          if (dp >= 0) cnt_arrive_wt(F, CW_T2S); } } while (0)
#define RUNNB(k, PH) do { if (IN(k)) { PH(0); if (REPS(k) == 2) { __syncthreads(); PH(1); } } } while (0)
#define RUN(k, PH) do { if (IN(k)) { PH(0); if (REPS(k) == 2) { __syncthreads(); PH(1); } if (BOTH(k)) GRID_BAR(); } } while (0)
    if (IN(0)) { PH0(0); if (REPS(0) == 2) { __syncthreads(); PH0(1); } if (IN(0) && !IN(1)) { } }
    RUN(1, PH1); RUN(2, PH2); RUN(3, PH3); RUNNB(5, PH5); RUNNB(6, PH6); RUNNB(7, PH7); RUNNB(8, PH8);
    if (IN(9)) {
        constexpr int NPC = 2 * (D / 256) * NS_DOWN; const int si = down_piece_of((int)blockIdx.x);
        if (si >= 0) { cnt_wait_ge(F, CW_T2S, (unsigned)NPC); ln_rows<true>(F, A, MP + si * (MS / NPC), MP + (si + 1) * (MS / NPC), F.wave, NWAVES); } }
#undef IN
#undef BOTH
}

extern "C" void kernel_launch(void* const* d_in, const int* in_sizes, int n_in, void* d_out, int out_size, void* d_ws, size_t ws_size, hipStream_t stream) {
    static int grid = 0;
    if (grid == 0) {
        if (n_in != 37 || in_sizes[0] != MP * D || out_size != (int)O_END || ws_size < WS_END) { fprintf(stderr, "kernel_launch: unexpected shapes (n_in %d, in0 %d, out %d, ws %zu)\n", n_in, n_in > 0 ? in_sizes[0] : -1, out_size, ws_size); grid = -1; return; }
        int dev = 0, cus = 0, per_cu = 0;
        if (hipGetDevice(&dev) != hipSuccess || hipDeviceGetAttribute(&cus, hipDeviceAttributeMultiprocessorCount, dev) != hipSuccess) { grid = -1; return; }
        if (hipFuncSetAttribute((const void*)fwd, hipFuncAttributeMaxDynamicSharedMemorySize, LDS_BYTES) != hipSuccess) { fprintf(stderr, "kernel_launch: hipFuncSetAttribute failed\n"); grid = -1; return; }
        if (hipOccupancyMaxActiveBlocksPerMultiprocessor(&per_cu, (const void*)fwd, NWAVES * 64, LDS_BYTES) != hipSuccess || per_cu < 1) { fprintf(stderr, "kernel_launch: occupancy query says %d\n", per_cu); }
        (void)hipGetLastError();
        grid = cus;
        if (grid < 256) { fprintf(stderr, "kernel_launch: this build needs 256 CUs (got %d)\n", grid); grid = -1; return; }
        grid = 256;
    }
    if (grid < 0) return;
    (void)hipMemsetAsync((char*)d_ws + WS_CTL, 0, CTL_ZERO_BYTES, stream);
    Args a{};
    for (int i = 0; i < 37; ++i) a.in[i] = (const float*)d_in[i];
    a.out = (float*)d_out; a.ws = (unsigned char*)d_ws;
    for (int li = 0; li < N_LAUNCHES; ++li) {
        if (N_LAUNCHES == 1) { a.ph_lo = 0; a.ph_hi = N_PHASES; } else { a.ph_lo = li; a.ph_hi = li + 1; }
        a.li = li;
        hipLaunchKernelGGL(fwd, dim3(grid), dim3(NWAVES * 64), LDS_BYTES, stream, a);
    }
}
```

```cpp
#include <hip/hip_runtime.h>
#include <cstdio>
#include <cstdint>
#include <cmath>

#ifndef MK_N_LAUNCHES
#define MK_N_LAUNCHES 1
#endif

namespace pg8 {
#define PG8_LAS __attribute__((address_space(3)))
typedef unsigned short bf16_t;
typedef short bf16x8 __attribute__((ext_vector_type(8)));
typedef float f32x4 __attribute__((ext_vector_type(4)));
typedef unsigned u32x4 __attribute__((ext_vector_type(4)));
constexpr int BM = 256, BK = 64, HALF = 128, HTB = HALF * BK * 2, STAGE_BYTES = 8 * HTB, NXCD = 8, WGM = 8;

__host__ __device__ __forceinline__ int lds_byte(int r, int c) { const int st = (r >> 4) * 2 + (c >> 5), rr = r & 15, cc = c & 31, ob = rr * 64 + cc * 2; return st * 1024 + (ob ^ (((ob >> 9) & 1) << 5)); }
__host__ __device__ __forceinline__ void stage_rc(int b, int& R, int& C) { const int st = b / 1024, sb = b % 1024, swz = sb ^ (((sb >> 9) & 1) << 5); R = (st >> 1) * 16 + swz / 64; C = (st & 1) * 32 + (swz % 64) / 2; }
__host__ __device__ __forceinline__ int perm32(int rho) { const int n = rho >> 4, i = rho & 15; return 8 * (i >> 2) + 4 * n + (i & 3); }

struct Unit { int pm, pn, k0, nkt, ks; };
struct Gemm { const bf16_t* A; const bf16_t* Bt; int M, N, K; };

struct StaticOrder {
    int nM, nN, nwg, G, c, K;
    __host__ __device__ void init(int M, int N, int G_, int c_, int K_) { nM = M / BM; nN = N / BM; nwg = nM * nN; G = G_; c = c_; K = K_; }
    __host__ __device__ __forceinline__ bool next(int i, Unit& u) const {
        const long L = (long)i * G + c; if (L >= nwg) return false;
        int wgid = (int)L; { const int q = nwg / NXCD, r = nwg % NXCD, xcd = wgid % NXCD, off = wgid / NXCD; wgid = (xcd < r ? xcd * (q + 1) : r * (q + 1) + (xcd - r) * q) + off; }
        const int nig = WGM * nN, gid = wgid / nig, fm = gid * WGM, gsz = (nM - fm) < WGM ? (nM - fm) : WGM;
        u.pm = fm + ((wgid % nig) % gsz); u.pn = (wgid % nig) / gsz; u.k0 = 0; u.nkt = K / BK; u.ks = 0; return true;
    }
    __device__ __forceinline__ void a_ready(const Unit&) const {}
    __device__ __forceinline__ void done(const Unit&) const {}
};

struct SplitOrder {
    StaticOrder P; int nN, NS, nP, G, c, K, r0;
    __host__ __device__ void init(int MPr, int N, int G_, int c_, int K_, int NS_) { P.init(MPr, N, G_, c_, K_); nN = N / BM; NS = NS_; nP = 2 * nN * NS; G = G_; c = c_; K = K_; r0 = (P.nwg + G - 1 - c) / G;   }
    __host__ __device__ __forceinline__ bool next(int i, Unit& u) const {
        Unit a; a.pm = 0; a.pn = 0; a.k0 = 0; a.nkt = K / BK; a.ks = 0;
        const bool okp = P.next(i < r0 ? i : 0, a);
        const int p = (i - r0) * G + (G - 1 - c), t = p / NS, ks = p % NS, nk = K / BK / NS;
        const bool split = i >= r0;
        u.pm = split ? P.nM + t / nN : a.pm; u.pn = split ? t % nN : a.pn; u.nkt = split ? nk : a.nkt; u.ks = split ? ks : 0; u.k0 = split ? ks * nk * BK : 0;
        return split ? (p < nP) : okp;
    }
    __device__ __forceinline__ void a_ready(const Unit&) const {}
    __device__ __forceinline__ void done(const Unit&) const {}
};

struct OneUnit {
    Unit u0;
    __host__ __device__ __forceinline__ bool next(int i, Unit& u) const { u = u0; return i == 0; }
    __device__ __forceinline__ void a_ready(const Unit&) const {}
    __device__ __forceinline__ void done(const Unit&) const {}
};
__device__ __forceinline__ void st16_wt(void* p, u32x4 v) { asm volatile("global_store_dwordx4 %0, %1, off sc1\n\ts_nop 1" :: "v"(p), "v"(v)); }
__device__ __forceinline__ void st16f_wt(void* p, f32x4 v) { asm volatile("global_store_dwordx4 %0, %1, off sc1\n\ts_nop 1" :: "v"(p), "v"(v)); }
__device__ __forceinline__ unsigned cvt_pk_bf16(float lo, float hi) { unsigned r; asm volatile("v_cvt_pk_bf16_f32 %0, %1, %2" : "=v"(r) : "v"(lo), "v"(hi)); return r; }
__device__ __forceinline__ float bf_lo(unsigned w) { return __builtin_bit_cast(float, w << 16); }
__device__ __forceinline__ float bf_hi(unsigned w) { return __builtin_bit_cast(float, w & 0xffff0000u); }

template <int ACT, bool WT = false> struct EpiBf16 {
    static constexpr bool PERM = true, AFTER_DRAIN = false;
    bf16_t* O; int ldc; const float* bias; bool wt = true;
    __device__ __forceinline__ void operator()(const f32x4 (&acc)[2][2][4][2], const Unit& u, int wr, int wc, int fr, int fq) const {
        const int row0 = u.pm * BM + wr * 64 + fr; const int col0 = u.pn * BM + wc * 32 + 8 * fq;
        f32x4 bv[2][2];
#pragma unroll
        for (int bj = 0; bj < 2; ++bj)
#pragma unroll
            for (int n = 0; n < 2; ++n) bv[bj][n] = bias ? *(const f32x4*)(bias + col0 + bj * HALF + 4 * n) : (f32x4){0.f, 0.f, 0.f, 0.f};
#pragma unroll
        for (int ai = 0; ai < 2; ++ai)
#pragma unroll
            for (int m = 0; m < 4; ++m) { bf16_t* rowp = O + (size_t)(row0 + ai * HALF + m * 16) * ldc + col0;
#pragma unroll
                for (int bj = 0; bj < 2; ++bj) { f32x4 v0 = acc[ai][bj][m][0] + bv[bj][0], v1 = acc[ai][bj][m][1] + bv[bj][1];
                    if (ACT == 3) {
#pragma unroll
                        for (int e = 0; e < 4; ++e) { const float a = fmaxf(v0[e], 0.f), b = fmaxf(v1[e], 0.f); v0[e] = a * a; v1[e] = b * b; } }
                    u32x4 w; w.x = cvt_pk_bf16(v0[0], v0[1]); w.y = cvt_pk_bf16(v0[2], v0[3]); w.z = cvt_pk_bf16(v1[0], v1[1]); w.w = cvt_pk_bf16(v1[2], v1[3]);
                    if (WT && wt) st16_wt(rowp + bj * HALF, w); else *(u32x4*)(rowp + bj * HALF) = w; } }
    }
};
struct EpiGlu {
    static constexpr bool PERM = true, AFTER_DRAIN = false;
    const bf16_t* Gy; int ldg; bf16_t* O; int ldc; int coff; const float* bias; bf16_t* Os; int MPs;
    __device__ __forceinline__ void operator()(const f32x4 (&acc)[2][2][4][2], const Unit& u, int wr, int wc, int fr, int fq) const {
        const int row0 = u.pm * BM + wr * 64 + fr; const int col0 = u.pn * BM + wc * 32 + 8 * fq;
        bf16_t* const Ob = u.pm * BM >= MPs ? Os - (size_t)MPs * ldc : O;
        f32x4 bv[2][2];
#pragma unroll
        for (int bj = 0; bj < 2; ++bj)
#pragma unroll
            for (int n = 0; n < 2; ++n) bv[bj][n] = *(const f32x4*)(bias + col0 + bj * HALF + 4 * n);
        constexpr int DEPTH = 4;
        u32x4 pg[DEPTH];
#define EPG_ROW(g) ((size_t)(row0 + ((g) >> 3) * HALF + (((g) >> 1) & 3) * 16))
#define EPG_COL(g) (col0 + ((g) & 1) * HALF)
#pragma unroll
        for (int g = 0; g < DEPTH; ++g) pg[g] = *(const u32x4*)(Gy + EPG_ROW(g) * ldg + EPG_COL(g));
#pragma unroll
        for (int gi = 0; gi < 16; ++gi) { const int ai = gi >> 3, m = (gi >> 1) & 3, bj = gi & 1;
            const u32x4 g = pg[gi % DEPTH];
            if (gi + DEPTH < 16) pg[gi % DEPTH] = *(const u32x4*)(Gy + EPG_ROW(gi + DEPTH) * ldg + EPG_COL(gi + DEPTH));
            const f32x4 v0 = acc[ai][bj][m][0] + bv[bj][0], v1 = acc[ai][bj][m][1] + bv[bj][1];
            float o[8];
            o[0] = bf_lo(g.x) * __builtin_amdgcn_rcpf(1.f + __builtin_amdgcn_exp2f(-1.4426950408889634f * v0[0])); o[1] = bf_hi(g.x) * __builtin_amdgcn_rcpf(1.f + __builtin_amdgcn_exp2f(-1.4426950408889634f * v0[1]));
            o[2] = bf_lo(g.y) * __builtin_amdgcn_rcpf(1.f + __builtin_amdgcn_exp2f(-1.4426950408889634f * v0[2])); o[3] = bf_hi(g.y) * __builtin_amdgcn_rcpf(1.f + __builtin_amdgcn_exp2f(-1.4426950408889634f * v0[3]));
            o[4] = bf_lo(g.z) * __builtin_amdgcn_rcpf(1.f + __builtin_amdgcn_exp2f(-1.4426950408889634f * v1[0])); o[5] = bf_hi(g.z) * __builtin_amdgcn_rcpf(1.f + __builtin_amdgcn_exp2f(-1.4426950408889634f * v1[1]));
            o[6] = bf_lo(g.w) * __builtin_amdgcn_rcpf(1.f + __builtin_amdgcn_exp2f(-1.4426950408889634f * v1[2])); o[7] = bf_hi(g.w) * __builtin_amdgcn_rcpf(1.f + __builtin_amdgcn_exp2f(-1.4426950408889634f * v1[3]));
            u32x4 w; w.x = cvt_pk_bf16(o[0], o[1]); w.y = cvt_pk_bf16(o[2], o[3]); w.z = cvt_pk_bf16(o[4], o[5]); w.w = cvt_pk_bf16(o[6], o[7]);
            *(u32x4*)(Ob + EPG_ROW(gi) * ldc + coff + EPG_COL(gi)) = w; }
#undef EPG_ROW
#undef EPG_COL
    }
};
template <bool BASE16> struct EpiRes {
    static constexpr bool PERM = true, AFTER_DRAIN = false;
    const void* basep; bf16_t* T; const float* gate  ; const float* bias; float alpha; int MP; float* slab;
    __device__ __forceinline__ void operator()(const f32x4 (&acc)[2][2][4][2], const Unit& u, int wr, int wc, int fr, int fq) const {
        const int row0 = u.pm * BM + wr * 64 + fr, col0 = u.pn * BM + wc * 32 + 8 * fq;
        if (row0 >= MP) {
            float* sp = slab + (size_t)u.ks * 512 * 1024;
#pragma unroll
            for (int ai = 0; ai < 2; ++ai)
#pragma unroll
                for (int m = 0; m < 4; ++m) { float* op = sp + (size_t)(row0 + ai * HALF + m * 16 - MP) * 1024;
#pragma unroll
                    for (int bj = 0; bj < 2; ++bj)
#pragma unroll
                        for (int n = 0; n < 2; ++n) st16f_wt(op + col0 + bj * HALF + n * 4, acc[ai][bj][m][n]); }
            return; }
        f32x4 bv[2][2], gv[2][2];
        const float* gp = gate + (size_t)(row0 >> 11) * 6144;
#pragma unroll
        for (int bj = 0; bj < 2; ++bj)
#pragma unroll
            for (int n = 0; n < 2; ++n) { bv[bj][n] = bias ? *(const f32x4*)(bias + col0 + bj * HALF + n * 4) : (f32x4){0.f, 0.f, 0.f, 0.f}; gv[bj][n] = *(const f32x4*)(gp + col0 + bj * HALF + n * 4); }
        constexpr int DEPTH = 3;
        f32x4 pb[DEPTH][2]; u32x4 pw[DEPTH];
#define EPR_ROW(g) (row0 + ((g) >> 3) * HALF + (((g) >> 1) & 3) * 16)
#define EPR_COL(g) (col0 + ((g) & 1) * HALF)
#define EPR_LOAD(g) do { if (BASE16) pw[(g) % DEPTH] = *(const u32x4*)((const bf16_t*)basep + (size_t)EPR_ROW(g) * 1024 + EPR_COL(g)); \
            else { const float* bp_ = (const float*)basep + (size_t)EPR_ROW(g) * 1024 + EPR_COL(g); pb[(g) % DEPTH][0] = *(const f32x4*)bp_; pb[(g) % DEPTH][1] = *(const f32x4*)(bp_ + 4); } } while (0)
#pragma unroll
        for (int g = 0; g < DEPTH; ++g) EPR_LOAD(g);
#pragma unroll
        for (int g = 0; g < 16; ++g) { const int ai = g >> 3, m = (g >> 1) & 3, bj = g & 1;
            f32x4 b0, b1;
            if (BASE16) { const u32x4 bw = pw[g % DEPTH]; b0 = (f32x4){bf_lo(bw.x), bf_hi(bw.x), bf_lo(bw.y), bf_hi(bw.y)}; b1 = (f32x4){bf_lo(bw.z), bf_hi(bw.z), bf_lo(bw.w), bf_hi(bw.w)}; }
            else { b0 = pb[g % DEPTH][0]; b1 = pb[g % DEPTH][1]; }
            if (g + DEPTH < 16) EPR_LOAD(g + DEPTH);
            const f32x4 v0 = b0 * alpha + gv[bj][0] * (acc[ai][bj][m][0] + bv[bj][0]), v1 = b1 * alpha + gv[bj][1] * (acc[ai][bj][m][1] + bv[bj][1]);
            u32x4 w; w.x = cvt_pk_bf16(v0[0], v0[1]); w.y = cvt_pk_bf16(v0[2], v0[3]); w.z = cvt_pk_bf16(v1[0], v1[1]); w.w = cvt_pk_bf16(v1[2], v1[3]);
            st16_wt(T + (size_t)EPR_ROW(g) * 1024 + EPR_COL(g), w); }
#undef EPR_ROW
#undef EPR_COL
#undef EPR_LOAD
    }
};

struct PieceOrder {
    int nN, NS, nP, G, c, K, nM;
    __host__ __device__ void init(int MPr, int N, int G_, int c_, int K_, int NS_) { nM = MPr / BM; nN = N / BM; NS = NS_; nP = 2 * nN * NS; G = G_; c = c_; K = K_; }
    __host__ __device__ __forceinline__ bool next(int i, Unit& u) const {
        const int p = G - 1 - c, t = p / NS, ks = p % NS, nk = K / BK / NS;
        u.pm = nM + t / nN; u.pn = t % nN; u.nkt = nk; u.ks = ks; u.k0 = ks * nk * BK; return i == 0 && p < nP;
    }
    __device__ __forceinline__ void a_ready(const Unit&) const {}
    __device__ __forceinline__ void done(const Unit&) const {}
};
struct EpiSlab {
    static constexpr bool PERM = true, AFTER_DRAIN = false;
    float* slab; int MP;
    __device__ __forceinline__ void operator()(const f32x4 (&acc)[2][2][4][2], const Unit& u, int wr, int wc, int fr, int fq) const {
        const int row0 = u.pm * BM + wr * 64 + fr, col0 = u.pn * BM + wc * 32 + 8 * fq;
        float* sp = slab + (size_t)u.ks * 512 * 1024;
#pragma unroll
        for (int ai = 0; ai < 2; ++ai)
#pragma unroll
            for (int m = 0; m < 4; ++m) { float* op = sp + (size_t)(row0 + ai * HALF + m * 16 - MP) * 1024;
#pragma unroll
                for (int bj = 0; bj < 2; ++bj)
#pragma unroll
                    for (int n = 0; n < 2; ++n) st16f_wt(op + col0 + bj * HALF + n * 4, acc[ai][bj][m][n]); }
    }
};
template <bool SECOND> struct EpiLnFused {
    static constexpr bool PERM = true, AFTER_DRAIN = true;
    const void* basep; const float* gate; const float* bias; float alpha; const float* lng; const float* lnb; const float* mod2  ;
    float* out; bf16_t* x1; bf16_t* xn; float* stat; unsigned* cnt; float eps; bool wt = true;
    __device__ __forceinline__ void fused(f32x4 (&acc)[2][2][4][2], const Unit& u, int wr, int wc, int fr, int fq, PG8_LAS unsigned char* lds, int wid, int lane) const {
        const int row0 = u.pm * BM + wr * 64 + fr, col0 = u.pn * BM + wc * 32 + 8 * fq, tid = wid * 64 + lane;
        {
            const float* gp = gate + (size_t)(row0 >> 11) * 6144;
#pragma unroll
            for (int bj = 0; bj < 2; ++bj) { const int c = col0 + bj * HALF;
                const f32x4 g0 = *(const f32x4*)(gp + c), g1 = *(const f32x4*)(gp + c + 4);
                const f32x4 v0 = bias ? *(const f32x4*)(bias + c) : (f32x4){0.f, 0.f, 0.f, 0.f}, v1 = bias ? *(const f32x4*)(bias + c + 4) : (f32x4){0.f, 0.f, 0.f, 0.f};
                constexpr int DEPTH = 2; f32x4 pb[DEPTH][2]; u32x4 pw[DEPTH];
#define EPF_ROW(g) (row0 + ((g) >> 2) * HALF + ((g) & 3) * 16)
#define EPF_LOAD(g) do { if (SECOND) pw[(g) % DEPTH] = *(const u32x4*)((const bf16_t*)basep + (size_t)EPF_ROW(g) * 1024 + c); \
                else { const float* bp_ = (const float*)basep + (size_t)EPF_ROW(g) * 1024 + c; pb[(g) % DEPTH][0] = *(const f32x4*)bp_; pb[(g) % DEPTH][1] = *(const f32x4*)(bp_ + 4); } } while (0)
#pragma unroll
                for (int g = 0; g < DEPTH; ++g) EPF_LOAD(g);
#pragma unroll
                for (int g = 0; g < 8; ++g) { const int ai = g >> 2, m = g & 3; f32x4 b0, b1;
                    if (SECOND) { const u32x4 bw = pw[g % DEPTH]; b0 = (f32x4){bf_lo(bw.x), bf_hi(bw.x), bf_lo(bw.y), bf_hi(bw.y)}; b1 = (f32x4){bf_lo(bw.z), bf_hi(bw.z), bf_lo(bw.w), bf_hi(bw.w)}; }
                    else { b0 = pb[g % DEPTH][0]; b1 = pb[g % DEPTH][1]; }
                    if (g + DEPTH < 8) EPF_LOAD(g + DEPTH);
                    acc[ai][bj][m][0] = b0 * alpha + g0 * (acc[ai][bj][m][0] + v0); acc[ai][bj][m][1] = b1 * alpha + g1 * (acc[ai][bj][m][1] + v1);
                    asm volatile("" : "+v"(acc[ai][bj][m][0]), "+v"(acc[ai][bj][m][1]) :: "memory"); }
#undef EPF_LOAD
#undef EPF_ROW
            }
        }
        typedef float f32x2v __attribute__((ext_vector_type(2)));
        PG8_LAS f32x2v* RS = (PG8_LAS f32x2v*)lds;
        PG8_LAS f32x2v* MR = (PG8_LAS f32x2v*)(lds + 8192);
#pragma unroll
        for (int ai = 0; ai < 2; ++ai)
#pragma unroll
            for (int m = 0; m < 4; ++m) { float sa = 0.f, sq = 0.f;
#pragma unroll
                for (int bj = 0; bj < 2; ++bj)
#pragma unroll
                    for (int n = 0; n < 2; ++n) { const f32x4 x = acc[ai][bj][m][n]; sa += (x[0] + x[1]) + (x[2] + x[3]); sq += (x[0] * x[0] + x[1] * x[1]) + (x[2] * x[2] + x[3] * x[3]); }
                sa += __shfl_xor(sa, 16); sa += __shfl_xor(sa, 32); sq += __shfl_xor(sq, 16); sq += __shfl_xor(sq, 32);
                if (fq == 0) RS[(ai * HALF + wr * 64 + m * 16 + fr) * 4 + wc] = (f32x2v){sa, sq}; }
        asm volatile("s_waitcnt lgkmcnt(0)" ::: "memory"); __builtin_amdgcn_s_barrier(); asm volatile("" ::: "memory");
        if (tid < 256) { const f32x2v a = RS[tid * 4 + 0], b = RS[tid * 4 + 1], c = RS[tid * 4 + 2], d = RS[tid * 4 + 3];
            unsigned long long* slot = (unsigned long long*)stat + ((size_t)(u.pm * 4 + u.pn) * 256 + tid);
            __hip_atomic_store(slot, ((unsigned long long)__builtin_bit_cast(unsigned, (a.y + b.y) + (c.y + d.y)) << 32) | __builtin_bit_cast(unsigned, (a.x + b.x) + (c.x + d.x)), __ATOMIC_RELAXED, __HIP_MEMORY_SCOPE_AGENT); }
        asm volatile("s_waitcnt vmcnt(0)" ::: "memory"); __builtin_amdgcn_s_barrier(); asm volatile("" ::: "memory");
        if (tid == 0) { (void)__hip_atomic_fetch_add(cnt + 64 * u.pm, 1u, __ATOMIC_RELAXED, __HIP_MEMORY_SCOPE_AGENT);
            unsigned sp = 0; while (__hip_atomic_load(cnt + 64 * u.pm, __ATOMIC_RELAXED, __HIP_MEMORY_SCOPE_AGENT) < 4u && ++sp < (1u << 22)) __builtin_amdgcn_s_sleep(2);
            __builtin_amdgcn_fence(__ATOMIC_ACQUIRE, "agent"); asm volatile("s_waitcnt vmcnt(0)" ::: "memory"); }
        __builtin_amdgcn_s_barrier(); asm volatile("" ::: "memory");
        if (tid < 256) { float S = 0.f, Q = 0.f;
#pragma unroll
            for (int p = 0; p < 4; ++p) { const unsigned long long w = __hip_atomic_load((const unsigned long long*)stat + ((size_t)(u.pm * 4 + p) * 256 + tid), __ATOMIC_RELAXED, __HIP_MEMORY_SCOPE_AGENT);
                S += __builtin_bit_cast(float, (unsigned)w); Q += __builtin_bit_cast(float, (unsigned)(w >> 32)); }
            const float mean = S * (1.f / 1024.f), var = fmaxf(Q * (1.f / 1024.f) - mean * mean, 0.f);
            MR[tid] = (f32x2v){mean, 1.0f / sqrtf(var + eps)}; }
        asm volatile("s_waitcnt lgkmcnt(0)" ::: "memory"); __builtin_amdgcn_s_barrier(); asm volatile("" ::: "memory");
#pragma unroll
        for (int bj = 0; bj < 2; ++bj) { const int c = col0 + bj * HALF;
            const f32x4 g0 = *(const f32x4*)(lng + c), g1 = *(const f32x4*)(lng + c + 4), b0 = *(const f32x4*)(lnb + c), b1 = *(const f32x4*)(lnb + c + 4);
            f32x4 s0, s1, h0, h1;
            if (!SECOND) { const float* mp = mod2 + (size_t)(row0 >> 11) * 6144 + c; h0 = *(const f32x4*)mp; h1 = *(const f32x4*)(mp + 4); s0 = *(const f32x4*)(mp + 1024) + 1.f; s1 = *(const f32x4*)(mp + 1028) + 1.f; }
#pragma unroll
            for (int ai = 0; ai < 2; ++ai)
#pragma unroll
                for (int m = 0; m < 4; ++m) { const int rl = ai * HALF + wr * 64 + m * 16 + fr; const size_t row = (size_t)(u.pm * BM + rl); const f32x2v mr = MR[rl];
                    const f32x4 y0 = (acc[ai][bj][m][0] - mr.x) * mr.y * g0 + b0, y1 = (acc[ai][bj][m][1] - mr.x) * mr.y * g1 + b1;
                    if (SECOND) { *(f32x4*)(out + row * 1024 + c) = y0; *(f32x4*)(out + row * 1024 + c + 4) = y1; }
                    else { u32x4 w; w.x = cvt_pk_bf16(y0[0], y0[1]); w.y = cvt_pk_bf16(y0[2], y0[3]); w.z = cvt_pk_bf16(y1[0], y1[1]); w.w = cvt_pk_bf16(y1[2], y1[3]);
                           *(u32x4*)(x1 + row * 1024 + c) = w;
                           const f32x4 z0 = y0 * s0 + h0, z1 = y1 * s1 + h1;
                           u32x4 v; v.x = cvt_pk_bf16(z0[0], z0[1]); v.y = cvt_pk_bf16(z0[2], z0[3]); v.z = cvt_pk_bf16(z1[0], z1[1]); v.w = cvt_pk_bf16(z1[2], z1[3]);
                           if (wt) st16_wt(xn + row * 1024 + c, v); else *(u32x4*)(xn + row * 1024 + c) = v; } } }
        asm volatile("s_waitcnt lgkmcnt(0)" ::: "memory"); __builtin_amdgcn_s_barrier(); asm volatile("" ::: "memory");
    }
};

template <class Epi, class Sched, bool ALIGN_EPI = false, bool SP2 = false>
__device__ __forceinline__ void gemm_phase(PG8_LAS unsigned char* lds, const Gemm g, const Sched& S, const Epi& E) {
    const int tid = threadIdx.x, wid = __builtin_amdgcn_readfirstlane(tid >> 6), lane = tid & 63, wr = wid >> 2, wc = wid & 3, fr = lane & 15, fq = lane >> 4;
    const int K = g.K;
    unsigned voffA[2], voffB[2];
#pragma unroll
    for (int i = 0; i < 2; ++i) { int R, C; stage_rc(tid * 16 + i * 8192, R, C); const int Rb = Epi::PERM ? ((R & ~31) + perm32(R & 31)) : R;
        voffA[i] = (unsigned)(R * K + C) * 2u; voffB[i] = (unsigned)(Rb * K + C) * 2u; }
    const size_t kstep = (size_t)(BK * 2);
    const size_t hstep = (size_t)HALF * K * 2;
    const size_t tstep = 2 * hstep;
    const unsigned ldsw = (unsigned)wid * 1024u;
    const int aoff = lds_byte(wr * 64 + fr, fq * 8), boff = lds_byte(wc * 32 + fr, fq * 8);
#define PG8_SA(b, h) (((b) * 2 + (h)) * HTB)
#define PG8_SB(b, h) ((4 + (b) * 2 + (h)) * HTB)
#define PG8_STAGE(bufoff, gbase, voff) do { _Pragma("unroll") for (int _i = 0; _i < 2; ++_i) \
        __builtin_amdgcn_global_load_lds((const unsigned*)((const char*)(gbase) + (voff)[_i]), (PG8_LAS unsigned*)(lds + (bufoff) + ldsw + _i * 8192), 16, 0, 0); } while (0)
#define PG8_LDA(dst, b, h) do { _Pragma("unroll") for (int m = 0; m < 4; ++m) _Pragma("unroll") for (int k = 0; k < 2; ++k) dst[m][k] = *(const PG8_LAS bf16x8*)(lds + PG8_SA(b, h) + aoff + m * 2048 + k * 1024); } while (0)
#define PG8_LDB(dst, b, h) do { _Pragma("unroll") for (int n = 0; n < 2; ++n) _Pragma("unroll") for (int k = 0; k < 2; ++k) dst[n][k] = *(const PG8_LAS bf16x8*)(lds + PG8_SB(b, h) + boff + n * 2048 + k * 1024); } while (0)
#define PG8_MMA(ai, bj, At, Bt) do { __builtin_amdgcn_s_setprio(1); _Pragma("unroll") for (int m = 0; m < 4; ++m) _Pragma("unroll") for (int n = 0; n < 2; ++n) _Pragma("unroll") for (int k = 0; k < 2; ++k) \
        acc[ai][bj][m][n] = __builtin_amdgcn_mfma_f32_16x16x32_bf16(Bt[n][k], At[m][k], acc[ai][bj][m][n], 0, 0, 0); __builtin_amdgcn_s_setprio(0); } while (0)
#define PG8_WAIT_V(n) asm volatile("s_waitcnt vmcnt(" #n ")" ::: "memory")
#define PG8_WAIT_L(n) asm volatile("s_waitcnt lgkmcnt(" #n ")" ::: "memory")
#define PG8_BAR __builtin_amdgcn_s_barrier()
#define PG8_SCHED __builtin_amdgcn_sched_barrier(0)
    Unit cur, nxt; int ui = 0;
    if (!S.next(0, cur)) return;
    f32x4 acc[2][2][4][2];
#pragma unroll
    for (int a = 0; a < 2; ++a)
#pragma unroll
        for (int b = 0; b < 2; ++b)
#pragma unroll
            for (int m = 0; m < 4; ++m)
#pragma unroll
                for (int n = 0; n < 2; ++n) acc[a][b][m][n] = (f32x4){0.f, 0.f, 0.f, 0.f};
    bf16x8 At[4][2], B0[2][2], B1[2][2];
    const char* cA = (const char*)g.A + (size_t)cur.pm * tstep + (size_t)cur.k0 * 2; const char* cB = (const char*)g.Bt + (size_t)cur.pn * tstep + (size_t)cur.k0 * 2;
    S.a_ready(cur);
    if constexpr (SP2) {
        PG8_STAGE(PG8_SB(0, 0), cB, voffB); PG8_STAGE(PG8_SB(0, 1), cB + hstep, voffB); PG8_STAGE(PG8_SA(0, 0), cA, voffA); PG8_STAGE(PG8_SA(0, 1), cA + hstep, voffA);
        if (wr == 1) PG8_BAR;
        PG8_WAIT_V(2); PG8_BAR;
        PG8_STAGE(PG8_SB(1, 0), cB + kstep, voffB); PG8_STAGE(PG8_SA(1, 0), cA + kstep, voffA); PG8_STAGE(PG8_SB(1, 1), cB + hstep + kstep, voffB);
        PG8_WAIT_V(6); PG8_BAR;
    } else {
        PG8_STAGE(PG8_SB(0, 0), cB, voffB); PG8_STAGE(PG8_SA(0, 0), cA, voffA); PG8_STAGE(PG8_SB(0, 1), cB + hstep, voffB); PG8_STAGE(PG8_SA(0, 1), cA + hstep, voffA);
        if (wr == 1) PG8_BAR;
        PG8_WAIT_V(4); PG8_BAR;
        PG8_STAGE(PG8_SB(1, 0), cB + kstep, voffB); PG8_STAGE(PG8_SA(1, 0), cA + kstep, voffA); PG8_STAGE(PG8_SB(1, 1), cB + hstep + kstep, voffB);
        PG8_WAIT_V(6); PG8_BAR;
    }
    for (;;) {
        const bool has_next = S.next(ui + 1, nxt);
        const char* nA = has_next ? (const char*)g.A + (size_t)nxt.pm * tstep + (size_t)nxt.k0 * 2 : cA; const char* nB = has_next ? (const char*)g.Bt + (size_t)nxt.pn * tstep + (size_t)nxt.k0 * 2 : cB;
        const int nt = cur.nkt;
        for (int t = 0; t < nt; t += 2) {
            const bool last = (t == nt - 2);
            const char* a1 = cA + (size_t)(t + 1) * kstep;
            const char* a2 = last ? nA : cA + (size_t)(t + 2) * kstep; const char* b2 = last ? nB : cB + (size_t)(t + 2) * kstep;
            const char* a3 = a2 + kstep; const char* b3 = b2 + kstep;
            if (last && has_next) S.a_ready(nxt);
            if constexpr (SP2) {
            PG8_LDB(B0, 0, 0); PG8_LDB(B1, 0, 1); PG8_SCHED; PG8_LDA(At, 0, 0); PG8_STAGE(PG8_SA(1, 1), a1 + hstep, voffA);
            PG8_WAIT_V(8); PG8_WAIT_L(0); PG8_BAR; PG8_MMA(0, 0, At, B0); PG8_MMA(0, 1, At, B1); PG8_BAR; PG8_SCHED;
            PG8_LDA(At, 0, 1); PG8_STAGE(PG8_SB(0, 0), b2, voffB); PG8_STAGE(PG8_SB(0, 1), b2 + hstep, voffB); PG8_STAGE(PG8_SA(0, 0), a2, voffA);
            PG8_WAIT_V(8); PG8_WAIT_L(0); PG8_BAR; PG8_MMA(1, 0, At, B0); PG8_MMA(1, 1, At, B1); PG8_BAR; PG8_SCHED;
            PG8_LDB(B0, 1, 0); PG8_LDB(B1, 1, 1); PG8_SCHED; PG8_LDA(At, 1, 0); PG8_STAGE(PG8_SA(0, 1), a2 + hstep, voffA);
            PG8_WAIT_V(8); PG8_WAIT_L(0); PG8_BAR; PG8_MMA(0, 0, At, B0); PG8_MMA(0, 1, At, B1); PG8_BAR; PG8_SCHED;
            PG8_LDA(At, 1, 1); PG8_STAGE(PG8_SB(1, 0), b3, voffB); PG8_STAGE(PG8_SB(1, 1), b3 + hstep, voffB); PG8_STAGE(PG8_SA(1, 0), a3, voffA);
            PG8_WAIT_V(8); PG8_WAIT_L(0); PG8_BAR; PG8_MMA(1, 0, At, B0); PG8_MMA(1, 1, At, B1); PG8_BAR; PG8_SCHED;
            } else {
            PG8_LDB(B0, 0, 0); PG8_SCHED; PG8_LDA(At, 0, 0); PG8_STAGE(PG8_SA(1, 1), a1 + hstep, voffA);
            PG8_WAIT_L(8); PG8_BAR; PG8_WAIT_L(0); PG8_MMA(0, 0, At, B0); PG8_BAR; PG8_SCHED;
            PG8_LDB(B1, 0, 1); PG8_STAGE(PG8_SB(0, 0), b2, voffB);
            PG8_BAR; PG8_WAIT_L(0); PG8_MMA(0, 1, At, B1); PG8_BAR;
            PG8_LDA(At, 0, 1); PG8_STAGE(PG8_SA(0, 0), a2, voffA);
            PG8_BAR; PG8_WAIT_L(0); PG8_MMA(1, 0, At, B0); PG8_BAR; PG8_SCHED;
            PG8_STAGE(PG8_SB(0, 1), b2 + hstep, voffB);
            PG8_WAIT_V(6); PG8_BAR; PG8_MMA(1, 1, At, B1); PG8_BAR;
            PG8_LDB(B0, 1, 0); PG8_SCHED; PG8_LDA(At, 1, 0); PG8_STAGE(PG8_SA(0, 1), a2 + hstep, voffA);
            PG8_WAIT_L(8); PG8_BAR; PG8_WAIT_L(0); PG8_MMA(0, 0, At, B0); PG8_BAR; PG8_SCHED;
            PG8_LDB(B1, 1, 1); PG8_STAGE(PG8_SB(1, 0), b3, voffB);
            PG8_BAR; PG8_WAIT_L(0); PG8_MMA(0, 1, At, B1); PG8_BAR;
            PG8_LDA(At, 1, 1); PG8_STAGE(PG8_SA(1, 0), a3, voffA);
            PG8_BAR; PG8_WAIT_L(0); PG8_MMA(1, 0, At, B0); PG8_BAR; PG8_SCHED;
            PG8_STAGE(PG8_SB(1, 1), b3 + hstep, voffB);
            PG8_WAIT_V(6); PG8_BAR; PG8_MMA(1, 1, At, B1); PG8_BAR;
            }
        }
        if constexpr (ALIGN_EPI) { if (wr == 0) PG8_BAR; }
        if constexpr (!Epi::AFTER_DRAIN) { E(acc, cur, wr, wc, fr, fq); S.done(cur); }
        if (!has_next) break;
#pragma unroll
        for (int a = 0; a < 2; ++a)
#pragma unroll
            for (int b = 0; b < 2; ++b)
#pragma unroll
                for (int m = 0; m < 4; ++m)
#pragma unroll
                    for (int n = 0; n < 2; ++n) acc[a][b][m][n] = (f32x4){0.f, 0.f, 0.f, 0.f};
        cur = nxt; cA = nA; cB = nB; ++ui;
        if constexpr (ALIGN_EPI) { if (wr == 1) PG8_BAR; }
    }
    PG8_WAIT_V(0);
    if constexpr (!ALIGN_EPI) { if (wr == 0) PG8_BAR; }
    PG8_BAR;
    if constexpr (Epi::AFTER_DRAIN) { E.fused(acc, cur, wr, wc, fr, fq, lds, wid, lane); S.done(cur); }
#undef PG8_SA
#undef PG8_SB
#undef PG8_STAGE
#undef PG8_LDA
#undef PG8_LDB
#undef PG8_MMA
#undef PG8_WAIT_V
#undef PG8_WAIT_L
#undef PG8_BAR
#undef PG8_SCHED
}
}

#ifndef PROBE_DUP
#define PROBE_DUP 0
#endif
#ifndef PG8_SP2
#define PG8_SP2 true
#endif
#ifndef PG8_ALIGN
#define PG8_ALIGN true
#endif

constexpr int NWAVES = 8;
constexpr int N_LAUNCHES = MK_N_LAUNCHES;
constexpr int N_PHASES = 10;
constexpr int D = 1024, MP = 16384, MS = 512, M = MP + MS, TP = 2048, NBP = 8, NBS = 128, TS = 4;
constexpr int NZ = 1536, WA = 512, WB = 512, FF = 4096, NMOD = 6 * D, NROWMOD = NBP + NBS;
constexpr int GB = 32, NS5 = 64, KS5 = 16, HA = 8, HDA = 64;
constexpr float LN_EPS = 1e-5f;
constexpr int NS_OUT = 4, NS_DOWN = 8;
constexpr float ALPHA = 1.189207115002721f;

constexpr size_t O_YP = 0, O_YS = (size_t)MP * D, O_CONVP = O_YS + (size_t)MS * D, O_HP = O_CONVP + (size_t)NBP * 3 * WA, O_SRP = O_HP + (size_t)NBP * WA,
                 O_SIP = O_SRP + (size_t)NBP * GB * NS5, O_CONVS = O_SIP + (size_t)NBP * GB * NS5, O_HS = O_CONVS + (size_t)NBS * 3 * WA, O_SRS = O_HS + (size_t)NBS * WA,
                 O_SIS = O_SRS + (size_t)NBS * GB * NS5, O_END = O_SIS + (size_t)NBS * GB * NS5;

constexpr size_t MiB = 1u << 20;
constexpr size_t WS_CTL = 0, CTL_ZERO_BYTES = 128 * 1024;
constexpr size_t WS_WIN = 1 * MiB, WS_WGLU = 4 * MiB, WS_WOUT = 5 * MiB, WS_W1 = 7 * MiB, WS_W2 = 15 * MiB;
constexpr size_t WS_MOD = 23 * MiB;
constexpr size_t WS_S5C = 27 * MiB;
constexpr size_t WS_STAT = 27 * MiB + 512 * 1024;
constexpr size_t WS_XN = 28 * MiB;
constexpr size_t WS_Z = 61 * MiB;
constexpr size_t WS_YCAT = WS_XN;
constexpr size_t WS_G = 144 * MiB;
constexpr size_t WS_U = 61 * MiB;
constexpr size_t WS_T1 = WS_Z;
constexpr size_t WS_T2 = WS_XN;
constexpr size_t WS_TAB = 246 * MiB;
constexpr size_t WS_SLAB = 194 * MiB;
constexpr size_t WS_X1B = 210 * MiB;
constexpr size_t WS_YCS = 244 * MiB;
constexpr size_t WS_END = 252 * MiB;
constexpr size_t TB_BF1 = 0, TB_BF2 = TB_BF1 + 32 * 4 * 64 * 16, TB_TA = TB_BF2 + 32 * 8 * 64 * 16, TB_ZP = TB_TA + 32 * 2 * 2 * 32 * 4, TB_Z16N = TB_ZP + 32 * 17 * 2 * 2 * 32 * 4,
                 TB_RG = TB_Z16N + 32 * 2 * 64 * 4, TB_CB = TB_RG + 8 * 2 * 2 * 4 * 64 * 16, TB_SILU = TB_CB + 128 * 3 * 512 * 2, TB_DG = TB_SILU + 160 * 1024 * 2, TB_W1 = TB_DG + 8 * 16 * 64 * 16, TB_C2 = TB_W1 + 32 * 8 * 4 * 64 * 16, TB_END = TB_C2 + (size_t)32 * 8 * 8 * 64 * 16;
static_assert(WS_SLAB + (size_t)8 * 512 * 1024 * 4 <= WS_X1B && WS_X1B + (size_t)MP * D * 2 <= WS_TAB && WS_TAB + TB_END <= WS_END, "tables");
static_assert(WS_XN + (size_t)M * D * 2 <= WS_Z && WS_Z + (size_t)M * NZ * 2 <= WS_G && WS_G + (size_t)M * WB * 2 <= WS_END && WS_U + (size_t)M * FF * 2 <= WS_SLAB, "d_ws map");
constexpr int SC_ABR = 0, SC_ABI = 2048, SC_BBR = 4096, SC_BBI = 4096 + 32768, SC_RGL = 4096 + 65536, SC_END = SC_RGL + 512;
constexpr int CW_TMO = 0, CW_CODE = 1, CW_SILU = 64, CW_MOD = 1024  , CW_S5B = 128  , CW_BAR = 4096,
              CW_T1 = 8192  , CW_T2 = 12288  , CW_T1S = 16384, CW_T2S = 16448  , CW_XNS = 16512  , CW_US = 16640  ,
              CW_G1 = 20480  , CW_G2 = 24576  ,
              CW_XCC = 28672  ;

constexpr int RING_OFF = 0, RING_BYTES = 131072;
constexpr int LDSCTL_OFF = RING_BYTES, MISC_OFF = LDSCTL_OFF + 320;
constexpr int LDS_BYTES = 147456;

#define GAS __attribute__((address_space(1)))
#define LAS __attribute__((address_space(3)))
typedef unsigned short bf16;
typedef unsigned v4u __attribute__((ext_vector_type(4)));
typedef float f32x4 __attribute__((ext_vector_type(4)));
typedef GAS unsigned gu32;
#define RLX_AGENT __ATOMIC_RELAXED, __HIP_MEMORY_SCOPE_AGENT
#define LDS_WAIT() asm volatile("s_waitcnt lgkmcnt(0)" ::: "memory")
#define VM_WAIT() asm volatile("s_waitcnt vmcnt(0)" ::: "memory")
__device__ __forceinline__ unsigned f2bf(float f) { unsigned u = __builtin_bit_cast(unsigned, f); return (u + 0x7fffu + ((u >> 16) & 1u)) >> 16; }
__device__ __forceinline__ unsigned pk2(float lo, float hi) { return f2bf(lo) | (f2bf(hi) << 16); }
__device__ __forceinline__ float bf2f(bf16 v) { return __builtin_bit_cast(float, (unsigned)v << 16); }
__device__ __forceinline__ float gelu_tanh(float x) { const float t = -2.3022082f * (x + 0.044715f * x * x * x); return x * __builtin_amdgcn_rcpf(1.f + __builtin_amdgcn_exp2f(t)); }
__device__ __forceinline__ float sigmoidf_(float x) { return __builtin_amdgcn_rcpf(1.f + __builtin_amdgcn_exp2f(-1.4426950408889634f * x)); }

#define XB_TMO      128
#define XB_XCNT(j)  (256  + 64 * (j))
#define XB_XSUB(j)  (1280 + 64 * (j))
#define XB_XGEN(j)  (2304 + 64 * (j))
#define XB_TOP      3328
#define XB_TOPGEN   3392
#define XCD_BAR_WORDS 3456
#define XB_SPIN_CAP (1u << 18)
__device__ __forceinline__ unsigned xb_ld(unsigned* p)              { return __hip_atomic_load(p, __ATOMIC_RELAXED, __HIP_MEMORY_SCOPE_AGENT); }
__device__ __forceinline__ unsigned xb_add(unsigned* p, unsigned v) { return __hip_atomic_fetch_add(p, v, __ATOMIC_RELAXED, __HIP_MEMORY_SCOPE_AGENT); }
__device__ __forceinline__ unsigned xb_xcc_id() { return (unsigned)__builtin_amdgcn_s_getreg((3 << 11) | 20) & 0xFu; }
#define XB_SPIN(cond, bar) do { unsigned _sp = 0; while (cond) { __builtin_amdgcn_s_sleep(1); \
    if ((++_sp & 255u) == 0u) { if (xb_ld(&(bar)[XB_TMO])) break; if (_sp > XB_SPIN_CAP) { atomicAdd(&(bar)[XB_TMO], 1u); break; } } } } while (0)
struct XcdBarrier { unsigned* bar; unsigned x; volatile LAS unsigned* st; };
__device__ __forceinline__ XcdBarrier xcd_barrier_post(unsigned* bar, volatile LAS unsigned* st) {
    XcdBarrier b; b.bar = bar; b.x = xb_xcc_id(); b.st = st;
    if (threadIdx.x == 0) (void)xb_add(&bar[XB_XCNT(b.x)], 1u);
    return b;
}
__device__ __forceinline__ void xcd_barrier_complete(unsigned* bar, unsigned x, unsigned& nloc, unsigned& nx) {
    const unsigned G = gridDim.x * gridDim.y * gridDim.z;
    unsigned sum, cnt, mine, sp = 0u;
    for (;;) {
        sum = 0u; cnt = 0u; mine = 0u;
#pragma unroll
        for (unsigned j = 0; j < 16; ++j) { const unsigned c = xb_ld(&bar[XB_XCNT(j)]); sum += c; cnt += (c > 0u) ? 1u : 0u; mine = (j == x) ? c : mine; }
        if (sum == G) break;
        __builtin_amdgcn_s_sleep(1);
        if ((++sp & 255u) == 0u) { if (xb_ld(&bar[XB_TMO])) break; if (sp > XB_SPIN_CAP) { atomicAdd(&bar[XB_TMO], 1u); break; } }
    }
    nloc = mine > 0u ? mine : 1u; nx = cnt > 0u ? cnt : 1u;
}
__device__ __forceinline__ void xcd_barrier(const XcdBarrier& b) {
    asm volatile("s_waitcnt vmcnt(0)" ::: "memory");
    __syncthreads();
    if (threadIdx.x == 0) {
        unsigned* bar = b.bar;
        __builtin_amdgcn_s_waitcnt(0);
        unsigned nloc = b.st[0], nx = b.st[1];
        if (nloc == 0u) { xcd_barrier_complete(bar, b.x, nloc, nx); b.st[0] = nloc; b.st[1] = nx; }
        const unsigned old = xb_add(&bar[XB_XSUB(b.x)], 1u);
        const unsigned gen = old / nloc;
        if (old + 1u == (gen + 1u) * nloc) {
            __builtin_amdgcn_fence(__ATOMIC_RELEASE, "agent");
            asm volatile("s_waitcnt vmcnt(0)" ::: "memory");
            const unsigned og = xb_add(&bar[XB_TOP], 1u);
            const unsigned tg = og / nx;
            if (og + 1u == (tg + 1u) * nx) xb_add(&bar[XB_TOPGEN], 1u);
            else XB_SPIN(xb_ld(&bar[XB_TOPGEN]) == tg, bar);
            __builtin_amdgcn_fence(__ATOMIC_ACQUIRE, "agent");
            xb_add(&bar[XB_XGEN(b.x)], 1u);
            asm volatile("s_waitcnt vmcnt(0)" ::: "memory");
        } else {
            XB_SPIN(xb_ld(&bar[XB_XGEN(b.x)]) == gen, bar);
            __builtin_amdgcn_fence(__ATOMIC_ACQUIRE, "agent");
            asm volatile("s_waitcnt vmcnt(0)" ::: "memory");
        }
    }
    __syncthreads();
}

struct Frame {
    LAS unsigned char* lds;
    volatile LAS unsigned* MISC;
    gu32* ctl;
    int tid, lane, wave;
    int vcu, G;
    bool grp_local;
    float* out;
    unsigned char* ws;
};
struct Args { const float* in[37]; float* out; unsigned char* ws; int ph_lo, ph_hi, li, pad; };
__device__ __forceinline__ void refresh(Frame& F) { int t = threadIdx.x; asm volatile("" : "+v"(t)); F.tid = t; F.lane = t & 63; F.wave = __builtin_amdgcn_readfirstlane(t >> 6); }
__device__ __forceinline__ void cnt_arrive(Frame& F, int word, unsigned n = 1u) {
    VM_WAIT(); __syncthreads();
    if (F.tid == 0) { __builtin_amdgcn_fence(__ATOMIC_RELEASE, "agent"); VM_WAIT(); (void)__hip_atomic_fetch_add((unsigned*)(F.ctl + word), n, RLX_AGENT); }
}
__device__ __forceinline__ void cnt_arrive_wt(Frame& F, int word, unsigned n = 1u) {
    VM_WAIT(); __syncthreads();
    if (F.tid == 0) (void)__hip_atomic_fetch_add((unsigned*)(F.ctl + word), n, RLX_AGENT);
}
__device__ __forceinline__ void cnt_wait_ge(Frame& F, int word, unsigned target) {
    if (F.tid == 0) { unsigned sp = 0; while (__hip_atomic_load((unsigned*)(F.ctl + word), RLX_AGENT) < target && ++sp < (1u << 22)) __builtin_amdgcn_s_sleep(2);
        __builtin_amdgcn_fence(__ATOMIC_ACQUIRE, "agent"); VM_WAIT(); }
    __syncthreads();
}
__device__ __forceinline__ float wave_sum(float v) {
#pragma unroll
    for (int o = 1; o < 64; o <<= 1) v += __shfl_xor(v, o);
    return v;
}
enum { I_XP = 0, I_XS, I_SCONV, I_SH, I_SSR, I_SSI, I_CP, I_CS, I_ADAW, I_ADAB, I_INPROJ, I_CONVW, I_CONVB, I_RGWR, I_RGBR, I_RGWI, I_RGBI, I_RGLAM,
       I_S5ARE, I_S5AIM, I_S5LOGDT, I_S5BRE, I_S5BIM, I_S5CRE, I_S5CIM, I_S5D, I_GLUW, I_GLUB, I_OUTPROJ, I_LN1G, I_LN1B, I_W1, I_B1, I_W2, I_B2, I_LN2G, I_LN2B };

typedef float f32x2m __attribute__((ext_vector_type(2)));
typedef __bf16 bf16x2m __attribute__((ext_vector_type(2)));
__device__ __forceinline__ unsigned pkbf0(float a, float b) { const f32x2m v = {a, b}; const bf16x2m r = __builtin_convertvector(v, bf16x2m); return __builtin_bit_cast(unsigned, r); }
typedef short bf16x8m __attribute__((ext_vector_type(8)));
typedef float f32x16m __attribute__((ext_vector_type(16)));
__device__ __forceinline__ void p0_transpose_item(const float* W, int K, int N, bf16* WT, LAS float* scr, int item, int lane) {
    const int nblk = N / 32, kb = item / nblk, nb = item % nblk, k0 = 64 * kb, n0 = 32 * nb;
#pragma unroll 8
    for (int i = 0; i < 32; ++i) { const int kk = 2 * i + (lane >> 5); scr[kk * 33 + (lane & 31)] = W[(size_t)(k0 + kk) * N + n0 + (lane & 31)]; }
    LDS_WAIT(); asm volatile("" ::: "memory");
    const int c = lane & 7;
#pragma unroll
    for (int j = 0; j < 4; ++j) { const int n = (lane >> 3) + 8 * j; const LAS float* s = scr + (8 * c) * 33 + n;
        v4u o; o.x = pk2(s[0 * 33], s[1 * 33]); o.y = pk2(s[2 * 33], s[3 * 33]); o.z = pk2(s[4 * 33], s[5 * 33]); o.w = pk2(s[6 * 33], s[7 * 33]);
        *(GAS v4u*)(WT + (size_t)(n0 + n) * K + k0 + 8 * c) = o; }
    LDS_WAIT(); asm volatile("" ::: "memory");
}

constexpr int XI_IN = (D / 64) * (NZ / 32), XI_GL = (WB / 64) * (WB / 32), XI_OU = (D / 64) * (D / 32), XI_1 = (D / 64) * (FF / 32), XI_2 = (FF / 64) * (D / 32);
constexpr int XO_OU = XI_IN + XI_GL, XO_1 = XO_OU + XI_OU, XO_2 = XO_1 + XI_1, XO_END = XO_2 + XI_2;
__device__ __forceinline__ void xpose_item(Frame& F, const Args& A, LAS float* scr, int r) {
    if (r < XI_IN) { p0_transpose_item(A.in[I_INPROJ], D, NZ, (bf16*)(F.ws + WS_WIN), scr, r, F.lane); return; } r -= XI_IN;
    if (r < XI_GL) { p0_transpose_item(A.in[I_GLUW], WB, WB, (bf16*)(F.ws + WS_WGLU), scr, r, F.lane); return; } r -= XI_GL;
    if (r < XI_OU) { p0_transpose_item(A.in[I_OUTPROJ], D, D, (bf16*)(F.ws + WS_WOUT), scr, r, F.lane); return; } r -= XI_OU;
    if (r < XI_1) { p0_transpose_item(A.in[I_W1], D, FF, (bf16*)(F.ws + WS_W1), scr, r, F.lane); return; } r -= XI_1;
    p0_transpose_item(A.in[I_W2], FF, D, (bf16*)(F.ws + WS_W2), scr, r, F.lane);
}
__device__ __forceinline__ void xpose_range(Frame& F, const Args& A, int lo, int hi, int vlo) {
    refresh(F);
    if (F.vcu < vlo) return;
    LAS float* scr = (LAS float*)(F.lds + RING_OFF + F.wave * 16384);
    const int gw = F.wave * (F.G - vlo) + (F.vcu - vlo), ngw = (F.G - vlo) * NWAVES;
    for (int it = lo + gw; it < hi; it += ngw) xpose_item(F, A, scr, it);
}
__device__ __forceinline__ void xpose_range_b(Frame& F, const Args& A, int lo, int hi, int blo) {
    refresh(F);
    LAS float* scr = (LAS float*)(F.lds + RING_OFF + F.wave * 16384);
    const int gw = F.wave * (F.G - blo) + ((int)blockIdx.x - blo), ngw = (F.G - blo) * NWAVES;
    for (int it = lo + gw; it < hi; it += ngw) xpose_item(F, A, scr, it);
}
#ifndef PROBE_P0PART
#define PROBE_P0PART 7
#endif
__device__ __forceinline__ void p0_prologue(Frame& F, const Args& A, int rep = 0) {
    refresh(F);
    const int pmask = rep ? PROBE_P0PART : 7;
    LAS float* scr = (LAS float*)(F.lds + RING_OFF + F.wave * 16384);
    const int gw = F.wave * F.G + F.vcu, NGW = F.G * NWAVES;
    {
        bf16* ST = (bf16*)(F.ws + WS_TAB + TB_SILU);
        for (int ch = F.vcu * NWAVES * 64 + F.tid; ch < 160 * 1024 / 8; ch += F.G * NWAVES * 64) { const int row = ch >> 7, k = (ch & 127) * 8; v4u o = (v4u){0u, 0u, 0u, 0u};
            if (row < NROWMOD) { const float* cp = (row < NBP ? A.in[I_CP] + (size_t)row * D : A.in[I_CS] + (size_t)(row - NBP) * D) + k; const f32x4 c0 = *(const f32x4*)cp, c1 = *(const f32x4*)(cp + 4);
                o.x = pk2(c0[0] * sigmoidf_(c0[0]), c0[1] * sigmoidf_(c0[1])); o.y = pk2(c0[2] * sigmoidf_(c0[2]), c0[3] * sigmoidf_(c0[3]));
                o.z = pk2(c1[0] * sigmoidf_(c1[0]), c1[1] * sigmoidf_(c1[1])); o.w = pk2(c1[2] * sigmoidf_(c1[2]), c1[3] * sigmoidf_(c1[3])); }
            pg8::st16_wt(ST + (size_t)ch * 8, o); }
        cnt_arrive_wt(F, CW_SILU);
    }
    constexpr int I_IN = XI_IN, I_GL = XI_GL;
    constexpr int I_S5 = GB, I_RG = WA / 64, I_RGT = HA * 2 * 2 * 4, I_CB = NBS * 3 * WA / 512, I_DG = HA * 16, I_S5J = GB * 8;
    constexpr int NITEMS = I_IN + I_GL + I_S5 + I_RG + I_RGT + I_CB + I_DG + I_S5J;
    float* sc = (float*)(F.ws + WS_S5C);
    constexpr int VW0 = 2 * D / 32;
    for (int it = F.vcu >= VW0 ? F.wave * (F.G - VW0) + (F.vcu - VW0) : NITEMS; it < NITEMS; it += (F.G - VW0) * NWAVES) {
        int r = it;
        if (!(pmask & 1) && it < I_IN + I_GL) continue;
        if (!(pmask & 2) && it >= I_IN + I_GL) continue;
        if (r < I_IN + I_GL) { xpose_item(F, A, scr, r); continue; } r -= I_IN + I_GL;
        if (r < I_S5) {
            const int g = r, n = F.lane, gn = g * NS5 + n;
            const double dt = exp((double)A.in[I_S5LOGDT][g]), ar = (double)A.in[I_S5ARE][gn], ai = (double)A.in[I_S5AIM][gn];
            const double mag = exp(dt * ar), abr = mag * cos(dt * ai), abi = mag * sin(dt * ai), den = ar * ar + ai * ai, nr = abr - 1.0;
            const double qr = (nr * ar + abi * ai) / den, qi = (abi * ar - nr * ai) / den;
            sc[SC_ABR + gn] = (float)abr; sc[SC_ABI + gn] = (float)abi;
            unsigned char* tab = F.ws + WS_TAB;
            float* TA = (float*)(tab + TB_TA); float* ZP = (float*)(tab + TB_ZP); float* Z16N = (float*)(tab + TB_Z16N);
            const int sh = n >> 5, v = n & 31, hh = (v >> 2) & 1, ii = (v & 3) + 4 * (v >> 3);
            double bbr_[KS5], bbi_[KS5];
            for (int k = 0; k < KS5; ++k) { const double br = (double)A.in[I_S5BRE][gn * KS5 + k], bi = (double)A.in[I_S5BIM][gn * KS5 + k];
                bbr_[k] = qr * br - qi * bi; bbi_[k] = qr * bi + qi * br;
                sc[SC_BBR + gn * KS5 + k] = (float)bbr_[k]; sc[SC_BBI + gn * KS5 + k] = (float)bbi_[k]; }
            { double pr = abr, pi = abi; for (int e = 0; e < 2; ++e) { const double t = pr * pr - pi * pi; pi = 2.0 * pr * pi; pr = t; }
              TA[((g * 2 + hh) * 2 + 0) * 32 + sh * 16 + ii] = (float)pr; TA[((g * 2 + hh) * 2 + 1) * 32 + sh * 16 + ii] = (float)pi; }
            const double mg8 = exp(8.0 * dt * ar), z1r = mg8 * cos(8.0 * dt * ai), z1i = mg8 * sin(8.0 * dt * ai); double pzr = 1.0, pzi = 0.0;
            for (int e = 0; e <= 16; ++e) { const float zr = (float)pzr, zi = (float)pzi; { const double nr2 = pzr * z1r - pzi * z1i, ni2 = pzr * z1i + pzi * z1r; pzr = nr2; pzi = ni2; }
                ZP[(((g * 17 + e) * 2 + hh) * 2 + 0) * 32 + sh * 16 + ii] = zr; ZP[(((g * 17 + e) * 2 + hh) * 2 + 1) * 32 + sh * 16 + ii] = zi;
                if (e == 16) { Z16N[(g * 2 + 0) * 64 + n] = zr; Z16N[(g * 2 + 1) * 64 + n] = zi; } }
            continue; } r -= I_S5;
        if (r < I_RG) { const int c = r * 64 + F.lane; const double lam = (double)A.in[I_RGLAM][c];
          sc[SC_RGL + c] = (float)(-8.0 * log1p(exp(-lam)) * 1.4426950408889634); continue; } r -= I_RG;
        if (r >= I_RGT + I_CB + I_DG) { r -= I_RGT + I_CB + I_DG;
            const int g = r >> 3, j = r & 7, n = F.lane, gn = g * NS5 + n, sh = n >> 5;
            const double dt = exp((double)A.in[I_S5LOGDT][g]), ar = (double)A.in[I_S5ARE][gn], ai = (double)A.in[I_S5AIM][gn];
            const double mag = exp(dt * ar), abr = mag * cos(dt * ai), abi = mag * sin(dt * ai), den = ar * ar + ai * ai, nr0 = abr - 1.0;
            const double qr = (nr0 * ar + abi * ai) / den, qi = (abi * ar - nr0 * ai) / den;
            const double mgp = exp((double)(j + 1) * dt * ar), anp = (double)(j + 1) * dt * ai, pr = mgp * cos(anp), pi = mgp * sin(anp);
            const double pm2 = pr * pr + pi * pi, nr_ = pr / pm2, ni_ = -pi / pm2;
            bf16* W1T = (bf16*)(F.ws + WS_TAB + TB_W1); bf16* C2T = (bf16*)(F.ws + WS_TAB + TB_C2);
            const int s2 = (n >> 4) & 1, jj2 = 4 * ((n >> 3) & 1) + (n & 3), hk2 = (n >> 2) & 1;
#pragma unroll 4
            for (int k = 0; k < KS5; ++k) { const double br = (double)A.in[I_S5BRE][gn * KS5 + k], bi = (double)A.in[I_S5BIM][gn * KS5 + k];
                const double bbr = qr * br - qi * bi, bbi = qr * bi + qi * br;
                const float wr = (float)(nr_ * bbr - ni_ * bbi), wi = (float)(nr_ * bbi + ni_ * bbr);
                const int lp = (n & 31) + 32 * (k >> 3), jj = k & 7;
                W1T[(size_t)(((g * 8 + j) * 4 + 0 + sh) * 64 + lp) * 8 + jj] = (bf16)f2bf(wr); W1T[(size_t)(((g * 8 + j) * 4 + 2 + sh) * 64 + lp) * 8 + jj] = (bf16)f2bf(wi); }
#pragma unroll 4
            for (int ch = 0; ch < KS5; ++ch) { const int hr_ = ch >> 3, i8 = ch & 7, R = (i8 & 3) + 8 * (i8 >> 2) + 4 * hr_, lp = R + 32 * hk2;
                const double cr = (double)A.in[I_S5CRE][(size_t)(g * KS5 + ch) * NS5 + n], ci = (double)A.in[I_S5CIM][(size_t)(g * KS5 + ch) * NS5 + n];
                const float c2r = (float)(cr * pr - ci * pi), c2i = (float)(cr * pi + ci * pr);
                C2T[(size_t)(((g * 8 + j) * 8 + (0 + sh) * 2 + s2) * 64 + lp) * 8 + jj2] = (bf16)f2bf(c2r); C2T[(size_t)(((g * 8 + j) * 8 + (2 + sh) * 2 + s2) * 64 + lp) * 8 + jj2] = (bf16)f2bf(-c2i); }
            for (int z = 0; z < 4; ++z) { const int cidx = n + 64 * z, ks = cidx >> 5, r16 = cidx & 31, lp = 16 + (r16 & 15) + 32 * (r16 >> 4);
                *(v4u*)(C2T + (size_t)(((g * 8 + j) * 8 + ks) * 64 + lp) * 8) = (v4u){0u, 0u, 0u, 0u}; }
            continue; }
        if (r >= I_RGT + I_CB) { r -= I_RGT + I_CB;
            const int k = r & 3, sp = (r >> 2) & 1, tau = (r >> 3) & 1, hd = r >> 4, R = F.lane & 31, hk = F.lane >> 5;
            unsigned wv = 0u; if ((R >> 3) == 2 * sp + hk) wv = f2bf(A.in[I_CONVW][k * WA + hd * 64 + 32 * tau + R]);
            const int jj = R & 7; v4u o = (v4u){0u, 0u, 0u, 0u}; const unsigned word = (jj & 1) ? (wv << 16) : wv;
            if ((jj >> 1) == 0) o.x = word; else if ((jj >> 1) == 1) o.y = word; else if ((jj >> 1) == 2) o.z = word; else o.w = word;
            *(v4u*)(F.ws + WS_TAB + TB_DG + (size_t)(r * 64 + F.lane) * 16) = o; continue; }
        if (r >= I_RGT) { r -= I_RGT;
            const float* src = A.in[I_SCONV] + (size_t)r * 512 + F.lane * 8; const f32x4 a0 = *(const f32x4*)src, a1 = *(const f32x4*)(src + 4);
            v4u o; o.x = pk2(a0[0], a0[1]); o.y = pk2(a0[2], a0[3]); o.z = pk2(a1[0], a1[1]); o.w = pk2(a1[2], a1[3]);
            *(v4u*)(F.ws + WS_TAB + TB_CB + ((size_t)r * 512 + F.lane * 8) * 2) = o; continue; }
        {
            const int ks = r & 3, gate = (r >> 2) & 1, jh = (r >> 3) & 1, hd = r >> 4;
            const int R = F.lane & 31, hk = F.lane >> 5;
            const float* W = A.in[gate ? I_RGWI : I_RGWR] + (size_t)(hd * 64 + 32 * (ks >> 1) + 16 * (ks & 1) + 4 * hk) * 64 + 32 * jh + R;
            v4u o; o.x = pk2(W[0], W[64]); o.y = pk2(W[128], W[192]); o.z = pk2(W[8 * 64], W[9 * 64]); o.w = pk2(W[10 * 64], W[11 * 64]);
            *(v4u*)(F.ws + WS_TAB + TB_RG + (size_t)(r * 64 + F.lane) * 16) = o;
        }
    }
    __syncthreads();
    if (F.tid == 0) {
        unsigned sp = 0; while (__hip_atomic_load((unsigned*)(F.ctl + CW_SILU), RLX_AGENT) < (unsigned)F.G && ++sp < (1u << 22)) __builtin_amdgcn_s_sleep(2);
        __builtin_amdgcn_fence(__ATOMIC_ACQUIRE, "agent"); VM_WAIT(); }
    __syncthreads();
    LAS float* RED = (LAS float*)(F.lds + RING_OFF);
    float* mod = (float*)(F.ws + WS_MOD);
    const int r32 = F.lane & 31, hh = F.lane >> 5;
    const bf16* ST = (const bf16*)(F.ws + WS_TAB + TB_SILU);
#pragma unroll 1
    for (int it = F.vcu; it < ((pmask & 4) ? NMOD / 32 : 0); it += F.G) {
        const int n0 = it * 32;
        f32x16m acc[5];
#pragma unroll
        for (int rt = 0; rt < 5; ++rt)
#pragma unroll
            for (int i = 0; i < 16; ++i) acc[rt][i] = 0.f;
#pragma unroll 1
        for (int kb = 0; kb < 4; ++kb) {
            float bw[2][8]; v4u af[2][5];
#pragma unroll
            for (int ks = 0; ks < 2; ++ks) { const int k0 = F.wave * 128 + (kb * 2 + ks) * 16 + 8 * hh;
                const float* wp = A.in[I_ADAW] + (size_t)k0 * NMOD + n0 + r32;
#pragma unroll
                for (int j = 0; j < 8; ++j) bw[ks][j] = wp[(size_t)j * NMOD];
#pragma unroll
                for (int rt = 0; rt < 5; ++rt) af[ks][rt] = *(const v4u*)(ST + (size_t)(32 * rt + r32) * D + k0); }
#pragma unroll
            for (int ks = 0; ks < 2; ++ks) {
                v4u bp; bp.x = pkbf0(bw[ks][0], bw[ks][1]); bp.y = pkbf0(bw[ks][2], bw[ks][3]); bp.z = pkbf0(bw[ks][4], bw[ks][5]); bp.w = pkbf0(bw[ks][6], bw[ks][7]);
                const bf16x8m bfr = __builtin_bit_cast(bf16x8m, bp);
#pragma unroll
                for (int rt = 0; rt < 5; ++rt) acc[rt] = __builtin_amdgcn_mfma_f32_32x32x16_bf16(__builtin_bit_cast(bf16x8m, af[ks][rt]), bfr, acc[rt], 0, 0, 0); }
        }
#pragma unroll
        for (int half = 4; half >= 1; half >>= 1) {
            if (F.wave >= half && F.wave < 2 * half) {
#pragma unroll
                for (int rt = 0; rt < 5; ++rt)
#pragma unroll
                    for (int i = 0; i < 16; ++i) RED[(F.wave - half) * 5120 + (rt * 16 + i) * 64 + F.lane] = acc[rt][i]; }
            __syncthreads();
            if (F.wave < half) {
#pragma unroll
                for (int rt = 0; rt < 5; ++rt)
#pragma unroll
                    for (int i = 0; i < 16; ++i) acc[rt][i] += RED[F.wave * 5120 + (rt * 16 + i) * 64 + F.lane]; }
            __syncthreads();
        }
        if (F.wave == 0) { const float bb = A.in[I_ADAB][n0 + r32];
#pragma unroll
            for (int rt = 0; rt < 5; ++rt)
#pragma unroll
                for (int i = 0; i < 16; ++i) { const int row = 32 * rt + (i & 3) + 8 * (i >> 2) + 4 * hh; if (row < NROWMOD) __hip_atomic_store(mod + (size_t)row * NMOD + n0 + r32, acc[rt][i] + bb, RLX_AGENT); } }
        if (n0 < 2 * D) cnt_arrive_wt(F, CW_MOD);
    }
}

__device__ __forceinline__ int mod_row(int m) { return m < MP ? (m >> 11) : NBP + ((m - MP) >> 2); }
__device__ __forceinline__ const float* x_row(const Args& A, int m) { return m < MP ? A.in[I_XP] + (size_t)m * D : A.in[I_XS] + (size_t)(m - MP) * D; }

__device__ __forceinline__ void p1_modulate(Frame& F, const Args& A, int rep = 0) {
    refresh(F);
    cnt_wait_ge(F, CW_MOD, (unsigned)(2 * D / 32));
    const int gw = F.vcu * NWAVES + F.wave, NGW = F.G * NWAVES;
    const float* mod = (const float*)(F.ws + WS_MOD); bf16* XN = (bf16*)(F.ws + WS_XN);
    for (int m = gw; m < M; m += NGW) {
        const float* xr = x_row(A, m) + 8 * F.lane; const float* mr = mod + (size_t)mod_row(m) * NMOD + 8 * F.lane;
#pragma unroll
        for (int j = 0; j < 2; ++j) { const f32x4 v0 = *(const f32x4*)(xr + 512 * j), v1 = *(const f32x4*)(xr + 512 * j + 4);
            const f32x4 a0 = *(const f32x4*)(mr + 512 * j), a1 = *(const f32x4*)(mr + 512 * j + 4), s0 = *(const f32x4*)(mr + D + 512 * j), s1 = *(const f32x4*)(mr + D + 512 * j + 4);
            const f32x4 h0 = v0 * (s0 + 1.f) + a0, h1 = v1 * (s1 + 1.f) + a1;
            v4u o; o.x = pk2(h0.x, h0.y); o.y = pk2(h0.z, h0.w); o.z = pk2(h1.x, h1.y); o.w = pk2(h1.z, h1.w);
            *(v4u*)(XN + (size_t)m * D + 512 * j + 8 * F.lane) = o; }
    }
}

__device__ __forceinline__ void unpack8(const v4u w, f32x4& a, f32x4& b) { a = (f32x4){pg8::bf_lo(w.x), pg8::bf_hi(w.x), pg8::bf_lo(w.y), pg8::bf_hi(w.y)}; b = (f32x4){pg8::bf_lo(w.z), pg8::bf_hi(w.z), pg8::bf_lo(w.w), pg8::bf_hi(w.w)}; }
__device__ __forceinline__ v4u pack8f(const f32x4 a, const f32x4 b) { v4u o; o.x = pk2(a.x, a.y); o.y = pk2(a.z, a.w); o.z = pk2(b.x, b.y); o.w = pk2(b.z, b.w); return o; }
template <bool SECOND>
__device__ __forceinline__ void ln_rows(Frame& F, const Args& A, int row_lo, int row_hi, int gw, int NGW) {
    refresh(F);
    const float* mod = (const float*)(F.ws + WS_MOD); bf16* XN = (bf16*)(F.ws + WS_XN);
    const float* gg = A.in[SECOND ? I_LN2G : I_LN1G] + 8 * F.lane; const float* gb = A.in[SECOND ? I_LN2B : I_LN1B] + 8 * F.lane;
    for (int m = row_lo + gw; m < row_hi; m += NGW) {
        float* xr = F.out + (size_t)m * D + 8 * F.lane;
        f32x4 v[2][2]; float s = 0.f;
        if (m >= MP) {
            const float* mr = mod + (size_t)mod_row(m) * NMOD + (SECOND ? 5 : 2) * D + 8 * F.lane;
            const float* bs = SECOND ? xr : A.in[I_XS] + (size_t)(m - MP) * D + 8 * F.lane;
            const float* sl = (const float*)(F.ws + WS_SLAB) + (size_t)(m - MP) * D + 8 * F.lane;
#pragma unroll
            for (int j = 0; j < 2; ++j)
#pragma unroll
                for (int h = 0; h < 2; ++h) { const int o = 512 * j + 4 * h; f32x4 a = SECOND ? *(const f32x4*)(A.in[I_B2] + 8 * F.lane + o) : (f32x4){0.f, 0.f, 0.f, 0.f};
#pragma unroll
                    for (int ks = 0; ks < (SECOND ? NS_DOWN : NS_OUT); ++ks) a += *(const f32x4*)(sl + (size_t)ks * (512 * 1024) + o);
                    v[j][h] = *(const f32x4*)(bs + o) * ALPHA + *(const f32x4*)(mr + o) * a; }
        } else {
            const bf16* tr = (const bf16*)(F.ws + (SECOND ? WS_T2 : WS_T1)) + (size_t)m * D + 8 * F.lane;
#pragma unroll
            for (int j = 0; j < 2; ++j) unpack8(*(const v4u*)(tr + 512 * j), v[j][0], v[j][1]);
        }
#pragma unroll
        for (int j = 0; j < 2; ++j)
#pragma unroll
            for (int h = 0; h < 2; ++h) s += (v[j][h].x + v[j][h].y) + (v[j][h].z + v[j][h].w);
        const float mean = wave_sum(s) * (1.f / D); float s2 = 0.f;
#pragma unroll
        for (int j = 0; j < 2; ++j)
#pragma unroll
            for (int h = 0; h < 2; ++h) { v[j][h] = v[j][h] - mean; s2 += (v[j][h].x * v[j][h].x + v[j][h].y * v[j][h].y) + (v[j][h].z * v[j][h].z + v[j][h].w * v[j][h].w); }
        const float rstd = 1.f / sqrtf(wave_sum(s2) * (1.f / D) + LN_EPS);
#pragma unroll
        for (int j = 0; j < 2; ++j)
#pragma unroll
            for (int h = 0; h < 2; ++h) v[j][h] = v[j][h] * rstd * *(const f32x4*)(gg + 512 * j + 4 * h) + *(const f32x4*)(gb + 512 * j + 4 * h);
        if (SECOND || m >= MP) {
#pragma unroll
            for (int j = 0; j < 2; ++j) { *(f32x4*)(xr + 512 * j) = v[j][0]; *(f32x4*)(xr + 512 * j + 4) = v[j][1]; }
        } else {
            bf16* x1 = (bf16*)(F.ws + WS_X1B) + (size_t)m * D + 8 * F.lane;
#pragma unroll
            for (int j = 0; j < 2; ++j) *(v4u*)(x1 + 512 * j) = pack8f(v[j][0], v[j][1]);
        }
        if (!SECOND) {
            const float* mr = mod + (size_t)mod_row(m) * NMOD + 8 * F.lane;
#pragma unroll
            for (int j = 0; j < 2; ++j) { const int o = 512 * j;
                const f32x4 h0 = v[j][0] * (*(const f32x4*)(mr + 4 * D + o) + 1.f) + *(const f32x4*)(mr + 3 * D + o), h1 = v[j][1] * (*(const f32x4*)(mr + 4 * D + o + 4) + 1.f) + *(const f32x4*)(mr + 3 * D + o + 4);
                pg8::st16_wt(XN + (size_t)m * D + o + 8 * F.lane, pack8f(h0, h1)); }
        }
    }
}

__device__ __forceinline__ void rg_item_ref(Frame& F, const Args& A, bool prompt, int b, int hd, LAS float* scr) {
    const int j = F.lane, c = hd * HDA + j;
    const bf16* Z = (const bf16*)(F.ws + WS_Z); bf16* Y = (bf16*)(F.ws + WS_YCAT); const float* sc = (const float*)(F.ws + WS_S5C);
    float wr[64], wi[64];
#pragma unroll
    for (int i = 0; i < 64; ++i) { wr[i] = A.in[I_RGWR][(size_t)(hd * 64 + i) * 64 + j]; wi[i] = A.in[I_RGWI][(size_t)(hd * 64 + i) * 64 + j]; }
    const float br = A.in[I_RGBR][c], bi = A.in[I_RGBI][c], L2 = sc[SC_RGL + c];
    const float w0 = A.in[I_CONVW][c], w1 = A.in[I_CONVW][WA + c], w2 = A.in[I_CONVW][2 * WA + c], w3 = A.in[I_CONVW][3 * WA + c], cb = A.in[I_CONVB][c];
    int T, m0; float x3, x2, x1, h;
    if (prompt) { T = TP; m0 = b * TP; x3 = 0.f; x2 = 0.f; x1 = 0.f; h = 0.f; }
    else { T = TS; m0 = MP + b * TS; x3 = A.in[I_SCONV][(size_t)(b * 3 + 0) * WA + c]; x2 = A.in[I_SCONV][(size_t)(b * 3 + 1) * WA + c]; x1 = A.in[I_SCONV][(size_t)(b * 3 + 2) * WA + c]; h = A.in[I_SH][(size_t)b * WA + c]; }
    for (int t = 0; t < T; ++t) {
        const size_t m = (size_t)(m0 + t);
        const float xa = bf2f(Z[m * NZ + WA + c]), gate = bf2f(Z[m * NZ + c]);
        const float xc = cb + w0 * x3 + w1 * x2 + w2 * x1 + w3 * xa; x3 = x2; x2 = x1; x1 = xa;
        scr[j] = xc; LDS_WAIT(); asm volatile("" ::: "memory");
        float rp = br, gp = bi;
#pragma unroll
        for (int i4 = 0; i4 < 16; ++i4) { const f32x4 v = *(const LAS f32x4*)(scr + 4 * i4);
            rp += v[0] * wr[4 * i4] + v[1] * wr[4 * i4 + 1] + v[2] * wr[4 * i4 + 2] + v[3] * wr[4 * i4 + 3];
            gp += v[0] * wi[4 * i4] + v[1] * wi[4 * i4 + 1] + v[2] * wi[4 * i4 + 2] + v[3] * wi[4 * i4 + 3]; }
        LDS_WAIT(); asm volatile("" ::: "memory");
        const float r = sigmoidf_(rp), gi = sigmoidf_(gp);
        const float a = exp2f(r * L2);
        float mult = sqrtf(fmaxf(1.f - a * a, 0.f));
        if (prompt && t == 0) mult = 1.f;
        h = a * h + mult * gi * xc;
        Y[m * D + c] = (bf16)f2bf(gelu_tanh(gate) * h);
    }
    float* oc = F.out + (prompt ? O_CONVP : O_CONVS); float* oh = F.out + (prompt ? O_HP : O_HS);
    oc[(size_t)(b * 3 + 0) * WA + c] = x3; oc[(size_t)(b * 3 + 1) * WA + c] = x2; oc[(size_t)(b * 3 + 2) * WA + c] = x1;
    oh[(size_t)b * WA + c] = h;
}
__device__ __forceinline__ void s5_item_ref(Frame& F, const Args& A, bool prompt, int b, int g, LAS float* scr) {
    const int n = F.lane, gn = g * NS5 + n, k = F.lane & 15, part = F.lane >> 4;
    const bf16* Z = (const bf16*)(F.ws + WS_Z); bf16* Gy = (bf16*)(F.ws + WS_G); const float* sc = (const float*)(F.ws + WS_S5C);
    float bbr[16], bbi[16], cre[16], cim[16];
#pragma unroll
    for (int i = 0; i < 16; ++i) { bbr[i] = sc[SC_BBR + gn * KS5 + i]; bbi[i] = sc[SC_BBI + gn * KS5 + i];
        cre[i] = A.in[I_S5CRE][(size_t)(g * KS5 + k) * NS5 + part * 16 + i]; cim[i] = A.in[I_S5CIM][(size_t)(g * KS5 + k) * NS5 + part * 16 + i]; }
    const float abr = sc[SC_ABR + gn], abi = sc[SC_ABI + gn], dk = A.in[I_S5D][g * KS5 + k];
    int T, m0; float hr, hi;
    if (prompt) { T = TP; m0 = b * TP; hr = 0.f; hi = 0.f; }
    else { T = TS; m0 = MP + b * TS; hr = A.in[I_SSR][(size_t)(b * GB + g) * NS5 + n]; hi = A.in[I_SSI][(size_t)(b * GB + g) * NS5 + n]; }
    for (int t = 0; t < T; ++t) {
        const size_t m = (size_t)(m0 + t);
        const bf16* zr = Z + m * NZ + 2 * WA + g * KS5;
        const v4u u0 = *(const v4u*)zr, u1 = *(const v4u*)(zr + 8);
        float u[16];
        u[0] = pg8::bf_lo(u0.x); u[1] = pg8::bf_hi(u0.x); u[2] = pg8::bf_lo(u0.y); u[3] = pg8::bf_hi(u0.y); u[4] = pg8::bf_lo(u0.z); u[5] = pg8::bf_hi(u0.z); u[6] = pg8::bf_lo(u0.w); u[7] = pg8::bf_hi(u0.w);
        u[8] = pg8::bf_lo(u1.x); u[9] = pg8::bf_hi(u1.x); u[10] = pg8::bf_lo(u1.y); u[11] = pg8::bf_hi(u1.y); u[12] = pg8::bf_lo(u1.z); u[13] = pg8::bf_hi(u1.z); u[14] = pg8::bf_lo(u1.w); u[15] = pg8::bf_hi(u1.w);
        float bur = 0.f, bui = 0.f;
#pragma unroll
        for (int i = 0; i < 16; ++i) { bur += bbr[i] * u[i]; bui += bbi[i] * u[i]; }
        const float nhr = abr * hr - abi * hi + bur, nhi = abr * hi + abi * hr + bui; hr = nhr; hi = nhi;
        scr[n] = hr; scr[64 + n] = hi; LDS_WAIT(); asm volatile("" ::: "memory");
        float p = 0.f;
#pragma unroll
        for (int i4 = 0; i4 < 4; ++i4) { const f32x4 vr = *(const LAS f32x4*)(scr + part * 16 + 4 * i4), vi = *(const LAS f32x4*)(scr + 64 + part * 16 + 4 * i4);
#pragma unroll
            for (int e = 0; e < 4; ++e) p += vr[e] * cre[4 * i4 + e] - vi[e] * cim[4 * i4 + e]; }
        LDS_WAIT(); asm volatile("" ::: "memory");
        p += __shfl_xor(p, 16); p += __shfl_xor(p, 32);
        const float uk = bf2f(zr[k]);
        if (F.lane < 16) Gy[m * WB + g * KS5 + k] = (bf16)f2bf(gelu_tanh(p + dk * uk));
    }
    float* osr = F.out + (prompt ? O_SRP : O_SRS); float* osi = F.out + (prompt ? O_SIP : O_SIS);
    osr[(size_t)(b * GB + g) * NS5 + n] = hr; osi[(size_t)(b * GB + g) * NS5 + n] = hi;
}

typedef short bf16x8v __attribute__((ext_vector_type(8)));
typedef float f32x16 __attribute__((ext_vector_type(16)));
typedef float f32x2v __attribute__((ext_vector_type(2)));
typedef __bf16 bf16x2v __attribute__((ext_vector_type(2)));
#define MFMA32(a, b, c) __builtin_amdgcn_mfma_f32_32x32x16_bf16((a), (b), (c), 0, 0, 0)
__device__ __forceinline__ unsigned pkbf(float a, float b) { const f32x2v v = {a, b}; const bf16x2v r = __builtin_convertvector(v, bf16x2v); return __builtin_bit_cast(unsigned, r); }
template <int CTRL> __device__ __forceinline__ float dppf(float old, float v) { return __builtin_bit_cast(float, __builtin_amdgcn_update_dpp(__builtin_bit_cast(int, old), __builtin_bit_cast(int, v), CTRL, 0xF, 0xF, false)); }
__device__ __forceinline__ f32x16 ld16(const float* p) { f32x16 r;
#pragma unroll
    for (int i = 0; i < 4; ++i) { const f32x4 v = *(const f32x4*)(p + 4 * i); r[4 * i] = v[0]; r[4 * i + 1] = v[1]; r[4 * i + 2] = v[2]; r[4 * i + 3] = v[3]; }
    return r; }
__device__ __forceinline__ f32x16 ld16l(const LAS float* p) { f32x16 r;
#pragma unroll
    for (int i = 0; i < 4; ++i) { const f32x4 v = *(const LAS f32x4*)(p + 4 * i); r[4 * i] = v[0]; r[4 * i + 1] = v[1]; r[4 * i + 2] = v[2]; r[4 * i + 3] = v[3]; }
    return r; }
__device__ __forceinline__ bf16x8v pack8(const f32x16& x, int s) { v4u p; p.x = pkbf(x[8 * s], x[8 * s + 1]); p.y = pkbf(x[8 * s + 2], x[8 * s + 3]); p.z = pkbf(x[8 * s + 4], x[8 * s + 5]); p.w = pkbf(x[8 * s + 6], x[8 * s + 7]); return __builtin_bit_cast(bf16x8v, p); }
template <int CTRL> __device__ __forceinline__ void s5_scan_step(f32x16& xr, f32x16& xi, const f32x16& zr, const f32x16& zi) {
#pragma unroll
    for (int i = 0; i < 16; ++i) { const float sr = dppf<CTRL>(0.f, xr[i]), si = dppf<CTRL>(0.f, xi[i]);
        xr[i] += zr[i] * sr - zi[i] * si; xi[i] += zr[i] * si + zi[i] * sr; }
}
constexpr int S5L_W1 = 0, S5L_C2 = 32768, S5L_TOT = 98304, S5L_CAR = 106496, S5L_ZP = 114688, S5L_TA = 123392;
static_assert(S5L_TA + 512 <= RING_BYTES, "S5 LDS map");
template <bool SECOND>
__device__ __forceinline__ void s5_step(LAS unsigned char* L, int lane, int j, const bf16x8v u, f32x16& gr0, f32x16& gr1, f32x16& gi0, f32x16& gi1, const float (&dk)[8], bf16* gout) {
    const LAS bf16x8v* a1 = (const LAS bf16x8v*)(L + S5L_W1) + j * 256 + lane;
    gr0 = MFMA32(a1[0], u, gr0); gr1 = MFMA32(a1[64], u, gr1); gi0 = MFMA32(a1[128], u, gi0); gi1 = MFMA32(a1[192], u, gi1);
    if (SECOND) {
        const LAS bf16x8v* a2 = (const LAS bf16x8v*)(L + S5L_C2) + j * 512 + lane;
        f32x16 y;
#pragma unroll
        for (int i = 0; i < 16; ++i) y[i] = 0.f;
        y = MFMA32(a2[0 * 64], pack8(gr0, 0), y); y = MFMA32(a2[1 * 64], pack8(gr0, 1), y);
        y = MFMA32(a2[2 * 64], pack8(gr1, 0), y); y = MFMA32(a2[3 * 64], pack8(gr1, 1), y);
        y = MFMA32(a2[4 * 64], pack8(gi0, 0), y); y = MFMA32(a2[5 * 64], pack8(gi0, 1), y);
        y = MFMA32(a2[6 * 64], pack8(gi1, 0), y); y = MFMA32(a2[7 * 64], pack8(gi1, 1), y);
        const v4u uw = __builtin_bit_cast(v4u, u);
        float o[8];
        o[0] = gelu_tanh(y[0] + dk[0] * pg8::bf_lo(uw.x)); o[1] = gelu_tanh(y[1] + dk[1] * pg8::bf_hi(uw.x));
        o[2] = gelu_tanh(y[2] + dk[2] * pg8::bf_lo(uw.y)); o[3] = gelu_tanh(y[3] + dk[3] * pg8::bf_hi(uw.y));
        o[4] = gelu_tanh(y[4] + dk[4] * pg8::bf_lo(uw.z)); o[5] = gelu_tanh(y[5] + dk[5] * pg8::bf_hi(uw.z));
        o[6] = gelu_tanh(y[6] + dk[6] * pg8::bf_lo(uw.w)); o[7] = gelu_tanh(y[7] + dk[7] * pg8::bf_hi(uw.w));
        v4u w; w.x = pkbf(o[0], o[1]); w.y = pkbf(o[2], o[3]); w.z = pkbf(o[4], o[5]); w.w = pkbf(o[6], o[7]);
        pg8::st16_wt(gout, w);
    }
}
__device__ __forceinline__ void s5_cmul(const LAS float* p, f32x16& r0, f32x16& r1, f32x16& i0, f32x16& i1) {
    { const f32x16 zr = ld16l(p), zi = ld16l(p + 32); const f32x16 t = zr * r0 - zi * i0; i0 = zr * i0 + zi * r0; r0 = t; }
    asm volatile("" : "+v"(r0), "+v"(i0) :: "memory");
    { const f32x16 zr = ld16l(p + 16), zi = ld16l(p + 48); const f32x16 t = zr * r1 - zi * i1; i1 = zr * i1 + zi * r1; r1 = t; }
    asm volatile("" : "+v"(r1), "+v"(i1) :: "memory");
}
__device__ __forceinline__ void s5_stage_tables(Frame& F, LAS unsigned char* L, const unsigned char* tab, int g) {
    const v4u* s1 = (const v4u*)(tab + TB_W1) + (size_t)g * 2048; const v4u* s2 = (const v4u*)(tab + TB_C2) + (size_t)g * 4096;
#pragma unroll
    for (int k = 0; k < 4; ++k) ((LAS v4u*)(L + S5L_W1))[F.tid + 512 * k] = s1[F.tid + 512 * k];
#pragma unroll
    for (int k = 0; k < 8; ++k) ((LAS v4u*)(L + S5L_C2))[F.tid + 512 * k] = s2[F.tid + 512 * k];
    const v4u* s3 = (const v4u*)(tab + TB_ZP) + (size_t)g * (17 * 128 / 4); for (int e = F.tid; e < 17 * 128 / 4; e += NWAVES * 64) ((LAS v4u*)(L + S5L_ZP))[e] = s3[e];
    if (F.tid < 32) ((LAS v4u*)(L + S5L_TA))[F.tid] = ((const v4u*)(tab + TB_TA) + (size_t)g * 32)[F.tid];
}
__device__ __forceinline__ void s5_item_fast(Frame& F, const Args& A, int b, int g) {
    refresh(F);
    const int lane = F.lane, q = lane & 31, hh = lane >> 5, w = F.wave, c = w * 32 + q;
    LAS unsigned char* L = F.lds + RING_OFF;
    const unsigned char* tab = F.ws + WS_TAB;
    const size_t m0 = (size_t)b * TP + (size_t)8 * c;
    const bf16* zrow = (const bf16*)(F.ws + WS_Z) + m0 * NZ + 2 * WA + g * KS5 + 8 * hh;
    bf16* grow = (bf16*)(F.ws + WS_G) + m0 * WB + g * KS5 + 8 * hh;
    bf16x8v uu[8];
#pragma unroll
    for (int j = 0; j < 8; ++j) uu[j] = *(const bf16x8v*)(zrow + (size_t)j * NZ);
    s5_stage_tables(F, L, tab, g);
    __syncthreads();
    f32x16 hr0, hr1, hi0, hi1;
#pragma unroll
    for (int i = 0; i < 16; ++i) { hr0[i] = 0.f; hr1[i] = 0.f; hi0[i] = 0.f; hi1[i] = 0.f; }
    float dk[8];
#pragma unroll
    for (int i = 0; i < 8; ++i) dk[i] = A.in[I_S5D][g * KS5 + 8 * hh + i];
#pragma unroll
    for (int j = 0; j < 8; ++j) s5_step<false>(L, lane, j, uu[j], hr0, hr1, hi0, hi1, dk, nullptr);
    const LAS float* ZP = (const LAS float*)(L + S5L_ZP);
    s5_cmul(ZP + ((1 * 2 + hh) * 2) * 32, hr0, hr1, hi0, hi1);
#define S5_SCAN(E, CTRL) do { const LAS float* z = ZP + (((E) * 2 + hh) * 2) * 32; \
        { const f32x16 zr = ld16l(z), zi = ld16l(z + 32); s5_scan_step<CTRL>(hr0, hi0, zr, zi); } \
        asm volatile("" : "+v"(hr0), "+v"(hi0) :: "memory"); \
        { const f32x16 zr = ld16l(z + 16), zi = ld16l(z + 48); s5_scan_step<CTRL>(hr1, hi1, zr, zi); } \
        asm volatile("" : "+v"(hr1), "+v"(hi1) :: "memory"); } while (0)
    S5_SCAN(1, 0x111); S5_SCAN(2, 0x112); S5_SCAN(4, 0x114); S5_SCAN(8, 0x118);
#undef S5_SCAN
    const int seg = w * 2 + (q >> 4);
    LAS float* TOT = (LAS float*)(L + S5L_TOT); LAS float* CAR = (LAS float*)(L + S5L_CAR);
    if ((lane & 15) == 15) {
#pragma unroll
        for (int rho = 0; rho < 4; ++rho) {
            *(LAS f32x4*)(TOT + (seg * 2 + 0) * 64 + 0 + 8 * rho + 4 * hh) = (f32x4){hr0[4 * rho], hr0[4 * rho + 1], hr0[4 * rho + 2], hr0[4 * rho + 3]};
            *(LAS f32x4*)(TOT + (seg * 2 + 0) * 64 + 32 + 8 * rho + 4 * hh) = (f32x4){hr1[4 * rho], hr1[4 * rho + 1], hr1[4 * rho + 2], hr1[4 * rho + 3]};
            *(LAS f32x4*)(TOT + (seg * 2 + 1) * 64 + 0 + 8 * rho + 4 * hh) = (f32x4){hi0[4 * rho], hi0[4 * rho + 1], hi0[4 * rho + 2], hi0[4 * rho + 3]};
            *(LAS f32x4*)(TOT + (seg * 2 + 1) * 64 + 32 + 8 * rho + 4 * hh) = (f32x4){hi1[4 * rho], hi1[4 * rho + 1], hi1[4 * rho + 2], hi1[4 * rho + 3]}; }
    }
    __syncthreads();
    if (F.tid < 64) {
        const float* z16 = (const float*)(tab + TB_Z16N) + (size_t)g * 128; const float zr = z16[F.tid], zi = z16[64 + F.tid];
        float cr = 0.f, ci = 0.f;
#pragma unroll
        for (int sg = 0; sg < 16; ++sg) { CAR[(sg * 2 + 0) * 64 + F.tid] = cr; CAR[(sg * 2 + 1) * 64 + F.tid] = ci;
            const float tr = TOT[(sg * 2 + 0) * 64 + F.tid], ti = TOT[(sg * 2 + 1) * 64 + F.tid];
            const float ncr = zr * cr - zi * ci + tr, nci = zr * ci + zi * cr + ti; cr = ncr; ci = nci; }
    }
    __syncthreads();
    {
        const LAS float* z = ZP + (((q & 15) * 2 + hh) * 2) * 32;
#define S5_EXCL(HR, HI, OFF) do { const f32x16 zr = ld16l(z + (OFF)), zi = ld16l(z + 32 + (OFF)); f32x16 kr, ki; \
        _Pragma("unroll") for (int rho = 0; rho < 4; ++rho) { \
            const f32x4 a0 = *(const LAS f32x4*)(CAR + (seg * 2 + 0) * 64 + 2 * (OFF) + 8 * rho + 4 * hh), b0 = *(const LAS f32x4*)(CAR + (seg * 2 + 1) * 64 + 2 * (OFF) + 8 * rho + 4 * hh); \
            _Pragma("unroll") for (int e = 0; e < 4; ++e) { kr[4 * rho + e] = a0[e]; ki[4 * rho + e] = b0[e]; } } \
        _Pragma("unroll") for (int i = 0; i < 16; ++i) { const float sr = dppf<0x111>(0.f, HR[i]), si = dppf<0x111>(0.f, HI[i]); \
            HR[i] = sr + zr[i] * kr[i] - zi[i] * ki[i]; HI[i] = si + zr[i] * ki[i] + zi[i] * kr[i]; } } while (0)
        S5_EXCL(hr0, hi0, 0); asm volatile("" : "+v"(hr0), "+v"(hi0) :: "memory"); S5_EXCL(hr1, hi1, 16); asm volatile("" : "+v"(hr1), "+v"(hi1) :: "memory");
#undef S5_EXCL
    }
#pragma unroll
    for (int j = 0; j < 8; ++j) s5_step<true>(L, lane, j, uu[j], hr0, hr1, hi0, hi1, dk, grow + (size_t)j * WB);
    if (w == NWAVES - 1 && q == 31) {
        s5_cmul(ZP + ((1 * 2 + hh) * 2) * 32, hr0, hr1, hi0, hi1);
        float* osr = F.out + O_SRP + (size_t)(b * GB + g) * NS5; float* osi = F.out + O_SIP + (size_t)(b * GB + g) * NS5;
#pragma unroll
        for (int i = 0; i < 16; ++i) { const int n = (i & 3) + 8 * (i >> 2) + 4 * hh; osr[n] = hr0[i]; osr[32 + n] = hr1[i]; osi[n] = hi0[i]; osi[32 + n] = hi1[i]; }
    }
    __syncthreads();
}

__device__ __forceinline__ void s5_item_sample(Frame& F, const Args& A, int g) {
    refresh(F);
    const int lane = F.lane, q = lane & 31, hh = lane >> 5, w = F.wave;
    LAS unsigned char* L = F.lds + RING_OFF;
    const unsigned char* tab = F.ws + WS_TAB;
    s5_stage_tables(F, L, tab, g);
    __syncthreads();
    if (w < 4) {
        const int b = w * 32 + q;
        f32x16 hr0, hr1, hi0, hi1;
        const float* sr = A.in[I_SSR] + (size_t)(b * GB + g) * NS5; const float* si = A.in[I_SSI] + (size_t)(b * GB + g) * NS5;
#pragma unroll
        for (int rho = 0; rho < 4; ++rho) { const f32x4 a0 = *(const f32x4*)(sr + 8 * rho + 4 * hh), a1 = *(const f32x4*)(sr + 32 + 8 * rho + 4 * hh), b0 = *(const f32x4*)(si + 8 * rho + 4 * hh), b1 = *(const f32x4*)(si + 32 + 8 * rho + 4 * hh);
#pragma unroll
            for (int e = 0; e < 4; ++e) { hr0[4 * rho + e] = a0[e]; hr1[4 * rho + e] = a1[e]; hi0[4 * rho + e] = b0[e]; hi1[4 * rho + e] = b1[e]; } }
        float dk[8];
#pragma unroll
        for (int i = 0; i < 8; ++i) dk[i] = A.in[I_S5D][g * KS5 + 8 * hh + i];
        const size_t m0 = (size_t)MP + (size_t)b * TS;
        const bf16* zrow = (const bf16*)(F.ws + WS_Z) + m0 * NZ + 2 * WA + g * KS5 + 8 * hh;
        bf16* grow = (bf16*)(F.ws + WS_G) + m0 * WB + g * KS5 + 8 * hh;
        bf16x8v uu[TS];
#pragma unroll
        for (int j = 0; j < TS; ++j) uu[j] = *(const bf16x8v*)(zrow + (size_t)j * NZ);
#pragma unroll
        for (int j = 0; j < TS; ++j) s5_step<true>(L, lane, j, uu[j], hr0, hr1, hi0, hi1, dk, grow + (size_t)j * WB);
        s5_cmul((const LAS float*)(L + S5L_TA) + hh * 64, hr0, hr1, hi0, hi1);
        float* osr = F.out + O_SRS + (size_t)(b * GB + g) * NS5; float* osi = F.out + O_SIS + (size_t)(b * GB + g) * NS5;
#pragma unroll
        for (int rho = 0; rho < 4; ++rho) {
            *(f32x4*)(osr + 8 * rho + 4 * hh) = (f32x4){hr0[4 * rho], hr0[4 * rho + 1], hr0[4 * rho + 2], hr0[4 * rho + 3]};
            *(f32x4*)(osr + 32 + 8 * rho + 4 * hh) = (f32x4){hr1[4 * rho], hr1[4 * rho + 1], hr1[4 * rho + 2], hr1[4 * rho + 3]};
            *(f32x4*)(osi + 8 * rho + 4 * hh) = (f32x4){hi0[4 * rho], hi0[4 * rho + 1], hi0[4 * rho + 2], hi0[4 * rho + 3]};
            *(f32x4*)(osi + 32 + 8 * rho + 4 * hh) = (f32x4){hi1[4 * rho], hi1[4 * rho + 1], hi1[4 * rho + 2], hi1[4 * rho + 3]}; }
    }
    __syncthreads();
}

template <int CTRL, int RMASK> __device__ __forceinline__ float dppm(float old, float v) { return __builtin_bit_cast(float, __builtin_amdgcn_update_dpp(__builtin_bit_cast(int, old), __builtin_bit_cast(int, v), CTRL, RMASK, 0xF, false)); }
template <int CTRL, int RMASK> __device__ __forceinline__ void rg_scan_step(f32x16& a, f32x16& b) {
#pragma unroll
    for (int i = 0; i < 16; ++i) { const float as = dppm<CTRL, RMASK>(1.f, a[i]), bs = dppm<CTRL, RMASK>(0.f, b[i]); b[i] = a[i] * bs + b[i]; a[i] = a[i] * as; }
}
constexpr int RGL_AFR = 0, RGL_DG = 8192, RGL_TOT = 24576, RGL_CST = 28672;
constexpr int RGL_XAP = 144;
constexpr int RGL_XA0 = 29696, RGL_BUF = 37376;
static_assert(259 * RGL_XAP <= RGL_BUF && RGL_XA0 + 2 * RGL_BUF <= RING_BYTES && RGL_CST + 640 <= RGL_XA0, "RG-LRU LDS map");
template <bool SAMPLE>
__device__ __forceinline__ void rg_item_fast(Frame& F, const Args& A, int b, int hd, int jh) {
    refresh(F);
    const int lane = F.lane, q = lane & 31, hh = lane >> 5, w = F.wave;
    LAS unsigned char* L = F.lds + RING_OFF;
    const float* sc = (const float*)(F.ws + WS_S5C);
    const bf16* Zb = (const bf16*)(F.ws + WS_Z) + (size_t)(SAMPLE ? MP : b * TP) * NZ; bf16* Yb = SAMPLE ? (bf16*)(F.ws + WS_YCS) : (bf16*)(F.ws + WS_YCAT) + (size_t)(b * TP) * D;
    const bf16* CB = (const bf16*)(F.ws + WS_TAB + TB_CB);
    auto stage_load = [&](int T0, v4u (&st)[5]) {
#pragma unroll
        for (int k = 0; k < 5; ++k) { const int ci = F.tid + 512 * k; v4u v = (v4u){0u, 0u, 0u, 0u};
            if (ci < 2072) { const int tk = T0 - 3 + (ci >> 3); if (tk >= 0) v = *(const v4u*)(Zb + (size_t)tk * NZ + WA + hd * 64 + (ci & 7) * 8); }
            st[k] = v; } };
    auto stage_write = [&](int par, const v4u (&st)[5]) {
#pragma unroll
        for (int k = 0; k < 5; ++k) { const int ci = F.tid + 512 * k;
            if (ci < 2072) *(LAS v4u*)(L + RGL_XA0 + par * RGL_BUF + (ci >> 3) * RGL_XAP + (ci & 7) * 16) = st[k]; } };
    {
        const v4u* src = (const v4u*)(F.ws + WS_TAB + TB_RG) + (size_t)((hd * 2 + jh) * 8) * 64;
        ((LAS v4u*)(L + RGL_AFR))[F.tid] = src[F.tid];
        const v4u* sd = (const v4u*)(F.ws + WS_TAB + TB_DG) + (size_t)(hd * 16) * 64;
        ((LAS v4u*)(L + RGL_DG))[F.tid] = sd[F.tid]; ((LAS v4u*)(L + RGL_DG))[512 + F.tid] = sd[512 + F.tid];
        if (F.tid < 160) { const int h2 = F.tid / 80, kind = (F.tid % 80) / 16, i = F.tid % 16, cr = (i & 3) + 8 * (i >> 2) + 4 * h2;
            const int c = hd * 64 + 32 * jh + cr;
            ((LAS float*)(L + RGL_CST))[F.tid] = kind == 0 ? A.in[I_RGBR][c] : kind == 1 ? A.in[I_RGBI][c] : kind == 2 ? sc[SC_RGL + c] : A.in[I_CONVB][hd * 64 + 32 * (kind - 3) + cr]; }
        if (!SAMPLE && jh == 0 && F.tid < 192) { const int k = F.tid >> 6, ch = F.tid & 63;
            F.out[O_CONVP + (size_t)(b * 3 + k) * WA + hd * 64 + ch] = bf2f(((const bf16*)(F.ws + WS_Z))[(size_t)(b * TP + TP - 3 + k) * NZ + WA + hd * 64 + ch]); }
        if (SAMPLE && jh == 0) { for (int e = F.tid; e < NBS * 3 * 64; e += NWAVES * 64) { const int bb = e / 192, k = (e / 64) % 3, ch = e & 63;
            F.out[O_CONVS + (size_t)(bb * 3 + k) * WA + hd * 64 + ch] = bf2f(((const bf16*)(F.ws + WS_Z))[(size_t)(MP + bb * TS + 1 + k) * NZ + WA + hd * 64 + ch]); } }
        if (!SAMPLE) { v4u st[5]; stage_load(0, st); stage_write(0, st); }
    }
    __syncthreads();
    float hround[16];
#pragma unroll
    for (int i = 0; i < 16; ++i) hround[i] = 0.f;
    const LAS float* CST = (const LAS float*)(L + RGL_CST) + hh * 80;
    const LAS bf16x8v* af = (const LAS bf16x8v*)(L + RGL_AFR) + lane;
    const LAS bf16x8v* dg = (const LAS bf16x8v*)(L + RGL_DG) + lane;
#pragma unroll 1
    for (int rd = 0; rd < (SAMPLE ? 2 : 8); ++rd) {
        const int t = rd * 256 + w * 32 + q;
        v4u stn[5];
        if (!SAMPLE) stage_load((rd + 1) * 256, stn);
        const LAS unsigned char* XAp = L + RGL_XA0 + (rd & 1) * RGL_BUF + (w * 32 + q) * RGL_XAP + 16 * hh;
        const bf16* zsr[4];
        if (SAMPLE) {
#pragma unroll
            for (int k = 0; k < 4; ++k) { const int jx = (t & 3) + k; zsr[k] = (jx < 3 ? CB + (size_t)((t >> 2) * 3 + jx) * WA : Zb + (size_t)(t - 3 + k) * NZ + WA) + hd * 64 + 8 * hh; } }
        const bf16* gr = Zb + (size_t)t * NZ + hd * 64 + 32 * jh + 4 * hh;
        unsigned long long gq[4];
#pragma unroll
        for (int rho = 0; rho < 4; ++rho) gq[rho] = *(const unsigned long long*)(gr + 8 * rho);
        f32x16 dx0, dx1;
        { const f32x4 c0 = *(const LAS f32x4*)(CST + 48), c1 = *(const LAS f32x4*)(CST + 52), c2 = *(const LAS f32x4*)(CST + 56), c3 = *(const LAS f32x4*)(CST + 60);
          const f32x4 e0 = *(const LAS f32x4*)(CST + 64), e1 = *(const LAS f32x4*)(CST + 68), e2 = *(const LAS f32x4*)(CST + 72), e3 = *(const LAS f32x4*)(CST + 76);
#pragma unroll
          for (int e = 0; e < 4; ++e) { dx0[e] = c0[e]; dx0[4 + e] = c1[e]; dx0[8 + e] = c2[e]; dx0[12 + e] = c3[e]; dx1[e] = e0[e]; dx1[4 + e] = e1[e]; dx1[8 + e] = e2[e]; dx1[12 + e] = e3[e]; } }
#pragma unroll
        for (int k = 0; k < 4; ++k)
#pragma unroll
            for (int s4 = 0; s4 < 4; ++s4) {
                const bf16x8v xb = SAMPLE ? *(const bf16x8v*)(zsr[k] + 16 * s4) : *(const LAS bf16x8v*)(XAp + k * RGL_XAP + s4 * 32);
                if (s4 < 2) dx0 = MFMA32(dg[((0 * 2 + (s4 & 1)) * 4 + k) * 64], xb, dx0); else dx1 = MFMA32(dg[((1 * 2 + (s4 & 1)) * 4 + k) * 64], xb, dx1);
                if (s4 == 3) asm volatile("" : "+v"(dx0), "+v"(dx1) :: "memory"); }
        f32x16 dr, di;
#pragma unroll
        for (int i = 0; i < 16; ++i) { dr[i] = 0.f; di[i] = 0.f; }
        { const bf16x8v b00 = pack8(dx0, 0), b01 = pack8(dx0, 1), b10 = pack8(dx1, 0), b11 = pack8(dx1, 1);
          dr = MFMA32(af[0 * 64], b00, dr); di = MFMA32(af[4 * 64], b00, di); dr = MFMA32(af[1 * 64], b01, dr); di = MFMA32(af[5 * 64], b01, di);
          dr = MFMA32(af[2 * 64], b10, dr); di = MFMA32(af[6 * 64], b10, di); dr = MFMA32(af[3 * 64], b11, dr); di = MFMA32(af[7 * 64], b11, di); }
        f32x16 av, bv;
        const bool first = !SAMPLE && (t == 0);
#pragma unroll
        for (int i = 0; i < 16; ++i) { const float xcv = jh ? dx1[i] : dx0[i];
            const float r = sigmoidf_(dr[i] + CST[i]), gi = sigmoidf_(di[i] + CST[16 + i]);
            const float a = __builtin_amdgcn_exp2f(r * CST[32 + i]);
            float mult = __builtin_amdgcn_sqrtf(fmaxf(1.f - a * a, 0.f)); if (first) mult = 1.f;
            av[i] = a; bv[i] = mult * gi * xcv; }
        if (SAMPLE && (t & 3) == 0) {
            const float* h0 = A.in[I_SH] + (size_t)(t >> 2) * WA + hd * 64 + 32 * jh + 4 * hh;
#pragma unroll
            for (int i = 0; i < 16; ++i) { bv[i] += av[i] * h0[(i & 3) + 8 * (i >> 2)]; av[i] = 0.f; } }
        rg_scan_step<0x111, 0xF>(av, bv); rg_scan_step<0x112, 0xF>(av, bv); rg_scan_step<0x114, 0xF>(av, bv); rg_scan_step<0x118, 0xF>(av, bv);
        rg_scan_step<0x142, 0xA>(av, bv);
        float hin[16];
#pragma unroll
        for (int i = 0; i < 16; ++i) hin[i] = 0.f;
        if (!SAMPLE) {
        LAS float* TOT = (LAS float*)(L + RGL_TOT) + (rd & 1) * 512;
        if (q == 31) {
#pragma unroll
            for (int i4 = 0; i4 < 4; ++i4) { *(LAS f32x4*)(TOT + (w * 2 + 0) * 32 + hh * 16 + 4 * i4) = (f32x4){av[4 * i4], av[4 * i4 + 1], av[4 * i4 + 2], av[4 * i4 + 3]};
                                             *(LAS f32x4*)(TOT + (w * 2 + 1) * 32 + hh * 16 + 4 * i4) = (f32x4){bv[4 * i4], bv[4 * i4 + 1], bv[4 * i4 + 2], bv[4 * i4 + 3]}; }
        }
        stage_write((rd + 1) & 1, stn);
        __syncthreads();
#pragma unroll
        for (int w2 = 0; w2 < 8; ++w2) {
            if (w2 == w) {
#pragma unroll
                for (int i = 0; i < 16; ++i) hin[i] = hround[i]; }
#pragma unroll
            for (int i4 = 0; i4 < 4; ++i4) { const f32x4 p = *(const LAS f32x4*)(TOT + (w2 * 2 + 0) * 32 + hh * 16 + 4 * i4), hl = *(const LAS f32x4*)(TOT + (w2 * 2 + 1) * 32 + hh * 16 + 4 * i4);
#pragma unroll
                for (int e = 0; e < 4; ++e) hround[4 * i4 + e] = p[e] * hround[4 * i4 + e] + hl[e]; }
        }
        }
        bf16* yr = Yb + (size_t)t * D + hd * 64 + 32 * jh + 4 * hh;
#pragma unroll
        for (int rho = 0; rho < 4; ++rho) { const unsigned glo = (unsigned)gq[rho], ghi = (unsigned)(gq[rho] >> 32);
            const float o0 = gelu_tanh(pg8::bf_lo(glo)) * (bv[4 * rho] + av[4 * rho] * hin[4 * rho]), o1 = gelu_tanh(pg8::bf_hi(glo)) * (bv[4 * rho + 1] + av[4 * rho + 1] * hin[4 * rho + 1]);
            const float o2 = gelu_tanh(pg8::bf_lo(ghi)) * (bv[4 * rho + 2] + av[4 * rho + 2] * hin[4 * rho + 2]), o3 = gelu_tanh(pg8::bf_hi(ghi)) * (bv[4 * rho + 3] + av[4 * rho + 3] * hin[4 * rho + 3]);
            *(unsigned long long*)(yr + 8 * rho) = (unsigned long long)pkbf(o0, o1) | ((unsigned long long)pkbf(o2, o3) << 32); }
        if (SAMPLE && (t & 3) == 3) {
#pragma unroll
            for (int i = 0; i < 16; ++i) F.out[O_HS + (size_t)(t >> 2) * WA + hd * 64 + 32 * jh + (i & 3) + 8 * (i >> 2) + 4 * hh] = bv[i]; }
    }
    if (!SAMPLE && w == 0 && q == 0) {
#pragma unroll
        for (int i = 0; i < 16; ++i) F.out[O_HP + (size_t)b * WA + hd * 64 + 32 * jh + (i & 3) + 8 * (i >> 2) + 4 * hh] = hround[i];
    }
    __syncthreads();
}

#ifndef PROBE_P3PART
#define PROBE_P3PART 7
#endif
__device__ __forceinline__ void p3_mixers_ref(Frame& F, const Args& A, int rep = 0) {
    constexpr int N_RGP = NBP * HA, N_S5P = NBP * GB;
    const int pm = rep ? PROBE_P3PART : 7;
    bf16* GY = (bf16*)(F.ws + WS_G); bf16* YC = (bf16*)(F.ws + WS_YCAT);
    pg8::Gemm gg{GY, (const bf16*)(F.ws + WS_WGLU), M, WB, WB}; pg8::EpiGlu EG{GY, WB, YC, D, WA, A.in[I_GLUB], (bf16*)(F.ws + WS_YCS), MP};
    pg8::OneUnit SG; SG.u0.pm = 0; SG.u0.pn = 0; SG.u0.k0 = 0; SG.u0.nkt = WB / 64; SG.u0.ks = 0; bool has_glu = false;
    if (F.vcu < 2 * N_RGP) {
        if ((pm & 4) && F.vcu < GB) { s5_item_sample(F, A, F.vcu); cnt_arrive_wt(F, CW_S5B + 64 * NBP); }
        if (pm & 1) rg_item_fast<false>(F, A, F.vcu / (2 * HA), (F.vcu / 2) % HA, F.vcu & 1);
        if (pm & 4) { if (F.vcu < GB) { }
                      else if (F.vcu < GB + 2 * HA) rg_item_fast<true>(F, A, 0, (F.vcu - GB) >> 1, (F.vcu - GB) & 1);
                      else if (F.vcu < GB + 2 * HA + 4) {
                          cnt_wait_ge(F, CW_S5B + 64 * NBP, (unsigned)GB); const int u = F.vcu - GB - 2 * HA; SG.u0.pm = MP / 256 + (u >> 1); SG.u0.pn = u & 1; has_glu = true; } }
    } else {
        const int v = F.vcu - 2 * N_RGP, it = 2 * v, bb = it / GB;
        if (pm & 2) { s5_item_fast(F, A, bb, it % GB);
                      s5_item_fast(F, A, bb, (it + 1) % GB);
                      cnt_arrive_wt(F, CW_S5B + 64 * bb);
                      cnt_wait_ge(F, CW_S5B + 64 * bb, 16u);
                      const int u = v & 15; SG.u0.pm = 8 * bb + (u >> 1); SG.u0.pn = u & 1; has_glu = true; }
    }
    if (has_glu) pg8::gemm_phase<pg8::EpiGlu, pg8::OneUnit, false, PG8_SP2>(F.lds + RING_OFF, gg, SG, EG);
    if (rep == 0 && F.vcu >= GB + 2 * HA + 4 && F.vcu < 2 * N_RGP) {
        constexpr int X0 = GB + 2 * HA + 4, NX = 2 * N_RGP - X0;
        LAS float* scr = (LAS float*)(F.lds + RING_OFF + F.wave * 16384);
        for (int it = XO_2 + F.wave * NX + (F.vcu - X0); it < XO_END; it += NX * NWAVES) xpose_item(F, A, scr, it); }
}

template <bool SECOND>
__device__ __forceinline__ void ln_phase(Frame& F, const Args& A, int rep) {
    pg8::StaticOrder P; P.init(MP, D, F.G, (int)blockIdx.x, D); pg8::Unit u; P.next(0, u);
    cnt_wait_ge(F, (SECOND ? CW_T2 : CW_T1) + 64 * u.pm, 4u);
    ln_rows<SECOND>(F, A, u.pm * 256 + u.pn * 64, u.pm * 256 + u.pn * 64 + 64, F.wave, NWAVES);
    constexpr int NPC = 2 * (D / 256) * (SECOND ? NS_DOWN : NS_OUT);
    const int si = (int)blockIdx.x - (F.G - NPC);
    if (si >= 0) { cnt_wait_ge(F, SECOND ? CW_T2S : CW_T1S, (unsigned)NPC);
        ln_rows<SECOND>(F, A, MP + si * (MS / NPC), MP + (si + 1) * (MS / NPC), F.wave, NWAVES); }
}
__device__ __forceinline__ int out_piece_of(int bx) { return (bx >= 192 && bx < 224) ? bx - 192 : -1; }
__device__ __forceinline__ int down_piece_of(int bx) { return (bx >= 32 && bx < 64) ? bx - 32 : (bx >= 96 && bx < 128) ? bx - 64 : -1; }
__global__ void __launch_bounds__(NWAVES * 64, 2) fwd(Args A) {
    extern __shared__ __attribute__((aligned(16))) unsigned char lds[];
    Frame F;
    F.lds = (LAS unsigned char*)lds;
    F.MISC = (volatile LAS unsigned*)(F.lds + MISC_OFF);
    F.tid = threadIdx.x; F.lane = F.tid & 63; F.wave = __builtin_amdgcn_readfirstlane(F.tid >> 6);
    F.G = gridDim.x; { const int bx = blockIdx.x; F.vcu = (F.G % 8 == 0) ? (bx % 8) * (F.G / 8) + bx / 8 : bx; }
    F.out = A.out; F.ws = A.ws; F.ctl = (gu32*)(A.ws + WS_CTL); F.grp_local = false;
    if (threadIdx.x == 0) __hip_atomic_store((unsigned*)(F.ctl + CW_XCC + blockIdx.x), 1u + xb_xcc_id(), RLX_AGENT);
    for (int u = F.tid; u < (LDS_BYTES - LDSCTL_OFF) / 4; u += NWAVES * 64) ((LAS unsigned*)(F.lds + LDSCTL_OFF))[u] = 0u;
    __syncthreads();
    XcdBarrier bar; bar.bar = (unsigned*)(F.ctl + CW_BAR); bar.x = 0; bar.st = nullptr;
    if (N_LAUNCHES == 1) bar = xcd_barrier_post((unsigned*)(F.ctl + CW_BAR), F.MISC + 8);
#define GRID_BAR() do { if (N_LAUNCHES == 1) xcd_barrier(bar); } while (0)
    const int lo = A.ph_lo, hi = A.ph_hi;
#define IN(k) (lo <= (k) && (k) < hi)
#define BOTH(k) (IN(k) && IN((k) + 1))
    bf16* XN = (bf16*)(F.ws + WS_XN); bf16* Z = (bf16*)(F.ws + WS_Z); bf16* YC = (bf16*)(F.ws + WS_YCAT); bf16* GY = (bf16*)(F.ws + WS_G); bf16* U = (bf16*)(F.ws + WS_U);
    const float* mod = (const float*)(F.ws + WS_MOD);

#define REPS(k) (((PROBE_DUP) >> (k)) & 1 ? 2 : 1)
#define PH0(rep) p0_prologue(F, A, rep)
#define PH1(rep) p1_modulate(F, A, rep)
#define PH2(rep) do {     \
        pg8::Gemm g{XN, (const bf16*)(F.ws + WS_WIN), M, NZ, D}; pg8::StaticOrder S; S.init(M, NZ, F.G, (int)blockIdx.x, D); \
        pg8::EpiBf16<0> E{Z, NZ, nullptr}; \
        pg8::gemm_phase<pg8::EpiBf16<0>, pg8::StaticOrder, PG8_ALIGN, PG8_SP2>(F.lds + RING_OFF, g, S, E); \
        if ((rep) == 0 && (int)blockIdx.x >= (M / 256) * (NZ / 256) - F.G) { __syncthreads(); xpose_range_b(F, A, XO_OU, XO_2, (M / 256) * (NZ / 256) - F.G); } } while (0)
#define PH3(rep) p3_mixers_ref(F, A, rep)
#define PH4(rep) do { } while (0)
#define PH5(rep) do {     \
        pg8::Gemm g{YC, (const bf16*)(F.ws + WS_WOUT), M, D, D}; \
        { pg8::StaticOrder S; S.init(MP, D, F.G, (int)blockIdx.x, D); \
          pg8::EpiLnFused<false> E{A.in[I_XP], mod + 2 * D, nullptr, ALPHA, A.in[I_LN1G], A.in[I_LN1B], mod + 3 * D, nullptr, (bf16*)(F.ws + WS_X1B), XN, (float*)(F.ws + WS_STAT), (unsigned*)(F.ctl + CW_T1), LN_EPS, !F.grp_local}; \
          pg8::gemm_phase<pg8::EpiLnFused<false>, pg8::StaticOrder, false, PG8_SP2>(F.lds + RING_OFF, g, S, E); \
          pg8::Unit u5; if (S.next(0, u5)) cnt_arrive_wt(F, CW_G1 + 64 * u5.pm); }     \
        { const int op = out_piece_of((int)blockIdx.x);     \
          pg8::PieceOrder S; S.init(MP, D, F.G, op >= 0 ? F.G - 1 - op : F.G - 1 - 2 * (D / 256) * NS_OUT, D, NS_OUT); pg8::EpiSlab E{(float*)(F.ws + WS_SLAB), MP}; \
          pg8::Gemm gs{(const bf16*)(F.ws + WS_YCS) - (size_t)MP * D, (const bf16*)(F.ws + WS_WOUT), M, D, D};     \
          pg8::gemm_phase<pg8::EpiSlab, pg8::PieceOrder, false, PG8_SP2>(F.lds + RING_OFF, gs, S, E); \
          if (op >= 0) cnt_arrive_wt(F, CW_T1S); } } while (0)
#define PH6(rep) do {     \
        constexpr int NPC1 = 2 * (D / 256) * NS_OUT; const int si1 = out_piece_of((int)blockIdx.x); \
        if (si1 >= 0) { cnt_wait_ge(F, CW_T1S, (unsigned)NPC1); ln_rows<false>(F, A, MP + si1 * (MS / NPC1), MP + (si1 + 1) * (MS / NPC1), F.wave, NWAVES); cnt_arrive_wt(F, CW_XNS); } } while (0)
#define PH7(rep) do {     \
        pg8::Gemm g{XN, (const bf16*)(F.ws + WS_W1), M, FF, D}; pg8::EpiBf16<3, true> E{U, FF, A.in[I_B1], !F.grp_local}, EW{U, FF, A.in[I_B1], true};     \
        { pg8::StaticOrder S; S.init(MP, FF, F.G, (int)blockIdx.x, D); pg8::Unit u7; \
          { int prev = -1; for (int i = 0; S.next(i, u7); ++i) if (u7.pm != prev) { prev = u7.pm; cnt_wait_ge(F, CW_G1 + 64 * prev, (unsigned)(D / 256)); } }     \
          pg8::gemm_phase<pg8::EpiBf16<3, true>, pg8::StaticOrder, PG8_ALIGN, PG8_SP2>(F.lds + RING_OFF, g, S, E); \
          { int prev = -1, n = 0; for (int i = 0; S.next(i, u7); ++i) { if (u7.pm != prev && n) { cnt_arrive_wt(F, CW_G2 + 64 * prev, (unsigned)n); n = 0; } prev = u7.pm; ++n; } \
            if (n) cnt_arrive_wt(F, CW_G2 + 64 * prev, (unsigned)n); } }     \
        if ((int)blockIdx.x < 2 * (FF / 256)) { cnt_wait_ge(F, CW_XNS, (unsigned)(2 * (D / 256) * NS_OUT)); \
          pg8::OneUnit S; S.u0.pm = MP / 256 + (int)blockIdx.x / (FF / 256); S.u0.pn = (int)blockIdx.x % (FF / 256); S.u0.k0 = 0; S.u0.nkt = D / 64; S.u0.ks = 0; \
          pg8::gemm_phase<pg8::EpiBf16<3, true>, pg8::OneUnit, false, PG8_SP2>(F.lds + RING_OFF, g, S, EW); cnt_arrive_wt(F, CW_US); } } while (0)
#define PH8(rep) do {     \
        pg8::Gemm g{U, (const bf16*)(F.ws + WS_W2), M, D, FF}; \
        { pg8::StaticOrder S; S.init(MP, D, F.G, (int)blockIdx.x, FF); \
          { pg8::Unit u8; if (S.next(0, u8)) cnt_wait_ge(F, CW_G2 + 64 * u8.pm, (unsigned)(FF / 256)); }     \
          pg8::EpiLnFused<true> E{(const bf16*)(F.ws + WS_X1B), mod + 5 * D, A.in[I_B2], ALPHA, A.in[I_LN2G], A.in[I_LN2B], nullptr, F.out, nullptr, nullptr, (float*)(F.ws + WS_STAT), (unsigned*)(F.ctl + CW_T2), LN_EPS}; \
          pg8::gemm_phase<pg8::EpiLnFused<true>, pg8::StaticOrder, false, PG8_SP2>(F.lds + RING_OFF, g, S, E); } \
        { const int dp = down_piece_of((int)blockIdx.x);     \
          pg8::PieceOrder S; S.init(MP, D, F.G, dp >= 0 ? F.G - 1 - dp : F.G - 1 - 2 * (D / 256) * NS_DOWN, FF, NS_DOWN); pg8::EpiSlab E{(float*)(F.ws + WS_SLAB), MP}; \
          if (dp >= 0) cnt_wait_ge(F, CW_US, (unsigned)(2 * (FF / 256)));     \
          pg8::gemm_phase<pg8::EpiSlab, pg8::PieceOrder, false, PG8_SP2>(F.lds + RING_OFF, g, S, E); \
          if (dp >= 0) cnt_arrive_wt(F, CW_T2S); } } while (0)
#define RUNNB(k, PH) do { if (IN(k)) { PH(0); if (REPS(k) == 2) { __syncthreads(); PH(1); } } } while (0)
#define RUN(k, PH) do { if (IN(k)) { PH(0); if (REPS(k) == 2) { __syncthreads(); PH(1); } if (BOTH(k)) GRID_BAR(); } } while (0)
    if (IN(0)) { PH0(0); if (REPS(0) == 2) { __syncthreads(); PH0(1); } if (IN(0) && !IN(1)) { } }
    RUN(1, PH1); RUN(2, PH2); RUN(3, PH3);
    if (N_LAUNCHES == 1 && F.G == 256) {
        const unsigned me = xb_xcc_id() + 1u; bool same = true;
#pragma unroll
        for (int p = 0; p < 4; ++p) same = same && (__hip_atomic_load((unsigned*)(F.ctl + CW_XCC + ((int)blockIdx.x & 63) + 64 * p), RLX_AGENT) == me);
        F.grp_local = __builtin_amdgcn_readfirstlane((int)same) != 0; }
    RUNNB(5, PH5); RUNNB(6, PH6); RUNNB(7, PH7); RUNNB(8, PH8);
    if (IN(9)) {
        constexpr int NPC = 2 * (D / 256) * NS_DOWN; const int si = down_piece_of((int)blockIdx.x);
        if (si >= 0) { cnt_wait_ge(F, CW_T2S, (unsigned)NPC); ln_rows<true>(F, A, MP + si * (MS / NPC), MP + (si + 1) * (MS / NPC), F.wave, NWAVES); } }
#undef IN
#undef BOTH
}

extern "C" void kernel_launch(void* const* d_in, const int* in_sizes, int n_in, void* d_out, int out_size, void* d_ws, size_t ws_size, hipStream_t stream) {
    static int grid = 0;
    if (grid == 0) {
        if (n_in != 37 || in_sizes[0] != MP * D || out_size != (int)O_END || ws_size < WS_END) { fprintf(stderr, "kernel_launch: unexpected shapes (n_in %d, in0 %d, out %d, ws %zu)\n", n_in, n_in > 0 ? in_sizes[0] : -1, out_size, ws_size); grid = -1; return; }
        int dev = 0, cus = 0, per_cu = 0;
        if (hipGetDevice(&dev) != hipSuccess || hipDeviceGetAttribute(&cus, hipDeviceAttributeMultiprocessorCount, dev) != hipSuccess) { grid = -1; return; }
        if (hipFuncSetAttribute((const void*)fwd, hipFuncAttributeMaxDynamicSharedMemorySize, LDS_BYTES) != hipSuccess) { fprintf(stderr, "kernel_launch: hipFuncSetAttribute failed\n"); grid = -1; return; }
        if (hipOccupancyMaxActiveBlocksPerMultiprocessor(&per_cu, (const void*)fwd, NWAVES * 64, LDS_BYTES) != hipSuccess || per_cu < 1) { fprintf(stderr, "kernel_launch: occupancy query says %d\n", per_cu); }
        (void)hipGetLastError();
        grid = cus;
        if (grid < 256) { fprintf(stderr, "kernel_launch: this build needs 256 CUs (got %d)\n", grid); grid = -1; return; }
        grid = 256;
    }
    if (grid < 0) return;
    (void)hipMemsetAsync((char*)d_ws + WS_CTL, 0, CTL_ZERO_BYTES, stream);
    Args a{};
    for (int i = 0; i < 37; ++i) a.in[i] = (const float*)d_in[i];
    a.out = (float*)d_out; a.ws = (unsigned char*)d_ws;
    for (int li = 0; li < N_LAUNCHES; ++li) {
        if (N_LAUNCHES == 1) { a.ph_lo = 0; a.ph_hi = N_PHASES; } else { a.ph_lo = li; a.ph_hi = li + 1; }
        a.li = li;
        hipLaunchKernelGGL(fwd, dim3(grid), dim3(NWAVES * 64), LDS_BYTES, stream, a);
    }
}
```
